# Optimizing an MI355X kernel written in HIP

```python
import jax, jax.numpy as jnp
from jax import lax
import numpy as np

D_MODEL = 1024
BATCH = 8
SEQ = 2048
DEPTH = 1
DEC_BATCH = 128
DEC_SEQ = 4
PAST_LEN = 16384
PAGE_SIZE = 128

N_META = 16
EPS = 1e-6
H_A = 8
DK_A = 128
DV_A = 128
D_QK_A = H_A * DK_A
D_A = H_A * DV_A
CONV_W = 4
GDN_CHUNK = 64
GDN_QKV = 2 * D_QK_A + D_A
H_B = 16
N_B = 64
D_B = H_B * N_B
LORA_W = 64
LORA_A = 64
GN_EPS = N_B * 1e-5
RWKV_SHIFT = 3 * D_B + LORA_W + LORA_A + D_B
OFF_GDN_QKV = 0
OFF_GDN_A = OFF_GDN_QKV + GDN_QKV
OFF_GDN_B = OFF_GDN_A + H_A
OFF_GDN_Z = OFF_GDN_B + H_A
OFF_RWKV = OFF_GDN_Z + D_A
OFF_GATE = OFF_RWKV + RWKV_SHIFT
D_IN = OFF_GATE + 2 * D_MODEL

kernel_name = "hybrid_gdn_rwkv7_gated_merge_step"


def rmsnorm(x, w):
    xf = x.astype(jnp.float32)
    xf = xf * lax.rsqrt(jnp.mean(xf * xf, axis=-1, keepdims=True) + EPS)
    return (xf * w.astype(jnp.float32)).astype(x.dtype)


def l2norm(x):
    return x * lax.rsqrt(jnp.sum(x * x, axis=-1, keepdims=True) + 1e-6)


def gdn_chunked(q, k, v, g, beta, s0, chunk):
    B, T, H, DK = q.shape
    DV = v.shape[-1]
    n = T // chunk

    def to_chunks(t):
        return jnp.moveaxis(t.reshape((B, n, chunk) + t.shape[2:]), 3, 2)

    q, k, v, g, beta = (to_chunks(t) for t in (q, k, v, g, beta))
    gc = jnp.cumsum(g, axis=-1)
    tril = jnp.tril(jnp.ones((chunk, chunk), dtype=bool))
    strict = jnp.tril(jnp.ones((chunk, chunk), dtype=bool), k=-1)
    diff = gc[..., :, None] - gc[..., None, :]
    decay = jnp.where(tril, jnp.exp(jnp.where(tril, diff, 0.0)), 0.0)
    k_beta = k * beta[..., None]
    v_beta = v * beta[..., None]
    lower = jnp.where(strict, jnp.einsum('bnhik,bnhjk->bnhij', k_beta, k) * decay, 0.0)
    eye = jnp.eye(chunk, dtype=q.dtype)
    t_inv = lax.linalg.triangular_solve(eye + lower, jnp.broadcast_to(eye, lower.shape),
                                        left_side=True, lower=True)
    u = jnp.einsum('bnhij,bnhjv->bnhiv', t_inv, v_beta)
    w = jnp.einsum('bnhij,bnhjk->bnhik', t_inv, k_beta * jnp.exp(gc)[..., None])
    qk = jnp.where(tril, jnp.einsum('bnhik,bnhjk->bnhij', q, k) * decay, 0.0)
    g_last = gc[..., -1]
    k_tail = k * jnp.exp(g_last[..., None] - gc)[..., None]

    def step(s, inp):
        q_c, gc_c, u_c, w_c, qk_c, gl_c, kt_c = inp
        v_new = u_c - jnp.einsum('bhck,bhkv->bhcv', w_c, s)
        o = (jnp.einsum('bhck,bhkv->bhcv', q_c * jnp.exp(gc_c)[..., None], s)
             + jnp.einsum('bhij,bhjv->bhiv', qk_c, v_new))
        s = s * jnp.exp(gl_c)[..., None, None] + jnp.einsum('bhck,bhcv->bhkv', kt_c, v_new)
        return s, o

    xs = tuple(jnp.moveaxis(t, 1, 0) for t in (q, gc, u, w, qk, g_last, k_tail))
    s, o = lax.scan(step, s0, xs)
    o = jnp.transpose(o, (1, 0, 3, 2, 4)).reshape(B, T, H, DV)
    return o, s


def rwkv7_scan(r, w_log, k, v, kk, a, s0):
    def step(s, inp):
        r_t, w_t, k_t, v_t, kk_t, a_t = inp
        sa = jnp.einsum('bhvk,bhk->bhv', s, kk_t)
        s = (s * jnp.exp(w_t)[:, :, None, :] - sa[..., None] * (kk_t * a_t)[:, :, None, :]
             + v_t[..., None] * k_t[:, :, None, :])
        y = jnp.einsum('bhvk,bhk->bhv', s, r_t)
        return s, y

    xs = tuple(jnp.moveaxis(t, 1, 0) for t in (r, w_log, k, v, kk, a))
    s, ys = lax.scan(step, s0, xs)
    return jnp.moveaxis(ys, 0, 1), s


def hybrid_layer(x, x_prev, conv_buf, s_gdn, s_rwkv, front_pad, chunk,
                 ln1_w, w_in, gdn_conv_w, gdn_a_log, gdn_dt_bias, gdn_norm_w, w_out_a,
                 rwkv_mu, rwkv_w0, rwkv_w2, rwkv_a0, rwkv_a2, rwkv_k_k, rwkv_k_a, rwkv_r_k,
                 rwkv_gn_w, rwkv_gn_b, w_out_b, w_out):
    f32 = jnp.float32
    B, T, _ = x.shape
    h = rmsnorm(x, ln1_w)
    p = jnp.einsum('btd,de->bte', h, w_in)

    qkv_raw = p[..., OFF_GDN_QKV:OFF_GDN_A]
    conv_in = jnp.concatenate([conv_buf.astype(p.dtype), qkv_raw], axis=1)
    qkv = conv_in[:, 0:T] * gdn_conv_w[0]
    for i in range(1, CONV_W):
        qkv = qkv + conv_in[:, i:i + T] * gdn_conv_w[i]
    qkv = jax.nn.silu(qkv.astype(f32))
    q = l2norm(qkv[..., :D_QK_A].reshape(B, T, H_A, DK_A)) * (DK_A ** -0.5)
    k = l2norm(qkv[..., D_QK_A:2 * D_QK_A].reshape(B, T, H_A, DK_A))
    v = qkv[..., 2 * D_QK_A:].reshape(B, T, H_A, DV_A)
    g = -jnp.exp(gdn_a_log.astype(f32)) * jax.nn.softplus(
        p[..., OFF_GDN_A:OFF_GDN_B].astype(f32) + gdn_dt_bias.astype(f32))
    beta = jax.nn.sigmoid(p[..., OFF_GDN_B:OFF_GDN_Z].astype(f32))
    pad4 = ((0, 0), (front_pad, 0), (0, 0), (0, 0))
    pad3 = ((0, 0), (front_pad, 0), (0, 0))
    o_a, s_gdn_new = gdn_chunked(jnp.pad(q, pad4), jnp.pad(k, pad4), jnp.pad(v, pad4),
                                 jnp.pad(g, pad3), jnp.pad(beta, pad3), s_gdn.astype(f32), chunk)
    o_a = o_a[:, front_pad:]
    z_a = p[..., OFF_GDN_Z:OFF_RWKV].astype(f32).reshape(B, T, H_A, DV_A)
    o_a = rmsnorm(o_a, gdn_norm_w) * jax.nn.silu(z_a)
    branch_a = jnp.einsum('bte,ed->btd', o_a.reshape(B, T, D_A).astype(x.dtype), w_out_a)

    w_b = w_in[:, OFF_RWKV:OFF_GATE]
    pb = p[..., OFF_RWKV:OFF_GATE]
    pb_first = jnp.einsum('bd,de->be', x_prev.astype(h.dtype), w_b)
    pb_prev = jnp.concatenate([pb_first[:, None].astype(pb.dtype), pb[:, :-1]], axis=1)
    mix = (pb + rwkv_mu * (pb_prev - pb)).astype(f32)
    r = mix[..., 0:D_B]
    kb = mix[..., D_B:2 * D_B]
    vb = mix[..., 2 * D_B:3 * D_B]
    wd = mix[..., 3 * D_B:3 * D_B + LORA_W]
    ad = mix[..., 3 * D_B + LORA_W:3 * D_B + LORA_W + LORA_A]
    z_b = mix[..., 3 * D_B + LORA_W + LORA_A:]
    w_raw = rwkv_w0.astype(f32) + jnp.tanh(wd) @ rwkv_w2.astype(f32)
    w_log = -jnp.exp(-jax.nn.softplus(-w_raw) - 0.5)
    a = jax.nn.sigmoid(rwkv_a0.astype(f32) + ad @ rwkv_a2.astype(f32))
    kk = l2norm((kb * rwkv_k_k.astype(f32)).reshape(B, T, H_B, N_B))
    kb = kb * (1.0 + (a - 1.0) * rwkv_k_a.astype(f32))
    r4 = r.reshape(B, T, H_B, N_B)
    k4 = kb.reshape(B, T, H_B, N_B)
    v4 = vb.reshape(B, T, H_B, N_B)
    y, s_rwkv_new = rwkv7_scan(r4, w_log.reshape(B, T, H_B, N_B), k4, v4, kk,
                               a.reshape(B, T, H_B, N_B), s_rwkv.astype(f32))
    mu = jnp.mean(y, axis=-1, keepdims=True)
    var = jnp.mean(jnp.square(y - mu), axis=-1, keepdims=True)
    yn = (y - mu) * lax.rsqrt(var + GN_EPS)
    yn = yn.reshape(B, T, D_B) * rwkv_gn_w.astype(f32) + rwkv_gn_b.astype(f32)
    bonus = jnp.sum(r4 * k4 * rwkv_r_k.astype(f32), axis=-1, keepdims=True) * v4
    o_b = (yn + bonus.reshape(B, T, D_B)) * jax.nn.silu(z_b)
    branch_b = jnp.einsum('bte,ed->btd', o_b.astype(x.dtype), w_out_b)

    gates = jax.nn.sigmoid(p[..., OFF_GATE:].astype(f32))
    merged = gates[..., :D_MODEL] * branch_a.astype(f32) + gates[..., D_MODEL:] * branch_b.astype(f32)
    x_new = x + jnp.einsum('btd,de->bte', merged.astype(x.dtype), w_out)
    new_state = (s_gdn_new.astype(x.dtype), conv_in[:, T:].astype(x.dtype),
                 s_rwkv_new.astype(x.dtype), h[:, -1])
    return x_new, new_state


def setup_inputs(seed: int = 0) -> dict:
    key = jax.random.key(seed)
    ks = jax.random.split(key, 32)
    f32 = jnp.float32
    nrm = lambda i, shape, s: (jax.random.normal(ks[i], shape, f32) * s)
    dt = jnp.exp(jax.random.uniform(ks[10], (DEPTH, H_A), f32, np.log(1e-3), np.log(1e-1)))
    return {
        "x_prompt": nrm(0, (BATCH, SEQ, D_MODEL), 1.0),
        "x_sample": nrm(1, (DEC_BATCH, DEC_SEQ, D_MODEL), 1.0),
        "state_gdn": nrm(2, (DEPTH, DEC_BATCH, H_A, DK_A, DV_A), 0.1),
        "state_gdn_conv": nrm(3, (DEPTH, DEC_BATCH, CONV_W - 1, GDN_QKV), 1.0),
        "state_rwkv": nrm(4, (DEPTH, DEC_BATCH, H_B, N_B, N_B), 0.1),
        "state_shift": nrm(5, (DEPTH, DEC_BATCH, D_MODEL), 1.0),
        "meta_tokens": nrm(6, (N_META, D_MODEL), 1.0),
        "ln1_w": 1.0 + nrm(7, (DEPTH, D_MODEL), 0.02),
        "w_in": nrm(8, (DEPTH, D_MODEL, D_IN), D_MODEL ** -0.5),
        "gdn_conv_w": nrm(9, (DEPTH, CONV_W, GDN_QKV), CONV_W ** -0.5),
        "gdn_a_log": jnp.log(jax.random.uniform(ks[11], (DEPTH, H_A), f32, 1.0, 16.0)),
        "gdn_dt_bias": dt + jnp.log(-jnp.expm1(-dt)),
        "gdn_norm_w": 1.0 + nrm(12, (DEPTH, DV_A), 0.02),
        "w_out_a": nrm(13, (DEPTH, D_A, D_MODEL), D_A ** -0.5),
        "rwkv_mu": jax.random.uniform(ks[14], (DEPTH, RWKV_SHIFT), f32, 0.0, 1.0),
        "rwkv_w0": jax.random.uniform(ks[15], (DEPTH, D_B), f32, -5.0, 0.5),
        "rwkv_w2": nrm(16, (DEPTH, LORA_W, D_B), 0.1),
        "rwkv_a0": nrm(17, (DEPTH, D_B), 0.1),
        "rwkv_a2": nrm(18, (DEPTH, LORA_A, D_B), 0.1),
        "rwkv_k_k": 0.85 + nrm(19, (DEPTH, D_B), 0.02),
        "rwkv_k_a": 1.0 + nrm(20, (DEPTH, D_B), 0.02),
        "rwkv_r_k": nrm(21, (DEPTH, H_B, N_B), 0.1),
        "rwkv_gn_w": 1.0 + nrm(22, (DEPTH, D_B), 0.02),
        "rwkv_gn_b": nrm(23, (DEPTH, D_B), 0.01),
        "w_out_b": nrm(24, (DEPTH, D_B, D_MODEL), D_B ** -0.5),
        "w_out": nrm(25, (DEPTH, D_MODEL, D_MODEL), D_MODEL ** -0.5),
        "lnf_w": 1.0 + nrm(26, (D_MODEL,), 0.02),
    }


def reference(x_prompt, x_sample, state_gdn, state_gdn_conv, state_rwkv, state_shift,
              meta_tokens, ln1_w, w_in, gdn_conv_w, gdn_a_log, gdn_dt_bias, gdn_norm_w, w_out_a,
              rwkv_mu, rwkv_w0, rwkv_w2, rwkv_a0, rwkv_a2, rwkv_k_k, rwkv_k_a, rwkv_r_k,
              rwkv_gn_w, rwkv_gn_b, w_out_b, w_out, lnf_w):
    dt = x_prompt.dtype
    bp = x_prompt.shape[0]
    xp = jnp.concatenate([jnp.broadcast_to(meta_tokens.astype(dt)[None], (bp, N_META, D_MODEL)),
                          x_prompt], axis=1)
    xs = x_sample
    front_pad = (-N_META) % GDN_CHUNK
    prompt_states = []
    sample_states = []
    for l in range(DEPTH):
        lw = (ln1_w[l], w_in[l], gdn_conv_w[l], gdn_a_log[l], gdn_dt_bias[l], gdn_norm_w[l], w_out_a[l],
              rwkv_mu[l], rwkv_w0[l], rwkv_w2[l], rwkv_a0[l], rwkv_a2[l], rwkv_k_k[l], rwkv_k_a[l],
              rwkv_r_k[l], rwkv_gn_w[l], rwkv_gn_b[l], w_out_b[l], w_out[l])
        xp, st_p = hybrid_layer(xp, jnp.zeros((bp, D_MODEL), dt),
                                jnp.zeros((bp, CONV_W - 1, GDN_QKV), dt),
                                jnp.zeros((bp, H_A, DK_A, DV_A), dt),
                                jnp.zeros((bp, H_B, N_B, N_B), dt),
                                front_pad, GDN_CHUNK, *lw)
        xs, st_s = hybrid_layer(xs, state_shift[l], state_gdn_conv[l], state_gdn[l], state_rwkv[l],
                                0, xs.shape[1], *lw)
        prompt_states.append(st_p)
        sample_states.append(st_s)
    y_prompt = rmsnorm(xp[:, N_META:], lnf_w)
    y_sample = rmsnorm(xs, lnf_w)
    new_gdn_prompt = jnp.stack([s[0] for s in prompt_states])
    new_conv_prompt = jnp.stack([s[1] for s in prompt_states])
    new_rwkv_prompt = jnp.stack([s[2] for s in prompt_states])
    new_shift_prompt = jnp.stack([s[3] for s in prompt_states])
    new_gdn_sample = jnp.stack([s[0] for s in sample_states])
    new_conv_sample = jnp.stack([s[1] for s in sample_states])
    new_rwkv_sample = jnp.stack([s[2] for s in sample_states])
    new_shift_sample = jnp.stack([s[3] for s in sample_states])
    return (y_prompt, y_sample, new_gdn_prompt, new_conv_prompt, new_rwkv_prompt, new_shift_prompt,
            new_gdn_sample, new_conv_sample, new_rwkv_sample, new_shift_sample)
```

```cpp
#include <hip/hip_runtime.h>
#include <hip/hip_cooperative_groups.h>
#include <cstdio>
namespace cg = cooperative_groups;

#define LAS __attribute__((address_space(3)))
typedef unsigned short bf16_t;
typedef short bf16x8 __attribute__((ext_vector_type(8)));
typedef float f32x4 __attribute__((ext_vector_type(4)));
typedef unsigned u32x4 __attribute__((ext_vector_type(4)));
typedef unsigned u32x2 __attribute__((ext_vector_type(2)));

constexpr int D = 1024;
constexpr int NBATCH = 8, SEQ = 2048, NMETA = 16, DECB = 128, DECT = 4;
constexpr int XROWS = NBATCH * SEQ;
constexpr int EX_SAMP = 16, EX_SHIFT = 528, EX_END = 656;
constexpr int HROWS = 17152, HTILES = 67;
constexpr int NSEG = 4, SEGTOK = SEQ / NSEG;
constexpr int TPB = SEGTOK / 256;
constexpr int LT_PROMPT = NBATCH * TPB;
constexpr int LEX0 = LT_PROMPT * 256;
constexpr int LROWS = LEX0 + 768;
constexpr int NP = 10496, NPB = 8448, NT_IN = 41, NT_PB = 33;
constexpr int C_A = 3072, C_B = 3080, C_Z = 3088, C_RW = 4112, C_GATE_REF = 8336;
constexpr int RW_SHIFT = 4224;

constexpr size_t O_YP = 0, O_YS = 16777216, O_GDN_P = 17301504, O_CONV_P = 18350080, O_RWKV_P = 18423808, O_SHIFT_P = 18948096,
                 O_GDN_S = 18956288, O_CONV_S = 35733504, O_RWKV_S = 36913152, O_SHIFT_S = 45301760;

constexpr size_t al256(size_t x) { return (x + 255) & ~(size_t)255; }
constexpr size_t WS_WT_IN = 0;
constexpr size_t WS_WT_A = al256(WS_WT_IN + (size_t)NP * D * 2);
constexpr size_t WS_WT_B = al256(WS_WT_A + (size_t)D * D * 2);
constexpr size_t WS_WT_O = al256(WS_WT_B + (size_t)D * D * 2);
constexpr size_t WS_H = al256(WS_WT_O + (size_t)D * D * 2);
constexpr size_t WS_OB = al256(WS_H + (size_t)HROWS * D * 2);
constexpr size_t WS_P = al256(WS_OB + (size_t)HROWS * D * 2);
constexpr size_t WS_ORAW = al256(WS_P + (size_t)LROWS * NPB * 2);
constexpr size_t WS_YRAW = al256(WS_ORAW + (size_t)LROWS * D * 4);
constexpr size_t WS_C0 = al256(WS_YRAW + (size_t)LROWS * D * 4);
constexpr size_t WS_C1 = al256(WS_C0 + (size_t)LROWS * D * 2);
constexpr size_t WS_GEX = al256(WS_C1 + (size_t)LROWS * D * 2);
constexpr size_t WS_CHALO = al256(WS_GEX + (size_t)768 * 2048 * 2);
constexpr size_t WS_PHALO = al256(WS_CHALO + (size_t)2 * NBATCH * 3 * 3072 * 4);
constexpr size_t WS_PK = al256(WS_PHALO + (size_t)2 * NBATCH * RW_SHIFT * 4);
constexpr int PK_CONVW = 0, PK_ALOG = 12288, PK_DTB = 12296, PK_NORMW = 12304, PK_MU = 12432, PK_W0 = 16656, PK_W2 = 17680, PK_A0 = 83216, PK_A2 = 84240,
              PK_KK = 149776, PK_KA = 150800, PK_RK = 151824, PK_GNW = 152848, PK_GNB = 153872, PK_LNF = 154896, PK_END = 155920;
constexpr size_t WS_END = al256(WS_PK + (size_t)PK_END * 4);
static_assert((size_t)HROWS * D * 4 <= (size_t)LROWS * NPB * 2, "TMP must fit in P");
static_assert((size_t)HROWS * D * 2 <= 2 * (size_t)LROWS * D * 4, "MERGED must fit in ORAW+YRAW");
static_assert(WS_END <= (size_t)268435456, "workspace");

struct Params { const float* in[27]; float* out; unsigned char* ws; };

__device__ __forceinline__ float bf2f(bf16_t v) { return __uint_as_float(((unsigned)v) << 16); }
__device__ __forceinline__ unsigned f2bf(float f) { unsigned u = __float_as_uint(f); u += 0x7fffu + ((u >> 16) & 1u); return u >> 16; }
__device__ __forceinline__ unsigned pk2(float lo, float hi) { return f2bf(lo) | (f2bf(hi) << 16); }
__device__ __forceinline__ unsigned cvt_pk_bf16(float lo, float hi) { unsigned r; asm volatile("v_cvt_pk_bf16_f32 %0, %1, %2" : "=v"(r) : "v"(lo), "v"(hi)); return r; }
__device__ __forceinline__ float sigm(float x) { return 1.f / (1.f + __expf(-x)); }
__device__ __forceinline__ float silu_(float x) { return x / (1.f + __expf(-x)); }
__device__ __forceinline__ float softplus_(float x) { return fmaxf(x, 0.f) + log1pf(expf(-fabsf(x))); }
__device__ __forceinline__ float wave_sum(float v) {
#pragma unroll
    for (int o = 1; o < 64; o <<= 1) v += __shfl_xor(v, o);
    return v;
}
__device__ __forceinline__ int otid() { int t = threadIdx.x; asm volatile("" : "+v"(t)); return t; }
__device__ __forceinline__ int obid() { int t = blockIdx.x; asm volatile("" : "+s"(t)); return t; }
__device__ __forceinline__ float tanh_(float x) { const float e = __expf(2.f * x); return 1.f - 2.f / (e + 1.f); }
template <int CTRL> __device__ __forceinline__ float dppf(float x) { return __builtin_bit_cast(float, __builtin_amdgcn_mov_dpp(__builtin_bit_cast(int, x), CTRL, 0xf, 0xf, true)); }
__device__ __forceinline__ float rowsum16(float x) { x += dppf<0x128>(x); x += dppf<0x124>(x); x += dppf<0x122>(x); x += dppf<0x121>(x); return x; }

namespace pg8 {
constexpr int BM = 256, BK = 64, HALF = 128, HTB = HALF * BK * 2, STAGE_BYTES = 8 * HTB, NXCD = 8, WGM = 8;
__device__ __forceinline__ int lds_byte(int r, int c) { const int st = (r >> 4) * 2 + (c >> 5), rr = r & 15, cc = c & 31, ob = rr * 64 + cc * 2; return st * 1024 + (ob ^ (((ob >> 9) & 1) << 5)); }
__device__ __forceinline__ void stage_rc(int b, int& R, int& C) { const int st = b / 1024, sb = b % 1024, swz = sb ^ (((sb >> 9) & 1) << 5); R = (st >> 1) * 16 + swz / 64; C = (st & 1) * 32 + (swz % 64) / 2; }
__device__ __forceinline__ int perm32(int rho) { const int n = rho >> 4, i = rho & 15; return 8 * (i >> 2) + 4 * n + (i & 3); }

struct Unit { int pm, pn, w; };
struct OrderBase {
    int nM, nN, nwg, G, c;
    __device__ void init(int nM_, int nN_, int G_, int c_) { nM = nM_; nN = nN_; nwg = nM * nN; G = G_; c = c_; }
    __device__ bool nextb(int i, Unit& u) const {
        const long L = (long)i * G + c; if (L >= nwg) return false;
        int wgid = (int)L; { const int q = nwg / NXCD, r = nwg % NXCD, xcd = wgid % NXCD, off = wgid / NXCD; wgid = (xcd < r ? xcd * (q + 1) : r * (q + 1) + (xcd - r) * q) + off; }
        const int nig = WGM * nN, gid = wgid / nig, fm = gid * WGM, gsz = (nM - fm) < WGM ? (nM - fm) : WGM;
        u.pm = fm + ((wgid % nig) % gsz); u.pn = (wgid % nig) / gsz; u.w = 0; return true;
    }
};

template <class Epi, class Sched>
__device__ __forceinline__ void gemm_phase(LAS unsigned char* lds, const int K, const Sched& S, const Epi& E) {
    const int tid = otid(), wid = __builtin_amdgcn_readfirstlane(tid >> 6), lane = tid & 63, wr = wid >> 2, wc = wid & 3, fr = lane & 15, fq = lane >> 4;
    const int nt = K / BK;
    unsigned voffA[2], voffB[2];
#pragma unroll
    for (int i = 0; i < 2; ++i) { int R, C; stage_rc(tid * 16 + i * 8192, R, C); const int Rb = Epi::PERM ? ((R & ~31) + perm32(R & 31)) : R;
        voffA[i] = (unsigned)(R * K + C) * 2u; voffB[i] = (unsigned)(Rb * K + C) * 2u; }
    const size_t kstep = (size_t)(BK * 2);
    const size_t hstep = (size_t)HALF * K * 2;
    const unsigned ldsw = (unsigned)wid * 1024u;
    const int aoff = lds_byte(wr * 64 + fr, fq * 8), boff = lds_byte(wc * 32 + fr, fq * 8);
#define PG8_SA(b, h) (((b) * 2 + (h)) * HTB)
#define PG8_SB(b, h) ((4 + (b) * 2 + (h)) * HTB)
#define PG8_STAGE(bufoff, gbase, voff) do { _Pragma("unroll") for (int _i = 0; _i < 2; ++_i) \
        __builtin_amdgcn_global_load_lds((const unsigned*)((const char*)(gbase) + (voff)[_i]), (LAS unsigned*)(lds + (bufoff) + ldsw + _i * 8192), 16, 0, 0); } while (0)
#define PG8_LDA(dst, b, h) do { _Pragma("unroll") for (int m = 0; m < 4; ++m) _Pragma("unroll") for (int k = 0; k < 2; ++k) dst[m][k] = *(const LAS bf16x8*)(lds + PG8_SA(b, h) + aoff + m * 2048 + k * 1024); } while (0)
#define PG8_LDB(dst, b, h) do { _Pragma("unroll") for (int n = 0; n < 2; ++n) _Pragma("unroll") for (int k = 0; k < 2; ++k) dst[n][k] = *(const LAS bf16x8*)(lds + PG8_SB(b, h) + boff + n * 2048 + k * 1024); } while (0)
#define PG8_MMA(ai, bj, At, Bt) do { __builtin_amdgcn_s_setprio(1); _Pragma("unroll") for (int m = 0; m < 4; ++m) _Pragma("unroll") for (int n = 0; n < 2; ++n) _Pragma("unroll") for (int k = 0; k < 2; ++k) \
        acc[ai][bj][m][n] = __builtin_amdgcn_mfma_f32_16x16x32_bf16(Bt[n][k], At[m][k], acc[ai][bj][m][n], 0, 0, 0); __builtin_amdgcn_s_setprio(0); } while (0)
#define PG8_WAIT_V(n) asm volatile("s_waitcnt vmcnt(" #n ")" ::: "memory")
#define PG8_WAIT_L(n) asm volatile("s_waitcnt lgkmcnt(" #n ")" ::: "memory")
#define PG8_BAR __builtin_amdgcn_s_barrier()
#define PG8_SCHED __builtin_amdgcn_sched_barrier(0)
    Unit cur, nxt; int ui = 0;
    if (!S.next(0, cur)) return;
    f32x4 acc[2][2][4][2];
#pragma unroll
    for (int a = 0; a < 2; ++a)
#pragma unroll
        for (int b = 0; b < 2; ++b)
#pragma unroll
            for (int m = 0; m < 4; ++m)
#pragma unroll
                for (int n = 0; n < 2; ++n) acc[a][b][m][n] = (f32x4){0.f, 0.f, 0.f, 0.f};
    bf16x8 At[4][2], B0[2][2], B1[2][2];
    const char* cA = S.a_ptr(cur); const char* cB = S.b_ptr(cur);
    PG8_STAGE(PG8_SB(0, 0), cB, voffB); PG8_STAGE(PG8_SA(0, 0), cA, voffA); PG8_STAGE(PG8_SB(0, 1), cB + hstep, voffB); PG8_STAGE(PG8_SA(0, 1), cA + hstep, voffA);
    if (wr == 1) PG8_BAR;
    PG8_WAIT_V(4); PG8_BAR;
    PG8_STAGE(PG8_SB(1, 0), cB + kstep, voffB); PG8_STAGE(PG8_SA(1, 0), cA + kstep, voffA); PG8_STAGE(PG8_SB(1, 1), cB + hstep + kstep, voffB);
    PG8_WAIT_V(6); PG8_BAR;
    for (;;) {
        const bool has_next = S.next(ui + 1, nxt);
        const char* nA = has_next ? S.a_ptr(nxt) : cA; const char* nB = has_next ? S.b_ptr(nxt) : cB;
        for (int t = 0; t < nt; t += 2) {
            const bool last = (t == nt - 2);
            const char* a1 = cA + (size_t)(t + 1) * kstep;
            const char* a2 = last ? nA : cA + (size_t)(t + 2) * kstep; const char* b2 = last ? nB : cB + (size_t)(t + 2) * kstep;
            const char* a3 = a2 + kstep; const char* b3 = b2 + kstep;
            PG8_LDB(B0, 0, 0); PG8_SCHED; PG8_LDA(At, 0, 0); PG8_STAGE(PG8_SA(1, 1), a1 + hstep, voffA);
            PG8_WAIT_L(8); PG8_BAR; PG8_WAIT_L(0); PG8_MMA(0, 0, At, B0); PG8_BAR; PG8_SCHED;
            PG8_LDB(B1, 0, 1); PG8_STAGE(PG8_SB(0, 0), b2, voffB);
            PG8_BAR; PG8_WAIT_L(0); PG8_MMA(0, 1, At, B1); PG8_BAR;
            PG8_LDA(At, 0, 1); PG8_STAGE(PG8_SA(0, 0), a2, voffA);
            PG8_BAR; PG8_WAIT_L(0); PG8_MMA(1, 0, At, B0); PG8_BAR; PG8_SCHED;
            PG8_STAGE(PG8_SB(0, 1), b2 + hstep, voffB);
            PG8_WAIT_V(6); PG8_BAR; PG8_MMA(1, 1, At, B1); PG8_BAR;
            PG8_LDB(B0, 1, 0); PG8_SCHED; PG8_LDA(At, 1, 0); PG8_STAGE(PG8_SA(0, 1), a2 + hstep, voffA);
            PG8_WAIT_L(8); PG8_BAR; PG8_WAIT_L(0); PG8_MMA(0, 0, At, B0); PG8_BAR; PG8_SCHED;
            PG8_LDB(B1, 1, 1); PG8_STAGE(PG8_SB(1, 0), b3, voffB);
            PG8_BAR; PG8_WAIT_L(0); PG8_MMA(0, 1, At, B1); PG8_BAR;
            PG8_LDA(At, 1, 1); PG8_STAGE(PG8_SA(1, 0), a3, voffA);
            PG8_BAR; PG8_WAIT_L(0); PG8_MMA(1, 0, At, B0); PG8_BAR; PG8_SCHED;
            PG8_STAGE(PG8_SB(1, 1), b3 + hstep, voffB);
            PG8_WAIT_V(6); PG8_BAR; PG8_MMA(1, 1, At, B1); PG8_BAR;
        }
        E(acc, cur, wr, wc, fr, fq);
        if (!has_next) break;
#pragma unroll
        for (int a = 0; a < 2; ++a)
#pragma unroll
            for (int b = 0; b < 2; ++b)
#pragma unroll
                for (int m = 0; m < 4; ++m)
#pragma unroll
                    for (int n = 0; n < 2; ++n) acc[a][b][m][n] = (f32x4){0.f, 0.f, 0.f, 0.f};
        cur = nxt; cA = nA; cB = nB; ++ui;
    }
    PG8_WAIT_V(0);
    if (wr == 0) PG8_BAR;
    PG8_BAR;
#undef PG8_SA
#undef PG8_SB
#undef PG8_STAGE
#undef PG8_LDA
#undef PG8_LDB
#undef PG8_MMA
#undef PG8_WAIT_V
#undef PG8_WAIT_L
#undef PG8_BAR
#undef PG8_SCHED
}
}
using pg8::Unit;

struct SchedIn {
    pg8::OrderBase ob; int seg; const char* A; const char* B;
    __device__ bool next(int i, Unit& u) const { return ob.nextb(i, u); }
    __device__ const char* a_ptr(const Unit& u) const {
        const int gt = u.pm < LT_PROMPT ? ((u.pm / TPB) * (SEQ / 256) + seg * TPB + (u.pm % TPB)) : (XROWS / 256 + (u.pm - LT_PROMPT));
        return A + (size_t)gt * 256 * D * 2; }
    __device__ const char* b_ptr(const Unit& u) const { return B + (size_t)u.pn * 256 * D * 2; }
};
struct SchedAB {
    pg8::OrderBase ob; const char* A0; const char* A1; const char* B0; const char* B1;
    __device__ bool next(int i, Unit& u) const { const bool ok = ob.nextb(i >> 1, u); u.w = i & 1; return ok; }
    __device__ const char* a_ptr(const Unit& u) const { return (u.w ? A1 : A0) + (size_t)u.pm * 256 * D * 2; }
    __device__ const char* b_ptr(const Unit& u) const { return (u.w ? B1 : B0) + (size_t)u.pn * 256 * D * 2; }
};
struct SchedO {
    pg8::OrderBase ob; const char* A; const char* B;
    __device__ bool next(int i, Unit& u) const { return ob.nextb(i, u); }
    __device__ const char* a_ptr(const Unit& u) const { return A + (size_t)u.pm * 256 * D * 2; }
    __device__ const char* b_ptr(const Unit& u) const { return B + (size_t)u.pn * 256 * D * 2; }
};

struct EpiIn {
    static constexpr bool PERM = true;
    bf16_t* P; bf16_t* gex; float* out; int seg;
    __device__ __forceinline__ void operator()(const f32x4 (&acc)[2][2][4][2], const Unit& u, int wr, int wc, int fr, int fq) const {
        const int lr0 = u.pm * 256 + wr * 64 + fr;
        const int c0 = u.pn * 256 + wc * 32 + 8 * fq;
#pragma unroll
        for (int ai = 0; ai < 2; ++ai)
#pragma unroll
            for (int m = 0; m < 4; ++m) {
                const int lr = lr0 + ai * 128 + m * 16;
                bf16_t* rowp;
                if (u.pn < NT_PB) rowp = P + (size_t)lr * NPB + c0;
                else if (lr < LEX0) { const int b = lr / SEGTOK; const size_t grow = (size_t)b * SEQ + seg * SEGTOK + (lr % SEGTOK); rowp = (bf16_t*)(out + O_YP + grow * D) + (c0 - NPB); }
                else rowp = gex + (size_t)(lr - LEX0) * 2048 + (c0 - NPB);
#pragma unroll
                for (int bj = 0; bj < 2; ++bj) { const f32x4 v0 = acc[ai][bj][m][0], v1 = acc[ai][bj][m][1];
                    u32x4 w; w.x = cvt_pk_bf16(v0[0], v0[1]); w.y = cvt_pk_bf16(v0[2], v0[3]); w.z = cvt_pk_bf16(v1[0], v1[1]); w.w = cvt_pk_bf16(v1[2], v1[3]);
                    *(u32x4*)(rowp + bj * 128) = w; }
            }
    }
};
struct EpiAB {
    static constexpr bool PERM = false;
    float* tmp; bf16_t* merged; const bf16_t* gex; const float* out;
    __device__ __forceinline__ void operator()(const f32x4 (&acc)[2][2][4][2], const Unit& u, int wr, int wc, int fr, int fq) const {
        const int row0 = u.pm * 256 + wr * 64 + fr, col0 = u.pn * 256 + wc * 32 + 4 * fq;
#pragma unroll
        for (int ai = 0; ai < 2; ++ai)
#pragma unroll
            for (int m = 0; m < 4; ++m) {
                const int grow = row0 + ai * 128 + m * 16;
                const bf16_t* gp = (grow < XROWS) ? ((const bf16_t*)(out + O_YP + (size_t)grow * D) + u.w * D) : (gex + (size_t)(grow - XROWS) * 2048 + u.w * D);
#pragma unroll
                for (int bj = 0; bj < 2; ++bj)
#pragma unroll
                    for (int n = 0; n < 2; ++n) {
                        const int c = col0 + bj * 128 + n * 16;
                        const u32x2 g = *(const u32x2*)(gp + c);
                        f32x4 v = acc[ai][bj][m][n];
                        v[0] *= sigm(__uint_as_float(g.x << 16)); v[1] *= sigm(__uint_as_float(g.x & 0xffff0000u));
                        v[2] *= sigm(__uint_as_float(g.y << 16)); v[3] *= sigm(__uint_as_float(g.y & 0xffff0000u));
                        float* tp = tmp + (size_t)grow * D + c;
                        if (u.w == 0) *(f32x4*)tp = v;
                        else { const f32x4 t = *(const f32x4*)tp; v = v + t; u32x2 o; o.x = cvt_pk_bf16(v[0], v[1]); o.y = cvt_pk_bf16(v[2], v[3]); *(u32x2*)(merged + (size_t)grow * D + c) = o; }
                    }
            }
    }
};
struct EpiO {
    static constexpr bool PERM = false;
    float* out; const float* xp; const float* xs;
    __device__ __forceinline__ void operator()(const f32x4 (&acc)[2][2][4][2], const Unit& u, int wr, int wc, int fr, int fq) const {
        const int row0 = u.pm * 256 + wr * 64 + fr, col0 = u.pn * 256 + wc * 32 + 4 * fq;
#pragma unroll
        for (int ai = 0; ai < 2; ++ai)
#pragma unroll
            for (int m = 0; m < 4; ++m) {
                const int grow = row0 + ai * 128 + m * 16;
                const float* xr; float* yr;
                if (grow < XROWS) { xr = xp + (size_t)grow * D; yr = out + O_YP + (size_t)grow * D; }
                else { const int e = grow - XROWS; if (e < EX_SAMP || e >= EX_SHIFT) continue; xr = xs + (size_t)(e - EX_SAMP) * D; yr = out + O_YS + (size_t)(e - EX_SAMP) * D; }
#pragma unroll
                for (int bj = 0; bj < 2; ++bj)
#pragma unroll
                    for (int n = 0; n < 2; ++n) { const int c = col0 + bj * 128 + n * 16; *(f32x4*)(yr + c) = *(const f32x4*)(xr + c) + acc[ai][bj][m][n]; }
            }
    }
};

__device__ __forceinline__ void p0_row(const Params& p, int r, int lane) {
    bf16_t* hrow = (bf16_t*)(p.ws + WS_H) + (size_t)r * D;
    const float* src = nullptr; bool norm = true; float* sh = nullptr;
    if (r < XROWS) { src = p.in[0] + (size_t)r * D; if ((r & (SEQ - 1)) == SEQ - 1) sh = p.out + O_SHIFT_P + (size_t)(r / SEQ) * D; }
    else { const int e = r - XROWS;
        if (e < EX_SAMP) src = p.in[6] + (size_t)e * D;
        else if (e < EX_SHIFT) { src = p.in[1] + (size_t)(e - EX_SAMP) * D; if (((e - EX_SAMP) & 3) == 3) sh = p.out + O_SHIFT_S + (size_t)((e - EX_SAMP) >> 2) * D; }
        else if (e < EX_END) { src = p.in[5] + (size_t)(e - EX_SHIFT) * D; norm = false; } }
    u32x2* o8 = (u32x2*)hrow + lane;
    if (!src) {
#pragma unroll
        for (int j = 0; j < 4; ++j) o8[64 * j] = (u32x2){0u, 0u};
        return; }
    const f32x4* xr = (const f32x4*)src + lane;
    f32x4 v[4]; float ss = 0.f;
#pragma unroll
    for (int j = 0; j < 4; ++j) { v[j] = xr[64 * j]; ss += v[j][0] * v[j][0] + v[j][1] * v[j][1] + v[j][2] * v[j][2] + v[j][3] * v[j][3]; }
    if (norm) {
        const float rs = rsqrtf(wave_sum(ss) * (1.f / D) + 1e-6f);
        const f32x4* wr = (const f32x4*)p.in[7] + lane;
#pragma unroll
        for (int j = 0; j < 4; ++j) v[j] = v[j] * rs * wr[64 * j];
    }
#pragma unroll
    for (int j = 0; j < 4; ++j) { o8[64 * j] = (u32x2){pk2(v[j][0], v[j][1]), pk2(v[j][2], v[j][3])}; if (sh) ((f32x4*)sh)[lane + 64 * j] = v[j]; }
}
template <int MODE> __device__ __forceinline__ void p0_tr_item(const float* W, int N, bf16_t* WT, float* scr, int kb, int nb, int lane) {
    const int k0 = 64 * kb, n0 = 32 * nb;
    const int nn = n0 + (lane & 31);
    int srcc = nn;
    if (MODE == 1) srcc = nn < C_GATE_REF ? nn : (nn < NPB ? -1 : nn - (NPB - C_GATE_REF));
#pragma unroll 8
    for (int i = 0; i < 32; ++i) { const int kk = 2 * i + (lane >> 5); scr[kk * 33 + (lane & 31)] = srcc >= 0 ? W[(size_t)(k0 + kk) * N + srcc] : 0.f; }
    asm volatile("s_waitcnt lgkmcnt(0)" ::: "memory");
    const int c = lane & 7;
#pragma unroll
    for (int j = 0; j < 4; ++j) { const int n = (lane >> 3) + 8 * j; const float* s = scr + (8 * c) * 33 + n;
        u32x4 o; o.x = pk2(s[0 * 33], s[1 * 33]); o.y = pk2(s[2 * 33], s[3 * 33]); o.z = pk2(s[4 * 33], s[5 * 33]); o.w = pk2(s[6 * 33], s[7 * 33]);
        *(u32x4*)(WT + (size_t)(n0 + n) * D + k0 + 8 * c) = o; }
    asm volatile("s_waitcnt lgkmcnt(0)" ::: "memory");
}
__device__ __forceinline__ void phase0(const Params& p, unsigned char* smem) {
    const int tid0 = otid(), wave = tid0 >> 6, lane = tid0 & 63;
    const int gw = obid() * 8 + wave, NGW = gridDim.x * 8;
    float* scr = (float*)smem + wave * (64 * 33);
    constexpr int I_IN = 16 * (NP / 32), I_SQ = 16 * 32;
    for (int it = gw; it < I_IN + 3 * I_SQ; it += NGW) {
        int r = it;
        if (r < I_IN) { p0_tr_item<1>(p.in[8], 10384, (bf16_t*)(p.ws + WS_WT_IN), scr, r / (NP / 32), r % (NP / 32), lane); continue; } r -= I_IN;
        if (r < I_SQ) { p0_tr_item<0>(p.in[13], D, (bf16_t*)(p.ws + WS_WT_A), scr, r / 32, r % 32, lane); continue; } r -= I_SQ;
        if (r < I_SQ) { p0_tr_item<0>(p.in[24], D, (bf16_t*)(p.ws + WS_WT_B), scr, r / 32, r % 32, lane); continue; } r -= I_SQ;
        p0_tr_item<0>(p.in[25], D, (bf16_t*)(p.ws + WS_WT_O), scr, r / 32, r % 32, lane);
    }
    for (int r = gw; r < HROWS; r += NGW) p0_row(p, r, lane);
    {
        float* pk = (float*)(p.ws + WS_PK);
        const int gt = obid() * 512 + tid0, NT = gridDim.x * 512;
#define PKCOPY(off, idx, n) for (int i = gt; i < (n); i += NT) pk[(off) + i] = p.in[idx][i];
        PKCOPY(PK_CONVW, 9, 12288) PKCOPY(PK_ALOG, 10, 8) PKCOPY(PK_DTB, 11, 8) PKCOPY(PK_NORMW, 12, 128) PKCOPY(PK_MU, 14, 4224) PKCOPY(PK_W0, 15, 1024)
        PKCOPY(PK_W2, 16, 65536) PKCOPY(PK_A0, 17, 1024) PKCOPY(PK_A2, 18, 65536) PKCOPY(PK_KK, 19, 1024) PKCOPY(PK_KA, 20, 1024) PKCOPY(PK_RK, 21, 1024)
        PKCOPY(PK_GNW, 22, 1024) PKCOPY(PK_GNB, 23, 1024) PKCOPY(PK_LNF, 26, 1024)
#undef PKCOPY
    }
}

__device__ __forceinline__ void gdn_item(const Params& p, unsigned char* smem, const float* s_in, float* s_out, const float* halo_in, float* halo_out,
                                         int h, int sl, int rowA, int nA, int rowB, int nB) {
    const int tid = otid(), w = tid >> 6, lane = tid & 63, vl = lane >> 4, kg = lane & 15;
    float* qk_s = (float*)smem; float* v_s = qk_s + 16384; float* o_s = v_s + 2048; float* gb_s = o_s + 2048; float* sst = gb_s + 128;
    const bf16_t* P = (const bf16_t*)(p.ws + WS_P);
    float* ORAW = (float*)(p.ws + WS_ORAW);
    float s[8];
    if (s_in) {
        { const int k = tid >> 2, q4 = tid & 3; const f32x4* src = (const f32x4*)(s_in + (size_t)k * 128 + sl * 32 + q4 * 8); const f32x4 a = src[0], b = src[1];
          float* d = sst + k * 33 + q4 * 8; d[0] = a[0]; d[1] = a[1]; d[2] = a[2]; d[3] = a[3]; d[4] = b[0]; d[5] = b[1]; d[6] = b[2]; d[7] = b[3]; }
        __syncthreads();
#pragma unroll
        for (int j = 0; j < 8; ++j) s[j] = sst[(kg * 8 + j) * 33 + 4 * w + vl];
        __syncthreads();
    } else {
#pragma unroll
        for (int j = 0; j < 8; ++j) s[j] = 0.f;
    }
    int pcol = -1;
    if (tid < 128) pcol = h * 128 + tid; else if (tid < 256) pcol = 1024 + h * 128 + (tid - 128); else if (tid < 288) pcol = 2048 + h * 128 + sl * 32 + (tid - 256);
    float cw0 = 0.f, cw1 = 0.f, cw2 = 0.f, cw3 = 0.f, x1 = 0.f, x2 = 0.f, x3 = 0.f;
    const float* pk = (const float*)(p.ws + WS_PK);
    if (pcol >= 0) { const float* cw = pk + PK_CONVW; cw0 = cw[pcol]; cw1 = cw[3072 + pcol]; cw2 = cw[6144 + pcol]; cw3 = cw[9216 + pcol];
        if (halo_in) { x3 = halo_in[pcol]; x2 = halo_in[3072 + pcol]; x1 = halo_in[6144 + pcol]; } }
    const float nalog = -expf(pk[PK_ALOG + h]), dtb = pk[PK_DTB + h];
#pragma unroll 1
    for (int run = 0; run < 2; ++run) {
        const int rrow = run ? rowB : rowA, rn = run ? nB : nA; const bool wout = run != 0;
#pragma unroll 1
        for (int c0 = 0; c0 < rn; c0 += 64) {
            const int nt = (rn - c0) < 64 ? (rn - c0) : 64; const int row = rrow + c0;
            if (pcol >= 0) {
                const bf16_t* src = P + (size_t)row * NPB + pcol;
                float* dst = tid < 256 ? (qk_s + tid) : (v_s + (tid - 256)); const int dstride = tid < 256 ? 256 : 32;
#pragma unroll 8
                for (int i = 0; i < nt; ++i) { const float x0 = bf2f(src[(size_t)i * NPB]); const float y = cw0 * x3 + cw1 * x2 + cw2 * x1 + cw3 * x0; x3 = x2; x2 = x1; x1 = x0; dst[i * dstride] = silu_(y); }
            } else if (tid < 352) {
                const int i = tid - 288;
                if (i < nt) { const float pa = bf2f(P[(size_t)(row + i) * NPB + C_A + h]), pb = bf2f(P[(size_t)(row + i) * NPB + C_B + h]);
                    gb_s[2 * i] = expf(nalog * softplus_(pa + dtb)); gb_s[2 * i + 1] = sigm(pb); }
            }
            __syncthreads();
#pragma unroll 1
            for (int ii = 0; ii < 8; ++ii) { const int i = w * 8 + ii;
                if (i < nt) {
#pragma unroll
                    for (int which = 0; which < 2; ++which) { float* rp = qk_s + i * 256 + which * 128; const float a = rp[lane], b = rp[lane + 64];
                        const float sc = rsqrtf(wave_sum(a * a + b * b) + 1e-6f) * (which == 0 ? 0.08838834764831845f : 1.f); rp[lane] = a * sc; rp[lane + 64] = b * sc; } } }
            __syncthreads();
#pragma unroll 1
            for (int i = 0; i < nt; ++i) {
                const f32x4 q0 = *(const f32x4*)(qk_s + i * 256 + kg * 8), q1 = *(const f32x4*)(qk_s + i * 256 + kg * 8 + 4);
                const f32x4 k0 = *(const f32x4*)(qk_s + i * 256 + 128 + kg * 8), k1 = *(const f32x4*)(qk_s + i * 256 + 128 + kg * 8 + 4);
                const float vv = v_s[i * 32 + 4 * w + vl], a = gb_s[2 * i], be = gb_s[2 * i + 1];
                float part = k0[0] * s[0] + k0[1] * s[1] + k0[2] * s[2] + k0[3] * s[3] + k1[0] * s[4] + k1[1] * s[5] + k1[2] * s[6] + k1[3] * s[7];
                const float kS = rowsum16(part);
                const float c = be * (vv - a * kS);
                s[0] = a * s[0] + k0[0] * c; s[1] = a * s[1] + k0[1] * c; s[2] = a * s[2] + k0[2] * c; s[3] = a * s[3] + k0[3] * c;
                s[4] = a * s[4] + k1[0] * c; s[5] = a * s[5] + k1[1] * c; s[6] = a * s[6] + k1[2] * c; s[7] = a * s[7] + k1[3] * c;
                float op = q0[0] * s[0] + q0[1] * s[1] + q0[2] * s[2] + q0[3] * s[3] + q1[0] * s[4] + q1[1] * s[5] + q1[2] * s[6] + q1[3] * s[7];
                const float o = rowsum16(op);
                if (kg == 0) o_s[i * 32 + 4 * w + vl] = o;
            }
            __syncthreads();
            if (wout) { const int i = tid >> 3, c4 = (tid & 7) * 4; if (i < nt) *(f32x4*)(ORAW + (size_t)(row + i) * D + h * 128 + sl * 32 + c4) = *(const f32x4*)(o_s + i * 32 + c4); }
        }
    }
    if (pcol >= 0 && (sl == 0 || tid >= 256)) { halo_out[pcol] = x3; halo_out[3072 + pcol] = x2; halo_out[6144 + pcol] = x1; }
#pragma unroll
    for (int j = 0; j < 8; ++j) sst[(kg * 8 + j) * 33 + 4 * w + vl] = s[j];
    __syncthreads();
    { const int k = tid >> 2, q4 = tid & 3; const float* d = sst + k * 33 + q4 * 8; f32x4* dst = (f32x4*)(s_out + (size_t)k * 128 + sl * 32 + q4 * 8);
      dst[0] = (f32x4){d[0], d[1], d[2], d[3]}; dst[1] = (f32x4){d[4], d[5], d[6], d[7]}; }
    __syncthreads();
}

constexpr int RW_W2 = 20544, RW_A2 = 24640;
__device__ __forceinline__ void rwkv_load_lora(const Params& p, unsigned char* smem, int hb) {
    float* w2_s = (float*)smem + RW_W2; float* a2_s = (float*)smem + RW_A2; const float* pk = (const float*)(p.ws + WS_PK);
    for (int i = otid(); i < 4096; i += 512) { const int l = i >> 6, c = i & 63; w2_s[i] = pk[PK_W2 + l * D + hb * 64 + c]; a2_s[i] = pk[PK_A2 + l * D + hb * 64 + c]; }
    __syncthreads();
}
__device__ __forceinline__ void rwkv_item(const Params& p, unsigned char* smem, const float* s_in, float* s_out, const bf16_t* prev_row, const float* halo_in, float* halo_out,
                                          int hb, int half, int rowA, int nA, int rowB, int nB) {
    const int tid = otid(), w = tid >> 6, lane = tid & 63, row = tid >> 4, kq = tid & 15;
    float* f = (float*)smem;
    float* r_s = f; float* kb_s = f + 2048; float* v_s = f + 4096; float* wd_s = f + 6144; float* ad_s = f + 8192; float* dec_s = f + 10240; float* a_s = f + 12288;
    float* kk_s = f + 14336; float* km_s = f + 16384; float* zb_s = f + 18432; float* y_s = f + 19456; float* bonus_s = f + 20480;
    const float* w2_s = f + RW_W2; const float* a2_s = f + RW_A2;
    const bf16_t* P = (const bf16_t*)(p.ws + WS_P);
    float* YRAW = (float*)(p.ws + WS_YRAW); bf16_t* C0 = (bf16_t*)(p.ws + WS_C0); bf16_t* C1 = (bf16_t*)(p.ws + WS_C1);
    float s[4];
    if (s_in) { const f32x4 t = *(const f32x4*)(s_in + (size_t)(half * 32 + row) * 64 + kq * 4); s[0] = t[0]; s[1] = t[1]; s[2] = t[2]; s[3] = t[3]; }
    else { s[0] = s[1] = s[2] = s[3] = 0.f; }
    int col = -1; float* dst = nullptr; int dstride = 64; bool is_wd = false, owner = false;
    if (tid < 64) { col = hb * 64 + tid; dst = r_s + tid; owner = half == 0; }
    else if (tid < 128) { col = 1024 + hb * 64 + (tid - 64); dst = kb_s + (tid - 64); owner = half == 0; }
    else if (tid < 192) { col = 2048 + hb * 64 + (tid - 128); dst = v_s + (tid - 128); owner = half == 0; }
    else if (tid < 256) { col = 3072 + (tid - 192); dst = wd_s + (tid - 192); is_wd = true; owner = (half == 0 && hb == 0); }
    else if (tid < 320) { col = 3136 + (tid - 256); dst = ad_s + (tid - 256); owner = (half == 0 && hb == 0); }
    else if (tid < 352) { col = 3200 + hb * 64 + half * 32 + (tid - 320); dst = zb_s + (tid - 320); dstride = 32; owner = true; }
    float mu = 0.f, prev = 0.f;
    const float* pk = (const float*)(p.ws + WS_PK);
    if (col >= 0) { mu = pk[PK_MU + col]; prev = prev_row ? bf2f(prev_row[C_RW + col]) : (halo_in ? halo_in[col] : 0.f); }
    const int cc = tid & 63, ig = tid >> 6;
    const int hc = hb * 64 + cc;
    const float w0c = pk[PK_W0 + hc], a0c = pk[PK_A0 + hc], kkc = pk[PK_KK + hc], kac = pk[PK_KA + hc];
    const float rkl = pk[PK_RK + hb * 64 + lane];
#pragma unroll 1
    for (int run = 0; run < 2; ++run) {
        const int rrow = run ? rowB : rowA, rn = run ? nB : nA; const bool wout = run != 0;
#pragma unroll 1
        for (int c0 = 0; c0 < rn; c0 += 32) {
            const int nt = (rn - c0) < 32 ? (rn - c0) : 32; const int row0 = rrow + c0;
            if (col >= 0) {
                const bf16_t* src = P + (size_t)row0 * NPB + C_RW + col;
#pragma unroll 8
                for (int i = 0; i < nt; ++i) { const float cur = bf2f(src[(size_t)i * NPB]); float m = cur + mu * (prev - cur); prev = cur; if (is_wd) m = tanh_(m); dst[i * dstride] = m; }
            }
            __syncthreads();
            {
                float aw[4] = {0.f, 0.f, 0.f, 0.f}, aa[4] = {0.f, 0.f, 0.f, 0.f};
#pragma unroll 4
                for (int l = 0; l < 64; ++l) { const float w2v = w2_s[l * 64 + cc], a2v = a2_s[l * 64 + cc];
#pragma unroll
                    for (int ii = 0; ii < 4; ++ii) { aw[ii] += wd_s[(ig * 4 + ii) * 64 + l] * w2v; aa[ii] += ad_s[(ig * 4 + ii) * 64 + l] * a2v; } }
#pragma unroll
                for (int ii = 0; ii < 4; ++ii) { const int i = ig * 4 + ii;
                    if (i < nt) { const float wraw = w0c + aw[ii]; const float wlog = -0.6065306597126334f * sigm(wraw); const float a = sigm(a0c + aa[ii]);
                        const float kbv = kb_s[i * 64 + cc];
                        dec_s[i * 64 + cc] = expf(wlog); a_s[i * 64 + cc] = a; kk_s[i * 64 + cc] = kbv * kkc; km_s[i * 64 + cc] = kbv * (1.f + (a - 1.f) * kac); } }
            }
            __syncthreads();
#pragma unroll 1
            for (int ii = 0; ii < 4; ++ii) { const int i = w * 4 + ii;
                if (i < nt) { const float kkr = kk_s[i * 64 + lane]; const float kk = kkr * rsqrtf(wave_sum(kkr * kkr) + 1e-6f); kk_s[i * 64 + lane] = kk;
                    const float a = a_s[i * 64 + lane]; a_s[i * 64 + lane] = kk * a;
                    const float rk = wave_sum(r_s[i * 64 + lane] * km_s[i * 64 + lane] * rkl); if (lane == 0) bonus_s[i] = rk; } }
            __syncthreads();
#pragma unroll 1
            for (int i = 0; i < nt; ++i) {
                const f32x4 kk4 = *(const f32x4*)(kk_s + i * 64 + kq * 4), de4 = *(const f32x4*)(dec_s + i * 64 + kq * 4), ka4 = *(const f32x4*)(a_s + i * 64 + kq * 4),
                            km4 = *(const f32x4*)(km_s + i * 64 + kq * 4), r4 = *(const f32x4*)(r_s + i * 64 + kq * 4);
                const float vv = v_s[i * 64 + half * 32 + row];
                const float sa = rowsum16(s[0] * kk4[0] + s[1] * kk4[1] + s[2] * kk4[2] + s[3] * kk4[3]);
#pragma unroll
                for (int j = 0; j < 4; ++j) s[j] = s[j] * de4[j] + (vv * km4[j] - sa * ka4[j]);
                const float y = rowsum16(s[0] * r4[0] + s[1] * r4[1] + s[2] * r4[2] + s[3] * r4[3]);
                if (kq == 0) y_s[i * 32 + row] = y;
            }
            __syncthreads();
            if (wout) { const int i = tid >> 4;
                if (i < nt) {
#pragma unroll
                    for (int q = 0; q < 2; ++q) { const int rr = (tid & 15) * 2 + q, v = half * 32 + rr, colo = hb * 64 + v;
                        const float sz = silu_(zb_s[i * 32 + rr]);
                        const size_t o = (size_t)(row0 + i) * D + colo;
                        YRAW[o] = y_s[i * 32 + rr]; C1[o] = (bf16_t)f2bf(pk[PK_GNW + colo] * sz); C0[o] = (bf16_t)f2bf((pk[PK_GNB + colo] + bonus_s[i] * v_s[i * 64 + v]) * sz); } } }
            __syncthreads();
        }
    }
    *(f32x4*)(s_out + (size_t)(half * 32 + row) * 64 + kq * 4) = (f32x4){s[0], s[1], s[2], s[3]};
    if (col >= 0 && owner && halo_out) halo_out[col] = prev;
}

__device__ __forceinline__ void phase2(const Params& p, int seg, unsigned char* smem) {
    const int blk = obid();
    float* out = p.out;
    float* chalo = (float*)(p.ws + WS_CHALO); float* phalo = (float*)(p.ws + WS_PHALO);
#ifndef SUB
#define SUB 0
#endif
#define SEN(x) (SUB == 0 || SUB == (x))
    if (SEN(1)) {
        const int h = blk & 7, sl = (blk >> 3) & 3, b = blk >> 5;
        float* st = out + O_GDN_P + (size_t)(b * 8 + h) * 16384;
        const float* hin = seg ? chalo + (size_t)(((seg - 1) & 1) * NBATCH + b) * 9216 : nullptr;
        float* hout = (seg == NSEG - 1) ? out + O_CONV_P + (size_t)b * 9216 : chalo + (size_t)((seg & 1) * NBATCH + b) * 9216;
        gdn_item(p, smem, seg ? st : nullptr, st, hin, hout, h, sl, LEX0, seg ? 0 : NMETA, b * SEGTOK, SEGTOK);
    }
    if (SEN(2) && seg == 0) {
#pragma unroll 1
        for (int it = blk; it < DECB * 32; it += gridDim.x) {
            const int h = it & 7, sl = (it >> 3) & 3, bs = it >> 5;
            gdn_item(p, smem, p.in[2] + (size_t)(bs * 8 + h) * 16384, out + O_GDN_S + (size_t)(bs * 8 + h) * 16384, p.in[3] + (size_t)bs * 9216, out + O_CONV_S + (size_t)bs * 9216,
                     h, sl, 0, 0, LEX0 + EX_SAMP + bs * DECT, DECT);
        }
    }
    {
        const int hb = blk & 15, rest = blk >> 4;
        rwkv_load_lora(p, smem, hb);
        if (SEN(3)) {
            const int b = rest >> 1, half = rest & 1;
            float* st = out + O_RWKV_P + (size_t)(b * 16 + hb) * 4096;
            const float* hin = seg ? phalo + (size_t)(((seg - 1) & 1) * NBATCH + b) * RW_SHIFT : nullptr;
            float* hout = phalo + (size_t)((seg & 1) * NBATCH + b) * RW_SHIFT;
            rwkv_item(p, smem, seg ? st : nullptr, st, nullptr, hin, hout, hb, half, LEX0, seg ? 0 : NMETA, b * SEGTOK, SEGTOK);
        }
        if (SEN(4) && seg == 0) {
#pragma unroll 1
            for (int j = 0; j < 16; ++j) {
                const int idx = rest * 16 + j, bs = idx >> 1, half = idx & 1;
                const bf16_t* prow = (const bf16_t*)(p.ws + WS_P) + (size_t)(LEX0 + EX_SHIFT + bs) * NPB;
                rwkv_item(p, smem, p.in[4] + (size_t)(bs * 16 + hb) * 4096, out + O_RWKV_S + (size_t)(bs * 16 + hb) * 4096, prow, nullptr, nullptr, hb, half, 0, 0, LEX0 + EX_SAMP + bs * DECT, DECT);
            }
        }
    }
}

__device__ __forceinline__ void phase25(const Params& p, int seg) {
    const int tid0 = otid(); const int lane = tid0 & 63; const int gw = obid() * 8 + (tid0 >> 6), NGW = gridDim.x * 8;
    const bf16_t* P = (const bf16_t*)(p.ws + WS_P);
    const float* ORAW = (const float*)(p.ws + WS_ORAW); const float* YRAW = (const float*)(p.ws + WS_YRAW);
    const bf16_t* C0 = (const bf16_t*)(p.ws + WS_C0); const bf16_t* C1 = (const bf16_t*)(p.ws + WS_C1);
    bf16_t* OA = (bf16_t*)(p.ws + WS_H); bf16_t* OB = (bf16_t*)(p.ws + WS_OB);
    const int nrows = LEX0 + (seg == 0 ? DECB * DECT : 0);
    const int c = lane * 16;
    f32x4 nw[4];
#pragma unroll
    for (int j = 0; j < 4; ++j) nw[j] = *(const f32x4*)((const float*)(p.ws + WS_PK) + PK_NORMW + (c & 127) + 4 * j);
#pragma unroll 1
    for (int rr = gw; rr < nrows; rr += NGW) {
        int lr; size_t grow;
        if (rr < LEX0) { lr = rr; grow = (size_t)(rr / SEGTOK) * SEQ + seg * SEGTOK + (rr % SEGTOK); } else { lr = LEX0 + EX_SAMP + (rr - LEX0); grow = (size_t)XROWS + EX_SAMP + (rr - LEX0); }
        {
            f32x4 o[4]; float ss = 0.f;
#pragma unroll
            for (int j = 0; j < 4; ++j) { o[j] = *(const f32x4*)(ORAW + (size_t)lr * D + c + 4 * j); ss += o[j][0] * o[j][0] + o[j][1] * o[j][1] + o[j][2] * o[j][2] + o[j][3] * o[j][3]; }
            ss += __shfl_xor(ss, 1); ss += __shfl_xor(ss, 2); ss += __shfl_xor(ss, 4);
            const float rs = rsqrtf(ss * (1.f / 128.f) + 1e-6f);
            const u32x4 z0 = *(const u32x4*)(P + (size_t)lr * NPB + C_Z + c), z1 = *(const u32x4*)(P + (size_t)lr * NPB + C_Z + c + 8);
            const unsigned zz[8] = {z0.x, z0.y, z0.z, z0.w, z1.x, z1.y, z1.z, z1.w};
            unsigned ow[8];
#pragma unroll
            for (int j = 0; j < 8; ++j) { const float za = __uint_as_float(zz[j] << 16), zb = __uint_as_float(zz[j] & 0xffff0000u);
                const float a = o[j >> 1][(j & 1) * 2] * rs * nw[j >> 1][(j & 1) * 2] * silu_(za), b = o[j >> 1][(j & 1) * 2 + 1] * rs * nw[j >> 1][(j & 1) * 2 + 1] * silu_(zb);
                ow[j] = pk2(a, b); }
            *(u32x4*)(OA + grow * D + c) = (u32x4){ow[0], ow[1], ow[2], ow[3]}; *(u32x4*)(OA + grow * D + c + 8) = (u32x4){ow[4], ow[5], ow[6], ow[7]};
        }
        {
            f32x4 y[4]; float sm = 0.f;
#pragma unroll
            for (int j = 0; j < 4; ++j) { y[j] = *(const f32x4*)(YRAW + (size_t)lr * D + c + 4 * j); sm += y[j][0] + y[j][1] + y[j][2] + y[j][3]; }
            sm += __shfl_xor(sm, 1); sm += __shfl_xor(sm, 2);
            const float mu = sm * (1.f / 64.f); float vs = 0.f;
#pragma unroll
            for (int j = 0; j < 4; ++j) { y[j] = y[j] - mu; vs += y[j][0] * y[j][0] + y[j][1] * y[j][1] + y[j][2] * y[j][2] + y[j][3] * y[j][3]; }
            vs += __shfl_xor(vs, 1); vs += __shfl_xor(vs, 2);
            const float rs = rsqrtf(vs * (1.f / 64.f) + 64e-5f);
            const u32x4 a0 = *(const u32x4*)(C0 + (size_t)lr * D + c), a1 = *(const u32x4*)(C0 + (size_t)lr * D + c + 8);
            const u32x4 b0 = *(const u32x4*)(C1 + (size_t)lr * D + c), b1 = *(const u32x4*)(C1 + (size_t)lr * D + c + 8);
            const unsigned c0w[8] = {a0.x, a0.y, a0.z, a0.w, a1.x, a1.y, a1.z, a1.w}, c1w[8] = {b0.x, b0.y, b0.z, b0.w, b1.x, b1.y, b1.z, b1.w};
            unsigned ow[8];
#pragma unroll
            for (int j = 0; j < 8; ++j) {
                const float a = y[j >> 1][(j & 1) * 2] * rs * __uint_as_float(c1w[j] << 16) + __uint_as_float(c0w[j] << 16);
                const float b = y[j >> 1][(j & 1) * 2 + 1] * rs * __uint_as_float(c1w[j] & 0xffff0000u) + __uint_as_float(c0w[j] & 0xffff0000u);
                ow[j] = pk2(a, b); }
            *(u32x4*)(OB + grow * D + c) = (u32x4){ow[0], ow[1], ow[2], ow[3]}; *(u32x4*)(OB + grow * D + c + 8) = (u32x4){ow[4], ow[5], ow[6], ow[7]};
        }
    }
}

__device__ __forceinline__ void phase_final(const Params& p) {
    const int tid0 = otid(); const int lane = tid0 & 63; const int gw = obid() * 8 + (tid0 >> 6), NGW = gridDim.x * 8;
    const f32x4* wr = (const f32x4*)((const float*)(p.ws + WS_PK) + PK_LNF) + lane;
#pragma unroll 1
    for (int r = gw; r < XROWS + DECB * DECT; r += NGW) {
        f32x4* xr = (f32x4*)(p.out + (size_t)r * D) + lane;
        f32x4 v[4]; float ss = 0.f;
#pragma unroll
        for (int j = 0; j < 4; ++j) { v[j] = xr[64 * j]; ss += v[j][0] * v[j][0] + v[j][1] * v[j][1] + v[j][2] * v[j][2] + v[j][3] * v[j][3]; }
        const float rs = rsqrtf(wave_sum(ss) * (1.f / D) + 1e-6f);
#pragma unroll
        for (int j = 0; j < 4; ++j) xr[64 * j] = v[j] * rs * wr[64 * j];
    }
}

__global__ __launch_bounds__(512, 2) void hybrid_mega(Params p) {
    extern __shared__ __attribute__((aligned(16))) unsigned char smem[];
    cg::grid_group grid = cg::this_grid();
    LAS unsigned char* lds = (LAS unsigned char*)smem;
    const int G = gridDim.x;

#ifndef ONLY
#define ONLY 0
#endif
#define EN(x) (ONLY == 0 || ONLY == (x))
    if (EN(1)) phase0(p, smem);
    grid.sync();
#pragma unroll 1
    for (int seg = 0; seg < NSEG; ++seg) {
        if (EN(2)) {
            SchedIn S; S.ob.init(seg == 0 ? LT_PROMPT + 3 : LT_PROMPT, NT_IN, G, obid()); S.seg = seg; S.A = (const char*)(p.ws + WS_H); S.B = (const char*)(p.ws + WS_WT_IN);
            EpiIn E; E.P = (bf16_t*)(p.ws + WS_P); E.gex = (bf16_t*)(p.ws + WS_GEX); E.out = p.out; E.seg = seg;
            pg8::gemm_phase<EpiIn, SchedIn>(lds, D, S, E);
        }
        grid.sync();
        if (EN(3)) phase2(p, seg, smem);
        grid.sync();
        if (EN(4)) phase25(p, seg);
        grid.sync();
    }
    if (EN(5)) {
        SchedAB S; S.ob.init(HTILES, 4, G, obid()); S.A0 = (const char*)(p.ws + WS_H); S.A1 = (const char*)(p.ws + WS_OB); S.B0 = (const char*)(p.ws + WS_WT_A); S.B1 = (const char*)(p.ws + WS_WT_B);
        EpiAB E; E.tmp = (float*)(p.ws + WS_P); E.merged = (bf16_t*)(p.ws + WS_ORAW); E.gex = (const bf16_t*)(p.ws + WS_GEX); E.out = p.out;
        pg8::gemm_phase<EpiAB, SchedAB>(lds, D, S, E);
    }
    grid.sync();
    if (EN(6)) {
        SchedO S; S.ob.init(HTILES, 4, G, obid()); S.A = (const char*)(p.ws + WS_ORAW); S.B = (const char*)(p.ws + WS_WT_O);
        EpiO E; E.out = p.out; E.xp = p.in[0]; E.xs = p.in[1];
        pg8::gemm_phase<EpiO, SchedO>(lds, D, S, E);
    }
    grid.sync();
    if (EN(7)) phase_final(p);
}

extern "C" void kernel_launch(void* const* d_in, const int* in_sizes, int n_in, void* d_out, int out_size, void* d_ws, size_t ws_size, hipStream_t stream) {
    static int grid_blocks = 0;
    constexpr int LDS_BYTES = 131072;
    if (grid_blocks == 0) {
        if (n_in != 27 || ws_size < WS_END) { fprintf(stderr, "kernel_launch: unexpected n_in %d / ws %zu (need %zu)\n", n_in, ws_size, (size_t)WS_END); grid_blocks = -1; return; }
        if (hipFuncSetAttribute((const void*)hybrid_mega, hipFuncAttributeMaxDynamicSharedMemorySize, LDS_BYTES) != hipSuccess) { fprintf(stderr, "kernel_launch: hipFuncSetAttribute failed\n"); grid_blocks = -1; return; }
        int dev = 0, cus = 0, per_cu = 0;
        hipGetDevice(&dev);
        hipDeviceGetAttribute(&cus, hipDeviceAttributeMultiprocessorCount, dev);
        hipOccupancyMaxActiveBlocksPerMultiprocessor(&per_cu, (const void*)hybrid_mega, 512, LDS_BYTES);
        if (per_cu < 1) { fprintf(stderr, "kernel_launch: occupancy query says %d blocks/CU\n", per_cu); per_cu = 1; }
        (void)hipGetLastError();
        grid_blocks = cus;
    }
    if (grid_blocks < 0) return;
    Params p{};
    for (int i = 0; i < 27; ++i) p.in[i] = (const float*)d_in[i];
    p.out = (float*)d_out; p.ws = (unsigned char*)d_ws;
    void* args[] = {&p};
    hipError_t e = hipLaunchCooperativeKernel((const void*)hybrid_mega, dim3(grid_blocks), dim3(512), args, LDS_BYTES, stream);
    if (e != hipSuccess) fprintf(stderr, "cooperative launch failed: %s (grid %d)\n", hipGetErrorString(e), grid_blocks);
}
```

```cpp
#include <hip/hip_runtime.h>
#include <hip/hip_cooperative_groups.h>
#include <cstdio>
namespace cg = cooperative_groups;

#define LAS __attribute__((address_space(3)))
typedef unsigned short bf16_t;
typedef short bf16x8 __attribute__((ext_vector_type(8)));
typedef float f32x4 __attribute__((ext_vector_type(4)));
typedef unsigned u32x4 __attribute__((ext_vector_type(4)));
typedef unsigned u32x2 __attribute__((ext_vector_type(2)));

constexpr int D = 1024;
constexpr int NBATCH = 8, SEQ = 2048, NMETA = 16, DECB = 128, DECT = 4;
constexpr int XROWS = NBATCH * SEQ;
constexpr int EX_SAMP = 16, EX_SHIFT = 528, EX_END = 656;
constexpr int HROWS = 17152, HTILES = 67;
constexpr int NSEG = 8, SEGTOK = SEQ / NSEG;
constexpr int CPS = SEGTOK / 64;
constexpr int TPB = SEGTOK / 256;
constexpr int LT_PROMPT = NBATCH * TPB;
constexpr int LEX0 = LT_PROMPT * 256;
constexpr int LROWS = LEX0 + 768;
constexpr int NP = 10496, NPB = 8448, NT_IN = 41, NT_PB = 33;
constexpr int C_A = 3072, C_B = 3080, C_Z = 3088, C_RW = 4112, C_GATE_REF = 8336;
constexpr int RW_SHIFT = 4224;

constexpr size_t O_YP = 0, O_YS = 16777216, O_GDN_P = 17301504, O_CONV_P = 18350080, O_RWKV_P = 18423808, O_SHIFT_P = 18948096,
                 O_GDN_S = 18956288, O_CONV_S = 35733504, O_RWKV_S = 36913152, O_SHIFT_S = 45301760;

constexpr size_t al256(size_t x) { return (x + 255) & ~(size_t)255; }
constexpr size_t WS_WT_IN = 0;
constexpr size_t WS_WT_A = al256(WS_WT_IN + (size_t)NP * D * 2);
constexpr size_t WS_WT_B = al256(WS_WT_A + (size_t)D * D * 2);
constexpr size_t WS_WT_O = al256(WS_WT_B + (size_t)D * D * 2);
constexpr size_t WS_H = al256(WS_WT_O + (size_t)D * D * 2);
constexpr size_t WS_OB = al256(WS_H + (size_t)HROWS * D * 2);
constexpr size_t WS_P = al256(WS_OB + (size_t)HROWS * D * 2);
constexpr size_t WS_ORAW = al256(WS_P + (size_t)LROWS * NPB * 2);
constexpr size_t WS_YRAW = al256(WS_ORAW + (size_t)LROWS * D * 4);
constexpr size_t WS_C0 = al256(WS_YRAW + (size_t)LROWS * D * 4);
constexpr size_t WS_C1 = al256(WS_C0 + (size_t)LROWS * D * 2);
constexpr size_t WS_GEX = al256(WS_C1 + (size_t)LROWS * D * 2);
constexpr size_t WS_CHALO = al256(WS_GEX + (size_t)768 * 2048 * 2);
constexpr size_t WS_PHALO = al256(WS_CHALO + (size_t)2 * NBATCH * 3 * 3072 * 4);
constexpr size_t WS_PK = al256(WS_PHALO + (size_t)2 * NBATCH * RW_SHIFT * 4);
constexpr int PK_CONVW = 0, PK_ALOG = 12288, PK_DTB = 12296, PK_NORMW = 12304, PK_MU = 12432, PK_W0 = 16656, PK_W2 = 17680, PK_A0 = 83216, PK_A2 = 84240,
              PK_KK = 149776, PK_KA = 150800, PK_RK = 151824, PK_GNW = 152848, PK_GNB = 153872, PK_LNF = 154896, PK_END = 155920;
constexpr size_t WS_MG = al256(WS_PK + (size_t)PK_END * 4);
constexpr int GP_AP = 0, GP_QH = 32768, GP_KH = 49152, GP_OH = 81920, GP_EGL = 98304, GP_STRIDE = 98560;
constexpr size_t WS_GP = al256(WS_MG + (size_t)HROWS * D * 2);
constexpr size_t WS_END = al256(WS_GP + (size_t)(CPS + 1) * 64 * GP_STRIDE);
static_assert((size_t)HROWS * D * 4 <= (size_t)LROWS * NPB * 2 + 2 * (size_t)LROWS * D * 4, "TMP must fit in P+ORAW+YRAW");
static_assert(WS_END <= (size_t)268435456, "workspace");

struct Params { const float* in[27]; float* out; unsigned char* ws; };

__device__ __forceinline__ float bf2f(bf16_t v) { return __uint_as_float(((unsigned)v) << 16); }
__device__ __forceinline__ unsigned f2bf(float f) { unsigned u = __float_as_uint(f); u += 0x7fffu + ((u >> 16) & 1u); return u >> 16; }
__device__ __forceinline__ unsigned pk2(float lo, float hi) { return f2bf(lo) | (f2bf(hi) << 16); }
__device__ __forceinline__ unsigned cvt_pk_bf16(float lo, float hi) { unsigned r; asm volatile("v_cvt_pk_bf16_f32 %0, %1, %2" : "=v"(r) : "v"(lo), "v"(hi)); return r; }
__device__ __forceinline__ float sigm(float x) { return 1.f / (1.f + __expf(-x)); }
__device__ __forceinline__ float silu_(float x) { return x / (1.f + __expf(-x)); }
__device__ __forceinline__ float softplus_(float x) { return fmaxf(x, 0.f) + log1pf(expf(-fabsf(x))); }
__device__ __forceinline__ float wave_sum(float v) {
#pragma unroll
    for (int o = 1; o < 64; o <<= 1) v += __shfl_xor(v, o);
    return v;
}
__device__ __forceinline__ int otid() { int t = threadIdx.x; asm volatile("" : "+v"(t)); return t; }
__device__ __forceinline__ int obid() { int t = blockIdx.x; asm volatile("" : "+s"(t)); return t; }
__device__ __forceinline__ float tanh_(float x) { const float e = __expf(2.f * x); return 1.f - 2.f / (e + 1.f); }
template <int CTRL> __device__ __forceinline__ float dppf(float x) { return __builtin_bit_cast(float, __builtin_amdgcn_mov_dpp(__builtin_bit_cast(int, x), CTRL, 0xf, 0xf, true)); }
__device__ __forceinline__ float rowsum16(float x) { x += dppf<0x128>(x); x += dppf<0x124>(x); x += dppf<0x122>(x); x += dppf<0x121>(x); return x; }

namespace pg8 {
constexpr int BM = 256, BK = 64, HALF = 128, HTB = HALF * BK * 2, STAGE_BYTES = 8 * HTB, NXCD = 8, WGM = 8;
__device__ __forceinline__ int lds_byte(int r, int c) { const int st = (r >> 4) * 2 + (c >> 5), rr = r & 15, cc = c & 31, ob = rr * 64 + cc * 2; return st * 1024 + (ob ^ (((ob >> 9) & 1) << 5)); }
__device__ __forceinline__ void stage_rc(int b, int& R, int& C) { const int st = b / 1024, sb = b % 1024, swz = sb ^ (((sb >> 9) & 1) << 5); R = (st >> 1) * 16 + swz / 64; C = (st & 1) * 32 + (swz % 64) / 2; }
__device__ __forceinline__ int perm32(int rho) { const int n = rho >> 4, i = rho & 15; return 8 * (i >> 2) + 4 * n + (i & 3); }

struct Unit { int pm, pn, w; };
struct OrderBase {
    int nM, nN, nwg, G, c;
    __device__ void init(int nM_, int nN_, int G_, int c_) { nM = nM_; nN = nN_; nwg = nM * nN; G = G_; c = c_; }
    __device__ bool nextb(int i, Unit& u) const {
        const long L = (long)i * G + c; if (L >= nwg) return false;
        int wgid = (int)L; { const int q = nwg / NXCD, r = nwg % NXCD, xcd = wgid % NXCD, off = wgid / NXCD; wgid = (xcd < r ? xcd * (q + 1) : r * (q + 1) + (xcd - r) * q) + off; }
        const int nig = WGM * nN, gid = wgid / nig, fm = gid * WGM, gsz = (nM - fm) < WGM ? (nM - fm) : WGM;
        u.pm = fm + ((wgid % nig) % gsz); u.pn = (wgid % nig) / gsz; u.w = 0; return true;
    }
};

template <class Epi, class Sched>
__device__ __forceinline__ void gemm_phase(LAS unsigned char* lds, const int K, const Sched& S, const Epi& E) {
    const int tid = otid(), wid = __builtin_amdgcn_readfirstlane(tid >> 6), lane = tid & 63, wr = wid >> 2, wc = wid & 3, fr = lane & 15, fq = lane >> 4;
    const int nt = K / BK;
    unsigned voffA[2], voffB[2];
#pragma unroll
    for (int i = 0; i < 2; ++i) { int R, C; stage_rc(tid * 16 + i * 8192, R, C); const int Rb = Epi::PERM ? ((R & ~31) + perm32(R & 31)) : R;
        voffA[i] = (unsigned)(R * K + C) * 2u; voffB[i] = (unsigned)(Rb * K + C) * 2u; }
    const size_t kstep = (size_t)(BK * 2);
    const size_t hstep = (size_t)HALF * K * 2;
    const unsigned ldsw = (unsigned)wid * 1024u;
    const int aoff = lds_byte(wr * 64 + fr, fq * 8), boff = lds_byte(wc * 32 + fr, fq * 8);
#define PG8_SA(b, h) (((b) * 2 + (h)) * HTB)
#define PG8_SB(b, h) ((4 + (b) * 2 + (h)) * HTB)
#define PG8_STAGE(bufoff, gbase, voff) do { _Pragma("unroll") for (int _i = 0; _i < 2; ++_i) \
        __builtin_amdgcn_global_load_lds((const unsigned*)((const char*)(gbase) + (voff)[_i]), (LAS unsigned*)(lds + (bufoff) + ldsw + _i * 8192), 16, 0, 0); } while (0)
#define PG8_LDA(dst, b, h) do { _Pragma("unroll") for (int m = 0; m < 4; ++m) _Pragma("unroll") for (int k = 0; k < 2; ++k) dst[m][k] = *(const LAS bf16x8*)(lds + PG8_SA(b, h) + aoff + m * 2048 + k * 1024); } while (0)
#define PG8_LDB(dst, b, h) do { _Pragma("unroll") for (int n = 0; n < 2; ++n) _Pragma("unroll") for (int k = 0; k < 2; ++k) dst[n][k] = *(const LAS bf16x8*)(lds + PG8_SB(b, h) + boff + n * 2048 + k * 1024); } while (0)
#define PG8_MMA(ai, bj, At, Bt) do { __builtin_amdgcn_s_setprio(1); _Pragma("unroll") for (int m = 0; m < 4; ++m) _Pragma("unroll") for (int n = 0; n < 2; ++n) _Pragma("unroll") for (int k = 0; k < 2; ++k) \
        acc[ai][bj][m][n] = __builtin_amdgcn_mfma_f32_16x16x32_bf16(Bt[n][k], At[m][k], acc[ai][bj][m][n], 0, 0, 0); __builtin_amdgcn_s_setprio(0); } while (0)
#define PG8_WAIT_V(n) asm volatile("s_waitcnt vmcnt(" #n ")" ::: "memory")
#define PG8_WAIT_L(n) asm volatile("s_waitcnt lgkmcnt(" #n ")" ::: "memory")
#define PG8_BAR __builtin_amdgcn_s_barrier()
#define PG8_SCHED __builtin_amdgcn_sched_barrier(0)
    Unit cur, nxt; int ui = 0;
    if (!S.next(0, cur)) return;
    f32x4 acc[2][2][4][2];
#pragma unroll
    for (int a = 0; a < 2; ++a)
#pragma unroll
        for (int b = 0; b < 2; ++b)
#pragma unroll
            for (int m = 0; m < 4; ++m)
#pragma unroll
                for (int n = 0; n < 2; ++n) acc[a][b][m][n] = (f32x4){0.f, 0.f, 0.f, 0.f};
    bf16x8 At[4][2], B0[2][2], B1[2][2];
    const char* cA = S.a_ptr(cur); const char* cB = S.b_ptr(cur);
    PG8_STAGE(PG8_SB(0, 0), cB, voffB); PG8_STAGE(PG8_SA(0, 0), cA, voffA); PG8_STAGE(PG8_SB(0, 1), cB + hstep, voffB); PG8_STAGE(PG8_SA(0, 1), cA + hstep, voffA);
    if (wr == 1) PG8_BAR;
    PG8_WAIT_V(4); PG8_BAR;
    PG8_STAGE(PG8_SB(1, 0), cB + kstep, voffB); PG8_STAGE(PG8_SA(1, 0), cA + kstep, voffA); PG8_STAGE(PG8_SB(1, 1), cB + hstep + kstep, voffB);
    PG8_WAIT_V(6); PG8_BAR;
    for (;;) {
        const bool has_next = S.next(ui + 1, nxt);
        const char* nA = has_next ? S.a_ptr(nxt) : cA; const char* nB = has_next ? S.b_ptr(nxt) : cB;
        for (int t = 0; t < nt; t += 2) {
            const bool last = (t == nt - 2);
            const char* a1 = cA + (size_t)(t + 1) * kstep;
            const char* a2 = last ? nA : cA + (size_t)(t + 2) * kstep; const char* b2 = last ? nB : cB + (size_t)(t + 2) * kstep;
            const char* a3 = a2 + kstep; const char* b3 = b2 + kstep;
            PG8_LDB(B0, 0, 0); PG8_SCHED; PG8_LDA(At, 0, 0); PG8_STAGE(PG8_SA(1, 1), a1 + hstep, voffA);
            PG8_WAIT_L(8); PG8_BAR; PG8_WAIT_L(0); PG8_MMA(0, 0, At, B0); PG8_BAR; PG8_SCHED;
            PG8_LDB(B1, 0, 1); PG8_STAGE(PG8_SB(0, 0), b2, voffB);
            PG8_BAR; PG8_WAIT_L(0); PG8_MMA(0, 1, At, B1); PG8_BAR;
            PG8_LDA(At, 0, 1); PG8_STAGE(PG8_SA(0, 0), a2, voffA);
            PG8_BAR; PG8_WAIT_L(0); PG8_MMA(1, 0, At, B0); PG8_BAR; PG8_SCHED;
            PG8_STAGE(PG8_SB(0, 1), b2 + hstep, voffB);
            PG8_WAIT_V(6); PG8_BAR; PG8_MMA(1, 1, At, B1); PG8_BAR;
            PG8_LDB(B0, 1, 0); PG8_SCHED; PG8_LDA(At, 1, 0); PG8_STAGE(PG8_SA(0, 1), a2 + hstep, voffA);
            PG8_WAIT_L(8); PG8_BAR; PG8_WAIT_L(0); PG8_MMA(0, 0, At, B0); PG8_BAR; PG8_SCHED;
            PG8_LDB(B1, 1, 1); PG8_STAGE(PG8_SB(1, 0), b3, voffB);
            PG8_BAR; PG8_WAIT_L(0); PG8_MMA(0, 1, At, B1); PG8_BAR;
            PG8_LDA(At, 1, 1); PG8_STAGE(PG8_SA(1, 0), a3, voffA);
            PG8_BAR; PG8_WAIT_L(0); PG8_MMA(1, 0, At, B0); PG8_BAR; PG8_SCHED;
            PG8_STAGE(PG8_SB(1, 1), b3 + hstep, voffB);
            PG8_WAIT_V(6); PG8_BAR; PG8_MMA(1, 1, At, B1); PG8_BAR;
        }
        E(acc, cur, wr, wc, fr, fq);
        if (!has_next) break;
#pragma unroll
        for (int a = 0; a < 2; ++a)
#pragma unroll
            for (int b = 0; b < 2; ++b)
#pragma unroll
                for (int m = 0; m < 4; ++m)
#pragma unroll
                    for (int n = 0; n < 2; ++n) acc[a][b][m][n] = (f32x4){0.f, 0.f, 0.f, 0.f};
        cur = nxt; cA = nA; cB = nB; ++ui;
    }
    PG8_WAIT_V(0);
    if (wr == 0) PG8_BAR;
    PG8_BAR;
#undef PG8_SA
#undef PG8_SB
#undef PG8_STAGE
#undef PG8_LDA
#undef PG8_LDB
#undef PG8_MMA
#undef PG8_WAIT_V
#undef PG8_WAIT_L
#undef PG8_BAR
#undef PG8_SCHED
}
}
using pg8::Unit;

struct SchedIn {
    pg8::OrderBase ob; int seg; const char* A; const char* B;
    __device__ bool next(int i, Unit& u) const { return ob.nextb(i, u); }
    __device__ const char* a_ptr(const Unit& u) const {
        const int gt = u.pm < LT_PROMPT ? ((u.pm / TPB) * (SEQ / 256) + seg * TPB + (u.pm % TPB)) : (XROWS / 256 + (u.pm - LT_PROMPT));
        return A + (size_t)gt * 256 * D * 2; }
    __device__ const char* b_ptr(const Unit& u) const { return B + (size_t)u.pn * 256 * D * 2; }
};
struct SchedAB {
    pg8::OrderBase ob; const char* A0; const char* A1; const char* B0; const char* B1;
    __device__ bool next(int i, Unit& u) const { const bool ok = ob.nextb(i >> 1, u); u.w = i & 1; return ok; }
    __device__ const char* a_ptr(const Unit& u) const { return (u.w ? A1 : A0) + (size_t)u.pm * 256 * D * 2; }
    __device__ const char* b_ptr(const Unit& u) const { return (u.w ? B1 : B0) + (size_t)u.pn * 256 * D * 2; }
};
struct SchedO {
    pg8::OrderBase ob; const char* A; const char* B;
    __device__ bool next(int i, Unit& u) const { return ob.nextb(i, u); }
    __device__ const char* a_ptr(const Unit& u) const { return A + (size_t)u.pm * 256 * D * 2; }
    __device__ const char* b_ptr(const Unit& u) const { return B + (size_t)u.pn * 256 * D * 2; }
};

struct EpiIn {
    static constexpr bool PERM = true;
    bf16_t* P; bf16_t* gex; float* out; int seg;
    __device__ __forceinline__ void operator()(const f32x4 (&acc)[2][2][4][2], const Unit& u, int wr, int wc, int fr, int fq) const {
        const int lr0 = u.pm * 256 + wr * 64 + fr;
        const int c0 = u.pn * 256 + wc * 32 + 8 * fq;
#pragma unroll
        for (int ai = 0; ai < 2; ++ai)
#pragma unroll
            for (int m = 0; m < 4; ++m) {
                const int lr = lr0 + ai * 128 + m * 16;
                bf16_t* rowp;
                if (u.pn < NT_PB) rowp = P + (size_t)lr * NPB + c0;
                else if (lr < LEX0) { const int b = lr / SEGTOK; const size_t grow = (size_t)b * SEQ + seg * SEGTOK + (lr % SEGTOK); rowp = (bf16_t*)(out + O_YP + grow * D) + (c0 - NPB); }
                else rowp = gex + (size_t)(lr - LEX0) * 2048 + (c0 - NPB);
#pragma unroll
                for (int bj = 0; bj < 2; ++bj) { const f32x4 v0 = acc[ai][bj][m][0], v1 = acc[ai][bj][m][1];
                    u32x4 w; w.x = cvt_pk_bf16(v0[0], v0[1]); w.y = cvt_pk_bf16(v0[2], v0[3]); w.z = cvt_pk_bf16(v1[0], v1[1]); w.w = cvt_pk_bf16(v1[2], v1[3]);
                    *(u32x4*)(rowp + bj * 128) = w; }
            }
    }
};
struct EpiAB {
    static constexpr bool PERM = false;
    float* tmp; bf16_t* merged; const bf16_t* gex; const float* out;
    __device__ __forceinline__ void operator()(const f32x4 (&acc)[2][2][4][2], const Unit& u, int wr, int wc, int fr, int fq) const {
        const int row0 = u.pm * 256 + wr * 64 + fr, col0 = u.pn * 256 + wc * 32 + 4 * fq;
#pragma unroll
        for (int ai = 0; ai < 2; ++ai)
#pragma unroll
            for (int m = 0; m < 4; ++m) {
                const int grow = row0 + ai * 128 + m * 16;
                const bf16_t* gp = (grow < XROWS) ? ((const bf16_t*)(out + O_YP + (size_t)grow * D) + u.w * D) : (gex + (size_t)(grow - XROWS) * 2048 + u.w * D);
#pragma unroll
                for (int bj = 0; bj < 2; ++bj)
#pragma unroll
                    for (int n = 0; n < 2; ++n) {
                        const int c = col0 + bj * 128 + n * 16;
                        const u32x2 g = *(const u32x2*)(gp + c);
                        f32x4 v = acc[ai][bj][m][n];
                        v[0] *= sigm(__uint_as_float(g.x << 16)); v[1] *= sigm(__uint_as_float(g.x & 0xffff0000u));
                        v[2] *= sigm(__uint_as_float(g.y << 16)); v[3] *= sigm(__uint_as_float(g.y & 0xffff0000u));
                        float* tp = tmp + (size_t)grow * D + c;
                        if (u.w == 0) *(f32x4*)tp = v;
                        else { const f32x4 t = *(const f32x4*)tp; v = v + t; u32x2 o; o.x = cvt_pk_bf16(v[0], v[1]); o.y = cvt_pk_bf16(v[2], v[3]); *(u32x2*)(merged + (size_t)grow * D + c) = o; }
                    }
            }
    }
};
struct EpiO {
    static constexpr bool PERM = false;
    float* out; const float* xp; const float* xs;
    __device__ __forceinline__ void operator()(const f32x4 (&acc)[2][2][4][2], const Unit& u, int wr, int wc, int fr, int fq) const {
        const int row0 = u.pm * 256 + wr * 64 + fr, col0 = u.pn * 256 + wc * 32 + 4 * fq;
#pragma unroll
        for (int ai = 0; ai < 2; ++ai)
#pragma unroll
            for (int m = 0; m < 4; ++m) {
                const int grow = row0 + ai * 128 + m * 16;
                const float* xr; float* yr;
                if (grow < XROWS) { xr = xp + (size_t)grow * D; yr = out + O_YP + (size_t)grow * D; }
                else { const int e = grow - XROWS; if (e < EX_SAMP || e >= EX_SHIFT) continue; xr = xs + (size_t)(e - EX_SAMP) * D; yr = out + O_YS + (size_t)(e - EX_SAMP) * D; }
#pragma unroll
                for (int bj = 0; bj < 2; ++bj)
#pragma unroll
                    for (int n = 0; n < 2; ++n) { const int c = col0 + bj * 128 + n * 16; *(f32x4*)(yr + c) = *(const f32x4*)(xr + c) + acc[ai][bj][m][n]; }
            }
    }
};

__device__ __forceinline__ void p0_row(const Params& p, int r, int lane) {
    bf16_t* hrow = (bf16_t*)(p.ws + WS_H) + (size_t)r * D;
    const float* src = nullptr; bool norm = true; float* sh = nullptr;
    if (r < XROWS) { src = p.in[0] + (size_t)r * D; if ((r & (SEQ - 1)) == SEQ - 1) sh = p.out + O_SHIFT_P + (size_t)(r / SEQ) * D; }
    else { const int e = r - XROWS;
        if (e < EX_SAMP) src = p.in[6] + (size_t)e * D;
        else if (e < EX_SHIFT) { src = p.in[1] + (size_t)(e - EX_SAMP) * D; if (((e - EX_SAMP) & 3) == 3) sh = p.out + O_SHIFT_S + (size_t)((e - EX_SAMP) >> 2) * D; }
        else if (e < EX_END) { src = p.in[5] + (size_t)(e - EX_SHIFT) * D; norm = false; } }
    u32x2* o8 = (u32x2*)hrow + lane;
    if (!src) {
#pragma unroll
        for (int j = 0; j < 4; ++j) o8[64 * j] = (u32x2){0u, 0u};
        return; }
    const f32x4* xr = (const f32x4*)src + lane;
    f32x4 v[4]; float ss = 0.f;
#pragma unroll
    for (int j = 0; j < 4; ++j) { v[j] = xr[64 * j]; ss += v[j][0] * v[j][0] + v[j][1] * v[j][1] + v[j][2] * v[j][2] + v[j][3] * v[j][3]; }
    if (norm) {
        const float rs = rsqrtf(wave_sum(ss) * (1.f / D) + 1e-6f);
        const f32x4* wr = (const f32x4*)p.in[7] + lane;
#pragma unroll
        for (int j = 0; j < 4; ++j) v[j] = v[j] * rs * wr[64 * j];
    }
#pragma unroll
    for (int j = 0; j < 4; ++j) { o8[64 * j] = (u32x2){pk2(v[j][0], v[j][1]), pk2(v[j][2], v[j][3])}; if (sh) ((f32x4*)sh)[lane + 64 * j] = v[j]; }
}
template <int MODE> __device__ __forceinline__ void p0_tr_item(const float* W, int N, bf16_t* WT, float* scr, int kb, int nb, int lane) {
    const int k0 = 64 * kb, n0 = 32 * nb;
    const int nn = n0 + (lane & 31);
    int srcc = nn;
    if (MODE == 1) srcc = nn < C_GATE_REF ? nn : (nn < NPB ? -1 : nn - (NPB - C_GATE_REF));
#pragma unroll 8
    for (int i = 0; i < 32; ++i) { const int kk = 2 * i + (lane >> 5); scr[kk * 33 + (lane & 31)] = srcc >= 0 ? W[(size_t)(k0 + kk) * N + srcc] : 0.f; }
    asm volatile("s_waitcnt lgkmcnt(0)" ::: "memory");
    const int c = lane & 7;
#pragma unroll
    for (int j = 0; j < 4; ++j) { const int n = (lane >> 3) + 8 * j; const float* s = scr + (8 * c) * 33 + n;
        u32x4 o; o.x = pk2(s[0 * 33], s[1 * 33]); o.y = pk2(s[2 * 33], s[3 * 33]); o.z = pk2(s[4 * 33], s[5 * 33]); o.w = pk2(s[6 * 33], s[7 * 33]);
        *(u32x4*)(WT + (size_t)(n0 + n) * D + k0 + 8 * c) = o; }
    asm volatile("s_waitcnt lgkmcnt(0)" ::: "memory");
}
__device__ __forceinline__ void phase0(const Params& p, unsigned char* smem) {
    const int tid0 = otid(), wave = tid0 >> 6, lane = tid0 & 63;
    const int gw = obid() * 8 + wave, NGW = gridDim.x * 8;
    float* scr = (float*)smem + wave * (64 * 33);
    constexpr int I_IN = 16 * (NP / 32), I_SQ = 16 * 32;
    for (int it = gw; it < I_IN + 3 * I_SQ; it += NGW) {
        int r = it;
        if (r < I_IN) { p0_tr_item<1>(p.in[8], 10384, (bf16_t*)(p.ws + WS_WT_IN), scr, r / (NP / 32), r % (NP / 32), lane); continue; } r -= I_IN;
        if (r < I_SQ) { p0_tr_item<0>(p.in[13], D, (bf16_t*)(p.ws + WS_WT_A), scr, r / 32, r % 32, lane); continue; } r -= I_SQ;
        if (r < I_SQ) { p0_tr_item<0>(p.in[24], D, (bf16_t*)(p.ws + WS_WT_B), scr, r / 32, r % 32, lane); continue; } r -= I_SQ;
        p0_tr_item<0>(p.in[25], D, (bf16_t*)(p.ws + WS_WT_O), scr, r / 32, r % 32, lane);
    }
    for (int r = gw; r < HROWS; r += NGW) p0_row(p, r, lane);
    {
        float* pk = (float*)(p.ws + WS_PK);
        const int gt = obid() * 512 + tid0, NT = gridDim.x * 512;
#define PKCOPY(off, idx, n) for (int i = gt; i < (n); i += NT) pk[(off) + i] = p.in[idx][i];
        PKCOPY(PK_CONVW, 9, 12288) PKCOPY(PK_ALOG, 10, 8) PKCOPY(PK_DTB, 11, 8) PKCOPY(PK_NORMW, 12, 128) PKCOPY(PK_MU, 14, 4224) PKCOPY(PK_W0, 15, 1024)
        PKCOPY(PK_W2, 16, 65536) PKCOPY(PK_A0, 17, 1024) PKCOPY(PK_A2, 18, 65536) PKCOPY(PK_KK, 19, 1024) PKCOPY(PK_KA, 20, 1024) PKCOPY(PK_RK, 21, 1024)
        PKCOPY(PK_GNW, 22, 1024) PKCOPY(PK_GNB, 23, 1024) PKCOPY(PK_LNF, 26, 1024)
#undef PKCOPY
    }
}

__device__ __forceinline__ void gdn_item(const Params& p, unsigned char* smem, const float* s_in, float* s_out, const float* halo_in, float* halo_out,
                                         int h, int sl, int rowA, int nA, int rowB, int nB) {
    const int tid = otid(), w = tid >> 6, lane = tid & 63, vl = lane >> 4, kg = lane & 15;
    float* qk_s = (float*)smem; float* v_s = qk_s + 16384; float* o_s = v_s + 2048; float* gb_s = o_s + 2048; float* sst = gb_s + 128;
    const bf16_t* P = (const bf16_t*)(p.ws + WS_P);
    float* ORAW = (float*)(p.ws + WS_ORAW);
    float s[8];
    if (s_in) {
        { const int k = tid >> 2, q4 = tid & 3; const f32x4* src = (const f32x4*)(s_in + (size_t)k * 128 + sl * 32 + q4 * 8); const f32x4 a = src[0], b = src[1];
          float* d = sst + k * 33 + q4 * 8; d[0] = a[0]; d[1] = a[1]; d[2] = a[2]; d[3] = a[3]; d[4] = b[0]; d[5] = b[1]; d[6] = b[2]; d[7] = b[3]; }
        __syncthreads();
#pragma unroll
        for (int j = 0; j < 8; ++j) s[j] = sst[(kg * 8 + j) * 33 + 4 * w + vl];
        __syncthreads();
    } else {
#pragma unroll
        for (int j = 0; j < 8; ++j) s[j] = 0.f;
    }
    int pcol = -1;
    if (tid < 128) pcol = h * 128 + tid; else if (tid < 256) pcol = 1024 + h * 128 + (tid - 128); else if (tid < 288) pcol = 2048 + h * 128 + sl * 32 + (tid - 256);
    float cw0 = 0.f, cw1 = 0.f, cw2 = 0.f, cw3 = 0.f, x1 = 0.f, x2 = 0.f, x3 = 0.f;
    const float* pk = (const float*)(p.ws + WS_PK);
    if (pcol >= 0) { const float* cw = pk + PK_CONVW; cw0 = cw[pcol]; cw1 = cw[3072 + pcol]; cw2 = cw[6144 + pcol]; cw3 = cw[9216 + pcol];
        if (halo_in) { x3 = halo_in[pcol]; x2 = halo_in[3072 + pcol]; x1 = halo_in[6144 + pcol]; } }
    const float nalog = -expf(pk[PK_ALOG + h]), dtb = pk[PK_DTB + h];
#pragma unroll 1
    for (int run = 0; run < 2; ++run) {
        const int rrow = run ? rowB : rowA, rn = run ? nB : nA; const bool wout = run != 0;
#pragma unroll 1
        for (int c0 = 0; c0 < rn; c0 += 64) {
            const int nt = (rn - c0) < 64 ? (rn - c0) : 64; const int row = rrow + c0;
            if (pcol >= 0) {
                const bf16_t* src = P + (size_t)row * NPB + pcol;
                float* dst = tid < 256 ? (qk_s + tid) : (v_s + (tid - 256)); const int dstride = tid < 256 ? 256 : 32;
#pragma unroll 8
                for (int i = 0; i < nt; ++i) { const float x0 = bf2f(src[(size_t)i * NPB]); const float y = cw0 * x3 + cw1 * x2 + cw2 * x1 + cw3 * x0; x3 = x2; x2 = x1; x1 = x0; dst[i * dstride] = silu_(y); }
            } else if (tid < 352) {
                const int i = tid - 288;
                if (i < nt) { const float pa = bf2f(P[(size_t)(row + i) * NPB + C_A + h]), pb = bf2f(P[(size_t)(row + i) * NPB + C_B + h]);
                    gb_s[2 * i] = expf(nalog * softplus_(pa + dtb)); gb_s[2 * i + 1] = sigm(pb); }
            }
            __syncthreads();
#pragma unroll 1
            for (int ii = 0; ii < 8; ++ii) { const int i = w * 8 + ii;
                if (i < nt) {
#pragma unroll
                    for (int which = 0; which < 2; ++which) { float* rp = qk_s + i * 256 + which * 128; const float a = rp[lane], b = rp[lane + 64];
                        const float sc = rsqrtf(wave_sum(a * a + b * b) + 1e-6f) * (which == 0 ? 0.08838834764831845f : 1.f); rp[lane] = a * sc; rp[lane + 64] = b * sc; } } }
            __syncthreads();
#pragma unroll 1
            for (int i = 0; i < nt; ++i) {
                const f32x4 q0 = *(const f32x4*)(qk_s + i * 256 + kg * 8), q1 = *(const f32x4*)(qk_s + i * 256 + kg * 8 + 4);
                const f32x4 k0 = *(const f32x4*)(qk_s + i * 256 + 128 + kg * 8), k1 = *(const f32x4*)(qk_s + i * 256 + 128 + kg * 8 + 4);
                const float vv = v_s[i * 32 + 4 * w + vl], a = gb_s[2 * i], be = gb_s[2 * i + 1];
                float part = k0[0] * s[0] + k0[1] * s[1] + k0[2] * s[2] + k0[3] * s[3] + k1[0] * s[4] + k1[1] * s[5] + k1[2] * s[6] + k1[3] * s[7];
                const float kS = rowsum16(part);
                const float c = be * (vv - a * kS);
                s[0] = a * s[0] + k0[0] * c; s[1] = a * s[1] + k0[1] * c; s[2] = a * s[2] + k0[2] * c; s[3] = a * s[3] + k0[3] * c;
                s[4] = a * s[4] + k1[0] * c; s[5] = a * s[5] + k1[1] * c; s[6] = a * s[6] + k1[2] * c; s[7] = a * s[7] + k1[3] * c;
                float op = q0[0] * s[0] + q0[1] * s[1] + q0[2] * s[2] + q0[3] * s[3] + q1[0] * s[4] + q1[1] * s[5] + q1[2] * s[6] + q1[3] * s[7];
                const float o = rowsum16(op);
                if (kg == 0) o_s[i * 32 + 4 * w + vl] = o;
            }
            __syncthreads();
            if (wout) { const int i = tid >> 3, c4 = (tid & 7) * 4; if (i < nt) *(f32x4*)(ORAW + (size_t)(row + i) * D + h * 128 + sl * 32 + c4) = *(const f32x4*)(o_s + i * 32 + c4); }
        }
    }
    if (pcol >= 0 && (sl == 0 || tid >= 256)) { halo_out[pcol] = x3; halo_out[3072 + pcol] = x2; halo_out[6144 + pcol] = x1; }
#pragma unroll
    for (int j = 0; j < 8; ++j) sst[(kg * 8 + j) * 33 + 4 * w + vl] = s[j];
    __syncthreads();
    { const int k = tid >> 2, q4 = tid & 3; const float* d = sst + k * 33 + q4 * 8; f32x4* dst = (f32x4*)(s_out + (size_t)k * 128 + sl * 32 + q4 * 8);
      dst[0] = (f32x4){d[0], d[1], d[2], d[3]}; dst[1] = (f32x4){d[4], d[5], d[6], d[7]}; }
    __syncthreads();
}

constexpr int RW_W2 = 20544, RW_A2 = 24640;
__device__ __forceinline__ void rwkv_load_lora(const Params& p, unsigned char* smem, int hb) {
    float* w2_s = (float*)smem + RW_W2; float* a2_s = (float*)smem + RW_A2; const float* pk = (const float*)(p.ws + WS_PK);
    for (int i = otid(); i < 4096; i += 512) { const int l = i >> 6, c = i & 63; w2_s[i] = pk[PK_W2 + l * D + hb * 64 + c]; a2_s[i] = pk[PK_A2 + l * D + hb * 64 + c]; }
    __syncthreads();
}
__device__ __forceinline__ void rwkv_item(const Params& p, unsigned char* smem, const float* s_in, float* s_out, const bf16_t* prev_row, const float* halo_in, float* halo_out,
                                          int hb, int half, int rowA, int nA, int rowB, int nB) {
    const int tid = otid(), w = tid >> 6, lane = tid & 63, row = tid >> 4, kq = tid & 15;
    float* f = (float*)smem;
    float* r_s = f; float* kb_s = f + 2048; float* v_s = f + 4096; float* wd_s = f + 6144; float* ad_s = f + 8192; float* dec_s = f + 10240; float* a_s = f + 12288;
    float* kk_s = f + 14336; float* km_s = f + 16384; float* zb_s = f + 18432; float* y_s = f + 19456; float* bonus_s = f + 20480;
    const float* w2_s = f + RW_W2; const float* a2_s = f + RW_A2;
    const bf16_t* P = (const bf16_t*)(p.ws + WS_P);
    float* YRAW = (float*)(p.ws + WS_YRAW); bf16_t* C0 = (bf16_t*)(p.ws + WS_C0); bf16_t* C1 = (bf16_t*)(p.ws + WS_C1);
    float s[4];
    if (s_in) { const f32x4 t = *(const f32x4*)(s_in + (size_t)(half * 32 + row) * 64 + kq * 4); s[0] = t[0]; s[1] = t[1]; s[2] = t[2]; s[3] = t[3]; }
    else { s[0] = s[1] = s[2] = s[3] = 0.f; }
    int col = -1; float* dst = nullptr; int dstride = 64; bool is_wd = false, owner = false;
    if (tid < 64) { col = hb * 64 + tid; dst = r_s + tid; owner = half == 0; }
    else if (tid < 128) { col = 1024 + hb * 64 + (tid - 64); dst = kb_s + (tid - 64); owner = half == 0; }
    else if (tid < 192) { col = 2048 + hb * 64 + (tid - 128); dst = v_s + (tid - 128); owner = half == 0; }
    else if (tid < 256) { col = 3072 + (tid - 192); dst = wd_s + (tid - 192); is_wd = true; owner = (half == 0 && hb == 0); }
    else if (tid < 320) { col = 3136 + (tid - 256); dst = ad_s + (tid - 256); owner = (half == 0 && hb == 0); }
    else if (tid < 352) { col = 3200 + hb * 64 + half * 32 + (tid - 320); dst = zb_s + (tid - 320); dstride = 32; owner = true; }
    float mu = 0.f, prev = 0.f;
    const float* pk = (const float*)(p.ws + WS_PK);
    if (col >= 0) { mu = pk[PK_MU + col]; prev = prev_row ? bf2f(prev_row[C_RW + col]) : (halo_in ? halo_in[col] : 0.f); }
    const int cc = tid & 63, ig = tid >> 6;
    const int hc = hb * 64 + cc;
    const float w0c = pk[PK_W0 + hc], a0c = pk[PK_A0 + hc], kkc = pk[PK_KK + hc], kac = pk[PK_KA + hc];
    const float rkl = pk[PK_RK + hb * 64 + lane];
#pragma unroll 1
    for (int run = 0; run < 2; ++run) {
        const int rrow = run ? rowB : rowA, rn = run ? nB : nA; const bool wout = run != 0;
#pragma unroll 1
        for (int c0 = 0; c0 < rn; c0 += 32) {
            const int nt = (rn - c0) < 32 ? (rn - c0) : 32; const int row0 = rrow + c0;
            if (col >= 0) {
                const bf16_t* src = P + (size_t)row0 * NPB + C_RW + col;
#pragma unroll 8
                for (int i = 0; i < nt; ++i) { const float cur = bf2f(src[(size_t)i * NPB]); float m = cur + mu * (prev - cur); prev = cur; if (is_wd) m = tanh_(m); dst[i * dstride] = m; }
            }
            __syncthreads();
            {
                float aw[4] = {0.f, 0.f, 0.f, 0.f}, aa[4] = {0.f, 0.f, 0.f, 0.f};
#pragma unroll 4
                for (int l = 0; l < 64; ++l) { const float w2v = w2_s[l * 64 + cc], a2v = a2_s[l * 64 + cc];
#pragma unroll
                    for (int ii = 0; ii < 4; ++ii) { aw[ii] += wd_s[(ig * 4 + ii) * 64 + l] * w2v; aa[ii] += ad_s[(ig * 4 + ii) * 64 + l] * a2v; } }
#pragma unroll
                for (int ii = 0; ii < 4; ++ii) { const int i = ig * 4 + ii;
                    if (i < nt) { const float wraw = w0c + aw[ii]; const float wlog = -0.6065306597126334f * sigm(wraw); const float a = sigm(a0c + aa[ii]);
                        const float kbv = kb_s[i * 64 + cc];
                        dec_s[i * 64 + cc] = expf(wlog); a_s[i * 64 + cc] = a; kk_s[i * 64 + cc] = kbv * kkc; km_s[i * 64 + cc] = kbv * (1.f + (a - 1.f) * kac); } }
            }
            __syncthreads();
#pragma unroll 1
            for (int ii = 0; ii < 4; ++ii) { const int i = w * 4 + ii;
                if (i < nt) { const float kkr = kk_s[i * 64 + lane]; const float kk = kkr * rsqrtf(wave_sum(kkr * kkr) + 1e-6f); kk_s[i * 64 + lane] = kk;
                    const float a = a_s[i * 64 + lane]; a_s[i * 64 + lane] = kk * a;
                    const float rk = wave_sum(r_s[i * 64 + lane] * km_s[i * 64 + lane] * rkl); if (lane == 0) bonus_s[i] = rk; } }
            __syncthreads();
#pragma unroll 1
            for (int i = 0; i < nt; ++i) {
                const f32x4 kk4 = *(const f32x4*)(kk_s + i * 64 + kq * 4), de4 = *(const f32x4*)(dec_s + i * 64 + kq * 4), ka4 = *(const f32x4*)(a_s + i * 64 + kq * 4),
                            km4 = *(const f32x4*)(km_s + i * 64 + kq * 4), r4 = *(const f32x4*)(r_s + i * 64 + kq * 4);
                const float vv = v_s[i * 64 + half * 32 + row];
                const float sa = rowsum16(s[0] * kk4[0] + s[1] * kk4[1] + s[2] * kk4[2] + s[3] * kk4[3]);
#pragma unroll
                for (int j = 0; j < 4; ++j) s[j] = s[j] * de4[j] + (vv * km4[j] - sa * ka4[j]);
                const float y = rowsum16(s[0] * r4[0] + s[1] * r4[1] + s[2] * r4[2] + s[3] * r4[3]);
                if (kq == 0) y_s[i * 32 + row] = y;
            }
            __syncthreads();
            if (wout) { const int i = tid >> 4;
                if (i < nt) {
#pragma unroll
                    for (int q = 0; q < 2; ++q) { const int rr = (tid & 15) * 2 + q, v = half * 32 + rr, colo = hb * 64 + v;
                        const float sz = silu_(zb_s[i * 32 + rr]);
                        const size_t o = (size_t)(row0 + i) * D + colo;
                        YRAW[o] = y_s[i * 32 + rr]; C1[o] = (bf16_t)f2bf(pk[PK_GNW + colo] * sz); C0[o] = (bf16_t)f2bf((pk[PK_GNB + colo] + bonus_s[i] * v_s[i * 64 + v]) * sz); } } }
            __syncthreads();
        }
    }
    *(f32x4*)(s_out + (size_t)(half * 32 + row) * 64 + kq * 4) = (f32x4){s[0], s[1], s[2], s[3]};
    if (col >= 0 && owner && halo_out) halo_out[col] = prev;
}


__device__ __forceinline__ bf16x8 ldfrag(const bf16_t* base, int stride, int r0, int k0, int lane) {
    return *(const bf16x8*)(base + (r0 + (lane & 15)) * stride + k0 + 8 * (lane >> 4));
}
#define MFMA16(a, b, c) __builtin_amdgcn_mfma_f32_16x16x32_bf16((a), (b), (c), 0, 0, 0)
constexpr int PL_QS = 0, PL_R1 = 17408, PL_KT = 35840, PL_KTT = 54272, PL_VT = 72704, PL_R3 = 91136, PL_QKM = 109568, PL_TP = 118784, PL_TPP = 128000, PL_SM = 137216;
constexpr int QSTR = 136, TSTR = 72;

__device__ __forceinline__ void gdn_prep_item(const Params& p, unsigned char* smem, int h, int row_start, int npad, int halo_mode, int hrow, const float* halo_buf,
                                              float* halo_out, unsigned char* rec) {
    const int tid = otid(), w = tid >> 6, lane = tid & 63, q4 = lane >> 4, l15 = lane & 15;
    bf16_t* qs = (bf16_t*)(smem + PL_QS); bf16_t* ks = (bf16_t*)(smem + PL_R1); bf16_t* WT = ks; bf16_t* kT = (bf16_t*)(smem + PL_KT); bf16_t* ktT = (bf16_t*)(smem + PL_KTT);
    bf16_t* vT = (bf16_t*)(smem + PL_VT); float* Lm = (float*)(smem + PL_R3); bf16_t* UT = (bf16_t*)(smem + PL_R3); bf16_t* QKm = (bf16_t*)(smem + PL_QKM);
    bf16_t* Tp = (bf16_t*)(smem + PL_TP); bf16_t* Tpp = (bf16_t*)(smem + PL_TPP);
    float* sm = (float*)(smem + PL_SM);
    float* gcs = sm; float* bes = sm + 64; float* ssq = sm + 128; float* ssk = sm + 192; float* egs = sm + 256; float* egl_s = sm + 320; float* beg = sm + 384;
    const bf16_t* P = (const bf16_t*)(p.ws + WS_P);
    const float* pk = (const float*)(p.ws + WS_PK);
    if (tid < 128) ssq[tid] = 0.f;
    if (tid >= 448) { const int i = tid - 448;
        float g = 0.f, be = 0.f;
        if (i >= npad) { const size_t r = (size_t)(row_start + i - npad) * NPB; const float pa = bf2f(P[r + C_A + h]), pb = bf2f(P[r + C_B + h]);
            g = -expf(pk[PK_ALOG + h]) * softplus_(pa + pk[PK_DTB + h]); be = sigm(pb); }
        gcs[i] = g; bes[i] = be; }
    __syncthreads();
    if (tid < 64) {
        float x = gcs[lane];
#pragma unroll
        for (int o = 1; o < 64; o <<= 1) { const float y = __shfl_up(x, o); if (lane >= o) x += y; }
        const float gl = __shfl(x, 63);
        gcs[lane] = x; egs[lane] = expf(x); egl_s[lane] = expf(gl - x); beg[lane] = bes[lane] * expf(x);
        if (lane == 0) *(float*)(rec + GP_EGL) = expf(gl);
    }
    const int cg = tid % 48, ts = tid / 48;
    const int sec = cg >> 4;
    const int pcol = sec * 1024 + h * 128 + (cg & 15) * 8;
    float val[7][8];
    if (ts < 10) {
        float cw[4][8];
#pragma unroll
        for (int j = 0; j < 4; ++j) { const f32x4 a = *(const f32x4*)(pk + PK_CONVW + j * 3072 + pcol), b = *(const f32x4*)(pk + PK_CONVW + j * 3072 + pcol + 4);
            cw[j][0] = a[0]; cw[j][1] = a[1]; cw[j][2] = a[2]; cw[j][3] = a[3]; cw[j][4] = b[0]; cw[j][5] = b[1]; cw[j][6] = b[2]; cw[j][7] = b[3]; }
#pragma unroll
        for (int it = 0; it < 7; ++it) {
            const int i = ts + 10 * it;
            float y[8];
#pragma unroll
            for (int e = 0; e < 8; ++e) y[e] = 0.f;
            if (i < 64 && i >= npad) {
#pragma unroll
                for (int dlt = 0; dlt < 4; ++dlt) {
                    const int ii = i - 3 + dlt;
                    float x[8];
                    bool have = true;
                    if (ii >= npad) { const u32x4 rw = *(const u32x4*)(P + (size_t)(row_start + ii - npad) * NPB + pcol);
                        x[0] = __uint_as_float(rw.x << 16); x[1] = __uint_as_float(rw.x & 0xffff0000u); x[2] = __uint_as_float(rw.y << 16); x[3] = __uint_as_float(rw.y & 0xffff0000u);
                        x[4] = __uint_as_float(rw.z << 16); x[5] = __uint_as_float(rw.z & 0xffff0000u); x[6] = __uint_as_float(rw.w << 16); x[7] = __uint_as_float(rw.w & 0xffff0000u); }
                    else if (ii < 0 && npad == 0 && halo_mode == 1) { const u32x4 rw = *(const u32x4*)(P + (size_t)(hrow + ii) * NPB + pcol);
                        x[0] = __uint_as_float(rw.x << 16); x[1] = __uint_as_float(rw.x & 0xffff0000u); x[2] = __uint_as_float(rw.y << 16); x[3] = __uint_as_float(rw.y & 0xffff0000u);
                        x[4] = __uint_as_float(rw.z << 16); x[5] = __uint_as_float(rw.z & 0xffff0000u); x[6] = __uint_as_float(rw.w << 16); x[7] = __uint_as_float(rw.w & 0xffff0000u); }
                    else if (ii < 0 && npad == 0 && halo_mode == 2) { const f32x4 a = *(const f32x4*)(halo_buf + (3 + ii) * 3072 + pcol), b = *(const f32x4*)(halo_buf + (3 + ii) * 3072 + pcol + 4);
                        x[0] = a[0]; x[1] = a[1]; x[2] = a[2]; x[3] = a[3]; x[4] = b[0]; x[5] = b[1]; x[6] = b[2]; x[7] = b[3]; }
                    else have = false;
                    if (have) {
#pragma unroll
                        for (int e = 0; e < 8; ++e) y[e] += cw[dlt][e] * x[e]; }
                }
                float ss = 0.f;
#pragma unroll
                for (int e = 0; e < 8; ++e) { y[e] = silu_(y[e]); ss += y[e] * y[e]; }
                if (sec == 0) atomicAdd(ssq + i, ss); else if (sec == 1) atomicAdd(ssk + i, ss);
            }
#pragma unroll
            for (int e = 0; e < 8; ++e) val[it][e] = y[e];
        }
    }
    if (halo_out && tid < 384) {
        const int c = (tid >> 7) * 1024 + h * 128 + (tid & 127);
#pragma unroll
        for (int dd = 0; dd < 3; ++dd) halo_out[dd * 3072 + c] = bf2f(P[(size_t)(row_start + 61 + dd) * NPB + c]);
    }
    __syncthreads();
    if (ts < 10) {
#pragma unroll
        for (int it = 0; it < 7; ++it) {
            const int i = ts + 10 * it;
            if (i < 64) {
                float sc = 1.f;
                if (sec == 0) sc = rsqrtf(ssq[i] + 1e-6f) * 0.08838834764831845f; else if (sec == 1) sc = rsqrtf(ssk[i] + 1e-6f);
                const int d0 = (cg & 15) * 8;
                float x[8];
#pragma unroll
                for (int e = 0; e < 8; ++e) x[e] = val[it][e] * sc;
                if (sec == 0) { *(u32x4*)(qs + i * QSTR + d0) = (u32x4){pk2(x[0], x[1]), pk2(x[2], x[3]), pk2(x[4], x[5]), pk2(x[6], x[7])}; }
                else if (sec == 1) { *(u32x4*)(ks + i * QSTR + d0) = (u32x4){pk2(x[0], x[1]), pk2(x[2], x[3]), pk2(x[4], x[5]), pk2(x[6], x[7])};
                    const float eg = egl_s[i];
#pragma unroll
                    for (int e = 0; e < 8; ++e) { kT[(d0 + e) * TSTR + i] = (bf16_t)f2bf(x[e]); ktT[(d0 + e) * TSTR + i] = (bf16_t)f2bf(x[e] * eg); } }
                else {
#pragma unroll
                    for (int e = 0; e < 8; ++e) vT[(d0 + e) * TSTR + i] = (bf16_t)f2bf(x[e]); }
            }
        }
    }
    __syncthreads();
    {
        const int which = w >> 2, it = w & 3;
        const bf16_t* Aarr = which ? qs : ks;
        bf16x8 af[4];
#pragma unroll
        for (int kk = 0; kk < 4; ++kk) af[kk] = ldfrag(Aarr, QSTR, 16 * it, 32 * kk, lane);
#pragma unroll
        for (int jt = 0; jt < 4; ++jt) {
            f32x4 acc = {0.f, 0.f, 0.f, 0.f};
#pragma unroll
            for (int kk = 0; kk < 4; ++kk) acc = MFMA16(af[kk], ldfrag(ks, QSTR, 16 * jt, 32 * kk, lane), acc);
            const int j = 16 * jt + l15; const float gj = gcs[j];
#pragma unroll
            for (int r = 0; r < 4; ++r) { const int i = 16 * it + 4 * q4 + r;
                if (which == 0) Lm[i * 64 + j] = (i > j) ? bes[i] * acc[r] * expf(gcs[i] - gj) : 0.f;
                else QKm[i * TSTR + j] = (bf16_t)f2bf((i >= j) ? acc[r] * expf(gcs[i] - gj) : 0.f); }
        }
    }
    __syncthreads();
    if (w == 0) {
        float Tr[64];
#pragma unroll
        for (int i = 0; i < 64; ++i) Tr[i] = 0.f;
#pragma unroll
        for (int i = 0; i < 64; ++i) {
            float a = (lane == i) ? 1.f : 0.f;
#pragma unroll
            for (int j0 = 0; j0 < i; j0 += 4) { const f32x4 l4 = *(const f32x4*)(Lm + i * 64 + j0);
                a -= l4[0] * Tr[j0]; a -= l4[1] * Tr[j0 + 1]; a -= l4[2] * Tr[j0 + 2]; a -= l4[3] * Tr[j0 + 3]; }
            Tr[i] = a;
        }
        const float s1 = beg[lane], s2 = bes[lane];
#pragma unroll
        for (int i = 0; i < 64; ++i) { Tp[i * TSTR + lane] = (bf16_t)f2bf(Tr[i] * s1); Tpp[i * TSTR + lane] = (bf16_t)f2bf(Tr[i] * s2); }
    }
    __syncthreads();
    {
        const int it = w & 3, half = w >> 2;
        f32x4 aw[4], au[4];
#pragma unroll
        for (int x = 0; x < 4; ++x) { aw[x] = (f32x4){0.f, 0.f, 0.f, 0.f}; au[x] = (f32x4){0.f, 0.f, 0.f, 0.f}; }
#pragma unroll
        for (int kk = 0; kk < 2; ++kk) {
            const bf16x8 a1 = ldfrag(Tp, TSTR, 16 * it, 32 * kk, lane), a2 = ldfrag(Tpp, TSTR, 16 * it, 32 * kk, lane);
#pragma unroll
            for (int x = 0; x < 4; ++x) { const int dt = half * 4 + x;
                aw[x] = MFMA16(a1, ldfrag(kT, TSTR, 16 * dt, 32 * kk, lane), aw[x]);
                au[x] = MFMA16(a2, ldfrag(vT, TSTR, 16 * dt, 32 * kk, lane), au[x]); }
        }
        __syncthreads();
#pragma unroll
        for (int x = 0; x < 4; ++x) { const int d = 16 * (half * 4 + x) + l15, i0 = 16 * it + 4 * q4;
            *(u32x2*)(WT + d * TSTR + i0) = (u32x2){pk2(aw[x][0], aw[x][1]), pk2(aw[x][2], aw[x][3])};
            *(u32x2*)(UT + d * TSTR + i0) = (u32x2){pk2(au[x][0], au[x][1]), pk2(au[x][2], au[x][3])}; }
    }
    __syncthreads();
    {
        bf16_t* gAP = (bf16_t*)(rec + GP_AP); bf16_t* gQH = (bf16_t*)(rec + GP_QH); bf16_t* gKH = (bf16_t*)(rec + GP_KH); bf16_t* gOH = (bf16_t*)(rec + GP_OH);
        {
            const int et = w;
            const bf16x8 a0 = ldfrag(WT, TSTR, 16 * et, 0, lane), a1 = ldfrag(WT, TSTR, 16 * et, 32, lane);
#pragma unroll
            for (int dt = 0; dt < 8; ++dt) { f32x4 acc = {0.f, 0.f, 0.f, 0.f};
                acc = MFMA16(a0, ldfrag(ktT, TSTR, 16 * dt, 0, lane), acc); acc = MFMA16(a1, ldfrag(ktT, TSTR, 16 * dt, 32, lane), acc);
                *(u32x2*)(gAP + ((size_t)(dt * 4 + (et >> 1)) * 64 + lane) * 8 + (et & 1) * 4) = (u32x2){pk2(-acc[0], -acc[1]), pk2(-acc[2], -acc[3])}; }
#pragma unroll
            for (int tt = 0; tt < 4; ++tt) { f32x4 acc = {0.f, 0.f, 0.f, 0.f};
                acc = MFMA16(a0, ldfrag(QKm, TSTR, 16 * tt, 0, lane), acc); acc = MFMA16(a1, ldfrag(QKm, TSTR, 16 * tt, 32, lane), acc);
                const int t = 16 * tt + l15, e0 = 16 * et + 4 * q4; const float eg = egs[t];
                const u32x2 qq = *(const u32x2*)(qs + t * QSTR + e0);
                const float o0 = __uint_as_float(qq.x << 16) * eg - acc[0], o1 = __uint_as_float(qq.x & 0xffff0000u) * eg - acc[1],
                            o2 = __uint_as_float(qq.y << 16) * eg - acc[2], o3 = __uint_as_float(qq.y & 0xffff0000u) * eg - acc[3];
                *(u32x2*)(gQH + ((size_t)(tt * 4 + (et >> 1)) * 64 + lane) * 8 + (et & 1) * 4) = (u32x2){pk2(o0, o1), pk2(o2, o3)}; }
        }
        {
            const int dt = w;
            const bf16x8 a0 = ldfrag(ktT, TSTR, 16 * dt, 0, lane), a1 = ldfrag(ktT, TSTR, 16 * dt, 32, lane);
#pragma unroll
            for (int vt = 0; vt < 8; ++vt) { f32x4 acc = {0.f, 0.f, 0.f, 0.f};
                acc = MFMA16(a0, ldfrag(UT, TSTR, 16 * vt, 0, lane), acc); acc = MFMA16(a1, ldfrag(UT, TSTR, 16 * vt, 32, lane), acc);
                *(u32x2*)(gKH + ((size_t)(vt * 8 + dt) * 64 + lane) * 4) = (u32x2){pk2(acc[0], acc[1]), pk2(acc[2], acc[3])}; }
            const int tt = w & 3, vh = w >> 2;
            const bf16x8 b0 = ldfrag(QKm, TSTR, 16 * tt, 0, lane), b1 = ldfrag(QKm, TSTR, 16 * tt, 32, lane);
#pragma unroll
            for (int x = 0; x < 4; ++x) { const int vt = vh * 4 + x; f32x4 acc = {0.f, 0.f, 0.f, 0.f};
                acc = MFMA16(b0, ldfrag(UT, TSTR, 16 * vt, 0, lane), acc); acc = MFMA16(b1, ldfrag(UT, TSTR, 16 * vt, 32, lane), acc);
                *(u32x2*)(gOH + ((size_t)(vt * 4 + tt) * 64 + lane) * 4) = (u32x2){pk2(acc[0], acc[1]), pk2(acc[2], acc[3])}; }
        }
    }
    __syncthreads();
}

__device__ __forceinline__ void phase_gprep(const Params& p, int seg, unsigned char* smem) {
    const int blk = obid();
    float* chalo = (float*)(p.ws + WS_CHALO);
    const int n_items = (CPS + (seg == 0 ? 1 : 0)) * 64;
#pragma unroll 1
    for (int it = blk; it < n_items; it += gridDim.x) {
        const int bh = it & 63, b = bh >> 3, h = bh & 7; int cl = it >> 6; if (seg != 0) cl += 1;
        unsigned char* rec = p.ws + WS_GP + (size_t)(cl * 64 + bh) * GP_STRIDE;
        if (cl == 0) gdn_prep_item(p, smem, h, LEX0, 48, 0, 0, nullptr, nullptr, rec);
        else {
            const int row = b * SEGTOK + (cl - 1) * 64;
            int mode = 1, hrow = row;
            const float* hb = nullptr;
            if (cl == 1) { if (seg == 0) { hrow = LEX0 + NMETA; } else { mode = 2; hb = chalo + (size_t)(((seg - 1) & 1) * NBATCH + b) * 9216; } }
            float* ho = nullptr;
            if (cl == CPS) ho = (seg == NSEG - 1) ? p.out + O_CONV_P + (size_t)b * 9216 : chalo + (size_t)((seg & 1) * NBATCH + b) * 9216;
            gdn_prep_item(p, smem, h, row, 0, mode, hrow, hb, ho, rec);
        }
    }
}

__device__ __forceinline__ void gdn_scan_block(const Params& p, int seg, unsigned char* smem, int bh) {
    const int tid = otid(), w = tid >> 6, lane = tid & 63, q4 = lane >> 4, l15 = lane & 15;
    const int b = bh >> 3, h = bh & 7;
    float* st = p.out + O_GDN_P + (size_t)bh * 16384;
    float* ORAW = (float*)(p.ws + WS_ORAW);
    f32x4 S[8];
    if (seg) {
#pragma unroll
        for (int mt = 0; mt < 8; ++mt)
#pragma unroll
            for (int r = 0; r < 4; ++r) S[mt][r] = st[(size_t)(16 * mt + 4 * q4 + r) * 128 + 16 * w + l15];
    } else {
#pragma unroll
        for (int mt = 0; mt < 8; ++mt) S[mt] = (f32x4){0.f, 0.f, 0.f, 0.f};
    }
    const int c_lo = seg ? 1 : 0;
#pragma unroll 1
    for (int cl = c_lo; cl <= CPS; ++cl) {
        const unsigned char* rec = p.ws + WS_GP + (size_t)(cl * 64 + bh) * GP_STRIDE;
        __syncthreads();
        {
            const u32x4* src = (const u32x4*)rec; u32x4* dst = (u32x4*)smem;
#pragma unroll
            for (int x = 0; x < 6; ++x) dst[tid + 512 * x] = src[tid + 512 * x];
        }
        const bf16_t* gKH = (const bf16_t*)(rec + GP_KH); const bf16_t* gOH = (const bf16_t*)(rec + GP_OH);
        u32x2 kh[8], oh[4];
#pragma unroll
        for (int mt = 0; mt < 8; ++mt) kh[mt] = *(const u32x2*)(gKH + ((size_t)(w * 8 + mt) * 64 + lane) * 4);
#pragma unroll
        for (int tt = 0; tt < 4; ++tt) oh[tt] = *(const u32x2*)(gOH + ((size_t)(w * 4 + tt) * 64 + lane) * 4);
        const float egl = *(const float*)(rec + GP_EGL);
        bf16x8 Bf[4];
#pragma unroll
        for (int ks = 0; ks < 4; ++ks) { u32x4 t; t.x = pk2(S[2 * ks][0], S[2 * ks][1]); t.y = pk2(S[2 * ks][2], S[2 * ks][3]); t.z = pk2(S[2 * ks + 1][0], S[2 * ks + 1][1]); t.w = pk2(S[2 * ks + 1][2], S[2 * ks + 1][3]);
            Bf[ks] = __builtin_bit_cast(bf16x8, t); }
        __syncthreads();
        const bf16x8* AP = (const bf16x8*)smem; const bf16x8* QH = (const bf16x8*)(smem + GP_QH);
        if (cl > 0) {
            const int row = b * SEGTOK + (cl - 1) * 64;
#pragma unroll
            for (int tt = 0; tt < 4; ++tt) { f32x4 o = {0.f, 0.f, 0.f, 0.f};
#pragma unroll
                for (int ks = 0; ks < 4; ++ks) o = MFMA16(QH[(tt * 4 + ks) * 64 + lane], Bf[ks], o);
                o[0] += __uint_as_float(oh[tt].x << 16); o[1] += __uint_as_float(oh[tt].x & 0xffff0000u); o[2] += __uint_as_float(oh[tt].y << 16); o[3] += __uint_as_float(oh[tt].y & 0xffff0000u);
#pragma unroll
                for (int r = 0; r < 4; ++r) ORAW[(size_t)(row + 16 * tt + 4 * q4 + r) * D + h * 128 + 16 * w + l15] = o[r]; }
        }
#pragma unroll
        for (int mt = 0; mt < 8; ++mt) { f32x4 t = {0.f, 0.f, 0.f, 0.f};
#pragma unroll
            for (int ks = 0; ks < 4; ++ks) t = MFMA16(AP[(mt * 4 + ks) * 64 + lane], Bf[ks], t);
            S[mt][0] = egl * S[mt][0] + t[0] + __uint_as_float(kh[mt].x << 16); S[mt][1] = egl * S[mt][1] + t[1] + __uint_as_float(kh[mt].x & 0xffff0000u);
            S[mt][2] = egl * S[mt][2] + t[2] + __uint_as_float(kh[mt].y << 16); S[mt][3] = egl * S[mt][3] + t[3] + __uint_as_float(kh[mt].y & 0xffff0000u); }
    }
#pragma unroll
    for (int mt = 0; mt < 8; ++mt)
#pragma unroll
        for (int r = 0; r < 4; ++r) st[(size_t)(16 * mt + 4 * q4 + r) * 128 + 16 * w + l15] = S[mt][r];
    __syncthreads();
}

__device__ __forceinline__ void phase2(const Params& p, int seg, unsigned char* smem) {
    const int blk = obid();
    float* out = p.out;
    float* chalo = (float*)(p.ws + WS_CHALO); float* phalo = (float*)(p.ws + WS_PHALO);
#ifndef SUB
#define SUB 0
#endif
#define SEN(x) (SUB == 0 || SUB == (x))
    if (SEN(1) && blk < 64) gdn_scan_block(p, seg, smem, blk);
    if (SEN(2) && seg == 0) {
#pragma unroll 1
        for (int it = blk; it < DECB * 32; it += gridDim.x) {
            const int h = it & 7, sl = (it >> 3) & 3, bs = it >> 5;
            gdn_item(p, smem, p.in[2] + (size_t)(bs * 8 + h) * 16384, out + O_GDN_S + (size_t)(bs * 8 + h) * 16384, p.in[3] + (size_t)bs * 9216, out + O_CONV_S + (size_t)bs * 9216,
                     h, sl, 0, 0, LEX0 + EX_SAMP + bs * DECT, DECT);
        }
    }
    {
        const int hb = blk & 15, rest = blk >> 4;
        rwkv_load_lora(p, smem, hb);
        if (SEN(3)) {
            const int b = rest >> 1, half = rest & 1;
            float* st = out + O_RWKV_P + (size_t)(b * 16 + hb) * 4096;
            const float* hin = seg ? phalo + (size_t)(((seg - 1) & 1) * NBATCH + b) * RW_SHIFT : nullptr;
            float* hout = phalo + (size_t)((seg & 1) * NBATCH + b) * RW_SHIFT;
            rwkv_item(p, smem, seg ? st : nullptr, st, nullptr, hin, hout, hb, half, LEX0, seg ? 0 : NMETA, b * SEGTOK, SEGTOK);
        }
        if (SEN(4) && seg == 0) {
#pragma unroll 1
            for (int j = 0; j < 16; ++j) {
                const int idx = rest * 16 + j, bs = idx >> 1, half = idx & 1;
                const bf16_t* prow = (const bf16_t*)(p.ws + WS_P) + (size_t)(LEX0 + EX_SHIFT + bs) * NPB;
                rwkv_item(p, smem, p.in[4] + (size_t)(bs * 16 + hb) * 4096, out + O_RWKV_S + (size_t)(bs * 16 + hb) * 4096, prow, nullptr, nullptr, hb, half, 0, 0, LEX0 + EX_SAMP + bs * DECT, DECT);
            }
        }
    }
}

__device__ __forceinline__ void phase25(const Params& p, int seg) {
    const int tid0 = otid(); const int lane = tid0 & 63; const int gw = obid() * 8 + (tid0 >> 6), NGW = gridDim.x * 8;
    const bf16_t* P = (const bf16_t*)(p.ws + WS_P);
    const float* ORAW = (const float*)(p.ws + WS_ORAW); const float* YRAW = (const float*)(p.ws + WS_YRAW);
    const bf16_t* C0 = (const bf16_t*)(p.ws + WS_C0); const bf16_t* C1 = (const bf16_t*)(p.ws + WS_C1);
    bf16_t* OA = (bf16_t*)(p.ws + WS_H); bf16_t* OB = (bf16_t*)(p.ws + WS_OB);
    const int nrows = LEX0 + (seg == 0 ? DECB * DECT : 0);
    const int c = lane * 16;
    f32x4 nw[4];
#pragma unroll
    for (int j = 0; j < 4; ++j) nw[j] = *(const f32x4*)((const float*)(p.ws + WS_PK) + PK_NORMW + (c & 127) + 4 * j);
#pragma unroll 1
    for (int rr = gw; rr < nrows; rr += NGW) {
        int lr; size_t grow;
        if (rr < LEX0) { lr = rr; grow = (size_t)(rr / SEGTOK) * SEQ + seg * SEGTOK + (rr % SEGTOK); } else { lr = LEX0 + EX_SAMP + (rr - LEX0); grow = (size_t)XROWS + EX_SAMP + (rr - LEX0); }
        {
            f32x4 o[4]; float ss = 0.f;
#pragma unroll
            for (int j = 0; j < 4; ++j) { o[j] = *(const f32x4*)(ORAW + (size_t)lr * D + c + 4 * j); ss += o[j][0] * o[j][0] + o[j][1] * o[j][1] + o[j][2] * o[j][2] + o[j][3] * o[j][3]; }
            ss += __shfl_xor(ss, 1); ss += __shfl_xor(ss, 2); ss += __shfl_xor(ss, 4);
            const float rs = rsqrtf(ss * (1.f / 128.f) + 1e-6f);
            const u32x4 z0 = *(const u32x4*)(P + (size_t)lr * NPB + C_Z + c), z1 = *(const u32x4*)(P + (size_t)lr * NPB + C_Z + c + 8);
            const unsigned zz[8] = {z0.x, z0.y, z0.z, z0.w, z1.x, z1.y, z1.z, z1.w};
            unsigned ow[8];
#pragma unroll
            for (int j = 0; j < 8; ++j) { const float za = __uint_as_float(zz[j] << 16), zb = __uint_as_float(zz[j] & 0xffff0000u);
                const float a = o[j >> 1][(j & 1) * 2] * rs * nw[j >> 1][(j & 1) * 2] * silu_(za), b = o[j >> 1][(j & 1) * 2 + 1] * rs * nw[j >> 1][(j & 1) * 2 + 1] * silu_(zb);
                ow[j] = pk2(a, b); }
            *(u32x4*)(OA + grow * D + c) = (u32x4){ow[0], ow[1], ow[2], ow[3]}; *(u32x4*)(OA + grow * D + c + 8) = (u32x4){ow[4], ow[5], ow[6], ow[7]};
        }
        {
            f32x4 y[4]; float sm = 0.f;
#pragma unroll
            for (int j = 0; j < 4; ++j) { y[j] = *(const f32x4*)(YRAW + (size_t)lr * D + c + 4 * j); sm += y[j][0] + y[j][1] + y[j][2] + y[j][3]; }
            sm += __shfl_xor(sm, 1); sm += __shfl_xor(sm, 2);
            const float mu = sm * (1.f / 64.f); float vs = 0.f;
#pragma unroll
            for (int j = 0; j < 4; ++j) { y[j] = y[j] - mu; vs += y[j][0] * y[j][0] + y[j][1] * y[j][1] + y[j][2] * y[j][2] + y[j][3] * y[j][3]; }
            vs += __shfl_xor(vs, 1); vs += __shfl_xor(vs, 2);
            const float rs = rsqrtf(vs * (1.f / 64.f) + 64e-5f);
            const u32x4 a0 = *(const u32x4*)(C0 + (size_t)lr * D + c), a1 = *(const u32x4*)(C0 + (size_t)lr * D + c + 8);
            const u32x4 b0 = *(const u32x4*)(C1 + (size_t)lr * D + c), b1 = *(const u32x4*)(C1 + (size_t)lr * D + c + 8);
            const unsigned c0w[8] = {a0.x, a0.y, a0.z, a0.w, a1.x, a1.y, a1.z, a1.w}, c1w[8] = {b0.x, b0.y, b0.z, b0.w, b1.x, b1.y, b1.z, b1.w};
            unsigned ow[8];
#pragma unroll
            for (int j = 0; j < 8; ++j) {
                const float a = y[j >> 1][(j & 1) * 2] * rs * __uint_as_float(c1w[j] << 16) + __uint_as_float(c0w[j] << 16);
                const float b = y[j >> 1][(j & 1) * 2 + 1] * rs * __uint_as_float(c1w[j] & 0xffff0000u) + __uint_as_float(c0w[j] & 0xffff0000u);
                ow[j] = pk2(a, b); }
            *(u32x4*)(OB + grow * D + c) = (u32x4){ow[0], ow[1], ow[2], ow[3]}; *(u32x4*)(OB + grow * D + c + 8) = (u32x4){ow[4], ow[5], ow[6], ow[7]};
        }
    }
}

__device__ __forceinline__ void phase_final(const Params& p) {
    const int tid0 = otid(); const int lane = tid0 & 63; const int gw = obid() * 8 + (tid0 >> 6), NGW = gridDim.x * 8;
    const f32x4* wr = (const f32x4*)((const float*)(p.ws + WS_PK) + PK_LNF) + lane;
#pragma unroll 1
    for (int r = gw; r < XROWS + DECB * DECT; r += NGW) {
        f32x4* xr = (f32x4*)(p.out + (size_t)r * D) + lane;
        f32x4 v[4]; float ss = 0.f;
#pragma unroll
        for (int j = 0; j < 4; ++j) { v[j] = xr[64 * j]; ss += v[j][0] * v[j][0] + v[j][1] * v[j][1] + v[j][2] * v[j][2] + v[j][3] * v[j][3]; }
        const float rs = rsqrtf(wave_sum(ss) * (1.f / D) + 1e-6f);
#pragma unroll
        for (int j = 0; j < 4; ++j) xr[64 * j] = v[j] * rs * wr[64 * j];
    }
}

__global__ __launch_bounds__(512, 2) void hybrid_mega(Params p) {
    extern __shared__ __attribute__((aligned(16))) unsigned char smem[];
    cg::grid_group grid = cg::this_grid();
    LAS unsigned char* lds = (LAS unsigned char*)smem;
    const int G = gridDim.x;

#ifndef ONLY
#define ONLY 0
#endif
#define EN(x) (ONLY == 0 || ONLY == (x))
    if (EN(1)) phase0(p, smem);
    grid.sync();
#pragma unroll 1
    for (int seg = 0; seg < NSEG; ++seg) {
        if (EN(2)) {
            SchedIn S; S.ob.init(seg == 0 ? LT_PROMPT + 3 : LT_PROMPT, NT_IN, G, obid()); S.seg = seg; S.A = (const char*)(p.ws + WS_H); S.B = (const char*)(p.ws + WS_WT_IN);
            EpiIn E; E.P = (bf16_t*)(p.ws + WS_P); E.gex = (bf16_t*)(p.ws + WS_GEX); E.out = p.out; E.seg = seg;
            pg8::gemm_phase<EpiIn, SchedIn>(lds, D, S, E);
        }
        grid.sync();
        if (EN(8)) phase_gprep(p, seg, smem);
        grid.sync();
        if (EN(3)) phase2(p, seg, smem);
        grid.sync();
        if (EN(4)) phase25(p, seg);
        grid.sync();
    }
    if (EN(5)) {
        SchedAB S; S.ob.init(HTILES, 4, G, obid()); S.A0 = (const char*)(p.ws + WS_H); S.A1 = (const char*)(p.ws + WS_OB); S.B0 = (const char*)(p.ws + WS_WT_A); S.B1 = (const char*)(p.ws + WS_WT_B);
        EpiAB E; E.tmp = (float*)(p.ws + WS_P); E.merged = (bf16_t*)(p.ws + WS_MG); E.gex = (const bf16_t*)(p.ws + WS_GEX); E.out = p.out;
        pg8::gemm_phase<EpiAB, SchedAB>(lds, D, S, E);
    }
    grid.sync();
    if (EN(6)) {
        SchedO S; S.ob.init(HTILES, 4, G, obid()); S.A = (const char*)(p.ws + WS_MG); S.B = (const char*)(p.ws + WS_WT_O);
        EpiO E; E.out = p.out; E.xp = p.in[0]; E.xs = p.in[1];
        pg8::gemm_phase<EpiO, SchedO>(lds, D, S, E);
    }
    grid.sync();
    if (EN(7)) phase_final(p);
}

extern "C" void kernel_launch(void* const* d_in, const int* in_sizes, int n_in, void* d_out, int out_size, void* d_ws, size_t ws_size, hipStream_t stream) {
    static int grid_blocks = 0;
    constexpr int LDS_BYTES = 147456;
    if (grid_blocks == 0) {
        if (n_in != 27 || ws_size < WS_END) { fprintf(stderr, "kernel_launch: unexpected n_in %d / ws %zu (need %zu)\n", n_in, ws_size, (size_t)WS_END); grid_blocks = -1; return; }
        if (hipFuncSetAttribute((const void*)hybrid_mega, hipFuncAttributeMaxDynamicSharedMemorySize, LDS_BYTES) != hipSuccess) { fprintf(stderr, "kernel_launch: hipFuncSetAttribute failed\n"); grid_blocks = -1; return; }
        int dev = 0, cus = 0, per_cu = 0;
        hipGetDevice(&dev);
        hipDeviceGetAttribute(&cus, hipDeviceAttributeMultiprocessorCount, dev);
        hipOccupancyMaxActiveBlocksPerMultiprocessor(&per_cu, (const void*)hybrid_mega, 512, LDS_BYTES);
        if (per_cu < 1) { fprintf(stderr, "kernel_launch: occupancy query says %d blocks/CU\n", per_cu); per_cu = 1; }
        (void)hipGetLastError();
        grid_blocks = cus;
    }
    if (grid_blocks < 0) return;
    Params p{};
    for (int i = 0; i < 27; ++i) p.in[i] = (const float*)d_in[i];
    p.out = (float*)d_out; p.ws = (unsigned char*)d_ws;
    void* args[] = {&p};
    hipError_t e = hipLaunchCooperativeKernel((const void*)hybrid_mega, dim3(grid_blocks), dim3(512), args, LDS_BYTES, stream);
    if (e != hipSuccess) fprintf(stderr, "cooperative launch failed: %s (grid %d)\n", hipGetErrorString(e), grid_blocks);
}
```

```cpp
#include <hip/hip_runtime.h>
#include <hip/hip_cooperative_groups.h>
#include <cstdio>
namespace cg = cooperative_groups;

#define LAS __attribute__((address_space(3)))
typedef unsigned short bf16_t;
typedef short bf16x8 __attribute__((ext_vector_type(8)));
typedef float f32x4 __attribute__((ext_vector_type(4)));
typedef unsigned u32x4 __attribute__((ext_vector_type(4)));
typedef unsigned u32x2 __attribute__((ext_vector_type(2)));

constexpr int D = 1024;
constexpr int NBATCH = 8, SEQ = 2048, NMETA = 16, DECB = 128, DECT = 4;
constexpr int XROWS = NBATCH * SEQ;
constexpr int EX_SAMP = 16, EX_SHIFT = 528, EX_END = 656;
constexpr int HROWS = 17152, HTILES = 67;
constexpr int NSEG = 8, SEGTOK = SEQ / NSEG;
constexpr int CPS = SEGTOK / 64;
constexpr int TPB = SEGTOK / 256;
constexpr int LT_PROMPT = NBATCH * TPB;
constexpr int LEX0 = LT_PROMPT * 256;
constexpr int LROWS = LEX0 + 768;
constexpr int NP = 10496, NPB = 8448, NT_IN = 41, NT_PB = 33;
constexpr int C_A = 3072, C_B = 3080, C_Z = 3088, C_RW = 4112, C_GATE_REF = 8336;
constexpr int RW_SHIFT = 4224;

constexpr size_t O_YP = 0, O_YS = 16777216, O_GDN_P = 17301504, O_CONV_P = 18350080, O_RWKV_P = 18423808, O_SHIFT_P = 18948096,
                 O_GDN_S = 18956288, O_CONV_S = 35733504, O_RWKV_S = 36913152, O_SHIFT_S = 45301760;

constexpr size_t al256(size_t x) { return (x + 255) & ~(size_t)255; }
constexpr size_t WS_WT_IN = 0;
constexpr size_t WS_WT_A = al256(WS_WT_IN + (size_t)NP * D * 2);
constexpr size_t WS_WT_B = al256(WS_WT_A + (size_t)D * D * 2);
constexpr size_t WS_WT_O = al256(WS_WT_B + (size_t)D * D * 2);
constexpr size_t WS_H = al256(WS_WT_O + (size_t)D * D * 2);
constexpr size_t WS_OB = al256(WS_H + (size_t)HROWS * D * 2);
constexpr size_t WS_P = al256(WS_OB + (size_t)HROWS * D * 2);
constexpr size_t WS_ORAW = al256(WS_P + (size_t)LROWS * NPB * 2);
constexpr size_t WS_YRAW = al256(WS_ORAW + (size_t)LROWS * D * 4);
constexpr size_t WS_C0 = al256(WS_YRAW + (size_t)LROWS * D * 4);
constexpr size_t WS_C1 = al256(WS_C0 + (size_t)LROWS * D * 2);
constexpr size_t WS_GEX = al256(WS_C1 + (size_t)LROWS * D * 2);
constexpr size_t WS_CHALO = al256(WS_GEX + (size_t)768 * 2048 * 2);
constexpr size_t WS_PHALO = al256(WS_CHALO + (size_t)2 * NBATCH * 3 * 3072 * 4);
constexpr size_t WS_PK = al256(WS_PHALO + (size_t)2 * NBATCH * RW_SHIFT * 4);
constexpr int PK_CONVW = 0, PK_ALOG = 12288, PK_DTB = 12296, PK_NORMW = 12304, PK_MU = 12432, PK_W0 = 16656, PK_W2 = 17680, PK_A0 = 83216, PK_A2 = 84240,
              PK_KK = 149776, PK_KA = 150800, PK_RK = 151824, PK_GNW = 152848, PK_GNB = 153872, PK_LNF = 154896, PK_END = 155920;
constexpr size_t WS_BAR = al256(WS_PK + (size_t)PK_END * 4);
constexpr size_t WS_MG = al256(WS_BAR + 16384);
constexpr int GP_AP = 0, GP_QH = 32768, GP_KH = 49152, GP_OH = 81920, GP_EGL = 98304, GP_STRIDE = 98560;
constexpr size_t WS_GP = al256(WS_MG + (size_t)HROWS * D * 2);
constexpr size_t WS_END = al256(WS_GP + (size_t)(CPS + 1) * 64 * GP_STRIDE);
static_assert((size_t)HROWS * D * 4 <= (size_t)LROWS * NPB * 2 + 2 * (size_t)LROWS * D * 4, "TMP must fit in P+ORAW+YRAW");
static_assert(WS_END <= (size_t)268435456, "workspace");

constexpr int LDS_TOTAL = 147456;
struct Params { const float* in[27]; float* out; unsigned char* ws; };

__device__ __forceinline__ float bf2f(bf16_t v) { return __uint_as_float(((unsigned)v) << 16); }
__device__ __forceinline__ unsigned f2bf(float f) { unsigned u = __float_as_uint(f); u += 0x7fffu + ((u >> 16) & 1u); return u >> 16; }
__device__ __forceinline__ unsigned pk2(float lo, float hi) { return f2bf(lo) | (f2bf(hi) << 16); }
__device__ __forceinline__ unsigned cvt_pk_bf16(float lo, float hi) { unsigned r; asm volatile("v_cvt_pk_bf16_f32 %0, %1, %2" : "=v"(r) : "v"(lo), "v"(hi)); return r; }
__device__ __forceinline__ float sigm(float x) { return 1.f / (1.f + __expf(-x)); }
__device__ __forceinline__ float silu_(float x) { return x / (1.f + __expf(-x)); }
__device__ __forceinline__ float softplus_(float x) { return fmaxf(x, 0.f) + log1pf(expf(-fabsf(x))); }
__device__ __forceinline__ float wave_sum(float v) {
#pragma unroll
    for (int o = 1; o < 64; o <<= 1) v += __shfl_xor(v, o);
    return v;
}
__device__ __forceinline__ int otid() { int t = threadIdx.x; asm volatile("" : "+v"(t)); return t; }
__device__ __forceinline__ int obid() { int t = blockIdx.x; asm volatile("" : "+s"(t)); return t; }
__device__ __forceinline__ float tanh_(float x) { const float e = __expf(2.f * x); return 1.f - 2.f / (e + 1.f); }
template <int CTRL> __device__ __forceinline__ float dppf(float x) { return __builtin_bit_cast(float, __builtin_amdgcn_mov_dpp(__builtin_bit_cast(int, x), CTRL, 0xf, 0xf, true)); }
__device__ __forceinline__ float rowsum16(float x) { x += dppf<0x128>(x); x += dppf<0x124>(x); x += dppf<0x122>(x); x += dppf<0x121>(x); return x; }


#define XB_TMO      128
#define XB_XCNT(j)  (256  + 64 * (j))
#define XB_XSUB(j)  (1280 + 64 * (j))
#define XB_XGEN(j)  (2304 + 64 * (j))
#define XB_TOP      3328
#define XB_TOPGEN   3392
#define XCD_BAR_WORDS 3456
#define XB_SPIN_CAP (1u << 22)
__device__ __forceinline__ unsigned xb_ld(unsigned* p)              { return __hip_atomic_load(p, __ATOMIC_RELAXED, __HIP_MEMORY_SCOPE_AGENT); }
__device__ __forceinline__ unsigned xb_add(unsigned* p, unsigned v) { return __hip_atomic_fetch_add(p, v, __ATOMIC_RELAXED, __HIP_MEMORY_SCOPE_AGENT); }
__device__ __forceinline__ unsigned xb_xcc_id() { return (unsigned)__builtin_amdgcn_s_getreg((3 << 11) | 20) & 0xFu; }
#define XB_SPIN(cond, bar) do { unsigned _sp = 0; while (cond) { __builtin_amdgcn_s_sleep(1); \
    if ((++_sp & 255u) == 0u) { if (xb_ld(&(bar)[XB_TMO])) break; if (_sp > XB_SPIN_CAP) { atomicAdd(&(bar)[XB_TMO], 1u); break; } } } } while (0)
struct XcdBarrier { unsigned* bar; unsigned x; volatile LAS unsigned* st; };
__device__ __forceinline__ XcdBarrier xcd_barrier_post(unsigned* bar, volatile LAS unsigned* st) {
    XcdBarrier b; b.bar = bar; b.x = xb_xcc_id(); b.st = st;
    if (threadIdx.x == 0) (void)xb_add(&bar[XB_XCNT(b.x)], 1u);
    return b;
}
__device__ __forceinline__ void xcd_barrier_complete(unsigned* bar, unsigned x, unsigned& nloc, unsigned& nx) {
    const unsigned G = gridDim.x * gridDim.y * gridDim.z;
    unsigned sum, cnt, mine, sp = 0u;
    for (;;) {
        sum = 0u; cnt = 0u; mine = 0u;
#pragma unroll
        for (unsigned j = 0; j < 16; ++j) { const unsigned c = xb_ld(&bar[XB_XCNT(j)]); sum += c; cnt += (c > 0u) ? 1u : 0u; mine = (j == x) ? c : mine; }
        if (sum == G) break;
        __builtin_amdgcn_s_sleep(1);
        if ((++sp & 255u) == 0u) { if (xb_ld(&bar[XB_TMO])) break; if (sp > XB_SPIN_CAP) { atomicAdd(&bar[XB_TMO], 1u); break; } }
    }
    nloc = mine > 0u ? mine : 1u; nx = cnt > 0u ? cnt : 1u;
}
__device__ __forceinline__ void xcd_barrier(const XcdBarrier& b) {
    asm volatile("s_waitcnt vmcnt(0)" ::: "memory");
    __syncthreads();
    if (threadIdx.x == 0) {
        unsigned* bar = b.bar;
        __builtin_amdgcn_s_waitcnt(0);
        unsigned nloc = b.st[0], nx = b.st[1];
        if (nloc == 0u) { xcd_barrier_complete(bar, b.x, nloc, nx); b.st[0] = nloc; b.st[1] = nx; }
        const unsigned old = xb_add(&bar[XB_XSUB(b.x)], 1u);
        const unsigned gen = old / nloc;
        if (old + 1u == (gen + 1u) * nloc) {
            __builtin_amdgcn_fence(__ATOMIC_RELEASE, "agent");
            asm volatile("s_waitcnt vmcnt(0)" ::: "memory");
            const unsigned og = xb_add(&bar[XB_TOP], 1u);
            const unsigned tg = og / nx;
            if (og + 1u == (tg + 1u) * nx) xb_add(&bar[XB_TOPGEN], 1u);
            else XB_SPIN(xb_ld(&bar[XB_TOPGEN]) == tg, bar);
            __builtin_amdgcn_fence(__ATOMIC_ACQUIRE, "agent");
            xb_add(&bar[XB_XGEN(b.x)], 1u);
            asm volatile("s_waitcnt vmcnt(0)" ::: "memory");
        } else {
            XB_SPIN(xb_ld(&bar[XB_XGEN(b.x)]) == gen, bar);
            __builtin_amdgcn_fence(__ATOMIC_ACQUIRE, "agent");
            asm volatile("s_waitcnt vmcnt(0)" ::: "memory");
        }
    }
    __syncthreads();
}

namespace pg8 {
constexpr int BM = 256, BK = 64, HALF = 128, HTB = HALF * BK * 2, STAGE_BYTES = 8 * HTB, NXCD = 8, WGM = 8;
__device__ __forceinline__ int lds_byte(int r, int c) { const int st = (r >> 4) * 2 + (c >> 5), rr = r & 15, cc = c & 31, ob = rr * 64 + cc * 2; return st * 1024 + (ob ^ (((ob >> 9) & 1) << 5)); }
__device__ __forceinline__ void stage_rc(int b, int& R, int& C) { const int st = b / 1024, sb = b % 1024, swz = sb ^ (((sb >> 9) & 1) << 5); R = (st >> 1) * 16 + swz / 64; C = (st & 1) * 32 + (swz % 64) / 2; }
__device__ __forceinline__ int perm32(int rho) { const int n = rho >> 4, i = rho & 15; return 8 * (i >> 2) + 4 * n + (i & 3); }

struct Unit { int pm, pn, w; };
struct OrderBase {
    int nM, nN, nwg, G, c;
    __device__ void init(int nM_, int nN_, int G_, int c_) { nM = nM_; nN = nN_; nwg = nM * nN; G = G_; c = c_; }
    __device__ bool nextb(int i, Unit& u) const {
        const long L = (long)i * G + c; if (L >= nwg) return false;
        int wgid = (int)L; { const int q = nwg / NXCD, r = nwg % NXCD, xcd = wgid % NXCD, off = wgid / NXCD; wgid = (xcd < r ? xcd * (q + 1) : r * (q + 1) + (xcd - r) * q) + off; }
        const int nig = WGM * nN, gid = wgid / nig, fm = gid * WGM, gsz = (nM - fm) < WGM ? (nM - fm) : WGM;
        u.pm = fm + ((wgid % nig) % gsz); u.pn = (wgid % nig) / gsz; u.w = 0; return true;
    }
};

template <class Epi, class Sched>
__device__ __forceinline__ void gemm_phase(LAS unsigned char* lds, const int K, const Sched& S, const Epi& E) {
    const int tid = otid(), wid = __builtin_amdgcn_readfirstlane(tid >> 6), lane = tid & 63, wr = wid >> 2, wc = wid & 3, fr = lane & 15, fq = lane >> 4;
    const int nt = K / BK;
    unsigned voffA[2], voffB[2];
#pragma unroll
    for (int i = 0; i < 2; ++i) { int R, C; stage_rc(tid * 16 + i * 8192, R, C); const int Rb = Epi::PERM ? ((R & ~31) + perm32(R & 31)) : R;
        voffA[i] = (unsigned)(R * K + C) * 2u; voffB[i] = (unsigned)(Rb * K + C) * 2u; }
    const size_t kstep = (size_t)(BK * 2);
    const size_t hstep = (size_t)HALF * K * 2;
    const unsigned ldsw = (unsigned)wid * 1024u;
    const int aoff = lds_byte(wr * 64 + fr, fq * 8), boff = lds_byte(wc * 32 + fr, fq * 8);
#define PG8_SA(b, h) (((b) * 2 + (h)) * HTB)
#define PG8_SB(b, h) ((4 + (b) * 2 + (h)) * HTB)
#define PG8_STAGE(bufoff, gbase, voff) do { _Pragma("unroll") for (int _i = 0; _i < 2; ++_i) \
        __builtin_amdgcn_global_load_lds((const unsigned*)((const char*)(gbase) + (voff)[_i]), (LAS unsigned*)(lds + (bufoff) + ldsw + _i * 8192), 16, 0, 0); } while (0)
#define PG8_LDA(dst, b, h) do { _Pragma("unroll") for (int m = 0; m < 4; ++m) _Pragma("unroll") for (int k = 0; k < 2; ++k) dst[m][k] = *(const LAS bf16x8*)(lds + PG8_SA(b, h) + aoff + m * 2048 + k * 1024); } while (0)
#define PG8_LDB(dst, b, h) do { _Pragma("unroll") for (int n = 0; n < 2; ++n) _Pragma("unroll") for (int k = 0; k < 2; ++k) dst[n][k] = *(const LAS bf16x8*)(lds + PG8_SB(b, h) + boff + n * 2048 + k * 1024); } while (0)
#define PG8_MMA(ai, bj, At, Bt) do { __builtin_amdgcn_s_setprio(1); _Pragma("unroll") for (int m = 0; m < 4; ++m) _Pragma("unroll") for (int n = 0; n < 2; ++n) _Pragma("unroll") for (int k = 0; k < 2; ++k) \
        acc[ai][bj][m][n] = __builtin_amdgcn_mfma_f32_16x16x32_bf16(Bt[n][k], At[m][k], acc[ai][bj][m][n], 0, 0, 0); __builtin_amdgcn_s_setprio(0); } while (0)
#define PG8_WAIT_V(n) asm volatile("s_waitcnt vmcnt(" #n ")" ::: "memory")
#define PG8_WAIT_L(n) asm volatile("s_waitcnt lgkmcnt(" #n ")" ::: "memory")
#define PG8_BAR __builtin_amdgcn_s_barrier()
#define PG8_SCHED __builtin_amdgcn_sched_barrier(0)
    Unit cur, nxt; int ui = 0;
    if (!S.next(0, cur)) return;
    f32x4 acc[2][2][4][2];
#pragma unroll
    for (int a = 0; a < 2; ++a)
#pragma unroll
        for (int b = 0; b < 2; ++b)
#pragma unroll
            for (int m = 0; m < 4; ++m)
#pragma unroll
                for (int n = 0; n < 2; ++n) acc[a][b][m][n] = (f32x4){0.f, 0.f, 0.f, 0.f};
    bf16x8 At[4][2], B0[2][2], B1[2][2];
    const char* cA = S.a_ptr(cur); const char* cB = S.b_ptr(cur);
    PG8_STAGE(PG8_SB(0, 0), cB, voffB); PG8_STAGE(PG8_SA(0, 0), cA, voffA); PG8_STAGE(PG8_SB(0, 1), cB + hstep, voffB); PG8_STAGE(PG8_SA(0, 1), cA + hstep, voffA);
    if (wr == 1) PG8_BAR;
    PG8_WAIT_V(4); PG8_BAR;
    PG8_STAGE(PG8_SB(1, 0), cB + kstep, voffB); PG8_STAGE(PG8_SA(1, 0), cA + kstep, voffA); PG8_STAGE(PG8_SB(1, 1), cB + hstep + kstep, voffB);
    PG8_WAIT_V(6); PG8_BAR;
    for (;;) {
        const bool has_next = S.next(ui + 1, nxt);
        const char* nA = has_next ? S.a_ptr(nxt) : cA; const char* nB = has_next ? S.b_ptr(nxt) : cB;
        for (int t = 0; t < nt; t += 2) {
            const bool last = (t == nt - 2);
            const char* a1 = cA + (size_t)(t + 1) * kstep;
            const char* a2 = last ? nA : cA + (size_t)(t + 2) * kstep; const char* b2 = last ? nB : cB + (size_t)(t + 2) * kstep;
            const char* a3 = a2 + kstep; const char* b3 = b2 + kstep;
            PG8_LDB(B0, 0, 0); PG8_SCHED; PG8_LDA(At, 0, 0); PG8_STAGE(PG8_SA(1, 1), a1 + hstep, voffA);
            PG8_WAIT_L(8); PG8_BAR; PG8_WAIT_L(0); PG8_MMA(0, 0, At, B0); PG8_BAR; PG8_SCHED;
            PG8_LDB(B1, 0, 1); PG8_STAGE(PG8_SB(0, 0), b2, voffB);
            PG8_BAR; PG8_WAIT_L(0); PG8_MMA(0, 1, At, B1); PG8_BAR;
            PG8_LDA(At, 0, 1); PG8_STAGE(PG8_SA(0, 0), a2, voffA);
            PG8_BAR; PG8_WAIT_L(0); PG8_MMA(1, 0, At, B0); PG8_BAR; PG8_SCHED;
            PG8_STAGE(PG8_SB(0, 1), b2 + hstep, voffB);
            PG8_WAIT_V(6); PG8_BAR; PG8_MMA(1, 1, At, B1); PG8_BAR;
            PG8_LDB(B0, 1, 0); PG8_SCHED; PG8_LDA(At, 1, 0); PG8_STAGE(PG8_SA(0, 1), a2 + hstep, voffA);
            PG8_WAIT_L(8); PG8_BAR; PG8_WAIT_L(0); PG8_MMA(0, 0, At, B0); PG8_BAR; PG8_SCHED;
            PG8_LDB(B1, 1, 1); PG8_STAGE(PG8_SB(1, 0), b3, voffB);
            PG8_BAR; PG8_WAIT_L(0); PG8_MMA(0, 1, At, B1); PG8_BAR;
            PG8_LDA(At, 1, 1); PG8_STAGE(PG8_SA(1, 0), a3, voffA);
            PG8_BAR; PG8_WAIT_L(0); PG8_MMA(1, 0, At, B0); PG8_BAR; PG8_SCHED;
            PG8_STAGE(PG8_SB(1, 1), b3 + hstep, voffB);
            PG8_WAIT_V(6); PG8_BAR; PG8_MMA(1, 1, At, B1); PG8_BAR;
        }
        E(acc, cur, wr, wc, fr, fq);
        if (!has_next) break;
#pragma unroll
        for (int a = 0; a < 2; ++a)
#pragma unroll
            for (int b = 0; b < 2; ++b)
#pragma unroll
                for (int m = 0; m < 4; ++m)
#pragma unroll
                    for (int n = 0; n < 2; ++n) acc[a][b][m][n] = (f32x4){0.f, 0.f, 0.f, 0.f};
        cur = nxt; cA = nA; cB = nB; ++ui;
    }
    PG8_WAIT_V(0);
    if (wr == 0) PG8_BAR;
    PG8_BAR;
#undef PG8_SA
#undef PG8_SB
#undef PG8_STAGE
#undef PG8_LDA
#undef PG8_LDB
#undef PG8_MMA
#undef PG8_WAIT_V
#undef PG8_WAIT_L
#undef PG8_BAR
#undef PG8_SCHED
}
}
using pg8::Unit;

struct SchedIn {
    pg8::OrderBase ob; int seg; const char* A; const char* B;
    __device__ bool next(int i, Unit& u) const { return ob.nextb(i, u); }
    __device__ const char* a_ptr(const Unit& u) const {
        const int gt = u.pm < LT_PROMPT ? ((u.pm / TPB) * (SEQ / 256) + seg * TPB + (u.pm % TPB)) : (XROWS / 256 + (u.pm - LT_PROMPT));
        return A + (size_t)gt * 256 * D * 2; }
    __device__ const char* b_ptr(const Unit& u) const { return B + (size_t)u.pn * 256 * D * 2; }
};
struct SchedAB {
    pg8::OrderBase ob; const char* A0; const char* A1; const char* B0; const char* B1;
    __device__ bool next(int i, Unit& u) const { const bool ok = ob.nextb(i >> 1, u); u.w = i & 1; return ok; }
    __device__ const char* a_ptr(const Unit& u) const { return (u.w ? A1 : A0) + (size_t)u.pm * 256 * D * 2; }
    __device__ const char* b_ptr(const Unit& u) const { return (u.w ? B1 : B0) + (size_t)u.pn * 256 * D * 2; }
};
struct SchedO {
    pg8::OrderBase ob; const char* A; const char* B;
    __device__ bool next(int i, Unit& u) const { return ob.nextb(i, u); }
    __device__ const char* a_ptr(const Unit& u) const { return A + (size_t)u.pm * 256 * D * 2; }
    __device__ const char* b_ptr(const Unit& u) const { return B + (size_t)u.pn * 256 * D * 2; }
};

struct EpiIn {
    static constexpr bool PERM = true;
    bf16_t* P; bf16_t* gex; float* out; int seg;
    __device__ __forceinline__ void operator()(const f32x4 (&acc)[2][2][4][2], const Unit& u, int wr, int wc, int fr, int fq) const {
        const int lr0 = u.pm * 256 + wr * 64 + fr;
        const int c0 = u.pn * 256 + wc * 32 + 8 * fq;
#pragma unroll
        for (int ai = 0; ai < 2; ++ai)
#pragma unroll
            for (int m = 0; m < 4; ++m) {
                const int lr = lr0 + ai * 128 + m * 16;
                bf16_t* rowp;
                if (u.pn < NT_PB) rowp = P + (size_t)lr * NPB + c0;
                else if (lr < LEX0) { const int b = lr / SEGTOK; const size_t grow = (size_t)b * SEQ + seg * SEGTOK + (lr % SEGTOK); rowp = (bf16_t*)(out + O_YP + grow * D) + (c0 - NPB); }
                else rowp = gex + (size_t)(lr - LEX0) * 2048 + (c0 - NPB);
#pragma unroll
                for (int bj = 0; bj < 2; ++bj) { const f32x4 v0 = acc[ai][bj][m][0], v1 = acc[ai][bj][m][1];
                    u32x4 w; w.x = cvt_pk_bf16(v0[0], v0[1]); w.y = cvt_pk_bf16(v0[2], v0[3]); w.z = cvt_pk_bf16(v1[0], v1[1]); w.w = cvt_pk_bf16(v1[2], v1[3]);
                    *(u32x4*)(rowp + bj * 128) = w; }
            }
    }
};
struct EpiAB {
    static constexpr bool PERM = false;
    float* tmp; bf16_t* merged; const bf16_t* gex; const float* out;
    __device__ __forceinline__ void operator()(const f32x4 (&acc)[2][2][4][2], const Unit& u, int wr, int wc, int fr, int fq) const {
        const int row0 = u.pm * 256 + wr * 64 + fr, col0 = u.pn * 256 + wc * 32 + 4 * fq;
#pragma unroll
        for (int ai = 0; ai < 2; ++ai)
#pragma unroll
            for (int m = 0; m < 4; ++m) {
                const int grow = row0 + ai * 128 + m * 16;
                const bf16_t* gp = (grow < XROWS) ? ((const bf16_t*)(out + O_YP + (size_t)grow * D) + u.w * D) : (gex + (size_t)(grow - XROWS) * 2048 + u.w * D);
#pragma unroll
                for (int bj = 0; bj < 2; ++bj)
#pragma unroll
                    for (int n = 0; n < 2; ++n) {
                        const int c = col0 + bj * 128 + n * 16;
                        const u32x2 g = *(const u32x2*)(gp + c);
                        f32x4 v = acc[ai][bj][m][n];
                        v[0] *= sigm(__uint_as_float(g.x << 16)); v[1] *= sigm(__uint_as_float(g.x & 0xffff0000u));
                        v[2] *= sigm(__uint_as_float(g.y << 16)); v[3] *= sigm(__uint_as_float(g.y & 0xffff0000u));
                        float* tp = tmp + (size_t)grow * D + c;
                        if (u.w == 0) *(f32x4*)tp = v;
                        else { const f32x4 t = *(const f32x4*)tp; v = v + t; u32x2 o; o.x = cvt_pk_bf16(v[0], v[1]); o.y = cvt_pk_bf16(v[2], v[3]); *(u32x2*)(merged + (size_t)grow * D + c) = o; }
                    }
            }
    }
};
struct EpiO {
    static constexpr bool PERM = false;
    float* out; const float* xp; const float* xs;
    __device__ __forceinline__ void operator()(const f32x4 (&acc)[2][2][4][2], const Unit& u, int wr, int wc, int fr, int fq) const {
        const int row0 = u.pm * 256 + wr * 64 + fr, col0 = u.pn * 256 + wc * 32 + 4 * fq;
#pragma unroll
        for (int ai = 0; ai < 2; ++ai)
#pragma unroll
            for (int m = 0; m < 4; ++m) {
                const int grow = row0 + ai * 128 + m * 16;
                const float* xr; float* yr;
                if (grow < XROWS) { xr = xp + (size_t)grow * D; yr = out + O_YP + (size_t)grow * D; }
                else { const int e = grow - XROWS; if (e < EX_SAMP || e >= EX_SHIFT) continue; xr = xs + (size_t)(e - EX_SAMP) * D; yr = out + O_YS + (size_t)(e - EX_SAMP) * D; }
#pragma unroll
                for (int bj = 0; bj < 2; ++bj)
#pragma unroll
                    for (int n = 0; n < 2; ++n) { const int c = col0 + bj * 128 + n * 16; *(f32x4*)(yr + c) = *(const f32x4*)(xr + c) + acc[ai][bj][m][n]; }
            }
    }
};

__device__ __forceinline__ void p0_row(const Params& p, int r, int lane) {
    bf16_t* hrow = (bf16_t*)(p.ws + WS_H) + (size_t)r * D;
    const float* src = nullptr; bool norm = true; float* sh = nullptr;
    if (r < XROWS) { src = p.in[0] + (size_t)r * D; if ((r & (SEQ - 1)) == SEQ - 1) sh = p.out + O_SHIFT_P + (size_t)(r / SEQ) * D; }
    else { const int e = r - XROWS;
        if (e < EX_SAMP) src = p.in[6] + (size_t)e * D;
        else if (e < EX_SHIFT) { src = p.in[1] + (size_t)(e - EX_SAMP) * D; if (((e - EX_SAMP) & 3) == 3) sh = p.out + O_SHIFT_S + (size_t)((e - EX_SAMP) >> 2) * D; }
        else if (e < EX_END) { src = p.in[5] + (size_t)(e - EX_SHIFT) * D; norm = false; } }
    u32x2* o8 = (u32x2*)hrow + lane;
    if (!src) {
#pragma unroll
        for (int j = 0; j < 4; ++j) o8[64 * j] = (u32x2){0u, 0u};
        return; }
    const f32x4* xr = (const f32x4*)src + lane;
    f32x4 v[4]; float ss = 0.f;
#pragma unroll
    for (int j = 0; j < 4; ++j) { v[j] = xr[64 * j]; ss += v[j][0] * v[j][0] + v[j][1] * v[j][1] + v[j][2] * v[j][2] + v[j][3] * v[j][3]; }
    if (norm) {
        const float rs = rsqrtf(wave_sum(ss) * (1.f / D) + 1e-6f);
        const f32x4* wr = (const f32x4*)p.in[7] + lane;
#pragma unroll
        for (int j = 0; j < 4; ++j) v[j] = v[j] * rs * wr[64 * j];
    }
#pragma unroll
    for (int j = 0; j < 4; ++j) { o8[64 * j] = (u32x2){pk2(v[j][0], v[j][1]), pk2(v[j][2], v[j][3])}; if (sh) ((f32x4*)sh)[lane + 64 * j] = v[j]; }
}
template <int MODE> __device__ __forceinline__ void p0_tr_item(const float* W, int N, bf16_t* WT, float* scr, int kb, int nb, int lane) {
    const int k0 = 64 * kb, n0 = 32 * nb;
    const int nn = n0 + (lane & 31);
    int srcc = nn;
    if (MODE == 1) srcc = nn < C_GATE_REF ? nn : (nn < NPB ? -1 : nn - (NPB - C_GATE_REF));
#pragma unroll 8
    for (int i = 0; i < 32; ++i) { const int kk = 2 * i + (lane >> 5); scr[kk * 33 + (lane & 31)] = srcc >= 0 ? W[(size_t)(k0 + kk) * N + srcc] : 0.f; }
    asm volatile("s_waitcnt lgkmcnt(0)" ::: "memory");
    const int c = lane & 7;
#pragma unroll
    for (int j = 0; j < 4; ++j) { const int n = (lane >> 3) + 8 * j; const float* s = scr + (8 * c) * 33 + n;
        u32x4 o; o.x = pk2(s[0 * 33], s[1 * 33]); o.y = pk2(s[2 * 33], s[3 * 33]); o.z = pk2(s[4 * 33], s[5 * 33]); o.w = pk2(s[6 * 33], s[7 * 33]);
        *(u32x4*)(WT + (size_t)(n0 + n) * D + k0 + 8 * c) = o; }
    asm volatile("s_waitcnt lgkmcnt(0)" ::: "memory");
}
__device__ __forceinline__ void phase0(const Params& p, unsigned char* smem) {
    const int tid0 = otid(), wave = tid0 >> 6, lane = tid0 & 63;
    const int gw = obid() * 8 + wave, NGW = gridDim.x * 8;
    float* scr = (float*)smem + wave * (64 * 33);
    constexpr int I_IN = 16 * (NP / 32), I_SQ = 16 * 32;
    for (int it = gw; it < I_IN + 3 * I_SQ; it += NGW) {
        int r = it;
        if (r < I_IN) { p0_tr_item<1>(p.in[8], 10384, (bf16_t*)(p.ws + WS_WT_IN), scr, r / (NP / 32), r % (NP / 32), lane); continue; } r -= I_IN;
        if (r < I_SQ) { p0_tr_item<0>(p.in[13], D, (bf16_t*)(p.ws + WS_WT_A), scr, r / 32, r % 32, lane); continue; } r -= I_SQ;
        if (r < I_SQ) { p0_tr_item<0>(p.in[24], D, (bf16_t*)(p.ws + WS_WT_B), scr, r / 32, r % 32, lane); continue; } r -= I_SQ;
        p0_tr_item<0>(p.in[25], D, (bf16_t*)(p.ws + WS_WT_O), scr, r / 32, r % 32, lane);
    }
    for (int r = gw; r < HROWS; r += NGW) p0_row(p, r, lane);
    {
        float* pk = (float*)(p.ws + WS_PK);
        const int gt = obid() * 512 + tid0, NT = gridDim.x * 512;
#define PKCOPY(off, idx, n) for (int i = gt; i < (n); i += NT) pk[(off) + i] = p.in[idx][i];
        PKCOPY(PK_CONVW, 9, 12288) PKCOPY(PK_ALOG, 10, 8) PKCOPY(PK_DTB, 11, 8) PKCOPY(PK_NORMW, 12, 128) PKCOPY(PK_MU, 14, 4224) PKCOPY(PK_W0, 15, 1024)
        PKCOPY(PK_W2, 16, 65536) PKCOPY(PK_A0, 17, 1024) PKCOPY(PK_A2, 18, 65536) PKCOPY(PK_KK, 19, 1024) PKCOPY(PK_KA, 20, 1024) PKCOPY(PK_RK, 21, 1024)
        PKCOPY(PK_GNW, 22, 1024) PKCOPY(PK_GNB, 23, 1024) PKCOPY(PK_LNF, 26, 1024)
#undef PKCOPY
    }
}

__device__ __forceinline__ void gdn_item(const Params& p, unsigned char* smem, const float* s_in, float* s_out, const float* halo_in, float* halo_out,
                                         int h, int sl, int rowA, int nA, int rowB, int nB) {
    const int tid = otid(), w = tid >> 6, lane = tid & 63, vl = lane >> 4, kg = lane & 15;
    float* qk_s = (float*)smem; float* v_s = qk_s + 16384; float* o_s = v_s + 2048; float* gb_s = o_s + 2048; float* sst = gb_s + 128;
    const bf16_t* P = (const bf16_t*)(p.ws + WS_P);
    float* ORAW = (float*)(p.ws + WS_ORAW);
    float s[8];
    if (s_in) {
        { const int k = tid >> 2, q4 = tid & 3; const f32x4* src = (const f32x4*)(s_in + (size_t)k * 128 + sl * 32 + q4 * 8); const f32x4 a = src[0], b = src[1];
          float* d = sst + k * 33 + q4 * 8; d[0] = a[0]; d[1] = a[1]; d[2] = a[2]; d[3] = a[3]; d[4] = b[0]; d[5] = b[1]; d[6] = b[2]; d[7] = b[3]; }
        __syncthreads();
#pragma unroll
        for (int j = 0; j < 8; ++j) s[j] = sst[(kg * 8 + j) * 33 + 4 * w + vl];
        __syncthreads();
    } else {
#pragma unroll
        for (int j = 0; j < 8; ++j) s[j] = 0.f;
    }
    int pcol = -1;
    if (tid < 128) pcol = h * 128 + tid; else if (tid < 256) pcol = 1024 + h * 128 + (tid - 128); else if (tid < 288) pcol = 2048 + h * 128 + sl * 32 + (tid - 256);
    float cw0 = 0.f, cw1 = 0.f, cw2 = 0.f, cw3 = 0.f, x1 = 0.f, x2 = 0.f, x3 = 0.f;
    const float* pk = (const float*)(p.ws + WS_PK);
    if (pcol >= 0) { const float* cw = pk + PK_CONVW; cw0 = cw[pcol]; cw1 = cw[3072 + pcol]; cw2 = cw[6144 + pcol]; cw3 = cw[9216 + pcol];
        if (halo_in) { x3 = halo_in[pcol]; x2 = halo_in[3072 + pcol]; x1 = halo_in[6144 + pcol]; } }
    const float nalog = -expf(pk[PK_ALOG + h]), dtb = pk[PK_DTB + h];
#pragma unroll 1
    for (int run = 0; run < 2; ++run) {
        const int rrow = run ? rowB : rowA, rn = run ? nB : nA; const bool wout = run != 0;
#pragma unroll 1
        for (int c0 = 0; c0 < rn; c0 += 64) {
            const int nt = (rn - c0) < 64 ? (rn - c0) : 64; const int row = rrow + c0;
            if (pcol >= 0) {
                const bf16_t* src = P + (size_t)row * NPB + pcol;
                float* dst = tid < 256 ? (qk_s + tid) : (v_s + (tid - 256)); const int dstride = tid < 256 ? 256 : 32;
#pragma unroll 8
                for (int i = 0; i < nt; ++i) { const float x0 = bf2f(src[(size_t)i * NPB]); const float y = cw0 * x3 + cw1 * x2 + cw2 * x1 + cw3 * x0; x3 = x2; x2 = x1; x1 = x0; dst[i * dstride] = silu_(y); }
            } else if (tid < 352) {
                const int i = tid - 288;
                if (i < nt) { const float pa = bf2f(P[(size_t)(row + i) * NPB + C_A + h]), pb = bf2f(P[(size_t)(row + i) * NPB + C_B + h]);
                    gb_s[2 * i] = expf(nalog * softplus_(pa + dtb)); gb_s[2 * i + 1] = sigm(pb); }
            }
            __syncthreads();
#pragma unroll 1
            for (int ii = 0; ii < 8; ++ii) { const int i = w * 8 + ii;
                if (i < nt) {
#pragma unroll
                    for (int which = 0; which < 2; ++which) { float* rp = qk_s + i * 256 + which * 128; const float a = rp[lane], b = rp[lane + 64];
                        const float sc = rsqrtf(wave_sum(a * a + b * b) + 1e-6f) * (which == 0 ? 0.08838834764831845f : 1.f); rp[lane] = a * sc; rp[lane + 64] = b * sc; } } }
            __syncthreads();
#pragma unroll 1
            for (int i = 0; i < nt; ++i) {
                const f32x4 q0 = *(const f32x4*)(qk_s + i * 256 + kg * 8), q1 = *(const f32x4*)(qk_s + i * 256 + kg * 8 + 4);
                const f32x4 k0 = *(const f32x4*)(qk_s + i * 256 + 128 + kg * 8), k1 = *(const f32x4*)(qk_s + i * 256 + 128 + kg * 8 + 4);
                const float vv = v_s[i * 32 + 4 * w + vl], a = gb_s[2 * i], be = gb_s[2 * i + 1];
                float part = k0[0] * s[0] + k0[1] * s[1] + k0[2] * s[2] + k0[3] * s[3] + k1[0] * s[4] + k1[1] * s[5] + k1[2] * s[6] + k1[3] * s[7];
                const float kS = rowsum16(part);
                const float c = be * (vv - a * kS);
                s[0] = a * s[0] + k0[0] * c; s[1] = a * s[1] + k0[1] * c; s[2] = a * s[2] + k0[2] * c; s[3] = a * s[3] + k0[3] * c;
                s[4] = a * s[4] + k1[0] * c; s[5] = a * s[5] + k1[1] * c; s[6] = a * s[6] + k1[2] * c; s[7] = a * s[7] + k1[3] * c;
                float op = q0[0] * s[0] + q0[1] * s[1] + q0[2] * s[2] + q0[3] * s[3] + q1[0] * s[4] + q1[1] * s[5] + q1[2] * s[6] + q1[3] * s[7];
                const float o = rowsum16(op);
                if (kg == 0) o_s[i * 32 + 4 * w + vl] = o;
            }
            __syncthreads();
            if (wout) { const int i = tid >> 3, c4 = (tid & 7) * 4; if (i < nt) *(f32x4*)(ORAW + (size_t)(row + i) * D + h * 128 + sl * 32 + c4) = *(const f32x4*)(o_s + i * 32 + c4); }
        }
    }
    if (pcol >= 0 && (sl == 0 || tid >= 256)) { halo_out[pcol] = x3; halo_out[3072 + pcol] = x2; halo_out[6144 + pcol] = x1; }
#pragma unroll
    for (int j = 0; j < 8; ++j) sst[(kg * 8 + j) * 33 + 4 * w + vl] = s[j];
    __syncthreads();
    { const int k = tid >> 2, q4 = tid & 3; const float* d = sst + k * 33 + q4 * 8; f32x4* dst = (f32x4*)(s_out + (size_t)k * 128 + sl * 32 + q4 * 8);
      dst[0] = (f32x4){d[0], d[1], d[2], d[3]}; dst[1] = (f32x4){d[4], d[5], d[6], d[7]}; }
    __syncthreads();
}

constexpr int RW_W2 = 20544, RW_A2 = 24640;
__device__ __forceinline__ void rwkv_load_lora(const Params& p, unsigned char* smem, int hb) {
    float* w2_s = (float*)smem + RW_W2; float* a2_s = (float*)smem + RW_A2; const float* pk = (const float*)(p.ws + WS_PK);
    for (int i = otid(); i < 4096; i += 512) { const int l = i >> 6, c = i & 63; w2_s[i] = pk[PK_W2 + l * D + hb * 64 + c]; a2_s[i] = pk[PK_A2 + l * D + hb * 64 + c]; }
    __syncthreads();
}
__device__ __forceinline__ void rwkv_item(const Params& p, unsigned char* smem, const float* s_in, float* s_out, const bf16_t* prev_row, const float* halo_in, float* halo_out,
                                          int hb, int half, int rowA, int nA, int rowB, int nB) {
    const int tid = otid(), w = tid >> 6, lane = tid & 63, row = tid >> 4, kq = tid & 15;
    float* f = (float*)smem;
    float* r_s = f; float* kb_s = f + 2048; float* v_s = f + 4096; float* wd_s = f + 6144; float* ad_s = f + 8192; float* dec_s = f + 10240; float* a_s = f + 12288;
    float* kk_s = f + 14336; float* km_s = f + 16384; float* zb_s = f + 18432; float* y_s = f + 19456; float* bonus_s = f + 20480;
    const float* w2_s = f + RW_W2; const float* a2_s = f + RW_A2;
    const bf16_t* P = (const bf16_t*)(p.ws + WS_P);
    float* YRAW = (float*)(p.ws + WS_YRAW); bf16_t* C0 = (bf16_t*)(p.ws + WS_C0); bf16_t* C1 = (bf16_t*)(p.ws + WS_C1);
    float s[4];
    if (s_in) { const f32x4 t = *(const f32x4*)(s_in + (size_t)(half * 32 + row) * 64 + kq * 4); s[0] = t[0]; s[1] = t[1]; s[2] = t[2]; s[3] = t[3]; }
    else { s[0] = s[1] = s[2] = s[3] = 0.f; }
    int col = -1; float* dst = nullptr; int dstride = 64; bool is_wd = false, owner = false;
    if (tid < 64) { col = hb * 64 + tid; dst = r_s + tid; owner = half == 0; }
    else if (tid < 128) { col = 1024 + hb * 64 + (tid - 64); dst = kb_s + (tid - 64); owner = half == 0; }
    else if (tid < 192) { col = 2048 + hb * 64 + (tid - 128); dst = v_s + (tid - 128); owner = half == 0; }
    else if (tid < 256) { col = 3072 + (tid - 192); dst = wd_s + (tid - 192); is_wd = true; owner = (half == 0 && hb == 0); }
    else if (tid < 320) { col = 3136 + (tid - 256); dst = ad_s + (tid - 256); owner = (half == 0 && hb == 0); }
    else if (tid < 352) { col = 3200 + hb * 64 + half * 32 + (tid - 320); dst = zb_s + (tid - 320); dstride = 32; owner = true; }
    float mu = 0.f, prev = 0.f;
    const float* pk = (const float*)(p.ws + WS_PK);
    if (col >= 0) { mu = pk[PK_MU + col]; prev = prev_row ? bf2f(prev_row[C_RW + col]) : (halo_in ? halo_in[col] : 0.f); }
    const int cc = tid & 63, ig = tid >> 6;
    const int hc = hb * 64 + cc;
    const float w0c = pk[PK_W0 + hc], a0c = pk[PK_A0 + hc], kkc = pk[PK_KK + hc], kac = pk[PK_KA + hc];
    const float rkl = pk[PK_RK + hb * 64 + lane];
#pragma unroll 1
    for (int run = 0; run < 2; ++run) {
        const int rrow = run ? rowB : rowA, rn = run ? nB : nA; const bool wout = run != 0;
#pragma unroll 1
        for (int c0 = 0; c0 < rn; c0 += 32) {
            const int nt = (rn - c0) < 32 ? (rn - c0) : 32; const int row0 = rrow + c0;
            if (col >= 0) {
                const bf16_t* src = P + (size_t)row0 * NPB + C_RW + col;
#pragma unroll 8
                for (int i = 0; i < nt; ++i) { const float cur = bf2f(src[(size_t)i * NPB]); float m = cur + mu * (prev - cur); prev = cur; if (is_wd) m = tanh_(m); dst[i * dstride] = m; }
            }
            __syncthreads();
            {
                float aw[4] = {0.f, 0.f, 0.f, 0.f}, aa[4] = {0.f, 0.f, 0.f, 0.f};
#pragma unroll 4
                for (int l = 0; l < 64; ++l) { const float w2v = w2_s[l * 64 + cc], a2v = a2_s[l * 64 + cc];
#pragma unroll
                    for (int ii = 0; ii < 4; ++ii) { aw[ii] += wd_s[(ig * 4 + ii) * 64 + l] * w2v; aa[ii] += ad_s[(ig * 4 + ii) * 64 + l] * a2v; } }
#pragma unroll
                for (int ii = 0; ii < 4; ++ii) { const int i = ig * 4 + ii;
                    if (i < nt) { const float wraw = w0c + aw[ii]; const float wlog = -0.6065306597126334f * sigm(wraw); const float a = sigm(a0c + aa[ii]);
                        const float kbv = kb_s[i * 64 + cc];
                        dec_s[i * 64 + cc] = expf(wlog); a_s[i * 64 + cc] = a; kk_s[i * 64 + cc] = kbv * kkc; km_s[i * 64 + cc] = kbv * (1.f + (a - 1.f) * kac); } }
            }
            __syncthreads();
#pragma unroll 1
            for (int ii = 0; ii < 4; ++ii) { const int i = w * 4 + ii;
                if (i < nt) { const float kkr = kk_s[i * 64 + lane]; const float kk = kkr * rsqrtf(wave_sum(kkr * kkr) + 1e-6f); kk_s[i * 64 + lane] = kk;
                    const float a = a_s[i * 64 + lane]; a_s[i * 64 + lane] = kk * a;
                    const float rk = wave_sum(r_s[i * 64 + lane] * km_s[i * 64 + lane] * rkl); if (lane == 0) bonus_s[i] = rk; } }
            __syncthreads();
#pragma unroll 1
            for (int i = 0; i < nt; ++i) {
                const f32x4 kk4 = *(const f32x4*)(kk_s + i * 64 + kq * 4), de4 = *(const f32x4*)(dec_s + i * 64 + kq * 4), ka4 = *(const f32x4*)(a_s + i * 64 + kq * 4),
                            km4 = *(const f32x4*)(km_s + i * 64 + kq * 4), r4 = *(const f32x4*)(r_s + i * 64 + kq * 4);
                const float vv = v_s[i * 64 + half * 32 + row];
                const float sa = rowsum16(s[0] * kk4[0] + s[1] * kk4[1] + s[2] * kk4[2] + s[3] * kk4[3]);
#pragma unroll
                for (int j = 0; j < 4; ++j) s[j] = s[j] * de4[j] + (vv * km4[j] - sa * ka4[j]);
                const float y = rowsum16(s[0] * r4[0] + s[1] * r4[1] + s[2] * r4[2] + s[3] * r4[3]);
                if (kq == 0) y_s[i * 32 + row] = y;
            }
            __syncthreads();
            if (wout) { const int i = tid >> 4;
                if (i < nt) {
#pragma unroll
                    for (int q = 0; q < 2; ++q) { const int rr = (tid & 15) * 2 + q, v = half * 32 + rr, colo = hb * 64 + v;
                        const float sz = silu_(zb_s[i * 32 + rr]);
                        const size_t o = (size_t)(row0 + i) * D + colo;
                        YRAW[o] = y_s[i * 32 + rr]; C1[o] = (bf16_t)f2bf(pk[PK_GNW + colo] * sz); C0[o] = (bf16_t)f2bf((pk[PK_GNB + colo] + bonus_s[i] * v_s[i * 64 + v]) * sz); } } }
            __syncthreads();
        }
    }
    *(f32x4*)(s_out + (size_t)(half * 32 + row) * 64 + kq * 4) = (f32x4){s[0], s[1], s[2], s[3]};
    if (col >= 0 && owner && halo_out) halo_out[col] = prev;
}


__device__ __forceinline__ bf16x8 ldfrag(const bf16_t* base, int stride, int r0, int k0, int lane) {
    return *(const bf16x8*)(base + (r0 + (lane & 15)) * stride + k0 + 8 * (lane >> 4));
}
#define MFMA16(a, b, c) __builtin_amdgcn_mfma_f32_16x16x32_bf16((a), (b), (c), 0, 0, 0)
constexpr int PL_QS = 0, PL_R1 = 17408, PL_KT = 35840, PL_KTT = 54272, PL_VT = 72704, PL_R3 = 91136, PL_QKM = 109568, PL_TP = 118784, PL_TPP = 128000, PL_SM = 137216;
constexpr int QSTR = 136, TSTR = 72;

__device__ __forceinline__ void gdn_prep_item(const Params& p, unsigned char* smem, int h, int row_start, int npad, int halo_mode, int hrow, const float* halo_buf,
                                              float* halo_out, unsigned char* rec) {
    const int tid = otid(), w = tid >> 6, lane = tid & 63, q4 = lane >> 4, l15 = lane & 15;
    bf16_t* qs = (bf16_t*)(smem + PL_QS); bf16_t* ks = (bf16_t*)(smem + PL_R1); bf16_t* WT = ks; bf16_t* kT = (bf16_t*)(smem + PL_KT); bf16_t* ktT = (bf16_t*)(smem + PL_KTT);
    bf16_t* vT = (bf16_t*)(smem + PL_VT); float* Lm = (float*)(smem + PL_R3); bf16_t* UT = (bf16_t*)(smem + PL_R3); bf16_t* QKm = (bf16_t*)(smem + PL_QKM);
    bf16_t* Tp = (bf16_t*)(smem + PL_TP); bf16_t* Tpp = (bf16_t*)(smem + PL_TPP);
    float* sm = (float*)(smem + PL_SM);
    float* gcs = sm; float* bes = sm + 64; float* ssq = sm + 128; float* ssk = sm + 192; float* egs = sm + 256; float* egl_s = sm + 320; float* beg = sm + 384;
    const bf16_t* P = (const bf16_t*)(p.ws + WS_P);
    const float* pk = (const float*)(p.ws + WS_PK);
    if (tid < 128) ssq[tid] = 0.f;
    if (tid >= 448) { const int i = tid - 448;
        float g = 0.f, be = 0.f;
        if (i >= npad) { const size_t r = (size_t)(row_start + i - npad) * NPB; const float pa = bf2f(P[r + C_A + h]), pb = bf2f(P[r + C_B + h]);
            g = -expf(pk[PK_ALOG + h]) * softplus_(pa + pk[PK_DTB + h]); be = sigm(pb); }
        gcs[i] = g; bes[i] = be; }
    __syncthreads();
    if (tid < 64) {
        float x = gcs[lane];
#pragma unroll
        for (int o = 1; o < 64; o <<= 1) { const float y = __shfl_up(x, o); if (lane >= o) x += y; }
        const float gl = __shfl(x, 63);
        gcs[lane] = x; egs[lane] = expf(x); egl_s[lane] = expf(gl - x); beg[lane] = bes[lane] * expf(x);
        if (lane == 0) *(float*)(rec + GP_EGL) = expf(gl);
    }
    const int cg = tid % 48, ts = tid / 48;
    const int sec = cg >> 4;
    const int pcol = sec * 1024 + h * 128 + (cg & 15) * 8;
    float val[7][8];
    if (ts < 10) {
        float cw[4][8];
#pragma unroll
        for (int j = 0; j < 4; ++j) { const f32x4 a = *(const f32x4*)(pk + PK_CONVW + j * 3072 + pcol), b = *(const f32x4*)(pk + PK_CONVW + j * 3072 + pcol + 4);
            cw[j][0] = a[0]; cw[j][1] = a[1]; cw[j][2] = a[2]; cw[j][3] = a[3]; cw[j][4] = b[0]; cw[j][5] = b[1]; cw[j][6] = b[2]; cw[j][7] = b[3]; }
#pragma unroll
        for (int it = 0; it < 7; ++it) {
            const int i = ts + 10 * it;
            float y[8];
#pragma unroll
            for (int e = 0; e < 8; ++e) y[e] = 0.f;
            if (i < 64 && i >= npad) {
#pragma unroll
                for (int dlt = 0; dlt < 4; ++dlt) {
                    const int ii = i - 3 + dlt;
                    float x[8];
                    bool have = true;
                    if (ii >= npad) { const u32x4 rw = *(const u32x4*)(P + (size_t)(row_start + ii - npad) * NPB + pcol);
                        x[0] = __uint_as_float(rw.x << 16); x[1] = __uint_as_float(rw.x & 0xffff0000u); x[2] = __uint_as_float(rw.y << 16); x[3] = __uint_as_float(rw.y & 0xffff0000u);
                        x[4] = __uint_as_float(rw.z << 16); x[5] = __uint_as_float(rw.z & 0xffff0000u); x[6] = __uint_as_float(rw.w << 16); x[7] = __uint_as_float(rw.w & 0xffff0000u); }
                    else if (ii < 0 && npad == 0 && halo_mode == 1) { const u32x4 rw = *(const u32x4*)(P + (size_t)(hrow + ii) * NPB + pcol);
                        x[0] = __uint_as_float(rw.x << 16); x[1] = __uint_as_float(rw.x & 0xffff0000u); x[2] = __uint_as_float(rw.y << 16); x[3] = __uint_as_float(rw.y & 0xffff0000u);
                        x[4] = __uint_as_float(rw.z << 16); x[5] = __uint_as_float(rw.z & 0xffff0000u); x[6] = __uint_as_float(rw.w << 16); x[7] = __uint_as_float(rw.w & 0xffff0000u); }
                    else if (ii < 0 && npad == 0 && halo_mode == 2) { const f32x4 a = *(const f32x4*)(halo_buf + (3 + ii) * 3072 + pcol), b = *(const f32x4*)(halo_buf + (3 + ii) * 3072 + pcol + 4);
                        x[0] = a[0]; x[1] = a[1]; x[2] = a[2]; x[3] = a[3]; x[4] = b[0]; x[5] = b[1]; x[6] = b[2]; x[7] = b[3]; }
                    else have = false;
                    if (have) {
#pragma unroll
                        for (int e = 0; e < 8; ++e) y[e] += cw[dlt][e] * x[e]; }
                }
                float ss = 0.f;
#pragma unroll
                for (int e = 0; e < 8; ++e) { y[e] = silu_(y[e]); ss += y[e] * y[e]; }
                if (sec == 0) atomicAdd(ssq + i, ss); else if (sec == 1) atomicAdd(ssk + i, ss);
            }
#pragma unroll
            for (int e = 0; e < 8; ++e) val[it][e] = y[e];
        }
    }
    if (halo_out && tid < 384) {
        const int c = (tid >> 7) * 1024 + h * 128 + (tid & 127);
#pragma unroll
        for (int dd = 0; dd < 3; ++dd) halo_out[dd * 3072 + c] = bf2f(P[(size_t)(row_start + 61 + dd) * NPB + c]);
    }
    __syncthreads();
    if (ts < 10) {
#pragma unroll
        for (int it = 0; it < 7; ++it) {
            const int i = ts + 10 * it;
            if (i < 64) {
                float sc = 1.f;
                if (sec == 0) sc = rsqrtf(ssq[i] + 1e-6f) * 0.08838834764831845f; else if (sec == 1) sc = rsqrtf(ssk[i] + 1e-6f);
                const int d0 = (cg & 15) * 8;
                float x[8];
#pragma unroll
                for (int e = 0; e < 8; ++e) x[e] = val[it][e] * sc;
                if (sec == 0) { *(u32x4*)(qs + i * QSTR + d0) = (u32x4){pk2(x[0], x[1]), pk2(x[2], x[3]), pk2(x[4], x[5]), pk2(x[6], x[7])}; }
                else if (sec == 1) { *(u32x4*)(ks + i * QSTR + d0) = (u32x4){pk2(x[0], x[1]), pk2(x[2], x[3]), pk2(x[4], x[5]), pk2(x[6], x[7])};
                    const float eg = egl_s[i];
#pragma unroll
                    for (int e = 0; e < 8; ++e) { kT[(d0 + e) * TSTR + i] = (bf16_t)f2bf(x[e]); ktT[(d0 + e) * TSTR + i] = (bf16_t)f2bf(x[e] * eg); } }
                else {
#pragma unroll
                    for (int e = 0; e < 8; ++e) vT[(d0 + e) * TSTR + i] = (bf16_t)f2bf(x[e]); }
            }
        }
    }
    __syncthreads();
    {
        const int which = w >> 2, it = w & 3;
        const bf16_t* Aarr = which ? qs : ks;
        bf16x8 af[4];
#pragma unroll
        for (int kk = 0; kk < 4; ++kk) af[kk] = ldfrag(Aarr, QSTR, 16 * it, 32 * kk, lane);
#pragma unroll
        for (int jt = 0; jt < 4; ++jt) {
            f32x4 acc = {0.f, 0.f, 0.f, 0.f};
#pragma unroll
            for (int kk = 0; kk < 4; ++kk) acc = MFMA16(af[kk], ldfrag(ks, QSTR, 16 * jt, 32 * kk, lane), acc);
            const int j = 16 * jt + l15; const float gj = gcs[j];
#pragma unroll
            for (int r = 0; r < 4; ++r) { const int i = 16 * it + 4 * q4 + r;
                if (which == 0) Lm[i * 64 + j] = (i > j) ? bes[i] * acc[r] * expf(gcs[i] - gj) : 0.f;
                else QKm[i * TSTR + j] = (bf16_t)f2bf((i >= j) ? acc[r] * expf(gcs[i] - gj) : 0.f); }
        }
    }
    __syncthreads();
    if (w == 0) {
        float Tr[64];
#pragma unroll
        for (int i = 0; i < 64; ++i) Tr[i] = 0.f;
#pragma unroll
        for (int i = 0; i < 64; ++i) {
            float a = (lane == i) ? 1.f : 0.f;
#pragma unroll
            for (int j0 = 0; j0 < i; j0 += 4) { const f32x4 l4 = *(const f32x4*)(Lm + i * 64 + j0);
                a -= l4[0] * Tr[j0]; a -= l4[1] * Tr[j0 + 1]; a -= l4[2] * Tr[j0 + 2]; a -= l4[3] * Tr[j0 + 3]; }
            Tr[i] = a;
        }
        const float s1 = beg[lane], s2 = bes[lane];
#pragma unroll
        for (int i = 0; i < 64; ++i) { Tp[i * TSTR + lane] = (bf16_t)f2bf(Tr[i] * s1); Tpp[i * TSTR + lane] = (bf16_t)f2bf(Tr[i] * s2); }
    }
    __syncthreads();
    {
        const int it = w & 3, half = w >> 2;
        f32x4 aw[4], au[4];
#pragma unroll
        for (int x = 0; x < 4; ++x) { aw[x] = (f32x4){0.f, 0.f, 0.f, 0.f}; au[x] = (f32x4){0.f, 0.f, 0.f, 0.f}; }
#pragma unroll
        for (int kk = 0; kk < 2; ++kk) {
            const bf16x8 a1 = ldfrag(Tp, TSTR, 16 * it, 32 * kk, lane), a2 = ldfrag(Tpp, TSTR, 16 * it, 32 * kk, lane);
#pragma unroll
            for (int x = 0; x < 4; ++x) { const int dt = half * 4 + x;
                aw[x] = MFMA16(a1, ldfrag(kT, TSTR, 16 * dt, 32 * kk, lane), aw[x]);
                au[x] = MFMA16(a2, ldfrag(vT, TSTR, 16 * dt, 32 * kk, lane), au[x]); }
        }
        __syncthreads();
#pragma unroll
        for (int x = 0; x < 4; ++x) { const int d = 16 * (half * 4 + x) + l15, i0 = 16 * it + 4 * q4;
            *(u32x2*)(WT + d * TSTR + i0) = (u32x2){pk2(aw[x][0], aw[x][1]), pk2(aw[x][2], aw[x][3])};
            *(u32x2*)(UT + d * TSTR + i0) = (u32x2){pk2(au[x][0], au[x][1]), pk2(au[x][2], au[x][3])}; }
    }
    __syncthreads();
    {
        bf16_t* gAP = (bf16_t*)(rec + GP_AP); bf16_t* gQH = (bf16_t*)(rec + GP_QH); bf16_t* gKH = (bf16_t*)(rec + GP_KH); bf16_t* gOH = (bf16_t*)(rec + GP_OH);
        {
            const int et = w;
            const bf16x8 a0 = ldfrag(WT, TSTR, 16 * et, 0, lane), a1 = ldfrag(WT, TSTR, 16 * et, 32, lane);
#pragma unroll
            for (int dt = 0; dt < 8; ++dt) { f32x4 acc = {0.f, 0.f, 0.f, 0.f};
                acc = MFMA16(a0, ldfrag(ktT, TSTR, 16 * dt, 0, lane), acc); acc = MFMA16(a1, ldfrag(ktT, TSTR, 16 * dt, 32, lane), acc);
                *(u32x2*)(gAP + ((size_t)(dt * 4 + (et >> 1)) * 64 + lane) * 8 + (et & 1) * 4) = (u32x2){pk2(-acc[0], -acc[1]), pk2(-acc[2], -acc[3])}; }
#pragma unroll
            for (int tt = 0; tt < 4; ++tt) { f32x4 acc = {0.f, 0.f, 0.f, 0.f};
                acc = MFMA16(a0, ldfrag(QKm, TSTR, 16 * tt, 0, lane), acc); acc = MFMA16(a1, ldfrag(QKm, TSTR, 16 * tt, 32, lane), acc);
                const int t = 16 * tt + l15, e0 = 16 * et + 4 * q4; const float eg = egs[t];
                const u32x2 qq = *(const u32x2*)(qs + t * QSTR + e0);
                const float o0 = __uint_as_float(qq.x << 16) * eg - acc[0], o1 = __uint_as_float(qq.x & 0xffff0000u) * eg - acc[1],
                            o2 = __uint_as_float(qq.y << 16) * eg - acc[2], o3 = __uint_as_float(qq.y & 0xffff0000u) * eg - acc[3];
                *(u32x2*)(gQH + ((size_t)(tt * 4 + (et >> 1)) * 64 + lane) * 8 + (et & 1) * 4) = (u32x2){pk2(o0, o1), pk2(o2, o3)}; }
        }
        {
            const int dt = w;
            const bf16x8 a0 = ldfrag(ktT, TSTR, 16 * dt, 0, lane), a1 = ldfrag(ktT, TSTR, 16 * dt, 32, lane);
#pragma unroll
            for (int vt = 0; vt < 8; ++vt) { f32x4 acc = {0.f, 0.f, 0.f, 0.f};
                acc = MFMA16(a0, ldfrag(UT, TSTR, 16 * vt, 0, lane), acc); acc = MFMA16(a1, ldfrag(UT, TSTR, 16 * vt, 32, lane), acc);
                *(u32x2*)(gKH + ((size_t)(vt * 8 + dt) * 64 + lane) * 4) = (u32x2){pk2(acc[0], acc[1]), pk2(acc[2], acc[3])}; }
            const int tt = w & 3, vh = w >> 2;
            const bf16x8 b0 = ldfrag(QKm, TSTR, 16 * tt, 0, lane), b1 = ldfrag(QKm, TSTR, 16 * tt, 32, lane);
#pragma unroll
            for (int x = 0; x < 4; ++x) { const int vt = vh * 4 + x; f32x4 acc = {0.f, 0.f, 0.f, 0.f};
                acc = MFMA16(b0, ldfrag(UT, TSTR, 16 * vt, 0, lane), acc); acc = MFMA16(b1, ldfrag(UT, TSTR, 16 * vt, 32, lane), acc);
                *(u32x2*)(gOH + ((size_t)(vt * 4 + tt) * 64 + lane) * 4) = (u32x2){pk2(acc[0], acc[1]), pk2(acc[2], acc[3])}; }
        }
    }
    __syncthreads();
}

__device__ __forceinline__ void phase_gprep(const Params& p, int seg, unsigned char* smem) {
    const int blk = obid();
    float* chalo = (float*)(p.ws + WS_CHALO);
    const int n_items = (CPS + (seg == 0 ? 1 : 0)) * 64;
#pragma unroll 1
    for (int it = blk; it < n_items; it += gridDim.x) {
        const int bh = it & 63, b = bh >> 3, h = bh & 7; int cl = it >> 6; if (seg != 0) cl += 1;
        unsigned char* rec = p.ws + WS_GP + (size_t)(cl * 64 + bh) * GP_STRIDE;
        if (cl == 0) gdn_prep_item(p, smem, h, LEX0, 48, 0, 0, nullptr, nullptr, rec);
        else {
            const int row = b * SEGTOK + (cl - 1) * 64;
            int mode = 1, hrow = row;
            const float* hb = nullptr;
            if (cl == 1) { if (seg == 0) { hrow = LEX0 + NMETA; } else { mode = 2; hb = chalo + (size_t)(((seg - 1) & 1) * NBATCH + b) * 9216; } }
            float* ho = nullptr;
            if (cl == CPS) ho = (seg == NSEG - 1) ? p.out + O_CONV_P + (size_t)b * 9216 : chalo + (size_t)((seg & 1) * NBATCH + b) * 9216;
            gdn_prep_item(p, smem, h, row, 0, mode, hrow, hb, ho, rec);
        }
    }
}

__device__ __forceinline__ void gdn_scan_block(const Params& p, int seg, unsigned char* smem, int bh) {
    const int tid = otid(), w = tid >> 6, lane = tid & 63, q4 = lane >> 4, l15 = lane & 15;
    const int b = bh >> 3, h = bh & 7;
    float* st = p.out + O_GDN_P + (size_t)bh * 16384;
    float* ORAW = (float*)(p.ws + WS_ORAW);
    f32x4 S[8];
    if (seg) {
#pragma unroll
        for (int mt = 0; mt < 8; ++mt)
#pragma unroll
            for (int r = 0; r < 4; ++r) S[mt][r] = st[(size_t)(16 * mt + 4 * q4 + r) * 128 + 16 * w + l15];
    } else {
#pragma unroll
        for (int mt = 0; mt < 8; ++mt) S[mt] = (f32x4){0.f, 0.f, 0.f, 0.f};
    }
    const int c_lo = seg ? 1 : 0;
#pragma unroll 1
    for (int cl = c_lo; cl <= CPS; ++cl) {
        const unsigned char* rec = p.ws + WS_GP + (size_t)(cl * 64 + bh) * GP_STRIDE;
        __syncthreads();
        {
            const u32x4* src = (const u32x4*)rec; u32x4* dst = (u32x4*)smem;
#pragma unroll
            for (int x = 0; x < 6; ++x) dst[tid + 512 * x] = src[tid + 512 * x];
        }
        const bf16_t* gKH = (const bf16_t*)(rec + GP_KH); const bf16_t* gOH = (const bf16_t*)(rec + GP_OH);
        u32x2 kh[8], oh[4];
#pragma unroll
        for (int mt = 0; mt < 8; ++mt) kh[mt] = *(const u32x2*)(gKH + ((size_t)(w * 8 + mt) * 64 + lane) * 4);
#pragma unroll
        for (int tt = 0; tt < 4; ++tt) oh[tt] = *(const u32x2*)(gOH + ((size_t)(w * 4 + tt) * 64 + lane) * 4);
        const float egl = *(const float*)(rec + GP_EGL);
        bf16x8 Bf[4];
#pragma unroll
        for (int ks = 0; ks < 4; ++ks) { u32x4 t; t.x = pk2(S[2 * ks][0], S[2 * ks][1]); t.y = pk2(S[2 * ks][2], S[2 * ks][3]); t.z = pk2(S[2 * ks + 1][0], S[2 * ks + 1][1]); t.w = pk2(S[2 * ks + 1][2], S[2 * ks + 1][3]);
            Bf[ks] = __builtin_bit_cast(bf16x8, t); }
        __syncthreads();
        const bf16x8* AP = (const bf16x8*)smem; const bf16x8* QH = (const bf16x8*)(smem + GP_QH);
        if (cl > 0) {
            const int row = b * SEGTOK + (cl - 1) * 64;
#pragma unroll
            for (int tt = 0; tt < 4; ++tt) { f32x4 o = {0.f, 0.f, 0.f, 0.f};
#pragma unroll
                for (int ks = 0; ks < 4; ++ks) o = MFMA16(QH[(tt * 4 + ks) * 64 + lane], Bf[ks], o);
                o[0] += __uint_as_float(oh[tt].x << 16); o[1] += __uint_as_float(oh[tt].x & 0xffff0000u); o[2] += __uint_as_float(oh[tt].y << 16); o[3] += __uint_as_float(oh[tt].y & 0xffff0000u);
#pragma unroll
                for (int r = 0; r < 4; ++r) ORAW[(size_t)(row + 16 * tt + 4 * q4 + r) * D + h * 128 + 16 * w + l15] = o[r]; }
        }
#pragma unroll
        for (int mt = 0; mt < 8; ++mt) { f32x4 t = {0.f, 0.f, 0.f, 0.f};
#pragma unroll
            for (int ks = 0; ks < 4; ++ks) t = MFMA16(AP[(mt * 4 + ks) * 64 + lane], Bf[ks], t);
            S[mt][0] = egl * S[mt][0] + t[0] + __uint_as_float(kh[mt].x << 16); S[mt][1] = egl * S[mt][1] + t[1] + __uint_as_float(kh[mt].x & 0xffff0000u);
            S[mt][2] = egl * S[mt][2] + t[2] + __uint_as_float(kh[mt].y << 16); S[mt][3] = egl * S[mt][3] + t[3] + __uint_as_float(kh[mt].y & 0xffff0000u); }
    }
#pragma unroll
    for (int mt = 0; mt < 8; ++mt)
#pragma unroll
        for (int r = 0; r < 4; ++r) st[(size_t)(16 * mt + 4 * q4 + r) * 128 + 16 * w + l15] = S[mt][r];
    __syncthreads();
}

__device__ __forceinline__ void phase2(const Params& p, int seg, unsigned char* smem) {
    const int blk = obid();
    float* out = p.out;
    float* chalo = (float*)(p.ws + WS_CHALO); float* phalo = (float*)(p.ws + WS_PHALO);
#ifndef SUB
#define SUB 0
#endif
#define SEN(x) (SUB == 0 || SUB == (x))
    if (SEN(1) && blk < 64) gdn_scan_block(p, seg, smem, blk);
#ifndef DUP
#define DUP 0
#endif
    if (SEN(2) && seg == 0) {
#pragma unroll 1
        for (int rep = 0; rep < (DUP == 2 ? 2 : 1); ++rep)
#pragma unroll 1
        for (int it = blk; it < DECB * 32; it += gridDim.x) {
            const int h = it & 7, sl = (it >> 3) & 3, bs = it >> 5;
            gdn_item(p, smem, p.in[2] + (size_t)(bs * 8 + h) * 16384, out + O_GDN_S + (size_t)(bs * 8 + h) * 16384, p.in[3] + (size_t)bs * 9216, out + O_CONV_S + (size_t)bs * 9216,
                     h, sl, 0, 0, LEX0 + EX_SAMP + bs * DECT, DECT);
        }
    }
    {
        const int hb = blk & 15, rest = blk >> 4;
        rwkv_load_lora(p, smem, hb);
        if (SEN(3)) {
            const int b = rest >> 1, half = rest & 1;
            float* st = out + O_RWKV_P + (size_t)(b * 16 + hb) * 4096;
            const float* hin = seg ? phalo + (size_t)(((seg - 1) & 1) * NBATCH + b) * RW_SHIFT : nullptr;
            float* hout = phalo + (size_t)((seg & 1) * NBATCH + b) * RW_SHIFT;
            if (DUP == 1) rwkv_item(p, smem, seg ? st : nullptr, (float*)(p.ws + WS_MG) + (size_t)blk * 4096, nullptr, hin, nullptr, hb, half, LEX0, seg ? 0 : NMETA, b * SEGTOK, SEGTOK);
            rwkv_item(p, smem, seg ? st : nullptr, st, nullptr, hin, hout, hb, half, LEX0, seg ? 0 : NMETA, b * SEGTOK, SEGTOK);
        }
        if (SEN(4) && seg == 0) {
#pragma unroll 1
            for (int rep = 0; rep < (DUP == 2 ? 2 : 1); ++rep)
#pragma unroll 1
            for (int j = 0; j < 16; ++j) {
                const int idx = rest * 16 + j, bs = idx >> 1, half = idx & 1;
                const bf16_t* prow = (const bf16_t*)(p.ws + WS_P) + (size_t)(LEX0 + EX_SHIFT + bs) * NPB;
                rwkv_item(p, smem, p.in[4] + (size_t)(bs * 16 + hb) * 4096, out + O_RWKV_S + (size_t)(bs * 16 + hb) * 4096, prow, nullptr, nullptr, hb, half, 0, 0, LEX0 + EX_SAMP + bs * DECT, DECT);
            }
        }
    }
}

__device__ __forceinline__ void phase25(const Params& p, int seg) {
    const int tid0 = otid(); const int lane = tid0 & 63; const int gw = obid() * 8 + (tid0 >> 6), NGW = gridDim.x * 8;
    const bf16_t* P = (const bf16_t*)(p.ws + WS_P);
    const float* ORAW = (const float*)(p.ws + WS_ORAW); const float* YRAW = (const float*)(p.ws + WS_YRAW);
    const bf16_t* C0 = (const bf16_t*)(p.ws + WS_C0); const bf16_t* C1 = (const bf16_t*)(p.ws + WS_C1);
    bf16_t* OA = (bf16_t*)(p.ws + WS_H); bf16_t* OB = (bf16_t*)(p.ws + WS_OB);
    const int nrows = LEX0 + (seg == 0 ? DECB * DECT : 0);
    const int c = lane * 16;
    f32x4 nw[4];
#pragma unroll
    for (int j = 0; j < 4; ++j) nw[j] = *(const f32x4*)((const float*)(p.ws + WS_PK) + PK_NORMW + (c & 127) + 4 * j);
#pragma unroll 1
    for (int rr = gw; rr < nrows; rr += NGW) {
        int lr; size_t grow;
        if (rr < LEX0) { lr = rr; grow = (size_t)(rr / SEGTOK) * SEQ + seg * SEGTOK + (rr % SEGTOK); } else { lr = LEX0 + EX_SAMP + (rr - LEX0); grow = (size_t)XROWS + EX_SAMP + (rr - LEX0); }
        {
            f32x4 o[4]; float ss = 0.f;
#pragma unroll
            for (int j = 0; j < 4; ++j) { o[j] = *(const f32x4*)(ORAW + (size_t)lr * D + c + 4 * j); ss += o[j][0] * o[j][0] + o[j][1] * o[j][1] + o[j][2] * o[j][2] + o[j][3] * o[j][3]; }
            ss += __shfl_xor(ss, 1); ss += __shfl_xor(ss, 2); ss += __shfl_xor(ss, 4);
            const float rs = rsqrtf(ss * (1.f / 128.f) + 1e-6f);
            const u32x4 z0 = *(const u32x4*)(P + (size_t)lr * NPB + C_Z + c), z1 = *(const u32x4*)(P + (size_t)lr * NPB + C_Z + c + 8);
            const unsigned zz[8] = {z0.x, z0.y, z0.z, z0.w, z1.x, z1.y, z1.z, z1.w};
            unsigned ow[8];
#pragma unroll
            for (int j = 0; j < 8; ++j) { const float za = __uint_as_float(zz[j] << 16), zb = __uint_as_float(zz[j] & 0xffff0000u);
                const float a = o[j >> 1][(j & 1) * 2] * rs * nw[j >> 1][(j & 1) * 2] * silu_(za), b = o[j >> 1][(j & 1) * 2 + 1] * rs * nw[j >> 1][(j & 1) * 2 + 1] * silu_(zb);
                ow[j] = pk2(a, b); }
            *(u32x4*)(OA + grow * D + c) = (u32x4){ow[0], ow[1], ow[2], ow[3]}; *(u32x4*)(OA + grow * D + c + 8) = (u32x4){ow[4], ow[5], ow[6], ow[7]};
        }
        {
            f32x4 y[4]; float sm = 0.f;
#pragma unroll
            for (int j = 0; j < 4; ++j) { y[j] = *(const f32x4*)(YRAW + (size_t)lr * D + c + 4 * j); sm += y[j][0] + y[j][1] + y[j][2] + y[j][3]; }
            sm += __shfl_xor(sm, 1); sm += __shfl_xor(sm, 2);
            const float mu = sm * (1.f / 64.f); float vs = 0.f;
#pragma unroll
            for (int j = 0; j < 4; ++j) { y[j] = y[j] - mu; vs += y[j][0] * y[j][0] + y[j][1] * y[j][1] + y[j][2] * y[j][2] + y[j][3] * y[j][3]; }
            vs += __shfl_xor(vs, 1); vs += __shfl_xor(vs, 2);
            const float rs = rsqrtf(vs * (1.f / 64.f) + 64e-5f);
            const u32x4 a0 = *(const u32x4*)(C0 + (size_t)lr * D + c), a1 = *(const u32x4*)(C0 + (size_t)lr * D + c + 8);
            const u32x4 b0 = *(const u32x4*)(C1 + (size_t)lr * D + c), b1 = *(const u32x4*)(C1 + (size_t)lr * D + c + 8);
            const unsigned c0w[8] = {a0.x, a0.y, a0.z, a0.w, a1.x, a1.y, a1.z, a1.w}, c1w[8] = {b0.x, b0.y, b0.z, b0.w, b1.x, b1.y, b1.z, b1.w};
            unsigned ow[8];
#pragma unroll
            for (int j = 0; j < 8; ++j) {
                const float a = y[j >> 1][(j & 1) * 2] * rs * __uint_as_float(c1w[j] << 16) + __uint_as_float(c0w[j] << 16);
                const float b = y[j >> 1][(j & 1) * 2 + 1] * rs * __uint_as_float(c1w[j] & 0xffff0000u) + __uint_as_float(c0w[j] & 0xffff0000u);
                ow[j] = pk2(a, b); }
            *(u32x4*)(OB + grow * D + c) = (u32x4){ow[0], ow[1], ow[2], ow[3]}; *(u32x4*)(OB + grow * D + c + 8) = (u32x4){ow[4], ow[5], ow[6], ow[7]};
        }
    }
}

__device__ __forceinline__ void phase_final(const Params& p) {
    const int tid0 = otid(); const int lane = tid0 & 63; const int gw = obid() * 8 + (tid0 >> 6), NGW = gridDim.x * 8;
    const f32x4* wr = (const f32x4*)((const float*)(p.ws + WS_PK) + PK_LNF) + lane;
#pragma unroll 1
    for (int r = gw; r < XROWS + DECB * DECT; r += NGW) {
        f32x4* xr = (f32x4*)(p.out + (size_t)r * D) + lane;
        f32x4 v[4]; float ss = 0.f;
#pragma unroll
        for (int j = 0; j < 4; ++j) { v[j] = xr[64 * j]; ss += v[j][0] * v[j][0] + v[j][1] * v[j][1] + v[j][2] * v[j][2] + v[j][3] * v[j][3]; }
        const float rs = rsqrtf(wave_sum(ss) * (1.f / D) + 1e-6f);
#pragma unroll
        for (int j = 0; j < 4; ++j) xr[64 * j] = v[j] * rs * wr[64 * j];
    }
}

__global__ __launch_bounds__(512, 2) void hybrid_mega(Params p) {
    extern __shared__ __attribute__((aligned(16))) unsigned char smem[];
    cg::grid_group grid = cg::this_grid();
    LAS unsigned char* lds = (LAS unsigned char*)smem;
    const int G = gridDim.x;
    volatile LAS unsigned* xst = (volatile LAS unsigned*)(lds + (LDS_TOTAL - 16));
    if (threadIdx.x == 0) { xst[0] = 0u; xst[1] = 0u; }
    __syncthreads();
    (void)xcd_barrier_post((unsigned*)(p.ws + WS_BAR), xst);
    if (G == 0x7fffffff) grid.sync();
#define GSYNC() do { XcdBarrier xb_; xb_.bar = (unsigned*)(p.ws + WS_BAR); xb_.x = xb_xcc_id(); xb_.st = (volatile LAS unsigned*)((LAS unsigned char*)smem + (LDS_TOTAL - 16)); xcd_barrier(xb_); } while (0)

#ifndef ONLY
#define ONLY 0
#endif
#define EN(x) (ONLY == 0 || ONLY == (x))
    if (EN(1)) phase0(p, smem);
    GSYNC();
#pragma unroll 1
    for (int seg = 0; seg < NSEG; ++seg) {
#pragma unroll 1
        for (int rep = 0; rep < (DUP == 3 ? 2 : 1); ++rep)
        if (EN(2)) {
            SchedIn S; S.ob.init(seg == 0 ? LT_PROMPT + 3 : LT_PROMPT, NT_IN, G, obid()); S.seg = seg; S.A = (const char*)(p.ws + WS_H); S.B = (const char*)(p.ws + WS_WT_IN);
            EpiIn E; E.P = (bf16_t*)(p.ws + WS_P); E.gex = (bf16_t*)(p.ws + WS_GEX); E.out = p.out; E.seg = seg;
            pg8::gemm_phase<EpiIn, SchedIn>(lds, D, S, E);
        }
        GSYNC();
#pragma unroll 1
        for (int rep = 0; rep < (DUP == 3 ? 2 : 1); ++rep)
        if (EN(8)) phase_gprep(p, seg, smem);
        GSYNC();
        if (EN(3)) phase2(p, seg, smem);
        GSYNC();
#pragma unroll 1
        for (int rep = 0; rep < (DUP == 3 ? 2 : 1); ++rep)
        if (EN(4)) phase25(p, seg);
        GSYNC();
    }
    if (EN(5)) {
        SchedAB S; S.ob.init(HTILES, 4, G, obid()); S.A0 = (const char*)(p.ws + WS_H); S.A1 = (const char*)(p.ws + WS_OB); S.B0 = (const char*)(p.ws + WS_WT_A); S.B1 = (const char*)(p.ws + WS_WT_B);
        EpiAB E; E.tmp = (float*)(p.ws + WS_P); E.merged = (bf16_t*)(p.ws + WS_MG); E.gex = (const bf16_t*)(p.ws + WS_GEX); E.out = p.out;
        pg8::gemm_phase<EpiAB, SchedAB>(lds, D, S, E);
    }
    GSYNC();
    if (EN(6)) {
        SchedO S; S.ob.init(HTILES, 4, G, obid()); S.A = (const char*)(p.ws + WS_MG); S.B = (const char*)(p.ws + WS_WT_O);
        EpiO E; E.out = p.out; E.xp = p.in[0]; E.xs = p.in[1];
        pg8::gemm_phase<EpiO, SchedO>(lds, D, S, E);
    }
    GSYNC();
    if (EN(7)) phase_final(p);
}

extern "C" void kernel_launch(void* const* d_in, const int* in_sizes, int n_in, void* d_out, int out_size, void* d_ws, size_t ws_size, hipStream_t stream) {
    static int grid_blocks = 0;
    constexpr int LDS_BYTES = LDS_TOTAL;
    if (grid_blocks == 0) {
        if (n_in != 27 || ws_size < WS_END) { fprintf(stderr, "kernel_launch: unexpected n_in %d / ws %zu (need %zu)\n", n_in, ws_size, (size_t)WS_END); grid_blocks = -1; return; }
        if (hipFuncSetAttribute((const void*)hybrid_mega, hipFuncAttributeMaxDynamicSharedMemorySize, LDS_BYTES) != hipSuccess) { fprintf(stderr, "kernel_launch: hipFuncSetAttribute failed\n"); grid_blocks = -1; return; }
        int dev = 0, cus = 0, per_cu = 0;
        hipGetDevice(&dev);
        hipDeviceGetAttribute(&cus, hipDeviceAttributeMultiprocessorCount, dev);
        hipOccupancyMaxActiveBlocksPerMultiprocessor(&per_cu, (const void*)hybrid_mega, 512, LDS_BYTES);
        if (per_cu < 1) { fprintf(stderr, "kernel_launch: occupancy query says %d blocks/CU\n", per_cu); per_cu = 1; }
        (void)hipGetLastError();
        grid_blocks = cus;
    }
    if (grid_blocks < 0) return;
    Params p{};
    for (int i = 0; i < 27; ++i) p.in[i] = (const float*)d_in[i];
    p.out = (float*)d_out; p.ws = (unsigned char*)d_ws;
    if (hipMemsetAsync((unsigned char*)d_ws + WS_BAR, 0, 16384, stream) != hipSuccess) { fprintf(stderr, "kernel_launch: memset of the barrier words failed\n"); return; }
    void* args[] = {&p};
    hipError_t e = hipLaunchCooperativeKernel((const void*)hybrid_mega, dim3(grid_blocks), dim3(512), args, LDS_BYTES, stream);
    if (e != hipSuccess) fprintf(stderr, "cooperative launch failed: %s (grid %d)\n", hipGetErrorString(e), grid_blocks);
}
```

```cpp
#include <hip/hip_runtime.h>
#include <hip/hip_cooperative_groups.h>
#include <cstdio>
namespace cg = cooperative_groups;

#define LAS __attribute__((address_space(3)))
typedef unsigned short bf16_t;
typedef short bf16x8 __attribute__((ext_vector_type(8)));
typedef float f32x4 __attribute__((ext_vector_type(4)));
typedef unsigned u32x4 __attribute__((ext_vector_type(4)));
typedef unsigned u32x2 __attribute__((ext_vector_type(2)));

constexpr int D = 1024;
constexpr int NBATCH = 8, SEQ = 2048, NMETA = 16, DECB = 128, DECT = 4;
constexpr int XROWS = NBATCH * SEQ;
constexpr int EX_SAMP = 16, EX_SHIFT = 528, EX_END = 656;
constexpr int HROWS = 17152, HTILES = 67;
constexpr int NSEG = 8, SEGTOK = SEQ / NSEG;
constexpr int CPS = SEGTOK / 64;
constexpr int TPB = SEGTOK / 256;
constexpr int LT_PROMPT = NBATCH * TPB;
constexpr int LEX0 = LT_PROMPT * 256;
constexpr int LROWS = LEX0 + 768;
constexpr int NP = 10496, NPB = 8448, NT_IN = 41, NT_PB = 33;
constexpr int C_A = 3072, C_B = 3080, C_Z = 3088, C_RW = 4112, C_GATE_REF = 8336;
constexpr int RW_SHIFT = 4224;

constexpr size_t O_YP = 0, O_YS = 16777216, O_GDN_P = 17301504, O_CONV_P = 18350080, O_RWKV_P = 18423808, O_SHIFT_P = 18948096,
                 O_GDN_S = 18956288, O_CONV_S = 35733504, O_RWKV_S = 36913152, O_SHIFT_S = 45301760;

constexpr size_t al256(size_t x) { return (x + 255) & ~(size_t)255; }
constexpr size_t WS_WT_IN = 0;
constexpr size_t WS_WT_A = al256(WS_WT_IN + (size_t)NP * D * 2);
constexpr size_t WS_WT_B = al256(WS_WT_A + (size_t)D * D * 2);
constexpr size_t WS_WT_O = al256(WS_WT_B + (size_t)D * D * 2);
constexpr size_t WS_H = al256(WS_WT_O + (size_t)D * D * 2);
constexpr size_t WS_OB = al256(WS_H + (size_t)HROWS * D * 2);
constexpr size_t WS_P = al256(WS_OB + (size_t)HROWS * D * 2);
constexpr size_t WS_ORAW = al256(WS_P + (size_t)LROWS * NPB * 2);
constexpr size_t WS_YRAW = al256(WS_ORAW + (size_t)LROWS * D * 4);
constexpr size_t WS_C0 = al256(WS_YRAW + (size_t)LROWS * D * 4);
constexpr size_t WS_C1 = al256(WS_C0 + (size_t)LROWS * D * 2);
constexpr size_t WS_GEX = al256(WS_C1 + (size_t)LROWS * D * 2);
constexpr size_t WS_CHALO = al256(WS_GEX + (size_t)768 * 2048 * 2);
constexpr size_t WS_PHALO = al256(WS_CHALO + (size_t)2 * NBATCH * 3 * 3072 * 4);
constexpr size_t WS_PK = al256(WS_PHALO + (size_t)2 * NBATCH * RW_SHIFT * 4);
constexpr int PK_CONVW = 0, PK_ALOG = 12288, PK_DTB = 12296, PK_NORMW = 12304, PK_MU = 12432, PK_W0 = 16656, PK_W2 = 17680, PK_A0 = 83216, PK_A2 = 84240,
              PK_KK = 149776, PK_KA = 150800, PK_RK = 151824, PK_GNW = 152848, PK_GNB = 153872, PK_LNF = 154896, PK_END = 155920;
constexpr size_t WS_BAR = al256(WS_PK + (size_t)PK_END * 4);
constexpr size_t WS_W2T = al256(WS_BAR + 16384);
constexpr size_t WS_A2T = al256(WS_W2T + 131072);
constexpr size_t WS_GP = al256(WS_A2T + 131072);
constexpr int GP_AP = 0, GP_QH = 32768, GP_KH = 49152, GP_OH = 81920, GP_EGL = 98304, GP_STRIDE = 98560;
constexpr int RP_AP = 0, RP_RH = 8192, RP_KH = 16384, RP_YH = 24576, RP_C1 = 32768, RP_C0 = 40960, RP_PC = 49152, RP_STRIDE = 49408;
constexpr size_t WS_RP = al256(WS_GP + (size_t)(CPS + 1) * 64 * GP_STRIDE);
constexpr size_t WS_END = al256(WS_RP + (size_t)(CPS + 1) * 128 * RP_STRIDE);
constexpr size_t WS_MG = WS_GP;
static_assert((size_t)HROWS * D * 2 <= WS_END - WS_GP, "MERGED must fit in the prep records");
static_assert((size_t)HROWS * D * 4 <= (size_t)LROWS * NPB * 2 + 2 * (size_t)LROWS * D * 4, "TMP must fit in P+ORAW+YRAW");
static_assert(WS_END <= (size_t)268435456, "workspace");

constexpr int LDS_TOTAL = 147456;
struct Params { const float* in[27]; float* out; unsigned char* ws; };

__device__ __forceinline__ float bf2f(bf16_t v) { return __uint_as_float(((unsigned)v) << 16); }
__device__ __forceinline__ unsigned f2bf(float f) { unsigned u = __float_as_uint(f); u += 0x7fffu + ((u >> 16) & 1u); return u >> 16; }
__device__ __forceinline__ unsigned pk2(float lo, float hi) { return f2bf(lo) | (f2bf(hi) << 16); }
__device__ __forceinline__ unsigned cvt_pk_bf16(float lo, float hi) { unsigned r; asm volatile("v_cvt_pk_bf16_f32 %0, %1, %2" : "=v"(r) : "v"(lo), "v"(hi)); return r; }
__device__ __forceinline__ float sigm(float x) { return 1.f / (1.f + __expf(-x)); }
__device__ __forceinline__ float silu_(float x) { return x / (1.f + __expf(-x)); }
__device__ __forceinline__ float softplus_(float x) { return fmaxf(x, 0.f) + log1pf(expf(-fabsf(x))); }
__device__ __forceinline__ float wave_sum(float v) {
#pragma unroll
    for (int o = 1; o < 64; o <<= 1) v += __shfl_xor(v, o);
    return v;
}
__device__ __forceinline__ int otid() { int t = threadIdx.x; asm volatile("" : "+v"(t)); return t; }
__device__ __forceinline__ int obid() { int t = blockIdx.x; asm volatile("" : "+s"(t)); return t; }
__device__ __forceinline__ float tanh_(float x) { const float e = __expf(2.f * x); return 1.f - 2.f / (e + 1.f); }
template <int CTRL> __device__ __forceinline__ float dppf(float x) { return __builtin_bit_cast(float, __builtin_amdgcn_mov_dpp(__builtin_bit_cast(int, x), CTRL, 0xf, 0xf, true)); }
__device__ __forceinline__ float rowsum16(float x) { x += dppf<0x128>(x); x += dppf<0x124>(x); x += dppf<0x122>(x); x += dppf<0x121>(x); return x; }


#define XB_TMO      128
#define XB_XCNT(j)  (256  + 64 * (j))
#define XB_XSUB(j)  (1280 + 64 * (j))
#define XB_XGEN(j)  (2304 + 64 * (j))
#define XB_TOP      3328
#define XB_TOPGEN   3392
#define XCD_BAR_WORDS 3456
#define XB_SPIN_CAP (1u << 22)
__device__ __forceinline__ unsigned xb_ld(unsigned* p)              { return __hip_atomic_load(p, __ATOMIC_RELAXED, __HIP_MEMORY_SCOPE_AGENT); }
__device__ __forceinline__ unsigned xb_add(unsigned* p, unsigned v) { return __hip_atomic_fetch_add(p, v, __ATOMIC_RELAXED, __HIP_MEMORY_SCOPE_AGENT); }
__device__ __forceinline__ unsigned xb_xcc_id() { return (unsigned)__builtin_amdgcn_s_getreg((3 << 11) | 20) & 0xFu; }
#define XB_SPIN(cond, bar) do { unsigned _sp = 0; while (cond) { __builtin_amdgcn_s_sleep(1); \
    if ((++_sp & 255u) == 0u) { if (xb_ld(&(bar)[XB_TMO])) break; if (_sp > XB_SPIN_CAP) { atomicAdd(&(bar)[XB_TMO], 1u); break; } } } } while (0)
struct XcdBarrier { unsigned* bar; unsigned x; volatile LAS unsigned* st; };
__device__ __forceinline__ XcdBarrier xcd_barrier_post(unsigned* bar, volatile LAS unsigned* st) {
    XcdBarrier b; b.bar = bar; b.x = xb_xcc_id(); b.st = st;
    if (threadIdx.x == 0) (void)xb_add(&bar[XB_XCNT(b.x)], 1u);
    return b;
}
__device__ __forceinline__ void xcd_barrier_complete(unsigned* bar, unsigned x, unsigned& nloc, unsigned& nx) {
    const unsigned G = gridDim.x * gridDim.y * gridDim.z;
    unsigned sum, cnt, mine, sp = 0u;
    for (;;) {
        sum = 0u; cnt = 0u; mine = 0u;
#pragma unroll
        for (unsigned j = 0; j < 16; ++j) { const unsigned c = xb_ld(&bar[XB_XCNT(j)]); sum += c; cnt += (c > 0u) ? 1u : 0u; mine = (j == x) ? c : mine; }
        if (sum == G) break;
        __builtin_amdgcn_s_sleep(1);
        if ((++sp & 255u) == 0u) { if (xb_ld(&bar[XB_TMO])) break; if (sp > XB_SPIN_CAP) { atomicAdd(&bar[XB_TMO], 1u); break; } }
    }
    nloc = mine > 0u ? mine : 1u; nx = cnt > 0u ? cnt : 1u;
}
__device__ __forceinline__ void xcd_barrier(const XcdBarrier& b) {
    asm volatile("s_waitcnt vmcnt(0)" ::: "memory");
    __syncthreads();
    if (threadIdx.x == 0) {
        unsigned* bar = b.bar;
        __builtin_amdgcn_s_waitcnt(0);
        unsigned nloc = b.st[0], nx = b.st[1];
        if (nloc == 0u) { xcd_barrier_complete(bar, b.x, nloc, nx); b.st[0] = nloc; b.st[1] = nx; }
        const unsigned old = xb_add(&bar[XB_XSUB(b.x)], 1u);
        const unsigned gen = old / nloc;
        if (old + 1u == (gen + 1u) * nloc) {
            __builtin_amdgcn_fence(__ATOMIC_RELEASE, "agent");
            asm volatile("s_waitcnt vmcnt(0)" ::: "memory");
            const unsigned og = xb_add(&bar[XB_TOP], 1u);
            const unsigned tg = og / nx;
            if (og + 1u == (tg + 1u) * nx) xb_add(&bar[XB_TOPGEN], 1u);
            else XB_SPIN(xb_ld(&bar[XB_TOPGEN]) == tg, bar);
            __builtin_amdgcn_fence(__ATOMIC_ACQUIRE, "agent");
            xb_add(&bar[XB_XGEN(b.x)], 1u);
            asm volatile("s_waitcnt vmcnt(0)" ::: "memory");
        } else {
            XB_SPIN(xb_ld(&bar[XB_XGEN(b.x)]) == gen, bar);
            __builtin_amdgcn_fence(__ATOMIC_ACQUIRE, "agent");
            asm volatile("s_waitcnt vmcnt(0)" ::: "memory");
        }
    }
    __syncthreads();
}

namespace pg8 {
constexpr int BM = 256, BK = 64, HALF = 128, HTB = HALF * BK * 2, STAGE_BYTES = 8 * HTB, NXCD = 8, WGM = 8;
__device__ __forceinline__ int lds_byte(int r, int c) { const int st = (r >> 4) * 2 + (c >> 5), rr = r & 15, cc = c & 31, ob = rr * 64 + cc * 2; return st * 1024 + (ob ^ (((ob >> 9) & 1) << 5)); }
__device__ __forceinline__ void stage_rc(int b, int& R, int& C) { const int st = b / 1024, sb = b % 1024, swz = sb ^ (((sb >> 9) & 1) << 5); R = (st >> 1) * 16 + swz / 64; C = (st & 1) * 32 + (swz % 64) / 2; }
__device__ __forceinline__ int perm32(int rho) { const int n = rho >> 4, i = rho & 15; return 8 * (i >> 2) + 4 * n + (i & 3); }

struct Unit { int pm, pn, w; };
struct OrderBase {
    int nM, nN, nwg, G, c;
    __device__ void init(int nM_, int nN_, int G_, int c_) { nM = nM_; nN = nN_; nwg = nM * nN; G = G_; c = c_; }
    __device__ bool nextb(int i, Unit& u) const {
        const long L = (long)i * G + c; if (L >= nwg) return false;
        int wgid = (int)L; { const int q = nwg / NXCD, r = nwg % NXCD, xcd = wgid % NXCD, off = wgid / NXCD; wgid = (xcd < r ? xcd * (q + 1) : r * (q + 1) + (xcd - r) * q) + off; }
        const int nig = WGM * nN, gid = wgid / nig, fm = gid * WGM, gsz = (nM - fm) < WGM ? (nM - fm) : WGM;
        u.pm = fm + ((wgid % nig) % gsz); u.pn = (wgid % nig) / gsz; u.w = 0; return true;
    }
};

template <class Epi, class Sched>
__device__ __forceinline__ void gemm_phase(LAS unsigned char* lds, const int K, const Sched& S, const Epi& E) {
    const int tid = otid(), wid = __builtin_amdgcn_readfirstlane(tid >> 6), lane = tid & 63, wr = wid >> 2, wc = wid & 3, fr = lane & 15, fq = lane >> 4;
    const int nt = K / BK;
    unsigned voffA[2], voffB[2];
#pragma unroll
    for (int i = 0; i < 2; ++i) { int R, C; stage_rc(tid * 16 + i * 8192, R, C); const int Rb = Epi::PERM ? ((R & ~31) + perm32(R & 31)) : R;
        voffA[i] = (unsigned)(R * K + C) * 2u; voffB[i] = (unsigned)(Rb * K + C) * 2u; }
    const size_t kstep = (size_t)(BK * 2);
    const size_t hstep = (size_t)HALF * K * 2;
    const unsigned ldsw = (unsigned)wid * 1024u;
    const int aoff = lds_byte(wr * 64 + fr, fq * 8), boff = lds_byte(wc * 32 + fr, fq * 8);
#define PG8_SA(b, h) (((b) * 2 + (h)) * HTB)
#define PG8_SB(b, h) ((4 + (b) * 2 + (h)) * HTB)
#define PG8_STAGE(bufoff, gbase, voff) do { _Pragma("unroll") for (int _i = 0; _i < 2; ++_i) \
        __builtin_amdgcn_global_load_lds((const unsigned*)((const char*)(gbase) + (voff)[_i]), (LAS unsigned*)(lds + (bufoff) + ldsw + _i * 8192), 16, 0, 0); } while (0)
#define PG8_LDA(dst, b, h) do { _Pragma("unroll") for (int m = 0; m < 4; ++m) _Pragma("unroll") for (int k = 0; k < 2; ++k) dst[m][k] = *(const LAS bf16x8*)(lds + PG8_SA(b, h) + aoff + m * 2048 + k * 1024); } while (0)
#define PG8_LDB(dst, b, h) do { _Pragma("unroll") for (int n = 0; n < 2; ++n) _Pragma("unroll") for (int k = 0; k < 2; ++k) dst[n][k] = *(const LAS bf16x8*)(lds + PG8_SB(b, h) + boff + n * 2048 + k * 1024); } while (0)
#define PG8_MMA(ai, bj, At, Bt) do { __builtin_amdgcn_s_setprio(1); _Pragma("unroll") for (int m = 0; m < 4; ++m) _Pragma("unroll") for (int n = 0; n < 2; ++n) _Pragma("unroll") for (int k = 0; k < 2; ++k) \
        acc[ai][bj][m][n] = __builtin_amdgcn_mfma_f32_16x16x32_bf16(Bt[n][k], At[m][k], acc[ai][bj][m][n], 0, 0, 0); __builtin_amdgcn_s_setprio(0); } while (0)
#define PG8_WAIT_V(n) asm volatile("s_waitcnt vmcnt(" #n ")" ::: "memory")
#define PG8_WAIT_L(n) asm volatile("s_waitcnt lgkmcnt(" #n ")" ::: "memory")
#define PG8_BAR __builtin_amdgcn_s_barrier()
#define PG8_SCHED __builtin_amdgcn_sched_barrier(0)
    Unit cur, nxt; int ui = 0;
    if (!S.next(0, cur)) return;
    f32x4 acc[2][2][4][2];
#pragma unroll
    for (int a = 0; a < 2; ++a)
#pragma unroll
        for (int b = 0; b < 2; ++b)
#pragma unroll
            for (int m = 0; m < 4; ++m)
#pragma unroll
                for (int n = 0; n < 2; ++n) acc[a][b][m][n] = (f32x4){0.f, 0.f, 0.f, 0.f};
    bf16x8 At[4][2], B0[2][2], B1[2][2];
    const char* cA = S.a_ptr(cur); const char* cB = S.b_ptr(cur);
    PG8_STAGE(PG8_SB(0, 0), cB, voffB); PG8_STAGE(PG8_SA(0, 0), cA, voffA); PG8_STAGE(PG8_SB(0, 1), cB + hstep, voffB); PG8_STAGE(PG8_SA(0, 1), cA + hstep, voffA);
    if (wr == 1) PG8_BAR;
    PG8_WAIT_V(4); PG8_BAR;
    PG8_STAGE(PG8_SB(1, 0), cB + kstep, voffB); PG8_STAGE(PG8_SA(1, 0), cA + kstep, voffA); PG8_STAGE(PG8_SB(1, 1), cB + hstep + kstep, voffB);
    PG8_WAIT_V(6); PG8_BAR;
    for (;;) {
        const bool has_next = S.next(ui + 1, nxt);
        const char* nA = has_next ? S.a_ptr(nxt) : cA; const char* nB = has_next ? S.b_ptr(nxt) : cB;
        for (int t = 0; t < nt; t += 2) {
            const bool last = (t == nt - 2);
            const char* a1 = cA + (size_t)(t + 1) * kstep;
            const char* a2 = last ? nA : cA + (size_t)(t + 2) * kstep; const char* b2 = last ? nB : cB + (size_t)(t + 2) * kstep;
            const char* a3 = a2 + kstep; const char* b3 = b2 + kstep;
            PG8_LDB(B0, 0, 0); PG8_SCHED; PG8_LDA(At, 0, 0); PG8_STAGE(PG8_SA(1, 1), a1 + hstep, voffA);
            PG8_WAIT_L(8); PG8_BAR; PG8_WAIT_L(0); PG8_MMA(0, 0, At, B0); PG8_BAR; PG8_SCHED;
            PG8_LDB(B1, 0, 1); PG8_STAGE(PG8_SB(0, 0), b2, voffB);
            PG8_BAR; PG8_WAIT_L(0); PG8_MMA(0, 1, At, B1); PG8_BAR;
            PG8_LDA(At, 0, 1); PG8_STAGE(PG8_SA(0, 0), a2, voffA);
            PG8_BAR; PG8_WAIT_L(0); PG8_MMA(1, 0, At, B0); PG8_BAR; PG8_SCHED;
            PG8_STAGE(PG8_SB(0, 1), b2 + hstep, voffB);
            PG8_WAIT_V(6); PG8_BAR; PG8_MMA(1, 1, At, B1); PG8_BAR;
            PG8_LDB(B0, 1, 0); PG8_SCHED; PG8_LDA(At, 1, 0); PG8_STAGE(PG8_SA(0, 1), a2 + hstep, voffA);
            PG8_WAIT_L(8); PG8_BAR; PG8_WAIT_L(0); PG8_MMA(0, 0, At, B0); PG8_BAR; PG8_SCHED;
            PG8_LDB(B1, 1, 1); PG8_STAGE(PG8_SB(1, 0), b3, voffB);
            PG8_BAR; PG8_WAIT_L(0); PG8_MMA(0, 1, At, B1); PG8_BAR;
            PG8_LDA(At, 1, 1); PG8_STAGE(PG8_SA(1, 0), a3, voffA);
            PG8_BAR; PG8_WAIT_L(0); PG8_MMA(1, 0, At, B0); PG8_BAR; PG8_SCHED;
            PG8_STAGE(PG8_SB(1, 1), b3 + hstep, voffB);
            PG8_WAIT_V(6); PG8_BAR; PG8_MMA(1, 1, At, B1); PG8_BAR;
        }
        E(acc, cur, wr, wc, fr, fq);
        if (!has_next) break;
#pragma unroll
        for (int a = 0; a < 2; ++a)
#pragma unroll
            for (int b = 0; b < 2; ++b)
#pragma unroll
                for (int m = 0; m < 4; ++m)
#pragma unroll
                    for (int n = 0; n < 2; ++n) acc[a][b][m][n] = (f32x4){0.f, 0.f, 0.f, 0.f};
        cur = nxt; cA = nA; cB = nB; ++ui;
    }
    PG8_WAIT_V(0);
    if (wr == 0) PG8_BAR;
    PG8_BAR;
#undef PG8_SA
#undef PG8_SB
#undef PG8_STAGE
#undef PG8_LDA
#undef PG8_LDB
#undef PG8_MMA
#undef PG8_WAIT_V
#undef PG8_WAIT_L
#undef PG8_BAR
#undef PG8_SCHED
}
}
using pg8::Unit;

struct SchedIn {
    pg8::OrderBase ob; int seg; const char* A; const char* B;
    __device__ bool next(int i, Unit& u) const { return ob.nextb(i, u); }
    __device__ const char* a_ptr(const Unit& u) const {
        const int gt = u.pm < LT_PROMPT ? ((u.pm / TPB) * (SEQ / 256) + seg * TPB + (u.pm % TPB)) : (XROWS / 256 + (u.pm - LT_PROMPT));
        return A + (size_t)gt * 256 * D * 2; }
    __device__ const char* b_ptr(const Unit& u) const { return B + (size_t)u.pn * 256 * D * 2; }
};
struct SchedAB {
    pg8::OrderBase ob; const char* A0; const char* A1; const char* B0; const char* B1;
    __device__ bool next(int i, Unit& u) const { const bool ok = ob.nextb(i >> 1, u); u.w = i & 1; return ok; }
    __device__ const char* a_ptr(const Unit& u) const { return (u.w ? A1 : A0) + (size_t)u.pm * 256 * D * 2; }
    __device__ const char* b_ptr(const Unit& u) const { return (u.w ? B1 : B0) + (size_t)u.pn * 256 * D * 2; }
};
struct SchedO {
    pg8::OrderBase ob; const char* A; const char* B;
    __device__ bool next(int i, Unit& u) const { return ob.nextb(i, u); }
    __device__ const char* a_ptr(const Unit& u) const { return A + (size_t)u.pm * 256 * D * 2; }
    __device__ const char* b_ptr(const Unit& u) const { return B + (size_t)u.pn * 256 * D * 2; }
};

struct EpiIn {
    static constexpr bool PERM = true;
    bf16_t* P; bf16_t* gex; float* out; int seg;
    __device__ __forceinline__ void operator()(const f32x4 (&acc)[2][2][4][2], const Unit& u, int wr, int wc, int fr, int fq) const {
        const int lr0 = u.pm * 256 + wr * 64 + fr;
        const int c0 = u.pn * 256 + wc * 32 + 8 * fq;
#pragma unroll
        for (int ai = 0; ai < 2; ++ai)
#pragma unroll
            for (int m = 0; m < 4; ++m) {
                const int lr = lr0 + ai * 128 + m * 16;
                bf16_t* rowp;
                if (u.pn < NT_PB) rowp = P + (size_t)lr * NPB + c0;
                else if (lr < LEX0) { const int b = lr / SEGTOK; const size_t grow = (size_t)b * SEQ + seg * SEGTOK + (lr % SEGTOK); rowp = (bf16_t*)(out + O_YP + grow * D) + (c0 - NPB); }
                else rowp = gex + (size_t)(lr - LEX0) * 2048 + (c0 - NPB);
#pragma unroll
                for (int bj = 0; bj < 2; ++bj) { const f32x4 v0 = acc[ai][bj][m][0], v1 = acc[ai][bj][m][1];
                    u32x4 w; w.x = cvt_pk_bf16(v0[0], v0[1]); w.y = cvt_pk_bf16(v0[2], v0[3]); w.z = cvt_pk_bf16(v1[0], v1[1]); w.w = cvt_pk_bf16(v1[2], v1[3]);
                    *(u32x4*)(rowp + bj * 128) = w; }
            }
    }
};
struct EpiAB {
    static constexpr bool PERM = false;
    float* tmp; bf16_t* merged; const bf16_t* gex; const float* out;
    __device__ __forceinline__ void operator()(const f32x4 (&acc)[2][2][4][2], const Unit& u, int wr, int wc, int fr, int fq) const {
        const int row0 = u.pm * 256 + wr * 64 + fr, col0 = u.pn * 256 + wc * 32 + 4 * fq;
#pragma unroll
        for (int ai = 0; ai < 2; ++ai)
#pragma unroll
            for (int m = 0; m < 4; ++m) {
                const int grow = row0 + ai * 128 + m * 16;
                const bf16_t* gp = (grow < XROWS) ? ((const bf16_t*)(out + O_YP + (size_t)grow * D) + u.w * D) : (gex + (size_t)(grow - XROWS) * 2048 + u.w * D);
#pragma unroll
                for (int bj = 0; bj < 2; ++bj)
#pragma unroll
                    for (int n = 0; n < 2; ++n) {
                        const int c = col0 + bj * 128 + n * 16;
                        const u32x2 g = *(const u32x2*)(gp + c);
                        f32x4 v = acc[ai][bj][m][n];
                        v[0] *= sigm(__uint_as_float(g.x << 16)); v[1] *= sigm(__uint_as_float(g.x & 0xffff0000u));
                        v[2] *= sigm(__uint_as_float(g.y << 16)); v[3] *= sigm(__uint_as_float(g.y & 0xffff0000u));
                        float* tp = tmp + (size_t)grow * D + c;
                        if (u.w == 0) *(f32x4*)tp = v;
                        else { const f32x4 t = *(const f32x4*)tp; v = v + t; u32x2 o; o.x = cvt_pk_bf16(v[0], v[1]); o.y = cvt_pk_bf16(v[2], v[3]); *(u32x2*)(merged + (size_t)grow * D + c) = o; }
                    }
            }
    }
};
struct EpiO {
    static constexpr bool PERM = false;
    float* out; const float* xp; const float* xs;
    __device__ __forceinline__ void operator()(const f32x4 (&acc)[2][2][4][2], const Unit& u, int wr, int wc, int fr, int fq) const {
        const int row0 = u.pm * 256 + wr * 64 + fr, col0 = u.pn * 256 + wc * 32 + 4 * fq;
#pragma unroll
        for (int ai = 0; ai < 2; ++ai)
#pragma unroll
            for (int m = 0; m < 4; ++m) {
                const int grow = row0 + ai * 128 + m * 16;
                const float* xr; float* yr;
                if (grow < XROWS) { xr = xp + (size_t)grow * D; yr = out + O_YP + (size_t)grow * D; }
                else { const int e = grow - XROWS; if (e < EX_SAMP || e >= EX_SHIFT) continue; xr = xs + (size_t)(e - EX_SAMP) * D; yr = out + O_YS + (size_t)(e - EX_SAMP) * D; }
#pragma unroll
                for (int bj = 0; bj < 2; ++bj)
#pragma unroll
                    for (int n = 0; n < 2; ++n) { const int c = col0 + bj * 128 + n * 16; *(f32x4*)(yr + c) = *(const f32x4*)(xr + c) + acc[ai][bj][m][n]; }
            }
    }
};

__device__ __forceinline__ void p0_row(const Params& p, int r, int lane) {
    bf16_t* hrow = (bf16_t*)(p.ws + WS_H) + (size_t)r * D;
    const float* src = nullptr; bool norm = true; float* sh = nullptr;
    if (r < XROWS) { src = p.in[0] + (size_t)r * D; if ((r & (SEQ - 1)) == SEQ - 1) sh = p.out + O_SHIFT_P + (size_t)(r / SEQ) * D; }
    else { const int e = r - XROWS;
        if (e < EX_SAMP) src = p.in[6] + (size_t)e * D;
        else if (e < EX_SHIFT) { src = p.in[1] + (size_t)(e - EX_SAMP) * D; if (((e - EX_SAMP) & 3) == 3) sh = p.out + O_SHIFT_S + (size_t)((e - EX_SAMP) >> 2) * D; }
        else if (e < EX_END) { src = p.in[5] + (size_t)(e - EX_SHIFT) * D; norm = false; } }
    u32x2* o8 = (u32x2*)hrow + lane;
    if (!src) {
#pragma unroll
        for (int j = 0; j < 4; ++j) o8[64 * j] = (u32x2){0u, 0u};
        return; }
    const f32x4* xr = (const f32x4*)src + lane;
    f32x4 v[4]; float ss = 0.f;
#pragma unroll
    for (int j = 0; j < 4; ++j) { v[j] = xr[64 * j]; ss += v[j][0] * v[j][0] + v[j][1] * v[j][1] + v[j][2] * v[j][2] + v[j][3] * v[j][3]; }
    if (norm) {
        const float rs = rsqrtf(wave_sum(ss) * (1.f / D) + 1e-6f);
        const f32x4* wr = (const f32x4*)p.in[7] + lane;
#pragma unroll
        for (int j = 0; j < 4; ++j) v[j] = v[j] * rs * wr[64 * j];
    }
#pragma unroll
    for (int j = 0; j < 4; ++j) { o8[64 * j] = (u32x2){pk2(v[j][0], v[j][1]), pk2(v[j][2], v[j][3])}; if (sh) ((f32x4*)sh)[lane + 64 * j] = v[j]; }
}
template <int MODE> __device__ __forceinline__ void p0_tr_item(const float* W, int N, bf16_t* WT, float* scr, int kb, int nb, int lane) {
    const int k0 = 64 * kb, n0 = 32 * nb;
    const int nn = n0 + (lane & 31);
    int srcc = nn;
    if (MODE == 1) srcc = nn < C_GATE_REF ? nn : (nn < NPB ? -1 : nn - (NPB - C_GATE_REF));
#pragma unroll 8
    for (int i = 0; i < 32; ++i) { const int kk = 2 * i + (lane >> 5); scr[kk * 33 + (lane & 31)] = srcc >= 0 ? W[(size_t)(k0 + kk) * N + srcc] : 0.f; }
    asm volatile("s_waitcnt lgkmcnt(0)" ::: "memory");
    const int c = lane & 7;
#pragma unroll
    for (int j = 0; j < 4; ++j) { const int n = (lane >> 3) + 8 * j; const float* s = scr + (8 * c) * 33 + n;
        u32x4 o; o.x = pk2(s[0 * 33], s[1 * 33]); o.y = pk2(s[2 * 33], s[3 * 33]); o.z = pk2(s[4 * 33], s[5 * 33]); o.w = pk2(s[6 * 33], s[7 * 33]);
        *(u32x4*)(WT + (size_t)(n0 + n) * D + k0 + 8 * c) = o; }
    asm volatile("s_waitcnt lgkmcnt(0)" ::: "memory");
}
__device__ __forceinline__ void phase0(const Params& p, unsigned char* smem) {
    const int tid0 = otid(), wave = tid0 >> 6, lane = tid0 & 63;
    const int gw = obid() * 8 + wave, NGW = gridDim.x * 8;
    float* scr = (float*)smem + wave * (64 * 33);
    constexpr int I_IN = 16 * (NP / 32), I_SQ = 16 * 32;
    for (int it = gw; it < I_IN + 3 * I_SQ; it += NGW) {
        int r = it;
        if (r < I_IN) { p0_tr_item<1>(p.in[8], 10384, (bf16_t*)(p.ws + WS_WT_IN), scr, r / (NP / 32), r % (NP / 32), lane); continue; } r -= I_IN;
        if (r < I_SQ) { p0_tr_item<0>(p.in[13], D, (bf16_t*)(p.ws + WS_WT_A), scr, r / 32, r % 32, lane); continue; } r -= I_SQ;
        if (r < I_SQ) { p0_tr_item<0>(p.in[24], D, (bf16_t*)(p.ws + WS_WT_B), scr, r / 32, r % 32, lane); continue; } r -= I_SQ;
        p0_tr_item<0>(p.in[25], D, (bf16_t*)(p.ws + WS_WT_O), scr, r / 32, r % 32, lane);
    }
    for (int r = gw; r < HROWS; r += NGW) p0_row(p, r, lane);
    {
        float* pk = (float*)(p.ws + WS_PK);
        const int gt = obid() * 512 + tid0, NT = gridDim.x * 512;
#define PKCOPY(off, idx, n) for (int i = gt; i < (n); i += NT) pk[(off) + i] = p.in[idx][i];
        PKCOPY(PK_CONVW, 9, 12288) PKCOPY(PK_ALOG, 10, 8) PKCOPY(PK_DTB, 11, 8) PKCOPY(PK_NORMW, 12, 128) PKCOPY(PK_MU, 14, 4224) PKCOPY(PK_W0, 15, 1024)
        PKCOPY(PK_W2, 16, 65536) PKCOPY(PK_A0, 17, 1024) PKCOPY(PK_A2, 18, 65536) PKCOPY(PK_KK, 19, 1024) PKCOPY(PK_KA, 20, 1024) PKCOPY(PK_RK, 21, 1024)
        PKCOPY(PK_GNW, 22, 1024) PKCOPY(PK_GNB, 23, 1024) PKCOPY(PK_LNF, 26, 1024)
#undef PKCOPY
        bf16_t* w2t = (bf16_t*)(p.ws + WS_W2T); bf16_t* a2t = (bf16_t*)(p.ws + WS_A2T);
        for (int i = gt; i < 65536; i += NT) { const int l = i & 63, c = (i >> 6) & 63, hb = i >> 12;
            w2t[i] = (bf16_t)f2bf(p.in[16][(size_t)l * D + hb * 64 + c]); a2t[i] = (bf16_t)f2bf(p.in[18][(size_t)l * D + hb * 64 + c]); }
    }
}

__device__ __forceinline__ void gdn_item(const Params& p, unsigned char* smem, const float* s_in, float* s_out, const float* halo_in, float* halo_out,
                                         int h, int sl, int rowA, int nA, int rowB, int nB) {
    const int tid = otid(), w = tid >> 6, lane = tid & 63, vl = lane >> 4, kg = lane & 15;
    float* qk_s = (float*)smem; float* v_s = qk_s + 16384; float* o_s = v_s + 2048; float* gb_s = o_s + 2048; float* sst = gb_s + 128;
    const bf16_t* P = (const bf16_t*)(p.ws + WS_P);
    float* ORAW = (float*)(p.ws + WS_ORAW);
    float s[8];
    if (s_in) {
        { const int k = tid >> 2, q4 = tid & 3; const f32x4* src = (const f32x4*)(s_in + (size_t)k * 128 + sl * 32 + q4 * 8); const f32x4 a = src[0], b = src[1];
          float* d = sst + k * 33 + q4 * 8; d[0] = a[0]; d[1] = a[1]; d[2] = a[2]; d[3] = a[3]; d[4] = b[0]; d[5] = b[1]; d[6] = b[2]; d[7] = b[3]; }
        __syncthreads();
#pragma unroll
        for (int j = 0; j < 8; ++j) s[j] = sst[(kg * 8 + j) * 33 + 4 * w + vl];
        __syncthreads();
    } else {
#pragma unroll
        for (int j = 0; j < 8; ++j) s[j] = 0.f;
    }
    int pcol = -1;
    if (tid < 128) pcol = h * 128 + tid; else if (tid < 256) pcol = 1024 + h * 128 + (tid - 128); else if (tid < 288) pcol = 2048 + h * 128 + sl * 32 + (tid - 256);
    float cw0 = 0.f, cw1 = 0.f, cw2 = 0.f, cw3 = 0.f, x1 = 0.f, x2 = 0.f, x3 = 0.f;
    const float* pk = (const float*)(p.ws + WS_PK);
    if (pcol >= 0) { const float* cw = pk + PK_CONVW; cw0 = cw[pcol]; cw1 = cw[3072 + pcol]; cw2 = cw[6144 + pcol]; cw3 = cw[9216 + pcol];
        if (halo_in) { x3 = halo_in[pcol]; x2 = halo_in[3072 + pcol]; x1 = halo_in[6144 + pcol]; } }
    const float nalog = -expf(pk[PK_ALOG + h]), dtb = pk[PK_DTB + h];
#pragma unroll 1
    for (int run = 0; run < 2; ++run) {
        const int rrow = run ? rowB : rowA, rn = run ? nB : nA; const bool wout = run != 0;
#pragma unroll 1
        for (int c0 = 0; c0 < rn; c0 += 64) {
            const int nt = (rn - c0) < 64 ? (rn - c0) : 64; const int row = rrow + c0;
            if (pcol >= 0) {
                const bf16_t* src = P + (size_t)row * NPB + pcol;
                float* dst = tid < 256 ? (qk_s + tid) : (v_s + (tid - 256)); const int dstride = tid < 256 ? 256 : 32;
#pragma unroll 8
                for (int i = 0; i < nt; ++i) { const float x0 = bf2f(src[(size_t)i * NPB]); const float y = cw0 * x3 + cw1 * x2 + cw2 * x1 + cw3 * x0; x3 = x2; x2 = x1; x1 = x0; dst[i * dstride] = silu_(y); }
            } else if (tid < 352) {
                const int i = tid - 288;
                if (i < nt) { const float pa = bf2f(P[(size_t)(row + i) * NPB + C_A + h]), pb = bf2f(P[(size_t)(row + i) * NPB + C_B + h]);
                    gb_s[2 * i] = expf(nalog * softplus_(pa + dtb)); gb_s[2 * i + 1] = sigm(pb); }
            }
            __syncthreads();
#pragma unroll 1
            for (int ii = 0; ii < 8; ++ii) { const int i = w * 8 + ii;
                if (i < nt) {
#pragma unroll
                    for (int which = 0; which < 2; ++which) { float* rp = qk_s + i * 256 + which * 128; const float a = rp[lane], b = rp[lane + 64];
                        const float sc = rsqrtf(wave_sum(a * a + b * b) + 1e-6f) * (which == 0 ? 0.08838834764831845f : 1.f); rp[lane] = a * sc; rp[lane + 64] = b * sc; } } }
            __syncthreads();
#pragma unroll 1
            for (int i = 0; i < nt; ++i) {
                const f32x4 q0 = *(const f32x4*)(qk_s + i * 256 + kg * 8), q1 = *(const f32x4*)(qk_s + i * 256 + kg * 8 + 4);
                const f32x4 k0 = *(const f32x4*)(qk_s + i * 256 + 128 + kg * 8), k1 = *(const f32x4*)(qk_s + i * 256 + 128 + kg * 8 + 4);
                const float vv = v_s[i * 32 + 4 * w + vl], a = gb_s[2 * i], be = gb_s[2 * i + 1];
                float part = k0[0] * s[0] + k0[1] * s[1] + k0[2] * s[2] + k0[3] * s[3] + k1[0] * s[4] + k1[1] * s[5] + k1[2] * s[6] + k1[3] * s[7];
                const float kS = rowsum16(part);
                const float c = be * (vv - a * kS);
                s[0] = a * s[0] + k0[0] * c; s[1] = a * s[1] + k0[1] * c; s[2] = a * s[2] + k0[2] * c; s[3] = a * s[3] + k0[3] * c;
                s[4] = a * s[4] + k1[0] * c; s[5] = a * s[5] + k1[1] * c; s[6] = a * s[6] + k1[2] * c; s[7] = a * s[7] + k1[3] * c;
                float op = q0[0] * s[0] + q0[1] * s[1] + q0[2] * s[2] + q0[3] * s[3] + q1[0] * s[4] + q1[1] * s[5] + q1[2] * s[6] + q1[3] * s[7];
                const float o = rowsum16(op);
                if (kg == 0) o_s[i * 32 + 4 * w + vl] = o;
            }
            __syncthreads();
            if (wout) { const int i = tid >> 3, c4 = (tid & 7) * 4; if (i < nt) *(f32x4*)(ORAW + (size_t)(row + i) * D + h * 128 + sl * 32 + c4) = *(const f32x4*)(o_s + i * 32 + c4); }
        }
    }
    if (pcol >= 0 && (sl == 0 || tid >= 256)) { halo_out[pcol] = x3; halo_out[3072 + pcol] = x2; halo_out[6144 + pcol] = x1; }
#pragma unroll
    for (int j = 0; j < 8; ++j) sst[(kg * 8 + j) * 33 + 4 * w + vl] = s[j];
    __syncthreads();
    { const int k = tid >> 2, q4 = tid & 3; const float* d = sst + k * 33 + q4 * 8; f32x4* dst = (f32x4*)(s_out + (size_t)k * 128 + sl * 32 + q4 * 8);
      dst[0] = (f32x4){d[0], d[1], d[2], d[3]}; dst[1] = (f32x4){d[4], d[5], d[6], d[7]}; }
    __syncthreads();
}

constexpr int RW_W2 = 20544, RW_A2 = 24640;
__device__ __forceinline__ void rwkv_load_lora(const Params& p, unsigned char* smem, int hb) {
    float* w2_s = (float*)smem + RW_W2; float* a2_s = (float*)smem + RW_A2; const float* pk = (const float*)(p.ws + WS_PK);
    for (int i = otid(); i < 4096; i += 512) { const int l = i >> 6, c = i & 63; w2_s[i] = pk[PK_W2 + l * D + hb * 64 + c]; a2_s[i] = pk[PK_A2 + l * D + hb * 64 + c]; }
    __syncthreads();
}
__device__ __forceinline__ void rwkv_item(const Params& p, unsigned char* smem, const float* s_in, float* s_out, const bf16_t* prev_row, const float* halo_in, float* halo_out,
                                          int hb, int half, int rowA, int nA, int rowB, int nB) {
    const int tid = otid(), w = tid >> 6, lane = tid & 63, row = tid >> 4, kq = tid & 15;
    float* f = (float*)smem;
    float* r_s = f; float* kb_s = f + 2048; float* v_s = f + 4096; float* wd_s = f + 6144; float* ad_s = f + 8192; float* dec_s = f + 10240; float* a_s = f + 12288;
    float* kk_s = f + 14336; float* km_s = f + 16384; float* zb_s = f + 18432; float* y_s = f + 19456; float* bonus_s = f + 20480;
    const float* w2_s = f + RW_W2; const float* a2_s = f + RW_A2;
    const bf16_t* P = (const bf16_t*)(p.ws + WS_P);
    float* YRAW = (float*)(p.ws + WS_YRAW); bf16_t* C0 = (bf16_t*)(p.ws + WS_C0); bf16_t* C1 = (bf16_t*)(p.ws + WS_C1);
    float s[4];
    if (s_in) { const f32x4 t = *(const f32x4*)(s_in + (size_t)(half * 32 + row) * 64 + kq * 4); s[0] = t[0]; s[1] = t[1]; s[2] = t[2]; s[3] = t[3]; }
    else { s[0] = s[1] = s[2] = s[3] = 0.f; }
    int col = -1; float* dst = nullptr; int dstride = 64; bool is_wd = false, owner = false;
    if (tid < 64) { col = hb * 64 + tid; dst = r_s + tid; owner = half == 0; }
    else if (tid < 128) { col = 1024 + hb * 64 + (tid - 64); dst = kb_s + (tid - 64); owner = half == 0; }
    else if (tid < 192) { col = 2048 + hb * 64 + (tid - 128); dst = v_s + (tid - 128); owner = half == 0; }
    else if (tid < 256) { col = 3072 + (tid - 192); dst = wd_s + (tid - 192); is_wd = true; owner = (half == 0 && hb == 0); }
    else if (tid < 320) { col = 3136 + (tid - 256); dst = ad_s + (tid - 256); owner = (half == 0 && hb == 0); }
    else if (tid < 352) { col = 3200 + hb * 64 + half * 32 + (tid - 320); dst = zb_s + (tid - 320); dstride = 32; owner = true; }
    float mu = 0.f, prev = 0.f;
    const float* pk = (const float*)(p.ws + WS_PK);
    if (col >= 0) { mu = pk[PK_MU + col]; prev = prev_row ? bf2f(prev_row[C_RW + col]) : (halo_in ? halo_in[col] : 0.f); }
    const int cc = tid & 63, ig = tid >> 6;
    const int hc = hb * 64 + cc;
    const float w0c = pk[PK_W0 + hc], a0c = pk[PK_A0 + hc], kkc = pk[PK_KK + hc], kac = pk[PK_KA + hc];
    const float rkl = pk[PK_RK + hb * 64 + lane];
#pragma unroll 1
    for (int run = 0; run < 2; ++run) {
        const int rrow = run ? rowB : rowA, rn = run ? nB : nA; const bool wout = run != 0;
#pragma unroll 1
        for (int c0 = 0; c0 < rn; c0 += 32) {
            const int nt = (rn - c0) < 32 ? (rn - c0) : 32; const int row0 = rrow + c0;
            if (col >= 0) {
                const bf16_t* src = P + (size_t)row0 * NPB + C_RW + col;
#pragma unroll 8
                for (int i = 0; i < nt; ++i) { const float cur = bf2f(src[(size_t)i * NPB]); float m = cur + mu * (prev - cur); prev = cur; if (is_wd) m = tanh_(m); dst[i * dstride] = m; }
            }
            __syncthreads();
            {
                float aw[4] = {0.f, 0.f, 0.f, 0.f}, aa[4] = {0.f, 0.f, 0.f, 0.f};
#pragma unroll 4
                for (int l = 0; l < 64; ++l) { const float w2v = w2_s[l * 64 + cc], a2v = a2_s[l * 64 + cc];
#pragma unroll
                    for (int ii = 0; ii < 4; ++ii) { aw[ii] += wd_s[(ig * 4 + ii) * 64 + l] * w2v; aa[ii] += ad_s[(ig * 4 + ii) * 64 + l] * a2v; } }
#pragma unroll
                for (int ii = 0; ii < 4; ++ii) { const int i = ig * 4 + ii;
                    if (i < nt) { const float wraw = w0c + aw[ii]; const float wlog = -0.6065306597126334f * sigm(wraw); const float a = sigm(a0c + aa[ii]);
                        const float kbv = kb_s[i * 64 + cc];
                        dec_s[i * 64 + cc] = expf(wlog); a_s[i * 64 + cc] = a; kk_s[i * 64 + cc] = kbv * kkc; km_s[i * 64 + cc] = kbv * (1.f + (a - 1.f) * kac); } }
            }
            __syncthreads();
#pragma unroll 1
            for (int ii = 0; ii < 4; ++ii) { const int i = w * 4 + ii;
                if (i < nt) { const float kkr = kk_s[i * 64 + lane]; const float kk = kkr * rsqrtf(wave_sum(kkr * kkr) + 1e-6f); kk_s[i * 64 + lane] = kk;
                    const float a = a_s[i * 64 + lane]; a_s[i * 64 + lane] = kk * a;
                    const float rk = wave_sum(r_s[i * 64 + lane] * km_s[i * 64 + lane] * rkl); if (lane == 0) bonus_s[i] = rk; } }
            __syncthreads();
#pragma unroll 1
            for (int i = 0; i < nt; ++i) {
                const f32x4 kk4 = *(const f32x4*)(kk_s + i * 64 + kq * 4), de4 = *(const f32x4*)(dec_s + i * 64 + kq * 4), ka4 = *(const f32x4*)(a_s + i * 64 + kq * 4),
                            km4 = *(const f32x4*)(km_s + i * 64 + kq * 4), r4 = *(const f32x4*)(r_s + i * 64 + kq * 4);
                const float vv = v_s[i * 64 + half * 32 + row];
                const float sa = rowsum16(s[0] * kk4[0] + s[1] * kk4[1] + s[2] * kk4[2] + s[3] * kk4[3]);
#pragma unroll
                for (int j = 0; j < 4; ++j) s[j] = s[j] * de4[j] + (vv * km4[j] - sa * ka4[j]);
                const float y = rowsum16(s[0] * r4[0] + s[1] * r4[1] + s[2] * r4[2] + s[3] * r4[3]);
                if (kq == 0) y_s[i * 32 + row] = y;
            }
            __syncthreads();
            if (wout) { const int i = tid >> 4;
                if (i < nt) {
#pragma unroll
                    for (int q = 0; q < 2; ++q) { const int rr = (tid & 15) * 2 + q, v = half * 32 + rr, colo = hb * 64 + v;
                        const float sz = silu_(zb_s[i * 32 + rr]);
                        const size_t o = (size_t)(row0 + i) * D + colo;
                        YRAW[o] = y_s[i * 32 + rr]; C1[o] = (bf16_t)f2bf(pk[PK_GNW + colo] * sz); C0[o] = (bf16_t)f2bf((pk[PK_GNB + colo] + bonus_s[i] * v_s[i * 64 + v]) * sz); } } }
            __syncthreads();
        }
    }
    *(f32x4*)(s_out + (size_t)(half * 32 + row) * 64 + kq * 4) = (f32x4){s[0], s[1], s[2], s[3]};
    if (col >= 0 && owner && halo_out) halo_out[col] = prev;
}


__device__ __forceinline__ bf16x8 ldfrag(const bf16_t* base, int stride, int r0, int k0, int lane) {
    return *(const bf16x8*)(base + (r0 + (lane & 15)) * stride + k0 + 8 * (lane >> 4));
}
#define MFMA16(a, b, c) __builtin_amdgcn_mfma_f32_16x16x32_bf16((a), (b), (c), 0, 0, 0)
__device__ __forceinline__ void inv_lower(const float* Lm_, float (&Tr)[64], int lane) {
    const LAS float* Lm = (const LAS float*)Lm_;
    asm volatile("" : "+v"(Lm));
#pragma unroll
    for (int i = 0; i < 64; ++i) Tr[i] = 0.f;
#pragma unroll
    for (int i = 0; i < 64; ++i) {
        float a = (lane == i) ? 1.f : 0.f;
        asm volatile("" ::: "memory");
#pragma unroll
        for (int j0 = 0; j0 < i; j0 += 4) { const f32x4 l4 = *(const LAS f32x4*)(Lm + i * 64 + j0);
            a -= l4[0] * Tr[j0]; a -= l4[1] * Tr[j0 + 1]; a -= l4[2] * Tr[j0 + 2]; a -= l4[3] * Tr[j0 + 3]; }
        Tr[i] = a;
    }
}
constexpr int PL_QS = 0, PL_R1 = 17408, PL_KT = 35840, PL_KTT = 54272, PL_VT = 72704, PL_R3 = 91136, PL_QKM = 109568, PL_TP = 118784, PL_TPP = 128000, PL_SM = 137216;
constexpr int QSTR = 136, TSTR = 72;

__device__ __forceinline__ void gdn_prep_item(const Params& p, unsigned char* smem, int h, int row_start, int npad, int halo_mode, int hrow, const float* halo_buf,
                                              float* halo_out, unsigned char* rec) {
    const int tid = otid(), w = tid >> 6, lane = tid & 63, q4 = lane >> 4, l15 = lane & 15;
    bf16_t* qs = (bf16_t*)(smem + PL_QS); bf16_t* ks = (bf16_t*)(smem + PL_R1); bf16_t* WT = ks; bf16_t* kT = (bf16_t*)(smem + PL_KT); bf16_t* ktT = (bf16_t*)(smem + PL_KTT);
    bf16_t* vT = (bf16_t*)(smem + PL_VT); float* Lm = (float*)(smem + PL_R3); bf16_t* UT = (bf16_t*)(smem + PL_R3); bf16_t* QKm = (bf16_t*)(smem + PL_QKM);
    bf16_t* Tp = (bf16_t*)(smem + PL_TP); bf16_t* Tpp = (bf16_t*)(smem + PL_TPP);
    float* sm = (float*)(smem + PL_SM);
    float* gcs = sm; float* bes = sm + 64; float* ssq = sm + 128; float* ssk = sm + 192; float* egs = sm + 256; float* egl_s = sm + 320; float* beg = sm + 384;
    const bf16_t* P = (const bf16_t*)(p.ws + WS_P);
    const float* pk = (const float*)(p.ws + WS_PK);
    if (tid < 128) ssq[tid] = 0.f;
    if (tid >= 448) { const int i = tid - 448;
        float g = 0.f, be = 0.f;
        if (i >= npad) { const size_t r = (size_t)(row_start + i - npad) * NPB; const float pa = bf2f(P[r + C_A + h]), pb = bf2f(P[r + C_B + h]);
            g = -expf(pk[PK_ALOG + h]) * softplus_(pa + pk[PK_DTB + h]); be = sigm(pb); }
        gcs[i] = g; bes[i] = be; }
    __syncthreads();
    if (tid < 64) {
        float x = gcs[lane];
#pragma unroll
        for (int o = 1; o < 64; o <<= 1) { const float y = __shfl_up(x, o); if (lane >= o) x += y; }
        const float gl = __shfl(x, 63);
        gcs[lane] = x; egs[lane] = expf(x); egl_s[lane] = expf(gl - x); beg[lane] = bes[lane] * expf(x);
        if (lane == 0) *(float*)(rec + GP_EGL) = expf(gl);
    }
    const int cg = tid % 48, ts = tid / 48;
    const int sec = cg >> 4;
    const int pcol = sec * 1024 + h * 128 + (cg & 15) * 8;
    float val[7][8];
    if (ts < 10) {
        float cw[4][8];
#pragma unroll
        for (int j = 0; j < 4; ++j) { const f32x4 a = *(const f32x4*)(pk + PK_CONVW + j * 3072 + pcol), b = *(const f32x4*)(pk + PK_CONVW + j * 3072 + pcol + 4);
            cw[j][0] = a[0]; cw[j][1] = a[1]; cw[j][2] = a[2]; cw[j][3] = a[3]; cw[j][4] = b[0]; cw[j][5] = b[1]; cw[j][6] = b[2]; cw[j][7] = b[3]; }
#pragma unroll
        for (int it = 0; it < 7; ++it) {
            const int i = ts + 10 * it;
            float y[8];
#pragma unroll
            for (int e = 0; e < 8; ++e) y[e] = 0.f;
            if (i < 64 && i >= npad) {
#pragma unroll
                for (int dlt = 0; dlt < 4; ++dlt) {
                    const int ii = i - 3 + dlt;
                    float x[8];
                    bool have = true;
                    if (ii >= npad) { const u32x4 rw = *(const u32x4*)(P + (size_t)(row_start + ii - npad) * NPB + pcol);
                        x[0] = __uint_as_float(rw.x << 16); x[1] = __uint_as_float(rw.x & 0xffff0000u); x[2] = __uint_as_float(rw.y << 16); x[3] = __uint_as_float(rw.y & 0xffff0000u);
                        x[4] = __uint_as_float(rw.z << 16); x[5] = __uint_as_float(rw.z & 0xffff0000u); x[6] = __uint_as_float(rw.w << 16); x[7] = __uint_as_float(rw.w & 0xffff0000u); }
                    else if (ii < 0 && npad == 0 && halo_mode == 1) { const u32x4 rw = *(const u32x4*)(P + (size_t)(hrow + ii) * NPB + pcol);
                        x[0] = __uint_as_float(rw.x << 16); x[1] = __uint_as_float(rw.x & 0xffff0000u); x[2] = __uint_as_float(rw.y << 16); x[3] = __uint_as_float(rw.y & 0xffff0000u);
                        x[4] = __uint_as_float(rw.z << 16); x[5] = __uint_as_float(rw.z & 0xffff0000u); x[6] = __uint_as_float(rw.w << 16); x[7] = __uint_as_float(rw.w & 0xffff0000u); }
                    else if (ii < 0 && npad == 0 && halo_mode == 2) { const f32x4 a = *(const f32x4*)(halo_buf + (3 + ii) * 3072 + pcol), b = *(const f32x4*)(halo_buf + (3 + ii) * 3072 + pcol + 4);
                        x[0] = a[0]; x[1] = a[1]; x[2] = a[2]; x[3] = a[3]; x[4] = b[0]; x[5] = b[1]; x[6] = b[2]; x[7] = b[3]; }
                    else have = false;
                    if (have) {
#pragma unroll
                        for (int e = 0; e < 8; ++e) y[e] += cw[dlt][e] * x[e]; }
                }
                float ss = 0.f;
#pragma unroll
                for (int e = 0; e < 8; ++e) { y[e] = silu_(y[e]); ss += y[e] * y[e]; }
                if (sec == 0) atomicAdd(ssq + i, ss); else if (sec == 1) atomicAdd(ssk + i, ss);
            }
#pragma unroll
            for (int e = 0; e < 8; ++e) val[it][e] = y[e];
        }
    }
    if (halo_out && tid < 384) {
        const int c = (tid >> 7) * 1024 + h * 128 + (tid & 127);
#pragma unroll
        for (int dd = 0; dd < 3; ++dd) halo_out[dd * 3072 + c] = bf2f(P[(size_t)(row_start + 61 + dd) * NPB + c]);
    }
    __syncthreads();
    if (ts < 10) {
#pragma unroll
        for (int it = 0; it < 7; ++it) {
            const int i = ts + 10 * it;
            if (i < 64) {
                float sc = 1.f;
                if (sec == 0) sc = rsqrtf(ssq[i] + 1e-6f) * 0.08838834764831845f; else if (sec == 1) sc = rsqrtf(ssk[i] + 1e-6f);
                const int d0 = (cg & 15) * 8;
                float x[8];
#pragma unroll
                for (int e = 0; e < 8; ++e) x[e] = val[it][e] * sc;
                if (sec == 0) { *(u32x4*)(qs + i * QSTR + d0) = (u32x4){pk2(x[0], x[1]), pk2(x[2], x[3]), pk2(x[4], x[5]), pk2(x[6], x[7])}; }
                else if (sec == 1) { *(u32x4*)(ks + i * QSTR + d0) = (u32x4){pk2(x[0], x[1]), pk2(x[2], x[3]), pk2(x[4], x[5]), pk2(x[6], x[7])};
                    const float eg = egl_s[i];
#pragma unroll
                    for (int e = 0; e < 8; ++e) { kT[(d0 + e) * TSTR + i] = (bf16_t)f2bf(x[e]); ktT[(d0 + e) * TSTR + i] = (bf16_t)f2bf(x[e] * eg); } }
                else {
#pragma unroll
                    for (int e = 0; e < 8; ++e) vT[(d0 + e) * TSTR + i] = (bf16_t)f2bf(x[e]); }
            }
        }
    }
    __syncthreads();
    {
        const int which = w >> 2, it = w & 3;
        const bf16_t* Aarr = which ? qs : ks;
        bf16x8 af[4];
#pragma unroll
        for (int kk = 0; kk < 4; ++kk) af[kk] = ldfrag(Aarr, QSTR, 16 * it, 32 * kk, lane);
#pragma unroll
        for (int jt = 0; jt < 4; ++jt) {
            f32x4 acc = {0.f, 0.f, 0.f, 0.f};
#pragma unroll
            for (int kk = 0; kk < 4; ++kk) acc = MFMA16(af[kk], ldfrag(ks, QSTR, 16 * jt, 32 * kk, lane), acc);
            const int j = 16 * jt + l15; const float gj = gcs[j];
#pragma unroll
            for (int r = 0; r < 4; ++r) { const int i = 16 * it + 4 * q4 + r;
                if (which == 0) Lm[i * 64 + j] = (i > j) ? bes[i] * acc[r] * expf(gcs[i] - gj) : 0.f;
                else QKm[i * TSTR + j] = (bf16_t)f2bf((i >= j) ? acc[r] * expf(gcs[i] - gj) : 0.f); }
        }
    }
    __syncthreads();
    if (w == 0) {
        float Tr[64];
        inv_lower(Lm, Tr, lane);
        const float s1 = beg[lane], s2 = bes[lane];
#pragma unroll
        for (int i = 0; i < 64; ++i) { Tp[i * TSTR + lane] = (bf16_t)f2bf(Tr[i] * s1); Tpp[i * TSTR + lane] = (bf16_t)f2bf(Tr[i] * s2); }
    }
    __syncthreads();
    {
        const int it = w & 3, half = w >> 2;
        f32x4 aw[4], au[4];
#pragma unroll
        for (int x = 0; x < 4; ++x) { aw[x] = (f32x4){0.f, 0.f, 0.f, 0.f}; au[x] = (f32x4){0.f, 0.f, 0.f, 0.f}; }
#pragma unroll
        for (int kk = 0; kk < 2; ++kk) {
            const bf16x8 a1 = ldfrag(Tp, TSTR, 16 * it, 32 * kk, lane), a2 = ldfrag(Tpp, TSTR, 16 * it, 32 * kk, lane);
#pragma unroll
            for (int x = 0; x < 4; ++x) { const int dt = half * 4 + x;
                aw[x] = MFMA16(a1, ldfrag(kT, TSTR, 16 * dt, 32 * kk, lane), aw[x]);
                au[x] = MFMA16(a2, ldfrag(vT, TSTR, 16 * dt, 32 * kk, lane), au[x]); }
        }
        __syncthreads();
#pragma unroll
        for (int x = 0; x < 4; ++x) { const int d = 16 * (half * 4 + x) + l15, i0 = 16 * it + 4 * q4;
            *(u32x2*)(WT + d * TSTR + i0) = (u32x2){pk2(aw[x][0], aw[x][1]), pk2(aw[x][2], aw[x][3])};
            *(u32x2*)(UT + d * TSTR + i0) = (u32x2){pk2(au[x][0], au[x][1]), pk2(au[x][2], au[x][3])}; }
    }
    __syncthreads();
    {
        bf16_t* gAP = (bf16_t*)(rec + GP_AP); bf16_t* gQH = (bf16_t*)(rec + GP_QH); bf16_t* gKH = (bf16_t*)(rec + GP_KH); bf16_t* gOH = (bf16_t*)(rec + GP_OH);
        {
            const int et = w;
            const bf16x8 a0 = ldfrag(WT, TSTR, 16 * et, 0, lane), a1 = ldfrag(WT, TSTR, 16 * et, 32, lane);
#pragma unroll
            for (int dt = 0; dt < 8; ++dt) { f32x4 acc = {0.f, 0.f, 0.f, 0.f};
                acc = MFMA16(a0, ldfrag(ktT, TSTR, 16 * dt, 0, lane), acc); acc = MFMA16(a1, ldfrag(ktT, TSTR, 16 * dt, 32, lane), acc);
                *(u32x2*)(gAP + ((size_t)(dt * 4 + (et >> 1)) * 64 + lane) * 8 + (et & 1) * 4) = (u32x2){pk2(-acc[0], -acc[1]), pk2(-acc[2], -acc[3])}; }
#pragma unroll
            for (int tt = 0; tt < 4; ++tt) { f32x4 acc = {0.f, 0.f, 0.f, 0.f};
                acc = MFMA16(a0, ldfrag(QKm, TSTR, 16 * tt, 0, lane), acc); acc = MFMA16(a1, ldfrag(QKm, TSTR, 16 * tt, 32, lane), acc);
                const int t = 16 * tt + l15, e0 = 16 * et + 4 * q4; const float eg = egs[t];
                const u32x2 qq = *(const u32x2*)(qs + t * QSTR + e0);
                const float o0 = __uint_as_float(qq.x << 16) * eg - acc[0], o1 = __uint_as_float(qq.x & 0xffff0000u) * eg - acc[1],
                            o2 = __uint_as_float(qq.y << 16) * eg - acc[2], o3 = __uint_as_float(qq.y & 0xffff0000u) * eg - acc[3];
                *(u32x2*)(gQH + ((size_t)(tt * 4 + (et >> 1)) * 64 + lane) * 8 + (et & 1) * 4) = (u32x2){pk2(o0, o1), pk2(o2, o3)}; }
        }
        {
            const int dt = w;
            const bf16x8 a0 = ldfrag(ktT, TSTR, 16 * dt, 0, lane), a1 = ldfrag(ktT, TSTR, 16 * dt, 32, lane);
#pragma unroll
            for (int vt = 0; vt < 8; ++vt) { f32x4 acc = {0.f, 0.f, 0.f, 0.f};
                acc = MFMA16(a0, ldfrag(UT, TSTR, 16 * vt, 0, lane), acc); acc = MFMA16(a1, ldfrag(UT, TSTR, 16 * vt, 32, lane), acc);
                *(u32x2*)(gKH + ((size_t)(vt * 8 + dt) * 64 + lane) * 4) = (u32x2){pk2(acc[0], acc[1]), pk2(acc[2], acc[3])}; }
            const int tt = w & 3, vh = w >> 2;
            const bf16x8 b0 = ldfrag(QKm, TSTR, 16 * tt, 0, lane), b1 = ldfrag(QKm, TSTR, 16 * tt, 32, lane);
#pragma unroll
            for (int x = 0; x < 4; ++x) { const int vt = vh * 4 + x; f32x4 acc = {0.f, 0.f, 0.f, 0.f};
                acc = MFMA16(b0, ldfrag(UT, TSTR, 16 * vt, 0, lane), acc); acc = MFMA16(b1, ldfrag(UT, TSTR, 16 * vt, 32, lane), acc);
                *(u32x2*)(gOH + ((size_t)(vt * 4 + tt) * 64 + lane) * 4) = (u32x2){pk2(acc[0], acc[1]), pk2(acc[2], acc[3])}; }
        }
    }
    __syncthreads();
}

__device__ __forceinline__ void phase_gprep(const Params& p, int seg, unsigned char* smem) {
    const int blk = obid();
    float* chalo = (float*)(p.ws + WS_CHALO);
    const int n_items = (CPS + (seg == 0 ? 1 : 0)) * 64;
#pragma unroll 1
    for (int it = blk; it < n_items; it += gridDim.x) {
        const int bh = it & 63, b = bh >> 3, h = bh & 7; int cl = it >> 6; if (seg != 0) cl += 1;
        unsigned char* rec = p.ws + WS_GP + (size_t)(cl * 64 + bh) * GP_STRIDE;
        if (cl == 0) gdn_prep_item(p, smem, h, LEX0, 48, 0, 0, nullptr, nullptr, rec);
        else {
            const int row = b * SEGTOK + (cl - 1) * 64;
            int mode = 1, hrow = row;
            const float* hb = nullptr;
            if (cl == 1) { if (seg == 0) { hrow = LEX0 + NMETA; } else { mode = 2; hb = chalo + (size_t)(((seg - 1) & 1) * NBATCH + b) * 9216; } }
            float* ho = nullptr;
            if (cl == CPS) ho = (seg == NSEG - 1) ? p.out + O_CONV_P + (size_t)b * 9216 : chalo + (size_t)((seg & 1) * NBATCH + b) * 9216;
            gdn_prep_item(p, smem, h, row, 0, mode, hrow, hb, ho, rec);
        }
    }
}

__device__ __forceinline__ void gdn_scan_block(const Params& p, int seg, unsigned char* smem, int bh) {
    const int tid = otid(), w = tid >> 6, lane = tid & 63, q4 = lane >> 4, l15 = lane & 15;
    const int b = bh >> 3, h = bh & 7;
    float* st = p.out + O_GDN_P + (size_t)bh * 16384;
    float* ORAW = (float*)(p.ws + WS_ORAW);
    f32x4 S[8];
    if (seg) {
#pragma unroll
        for (int mt = 0; mt < 8; ++mt)
#pragma unroll
            for (int r = 0; r < 4; ++r) S[mt][r] = st[(size_t)(16 * mt + 4 * q4 + r) * 128 + 16 * w + l15];
    } else {
#pragma unroll
        for (int mt = 0; mt < 8; ++mt) S[mt] = (f32x4){0.f, 0.f, 0.f, 0.f};
    }
    const int c_lo = seg ? 1 : 0;
#pragma unroll 1
    for (int cl = c_lo; cl <= CPS; ++cl) {
        const unsigned char* rec = p.ws + WS_GP + (size_t)(cl * 64 + bh) * GP_STRIDE;
        __syncthreads();
        {
            const u32x4* src = (const u32x4*)rec; u32x4* dst = (u32x4*)smem;
#pragma unroll
            for (int x = 0; x < 6; ++x) dst[tid + 512 * x] = src[tid + 512 * x];
        }
        const bf16_t* gKH = (const bf16_t*)(rec + GP_KH); const bf16_t* gOH = (const bf16_t*)(rec + GP_OH);
        u32x2 kh[8], oh[4];
#pragma unroll
        for (int mt = 0; mt < 8; ++mt) kh[mt] = *(const u32x2*)(gKH + ((size_t)(w * 8 + mt) * 64 + lane) * 4);
#pragma unroll
        for (int tt = 0; tt < 4; ++tt) oh[tt] = *(const u32x2*)(gOH + ((size_t)(w * 4 + tt) * 64 + lane) * 4);
        const float egl = *(const float*)(rec + GP_EGL);
        bf16x8 Bf[4];
#pragma unroll
        for (int ks = 0; ks < 4; ++ks) { u32x4 t; t.x = pk2(S[2 * ks][0], S[2 * ks][1]); t.y = pk2(S[2 * ks][2], S[2 * ks][3]); t.z = pk2(S[2 * ks + 1][0], S[2 * ks + 1][1]); t.w = pk2(S[2 * ks + 1][2], S[2 * ks + 1][3]);
            Bf[ks] = __builtin_bit_cast(bf16x8, t); }
        __syncthreads();
        const bf16x8* AP = (const bf16x8*)smem; const bf16x8* QH = (const bf16x8*)(smem + GP_QH);
        if (cl > 0) {
            const int row = b * SEGTOK + (cl - 1) * 64;
            float* obuf = (float*)(smem + 49152);
#pragma unroll
            for (int tt = 0; tt < 4; ++tt) { f32x4 o = {0.f, 0.f, 0.f, 0.f};
#pragma unroll
                for (int ks = 0; ks < 4; ++ks) o = MFMA16(QH[(tt * 4 + ks) * 64 + lane], Bf[ks], o);
                o[0] += __uint_as_float(oh[tt].x << 16); o[1] += __uint_as_float(oh[tt].x & 0xffff0000u); o[2] += __uint_as_float(oh[tt].y << 16); o[3] += __uint_as_float(oh[tt].y & 0xffff0000u);
#pragma unroll
                for (int r = 0; r < 4; ++r) obuf[(16 * tt + 4 * q4 + r) * 132 + 16 * w + l15] = o[r]; }
            __syncthreads();
            {
                const int t = tid >> 3, g = tid & 7;
                f32x4 o[4]; float ss = 0.f;
#pragma unroll
                for (int j = 0; j < 4; ++j) { o[j] = *(const f32x4*)(obuf + t * 132 + 16 * g + 4 * j); ss += o[j][0] * o[j][0] + o[j][1] * o[j][1] + o[j][2] * o[j][2] + o[j][3] * o[j][3]; }
                ss += __shfl_xor(ss, 1); ss += __shfl_xor(ss, 2); ss += __shfl_xor(ss, 4);
                const float rs = rsqrtf(ss * (1.f / 128.f) + 1e-6f);
                const bf16_t* zp = (const bf16_t*)(p.ws + WS_P) + (size_t)(row + t) * NPB + C_Z + h * 128 + 16 * g;
                const u32x4 z0 = *(const u32x4*)zp, z1 = *(const u32x4*)(zp + 8);
                const unsigned zz[8] = {z0.x, z0.y, z0.z, z0.w, z1.x, z1.y, z1.z, z1.w};
                const float* nwp = (const float*)(p.ws + WS_PK) + PK_NORMW + 16 * g;
                unsigned ow[8];
#pragma unroll
                for (int j = 0; j < 8; ++j) { const float za = __uint_as_float(zz[j] << 16), zb = __uint_as_float(zz[j] & 0xffff0000u);
                    ow[j] = pk2(o[j >> 1][(j & 1) * 2] * rs * nwp[2 * j] * silu_(za), o[j >> 1][(j & 1) * 2 + 1] * rs * nwp[2 * j + 1] * silu_(zb)); }
                const size_t grow = (size_t)b * SEQ + seg * SEGTOK + (cl - 1) * 64 + t;
                bf16_t* oa = (bf16_t*)(p.ws + WS_H) + grow * D + h * 128 + 16 * g;
                *(u32x4*)oa = (u32x4){ow[0], ow[1], ow[2], ow[3]}; *(u32x4*)(oa + 8) = (u32x4){ow[4], ow[5], ow[6], ow[7]};
            }
        }
#pragma unroll
        for (int mt = 0; mt < 8; ++mt) { f32x4 t = {0.f, 0.f, 0.f, 0.f};
#pragma unroll
            for (int ks = 0; ks < 4; ++ks) t = MFMA16(AP[(mt * 4 + ks) * 64 + lane], Bf[ks], t);
            S[mt][0] = egl * S[mt][0] + t[0] + __uint_as_float(kh[mt].x << 16); S[mt][1] = egl * S[mt][1] + t[1] + __uint_as_float(kh[mt].x & 0xffff0000u);
            S[mt][2] = egl * S[mt][2] + t[2] + __uint_as_float(kh[mt].y << 16); S[mt][3] = egl * S[mt][3] + t[3] + __uint_as_float(kh[mt].y & 0xffff0000u); }
    }
#pragma unroll
    for (int mt = 0; mt < 8; ++mt)
#pragma unroll
        for (int r = 0; r < 4; ++r) st[(size_t)(16 * mt + 4 * q4 + r) * 128 + 16 * w + l15] = S[mt][r];
    __syncthreads();
}

constexpr int RL_AT = 0, RL_BT = 9216, RL_KT = 18432, RL_ATT = 27648, RL_RT = 36864, RL_BTLT = 46080, RL_KTLT = 55296, RL_VT = 64512, RL_LAK = 73728, RL_MRB = 82944, RL_MRK = 92160,
              RL_LM = 101376, RL_AF = 117760;
__device__ __forceinline__ void unpack8(const u32x4 rw, float (&x)[8]) {
    x[0] = __uint_as_float(rw.x << 16); x[1] = __uint_as_float(rw.x & 0xffff0000u); x[2] = __uint_as_float(rw.y << 16); x[3] = __uint_as_float(rw.y & 0xffff0000u);
    x[4] = __uint_as_float(rw.z << 16); x[5] = __uint_as_float(rw.z & 0xffff0000u); x[6] = __uint_as_float(rw.w << 16); x[7] = __uint_as_float(rw.w & 0xffff0000u); }
__device__ __forceinline__ u32x4 pack8(const float (&x)[8]) { return (u32x4){pk2(x[0], x[1]), pk2(x[2], x[3]), pk2(x[4], x[5]), pk2(x[6], x[7])}; }

__device__ __forceinline__ void rwkv_prep_item(const Params& p, unsigned char* smem, int hb, int row_start, int npad, int prev_mode, int prow, const float* halo_buf,
                                               float* halo_out, unsigned char* rec) {
    const int tid = otid(), w = tid >> 6, lane = tid & 63, q4 = lane >> 4, l15 = lane & 15;
    bf16_t* At = (bf16_t*)(smem + RL_AT); bf16_t* Tb = At; bf16_t* Bt = (bf16_t*)(smem + RL_BT); bf16_t* WaT = Bt; bf16_t* Kt = (bf16_t*)(smem + RL_KT); bf16_t* XT = Kt;
    bf16_t* AtT = (bf16_t*)(smem + RL_ATT); bf16_t* Rt = (bf16_t*)(smem + RL_RT); bf16_t* BtlT = (bf16_t*)(smem + RL_BTLT); bf16_t* KtlT = (bf16_t*)(smem + RL_KTLT);
    bf16_t* VT = (bf16_t*)(smem + RL_VT); bf16_t* Lak = (bf16_t*)(smem + RL_LAK); bf16_t* Mrb = (bf16_t*)(smem + RL_MRB); bf16_t* Mrk = (bf16_t*)(smem + RL_MRK);
    float* Lm = (float*)(smem + RL_LM);
    bf16_t* thw = Lak; bf16_t* adb = Mrb; float* lc = Lm; float* af = (float*)(smem + RL_AF);
    const bf16_t* P = (const bf16_t*)(p.ws + WS_P);
    const float* pk = (const float*)(p.ws + WS_PK);
    const int t = tid >> 3, g = tid & 7;
    float rr[8], kb[8], vv[8], zb[8];
    {
        const bool real = t >= npad;
        const size_t currow = (size_t)(row_start + t - npad) * NPB;
        bool hasprev = false; const bf16_t* prevp = nullptr;
        if (real) { if (t > npad) { hasprev = true; prevp = P + currow - NPB; } else if (npad == 0 && prev_mode == 1) { hasprev = true; prevp = P + (size_t)prow * NPB; } }
        const bool halo = real && t == 0 && npad == 0 && prev_mode == 2;
        const int secbase[6] = {0, 1024, 2048, 3200, 3072, 3136};
        float m[6][8];
#pragma unroll
        for (int sidx = 0; sidx < 6; ++sidx) {
            const int col = secbase[sidx] + (sidx < 4 ? hb * 64 : 0) + g * 8;
            float cur[8], prv[8];
#pragma unroll
            for (int e = 0; e < 8; ++e) { cur[e] = 0.f; prv[e] = 0.f; }
            if (real) unpack8(*(const u32x4*)(P + currow + C_RW + col), cur);
            if (hasprev) unpack8(*(const u32x4*)(prevp + C_RW + col), prv);
            else if (halo) { const f32x4 a = *(const f32x4*)(halo_buf + col), b2 = *(const f32x4*)(halo_buf + col + 4); prv[0] = a[0]; prv[1] = a[1]; prv[2] = a[2]; prv[3] = a[3]; prv[4] = b2[0]; prv[5] = b2[1]; prv[6] = b2[2]; prv[7] = b2[3]; }
            const f32x4 mu0 = *(const f32x4*)(pk + PK_MU + col), mu1 = *(const f32x4*)(pk + PK_MU + col + 4);
            const float mu[8] = {mu0[0], mu0[1], mu0[2], mu0[3], mu1[0], mu1[1], mu1[2], mu1[3]};
#pragma unroll
            for (int e = 0; e < 8; ++e) m[sidx][e] = real ? cur[e] + mu[e] * (prv[e] - cur[e]) : 0.f;
            if (halo_out && t == 63 && (sidx < 4 || hb == 0)) {
                *(f32x4*)(halo_out + col) = (f32x4){cur[0], cur[1], cur[2], cur[3]}; *(f32x4*)(halo_out + col + 4) = (f32x4){cur[4], cur[5], cur[6], cur[7]}; }
        }
#pragma unroll
        for (int e = 0; e < 8; ++e) { rr[e] = m[0][e]; kb[e] = m[1][e]; vv[e] = m[2][e]; zb[e] = m[3][e]; }
        float th[8];
#pragma unroll
        for (int e = 0; e < 8; ++e) th[e] = tanh_(m[4][e]);
        *(u32x4*)(thw + t * TSTR + g * 8) = pack8(th);
        *(u32x4*)(adb + t * TSTR + g * 8) = pack8(m[5]);
    }
    __syncthreads();
    {
        const int which = w >> 2, ct = w & 3;
        const bf16_t* Wt = (const bf16_t*)(p.ws + (which ? WS_A2T : WS_W2T)) + (size_t)hb * 4096;
        const bf16x8 b0 = *(const bf16x8*)(Wt + (16 * ct + l15) * 64 + 8 * q4), b1 = *(const bf16x8*)(Wt + (16 * ct + l15) * 64 + 32 + 8 * q4);
        const bf16_t* Aarr = which ? adb : thw;
        const int c = 16 * ct + l15;
        const float bias = pk[(which ? PK_A0 : PK_W0) + hb * 64 + c];
        float carry = 0.f;
#pragma unroll
        for (int tt = 0; tt < 4; ++tt) {
            f32x4 acc = {0.f, 0.f, 0.f, 0.f};
            acc = MFMA16(ldfrag(Aarr, TSTR, 16 * tt, 0, lane), b0, acc); acc = MFMA16(ldfrag(Aarr, TSTR, 16 * tt, 32, lane), b1, acc);
            if (which) {
#pragma unroll
                for (int r = 0; r < 4; ++r) af[(16 * tt + 4 * q4 + r) * 64 + c] = sigm(bias + acc[r]);
            } else {
                float wl[4];
#pragma unroll
                for (int r = 0; r < 4; ++r) { const int tk = 16 * tt + 4 * q4 + r; wl[r] = (tk < npad) ? 0.f : -0.6065306597126334f * sigm(bias + acc[r]); }
                wl[1] += wl[0]; wl[2] += wl[1]; wl[3] += wl[2];
                const float Q = wl[3];
                const float Q0 = __shfl(Q, l15), Q1 = __shfl(Q, l15 + 16), Q2 = __shfl(Q, l15 + 32), Q3 = __shfl(Q, l15 + 48);
                const float ex = carry + (q4 > 0 ? Q0 : 0.f) + (q4 > 1 ? Q1 : 0.f) + (q4 > 2 ? Q2 : 0.f);
#pragma unroll
                for (int r = 0; r < 4; ++r) lc[(16 * tt + 4 * q4 + r) * 64 + c] = ex + wl[r];
                carry += Q0 + Q1 + Q2 + Q3;
            }
        }
    }
    __syncthreads();
    {
        float lct[8], lcp[8], lcC[8], av[8];
        { const f32x4 a = *(const f32x4*)(lc + t * 64 + g * 8), b2 = *(const f32x4*)(lc + t * 64 + g * 8 + 4); lct[0] = a[0]; lct[1] = a[1]; lct[2] = a[2]; lct[3] = a[3]; lct[4] = b2[0]; lct[5] = b2[1]; lct[6] = b2[2]; lct[7] = b2[3]; }
        if (t > 0) { const f32x4 a = *(const f32x4*)(lc + (t - 1) * 64 + g * 8), b2 = *(const f32x4*)(lc + (t - 1) * 64 + g * 8 + 4); lcp[0] = a[0]; lcp[1] = a[1]; lcp[2] = a[2]; lcp[3] = a[3]; lcp[4] = b2[0]; lcp[5] = b2[1]; lcp[6] = b2[2]; lcp[7] = b2[3]; }
        else {
#pragma unroll
            for (int e = 0; e < 8; ++e) lcp[e] = 0.f; }
        { const f32x4 a = *(const f32x4*)(lc + 63 * 64 + g * 8), b2 = *(const f32x4*)(lc + 63 * 64 + g * 8 + 4); lcC[0] = a[0]; lcC[1] = a[1]; lcC[2] = a[2]; lcC[3] = a[3]; lcC[4] = b2[0]; lcC[5] = b2[1]; lcC[6] = b2[2]; lcC[7] = b2[3]; }
        { const f32x4 a = *(const f32x4*)(af + t * 64 + g * 8), b2 = *(const f32x4*)(af + t * 64 + g * 8 + 4); av[0] = a[0]; av[1] = a[1]; av[2] = a[2]; av[3] = a[3]; av[4] = b2[0]; av[5] = b2[1]; av[6] = b2[2]; av[7] = b2[3]; }
        const int hc = hb * 64 + g * 8;
        float kk[8], km[8], ss = 0.f, rk = 0.f;
#pragma unroll
        for (int e = 0; e < 8; ++e) { kk[e] = kb[e] * pk[PK_KK + hc + e]; ss += kk[e] * kk[e]; km[e] = kb[e] * (1.f + (av[e] - 1.f) * pk[PK_KA + hc + e]); rk += rr[e] * km[e] * pk[PK_RK + hc + e]; }
        ss += __shfl_xor(ss, 1); ss += __shfl_xor(ss, 2); ss += __shfl_xor(ss, 4);
        rk += __shfl_xor(rk, 1); rk += __shfl_xor(rk, 2); rk += __shfl_xor(rk, 4);
        const float kn = rsqrtf(ss + 1e-6f);
        float xa[8], xb[8], xk[8], xr[8], xbt[8], xkt[8];
#pragma unroll
        for (int e = 0; e < 8; ++e) { kk[e] *= kn; const float ka = kk[e] * av[e]; const float ip = expf(-lct[e]), tl = expf(lcC[e] - lct[e]);
            xa[e] = kk[e] * expf(lcp[e]); xb[e] = ka * ip; xk[e] = km[e] * ip; xr[e] = rr[e] * expf(lct[e]); xbt[e] = ka * tl; xkt[e] = km[e] * tl; }
        *(u32x4*)(At + t * TSTR + g * 8) = pack8(xa); *(u32x4*)(Bt + t * TSTR + g * 8) = pack8(xb); *(u32x4*)(Kt + t * TSTR + g * 8) = pack8(xk); *(u32x4*)(Rt + t * TSTR + g * 8) = pack8(xr);
#pragma unroll
        for (int e = 0; e < 8; ++e) { const int c = g * 8 + e; AtT[c * TSTR + t] = (bf16_t)f2bf(xa[e]); BtlT[c * TSTR + t] = (bf16_t)f2bf(xbt[e]); KtlT[c * TSTR + t] = (bf16_t)f2bf(xkt[e]); VT[c * TSTR + t] = (bf16_t)f2bf(vv[e]); }
        float c1[8], c0[8];
#pragma unroll
        for (int e = 0; e < 8; ++e) { const float sz = silu_(zb[e]); c1[e] = pk[PK_GNW + hc + e] * sz; c0[e] = (pk[PK_GNB + hc + e] + rk * vv[e]) * sz; }
        *(u32x4*)((bf16_t*)(rec + RP_C1) + t * 64 + g * 8) = pack8(c1); *(u32x4*)((bf16_t*)(rec + RP_C0) + t * 64 + g * 8) = pack8(c0);
        if (t == 63) { float* pc = (float*)(rec + RP_PC) + g * 8; *(f32x4*)pc = (f32x4){expf(lcC[0]), expf(lcC[1]), expf(lcC[2]), expf(lcC[3])}; *(f32x4*)(pc + 4) = (f32x4){expf(lcC[4]), expf(lcC[5]), expf(lcC[6]), expf(lcC[7])}; }
    }
    __syncthreads();
    {
        const int pr = w >> 1;
        const bf16_t* Aarr = pr < 2 ? At : Rt; const bf16_t* Barr = (pr & 1) ? Kt : Bt;
#pragma unroll
        for (int x = 0; x < 2; ++x) { const int tt = 2 * (w & 1) + x;
            const bf16x8 a0 = ldfrag(Aarr, TSTR, 16 * tt, 0, lane), a1 = ldfrag(Aarr, TSTR, 16 * tt, 32, lane);
#pragma unroll
            for (int it = 0; it < 4; ++it) { f32x4 acc = {0.f, 0.f, 0.f, 0.f};
                acc = MFMA16(a0, ldfrag(Barr, TSTR, 16 * it, 0, lane), acc); acc = MFMA16(a1, ldfrag(Barr, TSTR, 16 * it, 32, lane), acc);
                const int i = 16 * it + l15;
#pragma unroll
                for (int r = 0; r < 4; ++r) { const int tk = 16 * tt + 4 * q4 + r;
                    if (pr == 0) Lm[tk * 64 + i] = (tk > i) ? acc[r] : 0.f;
                    else if (pr == 1) Lak[tk * TSTR + i] = (bf16_t)f2bf((tk > i) ? acc[r] : 0.f);
                    else if (pr == 2) Mrb[tk * TSTR + i] = (bf16_t)f2bf((tk >= i) ? acc[r] : 0.f);
                    else Mrk[tk * TSTR + i] = (bf16_t)f2bf((tk >= i) ? acc[r] : 0.f); } }
        }
    }
    __syncthreads();
    if (w == 0) {
        float Tr[64];
        inv_lower(Lm, Tr, lane);
#pragma unroll
        for (int i = 0; i < 64; ++i) Tb[i * TSTR + lane] = (bf16_t)f2bf(Tr[i]);
    }
    __syncthreads();
    {
        const int tt = w & 3, which = w >> 2;
        const bf16_t* Aarr = which ? Lak : Tb; const bf16_t* Barr = which ? VT : AtT; bf16_t* Out = which ? XT : WaT;
        const bf16x8 a0 = ldfrag(Aarr, TSTR, 16 * tt, 0, lane), a1 = ldfrag(Aarr, TSTR, 16 * tt, 32, lane);
#pragma unroll
        for (int ct = 0; ct < 4; ++ct) { f32x4 acc = {0.f, 0.f, 0.f, 0.f};
            acc = MFMA16(a0, ldfrag(Barr, TSTR, 16 * ct, 0, lane), acc); acc = MFMA16(a1, ldfrag(Barr, TSTR, 16 * ct, 32, lane), acc);
            *(u32x2*)(Out + (16 * ct + l15) * TSTR + 16 * tt + 4 * q4) = (u32x2){pk2(acc[0], acc[1]), pk2(acc[2], acc[3])}; }
    }
    __syncthreads();
    {
        f32x4 acc[4];
        if (w < 4) {
            const bf16x8 a0 = ldfrag(Tb, TSTR, 16 * w, 0, lane), a1 = ldfrag(Tb, TSTR, 16 * w, 32, lane);
#pragma unroll
            for (int ct = 0; ct < 4; ++ct) { acc[ct] = (f32x4){0.f, 0.f, 0.f, 0.f};
                acc[ct] = MFMA16(a0, ldfrag(XT, TSTR, 16 * ct, 0, lane), acc[ct]); acc[ct] = MFMA16(a1, ldfrag(XT, TSTR, 16 * ct, 32, lane), acc[ct]); }
        }
        __syncthreads();
        if (w < 4) {
#pragma unroll
            for (int ct = 0; ct < 4; ++ct) *(u32x2*)(XT + (16 * ct + l15) * TSTR + 16 * w + 4 * q4) = (u32x2){pk2(-acc[ct][0], -acc[ct][1]), pk2(-acc[ct][2], -acc[ct][3])};
        }
    }
    __syncthreads();
    {
        const bf16_t* UvT = XT;
        bf16_t* gAP = (bf16_t*)(rec + RP_AP); bf16_t* gRH = (bf16_t*)(rec + RP_RH); bf16_t* gKH = (bf16_t*)(rec + RP_KH); bf16_t* gYH = (bf16_t*)(rec + RP_YH);
        const int et = w & 3, part = w >> 2;
        {
            const bf16x8 a0 = ldfrag(WaT, TSTR, 16 * et, 0, lane), a1 = ldfrag(WaT, TSTR, 16 * et, 32, lane);
            if (part == 0) {
#pragma unroll
                for (int kt = 0; kt < 4; ++kt) { f32x4 acc = {0.f, 0.f, 0.f, 0.f};
                    acc = MFMA16(a0, ldfrag(BtlT, TSTR, 16 * kt, 0, lane), acc); acc = MFMA16(a1, ldfrag(BtlT, TSTR, 16 * kt, 32, lane), acc);
                    *(u32x2*)(gAP + ((size_t)(kt * 2 + (et >> 1)) * 64 + lane) * 8 + (et & 1) * 4) = (u32x2){pk2(-acc[0], -acc[1]), pk2(-acc[2], -acc[3])}; }
            } else {
#pragma unroll
                for (int tt = 0; tt < 4; ++tt) { f32x4 acc = {0.f, 0.f, 0.f, 0.f};
                    acc = MFMA16(a0, ldfrag(Mrb, TSTR, 16 * tt, 0, lane), acc); acc = MFMA16(a1, ldfrag(Mrb, TSTR, 16 * tt, 32, lane), acc);
                    const int tk = 16 * tt + l15, e0 = 16 * et + 4 * q4;
                    const u32x2 q2 = *(const u32x2*)(Rt + tk * TSTR + e0);
                    const float o0 = __uint_as_float(q2.x << 16) - acc[0], o1 = __uint_as_float(q2.x & 0xffff0000u) - acc[1], o2 = __uint_as_float(q2.y << 16) - acc[2], o3 = __uint_as_float(q2.y & 0xffff0000u) - acc[3];
                    *(u32x2*)(gRH + ((size_t)(tt * 2 + (et >> 1)) * 64 + lane) * 8 + (et & 1) * 4) = (u32x2){pk2(o0, o1), pk2(o2, o3)}; }
            }
        }
        {
            const int rt = w & 3;
            const bf16_t* A1 = part ? BtlT : Mrb; const bf16_t* A2 = part ? KtlT : Mrk; bf16_t* Out = part ? gKH : gYH;
            const bf16x8 a0 = ldfrag(A1, TSTR, 16 * rt, 0, lane), a1 = ldfrag(A1, TSTR, 16 * rt, 32, lane), a2 = ldfrag(A2, TSTR, 16 * rt, 0, lane), a3 = ldfrag(A2, TSTR, 16 * rt, 32, lane);
#pragma unroll
            for (int vt = 0; vt < 4; ++vt) { f32x4 acc = {0.f, 0.f, 0.f, 0.f};
                acc = MFMA16(a0, ldfrag(UvT, TSTR, 16 * vt, 0, lane), acc); acc = MFMA16(a1, ldfrag(UvT, TSTR, 16 * vt, 32, lane), acc);
                acc = MFMA16(a2, ldfrag(VT, TSTR, 16 * vt, 0, lane), acc); acc = MFMA16(a3, ldfrag(VT, TSTR, 16 * vt, 32, lane), acc);
                *(u32x2*)(Out + ((size_t)(vt * 4 + rt) * 64 + lane) * 4) = (u32x2){pk2(acc[0], acc[1]), pk2(acc[2], acc[3])}; }
        }
    }
    __syncthreads();
}

__device__ __forceinline__ void phase_rprep(const Params& p, int seg, unsigned char* smem) {
    const int blk = obid();
    float* phalo = (float*)(p.ws + WS_PHALO);
    const int n_items = (CPS + (seg == 0 ? 1 : 0)) * 128;
#pragma unroll 1
    for (int it = blk; it < n_items; it += gridDim.x) {
        const int bh = it & 127, b = bh >> 4, hb = bh & 15; int cl = it >> 7; if (seg != 0) cl += 1;
        unsigned char* rec = p.ws + WS_RP + (size_t)(cl * 128 + bh) * RP_STRIDE;
        if (cl == 0) rwkv_prep_item(p, smem, hb, LEX0, 48, 0, 0, nullptr, nullptr, rec);
        else {
            const int row = b * SEGTOK + (cl - 1) * 64;
            int mode = 1, prow = row - 1;
            const float* hbuf = nullptr;
            if (cl == 1) { if (seg == 0) prow = LEX0 + NMETA - 1; else { mode = 2; hbuf = phalo + (size_t)(((seg - 1) & 1) * NBATCH + b) * RW_SHIFT; } }
            float* ho = (cl == CPS) ? phalo + (size_t)((seg & 1) * NBATCH + b) * RW_SHIFT : nullptr;
            rwkv_prep_item(p, smem, hb, row, 0, mode, prow, hbuf, ho, rec);
        }
    }
}

__device__ __forceinline__ void rwkv_scan_block(const Params& p, int seg, unsigned char* smem, int pairidx) {
    const int tid = otid(), w = tid >> 6, lane = tid & 63, q4 = lane >> 4, l15 = lane & 15;
    const int hsel = w >> 2, vt = w & 3;
    const int bh = pairidx * 2 + hsel, b = bh >> 4, hb = bh & 15;
    float* st = p.out + O_RWKV_P + (size_t)bh * 4096;
    f32x4 S[4];
    if (seg) {
#pragma unroll
        for (int mt = 0; mt < 4; ++mt) S[mt] = *(const f32x4*)(st + (size_t)(16 * vt + l15) * 64 + 16 * mt + 4 * q4);
    } else {
#pragma unroll
        for (int mt = 0; mt < 4; ++mt) S[mt] = (f32x4){0.f, 0.f, 0.f, 0.f};
    }
    const int c_lo = seg ? 1 : 0;
    float* ybuf = (float*)(smem + 32768) + hsel * (64 * 68);
#pragma unroll 1
    for (int cl = c_lo; cl <= CPS; ++cl) {
        const unsigned char* rec = p.ws + WS_RP + (size_t)(cl * 128 + bh) * RP_STRIDE;
        __syncthreads();
        {
            const u32x4* src = (const u32x4*)rec; u32x4* dst = (u32x4*)(smem + hsel * 16384); const int tl = tid & 255;
#pragma unroll
            for (int x = 0; x < 4; ++x) dst[tl + 256 * x] = src[tl + 256 * x];
        }
        const bf16_t* gKH = (const bf16_t*)(rec + RP_KH); const bf16_t* gYH = (const bf16_t*)(rec + RP_YH);
        u32x2 kh[4], yh[4]; f32x4 pc[4];
#pragma unroll
        for (int mt = 0; mt < 4; ++mt) { kh[mt] = *(const u32x2*)(gKH + ((size_t)(vt * 4 + mt) * 64 + lane) * 4); yh[mt] = *(const u32x2*)(gYH + ((size_t)(vt * 4 + mt) * 64 + lane) * 4);
            pc[mt] = *(const f32x4*)((const float*)(rec + RP_PC) + 16 * mt + 4 * q4); }
        bf16x8 Bf[2];
#pragma unroll
        for (int ks = 0; ks < 2; ++ks) { u32x4 tq; tq.x = pk2(S[2 * ks][0], S[2 * ks][1]); tq.y = pk2(S[2 * ks][2], S[2 * ks][3]); tq.z = pk2(S[2 * ks + 1][0], S[2 * ks + 1][1]); tq.w = pk2(S[2 * ks + 1][2], S[2 * ks + 1][3]);
            Bf[ks] = __builtin_bit_cast(bf16x8, tq); }
        __syncthreads();
        const bf16x8* AP = (const bf16x8*)(smem + hsel * 16384); const bf16x8* RH = (const bf16x8*)(smem + hsel * 16384 + RP_RH);
        if (cl > 0) {
#pragma unroll
            for (int tt = 0; tt < 4; ++tt) { f32x4 y = {0.f, 0.f, 0.f, 0.f};
                y = MFMA16(RH[(tt * 2 + 0) * 64 + lane], Bf[0], y); y = MFMA16(RH[(tt * 2 + 1) * 64 + lane], Bf[1], y);
                y[0] += __uint_as_float(yh[tt].x << 16); y[1] += __uint_as_float(yh[tt].x & 0xffff0000u); y[2] += __uint_as_float(yh[tt].y << 16); y[3] += __uint_as_float(yh[tt].y & 0xffff0000u);
#pragma unroll
                for (int r = 0; r < 4; ++r) ybuf[(16 * tt + 4 * q4 + r) * 68 + 16 * vt + l15] = y[r]; }
        }
#pragma unroll
        for (int mt = 0; mt < 4; ++mt) { f32x4 tq = {0.f, 0.f, 0.f, 0.f};
            tq = MFMA16(AP[(mt * 2 + 0) * 64 + lane], Bf[0], tq); tq = MFMA16(AP[(mt * 2 + 1) * 64 + lane], Bf[1], tq);
            S[mt][0] = pc[mt][0] * S[mt][0] + tq[0] + __uint_as_float(kh[mt].x << 16); S[mt][1] = pc[mt][1] * S[mt][1] + tq[1] + __uint_as_float(kh[mt].x & 0xffff0000u);
            S[mt][2] = pc[mt][2] * S[mt][2] + tq[2] + __uint_as_float(kh[mt].y << 16); S[mt][3] = pc[mt][3] * S[mt][3] + tq[3] + __uint_as_float(kh[mt].y & 0xffff0000u); }
        if (cl > 0) {
            __syncthreads();
            const int tl = tid & 255, tk = tl >> 2, g = tl & 3;
            f32x4 y[4]; float sm = 0.f;
#pragma unroll
            for (int j = 0; j < 4; ++j) { y[j] = *(const f32x4*)(ybuf + tk * 68 + 16 * g + 4 * j); sm += y[j][0] + y[j][1] + y[j][2] + y[j][3]; }
            sm += __shfl_xor(sm, 1); sm += __shfl_xor(sm, 2);
            const float mu = sm * (1.f / 64.f); float vs = 0.f;
#pragma unroll
            for (int j = 0; j < 4; ++j) { y[j] = y[j] - mu; vs += y[j][0] * y[j][0] + y[j][1] * y[j][1] + y[j][2] * y[j][2] + y[j][3] * y[j][3]; }
            vs += __shfl_xor(vs, 1); vs += __shfl_xor(vs, 2);
            const float rs = rsqrtf(vs * (1.f / 64.f) + 64e-5f);
            const bf16_t* c1p = (const bf16_t*)(rec + RP_C1) + tk * 64 + 16 * g; const bf16_t* c0p = (const bf16_t*)(rec + RP_C0) + tk * 64 + 16 * g;
            const u32x4 a0 = *(const u32x4*)c0p, a1 = *(const u32x4*)(c0p + 8), b0 = *(const u32x4*)c1p, b1 = *(const u32x4*)(c1p + 8);
            const unsigned c0w[8] = {a0.x, a0.y, a0.z, a0.w, a1.x, a1.y, a1.z, a1.w}, c1w[8] = {b0.x, b0.y, b0.z, b0.w, b1.x, b1.y, b1.z, b1.w};
            unsigned ow[8];
#pragma unroll
            for (int j = 0; j < 8; ++j) ow[j] = pk2(y[j >> 1][(j & 1) * 2] * rs * __uint_as_float(c1w[j] << 16) + __uint_as_float(c0w[j] << 16),
                                                     y[j >> 1][(j & 1) * 2 + 1] * rs * __uint_as_float(c1w[j] & 0xffff0000u) + __uint_as_float(c0w[j] & 0xffff0000u));
            const size_t grow = (size_t)b * SEQ + seg * SEGTOK + (cl - 1) * 64 + tk;
            bf16_t* ob = (bf16_t*)(p.ws + WS_OB) + grow * D + hb * 64 + 16 * g;
            *(u32x4*)ob = (u32x4){ow[0], ow[1], ow[2], ow[3]}; *(u32x4*)(ob + 8) = (u32x4){ow[4], ow[5], ow[6], ow[7]};
        }
    }
#pragma unroll
    for (int mt = 0; mt < 4; ++mt) *(f32x4*)(st + (size_t)(16 * vt + l15) * 64 + 16 * mt + 4 * q4) = S[mt];
    __syncthreads();
}

__device__ __forceinline__ void phase2(const Params& p, int seg, unsigned char* smem) {
    const int blk = obid();
    float* out = p.out;
    float* chalo = (float*)(p.ws + WS_CHALO); float* phalo = (float*)(p.ws + WS_PHALO);
#ifndef SUB
#define SUB 0
#endif
#define SEN(x) (SUB == 0 || SUB == (x))
    if (SEN(1) && blk < 64) gdn_scan_block(p, seg, smem, blk);
    if (SEN(3) && blk >= 64 && blk < 128) rwkv_scan_block(p, seg, smem, blk - 64);
#ifndef DUP
#define DUP 0
#endif
    if (SEN(2) && seg == 0) {
#pragma unroll 1
        for (int rep = 0; rep < (DUP == 2 ? 2 : 1); ++rep)
#pragma unroll 1
        for (int it = blk; it < DECB * 32; it += gridDim.x) {
            const int h = it & 7, sl = (it >> 3) & 3, bs = it >> 5;
            gdn_item(p, smem, p.in[2] + (size_t)(bs * 8 + h) * 16384, out + O_GDN_S + (size_t)(bs * 8 + h) * 16384, p.in[3] + (size_t)bs * 9216, out + O_CONV_S + (size_t)bs * 9216,
                     h, sl, 0, 0, LEX0 + EX_SAMP + bs * DECT, DECT);
        }
    }
    if (seg == 0) {
        const int hb = blk & 15, rest = blk >> 4;
        rwkv_load_lora(p, smem, hb);
        if (SEN(4) && seg == 0) {
#pragma unroll 1
            for (int rep = 0; rep < (DUP == 2 ? 2 : 1); ++rep)
#pragma unroll 1
            for (int j = 0; j < 16; ++j) {
                const int idx = rest * 16 + j, bs = idx >> 1, half = idx & 1;
                const bf16_t* prow = (const bf16_t*)(p.ws + WS_P) + (size_t)(LEX0 + EX_SHIFT + bs) * NPB;
                rwkv_item(p, smem, p.in[4] + (size_t)(bs * 16 + hb) * 4096, out + O_RWKV_S + (size_t)(bs * 16 + hb) * 4096, prow, nullptr, nullptr, hb, half, 0, 0, LEX0 + EX_SAMP + bs * DECT, DECT);
            }
        }
    }
}

__device__ __forceinline__ void phase25(const Params& p, int seg) {
    const int tid0 = otid(); const int lane = tid0 & 63; const int gw = obid() * 8 + (tid0 >> 6), NGW = gridDim.x * 8;
    const bf16_t* P = (const bf16_t*)(p.ws + WS_P);
    const float* ORAW = (const float*)(p.ws + WS_ORAW); const float* YRAW = (const float*)(p.ws + WS_YRAW);
    const bf16_t* C0 = (const bf16_t*)(p.ws + WS_C0); const bf16_t* C1 = (const bf16_t*)(p.ws + WS_C1);
    bf16_t* OA = (bf16_t*)(p.ws + WS_H); bf16_t* OB = (bf16_t*)(p.ws + WS_OB);
    const int nrows = LEX0 + (seg == 0 ? DECB * DECT : 0);
    const int c = lane * 16;
    f32x4 nw[4];
#pragma unroll
    for (int j = 0; j < 4; ++j) nw[j] = *(const f32x4*)((const float*)(p.ws + WS_PK) + PK_NORMW + (c & 127) + 4 * j);
#pragma unroll 1
    for (int rr = LEX0 + gw; rr < nrows; rr += NGW) {
        int lr; size_t grow;
        if (rr < LEX0) { lr = rr; grow = (size_t)(rr / SEGTOK) * SEQ + seg * SEGTOK + (rr % SEGTOK); } else { lr = LEX0 + EX_SAMP + (rr - LEX0); grow = (size_t)XROWS + EX_SAMP + (rr - LEX0); }
        {
            f32x4 o[4]; float ss = 0.f;
#pragma unroll
            for (int j = 0; j < 4; ++j) { o[j] = *(const f32x4*)(ORAW + (size_t)lr * D + c + 4 * j); ss += o[j][0] * o[j][0] + o[j][1] * o[j][1] + o[j][2] * o[j][2] + o[j][3] * o[j][3]; }
            ss += __shfl_xor(ss, 1); ss += __shfl_xor(ss, 2); ss += __shfl_xor(ss, 4);
            const float rs = rsqrtf(ss * (1.f / 128.f) + 1e-6f);
            const u32x4 z0 = *(const u32x4*)(P + (size_t)lr * NPB + C_Z + c), z1 = *(const u32x4*)(P + (size_t)lr * NPB + C_Z + c + 8);
            const unsigned zz[8] = {z0.x, z0.y, z0.z, z0.w, z1.x, z1.y, z1.z, z1.w};
            unsigned ow[8];
#pragma unroll
            for (int j = 0; j < 8; ++j) { const float za = __uint_as_float(zz[j] << 16), zb = __uint_as_float(zz[j] & 0xffff0000u);
                const float a = o[j >> 1][(j & 1) * 2] * rs * nw[j >> 1][(j & 1) * 2] * silu_(za), b = o[j >> 1][(j & 1) * 2 + 1] * rs * nw[j >> 1][(j & 1) * 2 + 1] * silu_(zb);
                ow[j] = pk2(a, b); }
            *(u32x4*)(OA + grow * D + c) = (u32x4){ow[0], ow[1], ow[2], ow[3]}; *(u32x4*)(OA + grow * D + c + 8) = (u32x4){ow[4], ow[5], ow[6], ow[7]};
        }
        {
            f32x4 y[4]; float sm = 0.f;
#pragma unroll
            for (int j = 0; j < 4; ++j) { y[j] = *(const f32x4*)(YRAW + (size_t)lr * D + c + 4 * j); sm += y[j][0] + y[j][1] + y[j][2] + y[j][3]; }
            sm += __shfl_xor(sm, 1); sm += __shfl_xor(sm, 2);
            const float mu = sm * (1.f / 64.f); float vs = 0.f;
#pragma unroll
            for (int j = 0; j < 4; ++j) { y[j] = y[j] - mu; vs += y[j][0] * y[j][0] + y[j][1] * y[j][1] + y[j][2] * y[j][2] + y[j][3] * y[j][3]; }
            vs += __shfl_xor(vs, 1); vs += __shfl_xor(vs, 2);
            const float rs = rsqrtf(vs * (1.f / 64.f) + 64e-5f);
            const u32x4 a0 = *(const u32x4*)(C0 + (size_t)lr * D + c), a1 = *(const u32x4*)(C0 + (size_t)lr * D + c + 8);
            const u32x4 b0 = *(const u32x4*)(C1 + (size_t)lr * D + c), b1 = *(const u32x4*)(C1 + (size_t)lr * D + c + 8);
            const unsigned c0w[8] = {a0.x, a0.y, a0.z, a0.w, a1.x, a1.y, a1.z, a1.w}, c1w[8] = {b0.x, b0.y, b0.z, b0.w, b1.x, b1.y, b1.z, b1.w};
            unsigned ow[8];
#pragma unroll
            for (int j = 0; j < 8; ++j) {
                const float a = y[j >> 1][(j & 1) * 2] * rs * __uint_as_float(c1w[j] << 16) + __uint_as_float(c0w[j] << 16);
                const float b = y[j >> 1][(j & 1) * 2 + 1] * rs * __uint_as_float(c1w[j] & 0xffff0000u) + __uint_as_float(c0w[j] & 0xffff0000u);
                ow[j] = pk2(a, b); }
            *(u32x4*)(OB + grow * D + c) = (u32x4){ow[0], ow[1], ow[2], ow[3]}; *(u32x4*)(OB + grow * D + c + 8) = (u32x4){ow[4], ow[5], ow[6], ow[7]};
        }
    }
}

__device__ __forceinline__ void phase_final(const Params& p) {
    const int tid0 = otid(); const int lane = tid0 & 63; const int gw = obid() * 8 + (tid0 >> 6), NGW = gridDim.x * 8;
    const f32x4* wr = (const f32x4*)((const float*)(p.ws + WS_PK) + PK_LNF) + lane;
#pragma unroll 1
    for (int r = gw; r < XROWS + DECB * DECT; r += NGW) {
        f32x4* xr = (f32x4*)(p.out + (size_t)r * D) + lane;
        f32x4 v[4]; float ss = 0.f;
#pragma unroll
        for (int j = 0; j < 4; ++j) { v[j] = xr[64 * j]; ss += v[j][0] * v[j][0] + v[j][1] * v[j][1] + v[j][2] * v[j][2] + v[j][3] * v[j][3]; }
        const float rs = rsqrtf(wave_sum(ss) * (1.f / D) + 1e-6f);
#pragma unroll
        for (int j = 0; j < 4; ++j) xr[64 * j] = v[j] * rs * wr[64 * j];
    }
}

__global__ __launch_bounds__(512, 2) void hybrid_mega(Params p) {
    extern __shared__ __attribute__((aligned(16))) unsigned char smem[];
    cg::grid_group grid = cg::this_grid();
    LAS unsigned char* lds = (LAS unsigned char*)smem;
    const int G = gridDim.x;
    volatile LAS unsigned* xst = (volatile LAS unsigned*)(lds + (LDS_TOTAL - 16));
    if (threadIdx.x == 0) { xst[0] = 0u; xst[1] = 0u; }
    __syncthreads();
    (void)xcd_barrier_post((unsigned*)(p.ws + WS_BAR), xst);
    if (G == 0x7fffffff) grid.sync();
#define GSYNC() do { XcdBarrier xb_; xb_.bar = (unsigned*)(p.ws + WS_BAR); xb_.x = xb_xcc_id(); xb_.st = (volatile LAS unsigned*)((LAS unsigned char*)smem + (LDS_TOTAL - 16)); xcd_barrier(xb_); } while (0)

#ifndef ONLY
#define ONLY 0
#endif
#define EN(x) (ONLY == 0 || ONLY == (x))
    if (EN(1)) phase0(p, smem);
    GSYNC();
#pragma unroll 1
    for (int seg = 0; seg < NSEG; ++seg) {
#pragma unroll 1
        for (int rep = 0; rep < (DUP == 3 ? 2 : 1); ++rep)
        if (EN(2)) {
            SchedIn S; S.ob.init(seg == 0 ? LT_PROMPT + 3 : LT_PROMPT, NT_IN, G, obid()); S.seg = seg; S.A = (const char*)(p.ws + WS_H); S.B = (const char*)(p.ws + WS_WT_IN);
            EpiIn E; E.P = (bf16_t*)(p.ws + WS_P); E.gex = (bf16_t*)(p.ws + WS_GEX); E.out = p.out; E.seg = seg;
            pg8::gemm_phase<EpiIn, SchedIn>(lds, D, S, E);
        }
        GSYNC();
#pragma unroll 1
        for (int rep = 0; rep < (DUP == 3 ? 2 : 1); ++rep)
        if (EN(8)) { phase_gprep(p, seg, smem); phase_rprep(p, seg, smem); }
        GSYNC();
        if (EN(3)) phase2(p, seg, smem);
        GSYNC();
        if (seg == 0) {
            if (EN(4)) phase25(p, seg);
            GSYNC();
        }
    }
    if (EN(5)) {
        SchedAB S; S.ob.init(HTILES, 4, G, obid()); S.A0 = (const char*)(p.ws + WS_H); S.A1 = (const char*)(p.ws + WS_OB); S.B0 = (const char*)(p.ws + WS_WT_A); S.B1 = (const char*)(p.ws + WS_WT_B);
        EpiAB E; E.tmp = (float*)(p.ws + WS_P); E.merged = (bf16_t*)(p.ws + WS_MG); E.gex = (const bf16_t*)(p.ws + WS_GEX); E.out = p.out;
        pg8::gemm_phase<EpiAB, SchedAB>(lds, D, S, E);
    }
    GSYNC();
    if (EN(6)) {
        SchedO S; S.ob.init(HTILES, 4, G, obid()); S.A = (const char*)(p.ws + WS_MG); S.B = (const char*)(p.ws + WS_WT_O);
        EpiO E; E.out = p.out; E.xp = p.in[0]; E.xs = p.in[1];
        pg8::gemm_phase<EpiO, SchedO>(lds, D, S, E);
    }
    GSYNC();
    if (EN(7)) phase_final(p);
}

extern "C" void kernel_launch(void* const* d_in, const int* in_sizes, int n_in, void* d_out, int out_size, void* d_ws, size_t ws_size, hipStream_t stream) {
    static int grid_blocks = 0;
    constexpr int LDS_BYTES = LDS_TOTAL;
    if (grid_blocks == 0) {
        if (n_in != 27 || ws_size < WS_END) { fprintf(stderr, "kernel_launch: unexpected n_in %d / ws %zu (need %zu)\n", n_in, ws_size, (size_t)WS_END); grid_blocks = -1; return; }
        if (hipFuncSetAttribute((const void*)hybrid_mega, hipFuncAttributeMaxDynamicSharedMemorySize, LDS_BYTES) != hipSuccess) { fprintf(stderr, "kernel_launch: hipFuncSetAttribute failed\n"); grid_blocks = -1; return; }
        int dev = 0, cus = 0, per_cu = 0;
        hipGetDevice(&dev);
        hipDeviceGetAttribute(&cus, hipDeviceAttributeMultiprocessorCount, dev);
        hipOccupancyMaxActiveBlocksPerMultiprocessor(&per_cu, (const void*)hybrid_mega, 512, LDS_BYTES);
        if (per_cu < 1) { fprintf(stderr, "kernel_launch: occupancy query says %d blocks/CU\n", per_cu); per_cu = 1; }
        (void)hipGetLastError();
        grid_blocks = cus;
    }
    if (grid_blocks < 0) return;
    Params p{};
    for (int i = 0; i < 27; ++i) p.in[i] = (const float*)d_in[i];
    p.out = (float*)d_out; p.ws = (unsigned char*)d_ws;
    if (hipMemsetAsync((unsigned char*)d_ws + WS_BAR, 0, 16384, stream) != hipSuccess) { fprintf(stderr, "kernel_launch: memset of the barrier words failed\n"); return; }
    void* args[] = {&p};
    hipError_t e = hipLaunchCooperativeKernel((const void*)hybrid_mega, dim3(grid_blocks), dim3(512), args, LDS_BYTES, stream);
    if (e != hipSuccess) fprintf(stderr, "cooperative launch failed: %s (grid %d)\n", hipGetErrorString(e), grid_blocks);
}
```

```cpp
#include <hip/hip_runtime.h>
#include <hip/hip_cooperative_groups.h>
#include <cstdio>
namespace cg = cooperative_groups;

#define LAS __attribute__((address_space(3)))
typedef unsigned short bf16_t;
typedef short bf16x8 __attribute__((ext_vector_type(8)));
typedef float f32x4 __attribute__((ext_vector_type(4)));
typedef unsigned u32x4 __attribute__((ext_vector_type(4)));
typedef unsigned u32x2 __attribute__((ext_vector_type(2)));

constexpr int D = 1024;
constexpr int NBATCH = 8, SEQ = 2048, NMETA = 16, DECB = 128, DECT = 4;
constexpr int XROWS = NBATCH * SEQ;
constexpr int EX_SAMP = 16, EX_SHIFT = 528, EX_END = 656;
constexpr int HROWS = 17152, HTILES = 67;
constexpr int NSEG = 8, SEGTOK = SEQ / NSEG;
constexpr int CPS = SEGTOK / 64;
constexpr int TPB = SEGTOK / 256;
constexpr int LT_PROMPT = NBATCH * TPB;
constexpr int LEX0 = LT_PROMPT * 256;
constexpr int LROWS = LEX0 + 768;
constexpr int NP = 10496, NPB = 8448, NT_IN = 41, NT_PB = 33;
constexpr int C_A = 3072, C_B = 3080, C_Z = 3088, C_RW = 4112, C_GATE_REF = 8336;
constexpr int RW_SHIFT = 4224;

constexpr size_t O_YP = 0, O_YS = 16777216, O_GDN_P = 17301504, O_CONV_P = 18350080, O_RWKV_P = 18423808, O_SHIFT_P = 18948096,
                 O_GDN_S = 18956288, O_CONV_S = 35733504, O_RWKV_S = 36913152, O_SHIFT_S = 45301760;

constexpr size_t al256(size_t x) { return (x + 255) & ~(size_t)255; }
constexpr size_t WS_WT_IN = 0;
constexpr size_t WS_WT_A = al256(WS_WT_IN + (size_t)NP * D * 2);
constexpr size_t WS_WT_B = al256(WS_WT_A + (size_t)D * D * 2);
constexpr size_t WS_WT_O = al256(WS_WT_B + (size_t)D * D * 2);
constexpr size_t WS_H = al256(WS_WT_O + (size_t)D * D * 2);
constexpr size_t WS_OB = al256(WS_H + (size_t)HROWS * D * 2);
constexpr size_t WS_P = al256(WS_OB + (size_t)HROWS * D * 2);
constexpr size_t WS_ORAW = al256(WS_P + (size_t)LROWS * NPB * 2);
constexpr size_t WS_YRAW = al256(WS_ORAW + (size_t)LROWS * D * 4);
constexpr size_t WS_C0 = al256(WS_YRAW + (size_t)LROWS * D * 4);
constexpr size_t WS_C1 = al256(WS_C0 + (size_t)LROWS * D * 2);
constexpr size_t WS_GEX = al256(WS_C1 + (size_t)LROWS * D * 2);
constexpr size_t WS_CHALO = al256(WS_GEX + (size_t)768 * 2048 * 2);
constexpr size_t WS_PHALO = al256(WS_CHALO + (size_t)2 * NBATCH * 3 * NPB * 2);
constexpr size_t WS_PK = al256(WS_PHALO + (size_t)2 * NBATCH * NPB * 2);
constexpr int PK_CONVW = 0, PK_ALOG = 12288, PK_DTB = 12296, PK_NORMW = 12304, PK_MU = 12432, PK_W0 = 16656, PK_W2 = 17680, PK_A0 = 83216, PK_A2 = 84240,
              PK_KK = 149776, PK_KA = 150800, PK_RK = 151824, PK_GNW = 152848, PK_GNB = 153872, PK_LNF = 154896, PK_END = 155920;
constexpr size_t WS_BAR = al256(WS_PK + (size_t)PK_END * 4);
constexpr size_t WS_W2T = al256(WS_BAR + 16384);
constexpr size_t WS_A2T = al256(WS_W2T + 131072);
constexpr size_t WS_GP = al256(WS_A2T + 131072);
constexpr int GP_AP = 0, GP_QH = 32768, GP_KH = 49152, GP_OH = 81920, GP_EGL = 98304, GP_STRIDE = 98560;
constexpr int RP_AP = 0, RP_RH = 8192, RP_KH = 16384, RP_YH = 24576, RP_C1 = 32768, RP_C0 = 40960, RP_PC = 49152, RP_STRIDE = 49408;
constexpr size_t WS_RP = al256(WS_GP + (size_t)(CPS + 1) * 64 * GP_STRIDE);
constexpr size_t WS_END = al256(WS_RP + (size_t)(CPS + 1) * 128 * RP_STRIDE);
constexpr size_t WS_MG = WS_GP;
static_assert((size_t)HROWS * D * 2 <= WS_END - WS_GP, "MERGED must fit in the prep records");
static_assert((size_t)HROWS * D * 4 <= (size_t)LROWS * NPB * 2 + 2 * (size_t)LROWS * D * 4, "TMP must fit in P+ORAW+YRAW");
static_assert(WS_END <= (size_t)268435456, "workspace");

constexpr int LDS_TOTAL = 163840;
struct Params { const float* in[27]; float* out; unsigned char* ws; };

__device__ __forceinline__ float bf2f(bf16_t v) { return __uint_as_float(((unsigned)v) << 16); }
typedef __bf16 bf16n2 __attribute__((ext_vector_type(2)));
typedef float f32n2 __attribute__((ext_vector_type(2)));
__device__ __forceinline__ unsigned cvt_pk_bf16(float lo, float hi) { const f32n2 v = {lo, hi}; return __builtin_bit_cast(unsigned, __builtin_convertvector(v, bf16n2)); }
__device__ __forceinline__ unsigned pk2(float lo, float hi) { return cvt_pk_bf16(lo, hi); }
__device__ __forceinline__ unsigned f2bf(float f) { return cvt_pk_bf16(f, 0.f) & 0xffffu; }
__device__ __forceinline__ float sigm(float x) { return 1.f / (1.f + __expf(-x)); }
__device__ __forceinline__ float silu_(float x) { return x / (1.f + __expf(-x)); }
__device__ __forceinline__ float softplus_(float x) { return fmaxf(x, 0.f) + log1pf(expf(-fabsf(x))); }
__device__ __forceinline__ float wave_sum(float v) {
#pragma unroll
    for (int o = 1; o < 64; o <<= 1) v += __shfl_xor(v, o);
    return v;
}
__device__ __forceinline__ int otid() { int t = threadIdx.x; asm volatile("" : "+v"(t)); return t; }
__device__ __forceinline__ int obid() { int t = blockIdx.x; asm volatile("" : "+s"(t)); return t; }
__device__ __forceinline__ float tanh_(float x) { const float e = __expf(2.f * x); return 1.f - 2.f / (e + 1.f); }
template <int CTRL> __device__ __forceinline__ float dppf(float x) { return __builtin_bit_cast(float, __builtin_amdgcn_mov_dpp(__builtin_bit_cast(int, x), CTRL, 0xf, 0xf, true)); }
__device__ __forceinline__ float rowsum16(float x) { x += dppf<0x128>(x); x += dppf<0x124>(x); x += dppf<0x122>(x); x += dppf<0x121>(x); return x; }


#define XB_TMO      128
#define XB_XCNT(j)  (256  + 64 * (j))
#define XB_XSUB(j)  (1280 + 64 * (j))
#define XB_XGEN(j)  (2304 + 64 * (j))
#define XB_TOP      3328
#define XB_TOPGEN   3392
#define XCD_BAR_WORDS 3456
#define XB_SPIN_CAP (1u << 22)
__device__ __forceinline__ unsigned xb_ld(unsigned* p)              { return __hip_atomic_load(p, __ATOMIC_RELAXED, __HIP_MEMORY_SCOPE_AGENT); }
__device__ __forceinline__ unsigned xb_add(unsigned* p, unsigned v) { return __hip_atomic_fetch_add(p, v, __ATOMIC_RELAXED, __HIP_MEMORY_SCOPE_AGENT); }
__device__ __forceinline__ unsigned xb_xcc_id() { return (unsigned)__builtin_amdgcn_s_getreg((3 << 11) | 20) & 0xFu; }
#define XB_SPIN(cond, bar) do { unsigned _sp = 0; while (cond) { __builtin_amdgcn_s_sleep(1); \
    if ((++_sp & 255u) == 0u) { if (xb_ld(&(bar)[XB_TMO])) break; if (_sp > XB_SPIN_CAP) { atomicAdd(&(bar)[XB_TMO], 1u); break; } } } } while (0)
struct XcdBarrier { unsigned* bar; unsigned x; volatile LAS unsigned* st; };
__device__ __forceinline__ XcdBarrier xcd_barrier_post(unsigned* bar, volatile LAS unsigned* st) {
    XcdBarrier b; b.bar = bar; b.x = xb_xcc_id(); b.st = st;
    if (threadIdx.x == 0) (void)xb_add(&bar[XB_XCNT(b.x)], 1u);
    return b;
}
__device__ __forceinline__ void xcd_barrier_complete(unsigned* bar, unsigned x, unsigned& nloc, unsigned& nx) {
    const unsigned G = gridDim.x * gridDim.y * gridDim.z;
    unsigned sum, cnt, mine, sp = 0u;
    for (;;) {
        sum = 0u; cnt = 0u; mine = 0u;
#pragma unroll
        for (unsigned j = 0; j < 16; ++j) { const unsigned c = xb_ld(&bar[XB_XCNT(j)]); sum += c; cnt += (c > 0u) ? 1u : 0u; mine = (j == x) ? c : mine; }
        if (sum == G) break;
        __builtin_amdgcn_s_sleep(1);
        if ((++sp & 255u) == 0u) { if (xb_ld(&bar[XB_TMO])) break; if (sp > XB_SPIN_CAP) { atomicAdd(&bar[XB_TMO], 1u); break; } }
    }
    nloc = mine > 0u ? mine : 1u; nx = cnt > 0u ? cnt : 1u;
}
__device__ __forceinline__ void xcd_barrier(const XcdBarrier& b) {
    asm volatile("s_waitcnt vmcnt(0)" ::: "memory");
    __syncthreads();
    if (threadIdx.x == 0) {
        unsigned* bar = b.bar;
        __builtin_amdgcn_s_waitcnt(0);
        unsigned nloc = b.st[0], nx = b.st[1];
        if (nloc == 0u) { xcd_barrier_complete(bar, b.x, nloc, nx); b.st[0] = nloc; b.st[1] = nx; }
        const unsigned old = xb_add(&bar[XB_XSUB(b.x)], 1u);
        const unsigned gen = old / nloc;
        if (old + 1u == (gen + 1u) * nloc) {
            __builtin_amdgcn_fence(__ATOMIC_RELEASE, "agent");
            asm volatile("s_waitcnt vmcnt(0)" ::: "memory");
            const unsigned og = xb_add(&bar[XB_TOP], 1u);
            const unsigned tg = og / nx;
            if (og + 1u == (tg + 1u) * nx) xb_add(&bar[XB_TOPGEN], 1u);
            else XB_SPIN(xb_ld(&bar[XB_TOPGEN]) == tg, bar);
            __builtin_amdgcn_fence(__ATOMIC_ACQUIRE, "agent");
            xb_add(&bar[XB_XGEN(b.x)], 1u);
            asm volatile("s_waitcnt vmcnt(0)" ::: "memory");
        } else {
            XB_SPIN(xb_ld(&bar[XB_XGEN(b.x)]) == gen, bar);
            __builtin_amdgcn_fence(__ATOMIC_ACQUIRE, "agent");
            asm volatile("s_waitcnt vmcnt(0)" ::: "memory");
        }
    }
    __syncthreads();
}

namespace pg8 {
constexpr int BM = 256, BK = 64, HALF = 128, HTB = HALF * BK * 2, STAGE_BYTES = 8 * HTB, NXCD = 8, WGM = 8;
__device__ __forceinline__ int lds_byte(int r, int c) { const int st = (r >> 4) * 2 + (c >> 5), rr = r & 15, cc = c & 31, ob = rr * 64 + cc * 2; return st * 1024 + (ob ^ (((ob >> 9) & 1) << 5)); }
__device__ __forceinline__ void stage_rc(int b, int& R, int& C) { const int st = b / 1024, sb = b % 1024, swz = sb ^ (((sb >> 9) & 1) << 5); R = (st >> 1) * 16 + swz / 64; C = (st & 1) * 32 + (swz % 64) / 2; }
__device__ __forceinline__ int perm32(int rho) { const int n = rho >> 4, i = rho & 15; return 8 * (i >> 2) + 4 * n + (i & 3); }

struct Unit { int pm, pn, w; };
struct OrderBase {
    int nM, nN, nwg, G, c;
    __device__ void init(int nM_, int nN_, int G_, int c_) { nM = nM_; nN = nN_; nwg = nM * nN; G = G_; c = c_; }
    __device__ bool nextb(int i, Unit& u) const {
        const long L = (long)i * G + c; if (L >= nwg) return false;
        int wgid = (int)L; { const int q = nwg / NXCD, r = nwg % NXCD, xcd = wgid % NXCD, off = wgid / NXCD; wgid = (xcd < r ? xcd * (q + 1) : r * (q + 1) + (xcd - r) * q) + off; }
        const int nig = WGM * nN, gid = wgid / nig, fm = gid * WGM, gsz = (nM - fm) < WGM ? (nM - fm) : WGM;
        u.pm = fm + ((wgid % nig) % gsz); u.pn = (wgid % nig) / gsz; u.w = 0; return true;
    }
};

template <class Epi, class Sched>
__device__ __forceinline__ void gemm_phase(LAS unsigned char* lds, const int K, const Sched& S, const Epi& E) {
    const int tid = otid(), wid = __builtin_amdgcn_readfirstlane(tid >> 6), lane = tid & 63, wr = wid >> 2, wc = wid & 3, fr = lane & 15, fq = lane >> 4;
    const int nt = K / BK;
    unsigned voffA[2], voffB[2];
#pragma unroll
    for (int i = 0; i < 2; ++i) { int R, C; stage_rc(tid * 16 + i * 8192, R, C); const int Rb = Epi::PERM ? ((R & ~31) + perm32(R & 31)) : R;
        voffA[i] = (unsigned)(R * K + C) * 2u; voffB[i] = (unsigned)(Rb * K + C) * 2u; }
    const size_t kstep = (size_t)(BK * 2);
    const size_t hstep = (size_t)HALF * K * 2;
    const unsigned ldsw = (unsigned)wid * 1024u;
    const int aoff = lds_byte(wr * 64 + fr, fq * 8), boff = lds_byte(wc * 32 + fr, fq * 8);
#define PG8_SA(b, h) (((b) * 2 + (h)) * HTB)
#define PG8_SB(b, h) ((4 + (b) * 2 + (h)) * HTB)
#define PG8_STAGE(bufoff, gbase, voff) do { _Pragma("unroll") for (int _i = 0; _i < 2; ++_i) \
        __builtin_amdgcn_global_load_lds((const unsigned*)((const char*)(gbase) + (voff)[_i]), (LAS unsigned*)(lds + (bufoff) + ldsw + _i * 8192), 16, 0, 0); } while (0)
#define PG8_LDA(dst, b, h) do { _Pragma("unroll") for (int m = 0; m < 4; ++m) _Pragma("unroll") for (int k = 0; k < 2; ++k) dst[m][k] = *(const LAS bf16x8*)(lds + PG8_SA(b, h) + aoff + m * 2048 + k * 1024); } while (0)
#define PG8_LDB(dst, b, h) do { _Pragma("unroll") for (int n = 0; n < 2; ++n) _Pragma("unroll") for (int k = 0; k < 2; ++k) dst[n][k] = *(const LAS bf16x8*)(lds + PG8_SB(b, h) + boff + n * 2048 + k * 1024); } while (0)
#define PG8_MMA(ai, bj, At, Bt) do { __builtin_amdgcn_s_setprio(1); _Pragma("unroll") for (int m = 0; m < 4; ++m) _Pragma("unroll") for (int n = 0; n < 2; ++n) _Pragma("unroll") for (int k = 0; k < 2; ++k) \
        acc[ai][bj][m][n] = __builtin_amdgcn_mfma_f32_16x16x32_bf16(Bt[n][k], At[m][k], acc[ai][bj][m][n], 0, 0, 0); __builtin_amdgcn_s_setprio(0); } while (0)
#define PG8_WAIT_V(n) asm volatile("s_waitcnt vmcnt(" #n ")" ::: "memory")
#define PG8_WAIT_L(n) asm volatile("s_waitcnt lgkmcnt(" #n ")" ::: "memory")
#define PG8_BAR __builtin_amdgcn_s_barrier()
#define PG8_SCHED __builtin_amdgcn_sched_barrier(0)
    Unit cur, nxt; int ui = 0;
    if (!S.next(0, cur)) return;
    f32x4 acc[2][2][4][2];
#pragma unroll
    for (int a = 0; a < 2; ++a)
#pragma unroll
        for (int b = 0; b < 2; ++b)
#pragma unroll
            for (int m = 0; m < 4; ++m)
#pragma unroll
                for (int n = 0; n < 2; ++n) acc[a][b][m][n] = (f32x4){0.f, 0.f, 0.f, 0.f};
    bf16x8 At[4][2], B0[2][2], B1[2][2];
    const char* cA = S.a_ptr(cur); const char* cB = S.b_ptr(cur);
    PG8_STAGE(PG8_SB(0, 0), cB, voffB); PG8_STAGE(PG8_SA(0, 0), cA, voffA); PG8_STAGE(PG8_SB(0, 1), cB + hstep, voffB); PG8_STAGE(PG8_SA(0, 1), cA + hstep, voffA);
    if (wr == 1) PG8_BAR;
    PG8_WAIT_V(4); PG8_BAR;
    PG8_STAGE(PG8_SB(1, 0), cB + kstep, voffB); PG8_STAGE(PG8_SA(1, 0), cA + kstep, voffA); PG8_STAGE(PG8_SB(1, 1), cB + hstep + kstep, voffB);
    PG8_WAIT_V(6); PG8_BAR;
    for (;;) {
        const bool has_next = S.next(ui + 1, nxt);
        const char* nA = has_next ? S.a_ptr(nxt) : cA; const char* nB = has_next ? S.b_ptr(nxt) : cB;
        for (int t = 0; t < nt; t += 2) {
            const bool last = (t == nt - 2);
            const char* a1 = cA + (size_t)(t + 1) * kstep;
            const char* a2 = last ? nA : cA + (size_t)(t + 2) * kstep; const char* b2 = last ? nB : cB + (size_t)(t + 2) * kstep;
            const char* a3 = a2 + kstep; const char* b3 = b2 + kstep;
            PG8_LDB(B0, 0, 0); PG8_SCHED; PG8_LDA(At, 0, 0); PG8_STAGE(PG8_SA(1, 1), a1 + hstep, voffA);
            PG8_WAIT_L(8); PG8_BAR; PG8_WAIT_L(0); PG8_MMA(0, 0, At, B0); PG8_BAR; PG8_SCHED;
            PG8_LDB(B1, 0, 1); PG8_STAGE(PG8_SB(0, 0), b2, voffB);
            PG8_BAR; PG8_WAIT_L(0); PG8_MMA(0, 1, At, B1); PG8_BAR;
            PG8_LDA(At, 0, 1); PG8_STAGE(PG8_SA(0, 0), a2, voffA);
            PG8_BAR; PG8_WAIT_L(0); PG8_MMA(1, 0, At, B0); PG8_BAR; PG8_SCHED;
            PG8_STAGE(PG8_SB(0, 1), b2 + hstep, voffB);
            PG8_WAIT_V(6); PG8_BAR; PG8_MMA(1, 1, At, B1); PG8_BAR;
            PG8_LDB(B0, 1, 0); PG8_SCHED; PG8_LDA(At, 1, 0); PG8_STAGE(PG8_SA(0, 1), a2 + hstep, voffA);
            PG8_WAIT_L(8); PG8_BAR; PG8_WAIT_L(0); PG8_MMA(0, 0, At, B0); PG8_BAR; PG8_SCHED;
            PG8_LDB(B1, 1, 1); PG8_STAGE(PG8_SB(1, 0), b3, voffB);
            PG8_BAR; PG8_WAIT_L(0); PG8_MMA(0, 1, At, B1); PG8_BAR;
            PG8_LDA(At, 1, 1); PG8_STAGE(PG8_SA(1, 0), a3, voffA);
            PG8_BAR; PG8_WAIT_L(0); PG8_MMA(1, 0, At, B0); PG8_BAR; PG8_SCHED;
            PG8_STAGE(PG8_SB(1, 1), b3 + hstep, voffB);
            PG8_WAIT_V(6); PG8_BAR; PG8_MMA(1, 1, At, B1); PG8_BAR;
        }
        E(acc, cur, wr, wc, fr, fq);
        if (!has_next) break;
#pragma unroll
        for (int a = 0; a < 2; ++a)
#pragma unroll
            for (int b = 0; b < 2; ++b)
#pragma unroll
                for (int m = 0; m < 4; ++m)
#pragma unroll
                    for (int n = 0; n < 2; ++n) acc[a][b][m][n] = (f32x4){0.f, 0.f, 0.f, 0.f};
        cur = nxt; cA = nA; cB = nB; ++ui;
    }
    PG8_WAIT_V(0);
    if (wr == 0) PG8_BAR;
    PG8_BAR;
#undef PG8_SA
#undef PG8_SB
#undef PG8_STAGE
#undef PG8_LDA
#undef PG8_LDB
#undef PG8_MMA
#undef PG8_WAIT_V
#undef PG8_WAIT_L
#undef PG8_BAR
#undef PG8_SCHED
}
}
using pg8::Unit;

struct SchedIn {
    pg8::OrderBase ob; int seg; const char* A; const char* B;
    __device__ bool next(int i, Unit& u) const { return ob.nextb(i, u); }
    __device__ const char* a_ptr(const Unit& u) const {
        const int gt = u.pm < LT_PROMPT ? ((u.pm / TPB) * (SEQ / 256) + seg * TPB + (u.pm % TPB)) : (XROWS / 256 + (u.pm - LT_PROMPT));
        return A + (size_t)gt * 256 * D * 2; }
    __device__ const char* b_ptr(const Unit& u) const { return B + (size_t)u.pn * 256 * D * 2; }
};
struct SchedAB {
    pg8::OrderBase ob; const char* A0; const char* A1; const char* B0; const char* B1;
    __device__ bool next(int i, Unit& u) const { const bool ok = ob.nextb(i >> 1, u); u.w = i & 1; return ok; }
    __device__ const char* a_ptr(const Unit& u) const { return (u.w ? A1 : A0) + (size_t)u.pm * 256 * D * 2; }
    __device__ const char* b_ptr(const Unit& u) const { return (u.w ? B1 : B0) + (size_t)u.pn * 256 * D * 2; }
};
struct SchedO {
    pg8::OrderBase ob; const char* A; const char* B;
    __device__ bool next(int i, Unit& u) const { return ob.nextb(i, u); }
    __device__ const char* a_ptr(const Unit& u) const { return A + (size_t)u.pm * 256 * D * 2; }
    __device__ const char* b_ptr(const Unit& u) const { return B + (size_t)u.pn * 256 * D * 2; }
};

struct EpiIn {
    static constexpr bool PERM = true;
    bf16_t* P; bf16_t* gex; float* out; int seg;
    __device__ __forceinline__ void operator()(const f32x4 (&acc)[2][2][4][2], const Unit& u, int wr, int wc, int fr, int fq) const {
        const int lr0 = u.pm * 256 + wr * 64 + fr;
        const int c0 = u.pn * 256 + wc * 32 + 8 * fq;
#pragma unroll
        for (int ai = 0; ai < 2; ++ai)
#pragma unroll
            for (int m = 0; m < 4; ++m) {
                const int lr = lr0 + ai * 128 + m * 16;
                bf16_t* rowp;
                if (u.pn < NT_PB) rowp = P + (size_t)lr * NPB + c0;
                else if (lr < LEX0) { const int b = lr / SEGTOK; const size_t grow = (size_t)b * SEQ + seg * SEGTOK + (lr % SEGTOK); rowp = (bf16_t*)(out + O_YP + grow * D) + (c0 - NPB); }
                else rowp = gex + (size_t)(lr - LEX0) * 2048 + (c0 - NPB);
#pragma unroll
                for (int bj = 0; bj < 2; ++bj) { const f32x4 v0 = acc[ai][bj][m][0], v1 = acc[ai][bj][m][1];
                    u32x4 w; w.x = cvt_pk_bf16(v0[0], v0[1]); w.y = cvt_pk_bf16(v0[2], v0[3]); w.z = cvt_pk_bf16(v1[0], v1[1]); w.w = cvt_pk_bf16(v1[2], v1[3]);
                    *(u32x4*)(rowp + bj * 128) = w; }
            }
    }
};
struct EpiAB {
    static constexpr bool PERM = false;
    float* tmp; bf16_t* merged; const bf16_t* gex; const float* out;
    __device__ __forceinline__ void operator()(const f32x4 (&acc)[2][2][4][2], const Unit& u, int wr, int wc, int fr, int fq) const {
        const int row0 = u.pm * 256 + wr * 64 + fr, col0 = u.pn * 256 + wc * 32 + 4 * fq;
#pragma unroll
        for (int ai = 0; ai < 2; ++ai)
#pragma unroll
            for (int m = 0; m < 4; ++m) {
                const int grow = row0 + ai * 128 + m * 16;
                const bf16_t* gp = (grow < XROWS) ? ((const bf16_t*)(out + O_YP + (size_t)grow * D) + u.w * D) : (gex + (size_t)(grow - XROWS) * 2048 + u.w * D);
#pragma unroll
                for (int bj = 0; bj < 2; ++bj)
#pragma unroll
                    for (int n = 0; n < 2; ++n) {
                        const int c = col0 + bj * 128 + n * 16;
                        const u32x2 g = *(const u32x2*)(gp + c);
                        f32x4 v = acc[ai][bj][m][n];
                        v[0] *= sigm(__uint_as_float(g.x << 16)); v[1] *= sigm(__uint_as_float(g.x & 0xffff0000u));
                        v[2] *= sigm(__uint_as_float(g.y << 16)); v[3] *= sigm(__uint_as_float(g.y & 0xffff0000u));
                        float* tp = tmp + (size_t)grow * D + c;
                        if (u.w == 0) *(f32x4*)tp = v;
                        else { const f32x4 t = *(const f32x4*)tp; v = v + t; u32x2 o; o.x = cvt_pk_bf16(v[0], v[1]); o.y = cvt_pk_bf16(v[2], v[3]); *(u32x2*)(merged + (size_t)grow * D + c) = o; }
                    }
            }
    }
};
struct EpiO {
    static constexpr bool PERM = false;
    float* out; const float* xp; const float* xs;
    __device__ __forceinline__ void operator()(const f32x4 (&acc)[2][2][4][2], const Unit& u, int wr, int wc, int fr, int fq) const {
        const int row0 = u.pm * 256 + wr * 64 + fr, col0 = u.pn * 256 + wc * 32 + 4 * fq;
#pragma unroll
        for (int ai = 0; ai < 2; ++ai)
#pragma unroll
            for (int m = 0; m < 4; ++m) {
                const int grow = row0 + ai * 128 + m * 16;
                const float* xr; float* yr;
                if (grow < XROWS) { xr = xp + (size_t)grow * D; yr = out + O_YP + (size_t)grow * D; }
                else { const int e = grow - XROWS; if (e < EX_SAMP || e >= EX_SHIFT) continue; xr = xs + (size_t)(e - EX_SAMP) * D; yr = out + O_YS + (size_t)(e - EX_SAMP) * D; }
#pragma unroll
                for (int bj = 0; bj < 2; ++bj)
#pragma unroll
                    for (int n = 0; n < 2; ++n) { const int c = col0 + bj * 128 + n * 16; *(f32x4*)(yr + c) = *(const f32x4*)(xr + c) + acc[ai][bj][m][n]; }
            }
    }
};

__device__ __forceinline__ void p0_row(const Params& p, int r, int lane) {
    bf16_t* hrow = (bf16_t*)(p.ws + WS_H) + (size_t)r * D;
    const float* src = nullptr; bool norm = true; float* sh = nullptr;
    if (r < XROWS) { src = p.in[0] + (size_t)r * D; if ((r & (SEQ - 1)) == SEQ - 1) sh = p.out + O_SHIFT_P + (size_t)(r / SEQ) * D; }
    else { const int e = r - XROWS;
        if (e < EX_SAMP) src = p.in[6] + (size_t)e * D;
        else if (e < EX_SHIFT) { src = p.in[1] + (size_t)(e - EX_SAMP) * D; if (((e - EX_SAMP) & 3) == 3) sh = p.out + O_SHIFT_S + (size_t)((e - EX_SAMP) >> 2) * D; }
        else if (e < EX_END) { src = p.in[5] + (size_t)(e - EX_SHIFT) * D; norm = false; } }
    u32x2* o8 = (u32x2*)hrow + lane;
    if (!src) {
#pragma unroll
        for (int j = 0; j < 4; ++j) o8[64 * j] = (u32x2){0u, 0u};
        return; }
    const f32x4* xr = (const f32x4*)src + lane;
    f32x4 v[4]; float ss = 0.f;
#pragma unroll
    for (int j = 0; j < 4; ++j) { v[j] = xr[64 * j]; ss += v[j][0] * v[j][0] + v[j][1] * v[j][1] + v[j][2] * v[j][2] + v[j][3] * v[j][3]; }
    if (norm) {
        const float rs = rsqrtf(wave_sum(ss) * (1.f / D) + 1e-6f);
        const f32x4* wr = (const f32x4*)p.in[7] + lane;
#pragma unroll
        for (int j = 0; j < 4; ++j) v[j] = v[j] * rs * wr[64 * j];
    }
#pragma unroll
    for (int j = 0; j < 4; ++j) { o8[64 * j] = (u32x2){pk2(v[j][0], v[j][1]), pk2(v[j][2], v[j][3])}; if (sh) ((f32x4*)sh)[lane + 64 * j] = v[j]; }
}
template <int MODE> __device__ __forceinline__ void p0_tr_item(const float* W, int N, bf16_t* WT, float* scr, int kb, int nb, int lane) {
    const int k0 = 64 * kb, n0 = 32 * nb;
    const int nn = n0 + (lane & 31);
    int srcc = nn;
    if (MODE == 1) srcc = nn < C_GATE_REF ? nn : (nn < NPB ? -1 : nn - (NPB - C_GATE_REF));
#pragma unroll 8
    for (int i = 0; i < 32; ++i) { const int kk = 2 * i + (lane >> 5); scr[kk * 33 + (lane & 31)] = srcc >= 0 ? W[(size_t)(k0 + kk) * N + srcc] : 0.f; }
    asm volatile("s_waitcnt lgkmcnt(0)" ::: "memory");
    const int c = lane & 7;
#pragma unroll
    for (int j = 0; j < 4; ++j) { const int n = (lane >> 3) + 8 * j; const float* s = scr + (8 * c) * 33 + n;
        u32x4 o; o.x = pk2(s[0 * 33], s[1 * 33]); o.y = pk2(s[2 * 33], s[3 * 33]); o.z = pk2(s[4 * 33], s[5 * 33]); o.w = pk2(s[6 * 33], s[7 * 33]);
        *(u32x4*)(WT + (size_t)(n0 + n) * D + k0 + 8 * c) = o; }
    asm volatile("s_waitcnt lgkmcnt(0)" ::: "memory");
}
__device__ __forceinline__ void phase0(const Params& p, unsigned char* smem) {
    const int tid0 = otid(), wave = tid0 >> 6, lane = tid0 & 63;
    const int gw = obid() * 8 + wave, NGW = gridDim.x * 8;
    float* scr = (float*)smem + wave * (64 * 33);
    constexpr int I_IN = 16 * (NP / 32), I_SQ = 16 * 32;
    for (int it = gw; it < I_IN + 3 * I_SQ; it += NGW) {
        int r = it;
        if (r < I_IN) { p0_tr_item<1>(p.in[8], 10384, (bf16_t*)(p.ws + WS_WT_IN), scr, r / (NP / 32), r % (NP / 32), lane); continue; } r -= I_IN;
        if (r < I_SQ) { p0_tr_item<0>(p.in[13], D, (bf16_t*)(p.ws + WS_WT_A), scr, r / 32, r % 32, lane); continue; } r -= I_SQ;
        if (r < I_SQ) { p0_tr_item<0>(p.in[24], D, (bf16_t*)(p.ws + WS_WT_B), scr, r / 32, r % 32, lane); continue; } r -= I_SQ;
        p0_tr_item<0>(p.in[25], D, (bf16_t*)(p.ws + WS_WT_O), scr, r / 32, r % 32, lane);
    }
    for (int r = gw; r < HROWS; r += NGW) p0_row(p, r, lane);
    {
        float* pk = (float*)(p.ws + WS_PK);
        const int gt = obid() * 512 + tid0, NT = gridDim.x * 512;
#define PKCOPY(off, idx, n) for (int i = gt; i < (n); i += NT) pk[(off) + i] = p.in[idx][i];
        PKCOPY(PK_CONVW, 9, 12288) PKCOPY(PK_ALOG, 10, 8) PKCOPY(PK_DTB, 11, 8) PKCOPY(PK_NORMW, 12, 128) PKCOPY(PK_MU, 14, 4224) PKCOPY(PK_W0, 15, 1024)
        PKCOPY(PK_W2, 16, 65536) PKCOPY(PK_A0, 17, 1024) PKCOPY(PK_A2, 18, 65536) PKCOPY(PK_KK, 19, 1024) PKCOPY(PK_KA, 20, 1024) PKCOPY(PK_RK, 21, 1024)
        PKCOPY(PK_GNW, 22, 1024) PKCOPY(PK_GNB, 23, 1024) PKCOPY(PK_LNF, 26, 1024)
#undef PKCOPY
        bf16_t* w2t = (bf16_t*)(p.ws + WS_W2T); bf16_t* a2t = (bf16_t*)(p.ws + WS_A2T);
        for (int i = gt; i < 65536; i += NT) { const int l = i & 63, c = (i >> 6) & 63, hb = i >> 12;
            w2t[i] = (bf16_t)f2bf(p.in[16][(size_t)l * D + hb * 64 + c]); a2t[i] = (bf16_t)f2bf(p.in[18][(size_t)l * D + hb * 64 + c]); }
    }
}

__device__ __forceinline__ void gdn_item(const Params& p, unsigned char* smem, const float* s_in, float* s_out, const float* halo_in, float* halo_out,
                                         int h, int sl, int rowA, int nA, int rowB, int nB) {
    const int tid = otid(), w = tid >> 6, lane = tid & 63, vl = lane >> 4, kg = lane & 15;
    float* qk_s = (float*)smem; float* v_s = qk_s + 16384; float* o_s = v_s + 2048; float* gb_s = o_s + 2048; float* sst = gb_s + 128;
    const bf16_t* P = (const bf16_t*)(p.ws + WS_P);
    float* ORAW = (float*)(p.ws + WS_ORAW);
    float s[8];
    if (s_in) {
        { const int k = tid >> 2, q4 = tid & 3; const f32x4* src = (const f32x4*)(s_in + (size_t)k * 128 + sl * 32 + q4 * 8); const f32x4 a = src[0], b = src[1];
          float* d = sst + k * 33 + q4 * 8; d[0] = a[0]; d[1] = a[1]; d[2] = a[2]; d[3] = a[3]; d[4] = b[0]; d[5] = b[1]; d[6] = b[2]; d[7] = b[3]; }
        __syncthreads();
#pragma unroll
        for (int j = 0; j < 8; ++j) s[j] = sst[(kg * 8 + j) * 33 + 4 * w + vl];
        __syncthreads();
    } else {
#pragma unroll
        for (int j = 0; j < 8; ++j) s[j] = 0.f;
    }
    int pcol = -1;
    if (tid < 128) pcol = h * 128 + tid; else if (tid < 256) pcol = 1024 + h * 128 + (tid - 128); else if (tid < 288) pcol = 2048 + h * 128 + sl * 32 + (tid - 256);
    float cw0 = 0.f, cw1 = 0.f, cw2 = 0.f, cw3 = 0.f, x1 = 0.f, x2 = 0.f, x3 = 0.f;
    const float* pk = (const float*)(p.ws + WS_PK);
    if (pcol >= 0) { const float* cw = pk + PK_CONVW; cw0 = cw[pcol]; cw1 = cw[3072 + pcol]; cw2 = cw[6144 + pcol]; cw3 = cw[9216 + pcol];
        if (halo_in) { x3 = halo_in[pcol]; x2 = halo_in[3072 + pcol]; x1 = halo_in[6144 + pcol]; } }
    const float nalog = -expf(pk[PK_ALOG + h]), dtb = pk[PK_DTB + h];
#pragma unroll 1
    for (int run = 0; run < 2; ++run) {
        const int rrow = run ? rowB : rowA, rn = run ? nB : nA; const bool wout = run != 0;
#pragma unroll 1
        for (int c0 = 0; c0 < rn; c0 += 64) {
            const int nt = (rn - c0) < 64 ? (rn - c0) : 64; const int row = rrow + c0;
            if (pcol >= 0) {
                const bf16_t* src = P + (size_t)row * NPB + pcol;
                float* dst = tid < 256 ? (qk_s + tid) : (v_s + (tid - 256)); const int dstride = tid < 256 ? 256 : 32;
#pragma unroll 8
                for (int i = 0; i < nt; ++i) { const float x0 = bf2f(src[(size_t)i * NPB]); const float y = cw0 * x3 + cw1 * x2 + cw2 * x1 + cw3 * x0; x3 = x2; x2 = x1; x1 = x0; dst[i * dstride] = silu_(y); }
            } else if (tid < 352) {
                const int i = tid - 288;
                if (i < nt) { const float pa = bf2f(P[(size_t)(row + i) * NPB + C_A + h]), pb = bf2f(P[(size_t)(row + i) * NPB + C_B + h]);
                    gb_s[2 * i] = expf(nalog * softplus_(pa + dtb)); gb_s[2 * i + 1] = sigm(pb); }
            }
            __syncthreads();
#pragma unroll 1
            for (int ii = 0; ii < 8; ++ii) { const int i = w * 8 + ii;
                if (i < nt) {
#pragma unroll
                    for (int which = 0; which < 2; ++which) { float* rp = qk_s + i * 256 + which * 128; const float a = rp[lane], b = rp[lane + 64];
                        const float sc = rsqrtf(wave_sum(a * a + b * b) + 1e-6f) * (which == 0 ? 0.08838834764831845f : 1.f); rp[lane] = a * sc; rp[lane + 64] = b * sc; } } }
            __syncthreads();
#pragma unroll 1
            for (int i = 0; i < nt; ++i) {
                const f32x4 q0 = *(const f32x4*)(qk_s + i * 256 + kg * 8), q1 = *(const f32x4*)(qk_s + i * 256 + kg * 8 + 4);
                const f32x4 k0 = *(const f32x4*)(qk_s + i * 256 + 128 + kg * 8), k1 = *(const f32x4*)(qk_s + i * 256 + 128 + kg * 8 + 4);
                const float vv = v_s[i * 32 + 4 * w + vl], a = gb_s[2 * i], be = gb_s[2 * i + 1];
                float part = k0[0] * s[0] + k0[1] * s[1] + k0[2] * s[2] + k0[3] * s[3] + k1[0] * s[4] + k1[1] * s[5] + k1[2] * s[6] + k1[3] * s[7];
                const float kS = rowsum16(part);
                const float c = be * (vv - a * kS);
                s[0] = a * s[0] + k0[0] * c; s[1] = a * s[1] + k0[1] * c; s[2] = a * s[2] + k0[2] * c; s[3] = a * s[3] + k0[3] * c;
                s[4] = a * s[4] + k1[0] * c; s[5] = a * s[5] + k1[1] * c; s[6] = a * s[6] + k1[2] * c; s[7] = a * s[7] + k1[3] * c;
                float op = q0[0] * s[0] + q0[1] * s[1] + q0[2] * s[2] + q0[3] * s[3] + q1[0] * s[4] + q1[1] * s[5] + q1[2] * s[6] + q1[3] * s[7];
                const float o = rowsum16(op);
                if (kg == 0) o_s[i * 32 + 4 * w + vl] = o;
            }
            __syncthreads();
            if (wout) { const int i = tid >> 3, c4 = (tid & 7) * 4; if (i < nt) *(f32x4*)(ORAW + (size_t)(row + i) * D + h * 128 + sl * 32 + c4) = *(const f32x4*)(o_s + i * 32 + c4); }
        }
    }
    if (pcol >= 0 && (sl == 0 || tid >= 256)) { halo_out[pcol] = x3; halo_out[3072 + pcol] = x2; halo_out[6144 + pcol] = x1; }
#pragma unroll
    for (int j = 0; j < 8; ++j) sst[(kg * 8 + j) * 33 + 4 * w + vl] = s[j];
    __syncthreads();
    { const int k = tid >> 2, q4 = tid & 3; const float* d = sst + k * 33 + q4 * 8; f32x4* dst = (f32x4*)(s_out + (size_t)k * 128 + sl * 32 + q4 * 8);
      dst[0] = (f32x4){d[0], d[1], d[2], d[3]}; dst[1] = (f32x4){d[4], d[5], d[6], d[7]}; }
    __syncthreads();
}

constexpr int RW_W2 = 20544, RW_A2 = 24640;
__device__ __forceinline__ void rwkv_load_lora(const Params& p, unsigned char* smem, int hb) {
    float* w2_s = (float*)smem + RW_W2; float* a2_s = (float*)smem + RW_A2; const float* pk = (const float*)(p.ws + WS_PK);
    for (int i = otid(); i < 4096; i += 512) { const int l = i >> 6, c = i & 63; w2_s[i] = pk[PK_W2 + l * D + hb * 64 + c]; a2_s[i] = pk[PK_A2 + l * D + hb * 64 + c]; }
    __syncthreads();
}
__device__ __forceinline__ void rwkv_item(const Params& p, unsigned char* smem, const float* s_in, float* s_out, const bf16_t* prev_row, const float* halo_in, float* halo_out,
                                          int hb, int half, int rowA, int nA, int rowB, int nB) {
    const int tid = otid(), w = tid >> 6, lane = tid & 63, row = tid >> 4, kq = tid & 15;
    float* f = (float*)smem;
    float* r_s = f; float* kb_s = f + 2048; float* v_s = f + 4096; float* wd_s = f + 6144; float* ad_s = f + 8192; float* dec_s = f + 10240; float* a_s = f + 12288;
    float* kk_s = f + 14336; float* km_s = f + 16384; float* zb_s = f + 18432; float* y_s = f + 19456; float* bonus_s = f + 20480;
    const float* w2_s = f + RW_W2; const float* a2_s = f + RW_A2;
    const bf16_t* P = (const bf16_t*)(p.ws + WS_P);
    float* YRAW = (float*)(p.ws + WS_YRAW); bf16_t* C0 = (bf16_t*)(p.ws + WS_C0); bf16_t* C1 = (bf16_t*)(p.ws + WS_C1);
    float s[4];
    if (s_in) { const f32x4 t = *(const f32x4*)(s_in + (size_t)(half * 32 + row) * 64 + kq * 4); s[0] = t[0]; s[1] = t[1]; s[2] = t[2]; s[3] = t[3]; }
    else { s[0] = s[1] = s[2] = s[3] = 0.f; }
    int col = -1; float* dst = nullptr; int dstride = 64; bool is_wd = false, owner = false;
    if (tid < 64) { col = hb * 64 + tid; dst = r_s + tid; owner = half == 0; }
    else if (tid < 128) { col = 1024 + hb * 64 + (tid - 64); dst = kb_s + (tid - 64); owner = half == 0; }
    else if (tid < 192) { col = 2048 + hb * 64 + (tid - 128); dst = v_s + (tid - 128); owner = half == 0; }
    else if (tid < 256) { col = 3072 + (tid - 192); dst = wd_s + (tid - 192); is_wd = true; owner = (half == 0 && hb == 0); }
    else if (tid < 320) { col = 3136 + (tid - 256); dst = ad_s + (tid - 256); owner = (half == 0 && hb == 0); }
    else if (tid < 352) { col = 3200 + hb * 64 + half * 32 + (tid - 320); dst = zb_s + (tid - 320); dstride = 32; owner = true; }
    float mu = 0.f, prev = 0.f;
    const float* pk = (const float*)(p.ws + WS_PK);
    if (col >= 0) { mu = pk[PK_MU + col]; prev = prev_row ? bf2f(prev_row[C_RW + col]) : (halo_in ? halo_in[col] : 0.f); }
    const int cc = tid & 63, ig = tid >> 6;
    const int hc = hb * 64 + cc;
    const float w0c = pk[PK_W0 + hc], a0c = pk[PK_A0 + hc], kkc = pk[PK_KK + hc], kac = pk[PK_KA + hc];
    const float rkl = pk[PK_RK + hb * 64 + lane];
#pragma unroll 1
    for (int run = 0; run < 2; ++run) {
        const int rrow = run ? rowB : rowA, rn = run ? nB : nA; const bool wout = run != 0;
#pragma unroll 1
        for (int c0 = 0; c0 < rn; c0 += 32) {
            const int nt = (rn - c0) < 32 ? (rn - c0) : 32; const int row0 = rrow + c0;
            if (col >= 0) {
                const bf16_t* src = P + (size_t)row0 * NPB + C_RW + col;
#pragma unroll 8
                for (int i = 0; i < nt; ++i) { const float cur = bf2f(src[(size_t)i * NPB]); float m = cur + mu * (prev - cur); prev = cur; if (is_wd) m = tanh_(m); dst[i * dstride] = m; }
            }
            __syncthreads();
            {
                float aw[4] = {0.f, 0.f, 0.f, 0.f}, aa[4] = {0.f, 0.f, 0.f, 0.f};
#pragma unroll 4
                for (int l = 0; l < 64; ++l) { const float w2v = w2_s[l * 64 + cc], a2v = a2_s[l * 64 + cc];
#pragma unroll
                    for (int ii = 0; ii < 4; ++ii) { aw[ii] += wd_s[(ig * 4 + ii) * 64 + l] * w2v; aa[ii] += ad_s[(ig * 4 + ii) * 64 + l] * a2v; } }
#pragma unroll
                for (int ii = 0; ii < 4; ++ii) { const int i = ig * 4 + ii;
                    if (i < nt) { const float wraw = w0c + aw[ii]; const float wlog = -0.6065306597126334f * sigm(wraw); const float a = sigm(a0c + aa[ii]);
                        const float kbv = kb_s[i * 64 + cc];
                        dec_s[i * 64 + cc] = expf(wlog); a_s[i * 64 + cc] = a; kk_s[i * 64 + cc] = kbv * kkc; km_s[i * 64 + cc] = kbv * (1.f + (a - 1.f) * kac); } }
            }
            __syncthreads();
#pragma unroll 1
            for (int ii = 0; ii < 4; ++ii) { const int i = w * 4 + ii;
                if (i < nt) { const float kkr = kk_s[i * 64 + lane]; const float kk = kkr * rsqrtf(wave_sum(kkr * kkr) + 1e-6f); kk_s[i * 64 + lane] = kk;
                    const float a = a_s[i * 64 + lane]; a_s[i * 64 + lane] = kk * a;
                    const float rk = wave_sum(r_s[i * 64 + lane] * km_s[i * 64 + lane] * rkl); if (lane == 0) bonus_s[i] = rk; } }
            __syncthreads();
#pragma unroll 1
            for (int i = 0; i < nt; ++i) {
                const f32x4 kk4 = *(const f32x4*)(kk_s + i * 64 + kq * 4), de4 = *(const f32x4*)(dec_s + i * 64 + kq * 4), ka4 = *(const f32x4*)(a_s + i * 64 + kq * 4),
                            km4 = *(const f32x4*)(km_s + i * 64 + kq * 4), r4 = *(const f32x4*)(r_s + i * 64 + kq * 4);
                const float vv = v_s[i * 64 + half * 32 + row];
                const float sa = rowsum16(s[0] * kk4[0] + s[1] * kk4[1] + s[2] * kk4[2] + s[3] * kk4[3]);
#pragma unroll
                for (int j = 0; j < 4; ++j) s[j] = s[j] * de4[j] + (vv * km4[j] - sa * ka4[j]);
                const float y = rowsum16(s[0] * r4[0] + s[1] * r4[1] + s[2] * r4[2] + s[3] * r4[3]);
                if (kq == 0) y_s[i * 32 + row] = y;
            }
            __syncthreads();
            if (wout) { const int i = tid >> 4;
                if (i < nt) {
#pragma unroll
                    for (int q = 0; q < 2; ++q) { const int rr = (tid & 15) * 2 + q, v = half * 32 + rr, colo = hb * 64 + v;
                        const float sz = silu_(zb_s[i * 32 + rr]);
                        const size_t o = (size_t)(row0 + i) * D + colo;
                        YRAW[o] = y_s[i * 32 + rr]; C1[o] = (bf16_t)f2bf(pk[PK_GNW + colo] * sz); C0[o] = (bf16_t)f2bf((pk[PK_GNB + colo] + bonus_s[i] * v_s[i * 64 + v]) * sz); } } }
            __syncthreads();
        }
    }
    *(f32x4*)(s_out + (size_t)(half * 32 + row) * 64 + kq * 4) = (f32x4){s[0], s[1], s[2], s[3]};
    if (col >= 0 && owner && halo_out) halo_out[col] = prev;
}


__device__ __forceinline__ bf16x8 ldfrag(const bf16_t* base, int stride, int r0, int k0, int lane) {
    return *(const bf16x8*)(base + (r0 + (lane & 15)) * stride + k0 + 8 * (lane >> 4));
}
#define MFMA16(a, b, c) __builtin_amdgcn_mfma_f32_16x16x32_bf16((a), (b), (c), 0, 0, 0)
__device__ __forceinline__ void inv_block(const float* L, float* Tm, float* XS, int tid) {
    const int w = tid >> 6, lane = tid & 63;
    if (w < 4 && lane < 16) {
        const float* Lb = L + (16 * w) * 64 + 16 * w; float* Tb = Tm + (16 * w) * 64 + 16 * w;
        float tr[16];
#pragma unroll
        for (int i = 0; i < 16; ++i) { float a = (lane == i) ? 1.f : 0.f;
#pragma unroll
            for (int j = 0; j < i; ++j) a -= Lb[i * 64 + j] * tr[j];
            tr[i] = a; Tb[i * 64 + lane] = a; }
    }
    for (int e = tid; e < 1536; e += 512) { const int k = e >> 8, r = (e >> 4) & 15, c = e & 15;
        const int rb = k < 3 ? 0 : (k < 5 ? 1 : 2), cb = k < 3 ? k + 1 : (k < 5 ? k - 1 : 3);
        Tm[(16 * rb + r) * 64 + 16 * cb + c] = 0.f; }
    __syncthreads();
    {
        const int B = tid >> 8, i = (tid >> 4) & 15, c = tid & 15, o = 32 * B;
        float x = 0.f;
#pragma unroll
        for (int j = 0; j < 16; ++j) x += L[(o + 16 + i) * 64 + o + j] * Tm[(o + j) * 64 + o + c];
        XS[tid] = x;
        __syncthreads();
        float t = 0.f;
#pragma unroll
        for (int j = 0; j < 16; ++j) t += Tm[(o + 16 + i) * 64 + o + 16 + j] * XS[(B << 8) + j * 16 + c];
        Tm[(o + 16 + i) * 64 + o + c] = -t;
    }
    __syncthreads();
    {
        const int i = tid >> 4, c2 = (tid & 15) * 2;
        float x0 = 0.f, x1 = 0.f;
#pragma unroll 8
        for (int j = 0; j < 32; ++j) { const float l = L[(32 + i) * 64 + j]; x0 += l * Tm[j * 64 + c2]; x1 += l * Tm[j * 64 + c2 + 1]; }
        XS[i * 32 + c2] = x0; XS[i * 32 + c2 + 1] = x1;
        __syncthreads();
        float t0 = 0.f, t1 = 0.f;
#pragma unroll 8
        for (int j = 0; j < 32; ++j) { const float tv = Tm[(32 + i) * 64 + 32 + j]; t0 += tv * XS[j * 32 + c2]; t1 += tv * XS[j * 32 + c2 + 1]; }
        Tm[(32 + i) * 64 + c2] = -t0; Tm[(32 + i) * 64 + c2 + 1] = -t1;
    }
    __syncthreads();
}
__device__ __forceinline__ void unpack8(const u32x4 rw, float (&x)[8]) {
    x[0] = __uint_as_float(rw.x << 16); x[1] = __uint_as_float(rw.x & 0xffff0000u); x[2] = __uint_as_float(rw.y << 16); x[3] = __uint_as_float(rw.y & 0xffff0000u);
    x[4] = __uint_as_float(rw.z << 16); x[5] = __uint_as_float(rw.z & 0xffff0000u); x[6] = __uint_as_float(rw.w << 16); x[7] = __uint_as_float(rw.w & 0xffff0000u); }
__device__ __forceinline__ u32x4 pack8(const float (&x)[8]) { return (u32x4){pk2(x[0], x[1]), pk2(x[2], x[3]), pk2(x[4], x[5]), pk2(x[6], x[7])}; }

constexpr int PL_QS = 0, PL_R1 = 17408, PL_KT = 35840, PL_KTT = 54272, PL_VT = 72704, PL_R3 = 91136, PL_QKM = 109568, PL_TP = 118784, PL_TPP = 128000, PL_SM = 137216, PL_TM = 139264, PL_XS = 155648;
constexpr int QSTR = 136, TSTR = 72;

__device__ __forceinline__ void gdn_prep_item(const Params& p, unsigned char* smem, int h, int row_start, int npad, const bf16_t* hbase,
                                              bf16_t* halo_out, float* conv_out, unsigned char* rec) {
    const int tid = otid(), w = tid >> 6, lane = tid & 63, q4 = lane >> 4, l15 = lane & 15;
    bf16_t* qs = (bf16_t*)(smem + PL_QS); bf16_t* ks = (bf16_t*)(smem + PL_R1); bf16_t* WT = ks; bf16_t* kT = (bf16_t*)(smem + PL_KT); bf16_t* ktT = (bf16_t*)(smem + PL_KTT);
    bf16_t* vT = (bf16_t*)(smem + PL_VT); float* Lm = (float*)(smem + PL_R3); bf16_t* UT = (bf16_t*)(smem + PL_R3); bf16_t* QKm = (bf16_t*)(smem + PL_QKM);
    bf16_t* Tp = (bf16_t*)(smem + PL_TP); bf16_t* Tpp = (bf16_t*)(smem + PL_TPP);
    float* sm = (float*)(smem + PL_SM);
    float* gcs = sm; float* bes = sm + 64; float* ssq = sm + 128; float* ssk = sm + 192; float* egs = sm + 256; float* egl_s = sm + 320; float* beg = sm + 384;
    const bf16_t* P = (const bf16_t*)(p.ws + WS_P);
    const float* pk = (const float*)(p.ws + WS_PK);
    if (tid < 128) ssq[tid] = 0.f;
    if (tid >= 448) { const int i = tid - 448;
        float g = 0.f, be = 0.f;
        if (i >= npad) { const size_t r = (size_t)(row_start + i - npad) * NPB; const float pa = bf2f(P[r + C_A + h]), pb = bf2f(P[r + C_B + h]);
            g = -expf(pk[PK_ALOG + h]) * softplus_(pa + pk[PK_DTB + h]); be = sigm(pb); }
        gcs[i] = g; bes[i] = be; }
    __syncthreads();
    if (tid < 64) {
        float x = gcs[lane];
#pragma unroll
        for (int o = 1; o < 64; o <<= 1) { const float y = __shfl_up(x, o); if (lane >= o) x += y; }
        const float gl = __shfl(x, 63);
        gcs[lane] = x; egs[lane] = __expf(x); egl_s[lane] = __expf(gl - x); beg[lane] = bes[lane] * __expf(x);
        if (lane == 0) *(float*)(rec + GP_EGL) = __expf(gl);
    }
    const int cg = tid % 48, ts = tid / 48;
    const int sec = cg >> 4;
    const int pcol = sec * 1024 + h * 128 + (cg & 15) * 8;
    float val[7][8];
    if (ts < 10) {
        float cw[4][8];
#pragma unroll
        for (int j = 0; j < 4; ++j) { const f32x4 a = *(const f32x4*)(pk + PK_CONVW + j * 3072 + pcol), b = *(const f32x4*)(pk + PK_CONVW + j * 3072 + pcol + 4);
            cw[j][0] = a[0]; cw[j][1] = a[1]; cw[j][2] = a[2]; cw[j][3] = a[3]; cw[j][4] = b[0]; cw[j][5] = b[1]; cw[j][6] = b[2]; cw[j][7] = b[3]; }
#pragma unroll
        for (int it = 0; it < 7; ++it) {
            const int i = ts + 10 * it;
            float y[8];
#pragma unroll
            for (int e = 0; e < 8; ++e) y[e] = 0.f;
            const bool tokv = i < 64 && i >= npad;
            u32x4 rw[4]; float fv[4];
#pragma unroll
            for (int dlt = 0; dlt < 4; ++dlt) {
                const int ii = i - 3 + dlt;
                const bf16_t* ptr = P + pcol; float f = 0.f;
                if (tokv && ii >= npad) { ptr = P + (size_t)(row_start + ii - npad) * NPB + pcol; f = 1.f; }
                else if (tokv && ii < 0 && npad == 0 && hbase) { ptr = hbase + (size_t)(ii + 3) * NPB + pcol; f = 1.f; }
                rw[dlt] = *(const u32x4*)ptr; fv[dlt] = f;
            }
            if (tokv) {
#pragma unroll
                for (int dlt = 0; dlt < 4; ++dlt) { float x[8]; unpack8(rw[dlt], x);
#pragma unroll
                    for (int e = 0; e < 8; ++e) y[e] += cw[dlt][e] * fv[dlt] * x[e]; }
                float ss = 0.f;
#pragma unroll
                for (int e = 0; e < 8; ++e) { y[e] = silu_(y[e]); ss += y[e] * y[e]; }
                if (sec == 0) atomicAdd(ssq + i, ss); else if (sec == 1) atomicAdd(ssk + i, ss);
            }
#pragma unroll
            for (int e = 0; e < 8; ++e) val[it][e] = y[e];
        }
    }
    if (halo_out && tid < 384) {
        const int c = (tid >> 7) * 1024 + h * 128 + (tid & 127);
#pragma unroll
        for (int dd = 0; dd < 3; ++dd) { const bf16_t v = P[(size_t)(row_start + 61 + dd) * NPB + c]; halo_out[(size_t)dd * NPB + c] = v; if (conv_out) conv_out[dd * 3072 + c] = bf2f(v); }
    }
    __syncthreads();
    if (ts < 10) {
#pragma unroll
        for (int it = 0; it < 7; ++it) {
            const int i = ts + 10 * it;
            if (i < 64) {
                float sc = 1.f;
                if (sec == 0) sc = rsqrtf(ssq[i] + 1e-6f) * 0.08838834764831845f; else if (sec == 1) sc = rsqrtf(ssk[i] + 1e-6f);
                const int d0 = (cg & 15) * 8;
                float x[8];
#pragma unroll
                for (int e = 0; e < 8; ++e) x[e] = val[it][e] * sc;
                if (sec == 0) { *(u32x4*)(qs + i * QSTR + d0) = (u32x4){pk2(x[0], x[1]), pk2(x[2], x[3]), pk2(x[4], x[5]), pk2(x[6], x[7])}; }
                else if (sec == 1) { *(u32x4*)(ks + i * QSTR + d0) = (u32x4){pk2(x[0], x[1]), pk2(x[2], x[3]), pk2(x[4], x[5]), pk2(x[6], x[7])};
                    const float eg = egl_s[i];
#pragma unroll
                    for (int e = 0; e < 8; ++e) { kT[(d0 + e) * TSTR + i] = (bf16_t)f2bf(x[e]); ktT[(d0 + e) * TSTR + i] = (bf16_t)f2bf(x[e] * eg); } }
                else {
#pragma unroll
                    for (int e = 0; e < 8; ++e) vT[(d0 + e) * TSTR + i] = (bf16_t)f2bf(x[e]); }
            }
        }
    }
    __syncthreads();
    {
        const int which = w >> 2, it = w & 3;
        const bf16_t* Aarr = which ? qs : ks;
        bf16x8 af[4];
#pragma unroll
        for (int kk = 0; kk < 4; ++kk) af[kk] = ldfrag(Aarr, QSTR, 16 * it, 32 * kk, lane);
#pragma unroll
        for (int jt = 0; jt < 4; ++jt) {
            f32x4 acc = {0.f, 0.f, 0.f, 0.f};
#pragma unroll
            for (int kk = 0; kk < 4; ++kk) acc = MFMA16(af[kk], ldfrag(ks, QSTR, 16 * jt, 32 * kk, lane), acc);
            const int j = 16 * jt + l15; const float gj = gcs[j];
#pragma unroll
            for (int r = 0; r < 4; ++r) { const int i = 16 * it + 4 * q4 + r;
                if (which == 0) Lm[i * 64 + j] = (i > j) ? bes[i] * acc[r] * __expf(gcs[i] - gj) : 0.f;
                else QKm[i * TSTR + j] = (bf16_t)f2bf((i >= j) ? acc[r] * __expf(gcs[i] - gj) : 0.f); }
        }
    }
    __syncthreads();
    {
        float* Tm = (float*)(smem + PL_TM);
        inv_block(Lm, Tm, (float*)(smem + PL_XS), tid);
        const int i = tid >> 3, j0 = (tid & 7) * 8;
        float a[8], b2[8];
#pragma unroll
        for (int e = 0; e < 8; ++e) { const float tv = Tm[i * 64 + j0 + e]; a[e] = tv * beg[j0 + e]; b2[e] = tv * bes[j0 + e]; }
        *(u32x4*)(Tp + i * TSTR + j0) = (u32x4){pk2(a[0], a[1]), pk2(a[2], a[3]), pk2(a[4], a[5]), pk2(a[6], a[7])};
        *(u32x4*)(Tpp + i * TSTR + j0) = (u32x4){pk2(b2[0], b2[1]), pk2(b2[2], b2[3]), pk2(b2[4], b2[5]), pk2(b2[6], b2[7])};
    }
    __syncthreads();
    {
        const int it = w & 3, half = w >> 2;
        f32x4 aw[4], au[4];
#pragma unroll
        for (int x = 0; x < 4; ++x) { aw[x] = (f32x4){0.f, 0.f, 0.f, 0.f}; au[x] = (f32x4){0.f, 0.f, 0.f, 0.f}; }
#pragma unroll
        for (int kk = 0; kk < 2; ++kk) {
            const bf16x8 a1 = ldfrag(Tp, TSTR, 16 * it, 32 * kk, lane), a2 = ldfrag(Tpp, TSTR, 16 * it, 32 * kk, lane);
#pragma unroll
            for (int x = 0; x < 4; ++x) { const int dt = half * 4 + x;
                aw[x] = MFMA16(a1, ldfrag(kT, TSTR, 16 * dt, 32 * kk, lane), aw[x]);
                au[x] = MFMA16(a2, ldfrag(vT, TSTR, 16 * dt, 32 * kk, lane), au[x]); }
        }
        __syncthreads();
#pragma unroll
        for (int x = 0; x < 4; ++x) { const int d = 16 * (half * 4 + x) + l15, i0 = 16 * it + 4 * q4;
            *(u32x2*)(WT + d * TSTR + i0) = (u32x2){pk2(aw[x][0], aw[x][1]), pk2(aw[x][2], aw[x][3])};
            *(u32x2*)(UT + d * TSTR + i0) = (u32x2){pk2(au[x][0], au[x][1]), pk2(au[x][2], au[x][3])}; }
    }
    __syncthreads();
    {
        bf16_t* gAP = (bf16_t*)(rec + GP_AP); bf16_t* gQH = (bf16_t*)(rec + GP_QH); bf16_t* gKH = (bf16_t*)(rec + GP_KH); bf16_t* gOH = (bf16_t*)(rec + GP_OH);
        {
            const int et = w;
            const bf16x8 a0 = ldfrag(WT, TSTR, 16 * et, 0, lane), a1 = ldfrag(WT, TSTR, 16 * et, 32, lane);
#pragma unroll
            for (int dt = 0; dt < 8; ++dt) { f32x4 acc = {0.f, 0.f, 0.f, 0.f};
                acc = MFMA16(a0, ldfrag(ktT, TSTR, 16 * dt, 0, lane), acc); acc = MFMA16(a1, ldfrag(ktT, TSTR, 16 * dt, 32, lane), acc);
                *(u32x2*)(gAP + ((size_t)(dt * 4 + (et >> 1)) * 64 + lane) * 8 + (et & 1) * 4) = (u32x2){pk2(-acc[0], -acc[1]), pk2(-acc[2], -acc[3])}; }
#pragma unroll
            for (int tt = 0; tt < 4; ++tt) { f32x4 acc = {0.f, 0.f, 0.f, 0.f};
                acc = MFMA16(a0, ldfrag(QKm, TSTR, 16 * tt, 0, lane), acc); acc = MFMA16(a1, ldfrag(QKm, TSTR, 16 * tt, 32, lane), acc);
                const int t = 16 * tt + l15, e0 = 16 * et + 4 * q4; const float eg = egs[t];
                const u32x2 qq = *(const u32x2*)(qs + t * QSTR + e0);
                const float o0 = __uint_as_float(qq.x << 16) * eg - acc[0], o1 = __uint_as_float(qq.x & 0xffff0000u) * eg - acc[1],
                            o2 = __uint_as_float(qq.y << 16) * eg - acc[2], o3 = __uint_as_float(qq.y & 0xffff0000u) * eg - acc[3];
                *(u32x2*)(gQH + ((size_t)(tt * 4 + (et >> 1)) * 64 + lane) * 8 + (et & 1) * 4) = (u32x2){pk2(o0, o1), pk2(o2, o3)}; }
        }
        {
            const int dt = w;
            const bf16x8 a0 = ldfrag(ktT, TSTR, 16 * dt, 0, lane), a1 = ldfrag(ktT, TSTR, 16 * dt, 32, lane);
#pragma unroll
            for (int vt = 0; vt < 8; ++vt) { f32x4 acc = {0.f, 0.f, 0.f, 0.f};
                acc = MFMA16(a0, ldfrag(UT, TSTR, 16 * vt, 0, lane), acc); acc = MFMA16(a1, ldfrag(UT, TSTR, 16 * vt, 32, lane), acc);
                *(u32x2*)(gKH + ((size_t)(vt * 8 + dt) * 64 + lane) * 4) = (u32x2){pk2(acc[0], acc[1]), pk2(acc[2], acc[3])}; }
            const int tt = w & 3, vh = w >> 2;
            const bf16x8 b0 = ldfrag(QKm, TSTR, 16 * tt, 0, lane), b1 = ldfrag(QKm, TSTR, 16 * tt, 32, lane);
#pragma unroll
            for (int x = 0; x < 4; ++x) { const int vt = vh * 4 + x; f32x4 acc = {0.f, 0.f, 0.f, 0.f};
                acc = MFMA16(b0, ldfrag(UT, TSTR, 16 * vt, 0, lane), acc); acc = MFMA16(b1, ldfrag(UT, TSTR, 16 * vt, 32, lane), acc);
                *(u32x2*)(gOH + ((size_t)(vt * 4 + tt) * 64 + lane) * 4) = (u32x2){pk2(acc[0], acc[1]), pk2(acc[2], acc[3])}; }
        }
    }
    __syncthreads();
}

__device__ __forceinline__ void phase_gprep(const Params& p, int seg, unsigned char* smem) {
    const int blk = obid();
    const int n_items = (CPS + (seg == 0 ? 1 : 0)) * 64;
#pragma unroll 1
    for (int it = blk; it < n_items; it += gridDim.x) {
        const int bh = it & 63, b = bh >> 3, h = bh & 7; int cl = it >> 6; if (seg != 0) cl += 1;
        unsigned char* rec = p.ws + WS_GP + (size_t)(cl * 64 + bh) * GP_STRIDE;
        const bf16_t* Pb = (const bf16_t*)(p.ws + WS_P);
        bf16_t* chalo2 = (bf16_t*)(p.ws + WS_CHALO);
        if (cl == 0) gdn_prep_item(p, smem, h, LEX0, 48, nullptr, nullptr, nullptr, rec);
        else {
            const int row = b * SEGTOK + (cl - 1) * 64;
            const bf16_t* hbase = Pb + (size_t)(row - 3) * NPB;
            if (cl == 1) hbase = (seg == 0) ? Pb + (size_t)(LEX0 + NMETA - 3) * NPB : chalo2 + (size_t)(((seg - 1) & 1) * NBATCH + b) * 3 * NPB;
            bf16_t* ho = (cl == CPS) ? chalo2 + (size_t)((seg & 1) * NBATCH + b) * 3 * NPB : nullptr;
            float* co = (cl == CPS && seg == NSEG - 1) ? p.out + O_CONV_P + (size_t)b * 9216 : nullptr;
            gdn_prep_item(p, smem, h, row, 0, hbase, ho, co, rec);
        }
    }
}

__device__ __forceinline__ void gdn_scan_block(const Params& p, int seg, unsigned char* smem, int bh) {
    const int tid = otid(), w = tid >> 6, lane = tid & 63, q4 = lane >> 4, l15 = lane & 15;
    const int b = bh >> 3, h = bh & 7;
    float* st = p.out + O_GDN_P + (size_t)bh * 16384;
    float* ORAW = (float*)(p.ws + WS_ORAW);
    f32x4 S[8];
    if (seg) {
#pragma unroll
        for (int mt = 0; mt < 8; ++mt)
#pragma unroll
            for (int r = 0; r < 4; ++r) S[mt][r] = st[(size_t)(16 * mt + 4 * q4 + r) * 128 + 16 * w + l15];
    } else {
#pragma unroll
        for (int mt = 0; mt < 8; ++mt) S[mt] = (f32x4){0.f, 0.f, 0.f, 0.f};
    }
    const int c_lo = seg ? 1 : 0;
#pragma unroll 1
    for (int cl = c_lo; cl <= CPS; ++cl) {
        const unsigned char* rec = p.ws + WS_GP + (size_t)(cl * 64 + bh) * GP_STRIDE;
        __syncthreads();
        {
            const u32x4* src = (const u32x4*)rec; u32x4* dst = (u32x4*)smem;
#pragma unroll
            for (int x = 0; x < 6; ++x) dst[tid + 512 * x] = src[tid + 512 * x];
        }
        const bf16_t* gKH = (const bf16_t*)(rec + GP_KH); const bf16_t* gOH = (const bf16_t*)(rec + GP_OH);
        u32x2 kh[8], oh[4];
#pragma unroll
        for (int mt = 0; mt < 8; ++mt) kh[mt] = *(const u32x2*)(gKH + ((size_t)(w * 8 + mt) * 64 + lane) * 4);
#pragma unroll
        for (int tt = 0; tt < 4; ++tt) oh[tt] = *(const u32x2*)(gOH + ((size_t)(w * 4 + tt) * 64 + lane) * 4);
        const float egl = *(const float*)(rec + GP_EGL);
        bf16x8 Bf[4];
#pragma unroll
        for (int ks = 0; ks < 4; ++ks) { u32x4 t; t.x = pk2(S[2 * ks][0], S[2 * ks][1]); t.y = pk2(S[2 * ks][2], S[2 * ks][3]); t.z = pk2(S[2 * ks + 1][0], S[2 * ks + 1][1]); t.w = pk2(S[2 * ks + 1][2], S[2 * ks + 1][3]);
            Bf[ks] = __builtin_bit_cast(bf16x8, t); }
        __syncthreads();
        const bf16x8* AP = (const bf16x8*)smem; const bf16x8* QH = (const bf16x8*)(smem + GP_QH);
        if (cl > 0) {
            const int row = b * SEGTOK + (cl - 1) * 64;
            float* obuf = (float*)(smem + 49152);
#pragma unroll
            for (int tt = 0; tt < 4; ++tt) { f32x4 o = {0.f, 0.f, 0.f, 0.f};
#pragma unroll
                for (int ks = 0; ks < 4; ++ks) o = MFMA16(QH[(tt * 4 + ks) * 64 + lane], Bf[ks], o);
                o[0] += __uint_as_float(oh[tt].x << 16); o[1] += __uint_as_float(oh[tt].x & 0xffff0000u); o[2] += __uint_as_float(oh[tt].y << 16); o[3] += __uint_as_float(oh[tt].y & 0xffff0000u);
#pragma unroll
                for (int r = 0; r < 4; ++r) obuf[(16 * tt + 4 * q4 + r) * 132 + 16 * w + l15] = o[r]; }
            __syncthreads();
            {
                const int t = tid >> 3, g = tid & 7;
                f32x4 o[4]; float ss = 0.f;
#pragma unroll
                for (int j = 0; j < 4; ++j) { o[j] = *(const f32x4*)(obuf + t * 132 + 16 * g + 4 * j); ss += o[j][0] * o[j][0] + o[j][1] * o[j][1] + o[j][2] * o[j][2] + o[j][3] * o[j][3]; }
                ss += __shfl_xor(ss, 1); ss += __shfl_xor(ss, 2); ss += __shfl_xor(ss, 4);
                const float rs = rsqrtf(ss * (1.f / 128.f) + 1e-6f);
                const bf16_t* zp = (const bf16_t*)(p.ws + WS_P) + (size_t)(row + t) * NPB + C_Z + h * 128 + 16 * g;
                const u32x4 z0 = *(const u32x4*)zp, z1 = *(const u32x4*)(zp + 8);
                const unsigned zz[8] = {z0.x, z0.y, z0.z, z0.w, z1.x, z1.y, z1.z, z1.w};
                const float* nwp = (const float*)(p.ws + WS_PK) + PK_NORMW + 16 * g;
                unsigned ow[8];
#pragma unroll
                for (int j = 0; j < 8; ++j) { const float za = __uint_as_float(zz[j] << 16), zb = __uint_as_float(zz[j] & 0xffff0000u);
                    ow[j] = pk2(o[j >> 1][(j & 1) * 2] * rs * nwp[2 * j] * silu_(za), o[j >> 1][(j & 1) * 2 + 1] * rs * nwp[2 * j + 1] * silu_(zb)); }
                const size_t grow = (size_t)b * SEQ + seg * SEGTOK + (cl - 1) * 64 + t;
                bf16_t* oa = (bf16_t*)(p.ws + WS_H) + grow * D + h * 128 + 16 * g;
                *(u32x4*)oa = (u32x4){ow[0], ow[1], ow[2], ow[3]}; *(u32x4*)(oa + 8) = (u32x4){ow[4], ow[5], ow[6], ow[7]};
            }
        }
#pragma unroll
        for (int mt = 0; mt < 8; ++mt) { f32x4 t = {0.f, 0.f, 0.f, 0.f};
#pragma unroll
            for (int ks = 0; ks < 4; ++ks) t = MFMA16(AP[(mt * 4 + ks) * 64 + lane], Bf[ks], t);
            S[mt][0] = egl * S[mt][0] + t[0] + __uint_as_float(kh[mt].x << 16); S[mt][1] = egl * S[mt][1] + t[1] + __uint_as_float(kh[mt].x & 0xffff0000u);
            S[mt][2] = egl * S[mt][2] + t[2] + __uint_as_float(kh[mt].y << 16); S[mt][3] = egl * S[mt][3] + t[3] + __uint_as_float(kh[mt].y & 0xffff0000u); }
    }
#pragma unroll
    for (int mt = 0; mt < 8; ++mt)
#pragma unroll
        for (int r = 0; r < 4; ++r) st[(size_t)(16 * mt + 4 * q4 + r) * 128 + 16 * w + l15] = S[mt][r];
    __syncthreads();
}

constexpr int RL_AT = 0, RL_BT = 9216, RL_KT = 18432, RL_ATT = 27648, RL_RT = 36864, RL_BTLT = 46080, RL_KTLT = 55296, RL_VT = 64512, RL_LAK = 73728, RL_MRB = 82944, RL_MRK = 92160,
              RL_LM = 101376, RL_AF = 117760, RL_TM = 134144, RL_XS = 150528;
__device__ __forceinline__ void rwkv_prep_item(const Params& p, unsigned char* smem, int hb, int row_start, int npad, const bf16_t* prev_row,
                                               bf16_t* halo_out, unsigned char* rec) {
    const int tid = otid(), w = tid >> 6, lane = tid & 63, q4 = lane >> 4, l15 = lane & 15;
    bf16_t* At = (bf16_t*)(smem + RL_AT); bf16_t* Tb = At; bf16_t* Bt = (bf16_t*)(smem + RL_BT); bf16_t* WaT = Bt; bf16_t* Kt = (bf16_t*)(smem + RL_KT); bf16_t* XT = Kt;
    bf16_t* AtT = (bf16_t*)(smem + RL_ATT); bf16_t* Rt = (bf16_t*)(smem + RL_RT); bf16_t* BtlT = (bf16_t*)(smem + RL_BTLT); bf16_t* KtlT = (bf16_t*)(smem + RL_KTLT);
    bf16_t* VT = (bf16_t*)(smem + RL_VT); bf16_t* Lak = (bf16_t*)(smem + RL_LAK); bf16_t* Mrb = (bf16_t*)(smem + RL_MRB); bf16_t* Mrk = (bf16_t*)(smem + RL_MRK);
    float* Lm = (float*)(smem + RL_LM);
    bf16_t* thw = Lak; bf16_t* adb = Mrb; float* lc = Lm; float* af = (float*)(smem + RL_AF);
    const bf16_t* P = (const bf16_t*)(p.ws + WS_P);
    const float* pk = (const float*)(p.ws + WS_PK);
    const int t = tid >> 3, g = tid & 7;
    float rr[8], kb[8], vv[8], zb[8];
    {
        const bool real = t >= npad;
        const bf16_t* curp = P; const bf16_t* prevp = P; float fprev = 0.f;
        if (real) { curp = P + (size_t)(row_start + t - npad) * NPB; if (t > npad) { prevp = curp - NPB; fprev = 1.f; } else if (prev_row) { prevp = prev_row; fprev = 1.f; } }
        const int secbase[6] = {0, 1024, 2048, 3200, 3072, 3136};
        u32x4 rc[6], rp[6];
#pragma unroll
        for (int sidx = 0; sidx < 6; ++sidx) { const int col = secbase[sidx] + (sidx < 4 ? hb * 64 : 0) + g * 8; rc[sidx] = *(const u32x4*)(curp + C_RW + col); rp[sidx] = *(const u32x4*)(prevp + C_RW + col); }
        float m[6][8];
#pragma unroll
        for (int sidx = 0; sidx < 6; ++sidx) {
            const int col = secbase[sidx] + (sidx < 4 ? hb * 64 : 0) + g * 8;
            float cur[8], prv[8];
            unpack8(rc[sidx], cur); unpack8(rp[sidx], prv);
            const f32x4 mu0 = *(const f32x4*)(pk + PK_MU + col), mu1 = *(const f32x4*)(pk + PK_MU + col + 4);
            const float mu[8] = {mu0[0], mu0[1], mu0[2], mu0[3], mu1[0], mu1[1], mu1[2], mu1[3]};
#pragma unroll
            for (int e = 0; e < 8; ++e) m[sidx][e] = real ? cur[e] + mu[e] * (fprev * prv[e] - cur[e]) : 0.f;
            if (halo_out && t == 63 && (sidx < 4 || hb == 0)) *(u32x4*)(halo_out + C_RW + col) = rc[sidx];
        }
#pragma unroll
        for (int e = 0; e < 8; ++e) { rr[e] = m[0][e]; kb[e] = m[1][e]; vv[e] = m[2][e]; zb[e] = m[3][e]; }
        float th[8];
#pragma unroll
        for (int e = 0; e < 8; ++e) th[e] = tanh_(m[4][e]);
        *(u32x4*)(thw + t * TSTR + g * 8) = pack8(th);
        *(u32x4*)(adb + t * TSTR + g * 8) = pack8(m[5]);
    }
    __syncthreads();
    {
        const int which = w >> 2, ct = w & 3;
        const bf16_t* Wt = (const bf16_t*)(p.ws + (which ? WS_A2T : WS_W2T)) + (size_t)hb * 4096;
        const bf16x8 b0 = *(const bf16x8*)(Wt + (16 * ct + l15) * 64 + 8 * q4), b1 = *(const bf16x8*)(Wt + (16 * ct + l15) * 64 + 32 + 8 * q4);
        const bf16_t* Aarr = which ? adb : thw;
        const int c = 16 * ct + l15;
        const float bias = pk[(which ? PK_A0 : PK_W0) + hb * 64 + c];
        float carry = 0.f;
#pragma unroll
        for (int tt = 0; tt < 4; ++tt) {
            f32x4 acc = {0.f, 0.f, 0.f, 0.f};
            acc = MFMA16(ldfrag(Aarr, TSTR, 16 * tt, 0, lane), b0, acc); acc = MFMA16(ldfrag(Aarr, TSTR, 16 * tt, 32, lane), b1, acc);
            if (which) {
#pragma unroll
                for (int r = 0; r < 4; ++r) af[(16 * tt + 4 * q4 + r) * 64 + c] = sigm(bias + acc[r]);
            } else {
                float wl[4];
#pragma unroll
                for (int r = 0; r < 4; ++r) { const int tk = 16 * tt + 4 * q4 + r; wl[r] = (tk < npad) ? 0.f : -0.6065306597126334f * sigm(bias + acc[r]); }
                wl[1] += wl[0]; wl[2] += wl[1]; wl[3] += wl[2];
                const float Q = wl[3];
                const float Q0 = __shfl(Q, l15), Q1 = __shfl(Q, l15 + 16), Q2 = __shfl(Q, l15 + 32), Q3 = __shfl(Q, l15 + 48);
                const float ex = carry + (q4 > 0 ? Q0 : 0.f) + (q4 > 1 ? Q1 : 0.f) + (q4 > 2 ? Q2 : 0.f);
#pragma unroll
                for (int r = 0; r < 4; ++r) lc[(16 * tt + 4 * q4 + r) * 64 + c] = ex + wl[r];
                carry += Q0 + Q1 + Q2 + Q3;
            }
        }
    }
    __syncthreads();
    {
        float lct[8], lcp[8], lcC[8], av[8];
        { const f32x4 a = *(const f32x4*)(lc + t * 64 + g * 8), b2 = *(const f32x4*)(lc + t * 64 + g * 8 + 4); lct[0] = a[0]; lct[1] = a[1]; lct[2] = a[2]; lct[3] = a[3]; lct[4] = b2[0]; lct[5] = b2[1]; lct[6] = b2[2]; lct[7] = b2[3]; }
        if (t > 0) { const f32x4 a = *(const f32x4*)(lc + (t - 1) * 64 + g * 8), b2 = *(const f32x4*)(lc + (t - 1) * 64 + g * 8 + 4); lcp[0] = a[0]; lcp[1] = a[1]; lcp[2] = a[2]; lcp[3] = a[3]; lcp[4] = b2[0]; lcp[5] = b2[1]; lcp[6] = b2[2]; lcp[7] = b2[3]; }
        else {
#pragma unroll
            for (int e = 0; e < 8; ++e) lcp[e] = 0.f; }
        { const f32x4 a = *(const f32x4*)(lc + 63 * 64 + g * 8), b2 = *(const f32x4*)(lc + 63 * 64 + g * 8 + 4); lcC[0] = a[0]; lcC[1] = a[1]; lcC[2] = a[2]; lcC[3] = a[3]; lcC[4] = b2[0]; lcC[5] = b2[1]; lcC[6] = b2[2]; lcC[7] = b2[3]; }
        { const f32x4 a = *(const f32x4*)(af + t * 64 + g * 8), b2 = *(const f32x4*)(af + t * 64 + g * 8 + 4); av[0] = a[0]; av[1] = a[1]; av[2] = a[2]; av[3] = a[3]; av[4] = b2[0]; av[5] = b2[1]; av[6] = b2[2]; av[7] = b2[3]; }
        const int hc = hb * 64 + g * 8;
        float kk[8], km[8], ss = 0.f, rk = 0.f;
#pragma unroll
        for (int e = 0; e < 8; ++e) { kk[e] = kb[e] * pk[PK_KK + hc + e]; ss += kk[e] * kk[e]; km[e] = kb[e] * (1.f + (av[e] - 1.f) * pk[PK_KA + hc + e]); rk += rr[e] * km[e] * pk[PK_RK + hc + e]; }
        ss += __shfl_xor(ss, 1); ss += __shfl_xor(ss, 2); ss += __shfl_xor(ss, 4);
        rk += __shfl_xor(rk, 1); rk += __shfl_xor(rk, 2); rk += __shfl_xor(rk, 4);
        const float kn = rsqrtf(ss + 1e-6f);
        float xa[8], xb[8], xk[8], xr[8], xbt[8], xkt[8];
#pragma unroll
        for (int e = 0; e < 8; ++e) { kk[e] *= kn; const float ka = kk[e] * av[e]; const float ip = __expf(-lct[e]), tl = __expf(lcC[e] - lct[e]);
            xa[e] = kk[e] * __expf(lcp[e]); xb[e] = ka * ip; xk[e] = km[e] * ip; xr[e] = rr[e] * __expf(lct[e]); xbt[e] = ka * tl; xkt[e] = km[e] * tl; }
        *(u32x4*)(At + t * TSTR + g * 8) = pack8(xa); *(u32x4*)(Bt + t * TSTR + g * 8) = pack8(xb); *(u32x4*)(Kt + t * TSTR + g * 8) = pack8(xk); *(u32x4*)(Rt + t * TSTR + g * 8) = pack8(xr);
#pragma unroll
        for (int e = 0; e < 8; ++e) { const int c = g * 8 + e; AtT[c * TSTR + t] = (bf16_t)f2bf(xa[e]); BtlT[c * TSTR + t] = (bf16_t)f2bf(xbt[e]); KtlT[c * TSTR + t] = (bf16_t)f2bf(xkt[e]); VT[c * TSTR + t] = (bf16_t)f2bf(vv[e]); }
        float c1[8], c0[8];
#pragma unroll
        for (int e = 0; e < 8; ++e) { const float sz = silu_(zb[e]); c1[e] = pk[PK_GNW + hc + e] * sz; c0[e] = (pk[PK_GNB + hc + e] + rk * vv[e]) * sz; }
        *(u32x4*)((bf16_t*)(rec + RP_C1) + t * 64 + g * 8) = pack8(c1); *(u32x4*)((bf16_t*)(rec + RP_C0) + t * 64 + g * 8) = pack8(c0);
        if (t == 63) { float* pc = (float*)(rec + RP_PC) + g * 8; *(f32x4*)pc = (f32x4){__expf(lcC[0]), __expf(lcC[1]), __expf(lcC[2]), __expf(lcC[3])}; *(f32x4*)(pc + 4) = (f32x4){__expf(lcC[4]), __expf(lcC[5]), __expf(lcC[6]), __expf(lcC[7])}; }
    }
    __syncthreads();
    {
        const int pr = w >> 1;
        const bf16_t* Aarr = pr < 2 ? At : Rt; const bf16_t* Barr = (pr & 1) ? Kt : Bt;
#pragma unroll
        for (int x = 0; x < 2; ++x) { const int tt = 2 * (w & 1) + x;
            const bf16x8 a0 = ldfrag(Aarr, TSTR, 16 * tt, 0, lane), a1 = ldfrag(Aarr, TSTR, 16 * tt, 32, lane);
#pragma unroll
            for (int it = 0; it < 4; ++it) { f32x4 acc = {0.f, 0.f, 0.f, 0.f};
                acc = MFMA16(a0, ldfrag(Barr, TSTR, 16 * it, 0, lane), acc); acc = MFMA16(a1, ldfrag(Barr, TSTR, 16 * it, 32, lane), acc);
                const int i = 16 * it + l15;
#pragma unroll
                for (int r = 0; r < 4; ++r) { const int tk = 16 * tt + 4 * q4 + r;
                    if (pr == 0) Lm[tk * 64 + i] = (tk > i) ? acc[r] : 0.f;
                    else if (pr == 1) Lak[tk * TSTR + i] = (bf16_t)f2bf((tk > i) ? acc[r] : 0.f);
                    else if (pr == 2) Mrb[tk * TSTR + i] = (bf16_t)f2bf((tk >= i) ? acc[r] : 0.f);
                    else Mrk[tk * TSTR + i] = (bf16_t)f2bf((tk >= i) ? acc[r] : 0.f); } }
        }
    }
    __syncthreads();
    {
        float* Tm = (float*)(smem + RL_TM);
        inv_block(Lm, Tm, (float*)(smem + RL_XS), tid);
        const int i = tid >> 3, j0 = (tid & 7) * 8;
        float a[8];
#pragma unroll
        for (int e = 0; e < 8; ++e) a[e] = Tm[i * 64 + j0 + e];
        *(u32x4*)(Tb + i * TSTR + j0) = pack8(a);
    }
    __syncthreads();
    {
        const int tt = w & 3, which = w >> 2;
        const bf16_t* Aarr = which ? Lak : Tb; const bf16_t* Barr = which ? VT : AtT; bf16_t* Out = which ? XT : WaT;
        const bf16x8 a0 = ldfrag(Aarr, TSTR, 16 * tt, 0, lane), a1 = ldfrag(Aarr, TSTR, 16 * tt, 32, lane);
#pragma unroll
        for (int ct = 0; ct < 4; ++ct) { f32x4 acc = {0.f, 0.f, 0.f, 0.f};
            acc = MFMA16(a0, ldfrag(Barr, TSTR, 16 * ct, 0, lane), acc); acc = MFMA16(a1, ldfrag(Barr, TSTR, 16 * ct, 32, lane), acc);
            *(u32x2*)(Out + (16 * ct + l15) * TSTR + 16 * tt + 4 * q4) = (u32x2){pk2(acc[0], acc[1]), pk2(acc[2], acc[3])}; }
    }
    __syncthreads();
    {
        f32x4 acc[4];
        if (w < 4) {
            const bf16x8 a0 = ldfrag(Tb, TSTR, 16 * w, 0, lane), a1 = ldfrag(Tb, TSTR, 16 * w, 32, lane);
#pragma unroll
            for (int ct = 0; ct < 4; ++ct) { acc[ct] = (f32x4){0.f, 0.f, 0.f, 0.f};
                acc[ct] = MFMA16(a0, ldfrag(XT, TSTR, 16 * ct, 0, lane), acc[ct]); acc[ct] = MFMA16(a1, ldfrag(XT, TSTR, 16 * ct, 32, lane), acc[ct]); }
        }
        __syncthreads();
        if (w < 4) {
#pragma unroll
            for (int ct = 0; ct < 4; ++ct) *(u32x2*)(XT + (16 * ct + l15) * TSTR + 16 * w + 4 * q4) = (u32x2){pk2(-acc[ct][0], -acc[ct][1]), pk2(-acc[ct][2], -acc[ct][3])};
        }
    }
    __syncthreads();
    {
        const bf16_t* UvT = XT;
        bf16_t* gAP = (bf16_t*)(rec + RP_AP); bf16_t* gRH = (bf16_t*)(rec + RP_RH); bf16_t* gKH = (bf16_t*)(rec + RP_KH); bf16_t* gYH = (bf16_t*)(rec + RP_YH);
        const int et = w & 3, part = w >> 2;
        {
            const bf16x8 a0 = ldfrag(WaT, TSTR, 16 * et, 0, lane), a1 = ldfrag(WaT, TSTR, 16 * et, 32, lane);
            if (part == 0) {
#pragma unroll
                for (int kt = 0; kt < 4; ++kt) { f32x4 acc = {0.f, 0.f, 0.f, 0.f};
                    acc = MFMA16(a0, ldfrag(BtlT, TSTR, 16 * kt, 0, lane), acc); acc = MFMA16(a1, ldfrag(BtlT, TSTR, 16 * kt, 32, lane), acc);
                    *(u32x2*)(gAP + ((size_t)(kt * 2 + (et >> 1)) * 64 + lane) * 8 + (et & 1) * 4) = (u32x2){pk2(-acc[0], -acc[1]), pk2(-acc[2], -acc[3])}; }
            } else {
#pragma unroll
                for (int tt = 0; tt < 4; ++tt) { f32x4 acc = {0.f, 0.f, 0.f, 0.f};
                    acc = MFMA16(a0, ldfrag(Mrb, TSTR, 16 * tt, 0, lane), acc); acc = MFMA16(a1, ldfrag(Mrb, TSTR, 16 * tt, 32, lane), acc);
                    const int tk = 16 * tt + l15, e0 = 16 * et + 4 * q4;
                    const u32x2 q2 = *(const u32x2*)(Rt + tk * TSTR + e0);
                    const float o0 = __uint_as_float(q2.x << 16) - acc[0], o1 = __uint_as_float(q2.x & 0xffff0000u) - acc[1], o2 = __uint_as_float(q2.y << 16) - acc[2], o3 = __uint_as_float(q2.y & 0xffff0000u) - acc[3];
                    *(u32x2*)(gRH + ((size_t)(tt * 2 + (et >> 1)) * 64 + lane) * 8 + (et & 1) * 4) = (u32x2){pk2(o0, o1), pk2(o2, o3)}; }
            }
        }
        {
            const int rt = w & 3;
            const bf16_t* A1 = part ? BtlT : Mrb; const bf16_t* A2 = part ? KtlT : Mrk; bf16_t* Out = part ? gKH : gYH;
            const bf16x8 a0 = ldfrag(A1, TSTR, 16 * rt, 0, lane), a1 = ldfrag(A1, TSTR, 16 * rt, 32, lane), a2 = ldfrag(A2, TSTR, 16 * rt, 0, lane), a3 = ldfrag(A2, TSTR, 16 * rt, 32, lane);
#pragma unroll
            for (int vt = 0; vt < 4; ++vt) { f32x4 acc = {0.f, 0.f, 0.f, 0.f};
                acc = MFMA16(a0, ldfrag(UvT, TSTR, 16 * vt, 0, lane), acc); acc = MFMA16(a1, ldfrag(UvT, TSTR, 16 * vt, 32, lane), acc);
                acc = MFMA16(a2, ldfrag(VT, TSTR, 16 * vt, 0, lane), acc); acc = MFMA16(a3, ldfrag(VT, TSTR, 16 * vt, 32, lane), acc);
                *(u32x2*)(Out + ((size_t)(vt * 4 + rt) * 64 + lane) * 4) = (u32x2){pk2(acc[0], acc[1]), pk2(acc[2], acc[3])}; }
        }
    }
    __syncthreads();
}

__device__ __forceinline__ void phase_rprep(const Params& p, int seg, unsigned char* smem) {
    const int blk = obid();
    const int n_items = (CPS + (seg == 0 ? 1 : 0)) * 128;
#pragma unroll 1
    for (int it = blk; it < n_items; it += gridDim.x) {
        const int bh = it & 127, b = bh >> 4, hb = bh & 15; int cl = it >> 7; if (seg != 0) cl += 1;
        unsigned char* rec = p.ws + WS_RP + (size_t)(cl * 128 + bh) * RP_STRIDE;
        const bf16_t* Pb = (const bf16_t*)(p.ws + WS_P);
        bf16_t* phalo2 = (bf16_t*)(p.ws + WS_PHALO);
        if (cl == 0) rwkv_prep_item(p, smem, hb, LEX0, 48, nullptr, nullptr, rec);
        else {
            const int row = b * SEGTOK + (cl - 1) * 64;
            const bf16_t* prow = Pb + (size_t)(row - 1) * NPB;
            if (cl == 1) prow = (seg == 0) ? Pb + (size_t)(LEX0 + NMETA - 1) * NPB : phalo2 + (size_t)(((seg - 1) & 1) * NBATCH + b) * NPB;
            bf16_t* ho = (cl == CPS) ? phalo2 + (size_t)((seg & 1) * NBATCH + b) * NPB : nullptr;
            rwkv_prep_item(p, smem, hb, row, 0, prow, ho, rec);
        }
    }
}

__device__ __forceinline__ void rwkv_scan_block(const Params& p, int seg, unsigned char* smem, int pairidx) {
    const int tid = otid(), w = tid >> 6, lane = tid & 63, q4 = lane >> 4, l15 = lane & 15;
    const int hsel = w >> 2, vt = w & 3;
    const int bh = pairidx * 2 + hsel, b = bh >> 4, hb = bh & 15;
    float* st = p.out + O_RWKV_P + (size_t)bh * 4096;
    f32x4 S[4];
    if (seg) {
#pragma unroll
        for (int mt = 0; mt < 4; ++mt) S[mt] = *(const f32x4*)(st + (size_t)(16 * vt + l15) * 64 + 16 * mt + 4 * q4);
    } else {
#pragma unroll
        for (int mt = 0; mt < 4; ++mt) S[mt] = (f32x4){0.f, 0.f, 0.f, 0.f};
    }
    const int c_lo = seg ? 1 : 0;
    float* ybuf = (float*)(smem + 32768) + hsel * (64 * 68);
#pragma unroll 1
    for (int cl = c_lo; cl <= CPS; ++cl) {
        const unsigned char* rec = p.ws + WS_RP + (size_t)(cl * 128 + bh) * RP_STRIDE;
        __syncthreads();
        {
            const u32x4* src = (const u32x4*)rec; u32x4* dst = (u32x4*)(smem + hsel * 16384); const int tl = tid & 255;
#pragma unroll
            for (int x = 0; x < 4; ++x) dst[tl + 256 * x] = src[tl + 256 * x];
        }
        const bf16_t* gKH = (const bf16_t*)(rec + RP_KH); const bf16_t* gYH = (const bf16_t*)(rec + RP_YH);
        u32x2 kh[4], yh[4]; f32x4 pc[4];
#pragma unroll
        for (int mt = 0; mt < 4; ++mt) { kh[mt] = *(const u32x2*)(gKH + ((size_t)(vt * 4 + mt) * 64 + lane) * 4); yh[mt] = *(const u32x2*)(gYH + ((size_t)(vt * 4 + mt) * 64 + lane) * 4);
            pc[mt] = *(const f32x4*)((const float*)(rec + RP_PC) + 16 * mt + 4 * q4); }
        bf16x8 Bf[2];
#pragma unroll
        for (int ks = 0; ks < 2; ++ks) { u32x4 tq; tq.x = pk2(S[2 * ks][0], S[2 * ks][1]); tq.y = pk2(S[2 * ks][2], S[2 * ks][3]); tq.z = pk2(S[2 * ks + 1][0], S[2 * ks + 1][1]); tq.w = pk2(S[2 * ks + 1][2], S[2 * ks + 1][3]);
            Bf[ks] = __builtin_bit_cast(bf16x8, tq); }
        __syncthreads();
        const bf16x8* AP = (const bf16x8*)(smem + hsel * 16384); const bf16x8* RH = (const bf16x8*)(smem + hsel * 16384 + RP_RH);
        if (cl > 0) {
#pragma unroll
            for (int tt = 0; tt < 4; ++tt) { f32x4 y = {0.f, 0.f, 0.f, 0.f};
                y = MFMA16(RH[(tt * 2 + 0) * 64 + lane], Bf[0], y); y = MFMA16(RH[(tt * 2 + 1) * 64 + lane], Bf[1], y);
                y[0] += __uint_as_float(yh[tt].x << 16); y[1] += __uint_as_float(yh[tt].x & 0xffff0000u); y[2] += __uint_as_float(yh[tt].y << 16); y[3] += __uint_as_float(yh[tt].y & 0xffff0000u);
#pragma unroll
                for (int r = 0; r < 4; ++r) ybuf[(16 * tt + 4 * q4 + r) * 68 + 16 * vt + l15] = y[r]; }
        }
#pragma unroll
        for (int mt = 0; mt < 4; ++mt) { f32x4 tq = {0.f, 0.f, 0.f, 0.f};
            tq = MFMA16(AP[(mt * 2 + 0) * 64 + lane], Bf[0], tq); tq = MFMA16(AP[(mt * 2 + 1) * 64 + lane], Bf[1], tq);
            S[mt][0] = pc[mt][0] * S[mt][0] + tq[0] + __uint_as_float(kh[mt].x << 16); S[mt][1] = pc[mt][1] * S[mt][1] + tq[1] + __uint_as_float(kh[mt].x & 0xffff0000u);
            S[mt][2] = pc[mt][2] * S[mt][2] + tq[2] + __uint_as_float(kh[mt].y << 16); S[mt][3] = pc[mt][3] * S[mt][3] + tq[3] + __uint_as_float(kh[mt].y & 0xffff0000u); }
        if (cl > 0) {
            __syncthreads();
            const int tl = tid & 255, tk = tl >> 2, g = tl & 3;
            f32x4 y[4]; float sm = 0.f;
#pragma unroll
            for (int j = 0; j < 4; ++j) { y[j] = *(const f32x4*)(ybuf + tk * 68 + 16 * g + 4 * j); sm += y[j][0] + y[j][1] + y[j][2] + y[j][3]; }
            sm += __shfl_xor(sm, 1); sm += __shfl_xor(sm, 2);
            const float mu = sm * (1.f / 64.f); float vs = 0.f;
#pragma unroll
            for (int j = 0; j < 4; ++j) { y[j] = y[j] - mu; vs += y[j][0] * y[j][0] + y[j][1] * y[j][1] + y[j][2] * y[j][2] + y[j][3] * y[j][3]; }
            vs += __shfl_xor(vs, 1); vs += __shfl_xor(vs, 2);
            const float rs = rsqrtf(vs * (1.f / 64.f) + 64e-5f);
            const bf16_t* c1p = (const bf16_t*)(rec + RP_C1) + tk * 64 + 16 * g; const bf16_t* c0p = (const bf16_t*)(rec + RP_C0) + tk * 64 + 16 * g;
            const u32x4 a0 = *(const u32x4*)c0p, a1 = *(const u32x4*)(c0p + 8), b0 = *(const u32x4*)c1p, b1 = *(const u32x4*)(c1p + 8);
            const unsigned c0w[8] = {a0.x, a0.y, a0.z, a0.w, a1.x, a1.y, a1.z, a1.w}, c1w[8] = {b0.x, b0.y, b0.z, b0.w, b1.x, b1.y, b1.z, b1.w};
            unsigned ow[8];
#pragma unroll
            for (int j = 0; j < 8; ++j) ow[j] = pk2(y[j >> 1][(j & 1) * 2] * rs * __uint_as_float(c1w[j] << 16) + __uint_as_float(c0w[j] << 16),
                                                     y[j >> 1][(j & 1) * 2 + 1] * rs * __uint_as_float(c1w[j] & 0xffff0000u) + __uint_as_float(c0w[j] & 0xffff0000u));
            const size_t grow = (size_t)b * SEQ + seg * SEGTOK + (cl - 1) * 64 + tk;
            bf16_t* ob = (bf16_t*)(p.ws + WS_OB) + grow * D + hb * 64 + 16 * g;
            *(u32x4*)ob = (u32x4){ow[0], ow[1], ow[2], ow[3]}; *(u32x4*)(ob + 8) = (u32x4){ow[4], ow[5], ow[6], ow[7]};
        }
    }
#pragma unroll
    for (int mt = 0; mt < 4; ++mt) *(f32x4*)(st + (size_t)(16 * vt + l15) * 64 + 16 * mt + 4 * q4) = S[mt];
    __syncthreads();
}

__device__ __forceinline__ void gdn_sample_item(const Params& p, unsigned char* smem, int bs, int h) {
    const int tid = otid(), w = tid >> 6, lane = tid & 63, kq = tid >> 7, v = tid & 127;
    float* qk_s = (float*)smem; float* v_s = qk_s + 1024; float* gb_s = v_s + 512; float* part = gb_s + 16; float* part2 = part + 512;
    const bf16_t* P = (const bf16_t*)(p.ws + WS_P);
    const float* pk = (const float*)(p.ws + WS_PK);
    const float* s_in = p.in[2] + (size_t)(bs * 8 + h) * 16384; float* s_out = p.out + O_GDN_S + (size_t)(bs * 8 + h) * 16384;
    const int row0 = LEX0 + EX_SAMP + bs * DECT;
    float s[32];
#pragma unroll
    for (int j = 0; j < 32; ++j) s[j] = s_in[(size_t)(kq * 32 + j) * 128 + v];
    if (tid < 384) {
        const int pcol = (tid >> 7) * 1024 + h * 128 + (tid & 127);
        const float* cw = pk + PK_CONVW; const float* hin = p.in[3] + (size_t)bs * 9216; float* hout = p.out + O_CONV_S + (size_t)bs * 9216;
        const float cw0 = cw[pcol], cw1 = cw[3072 + pcol], cw2 = cw[6144 + pcol], cw3 = cw[9216 + pcol];
        float x3 = hin[pcol], x2 = hin[3072 + pcol], x1 = hin[6144 + pcol];
        float xr[4];
#pragma unroll
        for (int i = 0; i < 4; ++i) xr[i] = bf2f(P[(size_t)(row0 + i) * NPB + pcol]);
#pragma unroll
        for (int i = 0; i < 4; ++i) { const float y = cw0 * x3 + cw1 * x2 + cw2 * x1 + cw3 * xr[i]; x3 = x2; x2 = x1; x1 = xr[i];
            if (tid < 256) qk_s[i * 256 + tid] = silu_(y); else v_s[i * 128 + (tid - 256)] = silu_(y); }
        hout[pcol] = x3; hout[3072 + pcol] = x2; hout[6144 + pcol] = x1;
    } else if (tid < 388) {
        const int i = tid - 384; const size_t r = (size_t)(row0 + i) * NPB;
        const float pa = bf2f(P[r + C_A + h]), pb = bf2f(P[r + C_B + h]);
        gb_s[2 * i] = __expf(-expf(pk[PK_ALOG + h]) * softplus_(pa + pk[PK_DTB + h])); gb_s[2 * i + 1] = sigm(pb);
    }
    __syncthreads();
    { const int i = w >> 1, which = w & 1; float* rp = qk_s + i * 256 + which * 128; const float a = rp[lane], b = rp[lane + 64];
      const float sc = rsqrtf(wave_sum(a * a + b * b) + 1e-6f) * (which == 0 ? 0.08838834764831845f : 1.f); rp[lane] = a * sc; rp[lane + 64] = b * sc; }
    __syncthreads();
#pragma unroll 1
    for (int i = 0; i < 4; ++i) {
        const float* kp = qk_s + i * 256 + 128 + kq * 32; const float* qp = qk_s + i * 256 + kq * 32;
        float pa = 0.f;
#pragma unroll
        for (int j4 = 0; j4 < 8; ++j4) { const f32x4 k4 = *(const f32x4*)(kp + 4 * j4); pa += k4[0] * s[4 * j4] + k4[1] * s[4 * j4 + 1] + k4[2] * s[4 * j4 + 2] + k4[3] * s[4 * j4 + 3]; }
        part[kq * 128 + v] = pa;
        __syncthreads();
        const float kS = part[v] + part[128 + v] + part[256 + v] + part[384 + v];
        const float a = gb_s[2 * i], c = gb_s[2 * i + 1] * (v_s[i * 128 + v] - a * kS);
        float po = 0.f;
#pragma unroll
        for (int j4 = 0; j4 < 8; ++j4) { const f32x4 k4 = *(const f32x4*)(kp + 4 * j4), q4v = *(const f32x4*)(qp + 4 * j4);
#pragma unroll
            for (int e = 0; e < 4; ++e) { s[4 * j4 + e] = a * s[4 * j4 + e] + k4[e] * c; po += q4v[e] * s[4 * j4 + e]; } }
        part2[kq * 128 + v] = po;
        __syncthreads();
        if (kq == 0) ((float*)(p.ws + WS_ORAW))[(size_t)(row0 + i) * D + h * 128 + v] = part2[v] + part2[128 + v] + part2[256 + v] + part2[384 + v];
    }
#pragma unroll
    for (int j = 0; j < 32; ++j) s_out[(size_t)(kq * 32 + j) * 128 + v] = s[j];
    __syncthreads();
}

constexpr int SR_R = 0, SR_KK = 4096, SR_V = 8192, SR_ZB = 12288, SR_DEC = 16384, SR_KA = 20480, SR_KM = 24576, SR_WD = 28672, SR_AD = 28928, SR_RK = 29184;
__device__ __forceinline__ void rwkv_sample_item(const Params& p, unsigned char* smem, int bs) {
    const int tid = otid(), w = tid >> 6, lane = tid & 63;
    float* f = (float*)smem;
    const bf16_t* P = (const bf16_t*)(p.ws + WS_P);
    const float* pk = (const float*)(p.ws + WS_PK);
    const int row0 = LEX0 + EX_SAMP + bs * DECT;
    const bf16_t* prow = P + (size_t)(LEX0 + EX_SHIFT + bs) * NPB + C_RW;
#pragma unroll 1
    for (int col = tid; col < RW_SHIFT; col += 512) {
        const float mu = pk[PK_MU + col]; float prev = bf2f(prow[col]);
        float cur[4];
#pragma unroll
        for (int i = 0; i < 4; ++i) cur[i] = bf2f(P[(size_t)(row0 + i) * NPB + C_RW + col]);
        float* dst; int stride = 1024; bool th = false;
        if (col < 1024) dst = f + SR_R + col; else if (col < 2048) dst = f + SR_KK + (col - 1024); else if (col < 3072) dst = f + SR_V + (col - 2048);
        else if (col < 3136) { dst = f + SR_WD + (col - 3072); stride = 64; th = true; } else if (col < 3200) { dst = f + SR_AD + (col - 3136); stride = 64; } else dst = f + SR_ZB + (col - 3200);
#pragma unroll
        for (int i = 0; i < 4; ++i) { float m = cur[i] + mu * (prev - cur[i]); prev = cur[i]; if (th) m = tanh_(m); dst[i * stride] = m; }
    }
    __syncthreads();
#pragma unroll 1
    for (int cc = 0; cc < 2; ++cc) {
        const int c = tid + 512 * cc;
        float aw[4] = {0.f, 0.f, 0.f, 0.f}, aa[4] = {0.f, 0.f, 0.f, 0.f};
#pragma unroll 8
        for (int l = 0; l < 64; ++l) { const float w2v = pk[PK_W2 + l * D + c], a2v = pk[PK_A2 + l * D + c];
#pragma unroll
            for (int i = 0; i < 4; ++i) { aw[i] += f[SR_WD + i * 64 + l] * w2v; aa[i] += f[SR_AD + i * 64 + l] * a2v; } }
        const float w0c = pk[PK_W0 + c], a0c = pk[PK_A0 + c], kkc = pk[PK_KK + c], kac = pk[PK_KA + c];
#pragma unroll
        for (int i = 0; i < 4; ++i) { const float a = sigm(a0c + aa[i]); const float kbv = f[SR_KK + i * 1024 + c];
            f[SR_DEC + i * 1024 + c] = __expf(-0.6065306597126334f * sigm(w0c + aw[i])); f[SR_KA + i * 1024 + c] = a; f[SR_KK + i * 1024 + c] = kbv * kkc; f[SR_KM + i * 1024 + c] = kbv * (1.f + (a - 1.f) * kac); }
    }
    __syncthreads();
#pragma unroll 1
    for (int x = 0; x < 8; ++x) { const int pr = w * 8 + x, i = pr >> 4, hh = pr & 15; const int o = i * 1024 + hh * 64 + lane;
        const float kr = f[SR_KK + o]; const float kk = kr * rsqrtf(wave_sum(kr * kr) + 1e-6f); f[SR_KK + o] = kk; f[SR_KA + o] = kk * f[SR_KA + o];
        const float rkv = wave_sum(f[SR_R + o] * f[SR_KM + o] * pk[PK_RK + hh * 64 + lane]); if (lane == 0) f[SR_RK + pr] = rkv; }
    __syncthreads();
#pragma unroll 1
    for (int hp = 0; hp < 2; ++hp) {
        const int hb = hp * 8 + w;
        const float* s_in = p.in[4] + (size_t)(bs * 16 + hb) * 4096 + (size_t)lane * 64; float* s_out = p.out + O_RWKV_S + (size_t)(bs * 16 + hb) * 4096 + (size_t)lane * 64;
        f32x4 S[16];
#pragma unroll
        for (int j = 0; j < 16; ++j) S[j] = *(const f32x4*)(s_in + 4 * j);
        const int cch = hb * 64 + lane;
        const float gnw = pk[PK_GNW + cch], gnb = pk[PK_GNB + cch];
#pragma unroll 1
        for (int i = 0; i < 4; ++i) {
            const int o = i * 1024 + hb * 64;
            const float vv = f[SR_V + o + lane], rk = f[SR_RK + i * 16 + hb];
            float sa = 0.f;
#pragma unroll
            for (int j = 0; j < 16; ++j) { const f32x4 kk4 = *(const f32x4*)(f + SR_KK + o + 4 * j); sa += S[j][0] * kk4[0] + S[j][1] * kk4[1] + S[j][2] * kk4[2] + S[j][3] * kk4[3]; }
            float y = 0.f;
#pragma unroll
            for (int j = 0; j < 16; ++j) { const f32x4 de4 = *(const f32x4*)(f + SR_DEC + o + 4 * j), ka4 = *(const f32x4*)(f + SR_KA + o + 4 * j), km4 = *(const f32x4*)(f + SR_KM + o + 4 * j), r4 = *(const f32x4*)(f + SR_R + o + 4 * j);
#pragma unroll
                for (int e = 0; e < 4; ++e) { S[j][e] = S[j][e] * de4[e] + (vv * km4[e] - sa * ka4[e]); y += S[j][e] * r4[e]; } }
            const float mu = wave_sum(y) * (1.f / 64.f); const float dy = y - mu;
            const float rs = rsqrtf(wave_sum(dy * dy) * (1.f / 64.f) + 64e-5f);
            const float ov = (dy * rs * gnw + gnb + rk * vv) * silu_(f[SR_ZB + i * 1024 + cch]);
            ((bf16_t*)(p.ws + WS_OB))[(size_t)(XROWS + EX_SAMP + bs * DECT + i) * D + cch] = (bf16_t)f2bf(ov);
        }
#pragma unroll
        for (int j = 0; j < 16; ++j) *(f32x4*)(s_out + 4 * j) = S[j];
    }
    __syncthreads();
}

__device__ __forceinline__ void phase2(const Params& p, int seg, unsigned char* smem) {
    const int blk = obid();
    float* out = p.out;
    float* chalo = (float*)(p.ws + WS_CHALO); float* phalo = (float*)(p.ws + WS_PHALO);
#ifndef SUB
#define SUB 0
#endif
#define SEN(x) (SUB == 0 || SUB == (x))
    if (SEN(1) && blk < 64) gdn_scan_block(p, seg, smem, blk);
    if (SEN(3) && blk >= 64 && blk < 128) rwkv_scan_block(p, seg, smem, blk - 64);
#ifndef DUP
#define DUP 0
#endif
    if (seg == 0) {
#pragma unroll 1
        for (int it = blk; it < DECB * 8; it += gridDim.x) gdn_sample_item(p, smem, it >> 3, it & 7);
#pragma unroll 1
        for (int it = (blk + 128) & 255; it < DECB; it += gridDim.x) rwkv_sample_item(p, smem, it);
    }
}

__device__ __forceinline__ void phase25(const Params& p, int seg) {
    const int tid0 = otid(); const int lane = tid0 & 63; const int gw = obid() * 8 + (tid0 >> 6), NGW = gridDim.x * 8;
    const bf16_t* P = (const bf16_t*)(p.ws + WS_P);
    const float* ORAW = (const float*)(p.ws + WS_ORAW); const float* YRAW = (const float*)(p.ws + WS_YRAW);
    const bf16_t* C0 = (const bf16_t*)(p.ws + WS_C0); const bf16_t* C1 = (const bf16_t*)(p.ws + WS_C1);
    bf16_t* OA = (bf16_t*)(p.ws + WS_H); bf16_t* OB = (bf16_t*)(p.ws + WS_OB);
    const int nrows = LEX0 + (seg == 0 ? DECB * DECT : 0);
    const int c = lane * 16;
    f32x4 nw[4];
#pragma unroll
    for (int j = 0; j < 4; ++j) nw[j] = *(const f32x4*)((const float*)(p.ws + WS_PK) + PK_NORMW + (c & 127) + 4 * j);
#pragma unroll 1
    for (int rr = LEX0 + gw; rr < nrows; rr += NGW) {
        int lr; size_t grow;
        if (rr < LEX0) { lr = rr; grow = (size_t)(rr / SEGTOK) * SEQ + seg * SEGTOK + (rr % SEGTOK); } else { lr = LEX0 + EX_SAMP + (rr - LEX0); grow = (size_t)XROWS + EX_SAMP + (rr - LEX0); }
        {
            f32x4 o[4]; float ss = 0.f;
#pragma unroll
            for (int j = 0; j < 4; ++j) { o[j] = *(const f32x4*)(ORAW + (size_t)lr * D + c + 4 * j); ss += o[j][0] * o[j][0] + o[j][1] * o[j][1] + o[j][2] * o[j][2] + o[j][3] * o[j][3]; }
            ss += __shfl_xor(ss, 1); ss += __shfl_xor(ss, 2); ss += __shfl_xor(ss, 4);
            const float rs = rsqrtf(ss * (1.f / 128.f) + 1e-6f);
            const u32x4 z0 = *(const u32x4*)(P + (size_t)lr * NPB + C_Z + c), z1 = *(const u32x4*)(P + (size_t)lr * NPB + C_Z + c + 8);
            const unsigned zz[8] = {z0.x, z0.y, z0.z, z0.w, z1.x, z1.y, z1.z, z1.w};
            unsigned ow[8];
#pragma unroll
            for (int j = 0; j < 8; ++j) { const float za = __uint_as_float(zz[j] << 16), zb = __uint_as_float(zz[j] & 0xffff0000u);
                const float a = o[j >> 1][(j & 1) * 2] * rs * nw[j >> 1][(j & 1) * 2] * silu_(za), b = o[j >> 1][(j & 1) * 2 + 1] * rs * nw[j >> 1][(j & 1) * 2 + 1] * silu_(zb);
                ow[j] = pk2(a, b); }
            *(u32x4*)(OA + grow * D + c) = (u32x4){ow[0], ow[1], ow[2], ow[3]}; *(u32x4*)(OA + grow * D + c + 8) = (u32x4){ow[4], ow[5], ow[6], ow[7]};
        }
    }
}

__device__ __forceinline__ void phase_final(const Params& p) {
    const int tid0 = otid(); const int lane = tid0 & 63; const int gw = obid() * 8 + (tid0 >> 6), NGW = gridDim.x * 8;
    const f32x4* wr = (const f32x4*)((const float*)(p.ws + WS_PK) + PK_LNF) + lane;
#pragma unroll 1
    for (int r = gw; r < XROWS + DECB * DECT; r += NGW) {
        f32x4* xr = (f32x4*)(p.out + (size_t)r * D) + lane;
        f32x4 v[4]; float ss = 0.f;
#pragma unroll
        for (int j = 0; j < 4; ++j) { v[j] = xr[64 * j]; ss += v[j][0] * v[j][0] + v[j][1] * v[j][1] + v[j][2] * v[j][2] + v[j][3] * v[j][3]; }
        const float rs = rsqrtf(wave_sum(ss) * (1.f / D) + 1e-6f);
#pragma unroll
        for (int j = 0; j < 4; ++j) xr[64 * j] = v[j] * rs * wr[64 * j];
    }
}

__global__ __launch_bounds__(512, 2) void hybrid_mega(Params p) {
    extern __shared__ __attribute__((aligned(16))) unsigned char smem[];
    cg::grid_group grid = cg::this_grid();
    LAS unsigned char* lds = (LAS unsigned char*)smem;
    const int G = gridDim.x;
    volatile LAS unsigned* xst = (volatile LAS unsigned*)(lds + (LDS_TOTAL - 16));
    if (threadIdx.x == 0) { xst[0] = 0u; xst[1] = 0u; }
    __syncthreads();
    (void)xcd_barrier_post((unsigned*)(p.ws + WS_BAR), xst);
    if (G == 0x7fffffff) grid.sync();
#define GSYNC() do { XcdBarrier xb_; xb_.bar = (unsigned*)(p.ws + WS_BAR); xb_.x = xb_xcc_id(); xb_.st = (volatile LAS unsigned*)((LAS unsigned char*)smem + (LDS_TOTAL - 16)); xcd_barrier(xb_); } while (0)

#ifndef ONLY
#define ONLY 0
#endif
#define EN(x) (ONLY == 0 || ONLY == (x))
    if (EN(1)) phase0(p, smem);
    GSYNC();
#pragma unroll 1
    for (int seg = 0; seg < NSEG; ++seg) {
#pragma unroll 1
        for (int rep = 0; rep < (DUP == 3 ? 2 : 1); ++rep)
        if (EN(2)) {
            SchedIn S; S.ob.init(seg == 0 ? LT_PROMPT + 3 : LT_PROMPT, NT_IN, G, obid()); S.seg = seg; S.A = (const char*)(p.ws + WS_H); S.B = (const char*)(p.ws + WS_WT_IN);
            EpiIn E; E.P = (bf16_t*)(p.ws + WS_P); E.gex = (bf16_t*)(p.ws + WS_GEX); E.out = p.out; E.seg = seg;
            pg8::gemm_phase<EpiIn, SchedIn>(lds, D, S, E);
        }
        GSYNC();
#pragma unroll 1
        for (int rep = 0; rep < (DUP == 3 ? 2 : 1); ++rep)
        if (EN(8)) { phase_gprep(p, seg, smem); phase_rprep(p, seg, smem); }
        GSYNC();
        if (EN(3)) phase2(p, seg, smem);
        GSYNC();
        if (seg == 0) {
            if (EN(4)) phase25(p, seg);
            GSYNC();
        }
    }
    if (EN(5)) {
        SchedAB S; S.ob.init(HTILES, 4, G, obid()); S.A0 = (const char*)(p.ws + WS_H); S.A1 = (const char*)(p.ws + WS_OB); S.B0 = (const char*)(p.ws + WS_WT_A); S.B1 = (const char*)(p.ws + WS_WT_B);
        EpiAB E; E.tmp = (float*)(p.ws + WS_P); E.merged = (bf16_t*)(p.ws + WS_MG); E.gex = (const bf16_t*)(p.ws + WS_GEX); E.out = p.out;
        pg8::gemm_phase<EpiAB, SchedAB>(lds, D, S, E);
    }
    GSYNC();
    if (EN(6)) {
        SchedO S; S.ob.init(HTILES, 4, G, obid()); S.A = (const char*)(p.ws + WS_MG); S.B = (const char*)(p.ws + WS_WT_O);
        EpiO E; E.out = p.out; E.xp = p.in[0]; E.xs = p.in[1];
        pg8::gemm_phase<EpiO, SchedO>(lds, D, S, E);
    }
    GSYNC();
    if (EN(7)) phase_final(p);
}

extern "C" void kernel_launch(void* const* d_in, const int* in_sizes, int n_in, void* d_out, int out_size, void* d_ws, size_t ws_size, hipStream_t stream) {
    static int grid_blocks = 0;
    constexpr int LDS_BYTES = LDS_TOTAL;
    if (grid_blocks == 0) {
        if (n_in != 27 || ws_size < WS_END) { fprintf(stderr, "kernel_launch: unexpected n_in %d / ws %zu (need %zu)\n", n_in, ws_size, (size_t)WS_END); grid_blocks = -1; return; }
        if (hipFuncSetAttribute((const void*)hybrid_mega, hipFuncAttributeMaxDynamicSharedMemorySize, LDS_BYTES) != hipSuccess) { fprintf(stderr, "kernel_launch: hipFuncSetAttribute failed\n"); grid_blocks = -1; return; }
        int dev = 0, cus = 0, per_cu = 0;
        hipGetDevice(&dev);
        hipDeviceGetAttribute(&cus, hipDeviceAttributeMultiprocessorCount, dev);
        hipOccupancyMaxActiveBlocksPerMultiprocessor(&per_cu, (const void*)hybrid_mega, 512, LDS_BYTES);
        if (per_cu < 1) { fprintf(stderr, "kernel_launch: occupancy query says %d blocks/CU\n", per_cu); per_cu = 1; }
        (void)hipGetLastError();
        grid_blocks = cus;
    }
    if (grid_blocks < 0) return;
    Params p{};
    for (int i = 0; i < 27; ++i) p.in[i] = (const float*)d_in[i];
    p.out = (float*)d_out; p.ws = (unsigned char*)d_ws;
    if (hipMemsetAsync((unsigned char*)d_ws + WS_BAR, 0, 16384, stream) != hipSuccess) { fprintf(stderr, "kernel_launch: memset of the barrier words failed\n"); return; }
    void* args[] = {&p};
    hipError_t e = hipLaunchCooperativeKernel((const void*)hybrid_mega, dim3(grid_blocks), dim3(512), args, LDS_BYTES, stream);
    if (e != hipSuccess) fprintf(stderr, "cooperative launch failed: %s (grid %d)\n", hipGetErrorString(e), grid_blocks);
}
```

```cpp
#include <hip/hip_runtime.h>
#include <hip/hip_cooperative_groups.h>
#include <cstdio>
namespace cg = cooperative_groups;

#define LAS __attribute__((address_space(3)))
typedef unsigned short bf16_t;
typedef short bf16x8 __attribute__((ext_vector_type(8)));
typedef float f32x4 __attribute__((ext_vector_type(4)));
typedef unsigned u32x4 __attribute__((ext_vector_type(4)));
typedef unsigned u32x2 __attribute__((ext_vector_type(2)));

constexpr int D = 1024;
constexpr int NBATCH = 8, SEQ = 2048, NMETA = 16, DECB = 128, DECT = 4;
constexpr int XROWS = NBATCH * SEQ;
constexpr int EX_SAMP = 16, EX_SHIFT = 528, EX_END = 656;
constexpr int HROWS = 17152, HTILES = 67;
constexpr int NSEG = 8, SEGTOK = SEQ / NSEG;
constexpr int CPS = SEGTOK / 64;
constexpr int TPB = SEGTOK / 256;
constexpr int LT_PROMPT = NBATCH * TPB;
constexpr int LEX0 = LT_PROMPT * 256;
constexpr int LROWS = LEX0 + 768;
constexpr int NP = 10496, NPB = 8448, NT_IN = 41, NT_PB = 33;
constexpr int C_A = 3072, C_B = 3080, C_Z = 3088, C_RW = 4112, C_GATE_REF = 8336;
constexpr int RW_SHIFT = 4224;

constexpr size_t O_YP = 0, O_YS = 16777216, O_GDN_P = 17301504, O_CONV_P = 18350080, O_RWKV_P = 18423808, O_SHIFT_P = 18948096,
                 O_GDN_S = 18956288, O_CONV_S = 35733504, O_RWKV_S = 36913152, O_SHIFT_S = 45301760;

constexpr size_t al256(size_t x) { return (x + 255) & ~(size_t)255; }
constexpr size_t WS_WT_IN = 0;
constexpr size_t WS_WT_A = al256(WS_WT_IN + (size_t)NP * D * 2);
constexpr size_t WS_WT_B = al256(WS_WT_A + (size_t)D * D * 2);
constexpr size_t WS_WT_O = al256(WS_WT_B + (size_t)D * D * 2);
constexpr size_t WS_H = al256(WS_WT_O + (size_t)D * D * 2);
constexpr size_t WS_OB = al256(WS_H + (size_t)HROWS * D * 2);
constexpr size_t WS_P = al256(WS_OB + (size_t)HROWS * D * 2);
constexpr size_t WS_ORAW = al256(WS_P + (size_t)LROWS * NPB * 2);
constexpr size_t WS_YRAW = al256(WS_ORAW + (size_t)LROWS * D * 4);
constexpr size_t WS_C0 = al256(WS_YRAW + (size_t)LROWS * D * 4);
constexpr size_t WS_C1 = al256(WS_C0 + (size_t)LROWS * D * 2);
constexpr size_t WS_GEX = al256(WS_C1 + (size_t)LROWS * D * 2);
constexpr size_t WS_CHALO = al256(WS_GEX + (size_t)768 * 2048 * 2);
constexpr size_t WS_PHALO = al256(WS_CHALO + (size_t)2 * NBATCH * 3 * NPB * 2);
constexpr size_t WS_PK = al256(WS_PHALO + (size_t)2 * NBATCH * NPB * 2);
constexpr int PK_CONVW = 0, PK_ALOG = 12288, PK_DTB = 12296, PK_NORMW = 12304, PK_MU = 12432, PK_W0 = 16656, PK_W2 = 17680, PK_A0 = 83216, PK_A2 = 84240,
              PK_KK = 149776, PK_KA = 150800, PK_RK = 151824, PK_GNW = 152848, PK_GNB = 153872, PK_LNF = 154896, PK_END = 155920;
constexpr size_t WS_BAR = al256(WS_PK + (size_t)PK_END * 4);
constexpr size_t WS_W2T = al256(WS_BAR + 16384);
constexpr size_t WS_A2T = al256(WS_W2T + 131072);
constexpr size_t WS_GP = al256(WS_A2T + 131072);
constexpr int GP_AP = 0, GP_QH = 32768, GP_KH = 49152, GP_OH = 81920, GP_EGL = 98304, GP_G = 98560, GP_STRIDE = 114944;
constexpr int RP_AP = 0, RP_RH = 8192, RP_KH = 16384, RP_YH = 24576, RP_C1 = 32768, RP_C0 = 40960, RP_PC = 49152, RP_STRIDE = 49408;
constexpr size_t WS_RP = al256(WS_GP + (size_t)(CPS + 1) * 64 * GP_STRIDE);
constexpr size_t WS_END = al256(WS_RP + (size_t)(CPS + 1) * 128 * RP_STRIDE);
constexpr size_t WS_MG = WS_GP;
static_assert((size_t)HROWS * D * 2 <= WS_END - WS_GP, "MERGED must fit in the prep records");
static_assert((size_t)HROWS * D * 4 <= (size_t)LROWS * NPB * 2 + 2 * (size_t)LROWS * D * 4, "TMP must fit in P+ORAW+YRAW");
static_assert(WS_END <= (size_t)268435456, "workspace");

constexpr int LDS_TOTAL = 163840;
struct Params { const float* in[27]; float* out; unsigned char* ws; };

__device__ __forceinline__ float bf2f(bf16_t v) { return __uint_as_float(((unsigned)v) << 16); }
typedef __bf16 bf16n2 __attribute__((ext_vector_type(2)));
typedef float f32n2 __attribute__((ext_vector_type(2)));
__device__ __forceinline__ unsigned cvt_pk_bf16(float lo, float hi) { const f32n2 v = {lo, hi}; return __builtin_bit_cast(unsigned, __builtin_convertvector(v, bf16n2)); }
__device__ __forceinline__ unsigned pk2(float lo, float hi) { return cvt_pk_bf16(lo, hi); }
__device__ __forceinline__ unsigned f2bf(float f) { return cvt_pk_bf16(f, 0.f) & 0xffffu; }
__device__ __forceinline__ float sigm(float x) { return 1.f / (1.f + __expf(-x)); }
__device__ __forceinline__ float silu_(float x) { return x / (1.f + __expf(-x)); }
__device__ __forceinline__ float softplus_(float x) { return fmaxf(x, 0.f) + log1pf(expf(-fabsf(x))); }
__device__ __forceinline__ float wave_sum(float v) {
#pragma unroll
    for (int o = 1; o < 64; o <<= 1) v += __shfl_xor(v, o);
    return v;
}
__device__ __forceinline__ int otid() { int t = threadIdx.x; asm volatile("" : "+v"(t)); return t; }
__device__ __forceinline__ int obid() { int t = blockIdx.x; asm volatile("" : "+s"(t)); return t; }
__device__ __forceinline__ float tanh_(float x) { const float e = __expf(2.f * x); return 1.f - 2.f / (e + 1.f); }
template <int CTRL> __device__ __forceinline__ float dppf(float x) { return __builtin_bit_cast(float, __builtin_amdgcn_mov_dpp(__builtin_bit_cast(int, x), CTRL, 0xf, 0xf, true)); }
__device__ __forceinline__ float rowsum16(float x) { x += dppf<0x128>(x); x += dppf<0x124>(x); x += dppf<0x122>(x); x += dppf<0x121>(x); return x; }


#define XB_TMO      128
#define XB_XCNT(j)  (256  + 64 * (j))
#define XB_XSUB(j)  (1280 + 64 * (j))
#define XB_XGEN(j)  (2304 + 64 * (j))
#define XB_TOP      3328
#define XB_TOPGEN   3392
#define XCD_BAR_WORDS 3456
#define XB_SPIN_CAP (1u << 22)
__device__ __forceinline__ unsigned xb_ld(unsigned* p)              { return __hip_atomic_load(p, __ATOMIC_RELAXED, __HIP_MEMORY_SCOPE_AGENT); }
__device__ __forceinline__ unsigned xb_add(unsigned* p, unsigned v) { return __hip_atomic_fetch_add(p, v, __ATOMIC_RELAXED, __HIP_MEMORY_SCOPE_AGENT); }
__device__ __forceinline__ unsigned xb_xcc_id() { return (unsigned)__builtin_amdgcn_s_getreg((3 << 11) | 20) & 0xFu; }
#define XB_SPIN(cond, bar) do { unsigned _sp = 0; while (cond) { __builtin_amdgcn_s_sleep(1); \
    if ((++_sp & 255u) == 0u) { if (xb_ld(&(bar)[XB_TMO])) break; if (_sp > XB_SPIN_CAP) { atomicAdd(&(bar)[XB_TMO], 1u); break; } } } } while (0)
struct XcdBarrier { unsigned* bar; unsigned x; volatile LAS unsigned* st; };
__device__ __forceinline__ XcdBarrier xcd_barrier_post(unsigned* bar, volatile LAS unsigned* st) {
    XcdBarrier b; b.bar = bar; b.x = xb_xcc_id(); b.st = st;
    if (threadIdx.x == 0) (void)xb_add(&bar[XB_XCNT(b.x)], 1u);
    return b;
}
__device__ __forceinline__ void xcd_barrier_complete(unsigned* bar, unsigned x, unsigned& nloc, unsigned& nx) {
    const unsigned G = gridDim.x * gridDim.y * gridDim.z;
    unsigned sum, cnt, mine, sp = 0u;
    for (;;) {
        sum = 0u; cnt = 0u; mine = 0u;
#pragma unroll
        for (unsigned j = 0; j < 16; ++j) { const unsigned c = xb_ld(&bar[XB_XCNT(j)]); sum += c; cnt += (c > 0u) ? 1u : 0u; mine = (j == x) ? c : mine; }
        if (sum == G) break;
        __builtin_amdgcn_s_sleep(1);
        if ((++sp & 255u) == 0u) { if (xb_ld(&bar[XB_TMO])) break; if (sp > XB_SPIN_CAP) { atomicAdd(&bar[XB_TMO], 1u); break; } }
    }
    nloc = mine > 0u ? mine : 1u; nx = cnt > 0u ? cnt : 1u;
}
__device__ __forceinline__ void xcd_barrier(const XcdBarrier& b) {
    asm volatile("s_waitcnt vmcnt(0)" ::: "memory");
    __syncthreads();
    if (threadIdx.x == 0) {
        unsigned* bar = b.bar;
        __builtin_amdgcn_s_waitcnt(0);
        unsigned nloc = b.st[0], nx = b.st[1];
        if (nloc == 0u) { xcd_barrier_complete(bar, b.x, nloc, nx); b.st[0] = nloc; b.st[1] = nx; }
        const unsigned old = xb_add(&bar[XB_XSUB(b.x)], 1u);
        const unsigned gen = old / nloc;
        if (old + 1u == (gen + 1u) * nloc) {
            __builtin_amdgcn_fence(__ATOMIC_RELEASE, "agent");
            asm volatile("s_waitcnt vmcnt(0)" ::: "memory");
            const unsigned og = xb_add(&bar[XB_TOP], 1u);
            const unsigned tg = og / nx;
            if (og + 1u == (tg + 1u) * nx) xb_add(&bar[XB_TOPGEN], 1u);
            else XB_SPIN(xb_ld(&bar[XB_TOPGEN]) == tg, bar);
            __builtin_amdgcn_fence(__ATOMIC_ACQUIRE, "agent");
            xb_add(&bar[XB_XGEN(b.x)], 1u);
            asm volatile("s_waitcnt vmcnt(0)" ::: "memory");
        } else {
            XB_SPIN(xb_ld(&bar[XB_XGEN(b.x)]) == gen, bar);
            __builtin_amdgcn_fence(__ATOMIC_ACQUIRE, "agent");
            asm volatile("s_waitcnt vmcnt(0)" ::: "memory");
        }
    }
    __syncthreads();
}

namespace pg8 {
constexpr int BM = 256, BK = 64, HALF = 128, HTB = HALF * BK * 2, STAGE_BYTES = 8 * HTB, NXCD = 8, WGM = 8;
__device__ __forceinline__ int lds_byte(int r, int c) { const int st = (r >> 4) * 2 + (c >> 5), rr = r & 15, cc = c & 31, ob = rr * 64 + cc * 2; return st * 1024 + (ob ^ (((ob >> 9) & 1) << 5)); }
__device__ __forceinline__ void stage_rc(int b, int& R, int& C) { const int st = b / 1024, sb = b % 1024, swz = sb ^ (((sb >> 9) & 1) << 5); R = (st >> 1) * 16 + swz / 64; C = (st & 1) * 32 + (swz % 64) / 2; }
__device__ __forceinline__ int perm32(int rho) { const int n = rho >> 4, i = rho & 15; return 8 * (i >> 2) + 4 * n + (i & 3); }

struct Unit { int pm, pn, w; };
struct OrderBase {
    int nM, nN, nwg, G, c;
    __device__ void init(int nM_, int nN_, int G_, int c_) { nM = nM_; nN = nN_; nwg = nM * nN; G = G_; c = c_; }
    __device__ bool nextb(int i, Unit& u) const {
        const long L = (long)i * G + c; if (L >= nwg) return false;
        int wgid = (int)L; { const int q = nwg / NXCD, r = nwg % NXCD, xcd = wgid % NXCD, off = wgid / NXCD; wgid = (xcd < r ? xcd * (q + 1) : r * (q + 1) + (xcd - r) * q) + off; }
        const int nig = WGM * nN, gid = wgid / nig, fm = gid * WGM, gsz = (nM - fm) < WGM ? (nM - fm) : WGM;
        u.pm = fm + ((wgid % nig) % gsz); u.pn = (wgid % nig) / gsz; u.w = 0; return true;
    }
};

template <class Epi, class Sched>
__device__ __forceinline__ void gemm_phase(LAS unsigned char* lds, const int K, const Sched& S, const Epi& E) {
    const int tid = otid(), wid = __builtin_amdgcn_readfirstlane(tid >> 6), lane = tid & 63, wr = wid >> 2, wc = wid & 3, fr = lane & 15, fq = lane >> 4;
    const int nt = K / BK;
    unsigned voffA[2], voffB[2];
#pragma unroll
    for (int i = 0; i < 2; ++i) { int R, C; stage_rc(tid * 16 + i * 8192, R, C); const int Rb = Epi::PERM ? ((R & ~31) + perm32(R & 31)) : R;
        voffA[i] = (unsigned)(R * K + C) * 2u; voffB[i] = (unsigned)(Rb * K + C) * 2u; }
    const size_t kstep = (size_t)(BK * 2);
    const size_t hstep = (size_t)HALF * K * 2;
    const unsigned ldsw = (unsigned)wid * 1024u;
    const int aoff = lds_byte(wr * 64 + fr, fq * 8), boff = lds_byte(wc * 32 + fr, fq * 8);
#define PG8_SA(b, h) (((b) * 2 + (h)) * HTB)
#define PG8_SB(b, h) ((4 + (b) * 2 + (h)) * HTB)
#define PG8_STAGE(bufoff, gbase, voff) do { _Pragma("unroll") for (int _i = 0; _i < 2; ++_i) \
        __builtin_amdgcn_global_load_lds((const unsigned*)((const char*)(gbase) + (voff)[_i]), (LAS unsigned*)(lds + (bufoff) + ldsw + _i * 8192), 16, 0, 0); } while (0)
#define PG8_LDA(dst, b, h) do { _Pragma("unroll") for (int m = 0; m < 4; ++m) _Pragma("unroll") for (int k = 0; k < 2; ++k) dst[m][k] = *(const LAS bf16x8*)(lds + PG8_SA(b, h) + aoff + m * 2048 + k * 1024); } while (0)
#define PG8_LDB(dst, b, h) do { _Pragma("unroll") for (int n = 0; n < 2; ++n) _Pragma("unroll") for (int k = 0; k < 2; ++k) dst[n][k] = *(const LAS bf16x8*)(lds + PG8_SB(b, h) + boff + n * 2048 + k * 1024); } while (0)
#define PG8_MMA(ai, bj, At, Bt) do { __builtin_amdgcn_s_setprio(1); _Pragma("unroll") for (int m = 0; m < 4; ++m) _Pragma("unroll") for (int n = 0; n < 2; ++n) _Pragma("unroll") for (int k = 0; k < 2; ++k) \
        acc[ai][bj][m][n] = __builtin_amdgcn_mfma_f32_16x16x32_bf16(Bt[n][k], At[m][k], acc[ai][bj][m][n], 0, 0, 0); __builtin_amdgcn_s_setprio(0); } while (0)
#define PG8_WAIT_V(n) asm volatile("s_waitcnt vmcnt(" #n ")" ::: "memory")
#define PG8_WAIT_L(n) asm volatile("s_waitcnt lgkmcnt(" #n ")" ::: "memory")
#define PG8_BAR __builtin_amdgcn_s_barrier()
#define PG8_SCHED __builtin_amdgcn_sched_barrier(0)
    Unit cur, nxt; int ui = 0;
    if (!S.next(0, cur)) return;
    f32x4 acc[2][2][4][2];
#pragma unroll
    for (int a = 0; a < 2; ++a)
#pragma unroll
        for (int b = 0; b < 2; ++b)
#pragma unroll
            for (int m = 0; m < 4; ++m)
#pragma unroll
                for (int n = 0; n < 2; ++n) acc[a][b][m][n] = (f32x4){0.f, 0.f, 0.f, 0.f};
    bf16x8 At[4][2], B0[2][2], B1[2][2];
    const char* cA = S.a_ptr(cur); const char* cB = S.b_ptr(cur);
    PG8_STAGE(PG8_SB(0, 0), cB, voffB); PG8_STAGE(PG8_SA(0, 0), cA, voffA); PG8_STAGE(PG8_SB(0, 1), cB + hstep, voffB); PG8_STAGE(PG8_SA(0, 1), cA + hstep, voffA);
    if (wr == 1) PG8_BAR;
    PG8_WAIT_V(4); PG8_BAR;
    PG8_STAGE(PG8_SB(1, 0), cB + kstep, voffB); PG8_STAGE(PG8_SA(1, 0), cA + kstep, voffA); PG8_STAGE(PG8_SB(1, 1), cB + hstep + kstep, voffB);
    PG8_WAIT_V(6); PG8_BAR;
    for (;;) {
        const bool has_next = S.next(ui + 1, nxt);
        const char* nA = has_next ? S.a_ptr(nxt) : cA; const char* nB = has_next ? S.b_ptr(nxt) : cB;
        for (int t = 0; t < nt; t += 2) {
            const bool last = (t == nt - 2);
            const char* a1 = cA + (size_t)(t + 1) * kstep;
            const char* a2 = last ? nA : cA + (size_t)(t + 2) * kstep; const char* b2 = last ? nB : cB + (size_t)(t + 2) * kstep;
            const char* a3 = a2 + kstep; const char* b3 = b2 + kstep;
            PG8_LDB(B0, 0, 0); PG8_SCHED; PG8_LDA(At, 0, 0); PG8_STAGE(PG8_SA(1, 1), a1 + hstep, voffA);
            PG8_WAIT_L(8); PG8_BAR; PG8_WAIT_L(0); PG8_MMA(0, 0, At, B0); PG8_BAR; PG8_SCHED;
            PG8_LDB(B1, 0, 1); PG8_STAGE(PG8_SB(0, 0), b2, voffB);
            PG8_BAR; PG8_WAIT_L(0); PG8_MMA(0, 1, At, B1); PG8_BAR;
            PG8_LDA(At, 0, 1); PG8_STAGE(PG8_SA(0, 0), a2, voffA);
            PG8_BAR; PG8_WAIT_L(0); PG8_MMA(1, 0, At, B0); PG8_BAR; PG8_SCHED;
            PG8_STAGE(PG8_SB(0, 1), b2 + hstep, voffB);
            PG8_WAIT_V(6); PG8_BAR; PG8_MMA(1, 1, At, B1); PG8_BAR;
            PG8_LDB(B0, 1, 0); PG8_SCHED; PG8_LDA(At, 1, 0); PG8_STAGE(PG8_SA(0, 1), a2 + hstep, voffA);
            PG8_WAIT_L(8); PG8_BAR; PG8_WAIT_L(0); PG8_MMA(0, 0, At, B0); PG8_BAR; PG8_SCHED;
            PG8_LDB(B1, 1, 1); PG8_STAGE(PG8_SB(1, 0), b3, voffB);
            PG8_BAR; PG8_WAIT_L(0); PG8_MMA(0, 1, At, B1); PG8_BAR;
            PG8_LDA(At, 1, 1); PG8_STAGE(PG8_SA(1, 0), a3, voffA);
            PG8_BAR; PG8_WAIT_L(0); PG8_MMA(1, 0, At, B0); PG8_BAR; PG8_SCHED;
            PG8_STAGE(PG8_SB(1, 1), b3 + hstep, voffB);
            PG8_WAIT_V(6); PG8_BAR; PG8_MMA(1, 1, At, B1); PG8_BAR;
        }
        E(acc, cur, wr, wc, fr, fq);
        if (!has_next) break;
#pragma unroll
        for (int a = 0; a < 2; ++a)
#pragma unroll
            for (int b = 0; b < 2; ++b)
#pragma unroll
                for (int m = 0; m < 4; ++m)
#pragma unroll
                    for (int n = 0; n < 2; ++n) acc[a][b][m][n] = (f32x4){0.f, 0.f, 0.f, 0.f};
        cur = nxt; cA = nA; cB = nB; ++ui;
    }
    PG8_WAIT_V(0);
    if (wr == 0) PG8_BAR;
    PG8_BAR;
#undef PG8_SA
#undef PG8_SB
#undef PG8_STAGE
#undef PG8_LDA
#undef PG8_LDB
#undef PG8_MMA
#undef PG8_WAIT_V
#undef PG8_WAIT_L
#undef PG8_BAR
#undef PG8_SCHED
}
}
using pg8::Unit;

struct SchedIn {
    pg8::OrderBase ob; int seg; const char* A; const char* B;
    __device__ bool next(int i, Unit& u) const { return ob.nextb(i, u); }
    __device__ const char* a_ptr(const Unit& u) const {
        const int gt = u.pm < LT_PROMPT ? ((u.pm / TPB) * (SEQ / 256) + seg * TPB + (u.pm % TPB)) : (XROWS / 256 + (u.pm - LT_PROMPT));
        return A + (size_t)gt * 256 * D * 2; }
    __device__ const char* b_ptr(const Unit& u) const { return B + (size_t)u.pn * 256 * D * 2; }
};
struct SchedAB {
    pg8::OrderBase ob; const char* A0; const char* A1; const char* B0; const char* B1;
    __device__ bool next(int i, Unit& u) const { const bool ok = ob.nextb(i >> 1, u); u.w = i & 1; return ok; }
    __device__ const char* a_ptr(const Unit& u) const { return (u.w ? A1 : A0) + (size_t)u.pm * 256 * D * 2; }
    __device__ const char* b_ptr(const Unit& u) const { return (u.w ? B1 : B0) + (size_t)u.pn * 256 * D * 2; }
};
struct SchedO {
    pg8::OrderBase ob; const char* A; const char* B;
    __device__ bool next(int i, Unit& u) const { return ob.nextb(i, u); }
    __device__ const char* a_ptr(const Unit& u) const { return A + (size_t)u.pm * 256 * D * 2; }
    __device__ const char* b_ptr(const Unit& u) const { return B + (size_t)u.pn * 256 * D * 2; }
};

struct EpiIn {
    static constexpr bool PERM = true;
    bf16_t* P; bf16_t* gex; float* out; int seg;
    __device__ __forceinline__ void operator()(const f32x4 (&acc)[2][2][4][2], const Unit& u, int wr, int wc, int fr, int fq) const {
        const int lr0 = u.pm * 256 + wr * 64 + fr;
        const int c0 = u.pn * 256 + wc * 32 + 8 * fq;
#pragma unroll
        for (int ai = 0; ai < 2; ++ai)
#pragma unroll
            for (int m = 0; m < 4; ++m) {
                const int lr = lr0 + ai * 128 + m * 16;
                bf16_t* rowp;
                if (u.pn < NT_PB) rowp = P + (size_t)lr * NPB + c0;
                else if (lr < LEX0) { const int b = lr / SEGTOK; const size_t grow = (size_t)b * SEQ + seg * SEGTOK + (lr % SEGTOK); rowp = (bf16_t*)(out + O_YP + grow * D) + (c0 - NPB); }
                else rowp = gex + (size_t)(lr - LEX0) * 2048 + (c0 - NPB);
#pragma unroll
                for (int bj = 0; bj < 2; ++bj) { const f32x4 v0 = acc[ai][bj][m][0], v1 = acc[ai][bj][m][1];
                    u32x4 w; w.x = cvt_pk_bf16(v0[0], v0[1]); w.y = cvt_pk_bf16(v0[2], v0[3]); w.z = cvt_pk_bf16(v1[0], v1[1]); w.w = cvt_pk_bf16(v1[2], v1[3]);
                    *(u32x4*)(rowp + bj * 128) = w; }
            }
    }
};
struct EpiAB {
    static constexpr bool PERM = false;
    float* tmp; bf16_t* merged; const bf16_t* gex; const float* out;
    __device__ __forceinline__ void operator()(const f32x4 (&acc)[2][2][4][2], const Unit& u, int wr, int wc, int fr, int fq) const {
        const int row0 = u.pm * 256 + wr * 64 + fr, col0 = u.pn * 256 + wc * 32 + 4 * fq;
#pragma unroll
        for (int ai = 0; ai < 2; ++ai)
#pragma unroll
            for (int m = 0; m < 4; ++m) {
                const int grow = row0 + ai * 128 + m * 16;
                const bf16_t* gp = (grow < XROWS) ? ((const bf16_t*)(out + O_YP + (size_t)grow * D) + u.w * D) : (gex + (size_t)(grow - XROWS) * 2048 + u.w * D);
#pragma unroll
                for (int bj = 0; bj < 2; ++bj)
#pragma unroll
                    for (int n = 0; n < 2; ++n) {
                        const int c = col0 + bj * 128 + n * 16;
                        const u32x2 g = *(const u32x2*)(gp + c);
                        f32x4 v = acc[ai][bj][m][n];
                        v[0] *= sigm(__uint_as_float(g.x << 16)); v[1] *= sigm(__uint_as_float(g.x & 0xffff0000u));
                        v[2] *= sigm(__uint_as_float(g.y << 16)); v[3] *= sigm(__uint_as_float(g.y & 0xffff0000u));
                        float* tp = tmp + (size_t)grow * D + c;
                        if (u.w == 0) *(f32x4*)tp = v;
                        else { const f32x4 t = *(const f32x4*)tp; v = v + t; u32x2 o; o.x = cvt_pk_bf16(v[0], v[1]); o.y = cvt_pk_bf16(v[2], v[3]); *(u32x2*)(merged + (size_t)grow * D + c) = o; }
                    }
            }
    }
};
struct EpiO {
    static constexpr bool PERM = false;
    float* out; const float* xp; const float* xs;
    __device__ __forceinline__ void operator()(const f32x4 (&acc)[2][2][4][2], const Unit& u, int wr, int wc, int fr, int fq) const {
        const int row0 = u.pm * 256 + wr * 64 + fr, col0 = u.pn * 256 + wc * 32 + 4 * fq;
#pragma unroll
        for (int ai = 0; ai < 2; ++ai)
#pragma unroll
            for (int m = 0; m < 4; ++m) {
                const int grow = row0 + ai * 128 + m * 16;
                const float* xr; float* yr;
                if (grow < XROWS) { xr = xp + (size_t)grow * D; yr = out + O_YP + (size_t)grow * D; }
                else { const int e = grow - XROWS; if (e < EX_SAMP || e >= EX_SHIFT) continue; xr = xs + (size_t)(e - EX_SAMP) * D; yr = out + O_YS + (size_t)(e - EX_SAMP) * D; }
#pragma unroll
                for (int bj = 0; bj < 2; ++bj)
#pragma unroll
                    for (int n = 0; n < 2; ++n) { const int c = col0 + bj * 128 + n * 16; *(f32x4*)(yr + c) = *(const f32x4*)(xr + c) + acc[ai][bj][m][n]; }
            }
    }
};

__device__ __forceinline__ void p0_row(const Params& p, int r, int lane) {
    bf16_t* hrow = (bf16_t*)(p.ws + WS_H) + (size_t)r * D;
    const float* src = nullptr; bool norm = true; float* sh = nullptr;
    if (r < XROWS) { src = p.in[0] + (size_t)r * D; if ((r & (SEQ - 1)) == SEQ - 1) sh = p.out + O_SHIFT_P + (size_t)(r / SEQ) * D; }
    else { const int e = r - XROWS;
        if (e < EX_SAMP) src = p.in[6] + (size_t)e * D;
        else if (e < EX_SHIFT) { src = p.in[1] + (size_t)(e - EX_SAMP) * D; if (((e - EX_SAMP) & 3) == 3) sh = p.out + O_SHIFT_S + (size_t)((e - EX_SAMP) >> 2) * D; }
        else if (e < EX_END) { src = p.in[5] + (size_t)(e - EX_SHIFT) * D; norm = false; } }
    u32x2* o8 = (u32x2*)hrow + lane;
    if (!src) {
#pragma unroll
        for (int j = 0; j < 4; ++j) o8[64 * j] = (u32x2){0u, 0u};
        return; }
    const f32x4* xr = (const f32x4*)src + lane;
    f32x4 v[4]; float ss = 0.f;
#pragma unroll
    for (int j = 0; j < 4; ++j) { v[j] = xr[64 * j]; ss += v[j][0] * v[j][0] + v[j][1] * v[j][1] + v[j][2] * v[j][2] + v[j][3] * v[j][3]; }
    if (norm) {
        const float rs = rsqrtf(wave_sum(ss) * (1.f / D) + 1e-6f);
        const f32x4* wr = (const f32x4*)p.in[7] + lane;
#pragma unroll
        for (int j = 0; j < 4; ++j) v[j] = v[j] * rs * wr[64 * j];
    }
#pragma unroll
    for (int j = 0; j < 4; ++j) { o8[64 * j] = (u32x2){pk2(v[j][0], v[j][1]), pk2(v[j][2], v[j][3])}; if (sh) ((f32x4*)sh)[lane + 64 * j] = v[j]; }
}
template <int MODE> __device__ __forceinline__ void p0_tr_item(const float* W, int N, bf16_t* WT, float* scr, int kb, int nb, int lane) {
    const int k0 = 64 * kb, n0 = 32 * nb;
    const int nn = n0 + (lane & 31);
    int srcc = nn;
    if (MODE == 1) srcc = nn < C_GATE_REF ? nn : (nn < NPB ? -1 : nn - (NPB - C_GATE_REF));
#pragma unroll 8
    for (int i = 0; i < 32; ++i) { const int kk = 2 * i + (lane >> 5); scr[kk * 33 + (lane & 31)] = srcc >= 0 ? W[(size_t)(k0 + kk) * N + srcc] : 0.f; }
    asm volatile("s_waitcnt lgkmcnt(0)" ::: "memory");
    const int c = lane & 7;
#pragma unroll
    for (int j = 0; j < 4; ++j) { const int n = (lane >> 3) + 8 * j; const float* s = scr + (8 * c) * 33 + n;
        u32x4 o; o.x = pk2(s[0 * 33], s[1 * 33]); o.y = pk2(s[2 * 33], s[3 * 33]); o.z = pk2(s[4 * 33], s[5 * 33]); o.w = pk2(s[6 * 33], s[7 * 33]);
        *(u32x4*)(WT + (size_t)(n0 + n) * D + k0 + 8 * c) = o; }
    asm volatile("s_waitcnt lgkmcnt(0)" ::: "memory");
}
__device__ __forceinline__ void phase0(const Params& p, unsigned char* smem) {
    const int tid0 = otid(), wave = tid0 >> 6, lane = tid0 & 63;
    const int gw = obid() * 8 + wave, NGW = gridDim.x * 8;
    float* scr = (float*)smem + wave * (64 * 33);
    constexpr int I_IN = 16 * (NP / 32), I_SQ = 16 * 32;
    for (int it = gw; it < I_IN + 3 * I_SQ; it += NGW) {
        int r = it;
        if (r < I_IN) { p0_tr_item<1>(p.in[8], 10384, (bf16_t*)(p.ws + WS_WT_IN), scr, r / (NP / 32), r % (NP / 32), lane); continue; } r -= I_IN;
        if (r < I_SQ) { p0_tr_item<0>(p.in[13], D, (bf16_t*)(p.ws + WS_WT_A), scr, r / 32, r % 32, lane); continue; } r -= I_SQ;
        if (r < I_SQ) { p0_tr_item<0>(p.in[24], D, (bf16_t*)(p.ws + WS_WT_B), scr, r / 32, r % 32, lane); continue; } r -= I_SQ;
        p0_tr_item<0>(p.in[25], D, (bf16_t*)(p.ws + WS_WT_O), scr, r / 32, r % 32, lane);
    }
    for (int r = gw; r < HROWS; r += NGW) p0_row(p, r, lane);
    {
        float* pk = (float*)(p.ws + WS_PK);
        const int gt = obid() * 512 + tid0, NT = gridDim.x * 512;
#define PKCOPY(off, idx, n) for (int i = gt; i < (n); i += NT) pk[(off) + i] = p.in[idx][i];
        PKCOPY(PK_CONVW, 9, 12288) PKCOPY(PK_ALOG, 10, 8) PKCOPY(PK_DTB, 11, 8) PKCOPY(PK_NORMW, 12, 128) PKCOPY(PK_MU, 14, 4224) PKCOPY(PK_W0, 15, 1024)
        PKCOPY(PK_W2, 16, 65536) PKCOPY(PK_A0, 17, 1024) PKCOPY(PK_A2, 18, 65536) PKCOPY(PK_KK, 19, 1024) PKCOPY(PK_KA, 20, 1024) PKCOPY(PK_RK, 21, 1024)
        PKCOPY(PK_GNW, 22, 1024) PKCOPY(PK_GNB, 23, 1024) PKCOPY(PK_LNF, 26, 1024)
#undef PKCOPY
        bf16_t* w2t = (bf16_t*)(p.ws + WS_W2T); bf16_t* a2t = (bf16_t*)(p.ws + WS_A2T);
        for (int i = gt; i < 65536; i += NT) { const int l = i & 63, c = (i >> 6) & 63, hb = i >> 12;
            w2t[i] = (bf16_t)f2bf(p.in[16][(size_t)l * D + hb * 64 + c]); a2t[i] = (bf16_t)f2bf(p.in[18][(size_t)l * D + hb * 64 + c]); }
    }
}

__device__ __forceinline__ void gdn_item(const Params& p, unsigned char* smem, const float* s_in, float* s_out, const float* halo_in, float* halo_out,
                                         int h, int sl, int rowA, int nA, int rowB, int nB) {
    const int tid = otid(), w = tid >> 6, lane = tid & 63, vl = lane >> 4, kg = lane & 15;
    float* qk_s = (float*)smem; float* v_s = qk_s + 16384; float* o_s = v_s + 2048; float* gb_s = o_s + 2048; float* sst = gb_s + 128;
    const bf16_t* P = (const bf16_t*)(p.ws + WS_P);
    float* ORAW = (float*)(p.ws + WS_ORAW);
    float s[8];
    if (s_in) {
        { const int k = tid >> 2, q4 = tid & 3; const f32x4* src = (const f32x4*)(s_in + (size_t)k * 128 + sl * 32 + q4 * 8); const f32x4 a = src[0], b = src[1];
          float* d = sst + k * 33 + q4 * 8; d[0] = a[0]; d[1] = a[1]; d[2] = a[2]; d[3] = a[3]; d[4] = b[0]; d[5] = b[1]; d[6] = b[2]; d[7] = b[3]; }
        __syncthreads();
#pragma unroll
        for (int j = 0; j < 8; ++j) s[j] = sst[(kg * 8 + j) * 33 + 4 * w + vl];
        __syncthreads();
    } else {
#pragma unroll
        for (int j = 0; j < 8; ++j) s[j] = 0.f;
    }
    int pcol = -1;
    if (tid < 128) pcol = h * 128 + tid; else if (tid < 256) pcol = 1024 + h * 128 + (tid - 128); else if (tid < 288) pcol = 2048 + h * 128 + sl * 32 + (tid - 256);
    float cw0 = 0.f, cw1 = 0.f, cw2 = 0.f, cw3 = 0.f, x1 = 0.f, x2 = 0.f, x3 = 0.f;
    const float* pk = (const float*)(p.ws + WS_PK);
    if (pcol >= 0) { const float* cw = pk + PK_CONVW; cw0 = cw[pcol]; cw1 = cw[3072 + pcol]; cw2 = cw[6144 + pcol]; cw3 = cw[9216 + pcol];
        if (halo_in) { x3 = halo_in[pcol]; x2 = halo_in[3072 + pcol]; x1 = halo_in[6144 + pcol]; } }
    const float nalog = -expf(pk[PK_ALOG + h]), dtb = pk[PK_DTB + h];
#pragma unroll 1
    for (int run = 0; run < 2; ++run) {
        const int rrow = run ? rowB : rowA, rn = run ? nB : nA; const bool wout = run != 0;
#pragma unroll 1
        for (int c0 = 0; c0 < rn; c0 += 64) {
            const int nt = (rn - c0) < 64 ? (rn - c0) : 64; const int row = rrow + c0;
            if (pcol >= 0) {
                const bf16_t* src = P + (size_t)row * NPB + pcol;
                float* dst = tid < 256 ? (qk_s + tid) : (v_s + (tid - 256)); const int dstride = tid < 256 ? 256 : 32;
#pragma unroll 8
                for (int i = 0; i < nt; ++i) { const float x0 = bf2f(src[(size_t)i * NPB]); const float y = cw0 * x3 + cw1 * x2 + cw2 * x1 + cw3 * x0; x3 = x2; x2 = x1; x1 = x0; dst[i * dstride] = silu_(y); }
            } else if (tid < 352) {
                const int i = tid - 288;
                if (i < nt) { const float pa = bf2f(P[(size_t)(row + i) * NPB + C_A + h]), pb = bf2f(P[(size_t)(row + i) * NPB + C_B + h]);
                    gb_s[2 * i] = expf(nalog * softplus_(pa + dtb)); gb_s[2 * i + 1] = sigm(pb); }
            }
            __syncthreads();
#pragma unroll 1
            for (int ii = 0; ii < 8; ++ii) { const int i = w * 8 + ii;
                if (i < nt) {
#pragma unroll
                    for (int which = 0; which < 2; ++which) { float* rp = qk_s + i * 256 + which * 128; const float a = rp[lane], b = rp[lane + 64];
                        const float sc = rsqrtf(wave_sum(a * a + b * b) + 1e-6f) * (which == 0 ? 0.08838834764831845f : 1.f); rp[lane] = a * sc; rp[lane + 64] = b * sc; } } }
            __syncthreads();
#pragma unroll 1
            for (int i = 0; i < nt; ++i) {
                const f32x4 q0 = *(const f32x4*)(qk_s + i * 256 + kg * 8), q1 = *(const f32x4*)(qk_s + i * 256 + kg * 8 + 4);
                const f32x4 k0 = *(const f32x4*)(qk_s + i * 256 + 128 + kg * 8), k1 = *(const f32x4*)(qk_s + i * 256 + 128 + kg * 8 + 4);
                const float vv = v_s[i * 32 + 4 * w + vl], a = gb_s[2 * i], be = gb_s[2 * i + 1];
                float part = k0[0] * s[0] + k0[1] * s[1] + k0[2] * s[2] + k0[3] * s[3] + k1[0] * s[4] + k1[1] * s[5] + k1[2] * s[6] + k1[3] * s[7];
                const float kS = rowsum16(part);
                const float c = be * (vv - a * kS);
                s[0] = a * s[0] + k0[0] * c; s[1] = a * s[1] + k0[1] * c; s[2] = a * s[2] + k0[2] * c; s[3] = a * s[3] + k0[3] * c;
                s[4] = a * s[4] + k1[0] * c; s[5] = a * s[5] + k1[1] * c; s[6] = a * s[6] + k1[2] * c; s[7] = a * s[7] + k1[3] * c;
                float op = q0[0] * s[0] + q0[1] * s[1] + q0[2] * s[2] + q0[3] * s[3] + q1[0] * s[4] + q1[1] * s[5] + q1[2] * s[6] + q1[3] * s[7];
                const float o = rowsum16(op);
                if (kg == 0) o_s[i * 32 + 4 * w + vl] = o;
            }
            __syncthreads();
            if (wout) { const int i = tid >> 3, c4 = (tid & 7) * 4; if (i < nt) *(f32x4*)(ORAW + (size_t)(row + i) * D + h * 128 + sl * 32 + c4) = *(const f32x4*)(o_s + i * 32 + c4); }
        }
    }
    if (pcol >= 0 && (sl == 0 || tid >= 256)) { halo_out[pcol] = x3; halo_out[3072 + pcol] = x2; halo_out[6144 + pcol] = x1; }
#pragma unroll
    for (int j = 0; j < 8; ++j) sst[(kg * 8 + j) * 33 + 4 * w + vl] = s[j];
    __syncthreads();
    { const int k = tid >> 2, q4 = tid & 3; const float* d = sst + k * 33 + q4 * 8; f32x4* dst = (f32x4*)(s_out + (size_t)k * 128 + sl * 32 + q4 * 8);
      dst[0] = (f32x4){d[0], d[1], d[2], d[3]}; dst[1] = (f32x4){d[4], d[5], d[6], d[7]}; }
    __syncthreads();
}

constexpr int RW_W2 = 20544, RW_A2 = 24640;
__device__ __forceinline__ void rwkv_load_lora(const Params& p, unsigned char* smem, int hb) {
    float* w2_s = (float*)smem + RW_W2; float* a2_s = (float*)smem + RW_A2; const float* pk = (const float*)(p.ws + WS_PK);
    for (int i = otid(); i < 4096; i += 512) { const int l = i >> 6, c = i & 63; w2_s[i] = pk[PK_W2 + l * D + hb * 64 + c]; a2_s[i] = pk[PK_A2 + l * D + hb * 64 + c]; }
    __syncthreads();
}
__device__ __forceinline__ void rwkv_item(const Params& p, unsigned char* smem, const float* s_in, float* s_out, const bf16_t* prev_row, const float* halo_in, float* halo_out,
                                          int hb, int half, int rowA, int nA, int rowB, int nB) {
    const int tid = otid(), w = tid >> 6, lane = tid & 63, row = tid >> 4, kq = tid & 15;
    float* f = (float*)smem;
    float* r_s = f; float* kb_s = f + 2048; float* v_s = f + 4096; float* wd_s = f + 6144; float* ad_s = f + 8192; float* dec_s = f + 10240; float* a_s = f + 12288;
    float* kk_s = f + 14336; float* km_s = f + 16384; float* zb_s = f + 18432; float* y_s = f + 19456; float* bonus_s = f + 20480;
    const float* w2_s = f + RW_W2; const float* a2_s = f + RW_A2;
    const bf16_t* P = (const bf16_t*)(p.ws + WS_P);
    float* YRAW = (float*)(p.ws + WS_YRAW); bf16_t* C0 = (bf16_t*)(p.ws + WS_C0); bf16_t* C1 = (bf16_t*)(p.ws + WS_C1);
    float s[4];
    if (s_in) { const f32x4 t = *(const f32x4*)(s_in + (size_t)(half * 32 + row) * 64 + kq * 4); s[0] = t[0]; s[1] = t[1]; s[2] = t[2]; s[3] = t[3]; }
    else { s[0] = s[1] = s[2] = s[3] = 0.f; }
    int col = -1; float* dst = nullptr; int dstride = 64; bool is_wd = false, owner = false;
    if (tid < 64) { col = hb * 64 + tid; dst = r_s + tid; owner = half == 0; }
    else if (tid < 128) { col = 1024 + hb * 64 + (tid - 64); dst = kb_s + (tid - 64); owner = half == 0; }
    else if (tid < 192) { col = 2048 + hb * 64 + (tid - 128); dst = v_s + (tid - 128); owner = half == 0; }
    else if (tid < 256) { col = 3072 + (tid - 192); dst = wd_s + (tid - 192); is_wd = true; owner = (half == 0 && hb == 0); }
    else if (tid < 320) { col = 3136 + (tid - 256); dst = ad_s + (tid - 256); owner = (half == 0 && hb == 0); }
    else if (tid < 352) { col = 3200 + hb * 64 + half * 32 + (tid - 320); dst = zb_s + (tid - 320); dstride = 32; owner = true; }
    float mu = 0.f, prev = 0.f;
    const float* pk = (const float*)(p.ws + WS_PK);
    if (col >= 0) { mu = pk[PK_MU + col]; prev = prev_row ? bf2f(prev_row[C_RW + col]) : (halo_in ? halo_in[col] : 0.f); }
    const int cc = tid & 63, ig = tid >> 6;
    const int hc = hb * 64 + cc;
    const float w0c = pk[PK_W0 + hc], a0c = pk[PK_A0 + hc], kkc = pk[PK_KK + hc], kac = pk[PK_KA + hc];
    const float rkl = pk[PK_RK + hb * 64 + lane];
#pragma unroll 1
    for (int run = 0; run < 2; ++run) {
        const int rrow = run ? rowB : rowA, rn = run ? nB : nA; const bool wout = run != 0;
#pragma unroll 1
        for (int c0 = 0; c0 < rn; c0 += 32) {
            const int nt = (rn - c0) < 32 ? (rn - c0) : 32; const int row0 = rrow + c0;
            if (col >= 0) {
                const bf16_t* src = P + (size_t)row0 * NPB + C_RW + col;
#pragma unroll 8
                for (int i = 0; i < nt; ++i) { const float cur = bf2f(src[(size_t)i * NPB]); float m = cur + mu * (prev - cur); prev = cur; if (is_wd) m = tanh_(m); dst[i * dstride] = m; }
            }
            __syncthreads();
            {
                float aw[4] = {0.f, 0.f, 0.f, 0.f}, aa[4] = {0.f, 0.f, 0.f, 0.f};
#pragma unroll 4
                for (int l = 0; l < 64; ++l) { const float w2v = w2_s[l * 64 + cc], a2v = a2_s[l * 64 + cc];
#pragma unroll
                    for (int ii = 0; ii < 4; ++ii) { aw[ii] += wd_s[(ig * 4 + ii) * 64 + l] * w2v; aa[ii] += ad_s[(ig * 4 + ii) * 64 + l] * a2v; } }
#pragma unroll
                for (int ii = 0; ii < 4; ++ii) { const int i = ig * 4 + ii;
                    if (i < nt) { const float wraw = w0c + aw[ii]; const float wlog = -0.6065306597126334f * sigm(wraw); const float a = sigm(a0c + aa[ii]);
                        const float kbv = kb_s[i * 64 + cc];
                        dec_s[i * 64 + cc] = expf(wlog); a_s[i * 64 + cc] = a; kk_s[i * 64 + cc] = kbv * kkc; km_s[i * 64 + cc] = kbv * (1.f + (a - 1.f) * kac); } }
            }
            __syncthreads();
#pragma unroll 1
            for (int ii = 0; ii < 4; ++ii) { const int i = w * 4 + ii;
                if (i < nt) { const float kkr = kk_s[i * 64 + lane]; const float kk = kkr * rsqrtf(wave_sum(kkr * kkr) + 1e-6f); kk_s[i * 64 + lane] = kk;
                    const float a = a_s[i * 64 + lane]; a_s[i * 64 + lane] = kk * a;
                    const float rk = wave_sum(r_s[i * 64 + lane] * km_s[i * 64 + lane] * rkl); if (lane == 0) bonus_s[i] = rk; } }
            __syncthreads();
#pragma unroll 1
            for (int i = 0; i < nt; ++i) {
                const f32x4 kk4 = *(const f32x4*)(kk_s + i * 64 + kq * 4), de4 = *(const f32x4*)(dec_s + i * 64 + kq * 4), ka4 = *(const f32x4*)(a_s + i * 64 + kq * 4),
                            km4 = *(const f32x4*)(km_s + i * 64 + kq * 4), r4 = *(const f32x4*)(r_s + i * 64 + kq * 4);
                const float vv = v_s[i * 64 + half * 32 + row];
                const float sa = rowsum16(s[0] * kk4[0] + s[1] * kk4[1] + s[2] * kk4[2] + s[3] * kk4[3]);
#pragma unroll
                for (int j = 0; j < 4; ++j) s[j] = s[j] * de4[j] + (vv * km4[j] - sa * ka4[j]);
                const float y = rowsum16(s[0] * r4[0] + s[1] * r4[1] + s[2] * r4[2] + s[3] * r4[3]);
                if (kq == 0) y_s[i * 32 + row] = y;
            }
            __syncthreads();
            if (wout) { const int i = tid >> 4;
                if (i < nt) {
#pragma unroll
                    for (int q = 0; q < 2; ++q) { const int rr = (tid & 15) * 2 + q, v = half * 32 + rr, colo = hb * 64 + v;
                        const float sz = silu_(zb_s[i * 32 + rr]);
                        const size_t o = (size_t)(row0 + i) * D + colo;
                        YRAW[o] = y_s[i * 32 + rr]; C1[o] = (bf16_t)f2bf(pk[PK_GNW + colo] * sz); C0[o] = (bf16_t)f2bf((pk[PK_GNB + colo] + bonus_s[i] * v_s[i * 64 + v]) * sz); } } }
            __syncthreads();
        }
    }
    *(f32x4*)(s_out + (size_t)(half * 32 + row) * 64 + kq * 4) = (f32x4){s[0], s[1], s[2], s[3]};
    if (col >= 0 && owner && halo_out) halo_out[col] = prev;
}


__device__ __forceinline__ bf16x8 ldfrag(const bf16_t* base, int stride, int r0, int k0, int lane) {
    return *(const bf16x8*)(base + (r0 + (lane & 15)) * stride + k0 + 8 * (lane >> 4));
}
#define MFMA16(a, b, c) __builtin_amdgcn_mfma_f32_16x16x32_bf16((a), (b), (c), 0, 0, 0)
__device__ __forceinline__ void inv_block(const float* L, float* Tm, float* XS, int tid) {
    const int w = tid >> 6, lane = tid & 63;
    if (w < 4 && lane < 16) {
        const float* Lb = L + (16 * w) * 64 + 16 * w; float* Tb = Tm + (16 * w) * 64 + 16 * w;
        float tr[16];
#pragma unroll
        for (int i = 0; i < 16; ++i) { float a = (lane == i) ? 1.f : 0.f;
#pragma unroll
            for (int j = 0; j < i; ++j) a -= Lb[i * 64 + j] * tr[j];
            tr[i] = a; Tb[i * 64 + lane] = a; }
    }
    for (int e = tid; e < 1536; e += 512) { const int k = e >> 8, r = (e >> 4) & 15, c = e & 15;
        const int rb = k < 3 ? 0 : (k < 5 ? 1 : 2), cb = k < 3 ? k + 1 : (k < 5 ? k - 1 : 3);
        Tm[(16 * rb + r) * 64 + 16 * cb + c] = 0.f; }
    __syncthreads();
    {
        const int B = tid >> 8, i = (tid >> 4) & 15, c = tid & 15, o = 32 * B;
        float x = 0.f;
#pragma unroll
        for (int j = 0; j < 16; ++j) x += L[(o + 16 + i) * 64 + o + j] * Tm[(o + j) * 64 + o + c];
        XS[tid] = x;
        __syncthreads();
        float t = 0.f;
#pragma unroll
        for (int j = 0; j < 16; ++j) t += Tm[(o + 16 + i) * 64 + o + 16 + j] * XS[(B << 8) + j * 16 + c];
        Tm[(o + 16 + i) * 64 + o + c] = -t;
    }
    __syncthreads();
    {
        const int i = tid >> 4, c2 = (tid & 15) * 2;
        float x0 = 0.f, x1 = 0.f;
#pragma unroll 8
        for (int j = 0; j < 32; ++j) { const float l = L[(32 + i) * 64 + j]; x0 += l * Tm[j * 64 + c2]; x1 += l * Tm[j * 64 + c2 + 1]; }
        XS[i * 32 + c2] = x0; XS[i * 32 + c2 + 1] = x1;
        __syncthreads();
        float t0 = 0.f, t1 = 0.f;
#pragma unroll 8
        for (int j = 0; j < 32; ++j) { const float tv = Tm[(32 + i) * 64 + 32 + j]; t0 += tv * XS[j * 32 + c2]; t1 += tv * XS[j * 32 + c2 + 1]; }
        Tm[(32 + i) * 64 + c2] = -t0; Tm[(32 + i) * 64 + c2 + 1] = -t1;
    }
    __syncthreads();
}
__device__ __forceinline__ void unpack8(const u32x4 rw, float (&x)[8]) {
    x[0] = __uint_as_float(rw.x << 16); x[1] = __uint_as_float(rw.x & 0xffff0000u); x[2] = __uint_as_float(rw.y << 16); x[3] = __uint_as_float(rw.y & 0xffff0000u);
    x[4] = __uint_as_float(rw.z << 16); x[5] = __uint_as_float(rw.z & 0xffff0000u); x[6] = __uint_as_float(rw.w << 16); x[7] = __uint_as_float(rw.w & 0xffff0000u); }
__device__ __forceinline__ u32x4 pack8(const float (&x)[8]) { return (u32x4){pk2(x[0], x[1]), pk2(x[2], x[3]), pk2(x[4], x[5]), pk2(x[6], x[7])}; }

constexpr int PL_QS = 0, PL_R1 = 17408, PL_KT = 35840, PL_KTT = 54272, PL_VT = 72704, PL_R3 = 91136, PL_QKM = 109568, PL_TP = 118784, PL_TPP = 128000, PL_SM = 137216, PL_TM = 139264, PL_XS = 155648;
constexpr int QSTR = 136, TSTR = 72;

__device__ __forceinline__ void gdn_prep_item(const Params& p, unsigned char* smem, int h, int row_start, int npad, const bf16_t* hbase,
                                              bf16_t* halo_out, float* conv_out, unsigned char* rec) {
    const int tid = otid(), w = tid >> 6, lane = tid & 63, q4 = lane >> 4, l15 = lane & 15;
    bf16_t* qs = (bf16_t*)(smem + PL_QS); bf16_t* ks = (bf16_t*)(smem + PL_R1); bf16_t* WT = ks; bf16_t* kT = (bf16_t*)(smem + PL_KT); bf16_t* ktT = (bf16_t*)(smem + PL_KTT);
    bf16_t* vT = (bf16_t*)(smem + PL_VT); float* Lm = (float*)(smem + PL_R3); bf16_t* UT = (bf16_t*)(smem + PL_R3); bf16_t* QKm = (bf16_t*)(smem + PL_QKM);
    bf16_t* Tp = (bf16_t*)(smem + PL_TP); bf16_t* Tpp = (bf16_t*)(smem + PL_TPP);
    float* sm = (float*)(smem + PL_SM);
    float* gcs = sm; float* bes = sm + 64; float* ssq = sm + 128; float* ssk = sm + 192; float* egs = sm + 256; float* egl_s = sm + 320; float* beg = sm + 384;
    const bf16_t* P = (const bf16_t*)(p.ws + WS_P);
    const float* pk = (const float*)(p.ws + WS_PK);
    if (npad == 0) {
        const int t = tid >> 3, g = tid & 7;
        const bf16_t* zp = P + (size_t)(row_start + t) * NPB + C_Z + h * 128 + 16 * g;
        const u32x4 z0 = *(const u32x4*)zp, z1 = *(const u32x4*)(zp + 8);
        float za[8], zb[8]; unpack8(z0, za); unpack8(z1, zb);
        const float* nwp = pk + PK_NORMW + 16 * g;
        float ga[8], gb2[8];
#pragma unroll
        for (int e = 0; e < 8; ++e) { ga[e] = nwp[e] * silu_(za[e]); gb2[e] = nwp[8 + e] * silu_(zb[e]); }
        bf16_t* gp = (bf16_t*)(rec + GP_G) + t * 128 + 16 * g;
        *(u32x4*)gp = pack8(ga); *(u32x4*)(gp + 8) = pack8(gb2);
    }
    if (tid < 128) ssq[tid] = 0.f;
    if (tid >= 448) { const int i = tid - 448;
        float g = 0.f, be = 0.f;
        if (i >= npad) { const size_t r = (size_t)(row_start + i - npad) * NPB; const float pa = bf2f(P[r + C_A + h]), pb = bf2f(P[r + C_B + h]);
            g = -expf(pk[PK_ALOG + h]) * softplus_(pa + pk[PK_DTB + h]); be = sigm(pb); }
        gcs[i] = g; bes[i] = be; }
    __syncthreads();
    if (tid < 64) {
        float x = gcs[lane];
#pragma unroll
        for (int o = 1; o < 64; o <<= 1) { const float y = __shfl_up(x, o); if (lane >= o) x += y; }
        const float gl = __shfl(x, 63);
        gcs[lane] = x; egs[lane] = __expf(x); egl_s[lane] = __expf(gl - x); beg[lane] = bes[lane] * __expf(x);
        if (lane == 0) *(float*)(rec + GP_EGL) = __expf(gl);
    }
    const int cg = tid % 48, ts = tid / 48;
    const int sec = cg >> 4;
    const int pcol = sec * 1024 + h * 128 + (cg & 15) * 8;
    float val[7][8];
    if (ts < 10) {
        float cw[4][8];
#pragma unroll
        for (int j = 0; j < 4; ++j) { const f32x4 a = *(const f32x4*)(pk + PK_CONVW + j * 3072 + pcol), b = *(const f32x4*)(pk + PK_CONVW + j * 3072 + pcol + 4);
            cw[j][0] = a[0]; cw[j][1] = a[1]; cw[j][2] = a[2]; cw[j][3] = a[3]; cw[j][4] = b[0]; cw[j][5] = b[1]; cw[j][6] = b[2]; cw[j][7] = b[3]; }
#pragma unroll
        for (int it = 0; it < 7; ++it) {
            const int i = ts + 10 * it;
            float y[8];
#pragma unroll
            for (int e = 0; e < 8; ++e) y[e] = 0.f;
            const bool tokv = i < 64 && i >= npad;
            u32x4 rw[4]; float fv[4];
#pragma unroll
            for (int dlt = 0; dlt < 4; ++dlt) {
                const int ii = i - 3 + dlt;
                const bf16_t* ptr = P + pcol; float f = 0.f;
                if (tokv && ii >= npad) { ptr = P + (size_t)(row_start + ii - npad) * NPB + pcol; f = 1.f; }
                else if (tokv && ii < 0 && npad == 0 && hbase) { ptr = hbase + (size_t)(ii + 3) * NPB + pcol; f = 1.f; }
                rw[dlt] = *(const u32x4*)ptr; fv[dlt] = f;
            }
            if (tokv) {
#pragma unroll
                for (int dlt = 0; dlt < 4; ++dlt) { float x[8]; unpack8(rw[dlt], x);
#pragma unroll
                    for (int e = 0; e < 8; ++e) y[e] += cw[dlt][e] * fv[dlt] * x[e]; }
                float ss = 0.f;
#pragma unroll
                for (int e = 0; e < 8; ++e) { y[e] = silu_(y[e]); ss += y[e] * y[e]; }
                if (sec == 0) atomicAdd(ssq + i, ss); else if (sec == 1) atomicAdd(ssk + i, ss);
            }
#pragma unroll
            for (int e = 0; e < 8; ++e) val[it][e] = y[e];
        }
    }
    if (halo_out && tid < 384) {
        const int c = (tid >> 7) * 1024 + h * 128 + (tid & 127);
#pragma unroll
        for (int dd = 0; dd < 3; ++dd) { const bf16_t v = P[(size_t)(row_start + 61 + dd) * NPB + c]; halo_out[(size_t)dd * NPB + c] = v; if (conv_out) conv_out[dd * 3072 + c] = bf2f(v); }
    }
    __syncthreads();
    if (ts < 10) {
#pragma unroll
        for (int it = 0; it < 7; ++it) {
            const int i = ts + 10 * it;
            if (i < 64) {
                float sc = 1.f;
                if (sec == 0) sc = rsqrtf(ssq[i] + 1e-6f) * 0.08838834764831845f; else if (sec == 1) sc = rsqrtf(ssk[i] + 1e-6f);
                const int d0 = (cg & 15) * 8;
                float x[8];
#pragma unroll
                for (int e = 0; e < 8; ++e) x[e] = val[it][e] * sc;
                if (sec == 0) { *(u32x4*)(qs + i * QSTR + d0) = (u32x4){pk2(x[0], x[1]), pk2(x[2], x[3]), pk2(x[4], x[5]), pk2(x[6], x[7])}; }
                else if (sec == 1) { *(u32x4*)(ks + i * QSTR + d0) = (u32x4){pk2(x[0], x[1]), pk2(x[2], x[3]), pk2(x[4], x[5]), pk2(x[6], x[7])};
                    const float eg = egl_s[i];
#pragma unroll
                    for (int e = 0; e < 8; ++e) { kT[(d0 + e) * TSTR + i] = (bf16_t)f2bf(x[e]); ktT[(d0 + e) * TSTR + i] = (bf16_t)f2bf(x[e] * eg); } }
                else {
#pragma unroll
                    for (int e = 0; e < 8; ++e) vT[(d0 + e) * TSTR + i] = (bf16_t)f2bf(x[e]); }
            }
        }
    }
    __syncthreads();
    {
        const int which = w >> 2, it = w & 3;
        const bf16_t* Aarr = which ? qs : ks;
        bf16x8 af[4];
#pragma unroll
        for (int kk = 0; kk < 4; ++kk) af[kk] = ldfrag(Aarr, QSTR, 16 * it, 32 * kk, lane);
#pragma unroll
        for (int jt = 0; jt < 4; ++jt) {
            f32x4 acc = {0.f, 0.f, 0.f, 0.f};
#pragma unroll
            for (int kk = 0; kk < 4; ++kk) acc = MFMA16(af[kk], ldfrag(ks, QSTR, 16 * jt, 32 * kk, lane), acc);
            const int j = 16 * jt + l15; const float gj = gcs[j];
#pragma unroll
            for (int r = 0; r < 4; ++r) { const int i = 16 * it + 4 * q4 + r;
                if (which == 0) Lm[i * 64 + j] = (i > j) ? bes[i] * acc[r] * __expf(gcs[i] - gj) : 0.f;
                else QKm[i * TSTR + j] = (bf16_t)f2bf((i >= j) ? acc[r] * __expf(gcs[i] - gj) : 0.f); }
        }
    }
    __syncthreads();
    {
        float* Tm = (float*)(smem + PL_TM);
        inv_block(Lm, Tm, (float*)(smem + PL_XS), tid);
        const int i = tid >> 3, j0 = (tid & 7) * 8;
        float a[8], b2[8];
#pragma unroll
        for (int e = 0; e < 8; ++e) { const float tv = Tm[i * 64 + j0 + e]; a[e] = tv * beg[j0 + e]; b2[e] = tv * bes[j0 + e]; }
        *(u32x4*)(Tp + i * TSTR + j0) = (u32x4){pk2(a[0], a[1]), pk2(a[2], a[3]), pk2(a[4], a[5]), pk2(a[6], a[7])};
        *(u32x4*)(Tpp + i * TSTR + j0) = (u32x4){pk2(b2[0], b2[1]), pk2(b2[2], b2[3]), pk2(b2[4], b2[5]), pk2(b2[6], b2[7])};
    }
    __syncthreads();
    {
        const int it = w & 3, half = w >> 2;
        f32x4 aw[4], au[4];
#pragma unroll
        for (int x = 0; x < 4; ++x) { aw[x] = (f32x4){0.f, 0.f, 0.f, 0.f}; au[x] = (f32x4){0.f, 0.f, 0.f, 0.f}; }
#pragma unroll
        for (int kk = 0; kk < 2; ++kk) {
            const bf16x8 a1 = ldfrag(Tp, TSTR, 16 * it, 32 * kk, lane), a2 = ldfrag(Tpp, TSTR, 16 * it, 32 * kk, lane);
#pragma unroll
            for (int x = 0; x < 4; ++x) { const int dt = half * 4 + x;
                aw[x] = MFMA16(a1, ldfrag(kT, TSTR, 16 * dt, 32 * kk, lane), aw[x]);
                au[x] = MFMA16(a2, ldfrag(vT, TSTR, 16 * dt, 32 * kk, lane), au[x]); }
        }
        __syncthreads();
#pragma unroll
        for (int x = 0; x < 4; ++x) { const int d = 16 * (half * 4 + x) + l15, i0 = 16 * it + 4 * q4;
            *(u32x2*)(WT + d * TSTR + i0) = (u32x2){pk2(aw[x][0], aw[x][1]), pk2(aw[x][2], aw[x][3])};
            *(u32x2*)(UT + d * TSTR + i0) = (u32x2){pk2(au[x][0], au[x][1]), pk2(au[x][2], au[x][3])}; }
    }
    __syncthreads();
    {
        bf16_t* gAP = (bf16_t*)(rec + GP_AP); bf16_t* gQH = (bf16_t*)(rec + GP_QH); bf16_t* gKH = (bf16_t*)(rec + GP_KH); bf16_t* gOH = (bf16_t*)(rec + GP_OH);
        {
            const int et = w;
            const bf16x8 a0 = ldfrag(WT, TSTR, 16 * et, 0, lane), a1 = ldfrag(WT, TSTR, 16 * et, 32, lane);
#pragma unroll
            for (int dt = 0; dt < 8; ++dt) { f32x4 acc = {0.f, 0.f, 0.f, 0.f};
                acc = MFMA16(a0, ldfrag(ktT, TSTR, 16 * dt, 0, lane), acc); acc = MFMA16(a1, ldfrag(ktT, TSTR, 16 * dt, 32, lane), acc);
                *(u32x2*)(gAP + ((size_t)(dt * 4 + (et >> 1)) * 64 + lane) * 8 + (et & 1) * 4) = (u32x2){pk2(-acc[0], -acc[1]), pk2(-acc[2], -acc[3])}; }
#pragma unroll
            for (int tt = 0; tt < 4; ++tt) { f32x4 acc = {0.f, 0.f, 0.f, 0.f};
                acc = MFMA16(a0, ldfrag(QKm, TSTR, 16 * tt, 0, lane), acc); acc = MFMA16(a1, ldfrag(QKm, TSTR, 16 * tt, 32, lane), acc);
                const int t = 16 * tt + l15, e0 = 16 * et + 4 * q4; const float eg = egs[t];
                const u32x2 qq = *(const u32x2*)(qs + t * QSTR + e0);
                const float o0 = __uint_as_float(qq.x << 16) * eg - acc[0], o1 = __uint_as_float(qq.x & 0xffff0000u) * eg - acc[1],
                            o2 = __uint_as_float(qq.y << 16) * eg - acc[2], o3 = __uint_as_float(qq.y & 0xffff0000u) * eg - acc[3];
                *(u32x2*)(gQH + ((size_t)(tt * 4 + (et >> 1)) * 64 + lane) * 8 + (et & 1) * 4) = (u32x2){pk2(o0, o1), pk2(o2, o3)}; }
        }
        {
            const int dt = w;
            const bf16x8 a0 = ldfrag(ktT, TSTR, 16 * dt, 0, lane), a1 = ldfrag(ktT, TSTR, 16 * dt, 32, lane);
#pragma unroll
            for (int vt = 0; vt < 8; ++vt) { f32x4 acc = {0.f, 0.f, 0.f, 0.f};
                acc = MFMA16(a0, ldfrag(UT, TSTR, 16 * vt, 0, lane), acc); acc = MFMA16(a1, ldfrag(UT, TSTR, 16 * vt, 32, lane), acc);
                *(u32x2*)(gKH + ((size_t)(vt * 8 + dt) * 64 + lane) * 4) = (u32x2){pk2(acc[0], acc[1]), pk2(acc[2], acc[3])}; }
            const int tt = w & 3, vh = w >> 2;
            const bf16x8 b0 = ldfrag(QKm, TSTR, 16 * tt, 0, lane), b1 = ldfrag(QKm, TSTR, 16 * tt, 32, lane);
#pragma unroll
            for (int x = 0; x < 4; ++x) { const int vt = vh * 4 + x; f32x4 acc = {0.f, 0.f, 0.f, 0.f};
                acc = MFMA16(b0, ldfrag(UT, TSTR, 16 * vt, 0, lane), acc); acc = MFMA16(b1, ldfrag(UT, TSTR, 16 * vt, 32, lane), acc);
                *(u32x2*)(gOH + ((size_t)(vt * 4 + tt) * 64 + lane) * 4) = (u32x2){pk2(acc[0], acc[1]), pk2(acc[2], acc[3])}; }
        }
    }
    __syncthreads();
}

__device__ __forceinline__ void phase_gprep(const Params& p, int seg, unsigned char* smem) {
    const int blk = obid();
    const int n_items = (CPS + (seg == 0 ? 1 : 0)) * 64;
#pragma unroll 1
    for (int it = blk; it < n_items; it += gridDim.x) {
        const int bh = it & 63, b = bh >> 3, h = bh & 7; int cl = it >> 6; if (seg != 0) cl += 1;
        unsigned char* rec = p.ws + WS_GP + (size_t)(cl * 64 + bh) * GP_STRIDE;
        const bf16_t* Pb = (const bf16_t*)(p.ws + WS_P);
        bf16_t* chalo2 = (bf16_t*)(p.ws + WS_CHALO);
        if (cl == 0) gdn_prep_item(p, smem, h, LEX0, 48, nullptr, nullptr, nullptr, rec);
        else {
            const int row = b * SEGTOK + (cl - 1) * 64;
            const bf16_t* hbase = Pb + (size_t)(row - 3) * NPB;
            if (cl == 1) hbase = (seg == 0) ? Pb + (size_t)(LEX0 + NMETA - 3) * NPB : chalo2 + (size_t)(((seg - 1) & 1) * NBATCH + b) * 3 * NPB;
            bf16_t* ho = (cl == CPS) ? chalo2 + (size_t)((seg & 1) * NBATCH + b) * 3 * NPB : nullptr;
            float* co = (cl == CPS && seg == NSEG - 1) ? p.out + O_CONV_P + (size_t)b * 9216 : nullptr;
            gdn_prep_item(p, smem, h, row, 0, hbase, ho, co, rec);
        }
    }
}

__device__ __forceinline__ void gdn_scan_block(const Params& p, int seg, unsigned char* smem, int bh) {
    const int tid = otid(), w = tid >> 6, lane = tid & 63, q4 = lane >> 4, l15 = lane & 15;
    const int b = bh >> 3, h = bh & 7;
    float* st = p.out + O_GDN_P + (size_t)bh * 16384;
    float* ORAW = (float*)(p.ws + WS_ORAW);
    f32x4 S[8];
    if (seg) {
#pragma unroll
        for (int mt = 0; mt < 8; ++mt)
#pragma unroll
            for (int r = 0; r < 4; ++r) S[mt][r] = st[(size_t)(16 * mt + 4 * q4 + r) * 128 + 16 * w + l15];
    } else {
#pragma unroll
        for (int mt = 0; mt < 8; ++mt) S[mt] = (f32x4){0.f, 0.f, 0.f, 0.f};
    }
    const int c_lo = seg ? 1 : 0;
#pragma unroll 1
    for (int cl = c_lo; cl <= CPS; ++cl) {
        const unsigned char* rec = p.ws + WS_GP + (size_t)(cl * 64 + bh) * GP_STRIDE;
        __syncthreads();
        {
            const u32x4* src = (const u32x4*)rec; u32x4* dst = (u32x4*)smem;
#pragma unroll
            for (int x = 0; x < 6; ++x) dst[tid + 512 * x] = src[tid + 512 * x];
        }
        const bf16_t* gKH = (const bf16_t*)(rec + GP_KH); const bf16_t* gOH = (const bf16_t*)(rec + GP_OH);
        u32x2 kh[8], oh[4];
#pragma unroll
        for (int mt = 0; mt < 8; ++mt) kh[mt] = *(const u32x2*)(gKH + ((size_t)(w * 8 + mt) * 64 + lane) * 4);
#pragma unroll
        for (int tt = 0; tt < 4; ++tt) oh[tt] = *(const u32x2*)(gOH + ((size_t)(w * 4 + tt) * 64 + lane) * 4);
        const float egl = *(const float*)(rec + GP_EGL);
        bf16x8 Bf[4];
#pragma unroll
        for (int ks = 0; ks < 4; ++ks) { u32x4 t; t.x = pk2(S[2 * ks][0], S[2 * ks][1]); t.y = pk2(S[2 * ks][2], S[2 * ks][3]); t.z = pk2(S[2 * ks + 1][0], S[2 * ks + 1][1]); t.w = pk2(S[2 * ks + 1][2], S[2 * ks + 1][3]);
            Bf[ks] = __builtin_bit_cast(bf16x8, t); }
        __syncthreads();
        const bf16x8* AP = (const bf16x8*)smem; const bf16x8* QH = (const bf16x8*)(smem + GP_QH);
        if (cl > 0) {
            const int row = b * SEGTOK + (cl - 1) * 64;
            float* obuf = (float*)(smem + 49152);
#pragma unroll
            for (int tt = 0; tt < 4; ++tt) { f32x4 o = {0.f, 0.f, 0.f, 0.f};
#pragma unroll
                for (int ks = 0; ks < 4; ++ks) o = MFMA16(QH[(tt * 4 + ks) * 64 + lane], Bf[ks], o);
                o[0] += __uint_as_float(oh[tt].x << 16); o[1] += __uint_as_float(oh[tt].x & 0xffff0000u); o[2] += __uint_as_float(oh[tt].y << 16); o[3] += __uint_as_float(oh[tt].y & 0xffff0000u);
#pragma unroll
                for (int r = 0; r < 4; ++r) obuf[(16 * tt + 4 * q4 + r) * 132 + 16 * w + l15] = o[r]; }
            __syncthreads();
            {
                const int t = tid >> 3, g = tid & 7;
                f32x4 o[4]; float ss = 0.f;
#pragma unroll
                for (int j = 0; j < 4; ++j) { o[j] = *(const f32x4*)(obuf + t * 132 + 16 * g + 4 * j); ss += o[j][0] * o[j][0] + o[j][1] * o[j][1] + o[j][2] * o[j][2] + o[j][3] * o[j][3]; }
                ss += __shfl_xor(ss, 1); ss += __shfl_xor(ss, 2); ss += __shfl_xor(ss, 4);
                const float rs = rsqrtf(ss * (1.f / 128.f) + 1e-6f);
                const bf16_t* gp = (const bf16_t*)(rec + GP_G) + t * 128 + 16 * g;
                const u32x4 z0 = *(const u32x4*)gp, z1 = *(const u32x4*)(gp + 8);
                const unsigned zz[8] = {z0.x, z0.y, z0.z, z0.w, z1.x, z1.y, z1.z, z1.w};
                unsigned ow[8];
#pragma unroll
                for (int j = 0; j < 8; ++j) ow[j] = pk2(o[j >> 1][(j & 1) * 2] * rs * __uint_as_float(zz[j] << 16), o[j >> 1][(j & 1) * 2 + 1] * rs * __uint_as_float(zz[j] & 0xffff0000u));
                const size_t grow = (size_t)b * SEQ + seg * SEGTOK + (cl - 1) * 64 + t;
                bf16_t* oa = (bf16_t*)(p.ws + WS_H) + grow * D + h * 128 + 16 * g;
                *(u32x4*)oa = (u32x4){ow[0], ow[1], ow[2], ow[3]}; *(u32x4*)(oa + 8) = (u32x4){ow[4], ow[5], ow[6], ow[7]};
            }
        }
#pragma unroll
        for (int mt = 0; mt < 8; ++mt) { f32x4 t = {0.f, 0.f, 0.f, 0.f};
#pragma unroll
            for (int ks = 0; ks < 4; ++ks) t = MFMA16(AP[(mt * 4 + ks) * 64 + lane], Bf[ks], t);
            S[mt][0] = egl * S[mt][0] + t[0] + __uint_as_float(kh[mt].x << 16); S[mt][1] = egl * S[mt][1] + t[1] + __uint_as_float(kh[mt].x & 0xffff0000u);
            S[mt][2] = egl * S[mt][2] + t[2] + __uint_as_float(kh[mt].y << 16); S[mt][3] = egl * S[mt][3] + t[3] + __uint_as_float(kh[mt].y & 0xffff0000u); }
    }
#pragma unroll
    for (int mt = 0; mt < 8; ++mt)
#pragma unroll
        for (int r = 0; r < 4; ++r) st[(size_t)(16 * mt + 4 * q4 + r) * 128 + 16 * w + l15] = S[mt][r];
    __syncthreads();
}

constexpr int RL_AT = 0, RL_BT = 9216, RL_KT = 18432, RL_ATT = 27648, RL_RT = 36864, RL_BTLT = 46080, RL_KTLT = 55296, RL_VT = 64512, RL_LAK = 73728, RL_MRB = 82944, RL_MRK = 92160,
              RL_LM = 101376, RL_AF = 117760, RL_TM = 134144, RL_XS = 150528;
__device__ __forceinline__ void rwkv_prep_item(const Params& p, unsigned char* smem, int hb, int row_start, int npad, const bf16_t* prev_row,
                                               bf16_t* halo_out, unsigned char* rec) {
    const int tid = otid(), w = tid >> 6, lane = tid & 63, q4 = lane >> 4, l15 = lane & 15;
    bf16_t* At = (bf16_t*)(smem + RL_AT); bf16_t* Tb = At; bf16_t* Bt = (bf16_t*)(smem + RL_BT); bf16_t* WaT = Bt; bf16_t* Kt = (bf16_t*)(smem + RL_KT); bf16_t* XT = Kt;
    bf16_t* AtT = (bf16_t*)(smem + RL_ATT); bf16_t* Rt = (bf16_t*)(smem + RL_RT); bf16_t* BtlT = (bf16_t*)(smem + RL_BTLT); bf16_t* KtlT = (bf16_t*)(smem + RL_KTLT);
    bf16_t* VT = (bf16_t*)(smem + RL_VT); bf16_t* Lak = (bf16_t*)(smem + RL_LAK); bf16_t* Mrb = (bf16_t*)(smem + RL_MRB); bf16_t* Mrk = (bf16_t*)(smem + RL_MRK);
    float* Lm = (float*)(smem + RL_LM);
    bf16_t* thw = Lak; bf16_t* adb = Mrb; float* lc = Lm; float* af = (float*)(smem + RL_AF);
    const bf16_t* P = (const bf16_t*)(p.ws + WS_P);
    const float* pk = (const float*)(p.ws + WS_PK);
    const int t = tid >> 3, g = tid & 7;
    float rr[8], kb[8], vv[8], zb[8];
    {
        const bool real = t >= npad;
        const bf16_t* curp = P; const bf16_t* prevp = P; float fprev = 0.f;
        if (real) { curp = P + (size_t)(row_start + t - npad) * NPB; if (t > npad) { prevp = curp - NPB; fprev = 1.f; } else if (prev_row) { prevp = prev_row; fprev = 1.f; } }
        const int secbase[6] = {0, 1024, 2048, 3200, 3072, 3136};
        u32x4 rc[6], rp[6];
#pragma unroll
        for (int sidx = 0; sidx < 6; ++sidx) { const int col = secbase[sidx] + (sidx < 4 ? hb * 64 : 0) + g * 8; rc[sidx] = *(const u32x4*)(curp + C_RW + col); rp[sidx] = *(const u32x4*)(prevp + C_RW + col); }
        float m[6][8];
#pragma unroll
        for (int sidx = 0; sidx < 6; ++sidx) {
            const int col = secbase[sidx] + (sidx < 4 ? hb * 64 : 0) + g * 8;
            float cur[8], prv[8];
            unpack8(rc[sidx], cur); unpack8(rp[sidx], prv);
            const f32x4 mu0 = *(const f32x4*)(pk + PK_MU + col), mu1 = *(const f32x4*)(pk + PK_MU + col + 4);
            const float mu[8] = {mu0[0], mu0[1], mu0[2], mu0[3], mu1[0], mu1[1], mu1[2], mu1[3]};
#pragma unroll
            for (int e = 0; e < 8; ++e) m[sidx][e] = real ? cur[e] + mu[e] * (fprev * prv[e] - cur[e]) : 0.f;
            if (halo_out && t == 63 && (sidx < 4 || hb == 0)) *(u32x4*)(halo_out + C_RW + col) = rc[sidx];
        }
#pragma unroll
        for (int e = 0; e < 8; ++e) { rr[e] = m[0][e]; kb[e] = m[1][e]; vv[e] = m[2][e]; zb[e] = m[3][e]; }
        float th[8];
#pragma unroll
        for (int e = 0; e < 8; ++e) th[e] = tanh_(m[4][e]);
        *(u32x4*)(thw + t * TSTR + g * 8) = pack8(th);
        *(u32x4*)(adb + t * TSTR + g * 8) = pack8(m[5]);
    }
    __syncthreads();
    {
        const int which = w >> 2, ct = w & 3;
        const bf16_t* Wt = (const bf16_t*)(p.ws + (which ? WS_A2T : WS_W2T)) + (size_t)hb * 4096;
        const bf16x8 b0 = *(const bf16x8*)(Wt + (16 * ct + l15) * 64 + 8 * q4), b1 = *(const bf16x8*)(Wt + (16 * ct + l15) * 64 + 32 + 8 * q4);
        const bf16_t* Aarr = which ? adb : thw;
        const int c = 16 * ct + l15;
        const float bias = pk[(which ? PK_A0 : PK_W0) + hb * 64 + c];
        float carry = 0.f;
#pragma unroll
        for (int tt = 0; tt < 4; ++tt) {
            f32x4 acc = {0.f, 0.f, 0.f, 0.f};
            acc = MFMA16(ldfrag(Aarr, TSTR, 16 * tt, 0, lane), b0, acc); acc = MFMA16(ldfrag(Aarr, TSTR, 16 * tt, 32, lane), b1, acc);
            if (which) {
#pragma unroll
                for (int r = 0; r < 4; ++r) af[(16 * tt + 4 * q4 + r) * 64 + c] = sigm(bias + acc[r]);
            } else {
                float wl[4];
#pragma unroll
                for (int r = 0; r < 4; ++r) { const int tk = 16 * tt + 4 * q4 + r; wl[r] = (tk < npad) ? 0.f : -0.6065306597126334f * sigm(bias + acc[r]); }
                wl[1] += wl[0]; wl[2] += wl[1]; wl[3] += wl[2];
                const float Q = wl[3];
                const float Q0 = __shfl(Q, l15), Q1 = __shfl(Q, l15 + 16), Q2 = __shfl(Q, l15 + 32), Q3 = __shfl(Q, l15 + 48);
                const float ex = carry + (q4 > 0 ? Q0 : 0.f) + (q4 > 1 ? Q1 : 0.f) + (q4 > 2 ? Q2 : 0.f);
#pragma unroll
                for (int r = 0; r < 4; ++r) lc[(16 * tt + 4 * q4 + r) * 64 + c] = ex + wl[r];
                carry += Q0 + Q1 + Q2 + Q3;
            }
        }
    }
    __syncthreads();
    {
        float lct[8], lcp[8], lcC[8], av[8];
        { const f32x4 a = *(const f32x4*)(lc + t * 64 + g * 8), b2 = *(const f32x4*)(lc + t * 64 + g * 8 + 4); lct[0] = a[0]; lct[1] = a[1]; lct[2] = a[2]; lct[3] = a[3]; lct[4] = b2[0]; lct[5] = b2[1]; lct[6] = b2[2]; lct[7] = b2[3]; }
        if (t > 0) { const f32x4 a = *(const f32x4*)(lc + (t - 1) * 64 + g * 8), b2 = *(const f32x4*)(lc + (t - 1) * 64 + g * 8 + 4); lcp[0] = a[0]; lcp[1] = a[1]; lcp[2] = a[2]; lcp[3] = a[3]; lcp[4] = b2[0]; lcp[5] = b2[1]; lcp[6] = b2[2]; lcp[7] = b2[3]; }
        else {
#pragma unroll
            for (int e = 0; e < 8; ++e) lcp[e] = 0.f; }
        { const f32x4 a = *(const f32x4*)(lc + 63 * 64 + g * 8), b2 = *(const f32x4*)(lc + 63 * 64 + g * 8 + 4); lcC[0] = a[0]; lcC[1] = a[1]; lcC[2] = a[2]; lcC[3] = a[3]; lcC[4] = b2[0]; lcC[5] = b2[1]; lcC[6] = b2[2]; lcC[7] = b2[3]; }
        { const f32x4 a = *(const f32x4*)(af + t * 64 + g * 8), b2 = *(const f32x4*)(af + t * 64 + g * 8 + 4); av[0] = a[0]; av[1] = a[1]; av[2] = a[2]; av[3] = a[3]; av[4] = b2[0]; av[5] = b2[1]; av[6] = b2[2]; av[7] = b2[3]; }
        const int hc = hb * 64 + g * 8;
        float kk[8], km[8], ss = 0.f, rk = 0.f;
#pragma unroll
        for (int e = 0; e < 8; ++e) { kk[e] = kb[e] * pk[PK_KK + hc + e]; ss += kk[e] * kk[e]; km[e] = kb[e] * (1.f + (av[e] - 1.f) * pk[PK_KA + hc + e]); rk += rr[e] * km[e] * pk[PK_RK + hc + e]; }
        ss += __shfl_xor(ss, 1); ss += __shfl_xor(ss, 2); ss += __shfl_xor(ss, 4);
        rk += __shfl_xor(rk, 1); rk += __shfl_xor(rk, 2); rk += __shfl_xor(rk, 4);
        const float kn = rsqrtf(ss + 1e-6f);
        float xa[8], xb[8], xk[8], xr[8], xbt[8], xkt[8];
#pragma unroll
        for (int e = 0; e < 8; ++e) { kk[e] *= kn; const float ka = kk[e] * av[e]; const float ip = __expf(-lct[e]), tl = __expf(lcC[e] - lct[e]);
            xa[e] = kk[e] * __expf(lcp[e]); xb[e] = ka * ip; xk[e] = km[e] * ip; xr[e] = rr[e] * __expf(lct[e]); xbt[e] = ka * tl; xkt[e] = km[e] * tl; }
        *(u32x4*)(At + t * TSTR + g * 8) = pack8(xa); *(u32x4*)(Bt + t * TSTR + g * 8) = pack8(xb); *(u32x4*)(Kt + t * TSTR + g * 8) = pack8(xk); *(u32x4*)(Rt + t * TSTR + g * 8) = pack8(xr);
#pragma unroll
        for (int e = 0; e < 8; ++e) { const int c = g * 8 + e; AtT[c * TSTR + t] = (bf16_t)f2bf(xa[e]); BtlT[c * TSTR + t] = (bf16_t)f2bf(xbt[e]); KtlT[c * TSTR + t] = (bf16_t)f2bf(xkt[e]); VT[c * TSTR + t] = (bf16_t)f2bf(vv[e]); }
        float c1[8], c0[8];
#pragma unroll
        for (int e = 0; e < 8; ++e) { const float sz = silu_(zb[e]); c1[e] = pk[PK_GNW + hc + e] * sz; c0[e] = (pk[PK_GNB + hc + e] + rk * vv[e]) * sz; }
        *(u32x4*)((bf16_t*)(rec + RP_C1) + t * 64 + g * 8) = pack8(c1); *(u32x4*)((bf16_t*)(rec + RP_C0) + t * 64 + g * 8) = pack8(c0);
        if (t == 63) { float* pc = (float*)(rec + RP_PC) + g * 8; *(f32x4*)pc = (f32x4){__expf(lcC[0]), __expf(lcC[1]), __expf(lcC[2]), __expf(lcC[3])}; *(f32x4*)(pc + 4) = (f32x4){__expf(lcC[4]), __expf(lcC[5]), __expf(lcC[6]), __expf(lcC[7])}; }
    }
    __syncthreads();
    {
        const int pr = w >> 1;
        const bf16_t* Aarr = pr < 2 ? At : Rt; const bf16_t* Barr = (pr & 1) ? Kt : Bt;
#pragma unroll
        for (int x = 0; x < 2; ++x) { const int tt = 2 * (w & 1) + x;
            const bf16x8 a0 = ldfrag(Aarr, TSTR, 16 * tt, 0, lane), a1 = ldfrag(Aarr, TSTR, 16 * tt, 32, lane);
#pragma unroll
            for (int it = 0; it < 4; ++it) { f32x4 acc = {0.f, 0.f, 0.f, 0.f};
                acc = MFMA16(a0, ldfrag(Barr, TSTR, 16 * it, 0, lane), acc); acc = MFMA16(a1, ldfrag(Barr, TSTR, 16 * it, 32, lane), acc);
                const int i = 16 * it + l15;
#pragma unroll
                for (int r = 0; r < 4; ++r) { const int tk = 16 * tt + 4 * q4 + r;
                    if (pr == 0) Lm[tk * 64 + i] = (tk > i) ? acc[r] : 0.f;
                    else if (pr == 1) Lak[tk * TSTR + i] = (bf16_t)f2bf((tk > i) ? acc[r] : 0.f);
                    else if (pr == 2) Mrb[tk * TSTR + i] = (bf16_t)f2bf((tk >= i) ? acc[r] : 0.f);
                    else Mrk[tk * TSTR + i] = (bf16_t)f2bf((tk >= i) ? acc[r] : 0.f); } }
        }
    }
    __syncthreads();
    {
        float* Tm = (float*)(smem + RL_TM);
        inv_block(Lm, Tm, (float*)(smem + RL_XS), tid);
        const int i = tid >> 3, j0 = (tid & 7) * 8;
        float a[8];
#pragma unroll
        for (int e = 0; e < 8; ++e) a[e] = Tm[i * 64 + j0 + e];
        *(u32x4*)(Tb + i * TSTR + j0) = pack8(a);
    }
    __syncthreads();
    {
        const int tt = w & 3, which = w >> 2;
        const bf16_t* Aarr = which ? Lak : Tb; const bf16_t* Barr = which ? VT : AtT; bf16_t* Out = which ? XT : WaT;
        const bf16x8 a0 = ldfrag(Aarr, TSTR, 16 * tt, 0, lane), a1 = ldfrag(Aarr, TSTR, 16 * tt, 32, lane);
#pragma unroll
        for (int ct = 0; ct < 4; ++ct) { f32x4 acc = {0.f, 0.f, 0.f, 0.f};
            acc = MFMA16(a0, ldfrag(Barr, TSTR, 16 * ct, 0, lane), acc); acc = MFMA16(a1, ldfrag(Barr, TSTR, 16 * ct, 32, lane), acc);
            *(u32x2*)(Out + (16 * ct + l15) * TSTR + 16 * tt + 4 * q4) = (u32x2){pk2(acc[0], acc[1]), pk2(acc[2], acc[3])}; }
    }
    __syncthreads();
    {
        f32x4 acc[4];
        if (w < 4) {
            const bf16x8 a0 = ldfrag(Tb, TSTR, 16 * w, 0, lane), a1 = ldfrag(Tb, TSTR, 16 * w, 32, lane);
#pragma unroll
            for (int ct = 0; ct < 4; ++ct) { acc[ct] = (f32x4){0.f, 0.f, 0.f, 0.f};
                acc[ct] = MFMA16(a0, ldfrag(XT, TSTR, 16 * ct, 0, lane), acc[ct]); acc[ct] = MFMA16(a1, ldfrag(XT, TSTR, 16 * ct, 32, lane), acc[ct]); }
        }
        __syncthreads();
        if (w < 4) {
#pragma unroll
            for (int ct = 0; ct < 4; ++ct) *(u32x2*)(XT + (16 * ct + l15) * TSTR + 16 * w + 4 * q4) = (u32x2){pk2(-acc[ct][0], -acc[ct][1]), pk2(-acc[ct][2], -acc[ct][3])};
        }
    }
    __syncthreads();
    {
        const bf16_t* UvT = XT;
        bf16_t* gAP = (bf16_t*)(rec + RP_AP); bf16_t* gRH = (bf16_t*)(rec + RP_RH); bf16_t* gKH = (bf16_t*)(rec + RP_KH); bf16_t* gYH = (bf16_t*)(rec + RP_YH);
        const int et = w & 3, part = w >> 2;
        {
            const bf16x8 a0 = ldfrag(WaT, TSTR, 16 * et, 0, lane), a1 = ldfrag(WaT, TSTR, 16 * et, 32, lane);
            if (part == 0) {
#pragma unroll
                for (int kt = 0; kt < 4; ++kt) { f32x4 acc = {0.f, 0.f, 0.f, 0.f};
                    acc = MFMA16(a0, ldfrag(BtlT, TSTR, 16 * kt, 0, lane), acc); acc = MFMA16(a1, ldfrag(BtlT, TSTR, 16 * kt, 32, lane), acc);
                    *(u32x2*)(gAP + ((size_t)(kt * 2 + (et >> 1)) * 64 + lane) * 8 + (et & 1) * 4) = (u32x2){pk2(-acc[0], -acc[1]), pk2(-acc[2], -acc[3])}; }
            } else {
#pragma unroll
                for (int tt = 0; tt < 4; ++tt) { f32x4 acc = {0.f, 0.f, 0.f, 0.f};
                    acc = MFMA16(a0, ldfrag(Mrb, TSTR, 16 * tt, 0, lane), acc); acc = MFMA16(a1, ldfrag(Mrb, TSTR, 16 * tt, 32, lane), acc);
                    const int tk = 16 * tt + l15, e0 = 16 * et + 4 * q4;
                    const u32x2 q2 = *(const u32x2*)(Rt + tk * TSTR + e0);
                    const float o0 = __uint_as_float(q2.x << 16) - acc[0], o1 = __uint_as_float(q2.x & 0xffff0000u) - acc[1], o2 = __uint_as_float(q2.y << 16) - acc[2], o3 = __uint_as_float(q2.y & 0xffff0000u) - acc[3];
                    *(u32x2*)(gRH + ((size_t)(tt * 2 + (et >> 1)) * 64 + lane) * 8 + (et & 1) * 4) = (u32x2){pk2(o0, o1), pk2(o2, o3)}; }
            }
        }
        {
            const int rt = w & 3;
            const bf16_t* A1 = part ? BtlT : Mrb; const bf16_t* A2 = part ? KtlT : Mrk; bf16_t* Out = part ? gKH : gYH;
            const bf16x8 a0 = ldfrag(A1, TSTR, 16 * rt, 0, lane), a1 = ldfrag(A1, TSTR, 16 * rt, 32, lane), a2 = ldfrag(A2, TSTR, 16 * rt, 0, lane), a3 = ldfrag(A2, TSTR, 16 * rt, 32, lane);
#pragma unroll
            for (int vt = 0; vt < 4; ++vt) { f32x4 acc = {0.f, 0.f, 0.f, 0.f};
                acc = MFMA16(a0, ldfrag(UvT, TSTR, 16 * vt, 0, lane), acc); acc = MFMA16(a1, ldfrag(UvT, TSTR, 16 * vt, 32, lane), acc);
                acc = MFMA16(a2, ldfrag(VT, TSTR, 16 * vt, 0, lane), acc); acc = MFMA16(a3, ldfrag(VT, TSTR, 16 * vt, 32, lane), acc);
                *(u32x2*)(Out + ((size_t)(vt * 4 + rt) * 64 + lane) * 4) = (u32x2){pk2(acc[0], acc[1]), pk2(acc[2], acc[3])}; }
        }
    }
    __syncthreads();
}

__device__ __forceinline__ void phase_rprep(const Params& p, int seg, unsigned char* smem) {
    const int blk = obid();
    const int n_items = (CPS + (seg == 0 ? 1 : 0)) * 128;
#pragma unroll 1
    for (int it = blk; it < n_items; it += gridDim.x) {
        const int bh = it & 127, b = bh >> 4, hb = bh & 15; int cl = it >> 7; if (seg != 0) cl += 1;
        unsigned char* rec = p.ws + WS_RP + (size_t)(cl * 128 + bh) * RP_STRIDE;
        const bf16_t* Pb = (const bf16_t*)(p.ws + WS_P);
        bf16_t* phalo2 = (bf16_t*)(p.ws + WS_PHALO);
        if (cl == 0) rwkv_prep_item(p, smem, hb, LEX0, 48, nullptr, nullptr, rec);
        else {
            const int row = b * SEGTOK + (cl - 1) * 64;
            const bf16_t* prow = Pb + (size_t)(row - 1) * NPB;
            if (cl == 1) prow = (seg == 0) ? Pb + (size_t)(LEX0 + NMETA - 1) * NPB : phalo2 + (size_t)(((seg - 1) & 1) * NBATCH + b) * NPB;
            bf16_t* ho = (cl == CPS) ? phalo2 + (size_t)((seg & 1) * NBATCH + b) * NPB : nullptr;
            rwkv_prep_item(p, smem, hb, row, 0, prow, ho, rec);
        }
    }
}

__device__ __forceinline__ void rwkv_scan_block(const Params& p, int seg, unsigned char* smem, int pairidx) {
    const int tid = otid(), w = tid >> 6, lane = tid & 63, q4 = lane >> 4, l15 = lane & 15;
    const int hsel = w >> 2, vt = w & 3;
    const int bh = pairidx * 2 + hsel, b = bh >> 4, hb = bh & 15;
    float* st = p.out + O_RWKV_P + (size_t)bh * 4096;
    f32x4 S[4];
    if (seg) {
#pragma unroll
        for (int mt = 0; mt < 4; ++mt) S[mt] = *(const f32x4*)(st + (size_t)(16 * vt + l15) * 64 + 16 * mt + 4 * q4);
    } else {
#pragma unroll
        for (int mt = 0; mt < 4; ++mt) S[mt] = (f32x4){0.f, 0.f, 0.f, 0.f};
    }
    const int c_lo = seg ? 1 : 0;
    float* ybuf = (float*)(smem + 32768) + hsel * (64 * 68);
#pragma unroll 1
    for (int cl = c_lo; cl <= CPS; ++cl) {
        const unsigned char* rec = p.ws + WS_RP + (size_t)(cl * 128 + bh) * RP_STRIDE;
        __syncthreads();
        {
            const u32x4* src = (const u32x4*)rec; u32x4* dst = (u32x4*)(smem + hsel * 16384); const int tl = tid & 255;
#pragma unroll
            for (int x = 0; x < 4; ++x) dst[tl + 256 * x] = src[tl + 256 * x];
        }
        const bf16_t* gKH = (const bf16_t*)(rec + RP_KH); const bf16_t* gYH = (const bf16_t*)(rec + RP_YH);
        u32x2 kh[4], yh[4]; f32x4 pc[4];
#pragma unroll
        for (int mt = 0; mt < 4; ++mt) { kh[mt] = *(const u32x2*)(gKH + ((size_t)(vt * 4 + mt) * 64 + lane) * 4); yh[mt] = *(const u32x2*)(gYH + ((size_t)(vt * 4 + mt) * 64 + lane) * 4);
            pc[mt] = *(const f32x4*)((const float*)(rec + RP_PC) + 16 * mt + 4 * q4); }
        bf16x8 Bf[2];
#pragma unroll
        for (int ks = 0; ks < 2; ++ks) { u32x4 tq; tq.x = pk2(S[2 * ks][0], S[2 * ks][1]); tq.y = pk2(S[2 * ks][2], S[2 * ks][3]); tq.z = pk2(S[2 * ks + 1][0], S[2 * ks + 1][1]); tq.w = pk2(S[2 * ks + 1][2], S[2 * ks + 1][3]);
            Bf[ks] = __builtin_bit_cast(bf16x8, tq); }
        __syncthreads();
        const bf16x8* AP = (const bf16x8*)(smem + hsel * 16384); const bf16x8* RH = (const bf16x8*)(smem + hsel * 16384 + RP_RH);
        if (cl > 0) {
#pragma unroll
            for (int tt = 0; tt < 4; ++tt) { f32x4 y = {0.f, 0.f, 0.f, 0.f};
                y = MFMA16(RH[(tt * 2 + 0) * 64 + lane], Bf[0], y); y = MFMA16(RH[(tt * 2 + 1) * 64 + lane], Bf[1], y);
                y[0] += __uint_as_float(yh[tt].x << 16); y[1] += __uint_as_float(yh[tt].x & 0xffff0000u); y[2] += __uint_as_float(yh[tt].y << 16); y[3] += __uint_as_float(yh[tt].y & 0xffff0000u);
#pragma unroll
                for (int r = 0; r < 4; ++r) ybuf[(16 * tt + 4 * q4 + r) * 68 + 16 * vt + l15] = y[r]; }
        }
#pragma unroll
        for (int mt = 0; mt < 4; ++mt) { f32x4 tq = {0.f, 0.f, 0.f, 0.f};
            tq = MFMA16(AP[(mt * 2 + 0) * 64 + lane], Bf[0], tq); tq = MFMA16(AP[(mt * 2 + 1) * 64 + lane], Bf[1], tq);
            S[mt][0] = pc[mt][0] * S[mt][0] + tq[0] + __uint_as_float(kh[mt].x << 16); S[mt][1] = pc[mt][1] * S[mt][1] + tq[1] + __uint_as_float(kh[mt].x & 0xffff0000u);
            S[mt][2] = pc[mt][2] * S[mt][2] + tq[2] + __uint_as_float(kh[mt].y << 16); S[mt][3] = pc[mt][3] * S[mt][3] + tq[3] + __uint_as_float(kh[mt].y & 0xffff0000u); }
        if (cl > 0) {
            __syncthreads();
            const int tl = tid & 255, tk = tl >> 2, g = tl & 3;
            f32x4 y[4]; float sm = 0.f;
#pragma unroll
            for (int j = 0; j < 4; ++j) { y[j] = *(const f32x4*)(ybuf + tk * 68 + 16 * g + 4 * j); sm += y[j][0] + y[j][1] + y[j][2] + y[j][3]; }
            sm += __shfl_xor(sm, 1); sm += __shfl_xor(sm, 2);
            const float mu = sm * (1.f / 64.f); float vs = 0.f;
#pragma unroll
            for (int j = 0; j < 4; ++j) { y[j] = y[j] - mu; vs += y[j][0] * y[j][0] + y[j][1] * y[j][1] + y[j][2] * y[j][2] + y[j][3] * y[j][3]; }
            vs += __shfl_xor(vs, 1); vs += __shfl_xor(vs, 2);
            const float rs = rsqrtf(vs * (1.f / 64.f) + 64e-5f);
            const bf16_t* c1p = (const bf16_t*)(rec + RP_C1) + tk * 64 + 16 * g; const bf16_t* c0p = (const bf16_t*)(rec + RP_C0) + tk * 64 + 16 * g;
            const u32x4 a0 = *(const u32x4*)c0p, a1 = *(const u32x4*)(c0p + 8), b0 = *(const u32x4*)c1p, b1 = *(const u32x4*)(c1p + 8);
            const unsigned c0w[8] = {a0.x, a0.y, a0.z, a0.w, a1.x, a1.y, a1.z, a1.w}, c1w[8] = {b0.x, b0.y, b0.z, b0.w, b1.x, b1.y, b1.z, b1.w};
            unsigned ow[8];
#pragma unroll
            for (int j = 0; j < 8; ++j) ow[j] = pk2(y[j >> 1][(j & 1) * 2] * rs * __uint_as_float(c1w[j] << 16) + __uint_as_float(c0w[j] << 16),
                                                     y[j >> 1][(j & 1) * 2 + 1] * rs * __uint_as_float(c1w[j] & 0xffff0000u) + __uint_as_float(c0w[j] & 0xffff0000u));
            const size_t grow = (size_t)b * SEQ + seg * SEGTOK + (cl - 1) * 64 + tk;
            bf16_t* ob = (bf16_t*)(p.ws + WS_OB) + grow * D + hb * 64 + 16 * g;
            *(u32x4*)ob = (u32x4){ow[0], ow[1], ow[2], ow[3]}; *(u32x4*)(ob + 8) = (u32x4){ow[4], ow[5], ow[6], ow[7]};
        }
    }
#pragma unroll
    for (int mt = 0; mt < 4; ++mt) *(f32x4*)(st + (size_t)(16 * vt + l15) * 64 + 16 * mt + 4 * q4) = S[mt];
    __syncthreads();
}

__device__ __forceinline__ void gdn_sample_item(const Params& p, unsigned char* smem, int bs, int h) {
    const int tid = otid(), w = tid >> 6, lane = tid & 63, kq = tid >> 7, v = tid & 127;
    float* qk_s = (float*)smem; float* v_s = qk_s + 1024; float* gb_s = v_s + 512; float* part = gb_s + 16; float* part2 = part + 512;
    const bf16_t* P = (const bf16_t*)(p.ws + WS_P);
    const float* pk = (const float*)(p.ws + WS_PK);
    const float* s_in = p.in[2] + (size_t)(bs * 8 + h) * 16384; float* s_out = p.out + O_GDN_S + (size_t)(bs * 8 + h) * 16384;
    const int row0 = LEX0 + EX_SAMP + bs * DECT;
    float s[32];
#pragma unroll
    for (int j = 0; j < 32; ++j) s[j] = s_in[(size_t)(kq * 32 + j) * 128 + v];
    if (tid < 384) {
        const int pcol = (tid >> 7) * 1024 + h * 128 + (tid & 127);
        const float* cw = pk + PK_CONVW; const float* hin = p.in[3] + (size_t)bs * 9216; float* hout = p.out + O_CONV_S + (size_t)bs * 9216;
        const float cw0 = cw[pcol], cw1 = cw[3072 + pcol], cw2 = cw[6144 + pcol], cw3 = cw[9216 + pcol];
        float x3 = hin[pcol], x2 = hin[3072 + pcol], x1 = hin[6144 + pcol];
        float xr[4];
#pragma unroll
        for (int i = 0; i < 4; ++i) xr[i] = bf2f(P[(size_t)(row0 + i) * NPB + pcol]);
#pragma unroll
        for (int i = 0; i < 4; ++i) { const float y = cw0 * x3 + cw1 * x2 + cw2 * x1 + cw3 * xr[i]; x3 = x2; x2 = x1; x1 = xr[i];
            if (tid < 256) qk_s[i * 256 + tid] = silu_(y); else v_s[i * 128 + (tid - 256)] = silu_(y); }
        hout[pcol] = x3; hout[3072 + pcol] = x2; hout[6144 + pcol] = x1;
    } else if (tid < 388) {
        const int i = tid - 384; const size_t r = (size_t)(row0 + i) * NPB;
        const float pa = bf2f(P[r + C_A + h]), pb = bf2f(P[r + C_B + h]);
        gb_s[2 * i] = __expf(-expf(pk[PK_ALOG + h]) * softplus_(pa + pk[PK_DTB + h])); gb_s[2 * i + 1] = sigm(pb);
    }
    __syncthreads();
    { const int i = w >> 1, which = w & 1; float* rp = qk_s + i * 256 + which * 128; const float a = rp[lane], b = rp[lane + 64];
      const float sc = rsqrtf(wave_sum(a * a + b * b) + 1e-6f) * (which == 0 ? 0.08838834764831845f : 1.f); rp[lane] = a * sc; rp[lane + 64] = b * sc; }
    __syncthreads();
#pragma unroll 1
    for (int i = 0; i < 4; ++i) {
        const float* kp = qk_s + i * 256 + 128 + kq * 32; const float* qp = qk_s + i * 256 + kq * 32;
        float pa = 0.f;
#pragma unroll
        for (int j4 = 0; j4 < 8; ++j4) { const f32x4 k4 = *(const f32x4*)(kp + 4 * j4); pa += k4[0] * s[4 * j4] + k4[1] * s[4 * j4 + 1] + k4[2] * s[4 * j4 + 2] + k4[3] * s[4 * j4 + 3]; }
        part[kq * 128 + v] = pa;
        __syncthreads();
        const float kS = part[v] + part[128 + v] + part[256 + v] + part[384 + v];
        const float a = gb_s[2 * i], c = gb_s[2 * i + 1] * (v_s[i * 128 + v] - a * kS);
        float po = 0.f;
#pragma unroll
        for (int j4 = 0; j4 < 8; ++j4) { const f32x4 k4 = *(const f32x4*)(kp + 4 * j4), q4v = *(const f32x4*)(qp + 4 * j4);
#pragma unroll
            for (int e = 0; e < 4; ++e) { s[4 * j4 + e] = a * s[4 * j4 + e] + k4[e] * c; po += q4v[e] * s[4 * j4 + e]; } }
        part2[kq * 128 + v] = po;
        __syncthreads();
        if (kq == 0) ((float*)(p.ws + WS_ORAW))[(size_t)(row0 + i) * D + h * 128 + v] = part2[v] + part2[128 + v] + part2[256 + v] + part2[384 + v];
    }
#pragma unroll
    for (int j = 0; j < 32; ++j) s_out[(size_t)(kq * 32 + j) * 128 + v] = s[j];
    __syncthreads();
}

constexpr int SR_R = 0, SR_KK = 4096, SR_V = 8192, SR_ZB = 12288, SR_DEC = 16384, SR_KA = 20480, SR_KM = 24576, SR_WD = 28672, SR_AD = 28928, SR_RK = 29184;
__device__ __forceinline__ void rwkv_sample_item(const Params& p, unsigned char* smem, int bs) {
    const int tid = otid(), w = tid >> 6, lane = tid & 63;
    float* f = (float*)smem;
    const bf16_t* P = (const bf16_t*)(p.ws + WS_P);
    const float* pk = (const float*)(p.ws + WS_PK);
    const int row0 = LEX0 + EX_SAMP + bs * DECT;
    const bf16_t* prow = P + (size_t)(LEX0 + EX_SHIFT + bs) * NPB + C_RW;
#pragma unroll 1
    for (int col = tid; col < RW_SHIFT; col += 512) {
        const float mu = pk[PK_MU + col]; float prev = bf2f(prow[col]);
        float cur[4];
#pragma unroll
        for (int i = 0; i < 4; ++i) cur[i] = bf2f(P[(size_t)(row0 + i) * NPB + C_RW + col]);
        float* dst; int stride = 1024; bool th = false;
        if (col < 1024) dst = f + SR_R + col; else if (col < 2048) dst = f + SR_KK + (col - 1024); else if (col < 3072) dst = f + SR_V + (col - 2048);
        else if (col < 3136) { dst = f + SR_WD + (col - 3072); stride = 64; th = true; } else if (col < 3200) { dst = f + SR_AD + (col - 3136); stride = 64; } else dst = f + SR_ZB + (col - 3200);
#pragma unroll
        for (int i = 0; i < 4; ++i) { float m = cur[i] + mu * (prev - cur[i]); prev = cur[i]; if (th) m = tanh_(m); dst[i * stride] = m; }
    }
    __syncthreads();
#pragma unroll 1
    for (int cc = 0; cc < 2; ++cc) {
        const int c = tid + 512 * cc;
        float aw[4] = {0.f, 0.f, 0.f, 0.f}, aa[4] = {0.f, 0.f, 0.f, 0.f};
#pragma unroll 8
        for (int l = 0; l < 64; ++l) { const float w2v = pk[PK_W2 + l * D + c], a2v = pk[PK_A2 + l * D + c];
#pragma unroll
            for (int i = 0; i < 4; ++i) { aw[i] += f[SR_WD + i * 64 + l] * w2v; aa[i] += f[SR_AD + i * 64 + l] * a2v; } }
        const float w0c = pk[PK_W0 + c], a0c = pk[PK_A0 + c], kkc = pk[PK_KK + c], kac = pk[PK_KA + c];
#pragma unroll
        for (int i = 0; i < 4; ++i) { const float a = sigm(a0c + aa[i]); const float kbv = f[SR_KK + i * 1024 + c];
            f[SR_DEC + i * 1024 + c] = __expf(-0.6065306597126334f * sigm(w0c + aw[i])); f[SR_KA + i * 1024 + c] = a; f[SR_KK + i * 1024 + c] = kbv * kkc; f[SR_KM + i * 1024 + c] = kbv * (1.f + (a - 1.f) * kac); }
    }
    __syncthreads();
#pragma unroll 1
    for (int x = 0; x < 8; ++x) { const int pr = w * 8 + x, i = pr >> 4, hh = pr & 15; const int o = i * 1024 + hh * 64 + lane;
        const float kr = f[SR_KK + o]; const float kk = kr * rsqrtf(wave_sum(kr * kr) + 1e-6f); f[SR_KK + o] = kk; f[SR_KA + o] = kk * f[SR_KA + o];
        const float rkv = wave_sum(f[SR_R + o] * f[SR_KM + o] * pk[PK_RK + hh * 64 + lane]); if (lane == 0) f[SR_RK + pr] = rkv; }
    __syncthreads();
#pragma unroll 1
    for (int hp = 0; hp < 2; ++hp) {
        const int hb = hp * 8 + w;
        const float* s_in = p.in[4] + (size_t)(bs * 16 + hb) * 4096 + (size_t)lane * 64; float* s_out = p.out + O_RWKV_S + (size_t)(bs * 16 + hb) * 4096 + (size_t)lane * 64;
        f32x4 S[16];
#pragma unroll
        for (int j = 0; j < 16; ++j) S[j] = *(const f32x4*)(s_in + 4 * j);
        const int cch = hb * 64 + lane;
        const float gnw = pk[PK_GNW + cch], gnb = pk[PK_GNB + cch];
#pragma unroll 1
        for (int i = 0; i < 4; ++i) {
            const int o = i * 1024 + hb * 64;
            const float vv = f[SR_V + o + lane], rk = f[SR_RK + i * 16 + hb];
            float sa = 0.f;
#pragma unroll
            for (int j = 0; j < 16; ++j) { const f32x4 kk4 = *(const f32x4*)(f + SR_KK + o + 4 * j); sa += S[j][0] * kk4[0] + S[j][1] * kk4[1] + S[j][2] * kk4[2] + S[j][3] * kk4[3]; }
            float y = 0.f;
#pragma unroll
            for (int j = 0; j < 16; ++j) { const f32x4 de4 = *(const f32x4*)(f + SR_DEC + o + 4 * j), ka4 = *(const f32x4*)(f + SR_KA + o + 4 * j), km4 = *(const f32x4*)(f + SR_KM + o + 4 * j), r4 = *(const f32x4*)(f + SR_R + o + 4 * j);
#pragma unroll
                for (int e = 0; e < 4; ++e) { S[j][e] = S[j][e] * de4[e] + (vv * km4[e] - sa * ka4[e]); y += S[j][e] * r4[e]; } }
            const float mu = wave_sum(y) * (1.f / 64.f); const float dy = y - mu;
            const float rs = rsqrtf(wave_sum(dy * dy) * (1.f / 64.f) + 64e-5f);
            const float ov = (dy * rs * gnw + gnb + rk * vv) * silu_(f[SR_ZB + i * 1024 + cch]);
            ((bf16_t*)(p.ws + WS_OB))[(size_t)(XROWS + EX_SAMP + bs * DECT + i) * D + cch] = (bf16_t)f2bf(ov);
        }
#pragma unroll
        for (int j = 0; j < 16; ++j) *(f32x4*)(s_out + 4 * j) = S[j];
    }
    __syncthreads();
}

__device__ __forceinline__ void phase2(const Params& p, int seg, unsigned char* smem) {
    const int blk = obid();
    float* out = p.out;
    float* chalo = (float*)(p.ws + WS_CHALO); float* phalo = (float*)(p.ws + WS_PHALO);
#ifndef SUB
#define SUB 0
#endif
#define SEN(x) (SUB == 0 || SUB == (x))
    if (SEN(1) && blk < 64) gdn_scan_block(p, seg, smem, blk);
    if (SEN(3) && blk >= 64 && blk < 128) rwkv_scan_block(p, seg, smem, blk - 64);
#ifndef DUP
#define DUP 0
#endif
    if (seg == 0) {
#pragma unroll 1
        for (int it = blk; it < DECB * 8; it += gridDim.x) gdn_sample_item(p, smem, it >> 3, it & 7);
#pragma unroll 1
        for (int it = (blk + 128) & 255; it < DECB; it += gridDim.x) rwkv_sample_item(p, smem, it);
    }
}

__device__ __forceinline__ void phase25(const Params& p, int seg) {
    const int tid0 = otid(); const int lane = tid0 & 63; const int gw = obid() * 8 + (tid0 >> 6), NGW = gridDim.x * 8;
    const bf16_t* P = (const bf16_t*)(p.ws + WS_P);
    const float* ORAW = (const float*)(p.ws + WS_ORAW); const float* YRAW = (const float*)(p.ws + WS_YRAW);
    const bf16_t* C0 = (const bf16_t*)(p.ws + WS_C0); const bf16_t* C1 = (const bf16_t*)(p.ws + WS_C1);
    bf16_t* OA = (bf16_t*)(p.ws + WS_H); bf16_t* OB = (bf16_t*)(p.ws + WS_OB);
    const int nrows = LEX0 + (seg == 0 ? DECB * DECT : 0);
    const int c = lane * 16;
    f32x4 nw[4];
#pragma unroll
    for (int j = 0; j < 4; ++j) nw[j] = *(const f32x4*)((const float*)(p.ws + WS_PK) + PK_NORMW + (c & 127) + 4 * j);
#pragma unroll 1
    for (int rr = LEX0 + gw; rr < nrows; rr += NGW) {
        int lr; size_t grow;
        if (rr < LEX0) { lr = rr; grow = (size_t)(rr / SEGTOK) * SEQ + seg * SEGTOK + (rr % SEGTOK); } else { lr = LEX0 + EX_SAMP + (rr - LEX0); grow = (size_t)XROWS + EX_SAMP + (rr - LEX0); }
        {
            f32x4 o[4]; float ss = 0.f;
#pragma unroll
            for (int j = 0; j < 4; ++j) { o[j] = *(const f32x4*)(ORAW + (size_t)lr * D + c + 4 * j); ss += o[j][0] * o[j][0] + o[j][1] * o[j][1] + o[j][2] * o[j][2] + o[j][3] * o[j][3]; }
            ss += __shfl_xor(ss, 1); ss += __shfl_xor(ss, 2); ss += __shfl_xor(ss, 4);
            const float rs = rsqrtf(ss * (1.f / 128.f) + 1e-6f);
            const u32x4 z0 = *(const u32x4*)(P + (size_t)lr * NPB + C_Z + c), z1 = *(const u32x4*)(P + (size_t)lr * NPB + C_Z + c + 8);
            const unsigned zz[8] = {z0.x, z0.y, z0.z, z0.w, z1.x, z1.y, z1.z, z1.w};
            unsigned ow[8];
#pragma unroll
            for (int j = 0; j < 8; ++j) { const float za = __uint_as_float(zz[j] << 16), zb = __uint_as_float(zz[j] & 0xffff0000u);
                const float a = o[j >> 1][(j & 1) * 2] * rs * nw[j >> 1][(j & 1) * 2] * silu_(za), b = o[j >> 1][(j & 1) * 2 + 1] * rs * nw[j >> 1][(j & 1) * 2 + 1] * silu_(zb);
                ow[j] = pk2(a, b); }
            *(u32x4*)(OA + grow * D + c) = (u32x4){ow[0], ow[1], ow[2], ow[3]}; *(u32x4*)(OA + grow * D + c + 8) = (u32x4){ow[4], ow[5], ow[6], ow[7]};
        }
    }
}

__device__ __forceinline__ void phase_final(const Params& p) {
    const int tid0 = otid(); const int lane = tid0 & 63; const int gw = obid() * 8 + (tid0 >> 6), NGW = gridDim.x * 8;
    const f32x4* wr = (const f32x4*)((const float*)(p.ws + WS_PK) + PK_LNF) + lane;
#pragma unroll 1
    for (int r = gw; r < XROWS + DECB * DECT; r += NGW) {
        f32x4* xr = (f32x4*)(p.out + (size_t)r * D) + lane;
        f32x4 v[4]; float ss = 0.f;
#pragma unroll
        for (int j = 0; j < 4; ++j) { v[j] = xr[64 * j]; ss += v[j][0] * v[j][0] + v[j][1] * v[j][1] + v[j][2] * v[j][2] + v[j][3] * v[j][3]; }
        const float rs = rsqrtf(wave_sum(ss) * (1.f / D) + 1e-6f);
#pragma unroll
        for (int j = 0; j < 4; ++j) xr[64 * j] = v[j] * rs * wr[64 * j];
    }
}

__global__ __launch_bounds__(512, 2) void hybrid_mega(Params p) {
    extern __shared__ __attribute__((aligned(16))) unsigned char smem[];
    cg::grid_group grid = cg::this_grid();
    LAS unsigned char* lds = (LAS unsigned char*)smem;
    const int G = gridDim.x;
    volatile LAS unsigned* xst = (volatile LAS unsigned*)(lds + (LDS_TOTAL - 16));
    if (threadIdx.x == 0) { xst[0] = 0u; xst[1] = 0u; }
    __syncthreads();
    (void)xcd_barrier_post((unsigned*)(p.ws + WS_BAR), xst);
    if (G == 0x7fffffff) grid.sync();
#define GSYNC() do { XcdBarrier xb_; xb_.bar = (unsigned*)(p.ws + WS_BAR); xb_.x = xb_xcc_id(); xb_.st = (volatile LAS unsigned*)((LAS unsigned char*)smem + (LDS_TOTAL - 16)); xcd_barrier(xb_); } while (0)

#ifndef ONLY
#define ONLY 0
#endif
#define EN(x) (ONLY == 0 || ONLY == (x))
    if (EN(1)) phase0(p, smem);
    GSYNC();
#pragma unroll 1
    for (int it = 0; it <= NSEG; ++it) {
        if (it > 0 && EN(3)) phase2(p, it - 1, smem);
        if (it < NSEG && EN(2)) {
            const int seg = it;
            const int cidx = it > 0 ? (obid() + (G >> 1)) % G : obid();
            SchedIn S; S.ob.init(seg == 0 ? LT_PROMPT + 3 : LT_PROMPT, NT_IN, G, cidx); S.seg = seg; S.A = (const char*)(p.ws + WS_H); S.B = (const char*)(p.ws + WS_WT_IN);
            EpiIn E; E.P = (bf16_t*)(p.ws + WS_P); E.gex = (bf16_t*)(p.ws + WS_GEX); E.out = p.out; E.seg = seg;
            pg8::gemm_phase<EpiIn, SchedIn>(lds, D, S, E);
        }
        GSYNC();
        if (it < NSEG) {
            if (EN(8)) { phase_gprep(p, it, smem); phase_rprep(p, it, smem); }
            if (it == 1 && EN(4)) phase25(p, 0);
            GSYNC();
        }
    }
    if (EN(5)) {
        SchedAB S; S.ob.init(HTILES, 4, G, obid()); S.A0 = (const char*)(p.ws + WS_H); S.A1 = (const char*)(p.ws + WS_OB); S.B0 = (const char*)(p.ws + WS_WT_A); S.B1 = (const char*)(p.ws + WS_WT_B);
        EpiAB E; E.tmp = (float*)(p.ws + WS_P); E.merged = (bf16_t*)(p.ws + WS_MG); E.gex = (const bf16_t*)(p.ws + WS_GEX); E.out = p.out;
        pg8::gemm_phase<EpiAB, SchedAB>(lds, D, S, E);
    }
    GSYNC();
    if (EN(6)) {
        SchedO S; S.ob.init(HTILES, 4, G, obid()); S.A = (const char*)(p.ws + WS_MG); S.B = (const char*)(p.ws + WS_WT_O);
        EpiO E; E.out = p.out; E.xp = p.in[0]; E.xs = p.in[1];
        pg8::gemm_phase<EpiO, SchedO>(lds, D, S, E);
    }
    GSYNC();
    if (EN(7)) phase_final(p);
}

extern "C" void kernel_launch(void* const* d_in, const int* in_sizes, int n_in, void* d_out, int out_size, void* d_ws, size_t ws_size, hipStream_t stream) {
    static int grid_blocks = 0;
    constexpr int LDS_BYTES = LDS_TOTAL;
    if (grid_blocks == 0) {
        if (n_in != 27 || ws_size < WS_END) { fprintf(stderr, "kernel_launch: unexpected n_in %d / ws %zu (need %zu)\n", n_in, ws_size, (size_t)WS_END); grid_blocks = -1; return; }
        if (hipFuncSetAttribute((const void*)hybrid_mega, hipFuncAttributeMaxDynamicSharedMemorySize, LDS_BYTES) != hipSuccess) { fprintf(stderr, "kernel_launch: hipFuncSetAttribute failed\n"); grid_blocks = -1; return; }
        int dev = 0, cus = 0, per_cu = 0;
        hipGetDevice(&dev);
        hipDeviceGetAttribute(&cus, hipDeviceAttributeMultiprocessorCount, dev);
        hipOccupancyMaxActiveBlocksPerMultiprocessor(&per_cu, (const void*)hybrid_mega, 512, LDS_BYTES);
        if (per_cu < 1) { fprintf(stderr, "kernel_launch: occupancy query says %d blocks/CU\n", per_cu); per_cu = 1; }
        (void)hipGetLastError();
        grid_blocks = cus;
    }
    if (grid_blocks < 0) return;
    Params p{};
    for (int i = 0; i < 27; ++i) p.in[i] = (const float*)d_in[i];
    p.out = (float*)d_out; p.ws = (unsigned char*)d_ws;
    if (hipMemsetAsync((unsigned char*)d_ws + WS_BAR, 0, 16384, stream) != hipSuccess) { fprintf(stderr, "kernel_launch: memset of the barrier words failed\n"); return; }
    void* args[] = {&p};
    hipError_t e = hipLaunchCooperativeKernel((const void*)hybrid_mega, dim3(grid_blocks), dim3(512), args, LDS_BYTES, stream);
    if (e != hipSuccess) fprintf(stderr, "cooperative launch failed: %s (grid %d)\n", hipGetErrorString(e), grid_blocks);
}
```

```cpp
#include <hip/hip_runtime.h>
#include <hip/hip_cooperative_groups.h>
#include <cstdio>
namespace cg = cooperative_groups;

#define LAS __attribute__((address_space(3)))
typedef unsigned short bf16_t;
typedef short bf16x8 __attribute__((ext_vector_type(8)));
typedef float f32x4 __attribute__((ext_vector_type(4)));
typedef unsigned u32x4 __attribute__((ext_vector_type(4)));
typedef unsigned u32x2 __attribute__((ext_vector_type(2)));

constexpr int D = 1024;
constexpr int NBATCH = 8, SEQ = 2048, NMETA = 16, DECB = 128, DECT = 4;
constexpr int XROWS = NBATCH * SEQ;
constexpr int EX_SAMP = 16, EX_SHIFT = 528, EX_END = 656;
constexpr int HROWS = 17152, HTILES = 67;
constexpr int NSEG = 8, SEGTOK = SEQ / NSEG;
constexpr int CPS = SEGTOK / 64;
constexpr int TPB = SEGTOK / 256;
constexpr int LT_PROMPT = NBATCH * TPB;
constexpr int LEX0 = LT_PROMPT * 256;
constexpr int LROWS = LEX0 + 768;
constexpr int NP = 10496, NPB = 8448, NT_IN = 41, NT_PB = 33;
constexpr int C_A = 3072, C_B = 3080, C_Z = 3088, C_RW = 4112, C_GATE_REF = 8336;
constexpr int RW_SHIFT = 4224;

constexpr size_t O_YP = 0, O_YS = 16777216, O_GDN_P = 17301504, O_CONV_P = 18350080, O_RWKV_P = 18423808, O_SHIFT_P = 18948096,
                 O_GDN_S = 18956288, O_CONV_S = 35733504, O_RWKV_S = 36913152, O_SHIFT_S = 45301760;

constexpr size_t al256(size_t x) { return (x + 255) & ~(size_t)255; }
constexpr size_t WS_WT_IN = 0;
constexpr size_t WS_WT_A = al256(WS_WT_IN + (size_t)NP * D * 2);
constexpr size_t WS_WT_B = al256(WS_WT_A + (size_t)D * D * 2);
constexpr size_t WS_WT_O = al256(WS_WT_B + (size_t)D * D * 2);
constexpr size_t WS_H = al256(WS_WT_O + (size_t)D * D * 2);
constexpr size_t WS_OB = al256(WS_H + (size_t)HROWS * D * 2);
constexpr size_t WS_P = al256(WS_OB + (size_t)HROWS * D * 2);
constexpr size_t WS_ORAW = al256(WS_P + (size_t)LROWS * NPB * 2);
constexpr size_t WS_YRAW = al256(WS_ORAW + (size_t)LROWS * D * 4);
constexpr size_t WS_C0 = al256(WS_YRAW + (size_t)LROWS * D * 4);
constexpr size_t WS_C1 = al256(WS_C0 + (size_t)LROWS * D * 2);
constexpr size_t WS_GEX = al256(WS_C1 + (size_t)LROWS * D * 2);
constexpr size_t WS_CHALO = al256(WS_GEX + (size_t)768 * 2048 * 2);
constexpr size_t WS_PHALO = al256(WS_CHALO + (size_t)2 * NBATCH * 3 * NPB * 2);
constexpr size_t WS_PK = al256(WS_PHALO + (size_t)2 * NBATCH * NPB * 2);
constexpr int PK_CONVW = 0, PK_ALOG = 12288, PK_DTB = 12296, PK_NORMW = 12304, PK_MU = 12432, PK_W0 = 16656, PK_W2 = 17680, PK_A0 = 83216, PK_A2 = 84240,
              PK_KK = 149776, PK_KA = 150800, PK_RK = 151824, PK_GNW = 152848, PK_GNB = 153872, PK_LNF = 154896, PK_END = 155920;
constexpr size_t WS_BAR = al256(WS_PK + (size_t)PK_END * 4);
constexpr size_t WS_W2T = al256(WS_BAR + 16384);
constexpr size_t WS_A2T = al256(WS_W2T + 131072);
constexpr size_t WS_GP = al256(WS_A2T + 131072);
constexpr int GP_AP = 0, GP_QH = 32768, GP_KH = 49152, GP_OH = 81920, GP_EGL = 98304, GP_G = 98560, GP_STRIDE = 114944;
constexpr int RP_AP = 0, RP_RH = 8192, RP_KH = 16384, RP_YH = 24576, RP_C1 = 32768, RP_C0 = 40960, RP_PC = 49152, RP_STRIDE = 49408;
constexpr size_t WS_RP = al256(WS_GP + (size_t)(CPS + 1) * 64 * GP_STRIDE);
constexpr size_t WS_END = al256(WS_RP + (size_t)(CPS + 1) * 128 * RP_STRIDE);
constexpr size_t WS_MG = WS_GP;
static_assert((size_t)HROWS * D * 2 <= WS_END - WS_GP, "MERGED must fit in the prep records");
static_assert((size_t)HROWS * D * 4 <= (size_t)LROWS * NPB * 2 + 2 * (size_t)LROWS * D * 4, "TMP must fit in P+ORAW+YRAW");
static_assert(WS_END <= (size_t)268435456, "workspace");

constexpr int LDS_TOTAL = 163840;
struct Params { const float* in[27]; float* out; unsigned char* ws; };

__device__ __forceinline__ float bf2f(bf16_t v) { return __uint_as_float(((unsigned)v) << 16); }
typedef __bf16 bf16n2 __attribute__((ext_vector_type(2)));
typedef float f32n2 __attribute__((ext_vector_type(2)));
__device__ __forceinline__ unsigned cvt_pk_bf16(float lo, float hi) { const f32n2 v = {lo, hi}; return __builtin_bit_cast(unsigned, __builtin_convertvector(v, bf16n2)); }
__device__ __forceinline__ unsigned pk2(float lo, float hi) { return cvt_pk_bf16(lo, hi); }
__device__ __forceinline__ unsigned f2bf(float f) { return cvt_pk_bf16(f, 0.f) & 0xffffu; }
__device__ __forceinline__ float sigm(float x) { return 1.f / (1.f + __expf(-x)); }
__device__ __forceinline__ float silu_(float x) { return x / (1.f + __expf(-x)); }
__device__ __forceinline__ float softplus_(float x) { return fmaxf(x, 0.f) + log1pf(expf(-fabsf(x))); }
__device__ __forceinline__ float wave_sum(float v) {
#pragma unroll
    for (int o = 1; o < 64; o <<= 1) v += __shfl_xor(v, o);
    return v;
}
__device__ __forceinline__ int otid() { int t = threadIdx.x; asm volatile("" : "+v"(t)); return t; }
__device__ __forceinline__ int obid() { int t = blockIdx.x; asm volatile("" : "+s"(t)); return t; }
__device__ __forceinline__ float tanh_(float x) { const float e = __expf(2.f * x); return 1.f - 2.f / (e + 1.f); }
template <int CTRL> __device__ __forceinline__ float dppf(float x) { return __builtin_bit_cast(float, __builtin_amdgcn_mov_dpp(__builtin_bit_cast(int, x), CTRL, 0xf, 0xf, true)); }
__device__ __forceinline__ float rowsum16(float x) { x += dppf<0x128>(x); x += dppf<0x124>(x); x += dppf<0x122>(x); x += dppf<0x121>(x); return x; }


#define XB_TMO      128
#define XB_XCNT(j)  (256  + 64 * (j))
#define XB_XSUB(j)  (1280 + 64 * (j))
#define XB_XGEN(j)  (2304 + 64 * (j))
#define XB_TOP      3328
#define XB_TOPGEN   3392
#define XCD_BAR_WORDS 3456
#define XB_SPIN_CAP (1u << 22)
__device__ __forceinline__ unsigned xb_ld(unsigned* p)              { return __hip_atomic_load(p, __ATOMIC_RELAXED, __HIP_MEMORY_SCOPE_AGENT); }
__device__ __forceinline__ unsigned xb_add(unsigned* p, unsigned v) { return __hip_atomic_fetch_add(p, v, __ATOMIC_RELAXED, __HIP_MEMORY_SCOPE_AGENT); }
__device__ __forceinline__ unsigned xb_xcc_id() { return (unsigned)__builtin_amdgcn_s_getreg((3 << 11) | 20) & 0xFu; }
#define XB_SPIN(cond, bar) do { unsigned _sp = 0; while (cond) { __builtin_amdgcn_s_sleep(1); \
    if ((++_sp & 255u) == 0u) { if (xb_ld(&(bar)[XB_TMO])) break; if (_sp > XB_SPIN_CAP) { atomicAdd(&(bar)[XB_TMO], 1u); break; } } } } while (0)
struct XcdBarrier { unsigned* bar; unsigned x; volatile LAS unsigned* st; };
__device__ __forceinline__ XcdBarrier xcd_barrier_post(unsigned* bar, volatile LAS unsigned* st) {
    XcdBarrier b; b.bar = bar; b.x = xb_xcc_id(); b.st = st;
    if (threadIdx.x == 0) (void)xb_add(&bar[XB_XCNT(b.x)], 1u);
    return b;
}
__device__ __forceinline__ void xcd_barrier_complete(unsigned* bar, unsigned x, unsigned& nloc, unsigned& nx) {
    const unsigned G = gridDim.x * gridDim.y * gridDim.z;
    unsigned sum, cnt, mine, sp = 0u;
    for (;;) {
        sum = 0u; cnt = 0u; mine = 0u;
#pragma unroll
        for (unsigned j = 0; j < 16; ++j) { const unsigned c = xb_ld(&bar[XB_XCNT(j)]); sum += c; cnt += (c > 0u) ? 1u : 0u; mine = (j == x) ? c : mine; }
        if (sum == G) break;
        __builtin_amdgcn_s_sleep(1);
        if ((++sp & 255u) == 0u) { if (xb_ld(&bar[XB_TMO])) break; if (sp > XB_SPIN_CAP) { atomicAdd(&bar[XB_TMO], 1u); break; } }
    }
    nloc = mine > 0u ? mine : 1u; nx = cnt > 0u ? cnt : 1u;
}
__device__ __forceinline__ void xcd_barrier(const XcdBarrier& b) {
    asm volatile("s_waitcnt vmcnt(0)" ::: "memory");
    __syncthreads();
    if (threadIdx.x == 0) {
        unsigned* bar = b.bar;
        __builtin_amdgcn_s_waitcnt(0);
        unsigned nloc = b.st[0], nx = b.st[1];
        if (nloc == 0u) { xcd_barrier_complete(bar, b.x, nloc, nx); b.st[0] = nloc; b.st[1] = nx; }
        const unsigned old = xb_add(&bar[XB_XSUB(b.x)], 1u);
        const unsigned gen = old / nloc;
        if (old + 1u == (gen + 1u) * nloc) {
            __builtin_amdgcn_fence(__ATOMIC_RELEASE, "agent");
            asm volatile("s_waitcnt vmcnt(0)" ::: "memory");
            const unsigned og = xb_add(&bar[XB_TOP], 1u);
            const unsigned tg = og / nx;
            if (og + 1u == (tg + 1u) * nx) xb_add(&bar[XB_TOPGEN], 1u);
            else XB_SPIN(xb_ld(&bar[XB_TOPGEN]) == tg, bar);
            __builtin_amdgcn_fence(__ATOMIC_ACQUIRE, "agent");
            xb_add(&bar[XB_XGEN(b.x)], 1u);
            asm volatile("s_waitcnt vmcnt(0)" ::: "memory");
        } else {
            XB_SPIN(xb_ld(&bar[XB_XGEN(b.x)]) == gen, bar);
            __builtin_amdgcn_fence(__ATOMIC_ACQUIRE, "agent");
            asm volatile("s_waitcnt vmcnt(0)" ::: "memory");
        }
    }
    __syncthreads();
}

namespace pg8 {
constexpr int BM = 256, BK = 64, HALF = 128, HTB = HALF * BK * 2, STAGE_BYTES = 8 * HTB, NXCD = 8, WGM = 8;
__device__ __forceinline__ int lds_byte(int r, int c) { const int st = (r >> 4) * 2 + (c >> 5), rr = r & 15, cc = c & 31, ob = rr * 64 + cc * 2; return st * 1024 + (ob ^ (((ob >> 9) & 1) << 5)); }
__device__ __forceinline__ void stage_rc(int b, int& R, int& C) { const int st = b / 1024, sb = b % 1024, swz = sb ^ (((sb >> 9) & 1) << 5); R = (st >> 1) * 16 + swz / 64; C = (st & 1) * 32 + (swz % 64) / 2; }
__device__ __forceinline__ int perm32(int rho) { const int n = rho >> 4, i = rho & 15; return 8 * (i >> 2) + 4 * n + (i & 3); }

struct Unit { int pm, pn, w; };
struct OrderBase {
    int nM, nN, nwg, G, c;
    __device__ void init(int nM_, int nN_, int G_, int c_) { nM = nM_; nN = nN_; nwg = nM * nN; G = G_; c = c_; }
    __device__ bool nextb(int i, Unit& u) const {
        const long L = (long)i * G + c; if (L >= nwg) return false;
        int wgid = (int)L; { const int q = nwg / NXCD, r = nwg % NXCD, xcd = wgid % NXCD, off = wgid / NXCD; wgid = (xcd < r ? xcd * (q + 1) : r * (q + 1) + (xcd - r) * q) + off; }
        const int nig = WGM * nN, gid = wgid / nig, fm = gid * WGM, gsz = (nM - fm) < WGM ? (nM - fm) : WGM;
        u.pm = fm + ((wgid % nig) % gsz); u.pn = (wgid % nig) / gsz; u.w = 0; return true;
    }
};

template <class Epi, class Sched>
__device__ __forceinline__ void gemm_phase(LAS unsigned char* lds, const int K, const Sched& S, const Epi& E) {
    const int tid = otid(), wid = __builtin_amdgcn_readfirstlane(tid >> 6), lane = tid & 63, wr = wid >> 2, wc = wid & 3, fr = lane & 15, fq = lane >> 4;
    const int nt = K / BK;
    unsigned voffA[2], voffB[2];
#pragma unroll
    for (int i = 0; i < 2; ++i) { int R, C; stage_rc(tid * 16 + i * 8192, R, C); const int Rb = Epi::PERM ? ((R & ~31) + perm32(R & 31)) : R;
        voffA[i] = (unsigned)(R * K + C) * 2u; voffB[i] = (unsigned)(Rb * K + C) * 2u; }
    const size_t kstep = (size_t)(BK * 2);
    const size_t hstep = (size_t)HALF * K * 2;
    const unsigned ldsw = (unsigned)wid * 1024u;
    const int aoff = lds_byte(wr * 64 + fr, fq * 8), boff = lds_byte(wc * 32 + fr, fq * 8);
#define PG8_SA(b, h) (((b) * 2 + (h)) * HTB)
#define PG8_SB(b, h) ((4 + (b) * 2 + (h)) * HTB)
#define PG8_STAGE(bufoff, gbase, voff) do { _Pragma("unroll") for (int _i = 0; _i < 2; ++_i) \
        __builtin_amdgcn_global_load_lds((const unsigned*)((const char*)(gbase) + (voff)[_i]), (LAS unsigned*)(lds + (bufoff) + ldsw + _i * 8192), 16, 0, 0); } while (0)
#define PG8_LDA(dst, b, h) do { _Pragma("unroll") for (int m = 0; m < 4; ++m) _Pragma("unroll") for (int k = 0; k < 2; ++k) dst[m][k] = *(const LAS bf16x8*)(lds + PG8_SA(b, h) + aoff + m * 2048 + k * 1024); } while (0)
#define PG8_LDB(dst, b, h) do { _Pragma("unroll") for (int n = 0; n < 2; ++n) _Pragma("unroll") for (int k = 0; k < 2; ++k) dst[n][k] = *(const LAS bf16x8*)(lds + PG8_SB(b, h) + boff + n * 2048 + k * 1024); } while (0)
#define PG8_MMA(ai, bj, At, Bt) do { __builtin_amdgcn_s_setprio(1); _Pragma("unroll") for (int m = 0; m < 4; ++m) _Pragma("unroll") for (int n = 0; n < 2; ++n) _Pragma("unroll") for (int k = 0; k < 2; ++k) \
        acc[ai][bj][m][n] = __builtin_amdgcn_mfma_f32_16x16x32_bf16(Bt[n][k], At[m][k], acc[ai][bj][m][n], 0, 0, 0); __builtin_amdgcn_s_setprio(0); } while (0)
#define PG8_WAIT_V(n) asm volatile("s_waitcnt vmcnt(" #n ")" ::: "memory")
#define PG8_WAIT_L(n) asm volatile("s_waitcnt lgkmcnt(" #n ")" ::: "memory")
#define PG8_BAR __builtin_amdgcn_s_barrier()
#define PG8_SCHED __builtin_amdgcn_sched_barrier(0)
    Unit cur, nxt; int ui = 0;
    if (!S.next(0, cur)) return;
    f32x4 acc[2][2][4][2];
#pragma unroll
    for (int a = 0; a < 2; ++a)
#pragma unroll
        for (int b = 0; b < 2; ++b)
#pragma unroll
            for (int m = 0; m < 4; ++m)
#pragma unroll
                for (int n = 0; n < 2; ++n) acc[a][b][m][n] = (f32x4){0.f, 0.f, 0.f, 0.f};
    bf16x8 At[4][2], B0[2][2], B1[2][2];
    const char* cA = S.a_ptr(cur); const char* cB = S.b_ptr(cur);
    PG8_STAGE(PG8_SB(0, 0), cB, voffB); PG8_STAGE(PG8_SA(0, 0), cA, voffA); PG8_STAGE(PG8_SB(0, 1), cB + hstep, voffB); PG8_STAGE(PG8_SA(0, 1), cA + hstep, voffA);
    if (wr == 1) PG8_BAR;
    PG8_WAIT_V(4); PG8_BAR;
    PG8_STAGE(PG8_SB(1, 0), cB + kstep, voffB); PG8_STAGE(PG8_SA(1, 0), cA + kstep, voffA); PG8_STAGE(PG8_SB(1, 1), cB + hstep + kstep, voffB);
    PG8_WAIT_V(6); PG8_BAR;
    for (;;) {
        const bool has_next = S.next(ui + 1, nxt);
        const char* nA = has_next ? S.a_ptr(nxt) : cA; const char* nB = has_next ? S.b_ptr(nxt) : cB;
        for (int t = 0; t < nt; t += 2) {
            const bool last = (t == nt - 2);
            const char* a1 = cA + (size_t)(t + 1) * kstep;
            const char* a2 = last ? nA : cA + (size_t)(t + 2) * kstep; const char* b2 = last ? nB : cB + (size_t)(t + 2) * kstep;
            const char* a3 = a2 + kstep; const char* b3 = b2 + kstep;
            PG8_LDB(B0, 0, 0); PG8_SCHED; PG8_LDA(At, 0, 0); PG8_STAGE(PG8_SA(1, 1), a1 + hstep, voffA);
            PG8_WAIT_L(8); PG8_BAR; PG8_WAIT_L(0); PG8_MMA(0, 0, At, B0); PG8_BAR; PG8_SCHED;
            PG8_LDB(B1, 0, 1); PG8_STAGE(PG8_SB(0, 0), b2, voffB);
            PG8_BAR; PG8_WAIT_L(0); PG8_MMA(0, 1, At, B1); PG8_BAR;
            PG8_LDA(At, 0, 1); PG8_STAGE(PG8_SA(0, 0), a2, voffA);
            PG8_BAR; PG8_WAIT_L(0); PG8_MMA(1, 0, At, B0); PG8_BAR; PG8_SCHED;
            PG8_STAGE(PG8_SB(0, 1), b2 + hstep, voffB);
            PG8_WAIT_V(6); PG8_BAR; PG8_MMA(1, 1, At, B1); PG8_BAR;
            PG8_LDB(B0, 1, 0); PG8_SCHED; PG8_LDA(At, 1, 0); PG8_STAGE(PG8_SA(0, 1), a2 + hstep, voffA);
            PG8_WAIT_L(8); PG8_BAR; PG8_WAIT_L(0); PG8_MMA(0, 0, At, B0); PG8_BAR; PG8_SCHED;
            PG8_LDB(B1, 1, 1); PG8_STAGE(PG8_SB(1, 0), b3, voffB);
            PG8_BAR; PG8_WAIT_L(0); PG8_MMA(0, 1, At, B1); PG8_BAR;
            PG8_LDA(At, 1, 1); PG8_STAGE(PG8_SA(1, 0), a3, voffA);
            PG8_BAR; PG8_WAIT_L(0); PG8_MMA(1, 0, At, B0); PG8_BAR; PG8_SCHED;
            PG8_STAGE(PG8_SB(1, 1), b3 + hstep, voffB);
            PG8_WAIT_V(6); PG8_BAR; PG8_MMA(1, 1, At, B1); PG8_BAR;
        }
        E(acc, cur, wr, wc, fr, fq);
        if (!has_next) break;
#pragma unroll
        for (int a = 0; a < 2; ++a)
#pragma unroll
            for (int b = 0; b < 2; ++b)
#pragma unroll
                for (int m = 0; m < 4; ++m)
#pragma unroll
                    for (int n = 0; n < 2; ++n) acc[a][b][m][n] = (f32x4){0.f, 0.f, 0.f, 0.f};
        cur = nxt; cA = nA; cB = nB; ++ui;
    }
    PG8_WAIT_V(0);
    if (wr == 0) PG8_BAR;
    PG8_BAR;
#undef PG8_SA
#undef PG8_SB
#undef PG8_STAGE
#undef PG8_LDA
#undef PG8_LDB
#undef PG8_MMA
#undef PG8_WAIT_V
#undef PG8_WAIT_L
#undef PG8_BAR
#undef PG8_SCHED
}
}
using pg8::Unit;

struct SchedIn {
    pg8::OrderBase ob; int seg; const char* A; const char* B;
    __device__ bool next(int i, Unit& u) const { return ob.nextb(i, u); }
    __device__ const char* a_ptr(const Unit& u) const {
        const int gt = u.pm < LT_PROMPT ? ((u.pm / TPB) * (SEQ / 256) + seg * TPB + (u.pm % TPB)) : (XROWS / 256 + (u.pm - LT_PROMPT));
        return A + (size_t)gt * 256 * D * 2; }
    __device__ const char* b_ptr(const Unit& u) const { return B + (size_t)u.pn * 256 * D * 2; }
};
struct SchedAB {
    pg8::OrderBase ob; const char* A0; const char* A1; const char* B0; const char* B1;
    __device__ bool next(int i, Unit& u) const { const bool ok = ob.nextb(i >> 1, u); u.w = i & 1; return ok; }
    __device__ const char* a_ptr(const Unit& u) const { return (u.w ? A1 : A0) + (size_t)u.pm * 256 * D * 2; }
    __device__ const char* b_ptr(const Unit& u) const { return (u.w ? B1 : B0) + (size_t)u.pn * 256 * D * 2; }
};
struct SchedO {
    pg8::OrderBase ob; const char* A; const char* B;
    __device__ bool next(int i, Unit& u) const { return ob.nextb(i, u); }
    __device__ const char* a_ptr(const Unit& u) const { return A + (size_t)u.pm * 256 * D * 2; }
    __device__ const char* b_ptr(const Unit& u) const { return B + (size_t)u.pn * 256 * D * 2; }
};

struct EpiIn {
    static constexpr bool PERM = true;
    bf16_t* P; bf16_t* gex; float* out; int seg;
    __device__ __forceinline__ void operator()(const f32x4 (&acc)[2][2][4][2], const Unit& u, int wr, int wc, int fr, int fq) const {
        const int lr0 = u.pm * 256 + wr * 64 + fr;
        const int c0 = u.pn * 256 + wc * 32 + 8 * fq;
#pragma unroll
        for (int ai = 0; ai < 2; ++ai)
#pragma unroll
            for (int m = 0; m < 4; ++m) {
                const int lr = lr0 + ai * 128 + m * 16;
                bf16_t* rowp;
                if (u.pn < NT_PB) rowp = P + (size_t)lr * NPB + c0;
                else if (lr < LEX0) { const int b = lr / SEGTOK; const size_t grow = (size_t)b * SEQ + seg * SEGTOK + (lr % SEGTOK); rowp = (bf16_t*)(out + O_YP + grow * D) + (c0 - NPB); }
                else rowp = gex + (size_t)(lr - LEX0) * 2048 + (c0 - NPB);
#pragma unroll
                for (int bj = 0; bj < 2; ++bj) { const f32x4 v0 = acc[ai][bj][m][0], v1 = acc[ai][bj][m][1];
                    u32x4 w; w.x = cvt_pk_bf16(v0[0], v0[1]); w.y = cvt_pk_bf16(v0[2], v0[3]); w.z = cvt_pk_bf16(v1[0], v1[1]); w.w = cvt_pk_bf16(v1[2], v1[3]);
                    *(u32x4*)(rowp + bj * 128) = w; }
            }
    }
};
struct EpiAB {
    static constexpr bool PERM = false;
    float* tmp; bf16_t* merged; const bf16_t* gex; const float* out;
    __device__ __forceinline__ void operator()(const f32x4 (&acc)[2][2][4][2], const Unit& u, int wr, int wc, int fr, int fq) const {
        const int row0 = u.pm * 256 + wr * 64 + fr, col0 = u.pn * 256 + wc * 32 + 4 * fq;
#pragma unroll
        for (int ai = 0; ai < 2; ++ai)
#pragma unroll
            for (int m = 0; m < 4; ++m) {
                const int grow = row0 + ai * 128 + m * 16;
                const bf16_t* gp = (grow < XROWS) ? ((const bf16_t*)(out + O_YP + (size_t)grow * D) + u.w * D) : (gex + (size_t)(grow - XROWS) * 2048 + u.w * D);
#pragma unroll
                for (int bj = 0; bj < 2; ++bj)
#pragma unroll
                    for (int n = 0; n < 2; ++n) {
                        const int c = col0 + bj * 128 + n * 16;
                        const u32x2 g = *(const u32x2*)(gp + c);
                        f32x4 v = acc[ai][bj][m][n];
                        v[0] *= sigm(__uint_as_float(g.x << 16)); v[1] *= sigm(__uint_as_float(g.x & 0xffff0000u));
                        v[2] *= sigm(__uint_as_float(g.y << 16)); v[3] *= sigm(__uint_as_float(g.y & 0xffff0000u));
                        float* tp = tmp + (size_t)grow * D + c;
                        if (u.w == 0) *(f32x4*)tp = v;
                        else { const f32x4 t = *(const f32x4*)tp; v = v + t; u32x2 o; o.x = cvt_pk_bf16(v[0], v[1]); o.y = cvt_pk_bf16(v[2], v[3]); *(u32x2*)(merged + (size_t)grow * D + c) = o; }
                    }
            }
    }
};
struct EpiO {
    static constexpr bool PERM = false;
    float* out; const float* xp; const float* xs;
    __device__ __forceinline__ void operator()(const f32x4 (&acc)[2][2][4][2], const Unit& u, int wr, int wc, int fr, int fq) const {
        const int row0 = u.pm * 256 + wr * 64 + fr, col0 = u.pn * 256 + wc * 32 + 4 * fq;
#pragma unroll
        for (int ai = 0; ai < 2; ++ai)
#pragma unroll
            for (int m = 0; m < 4; ++m) {
                const int grow = row0 + ai * 128 + m * 16;
                const float* xr; float* yr;
                if (grow < XROWS) { xr = xp + (size_t)grow * D; yr = out + O_YP + (size_t)grow * D; }
                else { const int e = grow - XROWS; if (e < EX_SAMP || e >= EX_SHIFT) continue; xr = xs + (size_t)(e - EX_SAMP) * D; yr = out + O_YS + (size_t)(e - EX_SAMP) * D; }
#pragma unroll
                for (int bj = 0; bj < 2; ++bj)
#pragma unroll
                    for (int n = 0; n < 2; ++n) { const int c = col0 + bj * 128 + n * 16; *(f32x4*)(yr + c) = *(const f32x4*)(xr + c) + acc[ai][bj][m][n]; }
            }
    }
};

__device__ __forceinline__ void p0_row(const Params& p, int r, int lane) {
    bf16_t* hrow = (bf16_t*)(p.ws + WS_H) + (size_t)r * D;
    const float* src = nullptr; bool norm = true; float* sh = nullptr;
    if (r < XROWS) { src = p.in[0] + (size_t)r * D; if ((r & (SEQ - 1)) == SEQ - 1) sh = p.out + O_SHIFT_P + (size_t)(r / SEQ) * D; }
    else { const int e = r - XROWS;
        if (e < EX_SAMP) src = p.in[6] + (size_t)e * D;
        else if (e < EX_SHIFT) { src = p.in[1] + (size_t)(e - EX_SAMP) * D; if (((e - EX_SAMP) & 3) == 3) sh = p.out + O_SHIFT_S + (size_t)((e - EX_SAMP) >> 2) * D; }
        else if (e < EX_END) { src = p.in[5] + (size_t)(e - EX_SHIFT) * D; norm = false; } }
    u32x2* o8 = (u32x2*)hrow + lane;
    if (!src) {
#pragma unroll
        for (int j = 0; j < 4; ++j) o8[64 * j] = (u32x2){0u, 0u};
        return; }
    const f32x4* xr = (const f32x4*)src + lane;
    f32x4 v[4]; float ss = 0.f;
#pragma unroll
    for (int j = 0; j < 4; ++j) { v[j] = xr[64 * j]; ss += v[j][0] * v[j][0] + v[j][1] * v[j][1] + v[j][2] * v[j][2] + v[j][3] * v[j][3]; }
    if (norm) {
        const float rs = rsqrtf(wave_sum(ss) * (1.f / D) + 1e-6f);
        const f32x4* wr = (const f32x4*)p.in[7] + lane;
#pragma unroll
        for (int j = 0; j < 4; ++j) v[j] = v[j] * rs * wr[64 * j];
    }
#pragma unroll
    for (int j = 0; j < 4; ++j) { o8[64 * j] = (u32x2){pk2(v[j][0], v[j][1]), pk2(v[j][2], v[j][3])}; if (sh) ((f32x4*)sh)[lane + 64 * j] = v[j]; }
}
template <int MODE> __device__ __forceinline__ void p0_tr_item(const float* W, int N, bf16_t* WT, float* scr, int kb, int nb, int lane) {
    const int k0 = 64 * kb, n0 = 32 * nb;
    const int nn = n0 + (lane & 31);
    int srcc = nn;
    if (MODE == 1) srcc = nn < C_GATE_REF ? nn : (nn < NPB ? -1 : nn - (NPB - C_GATE_REF));
#pragma unroll 8
    for (int i = 0; i < 32; ++i) { const int kk = 2 * i + (lane >> 5); scr[kk * 33 + (lane & 31)] = srcc >= 0 ? W[(size_t)(k0 + kk) * N + srcc] : 0.f; }
    asm volatile("s_waitcnt lgkmcnt(0)" ::: "memory");
    const int c = lane & 7;
#pragma unroll
    for (int j = 0; j < 4; ++j) { const int n = (lane >> 3) + 8 * j; const float* s = scr + (8 * c) * 33 + n;
        u32x4 o; o.x = pk2(s[0 * 33], s[1 * 33]); o.y = pk2(s[2 * 33], s[3 * 33]); o.z = pk2(s[4 * 33], s[5 * 33]); o.w = pk2(s[6 * 33], s[7 * 33]);
        *(u32x4*)(WT + (size_t)(n0 + n) * D + k0 + 8 * c) = o; }
    asm volatile("s_waitcnt lgkmcnt(0)" ::: "memory");
}
__device__ __forceinline__ void phase0(const Params& p, unsigned char* smem) {
    const int tid0 = otid(), wave = tid0 >> 6, lane = tid0 & 63;
    const int gw = obid() * 8 + wave, NGW = gridDim.x * 8;
    float* scr = (float*)smem + wave * (64 * 33);
    constexpr int I_IN = 16 * (NP / 32), I_SQ = 16 * 32;
    for (int it = gw; it < I_IN + 3 * I_SQ; it += NGW) {
        int r = it;
        if (r < I_IN) { p0_tr_item<1>(p.in[8], 10384, (bf16_t*)(p.ws + WS_WT_IN), scr, r / (NP / 32), r % (NP / 32), lane); continue; } r -= I_IN;
        if (r < I_SQ) { p0_tr_item<0>(p.in[13], D, (bf16_t*)(p.ws + WS_WT_A), scr, r / 32, r % 32, lane); continue; } r -= I_SQ;
        if (r < I_SQ) { p0_tr_item<0>(p.in[24], D, (bf16_t*)(p.ws + WS_WT_B), scr, r / 32, r % 32, lane); continue; } r -= I_SQ;
        p0_tr_item<0>(p.in[25], D, (bf16_t*)(p.ws + WS_WT_O), scr, r / 32, r % 32, lane);
    }
    for (int r = gw; r < HROWS; r += NGW) p0_row(p, r, lane);
    {
        float* pk = (float*)(p.ws + WS_PK);
        const int gt = obid() * 512 + tid0, NT = gridDim.x * 512;
#define PKCOPY(off, idx, n) for (int i = gt; i < (n); i += NT) pk[(off) + i] = p.in[idx][i];
        PKCOPY(PK_CONVW, 9, 12288) PKCOPY(PK_ALOG, 10, 8) PKCOPY(PK_DTB, 11, 8) PKCOPY(PK_NORMW, 12, 128) PKCOPY(PK_MU, 14, 4224) PKCOPY(PK_W0, 15, 1024)
        PKCOPY(PK_W2, 16, 65536) PKCOPY(PK_A0, 17, 1024) PKCOPY(PK_A2, 18, 65536) PKCOPY(PK_KK, 19, 1024) PKCOPY(PK_KA, 20, 1024) PKCOPY(PK_RK, 21, 1024)
        PKCOPY(PK_GNW, 22, 1024) PKCOPY(PK_GNB, 23, 1024) PKCOPY(PK_LNF, 26, 1024)
#undef PKCOPY
        bf16_t* w2t = (bf16_t*)(p.ws + WS_W2T); bf16_t* a2t = (bf16_t*)(p.ws + WS_A2T);
        for (int i = gt; i < 65536; i += NT) { const int l = i & 63, c = (i >> 6) & 63, hb = i >> 12;
            w2t[i] = (bf16_t)f2bf(p.in[16][(size_t)l * D + hb * 64 + c]); a2t[i] = (bf16_t)f2bf(p.in[18][(size_t)l * D + hb * 64 + c]); }
    }
}

__device__ __forceinline__ void gdn_item(const Params& p, unsigned char* smem, const float* s_in, float* s_out, const float* halo_in, float* halo_out,
                                         int h, int sl, int rowA, int nA, int rowB, int nB) {
    const int tid = otid(), w = tid >> 6, lane = tid & 63, vl = lane >> 4, kg = lane & 15;
    float* qk_s = (float*)smem; float* v_s = qk_s + 16384; float* o_s = v_s + 2048; float* gb_s = o_s + 2048; float* sst = gb_s + 128;
    const bf16_t* P = (const bf16_t*)(p.ws + WS_P);
    float* ORAW = (float*)(p.ws + WS_ORAW);
    float s[8];
    if (s_in) {
        { const int k = tid >> 2, q4 = tid & 3; const f32x4* src = (const f32x4*)(s_in + (size_t)k * 128 + sl * 32 + q4 * 8); const f32x4 a = src[0], b = src[1];
          float* d = sst + k * 33 + q4 * 8; d[0] = a[0]; d[1] = a[1]; d[2] = a[2]; d[3] = a[3]; d[4] = b[0]; d[5] = b[1]; d[6] = b[2]; d[7] = b[3]; }
        __syncthreads();
#pragma unroll
        for (int j = 0; j < 8; ++j) s[j] = sst[(kg * 8 + j) * 33 + 4 * w + vl];
        __syncthreads();
    } else {
#pragma unroll
        for (int j = 0; j < 8; ++j) s[j] = 0.f;
    }
    int pcol = -1;
    if (tid < 128) pcol = h * 128 + tid; else if (tid < 256) pcol = 1024 + h * 128 + (tid - 128); else if (tid < 288) pcol = 2048 + h * 128 + sl * 32 + (tid - 256);
    float cw0 = 0.f, cw1 = 0.f, cw2 = 0.f, cw3 = 0.f, x1 = 0.f, x2 = 0.f, x3 = 0.f;
    const float* pk = (const float*)(p.ws + WS_PK);
    if (pcol >= 0) { const float* cw = pk + PK_CONVW; cw0 = cw[pcol]; cw1 = cw[3072 + pcol]; cw2 = cw[6144 + pcol]; cw3 = cw[9216 + pcol];
        if (halo_in) { x3 = halo_in[pcol]; x2 = halo_in[3072 + pcol]; x1 = halo_in[6144 + pcol]; } }
    const float nalog = -expf(pk[PK_ALOG + h]), dtb = pk[PK_DTB + h];
#pragma unroll 1
    for (int run = 0; run < 2; ++run) {
        const int rrow = run ? rowB : rowA, rn = run ? nB : nA; const bool wout = run != 0;
#pragma unroll 1
        for (int c0 = 0; c0 < rn; c0 += 64) {
            const int nt = (rn - c0) < 64 ? (rn - c0) : 64; const int row = rrow + c0;
            if (pcol >= 0) {
                const bf16_t* src = P + (size_t)row * NPB + pcol;
                float* dst = tid < 256 ? (qk_s + tid) : (v_s + (tid - 256)); const int dstride = tid < 256 ? 256 : 32;
#pragma unroll 8
                for (int i = 0; i < nt; ++i) { const float x0 = bf2f(src[(size_t)i * NPB]); const float y = cw0 * x3 + cw1 * x2 + cw2 * x1 + cw3 * x0; x3 = x2; x2 = x1; x1 = x0; dst[i * dstride] = silu_(y); }
            } else if (tid < 352) {
                const int i = tid - 288;
                if (i < nt) { const float pa = bf2f(P[(size_t)(row + i) * NPB + C_A + h]), pb = bf2f(P[(size_t)(row + i) * NPB + C_B + h]);
                    gb_s[2 * i] = expf(nalog * softplus_(pa + dtb)); gb_s[2 * i + 1] = sigm(pb); }
            }
            __syncthreads();
#pragma unroll 1
            for (int ii = 0; ii < 8; ++ii) { const int i = w * 8 + ii;
                if (i < nt) {
#pragma unroll
                    for (int which = 0; which < 2; ++which) { float* rp = qk_s + i * 256 + which * 128; const float a = rp[lane], b = rp[lane + 64];
                        const float sc = rsqrtf(wave_sum(a * a + b * b) + 1e-6f) * (which == 0 ? 0.08838834764831845f : 1.f); rp[lane] = a * sc; rp[lane + 64] = b * sc; } } }
            __syncthreads();
#pragma unroll 1
            for (int i = 0; i < nt; ++i) {
                const f32x4 q0 = *(const f32x4*)(qk_s + i * 256 + kg * 8), q1 = *(const f32x4*)(qk_s + i * 256 + kg * 8 + 4);
                const f32x4 k0 = *(const f32x4*)(qk_s + i * 256 + 128 + kg * 8), k1 = *(const f32x4*)(qk_s + i * 256 + 128 + kg * 8 + 4);
                const float vv = v_s[i * 32 + 4 * w + vl], a = gb_s[2 * i], be = gb_s[2 * i + 1];
                float part = k0[0] * s[0] + k0[1] * s[1] + k0[2] * s[2] + k0[3] * s[3] + k1[0] * s[4] + k1[1] * s[5] + k1[2] * s[6] + k1[3] * s[7];
                const float kS = rowsum16(part);
                const float c = be * (vv - a * kS);
                s[0] = a * s[0] + k0[0] * c; s[1] = a * s[1] + k0[1] * c; s[2] = a * s[2] + k0[2] * c; s[3] = a * s[3] + k0[3] * c;
                s[4] = a * s[4] + k1[0] * c; s[5] = a * s[5] + k1[1] * c; s[6] = a * s[6] + k1[2] * c; s[7] = a * s[7] + k1[3] * c;
                float op = q0[0] * s[0] + q0[1] * s[1] + q0[2] * s[2] + q0[3] * s[3] + q1[0] * s[4] + q1[1] * s[5] + q1[2] * s[6] + q1[3] * s[7];
                const float o = rowsum16(op);
                if (kg == 0) o_s[i * 32 + 4 * w + vl] = o;
            }
            __syncthreads();
            if (wout) { const int i = tid >> 3, c4 = (tid & 7) * 4; if (i < nt) *(f32x4*)(ORAW + (size_t)(row + i) * D + h * 128 + sl * 32 + c4) = *(const f32x4*)(o_s + i * 32 + c4); }
        }
    }
    if (pcol >= 0 && (sl == 0 || tid >= 256)) { halo_out[pcol] = x3; halo_out[3072 + pcol] = x2; halo_out[6144 + pcol] = x1; }
#pragma unroll
    for (int j = 0; j < 8; ++j) sst[(kg * 8 + j) * 33 + 4 * w + vl] = s[j];
    __syncthreads();
    { const int k = tid >> 2, q4 = tid & 3; const float* d = sst + k * 33 + q4 * 8; f32x4* dst = (f32x4*)(s_out + (size_t)k * 128 + sl * 32 + q4 * 8);
      dst[0] = (f32x4){d[0], d[1], d[2], d[3]}; dst[1] = (f32x4){d[4], d[5], d[6], d[7]}; }
    __syncthreads();
}

constexpr int RW_W2 = 20544, RW_A2 = 24640;
__device__ __forceinline__ void rwkv_load_lora(const Params& p, unsigned char* smem, int hb) {
    float* w2_s = (float*)smem + RW_W2; float* a2_s = (float*)smem + RW_A2; const float* pk = (const float*)(p.ws + WS_PK);
    for (int i = otid(); i < 4096; i += 512) { const int l = i >> 6, c = i & 63; w2_s[i] = pk[PK_W2 + l * D + hb * 64 + c]; a2_s[i] = pk[PK_A2 + l * D + hb * 64 + c]; }
    __syncthreads();
}
__device__ __forceinline__ void rwkv_item(const Params& p, unsigned char* smem, const float* s_in, float* s_out, const bf16_t* prev_row, const float* halo_in, float* halo_out,
                                          int hb, int half, int rowA, int nA, int rowB, int nB) {
    const int tid = otid(), w = tid >> 6, lane = tid & 63, row = tid >> 4, kq = tid & 15;
    float* f = (float*)smem;
    float* r_s = f; float* kb_s = f + 2048; float* v_s = f + 4096; float* wd_s = f + 6144; float* ad_s = f + 8192; float* dec_s = f + 10240; float* a_s = f + 12288;
    float* kk_s = f + 14336; float* km_s = f + 16384; float* zb_s = f + 18432; float* y_s = f + 19456; float* bonus_s = f + 20480;
    const float* w2_s = f + RW_W2; const float* a2_s = f + RW_A2;
    const bf16_t* P = (const bf16_t*)(p.ws + WS_P);
    float* YRAW = (float*)(p.ws + WS_YRAW); bf16_t* C0 = (bf16_t*)(p.ws + WS_C0); bf16_t* C1 = (bf16_t*)(p.ws + WS_C1);
    float s[4];
    if (s_in) { const f32x4 t = *(const f32x4*)(s_in + (size_t)(half * 32 + row) * 64 + kq * 4); s[0] = t[0]; s[1] = t[1]; s[2] = t[2]; s[3] = t[3]; }
    else { s[0] = s[1] = s[2] = s[3] = 0.f; }
    int col = -1; float* dst = nullptr; int dstride = 64; bool is_wd = false, owner = false;
    if (tid < 64) { col = hb * 64 + tid; dst = r_s + tid; owner = half == 0; }
    else if (tid < 128) { col = 1024 + hb * 64 + (tid - 64); dst = kb_s + (tid - 64); owner = half == 0; }
    else if (tid < 192) { col = 2048 + hb * 64 + (tid - 128); dst = v_s + (tid - 128); owner = half == 0; }
    else if (tid < 256) { col = 3072 + (tid - 192); dst = wd_s + (tid - 192); is_wd = true; owner = (half == 0 && hb == 0); }
    else if (tid < 320) { col = 3136 + (tid - 256); dst = ad_s + (tid - 256); owner = (half == 0 && hb == 0); }
    else if (tid < 352) { col = 3200 + hb * 64 + half * 32 + (tid - 320); dst = zb_s + (tid - 320); dstride = 32; owner = true; }
    float mu = 0.f, prev = 0.f;
    const float* pk = (const float*)(p.ws + WS_PK);
    if (col >= 0) { mu = pk[PK_MU + col]; prev = prev_row ? bf2f(prev_row[C_RW + col]) : (halo_in ? halo_in[col] : 0.f); }
    const int cc = tid & 63, ig = tid >> 6;
    const int hc = hb * 64 + cc;
    const float w0c = pk[PK_W0 + hc], a0c = pk[PK_A0 + hc], kkc = pk[PK_KK + hc], kac = pk[PK_KA + hc];
    const float rkl = pk[PK_RK + hb * 64 + lane];
#pragma unroll 1
    for (int run = 0; run < 2; ++run) {
        const int rrow = run ? rowB : rowA, rn = run ? nB : nA; const bool wout = run != 0;
#pragma unroll 1
        for (int c0 = 0; c0 < rn; c0 += 32) {
            const int nt = (rn - c0) < 32 ? (rn - c0) : 32; const int row0 = rrow + c0;
            if (col >= 0) {
                const bf16_t* src = P + (size_t)row0 * NPB + C_RW + col;
#pragma unroll 8
                for (int i = 0; i < nt; ++i) { const float cur = bf2f(src[(size_t)i * NPB]); float m = cur + mu * (prev - cur); prev = cur; if (is_wd) m = tanh_(m); dst[i * dstride] = m; }
            }
            __syncthreads();
            {
                float aw[4] = {0.f, 0.f, 0.f, 0.f}, aa[4] = {0.f, 0.f, 0.f, 0.f};
#pragma unroll 4
                for (int l = 0; l < 64; ++l) { const float w2v = w2_s[l * 64 + cc], a2v = a2_s[l * 64 + cc];
#pragma unroll
                    for (int ii = 0; ii < 4; ++ii) { aw[ii] += wd_s[(ig * 4 + ii) * 64 + l] * w2v; aa[ii] += ad_s[(ig * 4 + ii) * 64 + l] * a2v; } }
#pragma unroll
                for (int ii = 0; ii < 4; ++ii) { const int i = ig * 4 + ii;
                    if (i < nt) { const float wraw = w0c + aw[ii]; const float wlog = -0.6065306597126334f * sigm(wraw); const float a = sigm(a0c + aa[ii]);
                        const float kbv = kb_s[i * 64 + cc];
                        dec_s[i * 64 + cc] = expf(wlog); a_s[i * 64 + cc] = a; kk_s[i * 64 + cc] = kbv * kkc; km_s[i * 64 + cc] = kbv * (1.f + (a - 1.f) * kac); } }
            }
            __syncthreads();
#pragma unroll 1
            for (int ii = 0; ii < 4; ++ii) { const int i = w * 4 + ii;
                if (i < nt) { const float kkr = kk_s[i * 64 + lane]; const float kk = kkr * rsqrtf(wave_sum(kkr * kkr) + 1e-6f); kk_s[i * 64 + lane] = kk;
                    const float a = a_s[i * 64 + lane]; a_s[i * 64 + lane] = kk * a;
                    const float rk = wave_sum(r_s[i * 64 + lane] * km_s[i * 64 + lane] * rkl); if (lane == 0) bonus_s[i] = rk; } }
            __syncthreads();
#pragma unroll 1
            for (int i = 0; i < nt; ++i) {
                const f32x4 kk4 = *(const f32x4*)(kk_s + i * 64 + kq * 4), de4 = *(const f32x4*)(dec_s + i * 64 + kq * 4), ka4 = *(const f32x4*)(a_s + i * 64 + kq * 4),
                            km4 = *(const f32x4*)(km_s + i * 64 + kq * 4), r4 = *(const f32x4*)(r_s + i * 64 + kq * 4);
                const float vv = v_s[i * 64 + half * 32 + row];
                const float sa = rowsum16(s[0] * kk4[0] + s[1] * kk4[1] + s[2] * kk4[2] + s[3] * kk4[3]);
#pragma unroll
                for (int j = 0; j < 4; ++j) s[j] = s[j] * de4[j] + (vv * km4[j] - sa * ka4[j]);
                const float y = rowsum16(s[0] * r4[0] + s[1] * r4[1] + s[2] * r4[2] + s[3] * r4[3]);
                if (kq == 0) y_s[i * 32 + row] = y;
            }
            __syncthreads();
            if (wout) { const int i = tid >> 4;
                if (i < nt) {
#pragma unroll
                    for (int q = 0; q < 2; ++q) { const int rr = (tid & 15) * 2 + q, v = half * 32 + rr, colo = hb * 64 + v;
                        const float sz = silu_(zb_s[i * 32 + rr]);
                        const size_t o = (size_t)(row0 + i) * D + colo;
                        YRAW[o] = y_s[i * 32 + rr]; C1[o] = (bf16_t)f2bf(pk[PK_GNW + colo] * sz); C0[o] = (bf16_t)f2bf((pk[PK_GNB + colo] + bonus_s[i] * v_s[i * 64 + v]) * sz); } } }
            __syncthreads();
        }
    }
    *(f32x4*)(s_out + (size_t)(half * 32 + row) * 64 + kq * 4) = (f32x4){s[0], s[1], s[2], s[3]};
    if (col >= 0 && owner && halo_out) halo_out[col] = prev;
}


__device__ __forceinline__ bf16x8 ldfrag(const bf16_t* base, int stride, int r0, int k0, int lane) {
    return *(const bf16x8*)(base + (r0 + (lane & 15)) * stride + k0 + 8 * (lane >> 4));
}
#define MFMA16(a, b, c) __builtin_amdgcn_mfma_f32_16x16x32_bf16((a), (b), (c), 0, 0, 0)
__device__ __forceinline__ void inv_block(const float* L, float* Tm, float* XS, int tid) {
    const int w = tid >> 6, lane = tid & 63;
    if (w < 4 && lane < 16) {
        const float* Lb = L + (16 * w) * 64 + 16 * w; float* Tb = Tm + (16 * w) * 64 + 16 * w;
        float tr[16];
#pragma unroll
        for (int i = 0; i < 16; ++i) { float a = (lane == i) ? 1.f : 0.f;
#pragma unroll
            for (int j = 0; j < i; ++j) a -= Lb[i * 64 + j] * tr[j];
            tr[i] = a; Tb[i * 64 + lane] = a; }
    }
    for (int e = tid; e < 1536; e += 512) { const int k = e >> 8, r = (e >> 4) & 15, c = e & 15;
        const int rb = k < 3 ? 0 : (k < 5 ? 1 : 2), cb = k < 3 ? k + 1 : (k < 5 ? k - 1 : 3);
        Tm[(16 * rb + r) * 64 + 16 * cb + c] = 0.f; }
    __syncthreads();
    {
        const int B = tid >> 8, i = (tid >> 4) & 15, c = tid & 15, o = 32 * B;
        float x = 0.f;
#pragma unroll
        for (int j = 0; j < 16; ++j) x += L[(o + 16 + i) * 64 + o + j] * Tm[(o + j) * 64 + o + c];
        XS[tid] = x;
        __syncthreads();
        float t = 0.f;
#pragma unroll
        for (int j = 0; j < 16; ++j) t += Tm[(o + 16 + i) * 64 + o + 16 + j] * XS[(B << 8) + j * 16 + c];
        Tm[(o + 16 + i) * 64 + o + c] = -t;
    }
    __syncthreads();
    {
        const int i = tid >> 4, c2 = (tid & 15) * 2;
        float x0 = 0.f, x1 = 0.f;
#pragma unroll 8
        for (int j = 0; j < 32; ++j) { const float l = L[(32 + i) * 64 + j]; x0 += l * Tm[j * 64 + c2]; x1 += l * Tm[j * 64 + c2 + 1]; }
        XS[i * 32 + c2] = x0; XS[i * 32 + c2 + 1] = x1;
        __syncthreads();
        float t0 = 0.f, t1 = 0.f;
#pragma unroll 8
        for (int j = 0; j < 32; ++j) { const float tv = Tm[(32 + i) * 64 + 32 + j]; t0 += tv * XS[j * 32 + c2]; t1 += tv * XS[j * 32 + c2 + 1]; }
        Tm[(32 + i) * 64 + c2] = -t0; Tm[(32 + i) * 64 + c2 + 1] = -t1;
    }
    __syncthreads();
}
__device__ __forceinline__ void unpack8(const u32x4 rw, float (&x)[8]) {
    x[0] = __uint_as_float(rw.x << 16); x[1] = __uint_as_float(rw.x & 0xffff0000u); x[2] = __uint_as_float(rw.y << 16); x[3] = __uint_as_float(rw.y & 0xffff0000u);
    x[4] = __uint_as_float(rw.z << 16); x[5] = __uint_as_float(rw.z & 0xffff0000u); x[6] = __uint_as_float(rw.w << 16); x[7] = __uint_as_float(rw.w & 0xffff0000u); }
__device__ __forceinline__ u32x4 pack8(const float (&x)[8]) { return (u32x4){pk2(x[0], x[1]), pk2(x[2], x[3]), pk2(x[4], x[5]), pk2(x[6], x[7])}; }

constexpr int PL_QS = 0, PL_R1 = 17408, PL_KT = 35840, PL_KTT = 54272, PL_VT = 72704, PL_R3 = 91136, PL_QKM = 109568, PL_TP = 118784, PL_TPP = 128000, PL_SM = 137216, PL_TM = 139264, PL_XS = 155648;
constexpr int QSTR = 136, TSTR = 72;

__device__ __forceinline__ void gdn_prep_item(const Params& p, unsigned char* smem, int h, int row_start, int npad, const bf16_t* hbase,
                                              bf16_t* halo_out, float* conv_out, unsigned char* rec) {
    const int tid = otid(), w = tid >> 6, lane = tid & 63, q4 = lane >> 4, l15 = lane & 15;
    bf16_t* qs = (bf16_t*)(smem + PL_QS); bf16_t* ks = (bf16_t*)(smem + PL_R1); bf16_t* WT = ks; bf16_t* kT = (bf16_t*)(smem + PL_KT); bf16_t* ktT = (bf16_t*)(smem + PL_KTT);
    bf16_t* vT = (bf16_t*)(smem + PL_VT); float* Lm = (float*)(smem + PL_R3); bf16_t* UT = (bf16_t*)(smem + PL_R3); bf16_t* QKm = (bf16_t*)(smem + PL_QKM);
    bf16_t* Tp = (bf16_t*)(smem + PL_TP); bf16_t* Tpp = (bf16_t*)(smem + PL_TPP);
    float* sm = (float*)(smem + PL_SM);
    float* gcs = sm; float* bes = sm + 64; float* ssq = sm + 128; float* ssk = sm + 192; float* egs = sm + 256; float* egl_s = sm + 320; float* beg = sm + 384;
    const bf16_t* P = (const bf16_t*)(p.ws + WS_P);
    const float* pk = (const float*)(p.ws + WS_PK);
    if (npad == 0) {
        const int t = tid >> 3, g = tid & 7;
        const bf16_t* zp = P + (size_t)(row_start + t) * NPB + C_Z + h * 128 + 16 * g;
        const u32x4 z0 = *(const u32x4*)zp, z1 = *(const u32x4*)(zp + 8);
        float za[8], zb[8]; unpack8(z0, za); unpack8(z1, zb);
        const float* nwp = pk + PK_NORMW + 16 * g;
        float ga[8], gb2[8];
#pragma unroll
        for (int e = 0; e < 8; ++e) { ga[e] = nwp[e] * silu_(za[e]); gb2[e] = nwp[8 + e] * silu_(zb[e]); }
        bf16_t* gp = (bf16_t*)(rec + GP_G) + t * 128 + 16 * g;
        *(u32x4*)gp = pack8(ga); *(u32x4*)(gp + 8) = pack8(gb2);
    }
    if (w == 7) {
        const int i = lane;
        float g = 0.f, be = 0.f;
        if (i >= npad) { const size_t r = (size_t)(row_start + i - npad) * NPB; const float pa = bf2f(P[r + C_A + h]), pb = bf2f(P[r + C_B + h]);
            g = -expf(pk[PK_ALOG + h]) * softplus_(pa + pk[PK_DTB + h]); be = sigm(pb); }
        float x = g;
#pragma unroll
        for (int o = 1; o < 64; o <<= 1) { const float y = __shfl_up(x, o); if (lane >= o) x += y; }
        const float gl = __shfl(x, 63);
        gcs[lane] = x; bes[lane] = be; egs[lane] = __expf(x); egl_s[lane] = __expf(gl - x); beg[lane] = be * __expf(x);
        if (lane == 0) *(float*)(rec + GP_EGL) = __expf(gl);
    }
    __syncthreads();
    if (tid < 384) {
        const int sec = tid >> 7, ts = (tid >> 4) & 7, t0 = 8 * ts, d0 = l15 * 8;
        const int pcol = sec * 1024 + h * 128 + d0;
        float cw[4][8];
#pragma unroll
        for (int j = 0; j < 4; ++j) { const f32x4 a = *(const f32x4*)(pk + PK_CONVW + j * 3072 + pcol), b = *(const f32x4*)(pk + PK_CONVW + j * 3072 + pcol + 4);
            cw[j][0] = a[0]; cw[j][1] = a[1]; cw[j][2] = a[2]; cw[j][3] = a[3]; cw[j][4] = b[0]; cw[j][5] = b[1]; cw[j][6] = b[2]; cw[j][7] = b[3]; }
        u32x4 rw[11]; float fv[11];
#pragma unroll
        for (int k = 0; k < 11; ++k) {
            const int ii = t0 - 3 + k;
            const bf16_t* ptr = P + pcol; float f = 0.f;
            if (ii >= npad) { ptr = P + (size_t)(row_start + ii - npad) * NPB + pcol; f = 1.f; }
            else if (ii < 0 && npad == 0 && hbase) { ptr = hbase + (size_t)(ii + 3) * NPB + pcol; f = 1.f; }
            rw[k] = *(const u32x4*)ptr; fv[k] = f;
        }
        if (halo_out && ts == 7) {
#pragma unroll
            for (int dd = 0; dd < 3; ++dd) { *(u32x4*)(halo_out + (size_t)dd * NPB + pcol) = rw[8 + dd];
                if (conv_out) { float x[8]; unpack8(rw[8 + dd], x); *(f32x4*)(conv_out + dd * 3072 + pcol) = (f32x4){x[0], x[1], x[2], x[3]}; *(f32x4*)(conv_out + dd * 3072 + pcol + 4) = (f32x4){x[4], x[5], x[6], x[7]}; } }
        }
        float y[8][8];
#pragma unroll
        for (int t = 0; t < 8; ++t)
#pragma unroll
            for (int e = 0; e < 8; ++e) y[t][e] = 0.f;
#pragma unroll
        for (int k = 0; k < 11; ++k) { float x[8]; unpack8(rw[k], x);
#pragma unroll
            for (int e = 0; e < 8; ++e) x[e] *= fv[k];
#pragma unroll
            for (int dlt = 0; dlt < 4; ++dlt) { const int t = k - dlt;
                if (t >= 0 && t < 8) {
#pragma unroll
                    for (int e = 0; e < 8; ++e) y[t][e] += cw[dlt][e] * x[e]; } }
        }
        const float qsc = sec == 0 ? 0.08838834764831845f : 1.f;
#pragma unroll
        for (int t = 0; t < 8; ++t) {
            const bool tokv = (t0 + t) >= npad;
            float ss = 0.f;
#pragma unroll
            for (int e = 0; e < 8; ++e) { y[t][e] = tokv ? silu_(y[t][e]) : 0.f; ss += y[t][e] * y[t][e]; }
            if (sec < 2) { const float sc = rsqrtf(rowsum16(ss) + 1e-6f) * qsc;
#pragma unroll
                for (int e = 0; e < 8; ++e) y[t][e] *= sc; }
        }
        if (sec < 2) { bf16_t* dst = sec == 0 ? qs : ks;
#pragma unroll
            for (int t = 0; t < 8; ++t) *(u32x4*)(dst + (t0 + t) * QSTR + d0) = pack8(y[t]); }
        if (sec >= 1) { bf16_t* dT = sec == 1 ? kT : vT;
#pragma unroll
            for (int e = 0; e < 8; ++e) *(u32x4*)(dT + (d0 + e) * TSTR + t0) = (u32x4){pk2(y[0][e], y[1][e]), pk2(y[2][e], y[3][e]), pk2(y[4][e], y[5][e]), pk2(y[6][e], y[7][e])}; }
        if (sec == 1) { float eg[8];
#pragma unroll
            for (int t = 0; t < 8; ++t) eg[t] = egl_s[t0 + t];
#pragma unroll
            for (int e = 0; e < 8; ++e) *(u32x4*)(ktT + (d0 + e) * TSTR + t0) = (u32x4){pk2(y[0][e] * eg[0], y[1][e] * eg[1]), pk2(y[2][e] * eg[2], y[3][e] * eg[3]), pk2(y[4][e] * eg[4], y[5][e] * eg[5]), pk2(y[6][e] * eg[6], y[7][e] * eg[7])}; }
    }
    __syncthreads();
    {
        const int which = w >> 2, it = w & 3;
        const bf16_t* Barr = which ? qs : ks;
        bf16x8 bfr[4];
#pragma unroll
        for (int kk = 0; kk < 4; ++kk) bfr[kk] = ldfrag(Barr, QSTR, 16 * it, 32 * kk, lane);
        const int i = 16 * it + l15; const float gi = gcs[i], bi = bes[i];
#pragma unroll
        for (int jt = 0; jt < 4; ++jt) {
            f32x4 acc = {0.f, 0.f, 0.f, 0.f};
#pragma unroll
            for (int kk = 0; kk < 4; ++kk) acc = MFMA16(ldfrag(ks, QSTR, 16 * jt, 32 * kk, lane), bfr[kk], acc);
            const int j0 = 16 * jt + 4 * q4; const f32x4 gj = *(const f32x4*)(gcs + j0);
            f32x4 o;
#pragma unroll
            for (int r = 0; r < 4; ++r) { const int j = j0 + r; const bool keep = which ? (i >= j) : (i > j); o[r] = keep ? acc[r] * __expf(gi - gj[r]) : 0.f; }
            if (which == 0) *(f32x4*)(Lm + i * 64 + j0) = o * bi;
            else *(u32x2*)(QKm + i * TSTR + j0) = (u32x2){pk2(o[0], o[1]), pk2(o[2], o[3])};
        }
    }
    __syncthreads();
    {
        float* Tm = (float*)(smem + PL_TM);
        inv_block(Lm, Tm, (float*)(smem + PL_XS), tid);
        const int i = tid >> 3, j0 = (tid & 7) * 8;
        float a[8], b2[8];
#pragma unroll
        for (int e = 0; e < 8; ++e) { const float tv = Tm[i * 64 + j0 + e]; a[e] = tv * beg[j0 + e]; b2[e] = tv * bes[j0 + e]; }
        *(u32x4*)(Tp + i * TSTR + j0) = (u32x4){pk2(a[0], a[1]), pk2(a[2], a[3]), pk2(a[4], a[5]), pk2(a[6], a[7])};
        *(u32x4*)(Tpp + i * TSTR + j0) = (u32x4){pk2(b2[0], b2[1]), pk2(b2[2], b2[3]), pk2(b2[4], b2[5]), pk2(b2[6], b2[7])};
    }
    __syncthreads();
    {
        const int it = w & 3, half = w >> 2;
        f32x4 aw[4], au[4];
#pragma unroll
        for (int x = 0; x < 4; ++x) { aw[x] = (f32x4){0.f, 0.f, 0.f, 0.f}; au[x] = (f32x4){0.f, 0.f, 0.f, 0.f}; }
#pragma unroll
        for (int kk = 0; kk < 2; ++kk) {
            const bf16x8 a1 = ldfrag(Tp, TSTR, 16 * it, 32 * kk, lane), a2 = ldfrag(Tpp, TSTR, 16 * it, 32 * kk, lane);
#pragma unroll
            for (int x = 0; x < 4; ++x) { const int dt = half * 4 + x;
                aw[x] = MFMA16(a1, ldfrag(kT, TSTR, 16 * dt, 32 * kk, lane), aw[x]);
                au[x] = MFMA16(a2, ldfrag(vT, TSTR, 16 * dt, 32 * kk, lane), au[x]); }
        }
        __syncthreads();
#pragma unroll
        for (int x = 0; x < 4; ++x) { const int d = 16 * (half * 4 + x) + l15, i0 = 16 * it + 4 * q4;
            *(u32x2*)(WT + d * TSTR + i0) = (u32x2){pk2(aw[x][0], aw[x][1]), pk2(aw[x][2], aw[x][3])};
            *(u32x2*)(UT + d * TSTR + i0) = (u32x2){pk2(au[x][0], au[x][1]), pk2(au[x][2], au[x][3])}; }
    }
    __syncthreads();
    {
        bf16_t* gAP = (bf16_t*)(rec + GP_AP); bf16_t* gQH = (bf16_t*)(rec + GP_QH); bf16_t* gKH = (bf16_t*)(rec + GP_KH); bf16_t* gOH = (bf16_t*)(rec + GP_OH);
        {
            const int et = w;
            const bf16x8 a0 = ldfrag(WT, TSTR, 16 * et, 0, lane), a1 = ldfrag(WT, TSTR, 16 * et, 32, lane);
#pragma unroll
            for (int dt = 0; dt < 8; ++dt) { f32x4 acc = {0.f, 0.f, 0.f, 0.f};
                acc = MFMA16(a0, ldfrag(ktT, TSTR, 16 * dt, 0, lane), acc); acc = MFMA16(a1, ldfrag(ktT, TSTR, 16 * dt, 32, lane), acc);
                *(u32x2*)(gAP + ((size_t)(dt * 4 + (et >> 1)) * 64 + lane) * 8 + (et & 1) * 4) = (u32x2){pk2(-acc[0], -acc[1]), pk2(-acc[2], -acc[3])}; }
#pragma unroll
            for (int tt = 0; tt < 4; ++tt) { f32x4 acc = {0.f, 0.f, 0.f, 0.f};
                acc = MFMA16(a0, ldfrag(QKm, TSTR, 16 * tt, 0, lane), acc); acc = MFMA16(a1, ldfrag(QKm, TSTR, 16 * tt, 32, lane), acc);
                const int t = 16 * tt + l15, e0 = 16 * et + 4 * q4; const float eg = egs[t];
                const u32x2 qq = *(const u32x2*)(qs + t * QSTR + e0);
                const float o0 = __uint_as_float(qq.x << 16) * eg - acc[0], o1 = __uint_as_float(qq.x & 0xffff0000u) * eg - acc[1],
                            o2 = __uint_as_float(qq.y << 16) * eg - acc[2], o3 = __uint_as_float(qq.y & 0xffff0000u) * eg - acc[3];
                *(u32x2*)(gQH + ((size_t)(tt * 4 + (et >> 1)) * 64 + lane) * 8 + (et & 1) * 4) = (u32x2){pk2(o0, o1), pk2(o2, o3)}; }
        }
        {
            const int dt = w;
            const bf16x8 a0 = ldfrag(ktT, TSTR, 16 * dt, 0, lane), a1 = ldfrag(ktT, TSTR, 16 * dt, 32, lane);
#pragma unroll
            for (int vt = 0; vt < 8; ++vt) { f32x4 acc = {0.f, 0.f, 0.f, 0.f};
                acc = MFMA16(a0, ldfrag(UT, TSTR, 16 * vt, 0, lane), acc); acc = MFMA16(a1, ldfrag(UT, TSTR, 16 * vt, 32, lane), acc);
                *(u32x2*)(gKH + ((size_t)(vt * 8 + dt) * 64 + lane) * 4) = (u32x2){pk2(acc[0], acc[1]), pk2(acc[2], acc[3])}; }
            const int tt = w & 3, vh = w >> 2;
            const bf16x8 b0 = ldfrag(QKm, TSTR, 16 * tt, 0, lane), b1 = ldfrag(QKm, TSTR, 16 * tt, 32, lane);
#pragma unroll
            for (int x = 0; x < 4; ++x) { const int vt = vh * 4 + x; f32x4 acc = {0.f, 0.f, 0.f, 0.f};
                acc = MFMA16(b0, ldfrag(UT, TSTR, 16 * vt, 0, lane), acc); acc = MFMA16(b1, ldfrag(UT, TSTR, 16 * vt, 32, lane), acc);
                *(u32x2*)(gOH + ((size_t)(vt * 4 + tt) * 64 + lane) * 4) = (u32x2){pk2(acc[0], acc[1]), pk2(acc[2], acc[3])}; }
        }
    }
    __syncthreads();
}

__device__ __forceinline__ void phase_gprep(const Params& p, int seg, unsigned char* smem) {
    const int blk = obid();
    const int n_items = (CPS + (seg == 0 ? 1 : 0)) * 64;
#pragma unroll 1
    for (int it = blk; it < n_items; it += gridDim.x) {
        const int bh = it & 63, b = bh >> 3, h = bh & 7; int cl = it >> 6; if (seg != 0) cl += 1;
        unsigned char* rec = p.ws + WS_GP + (size_t)(cl * 64 + bh) * GP_STRIDE;
        const bf16_t* Pb = (const bf16_t*)(p.ws + WS_P);
        bf16_t* chalo2 = (bf16_t*)(p.ws + WS_CHALO);
        if (cl == 0) gdn_prep_item(p, smem, h, LEX0, 48, nullptr, nullptr, nullptr, rec);
        else {
            const int row = b * SEGTOK + (cl - 1) * 64;
            const bf16_t* hbase = Pb + (size_t)(row - 3) * NPB;
            if (cl == 1) hbase = (seg == 0) ? Pb + (size_t)(LEX0 + NMETA - 3) * NPB : chalo2 + (size_t)(((seg - 1) & 1) * NBATCH + b) * 3 * NPB;
            bf16_t* ho = (cl == CPS) ? chalo2 + (size_t)((seg & 1) * NBATCH + b) * 3 * NPB : nullptr;
            float* co = (cl == CPS && seg == NSEG - 1) ? p.out + O_CONV_P + (size_t)b * 9216 : nullptr;
            gdn_prep_item(p, smem, h, row, 0, hbase, ho, co, rec);
        }
    }
}

__device__ __forceinline__ void gdn_scan_block(const Params& p, int seg, unsigned char* smem, int bh) {
    const int tid = otid(), w = tid >> 6, lane = tid & 63, q4 = lane >> 4, l15 = lane & 15;
    const int b = bh >> 3, h = bh & 7;
    float* st = p.out + O_GDN_P + (size_t)bh * 16384;
    float* ORAW = (float*)(p.ws + WS_ORAW);
    f32x4 S[8];
    if (seg) {
#pragma unroll
        for (int mt = 0; mt < 8; ++mt)
#pragma unroll
            for (int r = 0; r < 4; ++r) S[mt][r] = st[(size_t)(16 * mt + 4 * q4 + r) * 128 + 16 * w + l15];
    } else {
#pragma unroll
        for (int mt = 0; mt < 8; ++mt) S[mt] = (f32x4){0.f, 0.f, 0.f, 0.f};
    }
    const int c_lo = seg ? 1 : 0;
#pragma unroll 1
    for (int cl = c_lo; cl <= CPS; ++cl) {
        const unsigned char* rec = p.ws + WS_GP + (size_t)(cl * 64 + bh) * GP_STRIDE;
        __syncthreads();
        {
            const u32x4* src = (const u32x4*)rec; u32x4* dst = (u32x4*)smem;
#pragma unroll
            for (int x = 0; x < 6; ++x) dst[tid + 512 * x] = src[tid + 512 * x];
        }
        const bf16_t* gKH = (const bf16_t*)(rec + GP_KH); const bf16_t* gOH = (const bf16_t*)(rec + GP_OH);
        u32x2 kh[8], oh[4];
#pragma unroll
        for (int mt = 0; mt < 8; ++mt) kh[mt] = *(const u32x2*)(gKH + ((size_t)(w * 8 + mt) * 64 + lane) * 4);
#pragma unroll
        for (int tt = 0; tt < 4; ++tt) oh[tt] = *(const u32x2*)(gOH + ((size_t)(w * 4 + tt) * 64 + lane) * 4);
        const float egl = *(const float*)(rec + GP_EGL);
        bf16x8 Bf[4];
#pragma unroll
        for (int ks = 0; ks < 4; ++ks) { u32x4 t; t.x = pk2(S[2 * ks][0], S[2 * ks][1]); t.y = pk2(S[2 * ks][2], S[2 * ks][3]); t.z = pk2(S[2 * ks + 1][0], S[2 * ks + 1][1]); t.w = pk2(S[2 * ks + 1][2], S[2 * ks + 1][3]);
            Bf[ks] = __builtin_bit_cast(bf16x8, t); }
        __syncthreads();
        const bf16x8* AP = (const bf16x8*)smem; const bf16x8* QH = (const bf16x8*)(smem + GP_QH);
        if (cl > 0) {
            const int row = b * SEGTOK + (cl - 1) * 64;
            float* obuf = (float*)(smem + 49152);
#pragma unroll
            for (int tt = 0; tt < 4; ++tt) { f32x4 o = {0.f, 0.f, 0.f, 0.f};
#pragma unroll
                for (int ks = 0; ks < 4; ++ks) o = MFMA16(QH[(tt * 4 + ks) * 64 + lane], Bf[ks], o);
                o[0] += __uint_as_float(oh[tt].x << 16); o[1] += __uint_as_float(oh[tt].x & 0xffff0000u); o[2] += __uint_as_float(oh[tt].y << 16); o[3] += __uint_as_float(oh[tt].y & 0xffff0000u);
#pragma unroll
                for (int r = 0; r < 4; ++r) obuf[(16 * tt + 4 * q4 + r) * 132 + 16 * w + l15] = o[r]; }
            __syncthreads();
            {
                const int t = tid >> 3, g = tid & 7;
                f32x4 o[4]; float ss = 0.f;
#pragma unroll
                for (int j = 0; j < 4; ++j) { o[j] = *(const f32x4*)(obuf + t * 132 + 16 * g + 4 * j); ss += o[j][0] * o[j][0] + o[j][1] * o[j][1] + o[j][2] * o[j][2] + o[j][3] * o[j][3]; }
                ss += __shfl_xor(ss, 1); ss += __shfl_xor(ss, 2); ss += __shfl_xor(ss, 4);
                const float rs = rsqrtf(ss * (1.f / 128.f) + 1e-6f);
                const bf16_t* gp = (const bf16_t*)(rec + GP_G) + t * 128 + 16 * g;
                const u32x4 z0 = *(const u32x4*)gp, z1 = *(const u32x4*)(gp + 8);
                const unsigned zz[8] = {z0.x, z0.y, z0.z, z0.w, z1.x, z1.y, z1.z, z1.w};
                unsigned ow[8];
#pragma unroll
                for (int j = 0; j < 8; ++j) ow[j] = pk2(o[j >> 1][(j & 1) * 2] * rs * __uint_as_float(zz[j] << 16), o[j >> 1][(j & 1) * 2 + 1] * rs * __uint_as_float(zz[j] & 0xffff0000u));
                const size_t grow = (size_t)b * SEQ + seg * SEGTOK + (cl - 1) * 64 + t;
                bf16_t* oa = (bf16_t*)(p.ws + WS_H) + grow * D + h * 128 + 16 * g;
                *(u32x4*)oa = (u32x4){ow[0], ow[1], ow[2], ow[3]}; *(u32x4*)(oa + 8) = (u32x4){ow[4], ow[5], ow[6], ow[7]};
            }
        }
#pragma unroll
        for (int mt = 0; mt < 8; ++mt) { f32x4 t = {0.f, 0.f, 0.f, 0.f};
#pragma unroll
            for (int ks = 0; ks < 4; ++ks) t = MFMA16(AP[(mt * 4 + ks) * 64 + lane], Bf[ks], t);
            S[mt][0] = egl * S[mt][0] + t[0] + __uint_as_float(kh[mt].x << 16); S[mt][1] = egl * S[mt][1] + t[1] + __uint_as_float(kh[mt].x & 0xffff0000u);
            S[mt][2] = egl * S[mt][2] + t[2] + __uint_as_float(kh[mt].y << 16); S[mt][3] = egl * S[mt][3] + t[3] + __uint_as_float(kh[mt].y & 0xffff0000u); }
    }
#pragma unroll
    for (int mt = 0; mt < 8; ++mt)
#pragma unroll
        for (int r = 0; r < 4; ++r) st[(size_t)(16 * mt + 4 * q4 + r) * 128 + 16 * w + l15] = S[mt][r];
    __syncthreads();
}

constexpr int RL_AT = 0, RL_BT = 9216, RL_KT = 18432, RL_ATT = 27648, RL_RT = 36864, RL_BTLT = 46080, RL_KTLT = 55296, RL_VT = 64512, RL_LAK = 73728, RL_MRB = 82944, RL_MRK = 92160,
              RL_LM = 101376, RL_AF = 117760, RL_TM = 134144, RL_XS = 150528;
__device__ __forceinline__ void rwkv_prep_item(const Params& p, unsigned char* smem, int hb, int row_start, int npad, const bf16_t* prev_row,
                                               bf16_t* halo_out, unsigned char* rec) {
    const int tid = otid(), w = tid >> 6, lane = tid & 63, q4 = lane >> 4, l15 = lane & 15;
    bf16_t* At = (bf16_t*)(smem + RL_AT); bf16_t* Tb = At; bf16_t* Bt = (bf16_t*)(smem + RL_BT); bf16_t* WaT = Bt; bf16_t* Kt = (bf16_t*)(smem + RL_KT); bf16_t* XT = Kt;
    bf16_t* AtT = (bf16_t*)(smem + RL_ATT); bf16_t* Rt = (bf16_t*)(smem + RL_RT); bf16_t* BtlT = (bf16_t*)(smem + RL_BTLT); bf16_t* KtlT = (bf16_t*)(smem + RL_KTLT);
    bf16_t* VT = (bf16_t*)(smem + RL_VT); bf16_t* Lak = (bf16_t*)(smem + RL_LAK); bf16_t* Mrb = (bf16_t*)(smem + RL_MRB); bf16_t* Mrk = (bf16_t*)(smem + RL_MRK);
    float* Lm = (float*)(smem + RL_LM);
    bf16_t* thw = Lak; bf16_t* adb = Mrb; float* lc = Lm; float* af = (float*)(smem + RL_AF);
    const bf16_t* P = (const bf16_t*)(p.ws + WS_P);
    const float* pk = (const float*)(p.ws + WS_PK);
    const int t = tid >> 3, g = tid & 7;
    float rr[8], kb[8], vv[8], zb[8];
    {
        const bool real = t >= npad;
        const bf16_t* curp = P; const bf16_t* prevp = P; float fprev = 0.f;
        if (real) { curp = P + (size_t)(row_start + t - npad) * NPB; if (t > npad) { prevp = curp - NPB; fprev = 1.f; } else if (prev_row) { prevp = prev_row; fprev = 1.f; } }
        const int secbase[6] = {0, 1024, 2048, 3200, 3072, 3136};
        u32x4 rc[6], rp[6];
#pragma unroll
        for (int sidx = 0; sidx < 6; ++sidx) { const int col = secbase[sidx] + (sidx < 4 ? hb * 64 : 0) + g * 8; rc[sidx] = *(const u32x4*)(curp + C_RW + col); rp[sidx] = *(const u32x4*)(prevp + C_RW + col); }
        float m[6][8];
#pragma unroll
        for (int sidx = 0; sidx < 6; ++sidx) {
            const int col = secbase[sidx] + (sidx < 4 ? hb * 64 : 0) + g * 8;
            float cur[8], prv[8];
            unpack8(rc[sidx], cur); unpack8(rp[sidx], prv);
            const f32x4 mu0 = *(const f32x4*)(pk + PK_MU + col), mu1 = *(const f32x4*)(pk + PK_MU + col + 4);
            const float mu[8] = {mu0[0], mu0[1], mu0[2], mu0[3], mu1[0], mu1[1], mu1[2], mu1[3]};
#pragma unroll
            for (int e = 0; e < 8; ++e) m[sidx][e] = real ? cur[e] + mu[e] * (fprev * prv[e] - cur[e]) : 0.f;
            if (halo_out && t == 63 && (sidx < 4 || hb == 0)) *(u32x4*)(halo_out + C_RW + col) = rc[sidx];
        }
#pragma unroll
        for (int e = 0; e < 8; ++e) { rr[e] = m[0][e]; kb[e] = m[1][e]; vv[e] = m[2][e]; zb[e] = m[3][e]; }
        float th[8];
#pragma unroll
        for (int e = 0; e < 8; ++e) th[e] = tanh_(m[4][e]);
        *(u32x4*)(thw + t * TSTR + g * 8) = pack8(th);
        *(u32x4*)(adb + t * TSTR + g * 8) = pack8(m[5]);
    }
    __syncthreads();
    {
        const int which = w >> 2, ct = w & 3;
        const bf16_t* Wt = (const bf16_t*)(p.ws + (which ? WS_A2T : WS_W2T)) + (size_t)hb * 4096;
        const bf16x8 b0 = *(const bf16x8*)(Wt + (16 * ct + l15) * 64 + 8 * q4), b1 = *(const bf16x8*)(Wt + (16 * ct + l15) * 64 + 32 + 8 * q4);
        const bf16_t* Aarr = which ? adb : thw;
        const int c = 16 * ct + l15;
        const float bias = pk[(which ? PK_A0 : PK_W0) + hb * 64 + c];
        float carry = 0.f;
#pragma unroll
        for (int tt = 0; tt < 4; ++tt) {
            f32x4 acc = {0.f, 0.f, 0.f, 0.f};
            acc = MFMA16(ldfrag(Aarr, TSTR, 16 * tt, 0, lane), b0, acc); acc = MFMA16(ldfrag(Aarr, TSTR, 16 * tt, 32, lane), b1, acc);
            if (which) {
#pragma unroll
                for (int r = 0; r < 4; ++r) af[(16 * tt + 4 * q4 + r) * 64 + c] = sigm(bias + acc[r]);
            } else {
                float wl[4];
#pragma unroll
                for (int r = 0; r < 4; ++r) { const int tk = 16 * tt + 4 * q4 + r; wl[r] = (tk < npad) ? 0.f : -0.6065306597126334f * sigm(bias + acc[r]); }
                wl[1] += wl[0]; wl[2] += wl[1]; wl[3] += wl[2];
                const float Q = wl[3];
                const float Q0 = __shfl(Q, l15), Q1 = __shfl(Q, l15 + 16), Q2 = __shfl(Q, l15 + 32), Q3 = __shfl(Q, l15 + 48);
                const float ex = carry + (q4 > 0 ? Q0 : 0.f) + (q4 > 1 ? Q1 : 0.f) + (q4 > 2 ? Q2 : 0.f);
#pragma unroll
                for (int r = 0; r < 4; ++r) lc[(16 * tt + 4 * q4 + r) * 64 + c] = ex + wl[r];
                carry += Q0 + Q1 + Q2 + Q3;
            }
        }
    }
    __syncthreads();
    {
        float lct[8], lcp[8], lcC[8], av[8];
        { const f32x4 a = *(const f32x4*)(lc + t * 64 + g * 8), b2 = *(const f32x4*)(lc + t * 64 + g * 8 + 4); lct[0] = a[0]; lct[1] = a[1]; lct[2] = a[2]; lct[3] = a[3]; lct[4] = b2[0]; lct[5] = b2[1]; lct[6] = b2[2]; lct[7] = b2[3]; }
        if (t > 0) { const f32x4 a = *(const f32x4*)(lc + (t - 1) * 64 + g * 8), b2 = *(const f32x4*)(lc + (t - 1) * 64 + g * 8 + 4); lcp[0] = a[0]; lcp[1] = a[1]; lcp[2] = a[2]; lcp[3] = a[3]; lcp[4] = b2[0]; lcp[5] = b2[1]; lcp[6] = b2[2]; lcp[7] = b2[3]; }
        else {
#pragma unroll
            for (int e = 0; e < 8; ++e) lcp[e] = 0.f; }
        { const f32x4 a = *(const f32x4*)(lc + 63 * 64 + g * 8), b2 = *(const f32x4*)(lc + 63 * 64 + g * 8 + 4); lcC[0] = a[0]; lcC[1] = a[1]; lcC[2] = a[2]; lcC[3] = a[3]; lcC[4] = b2[0]; lcC[5] = b2[1]; lcC[6] = b2[2]; lcC[7] = b2[3]; }
        { const f32x4 a = *(const f32x4*)(af + t * 64 + g * 8), b2 = *(const f32x4*)(af + t * 64 + g * 8 + 4); av[0] = a[0]; av[1] = a[1]; av[2] = a[2]; av[3] = a[3]; av[4] = b2[0]; av[5] = b2[1]; av[6] = b2[2]; av[7] = b2[3]; }
        const int hc = hb * 64 + g * 8;
        float kk[8], km[8], ss = 0.f, rk = 0.f;
#pragma unroll
        for (int e = 0; e < 8; ++e) { kk[e] = kb[e] * pk[PK_KK + hc + e]; ss += kk[e] * kk[e]; km[e] = kb[e] * (1.f + (av[e] - 1.f) * pk[PK_KA + hc + e]); rk += rr[e] * km[e] * pk[PK_RK + hc + e]; }
        ss += __shfl_xor(ss, 1); ss += __shfl_xor(ss, 2); ss += __shfl_xor(ss, 4);
        rk += __shfl_xor(rk, 1); rk += __shfl_xor(rk, 2); rk += __shfl_xor(rk, 4);
        const float kn = rsqrtf(ss + 1e-6f);
        float xa[8], xb[8], xk[8], xr[8], xbt[8], xkt[8];
#pragma unroll
        for (int e = 0; e < 8; ++e) { kk[e] *= kn; const float ka = kk[e] * av[e]; const float ip = __expf(-lct[e]), tl = __expf(lcC[e] - lct[e]);
            xa[e] = kk[e] * __expf(lcp[e]); xb[e] = ka * ip; xk[e] = km[e] * ip; xr[e] = rr[e] * __expf(lct[e]); xbt[e] = ka * tl; xkt[e] = km[e] * tl; }
        *(u32x4*)(At + t * TSTR + g * 8) = pack8(xa); *(u32x4*)(Bt + t * TSTR + g * 8) = pack8(xb); *(u32x4*)(Kt + t * TSTR + g * 8) = pack8(xk); *(u32x4*)(Rt + t * TSTR + g * 8) = pack8(xr);
#pragma unroll
        for (int e = 0; e < 8; ++e) { const int c = g * 8 + e; AtT[c * TSTR + t] = (bf16_t)f2bf(xa[e]); BtlT[c * TSTR + t] = (bf16_t)f2bf(xbt[e]); KtlT[c * TSTR + t] = (bf16_t)f2bf(xkt[e]); VT[c * TSTR + t] = (bf16_t)f2bf(vv[e]); }
        float c1[8], c0[8];
#pragma unroll
        for (int e = 0; e < 8; ++e) { const float sz = silu_(zb[e]); c1[e] = pk[PK_GNW + hc + e] * sz; c0[e] = (pk[PK_GNB + hc + e] + rk * vv[e]) * sz; }
        *(u32x4*)((bf16_t*)(rec + RP_C1) + t * 64 + g * 8) = pack8(c1); *(u32x4*)((bf16_t*)(rec + RP_C0) + t * 64 + g * 8) = pack8(c0);
        if (t == 63) { float* pc = (float*)(rec + RP_PC) + g * 8; *(f32x4*)pc = (f32x4){__expf(lcC[0]), __expf(lcC[1]), __expf(lcC[2]), __expf(lcC[3])}; *(f32x4*)(pc + 4) = (f32x4){__expf(lcC[4]), __expf(lcC[5]), __expf(lcC[6]), __expf(lcC[7])}; }
    }
    __syncthreads();
    {
        const int pr = w >> 1;
        const bf16_t* Aarr = pr < 2 ? At : Rt; const bf16_t* Barr = (pr & 1) ? Kt : Bt;
#pragma unroll
        for (int x = 0; x < 2; ++x) { const int tt = 2 * (w & 1) + x;
            const bf16x8 a0 = ldfrag(Aarr, TSTR, 16 * tt, 0, lane), a1 = ldfrag(Aarr, TSTR, 16 * tt, 32, lane);
            const int tk = 16 * tt + l15;
#pragma unroll
            for (int it = 0; it < 4; ++it) { f32x4 acc = {0.f, 0.f, 0.f, 0.f};
                acc = MFMA16(ldfrag(Barr, TSTR, 16 * it, 0, lane), a0, acc); acc = MFMA16(ldfrag(Barr, TSTR, 16 * it, 32, lane), a1, acc);
                const int i0 = 16 * it + 4 * q4;
                f32x4 o;
#pragma unroll
                for (int r = 0; r < 4; ++r) { const int i = i0 + r; const bool keep = pr < 2 ? (tk > i) : (tk >= i); o[r] = keep ? acc[r] : 0.f; }
                if (pr == 0) *(f32x4*)(Lm + tk * 64 + i0) = o;
                else { bf16_t* Out = pr == 1 ? Lak : (pr == 2 ? Mrb : Mrk); *(u32x2*)(Out + tk * TSTR + i0) = (u32x2){pk2(o[0], o[1]), pk2(o[2], o[3])}; } }
        }
    }
    __syncthreads();
    {
        float* Tm = (float*)(smem + RL_TM);
        inv_block(Lm, Tm, (float*)(smem + RL_XS), tid);
        const int i = tid >> 3, j0 = (tid & 7) * 8;
        float a[8];
#pragma unroll
        for (int e = 0; e < 8; ++e) a[e] = Tm[i * 64 + j0 + e];
        *(u32x4*)(Tb + i * TSTR + j0) = pack8(a);
    }
    __syncthreads();
    {
        const int tt = w & 3, which = w >> 2;
        const bf16_t* Aarr = which ? Lak : Tb; const bf16_t* Barr = which ? VT : AtT; bf16_t* Out = which ? XT : WaT;
        const bf16x8 a0 = ldfrag(Aarr, TSTR, 16 * tt, 0, lane), a1 = ldfrag(Aarr, TSTR, 16 * tt, 32, lane);
#pragma unroll
        for (int ct = 0; ct < 4; ++ct) { f32x4 acc = {0.f, 0.f, 0.f, 0.f};
            acc = MFMA16(a0, ldfrag(Barr, TSTR, 16 * ct, 0, lane), acc); acc = MFMA16(a1, ldfrag(Barr, TSTR, 16 * ct, 32, lane), acc);
            *(u32x2*)(Out + (16 * ct + l15) * TSTR + 16 * tt + 4 * q4) = (u32x2){pk2(acc[0], acc[1]), pk2(acc[2], acc[3])}; }
    }
    __syncthreads();
    {
        f32x4 acc[4];
        if (w < 4) {
            const bf16x8 a0 = ldfrag(Tb, TSTR, 16 * w, 0, lane), a1 = ldfrag(Tb, TSTR, 16 * w, 32, lane);
#pragma unroll
            for (int ct = 0; ct < 4; ++ct) { acc[ct] = (f32x4){0.f, 0.f, 0.f, 0.f};
                acc[ct] = MFMA16(a0, ldfrag(XT, TSTR, 16 * ct, 0, lane), acc[ct]); acc[ct] = MFMA16(a1, ldfrag(XT, TSTR, 16 * ct, 32, lane), acc[ct]); }
        }
        __syncthreads();
        if (w < 4) {
#pragma unroll
            for (int ct = 0; ct < 4; ++ct) *(u32x2*)(XT + (16 * ct + l15) * TSTR + 16 * w + 4 * q4) = (u32x2){pk2(-acc[ct][0], -acc[ct][1]), pk2(-acc[ct][2], -acc[ct][3])};
        }
    }
    __syncthreads();
    {
        const bf16_t* UvT = XT;
        bf16_t* gAP = (bf16_t*)(rec + RP_AP); bf16_t* gRH = (bf16_t*)(rec + RP_RH); bf16_t* gKH = (bf16_t*)(rec + RP_KH); bf16_t* gYH = (bf16_t*)(rec + RP_YH);
        const int et = w & 3, part = w >> 2;
        {
            const bf16x8 a0 = ldfrag(WaT, TSTR, 16 * et, 0, lane), a1 = ldfrag(WaT, TSTR, 16 * et, 32, lane);
            if (part == 0) {
#pragma unroll
                for (int kt = 0; kt < 4; ++kt) { f32x4 acc = {0.f, 0.f, 0.f, 0.f};
                    acc = MFMA16(a0, ldfrag(BtlT, TSTR, 16 * kt, 0, lane), acc); acc = MFMA16(a1, ldfrag(BtlT, TSTR, 16 * kt, 32, lane), acc);
                    *(u32x2*)(gAP + ((size_t)(kt * 2 + (et >> 1)) * 64 + lane) * 8 + (et & 1) * 4) = (u32x2){pk2(-acc[0], -acc[1]), pk2(-acc[2], -acc[3])}; }
            } else {
#pragma unroll
                for (int tt = 0; tt < 4; ++tt) { f32x4 acc = {0.f, 0.f, 0.f, 0.f};
                    acc = MFMA16(a0, ldfrag(Mrb, TSTR, 16 * tt, 0, lane), acc); acc = MFMA16(a1, ldfrag(Mrb, TSTR, 16 * tt, 32, lane), acc);
                    const int tk = 16 * tt + l15, e0 = 16 * et + 4 * q4;
                    const u32x2 q2 = *(const u32x2*)(Rt + tk * TSTR + e0);
                    const float o0 = __uint_as_float(q2.x << 16) - acc[0], o1 = __uint_as_float(q2.x & 0xffff0000u) - acc[1], o2 = __uint_as_float(q2.y << 16) - acc[2], o3 = __uint_as_float(q2.y & 0xffff0000u) - acc[3];
                    *(u32x2*)(gRH + ((size_t)(tt * 2 + (et >> 1)) * 64 + lane) * 8 + (et & 1) * 4) = (u32x2){pk2(o0, o1), pk2(o2, o3)}; }
            }
        }
        {
            const int rt = w & 3;
            const bf16_t* A1 = part ? BtlT : Mrb; const bf16_t* A2 = part ? KtlT : Mrk; bf16_t* Out = part ? gKH : gYH;
            const bf16x8 a0 = ldfrag(A1, TSTR, 16 * rt, 0, lane), a1 = ldfrag(A1, TSTR, 16 * rt, 32, lane), a2 = ldfrag(A2, TSTR, 16 * rt, 0, lane), a3 = ldfrag(A2, TSTR, 16 * rt, 32, lane);
#pragma unroll
            for (int vt = 0; vt < 4; ++vt) { f32x4 acc = {0.f, 0.f, 0.f, 0.f};
                acc = MFMA16(a0, ldfrag(UvT, TSTR, 16 * vt, 0, lane), acc); acc = MFMA16(a1, ldfrag(UvT, TSTR, 16 * vt, 32, lane), acc);
                acc = MFMA16(a2, ldfrag(VT, TSTR, 16 * vt, 0, lane), acc); acc = MFMA16(a3, ldfrag(VT, TSTR, 16 * vt, 32, lane), acc);
                *(u32x2*)(Out + ((size_t)(vt * 4 + rt) * 64 + lane) * 4) = (u32x2){pk2(acc[0], acc[1]), pk2(acc[2], acc[3])}; }
        }
    }
    __syncthreads();
}

__device__ __forceinline__ void phase_rprep(const Params& p, int seg, unsigned char* smem) {
    const int blk = obid();
    const int n_items = (CPS + (seg == 0 ? 1 : 0)) * 128;
#pragma unroll 1
    for (int it = blk; it < n_items; it += gridDim.x) {
        const int bh = it & 127, b = bh >> 4, hb = bh & 15; int cl = it >> 7; if (seg != 0) cl += 1;
        unsigned char* rec = p.ws + WS_RP + (size_t)(cl * 128 + bh) * RP_STRIDE;
        const bf16_t* Pb = (const bf16_t*)(p.ws + WS_P);
        bf16_t* phalo2 = (bf16_t*)(p.ws + WS_PHALO);
        if (cl == 0) rwkv_prep_item(p, smem, hb, LEX0, 48, nullptr, nullptr, rec);
        else {
            const int row = b * SEGTOK + (cl - 1) * 64;
            const bf16_t* prow = Pb + (size_t)(row - 1) * NPB;
            if (cl == 1) prow = (seg == 0) ? Pb + (size_t)(LEX0 + NMETA - 1) * NPB : phalo2 + (size_t)(((seg - 1) & 1) * NBATCH + b) * NPB;
            bf16_t* ho = (cl == CPS) ? phalo2 + (size_t)((seg & 1) * NBATCH + b) * NPB : nullptr;
            rwkv_prep_item(p, smem, hb, row, 0, prow, ho, rec);
        }
    }
}

__device__ __forceinline__ void rwkv_scan_block(const Params& p, int seg, unsigned char* smem, int pairidx) {
    const int tid = otid(), w = tid >> 6, lane = tid & 63, q4 = lane >> 4, l15 = lane & 15;
    const int hsel = w >> 2, vt = w & 3;
    const int bh = pairidx * 2 + hsel, b = bh >> 4, hb = bh & 15;
    float* st = p.out + O_RWKV_P + (size_t)bh * 4096;
    f32x4 S[4];
    if (seg) {
#pragma unroll
        for (int mt = 0; mt < 4; ++mt) S[mt] = *(const f32x4*)(st + (size_t)(16 * vt + l15) * 64 + 16 * mt + 4 * q4);
    } else {
#pragma unroll
        for (int mt = 0; mt < 4; ++mt) S[mt] = (f32x4){0.f, 0.f, 0.f, 0.f};
    }
    const int c_lo = seg ? 1 : 0;
    float* ybuf = (float*)(smem + 32768) + hsel * (64 * 68);
#pragma unroll 1
    for (int cl = c_lo; cl <= CPS; ++cl) {
        const unsigned char* rec = p.ws + WS_RP + (size_t)(cl * 128 + bh) * RP_STRIDE;
        __syncthreads();
        {
            const u32x4* src = (const u32x4*)rec; u32x4* dst = (u32x4*)(smem + hsel * 16384); const int tl = tid & 255;
#pragma unroll
            for (int x = 0; x < 4; ++x) dst[tl + 256 * x] = src[tl + 256 * x];
        }
        const bf16_t* gKH = (const bf16_t*)(rec + RP_KH); const bf16_t* gYH = (const bf16_t*)(rec + RP_YH);
        u32x2 kh[4], yh[4]; f32x4 pc[4];
#pragma unroll
        for (int mt = 0; mt < 4; ++mt) { kh[mt] = *(const u32x2*)(gKH + ((size_t)(vt * 4 + mt) * 64 + lane) * 4); yh[mt] = *(const u32x2*)(gYH + ((size_t)(vt * 4 + mt) * 64 + lane) * 4);
            pc[mt] = *(const f32x4*)((const float*)(rec + RP_PC) + 16 * mt + 4 * q4); }
        bf16x8 Bf[2];
#pragma unroll
        for (int ks = 0; ks < 2; ++ks) { u32x4 tq; tq.x = pk2(S[2 * ks][0], S[2 * ks][1]); tq.y = pk2(S[2 * ks][2], S[2 * ks][3]); tq.z = pk2(S[2 * ks + 1][0], S[2 * ks + 1][1]); tq.w = pk2(S[2 * ks + 1][2], S[2 * ks + 1][3]);
            Bf[ks] = __builtin_bit_cast(bf16x8, tq); }
        __syncthreads();
        const bf16x8* AP = (const bf16x8*)(smem + hsel * 16384); const bf16x8* RH = (const bf16x8*)(smem + hsel * 16384 + RP_RH);
        if (cl > 0) {
#pragma unroll
            for (int tt = 0; tt < 4; ++tt) { f32x4 y = {0.f, 0.f, 0.f, 0.f};
                y = MFMA16(RH[(tt * 2 + 0) * 64 + lane], Bf[0], y); y = MFMA16(RH[(tt * 2 + 1) * 64 + lane], Bf[1], y);
                y[0] += __uint_as_float(yh[tt].x << 16); y[1] += __uint_as_float(yh[tt].x & 0xffff0000u); y[2] += __uint_as_float(yh[tt].y << 16); y[3] += __uint_as_float(yh[tt].y & 0xffff0000u);
#pragma unroll
                for (int r = 0; r < 4; ++r) ybuf[(16 * tt + 4 * q4 + r) * 68 + 16 * vt + l15] = y[r]; }
        }
#pragma unroll
        for (int mt = 0; mt < 4; ++mt) { f32x4 tq = {0.f, 0.f, 0.f, 0.f};
            tq = MFMA16(AP[(mt * 2 + 0) * 64 + lane], Bf[0], tq); tq = MFMA16(AP[(mt * 2 + 1) * 64 + lane], Bf[1], tq);
            S[mt][0] = pc[mt][0] * S[mt][0] + tq[0] + __uint_as_float(kh[mt].x << 16); S[mt][1] = pc[mt][1] * S[mt][1] + tq[1] + __uint_as_float(kh[mt].x & 0xffff0000u);
            S[mt][2] = pc[mt][2] * S[mt][2] + tq[2] + __uint_as_float(kh[mt].y << 16); S[mt][3] = pc[mt][3] * S[mt][3] + tq[3] + __uint_as_float(kh[mt].y & 0xffff0000u); }
        if (cl > 0) {
            __syncthreads();
            const int tl = tid & 255, tk = tl >> 2, g = tl & 3;
            f32x4 y[4]; float sm = 0.f;
#pragma unroll
            for (int j = 0; j < 4; ++j) { y[j] = *(const f32x4*)(ybuf + tk * 68 + 16 * g + 4 * j); sm += y[j][0] + y[j][1] + y[j][2] + y[j][3]; }
            sm += __shfl_xor(sm, 1); sm += __shfl_xor(sm, 2);
            const float mu = sm * (1.f / 64.f); float vs = 0.f;
#pragma unroll
            for (int j = 0; j < 4; ++j) { y[j] = y[j] - mu; vs += y[j][0] * y[j][0] + y[j][1] * y[j][1] + y[j][2] * y[j][2] + y[j][3] * y[j][3]; }
            vs += __shfl_xor(vs, 1); vs += __shfl_xor(vs, 2);
            const float rs = rsqrtf(vs * (1.f / 64.f) + 64e-5f);
            const bf16_t* c1p = (const bf16_t*)(rec + RP_C1) + tk * 64 + 16 * g; const bf16_t* c0p = (const bf16_t*)(rec + RP_C0) + tk * 64 + 16 * g;
            const u32x4 a0 = *(const u32x4*)c0p, a1 = *(const u32x4*)(c0p + 8), b0 = *(const u32x4*)c1p, b1 = *(const u32x4*)(c1p + 8);
            const unsigned c0w[8] = {a0.x, a0.y, a0.z, a0.w, a1.x, a1.y, a1.z, a1.w}, c1w[8] = {b0.x, b0.y, b0.z, b0.w, b1.x, b1.y, b1.z, b1.w};
            unsigned ow[8];
#pragma unroll
            for (int j = 0; j < 8; ++j) ow[j] = pk2(y[j >> 1][(j & 1) * 2] * rs * __uint_as_float(c1w[j] << 16) + __uint_as_float(c0w[j] << 16),
                                                     y[j >> 1][(j & 1) * 2 + 1] * rs * __uint_as_float(c1w[j] & 0xffff0000u) + __uint_as_float(c0w[j] & 0xffff0000u));
            const size_t grow = (size_t)b * SEQ + seg * SEGTOK + (cl - 1) * 64 + tk;
            bf16_t* ob = (bf16_t*)(p.ws + WS_OB) + grow * D + hb * 64 + 16 * g;
            *(u32x4*)ob = (u32x4){ow[0], ow[1], ow[2], ow[3]}; *(u32x4*)(ob + 8) = (u32x4){ow[4], ow[5], ow[6], ow[7]};
        }
    }
#pragma unroll
    for (int mt = 0; mt < 4; ++mt) *(f32x4*)(st + (size_t)(16 * vt + l15) * 64 + 16 * mt + 4 * q4) = S[mt];
    __syncthreads();
}

__device__ __forceinline__ void gdn_sample_item(const Params& p, unsigned char* smem, int bs, int h) {
    const int tid = otid(), w = tid >> 6, lane = tid & 63, kq = tid >> 7, v = tid & 127;
    float* qk_s = (float*)smem; float* v_s = qk_s + 1024; float* gb_s = v_s + 512; float* part = gb_s + 16; float* part2 = part + 512;
    const bf16_t* P = (const bf16_t*)(p.ws + WS_P);
    const float* pk = (const float*)(p.ws + WS_PK);
    const float* s_in = p.in[2] + (size_t)(bs * 8 + h) * 16384; float* s_out = p.out + O_GDN_S + (size_t)(bs * 8 + h) * 16384;
    const int row0 = LEX0 + EX_SAMP + bs * DECT;
    float s[32];
#pragma unroll
    for (int j = 0; j < 32; ++j) s[j] = s_in[(size_t)(kq * 32 + j) * 128 + v];
    if (tid < 384) {
        const int pcol = (tid >> 7) * 1024 + h * 128 + (tid & 127);
        const float* cw = pk + PK_CONVW; const float* hin = p.in[3] + (size_t)bs * 9216; float* hout = p.out + O_CONV_S + (size_t)bs * 9216;
        const float cw0 = cw[pcol], cw1 = cw[3072 + pcol], cw2 = cw[6144 + pcol], cw3 = cw[9216 + pcol];
        float x3 = hin[pcol], x2 = hin[3072 + pcol], x1 = hin[6144 + pcol];
        float xr[4];
#pragma unroll
        for (int i = 0; i < 4; ++i) xr[i] = bf2f(P[(size_t)(row0 + i) * NPB + pcol]);
#pragma unroll
        for (int i = 0; i < 4; ++i) { const float y = cw0 * x3 + cw1 * x2 + cw2 * x1 + cw3 * xr[i]; x3 = x2; x2 = x1; x1 = xr[i];
            if (tid < 256) qk_s[i * 256 + tid] = silu_(y); else v_s[i * 128 + (tid - 256)] = silu_(y); }
        hout[pcol] = x3; hout[3072 + pcol] = x2; hout[6144 + pcol] = x1;
    } else if (tid < 388) {
        const int i = tid - 384; const size_t r = (size_t)(row0 + i) * NPB;
        const float pa = bf2f(P[r + C_A + h]), pb = bf2f(P[r + C_B + h]);
        gb_s[2 * i] = __expf(-expf(pk[PK_ALOG + h]) * softplus_(pa + pk[PK_DTB + h])); gb_s[2 * i + 1] = sigm(pb);
    }
    __syncthreads();
    { const int i = w >> 1, which = w & 1; float* rp = qk_s + i * 256 + which * 128; const float a = rp[lane], b = rp[lane + 64];
      const float sc = rsqrtf(wave_sum(a * a + b * b) + 1e-6f) * (which == 0 ? 0.08838834764831845f : 1.f); rp[lane] = a * sc; rp[lane + 64] = b * sc; }
    __syncthreads();
#pragma unroll 1
    for (int i = 0; i < 4; ++i) {
        const float* kp = qk_s + i * 256 + 128 + kq * 32; const float* qp = qk_s + i * 256 + kq * 32;
        float pa = 0.f;
#pragma unroll
        for (int j4 = 0; j4 < 8; ++j4) { const f32x4 k4 = *(const f32x4*)(kp + 4 * j4); pa += k4[0] * s[4 * j4] + k4[1] * s[4 * j4 + 1] + k4[2] * s[4 * j4 + 2] + k4[3] * s[4 * j4 + 3]; }
        part[kq * 128 + v] = pa;
        __syncthreads();
        const float kS = part[v] + part[128 + v] + part[256 + v] + part[384 + v];
        const float a = gb_s[2 * i], c = gb_s[2 * i + 1] * (v_s[i * 128 + v] - a * kS);
        float po = 0.f;
#pragma unroll
        for (int j4 = 0; j4 < 8; ++j4) { const f32x4 k4 = *(const f32x4*)(kp + 4 * j4), q4v = *(const f32x4*)(qp + 4 * j4);
#pragma unroll
            for (int e = 0; e < 4; ++e) { s[4 * j4 + e] = a * s[4 * j4 + e] + k4[e] * c; po += q4v[e] * s[4 * j4 + e]; } }
        part2[kq * 128 + v] = po;
        __syncthreads();
        if (kq == 0) ((float*)(p.ws + WS_ORAW))[(size_t)(row0 + i) * D + h * 128 + v] = part2[v] + part2[128 + v] + part2[256 + v] + part2[384 + v];
    }
#pragma unroll
    for (int j = 0; j < 32; ++j) s_out[(size_t)(kq * 32 + j) * 128 + v] = s[j];
    __syncthreads();
}

constexpr int SR_R = 0, SR_KK = 4096, SR_V = 8192, SR_ZB = 12288, SR_DEC = 16384, SR_KA = 20480, SR_KM = 24576, SR_WD = 28672, SR_AD = 28928, SR_RK = 29184;
__device__ __forceinline__ void rwkv_sample_item(const Params& p, unsigned char* smem, int bs) {
    const int tid = otid(), w = tid >> 6, lane = tid & 63;
    float* f = (float*)smem;
    const bf16_t* P = (const bf16_t*)(p.ws + WS_P);
    const float* pk = (const float*)(p.ws + WS_PK);
    const int row0 = LEX0 + EX_SAMP + bs * DECT;
    const bf16_t* prow = P + (size_t)(LEX0 + EX_SHIFT + bs) * NPB + C_RW;
#pragma unroll 1
    for (int col = tid; col < RW_SHIFT; col += 512) {
        const float mu = pk[PK_MU + col]; float prev = bf2f(prow[col]);
        float cur[4];
#pragma unroll
        for (int i = 0; i < 4; ++i) cur[i] = bf2f(P[(size_t)(row0 + i) * NPB + C_RW + col]);
        float* dst; int stride = 1024; bool th = false;
        if (col < 1024) dst = f + SR_R + col; else if (col < 2048) dst = f + SR_KK + (col - 1024); else if (col < 3072) dst = f + SR_V + (col - 2048);
        else if (col < 3136) { dst = f + SR_WD + (col - 3072); stride = 64; th = true; } else if (col < 3200) { dst = f + SR_AD + (col - 3136); stride = 64; } else dst = f + SR_ZB + (col - 3200);
#pragma unroll
        for (int i = 0; i < 4; ++i) { float m = cur[i] + mu * (prev - cur[i]); prev = cur[i]; if (th) m = tanh_(m); dst[i * stride] = m; }
    }
    __syncthreads();
#pragma unroll 1
    for (int cc = 0; cc < 2; ++cc) {
        const int c = tid + 512 * cc;
        float aw[4] = {0.f, 0.f, 0.f, 0.f}, aa[4] = {0.f, 0.f, 0.f, 0.f};
#pragma unroll 8
        for (int l = 0; l < 64; ++l) { const float w2v = pk[PK_W2 + l * D + c], a2v = pk[PK_A2 + l * D + c];
#pragma unroll
            for (int i = 0; i < 4; ++i) { aw[i] += f[SR_WD + i * 64 + l] * w2v; aa[i] += f[SR_AD + i * 64 + l] * a2v; } }
        const float w0c = pk[PK_W0 + c], a0c = pk[PK_A0 + c], kkc = pk[PK_KK + c], kac = pk[PK_KA + c];
#pragma unroll
        for (int i = 0; i < 4; ++i) { const float a = sigm(a0c + aa[i]); const float kbv = f[SR_KK + i * 1024 + c];
            f[SR_DEC + i * 1024 + c] = __expf(-0.6065306597126334f * sigm(w0c + aw[i])); f[SR_KA + i * 1024 + c] = a; f[SR_KK + i * 1024 + c] = kbv * kkc; f[SR_KM + i * 1024 + c] = kbv * (1.f + (a - 1.f) * kac); }
    }
    __syncthreads();
#pragma unroll 1
    for (int x = 0; x < 8; ++x) { const int pr = w * 8 + x, i = pr >> 4, hh = pr & 15; const int o = i * 1024 + hh * 64 + lane;
        const float kr = f[SR_KK + o]; const float kk = kr * rsqrtf(wave_sum(kr * kr) + 1e-6f); f[SR_KK + o] = kk; f[SR_KA + o] = kk * f[SR_KA + o];
        const float rkv = wave_sum(f[SR_R + o] * f[SR_KM + o] * pk[PK_RK + hh * 64 + lane]); if (lane == 0) f[SR_RK + pr] = rkv; }
    __syncthreads();
#pragma unroll 1
    for (int hp = 0; hp < 2; ++hp) {
        const int hb = hp * 8 + w;
        const float* s_in = p.in[4] + (size_t)(bs * 16 + hb) * 4096 + (size_t)lane * 64; float* s_out = p.out + O_RWKV_S + (size_t)(bs * 16 + hb) * 4096 + (size_t)lane * 64;
        f32x4 S[16];
#pragma unroll
        for (int j = 0; j < 16; ++j) S[j] = *(const f32x4*)(s_in + 4 * j);
        const int cch = hb * 64 + lane;
        const float gnw = pk[PK_GNW + cch], gnb = pk[PK_GNB + cch];
#pragma unroll 1
        for (int i = 0; i < 4; ++i) {
            const int o = i * 1024 + hb * 64;
            const float vv = f[SR_V + o + lane], rk = f[SR_RK + i * 16 + hb];
            float sa = 0.f;
#pragma unroll
            for (int j = 0; j < 16; ++j) { const f32x4 kk4 = *(const f32x4*)(f + SR_KK + o + 4 * j); sa += S[j][0] * kk4[0] + S[j][1] * kk4[1] + S[j][2] * kk4[2] + S[j][3] * kk4[3]; }
            float y = 0.f;
#pragma unroll
            for (int j = 0; j < 16; ++j) { const f32x4 de4 = *(const f32x4*)(f + SR_DEC + o + 4 * j), ka4 = *(const f32x4*)(f + SR_KA + o + 4 * j), km4 = *(const f32x4*)(f + SR_KM + o + 4 * j), r4 = *(const f32x4*)(f + SR_R + o + 4 * j);
#pragma unroll
                for (int e = 0; e < 4; ++e) { S[j][e] = S[j][e] * de4[e] + (vv * km4[e] - sa * ka4[e]); y += S[j][e] * r4[e]; } }
            const float mu = wave_sum(y) * (1.f / 64.f); const float dy = y - mu;
            const float rs = rsqrtf(wave_sum(dy * dy) * (1.f / 64.f) + 64e-5f);
            const float ov = (dy * rs * gnw + gnb + rk * vv) * silu_(f[SR_ZB + i * 1024 + cch]);
            ((bf16_t*)(p.ws + WS_OB))[(size_t)(XROWS + EX_SAMP + bs * DECT + i) * D + cch] = (bf16_t)f2bf(ov);
        }
#pragma unroll
        for (int j = 0; j < 16; ++j) *(f32x4*)(s_out + 4 * j) = S[j];
    }
    __syncthreads();
}

__device__ __forceinline__ void phase2(const Params& p, int seg, unsigned char* smem) {
    const int blk = obid();
    float* out = p.out;
    float* chalo = (float*)(p.ws + WS_CHALO); float* phalo = (float*)(p.ws + WS_PHALO);
#ifndef SUB
#define SUB 0
#endif
#define SEN(x) (SUB == 0 || SUB == (x))
    if (SEN(1) && blk < 64) gdn_scan_block(p, seg, smem, blk);
    if (SEN(3) && blk >= 64 && blk < 128) rwkv_scan_block(p, seg, smem, blk - 64);
#ifndef DUP
#define DUP 0
#endif
    if (seg == 0) {
#pragma unroll 1
        for (int it = blk; it < DECB * 8; it += gridDim.x) gdn_sample_item(p, smem, it >> 3, it & 7);
#pragma unroll 1
        for (int it = (blk + 128) & 255; it < DECB; it += gridDim.x) rwkv_sample_item(p, smem, it);
    }
}

__device__ __forceinline__ void phase25(const Params& p, int seg) {
    const int tid0 = otid(); const int lane = tid0 & 63; const int gw = obid() * 8 + (tid0 >> 6), NGW = gridDim.x * 8;
    const bf16_t* P = (const bf16_t*)(p.ws + WS_P);
    const float* ORAW = (const float*)(p.ws + WS_ORAW); const float* YRAW = (const float*)(p.ws + WS_YRAW);
    const bf16_t* C0 = (const bf16_t*)(p.ws + WS_C0); const bf16_t* C1 = (const bf16_t*)(p.ws + WS_C1);
    bf16_t* OA = (bf16_t*)(p.ws + WS_H); bf16_t* OB = (bf16_t*)(p.ws + WS_OB);
    const int nrows = LEX0 + (seg == 0 ? DECB * DECT : 0);
    const int c = lane * 16;
    f32x4 nw[4];
#pragma unroll
    for (int j = 0; j < 4; ++j) nw[j] = *(const f32x4*)((const float*)(p.ws + WS_PK) + PK_NORMW + (c & 127) + 4 * j);
#pragma unroll 1
    for (int rr = LEX0 + gw; rr < nrows; rr += NGW) {
        int lr; size_t grow;
        if (rr < LEX0) { lr = rr; grow = (size_t)(rr / SEGTOK) * SEQ + seg * SEGTOK + (rr % SEGTOK); } else { lr = LEX0 + EX_SAMP + (rr - LEX0); grow = (size_t)XROWS + EX_SAMP + (rr - LEX0); }
        {
            f32x4 o[4]; float ss = 0.f;
#pragma unroll
            for (int j = 0; j < 4; ++j) { o[j] = *(const f32x4*)(ORAW + (size_t)lr * D + c + 4 * j); ss += o[j][0] * o[j][0] + o[j][1] * o[j][1] + o[j][2] * o[j][2] + o[j][3] * o[j][3]; }
            ss += __shfl_xor(ss, 1); ss += __shfl_xor(ss, 2); ss += __shfl_xor(ss, 4);
            const float rs = rsqrtf(ss * (1.f / 128.f) + 1e-6f);
            const u32x4 z0 = *(const u32x4*)(P + (size_t)lr * NPB + C_Z + c), z1 = *(const u32x4*)(P + (size_t)lr * NPB + C_Z + c + 8);
            const unsigned zz[8] = {z0.x, z0.y, z0.z, z0.w, z1.x, z1.y, z1.z, z1.w};
            unsigned ow[8];
#pragma unroll
            for (int j = 0; j < 8; ++j) { const float za = __uint_as_float(zz[j] << 16), zb = __uint_as_float(zz[j] & 0xffff0000u);
                const float a = o[j >> 1][(j & 1) * 2] * rs * nw[j >> 1][(j & 1) * 2] * silu_(za), b = o[j >> 1][(j & 1) * 2 + 1] * rs * nw[j >> 1][(j & 1) * 2 + 1] * silu_(zb);
                ow[j] = pk2(a, b); }
            *(u32x4*)(OA + grow * D + c) = (u32x4){ow[0], ow[1], ow[2], ow[3]}; *(u32x4*)(OA + grow * D + c + 8) = (u32x4){ow[4], ow[5], ow[6], ow[7]};
        }
    }
}

__device__ __forceinline__ void phase_final(const Params& p) {
    const int tid0 = otid(); const int lane = tid0 & 63; const int gw = obid() * 8 + (tid0 >> 6), NGW = gridDim.x * 8;
    const f32x4* wr = (const f32x4*)((const float*)(p.ws + WS_PK) + PK_LNF) + lane;
#pragma unroll 1
    for (int r = gw; r < XROWS + DECB * DECT; r += NGW) {
        f32x4* xr = (f32x4*)(p.out + (size_t)r * D) + lane;
        f32x4 v[4]; float ss = 0.f;
#pragma unroll
        for (int j = 0; j < 4; ++j) { v[j] = xr[64 * j]; ss += v[j][0] * v[j][0] + v[j][1] * v[j][1] + v[j][2] * v[j][2] + v[j][3] * v[j][3]; }
        const float rs = rsqrtf(wave_sum(ss) * (1.f / D) + 1e-6f);
#pragma unroll
        for (int j = 0; j < 4; ++j) xr[64 * j] = v[j] * rs * wr[64 * j];
    }
}

__global__ __launch_bounds__(512, 2) void hybrid_mega(Params p) {
    extern __shared__ __attribute__((aligned(16))) unsigned char smem[];
    cg::grid_group grid = cg::this_grid();
    LAS unsigned char* lds = (LAS unsigned char*)smem;
    const int G = gridDim.x;
    volatile LAS unsigned* xst = (volatile LAS unsigned*)(lds + (LDS_TOTAL - 16));
    if (threadIdx.x == 0) { xst[0] = 0u; xst[1] = 0u; }
    __syncthreads();
    (void)xcd_barrier_post((unsigned*)(p.ws + WS_BAR), xst);
    if (G == 0x7fffffff) grid.sync();
#define GSYNC() do { XcdBarrier xb_; xb_.bar = (unsigned*)(p.ws + WS_BAR); xb_.x = xb_xcc_id(); xb_.st = (volatile LAS unsigned*)((LAS unsigned char*)smem + (LDS_TOTAL - 16)); xcd_barrier(xb_); } while (0)

#ifndef ONLY
#define ONLY 0
#endif
#define EN(x) (ONLY == 0 || ONLY == (x))
    if (EN(1)) phase0(p, smem);
    GSYNC();
#pragma unroll 1
    for (int it = 0; it <= NSEG; ++it) {
        if (it > 0 && EN(3)) phase2(p, it - 1, smem);
        if (it < NSEG && EN(2)) {
            const int seg = it;
            const int cidx = it > 0 ? (obid() + (G >> 1)) % G : obid();
            SchedIn S; S.ob.init(seg == 0 ? LT_PROMPT + 3 : LT_PROMPT, NT_IN, G, cidx); S.seg = seg; S.A = (const char*)(p.ws + WS_H); S.B = (const char*)(p.ws + WS_WT_IN);
            EpiIn E; E.P = (bf16_t*)(p.ws + WS_P); E.gex = (bf16_t*)(p.ws + WS_GEX); E.out = p.out; E.seg = seg;
            pg8::gemm_phase<EpiIn, SchedIn>(lds, D, S, E);
        }
        GSYNC();
        if (it < NSEG) {
            if (EN(8)) { phase_gprep(p, it, smem); phase_rprep(p, it, smem); }
            if (it == 1 && EN(4)) phase25(p, 0);
            GSYNC();
        }
    }
    if (EN(5)) {
        SchedAB S; S.ob.init(HTILES, 4, G, obid()); S.A0 = (const char*)(p.ws + WS_H); S.A1 = (const char*)(p.ws + WS_OB); S.B0 = (const char*)(p.ws + WS_WT_A); S.B1 = (const char*)(p.ws + WS_WT_B);
        EpiAB E; E.tmp = (float*)(p.ws + WS_P); E.merged = (bf16_t*)(p.ws + WS_MG); E.gex = (const bf16_t*)(p.ws + WS_GEX); E.out = p.out;
        pg8::gemm_phase<EpiAB, SchedAB>(lds, D, S, E);
    }
    GSYNC();
    if (EN(6)) {
        SchedO S; S.ob.init(HTILES, 4, G, obid()); S.A = (const char*)(p.ws + WS_MG); S.B = (const char*)(p.ws + WS_WT_O);
        EpiO E; E.out = p.out; E.xp = p.in[0]; E.xs = p.in[1];
        pg8::gemm_phase<EpiO, SchedO>(lds, D, S, E);
    }
    GSYNC();
    if (EN(7)) phase_final(p);
}

extern "C" void kernel_launch(void* const* d_in, const int* in_sizes, int n_in, void* d_out, int out_size, void* d_ws, size_t ws_size, hipStream_t stream) {
    static int grid_blocks = 0;
    constexpr int LDS_BYTES = LDS_TOTAL;
    if (grid_blocks == 0) {
        if (n_in != 27 || ws_size < WS_END) { fprintf(stderr, "kernel_launch: unexpected n_in %d / ws %zu (need %zu)\n", n_in, ws_size, (size_t)WS_END); grid_blocks = -1; return; }
        if (hipFuncSetAttribute((const void*)hybrid_mega, hipFuncAttributeMaxDynamicSharedMemorySize, LDS_BYTES) != hipSuccess) { fprintf(stderr, "kernel_launch: hipFuncSetAttribute failed\n"); grid_blocks = -1; return; }
        int dev = 0, cus = 0, per_cu = 0;
        hipGetDevice(&dev);
        hipDeviceGetAttribute(&cus, hipDeviceAttributeMultiprocessorCount, dev);
        hipOccupancyMaxActiveBlocksPerMultiprocessor(&per_cu, (const void*)hybrid_mega, 512, LDS_BYTES);
        if (per_cu < 1) { fprintf(stderr, "kernel_launch: occupancy query says %d blocks/CU\n", per_cu); per_cu = 1; }
        (void)hipGetLastError();
        grid_blocks = cus;
    }
    if (grid_blocks < 0) return;
    Params p{};
    for (int i = 0; i < 27; ++i) p.in[i] = (const float*)d_in[i];
    p.out = (float*)d_out; p.ws = (unsigned char*)d_ws;
    if (hipMemsetAsync((unsigned char*)d_ws + WS_BAR, 0, 16384, stream) != hipSuccess) { fprintf(stderr, "kernel_launch: memset of the barrier words failed\n"); return; }
    void* args[] = {&p};
    hipError_t e = hipLaunchCooperativeKernel((const void*)hybrid_mega, dim3(grid_blocks), dim3(512), args, LDS_BYTES, stream);
    if (e != hipSuccess) fprintf(stderr, "cooperative launch failed: %s (grid %d)\n", hipGetErrorString(e), grid_blocks);
}
```

```cpp
#include <hip/hip_runtime.h>
#include <hip/hip_cooperative_groups.h>
#include <cstdio>
namespace cg = cooperative_groups;

#define LAS __attribute__((address_space(3)))
typedef unsigned short bf16_t;
typedef short bf16x8 __attribute__((ext_vector_type(8)));
typedef float f32x4 __attribute__((ext_vector_type(4)));
typedef unsigned u32x4 __attribute__((ext_vector_type(4)));
typedef unsigned u32x2 __attribute__((ext_vector_type(2)));

constexpr int D = 1024;
constexpr int NBATCH = 8, SEQ = 2048, NMETA = 16, DECB = 128, DECT = 4;
constexpr int XROWS = NBATCH * SEQ;
constexpr int EX_SAMP = 16, EX_SHIFT = 528, EX_END = 656;
constexpr int HROWS = 17152, HTILES = 67;
constexpr int NSEG = 8, SEGTOK = SEQ / NSEG;
constexpr int CPS = SEGTOK / 64;
constexpr int TPB = SEGTOK / 256;
constexpr int LT_PROMPT = NBATCH * TPB;
constexpr int LEX0 = LT_PROMPT * 256;
constexpr int LROWS = LEX0 + 768;
constexpr int NP = 10496, NPB = 8448, NT_IN = 41, NT_PB = 33;
constexpr int C_A = 3072, C_B = 3080, C_Z = 3088, C_RW = 4112, C_GATE_REF = 8336;
constexpr int RW_SHIFT = 4224;

constexpr size_t O_YP = 0, O_YS = 16777216, O_GDN_P = 17301504, O_CONV_P = 18350080, O_RWKV_P = 18423808, O_SHIFT_P = 18948096,
                 O_GDN_S = 18956288, O_CONV_S = 35733504, O_RWKV_S = 36913152, O_SHIFT_S = 45301760;

constexpr size_t al256(size_t x) { return (x + 255) & ~(size_t)255; }
constexpr size_t WS_WT_IN = 0;
constexpr size_t WS_WT_A = al256(WS_WT_IN + (size_t)NP * D * 2);
constexpr size_t WS_WT_B = al256(WS_WT_A + (size_t)D * D * 2);
constexpr size_t WS_WT_O = al256(WS_WT_B + (size_t)D * D * 2);
constexpr size_t WS_H = al256(WS_WT_O + (size_t)D * D * 2);
constexpr size_t WS_OB = al256(WS_H + (size_t)HROWS * D * 2);
constexpr size_t WS_P = al256(WS_OB + (size_t)HROWS * D * 2);
constexpr size_t WS_ORAW = al256(WS_P + (size_t)LROWS * NPB * 2);
constexpr size_t WS_YRAW = al256(WS_ORAW + (size_t)LROWS * D * 4);
constexpr size_t WS_C0 = al256(WS_YRAW + (size_t)LROWS * D * 4);
constexpr size_t WS_C1 = al256(WS_C0 + (size_t)LROWS * D * 2);
constexpr size_t WS_GEX = al256(WS_C1 + (size_t)LROWS * D * 2);
constexpr size_t WS_CHALO = al256(WS_GEX + (size_t)768 * 2048 * 2);
constexpr size_t WS_PHALO = al256(WS_CHALO + (size_t)2 * NBATCH * 3 * NPB * 2);
constexpr size_t WS_PK = al256(WS_PHALO + (size_t)2 * NBATCH * NPB * 2);
constexpr int PK_CONVW = 0, PK_ALOG = 12288, PK_DTB = 12296, PK_NORMW = 12304, PK_MU = 12432, PK_W0 = 16656, PK_W2 = 17680, PK_A0 = 83216, PK_A2 = 84240,
              PK_KK = 149776, PK_KA = 150800, PK_RK = 151824, PK_GNW = 152848, PK_GNB = 153872, PK_LNF = 154896, PK_END = 155920;
constexpr size_t WS_BAR = al256(WS_PK + (size_t)PK_END * 4);
constexpr size_t WS_W2T = al256(WS_BAR + 16384);
constexpr size_t WS_A2T = al256(WS_W2T + 131072);
constexpr size_t WS_GP = al256(WS_A2T + 131072);
constexpr int GP_AP = 0, GP_QH = 32768, GP_KH = 49152, GP_OH = 81920, GP_EGL = 98304, GP_G = 98560, GP_STRIDE = 114944;
constexpr int RP_AP = 0, RP_RH = 8192, RP_KH = 16384, RP_YH = 24576, RP_C1 = 32768, RP_C0 = 40960, RP_PC = 49152, RP_STRIDE = 49408;
constexpr size_t WS_RP = al256(WS_GP + (size_t)(CPS + 1) * 64 * GP_STRIDE);
constexpr size_t WS_END = al256(WS_RP + (size_t)(CPS + 1) * 128 * RP_STRIDE);
constexpr size_t WS_MG = WS_GP;
static_assert((size_t)HROWS * D * 2 <= WS_END - WS_GP, "MERGED must fit in the prep records");
static_assert((size_t)HROWS * D * 4 <= (size_t)LROWS * NPB * 2 + 2 * (size_t)LROWS * D * 4, "TMP must fit in P+ORAW+YRAW");
static_assert(WS_END <= (size_t)268435456, "workspace");

constexpr int LDS_TOTAL = 163840;
struct Params { const float* in[27]; float* out; unsigned char* ws; };

__device__ __forceinline__ float bf2f(bf16_t v) { return __uint_as_float(((unsigned)v) << 16); }
typedef __bf16 bf16n2 __attribute__((ext_vector_type(2)));
typedef float f32n2 __attribute__((ext_vector_type(2)));
__device__ __forceinline__ unsigned cvt_pk_bf16(float lo, float hi) { const f32n2 v = {lo, hi}; return __builtin_bit_cast(unsigned, __builtin_convertvector(v, bf16n2)); }
__device__ __forceinline__ unsigned pk2(float lo, float hi) { return cvt_pk_bf16(lo, hi); }
__device__ __forceinline__ unsigned f2bf(float f) { return cvt_pk_bf16(f, 0.f) & 0xffffu; }
__device__ __forceinline__ float sigm(float x) { return __builtin_amdgcn_rcpf(1.f + __expf(-x)); }
__device__ __forceinline__ float silu_(float x) { return x * __builtin_amdgcn_rcpf(1.f + __expf(-x)); }
__device__ __forceinline__ float softplus_(float x) { return fmaxf(x, 0.f) + log1pf(expf(-fabsf(x))); }
__device__ __forceinline__ float wave_sum(float v) {
#pragma unroll
    for (int o = 1; o < 64; o <<= 1) v += __shfl_xor(v, o);
    return v;
}
__device__ __forceinline__ int otid() { int t = threadIdx.x; asm volatile("" : "+v"(t)); return t; }
__device__ __forceinline__ int obid() { int t = blockIdx.x; asm volatile("" : "+s"(t)); return t; }
__device__ __forceinline__ float tanh_(float x) { const float e = __expf(2.f * x); return 1.f - 2.f * __builtin_amdgcn_rcpf(e + 1.f); }
template <int CTRL> __device__ __forceinline__ float dppf(float x) { return __builtin_bit_cast(float, __builtin_amdgcn_mov_dpp(__builtin_bit_cast(int, x), CTRL, 0xf, 0xf, true)); }
__device__ __forceinline__ float rowsum16(float x) { x += dppf<0x128>(x); x += dppf<0x124>(x); x += dppf<0x122>(x); x += dppf<0x121>(x); return x; }


#define XB_TMO      128
#define XB_XCNT(j)  (256  + 64 * (j))
#define XB_XSUB(j)  (1280 + 64 * (j))
#define XB_XGEN(j)  (2304 + 64 * (j))
#define XB_TOP      3328
#define XB_TOPGEN   3392
#define XCD_BAR_WORDS 3456
#define XB_SPIN_CAP (1u << 22)
__device__ __forceinline__ unsigned xb_ld(unsigned* p)              { return __hip_atomic_load(p, __ATOMIC_RELAXED, __HIP_MEMORY_SCOPE_AGENT); }
__device__ __forceinline__ unsigned xb_add(unsigned* p, unsigned v) { return __hip_atomic_fetch_add(p, v, __ATOMIC_RELAXED, __HIP_MEMORY_SCOPE_AGENT); }
__device__ __forceinline__ unsigned xb_xcc_id() { return (unsigned)__builtin_amdgcn_s_getreg((3 << 11) | 20) & 0xFu; }
#define XB_SPIN(cond, bar) do { unsigned _sp = 0; while (cond) { __builtin_amdgcn_s_sleep(1); \
    if ((++_sp & 255u) == 0u) { if (xb_ld(&(bar)[XB_TMO])) break; if (_sp > XB_SPIN_CAP) { atomicAdd(&(bar)[XB_TMO], 1u); break; } } } } while (0)
struct XcdBarrier { unsigned* bar; unsigned x; volatile LAS unsigned* st; };
__device__ __forceinline__ XcdBarrier xcd_barrier_post(unsigned* bar, volatile LAS unsigned* st) {
    XcdBarrier b; b.bar = bar; b.x = xb_xcc_id(); b.st = st;
    if (threadIdx.x == 0) (void)xb_add(&bar[XB_XCNT(b.x)], 1u);
    return b;
}
__device__ __forceinline__ void xcd_barrier_complete(unsigned* bar, unsigned x, unsigned& nloc, unsigned& nx) {
    const unsigned G = gridDim.x * gridDim.y * gridDim.z;
    unsigned sum, cnt, mine, sp = 0u;
    for (;;) {
        sum = 0u; cnt = 0u; mine = 0u;
#pragma unroll
        for (unsigned j = 0; j < 16; ++j) { const unsigned c = xb_ld(&bar[XB_XCNT(j)]); sum += c; cnt += (c > 0u) ? 1u : 0u; mine = (j == x) ? c : mine; }
        if (sum == G) break;
        __builtin_amdgcn_s_sleep(1);
        if ((++sp & 255u) == 0u) { if (xb_ld(&bar[XB_TMO])) break; if (sp > XB_SPIN_CAP) { atomicAdd(&bar[XB_TMO], 1u); break; } }
    }
    nloc = mine > 0u ? mine : 1u; nx = cnt > 0u ? cnt : 1u;
}
__device__ __forceinline__ void xcd_barrier(const XcdBarrier& b) {
    asm volatile("s_waitcnt vmcnt(0)" ::: "memory");
    __syncthreads();
    if (threadIdx.x == 0) {
        unsigned* bar = b.bar;
        __builtin_amdgcn_s_waitcnt(0);
        unsigned nloc = b.st[0], nx = b.st[1];
        if (nloc == 0u) { xcd_barrier_complete(bar, b.x, nloc, nx); b.st[0] = nloc; b.st[1] = nx; }
        const unsigned old = xb_add(&bar[XB_XSUB(b.x)], 1u);
        const unsigned gen = old / nloc;
        if (old + 1u == (gen + 1u) * nloc) {
            __builtin_amdgcn_fence(__ATOMIC_RELEASE, "agent");
            asm volatile("s_waitcnt vmcnt(0)" ::: "memory");
            const unsigned og = xb_add(&bar[XB_TOP], 1u);
            const unsigned tg = og / nx;
            if (og + 1u == (tg + 1u) * nx) xb_add(&bar[XB_TOPGEN], 1u);
            else XB_SPIN(xb_ld(&bar[XB_TOPGEN]) == tg, bar);
            __builtin_amdgcn_fence(__ATOMIC_ACQUIRE, "agent");
            xb_add(&bar[XB_XGEN(b.x)], 1u);
            asm volatile("s_waitcnt vmcnt(0)" ::: "memory");
        } else {
            XB_SPIN(xb_ld(&bar[XB_XGEN(b.x)]) == gen, bar);
            __builtin_amdgcn_fence(__ATOMIC_ACQUIRE, "agent");
            asm volatile("s_waitcnt vmcnt(0)" ::: "memory");
        }
    }
    __syncthreads();
}

namespace pg8 {
constexpr int BM = 256, BK = 64, HALF = 128, HTB = HALF * BK * 2, STAGE_BYTES = 8 * HTB, NXCD = 8, WGM = 8;
__device__ __forceinline__ int lds_byte(int r, int c) { const int st = (r >> 4) * 2 + (c >> 5), rr = r & 15, cc = c & 31, ob = rr * 64 + cc * 2; return st * 1024 + (ob ^ (((ob >> 9) & 1) << 5)); }
__device__ __forceinline__ void stage_rc(int b, int& R, int& C) { const int st = b / 1024, sb = b % 1024, swz = sb ^ (((sb >> 9) & 1) << 5); R = (st >> 1) * 16 + swz / 64; C = (st & 1) * 32 + (swz % 64) / 2; }
__device__ __forceinline__ int perm32(int rho) { const int n = rho >> 4, i = rho & 15; return 8 * (i >> 2) + 4 * n + (i & 3); }

struct Unit { int pm, pn, w; };
struct OrderBase {
    int nM, nN, nwg, G, c;
    __device__ void init(int nM_, int nN_, int G_, int c_) { nM = nM_; nN = nN_; nwg = nM * nN; G = G_; c = c_; }
    __device__ bool nextb(int i, Unit& u) const {
        const long L = (long)i * G + c; if (L >= nwg) return false;
        int wgid = (int)L; { const int q = nwg / NXCD, r = nwg % NXCD, xcd = wgid % NXCD, off = wgid / NXCD; wgid = (xcd < r ? xcd * (q + 1) : r * (q + 1) + (xcd - r) * q) + off; }
        const int nig = WGM * nN, gid = wgid / nig, fm = gid * WGM, gsz = (nM - fm) < WGM ? (nM - fm) : WGM;
        u.pm = fm + ((wgid % nig) % gsz); u.pn = (wgid % nig) / gsz; u.w = 0; return true;
    }
};

template <class Epi, class Sched>
__device__ __forceinline__ void gemm_phase(LAS unsigned char* lds, const int K, const Sched& S, const Epi& E) {
    const int tid = otid(), wid = __builtin_amdgcn_readfirstlane(tid >> 6), lane = tid & 63, wr = wid >> 2, wc = wid & 3, fr = lane & 15, fq = lane >> 4;
    const int nt = K / BK;
    unsigned voffA[2], voffB[2];
#pragma unroll
    for (int i = 0; i < 2; ++i) { int R, C; stage_rc(tid * 16 + i * 8192, R, C); const int Rb = Epi::PERM ? ((R & ~31) + perm32(R & 31)) : R;
        voffA[i] = (unsigned)(R * K + C) * 2u; voffB[i] = (unsigned)(Rb * K + C) * 2u; }
    const size_t kstep = (size_t)(BK * 2);
    const size_t hstep = (size_t)HALF * K * 2;
    const unsigned ldsw = (unsigned)wid * 1024u;
    const int aoff = lds_byte(wr * 64 + fr, fq * 8), boff = lds_byte(wc * 32 + fr, fq * 8);
#define PG8_SA(b, h) (((b) * 2 + (h)) * HTB)
#define PG8_SB(b, h) ((4 + (b) * 2 + (h)) * HTB)
#define PG8_STAGE(bufoff, gbase, voff) do { _Pragma("unroll") for (int _i = 0; _i < 2; ++_i) \
        __builtin_amdgcn_global_load_lds((const unsigned*)((const char*)(gbase) + (voff)[_i]), (LAS unsigned*)(lds + (bufoff) + ldsw + _i * 8192), 16, 0, 0); } while (0)
#define PG8_LDA(dst, b, h) do { _Pragma("unroll") for (int m = 0; m < 4; ++m) _Pragma("unroll") for (int k = 0; k < 2; ++k) dst[m][k] = *(const LAS bf16x8*)(lds + PG8_SA(b, h) + aoff + m * 2048 + k * 1024); } while (0)
#define PG8_LDB(dst, b, h) do { _Pragma("unroll") for (int n = 0; n < 2; ++n) _Pragma("unroll") for (int k = 0; k < 2; ++k) dst[n][k] = *(const LAS bf16x8*)(lds + PG8_SB(b, h) + boff + n * 2048 + k * 1024); } while (0)
#define PG8_MMA(ai, bj, At, Bt) do { __builtin_amdgcn_s_setprio(1); _Pragma("unroll") for (int m = 0; m < 4; ++m) _Pragma("unroll") for (int n = 0; n < 2; ++n) _Pragma("unroll") for (int k = 0; k < 2; ++k) \
        acc[ai][bj][m][n] = __builtin_amdgcn_mfma_f32_16x16x32_bf16(Bt[n][k], At[m][k], acc[ai][bj][m][n], 0, 0, 0); __builtin_amdgcn_s_setprio(0); } while (0)
#define PG8_WAIT_V(n) asm volatile("s_waitcnt vmcnt(" #n ")" ::: "memory")
#define PG8_WAIT_L(n) asm volatile("s_waitcnt lgkmcnt(" #n ")" ::: "memory")
#define PG8_BAR __builtin_amdgcn_s_barrier()
#define PG8_SCHED __builtin_amdgcn_sched_barrier(0)
    Unit cur, nxt; int ui = 0;
    if (!S.next(0, cur)) return;
    f32x4 acc[2][2][4][2];
#pragma unroll
    for (int a = 0; a < 2; ++a)
#pragma unroll
        for (int b = 0; b < 2; ++b)
#pragma unroll
            for (int m = 0; m < 4; ++m)
#pragma unroll
                for (int n = 0; n < 2; ++n) acc[a][b][m][n] = (f32x4){0.f, 0.f, 0.f, 0.f};
    bf16x8 At[4][2], B0[2][2], B1[2][2];
    const char* cA = S.a_ptr(cur); const char* cB = S.b_ptr(cur);
    PG8_STAGE(PG8_SB(0, 0), cB, voffB); PG8_STAGE(PG8_SA(0, 0), cA, voffA); PG8_STAGE(PG8_SB(0, 1), cB + hstep, voffB); PG8_STAGE(PG8_SA(0, 1), cA + hstep, voffA);
    if (wr == 1) PG8_BAR;
    PG8_WAIT_V(4); PG8_BAR;
    PG8_STAGE(PG8_SB(1, 0), cB + kstep, voffB); PG8_STAGE(PG8_SA(1, 0), cA + kstep, voffA); PG8_STAGE(PG8_SB(1, 1), cB + hstep + kstep, voffB);
    PG8_WAIT_V(6); PG8_BAR;
    for (;;) {
        const bool has_next = S.next(ui + 1, nxt);
        const char* nA = has_next ? S.a_ptr(nxt) : cA; const char* nB = has_next ? S.b_ptr(nxt) : cB;
        for (int t = 0; t < nt; t += 2) {
            const bool last = (t == nt - 2);
            const char* a1 = cA + (size_t)(t + 1) * kstep;
            const char* a2 = last ? nA : cA + (size_t)(t + 2) * kstep; const char* b2 = last ? nB : cB + (size_t)(t + 2) * kstep;
            const char* a3 = a2 + kstep; const char* b3 = b2 + kstep;
            PG8_LDB(B0, 0, 0); PG8_SCHED; PG8_LDA(At, 0, 0); PG8_STAGE(PG8_SA(1, 1), a1 + hstep, voffA);
            PG8_WAIT_L(8); PG8_BAR; PG8_WAIT_L(0); PG8_MMA(0, 0, At, B0); PG8_BAR; PG8_SCHED;
            PG8_LDB(B1, 0, 1); PG8_STAGE(PG8_SB(0, 0), b2, voffB);
            PG8_BAR; PG8_WAIT_L(0); PG8_MMA(0, 1, At, B1); PG8_BAR;
            PG8_LDA(At, 0, 1); PG8_STAGE(PG8_SA(0, 0), a2, voffA);
            PG8_BAR; PG8_WAIT_L(0); PG8_MMA(1, 0, At, B0); PG8_BAR; PG8_SCHED;
            PG8_STAGE(PG8_SB(0, 1), b2 + hstep, voffB);
            PG8_WAIT_V(6); PG8_BAR; PG8_MMA(1, 1, At, B1); PG8_BAR;
            PG8_LDB(B0, 1, 0); PG8_SCHED; PG8_LDA(At, 1, 0); PG8_STAGE(PG8_SA(0, 1), a2 + hstep, voffA);
            PG8_WAIT_L(8); PG8_BAR; PG8_WAIT_L(0); PG8_MMA(0, 0, At, B0); PG8_BAR; PG8_SCHED;
            PG8_LDB(B1, 1, 1); PG8_STAGE(PG8_SB(1, 0), b3, voffB);
            PG8_BAR; PG8_WAIT_L(0); PG8_MMA(0, 1, At, B1); PG8_BAR;
            PG8_LDA(At, 1, 1); PG8_STAGE(PG8_SA(1, 0), a3, voffA);
            PG8_BAR; PG8_WAIT_L(0); PG8_MMA(1, 0, At, B0); PG8_BAR; PG8_SCHED;
            PG8_STAGE(PG8_SB(1, 1), b3 + hstep, voffB);
            PG8_WAIT_V(6); PG8_BAR; PG8_MMA(1, 1, At, B1); PG8_BAR;
        }
        E(acc, cur, wr, wc, fr, fq);
        if (!has_next) break;
#pragma unroll
        for (int a = 0; a < 2; ++a)
#pragma unroll
            for (int b = 0; b < 2; ++b)
#pragma unroll
                for (int m = 0; m < 4; ++m)
#pragma unroll
                    for (int n = 0; n < 2; ++n) acc[a][b][m][n] = (f32x4){0.f, 0.f, 0.f, 0.f};
        cur = nxt; cA = nA; cB = nB; ++ui;
    }
    PG8_WAIT_V(0);
    if (wr == 0) PG8_BAR;
    PG8_BAR;
#undef PG8_SA
#undef PG8_SB
#undef PG8_STAGE
#undef PG8_LDA
#undef PG8_LDB
#undef PG8_MMA
#undef PG8_WAIT_V
#undef PG8_WAIT_L
#undef PG8_BAR
#undef PG8_SCHED
}
}
using pg8::Unit;

struct SchedIn {
    pg8::OrderBase ob; int seg; const char* A; const char* B;
    __device__ bool next(int i, Unit& u) const { return ob.nextb(i, u); }
    __device__ const char* a_ptr(const Unit& u) const {
        const int gt = u.pm < LT_PROMPT ? ((u.pm / TPB) * (SEQ / 256) + seg * TPB + (u.pm % TPB)) : (XROWS / 256 + (u.pm - LT_PROMPT));
        return A + (size_t)gt * 256 * D * 2; }
    __device__ const char* b_ptr(const Unit& u) const { return B + (size_t)u.pn * 256 * D * 2; }
};
struct SchedAB {
    pg8::OrderBase ob; const char* A0; const char* A1; const char* B0; const char* B1;
    __device__ bool next(int i, Unit& u) const { const bool ok = ob.nextb(i >> 1, u); u.w = i & 1; return ok; }
    __device__ const char* a_ptr(const Unit& u) const { return (u.w ? A1 : A0) + (size_t)u.pm * 256 * D * 2; }
    __device__ const char* b_ptr(const Unit& u) const { return (u.w ? B1 : B0) + (size_t)u.pn * 256 * D * 2; }
};
struct SchedO {
    pg8::OrderBase ob; const char* A; const char* B;
    __device__ bool next(int i, Unit& u) const { return ob.nextb(i, u); }
    __device__ const char* a_ptr(const Unit& u) const { return A + (size_t)u.pm * 256 * D * 2; }
    __device__ const char* b_ptr(const Unit& u) const { return B + (size_t)u.pn * 256 * D * 2; }
};

struct EpiIn {
    static constexpr bool PERM = true;
    bf16_t* P; bf16_t* gex; float* out; int seg;
    __device__ __forceinline__ void operator()(const f32x4 (&acc)[2][2][4][2], const Unit& u, int wr, int wc, int fr, int fq) const {
        const int lr0 = u.pm * 256 + wr * 64 + fr;
        const int c0 = u.pn * 256 + wc * 32 + 8 * fq;
#pragma unroll
        for (int ai = 0; ai < 2; ++ai)
#pragma unroll
            for (int m = 0; m < 4; ++m) {
                const int lr = lr0 + ai * 128 + m * 16;
                bf16_t* rowp;
                if (u.pn < NT_PB) rowp = P + (size_t)lr * NPB + c0;
                else if (lr < LEX0) { const int b = lr / SEGTOK; const size_t grow = (size_t)b * SEQ + seg * SEGTOK + (lr % SEGTOK); rowp = (bf16_t*)(out + O_YP + grow * D) + (c0 - NPB); }
                else rowp = gex + (size_t)(lr - LEX0) * 2048 + (c0 - NPB);
#pragma unroll
                for (int bj = 0; bj < 2; ++bj) { const f32x4 v0 = acc[ai][bj][m][0], v1 = acc[ai][bj][m][1];
                    u32x4 w; w.x = cvt_pk_bf16(v0[0], v0[1]); w.y = cvt_pk_bf16(v0[2], v0[3]); w.z = cvt_pk_bf16(v1[0], v1[1]); w.w = cvt_pk_bf16(v1[2], v1[3]);
                    *(u32x4*)(rowp + bj * 128) = w; }
            }
    }
};
struct EpiAB {
    static constexpr bool PERM = false;
    float* tmp; bf16_t* merged; const bf16_t* gex; const float* out;
    __device__ __forceinline__ void operator()(const f32x4 (&acc)[2][2][4][2], const Unit& u, int wr, int wc, int fr, int fq) const {
        const int row0 = u.pm * 256 + wr * 64 + fr, col0 = u.pn * 256 + wc * 32 + 4 * fq;
#pragma unroll
        for (int ai = 0; ai < 2; ++ai)
#pragma unroll
            for (int m = 0; m < 4; ++m) {
                const int grow = row0 + ai * 128 + m * 16;
                const bf16_t* gp = (grow < XROWS) ? ((const bf16_t*)(out + O_YP + (size_t)grow * D) + u.w * D) : (gex + (size_t)(grow - XROWS) * 2048 + u.w * D);
#pragma unroll
                for (int bj = 0; bj < 2; ++bj)
#pragma unroll
                    for (int n = 0; n < 2; ++n) {
                        const int c = col0 + bj * 128 + n * 16;
                        const u32x2 g = *(const u32x2*)(gp + c);
                        f32x4 v = acc[ai][bj][m][n];
                        v[0] *= sigm(__uint_as_float(g.x << 16)); v[1] *= sigm(__uint_as_float(g.x & 0xffff0000u));
                        v[2] *= sigm(__uint_as_float(g.y << 16)); v[3] *= sigm(__uint_as_float(g.y & 0xffff0000u));
                        float* tp = tmp + (size_t)grow * D + c;
                        if (u.w == 0) *(f32x4*)tp = v;
                        else { const f32x4 t = *(const f32x4*)tp; v = v + t; u32x2 o; o.x = cvt_pk_bf16(v[0], v[1]); o.y = cvt_pk_bf16(v[2], v[3]); *(u32x2*)(merged + (size_t)grow * D + c) = o; }
                    }
            }
    }
};
struct EpiO {
    static constexpr bool PERM = false;
    float* out; const float* xp; const float* xs;
    __device__ __forceinline__ void operator()(const f32x4 (&acc)[2][2][4][2], const Unit& u, int wr, int wc, int fr, int fq) const {
        const int row0 = u.pm * 256 + wr * 64 + fr, col0 = u.pn * 256 + wc * 32 + 4 * fq;
#pragma unroll
        for (int ai = 0; ai < 2; ++ai)
#pragma unroll
            for (int m = 0; m < 4; ++m) {
                const int grow = row0 + ai * 128 + m * 16;
                const float* xr; float* yr;
                if (grow < XROWS) { xr = xp + (size_t)grow * D; yr = out + O_YP + (size_t)grow * D; }
                else { const int e = grow - XROWS; if (e < EX_SAMP || e >= EX_SHIFT) continue; xr = xs + (size_t)(e - EX_SAMP) * D; yr = out + O_YS + (size_t)(e - EX_SAMP) * D; }
#pragma unroll
                for (int bj = 0; bj < 2; ++bj)
#pragma unroll
                    for (int n = 0; n < 2; ++n) { const int c = col0 + bj * 128 + n * 16; *(f32x4*)(yr + c) = *(const f32x4*)(xr + c) + acc[ai][bj][m][n]; }
            }
    }
};

__device__ __forceinline__ void p0_row(const Params& p, int r, int lane) {
    bf16_t* hrow = (bf16_t*)(p.ws + WS_H) + (size_t)r * D;
    const float* src = nullptr; bool norm = true; float* sh = nullptr;
    if (r < XROWS) { src = p.in[0] + (size_t)r * D; if ((r & (SEQ - 1)) == SEQ - 1) sh = p.out + O_SHIFT_P + (size_t)(r / SEQ) * D; }
    else { const int e = r - XROWS;
        if (e < EX_SAMP) src = p.in[6] + (size_t)e * D;
        else if (e < EX_SHIFT) { src = p.in[1] + (size_t)(e - EX_SAMP) * D; if (((e - EX_SAMP) & 3) == 3) sh = p.out + O_SHIFT_S + (size_t)((e - EX_SAMP) >> 2) * D; }
        else if (e < EX_END) { src = p.in[5] + (size_t)(e - EX_SHIFT) * D; norm = false; } }
    u32x2* o8 = (u32x2*)hrow + lane;
    if (!src) {
#pragma unroll
        for (int j = 0; j < 4; ++j) o8[64 * j] = (u32x2){0u, 0u};
        return; }
    const f32x4* xr = (const f32x4*)src + lane;
    f32x4 v[4]; float ss = 0.f;
#pragma unroll
    for (int j = 0; j < 4; ++j) { v[j] = xr[64 * j]; ss += v[j][0] * v[j][0] + v[j][1] * v[j][1] + v[j][2] * v[j][2] + v[j][3] * v[j][3]; }
    if (norm) {
        const float rs = __builtin_amdgcn_rsqf(wave_sum(ss) * (1.f / D) + 1e-6f);
        const f32x4* wr = (const f32x4*)p.in[7] + lane;
#pragma unroll
        for (int j = 0; j < 4; ++j) v[j] = v[j] * rs * wr[64 * j];
    }
#pragma unroll
    for (int j = 0; j < 4; ++j) { o8[64 * j] = (u32x2){pk2(v[j][0], v[j][1]), pk2(v[j][2], v[j][3])}; if (sh) ((f32x4*)sh)[lane + 64 * j] = v[j]; }
}
template <int MODE> __device__ __forceinline__ void p0_tr_item(const float* W, int N, bf16_t* WT, float* scr, int kb, int nb, int lane) {
    const int k0 = 64 * kb, n0 = 32 * nb;
    const int nn = n0 + (lane & 31);
    int srcc = nn;
    if (MODE == 1) srcc = nn < C_GATE_REF ? nn : (nn < NPB ? -1 : nn - (NPB - C_GATE_REF));
#pragma unroll 8
    for (int i = 0; i < 32; ++i) { const int kk = 2 * i + (lane >> 5); scr[kk * 33 + (lane & 31)] = srcc >= 0 ? W[(size_t)(k0 + kk) * N + srcc] : 0.f; }
    asm volatile("s_waitcnt lgkmcnt(0)" ::: "memory");
    const int c = lane & 7;
#pragma unroll
    for (int j = 0; j < 4; ++j) { const int n = (lane >> 3) + 8 * j; const float* s = scr + (8 * c) * 33 + n;
        u32x4 o; o.x = pk2(s[0 * 33], s[1 * 33]); o.y = pk2(s[2 * 33], s[3 * 33]); o.z = pk2(s[4 * 33], s[5 * 33]); o.w = pk2(s[6 * 33], s[7 * 33]);
        *(u32x4*)(WT + (size_t)(n0 + n) * D + k0 + 8 * c) = o; }
    asm volatile("s_waitcnt lgkmcnt(0)" ::: "memory");
}
__device__ __forceinline__ void phase0(const Params& p, unsigned char* smem) {
    const int tid0 = otid(), wave = tid0 >> 6, lane = tid0 & 63;
    const int gw = obid() * 8 + wave, NGW = gridDim.x * 8;
    float* scr = (float*)smem + wave * (64 * 33);
    constexpr int I_IN = 16 * (NP / 32), I_SQ = 16 * 32;
    for (int it = gw; it < I_IN + 3 * I_SQ; it += NGW) {
        int r = it;
        if (r < I_IN) { p0_tr_item<1>(p.in[8], 10384, (bf16_t*)(p.ws + WS_WT_IN), scr, r / (NP / 32), r % (NP / 32), lane); continue; } r -= I_IN;
        if (r < I_SQ) { p0_tr_item<0>(p.in[13], D, (bf16_t*)(p.ws + WS_WT_A), scr, r / 32, r % 32, lane); continue; } r -= I_SQ;
        if (r < I_SQ) { p0_tr_item<0>(p.in[24], D, (bf16_t*)(p.ws + WS_WT_B), scr, r / 32, r % 32, lane); continue; } r -= I_SQ;
        p0_tr_item<0>(p.in[25], D, (bf16_t*)(p.ws + WS_WT_O), scr, r / 32, r % 32, lane);
    }
    for (int r = gw; r < HROWS; r += NGW) p0_row(p, r, lane);
    {
        float* pk = (float*)(p.ws + WS_PK);
        const int gt = obid() * 512 + tid0, NT = gridDim.x * 512;
#define PKCOPY(off, idx, n) for (int i = gt; i < (n); i += NT) pk[(off) + i] = p.in[idx][i];
        PKCOPY(PK_CONVW, 9, 12288) PKCOPY(PK_ALOG, 10, 8) PKCOPY(PK_DTB, 11, 8) PKCOPY(PK_NORMW, 12, 128) PKCOPY(PK_MU, 14, 4224) PKCOPY(PK_W0, 15, 1024)
        PKCOPY(PK_W2, 16, 65536) PKCOPY(PK_A0, 17, 1024) PKCOPY(PK_A2, 18, 65536) PKCOPY(PK_KK, 19, 1024) PKCOPY(PK_KA, 20, 1024) PKCOPY(PK_RK, 21, 1024)
        PKCOPY(PK_GNW, 22, 1024) PKCOPY(PK_GNB, 23, 1024) PKCOPY(PK_LNF, 26, 1024)
#undef PKCOPY
        bf16_t* w2t = (bf16_t*)(p.ws + WS_W2T); bf16_t* a2t = (bf16_t*)(p.ws + WS_A2T);
        for (int i = gt; i < 65536; i += NT) { const int l = i & 63, c = (i >> 6) & 63, hb = i >> 12;
            w2t[i] = (bf16_t)f2bf(p.in[16][(size_t)l * D + hb * 64 + c]); a2t[i] = (bf16_t)f2bf(p.in[18][(size_t)l * D + hb * 64 + c]); }
    }
}

__device__ __forceinline__ void gdn_item(const Params& p, unsigned char* smem, const float* s_in, float* s_out, const float* halo_in, float* halo_out,
                                         int h, int sl, int rowA, int nA, int rowB, int nB) {
    const int tid = otid(), w = tid >> 6, lane = tid & 63, vl = lane >> 4, kg = lane & 15;
    float* qk_s = (float*)smem; float* v_s = qk_s + 16384; float* o_s = v_s + 2048; float* gb_s = o_s + 2048; float* sst = gb_s + 128;
    const bf16_t* P = (const bf16_t*)(p.ws + WS_P);
    float* ORAW = (float*)(p.ws + WS_ORAW);
    float s[8];
    if (s_in) {
        { const int k = tid >> 2, q4 = tid & 3; const f32x4* src = (const f32x4*)(s_in + (size_t)k * 128 + sl * 32 + q4 * 8); const f32x4 a = src[0], b = src[1];
          float* d = sst + k * 33 + q4 * 8; d[0] = a[0]; d[1] = a[1]; d[2] = a[2]; d[3] = a[3]; d[4] = b[0]; d[5] = b[1]; d[6] = b[2]; d[7] = b[3]; }
        __syncthreads();
#pragma unroll
        for (int j = 0; j < 8; ++j) s[j] = sst[(kg * 8 + j) * 33 + 4 * w + vl];
        __syncthreads();
    } else {
#pragma unroll
        for (int j = 0; j < 8; ++j) s[j] = 0.f;
    }
    int pcol = -1;
    if (tid < 128) pcol = h * 128 + tid; else if (tid < 256) pcol = 1024 + h * 128 + (tid - 128); else if (tid < 288) pcol = 2048 + h * 128 + sl * 32 + (tid - 256);
    float cw0 = 0.f, cw1 = 0.f, cw2 = 0.f, cw3 = 0.f, x1 = 0.f, x2 = 0.f, x3 = 0.f;
    const float* pk = (const float*)(p.ws + WS_PK);
    if (pcol >= 0) { const float* cw = pk + PK_CONVW; cw0 = cw[pcol]; cw1 = cw[3072 + pcol]; cw2 = cw[6144 + pcol]; cw3 = cw[9216 + pcol];
        if (halo_in) { x3 = halo_in[pcol]; x2 = halo_in[3072 + pcol]; x1 = halo_in[6144 + pcol]; } }
    const float nalog = -expf(pk[PK_ALOG + h]), dtb = pk[PK_DTB + h];
#pragma unroll 1
    for (int run = 0; run < 2; ++run) {
        const int rrow = run ? rowB : rowA, rn = run ? nB : nA; const bool wout = run != 0;
#pragma unroll 1
        for (int c0 = 0; c0 < rn; c0 += 64) {
            const int nt = (rn - c0) < 64 ? (rn - c0) : 64; const int row = rrow + c0;
            if (pcol >= 0) {
                const bf16_t* src = P + (size_t)row * NPB + pcol;
                float* dst = tid < 256 ? (qk_s + tid) : (v_s + (tid - 256)); const int dstride = tid < 256 ? 256 : 32;
#pragma unroll 8
                for (int i = 0; i < nt; ++i) { const float x0 = bf2f(src[(size_t)i * NPB]); const float y = cw0 * x3 + cw1 * x2 + cw2 * x1 + cw3 * x0; x3 = x2; x2 = x1; x1 = x0; dst[i * dstride] = silu_(y); }
            } else if (tid < 352) {
                const int i = tid - 288;
                if (i < nt) { const float pa = bf2f(P[(size_t)(row + i) * NPB + C_A + h]), pb = bf2f(P[(size_t)(row + i) * NPB + C_B + h]);
                    gb_s[2 * i] = expf(nalog * softplus_(pa + dtb)); gb_s[2 * i + 1] = sigm(pb); }
            }
            __syncthreads();
#pragma unroll 1
            for (int ii = 0; ii < 8; ++ii) { const int i = w * 8 + ii;
                if (i < nt) {
#pragma unroll
                    for (int which = 0; which < 2; ++which) { float* rp = qk_s + i * 256 + which * 128; const float a = rp[lane], b = rp[lane + 64];
                        const float sc = __builtin_amdgcn_rsqf(wave_sum(a * a + b * b) + 1e-6f) * (which == 0 ? 0.08838834764831845f : 1.f); rp[lane] = a * sc; rp[lane + 64] = b * sc; } } }
            __syncthreads();
#pragma unroll 1
            for (int i = 0; i < nt; ++i) {
                const f32x4 q0 = *(const f32x4*)(qk_s + i * 256 + kg * 8), q1 = *(const f32x4*)(qk_s + i * 256 + kg * 8 + 4);
                const f32x4 k0 = *(const f32x4*)(qk_s + i * 256 + 128 + kg * 8), k1 = *(const f32x4*)(qk_s + i * 256 + 128 + kg * 8 + 4);
                const float vv = v_s[i * 32 + 4 * w + vl], a = gb_s[2 * i], be = gb_s[2 * i + 1];
                float part = k0[0] * s[0] + k0[1] * s[1] + k0[2] * s[2] + k0[3] * s[3] + k1[0] * s[4] + k1[1] * s[5] + k1[2] * s[6] + k1[3] * s[7];
                const float kS = rowsum16(part);
                const float c = be * (vv - a * kS);
                s[0] = a * s[0] + k0[0] * c; s[1] = a * s[1] + k0[1] * c; s[2] = a * s[2] + k0[2] * c; s[3] = a * s[3] + k0[3] * c;
                s[4] = a * s[4] + k1[0] * c; s[5] = a * s[5] + k1[1] * c; s[6] = a * s[6] + k1[2] * c; s[7] = a * s[7] + k1[3] * c;
                float op = q0[0] * s[0] + q0[1] * s[1] + q0[2] * s[2] + q0[3] * s[3] + q1[0] * s[4] + q1[1] * s[5] + q1[2] * s[6] + q1[3] * s[7];
                const float o = rowsum16(op);
                if (kg == 0) o_s[i * 32 + 4 * w + vl] = o;
            }
            __syncthreads();
            if (wout) { const int i = tid >> 3, c4 = (tid & 7) * 4; if (i < nt) *(f32x4*)(ORAW + (size_t)(row + i) * D + h * 128 + sl * 32 + c4) = *(const f32x4*)(o_s + i * 32 + c4); }
        }
    }
    if (pcol >= 0 && (sl == 0 || tid >= 256)) { halo_out[pcol] = x3; halo_out[3072 + pcol] = x2; halo_out[6144 + pcol] = x1; }
#pragma unroll
    for (int j = 0; j < 8; ++j) sst[(kg * 8 + j) * 33 + 4 * w + vl] = s[j];
    __syncthreads();
    { const int k = tid >> 2, q4 = tid & 3; const float* d = sst + k * 33 + q4 * 8; f32x4* dst = (f32x4*)(s_out + (size_t)k * 128 + sl * 32 + q4 * 8);
      dst[0] = (f32x4){d[0], d[1], d[2], d[3]}; dst[1] = (f32x4){d[4], d[5], d[6], d[7]}; }
    __syncthreads();
}

constexpr int RW_W2 = 20544, RW_A2 = 24640;
__device__ __forceinline__ void rwkv_load_lora(const Params& p, unsigned char* smem, int hb) {
    float* w2_s = (float*)smem + RW_W2; float* a2_s = (float*)smem + RW_A2; const float* pk = (const float*)(p.ws + WS_PK);
    for (int i = otid(); i < 4096; i += 512) { const int l = i >> 6, c = i & 63; w2_s[i] = pk[PK_W2 + l * D + hb * 64 + c]; a2_s[i] = pk[PK_A2 + l * D + hb * 64 + c]; }
    __syncthreads();
}
__device__ __forceinline__ void rwkv_item(const Params& p, unsigned char* smem, const float* s_in, float* s_out, const bf16_t* prev_row, const float* halo_in, float* halo_out,
                                          int hb, int half, int rowA, int nA, int rowB, int nB) {
    const int tid = otid(), w = tid >> 6, lane = tid & 63, row = tid >> 4, kq = tid & 15;
    float* f = (float*)smem;
    float* r_s = f; float* kb_s = f + 2048; float* v_s = f + 4096; float* wd_s = f + 6144; float* ad_s = f + 8192; float* dec_s = f + 10240; float* a_s = f + 12288;
    float* kk_s = f + 14336; float* km_s = f + 16384; float* zb_s = f + 18432; float* y_s = f + 19456; float* bonus_s = f + 20480;
    const float* w2_s = f + RW_W2; const float* a2_s = f + RW_A2;
    const bf16_t* P = (const bf16_t*)(p.ws + WS_P);
    float* YRAW = (float*)(p.ws + WS_YRAW); bf16_t* C0 = (bf16_t*)(p.ws + WS_C0); bf16_t* C1 = (bf16_t*)(p.ws + WS_C1);
    float s[4];
    if (s_in) { const f32x4 t = *(const f32x4*)(s_in + (size_t)(half * 32 + row) * 64 + kq * 4); s[0] = t[0]; s[1] = t[1]; s[2] = t[2]; s[3] = t[3]; }
    else { s[0] = s[1] = s[2] = s[3] = 0.f; }
    int col = -1; float* dst = nullptr; int dstride = 64; bool is_wd = false, owner = false;
    if (tid < 64) { col = hb * 64 + tid; dst = r_s + tid; owner = half == 0; }
    else if (tid < 128) { col = 1024 + hb * 64 + (tid - 64); dst = kb_s + (tid - 64); owner = half == 0; }
    else if (tid < 192) { col = 2048 + hb * 64 + (tid - 128); dst = v_s + (tid - 128); owner = half == 0; }
    else if (tid < 256) { col = 3072 + (tid - 192); dst = wd_s + (tid - 192); is_wd = true; owner = (half == 0 && hb == 0); }
    else if (tid < 320) { col = 3136 + (tid - 256); dst = ad_s + (tid - 256); owner = (half == 0 && hb == 0); }
    else if (tid < 352) { col = 3200 + hb * 64 + half * 32 + (tid - 320); dst = zb_s + (tid - 320); dstride = 32; owner = true; }
    float mu = 0.f, prev = 0.f;
    const float* pk = (const float*)(p.ws + WS_PK);
    if (col >= 0) { mu = pk[PK_MU + col]; prev = prev_row ? bf2f(prev_row[C_RW + col]) : (halo_in ? halo_in[col] : 0.f); }
    const int cc = tid & 63, ig = tid >> 6;
    const int hc = hb * 64 + cc;
    const float w0c = pk[PK_W0 + hc], a0c = pk[PK_A0 + hc], kkc = pk[PK_KK + hc], kac = pk[PK_KA + hc];
    const float rkl = pk[PK_RK + hb * 64 + lane];
#pragma unroll 1
    for (int run = 0; run < 2; ++run) {
        const int rrow = run ? rowB : rowA, rn = run ? nB : nA; const bool wout = run != 0;
#pragma unroll 1
        for (int c0 = 0; c0 < rn; c0 += 32) {
            const int nt = (rn - c0) < 32 ? (rn - c0) : 32; const int row0 = rrow + c0;
            if (col >= 0) {
                const bf16_t* src = P + (size_t)row0 * NPB + C_RW + col;
#pragma unroll 8
                for (int i = 0; i < nt; ++i) { const float cur = bf2f(src[(size_t)i * NPB]); float m = cur + mu * (prev - cur); prev = cur; if (is_wd) m = tanh_(m); dst[i * dstride] = m; }
            }
            __syncthreads();
            {
                float aw[4] = {0.f, 0.f, 0.f, 0.f}, aa[4] = {0.f, 0.f, 0.f, 0.f};
#pragma unroll 4
                for (int l = 0; l < 64; ++l) { const float w2v = w2_s[l * 64 + cc], a2v = a2_s[l * 64 + cc];
#pragma unroll
                    for (int ii = 0; ii < 4; ++ii) { aw[ii] += wd_s[(ig * 4 + ii) * 64 + l] * w2v; aa[ii] += ad_s[(ig * 4 + ii) * 64 + l] * a2v; } }
#pragma unroll
                for (int ii = 0; ii < 4; ++ii) { const int i = ig * 4 + ii;
                    if (i < nt) { const float wraw = w0c + aw[ii]; const float wlog = -0.6065306597126334f * sigm(wraw); const float a = sigm(a0c + aa[ii]);
                        const float kbv = kb_s[i * 64 + cc];
                        dec_s[i * 64 + cc] = expf(wlog); a_s[i * 64 + cc] = a; kk_s[i * 64 + cc] = kbv * kkc; km_s[i * 64 + cc] = kbv * (1.f + (a - 1.f) * kac); } }
            }
            __syncthreads();
#pragma unroll 1
            for (int ii = 0; ii < 4; ++ii) { const int i = w * 4 + ii;
                if (i < nt) { const float kkr = kk_s[i * 64 + lane]; const float kk = kkr * __builtin_amdgcn_rsqf(wave_sum(kkr * kkr) + 1e-6f); kk_s[i * 64 + lane] = kk;
                    const float a = a_s[i * 64 + lane]; a_s[i * 64 + lane] = kk * a;
                    const float rk = wave_sum(r_s[i * 64 + lane] * km_s[i * 64 + lane] * rkl); if (lane == 0) bonus_s[i] = rk; } }
            __syncthreads();
#pragma unroll 1
            for (int i = 0; i < nt; ++i) {
                const f32x4 kk4 = *(const f32x4*)(kk_s + i * 64 + kq * 4), de4 = *(const f32x4*)(dec_s + i * 64 + kq * 4), ka4 = *(const f32x4*)(a_s + i * 64 + kq * 4),
                            km4 = *(const f32x4*)(km_s + i * 64 + kq * 4), r4 = *(const f32x4*)(r_s + i * 64 + kq * 4);
                const float vv = v_s[i * 64 + half * 32 + row];
                const float sa = rowsum16(s[0] * kk4[0] + s[1] * kk4[1] + s[2] * kk4[2] + s[3] * kk4[3]);
#pragma unroll
                for (int j = 0; j < 4; ++j) s[j] = s[j] * de4[j] + (vv * km4[j] - sa * ka4[j]);
                const float y = rowsum16(s[0] * r4[0] + s[1] * r4[1] + s[2] * r4[2] + s[3] * r4[3]);
                if (kq == 0) y_s[i * 32 + row] = y;
            }
            __syncthreads();
            if (wout) { const int i = tid >> 4;
                if (i < nt) {
#pragma unroll
                    for (int q = 0; q < 2; ++q) { const int rr = (tid & 15) * 2 + q, v = half * 32 + rr, colo = hb * 64 + v;
                        const float sz = silu_(zb_s[i * 32 + rr]);
                        const size_t o = (size_t)(row0 + i) * D + colo;
                        YRAW[o] = y_s[i * 32 + rr]; C1[o] = (bf16_t)f2bf(pk[PK_GNW + colo] * sz); C0[o] = (bf16_t)f2bf((pk[PK_GNB + colo] + bonus_s[i] * v_s[i * 64 + v]) * sz); } } }
            __syncthreads();
        }
    }
    *(f32x4*)(s_out + (size_t)(half * 32 + row) * 64 + kq * 4) = (f32x4){s[0], s[1], s[2], s[3]};
    if (col >= 0 && owner && halo_out) halo_out[col] = prev;
}


__device__ __forceinline__ bf16x8 ldfrag(const bf16_t* base, int stride, int r0, int k0, int lane) {
    return *(const bf16x8*)(base + (r0 + (lane & 15)) * stride + k0 + 8 * (lane >> 4));
}
#define MFMA16(a, b, c) __builtin_amdgcn_mfma_f32_16x16x32_bf16((a), (b), (c), 0, 0, 0)
typedef short s16x4 __attribute__((ext_vector_type(4)));
__device__ __forceinline__ bf16x8 ldfrag_tr(const bf16_t* X, int stride, int c0, int k0, int lane) {
    const int l15 = lane & 15;
    const bf16_t* a = X + (k0 + 8 * (lane >> 4) + (l15 >> 2)) * stride + c0 + 4 * (l15 & 3);
    const s16x4 lo = __builtin_amdgcn_ds_read_tr16_b64_v4i16((LAS s16x4*)a), hi = __builtin_amdgcn_ds_read_tr16_b64_v4i16((LAS s16x4*)(a + 4 * stride));
    return __builtin_shufflevector(lo, hi, 0, 1, 2, 3, 4, 5, 6, 7);
}
__device__ __forceinline__ void inv_block(const float* L, float* Tm, float* XS, int tid) {
    const int w = tid >> 6, lane = tid & 63;
    if (w < 4 && lane < 16) {
        const float* Lb = L + (16 * w) * 64 + 16 * w; float* Tb = Tm + (16 * w) * 64 + 16 * w;
        float tr[16];
#pragma unroll
        for (int i = 0; i < 16; ++i) { float a = (lane == i) ? 1.f : 0.f;
#pragma unroll
            for (int j = 0; j < i; ++j) a -= Lb[i * 64 + j] * tr[j];
            tr[i] = a; Tb[i * 64 + lane] = a; }
    }
    for (int e = tid; e < 1536; e += 512) { const int k = e >> 8, r = (e >> 4) & 15, c = e & 15;
        const int rb = k < 3 ? 0 : (k < 5 ? 1 : 2), cb = k < 3 ? k + 1 : (k < 5 ? k - 1 : 3);
        Tm[(16 * rb + r) * 64 + 16 * cb + c] = 0.f; }
    __syncthreads();
    {
        const int B = tid >> 8, i = (tid >> 4) & 15, c = tid & 15, o = 32 * B;
        float x = 0.f;
#pragma unroll
        for (int j = 0; j < 16; ++j) x += L[(o + 16 + i) * 64 + o + j] * Tm[(o + j) * 64 + o + c];
        XS[tid] = x;
        __syncthreads();
        float t = 0.f;
#pragma unroll
        for (int j = 0; j < 16; ++j) t += Tm[(o + 16 + i) * 64 + o + 16 + j] * XS[(B << 8) + j * 16 + c];
        Tm[(o + 16 + i) * 64 + o + c] = -t;
    }
    __syncthreads();
    {
        const int i = tid >> 4, c2 = (tid & 15) * 2;
        float x0 = 0.f, x1 = 0.f;
#pragma unroll 8
        for (int j = 0; j < 32; ++j) { const float l = L[(32 + i) * 64 + j]; x0 += l * Tm[j * 64 + c2]; x1 += l * Tm[j * 64 + c2 + 1]; }
        XS[i * 32 + c2] = x0; XS[i * 32 + c2 + 1] = x1;
        __syncthreads();
        float t0 = 0.f, t1 = 0.f;
#pragma unroll 8
        for (int j = 0; j < 32; ++j) { const float tv = Tm[(32 + i) * 64 + 32 + j]; t0 += tv * XS[j * 32 + c2]; t1 += tv * XS[j * 32 + c2 + 1]; }
        Tm[(32 + i) * 64 + c2] = -t0; Tm[(32 + i) * 64 + c2 + 1] = -t1;
    }
    __syncthreads();
}
__device__ __forceinline__ void unpack8(const u32x4 rw, float (&x)[8]) {
    x[0] = __uint_as_float(rw.x << 16); x[1] = __uint_as_float(rw.x & 0xffff0000u); x[2] = __uint_as_float(rw.y << 16); x[3] = __uint_as_float(rw.y & 0xffff0000u);
    x[4] = __uint_as_float(rw.z << 16); x[5] = __uint_as_float(rw.z & 0xffff0000u); x[6] = __uint_as_float(rw.w << 16); x[7] = __uint_as_float(rw.w & 0xffff0000u); }
__device__ __forceinline__ u32x4 pack8(const float (&x)[8]) { return (u32x4){pk2(x[0], x[1]), pk2(x[2], x[3]), pk2(x[4], x[5]), pk2(x[6], x[7])}; }

constexpr int PL_QS = 0, PL_R1 = 17408, PL_KT = 35840, PL_KTT = 54272, PL_VT = 72704, PL_R3 = 91136, PL_QKM = 109568, PL_TP = 118784, PL_TPP = 128000, PL_SM = 137216, PL_TM = 139264, PL_XS = 155648;
constexpr int QSTR = 136, TSTR = 72;

__device__ __forceinline__ void gdn_prep_item(const Params& p, unsigned char* smem, int h, int row_start, int npad, const bf16_t* hbase,
                                              bf16_t* halo_out, float* conv_out, unsigned char* rec) {
    const int tid = otid(), w = tid >> 6, lane = tid & 63, q4 = lane >> 4, l15 = lane & 15;
    bf16_t* qs = (bf16_t*)(smem + PL_QS); bf16_t* ks = (bf16_t*)(smem + PL_R1); bf16_t* WT = ks; bf16_t* kts = (bf16_t*)(smem + PL_KT);
    bf16_t* vs = (bf16_t*)(smem + PL_VT);         float* Lm = (float*)(smem + PL_R3); bf16_t* UT = (bf16_t*)(smem + PL_R3); bf16_t* QKm = (bf16_t*)(smem + PL_QKM);
    bf16_t* Tp = (bf16_t*)(smem + PL_TP); bf16_t* Tpp = (bf16_t*)(smem + PL_TPP);
    float* sm = (float*)(smem + PL_SM);
    float* gcs = sm; float* bes = sm + 64; float* ssq = sm + 128; float* ssk = sm + 192; float* egs = sm + 256; float* egl_s = sm + 320; float* beg = sm + 384;
    const bf16_t* P = (const bf16_t*)(p.ws + WS_P);
    const float* pk = (const float*)(p.ws + WS_PK);
    if (npad == 0) {
        const int t = tid >> 3, g = tid & 7;
        const bf16_t* zp = P + (size_t)(row_start + t) * NPB + C_Z + h * 128 + 16 * g;
        const u32x4 z0 = *(const u32x4*)zp, z1 = *(const u32x4*)(zp + 8);
        float za[8], zb[8]; unpack8(z0, za); unpack8(z1, zb);
        const float* nwp = pk + PK_NORMW + 16 * g;
        float ga[8], gb2[8];
#pragma unroll
        for (int e = 0; e < 8; ++e) { ga[e] = nwp[e] * silu_(za[e]); gb2[e] = nwp[8 + e] * silu_(zb[e]); }
        bf16_t* gp = (bf16_t*)(rec + GP_G) + t * 128 + 16 * g;
        *(u32x4*)gp = pack8(ga); *(u32x4*)(gp + 8) = pack8(gb2);
    }
    if (w == 7) {
        const int i = lane;
        float g = 0.f, be = 0.f;
        if (i >= npad) { const size_t r = (size_t)(row_start + i - npad) * NPB; const float pa = bf2f(P[r + C_A + h]), pb = bf2f(P[r + C_B + h]);
            g = -expf(pk[PK_ALOG + h]) * softplus_(pa + pk[PK_DTB + h]); be = sigm(pb); }
        float x = g;
#pragma unroll
        for (int o = 1; o < 64; o <<= 1) { const float y = __shfl_up(x, o); if (lane >= o) x += y; }
        const float gl = __shfl(x, 63);
        gcs[lane] = x; bes[lane] = be; egs[lane] = __expf(x); egl_s[lane] = __expf(gl - x); beg[lane] = be * __expf(x);
        if (lane == 0) *(float*)(rec + GP_EGL) = __expf(gl);
    }
    __syncthreads();
    if (tid < 384) {
        const int sec = tid >> 7, ts = (tid >> 4) & 7, t0 = 8 * ts, d0 = l15 * 8;
        const int pcol = sec * 1024 + h * 128 + d0;
        float cw[4][8];
#pragma unroll
        for (int j = 0; j < 4; ++j) { const f32x4 a = *(const f32x4*)(pk + PK_CONVW + j * 3072 + pcol), b = *(const f32x4*)(pk + PK_CONVW + j * 3072 + pcol + 4);
            cw[j][0] = a[0]; cw[j][1] = a[1]; cw[j][2] = a[2]; cw[j][3] = a[3]; cw[j][4] = b[0]; cw[j][5] = b[1]; cw[j][6] = b[2]; cw[j][7] = b[3]; }
        u32x4 rw[11]; float fv[11];
#pragma unroll
        for (int k = 0; k < 11; ++k) {
            const int ii = t0 - 3 + k;
            const bf16_t* ptr = P + pcol; float f = 0.f;
            if (ii >= npad) { ptr = P + (size_t)(row_start + ii - npad) * NPB + pcol; f = 1.f; }
            else if (ii < 0 && npad == 0 && hbase) { ptr = hbase + (size_t)(ii + 3) * NPB + pcol; f = 1.f; }
            rw[k] = *(const u32x4*)ptr; fv[k] = f;
        }
        if (halo_out && ts == 7) {
#pragma unroll
            for (int dd = 0; dd < 3; ++dd) { *(u32x4*)(halo_out + (size_t)dd * NPB + pcol) = rw[8 + dd];
                if (conv_out) { float x[8]; unpack8(rw[8 + dd], x); *(f32x4*)(conv_out + dd * 3072 + pcol) = (f32x4){x[0], x[1], x[2], x[3]}; *(f32x4*)(conv_out + dd * 3072 + pcol + 4) = (f32x4){x[4], x[5], x[6], x[7]}; } }
        }
        float y[8][8];
#pragma unroll
        for (int t = 0; t < 8; ++t)
#pragma unroll
            for (int e = 0; e < 8; ++e) y[t][e] = 0.f;
#pragma unroll
        for (int k = 0; k < 11; ++k) { float x[8]; unpack8(rw[k], x);
#pragma unroll
            for (int e = 0; e < 8; ++e) x[e] *= fv[k];
#pragma unroll
            for (int dlt = 0; dlt < 4; ++dlt) { const int t = k - dlt;
                if (t >= 0 && t < 8) {
#pragma unroll
                    for (int e = 0; e < 8; ++e) y[t][e] += cw[dlt][e] * x[e]; } }
        }
        const float qsc = sec == 0 ? 0.08838834764831845f : 1.f;
#pragma unroll
        for (int t = 0; t < 8; ++t) {
            const bool tokv = (t0 + t) >= npad;
            float ss = 0.f;
#pragma unroll
            for (int e = 0; e < 8; ++e) { y[t][e] = tokv ? silu_(y[t][e]) : 0.f; ss += y[t][e] * y[t][e]; }
            if (sec < 2) { const float sc = __builtin_amdgcn_rsqf(rowsum16(ss) + 1e-6f) * qsc;
#pragma unroll
                for (int e = 0; e < 8; ++e) y[t][e] *= sc; }
        }
        { bf16_t* dst = sec == 0 ? qs : (sec == 1 ? ks : vs);
#pragma unroll
            for (int t = 0; t < 8; ++t) *(u32x4*)(dst + (t0 + t) * QSTR + d0) = pack8(y[t]); }
        if (sec == 1) {
#pragma unroll
            for (int t = 0; t < 8; ++t) { const float eg = egl_s[t0 + t]; float z[8];
#pragma unroll
                for (int e = 0; e < 8; ++e) z[e] = y[t][e] * eg;
                *(u32x4*)(kts + (t0 + t) * QSTR + d0) = pack8(z); } }
    }
    __syncthreads();
    {
        const int which = w >> 2, it = w & 3;
        const bf16_t* Barr = which ? qs : ks;
        bf16x8 bfr[4];
#pragma unroll
        for (int kk = 0; kk < 4; ++kk) bfr[kk] = ldfrag(Barr, QSTR, 16 * it, 32 * kk, lane);
        const int i = 16 * it + l15; const float gi = gcs[i], bi = bes[i];
#pragma unroll
        for (int jt = 0; jt < 4; ++jt) {
            f32x4 acc = {0.f, 0.f, 0.f, 0.f};
#pragma unroll
            for (int kk = 0; kk < 4; ++kk) acc = MFMA16(ldfrag(ks, QSTR, 16 * jt, 32 * kk, lane), bfr[kk], acc);
            const int j0 = 16 * jt + 4 * q4; const f32x4 gj = *(const f32x4*)(gcs + j0);
            f32x4 o;
#pragma unroll
            for (int r = 0; r < 4; ++r) { const int j = j0 + r; const bool keep = which ? (i >= j) : (i > j); o[r] = keep ? acc[r] * __expf(gi - gj[r]) : 0.f; }
            if (which == 0) *(f32x4*)(Lm + i * 64 + j0) = o * bi;
            else *(u32x2*)(QKm + i * TSTR + j0) = (u32x2){pk2(o[0], o[1]), pk2(o[2], o[3])};
        }
    }
    __syncthreads();
    {
        float* Tm = (float*)(smem + PL_TM);
        inv_block(Lm, Tm, (float*)(smem + PL_XS), tid);
        const int i = tid >> 3, j0 = (tid & 7) * 8;
        float a[8], b2[8];
#pragma unroll
        for (int e = 0; e < 8; ++e) { const float tv = Tm[i * 64 + j0 + e]; a[e] = tv * beg[j0 + e]; b2[e] = tv * bes[j0 + e]; }
        *(u32x4*)(Tp + i * TSTR + j0) = (u32x4){pk2(a[0], a[1]), pk2(a[2], a[3]), pk2(a[4], a[5]), pk2(a[6], a[7])};
        *(u32x4*)(Tpp + i * TSTR + j0) = (u32x4){pk2(b2[0], b2[1]), pk2(b2[2], b2[3]), pk2(b2[4], b2[5]), pk2(b2[6], b2[7])};
    }
    __syncthreads();
    {
        const int it = w & 3, half = w >> 2;
        f32x4 aw[4], au[4];
#pragma unroll
        for (int x = 0; x < 4; ++x) { aw[x] = (f32x4){0.f, 0.f, 0.f, 0.f}; au[x] = (f32x4){0.f, 0.f, 0.f, 0.f}; }
#pragma unroll
        for (int kk = 0; kk < 2; ++kk) {
            const bf16x8 a1 = ldfrag(Tp, TSTR, 16 * it, 32 * kk, lane), a2 = ldfrag(Tpp, TSTR, 16 * it, 32 * kk, lane);
#pragma unroll
            for (int x = 0; x < 4; ++x) { const int dt = half * 4 + x;
                aw[x] = MFMA16(a1, ldfrag_tr(ks, QSTR, 16 * dt, 32 * kk, lane), aw[x]);
                au[x] = MFMA16(a2, ldfrag_tr(vs, QSTR, 16 * dt, 32 * kk, lane), au[x]); }
        }
        __syncthreads();
#pragma unroll
        for (int x = 0; x < 4; ++x) { const int d = 16 * (half * 4 + x) + l15, i0 = 16 * it + 4 * q4;
            *(u32x2*)(WT + d * TSTR + i0) = (u32x2){pk2(aw[x][0], aw[x][1]), pk2(aw[x][2], aw[x][3])};
            *(u32x2*)(UT + d * TSTR + i0) = (u32x2){pk2(au[x][0], au[x][1]), pk2(au[x][2], au[x][3])}; }
    }
    __syncthreads();
    {
        bf16_t* gAP = (bf16_t*)(rec + GP_AP); bf16_t* gQH = (bf16_t*)(rec + GP_QH); bf16_t* gKH = (bf16_t*)(rec + GP_KH); bf16_t* gOH = (bf16_t*)(rec + GP_OH);
        {
            const int et = w;
            const bf16x8 a0 = ldfrag(WT, TSTR, 16 * et, 0, lane), a1 = ldfrag(WT, TSTR, 16 * et, 32, lane);
#pragma unroll
            for (int dt = 0; dt < 8; ++dt) { f32x4 acc = {0.f, 0.f, 0.f, 0.f};
                acc = MFMA16(a0, ldfrag_tr(kts, QSTR, 16 * dt, 0, lane), acc); acc = MFMA16(a1, ldfrag_tr(kts, QSTR, 16 * dt, 32, lane), acc);
                *(u32x2*)(gAP + ((size_t)(dt * 4 + (et >> 1)) * 64 + lane) * 8 + (et & 1) * 4) = (u32x2){pk2(-acc[0], -acc[1]), pk2(-acc[2], -acc[3])}; }
#pragma unroll
            for (int tt = 0; tt < 4; ++tt) { f32x4 acc = {0.f, 0.f, 0.f, 0.f};
                acc = MFMA16(a0, ldfrag(QKm, TSTR, 16 * tt, 0, lane), acc); acc = MFMA16(a1, ldfrag(QKm, TSTR, 16 * tt, 32, lane), acc);
                const int t = 16 * tt + l15, e0 = 16 * et + 4 * q4; const float eg = egs[t];
                const u32x2 qq = *(const u32x2*)(qs + t * QSTR + e0);
                const float o0 = __uint_as_float(qq.x << 16) * eg - acc[0], o1 = __uint_as_float(qq.x & 0xffff0000u) * eg - acc[1],
                            o2 = __uint_as_float(qq.y << 16) * eg - acc[2], o3 = __uint_as_float(qq.y & 0xffff0000u) * eg - acc[3];
                *(u32x2*)(gQH + ((size_t)(tt * 4 + (et >> 1)) * 64 + lane) * 8 + (et & 1) * 4) = (u32x2){pk2(o0, o1), pk2(o2, o3)}; }
        }
        {
            const int dt = w;
            const bf16x8 a0 = ldfrag_tr(kts, QSTR, 16 * dt, 0, lane), a1 = ldfrag_tr(kts, QSTR, 16 * dt, 32, lane);
#pragma unroll
            for (int vt = 0; vt < 8; ++vt) { f32x4 acc = {0.f, 0.f, 0.f, 0.f};
                acc = MFMA16(a0, ldfrag(UT, TSTR, 16 * vt, 0, lane), acc); acc = MFMA16(a1, ldfrag(UT, TSTR, 16 * vt, 32, lane), acc);
                *(u32x2*)(gKH + ((size_t)(vt * 8 + dt) * 64 + lane) * 4) = (u32x2){pk2(acc[0], acc[1]), pk2(acc[2], acc[3])}; }
            const int tt = w & 3, vh = w >> 2;
            const bf16x8 b0 = ldfrag(QKm, TSTR, 16 * tt, 0, lane), b1 = ldfrag(QKm, TSTR, 16 * tt, 32, lane);
#pragma unroll
            for (int x = 0; x < 4; ++x) { const int vt = vh * 4 + x; f32x4 acc = {0.f, 0.f, 0.f, 0.f};
                acc = MFMA16(b0, ldfrag(UT, TSTR, 16 * vt, 0, lane), acc); acc = MFMA16(b1, ldfrag(UT, TSTR, 16 * vt, 32, lane), acc);
                *(u32x2*)(gOH + ((size_t)(vt * 4 + tt) * 64 + lane) * 4) = (u32x2){pk2(acc[0], acc[1]), pk2(acc[2], acc[3])}; }
        }
    }
    __syncthreads();
}

__device__ __forceinline__ void phase_gprep(const Params& p, int seg, unsigned char* smem) {
    const int blk = obid();
    const int n_items = (CPS + (seg == 0 ? 1 : 0)) * 64;
#pragma unroll 1
    for (int it = blk; it < n_items; it += gridDim.x) {
        const int bh = it & 63, b = bh >> 3, h = bh & 7; int cl = it >> 6; if (seg != 0) cl += 1;
        unsigned char* rec = p.ws + WS_GP + (size_t)(cl * 64 + bh) * GP_STRIDE;
        const bf16_t* Pb = (const bf16_t*)(p.ws + WS_P);
        bf16_t* chalo2 = (bf16_t*)(p.ws + WS_CHALO);
        if (cl == 0) gdn_prep_item(p, smem, h, LEX0, 48, nullptr, nullptr, nullptr, rec);
        else {
            const int row = b * SEGTOK + (cl - 1) * 64;
            const bf16_t* hbase = Pb + (size_t)(row - 3) * NPB;
            if (cl == 1) hbase = (seg == 0) ? Pb + (size_t)(LEX0 + NMETA - 3) * NPB : chalo2 + (size_t)(((seg - 1) & 1) * NBATCH + b) * 3 * NPB;
            bf16_t* ho = (cl == CPS) ? chalo2 + (size_t)((seg & 1) * NBATCH + b) * 3 * NPB : nullptr;
            float* co = (cl == CPS && seg == NSEG - 1) ? p.out + O_CONV_P + (size_t)b * 9216 : nullptr;
            gdn_prep_item(p, smem, h, row, 0, hbase, ho, co, rec);
        }
    }
}

__device__ __forceinline__ void gdn_scan_block(const Params& p, int seg, unsigned char* smem, int bh) {
    const int tid = otid(), w = tid >> 6, lane = tid & 63, q4 = lane >> 4, l15 = lane & 15;
    const int b = bh >> 3, h = bh & 7;
    float* st = p.out + O_GDN_P + (size_t)bh * 16384;
    f32x4 S[8];
    if (seg) {
#pragma unroll
        for (int mt = 0; mt < 8; ++mt)
#pragma unroll
            for (int r = 0; r < 4; ++r) S[mt][r] = st[(size_t)(16 * mt + 4 * q4 + r) * 128 + 16 * w + l15];
    } else {
#pragma unroll
        for (int mt = 0; mt < 8; ++mt) S[mt] = (f32x4){0.f, 0.f, 0.f, 0.f};
    }
    const int c_lo = seg ? 1 : 0;
    float* obuf = (float*)(smem + 98304);
    {
        const u32x4* src = (const u32x4*)(p.ws + WS_GP + (size_t)(c_lo * 64 + bh) * GP_STRIDE); u32x4* dst = (u32x4*)smem;
#pragma unroll
        for (int x = 0; x < 6; ++x) dst[tid + 512 * x] = src[tid + 512 * x];
    }
#pragma unroll 1
    for (int cl = c_lo; cl <= CPS; ++cl) {
        const unsigned char* rec = p.ws + WS_GP + (size_t)(cl * 64 + bh) * GP_STRIDE;
        const int cur = (cl - c_lo) & 1;
        __syncthreads();
        u32x4 nx[6];
        const bool more = cl < CPS;
        if (more) { const u32x4* src = (const u32x4*)(rec + GP_STRIDE * 64);
#pragma unroll
            for (int x = 0; x < 6; ++x) nx[x] = src[tid + 512 * x]; }
        const bf16_t* gKH = (const bf16_t*)(rec + GP_KH); const bf16_t* gOH = (const bf16_t*)(rec + GP_OH);
        u32x2 kh[8], oh[4];
#pragma unroll
        for (int mt = 0; mt < 8; ++mt) kh[mt] = *(const u32x2*)(gKH + ((size_t)(w * 8 + mt) * 64 + lane) * 4);
#pragma unroll
        for (int tt = 0; tt < 4; ++tt) oh[tt] = *(const u32x2*)(gOH + ((size_t)(w * 4 + tt) * 64 + lane) * 4);
        const float egl = *(const float*)(rec + GP_EGL);
        const int et = tid >> 3, eg = tid & 7;
        const bf16_t* gp = (const bf16_t*)(rec + GP_G) + et * 128 + 16 * eg;
        u32x4 z0 = {0u, 0u, 0u, 0u}, z1 = {0u, 0u, 0u, 0u};
        if (cl > 0) { z0 = *(const u32x4*)gp; z1 = *(const u32x4*)(gp + 8); }
        bf16x8 Bf[4];
#pragma unroll
        for (int ks = 0; ks < 4; ++ks) { u32x4 t; t.x = pk2(S[2 * ks][0], S[2 * ks][1]); t.y = pk2(S[2 * ks][2], S[2 * ks][3]); t.z = pk2(S[2 * ks + 1][0], S[2 * ks + 1][1]); t.w = pk2(S[2 * ks + 1][2], S[2 * ks + 1][3]);
            Bf[ks] = __builtin_bit_cast(bf16x8, t); }
        const bf16x8* AP = (const bf16x8*)(smem + cur * 49152); const bf16x8* QH = (const bf16x8*)(smem + cur * 49152 + GP_QH);
        f32x4 o[4], tS[8];
#pragma unroll
        for (int tt = 0; tt < 4; ++tt) { o[tt] = (f32x4){0.f, 0.f, 0.f, 0.f};
#pragma unroll
            for (int ks = 0; ks < 4; ++ks) o[tt] = MFMA16(QH[(tt * 4 + ks) * 64 + lane], Bf[ks], o[tt]); }
#pragma unroll
        for (int mt = 0; mt < 8; ++mt) { tS[mt] = (f32x4){0.f, 0.f, 0.f, 0.f};
#pragma unroll
            for (int ks = 0; ks < 4; ++ks) tS[mt] = MFMA16(AP[(mt * 4 + ks) * 64 + lane], Bf[ks], tS[mt]); }
#pragma unroll
        for (int mt = 0; mt < 8; ++mt) {
            S[mt][0] = egl * S[mt][0] + tS[mt][0] + __uint_as_float(kh[mt].x << 16); S[mt][1] = egl * S[mt][1] + tS[mt][1] + __uint_as_float(kh[mt].x & 0xffff0000u);
            S[mt][2] = egl * S[mt][2] + tS[mt][2] + __uint_as_float(kh[mt].y << 16); S[mt][3] = egl * S[mt][3] + tS[mt][3] + __uint_as_float(kh[mt].y & 0xffff0000u); }
        if (cl > 0) {
#pragma unroll
            for (int tt = 0; tt < 4; ++tt) {
                o[tt][0] += __uint_as_float(oh[tt].x << 16); o[tt][1] += __uint_as_float(oh[tt].x & 0xffff0000u); o[tt][2] += __uint_as_float(oh[tt].y << 16); o[tt][3] += __uint_as_float(oh[tt].y & 0xffff0000u);
#pragma unroll
                for (int r = 0; r < 4; ++r) obuf[(16 * tt + 4 * q4 + r) * 132 + 16 * w + l15] = o[tt][r]; }
        }
        if (more) { u32x4* dst = (u32x4*)(smem + (cur ^ 1) * 49152);
#pragma unroll
            for (int x = 0; x < 6; ++x) dst[tid + 512 * x] = nx[x]; }
        if (cl > 0) {
            __syncthreads();
            f32x4 ov[4]; float ss = 0.f;
#pragma unroll
            for (int j = 0; j < 4; ++j) { ov[j] = *(const f32x4*)(obuf + et * 132 + 16 * eg + 4 * j); ss += ov[j][0] * ov[j][0] + ov[j][1] * ov[j][1] + ov[j][2] * ov[j][2] + ov[j][3] * ov[j][3]; }
            ss += __shfl_xor(ss, 1); ss += __shfl_xor(ss, 2); ss += __shfl_xor(ss, 4);
            const float rs = __builtin_amdgcn_rsqf(ss * (1.f / 128.f) + 1e-6f);
            const unsigned zz[8] = {z0.x, z0.y, z0.z, z0.w, z1.x, z1.y, z1.z, z1.w};
            unsigned ow[8];
#pragma unroll
            for (int j = 0; j < 8; ++j) ow[j] = pk2(ov[j >> 1][(j & 1) * 2] * rs * __uint_as_float(zz[j] << 16), ov[j >> 1][(j & 1) * 2 + 1] * rs * __uint_as_float(zz[j] & 0xffff0000u));
            const size_t grow = (size_t)b * SEQ + seg * SEGTOK + (cl - 1) * 64 + et;
            bf16_t* oa = (bf16_t*)(p.ws + WS_H) + grow * D + h * 128 + 16 * eg;
            *(u32x4*)oa = (u32x4){ow[0], ow[1], ow[2], ow[3]}; *(u32x4*)(oa + 8) = (u32x4){ow[4], ow[5], ow[6], ow[7]};
        }
    }
#pragma unroll
    for (int mt = 0; mt < 8; ++mt)
#pragma unroll
        for (int r = 0; r < 4; ++r) st[(size_t)(16 * mt + 4 * q4 + r) * 128 + 16 * w + l15] = S[mt][r];
    __syncthreads();
}

constexpr int RL_AT = 0, RL_BT = 9216, RL_KT = 18432, RL_ATT = 27648, RL_RT = 36864, RL_BTLT = 46080, RL_KTLT = 55296, RL_VT = 64512, RL_LAK = 73728, RL_MRB = 82944, RL_MRK = 92160,
              RL_LM = 101376, RL_AF = 117760, RL_TM = 134144, RL_XS = 150528;
__device__ __forceinline__ void rwkv_prep_item(const Params& p, unsigned char* smem, int hb, int row_start, int npad, const bf16_t* prev_row,
                                               bf16_t* halo_out, unsigned char* rec) {
    const int tid = otid(), w = tid >> 6, lane = tid & 63, q4 = lane >> 4, l15 = lane & 15;
    bf16_t* At = (bf16_t*)(smem + RL_AT); bf16_t* Tb = At; bf16_t* Bt = (bf16_t*)(smem + RL_BT); bf16_t* WaT = Bt; bf16_t* Kt = (bf16_t*)(smem + RL_KT); bf16_t* XT = Kt;
    bf16_t* At2 = (bf16_t*)(smem + RL_ATT); bf16_t* Rt = (bf16_t*)(smem + RL_RT); bf16_t* Btl = (bf16_t*)(smem + RL_BTLT); bf16_t* Ktl = (bf16_t*)(smem + RL_KTLT);
    bf16_t* Vr = (bf16_t*)(smem + RL_VT);        bf16_t* Lak = (bf16_t*)(smem + RL_LAK); bf16_t* Mrb = (bf16_t*)(smem + RL_MRB); bf16_t* Mrk = (bf16_t*)(smem + RL_MRK);
    float* Lm = (float*)(smem + RL_LM);
    bf16_t* thw = Lak; bf16_t* adb = Mrb; float* lc = Lm; float* af = (float*)(smem + RL_AF);
    const bf16_t* P = (const bf16_t*)(p.ws + WS_P);
    const float* pk = (const float*)(p.ws + WS_PK);
    const int t = tid >> 3, g = tid & 7;
    float rr[8], kb[8], vv[8], zb[8];
    {
        const bool real = t >= npad;
        const bf16_t* curp = P; const bf16_t* prevp = P; float fprev = 0.f;
        if (real) { curp = P + (size_t)(row_start + t - npad) * NPB; if (t > npad) { prevp = curp - NPB; fprev = 1.f; } else if (prev_row) { prevp = prev_row; fprev = 1.f; } }
        const int secbase[6] = {0, 1024, 2048, 3200, 3072, 3136};
        u32x4 rc[6], rp[6];
#pragma unroll
        for (int sidx = 0; sidx < 6; ++sidx) { const int col = secbase[sidx] + (sidx < 4 ? hb * 64 : 0) + g * 8; rc[sidx] = *(const u32x4*)(curp + C_RW + col); rp[sidx] = *(const u32x4*)(prevp + C_RW + col); }
        float m[6][8];
#pragma unroll
        for (int sidx = 0; sidx < 6; ++sidx) {
            const int col = secbase[sidx] + (sidx < 4 ? hb * 64 : 0) + g * 8;
            float cur[8], prv[8];
            unpack8(rc[sidx], cur); unpack8(rp[sidx], prv);
            const f32x4 mu0 = *(const f32x4*)(pk + PK_MU + col), mu1 = *(const f32x4*)(pk + PK_MU + col + 4);
            const float mu[8] = {mu0[0], mu0[1], mu0[2], mu0[3], mu1[0], mu1[1], mu1[2], mu1[3]};
#pragma unroll
            for (int e = 0; e < 8; ++e) m[sidx][e] = real ? cur[e] + mu[e] * (fprev * prv[e] - cur[e]) : 0.f;
            if (halo_out && t == 63 && (sidx < 4 || hb == 0)) *(u32x4*)(halo_out + C_RW + col) = rc[sidx];
        }
#pragma unroll
        for (int e = 0; e < 8; ++e) { rr[e] = m[0][e]; kb[e] = m[1][e]; vv[e] = m[2][e]; zb[e] = m[3][e]; }
        float th[8];
#pragma unroll
        for (int e = 0; e < 8; ++e) th[e] = tanh_(m[4][e]);
        *(u32x4*)(thw + t * TSTR + g * 8) = pack8(th);
        *(u32x4*)(adb + t * TSTR + g * 8) = pack8(m[5]);
    }
    __syncthreads();
    {
        const int which = w >> 2, ct = w & 3;
        const bf16_t* Wt = (const bf16_t*)(p.ws + (which ? WS_A2T : WS_W2T)) + (size_t)hb * 4096;
        const bf16x8 b0 = *(const bf16x8*)(Wt + (16 * ct + l15) * 64 + 8 * q4), b1 = *(const bf16x8*)(Wt + (16 * ct + l15) * 64 + 32 + 8 * q4);
        const bf16_t* Aarr = which ? adb : thw;
        const int c = 16 * ct + l15;
        const float bias = pk[(which ? PK_A0 : PK_W0) + hb * 64 + c];
        float carry = 0.f;
#pragma unroll
        for (int tt = 0; tt < 4; ++tt) {
            f32x4 acc = {0.f, 0.f, 0.f, 0.f};
            acc = MFMA16(ldfrag(Aarr, TSTR, 16 * tt, 0, lane), b0, acc); acc = MFMA16(ldfrag(Aarr, TSTR, 16 * tt, 32, lane), b1, acc);
            if (which) {
#pragma unroll
                for (int r = 0; r < 4; ++r) af[(16 * tt + 4 * q4 + r) * 64 + c] = sigm(bias + acc[r]);
            } else {
                float wl[4];
#pragma unroll
                for (int r = 0; r < 4; ++r) { const int tk = 16 * tt + 4 * q4 + r; wl[r] = (tk < npad) ? 0.f : -0.6065306597126334f * sigm(bias + acc[r]); }
                wl[1] += wl[0]; wl[2] += wl[1]; wl[3] += wl[2];
                const float Q = wl[3];
                const float Q0 = __shfl(Q, l15), Q1 = __shfl(Q, l15 + 16), Q2 = __shfl(Q, l15 + 32), Q3 = __shfl(Q, l15 + 48);
                const float ex = carry + (q4 > 0 ? Q0 : 0.f) + (q4 > 1 ? Q1 : 0.f) + (q4 > 2 ? Q2 : 0.f);
#pragma unroll
                for (int r = 0; r < 4; ++r) lc[(16 * tt + 4 * q4 + r) * 64 + c] = ex + wl[r];
                carry += Q0 + Q1 + Q2 + Q3;
            }
        }
    }
    __syncthreads();
    {
        float lct[8], lcp[8], lcC[8], av[8];
        { const f32x4 a = *(const f32x4*)(lc + t * 64 + g * 8), b2 = *(const f32x4*)(lc + t * 64 + g * 8 + 4); lct[0] = a[0]; lct[1] = a[1]; lct[2] = a[2]; lct[3] = a[3]; lct[4] = b2[0]; lct[5] = b2[1]; lct[6] = b2[2]; lct[7] = b2[3]; }
        if (t > 0) { const f32x4 a = *(const f32x4*)(lc + (t - 1) * 64 + g * 8), b2 = *(const f32x4*)(lc + (t - 1) * 64 + g * 8 + 4); lcp[0] = a[0]; lcp[1] = a[1]; lcp[2] = a[2]; lcp[3] = a[3]; lcp[4] = b2[0]; lcp[5] = b2[1]; lcp[6] = b2[2]; lcp[7] = b2[3]; }
        else {
#pragma unroll
            for (int e = 0; e < 8; ++e) lcp[e] = 0.f; }
        { const f32x4 a = *(const f32x4*)(lc + 63 * 64 + g * 8), b2 = *(const f32x4*)(lc + 63 * 64 + g * 8 + 4); lcC[0] = a[0]; lcC[1] = a[1]; lcC[2] = a[2]; lcC[3] = a[3]; lcC[4] = b2[0]; lcC[5] = b2[1]; lcC[6] = b2[2]; lcC[7] = b2[3]; }
        { const f32x4 a = *(const f32x4*)(af + t * 64 + g * 8), b2 = *(const f32x4*)(af + t * 64 + g * 8 + 4); av[0] = a[0]; av[1] = a[1]; av[2] = a[2]; av[3] = a[3]; av[4] = b2[0]; av[5] = b2[1]; av[6] = b2[2]; av[7] = b2[3]; }
        const int hc = hb * 64 + g * 8;
        float kk[8], km[8], ss = 0.f, rk = 0.f;
#pragma unroll
        for (int e = 0; e < 8; ++e) { kk[e] = kb[e] * pk[PK_KK + hc + e]; ss += kk[e] * kk[e]; km[e] = kb[e] * (1.f + (av[e] - 1.f) * pk[PK_KA + hc + e]); rk += rr[e] * km[e] * pk[PK_RK + hc + e]; }
        ss += __shfl_xor(ss, 1); ss += __shfl_xor(ss, 2); ss += __shfl_xor(ss, 4);
        rk += __shfl_xor(rk, 1); rk += __shfl_xor(rk, 2); rk += __shfl_xor(rk, 4);
        const float kn = __builtin_amdgcn_rsqf(ss + 1e-6f);
        float xa[8], xb[8], xk[8], xr[8], xbt[8], xkt[8];
#pragma unroll
        for (int e = 0; e < 8; ++e) { kk[e] *= kn; const float ka = kk[e] * av[e]; const float ip = __expf(-lct[e]), tl = __expf(lcC[e] - lct[e]);
            xa[e] = kk[e] * __expf(lcp[e]); xb[e] = ka * ip; xk[e] = km[e] * ip; xr[e] = rr[e] * __expf(lct[e]); xbt[e] = ka * tl; xkt[e] = km[e] * tl; }
        *(u32x4*)(At + t * TSTR + g * 8) = pack8(xa); *(u32x4*)(Bt + t * TSTR + g * 8) = pack8(xb); *(u32x4*)(Kt + t * TSTR + g * 8) = pack8(xk); *(u32x4*)(Rt + t * TSTR + g * 8) = pack8(xr);
        *(u32x4*)(At2 + t * TSTR + g * 8) = pack8(xa); *(u32x4*)(Btl + t * TSTR + g * 8) = pack8(xbt); *(u32x4*)(Ktl + t * TSTR + g * 8) = pack8(xkt); *(u32x4*)(Vr + t * TSTR + g * 8) = pack8(vv);
        float c1[8], c0[8];
#pragma unroll
        for (int e = 0; e < 8; ++e) { const float sz = silu_(zb[e]); c1[e] = pk[PK_GNW + hc + e] * sz; c0[e] = (pk[PK_GNB + hc + e] + rk * vv[e]) * sz; }
        *(u32x4*)((bf16_t*)(rec + RP_C1) + t * 64 + g * 8) = pack8(c1); *(u32x4*)((bf16_t*)(rec + RP_C0) + t * 64 + g * 8) = pack8(c0);
        if (t == 63) { float* pc = (float*)(rec + RP_PC) + g * 8; *(f32x4*)pc = (f32x4){__expf(lcC[0]), __expf(lcC[1]), __expf(lcC[2]), __expf(lcC[3])}; *(f32x4*)(pc + 4) = (f32x4){__expf(lcC[4]), __expf(lcC[5]), __expf(lcC[6]), __expf(lcC[7])}; }
    }
    __syncthreads();
    {
        const int pr = w >> 1;
        const bf16_t* Aarr = pr < 2 ? At : Rt; const bf16_t* Barr = (pr & 1) ? Kt : Bt;
#pragma unroll
        for (int x = 0; x < 2; ++x) { const int tt = 2 * (w & 1) + x;
            const bf16x8 a0 = ldfrag(Aarr, TSTR, 16 * tt, 0, lane), a1 = ldfrag(Aarr, TSTR, 16 * tt, 32, lane);
            const int tk = 16 * tt + l15;
#pragma unroll
            for (int it = 0; it < 4; ++it) { f32x4 acc = {0.f, 0.f, 0.f, 0.f};
                acc = MFMA16(ldfrag(Barr, TSTR, 16 * it, 0, lane), a0, acc); acc = MFMA16(ldfrag(Barr, TSTR, 16 * it, 32, lane), a1, acc);
                const int i0 = 16 * it + 4 * q4;
                f32x4 o;
#pragma unroll
                for (int r = 0; r < 4; ++r) { const int i = i0 + r; const bool keep = pr < 2 ? (tk > i) : (tk >= i); o[r] = keep ? acc[r] : 0.f; }
                if (pr == 0) *(f32x4*)(Lm + tk * 64 + i0) = o;
                else { bf16_t* Out = pr == 1 ? Lak : (pr == 2 ? Mrb : Mrk); *(u32x2*)(Out + tk * TSTR + i0) = (u32x2){pk2(o[0], o[1]), pk2(o[2], o[3])}; } }
        }
    }
    __syncthreads();
    {
        float* Tm = (float*)(smem + RL_TM);
        inv_block(Lm, Tm, (float*)(smem + RL_XS), tid);
        const int i = tid >> 3, j0 = (tid & 7) * 8;
        float a[8];
#pragma unroll
        for (int e = 0; e < 8; ++e) a[e] = Tm[i * 64 + j0 + e];
        *(u32x4*)(Tb + i * TSTR + j0) = pack8(a);
    }
    __syncthreads();
    {
        const int tt = w & 3, which = w >> 2;
        const bf16_t* Aarr = which ? Lak : Tb; const bf16_t* Barr = which ? Vr : At2; bf16_t* Out = which ? XT : WaT;
        const bf16x8 a0 = ldfrag(Aarr, TSTR, 16 * tt, 0, lane), a1 = ldfrag(Aarr, TSTR, 16 * tt, 32, lane);
#pragma unroll
        for (int ct = 0; ct < 4; ++ct) { f32x4 acc = {0.f, 0.f, 0.f, 0.f};
            acc = MFMA16(a0, ldfrag_tr(Barr, TSTR, 16 * ct, 0, lane), acc); acc = MFMA16(a1, ldfrag_tr(Barr, TSTR, 16 * ct, 32, lane), acc);
            *(u32x2*)(Out + (16 * ct + l15) * TSTR + 16 * tt + 4 * q4) = (u32x2){pk2(acc[0], acc[1]), pk2(acc[2], acc[3])}; }
    }
    __syncthreads();
    {
        f32x4 acc[4];
        if (w < 4) {
            const bf16x8 a0 = ldfrag(Tb, TSTR, 16 * w, 0, lane), a1 = ldfrag(Tb, TSTR, 16 * w, 32, lane);
#pragma unroll
            for (int ct = 0; ct < 4; ++ct) { acc[ct] = (f32x4){0.f, 0.f, 0.f, 0.f};
                acc[ct] = MFMA16(a0, ldfrag(XT, TSTR, 16 * ct, 0, lane), acc[ct]); acc[ct] = MFMA16(a1, ldfrag(XT, TSTR, 16 * ct, 32, lane), acc[ct]); }
        }
        __syncthreads();
        if (w < 4) {
#pragma unroll
            for (int ct = 0; ct < 4; ++ct) *(u32x2*)(XT + (16 * ct + l15) * TSTR + 16 * w + 4 * q4) = (u32x2){pk2(-acc[ct][0], -acc[ct][1]), pk2(-acc[ct][2], -acc[ct][3])};
        }
    }
    __syncthreads();
    {
        const bf16_t* UvT = XT;
        bf16_t* gAP = (bf16_t*)(rec + RP_AP); bf16_t* gRH = (bf16_t*)(rec + RP_RH); bf16_t* gKH = (bf16_t*)(rec + RP_KH); bf16_t* gYH = (bf16_t*)(rec + RP_YH);
        const int et = w & 3, part = w >> 2;
        {
            const bf16x8 a0 = ldfrag(WaT, TSTR, 16 * et, 0, lane), a1 = ldfrag(WaT, TSTR, 16 * et, 32, lane);
            if (part == 0) {
#pragma unroll
                for (int kt = 0; kt < 4; ++kt) { f32x4 acc = {0.f, 0.f, 0.f, 0.f};
                    acc = MFMA16(a0, ldfrag_tr(Btl, TSTR, 16 * kt, 0, lane), acc); acc = MFMA16(a1, ldfrag_tr(Btl, TSTR, 16 * kt, 32, lane), acc);
                    *(u32x2*)(gAP + ((size_t)(kt * 2 + (et >> 1)) * 64 + lane) * 8 + (et & 1) * 4) = (u32x2){pk2(-acc[0], -acc[1]), pk2(-acc[2], -acc[3])}; }
            } else {
#pragma unroll
                for (int tt = 0; tt < 4; ++tt) { f32x4 acc = {0.f, 0.f, 0.f, 0.f};
                    acc = MFMA16(a0, ldfrag(Mrb, TSTR, 16 * tt, 0, lane), acc); acc = MFMA16(a1, ldfrag(Mrb, TSTR, 16 * tt, 32, lane), acc);
                    const int tk = 16 * tt + l15, e0 = 16 * et + 4 * q4;
                    const u32x2 q2 = *(const u32x2*)(Rt + tk * TSTR + e0);
                    const float o0 = __uint_as_float(q2.x << 16) - acc[0], o1 = __uint_as_float(q2.x & 0xffff0000u) - acc[1], o2 = __uint_as_float(q2.y << 16) - acc[2], o3 = __uint_as_float(q2.y & 0xffff0000u) - acc[3];
                    *(u32x2*)(gRH + ((size_t)(tt * 2 + (et >> 1)) * 64 + lane) * 8 + (et & 1) * 4) = (u32x2){pk2(o0, o1), pk2(o2, o3)}; }
            }
        }
        {
            const int rt = w & 3;
            bf16_t* Out = part ? gKH : gYH;
            bf16x8 a0, a1, a2, a3;
            if (part) { a0 = ldfrag_tr(Btl, TSTR, 16 * rt, 0, lane); a1 = ldfrag_tr(Btl, TSTR, 16 * rt, 32, lane); a2 = ldfrag_tr(Ktl, TSTR, 16 * rt, 0, lane); a3 = ldfrag_tr(Ktl, TSTR, 16 * rt, 32, lane); }
            else { a0 = ldfrag(Mrb, TSTR, 16 * rt, 0, lane); a1 = ldfrag(Mrb, TSTR, 16 * rt, 32, lane); a2 = ldfrag(Mrk, TSTR, 16 * rt, 0, lane); a3 = ldfrag(Mrk, TSTR, 16 * rt, 32, lane); }
#pragma unroll
            for (int vt = 0; vt < 4; ++vt) { f32x4 acc = {0.f, 0.f, 0.f, 0.f};
                acc = MFMA16(a0, ldfrag(UvT, TSTR, 16 * vt, 0, lane), acc); acc = MFMA16(a1, ldfrag(UvT, TSTR, 16 * vt, 32, lane), acc);
                acc = MFMA16(a2, ldfrag_tr(Vr, TSTR, 16 * vt, 0, lane), acc); acc = MFMA16(a3, ldfrag_tr(Vr, TSTR, 16 * vt, 32, lane), acc);
                *(u32x2*)(Out + ((size_t)(vt * 4 + rt) * 64 + lane) * 4) = (u32x2){pk2(acc[0], acc[1]), pk2(acc[2], acc[3])}; }
        }
    }
    __syncthreads();
}

__device__ __forceinline__ void phase_rprep(const Params& p, int seg, unsigned char* smem) {
    const int blk = obid();
    const int n_items = (CPS + (seg == 0 ? 1 : 0)) * 128;
#pragma unroll 1
    for (int it = blk; it < n_items; it += gridDim.x) {
        const int bh = it & 127, b = bh >> 4, hb = bh & 15; int cl = it >> 7; if (seg != 0) cl += 1;
        unsigned char* rec = p.ws + WS_RP + (size_t)(cl * 128 + bh) * RP_STRIDE;
        const bf16_t* Pb = (const bf16_t*)(p.ws + WS_P);
        bf16_t* phalo2 = (bf16_t*)(p.ws + WS_PHALO);
        if (cl == 0) rwkv_prep_item(p, smem, hb, LEX0, 48, nullptr, nullptr, rec);
        else {
            const int row = b * SEGTOK + (cl - 1) * 64;
            const bf16_t* prow = Pb + (size_t)(row - 1) * NPB;
            if (cl == 1) prow = (seg == 0) ? Pb + (size_t)(LEX0 + NMETA - 1) * NPB : phalo2 + (size_t)(((seg - 1) & 1) * NBATCH + b) * NPB;
            bf16_t* ho = (cl == CPS) ? phalo2 + (size_t)((seg & 1) * NBATCH + b) * NPB : nullptr;
            rwkv_prep_item(p, smem, hb, row, 0, prow, ho, rec);
        }
    }
}

__device__ __forceinline__ void rwkv_scan_block(const Params& p, int seg, unsigned char* smem, int pairidx) {
    const int tid = otid(), w = tid >> 6, lane = tid & 63, q4 = lane >> 4, l15 = lane & 15;
    const int hsel = w >> 2, vt = w & 3;
    const int bh = pairidx * 2 + hsel, b = bh >> 4, hb = bh & 15;
    float* st = p.out + O_RWKV_P + (size_t)bh * 4096;
    f32x4 S[4];
    if (seg) {
#pragma unroll
        for (int mt = 0; mt < 4; ++mt) S[mt] = *(const f32x4*)(st + (size_t)(16 * vt + l15) * 64 + 16 * mt + 4 * q4);
    } else {
#pragma unroll
        for (int mt = 0; mt < 4; ++mt) S[mt] = (f32x4){0.f, 0.f, 0.f, 0.f};
    }
    const int c_lo = seg ? 1 : 0;
    float* ybuf = (float*)(smem + 65536) + hsel * (64 * 68);
    const int tl = tid & 255;
    {
        const u32x4* src = (const u32x4*)(p.ws + WS_RP + (size_t)(c_lo * 128 + bh) * RP_STRIDE); u32x4* dst = (u32x4*)(smem + hsel * 16384);
#pragma unroll
        for (int x = 0; x < 4; ++x) dst[tl + 256 * x] = src[tl + 256 * x];
    }
#pragma unroll 1
    for (int cl = c_lo; cl <= CPS; ++cl) {
        const unsigned char* rec = p.ws + WS_RP + (size_t)(cl * 128 + bh) * RP_STRIDE;
        const int cur = (cl - c_lo) & 1;
        __syncthreads();
        u32x4 nx[4];
        const bool more = cl < CPS;
        if (more) { const u32x4* src = (const u32x4*)(rec + (size_t)RP_STRIDE * 128);
#pragma unroll
            for (int x = 0; x < 4; ++x) nx[x] = src[tl + 256 * x]; }
        const bf16_t* gKH = (const bf16_t*)(rec + RP_KH); const bf16_t* gYH = (const bf16_t*)(rec + RP_YH);
        u32x2 kh[4], yh[4]; f32x4 pc[4];
#pragma unroll
        for (int mt = 0; mt < 4; ++mt) { kh[mt] = *(const u32x2*)(gKH + ((size_t)(vt * 4 + mt) * 64 + lane) * 4); yh[mt] = *(const u32x2*)(gYH + ((size_t)(vt * 4 + mt) * 64 + lane) * 4);
            pc[mt] = *(const f32x4*)((const float*)(rec + RP_PC) + 16 * mt + 4 * q4); }
        const int tk = tl >> 2, g = tl & 3;
        u32x4 a0 = {0u, 0u, 0u, 0u}, a1 = a0, b0 = a0, b1 = a0;
        if (cl > 0) { const bf16_t* c1p = (const bf16_t*)(rec + RP_C1) + tk * 64 + 16 * g; const bf16_t* c0p = (const bf16_t*)(rec + RP_C0) + tk * 64 + 16 * g;
            a0 = *(const u32x4*)c0p; a1 = *(const u32x4*)(c0p + 8); b0 = *(const u32x4*)c1p; b1 = *(const u32x4*)(c1p + 8); }
        bf16x8 Bf[2];
#pragma unroll
        for (int ks = 0; ks < 2; ++ks) { u32x4 tq; tq.x = pk2(S[2 * ks][0], S[2 * ks][1]); tq.y = pk2(S[2 * ks][2], S[2 * ks][3]); tq.z = pk2(S[2 * ks + 1][0], S[2 * ks + 1][1]); tq.w = pk2(S[2 * ks + 1][2], S[2 * ks + 1][3]);
            Bf[ks] = __builtin_bit_cast(bf16x8, tq); }
        const bf16x8* AP = (const bf16x8*)(smem + cur * 32768 + hsel * 16384); const bf16x8* RH = (const bf16x8*)(smem + cur * 32768 + hsel * 16384 + RP_RH);
        f32x4 y[4], tS[4];
#pragma unroll
        for (int tt = 0; tt < 4; ++tt) { y[tt] = (f32x4){0.f, 0.f, 0.f, 0.f}; y[tt] = MFMA16(RH[(tt * 2 + 0) * 64 + lane], Bf[0], y[tt]); y[tt] = MFMA16(RH[(tt * 2 + 1) * 64 + lane], Bf[1], y[tt]); }
#pragma unroll
        for (int mt = 0; mt < 4; ++mt) { tS[mt] = (f32x4){0.f, 0.f, 0.f, 0.f}; tS[mt] = MFMA16(AP[(mt * 2 + 0) * 64 + lane], Bf[0], tS[mt]); tS[mt] = MFMA16(AP[(mt * 2 + 1) * 64 + lane], Bf[1], tS[mt]); }
#pragma unroll
        for (int mt = 0; mt < 4; ++mt) {
            S[mt][0] = pc[mt][0] * S[mt][0] + tS[mt][0] + __uint_as_float(kh[mt].x << 16); S[mt][1] = pc[mt][1] * S[mt][1] + tS[mt][1] + __uint_as_float(kh[mt].x & 0xffff0000u);
            S[mt][2] = pc[mt][2] * S[mt][2] + tS[mt][2] + __uint_as_float(kh[mt].y << 16); S[mt][3] = pc[mt][3] * S[mt][3] + tS[mt][3] + __uint_as_float(kh[mt].y & 0xffff0000u); }
        if (cl > 0) {
#pragma unroll
            for (int tt = 0; tt < 4; ++tt) {
                y[tt][0] += __uint_as_float(yh[tt].x << 16); y[tt][1] += __uint_as_float(yh[tt].x & 0xffff0000u); y[tt][2] += __uint_as_float(yh[tt].y << 16); y[tt][3] += __uint_as_float(yh[tt].y & 0xffff0000u);
#pragma unroll
                for (int r = 0; r < 4; ++r) ybuf[(16 * tt + 4 * q4 + r) * 68 + 16 * vt + l15] = y[tt][r]; }
        }
        if (more) { u32x4* dst = (u32x4*)(smem + (cur ^ 1) * 32768 + hsel * 16384);
#pragma unroll
            for (int x = 0; x < 4; ++x) dst[tl + 256 * x] = nx[x]; }
        if (cl > 0) {
            __syncthreads();
            f32x4 yv[4]; float sm = 0.f;
#pragma unroll
            for (int j = 0; j < 4; ++j) { yv[j] = *(const f32x4*)(ybuf + tk * 68 + 16 * g + 4 * j); sm += yv[j][0] + yv[j][1] + yv[j][2] + yv[j][3]; }
            sm += __shfl_xor(sm, 1); sm += __shfl_xor(sm, 2);
            const float mu = sm * (1.f / 64.f); float vs = 0.f;
#pragma unroll
            for (int j = 0; j < 4; ++j) { yv[j] = yv[j] - mu; vs += yv[j][0] * yv[j][0] + yv[j][1] * yv[j][1] + yv[j][2] * yv[j][2] + yv[j][3] * yv[j][3]; }
            vs += __shfl_xor(vs, 1); vs += __shfl_xor(vs, 2);
            const float rs = __builtin_amdgcn_rsqf(vs * (1.f / 64.f) + 64e-5f);
            const unsigned c0w[8] = {a0.x, a0.y, a0.z, a0.w, a1.x, a1.y, a1.z, a1.w}, c1w[8] = {b0.x, b0.y, b0.z, b0.w, b1.x, b1.y, b1.z, b1.w};
            unsigned ow[8];
#pragma unroll
            for (int j = 0; j < 8; ++j) ow[j] = pk2(yv[j >> 1][(j & 1) * 2] * rs * __uint_as_float(c1w[j] << 16) + __uint_as_float(c0w[j] << 16),
                                                     yv[j >> 1][(j & 1) * 2 + 1] * rs * __uint_as_float(c1w[j] & 0xffff0000u) + __uint_as_float(c0w[j] & 0xffff0000u));
            const size_t grow = (size_t)b * SEQ + seg * SEGTOK + (cl - 1) * 64 + tk;
            bf16_t* ob = (bf16_t*)(p.ws + WS_OB) + grow * D + hb * 64 + 16 * g;
            *(u32x4*)ob = (u32x4){ow[0], ow[1], ow[2], ow[3]}; *(u32x4*)(ob + 8) = (u32x4){ow[4], ow[5], ow[6], ow[7]};
        }
    }
#pragma unroll
    for (int mt = 0; mt < 4; ++mt) *(f32x4*)(st + (size_t)(16 * vt + l15) * 64 + 16 * mt + 4 * q4) = S[mt];
    __syncthreads();
}

__device__ __forceinline__ void gdn_sample_item(const Params& p, unsigned char* smem, int bs, int h) {
    const int tid = otid(), w = tid >> 6, lane = tid & 63, kq = tid >> 7, v = tid & 127;
    float* qk_s = (float*)smem; float* v_s = qk_s + 1024; float* gb_s = v_s + 512; float* part = gb_s + 16; float* part2 = part + 512;
    const bf16_t* P = (const bf16_t*)(p.ws + WS_P);
    const float* pk = (const float*)(p.ws + WS_PK);
    const float* s_in = p.in[2] + (size_t)(bs * 8 + h) * 16384; float* s_out = p.out + O_GDN_S + (size_t)(bs * 8 + h) * 16384;
    const int row0 = LEX0 + EX_SAMP + bs * DECT;
    float s[32];
#pragma unroll
    for (int j = 0; j < 32; ++j) s[j] = s_in[(size_t)(kq * 32 + j) * 128 + v];
    if (tid < 384) {
        const int pcol = (tid >> 7) * 1024 + h * 128 + (tid & 127);
        const float* cw = pk + PK_CONVW; const float* hin = p.in[3] + (size_t)bs * 9216; float* hout = p.out + O_CONV_S + (size_t)bs * 9216;
        const float cw0 = cw[pcol], cw1 = cw[3072 + pcol], cw2 = cw[6144 + pcol], cw3 = cw[9216 + pcol];
        float x3 = hin[pcol], x2 = hin[3072 + pcol], x1 = hin[6144 + pcol];
        float xr[4];
#pragma unroll
        for (int i = 0; i < 4; ++i) xr[i] = bf2f(P[(size_t)(row0 + i) * NPB + pcol]);
#pragma unroll
        for (int i = 0; i < 4; ++i) { const float y = cw0 * x3 + cw1 * x2 + cw2 * x1 + cw3 * xr[i]; x3 = x2; x2 = x1; x1 = xr[i];
            if (tid < 256) qk_s[i * 256 + tid] = silu_(y); else v_s[i * 128 + (tid - 256)] = silu_(y); }
        hout[pcol] = x3; hout[3072 + pcol] = x2; hout[6144 + pcol] = x1;
    } else if (tid < 388) {
        const int i = tid - 384; const size_t r = (size_t)(row0 + i) * NPB;
        const float pa = bf2f(P[r + C_A + h]), pb = bf2f(P[r + C_B + h]);
        gb_s[2 * i] = __expf(-expf(pk[PK_ALOG + h]) * softplus_(pa + pk[PK_DTB + h])); gb_s[2 * i + 1] = sigm(pb);
    }
    __syncthreads();
    { const int i = w >> 1, which = w & 1; float* rp = qk_s + i * 256 + which * 128; const float a = rp[lane], b = rp[lane + 64];
      const float sc = __builtin_amdgcn_rsqf(wave_sum(a * a + b * b) + 1e-6f) * (which == 0 ? 0.08838834764831845f : 1.f); rp[lane] = a * sc; rp[lane + 64] = b * sc; }
    __syncthreads();
#pragma unroll 1
    for (int i = 0; i < 4; ++i) {
        const float* kp = qk_s + i * 256 + 128 + kq * 32; const float* qp = qk_s + i * 256 + kq * 32;
        float pa = 0.f;
#pragma unroll
        for (int j4 = 0; j4 < 8; ++j4) { const f32x4 k4 = *(const f32x4*)(kp + 4 * j4); pa += k4[0] * s[4 * j4] + k4[1] * s[4 * j4 + 1] + k4[2] * s[4 * j4 + 2] + k4[3] * s[4 * j4 + 3]; }
        part[kq * 128 + v] = pa;
        __syncthreads();
        const float kS = part[v] + part[128 + v] + part[256 + v] + part[384 + v];
        const float a = gb_s[2 * i], c = gb_s[2 * i + 1] * (v_s[i * 128 + v] - a * kS);
        float po = 0.f;
#pragma unroll
        for (int j4 = 0; j4 < 8; ++j4) { const f32x4 k4 = *(const f32x4*)(kp + 4 * j4), q4v = *(const f32x4*)(qp + 4 * j4);
#pragma unroll
            for (int e = 0; e < 4; ++e) { s[4 * j4 + e] = a * s[4 * j4 + e] + k4[e] * c; po += q4v[e] * s[4 * j4 + e]; } }
        part2[kq * 128 + v] = po;
        __syncthreads();
        if (kq == 0) ((float*)(p.ws + WS_ORAW))[(size_t)(row0 + i) * D + h * 128 + v] = part2[v] + part2[128 + v] + part2[256 + v] + part2[384 + v];
    }
#pragma unroll
    for (int j = 0; j < 32; ++j) s_out[(size_t)(kq * 32 + j) * 128 + v] = s[j];
    __syncthreads();
}

constexpr int SR_R = 0, SR_KK = 4096, SR_V = 8192, SR_ZB = 12288, SR_DEC = 16384, SR_KA = 20480, SR_KM = 24576, SR_WD = 28672, SR_AD = 28928, SR_RK = 29184;
__device__ __forceinline__ void rwkv_sample_item(const Params& p, unsigned char* smem, int bs) {
    const int tid = otid(), w = tid >> 6, lane = tid & 63;
    float* f = (float*)smem;
    const bf16_t* P = (const bf16_t*)(p.ws + WS_P);
    const float* pk = (const float*)(p.ws + WS_PK);
    const int row0 = LEX0 + EX_SAMP + bs * DECT;
    const bf16_t* prow = P + (size_t)(LEX0 + EX_SHIFT + bs) * NPB + C_RW;
#pragma unroll 1
    for (int col = tid; col < RW_SHIFT; col += 512) {
        const float mu = pk[PK_MU + col]; float prev = bf2f(prow[col]);
        float cur[4];
#pragma unroll
        for (int i = 0; i < 4; ++i) cur[i] = bf2f(P[(size_t)(row0 + i) * NPB + C_RW + col]);
        float* dst; int stride = 1024; bool th = false;
        if (col < 1024) dst = f + SR_R + col; else if (col < 2048) dst = f + SR_KK + (col - 1024); else if (col < 3072) dst = f + SR_V + (col - 2048);
        else if (col < 3136) { dst = f + SR_WD + (col - 3072); stride = 64; th = true; } else if (col < 3200) { dst = f + SR_AD + (col - 3136); stride = 64; } else dst = f + SR_ZB + (col - 3200);
#pragma unroll
        for (int i = 0; i < 4; ++i) { float m = cur[i] + mu * (prev - cur[i]); prev = cur[i]; if (th) m = tanh_(m); dst[i * stride] = m; }
    }
    __syncthreads();
#pragma unroll 1
    for (int cc = 0; cc < 2; ++cc) {
        const int c = tid + 512 * cc;
        float aw[4] = {0.f, 0.f, 0.f, 0.f}, aa[4] = {0.f, 0.f, 0.f, 0.f};
#pragma unroll 8
        for (int l = 0; l < 64; ++l) { const float w2v = pk[PK_W2 + l * D + c], a2v = pk[PK_A2 + l * D + c];
#pragma unroll
            for (int i = 0; i < 4; ++i) { aw[i] += f[SR_WD + i * 64 + l] * w2v; aa[i] += f[SR_AD + i * 64 + l] * a2v; } }
        const float w0c = pk[PK_W0 + c], a0c = pk[PK_A0 + c], kkc = pk[PK_KK + c], kac = pk[PK_KA + c];
#pragma unroll
        for (int i = 0; i < 4; ++i) { const float a = sigm(a0c + aa[i]); const float kbv = f[SR_KK + i * 1024 + c];
            f[SR_DEC + i * 1024 + c] = __expf(-0.6065306597126334f * sigm(w0c + aw[i])); f[SR_KA + i * 1024 + c] = a; f[SR_KK + i * 1024 + c] = kbv * kkc; f[SR_KM + i * 1024 + c] = kbv * (1.f + (a - 1.f) * kac); }
    }
    __syncthreads();
#pragma unroll 1
    for (int x = 0; x < 8; ++x) { const int pr = w * 8 + x, i = pr >> 4, hh = pr & 15; const int o = i * 1024 + hh * 64 + lane;
        const float kr = f[SR_KK + o]; const float kk = kr * __builtin_amdgcn_rsqf(wave_sum(kr * kr) + 1e-6f); f[SR_KK + o] = kk; f[SR_KA + o] = kk * f[SR_KA + o];
        const float rkv = wave_sum(f[SR_R + o] * f[SR_KM + o] * pk[PK_RK + hh * 64 + lane]); if (lane == 0) f[SR_RK + pr] = rkv; }
    __syncthreads();
#pragma unroll 1
    for (int hp = 0; hp < 2; ++hp) {
        const int hb = hp * 8 + w;
        const float* s_in = p.in[4] + (size_t)(bs * 16 + hb) * 4096 + (size_t)lane * 64; float* s_out = p.out + O_RWKV_S + (size_t)(bs * 16 + hb) * 4096 + (size_t)lane * 64;
        f32x4 S[16];
#pragma unroll
        for (int j = 0; j < 16; ++j) S[j] = *(const f32x4*)(s_in + 4 * j);
        const int cch = hb * 64 + lane;
        const float gnw = pk[PK_GNW + cch], gnb = pk[PK_GNB + cch];
#pragma unroll 1
        for (int i = 0; i < 4; ++i) {
            const int o = i * 1024 + hb * 64;
            const float vv = f[SR_V + o + lane], rk = f[SR_RK + i * 16 + hb];
            float sa = 0.f;
#pragma unroll
            for (int j = 0; j < 16; ++j) { const f32x4 kk4 = *(const f32x4*)(f + SR_KK + o + 4 * j); sa += S[j][0] * kk4[0] + S[j][1] * kk4[1] + S[j][2] * kk4[2] + S[j][3] * kk4[3]; }
            float y = 0.f;
#pragma unroll
            for (int j = 0; j < 16; ++j) { const f32x4 de4 = *(const f32x4*)(f + SR_DEC + o + 4 * j), ka4 = *(const f32x4*)(f + SR_KA + o + 4 * j), km4 = *(const f32x4*)(f + SR_KM + o + 4 * j), r4 = *(const f32x4*)(f + SR_R + o + 4 * j);
#pragma unroll
                for (int e = 0; e < 4; ++e) { S[j][e] = S[j][e] * de4[e] + (vv * km4[e] - sa * ka4[e]); y += S[j][e] * r4[e]; } }
            const float mu = wave_sum(y) * (1.f / 64.f); const float dy = y - mu;
            const float rs = __builtin_amdgcn_rsqf(wave_sum(dy * dy) * (1.f / 64.f) + 64e-5f);
            const float ov = (dy * rs * gnw + gnb + rk * vv) * silu_(f[SR_ZB + i * 1024 + cch]);
            ((bf16_t*)(p.ws + WS_OB))[(size_t)(XROWS + EX_SAMP + bs * DECT + i) * D + cch] = (bf16_t)f2bf(ov);
        }
#pragma unroll
        for (int j = 0; j < 16; ++j) *(f32x4*)(s_out + 4 * j) = S[j];
    }
    __syncthreads();
}

__device__ __forceinline__ void phase2(const Params& p, int seg, unsigned char* smem) {
    const int blk = obid();
    float* out = p.out;
    float* chalo = (float*)(p.ws + WS_CHALO); float* phalo = (float*)(p.ws + WS_PHALO);
#ifndef SUB
#define SUB 0
#endif
#define SEN(x) (SUB == 0 || SUB == (x))
    if (SEN(1) && blk < 64) gdn_scan_block(p, seg, smem, blk);
    if (SEN(3) && blk >= 64 && blk < 128) rwkv_scan_block(p, seg, smem, blk - 64);
#ifndef DUP
#define DUP 0
#endif
    if (seg == 0) {
#pragma unroll 1
        for (int it = blk; it < DECB * 8; it += gridDim.x) gdn_sample_item(p, smem, it >> 3, it & 7);
#pragma unroll 1
        for (int it = (blk + 128) & 255; it < DECB; it += gridDim.x) rwkv_sample_item(p, smem, it);
    }
}

__device__ __forceinline__ void phase25(const Params& p, int seg) {
    const int tid0 = otid(); const int lane = tid0 & 63; const int gw = obid() * 8 + (tid0 >> 6), NGW = gridDim.x * 8;
    const bf16_t* P = (const bf16_t*)(p.ws + WS_P);
    const float* ORAW = (const float*)(p.ws + WS_ORAW); const float* YRAW = (const float*)(p.ws + WS_YRAW);
    const bf16_t* C0 = (const bf16_t*)(p.ws + WS_C0); const bf16_t* C1 = (const bf16_t*)(p.ws + WS_C1);
    bf16_t* OA = (bf16_t*)(p.ws + WS_H); bf16_t* OB = (bf16_t*)(p.ws + WS_OB);
    const int nrows = LEX0 + (seg == 0 ? DECB * DECT : 0);
    const int c = lane * 16;
    f32x4 nw[4];
#pragma unroll
    for (int j = 0; j < 4; ++j) nw[j] = *(const f32x4*)((const float*)(p.ws + WS_PK) + PK_NORMW + (c & 127) + 4 * j);
#pragma unroll 1
    for (int rr = LEX0 + gw; rr < nrows; rr += NGW) {
        int lr; size_t grow;
        if (rr < LEX0) { lr = rr; grow = (size_t)(rr / SEGTOK) * SEQ + seg * SEGTOK + (rr % SEGTOK); } else { lr = LEX0 + EX_SAMP + (rr - LEX0); grow = (size_t)XROWS + EX_SAMP + (rr - LEX0); }
        {
            f32x4 o[4]; float ss = 0.f;
#pragma unroll
            for (int j = 0; j < 4; ++j) { o[j] = *(const f32x4*)(ORAW + (size_t)lr * D + c + 4 * j); ss += o[j][0] * o[j][0] + o[j][1] * o[j][1] + o[j][2] * o[j][2] + o[j][3] * o[j][3]; }
            ss += __shfl_xor(ss, 1); ss += __shfl_xor(ss, 2); ss += __shfl_xor(ss, 4);
            const float rs = __builtin_amdgcn_rsqf(ss * (1.f / 128.f) + 1e-6f);
            const u32x4 z0 = *(const u32x4*)(P + (size_t)lr * NPB + C_Z + c), z1 = *(const u32x4*)(P + (size_t)lr * NPB + C_Z + c + 8);
            const unsigned zz[8] = {z0.x, z0.y, z0.z, z0.w, z1.x, z1.y, z1.z, z1.w};
            unsigned ow[8];
#pragma unroll
            for (int j = 0; j < 8; ++j) { const float za = __uint_as_float(zz[j] << 16), zb = __uint_as_float(zz[j] & 0xffff0000u);
                const float a = o[j >> 1][(j & 1) * 2] * rs * nw[j >> 1][(j & 1) * 2] * silu_(za), b = o[j >> 1][(j & 1) * 2 + 1] * rs * nw[j >> 1][(j & 1) * 2 + 1] * silu_(zb);
                ow[j] = pk2(a, b); }
            *(u32x4*)(OA + grow * D + c) = (u32x4){ow[0], ow[1], ow[2], ow[3]}; *(u32x4*)(OA + grow * D + c + 8) = (u32x4){ow[4], ow[5], ow[6], ow[7]};
        }
    }
}

__device__ __forceinline__ void phase_final(const Params& p) {
    const int tid0 = otid(); const int lane = tid0 & 63; const int gw = obid() * 8 + (tid0 >> 6), NGW = gridDim.x * 8;
    const f32x4* wr = (const f32x4*)((const float*)(p.ws + WS_PK) + PK_LNF) + lane;
#pragma unroll 1
    for (int r = gw; r < XROWS + DECB * DECT; r += NGW) {
        f32x4* xr = (f32x4*)(p.out + (size_t)r * D) + lane;
        f32x4 v[4]; float ss = 0.f;
#pragma unroll
        for (int j = 0; j < 4; ++j) { v[j] = xr[64 * j]; ss += v[j][0] * v[j][0] + v[j][1] * v[j][1] + v[j][2] * v[j][2] + v[j][3] * v[j][3]; }
        const float rs = __builtin_amdgcn_rsqf(wave_sum(ss) * (1.f / D) + 1e-6f);
#pragma unroll
        for (int j = 0; j < 4; ++j) xr[64 * j] = v[j] * rs * wr[64 * j];
    }
}

__global__ __launch_bounds__(512, 2) void hybrid_mega(Params p) {
    extern __shared__ __attribute__((aligned(16))) unsigned char smem[];
    cg::grid_group grid = cg::this_grid();
    LAS unsigned char* lds = (LAS unsigned char*)smem;
    const int G = gridDim.x;
    volatile LAS unsigned* xst = (volatile LAS unsigned*)(lds + (LDS_TOTAL - 16));
    if (threadIdx.x == 0) { xst[0] = 0u; xst[1] = 0u; }
    __syncthreads();
    (void)xcd_barrier_post((unsigned*)(p.ws + WS_BAR), xst);
    if (G == 0x7fffffff) grid.sync();
#define GSYNC() do { XcdBarrier xb_; xb_.bar = (unsigned*)(p.ws + WS_BAR); xb_.x = xb_xcc_id(); xb_.st = (volatile LAS unsigned*)((LAS unsigned char*)smem + (LDS_TOTAL - 16)); xcd_barrier(xb_); } while (0)

#ifndef ONLY
#define ONLY 0
#endif
#define EN(x) (ONLY == 0 || ONLY == (x))
    if (EN(1)) phase0(p, smem);
    GSYNC();
#pragma unroll 1
    for (int it = 0; it <= NSEG; ++it) {
        if (it > 0 && EN(3)) phase2(p, it - 1, smem);
        if (it < NSEG && EN(2)) {
            const int seg = it;
            const int cidx = it > 0 ? (obid() + (G >> 1)) % G : obid();
            SchedIn S; S.ob.init(seg == 0 ? LT_PROMPT + 3 : LT_PROMPT, NT_IN, G, cidx); S.seg = seg; S.A = (const char*)(p.ws + WS_H); S.B = (const char*)(p.ws + WS_WT_IN);
            EpiIn E; E.P = (bf16_t*)(p.ws + WS_P); E.gex = (bf16_t*)(p.ws + WS_GEX); E.out = p.out; E.seg = seg;
            pg8::gemm_phase<EpiIn, SchedIn>(lds, D, S, E);
        }
        GSYNC();
        if (it < NSEG) {
            if (EN(8)) { phase_gprep(p, it, smem); phase_rprep(p, it, smem); }
            if (it == 1 && EN(4)) phase25(p, 0);
            GSYNC();
        }
    }
    if (EN(5)) {
        SchedAB S; S.ob.init(HTILES, 4, G, obid()); S.A0 = (const char*)(p.ws + WS_H); S.A1 = (const char*)(p.ws + WS_OB); S.B0 = (const char*)(p.ws + WS_WT_A); S.B1 = (const char*)(p.ws + WS_WT_B);
        EpiAB E; E.tmp = (float*)(p.ws + WS_P); E.merged = (bf16_t*)(p.ws + WS_MG); E.gex = (const bf16_t*)(p.ws + WS_GEX); E.out = p.out;
        pg8::gemm_phase<EpiAB, SchedAB>(lds, D, S, E);
    }
    GSYNC();
    if (EN(6)) {
        SchedO S; S.ob.init(HTILES, 4, G, obid()); S.A = (const char*)(p.ws + WS_MG); S.B = (const char*)(p.ws + WS_WT_O);
        EpiO E; E.out = p.out; E.xp = p.in[0]; E.xs = p.in[1];
        pg8::gemm_phase<EpiO, SchedO>(lds, D, S, E);
    }
    GSYNC();
    if (EN(7)) phase_final(p);
}

extern "C" void kernel_launch(void* const* d_in, const int* in_sizes, int n_in, void* d_out, int out_size, void* d_ws, size_t ws_size, hipStream_t stream) {
    static int grid_blocks = 0;
    constexpr int LDS_BYTES = LDS_TOTAL;
    if (grid_blocks == 0) {
        if (n_in != 27 || ws_size < WS_END) { fprintf(stderr, "kernel_launch: unexpected n_in %d / ws %zu (need %zu)\n", n_in, ws_size, (size_t)WS_END); grid_blocks = -1; return; }
        if (hipFuncSetAttribute((const void*)hybrid_mega, hipFuncAttributeMaxDynamicSharedMemorySize, LDS_BYTES) != hipSuccess) { fprintf(stderr, "kernel_launch: hipFuncSetAttribute failed\n"); grid_blocks = -1; return; }
        int dev = 0, cus = 0, per_cu = 0;
        hipGetDevice(&dev);
        hipDeviceGetAttribute(&cus, hipDeviceAttributeMultiprocessorCount, dev);
        hipOccupancyMaxActiveBlocksPerMultiprocessor(&per_cu, (const void*)hybrid_mega, 512, LDS_BYTES);
        if (per_cu < 1) { fprintf(stderr, "kernel_launch: occupancy query says %d blocks/CU\n", per_cu); per_cu = 1; }
        (void)hipGetLastError();
        grid_blocks = cus;
    }
    if (grid_blocks < 0) return;
    Params p{};
    for (int i = 0; i < 27; ++i) p.in[i] = (const float*)d_in[i];
    p.out = (float*)d_out; p.ws = (unsigned char*)d_ws;
    if (hipMemsetAsync((unsigned char*)d_ws + WS_BAR, 0, 16384, stream) != hipSuccess) { fprintf(stderr, "kernel_launch: memset of the barrier words failed\n"); return; }
    void* args[] = {&p};
    hipError_t e = hipLaunchCooperativeKernel((const void*)hybrid_mega, dim3(grid_blocks), dim3(512), args, LDS_BYTES, stream);
    if (e != hipSuccess) fprintf(stderr, "cooperative launch failed: %s (grid %d)\n", hipGetErrorString(e), grid_blocks);
}
```

```cpp
#include <hip/hip_runtime.h>
#include <hip/hip_cooperative_groups.h>
#include <cstdio>
namespace cg = cooperative_groups;

#define LAS __attribute__((address_space(3)))
typedef unsigned short bf16_t;
typedef short bf16x8 __attribute__((ext_vector_type(8)));
typedef float f32x4 __attribute__((ext_vector_type(4)));
typedef unsigned u32x4 __attribute__((ext_vector_type(4)));
typedef unsigned u32x2 __attribute__((ext_vector_type(2)));

constexpr int D = 1024;
constexpr int NBATCH = 8, SEQ = 2048, NMETA = 16, DECB = 128, DECT = 4;
constexpr int XROWS = NBATCH * SEQ;
constexpr int EX_SAMP = 16, EX_SHIFT = 528, EX_END = 656;
constexpr int HROWS = 17152, HTILES = 67;
constexpr int NSEG = 8, SEGTOK = SEQ / NSEG;
constexpr int CPS = SEGTOK / 64;
constexpr int TPB = SEGTOK / 256;
constexpr int LT_PROMPT = NBATCH * TPB;
constexpr int LEX0 = LT_PROMPT * 256;
constexpr int LROWS = LEX0 + 768;
constexpr int NP = 10496, NPB = 8448, NT_IN = 41, NT_PB = 33;
constexpr int C_A = 3072, C_B = 3080, C_Z = 3088, C_RW = 4112, C_GATE_REF = 8336;
constexpr int RW_SHIFT = 4224;

constexpr size_t O_YP = 0, O_YS = 16777216, O_GDN_P = 17301504, O_CONV_P = 18350080, O_RWKV_P = 18423808, O_SHIFT_P = 18948096,
                 O_GDN_S = 18956288, O_CONV_S = 35733504, O_RWKV_S = 36913152, O_SHIFT_S = 45301760;

constexpr size_t al256(size_t x) { return (x + 255) & ~(size_t)255; }
constexpr size_t WS_WT_IN = 0;
constexpr size_t WS_WT_A = al256(WS_WT_IN + (size_t)NP * D * 2);
constexpr size_t WS_WT_B = al256(WS_WT_A + (size_t)D * D * 2);
constexpr size_t WS_WT_O = al256(WS_WT_B + (size_t)D * D * 2);
constexpr size_t WS_H = al256(WS_WT_O + (size_t)D * D * 2);
constexpr size_t WS_OB = al256(WS_H + (size_t)HROWS * D * 2);
constexpr size_t WS_P = al256(WS_OB + (size_t)HROWS * D * 2);
constexpr size_t WS_ORAW = al256(WS_P + (size_t)LROWS * NPB * 2);
constexpr size_t WS_YRAW = al256(WS_ORAW + (size_t)LROWS * D * 4);
constexpr size_t WS_C0 = al256(WS_YRAW + (size_t)LROWS * D * 4);
constexpr size_t WS_C1 = al256(WS_C0 + (size_t)LROWS * D * 2);
constexpr size_t WS_GEX = al256(WS_C1 + (size_t)LROWS * D * 2);
constexpr size_t WS_CHALO = al256(WS_GEX + (size_t)768 * 2048 * 2);
constexpr size_t WS_PHALO = al256(WS_CHALO + (size_t)2 * NBATCH * 3 * NPB * 2);
constexpr size_t WS_PK = al256(WS_PHALO + (size_t)2 * NBATCH * NPB * 2);
constexpr int PK_CONVW = 0, PK_ALOG = 12288, PK_DTB = 12296, PK_NORMW = 12304, PK_MU = 12432, PK_W0 = 16656, PK_W2 = 17680, PK_A0 = 83216, PK_A2 = 84240,
              PK_KK = 149776, PK_KA = 150800, PK_RK = 151824, PK_GNW = 152848, PK_GNB = 153872, PK_LNF = 154896, PK_END = 155920;
constexpr size_t WS_BAR = al256(WS_PK + (size_t)PK_END * 4);
constexpr size_t WS_W2T = al256(WS_BAR + 16384);
constexpr size_t WS_A2T = al256(WS_W2T + 131072);
constexpr size_t WS_GP = al256(WS_A2T + 131072);
constexpr int GP_AP = 0, GP_QH = 32768, GP_KH = 49152, GP_OH = 81920, GP_EGL = 98304, GP_G = 98560, GP_STRIDE = 114944;
constexpr int RP_AP = 0, RP_RH = 8192, RP_KH = 16384, RP_YH = 24576, RP_C1 = 32768, RP_C0 = 40960, RP_PC = 49152, RP_STRIDE = 49408;
constexpr size_t WS_RP = al256(WS_GP + (size_t)(CPS + 1) * 64 * GP_STRIDE);
constexpr size_t WS_END = al256(WS_RP + (size_t)(CPS + 1) * 128 * RP_STRIDE);
constexpr size_t WS_MG = WS_GP;
static_assert((size_t)HROWS * D * 2 <= WS_END - WS_GP, "MERGED must fit in the prep records");
static_assert((size_t)HROWS * D * 4 <= (size_t)LROWS * NPB * 2 + 2 * (size_t)LROWS * D * 4, "TMP must fit in P+ORAW+YRAW");
static_assert(WS_END <= (size_t)268435456, "workspace");

constexpr int LDS_TOTAL = 163840;
struct Params { const float* in[27]; float* out; unsigned char* ws; };

__device__ __forceinline__ float bf2f(bf16_t v) { return __uint_as_float(((unsigned)v) << 16); }
typedef __bf16 bf16n2 __attribute__((ext_vector_type(2)));
typedef float f32n2 __attribute__((ext_vector_type(2)));
__device__ __forceinline__ unsigned cvt_pk_bf16(float lo, float hi) { const f32n2 v = {lo, hi}; return __builtin_bit_cast(unsigned, __builtin_convertvector(v, bf16n2)); }
__device__ __forceinline__ unsigned pk2(float lo, float hi) { return cvt_pk_bf16(lo, hi); }
__device__ __forceinline__ unsigned f2bf(float f) { return cvt_pk_bf16(f, 0.f) & 0xffffu; }
__device__ __forceinline__ float sigm(float x) { return __builtin_amdgcn_rcpf(1.f + __expf(-x)); }
__device__ __forceinline__ float silu_(float x) { return x * __builtin_amdgcn_rcpf(1.f + __expf(-x)); }
__device__ __forceinline__ float softplus_(float x) { return fmaxf(x, 0.f) + log1pf(expf(-fabsf(x))); }
__device__ __forceinline__ float wave_sum(float v) {
#pragma unroll
    for (int o = 1; o < 64; o <<= 1) v += __shfl_xor(v, o);
    return v;
}
__device__ __forceinline__ int otid() { int t = threadIdx.x; asm volatile("" : "+v"(t)); return t; }
__device__ __forceinline__ int obid() { int t = blockIdx.x; asm volatile("" : "+s"(t)); return t; }
__device__ __forceinline__ float tanh_(float x) { const float e = __expf(2.f * x); return 1.f - 2.f * __builtin_amdgcn_rcpf(e + 1.f); }
template <int CTRL> __device__ __forceinline__ float dppf(float x) { return __builtin_bit_cast(float, __builtin_amdgcn_mov_dpp(__builtin_bit_cast(int, x), CTRL, 0xf, 0xf, true)); }
__device__ __forceinline__ float rowsum16(float x) { x += dppf<0x128>(x); x += dppf<0x124>(x); x += dppf<0x122>(x); x += dppf<0x121>(x); return x; }


#define XB_TMO      128
#define XB_XCNT(j)  (256  + 64 * (j))
#define XB_XSUB(j)  (1280 + 64 * (j))
#define XB_XGEN(j)  (2304 + 64 * (j))
#define XB_TOP      3328
#define XB_TOPGEN   3392
#define XCD_BAR_WORDS 3456
#define XB_SPIN_CAP (1u << 22)
__device__ __forceinline__ unsigned xb_ld(unsigned* p)              { return __hip_atomic_load(p, __ATOMIC_RELAXED, __HIP_MEMORY_SCOPE_AGENT); }
__device__ __forceinline__ unsigned xb_add(unsigned* p, unsigned v) { return __hip_atomic_fetch_add(p, v, __ATOMIC_RELAXED, __HIP_MEMORY_SCOPE_AGENT); }
__device__ __forceinline__ unsigned xb_xcc_id() { return (unsigned)__builtin_amdgcn_s_getreg((3 << 11) | 20) & 0xFu; }
#define XB_SPIN(cond, bar) do { unsigned _sp = 0; while (cond) { __builtin_amdgcn_s_sleep(1); \
    if ((++_sp & 255u) == 0u) { if (xb_ld(&(bar)[XB_TMO])) break; if (_sp > XB_SPIN_CAP) { atomicAdd(&(bar)[XB_TMO], 1u); break; } } } } while (0)
struct XcdBarrier { unsigned* bar; unsigned x; volatile LAS unsigned* st; };
__device__ __forceinline__ XcdBarrier xcd_barrier_post(unsigned* bar, volatile LAS unsigned* st) {
    XcdBarrier b; b.bar = bar; b.x = xb_xcc_id(); b.st = st;
    if (threadIdx.x == 0) (void)xb_add(&bar[XB_XCNT(b.x)], 1u);
    return b;
}
__device__ __forceinline__ void xcd_barrier_complete(unsigned* bar, unsigned x, unsigned& nloc, unsigned& nx) {
    const unsigned G = gridDim.x * gridDim.y * gridDim.z;
    unsigned sum, cnt, mine, sp = 0u;
    for (;;) {
        sum = 0u; cnt = 0u; mine = 0u;
#pragma unroll
        for (unsigned j = 0; j < 16; ++j) { const unsigned c = xb_ld(&bar[XB_XCNT(j)]); sum += c; cnt += (c > 0u) ? 1u : 0u; mine = (j == x) ? c : mine; }
        if (sum == G) break;
        __builtin_amdgcn_s_sleep(1);
        if ((++sp & 255u) == 0u) { if (xb_ld(&bar[XB_TMO])) break; if (sp > XB_SPIN_CAP) { atomicAdd(&bar[XB_TMO], 1u); break; } }
    }
    nloc = mine > 0u ? mine : 1u; nx = cnt > 0u ? cnt : 1u;
}
__device__ __forceinline__ void xcd_barrier(const XcdBarrier& b) {
    asm volatile("s_waitcnt vmcnt(0)" ::: "memory");
    __syncthreads();
    if (threadIdx.x == 0) {
        unsigned* bar = b.bar;
        __builtin_amdgcn_s_waitcnt(0);
        unsigned nloc = b.st[0], nx = b.st[1];
        if (nloc == 0u) { xcd_barrier_complete(bar, b.x, nloc, nx); b.st[0] = nloc; b.st[1] = nx; }
        const unsigned old = xb_add(&bar[XB_XSUB(b.x)], 1u);
        const unsigned gen = old / nloc;
        if (old + 1u == (gen + 1u) * nloc) {
            __builtin_amdgcn_fence(__ATOMIC_RELEASE, "agent");
            asm volatile("s_waitcnt vmcnt(0)" ::: "memory");
            const unsigned og = xb_add(&bar[XB_TOP], 1u);
            const unsigned tg = og / nx;
            if (og + 1u == (tg + 1u) * nx) xb_add(&bar[XB_TOPGEN], 1u);
            else XB_SPIN(xb_ld(&bar[XB_TOPGEN]) == tg, bar);
            __builtin_amdgcn_fence(__ATOMIC_ACQUIRE, "agent");
            xb_add(&bar[XB_XGEN(b.x)], 1u);
            asm volatile("s_waitcnt vmcnt(0)" ::: "memory");
        } else {
            XB_SPIN(xb_ld(&bar[XB_XGEN(b.x)]) == gen, bar);
            __builtin_amdgcn_fence(__ATOMIC_ACQUIRE, "agent");
            asm volatile("s_waitcnt vmcnt(0)" ::: "memory");
        }
    }
    __syncthreads();
}

namespace pg8 {
constexpr int BM = 256, BK = 64, HALF = 128, HTB = HALF * BK * 2, STAGE_BYTES = 8 * HTB, NXCD = 8, WGM = 8;
__device__ __forceinline__ int lds_byte(int r, int c) { const int st = (r >> 4) * 2 + (c >> 5), rr = r & 15, cc = c & 31, ob = rr * 64 + cc * 2; return st * 1024 + (ob ^ (((ob >> 9) & 1) << 5)); }
__device__ __forceinline__ void stage_rc(int b, int& R, int& C) { const int st = b / 1024, sb = b % 1024, swz = sb ^ (((sb >> 9) & 1) << 5); R = (st >> 1) * 16 + swz / 64; C = (st & 1) * 32 + (swz % 64) / 2; }
__device__ __forceinline__ int perm32(int rho) { const int n = rho >> 4, i = rho & 15; return 8 * (i >> 2) + 4 * n + (i & 3); }

struct Unit { int pm, pn, w; };
struct OrderBase {
    int nM, nN, nwg, G, c;
    __device__ void init(int nM_, int nN_, int G_, int c_) { nM = nM_; nN = nN_; nwg = nM * nN; G = G_; c = c_; }
    __device__ bool nextb(int i, Unit& u) const {
        const long L = (long)i * G + c; if (L >= nwg) return false;
        int wgid = (int)L; { const int q = nwg / NXCD, r = nwg % NXCD, xcd = wgid % NXCD, off = wgid / NXCD; wgid = (xcd < r ? xcd * (q + 1) : r * (q + 1) + (xcd - r) * q) + off; }
        const int nig = WGM * nN, gid = wgid / nig, fm = gid * WGM, gsz = (nM - fm) < WGM ? (nM - fm) : WGM;
        u.pm = fm + ((wgid % nig) % gsz); u.pn = (wgid % nig) / gsz; u.w = 0; return true;
    }
};

template <class Epi, class Sched>
__device__ __forceinline__ void gemm_phase(LAS unsigned char* lds, const int K, const Sched& S, const Epi& E) {
    const int tid = otid(), wid = __builtin_amdgcn_readfirstlane(tid >> 6), lane = tid & 63, wr = wid >> 2, wc = wid & 3, fr = lane & 15, fq = lane >> 4;
    const int nt = K / BK;
    unsigned voffA[2], voffB[2];
#pragma unroll
    for (int i = 0; i < 2; ++i) { int R, C; stage_rc(tid * 16 + i * 8192, R, C); const int Rb = Epi::PERM ? ((R & ~31) + perm32(R & 31)) : R;
        voffA[i] = (unsigned)(R * K + C) * 2u; voffB[i] = (unsigned)(Rb * K + C) * 2u; }
    const size_t kstep = (size_t)(BK * 2);
    const size_t hstep = (size_t)HALF * K * 2;
    const unsigned ldsw = (unsigned)wid * 1024u;
    const int aoff = lds_byte(wr * 64 + fr, fq * 8), boff = lds_byte(wc * 32 + fr, fq * 8);
#define PG8_SA(b, h) (((b) * 2 + (h)) * HTB)
#define PG8_SB(b, h) ((4 + (b) * 2 + (h)) * HTB)
#define PG8_STAGE(bufoff, gbase, voff) do { _Pragma("unroll") for (int _i = 0; _i < 2; ++_i) \
        __builtin_amdgcn_global_load_lds((const unsigned*)((const char*)(gbase) + (voff)[_i]), (LAS unsigned*)(lds + (bufoff) + ldsw + _i * 8192), 16, 0, 0); } while (0)
#define PG8_LDA(dst, b, h) do { _Pragma("unroll") for (int m = 0; m < 4; ++m) _Pragma("unroll") for (int k = 0; k < 2; ++k) dst[m][k] = *(const LAS bf16x8*)(lds + PG8_SA(b, h) + aoff + m * 2048 + k * 1024); } while (0)
#define PG8_LDB(dst, b, h) do { _Pragma("unroll") for (int n = 0; n < 2; ++n) _Pragma("unroll") for (int k = 0; k < 2; ++k) dst[n][k] = *(const LAS bf16x8*)(lds + PG8_SB(b, h) + boff + n * 2048 + k * 1024); } while (0)
#define PG8_MMA(ai, bj, At, Bt) do { __builtin_amdgcn_s_setprio(1); _Pragma("unroll") for (int m = 0; m < 4; ++m) _Pragma("unroll") for (int n = 0; n < 2; ++n) _Pragma("unroll") for (int k = 0; k < 2; ++k) \
        acc[ai][bj][m][n] = __builtin_amdgcn_mfma_f32_16x16x32_bf16(Bt[n][k], At[m][k], acc[ai][bj][m][n], 0, 0, 0); __builtin_amdgcn_s_setprio(0); } while (0)
#define PG8_WAIT_V(n) asm volatile("s_waitcnt vmcnt(" #n ")" ::: "memory")
#define PG8_WAIT_L(n) asm volatile("s_waitcnt lgkmcnt(" #n ")" ::: "memory")
#define PG8_BAR __builtin_amdgcn_s_barrier()
#define PG8_SCHED __builtin_amdgcn_sched_barrier(0)
    Unit cur, nxt; int ui = 0;
    if (!S.next(0, cur)) return;
    f32x4 acc[2][2][4][2];
#pragma unroll
    for (int a = 0; a < 2; ++a)
#pragma unroll
        for (int b = 0; b < 2; ++b)
#pragma unroll
            for (int m = 0; m < 4; ++m)
#pragma unroll
                for (int n = 0; n < 2; ++n) acc[a][b][m][n] = (f32x4){0.f, 0.f, 0.f, 0.f};
    bf16x8 At[4][2], B0[2][2], B1[2][2];
    const char* cA = S.a_ptr(cur); const char* cB = S.b_ptr(cur);
    PG8_STAGE(PG8_SB(0, 0), cB, voffB); PG8_STAGE(PG8_SA(0, 0), cA, voffA); PG8_STAGE(PG8_SB(0, 1), cB + hstep, voffB); PG8_STAGE(PG8_SA(0, 1), cA + hstep, voffA);
    if (wr == 1) PG8_BAR;
    PG8_WAIT_V(4); PG8_BAR;
    PG8_STAGE(PG8_SB(1, 0), cB + kstep, voffB); PG8_STAGE(PG8_SA(1, 0), cA + kstep, voffA); PG8_STAGE(PG8_SB(1, 1), cB + hstep + kstep, voffB);
    PG8_WAIT_V(6); PG8_BAR;
    for (;;) {
        const bool has_next = S.next(ui + 1, nxt);
        const char* nA = has_next ? S.a_ptr(nxt) : cA; const char* nB = has_next ? S.b_ptr(nxt) : cB;
        for (int t = 0; t < nt; t += 2) {
            const bool last = (t == nt - 2);
            const char* a1 = cA + (size_t)(t + 1) * kstep;
            const char* a2 = last ? nA : cA + (size_t)(t + 2) * kstep; const char* b2 = last ? nB : cB + (size_t)(t + 2) * kstep;
            const char* a3 = a2 + kstep; const char* b3 = b2 + kstep;
            PG8_LDB(B0, 0, 0); PG8_SCHED; PG8_LDA(At, 0, 0); PG8_STAGE(PG8_SA(1, 1), a1 + hstep, voffA);
            PG8_WAIT_L(8); PG8_BAR; PG8_WAIT_L(0); PG8_MMA(0, 0, At, B0); PG8_BAR; PG8_SCHED;
            PG8_LDB(B1, 0, 1); PG8_STAGE(PG8_SB(0, 0), b2, voffB);
            PG8_BAR; PG8_WAIT_L(0); PG8_MMA(0, 1, At, B1); PG8_BAR;
            PG8_LDA(At, 0, 1); PG8_STAGE(PG8_SA(0, 0), a2, voffA);
            PG8_BAR; PG8_WAIT_L(0); PG8_MMA(1, 0, At, B0); PG8_BAR; PG8_SCHED;
            PG8_STAGE(PG8_SB(0, 1), b2 + hstep, voffB);
            PG8_WAIT_V(6); PG8_BAR; PG8_MMA(1, 1, At, B1); PG8_BAR;
            PG8_LDB(B0, 1, 0); PG8_SCHED; PG8_LDA(At, 1, 0); PG8_STAGE(PG8_SA(0, 1), a2 + hstep, voffA);
            PG8_WAIT_L(8); PG8_BAR; PG8_WAIT_L(0); PG8_MMA(0, 0, At, B0); PG8_BAR; PG8_SCHED;
            PG8_LDB(B1, 1, 1); PG8_STAGE(PG8_SB(1, 0), b3, voffB);
            PG8_BAR; PG8_WAIT_L(0); PG8_MMA(0, 1, At, B1); PG8_BAR;
            PG8_LDA(At, 1, 1); PG8_STAGE(PG8_SA(1, 0), a3, voffA);
            PG8_BAR; PG8_WAIT_L(0); PG8_MMA(1, 0, At, B0); PG8_BAR; PG8_SCHED;
            PG8_STAGE(PG8_SB(1, 1), b3 + hstep, voffB);
            PG8_WAIT_V(6); PG8_BAR; PG8_MMA(1, 1, At, B1); PG8_BAR;
        }
        E(acc, cur, wr, wc, fr, fq);
        if (!has_next) break;
#pragma unroll
        for (int a = 0; a < 2; ++a)
#pragma unroll
            for (int b = 0; b < 2; ++b)
#pragma unroll
                for (int m = 0; m < 4; ++m)
#pragma unroll
                    for (int n = 0; n < 2; ++n) acc[a][b][m][n] = (f32x4){0.f, 0.f, 0.f, 0.f};
        cur = nxt; cA = nA; cB = nB; ++ui;
    }
    PG8_WAIT_V(0);
    if (wr == 0) PG8_BAR;
    PG8_BAR;
#undef PG8_SA
#undef PG8_SB
#undef PG8_STAGE
#undef PG8_LDA
#undef PG8_LDB
#undef PG8_MMA
#undef PG8_WAIT_V
#undef PG8_WAIT_L
#undef PG8_BAR
#undef PG8_SCHED
}
}
using pg8::Unit;

struct SchedIn {
    pg8::OrderBase ob; int seg; const char* A; const char* B;
    __device__ bool next(int i, Unit& u) const { return ob.nextb(i, u); }
    __device__ const char* a_ptr(const Unit& u) const {
        const int gt = u.pm < LT_PROMPT ? ((u.pm / TPB) * (SEQ / 256) + seg * TPB + (u.pm % TPB)) : (XROWS / 256 + (u.pm - LT_PROMPT));
        return A + (size_t)gt * 256 * D * 2; }
    __device__ const char* b_ptr(const Unit& u) const { return B + (size_t)u.pn * 256 * D * 2; }
};
struct SchedAB {
    pg8::OrderBase ob; int pm0; const char* A0; const char* A1; const char* B0; const char* B1;
    __device__ bool next(int i, Unit& u) const { const bool ok = ob.nextb(i >> 1, u); u.pm += pm0; u.w = i & 1; return ok; }
    __device__ const char* a_ptr(const Unit& u) const { return (u.w ? A1 : A0) + (size_t)u.pm * 256 * D * 2; }
    __device__ const char* b_ptr(const Unit& u) const { return (u.w ? B1 : B0) + (size_t)u.pn * 256 * D * 2; }
};
struct SchedO {
    pg8::OrderBase ob; int pm0; const char* A; const char* B;
    __device__ bool next(int i, Unit& u) const { const bool ok = ob.nextb(i, u); u.pm += pm0; return ok; }
    __device__ const char* a_ptr(const Unit& u) const { return A + (size_t)u.pm * 256 * D * 2; }
    __device__ const char* b_ptr(const Unit& u) const { return B + (size_t)u.pn * 256 * D * 2; }
};

struct EpiIn {
    static constexpr bool PERM = true;
    bf16_t* P; bf16_t* gex; float* out; int seg;
    __device__ __forceinline__ void operator()(const f32x4 (&acc)[2][2][4][2], const Unit& u, int wr, int wc, int fr, int fq) const {
        const int lr0 = u.pm * 256 + wr * 64 + fr;
        const int c0 = u.pn * 256 + wc * 32 + 8 * fq;
#pragma unroll
        for (int ai = 0; ai < 2; ++ai)
#pragma unroll
            for (int m = 0; m < 4; ++m) {
                const int lr = lr0 + ai * 128 + m * 16;
                bf16_t* rowp;
                if (u.pn < NT_PB) rowp = P + (size_t)lr * NPB + c0;
                else if (lr < LEX0) { const int b = lr / SEGTOK; const size_t grow = (size_t)b * SEQ + seg * SEGTOK + (lr % SEGTOK); rowp = (bf16_t*)(out + O_YP + grow * D) + (c0 - NPB); }
                else rowp = gex + (size_t)(lr - LEX0) * 2048 + (c0 - NPB);
#pragma unroll
                for (int bj = 0; bj < 2; ++bj) { const f32x4 v0 = acc[ai][bj][m][0], v1 = acc[ai][bj][m][1];
                    u32x4 w; w.x = cvt_pk_bf16(v0[0], v0[1]); w.y = cvt_pk_bf16(v0[2], v0[3]); w.z = cvt_pk_bf16(v1[0], v1[1]); w.w = cvt_pk_bf16(v1[2], v1[3]);
                    *(u32x4*)(rowp + bj * 128) = w; }
            }
    }
};
struct EpiAB {
    static constexpr bool PERM = false;
    float* tmp; bf16_t* merged; const bf16_t* gex; const float* out;
    __device__ __forceinline__ void operator()(const f32x4 (&acc)[2][2][4][2], const Unit& u, int wr, int wc, int fr, int fq) const {
        const int row0 = u.pm * 256 + wr * 64 + fr, col0 = u.pn * 256 + wc * 32 + 4 * fq;
#pragma unroll
        for (int ai = 0; ai < 2; ++ai)
#pragma unroll
            for (int m = 0; m < 4; ++m) {
                const int grow = row0 + ai * 128 + m * 16;
                const bf16_t* gp = (grow < XROWS) ? ((const bf16_t*)(out + O_YP + (size_t)grow * D) + u.w * D) : (gex + (size_t)(grow - XROWS) * 2048 + u.w * D);
#pragma unroll
                for (int bj = 0; bj < 2; ++bj)
#pragma unroll
                    for (int n = 0; n < 2; ++n) {
                        const int c = col0 + bj * 128 + n * 16;
                        const u32x2 g = *(const u32x2*)(gp + c);
                        f32x4 v = acc[ai][bj][m][n];
                        v[0] *= sigm(__uint_as_float(g.x << 16)); v[1] *= sigm(__uint_as_float(g.x & 0xffff0000u));
                        v[2] *= sigm(__uint_as_float(g.y << 16)); v[3] *= sigm(__uint_as_float(g.y & 0xffff0000u));
                        float* tp = tmp + (size_t)grow * D + c;
                        if (u.w == 0) *(f32x4*)tp = v;
                        else { const f32x4 t = *(const f32x4*)tp; v = v + t; u32x2 o; o.x = cvt_pk_bf16(v[0], v[1]); o.y = cvt_pk_bf16(v[2], v[3]); *(u32x2*)(merged + (size_t)grow * D + c) = o; }
                    }
            }
    }
};
struct EpiO {
    static constexpr bool PERM = false;
    float* out; const float* xp; const float* xs;
    __device__ __forceinline__ void operator()(const f32x4 (&acc)[2][2][4][2], const Unit& u, int wr, int wc, int fr, int fq) const {
        const int row0 = u.pm * 256 + wr * 64 + fr, col0 = u.pn * 256 + wc * 32 + 4 * fq;
#pragma unroll
        for (int ai = 0; ai < 2; ++ai)
#pragma unroll
            for (int m = 0; m < 4; ++m) {
                const int grow = row0 + ai * 128 + m * 16;
                const float* xr; float* yr;
                if (grow < XROWS) { xr = xp + (size_t)grow * D; yr = out + O_YP + (size_t)grow * D; }
                else { const int e = grow - XROWS; if (e < EX_SAMP || e >= EX_SHIFT) continue; xr = xs + (size_t)(e - EX_SAMP) * D; yr = out + O_YS + (size_t)(e - EX_SAMP) * D; }
#pragma unroll
                for (int bj = 0; bj < 2; ++bj)
#pragma unroll
                    for (int n = 0; n < 2; ++n) { const int c = col0 + bj * 128 + n * 16; *(f32x4*)(yr + c) = *(const f32x4*)(xr + c) + acc[ai][bj][m][n]; }
            }
    }
};

__device__ __forceinline__ void p0_row(const Params& p, int r, int lane) {
    bf16_t* hrow = (bf16_t*)(p.ws + WS_H) + (size_t)r * D;
    const float* src = nullptr; bool norm = true; float* sh = nullptr;
    if (r < XROWS) { src = p.in[0] + (size_t)r * D; if ((r & (SEQ - 1)) == SEQ - 1) sh = p.out + O_SHIFT_P + (size_t)(r / SEQ) * D; }
    else { const int e = r - XROWS;
        if (e < EX_SAMP) src = p.in[6] + (size_t)e * D;
        else if (e < EX_SHIFT) { src = p.in[1] + (size_t)(e - EX_SAMP) * D; if (((e - EX_SAMP) & 3) == 3) sh = p.out + O_SHIFT_S + (size_t)((e - EX_SAMP) >> 2) * D; }
        else if (e < EX_END) { src = p.in[5] + (size_t)(e - EX_SHIFT) * D; norm = false; } }
    u32x2* o8 = (u32x2*)hrow + lane;
    if (!src) {
#pragma unroll
        for (int j = 0; j < 4; ++j) o8[64 * j] = (u32x2){0u, 0u};
        return; }
    const f32x4* xr = (const f32x4*)src + lane;
    f32x4 v[4]; float ss = 0.f;
#pragma unroll
    for (int j = 0; j < 4; ++j) { v[j] = xr[64 * j]; ss += v[j][0] * v[j][0] + v[j][1] * v[j][1] + v[j][2] * v[j][2] + v[j][3] * v[j][3]; }
    if (norm) {
        const float rs = __builtin_amdgcn_rsqf(wave_sum(ss) * (1.f / D) + 1e-6f);
        const f32x4* wr = (const f32x4*)p.in[7] + lane;
#pragma unroll
        for (int j = 0; j < 4; ++j) v[j] = v[j] * rs * wr[64 * j];
    }
#pragma unroll
    for (int j = 0; j < 4; ++j) { o8[64 * j] = (u32x2){pk2(v[j][0], v[j][1]), pk2(v[j][2], v[j][3])}; if (sh) ((f32x4*)sh)[lane + 64 * j] = v[j]; }
}
template <int MODE> __device__ __forceinline__ void p0_tr_item(const float* W, int N, bf16_t* WT, float* scr, int kb, int nb, int lane) {
    const int k0 = 64 * kb, n0 = 32 * nb;
    const int nn = n0 + (lane & 31);
    int srcc = nn;
    if (MODE == 1) srcc = nn < C_GATE_REF ? nn : (nn < NPB ? -1 : nn - (NPB - C_GATE_REF));
#pragma unroll 8
    for (int i = 0; i < 32; ++i) { const int kk = 2 * i + (lane >> 5); scr[kk * 33 + (lane & 31)] = srcc >= 0 ? W[(size_t)(k0 + kk) * N + srcc] : 0.f; }
    asm volatile("s_waitcnt lgkmcnt(0)" ::: "memory");
    const int c = lane & 7;
#pragma unroll
    for (int j = 0; j < 4; ++j) { const int n = (lane >> 3) + 8 * j; const float* s = scr + (8 * c) * 33 + n;
        u32x4 o; o.x = pk2(s[0 * 33], s[1 * 33]); o.y = pk2(s[2 * 33], s[3 * 33]); o.z = pk2(s[4 * 33], s[5 * 33]); o.w = pk2(s[6 * 33], s[7 * 33]);
        *(u32x4*)(WT + (size_t)(n0 + n) * D + k0 + 8 * c) = o; }
    asm volatile("s_waitcnt lgkmcnt(0)" ::: "memory");
}
__device__ __forceinline__ void phase0(const Params& p, unsigned char* smem) {
    const int tid0 = otid(), wave = tid0 >> 6, lane = tid0 & 63;
    const int gw = obid() * 8 + wave, NGW = gridDim.x * 8;
    float* scr = (float*)smem + wave * (64 * 33);
    constexpr int I_IN = 16 * (NP / 32), I_SQ = 16 * 32;
    for (int it = gw; it < I_IN + 3 * I_SQ; it += NGW) {
        int r = it;
        if (r < I_IN) { p0_tr_item<1>(p.in[8], 10384, (bf16_t*)(p.ws + WS_WT_IN), scr, r / (NP / 32), r % (NP / 32), lane); continue; } r -= I_IN;
        if (r < I_SQ) { p0_tr_item<0>(p.in[13], D, (bf16_t*)(p.ws + WS_WT_A), scr, r / 32, r % 32, lane); continue; } r -= I_SQ;
        if (r < I_SQ) { p0_tr_item<0>(p.in[24], D, (bf16_t*)(p.ws + WS_WT_B), scr, r / 32, r % 32, lane); continue; } r -= I_SQ;
        p0_tr_item<0>(p.in[25], D, (bf16_t*)(p.ws + WS_WT_O), scr, r / 32, r % 32, lane);
    }
    {
        const f32x4* lw = (const f32x4*)p.in[7] + lane;
        f32x4 wv[4];
#pragma unroll
        for (int j = 0; j < 4; ++j) wv[j] = lw[64 * j];
#pragma unroll 1
        for (int r = gw; r < XROWS; r += 2 * NGW) {
            const int r1 = r + NGW; const bool has1 = r1 < XROWS;
            const f32x4* x0 = (const f32x4*)(p.in[0] + (size_t)r * D) + lane; const f32x4* x1 = (const f32x4*)(p.in[0] + (size_t)(has1 ? r1 : r) * D) + lane;
            f32x4 a[4], b[4]; float s0 = 0.f, s1 = 0.f;
#pragma unroll
            for (int j = 0; j < 4; ++j) { a[j] = x0[64 * j]; b[j] = x1[64 * j]; }
#pragma unroll
            for (int j = 0; j < 4; ++j) { s0 += a[j][0] * a[j][0] + a[j][1] * a[j][1] + a[j][2] * a[j][2] + a[j][3] * a[j][3]; s1 += b[j][0] * b[j][0] + b[j][1] * b[j][1] + b[j][2] * b[j][2] + b[j][3] * b[j][3]; }
            const float q0 = __builtin_amdgcn_rsqf(wave_sum(s0) * (1.f / D) + 1e-6f), q1 = __builtin_amdgcn_rsqf(wave_sum(s1) * (1.f / D) + 1e-6f);
            u32x2* o0 = (u32x2*)((bf16_t*)(p.ws + WS_H) + (size_t)r * D) + lane; u32x2* o1 = (u32x2*)((bf16_t*)(p.ws + WS_H) + (size_t)r1 * D) + lane;
#pragma unroll
            for (int j = 0; j < 4; ++j) { a[j] = a[j] * q0 * wv[j]; o0[64 * j] = (u32x2){pk2(a[j][0], a[j][1]), pk2(a[j][2], a[j][3])}; }
            if ((r & (SEQ - 1)) == SEQ - 1) { f32x4* sh = (f32x4*)(p.out + O_SHIFT_P + (size_t)(r / SEQ) * D) + lane;
#pragma unroll
                for (int j = 0; j < 4; ++j) sh[64 * j] = a[j]; }
            if (has1) {
#pragma unroll
                for (int j = 0; j < 4; ++j) { b[j] = b[j] * q1 * wv[j]; o1[64 * j] = (u32x2){pk2(b[j][0], b[j][1]), pk2(b[j][2], b[j][3])}; }
                if ((r1 & (SEQ - 1)) == SEQ - 1) { f32x4* sh = (f32x4*)(p.out + O_SHIFT_P + (size_t)(r1 / SEQ) * D) + lane;
#pragma unroll
                    for (int j = 0; j < 4; ++j) sh[64 * j] = b[j]; }
            }
        }
    }
    for (int r = XROWS + gw; r < HROWS; r += NGW) p0_row(p, r, lane);
    {
        float* pk = (float*)(p.ws + WS_PK);
        const int gt = obid() * 512 + tid0, NT = gridDim.x * 512;
        for (int i = gt; i < PK_END; i += NT) {
            const float* src; int o;
            if (i < PK_ALOG) { src = p.in[9]; o = i - PK_CONVW; } else if (i < PK_DTB) { src = p.in[10]; o = i - PK_ALOG; } else if (i < PK_NORMW) { src = p.in[11]; o = i - PK_DTB; }
            else if (i < PK_MU) { src = p.in[12]; o = i - PK_NORMW; } else if (i < PK_W0) { src = p.in[14]; o = i - PK_MU; } else if (i < PK_W2) { src = p.in[15]; o = i - PK_W0; }
            else if (i < PK_A0) { src = p.in[16]; o = i - PK_W2; } else if (i < PK_A2) { src = p.in[17]; o = i - PK_A0; } else if (i < PK_KK) { src = p.in[18]; o = i - PK_A2; }
            else if (i < PK_KA) { src = p.in[19]; o = i - PK_KK; } else if (i < PK_RK) { src = p.in[20]; o = i - PK_KA; } else if (i < PK_GNW) { src = p.in[21]; o = i - PK_RK; }
            else if (i < PK_GNB) { src = p.in[22]; o = i - PK_GNW; } else if (i < PK_LNF) { src = p.in[23]; o = i - PK_GNB; } else { src = p.in[26]; o = i - PK_LNF; }
            pk[i] = src[o];
        }
        bf16_t* w2t = (bf16_t*)(p.ws + WS_W2T); bf16_t* a2t = (bf16_t*)(p.ws + WS_A2T);
        for (int i = gt; i < 65536; i += NT) { const int l = i & 63, c = (i >> 6) & 63, hb = i >> 12;
            w2t[i] = (bf16_t)f2bf(p.in[16][(size_t)l * D + hb * 64 + c]); a2t[i] = (bf16_t)f2bf(p.in[18][(size_t)l * D + hb * 64 + c]); }
    }
}

__device__ __forceinline__ void gdn_item(const Params& p, unsigned char* smem, const float* s_in, float* s_out, const float* halo_in, float* halo_out,
                                         int h, int sl, int rowA, int nA, int rowB, int nB) {
    const int tid = otid(), w = tid >> 6, lane = tid & 63, vl = lane >> 4, kg = lane & 15;
    float* qk_s = (float*)smem; float* v_s = qk_s + 16384; float* o_s = v_s + 2048; float* gb_s = o_s + 2048; float* sst = gb_s + 128;
    const bf16_t* P = (const bf16_t*)(p.ws + WS_P);
    float* ORAW = (float*)(p.ws + WS_ORAW);
    float s[8];
    if (s_in) {
        { const int k = tid >> 2, q4 = tid & 3; const f32x4* src = (const f32x4*)(s_in + (size_t)k * 128 + sl * 32 + q4 * 8); const f32x4 a = src[0], b = src[1];
          float* d = sst + k * 33 + q4 * 8; d[0] = a[0]; d[1] = a[1]; d[2] = a[2]; d[3] = a[3]; d[4] = b[0]; d[5] = b[1]; d[6] = b[2]; d[7] = b[3]; }
        __syncthreads();
#pragma unroll
        for (int j = 0; j < 8; ++j) s[j] = sst[(kg * 8 + j) * 33 + 4 * w + vl];
        __syncthreads();
    } else {
#pragma unroll
        for (int j = 0; j < 8; ++j) s[j] = 0.f;
    }
    int pcol = -1;
    if (tid < 128) pcol = h * 128 + tid; else if (tid < 256) pcol = 1024 + h * 128 + (tid - 128); else if (tid < 288) pcol = 2048 + h * 128 + sl * 32 + (tid - 256);
    float cw0 = 0.f, cw1 = 0.f, cw2 = 0.f, cw3 = 0.f, x1 = 0.f, x2 = 0.f, x3 = 0.f;
    const float* pk = (const float*)(p.ws + WS_PK);
    if (pcol >= 0) { const float* cw = pk + PK_CONVW; cw0 = cw[pcol]; cw1 = cw[3072 + pcol]; cw2 = cw[6144 + pcol]; cw3 = cw[9216 + pcol];
        if (halo_in) { x3 = halo_in[pcol]; x2 = halo_in[3072 + pcol]; x1 = halo_in[6144 + pcol]; } }
    const float nalog = -expf(pk[PK_ALOG + h]), dtb = pk[PK_DTB + h];
#pragma unroll 1
    for (int run = 0; run < 2; ++run) {
        const int rrow = run ? rowB : rowA, rn = run ? nB : nA; const bool wout = run != 0;
#pragma unroll 1
        for (int c0 = 0; c0 < rn; c0 += 64) {
            const int nt = (rn - c0) < 64 ? (rn - c0) : 64; const int row = rrow + c0;
            if (pcol >= 0) {
                const bf16_t* src = P + (size_t)row * NPB + pcol;
                float* dst = tid < 256 ? (qk_s + tid) : (v_s + (tid - 256)); const int dstride = tid < 256 ? 256 : 32;
#pragma unroll 8
                for (int i = 0; i < nt; ++i) { const float x0 = bf2f(src[(size_t)i * NPB]); const float y = cw0 * x3 + cw1 * x2 + cw2 * x1 + cw3 * x0; x3 = x2; x2 = x1; x1 = x0; dst[i * dstride] = silu_(y); }
            } else if (tid < 352) {
                const int i = tid - 288;
                if (i < nt) { const float pa = bf2f(P[(size_t)(row + i) * NPB + C_A + h]), pb = bf2f(P[(size_t)(row + i) * NPB + C_B + h]);
                    gb_s[2 * i] = expf(nalog * softplus_(pa + dtb)); gb_s[2 * i + 1] = sigm(pb); }
            }
            __syncthreads();
#pragma unroll 1
            for (int ii = 0; ii < 8; ++ii) { const int i = w * 8 + ii;
                if (i < nt) {
#pragma unroll
                    for (int which = 0; which < 2; ++which) { float* rp = qk_s + i * 256 + which * 128; const float a = rp[lane], b = rp[lane + 64];
                        const float sc = __builtin_amdgcn_rsqf(wave_sum(a * a + b * b) + 1e-6f) * (which == 0 ? 0.08838834764831845f : 1.f); rp[lane] = a * sc; rp[lane + 64] = b * sc; } } }
            __syncthreads();
#pragma unroll 1
            for (int i = 0; i < nt; ++i) {
                const f32x4 q0 = *(const f32x4*)(qk_s + i * 256 + kg * 8), q1 = *(const f32x4*)(qk_s + i * 256 + kg * 8 + 4);
                const f32x4 k0 = *(const f32x4*)(qk_s + i * 256 + 128 + kg * 8), k1 = *(const f32x4*)(qk_s + i * 256 + 128 + kg * 8 + 4);
                const float vv = v_s[i * 32 + 4 * w + vl], a = gb_s[2 * i], be = gb_s[2 * i + 1];
                float part = k0[0] * s[0] + k0[1] * s[1] + k0[2] * s[2] + k0[3] * s[3] + k1[0] * s[4] + k1[1] * s[5] + k1[2] * s[6] + k1[3] * s[7];
                const float kS = rowsum16(part);
                const float c = be * (vv - a * kS);
                s[0] = a * s[0] + k0[0] * c; s[1] = a * s[1] + k0[1] * c; s[2] = a * s[2] + k0[2] * c; s[3] = a * s[3] + k0[3] * c;
                s[4] = a * s[4] + k1[0] * c; s[5] = a * s[5] + k1[1] * c; s[6] = a * s[6] + k1[2] * c; s[7] = a * s[7] + k1[3] * c;
                float op = q0[0] * s[0] + q0[1] * s[1] + q0[2] * s[2] + q0[3] * s[3] + q1[0] * s[4] + q1[1] * s[5] + q1[2] * s[6] + q1[3] * s[7];
                const float o = rowsum16(op);
                if (kg == 0) o_s[i * 32 + 4 * w + vl] = o;
            }
            __syncthreads();
            if (wout) { const int i = tid >> 3, c4 = (tid & 7) * 4; if (i < nt) *(f32x4*)(ORAW + (size_t)(row + i) * D + h * 128 + sl * 32 + c4) = *(const f32x4*)(o_s + i * 32 + c4); }
        }
    }
    if (pcol >= 0 && (sl == 0 || tid >= 256)) { halo_out[pcol] = x3; halo_out[3072 + pcol] = x2; halo_out[6144 + pcol] = x1; }
#pragma unroll
    for (int j = 0; j < 8; ++j) sst[(kg * 8 + j) * 33 + 4 * w + vl] = s[j];
    __syncthreads();
    { const int k = tid >> 2, q4 = tid & 3; const float* d = sst + k * 33 + q4 * 8; f32x4* dst = (f32x4*)(s_out + (size_t)k * 128 + sl * 32 + q4 * 8);
      dst[0] = (f32x4){d[0], d[1], d[2], d[3]}; dst[1] = (f32x4){d[4], d[5], d[6], d[7]}; }
    __syncthreads();
}

constexpr int RW_W2 = 20544, RW_A2 = 24640;
__device__ __forceinline__ void rwkv_load_lora(const Params& p, unsigned char* smem, int hb) {
    float* w2_s = (float*)smem + RW_W2; float* a2_s = (float*)smem + RW_A2; const float* pk = (const float*)(p.ws + WS_PK);
    for (int i = otid(); i < 4096; i += 512) { const int l = i >> 6, c = i & 63; w2_s[i] = pk[PK_W2 + l * D + hb * 64 + c]; a2_s[i] = pk[PK_A2 + l * D + hb * 64 + c]; }
    __syncthreads();
}
__device__ __forceinline__ void rwkv_item(const Params& p, unsigned char* smem, const float* s_in, float* s_out, const bf16_t* prev_row, const float* halo_in, float* halo_out,
                                          int hb, int half, int rowA, int nA, int rowB, int nB) {
    const int tid = otid(), w = tid >> 6, lane = tid & 63, row = tid >> 4, kq = tid & 15;
    float* f = (float*)smem;
    float* r_s = f; float* kb_s = f + 2048; float* v_s = f + 4096; float* wd_s = f + 6144; float* ad_s = f + 8192; float* dec_s = f + 10240; float* a_s = f + 12288;
    float* kk_s = f + 14336; float* km_s = f + 16384; float* zb_s = f + 18432; float* y_s = f + 19456; float* bonus_s = f + 20480;
    const float* w2_s = f + RW_W2; const float* a2_s = f + RW_A2;
    const bf16_t* P = (const bf16_t*)(p.ws + WS_P);
    float* YRAW = (float*)(p.ws + WS_YRAW); bf16_t* C0 = (bf16_t*)(p.ws + WS_C0); bf16_t* C1 = (bf16_t*)(p.ws + WS_C1);
    float s[4];
    if (s_in) { const f32x4 t = *(const f32x4*)(s_in + (size_t)(half * 32 + row) * 64 + kq * 4); s[0] = t[0]; s[1] = t[1]; s[2] = t[2]; s[3] = t[3]; }
    else { s[0] = s[1] = s[2] = s[3] = 0.f; }
    int col = -1; float* dst = nullptr; int dstride = 64; bool is_wd = false, owner = false;
    if (tid < 64) { col = hb * 64 + tid; dst = r_s + tid; owner = half == 0; }
    else if (tid < 128) { col = 1024 + hb * 64 + (tid - 64); dst = kb_s + (tid - 64); owner = half == 0; }
    else if (tid < 192) { col = 2048 + hb * 64 + (tid - 128); dst = v_s + (tid - 128); owner = half == 0; }
    else if (tid < 256) { col = 3072 + (tid - 192); dst = wd_s + (tid - 192); is_wd = true; owner = (half == 0 && hb == 0); }
    else if (tid < 320) { col = 3136 + (tid - 256); dst = ad_s + (tid - 256); owner = (half == 0 && hb == 0); }
    else if (tid < 352) { col = 3200 + hb * 64 + half * 32 + (tid - 320); dst = zb_s + (tid - 320); dstride = 32; owner = true; }
    float mu = 0.f, prev = 0.f;
    const float* pk = (const float*)(p.ws + WS_PK);
    if (col >= 0) { mu = pk[PK_MU + col]; prev = prev_row ? bf2f(prev_row[C_RW + col]) : (halo_in ? halo_in[col] : 0.f); }
    const int cc = tid & 63, ig = tid >> 6;
    const int hc = hb * 64 + cc;
    const float w0c = pk[PK_W0 + hc], a0c = pk[PK_A0 + hc], kkc = pk[PK_KK + hc], kac = pk[PK_KA + hc];
    const float rkl = pk[PK_RK + hb * 64 + lane];
#pragma unroll 1
    for (int run = 0; run < 2; ++run) {
        const int rrow = run ? rowB : rowA, rn = run ? nB : nA; const bool wout = run != 0;
#pragma unroll 1
        for (int c0 = 0; c0 < rn; c0 += 32) {
            const int nt = (rn - c0) < 32 ? (rn - c0) : 32; const int row0 = rrow + c0;
            if (col >= 0) {
                const bf16_t* src = P + (size_t)row0 * NPB + C_RW + col;
#pragma unroll 8
                for (int i = 0; i < nt; ++i) { const float cur = bf2f(src[(size_t)i * NPB]); float m = cur + mu * (prev - cur); prev = cur; if (is_wd) m = tanh_(m); dst[i * dstride] = m; }
            }
            __syncthreads();
            {
                float aw[4] = {0.f, 0.f, 0.f, 0.f}, aa[4] = {0.f, 0.f, 0.f, 0.f};
#pragma unroll 4
                for (int l = 0; l < 64; ++l) { const float w2v = w2_s[l * 64 + cc], a2v = a2_s[l * 64 + cc];
#pragma unroll
                    for (int ii = 0; ii < 4; ++ii) { aw[ii] += wd_s[(ig * 4 + ii) * 64 + l] * w2v; aa[ii] += ad_s[(ig * 4 + ii) * 64 + l] * a2v; } }
#pragma unroll
                for (int ii = 0; ii < 4; ++ii) { const int i = ig * 4 + ii;
                    if (i < nt) { const float wraw = w0c + aw[ii]; const float wlog = -0.6065306597126334f * sigm(wraw); const float a = sigm(a0c + aa[ii]);
                        const float kbv = kb_s[i * 64 + cc];
                        dec_s[i * 64 + cc] = expf(wlog); a_s[i * 64 + cc] = a; kk_s[i * 64 + cc] = kbv * kkc; km_s[i * 64 + cc] = kbv * (1.f + (a - 1.f) * kac); } }
            }
            __syncthreads();
#pragma unroll 1
            for (int ii = 0; ii < 4; ++ii) { const int i = w * 4 + ii;
                if (i < nt) { const float kkr = kk_s[i * 64 + lane]; const float kk = kkr * __builtin_amdgcn_rsqf(wave_sum(kkr * kkr) + 1e-6f); kk_s[i * 64 + lane] = kk;
                    const float a = a_s[i * 64 + lane]; a_s[i * 64 + lane] = kk * a;
                    const float rk = wave_sum(r_s[i * 64 + lane] * km_s[i * 64 + lane] * rkl); if (lane == 0) bonus_s[i] = rk; } }
            __syncthreads();
#pragma unroll 1
            for (int i = 0; i < nt; ++i) {
                const f32x4 kk4 = *(const f32x4*)(kk_s + i * 64 + kq * 4), de4 = *(const f32x4*)(dec_s + i * 64 + kq * 4), ka4 = *(const f32x4*)(a_s + i * 64 + kq * 4),
                            km4 = *(const f32x4*)(km_s + i * 64 + kq * 4), r4 = *(const f32x4*)(r_s + i * 64 + kq * 4);
                const float vv = v_s[i * 64 + half * 32 + row];
                const float sa = rowsum16(s[0] * kk4[0] + s[1] * kk4[1] + s[2] * kk4[2] + s[3] * kk4[3]);
#pragma unroll
                for (int j = 0; j < 4; ++j) s[j] = s[j] * de4[j] + (vv * km4[j] - sa * ka4[j]);
                const float y = rowsum16(s[0] * r4[0] + s[1] * r4[1] + s[2] * r4[2] + s[3] * r4[3]);
                if (kq == 0) y_s[i * 32 + row] = y;
            }
            __syncthreads();
            if (wout) { const int i = tid >> 4;
                if (i < nt) {
#pragma unroll
                    for (int q = 0; q < 2; ++q) { const int rr = (tid & 15) * 2 + q, v = half * 32 + rr, colo = hb * 64 + v;
                        const float sz = silu_(zb_s[i * 32 + rr]);
                        const size_t o = (size_t)(row0 + i) * D + colo;
                        YRAW[o] = y_s[i * 32 + rr]; C1[o] = (bf16_t)f2bf(pk[PK_GNW + colo] * sz); C0[o] = (bf16_t)f2bf((pk[PK_GNB + colo] + bonus_s[i] * v_s[i * 64 + v]) * sz); } } }
            __syncthreads();
        }
    }
    *(f32x4*)(s_out + (size_t)(half * 32 + row) * 64 + kq * 4) = (f32x4){s[0], s[1], s[2], s[3]};
    if (col >= 0 && owner && halo_out) halo_out[col] = prev;
}


__device__ __forceinline__ bf16x8 ldfrag(const bf16_t* base, int stride, int r0, int k0, int lane) {
    return *(const bf16x8*)(base + (r0 + (lane & 15)) * stride + k0 + 8 * (lane >> 4));
}
#define MFMA16(a, b, c) __builtin_amdgcn_mfma_f32_16x16x32_bf16((a), (b), (c), 0, 0, 0)
typedef short s16x4 __attribute__((ext_vector_type(4)));
__device__ __forceinline__ bf16x8 ldfrag_tr(const bf16_t* X, int stride, int c0, int k0, int lane) {
    const int l15 = lane & 15;
    const bf16_t* a = X + (k0 + 8 * (lane >> 4) + (l15 >> 2)) * stride + c0 + 4 * (l15 & 3);
    const s16x4 lo = __builtin_amdgcn_ds_read_tr16_b64_v4i16((LAS s16x4*)a), hi = __builtin_amdgcn_ds_read_tr16_b64_v4i16((LAS s16x4*)(a + 4 * stride));
    return __builtin_shufflevector(lo, hi, 0, 1, 2, 3, 4, 5, 6, 7);
}
__device__ __forceinline__ void inv_block(const float* L, float* Tm, float* XS, int tid) {
    const int w = tid >> 6, lane = tid & 63;
    if (w < 4 && lane < 16) {
        const float* Lb = L + (16 * w) * 64 + 16 * w; float* Tb = Tm + (16 * w) * 64 + 16 * w;
        float tr[16];
#pragma unroll
        for (int i = 0; i < 16; ++i) { float a = (lane == i) ? 1.f : 0.f;
#pragma unroll
            for (int j = 0; j < i; ++j) a -= Lb[i * 64 + j] * tr[j];
            tr[i] = a; Tb[i * 64 + lane] = a; }
    }
    for (int e = tid; e < 1536; e += 512) { const int k = e >> 8, r = (e >> 4) & 15, c = e & 15;
        const int rb = k < 3 ? 0 : (k < 5 ? 1 : 2), cb = k < 3 ? k + 1 : (k < 5 ? k - 1 : 3);
        Tm[(16 * rb + r) * 64 + 16 * cb + c] = 0.f; }
    __syncthreads();
    {
        const int B = tid >> 8, i = (tid >> 4) & 15, c = tid & 15, o = 32 * B;
        float x = 0.f;
#pragma unroll
        for (int j = 0; j < 16; ++j) x += L[(o + 16 + i) * 64 + o + j] * Tm[(o + j) * 64 + o + c];
        XS[tid] = x;
        __syncthreads();
        float t = 0.f;
#pragma unroll
        for (int j = 0; j < 16; ++j) t += Tm[(o + 16 + i) * 64 + o + 16 + j] * XS[(B << 8) + j * 16 + c];
        Tm[(o + 16 + i) * 64 + o + c] = -t;
    }
    __syncthreads();
    {
        const int i = tid >> 4, c2 = (tid & 15) * 2;
        float x0 = 0.f, x1 = 0.f;
#pragma unroll 8
        for (int j = 0; j < 32; ++j) { const float l = L[(32 + i) * 64 + j]; x0 += l * Tm[j * 64 + c2]; x1 += l * Tm[j * 64 + c2 + 1]; }
        XS[i * 32 + c2] = x0; XS[i * 32 + c2 + 1] = x1;
        __syncthreads();
        float t0 = 0.f, t1 = 0.f;
#pragma unroll 8
        for (int j = 0; j < 32; ++j) { const float tv = Tm[(32 + i) * 64 + 32 + j]; t0 += tv * XS[j * 32 + c2]; t1 += tv * XS[j * 32 + c2 + 1]; }
        Tm[(32 + i) * 64 + c2] = -t0; Tm[(32 + i) * 64 + c2 + 1] = -t1;
    }
    __syncthreads();
}
__device__ __forceinline__ void unpack8(const u32x4 rw, float (&x)[8]) {
    x[0] = __uint_as_float(rw.x << 16); x[1] = __uint_as_float(rw.x & 0xffff0000u); x[2] = __uint_as_float(rw.y << 16); x[3] = __uint_as_float(rw.y & 0xffff0000u);
    x[4] = __uint_as_float(rw.z << 16); x[5] = __uint_as_float(rw.z & 0xffff0000u); x[6] = __uint_as_float(rw.w << 16); x[7] = __uint_as_float(rw.w & 0xffff0000u); }
__device__ __forceinline__ u32x4 pack8(const float (&x)[8]) { return (u32x4){pk2(x[0], x[1]), pk2(x[2], x[3]), pk2(x[4], x[5]), pk2(x[6], x[7])}; }

constexpr int PL_QS = 0, PL_R1 = 17408, PL_KT = 35840, PL_KTT = 54272, PL_VT = 72704, PL_R3 = 91136, PL_QKM = 109568, PL_TP = 118784, PL_TPP = 128000, PL_SM = 137216, PL_TM = 139264, PL_XS = 155648;
constexpr int QSTR = 136, TSTR = 72;

__device__ __forceinline__ void gdn_prep_item(const Params& p, unsigned char* smem, int h, int row_start, int npad, const bf16_t* hbase,
                                              bf16_t* halo_out, float* conv_out, unsigned char* rec) {
    const int tid = otid(), w = tid >> 6, lane = tid & 63, q4 = lane >> 4, l15 = lane & 15;
    bf16_t* qs = (bf16_t*)(smem + PL_QS); bf16_t* ks = (bf16_t*)(smem + PL_R1); bf16_t* WT = ks; bf16_t* kts = (bf16_t*)(smem + PL_KT);
    bf16_t* vs = (bf16_t*)(smem + PL_VT);         float* Lm = (float*)(smem + PL_R3); bf16_t* UT = (bf16_t*)(smem + PL_R3); bf16_t* QKm = (bf16_t*)(smem + PL_QKM);
    bf16_t* Tp = (bf16_t*)(smem + PL_TP); bf16_t* Tpp = (bf16_t*)(smem + PL_TPP);
    float* sm = (float*)(smem + PL_SM);
    float* gcs = sm; float* bes = sm + 64; float* ssq = sm + 128; float* ssk = sm + 192; float* egs = sm + 256; float* egl_s = sm + 320; float* beg = sm + 384;
    const bf16_t* P = (const bf16_t*)(p.ws + WS_P);
    const float* pk = (const float*)(p.ws + WS_PK);
    if (npad == 0) {
        const int t = tid >> 3, g = tid & 7;
        const bf16_t* zp = P + (size_t)(row_start + t) * NPB + C_Z + h * 128 + 16 * g;
        const u32x4 z0 = *(const u32x4*)zp, z1 = *(const u32x4*)(zp + 8);
        float za[8], zb[8]; unpack8(z0, za); unpack8(z1, zb);
        const float* nwp = pk + PK_NORMW + 16 * g;
        float ga[8], gb2[8];
#pragma unroll
        for (int e = 0; e < 8; ++e) { ga[e] = nwp[e] * silu_(za[e]); gb2[e] = nwp[8 + e] * silu_(zb[e]); }
        bf16_t* gp = (bf16_t*)(rec + GP_G) + t * 128 + 16 * g;
        *(u32x4*)gp = pack8(ga); *(u32x4*)(gp + 8) = pack8(gb2);
    }
    if (w == 7) {
        const int i = lane;
        float g = 0.f, be = 0.f;
        if (i >= npad) { const size_t r = (size_t)(row_start + i - npad) * NPB; const float pa = bf2f(P[r + C_A + h]), pb = bf2f(P[r + C_B + h]);
            g = -expf(pk[PK_ALOG + h]) * softplus_(pa + pk[PK_DTB + h]); be = sigm(pb); }
        float x = g;
#pragma unroll
        for (int o = 1; o < 64; o <<= 1) { const float y = __shfl_up(x, o); if (lane >= o) x += y; }
        const float gl = __shfl(x, 63);
        gcs[lane] = x; bes[lane] = be; egs[lane] = __expf(x); egl_s[lane] = __expf(gl - x); beg[lane] = be * __expf(x);
        if (lane == 0) *(float*)(rec + GP_EGL) = __expf(gl);
    }
    __syncthreads();
    if (tid < 384) {
        const int sec = tid >> 7, ts = (tid >> 4) & 7, t0 = 8 * ts, d0 = l15 * 8;
        const int pcol = sec * 1024 + h * 128 + d0;
        float cw[4][8];
#pragma unroll
        for (int j = 0; j < 4; ++j) { const f32x4 a = *(const f32x4*)(pk + PK_CONVW + j * 3072 + pcol), b = *(const f32x4*)(pk + PK_CONVW + j * 3072 + pcol + 4);
            cw[j][0] = a[0]; cw[j][1] = a[1]; cw[j][2] = a[2]; cw[j][3] = a[3]; cw[j][4] = b[0]; cw[j][5] = b[1]; cw[j][6] = b[2]; cw[j][7] = b[3]; }
        u32x4 rw[11]; float fv[11];
#pragma unroll
        for (int k = 0; k < 11; ++k) {
            const int ii = t0 - 3 + k;
            const bf16_t* ptr = P + pcol; float f = 0.f;
            if (ii >= npad) { ptr = P + (size_t)(row_start + ii - npad) * NPB + pcol; f = 1.f; }
            else if (ii < 0 && npad == 0 && hbase) { ptr = hbase + (size_t)(ii + 3) * NPB + pcol; f = 1.f; }
            rw[k] = *(const u32x4*)ptr; fv[k] = f;
        }
        if (halo_out && ts == 7) {
#pragma unroll
            for (int dd = 0; dd < 3; ++dd) { *(u32x4*)(halo_out + (size_t)dd * NPB + pcol) = rw[8 + dd];
                if (conv_out) { float x[8]; unpack8(rw[8 + dd], x); *(f32x4*)(conv_out + dd * 3072 + pcol) = (f32x4){x[0], x[1], x[2], x[3]}; *(f32x4*)(conv_out + dd * 3072 + pcol + 4) = (f32x4){x[4], x[5], x[6], x[7]}; } }
        }
        float y[8][8];
#pragma unroll
        for (int t = 0; t < 8; ++t)
#pragma unroll
            for (int e = 0; e < 8; ++e) y[t][e] = 0.f;
#pragma unroll
        for (int k = 0; k < 11; ++k) { float x[8]; unpack8(rw[k], x);
#pragma unroll
            for (int e = 0; e < 8; ++e) x[e] *= fv[k];
#pragma unroll
            for (int dlt = 0; dlt < 4; ++dlt) { const int t = k - dlt;
                if (t >= 0 && t < 8) {
#pragma unroll
                    for (int e = 0; e < 8; ++e) y[t][e] += cw[dlt][e] * x[e]; } }
        }
        const float qsc = sec == 0 ? 0.08838834764831845f : 1.f;
#pragma unroll
        for (int t = 0; t < 8; ++t) {
            const bool tokv = (t0 + t) >= npad;
            float ss = 0.f;
#pragma unroll
            for (int e = 0; e < 8; ++e) { y[t][e] = tokv ? silu_(y[t][e]) : 0.f; ss += y[t][e] * y[t][e]; }
            if (sec < 2) { const float sc = __builtin_amdgcn_rsqf(rowsum16(ss) + 1e-6f) * qsc;
#pragma unroll
                for (int e = 0; e < 8; ++e) y[t][e] *= sc; }
        }
        { bf16_t* dst = sec == 0 ? qs : (sec == 1 ? ks : vs);
#pragma unroll
            for (int t = 0; t < 8; ++t) *(u32x4*)(dst + (t0 + t) * QSTR + d0) = pack8(y[t]); }
        if (sec == 1) {
#pragma unroll
            for (int t = 0; t < 8; ++t) { const float eg = egl_s[t0 + t]; float z[8];
#pragma unroll
                for (int e = 0; e < 8; ++e) z[e] = y[t][e] * eg;
                *(u32x4*)(kts + (t0 + t) * QSTR + d0) = pack8(z); } }
    }
    __syncthreads();
    {
        const int which = w >> 2, it = w & 3;
        const bf16_t* Barr = which ? qs : ks;
        bf16x8 bfr[4];
#pragma unroll
        for (int kk = 0; kk < 4; ++kk) bfr[kk] = ldfrag(Barr, QSTR, 16 * it, 32 * kk, lane);
        const int i = 16 * it + l15; const float gi = gcs[i], bi = bes[i];
#pragma unroll
        for (int jt = 0; jt < 4; ++jt) {
            f32x4 acc = {0.f, 0.f, 0.f, 0.f};
#pragma unroll
            for (int kk = 0; kk < 4; ++kk) acc = MFMA16(ldfrag(ks, QSTR, 16 * jt, 32 * kk, lane), bfr[kk], acc);
            const int j0 = 16 * jt + 4 * q4; const f32x4 gj = *(const f32x4*)(gcs + j0);
            f32x4 o;
#pragma unroll
            for (int r = 0; r < 4; ++r) { const int j = j0 + r; const bool keep = which ? (i >= j) : (i > j); o[r] = keep ? acc[r] * __expf(gi - gj[r]) : 0.f; }
            if (which == 0) *(f32x4*)(Lm + i * 64 + j0) = o * bi;
            else *(u32x2*)(QKm + i * TSTR + j0) = (u32x2){pk2(o[0], o[1]), pk2(o[2], o[3])};
        }
    }
    __syncthreads();
    {
        float* Tm = (float*)(smem + PL_TM);
        inv_block(Lm, Tm, (float*)(smem + PL_XS), tid);
        const int i = tid >> 3, j0 = (tid & 7) * 8;
        float a[8], b2[8];
#pragma unroll
        for (int e = 0; e < 8; ++e) { const float tv = Tm[i * 64 + j0 + e]; a[e] = tv * beg[j0 + e]; b2[e] = tv * bes[j0 + e]; }
        *(u32x4*)(Tp + i * TSTR + j0) = (u32x4){pk2(a[0], a[1]), pk2(a[2], a[3]), pk2(a[4], a[5]), pk2(a[6], a[7])};
        *(u32x4*)(Tpp + i * TSTR + j0) = (u32x4){pk2(b2[0], b2[1]), pk2(b2[2], b2[3]), pk2(b2[4], b2[5]), pk2(b2[6], b2[7])};
    }
    __syncthreads();
    {
        const int it = w & 3, half = w >> 2;
        f32x4 aw[4], au[4];
#pragma unroll
        for (int x = 0; x < 4; ++x) { aw[x] = (f32x4){0.f, 0.f, 0.f, 0.f}; au[x] = (f32x4){0.f, 0.f, 0.f, 0.f}; }
#pragma unroll
        for (int kk = 0; kk < 2; ++kk) {
            const bf16x8 a1 = ldfrag(Tp, TSTR, 16 * it, 32 * kk, lane), a2 = ldfrag(Tpp, TSTR, 16 * it, 32 * kk, lane);
#pragma unroll
            for (int x = 0; x < 4; ++x) { const int dt = half * 4 + x;
                aw[x] = MFMA16(a1, ldfrag_tr(ks, QSTR, 16 * dt, 32 * kk, lane), aw[x]);
                au[x] = MFMA16(a2, ldfrag_tr(vs, QSTR, 16 * dt, 32 * kk, lane), au[x]); }
        }
        __syncthreads();
#pragma unroll
        for (int x = 0; x < 4; ++x) { const int d = 16 * (half * 4 + x) + l15, i0 = 16 * it + 4 * q4;
            *(u32x2*)(WT + d * TSTR + i0) = (u32x2){pk2(aw[x][0], aw[x][1]), pk2(aw[x][2], aw[x][3])};
            *(u32x2*)(UT + d * TSTR + i0) = (u32x2){pk2(au[x][0], au[x][1]), pk2(au[x][2], au[x][3])}; }
    }
    __syncthreads();
    {
        bf16_t* gAP = (bf16_t*)(rec + GP_AP); bf16_t* gQH = (bf16_t*)(rec + GP_QH); bf16_t* gKH = (bf16_t*)(rec + GP_KH); bf16_t* gOH = (bf16_t*)(rec + GP_OH);
        {
            const int et = w;
            const bf16x8 a0 = ldfrag(WT, TSTR, 16 * et, 0, lane), a1 = ldfrag(WT, TSTR, 16 * et, 32, lane);
#pragma unroll
            for (int dt = 0; dt < 8; ++dt) { f32x4 acc = {0.f, 0.f, 0.f, 0.f};
                acc = MFMA16(a0, ldfrag_tr(kts, QSTR, 16 * dt, 0, lane), acc); acc = MFMA16(a1, ldfrag_tr(kts, QSTR, 16 * dt, 32, lane), acc);
                *(u32x2*)(gAP + ((size_t)(dt * 4 + (et >> 1)) * 64 + lane) * 8 + (et & 1) * 4) = (u32x2){pk2(-acc[0], -acc[1]), pk2(-acc[2], -acc[3])}; }
#pragma unroll
            for (int tt = 0; tt < 4; ++tt) { f32x4 acc = {0.f, 0.f, 0.f, 0.f};
                acc = MFMA16(a0, ldfrag(QKm, TSTR, 16 * tt, 0, lane), acc); acc = MFMA16(a1, ldfrag(QKm, TSTR, 16 * tt, 32, lane), acc);
                const int t = 16 * tt + l15, e0 = 16 * et + 4 * q4; const float eg = egs[t];
                const u32x2 qq = *(const u32x2*)(qs + t * QSTR + e0);
                const float o0 = __uint_as_float(qq.x << 16) * eg - acc[0], o1 = __uint_as_float(qq.x & 0xffff0000u) * eg - acc[1],
                            o2 = __uint_as_float(qq.y << 16) * eg - acc[2], o3 = __uint_as_float(qq.y & 0xffff0000u) * eg - acc[3];
                *(u32x2*)(gQH + ((size_t)(tt * 4 + (et >> 1)) * 64 + lane) * 8 + (et & 1) * 4) = (u32x2){pk2(o0, o1), pk2(o2, o3)}; }
        }
        {
            const int dt = w;
            const bf16x8 a0 = ldfrag_tr(kts, QSTR, 16 * dt, 0, lane), a1 = ldfrag_tr(kts, QSTR, 16 * dt, 32, lane);
#pragma unroll
            for (int vt = 0; vt < 8; ++vt) { f32x4 acc = {0.f, 0.f, 0.f, 0.f};
                acc = MFMA16(a0, ldfrag(UT, TSTR, 16 * vt, 0, lane), acc); acc = MFMA16(a1, ldfrag(UT, TSTR, 16 * vt, 32, lane), acc);
                *(u32x2*)(gKH + ((size_t)(vt * 8 + dt) * 64 + lane) * 4) = (u32x2){pk2(acc[0], acc[1]), pk2(acc[2], acc[3])}; }
            const int tt = w & 3, vh = w >> 2;
            const bf16x8 b0 = ldfrag(QKm, TSTR, 16 * tt, 0, lane), b1 = ldfrag(QKm, TSTR, 16 * tt, 32, lane);
#pragma unroll
            for (int x = 0; x < 4; ++x) { const int vt = vh * 4 + x; f32x4 acc = {0.f, 0.f, 0.f, 0.f};
                acc = MFMA16(b0, ldfrag(UT, TSTR, 16 * vt, 0, lane), acc); acc = MFMA16(b1, ldfrag(UT, TSTR, 16 * vt, 32, lane), acc);
                *(u32x2*)(gOH + ((size_t)(vt * 4 + tt) * 64 + lane) * 4) = (u32x2){pk2(acc[0], acc[1]), pk2(acc[2], acc[3])}; }
        }
    }
    __syncthreads();
}

__device__ __forceinline__ void phase_gprep(const Params& p, int seg, unsigned char* smem) {
    const int blk = obid();
    const int n_items = (CPS + (seg == 0 ? 1 : 0)) * 64;
#pragma unroll 1
    for (int it = blk; it < n_items; it += gridDim.x) {
        const int bh = it & 63, b = bh >> 3, h = bh & 7; int cl = it >> 6; if (seg != 0) cl += 1;
        unsigned char* rec = p.ws + WS_GP + (size_t)(cl * 64 + bh) * GP_STRIDE;
        const bf16_t* Pb = (const bf16_t*)(p.ws + WS_P);
        bf16_t* chalo2 = (bf16_t*)(p.ws + WS_CHALO);
        if (cl == 0) gdn_prep_item(p, smem, h, LEX0, 48, nullptr, nullptr, nullptr, rec);
        else {
            const int row = b * SEGTOK + (cl - 1) * 64;
            const bf16_t* hbase = Pb + (size_t)(row - 3) * NPB;
            if (cl == 1) hbase = (seg == 0) ? Pb + (size_t)(LEX0 + NMETA - 3) * NPB : chalo2 + (size_t)(((seg - 1) & 1) * NBATCH + b) * 3 * NPB;
            bf16_t* ho = (cl == CPS) ? chalo2 + (size_t)((seg & 1) * NBATCH + b) * 3 * NPB : nullptr;
            float* co = (cl == CPS && seg == NSEG - 1) ? p.out + O_CONV_P + (size_t)b * 9216 : nullptr;
            gdn_prep_item(p, smem, h, row, 0, hbase, ho, co, rec);
        }
    }
}

__device__ __forceinline__ void gdn_scan_block(const Params& p, int seg, unsigned char* smem, int bh) {
    const int tid = otid(), w = tid >> 6, lane = tid & 63, q4 = lane >> 4, l15 = lane & 15;
    const int b = bh >> 3, h = bh & 7;
    float* st = p.out + O_GDN_P + (size_t)bh * 16384;
    f32x4 S[8];
    if (seg) {
#pragma unroll
        for (int mt = 0; mt < 8; ++mt)
#pragma unroll
            for (int r = 0; r < 4; ++r) S[mt][r] = st[(size_t)(16 * mt + 4 * q4 + r) * 128 + 16 * w + l15];
    } else {
#pragma unroll
        for (int mt = 0; mt < 8; ++mt) S[mt] = (f32x4){0.f, 0.f, 0.f, 0.f};
    }
    const int c_lo = seg ? 1 : 0;
    float* obuf = (float*)(smem + 98304);
    {
        const u32x4* src = (const u32x4*)(p.ws + WS_GP + (size_t)(c_lo * 64 + bh) * GP_STRIDE); u32x4* dst = (u32x4*)smem;
#pragma unroll
        for (int x = 0; x < 6; ++x) dst[tid + 512 * x] = src[tid + 512 * x];
    }
#pragma unroll 1
    for (int cl = c_lo; cl <= CPS; ++cl) {
        const unsigned char* rec = p.ws + WS_GP + (size_t)(cl * 64 + bh) * GP_STRIDE;
        const int cur = (cl - c_lo) & 1;
        __syncthreads();
        u32x4 nx[6];
        const bool more = cl < CPS;
        if (more) { const u32x4* src = (const u32x4*)(rec + GP_STRIDE * 64);
#pragma unroll
            for (int x = 0; x < 6; ++x) nx[x] = src[tid + 512 * x]; }
        const bf16_t* gKH = (const bf16_t*)(rec + GP_KH); const bf16_t* gOH = (const bf16_t*)(rec + GP_OH);
        u32x2 kh[8], oh[4];
#pragma unroll
        for (int mt = 0; mt < 8; ++mt) kh[mt] = *(const u32x2*)(gKH + ((size_t)(w * 8 + mt) * 64 + lane) * 4);
#pragma unroll
        for (int tt = 0; tt < 4; ++tt) oh[tt] = *(const u32x2*)(gOH + ((size_t)(w * 4 + tt) * 64 + lane) * 4);
        const float egl = *(const float*)(rec + GP_EGL);
        const int et = tid >> 3, eg = tid & 7;
        const bf16_t* gp = (const bf16_t*)(rec + GP_G) + et * 128 + 16 * eg;
        u32x4 z0 = {0u, 0u, 0u, 0u}, z1 = {0u, 0u, 0u, 0u};
        if (cl > 0) { z0 = *(const u32x4*)gp; z1 = *(const u32x4*)(gp + 8); }
        bf16x8 Bf[4];
#pragma unroll
        for (int ks = 0; ks < 4; ++ks) { u32x4 t; t.x = pk2(S[2 * ks][0], S[2 * ks][1]); t.y = pk2(S[2 * ks][2], S[2 * ks][3]); t.z = pk2(S[2 * ks + 1][0], S[2 * ks + 1][1]); t.w = pk2(S[2 * ks + 1][2], S[2 * ks + 1][3]);
            Bf[ks] = __builtin_bit_cast(bf16x8, t); }
        const bf16x8* AP = (const bf16x8*)(smem + cur * 49152); const bf16x8* QH = (const bf16x8*)(smem + cur * 49152 + GP_QH);
        f32x4 o[4], tS[8];
#pragma unroll
        for (int tt = 0; tt < 4; ++tt) { o[tt] = (f32x4){0.f, 0.f, 0.f, 0.f};
#pragma unroll
            for (int ks = 0; ks < 4; ++ks) o[tt] = MFMA16(QH[(tt * 4 + ks) * 64 + lane], Bf[ks], o[tt]); }
#pragma unroll
        for (int mt = 0; mt < 8; ++mt) { tS[mt] = (f32x4){0.f, 0.f, 0.f, 0.f};
#pragma unroll
            for (int ks = 0; ks < 4; ++ks) tS[mt] = MFMA16(AP[(mt * 4 + ks) * 64 + lane], Bf[ks], tS[mt]); }
#pragma unroll
        for (int mt = 0; mt < 8; ++mt) {
            S[mt][0] = egl * S[mt][0] + tS[mt][0] + __uint_as_float(kh[mt].x << 16); S[mt][1] = egl * S[mt][1] + tS[mt][1] + __uint_as_float(kh[mt].x & 0xffff0000u);
            S[mt][2] = egl * S[mt][2] + tS[mt][2] + __uint_as_float(kh[mt].y << 16); S[mt][3] = egl * S[mt][3] + tS[mt][3] + __uint_as_float(kh[mt].y & 0xffff0000u); }
        if (cl > 0) {
#pragma unroll
            for (int tt = 0; tt < 4; ++tt) {
                o[tt][0] += __uint_as_float(oh[tt].x << 16); o[tt][1] += __uint_as_float(oh[tt].x & 0xffff0000u); o[tt][2] += __uint_as_float(oh[tt].y << 16); o[tt][3] += __uint_as_float(oh[tt].y & 0xffff0000u);
#pragma unroll
                for (int r = 0; r < 4; ++r) obuf[(16 * tt + 4 * q4 + r) * 132 + 16 * w + l15] = o[tt][r]; }
        }
        if (more) { u32x4* dst = (u32x4*)(smem + (cur ^ 1) * 49152);
#pragma unroll
            for (int x = 0; x < 6; ++x) dst[tid + 512 * x] = nx[x]; }
        if (cl > 0) {
            __syncthreads();
            f32x4 ov[4]; float ss = 0.f;
#pragma unroll
            for (int j = 0; j < 4; ++j) { ov[j] = *(const f32x4*)(obuf + et * 132 + 16 * eg + 4 * j); ss += ov[j][0] * ov[j][0] + ov[j][1] * ov[j][1] + ov[j][2] * ov[j][2] + ov[j][3] * ov[j][3]; }
            ss += __shfl_xor(ss, 1); ss += __shfl_xor(ss, 2); ss += __shfl_xor(ss, 4);
            const float rs = __builtin_amdgcn_rsqf(ss * (1.f / 128.f) + 1e-6f);
            const unsigned zz[8] = {z0.x, z0.y, z0.z, z0.w, z1.x, z1.y, z1.z, z1.w};
            unsigned ow[8];
#pragma unroll
            for (int j = 0; j < 8; ++j) ow[j] = pk2(ov[j >> 1][(j & 1) * 2] * rs * __uint_as_float(zz[j] << 16), ov[j >> 1][(j & 1) * 2 + 1] * rs * __uint_as_float(zz[j] & 0xffff0000u));
            const size_t grow = (size_t)b * SEQ + seg * SEGTOK + (cl - 1) * 64 + et;
            bf16_t* oa = (bf16_t*)(p.ws + WS_H) + grow * D + h * 128 + 16 * eg;
            *(u32x4*)oa = (u32x4){ow[0], ow[1], ow[2], ow[3]}; *(u32x4*)(oa + 8) = (u32x4){ow[4], ow[5], ow[6], ow[7]};
        }
    }
#pragma unroll
    for (int mt = 0; mt < 8; ++mt)
#pragma unroll
        for (int r = 0; r < 4; ++r) st[(size_t)(16 * mt + 4 * q4 + r) * 128 + 16 * w + l15] = S[mt][r];
    __syncthreads();
}

constexpr int RL_AT = 0, RL_BT = 9216, RL_KT = 18432, RL_ATT = 27648, RL_RT = 36864, RL_BTLT = 46080, RL_KTLT = 55296, RL_VT = 64512, RL_LAK = 73728, RL_MRB = 82944, RL_MRK = 92160,
              RL_LM = 101376, RL_AF = 117760, RL_TM = 134144, RL_XS = 150528;
__device__ __forceinline__ void rwkv_prep_item(const Params& p, unsigned char* smem, int hb, int row_start, int npad, const bf16_t* prev_row,
                                               bf16_t* halo_out, unsigned char* rec) {
    const int tid = otid(), w = tid >> 6, lane = tid & 63, q4 = lane >> 4, l15 = lane & 15;
    bf16_t* At = (bf16_t*)(smem + RL_AT); bf16_t* Tb = At; bf16_t* Bt = (bf16_t*)(smem + RL_BT); bf16_t* WaT = Bt; bf16_t* Kt = (bf16_t*)(smem + RL_KT); bf16_t* XT = Kt;
    bf16_t* At2 = (bf16_t*)(smem + RL_ATT); bf16_t* Rt = (bf16_t*)(smem + RL_RT); bf16_t* Btl = (bf16_t*)(smem + RL_BTLT); bf16_t* Ktl = (bf16_t*)(smem + RL_KTLT);
    bf16_t* Vr = (bf16_t*)(smem + RL_VT);        bf16_t* Lak = (bf16_t*)(smem + RL_LAK); bf16_t* Mrb = (bf16_t*)(smem + RL_MRB); bf16_t* Mrk = (bf16_t*)(smem + RL_MRK);
    float* Lm = (float*)(smem + RL_LM);
    bf16_t* thw = Lak; bf16_t* adb = Mrb; float* lc = Lm; float* af = (float*)(smem + RL_AF);
    const bf16_t* P = (const bf16_t*)(p.ws + WS_P);
    const float* pk = (const float*)(p.ws + WS_PK);
    const int t = tid >> 3, g = tid & 7;
    float rr[8], kb[8], vv[8], zb[8];
    {
        const bool real = t >= npad;
        const bf16_t* curp = P; const bf16_t* prevp = P; float fprev = 0.f;
        if (real) { curp = P + (size_t)(row_start + t - npad) * NPB; if (t > npad) { prevp = curp - NPB; fprev = 1.f; } else if (prev_row) { prevp = prev_row; fprev = 1.f; } }
        const int secbase[6] = {0, 1024, 2048, 3200, 3072, 3136};
        u32x4 rc[6], rp[6];
#pragma unroll
        for (int sidx = 0; sidx < 6; ++sidx) { const int col = secbase[sidx] + (sidx < 4 ? hb * 64 : 0) + g * 8; rc[sidx] = *(const u32x4*)(curp + C_RW + col); rp[sidx] = *(const u32x4*)(prevp + C_RW + col); }
        float m[6][8];
#pragma unroll
        for (int sidx = 0; sidx < 6; ++sidx) {
            const int col = secbase[sidx] + (sidx < 4 ? hb * 64 : 0) + g * 8;
            float cur[8], prv[8];
            unpack8(rc[sidx], cur); unpack8(rp[sidx], prv);
            const f32x4 mu0 = *(const f32x4*)(pk + PK_MU + col), mu1 = *(const f32x4*)(pk + PK_MU + col + 4);
            const float mu[8] = {mu0[0], mu0[1], mu0[2], mu0[3], mu1[0], mu1[1], mu1[2], mu1[3]};
#pragma unroll
            for (int e = 0; e < 8; ++e) m[sidx][e] = real ? cur[e] + mu[e] * (fprev * prv[e] - cur[e]) : 0.f;
            if (halo_out && t == 63 && (sidx < 4 || hb == 0)) *(u32x4*)(halo_out + C_RW + col) = rc[sidx];
        }
#pragma unroll
        for (int e = 0; e < 8; ++e) { rr[e] = m[0][e]; kb[e] = m[1][e]; vv[e] = m[2][e]; zb[e] = m[3][e]; }
        float th[8];
#pragma unroll
        for (int e = 0; e < 8; ++e) th[e] = tanh_(m[4][e]);
        *(u32x4*)(thw + t * TSTR + g * 8) = pack8(th);
        *(u32x4*)(adb + t * TSTR + g * 8) = pack8(m[5]);
    }
    __syncthreads();
    {
        const int which = w >> 2, ct = w & 3;
        const bf16_t* Wt = (const bf16_t*)(p.ws + (which ? WS_A2T : WS_W2T)) + (size_t)hb * 4096;
        const bf16x8 b0 = *(const bf16x8*)(Wt + (16 * ct + l15) * 64 + 8 * q4), b1 = *(const bf16x8*)(Wt + (16 * ct + l15) * 64 + 32 + 8 * q4);
        const bf16_t* Aarr = which ? adb : thw;
        const int c = 16 * ct + l15;
        const float bias = pk[(which ? PK_A0 : PK_W0) + hb * 64 + c];
        float carry = 0.f;
#pragma unroll
        for (int tt = 0; tt < 4; ++tt) {
            f32x4 acc = {0.f, 0.f, 0.f, 0.f};
            acc = MFMA16(ldfrag(Aarr, TSTR, 16 * tt, 0, lane), b0, acc); acc = MFMA16(ldfrag(Aarr, TSTR, 16 * tt, 32, lane), b1, acc);
            if (which) {
#pragma unroll
                for (int r = 0; r < 4; ++r) af[(16 * tt + 4 * q4 + r) * 64 + c] = sigm(bias + acc[r]);
            } else {
                float wl[4];
#pragma unroll
                for (int r = 0; r < 4; ++r) { const int tk = 16 * tt + 4 * q4 + r; wl[r] = (tk < npad) ? 0.f : -0.6065306597126334f * sigm(bias + acc[r]); }
                wl[1] += wl[0]; wl[2] += wl[1]; wl[3] += wl[2];
                const float Q = wl[3];
                const float Q0 = __shfl(Q, l15), Q1 = __shfl(Q, l15 + 16), Q2 = __shfl(Q, l15 + 32), Q3 = __shfl(Q, l15 + 48);
                const float ex = carry + (q4 > 0 ? Q0 : 0.f) + (q4 > 1 ? Q1 : 0.f) + (q4 > 2 ? Q2 : 0.f);
#pragma unroll
                for (int r = 0; r < 4; ++r) lc[(16 * tt + 4 * q4 + r) * 64 + c] = ex + wl[r];
                carry += Q0 + Q1 + Q2 + Q3;
            }
        }
    }
    __syncthreads();
    {
        float lct[8], lcp[8], lcC[8], av[8];
        { const f32x4 a = *(const f32x4*)(lc + t * 64 + g * 8), b2 = *(const f32x4*)(lc + t * 64 + g * 8 + 4); lct[0] = a[0]; lct[1] = a[1]; lct[2] = a[2]; lct[3] = a[3]; lct[4] = b2[0]; lct[5] = b2[1]; lct[6] = b2[2]; lct[7] = b2[3]; }
        if (t > 0) { const f32x4 a = *(const f32x4*)(lc + (t - 1) * 64 + g * 8), b2 = *(const f32x4*)(lc + (t - 1) * 64 + g * 8 + 4); lcp[0] = a[0]; lcp[1] = a[1]; lcp[2] = a[2]; lcp[3] = a[3]; lcp[4] = b2[0]; lcp[5] = b2[1]; lcp[6] = b2[2]; lcp[7] = b2[3]; }
        else {
#pragma unroll
            for (int e = 0; e < 8; ++e) lcp[e] = 0.f; }
        { const f32x4 a = *(const f32x4*)(lc + 63 * 64 + g * 8), b2 = *(const f32x4*)(lc + 63 * 64 + g * 8 + 4); lcC[0] = a[0]; lcC[1] = a[1]; lcC[2] = a[2]; lcC[3] = a[3]; lcC[4] = b2[0]; lcC[5] = b2[1]; lcC[6] = b2[2]; lcC[7] = b2[3]; }
        { const f32x4 a = *(const f32x4*)(af + t * 64 + g * 8), b2 = *(const f32x4*)(af + t * 64 + g * 8 + 4); av[0] = a[0]; av[1] = a[1]; av[2] = a[2]; av[3] = a[3]; av[4] = b2[0]; av[5] = b2[1]; av[6] = b2[2]; av[7] = b2[3]; }
        const int hc = hb * 64 + g * 8;
        float kk[8], km[8], ss = 0.f, rk = 0.f;
#pragma unroll
        for (int e = 0; e < 8; ++e) { kk[e] = kb[e] * pk[PK_KK + hc + e]; ss += kk[e] * kk[e]; km[e] = kb[e] * (1.f + (av[e] - 1.f) * pk[PK_KA + hc + e]); rk += rr[e] * km[e] * pk[PK_RK + hc + e]; }
        ss += __shfl_xor(ss, 1); ss += __shfl_xor(ss, 2); ss += __shfl_xor(ss, 4);
        rk += __shfl_xor(rk, 1); rk += __shfl_xor(rk, 2); rk += __shfl_xor(rk, 4);
        const float kn = __builtin_amdgcn_rsqf(ss + 1e-6f);
        float xa[8], xb[8], xk[8], xr[8], xbt[8], xkt[8];
#pragma unroll
        for (int e = 0; e < 8; ++e) { kk[e] *= kn; const float ka = kk[e] * av[e]; const float ip = __expf(-lct[e]), tl = __expf(lcC[e] - lct[e]);
            xa[e] = kk[e] * __expf(lcp[e]); xb[e] = ka * ip; xk[e] = km[e] * ip; xr[e] = rr[e] * __expf(lct[e]); xbt[e] = ka * tl; xkt[e] = km[e] * tl; }
        *(u32x4*)(At + t * TSTR + g * 8) = pack8(xa); *(u32x4*)(Bt + t * TSTR + g * 8) = pack8(xb); *(u32x4*)(Kt + t * TSTR + g * 8) = pack8(xk); *(u32x4*)(Rt + t * TSTR + g * 8) = pack8(xr);
        *(u32x4*)(At2 + t * TSTR + g * 8) = pack8(xa); *(u32x4*)(Btl + t * TSTR + g * 8) = pack8(xbt); *(u32x4*)(Ktl + t * TSTR + g * 8) = pack8(xkt); *(u32x4*)(Vr + t * TSTR + g * 8) = pack8(vv);
        float c1[8], c0[8];
#pragma unroll
        for (int e = 0; e < 8; ++e) { const float sz = silu_(zb[e]); c1[e] = pk[PK_GNW + hc + e] * sz; c0[e] = (pk[PK_GNB + hc + e] + rk * vv[e]) * sz; }
        *(u32x4*)((bf16_t*)(rec + RP_C1) + t * 64 + g * 8) = pack8(c1); *(u32x4*)((bf16_t*)(rec + RP_C0) + t * 64 + g * 8) = pack8(c0);
        if (t == 63) { float* pc = (float*)(rec + RP_PC) + g * 8; *(f32x4*)pc = (f32x4){__expf(lcC[0]), __expf(lcC[1]), __expf(lcC[2]), __expf(lcC[3])}; *(f32x4*)(pc + 4) = (f32x4){__expf(lcC[4]), __expf(lcC[5]), __expf(lcC[6]), __expf(lcC[7])}; }
    }
    __syncthreads();
    {
        const int pr = w >> 1;
        const bf16_t* Aarr = pr < 2 ? At : Rt; const bf16_t* Barr = (pr & 1) ? Kt : Bt;
#pragma unroll
        for (int x = 0; x < 2; ++x) { const int tt = 2 * (w & 1) + x;
            const bf16x8 a0 = ldfrag(Aarr, TSTR, 16 * tt, 0, lane), a1 = ldfrag(Aarr, TSTR, 16 * tt, 32, lane);
            const int tk = 16 * tt + l15;
#pragma unroll
            for (int it = 0; it < 4; ++it) { f32x4 acc = {0.f, 0.f, 0.f, 0.f};
                acc = MFMA16(ldfrag(Barr, TSTR, 16 * it, 0, lane), a0, acc); acc = MFMA16(ldfrag(Barr, TSTR, 16 * it, 32, lane), a1, acc);
                const int i0 = 16 * it + 4 * q4;
                f32x4 o;
#pragma unroll
                for (int r = 0; r < 4; ++r) { const int i = i0 + r; const bool keep = pr < 2 ? (tk > i) : (tk >= i); o[r] = keep ? acc[r] : 0.f; }
                if (pr == 0) *(f32x4*)(Lm + tk * 64 + i0) = o;
                else { bf16_t* Out = pr == 1 ? Lak : (pr == 2 ? Mrb : Mrk); *(u32x2*)(Out + tk * TSTR + i0) = (u32x2){pk2(o[0], o[1]), pk2(o[2], o[3])}; } }
        }
    }
    __syncthreads();
    {
        float* Tm = (float*)(smem + RL_TM);
        inv_block(Lm, Tm, (float*)(smem + RL_XS), tid);
        const int i = tid >> 3, j0 = (tid & 7) * 8;
        float a[8];
#pragma unroll
        for (int e = 0; e < 8; ++e) a[e] = Tm[i * 64 + j0 + e];
        *(u32x4*)(Tb + i * TSTR + j0) = pack8(a);
    }
    __syncthreads();
    {
        const int tt = w & 3, which = w >> 2;
        const bf16_t* Aarr = which ? Lak : Tb; const bf16_t* Barr = which ? Vr : At2; bf16_t* Out = which ? XT : WaT;
        const bf16x8 a0 = ldfrag(Aarr, TSTR, 16 * tt, 0, lane), a1 = ldfrag(Aarr, TSTR, 16 * tt, 32, lane);
#pragma unroll
        for (int ct = 0; ct < 4; ++ct) { f32x4 acc = {0.f, 0.f, 0.f, 0.f};
            acc = MFMA16(a0, ldfrag_tr(Barr, TSTR, 16 * ct, 0, lane), acc); acc = MFMA16(a1, ldfrag_tr(Barr, TSTR, 16 * ct, 32, lane), acc);
            *(u32x2*)(Out + (16 * ct + l15) * TSTR + 16 * tt + 4 * q4) = (u32x2){pk2(acc[0], acc[1]), pk2(acc[2], acc[3])}; }
    }
    __syncthreads();
    {
        f32x4 acc[4];
        if (w < 4) {
            const bf16x8 a0 = ldfrag(Tb, TSTR, 16 * w, 0, lane), a1 = ldfrag(Tb, TSTR, 16 * w, 32, lane);
#pragma unroll
            for (int ct = 0; ct < 4; ++ct) { acc[ct] = (f32x4){0.f, 0.f, 0.f, 0.f};
                acc[ct] = MFMA16(a0, ldfrag(XT, TSTR, 16 * ct, 0, lane), acc[ct]); acc[ct] = MFMA16(a1, ldfrag(XT, TSTR, 16 * ct, 32, lane), acc[ct]); }
        }
        __syncthreads();
        if (w < 4) {
#pragma unroll
            for (int ct = 0; ct < 4; ++ct) *(u32x2*)(XT + (16 * ct + l15) * TSTR + 16 * w + 4 * q4) = (u32x2){pk2(-acc[ct][0], -acc[ct][1]), pk2(-acc[ct][2], -acc[ct][3])};
        }
    }
    __syncthreads();
    {
        const bf16_t* UvT = XT;
        bf16_t* gAP = (bf16_t*)(rec + RP_AP); bf16_t* gRH = (bf16_t*)(rec + RP_RH); bf16_t* gKH = (bf16_t*)(rec + RP_KH); bf16_t* gYH = (bf16_t*)(rec + RP_YH);
        const int et = w & 3, part = w >> 2;
        {
            const bf16x8 a0 = ldfrag(WaT, TSTR, 16 * et, 0, lane), a1 = ldfrag(WaT, TSTR, 16 * et, 32, lane);
            if (part == 0) {
#pragma unroll
                for (int kt = 0; kt < 4; ++kt) { f32x4 acc = {0.f, 0.f, 0.f, 0.f};
                    acc = MFMA16(a0, ldfrag_tr(Btl, TSTR, 16 * kt, 0, lane), acc); acc = MFMA16(a1, ldfrag_tr(Btl, TSTR, 16 * kt, 32, lane), acc);
                    *(u32x2*)(gAP + ((size_t)(kt * 2 + (et >> 1)) * 64 + lane) * 8 + (et & 1) * 4) = (u32x2){pk2(-acc[0], -acc[1]), pk2(-acc[2], -acc[3])}; }
            } else {
#pragma unroll
                for (int tt = 0; tt < 4; ++tt) { f32x4 acc = {0.f, 0.f, 0.f, 0.f};
                    acc = MFMA16(a0, ldfrag(Mrb, TSTR, 16 * tt, 0, lane), acc); acc = MFMA16(a1, ldfrag(Mrb, TSTR, 16 * tt, 32, lane), acc);
                    const int tk = 16 * tt + l15, e0 = 16 * et + 4 * q4;
                    const u32x2 q2 = *(const u32x2*)(Rt + tk * TSTR + e0);
                    const float o0 = __uint_as_float(q2.x << 16) - acc[0], o1 = __uint_as_float(q2.x & 0xffff0000u) - acc[1], o2 = __uint_as_float(q2.y << 16) - acc[2], o3 = __uint_as_float(q2.y & 0xffff0000u) - acc[3];
                    *(u32x2*)(gRH + ((size_t)(tt * 2 + (et >> 1)) * 64 + lane) * 8 + (et & 1) * 4) = (u32x2){pk2(o0, o1), pk2(o2, o3)}; }
            }
        }
        {
            const int rt = w & 3;
            bf16_t* Out = part ? gKH : gYH;
            bf16x8 a0, a1, a2, a3;
            if (part) { a0 = ldfrag_tr(Btl, TSTR, 16 * rt, 0, lane); a1 = ldfrag_tr(Btl, TSTR, 16 * rt, 32, lane); a2 = ldfrag_tr(Ktl, TSTR, 16 * rt, 0, lane); a3 = ldfrag_tr(Ktl, TSTR, 16 * rt, 32, lane); }
            else { a0 = ldfrag(Mrb, TSTR, 16 * rt, 0, lane); a1 = ldfrag(Mrb, TSTR, 16 * rt, 32, lane); a2 = ldfrag(Mrk, TSTR, 16 * rt, 0, lane); a3 = ldfrag(Mrk, TSTR, 16 * rt, 32, lane); }
#pragma unroll
            for (int vt = 0; vt < 4; ++vt) { f32x4 acc = {0.f, 0.f, 0.f, 0.f};
                acc = MFMA16(a0, ldfrag(UvT, TSTR, 16 * vt, 0, lane), acc); acc = MFMA16(a1, ldfrag(UvT, TSTR, 16 * vt, 32, lane), acc);
                acc = MFMA16(a2, ldfrag_tr(Vr, TSTR, 16 * vt, 0, lane), acc); acc = MFMA16(a3, ldfrag_tr(Vr, TSTR, 16 * vt, 32, lane), acc);
                *(u32x2*)(Out + ((size_t)(vt * 4 + rt) * 64 + lane) * 4) = (u32x2){pk2(acc[0], acc[1]), pk2(acc[2], acc[3])}; }
        }
    }
    __syncthreads();
}

__device__ __forceinline__ void phase_rprep(const Params& p, int seg, unsigned char* smem) {
    const int blk = obid();
    const int n_items = (CPS + (seg == 0 ? 1 : 0)) * 128;
#pragma unroll 1
    for (int it = blk; it < n_items; it += gridDim.x) {
        const int bh = it & 127, b = bh >> 4, hb = bh & 15; int cl = it >> 7; if (seg != 0) cl += 1;
        unsigned char* rec = p.ws + WS_RP + (size_t)(cl * 128 + bh) * RP_STRIDE;
        const bf16_t* Pb = (const bf16_t*)(p.ws + WS_P);
        bf16_t* phalo2 = (bf16_t*)(p.ws + WS_PHALO);
        if (cl == 0) rwkv_prep_item(p, smem, hb, LEX0, 48, nullptr, nullptr, rec);
        else {
            const int row = b * SEGTOK + (cl - 1) * 64;
            const bf16_t* prow = Pb + (size_t)(row - 1) * NPB;
            if (cl == 1) prow = (seg == 0) ? Pb + (size_t)(LEX0 + NMETA - 1) * NPB : phalo2 + (size_t)(((seg - 1) & 1) * NBATCH + b) * NPB;
            bf16_t* ho = (cl == CPS) ? phalo2 + (size_t)((seg & 1) * NBATCH + b) * NPB : nullptr;
            rwkv_prep_item(p, smem, hb, row, 0, prow, ho, rec);
        }
    }
}

__device__ __forceinline__ void rwkv_scan_block(const Params& p, int seg, unsigned char* smem, int pairidx) {
    const int tid = otid(), w = tid >> 6, lane = tid & 63, q4 = lane >> 4, l15 = lane & 15;
    const int hsel = w >> 2, vt = w & 3;
    const int bh = pairidx * 2 + hsel, b = bh >> 4, hb = bh & 15;
    float* st = p.out + O_RWKV_P + (size_t)bh * 4096;
    f32x4 S[4];
    if (seg) {
#pragma unroll
        for (int mt = 0; mt < 4; ++mt) S[mt] = *(const f32x4*)(st + (size_t)(16 * vt + l15) * 64 + 16 * mt + 4 * q4);
    } else {
#pragma unroll
        for (int mt = 0; mt < 4; ++mt) S[mt] = (f32x4){0.f, 0.f, 0.f, 0.f};
    }
    const int c_lo = seg ? 1 : 0;
    float* ybuf = (float*)(smem + 65536) + hsel * (64 * 68);
    const int tl = tid & 255;
    {
        const u32x4* src = (const u32x4*)(p.ws + WS_RP + (size_t)(c_lo * 128 + bh) * RP_STRIDE); u32x4* dst = (u32x4*)(smem + hsel * 16384);
#pragma unroll
        for (int x = 0; x < 4; ++x) dst[tl + 256 * x] = src[tl + 256 * x];
    }
#pragma unroll 1
    for (int cl = c_lo; cl <= CPS; ++cl) {
        const unsigned char* rec = p.ws + WS_RP + (size_t)(cl * 128 + bh) * RP_STRIDE;
        const int cur = (cl - c_lo) & 1;
        __syncthreads();
        u32x4 nx[4];
        const bool more = cl < CPS;
        if (more) { const u32x4* src = (const u32x4*)(rec + (size_t)RP_STRIDE * 128);
#pragma unroll
            for (int x = 0; x < 4; ++x) nx[x] = src[tl + 256 * x]; }
        const bf16_t* gKH = (const bf16_t*)(rec + RP_KH); const bf16_t* gYH = (const bf16_t*)(rec + RP_YH);
        u32x2 kh[4], yh[4]; f32x4 pc[4];
#pragma unroll
        for (int mt = 0; mt < 4; ++mt) { kh[mt] = *(const u32x2*)(gKH + ((size_t)(vt * 4 + mt) * 64 + lane) * 4); yh[mt] = *(const u32x2*)(gYH + ((size_t)(vt * 4 + mt) * 64 + lane) * 4);
            pc[mt] = *(const f32x4*)((const float*)(rec + RP_PC) + 16 * mt + 4 * q4); }
        const int tk = tl >> 2, g = tl & 3;
        u32x4 a0 = {0u, 0u, 0u, 0u}, a1 = a0, b0 = a0, b1 = a0;
        if (cl > 0) { const bf16_t* c1p = (const bf16_t*)(rec + RP_C1) + tk * 64 + 16 * g; const bf16_t* c0p = (const bf16_t*)(rec + RP_C0) + tk * 64 + 16 * g;
            a0 = *(const u32x4*)c0p; a1 = *(const u32x4*)(c0p + 8); b0 = *(const u32x4*)c1p; b1 = *(const u32x4*)(c1p + 8); }
        bf16x8 Bf[2];
#pragma unroll
        for (int ks = 0; ks < 2; ++ks) { u32x4 tq; tq.x = pk2(S[2 * ks][0], S[2 * ks][1]); tq.y = pk2(S[2 * ks][2], S[2 * ks][3]); tq.z = pk2(S[2 * ks + 1][0], S[2 * ks + 1][1]); tq.w = pk2(S[2 * ks + 1][2], S[2 * ks + 1][3]);
            Bf[ks] = __builtin_bit_cast(bf16x8, tq); }
        const bf16x8* AP = (const bf16x8*)(smem + cur * 32768 + hsel * 16384); const bf16x8* RH = (const bf16x8*)(smem + cur * 32768 + hsel * 16384 + RP_RH);
        f32x4 y[4], tS[4];
#pragma unroll
        for (int tt = 0; tt < 4; ++tt) { y[tt] = (f32x4){0.f, 0.f, 0.f, 0.f}; y[tt] = MFMA16(RH[(tt * 2 + 0) * 64 + lane], Bf[0], y[tt]); y[tt] = MFMA16(RH[(tt * 2 + 1) * 64 + lane], Bf[1], y[tt]); }
#pragma unroll
        for (int mt = 0; mt < 4; ++mt) { tS[mt] = (f32x4){0.f, 0.f, 0.f, 0.f}; tS[mt] = MFMA16(AP[(mt * 2 + 0) * 64 + lane], Bf[0], tS[mt]); tS[mt] = MFMA16(AP[(mt * 2 + 1) * 64 + lane], Bf[1], tS[mt]); }
#pragma unroll
        for (int mt = 0; mt < 4; ++mt) {
            S[mt][0] = pc[mt][0] * S[mt][0] + tS[mt][0] + __uint_as_float(kh[mt].x << 16); S[mt][1] = pc[mt][1] * S[mt][1] + tS[mt][1] + __uint_as_float(kh[mt].x & 0xffff0000u);
            S[mt][2] = pc[mt][2] * S[mt][2] + tS[mt][2] + __uint_as_float(kh[mt].y << 16); S[mt][3] = pc[mt][3] * S[mt][3] + tS[mt][3] + __uint_as_float(kh[mt].y & 0xffff0000u); }
        if (cl > 0) {
#pragma unroll
            for (int tt = 0; tt < 4; ++tt) {
                y[tt][0] += __uint_as_float(yh[tt].x << 16); y[tt][1] += __uint_as_float(yh[tt].x & 0xffff0000u); y[tt][2] += __uint_as_float(yh[tt].y << 16); y[tt][3] += __uint_as_float(yh[tt].y & 0xffff0000u);
#pragma unroll
                for (int r = 0; r < 4; ++r) ybuf[(16 * tt + 4 * q4 + r) * 68 + 16 * vt + l15] = y[tt][r]; }
        }
        if (more) { u32x4* dst = (u32x4*)(smem + (cur ^ 1) * 32768 + hsel * 16384);
#pragma unroll
            for (int x = 0; x < 4; ++x) dst[tl + 256 * x] = nx[x]; }
        if (cl > 0) {
            __syncthreads();
            f32x4 yv[4]; float sm = 0.f;
#pragma unroll
            for (int j = 0; j < 4; ++j) { yv[j] = *(const f32x4*)(ybuf + tk * 68 + 16 * g + 4 * j); sm += yv[j][0] + yv[j][1] + yv[j][2] + yv[j][3]; }
            sm += __shfl_xor(sm, 1); sm += __shfl_xor(sm, 2);
            const float mu = sm * (1.f / 64.f); float vs = 0.f;
#pragma unroll
            for (int j = 0; j < 4; ++j) { yv[j] = yv[j] - mu; vs += yv[j][0] * yv[j][0] + yv[j][1] * yv[j][1] + yv[j][2] * yv[j][2] + yv[j][3] * yv[j][3]; }
            vs += __shfl_xor(vs, 1); vs += __shfl_xor(vs, 2);
            const float rs = __builtin_amdgcn_rsqf(vs * (1.f / 64.f) + 64e-5f);
            const unsigned c0w[8] = {a0.x, a0.y, a0.z, a0.w, a1.x, a1.y, a1.z, a1.w}, c1w[8] = {b0.x, b0.y, b0.z, b0.w, b1.x, b1.y, b1.z, b1.w};
            unsigned ow[8];
#pragma unroll
            for (int j = 0; j < 8; ++j) ow[j] = pk2(yv[j >> 1][(j & 1) * 2] * rs * __uint_as_float(c1w[j] << 16) + __uint_as_float(c0w[j] << 16),
                                                     yv[j >> 1][(j & 1) * 2 + 1] * rs * __uint_as_float(c1w[j] & 0xffff0000u) + __uint_as_float(c0w[j] & 0xffff0000u));
            const size_t grow = (size_t)b * SEQ + seg * SEGTOK + (cl - 1) * 64 + tk;
            bf16_t* ob = (bf16_t*)(p.ws + WS_OB) + grow * D + hb * 64 + 16 * g;
            *(u32x4*)ob = (u32x4){ow[0], ow[1], ow[2], ow[3]}; *(u32x4*)(ob + 8) = (u32x4){ow[4], ow[5], ow[6], ow[7]};
        }
    }
#pragma unroll
    for (int mt = 0; mt < 4; ++mt) *(f32x4*)(st + (size_t)(16 * vt + l15) * 64 + 16 * mt + 4 * q4) = S[mt];
    __syncthreads();
}

__device__ __forceinline__ void gdn_sample_item(const Params& p, unsigned char* smem, int bs, int h) {
    const int tid = otid(), w = tid >> 6, lane = tid & 63, kq = tid >> 7, v = tid & 127;
    float* qk_s = (float*)smem; float* v_s = qk_s + 1024; float* gb_s = v_s + 512; float* part = gb_s + 16; float* part2 = part + 512;
    const bf16_t* P = (const bf16_t*)(p.ws + WS_P);
    const float* pk = (const float*)(p.ws + WS_PK);
    const float* s_in = p.in[2] + (size_t)(bs * 8 + h) * 16384; float* s_out = p.out + O_GDN_S + (size_t)(bs * 8 + h) * 16384;
    const int row0 = LEX0 + EX_SAMP + bs * DECT;
    float s[32];
#pragma unroll
    for (int j = 0; j < 32; ++j) s[j] = s_in[(size_t)(kq * 32 + j) * 128 + v];
    if (tid < 384) {
        const int pcol = (tid >> 7) * 1024 + h * 128 + (tid & 127);
        const float* cw = pk + PK_CONVW; const float* hin = p.in[3] + (size_t)bs * 9216; float* hout = p.out + O_CONV_S + (size_t)bs * 9216;
        const float cw0 = cw[pcol], cw1 = cw[3072 + pcol], cw2 = cw[6144 + pcol], cw3 = cw[9216 + pcol];
        float x3 = hin[pcol], x2 = hin[3072 + pcol], x1 = hin[6144 + pcol];
        float xr[4];
#pragma unroll
        for (int i = 0; i < 4; ++i) xr[i] = bf2f(P[(size_t)(row0 + i) * NPB + pcol]);
#pragma unroll
        for (int i = 0; i < 4; ++i) { const float y = cw0 * x3 + cw1 * x2 + cw2 * x1 + cw3 * xr[i]; x3 = x2; x2 = x1; x1 = xr[i];
            if (tid < 256) qk_s[i * 256 + tid] = silu_(y); else v_s[i * 128 + (tid - 256)] = silu_(y); }
        hout[pcol] = x3; hout[3072 + pcol] = x2; hout[6144 + pcol] = x1;
    } else if (tid < 388) {
        const int i = tid - 384; const size_t r = (size_t)(row0 + i) * NPB;
        const float pa = bf2f(P[r + C_A + h]), pb = bf2f(P[r + C_B + h]);
        gb_s[2 * i] = __expf(-expf(pk[PK_ALOG + h]) * softplus_(pa + pk[PK_DTB + h])); gb_s[2 * i + 1] = sigm(pb);
    }
    __syncthreads();
    { const int i = w >> 1, which = w & 1; float* rp = qk_s + i * 256 + which * 128; const float a = rp[lane], b = rp[lane + 64];
      const float sc = __builtin_amdgcn_rsqf(wave_sum(a * a + b * b) + 1e-6f) * (which == 0 ? 0.08838834764831845f : 1.f); rp[lane] = a * sc; rp[lane + 64] = b * sc; }
    __syncthreads();
#pragma unroll 1
    for (int i = 0; i < 4; ++i) {
        const float* kp = qk_s + i * 256 + 128 + kq * 32; const float* qp = qk_s + i * 256 + kq * 32;
        float pa = 0.f;
#pragma unroll
        for (int j4 = 0; j4 < 8; ++j4) { const f32x4 k4 = *(const f32x4*)(kp + 4 * j4); pa += k4[0] * s[4 * j4] + k4[1] * s[4 * j4 + 1] + k4[2] * s[4 * j4 + 2] + k4[3] * s[4 * j4 + 3]; }
        part[kq * 128 + v] = pa;
        __syncthreads();
        const float kS = part[v] + part[128 + v] + part[256 + v] + part[384 + v];
        const float a = gb_s[2 * i], c = gb_s[2 * i + 1] * (v_s[i * 128 + v] - a * kS);
        float po = 0.f;
#pragma unroll
        for (int j4 = 0; j4 < 8; ++j4) { const f32x4 k4 = *(const f32x4*)(kp + 4 * j4), q4v = *(const f32x4*)(qp + 4 * j4);
#pragma unroll
            for (int e = 0; e < 4; ++e) { s[4 * j4 + e] = a * s[4 * j4 + e] + k4[e] * c; po += q4v[e] * s[4 * j4 + e]; } }
        part2[kq * 128 + v] = po;
        __syncthreads();
        if (kq == 0) ((float*)(p.ws + WS_ORAW))[(size_t)(row0 + i) * D + h * 128 + v] = part2[v] + part2[128 + v] + part2[256 + v] + part2[384 + v];
    }
#pragma unroll
    for (int j = 0; j < 32; ++j) s_out[(size_t)(kq * 32 + j) * 128 + v] = s[j];
    __syncthreads();
}

constexpr int SR_R = 0, SR_KK = 4096, SR_V = 8192, SR_ZB = 12288, SR_DEC = 16384, SR_KA = 20480, SR_KM = 24576, SR_WD = 28672, SR_AD = 28928, SR_RK = 29184;
__device__ __forceinline__ void rwkv_sample_item(const Params& p, unsigned char* smem, int bs) {
    const int tid = otid(), w = tid >> 6, lane = tid & 63;
    float* f = (float*)smem;
    const bf16_t* P = (const bf16_t*)(p.ws + WS_P);
    const float* pk = (const float*)(p.ws + WS_PK);
    const int row0 = LEX0 + EX_SAMP + bs * DECT;
    const bf16_t* prow = P + (size_t)(LEX0 + EX_SHIFT + bs) * NPB + C_RW;
#pragma unroll 1
    for (int col = tid; col < RW_SHIFT; col += 512) {
        const float mu = pk[PK_MU + col]; float prev = bf2f(prow[col]);
        float cur[4];
#pragma unroll
        for (int i = 0; i < 4; ++i) cur[i] = bf2f(P[(size_t)(row0 + i) * NPB + C_RW + col]);
        float* dst; int stride = 1024; bool th = false;
        if (col < 1024) dst = f + SR_R + col; else if (col < 2048) dst = f + SR_KK + (col - 1024); else if (col < 3072) dst = f + SR_V + (col - 2048);
        else if (col < 3136) { dst = f + SR_WD + (col - 3072); stride = 64; th = true; } else if (col < 3200) { dst = f + SR_AD + (col - 3136); stride = 64; } else dst = f + SR_ZB + (col - 3200);
#pragma unroll
        for (int i = 0; i < 4; ++i) { float m = cur[i] + mu * (prev - cur[i]); prev = cur[i]; if (th) m = tanh_(m); dst[i * stride] = m; }
    }
    __syncthreads();
#pragma unroll 1
    for (int cc = 0; cc < 2; ++cc) {
        const int c = tid + 512 * cc;
        float aw[4] = {0.f, 0.f, 0.f, 0.f}, aa[4] = {0.f, 0.f, 0.f, 0.f};
#pragma unroll 8
        for (int l = 0; l < 64; ++l) { const float w2v = pk[PK_W2 + l * D + c], a2v = pk[PK_A2 + l * D + c];
#pragma unroll
            for (int i = 0; i < 4; ++i) { aw[i] += f[SR_WD + i * 64 + l] * w2v; aa[i] += f[SR_AD + i * 64 + l] * a2v; } }
        const float w0c = pk[PK_W0 + c], a0c = pk[PK_A0 + c], kkc = pk[PK_KK + c], kac = pk[PK_KA + c];
#pragma unroll
        for (int i = 0; i < 4; ++i) { const float a = sigm(a0c + aa[i]); const float kbv = f[SR_KK + i * 1024 + c];
            f[SR_DEC + i * 1024 + c] = __expf(-0.6065306597126334f * sigm(w0c + aw[i])); f[SR_KA + i * 1024 + c] = a; f[SR_KK + i * 1024 + c] = kbv * kkc; f[SR_KM + i * 1024 + c] = kbv * (1.f + (a - 1.f) * kac); }
    }
    __syncthreads();
#pragma unroll 1
    for (int x = 0; x < 8; ++x) { const int pr = w * 8 + x, i = pr >> 4, hh = pr & 15; const int o = i * 1024 + hh * 64 + lane;
        const float kr = f[SR_KK + o]; const float kk = kr * __builtin_amdgcn_rsqf(wave_sum(kr * kr) + 1e-6f); f[SR_KK + o] = kk; f[SR_KA + o] = kk * f[SR_KA + o];
        const float rkv = wave_sum(f[SR_R + o] * f[SR_KM + o] * pk[PK_RK + hh * 64 + lane]); if (lane == 0) f[SR_RK + pr] = rkv; }
    __syncthreads();
#pragma unroll 1
    for (int hp = 0; hp < 2; ++hp) {
        const int hb = hp * 8 + w;
        const float* s_in = p.in[4] + (size_t)(bs * 16 + hb) * 4096 + (size_t)lane * 64; float* s_out = p.out + O_RWKV_S + (size_t)(bs * 16 + hb) * 4096 + (size_t)lane * 64;
        f32x4 S[16];
#pragma unroll
        for (int j = 0; j < 16; ++j) S[j] = *(const f32x4*)(s_in + 4 * j);
        const int cch = hb * 64 + lane;
        const float gnw = pk[PK_GNW + cch], gnb = pk[PK_GNB + cch];
#pragma unroll 1
        for (int i = 0; i < 4; ++i) {
            const int o = i * 1024 + hb * 64;
            const float vv = f[SR_V + o + lane], rk = f[SR_RK + i * 16 + hb];
            float sa = 0.f;
#pragma unroll
            for (int j = 0; j < 16; ++j) { const f32x4 kk4 = *(const f32x4*)(f + SR_KK + o + 4 * j); sa += S[j][0] * kk4[0] + S[j][1] * kk4[1] + S[j][2] * kk4[2] + S[j][3] * kk4[3]; }
            float y = 0.f;
#pragma unroll
            for (int j = 0; j < 16; ++j) { const f32x4 de4 = *(const f32x4*)(f + SR_DEC + o + 4 * j), ka4 = *(const f32x4*)(f + SR_KA + o + 4 * j), km4 = *(const f32x4*)(f + SR_KM + o + 4 * j), r4 = *(const f32x4*)(f + SR_R + o + 4 * j);
#pragma unroll
                for (int e = 0; e < 4; ++e) { S[j][e] = S[j][e] * de4[e] + (vv * km4[e] - sa * ka4[e]); y += S[j][e] * r4[e]; } }
            const float mu = wave_sum(y) * (1.f / 64.f); const float dy = y - mu;
            const float rs = __builtin_amdgcn_rsqf(wave_sum(dy * dy) * (1.f / 64.f) + 64e-5f);
            const float ov = (dy * rs * gnw + gnb + rk * vv) * silu_(f[SR_ZB + i * 1024 + cch]);
            ((bf16_t*)(p.ws + WS_OB))[(size_t)(XROWS + EX_SAMP + bs * DECT + i) * D + cch] = (bf16_t)f2bf(ov);
        }
#pragma unroll
        for (int j = 0; j < 16; ++j) *(f32x4*)(s_out + 4 * j) = S[j];
    }
    __syncthreads();
}

__device__ __forceinline__ void phase2(const Params& p, int seg, unsigned char* smem) {
    const int blk = obid();
    float* out = p.out;
    float* chalo = (float*)(p.ws + WS_CHALO); float* phalo = (float*)(p.ws + WS_PHALO);
#ifndef SUB
#define SUB 0
#endif
#define SEN(x) (SUB == 0 || SUB == (x))
    if (SEN(1) && blk < 64) gdn_scan_block(p, seg, smem, blk);
    if (SEN(3) && blk >= 64 && blk < 128) rwkv_scan_block(p, seg, smem, blk - 64);
#ifndef DUP
#define DUP 0
#endif
    if (seg == 0) {
#pragma unroll 1
        for (int it = blk; it < DECB * 8; it += gridDim.x) gdn_sample_item(p, smem, it >> 3, it & 7);
#pragma unroll 1
        for (int it = (blk + 128) & 255; it < DECB; it += gridDim.x) rwkv_sample_item(p, smem, it);
    }
}

__device__ __forceinline__ void phase25(const Params& p, int seg) {
    const int tid0 = otid(); const int lane = tid0 & 63; const int gw = obid() * 8 + (tid0 >> 6), NGW = gridDim.x * 8;
    const bf16_t* P = (const bf16_t*)(p.ws + WS_P);
    const float* ORAW = (const float*)(p.ws + WS_ORAW); const float* YRAW = (const float*)(p.ws + WS_YRAW);
    const bf16_t* C0 = (const bf16_t*)(p.ws + WS_C0); const bf16_t* C1 = (const bf16_t*)(p.ws + WS_C1);
    bf16_t* OA = (bf16_t*)(p.ws + WS_H); bf16_t* OB = (bf16_t*)(p.ws + WS_OB);
    const int nrows = LEX0 + (seg == 0 ? DECB * DECT : 0);
    const int c = lane * 16;
    f32x4 nw[4];
#pragma unroll
    for (int j = 0; j < 4; ++j) nw[j] = *(const f32x4*)((const float*)(p.ws + WS_PK) + PK_NORMW + (c & 127) + 4 * j);
#pragma unroll 1
    for (int rr = LEX0 + gw; rr < nrows; rr += NGW) {
        int lr; size_t grow;
        if (rr < LEX0) { lr = rr; grow = (size_t)(rr / SEGTOK) * SEQ + seg * SEGTOK + (rr % SEGTOK); } else { lr = LEX0 + EX_SAMP + (rr - LEX0); grow = (size_t)XROWS + EX_SAMP + (rr - LEX0); }
        {
            f32x4 o[4]; float ss = 0.f;
#pragma unroll
            for (int j = 0; j < 4; ++j) { o[j] = *(const f32x4*)(ORAW + (size_t)lr * D + c + 4 * j); ss += o[j][0] * o[j][0] + o[j][1] * o[j][1] + o[j][2] * o[j][2] + o[j][3] * o[j][3]; }
            ss += __shfl_xor(ss, 1); ss += __shfl_xor(ss, 2); ss += __shfl_xor(ss, 4);
            const float rs = __builtin_amdgcn_rsqf(ss * (1.f / 128.f) + 1e-6f);
            const u32x4 z0 = *(const u32x4*)(P + (size_t)lr * NPB + C_Z + c), z1 = *(const u32x4*)(P + (size_t)lr * NPB + C_Z + c + 8);
            const unsigned zz[8] = {z0.x, z0.y, z0.z, z0.w, z1.x, z1.y, z1.z, z1.w};
            unsigned ow[8];
#pragma unroll
            for (int j = 0; j < 8; ++j) { const float za = __uint_as_float(zz[j] << 16), zb = __uint_as_float(zz[j] & 0xffff0000u);
                const float a = o[j >> 1][(j & 1) * 2] * rs * nw[j >> 1][(j & 1) * 2] * silu_(za), b = o[j >> 1][(j & 1) * 2 + 1] * rs * nw[j >> 1][(j & 1) * 2 + 1] * silu_(zb);
                ow[j] = pk2(a, b); }
            *(u32x4*)(OA + grow * D + c) = (u32x4){ow[0], ow[1], ow[2], ow[3]}; *(u32x4*)(OA + grow * D + c + 8) = (u32x4){ow[4], ow[5], ow[6], ow[7]};
        }
    }
}

__device__ __forceinline__ void phase_final(const Params& p) {
    const int tid0 = otid(); const int lane = tid0 & 63; const int gw = obid() * 8 + (tid0 >> 6), NGW = gridDim.x * 8;
    const f32x4* wr = (const f32x4*)((const float*)(p.ws + WS_PK) + PK_LNF) + lane;
#pragma unroll 1
    for (int r = gw; r < XROWS + DECB * DECT; r += NGW) {
        f32x4* xr = (f32x4*)(p.out + (size_t)r * D) + lane;
        f32x4 v[4]; float ss = 0.f;
#pragma unroll
        for (int j = 0; j < 4; ++j) { v[j] = xr[64 * j]; ss += v[j][0] * v[j][0] + v[j][1] * v[j][1] + v[j][2] * v[j][2] + v[j][3] * v[j][3]; }
        const float rs = __builtin_amdgcn_rsqf(wave_sum(ss) * (1.f / D) + 1e-6f);
#pragma unroll
        for (int j = 0; j < 4; ++j) xr[64 * j] = v[j] * rs * wr[64 * j];
    }
}

__global__ __launch_bounds__(512, 2) void hybrid_mega(Params p) {
    extern __shared__ __attribute__((aligned(16))) unsigned char smem[];
    cg::grid_group grid = cg::this_grid();
    LAS unsigned char* lds = (LAS unsigned char*)smem;
    const int G = gridDim.x;
    volatile LAS unsigned* xst = (volatile LAS unsigned*)(lds + (LDS_TOTAL - 16));
    if (threadIdx.x == 0) { xst[0] = 0u; xst[1] = 0u; }
    __syncthreads();
    (void)xcd_barrier_post((unsigned*)(p.ws + WS_BAR), xst);
    if (G == 0x7fffffff) grid.sync();
#define GSYNC() do { XcdBarrier xb_; xb_.bar = (unsigned*)(p.ws + WS_BAR); xb_.x = xb_xcc_id(); xb_.st = (volatile LAS unsigned*)((LAS unsigned char*)smem + (LDS_TOTAL - 16)); xcd_barrier(xb_); } while (0)

#ifndef ONLY
#define ONLY 0
#endif
#define EN(x) (ONLY == 0 || ONLY == (x))
    if (EN(1)) phase0(p, smem);
    GSYNC();
#pragma unroll 1
    for (int it = 0; it <= NSEG + 2; ++it) {
        const int xblk = obid() - (G - 12);
        const bool xrole = xblk >= 0;
        if (it > 0 && it <= NSEG && EN(3)) phase2(p, it - 1, smem);
        if (((it == 2 && xrole) || it == NSEG + 1) && EN(5)) {
            const bool ex = it == 2;
            SchedAB S; S.ob.init(ex ? 3 : XROWS / 256, 4, ex ? 12 : G, ex ? xblk : obid()); S.pm0 = ex ? XROWS / 256 : 0;
            S.A0 = (const char*)(p.ws + WS_H); S.A1 = (const char*)(p.ws + WS_OB); S.B0 = (const char*)(p.ws + WS_WT_A); S.B1 = (const char*)(p.ws + WS_WT_B);
            EpiAB E; E.tmp = ex ? (float*)(p.ws + WS_YRAW) - (size_t)XROWS * D : (float*)(p.ws + WS_P); E.merged = ex ? (bf16_t*)(p.ws + WS_C0) - (size_t)XROWS * D : (bf16_t*)(p.ws + WS_MG);
            E.gex = (const bf16_t*)(p.ws + WS_GEX); E.out = p.out;
            pg8::gemm_phase<EpiAB, SchedAB>(lds, D, S, E);
        }
        if (((it == 3 && xrole) || it == NSEG + 2) && EN(6)) {
            const bool ex = it == 3;
            SchedO S; S.ob.init(ex ? 3 : XROWS / 256, 4, ex ? 12 : G, ex ? xblk : obid()); S.pm0 = ex ? XROWS / 256 : 0;
            S.A = ex ? (const char*)((bf16_t*)(p.ws + WS_C0) - (size_t)XROWS * D) : (const char*)(p.ws + WS_MG); S.B = (const char*)(p.ws + WS_WT_O);
            EpiO E; E.out = p.out; E.xp = p.in[0]; E.xs = p.in[1];
            pg8::gemm_phase<EpiO, SchedO>(lds, D, S, E);
        }
        if (it < NSEG && EN(2) && !(it == 2 && xrole)) {
            const int seg = it;
            const int Gp = it == 2 ? G - 12 : G;
            const int cidx = it > 0 ? (obid() + (Gp >> 1)) % Gp : obid();
            SchedIn S; S.ob.init(seg == 0 ? LT_PROMPT + 3 : LT_PROMPT, NT_IN, Gp, cidx); S.seg = seg; S.A = (const char*)(p.ws + WS_H); S.B = (const char*)(p.ws + WS_WT_IN);
            EpiIn E; E.P = (bf16_t*)(p.ws + WS_P); E.gex = (bf16_t*)(p.ws + WS_GEX); E.out = p.out; E.seg = seg;
            pg8::gemm_phase<EpiIn, SchedIn>(lds, D, S, E);
        }
        GSYNC();
        if (it < NSEG) {
            if (EN(8)) { phase_gprep(p, it, smem); phase_rprep(p, it, smem); }
            if (it == 1 && EN(4)) phase25(p, 0);
            GSYNC();
        }
    }
    if (EN(7)) phase_final(p);
}

extern "C" void kernel_launch(void* const* d_in, const int* in_sizes, int n_in, void* d_out, int out_size, void* d_ws, size_t ws_size, hipStream_t stream) {
    static int grid_blocks = 0;
    constexpr int LDS_BYTES = LDS_TOTAL;
    if (grid_blocks == 0) {
        if (n_in != 27 || ws_size < WS_END) { fprintf(stderr, "kernel_launch: unexpected n_in %d / ws %zu (need %zu)\n", n_in, ws_size, (size_t)WS_END); grid_blocks = -1; return; }
        if (hipFuncSetAttribute((const void*)hybrid_mega, hipFuncAttributeMaxDynamicSharedMemorySize, LDS_BYTES) != hipSuccess) { fprintf(stderr, "kernel_launch: hipFuncSetAttribute failed\n"); grid_blocks = -1; return; }
        int dev = 0, cus = 0, per_cu = 0;
        hipGetDevice(&dev);
        hipDeviceGetAttribute(&cus, hipDeviceAttributeMultiprocessorCount, dev);
        hipOccupancyMaxActiveBlocksPerMultiprocessor(&per_cu, (const void*)hybrid_mega, 512, LDS_BYTES);
        if (per_cu < 1) { fprintf(stderr, "kernel_launch: occupancy query says %d blocks/CU\n", per_cu); per_cu = 1; }
        (void)hipGetLastError();
        grid_blocks = cus;
    }
    if (grid_blocks < 0) return;
    Params p{};
    for (int i = 0; i < 27; ++i) p.in[i] = (const float*)d_in[i];
    p.out = (float*)d_out; p.ws = (unsigned char*)d_ws;
    if (hipMemsetAsync((unsigned char*)d_ws + WS_BAR, 0, 16384, stream) != hipSuccess) { fprintf(stderr, "kernel_launch: memset of the barrier words failed\n"); return; }
    void* args[] = {&p};
    hipError_t e = hipLaunchCooperativeKernel((const void*)hybrid_mega, dim3(grid_blocks), dim3(512), args, LDS_BYTES, stream);
    if (e != hipSuccess) fprintf(stderr, "cooperative launch failed: %s (grid %d)\n", hipGetErrorString(e), grid_blocks);
}
```

```cpp
#include <hip/hip_runtime.h>
#include <hip/hip_cooperative_groups.h>
#include <cstdio>
namespace cg = cooperative_groups;

#define LAS __attribute__((address_space(3)))
typedef unsigned short bf16_t;
typedef short bf16x8 __attribute__((ext_vector_type(8)));
typedef float f32x4 __attribute__((ext_vector_type(4)));
typedef unsigned u32x4 __attribute__((ext_vector_type(4)));
typedef unsigned u32x2 __attribute__((ext_vector_type(2)));

constexpr int D = 1024;
constexpr int NBATCH = 8, SEQ = 2048, NMETA = 16, DECB = 128, DECT = 4;
constexpr int XROWS = NBATCH * SEQ;
constexpr int EX_SAMP = 16, EX_SHIFT = 528, EX_END = 656;
constexpr int HROWS = 17152, HTILES = 67;
constexpr int NSEG = 8, SEGTOK = SEQ / NSEG;
constexpr int CPS = SEGTOK / 64;
constexpr int TPB = SEGTOK / 256;
constexpr int LT_PROMPT = NBATCH * TPB;
constexpr int LEX0 = LT_PROMPT * 256;
constexpr int LROWS = LEX0 + 768;
constexpr int NP = 10496, NPB = 8448, NT_IN = 41, NT_PB = 33;
constexpr int C_A = 3072, C_B = 3080, C_Z = 3088, C_RW = 4112, C_GATE_REF = 8336;
constexpr int RW_SHIFT = 4224;

constexpr size_t O_YP = 0, O_YS = 16777216, O_GDN_P = 17301504, O_CONV_P = 18350080, O_RWKV_P = 18423808, O_SHIFT_P = 18948096,
                 O_GDN_S = 18956288, O_CONV_S = 35733504, O_RWKV_S = 36913152, O_SHIFT_S = 45301760;

constexpr size_t al256(size_t x) { return (x + 255) & ~(size_t)255; }
constexpr size_t WS_WT_IN = 0;
constexpr size_t WS_WT_A = al256(WS_WT_IN + (size_t)NP * D * 2);
constexpr size_t WS_WT_B = al256(WS_WT_A + (size_t)D * D * 2);
constexpr size_t WS_WT_O = al256(WS_WT_B + (size_t)D * D * 2);
constexpr size_t WS_H = al256(WS_WT_O + (size_t)D * D * 2);
constexpr size_t WS_OB = al256(WS_H + (size_t)HROWS * D * 2);
constexpr size_t WS_P = al256(WS_OB + (size_t)HROWS * D * 2);
constexpr size_t WS_ORAW = al256(WS_P + (size_t)LROWS * NPB * 2);
constexpr size_t WS_YRAW = al256(WS_ORAW + (size_t)LROWS * D * 4);
constexpr size_t WS_C0 = al256(WS_YRAW + (size_t)LROWS * D * 4);
constexpr size_t WS_C1 = al256(WS_C0 + (size_t)LROWS * D * 2);
constexpr size_t WS_GEX = al256(WS_C1 + (size_t)LROWS * D * 2);
constexpr size_t WS_CHALO = al256(WS_GEX + (size_t)768 * 2048 * 2);
constexpr size_t WS_PHALO = al256(WS_CHALO + (size_t)2 * NBATCH * 3 * NPB * 2);
constexpr size_t WS_PK = al256(WS_PHALO + (size_t)2 * NBATCH * NPB * 2);
constexpr int PK_CONVW = 0, PK_ALOG = 12288, PK_DTB = 12296, PK_NORMW = 12304, PK_MU = 12432, PK_W0 = 16656, PK_W2 = 17680, PK_A0 = 83216, PK_A2 = 84240,
              PK_KK = 149776, PK_KA = 150800, PK_RK = 151824, PK_GNW = 152848, PK_GNB = 153872, PK_LNF = 154896, PK_END = 155920;
constexpr size_t WS_BAR = al256(WS_PK + (size_t)PK_END * 4);
constexpr size_t WS_W2T = al256(WS_BAR + 16384);
constexpr size_t WS_A2T = al256(WS_W2T + 131072);
constexpr size_t WS_GP = al256(WS_A2T + 131072);
constexpr int GP_AP = 0, GP_QH = 32768, GP_KH = 49152, GP_OH = 81920, GP_EGL = 98304, GP_G = 98560, GP_STRIDE = 114944;
constexpr int RP_AP = 0, RP_RH = 8192, RP_KH = 16384, RP_YH = 24576, RP_C1 = 32768, RP_C0 = 40960, RP_PC = 49152, RP_STRIDE = 49408;
constexpr size_t WS_RP = al256(WS_GP + (size_t)(CPS + 1) * 64 * GP_STRIDE);
constexpr size_t WS_END = al256(WS_RP + (size_t)(CPS + 1) * 128 * RP_STRIDE);
constexpr size_t WS_MG = WS_GP;
static_assert((size_t)HROWS * D * 2 <= WS_END - WS_GP, "MERGED must fit in the prep records");
static_assert((size_t)HROWS * D * 4 <= (size_t)LROWS * NPB * 2 + 2 * (size_t)LROWS * D * 4, "TMP must fit in P+ORAW+YRAW");
static_assert(WS_END <= (size_t)268435456, "workspace");

constexpr int LDS_TOTAL = 163840;
struct Params { const float* in[27]; float* out; unsigned char* ws; };

__device__ __forceinline__ float bf2f(bf16_t v) { return __uint_as_float(((unsigned)v) << 16); }
typedef __bf16 bf16n2 __attribute__((ext_vector_type(2)));
typedef float f32n2 __attribute__((ext_vector_type(2)));
__device__ __forceinline__ unsigned cvt_pk_bf16(float lo, float hi) { const f32n2 v = {lo, hi}; return __builtin_bit_cast(unsigned, __builtin_convertvector(v, bf16n2)); }
__device__ __forceinline__ unsigned pk2(float lo, float hi) { return cvt_pk_bf16(lo, hi); }
__device__ __forceinline__ unsigned f2bf(float f) { return cvt_pk_bf16(f, 0.f) & 0xffffu; }
__device__ __forceinline__ float sigm(float x) { return __builtin_amdgcn_rcpf(1.f + __expf(-x)); }
__device__ __forceinline__ float silu_(float x) { return x * __builtin_amdgcn_rcpf(1.f + __expf(-x)); }
__device__ __forceinline__ float softplus_(float x) { return fmaxf(x, 0.f) + log1pf(expf(-fabsf(x))); }
__device__ __forceinline__ float wave_sum(float v) {
#pragma unroll
    for (int o = 1; o < 64; o <<= 1) v += __shfl_xor(v, o);
    return v;
}
__device__ __forceinline__ int otid() { int t = threadIdx.x; asm volatile("" : "+v"(t)); return t; }
__device__ __forceinline__ int obid() { int t = blockIdx.x; asm volatile("" : "+s"(t)); return t; }
__device__ __forceinline__ float tanh_(float x) { const float e = __expf(2.f * x); return 1.f - 2.f * __builtin_amdgcn_rcpf(e + 1.f); }
template <int CTRL> __device__ __forceinline__ float dppf(float x) { return __builtin_bit_cast(float, __builtin_amdgcn_mov_dpp(__builtin_bit_cast(int, x), CTRL, 0xf, 0xf, true)); }
__device__ __forceinline__ float rowsum16(float x) { x += dppf<0x128>(x); x += dppf<0x124>(x); x += dppf<0x122>(x); x += dppf<0x121>(x); return x; }


#define XB_TMO      128
#define XB_XCNT(j)  (256  + 64 * (j))
#define XB_XSUB(j)  (1280 + 64 * (j))
#define XB_XGEN(j)  (2304 + 64 * (j))
#define XB_TOP      3328
#define XB_TOPGEN   3392
#define XCD_BAR_WORDS 3456
#define XB_SPIN_CAP (1u << 22)
__device__ __forceinline__ unsigned xb_ld(unsigned* p)              { return __hip_atomic_load(p, __ATOMIC_RELAXED, __HIP_MEMORY_SCOPE_AGENT); }
__device__ __forceinline__ unsigned xb_add(unsigned* p, unsigned v) { return __hip_atomic_fetch_add(p, v, __ATOMIC_RELAXED, __HIP_MEMORY_SCOPE_AGENT); }
__device__ __forceinline__ unsigned xb_xcc_id() { return (unsigned)__builtin_amdgcn_s_getreg((3 << 11) | 20) & 0xFu; }
#define XB_SPIN(cond, bar) do { unsigned _sp = 0; while (cond) { __builtin_amdgcn_s_sleep(1); \
    if ((++_sp & 255u) == 0u) { if (xb_ld(&(bar)[XB_TMO])) break; if (_sp > XB_SPIN_CAP) { atomicAdd(&(bar)[XB_TMO], 1u); break; } } } } while (0)
struct XcdBarrier { unsigned* bar; unsigned x; volatile LAS unsigned* st; };
__device__ __forceinline__ XcdBarrier xcd_barrier_post(unsigned* bar, volatile LAS unsigned* st) {
    XcdBarrier b; b.bar = bar; b.x = xb_xcc_id(); b.st = st;
    if (threadIdx.x == 0) (void)xb_add(&bar[XB_XCNT(b.x)], 1u);
    return b;
}
__device__ __forceinline__ void xcd_barrier_complete(unsigned* bar, unsigned x, unsigned& nloc, unsigned& nx) {
    const unsigned G = gridDim.x * gridDim.y * gridDim.z;
    unsigned sum, cnt, mine, sp = 0u;
    for (;;) {
        sum = 0u; cnt = 0u; mine = 0u;
#pragma unroll
        for (unsigned j = 0; j < 16; ++j) { const unsigned c = xb_ld(&bar[XB_XCNT(j)]); sum += c; cnt += (c > 0u) ? 1u : 0u; mine = (j == x) ? c : mine; }
        if (sum == G) break;
        __builtin_amdgcn_s_sleep(1);
        if ((++sp & 255u) == 0u) { if (xb_ld(&bar[XB_TMO])) break; if (sp > XB_SPIN_CAP) { atomicAdd(&bar[XB_TMO], 1u); break; } }
    }
    nloc = mine > 0u ? mine : 1u; nx = cnt > 0u ? cnt : 1u;
}
__device__ __forceinline__ void xcd_barrier(const XcdBarrier& b) {
    asm volatile("s_waitcnt vmcnt(0)" ::: "memory");
    __syncthreads();
    if (threadIdx.x == 0) {
        unsigned* bar = b.bar;
        __builtin_amdgcn_s_waitcnt(0);
        unsigned nloc = b.st[0], nx = b.st[1];
        if (nloc == 0u) { xcd_barrier_complete(bar, b.x, nloc, nx); b.st[0] = nloc; b.st[1] = nx; }
        const unsigned old = xb_add(&bar[XB_XSUB(b.x)], 1u);
        const unsigned gen = old / nloc;
        if (old + 1u == (gen + 1u) * nloc) {
            __builtin_amdgcn_fence(__ATOMIC_RELEASE, "agent");
            asm volatile("s_waitcnt vmcnt(0)" ::: "memory");
            const unsigned og = xb_add(&bar[XB_TOP], 1u);
            const unsigned tg = og / nx;
            if (og + 1u == (tg + 1u) * nx) xb_add(&bar[XB_TOPGEN], 1u);
            else XB_SPIN(xb_ld(&bar[XB_TOPGEN]) == tg, bar);
            __builtin_amdgcn_fence(__ATOMIC_ACQUIRE, "agent");
            xb_add(&bar[XB_XGEN(b.x)], 1u);
            asm volatile("s_waitcnt vmcnt(0)" ::: "memory");
        } else {
            XB_SPIN(xb_ld(&bar[XB_XGEN(b.x)]) == gen, bar);
            __builtin_amdgcn_fence(__ATOMIC_ACQUIRE, "agent");
            asm volatile("s_waitcnt vmcnt(0)" ::: "memory");
        }
    }
    __syncthreads();
}

namespace pg8 {
constexpr int BM = 256, BK = 64, HALF = 128, HTB = HALF * BK * 2, STAGE_BYTES = 8 * HTB, NXCD = 8, WGM = 8;
__device__ __forceinline__ int lds_byte(int r, int c) { const int st = (r >> 4) * 2 + (c >> 5), rr = r & 15, cc = c & 31, ob = rr * 64 + cc * 2; return st * 1024 + (ob ^ (((ob >> 9) & 1) << 5)); }
__device__ __forceinline__ void stage_rc(int b, int& R, int& C) { const int st = b / 1024, sb = b % 1024, swz = sb ^ (((sb >> 9) & 1) << 5); R = (st >> 1) * 16 + swz / 64; C = (st & 1) * 32 + (swz % 64) / 2; }
__device__ __forceinline__ int perm32(int rho) { const int n = rho >> 4, i = rho & 15; return 8 * (i >> 2) + 4 * n + (i & 3); }

struct Unit { int pm, pn, w; };
struct OrderBase {
    int nM, nN, nwg, G, c;
    __device__ void init(int nM_, int nN_, int G_, int c_) { nM = nM_; nN = nN_; nwg = nM * nN; G = G_; c = c_; }
    __device__ bool nextb(int i, Unit& u) const {
        const long L = (long)i * G + c; if (L >= nwg) return false;
        int wgid = (int)L; { const int q = nwg / NXCD, r = nwg % NXCD, xcd = wgid % NXCD, off = wgid / NXCD; wgid = (xcd < r ? xcd * (q + 1) : r * (q + 1) + (xcd - r) * q) + off; }
        const int nig = WGM * nN, gid = wgid / nig, fm = gid * WGM, gsz = (nM - fm) < WGM ? (nM - fm) : WGM;
        u.pm = fm + ((wgid % nig) % gsz); u.pn = (wgid % nig) / gsz; u.w = 0; return true;
    }
};

template <class Epi, class Sched>
__device__ __forceinline__ void gemm_phase(LAS unsigned char* lds, const int K, const Sched& S, const Epi& E) {
    const int tid = otid(), wid = __builtin_amdgcn_readfirstlane(tid >> 6), lane = tid & 63, wr = wid >> 2, wc = wid & 3, fr = lane & 15, fq = lane >> 4;
    const int nt = K / BK;
    unsigned voffA[2], voffB[2];
#pragma unroll
    for (int i = 0; i < 2; ++i) { int R, C; stage_rc(tid * 16 + i * 8192, R, C); const int Rb = Epi::PERM ? ((R & ~31) + perm32(R & 31)) : R;
        voffA[i] = (unsigned)(R * K + C) * 2u; voffB[i] = (unsigned)(Rb * K + C) * 2u; }
    const size_t kstep = (size_t)(BK * 2);
    const size_t hstep = (size_t)HALF * K * 2;
    const unsigned ldsw = (unsigned)wid * 1024u;
    const int aoff = lds_byte(wr * 64 + fr, fq * 8), boff = lds_byte(wc * 32 + fr, fq * 8);
#define PG8_SA(b, h) (((b) * 2 + (h)) * HTB)
#define PG8_SB(b, h) ((4 + (b) * 2 + (h)) * HTB)
#define PG8_STAGE(bufoff, gbase, voff) do { _Pragma("unroll") for (int _i = 0; _i < 2; ++_i) \
        __builtin_amdgcn_global_load_lds((const unsigned*)((const char*)(gbase) + (voff)[_i]), (LAS unsigned*)(lds + (bufoff) + ldsw + _i * 8192), 16, 0, 0); } while (0)
#define PG8_LDA(dst, b, h) do { _Pragma("unroll") for (int m = 0; m < 4; ++m) _Pragma("unroll") for (int k = 0; k < 2; ++k) dst[m][k] = *(const LAS bf16x8*)(lds + PG8_SA(b, h) + aoff + m * 2048 + k * 1024); } while (0)
#define PG8_LDB(dst, b, h) do { _Pragma("unroll") for (int n = 0; n < 2; ++n) _Pragma("unroll") for (int k = 0; k < 2; ++k) dst[n][k] = *(const LAS bf16x8*)(lds + PG8_SB(b, h) + boff + n * 2048 + k * 1024); } while (0)
#define PG8_MMA(ai, bj, At, Bt) do { __builtin_amdgcn_s_setprio(1); _Pragma("unroll") for (int m = 0; m < 4; ++m) _Pragma("unroll") for (int n = 0; n < 2; ++n) _Pragma("unroll") for (int k = 0; k < 2; ++k) \
        acc[ai][bj][m][n] = __builtin_amdgcn_mfma_f32_16x16x32_bf16(Bt[n][k], At[m][k], acc[ai][bj][m][n], 0, 0, 0); __builtin_amdgcn_s_setprio(0); } while (0)
#define PG8_WAIT_V(n) asm volatile("s_waitcnt vmcnt(" #n ")" ::: "memory")
#define PG8_WAIT_L(n) asm volatile("s_waitcnt lgkmcnt(" #n ")" ::: "memory")
#define PG8_BAR __builtin_amdgcn_s_barrier()
#define PG8_SCHED __builtin_amdgcn_sched_barrier(0)
    Unit cur, nxt; int ui = 0;
    if (!S.next(0, cur)) return;
    f32x4 acc[2][2][4][2];
#pragma unroll
    for (int a = 0; a < 2; ++a)
#pragma unroll
        for (int b = 0; b < 2; ++b)
#pragma unroll
            for (int m = 0; m < 4; ++m)
#pragma unroll
                for (int n = 0; n < 2; ++n) acc[a][b][m][n] = (f32x4){0.f, 0.f, 0.f, 0.f};
    bf16x8 At[4][2], B0[2][2], B1[2][2];
    const char* cA = S.a_ptr(cur); const char* cB = S.b_ptr(cur);
    PG8_STAGE(PG8_SB(0, 0), cB, voffB); PG8_STAGE(PG8_SA(0, 0), cA, voffA); PG8_STAGE(PG8_SB(0, 1), cB + hstep, voffB); PG8_STAGE(PG8_SA(0, 1), cA + hstep, voffA);
    if (wr == 1) PG8_BAR;
    PG8_WAIT_V(4); PG8_BAR;
    PG8_STAGE(PG8_SB(1, 0), cB + kstep, voffB); PG8_STAGE(PG8_SA(1, 0), cA + kstep, voffA); PG8_STAGE(PG8_SB(1, 1), cB + hstep + kstep, voffB);
    PG8_WAIT_V(6); PG8_BAR;
    for (;;) {
        const bool has_next = S.next(ui + 1, nxt);
        const char* nA = has_next ? S.a_ptr(nxt) : cA; const char* nB = has_next ? S.b_ptr(nxt) : cB;
        for (int t = 0; t < nt; t += 2) {
            const bool last = (t == nt - 2);
            const char* a1 = cA + (size_t)(t + 1) * kstep;
            const char* a2 = last ? nA : cA + (size_t)(t + 2) * kstep; const char* b2 = last ? nB : cB + (size_t)(t + 2) * kstep;
            const char* a3 = a2 + kstep; const char* b3 = b2 + kstep;
            PG8_LDB(B0, 0, 0); PG8_SCHED; PG8_LDA(At, 0, 0); PG8_STAGE(PG8_SA(1, 1), a1 + hstep, voffA);
            PG8_WAIT_L(8); PG8_BAR; PG8_WAIT_L(0); PG8_MMA(0, 0, At, B0); PG8_BAR; PG8_SCHED;
            PG8_LDB(B1, 0, 1); PG8_STAGE(PG8_SB(0, 0), b2, voffB);
            PG8_BAR; PG8_WAIT_L(0); PG8_MMA(0, 1, At, B1); PG8_BAR;
            PG8_LDA(At, 0, 1); PG8_STAGE(PG8_SA(0, 0), a2, voffA);
            PG8_BAR; PG8_WAIT_L(0); PG8_MMA(1, 0, At, B0); PG8_BAR; PG8_SCHED;
            PG8_STAGE(PG8_SB(0, 1), b2 + hstep, voffB);
            PG8_WAIT_V(6); PG8_BAR; PG8_MMA(1, 1, At, B1); PG8_BAR;
            PG8_LDB(B0, 1, 0); PG8_SCHED; PG8_LDA(At, 1, 0); PG8_STAGE(PG8_SA(0, 1), a2 + hstep, voffA);
            PG8_WAIT_L(8); PG8_BAR; PG8_WAIT_L(0); PG8_MMA(0, 0, At, B0); PG8_BAR; PG8_SCHED;
            PG8_LDB(B1, 1, 1); PG8_STAGE(PG8_SB(1, 0), b3, voffB);
            PG8_BAR; PG8_WAIT_L(0); PG8_MMA(0, 1, At, B1); PG8_BAR;
            PG8_LDA(At, 1, 1); PG8_STAGE(PG8_SA(1, 0), a3, voffA);
            PG8_BAR; PG8_WAIT_L(0); PG8_MMA(1, 0, At, B0); PG8_BAR; PG8_SCHED;
            PG8_STAGE(PG8_SB(1, 1), b3 + hstep, voffB);
            PG8_WAIT_V(6); PG8_BAR; PG8_MMA(1, 1, At, B1); PG8_BAR;
        }
        E(acc, cur, wr, wc, fr, fq);
        if (!has_next) break;
#pragma unroll
        for (int a = 0; a < 2; ++a)
#pragma unroll
            for (int b = 0; b < 2; ++b)
#pragma unroll
                for (int m = 0; m < 4; ++m)
#pragma unroll
                    for (int n = 0; n < 2; ++n) acc[a][b][m][n] = (f32x4){0.f, 0.f, 0.f, 0.f};
        cur = nxt; cA = nA; cB = nB; ++ui;
    }
    PG8_WAIT_V(0);
    if (wr == 0) PG8_BAR;
    PG8_BAR;
#undef PG8_SA
#undef PG8_SB
#undef PG8_STAGE
#undef PG8_LDA
#undef PG8_LDB
#undef PG8_MMA
#undef PG8_WAIT_V
#undef PG8_WAIT_L
#undef PG8_BAR
#undef PG8_SCHED
}
}
using pg8::Unit;

struct SchedIn {
    pg8::OrderBase ob; int seg; const char* A; const char* B;
    __device__ bool next(int i, Unit& u) const { return ob.nextb(i, u); }
    __device__ const char* a_ptr(const Unit& u) const {
        const int gt = u.pm < LT_PROMPT ? ((u.pm / TPB) * (SEQ / 256) + seg * TPB + (u.pm % TPB)) : (XROWS / 256 + (u.pm - LT_PROMPT));
        return A + (size_t)gt * 256 * D * 2; }
    __device__ const char* b_ptr(const Unit& u) const { return B + (size_t)u.pn * 256 * D * 2; }
};
struct SchedAB {
    pg8::OrderBase ob; int pm0; const char* A0; const char* A1; const char* B0; const char* B1;
    __device__ bool next(int i, Unit& u) const { const bool ok = ob.nextb(i >> 1, u); u.pm += pm0; u.w = i & 1; return ok; }
    __device__ const char* a_ptr(const Unit& u) const { return (u.w ? A1 : A0) + (size_t)u.pm * 256 * D * 2; }
    __device__ const char* b_ptr(const Unit& u) const { return (u.w ? B1 : B0) + (size_t)u.pn * 256 * D * 2; }
};
struct SchedO {
    pg8::OrderBase ob; int pm0; const char* A; const char* B;
    __device__ bool next(int i, Unit& u) const { const bool ok = ob.nextb(i, u); u.pm += pm0; return ok; }
    __device__ const char* a_ptr(const Unit& u) const { return A + (size_t)u.pm * 256 * D * 2; }
    __device__ const char* b_ptr(const Unit& u) const { return B + (size_t)u.pn * 256 * D * 2; }
};

struct EpiIn {
    static constexpr bool PERM = true;
    bf16_t* P; bf16_t* gex; float* out; int seg;
    __device__ __forceinline__ void operator()(const f32x4 (&acc)[2][2][4][2], const Unit& u, int wr, int wc, int fr, int fq) const {
        const int lr0 = u.pm * 256 + wr * 64 + fr;
        const int c0 = u.pn * 256 + wc * 32 + 8 * fq;
#pragma unroll
        for (int ai = 0; ai < 2; ++ai)
#pragma unroll
            for (int m = 0; m < 4; ++m) {
                const int lr = lr0 + ai * 128 + m * 16;
                bf16_t* rowp;
                if (u.pn < NT_PB) rowp = P + (size_t)lr * NPB + c0;
                else if (lr < LEX0) { const int b = lr / SEGTOK; const size_t grow = (size_t)b * SEQ + seg * SEGTOK + (lr % SEGTOK); rowp = (bf16_t*)(out + O_YP + grow * D) + (c0 - NPB); }
                else rowp = gex + (size_t)(lr - LEX0) * 2048 + (c0 - NPB);
#pragma unroll
                for (int bj = 0; bj < 2; ++bj) { const f32x4 v0 = acc[ai][bj][m][0], v1 = acc[ai][bj][m][1];
                    u32x4 w; w.x = cvt_pk_bf16(v0[0], v0[1]); w.y = cvt_pk_bf16(v0[2], v0[3]); w.z = cvt_pk_bf16(v1[0], v1[1]); w.w = cvt_pk_bf16(v1[2], v1[3]);
                    *(u32x4*)(rowp + bj * 128) = w; }
            }
    }
};
struct EpiAB {
    static constexpr bool PERM = false;
    float* tmp; bf16_t* merged; const bf16_t* gex; const float* out;
    __device__ __forceinline__ void operator()(const f32x4 (&acc)[2][2][4][2], const Unit& u, int wr, int wc, int fr, int fq) const {
        const int row0 = u.pm * 256 + wr * 64 + fr, col0 = u.pn * 256 + wc * 32 + 4 * fq;
#pragma unroll
        for (int ai = 0; ai < 2; ++ai)
#pragma unroll
            for (int m = 0; m < 4; ++m) {
                const int grow = row0 + ai * 128 + m * 16;
                const bf16_t* gp = (grow < XROWS) ? ((const bf16_t*)(out + O_YP + (size_t)grow * D) + u.w * D) : (gex + (size_t)(grow - XROWS) * 2048 + u.w * D);
#pragma unroll
                for (int bj = 0; bj < 2; ++bj)
#pragma unroll
                    for (int n = 0; n < 2; ++n) {
                        const int c = col0 + bj * 128 + n * 16;
                        const u32x2 g = *(const u32x2*)(gp + c);
                        f32x4 v = acc[ai][bj][m][n];
                        v[0] *= sigm(__uint_as_float(g.x << 16)); v[1] *= sigm(__uint_as_float(g.x & 0xffff0000u));
                        v[2] *= sigm(__uint_as_float(g.y << 16)); v[3] *= sigm(__uint_as_float(g.y & 0xffff0000u));
                        float* tp = tmp + (size_t)grow * D + c;
                        if (u.w == 0) *(f32x4*)tp = v;
                        else { const f32x4 t = *(const f32x4*)tp; v = v + t; u32x2 o; o.x = cvt_pk_bf16(v[0], v[1]); o.y = cvt_pk_bf16(v[2], v[3]); *(u32x2*)(merged + (size_t)grow * D + c) = o; }
                    }
            }
    }
};
struct EpiO {
    static constexpr bool PERM = false;
    float* out; const float* xp; const float* xs;
    __device__ __forceinline__ void operator()(const f32x4 (&acc)[2][2][4][2], const Unit& u, int wr, int wc, int fr, int fq) const {
        const int row0 = u.pm * 256 + wr * 64 + fr, col0 = u.pn * 256 + wc * 32 + 4 * fq;
#pragma unroll
        for (int ai = 0; ai < 2; ++ai)
#pragma unroll
            for (int m = 0; m < 4; ++m) {
                const int grow = row0 + ai * 128 + m * 16;
                const float* xr; float* yr;
                if (grow < XROWS) { xr = xp + (size_t)grow * D; yr = out + O_YP + (size_t)grow * D; }
                else { const int e = grow - XROWS; if (e < EX_SAMP || e >= EX_SHIFT) continue; xr = xs + (size_t)(e - EX_SAMP) * D; yr = out + O_YS + (size_t)(e - EX_SAMP) * D; }
#pragma unroll
                for (int bj = 0; bj < 2; ++bj)
#pragma unroll
                    for (int n = 0; n < 2; ++n) { const int c = col0 + bj * 128 + n * 16; *(f32x4*)(yr + c) = *(const f32x4*)(xr + c) + acc[ai][bj][m][n]; }
            }
    }
};

__device__ __forceinline__ void p0_row(const Params& p, int r, int lane) {
    bf16_t* hrow = (bf16_t*)(p.ws + WS_H) + (size_t)r * D;
    const float* src = nullptr; bool norm = true; float* sh = nullptr;
    if (r < XROWS) { src = p.in[0] + (size_t)r * D; if ((r & (SEQ - 1)) == SEQ - 1) sh = p.out + O_SHIFT_P + (size_t)(r / SEQ) * D; }
    else { const int e = r - XROWS;
        if (e < EX_SAMP) src = p.in[6] + (size_t)e * D;
        else if (e < EX_SHIFT) { src = p.in[1] + (size_t)(e - EX_SAMP) * D; if (((e - EX_SAMP) & 3) == 3) sh = p.out + O_SHIFT_S + (size_t)((e - EX_SAMP) >> 2) * D; }
        else if (e < EX_END) { src = p.in[5] + (size_t)(e - EX_SHIFT) * D; norm = false; } }
    u32x2* o8 = (u32x2*)hrow + lane;
    if (!src) {
#pragma unroll
        for (int j = 0; j < 4; ++j) o8[64 * j] = (u32x2){0u, 0u};
        return; }
    const f32x4* xr = (const f32x4*)src + lane;
    f32x4 v[4]; float ss = 0.f;
#pragma unroll
    for (int j = 0; j < 4; ++j) { v[j] = xr[64 * j]; ss += v[j][0] * v[j][0] + v[j][1] * v[j][1] + v[j][2] * v[j][2] + v[j][3] * v[j][3]; }
    if (norm) {
        const float rs = __builtin_amdgcn_rsqf(wave_sum(ss) * (1.f / D) + 1e-6f);
        const f32x4* wr = (const f32x4*)p.in[7] + lane;
#pragma unroll
        for (int j = 0; j < 4; ++j) v[j] = v[j] * rs * wr[64 * j];
    }
#pragma unroll
    for (int j = 0; j < 4; ++j) { o8[64 * j] = (u32x2){pk2(v[j][0], v[j][1]), pk2(v[j][2], v[j][3])}; if (sh) ((f32x4*)sh)[lane + 64 * j] = v[j]; }
}
template <int MODE> __device__ __forceinline__ void p0_tr_item(const float* W, int N, bf16_t* WT, float* scr, int kb, int nb, int lane) {
    const int k0 = 64 * kb, n0 = 32 * nb;
    const int nn = n0 + (lane & 31);
    int srcc = nn;
    if (MODE == 1) srcc = nn < C_GATE_REF ? nn : (nn < NPB ? -1 : nn - (NPB - C_GATE_REF));
#pragma unroll 8
    for (int i = 0; i < 32; ++i) { const int kk = 2 * i + (lane >> 5); scr[kk * 33 + (lane & 31)] = srcc >= 0 ? W[(size_t)(k0 + kk) * N + srcc] : 0.f; }
    asm volatile("s_waitcnt lgkmcnt(0)" ::: "memory");
    const int c = lane & 7;
#pragma unroll
    for (int j = 0; j < 4; ++j) { const int n = (lane >> 3) + 8 * j; const float* s = scr + (8 * c) * 33 + n;
        u32x4 o; o.x = pk2(s[0 * 33], s[1 * 33]); o.y = pk2(s[2 * 33], s[3 * 33]); o.z = pk2(s[4 * 33], s[5 * 33]); o.w = pk2(s[6 * 33], s[7 * 33]);
        *(u32x4*)(WT + (size_t)(n0 + n) * D + k0 + 8 * c) = o; }
    asm volatile("s_waitcnt lgkmcnt(0)" ::: "memory");
}
__device__ __forceinline__ void phase0(const Params& p, unsigned char* smem) {
    const int tid0 = otid(), wave = tid0 >> 6, lane = tid0 & 63;
    const int gw = obid() * 8 + wave, NGW = gridDim.x * 8;
    float* scr = (float*)smem + wave * (64 * 33);
    constexpr int I_IN = 16 * (NP / 32), I_SQ = 16 * 32;
    for (int it = gw; it < I_IN + 3 * I_SQ; it += NGW) {
        int r = it;
        if (r < I_IN) { p0_tr_item<1>(p.in[8], 10384, (bf16_t*)(p.ws + WS_WT_IN), scr, r / (NP / 32), r % (NP / 32), lane); continue; } r -= I_IN;
        if (r < I_SQ) { p0_tr_item<0>(p.in[13], D, (bf16_t*)(p.ws + WS_WT_A), scr, r / 32, r % 32, lane); continue; } r -= I_SQ;
        if (r < I_SQ) { p0_tr_item<0>(p.in[24], D, (bf16_t*)(p.ws + WS_WT_B), scr, r / 32, r % 32, lane); continue; } r -= I_SQ;
        p0_tr_item<0>(p.in[25], D, (bf16_t*)(p.ws + WS_WT_O), scr, r / 32, r % 32, lane);
    }
    {
        const f32x4* lw = (const f32x4*)p.in[7] + lane;
        f32x4 wv[4];
#pragma unroll
        for (int j = 0; j < 4; ++j) wv[j] = lw[64 * j];
#pragma unroll 1
        for (int r = gw; r < XROWS; r += 2 * NGW) {
            const int r1 = r + NGW; const bool has1 = r1 < XROWS;
            const f32x4* x0 = (const f32x4*)(p.in[0] + (size_t)r * D) + lane; const f32x4* x1 = (const f32x4*)(p.in[0] + (size_t)(has1 ? r1 : r) * D) + lane;
            f32x4 a[4], b[4]; float s0 = 0.f, s1 = 0.f;
#pragma unroll
            for (int j = 0; j < 4; ++j) { a[j] = x0[64 * j]; b[j] = x1[64 * j]; }
#pragma unroll
            for (int j = 0; j < 4; ++j) { s0 += a[j][0] * a[j][0] + a[j][1] * a[j][1] + a[j][2] * a[j][2] + a[j][3] * a[j][3]; s1 += b[j][0] * b[j][0] + b[j][1] * b[j][1] + b[j][2] * b[j][2] + b[j][3] * b[j][3]; }
            const float q0 = __builtin_amdgcn_rsqf(wave_sum(s0) * (1.f / D) + 1e-6f), q1 = __builtin_amdgcn_rsqf(wave_sum(s1) * (1.f / D) + 1e-6f);
            u32x2* o0 = (u32x2*)((bf16_t*)(p.ws + WS_H) + (size_t)r * D) + lane; u32x2* o1 = (u32x2*)((bf16_t*)(p.ws + WS_H) + (size_t)r1 * D) + lane;
#pragma unroll
            for (int j = 0; j < 4; ++j) { a[j] = a[j] * q0 * wv[j]; o0[64 * j] = (u32x2){pk2(a[j][0], a[j][1]), pk2(a[j][2], a[j][3])}; }
            if ((r & (SEQ - 1)) == SEQ - 1) { f32x4* sh = (f32x4*)(p.out + O_SHIFT_P + (size_t)(r / SEQ) * D) + lane;
#pragma unroll
                for (int j = 0; j < 4; ++j) sh[64 * j] = a[j]; }
            if (has1) {
#pragma unroll
                for (int j = 0; j < 4; ++j) { b[j] = b[j] * q1 * wv[j]; o1[64 * j] = (u32x2){pk2(b[j][0], b[j][1]), pk2(b[j][2], b[j][3])}; }
                if ((r1 & (SEQ - 1)) == SEQ - 1) { f32x4* sh = (f32x4*)(p.out + O_SHIFT_P + (size_t)(r1 / SEQ) * D) + lane;
#pragma unroll
                    for (int j = 0; j < 4; ++j) sh[64 * j] = b[j]; }
            }
        }
    }
    for (int r = XROWS + gw; r < HROWS; r += NGW) p0_row(p, r, lane);
    {
        float* pk = (float*)(p.ws + WS_PK);
        const int gt = obid() * 512 + tid0, NT = gridDim.x * 512;
        for (int i = gt; i < PK_END; i += NT) {
            const float* src; int o;
            if (i < PK_ALOG) { src = p.in[9]; o = i - PK_CONVW; } else if (i < PK_DTB) { src = p.in[10]; o = i - PK_ALOG; } else if (i < PK_NORMW) { src = p.in[11]; o = i - PK_DTB; }
            else if (i < PK_MU) { src = p.in[12]; o = i - PK_NORMW; } else if (i < PK_W0) { src = p.in[14]; o = i - PK_MU; } else if (i < PK_W2) { src = p.in[15]; o = i - PK_W0; }
            else if (i < PK_A0) { src = p.in[16]; o = i - PK_W2; } else if (i < PK_A2) { src = p.in[17]; o = i - PK_A0; } else if (i < PK_KK) { src = p.in[18]; o = i - PK_A2; }
            else if (i < PK_KA) { src = p.in[19]; o = i - PK_KK; } else if (i < PK_RK) { src = p.in[20]; o = i - PK_KA; } else if (i < PK_GNW) { src = p.in[21]; o = i - PK_RK; }
            else if (i < PK_GNB) { src = p.in[22]; o = i - PK_GNW; } else if (i < PK_LNF) { src = p.in[23]; o = i - PK_GNB; } else { src = p.in[26]; o = i - PK_LNF; }
            pk[i] = src[o];
        }
        bf16_t* w2t = (bf16_t*)(p.ws + WS_W2T); bf16_t* a2t = (bf16_t*)(p.ws + WS_A2T);
        for (int i = gt; i < 65536; i += NT) { const int l = i & 63, c = (i >> 6) & 63, hb = i >> 12;
            w2t[i] = (bf16_t)f2bf(p.in[16][(size_t)l * D + hb * 64 + c]); a2t[i] = (bf16_t)f2bf(p.in[18][(size_t)l * D + hb * 64 + c]); }
    }
}

__device__ __forceinline__ void gdn_item(const Params& p, unsigned char* smem, const float* s_in, float* s_out, const float* halo_in, float* halo_out,
                                         int h, int sl, int rowA, int nA, int rowB, int nB) {
    const int tid = otid(), w = tid >> 6, lane = tid & 63, vl = lane >> 4, kg = lane & 15;
    float* qk_s = (float*)smem; float* v_s = qk_s + 16384; float* o_s = v_s + 2048; float* gb_s = o_s + 2048; float* sst = gb_s + 128;
    const bf16_t* P = (const bf16_t*)(p.ws + WS_P);
    float* ORAW = (float*)(p.ws + WS_ORAW);
    float s[8];
    if (s_in) {
        { const int k = tid >> 2, q4 = tid & 3; const f32x4* src = (const f32x4*)(s_in + (size_t)k * 128 + sl * 32 + q4 * 8); const f32x4 a = src[0], b = src[1];
          float* d = sst + k * 33 + q4 * 8; d[0] = a[0]; d[1] = a[1]; d[2] = a[2]; d[3] = a[3]; d[4] = b[0]; d[5] = b[1]; d[6] = b[2]; d[7] = b[3]; }
        __syncthreads();
#pragma unroll
        for (int j = 0; j < 8; ++j) s[j] = sst[(kg * 8 + j) * 33 + 4 * w + vl];
        __syncthreads();
    } else {
#pragma unroll
        for (int j = 0; j < 8; ++j) s[j] = 0.f;
    }
    int pcol = -1;
    if (tid < 128) pcol = h * 128 + tid; else if (tid < 256) pcol = 1024 + h * 128 + (tid - 128); else if (tid < 288) pcol = 2048 + h * 128 + sl * 32 + (tid - 256);
    float cw0 = 0.f, cw1 = 0.f, cw2 = 0.f, cw3 = 0.f, x1 = 0.f, x2 = 0.f, x3 = 0.f;
    const float* pk = (const float*)(p.ws + WS_PK);
    if (pcol >= 0) { const float* cw = pk + PK_CONVW; cw0 = cw[pcol]; cw1 = cw[3072 + pcol]; cw2 = cw[6144 + pcol]; cw3 = cw[9216 + pcol];
        if (halo_in) { x3 = halo_in[pcol]; x2 = halo_in[3072 + pcol]; x1 = halo_in[6144 + pcol]; } }
    const float nalog = -expf(pk[PK_ALOG + h]), dtb = pk[PK_DTB + h];
#pragma unroll 1
    for (int run = 0; run < 2; ++run) {
        const int rrow = run ? rowB : rowA, rn = run ? nB : nA; const bool wout = run != 0;
#pragma unroll 1
        for (int c0 = 0; c0 < rn; c0 += 64) {
            const int nt = (rn - c0) < 64 ? (rn - c0) : 64; const int row = rrow + c0;
            if (pcol >= 0) {
                const bf16_t* src = P + (size_t)row * NPB + pcol;
                float* dst = tid < 256 ? (qk_s + tid) : (v_s + (tid - 256)); const int dstride = tid < 256 ? 256 : 32;
#pragma unroll 8
                for (int i = 0; i < nt; ++i) { const float x0 = bf2f(src[(size_t)i * NPB]); const float y = cw0 * x3 + cw1 * x2 + cw2 * x1 + cw3 * x0; x3 = x2; x2 = x1; x1 = x0; dst[i * dstride] = silu_(y); }
            } else if (tid < 352) {
                const int i = tid - 288;
                if (i < nt) { const float pa = bf2f(P[(size_t)(row + i) * NPB + C_A + h]), pb = bf2f(P[(size_t)(row + i) * NPB + C_B + h]);
                    gb_s[2 * i] = expf(nalog * softplus_(pa + dtb)); gb_s[2 * i + 1] = sigm(pb); }
            }
            __syncthreads();
#pragma unroll 1
            for (int ii = 0; ii < 8; ++ii) { const int i = w * 8 + ii;
                if (i < nt) {
#pragma unroll
                    for (int which = 0; which < 2; ++which) { float* rp = qk_s + i * 256 + which * 128; const float a = rp[lane], b = rp[lane + 64];
                        const float sc = __builtin_amdgcn_rsqf(wave_sum(a * a + b * b) + 1e-6f) * (which == 0 ? 0.08838834764831845f : 1.f); rp[lane] = a * sc; rp[lane + 64] = b * sc; } } }
            __syncthreads();
#pragma unroll 1
            for (int i = 0; i < nt; ++i) {
                const f32x4 q0 = *(const f32x4*)(qk_s + i * 256 + kg * 8), q1 = *(const f32x4*)(qk_s + i * 256 + kg * 8 + 4);
                const f32x4 k0 = *(const f32x4*)(qk_s + i * 256 + 128 + kg * 8), k1 = *(const f32x4*)(qk_s + i * 256 + 128 + kg * 8 + 4);
                const float vv = v_s[i * 32 + 4 * w + vl], a = gb_s[2 * i], be = gb_s[2 * i + 1];
                float part = k0[0] * s[0] + k0[1] * s[1] + k0[2] * s[2] + k0[3] * s[3] + k1[0] * s[4] + k1[1] * s[5] + k1[2] * s[6] + k1[3] * s[7];
                const float kS = rowsum16(part);
                const float c = be * (vv - a * kS);
                s[0] = a * s[0] + k0[0] * c; s[1] = a * s[1] + k0[1] * c; s[2] = a * s[2] + k0[2] * c; s[3] = a * s[3] + k0[3] * c;
                s[4] = a * s[4] + k1[0] * c; s[5] = a * s[5] + k1[1] * c; s[6] = a * s[6] + k1[2] * c; s[7] = a * s[7] + k1[3] * c;
                float op = q0[0] * s[0] + q0[1] * s[1] + q0[2] * s[2] + q0[3] * s[3] + q1[0] * s[4] + q1[1] * s[5] + q1[2] * s[6] + q1[3] * s[7];
                const float o = rowsum16(op);
                if (kg == 0) o_s[i * 32 + 4 * w + vl] = o;
            }
            __syncthreads();
            if (wout) { const int i = tid >> 3, c4 = (tid & 7) * 4; if (i < nt) *(f32x4*)(ORAW + (size_t)(row + i) * D + h * 128 + sl * 32 + c4) = *(const f32x4*)(o_s + i * 32 + c4); }
        }
    }
    if (pcol >= 0 && (sl == 0 || tid >= 256)) { halo_out[pcol] = x3; halo_out[3072 + pcol] = x2; halo_out[6144 + pcol] = x1; }
#pragma unroll
    for (int j = 0; j < 8; ++j) sst[(kg * 8 + j) * 33 + 4 * w + vl] = s[j];
    __syncthreads();
    { const int k = tid >> 2, q4 = tid & 3; const float* d = sst + k * 33 + q4 * 8; f32x4* dst = (f32x4*)(s_out + (size_t)k * 128 + sl * 32 + q4 * 8);
      dst[0] = (f32x4){d[0], d[1], d[2], d[3]}; dst[1] = (f32x4){d[4], d[5], d[6], d[7]}; }
    __syncthreads();
}

constexpr int RW_W2 = 20544, RW_A2 = 24640;
__device__ __forceinline__ void rwkv_load_lora(const Params& p, unsigned char* smem, int hb) {
    float* w2_s = (float*)smem + RW_W2; float* a2_s = (float*)smem + RW_A2; const float* pk = (const float*)(p.ws + WS_PK);
    for (int i = otid(); i < 4096; i += 512) { const int l = i >> 6, c = i & 63; w2_s[i] = pk[PK_W2 + l * D + hb * 64 + c]; a2_s[i] = pk[PK_A2 + l * D + hb * 64 + c]; }
    __syncthreads();
}
__device__ __forceinline__ void rwkv_item(const Params& p, unsigned char* smem, const float* s_in, float* s_out, const bf16_t* prev_row, const float* halo_in, float* halo_out,
                                          int hb, int half, int rowA, int nA, int rowB, int nB) {
    const int tid = otid(), w = tid >> 6, lane = tid & 63, row = tid >> 4, kq = tid & 15;
    float* f = (float*)smem;
    float* r_s = f; float* kb_s = f + 2048; float* v_s = f + 4096; float* wd_s = f + 6144; float* ad_s = f + 8192; float* dec_s = f + 10240; float* a_s = f + 12288;
    float* kk_s = f + 14336; float* km_s = f + 16384; float* zb_s = f + 18432; float* y_s = f + 19456; float* bonus_s = f + 20480;
    const float* w2_s = f + RW_W2; const float* a2_s = f + RW_A2;
    const bf16_t* P = (const bf16_t*)(p.ws + WS_P);
    float* YRAW = (float*)(p.ws + WS_YRAW); bf16_t* C0 = (bf16_t*)(p.ws + WS_C0); bf16_t* C1 = (bf16_t*)(p.ws + WS_C1);
    float s[4];
    if (s_in) { const f32x4 t = *(const f32x4*)(s_in + (size_t)(half * 32 + row) * 64 + kq * 4); s[0] = t[0]; s[1] = t[1]; s[2] = t[2]; s[3] = t[3]; }
    else { s[0] = s[1] = s[2] = s[3] = 0.f; }
    int col = -1; float* dst = nullptr; int dstride = 64; bool is_wd = false, owner = false;
    if (tid < 64) { col = hb * 64 + tid; dst = r_s + tid; owner = half == 0; }
    else if (tid < 128) { col = 1024 + hb * 64 + (tid - 64); dst = kb_s + (tid - 64); owner = half == 0; }
    else if (tid < 192) { col = 2048 + hb * 64 + (tid - 128); dst = v_s + (tid - 128); owner = half == 0; }
    else if (tid < 256) { col = 3072 + (tid - 192); dst = wd_s + (tid - 192); is_wd = true; owner = (half == 0 && hb == 0); }
    else if (tid < 320) { col = 3136 + (tid - 256); dst = ad_s + (tid - 256); owner = (half == 0 && hb == 0); }
    else if (tid < 352) { col = 3200 + hb * 64 + half * 32 + (tid - 320); dst = zb_s + (tid - 320); dstride = 32; owner = true; }
    float mu = 0.f, prev = 0.f;
    const float* pk = (const float*)(p.ws + WS_PK);
    if (col >= 0) { mu = pk[PK_MU + col]; prev = prev_row ? bf2f(prev_row[C_RW + col]) : (halo_in ? halo_in[col] : 0.f); }
    const int cc = tid & 63, ig = tid >> 6;
    const int hc = hb * 64 + cc;
    const float w0c = pk[PK_W0 + hc], a0c = pk[PK_A0 + hc], kkc = pk[PK_KK + hc], kac = pk[PK_KA + hc];
    const float rkl = pk[PK_RK + hb * 64 + lane];
#pragma unroll 1
    for (int run = 0; run < 2; ++run) {
        const int rrow = run ? rowB : rowA, rn = run ? nB : nA; const bool wout = run != 0;
#pragma unroll 1
        for (int c0 = 0; c0 < rn; c0 += 32) {
            const int nt = (rn - c0) < 32 ? (rn - c0) : 32; const int row0 = rrow + c0;
            if (col >= 0) {
                const bf16_t* src = P + (size_t)row0 * NPB + C_RW + col;
#pragma unroll 8
                for (int i = 0; i < nt; ++i) { const float cur = bf2f(src[(size_t)i * NPB]); float m = cur + mu * (prev - cur); prev = cur; if (is_wd) m = tanh_(m); dst[i * dstride] = m; }
            }
            __syncthreads();
            {
                float aw[4] = {0.f, 0.f, 0.f, 0.f}, aa[4] = {0.f, 0.f, 0.f, 0.f};
#pragma unroll 4
                for (int l = 0; l < 64; ++l) { const float w2v = w2_s[l * 64 + cc], a2v = a2_s[l * 64 + cc];
#pragma unroll
                    for (int ii = 0; ii < 4; ++ii) { aw[ii] += wd_s[(ig * 4 + ii) * 64 + l] * w2v; aa[ii] += ad_s[(ig * 4 + ii) * 64 + l] * a2v; } }
#pragma unroll
                for (int ii = 0; ii < 4; ++ii) { const int i = ig * 4 + ii;
                    if (i < nt) { const float wraw = w0c + aw[ii]; const float wlog = -0.6065306597126334f * sigm(wraw); const float a = sigm(a0c + aa[ii]);
                        const float kbv = kb_s[i * 64 + cc];
                        dec_s[i * 64 + cc] = expf(wlog); a_s[i * 64 + cc] = a; kk_s[i * 64 + cc] = kbv * kkc; km_s[i * 64 + cc] = kbv * (1.f + (a - 1.f) * kac); } }
            }
            __syncthreads();
#pragma unroll 1
            for (int ii = 0; ii < 4; ++ii) { const int i = w * 4 + ii;
                if (i < nt) { const float kkr = kk_s[i * 64 + lane]; const float kk = kkr * __builtin_amdgcn_rsqf(wave_sum(kkr * kkr) + 1e-6f); kk_s[i * 64 + lane] = kk;
                    const float a = a_s[i * 64 + lane]; a_s[i * 64 + lane] = kk * a;
                    const float rk = wave_sum(r_s[i * 64 + lane] * km_s[i * 64 + lane] * rkl); if (lane == 0) bonus_s[i] = rk; } }
            __syncthreads();
#pragma unroll 1
            for (int i = 0; i < nt; ++i) {
                const f32x4 kk4 = *(const f32x4*)(kk_s + i * 64 + kq * 4), de4 = *(const f32x4*)(dec_s + i * 64 + kq * 4), ka4 = *(const f32x4*)(a_s + i * 64 + kq * 4),
                            km4 = *(const f32x4*)(km_s + i * 64 + kq * 4), r4 = *(const f32x4*)(r_s + i * 64 + kq * 4);
                const float vv = v_s[i * 64 + half * 32 + row];
                const float sa = rowsum16(s[0] * kk4[0] + s[1] * kk4[1] + s[2] * kk4[2] + s[3] * kk4[3]);
#pragma unroll
                for (int j = 0; j < 4; ++j) s[j] = s[j] * de4[j] + (vv * km4[j] - sa * ka4[j]);
                const float y = rowsum16(s[0] * r4[0] + s[1] * r4[1] + s[2] * r4[2] + s[3] * r4[3]);
                if (kq == 0) y_s[i * 32 + row] = y;
            }
            __syncthreads();
            if (wout) { const int i = tid >> 4;
                if (i < nt) {
#pragma unroll
                    for (int q = 0; q < 2; ++q) { const int rr = (tid & 15) * 2 + q, v = half * 32 + rr, colo = hb * 64 + v;
                        const float sz = silu_(zb_s[i * 32 + rr]);
                        const size_t o = (size_t)(row0 + i) * D + colo;
                        YRAW[o] = y_s[i * 32 + rr]; C1[o] = (bf16_t)f2bf(pk[PK_GNW + colo] * sz); C0[o] = (bf16_t)f2bf((pk[PK_GNB + colo] + bonus_s[i] * v_s[i * 64 + v]) * sz); } } }
            __syncthreads();
        }
    }
    *(f32x4*)(s_out + (size_t)(half * 32 + row) * 64 + kq * 4) = (f32x4){s[0], s[1], s[2], s[3]};
    if (col >= 0 && owner && halo_out) halo_out[col] = prev;
}


__device__ __forceinline__ bf16x8 ldfrag(const bf16_t* base, int stride, int r0, int k0, int lane) {
    return *(const bf16x8*)(base + (r0 + (lane & 15)) * stride + k0 + 8 * (lane >> 4));
}
#define MFMA16(a, b, c) __builtin_amdgcn_mfma_f32_16x16x32_bf16((a), (b), (c), 0, 0, 0)
typedef short s16x4 __attribute__((ext_vector_type(4)));
__device__ __forceinline__ bf16x8 ldfrag_tr(const bf16_t* X, int stride, int c0, int k0, int lane) {
    const int l15 = lane & 15;
    const bf16_t* a = X + (k0 + 8 * (lane >> 4) + (l15 >> 2)) * stride + c0 + 4 * (l15 & 3);
    const s16x4 lo = __builtin_amdgcn_ds_read_tr16_b64_v4i16((LAS s16x4*)a), hi = __builtin_amdgcn_ds_read_tr16_b64_v4i16((LAS s16x4*)(a + 4 * stride));
    return __builtin_shufflevector(lo, hi, 0, 1, 2, 3, 4, 5, 6, 7);
}
__device__ __forceinline__ void inv_block(const float* L, float* Tm, float* XS, int tid) {
    const int w = tid >> 6, lane = tid & 63;
    if (w < 4 && lane < 16) {
        const float* Lb = L + (16 * w) * 64 + 16 * w; float* Tb = Tm + (16 * w) * 64 + 16 * w;
        float tr[16];
#pragma unroll
        for (int i = 0; i < 16; ++i) { float a = (lane == i) ? 1.f : 0.f;
#pragma unroll
            for (int j = 0; j < i; ++j) a -= Lb[i * 64 + j] * tr[j];
            tr[i] = a; Tb[i * 64 + lane] = a; }
    }
    for (int e = tid; e < 1536; e += 512) { const int k = e >> 8, r = (e >> 4) & 15, c = e & 15;
        const int rb = k < 3 ? 0 : (k < 5 ? 1 : 2), cb = k < 3 ? k + 1 : (k < 5 ? k - 1 : 3);
        Tm[(16 * rb + r) * 64 + 16 * cb + c] = 0.f; }
    __syncthreads();
    {
        const int B = tid >> 8, i = (tid >> 4) & 15, c = tid & 15, o = 32 * B;
        float x = 0.f;
#pragma unroll
        for (int j = 0; j < 16; ++j) x += L[(o + 16 + i) * 64 + o + j] * Tm[(o + j) * 64 + o + c];
        XS[tid] = x;
        __syncthreads();
        float t = 0.f;
#pragma unroll
        for (int j = 0; j < 16; ++j) t += Tm[(o + 16 + i) * 64 + o + 16 + j] * XS[(B << 8) + j * 16 + c];
        Tm[(o + 16 + i) * 64 + o + c] = -t;
    }
    __syncthreads();
    {
        const int i = tid >> 4, c2 = (tid & 15) * 2;
        float x0 = 0.f, x1 = 0.f;
#pragma unroll 8
        for (int j = 0; j < 32; ++j) { const float l = L[(32 + i) * 64 + j]; x0 += l * Tm[j * 64 + c2]; x1 += l * Tm[j * 64 + c2 + 1]; }
        XS[i * 32 + c2] = x0; XS[i * 32 + c2 + 1] = x1;
        __syncthreads();
        float t0 = 0.f, t1 = 0.f;
#pragma unroll 8
        for (int j = 0; j < 32; ++j) { const float tv = Tm[(32 + i) * 64 + 32 + j]; t0 += tv * XS[j * 32 + c2]; t1 += tv * XS[j * 32 + c2 + 1]; }
        Tm[(32 + i) * 64 + c2] = -t0; Tm[(32 + i) * 64 + c2 + 1] = -t1;
    }
    __syncthreads();
}
__device__ __forceinline__ void unpack8(const u32x4 rw, float (&x)[8]) {
    x[0] = __uint_as_float(rw.x << 16); x[1] = __uint_as_float(rw.x & 0xffff0000u); x[2] = __uint_as_float(rw.y << 16); x[3] = __uint_as_float(rw.y & 0xffff0000u);
    x[4] = __uint_as_float(rw.z << 16); x[5] = __uint_as_float(rw.z & 0xffff0000u); x[6] = __uint_as_float(rw.w << 16); x[7] = __uint_as_float(rw.w & 0xffff0000u); }
__device__ __forceinline__ u32x4 pack8(const float (&x)[8]) { return (u32x4){pk2(x[0], x[1]), pk2(x[2], x[3]), pk2(x[4], x[5]), pk2(x[6], x[7])}; }

constexpr int PL_QS = 0, PL_R1 = 17408, PL_KT = 35840, PL_KTT = 54272, PL_VT = 72704, PL_R3 = 91136, PL_QKM = 109568, PL_TP = 118784, PL_TPP = 128000, PL_SM = 137216, PL_TM = 139264, PL_XS = 155648;
constexpr int QSTR = 136, TSTR = 72;

__device__ __forceinline__ void gdn_prep_item(const Params& p, unsigned char* smem, int h, int row_start, int npad, const bf16_t* hbase,
                                              bf16_t* halo_out, float* conv_out, unsigned char* rec) {
    const int tid = otid(), w = tid >> 6, lane = tid & 63, q4 = lane >> 4, l15 = lane & 15;
    bf16_t* qs = (bf16_t*)(smem + PL_QS); bf16_t* ks = (bf16_t*)(smem + PL_R1); bf16_t* WT = ks; bf16_t* kts = (bf16_t*)(smem + PL_KT);
    bf16_t* vs = (bf16_t*)(smem + PL_VT);         float* Lm = (float*)(smem + PL_R3); bf16_t* UT = (bf16_t*)(smem + PL_R3); bf16_t* QKm = (bf16_t*)(smem + PL_QKM);
    bf16_t* Tp = (bf16_t*)(smem + PL_TP); bf16_t* Tpp = (bf16_t*)(smem + PL_TPP);
    float* sm = (float*)(smem + PL_SM);
    float* gcs = sm; float* bes = sm + 64; float* ssq = sm + 128; float* ssk = sm + 192; float* egs = sm + 256; float* egl_s = sm + 320; float* beg = sm + 384;
    const bf16_t* P = (const bf16_t*)(p.ws + WS_P);
    const float* pk = (const float*)(p.ws + WS_PK);
    if (npad == 0) {
        const int t = tid >> 3, g = tid & 7;
        const bf16_t* zp = P + (size_t)(row_start + t) * NPB + C_Z + h * 128 + 16 * g;
        const u32x4 z0 = *(const u32x4*)zp, z1 = *(const u32x4*)(zp + 8);
        float za[8], zb[8]; unpack8(z0, za); unpack8(z1, zb);
        const float* nwp = pk + PK_NORMW + 16 * g;
        float ga[8], gb2[8];
#pragma unroll
        for (int e = 0; e < 8; ++e) { ga[e] = nwp[e] * silu_(za[e]); gb2[e] = nwp[8 + e] * silu_(zb[e]); }
        bf16_t* gp = (bf16_t*)(rec + GP_G) + t * 128 + 16 * g;
        *(u32x4*)gp = pack8(ga); *(u32x4*)(gp + 8) = pack8(gb2);
    }
    if (w == 7) {
        const int i = lane;
        float g = 0.f, be = 0.f;
        if (i >= npad) { const size_t r = (size_t)(row_start + i - npad) * NPB; const float pa = bf2f(P[r + C_A + h]), pb = bf2f(P[r + C_B + h]);
            g = -expf(pk[PK_ALOG + h]) * softplus_(pa + pk[PK_DTB + h]); be = sigm(pb); }
        float x = g;
#pragma unroll
        for (int o = 1; o < 64; o <<= 1) { const float y = __shfl_up(x, o); if (lane >= o) x += y; }
        const float gl = __shfl(x, 63);
        gcs[lane] = x; bes[lane] = be; egs[lane] = __expf(x); egl_s[lane] = __expf(gl - x); beg[lane] = be * __expf(x);
        if (lane == 0) *(float*)(rec + GP_EGL) = __expf(gl);
    }
    __syncthreads();
    if (tid < 384) {
        const int sec = tid >> 7, ts = (tid >> 4) & 7, t0 = 8 * ts, d0 = l15 * 8;
        const int pcol = sec * 1024 + h * 128 + d0;
        float cw[4][8];
#pragma unroll
        for (int j = 0; j < 4; ++j) { const f32x4 a = *(const f32x4*)(pk + PK_CONVW + j * 3072 + pcol), b = *(const f32x4*)(pk + PK_CONVW + j * 3072 + pcol + 4);
            cw[j][0] = a[0]; cw[j][1] = a[1]; cw[j][2] = a[2]; cw[j][3] = a[3]; cw[j][4] = b[0]; cw[j][5] = b[1]; cw[j][6] = b[2]; cw[j][7] = b[3]; }
        u32x4 rw[11]; float fv[11];
#pragma unroll
        for (int k = 0; k < 11; ++k) {
            const int ii = t0 - 3 + k;
            const bf16_t* ptr = P + pcol; float f = 0.f;
            if (ii >= npad) { ptr = P + (size_t)(row_start + ii - npad) * NPB + pcol; f = 1.f; }
            else if (ii < 0 && npad == 0 && hbase) { ptr = hbase + (size_t)(ii + 3) * NPB + pcol; f = 1.f; }
            rw[k] = *(const u32x4*)ptr; fv[k] = f;
        }
        if (halo_out && ts == 7) {
#pragma unroll
            for (int dd = 0; dd < 3; ++dd) { *(u32x4*)(halo_out + (size_t)dd * NPB + pcol) = rw[8 + dd];
                if (conv_out) { float x[8]; unpack8(rw[8 + dd], x); *(f32x4*)(conv_out + dd * 3072 + pcol) = (f32x4){x[0], x[1], x[2], x[3]}; *(f32x4*)(conv_out + dd * 3072 + pcol + 4) = (f32x4){x[4], x[5], x[6], x[7]}; } }
        }
        float y[8][8];
#pragma unroll
        for (int t = 0; t < 8; ++t)
#pragma unroll
            for (int e = 0; e < 8; ++e) y[t][e] = 0.f;
#pragma unroll
        for (int k = 0; k < 11; ++k) { float x[8]; unpack8(rw[k], x);
#pragma unroll
            for (int e = 0; e < 8; ++e) x[e] *= fv[k];
#pragma unroll
            for (int dlt = 0; dlt < 4; ++dlt) { const int t = k - dlt;
                if (t >= 0 && t < 8) {
#pragma unroll
                    for (int e = 0; e < 8; ++e) y[t][e] += cw[dlt][e] * x[e]; } }
        }
        const float qsc = sec == 0 ? 0.08838834764831845f : 1.f;
#pragma unroll
        for (int t = 0; t < 8; ++t) {
            const bool tokv = (t0 + t) >= npad;
            float ss = 0.f;
#pragma unroll
            for (int e = 0; e < 8; ++e) { y[t][e] = tokv ? silu_(y[t][e]) : 0.f; ss += y[t][e] * y[t][e]; }
            if (sec < 2) { const float sc = __builtin_amdgcn_rsqf(rowsum16(ss) + 1e-6f) * qsc;
#pragma unroll
                for (int e = 0; e < 8; ++e) y[t][e] *= sc; }
        }
        { bf16_t* dst = sec == 0 ? qs : (sec == 1 ? ks : vs);
#pragma unroll
            for (int t = 0; t < 8; ++t) *(u32x4*)(dst + (t0 + t) * QSTR + d0) = pack8(y[t]); }
        if (sec == 1) {
#pragma unroll
            for (int t = 0; t < 8; ++t) { const float eg = egl_s[t0 + t]; float z[8];
#pragma unroll
                for (int e = 0; e < 8; ++e) z[e] = y[t][e] * eg;
                *(u32x4*)(kts + (t0 + t) * QSTR + d0) = pack8(z); } }
    }
    __syncthreads();
    {
        const int which = w >> 2, it = w & 3;
        const bf16_t* Barr = which ? qs : ks;
        bf16x8 bfr[4];
#pragma unroll
        for (int kk = 0; kk < 4; ++kk) bfr[kk] = ldfrag(Barr, QSTR, 16 * it, 32 * kk, lane);
        const int i = 16 * it + l15; const float gi = gcs[i], bi = bes[i];
#pragma unroll
        for (int jt = 0; jt < 4; ++jt) {
            f32x4 acc = {0.f, 0.f, 0.f, 0.f};
#pragma unroll
            for (int kk = 0; kk < 4; ++kk) acc = MFMA16(ldfrag(ks, QSTR, 16 * jt, 32 * kk, lane), bfr[kk], acc);
            const int j0 = 16 * jt + 4 * q4; const f32x4 gj = *(const f32x4*)(gcs + j0);
            f32x4 o;
#pragma unroll
            for (int r = 0; r < 4; ++r) { const int j = j0 + r; const bool keep = which ? (i >= j) : (i > j); o[r] = keep ? acc[r] * __expf(gi - gj[r]) : 0.f; }
            if (which == 0) *(f32x4*)(Lm + i * 64 + j0) = o * bi;
            else *(u32x2*)(QKm + i * TSTR + j0) = (u32x2){pk2(o[0], o[1]), pk2(o[2], o[3])};
        }
    }
    __syncthreads();
    {
        float* Tm = (float*)(smem + PL_TM);
        inv_block(Lm, Tm, (float*)(smem + PL_XS), tid);
        const int i = tid >> 3, j0 = (tid & 7) * 8;
        float a[8], b2[8];
#pragma unroll
        for (int e = 0; e < 8; ++e) { const float tv = Tm[i * 64 + j0 + e]; a[e] = tv * beg[j0 + e]; b2[e] = tv * bes[j0 + e]; }
        *(u32x4*)(Tp + i * TSTR + j0) = (u32x4){pk2(a[0], a[1]), pk2(a[2], a[3]), pk2(a[4], a[5]), pk2(a[6], a[7])};
        *(u32x4*)(Tpp + i * TSTR + j0) = (u32x4){pk2(b2[0], b2[1]), pk2(b2[2], b2[3]), pk2(b2[4], b2[5]), pk2(b2[6], b2[7])};
    }
    __syncthreads();
    {
        const int it = w & 3, half = w >> 2;
        f32x4 aw[4], au[4];
#pragma unroll
        for (int x = 0; x < 4; ++x) { aw[x] = (f32x4){0.f, 0.f, 0.f, 0.f}; au[x] = (f32x4){0.f, 0.f, 0.f, 0.f}; }
#pragma unroll
        for (int kk = 0; kk < 2; ++kk) {
            const bf16x8 a1 = ldfrag(Tp, TSTR, 16 * it, 32 * kk, lane), a2 = ldfrag(Tpp, TSTR, 16 * it, 32 * kk, lane);
#pragma unroll
            for (int x = 0; x < 4; ++x) { const int dt = half * 4 + x;
                aw[x] = MFMA16(a1, ldfrag_tr(ks, QSTR, 16 * dt, 32 * kk, lane), aw[x]);
                au[x] = MFMA16(a2, ldfrag_tr(vs, QSTR, 16 * dt, 32 * kk, lane), au[x]); }
        }
        __syncthreads();
#pragma unroll
        for (int x = 0; x < 4; ++x) { const int d = 16 * (half * 4 + x) + l15, i0 = 16 * it + 4 * q4;
            *(u32x2*)(WT + d * TSTR + i0) = (u32x2){pk2(aw[x][0], aw[x][1]), pk2(aw[x][2], aw[x][3])};
            *(u32x2*)(UT + d * TSTR + i0) = (u32x2){pk2(au[x][0], au[x][1]), pk2(au[x][2], au[x][3])}; }
    }
    __syncthreads();
    {
        bf16_t* gAP = (bf16_t*)(rec + GP_AP); bf16_t* gQH = (bf16_t*)(rec + GP_QH); bf16_t* gKH = (bf16_t*)(rec + GP_KH); bf16_t* gOH = (bf16_t*)(rec + GP_OH);
        {
            const int et = w;
            const bf16x8 a0 = ldfrag(WT, TSTR, 16 * et, 0, lane), a1 = ldfrag(WT, TSTR, 16 * et, 32, lane);
#pragma unroll
            for (int dt = 0; dt < 8; ++dt) { f32x4 acc = {0.f, 0.f, 0.f, 0.f};
                acc = MFMA16(a0, ldfrag_tr(kts, QSTR, 16 * dt, 0, lane), acc); acc = MFMA16(a1, ldfrag_tr(kts, QSTR, 16 * dt, 32, lane), acc);
                *(u32x2*)(gAP + ((size_t)(dt * 4 + (et >> 1)) * 64 + lane) * 8 + (et & 1) * 4) = (u32x2){pk2(-acc[0], -acc[1]), pk2(-acc[2], -acc[3])}; }
#pragma unroll
            for (int tt = 0; tt < 4; ++tt) { f32x4 acc = {0.f, 0.f, 0.f, 0.f};
                acc = MFMA16(a0, ldfrag(QKm, TSTR, 16 * tt, 0, lane), acc); acc = MFMA16(a1, ldfrag(QKm, TSTR, 16 * tt, 32, lane), acc);
                const int t = 16 * tt + l15, e0 = 16 * et + 4 * q4; const float eg = egs[t];
                const u32x2 qq = *(const u32x2*)(qs + t * QSTR + e0);
                const float o0 = __uint_as_float(qq.x << 16) * eg - acc[0], o1 = __uint_as_float(qq.x & 0xffff0000u) * eg - acc[1],
                            o2 = __uint_as_float(qq.y << 16) * eg - acc[2], o3 = __uint_as_float(qq.y & 0xffff0000u) * eg - acc[3];
                *(u32x2*)(gQH + ((size_t)(tt * 4 + (et >> 1)) * 64 + lane) * 8 + (et & 1) * 4) = (u32x2){pk2(o0, o1), pk2(o2, o3)}; }
        }
        {
            const int dt = w;
            const bf16x8 a0 = ldfrag_tr(kts, QSTR, 16 * dt, 0, lane), a1 = ldfrag_tr(kts, QSTR, 16 * dt, 32, lane);
#pragma unroll
            for (int vt = 0; vt < 8; ++vt) { f32x4 acc = {0.f, 0.f, 0.f, 0.f};
                acc = MFMA16(a0, ldfrag(UT, TSTR, 16 * vt, 0, lane), acc); acc = MFMA16(a1, ldfrag(UT, TSTR, 16 * vt, 32, lane), acc);
                *(u32x2*)(gKH + ((size_t)(vt * 8 + dt) * 64 + lane) * 4) = (u32x2){pk2(acc[0], acc[1]), pk2(acc[2], acc[3])}; }
            const int tt = w & 3, vh = w >> 2;
            const bf16x8 b0 = ldfrag(QKm, TSTR, 16 * tt, 0, lane), b1 = ldfrag(QKm, TSTR, 16 * tt, 32, lane);
#pragma unroll
            for (int x = 0; x < 4; ++x) { const int vt = vh * 4 + x; f32x4 acc = {0.f, 0.f, 0.f, 0.f};
                acc = MFMA16(b0, ldfrag(UT, TSTR, 16 * vt, 0, lane), acc); acc = MFMA16(b1, ldfrag(UT, TSTR, 16 * vt, 32, lane), acc);
                *(u32x2*)(gOH + ((size_t)(vt * 4 + tt) * 64 + lane) * 4) = (u32x2){pk2(acc[0], acc[1]), pk2(acc[2], acc[3])}; }
        }
    }
    __syncthreads();
}

__device__ __forceinline__ void phase_gprep(const Params& p, int seg, unsigned char* smem) {
    const int blk = obid();
    const int n_items = (CPS + (seg == 0 ? 1 : 0)) * 64;
#pragma unroll 1
    for (int it = blk; it < n_items; it += gridDim.x) {
        const int bh = it & 63, b = bh >> 3, h = bh & 7; int cl = it >> 6; if (seg != 0) cl += 1;
        unsigned char* rec = p.ws + WS_GP + (size_t)(cl * 64 + bh) * GP_STRIDE;
        const bf16_t* Pb = (const bf16_t*)(p.ws + WS_P);
        bf16_t* chalo2 = (bf16_t*)(p.ws + WS_CHALO);
        if (cl == 0) gdn_prep_item(p, smem, h, LEX0, 48, nullptr, nullptr, nullptr, rec);
        else {
            const int row = b * SEGTOK + (cl - 1) * 64;
            const bf16_t* hbase = Pb + (size_t)(row - 3) * NPB;
            if (cl == 1) hbase = (seg == 0) ? Pb + (size_t)(LEX0 + NMETA - 3) * NPB : chalo2 + (size_t)(((seg - 1) & 1) * NBATCH + b) * 3 * NPB;
            bf16_t* ho = (cl == CPS) ? chalo2 + (size_t)((seg & 1) * NBATCH + b) * 3 * NPB : nullptr;
            float* co = (cl == CPS && seg == NSEG - 1) ? p.out + O_CONV_P + (size_t)b * 9216 : nullptr;
            gdn_prep_item(p, smem, h, row, 0, hbase, ho, co, rec);
        }
    }
}

__device__ __forceinline__ void gdn_scan_block(const Params& p, int seg, unsigned char* smem, int bh) {
    const int tid = otid(), w = tid >> 6, lane = tid & 63, q4 = lane >> 4, l15 = lane & 15;
    const int b = bh >> 3, h = bh & 7;
    float* st = p.out + O_GDN_P + (size_t)bh * 16384;
    f32x4 S[8];
    if (seg) {
#pragma unroll
        for (int mt = 0; mt < 8; ++mt)
#pragma unroll
            for (int r = 0; r < 4; ++r) S[mt][r] = st[(size_t)(16 * mt + 4 * q4 + r) * 128 + 16 * w + l15];
    } else {
#pragma unroll
        for (int mt = 0; mt < 8; ++mt) S[mt] = (f32x4){0.f, 0.f, 0.f, 0.f};
    }
    const int c_lo = seg ? 1 : 0;
    float* obuf = (float*)(smem + 98304);
    {
        const u32x4* src = (const u32x4*)(p.ws + WS_GP + (size_t)(c_lo * 64 + bh) * GP_STRIDE); u32x4* dst = (u32x4*)smem;
#pragma unroll
        for (int x = 0; x < 6; ++x) dst[tid + 512 * x] = src[tid + 512 * x];
    }
#pragma unroll 1
    for (int cl = c_lo; cl <= CPS; ++cl) {
        const unsigned char* rec = p.ws + WS_GP + (size_t)(cl * 64 + bh) * GP_STRIDE;
        const int cur = (cl - c_lo) & 1;
        __syncthreads();
        u32x4 nx[6];
        const bool more = cl < CPS;
        if (more) { const u32x4* src = (const u32x4*)(rec + GP_STRIDE * 64);
#pragma unroll
            for (int x = 0; x < 6; ++x) nx[x] = src[tid + 512 * x]; }
        const bf16_t* gKH = (const bf16_t*)(rec + GP_KH); const bf16_t* gOH = (const bf16_t*)(rec + GP_OH);
        u32x2 kh[8], oh[4];
#pragma unroll
        for (int mt = 0; mt < 8; ++mt) kh[mt] = *(const u32x2*)(gKH + ((size_t)(w * 8 + mt) * 64 + lane) * 4);
#pragma unroll
        for (int tt = 0; tt < 4; ++tt) oh[tt] = *(const u32x2*)(gOH + ((size_t)(w * 4 + tt) * 64 + lane) * 4);
        const float egl = *(const float*)(rec + GP_EGL);
        const int et = tid >> 3, eg = tid & 7;
        const bf16_t* gp = (const bf16_t*)(rec + GP_G) + et * 128 + 16 * eg;
        u32x4 z0 = {0u, 0u, 0u, 0u}, z1 = {0u, 0u, 0u, 0u};
        if (cl > 0) { z0 = *(const u32x4*)gp; z1 = *(const u32x4*)(gp + 8); }
        bf16x8 Bf[4];
#pragma unroll
        for (int ks = 0; ks < 4; ++ks) { u32x4 t; t.x = pk2(S[2 * ks][0], S[2 * ks][1]); t.y = pk2(S[2 * ks][2], S[2 * ks][3]); t.z = pk2(S[2 * ks + 1][0], S[2 * ks + 1][1]); t.w = pk2(S[2 * ks + 1][2], S[2 * ks + 1][3]);
            Bf[ks] = __builtin_bit_cast(bf16x8, t); }
        const bf16x8* AP = (const bf16x8*)(smem + cur * 49152); const bf16x8* QH = (const bf16x8*)(smem + cur * 49152 + GP_QH);
        f32x4 o[4], tS[8];
#pragma unroll
        for (int tt = 0; tt < 4; ++tt) { o[tt] = (f32x4){0.f, 0.f, 0.f, 0.f};
#pragma unroll
            for (int ks = 0; ks < 4; ++ks) o[tt] = MFMA16(QH[(tt * 4 + ks) * 64 + lane], Bf[ks], o[tt]); }
#pragma unroll
        for (int mt = 0; mt < 8; ++mt) { tS[mt] = (f32x4){0.f, 0.f, 0.f, 0.f};
#pragma unroll
            for (int ks = 0; ks < 4; ++ks) tS[mt] = MFMA16(AP[(mt * 4 + ks) * 64 + lane], Bf[ks], tS[mt]); }
#pragma unroll
        for (int mt = 0; mt < 8; ++mt) {
            S[mt][0] = egl * S[mt][0] + tS[mt][0] + __uint_as_float(kh[mt].x << 16); S[mt][1] = egl * S[mt][1] + tS[mt][1] + __uint_as_float(kh[mt].x & 0xffff0000u);
            S[mt][2] = egl * S[mt][2] + tS[mt][2] + __uint_as_float(kh[mt].y << 16); S[mt][3] = egl * S[mt][3] + tS[mt][3] + __uint_as_float(kh[mt].y & 0xffff0000u); }
        if (cl > 0) {
#pragma unroll
            for (int tt = 0; tt < 4; ++tt) {
                o[tt][0] += __uint_as_float(oh[tt].x << 16); o[tt][1] += __uint_as_float(oh[tt].x & 0xffff0000u); o[tt][2] += __uint_as_float(oh[tt].y << 16); o[tt][3] += __uint_as_float(oh[tt].y & 0xffff0000u);
#pragma unroll
                for (int r = 0; r < 4; ++r) obuf[(16 * tt + 4 * q4 + r) * 132 + 16 * w + l15] = o[tt][r]; }
        }
        if (more) { u32x4* dst = (u32x4*)(smem + (cur ^ 1) * 49152);
#pragma unroll
            for (int x = 0; x < 6; ++x) dst[tid + 512 * x] = nx[x]; }
        if (cl > 0) {
            __syncthreads();
            f32x4 ov[4]; float ss = 0.f;
#pragma unroll
            for (int j = 0; j < 4; ++j) { ov[j] = *(const f32x4*)(obuf + et * 132 + 16 * eg + 4 * j); ss += ov[j][0] * ov[j][0] + ov[j][1] * ov[j][1] + ov[j][2] * ov[j][2] + ov[j][3] * ov[j][3]; }
            ss += __shfl_xor(ss, 1); ss += __shfl_xor(ss, 2); ss += __shfl_xor(ss, 4);
            const float rs = __builtin_amdgcn_rsqf(ss * (1.f / 128.f) + 1e-6f);
            const unsigned zz[8] = {z0.x, z0.y, z0.z, z0.w, z1.x, z1.y, z1.z, z1.w};
            unsigned ow[8];
#pragma unroll
            for (int j = 0; j < 8; ++j) ow[j] = pk2(ov[j >> 1][(j & 1) * 2] * rs * __uint_as_float(zz[j] << 16), ov[j >> 1][(j & 1) * 2 + 1] * rs * __uint_as_float(zz[j] & 0xffff0000u));
            const size_t grow = (size_t)b * SEQ + seg * SEGTOK + (cl - 1) * 64 + et;
            bf16_t* oa = (bf16_t*)(p.ws + WS_H) + grow * D + h * 128 + 16 * eg;
            *(u32x4*)oa = (u32x4){ow[0], ow[1], ow[2], ow[3]}; *(u32x4*)(oa + 8) = (u32x4){ow[4], ow[5], ow[6], ow[7]};
        }
    }
#pragma unroll
    for (int mt = 0; mt < 8; ++mt)
#pragma unroll
        for (int r = 0; r < 4; ++r) st[(size_t)(16 * mt + 4 * q4 + r) * 128 + 16 * w + l15] = S[mt][r];
    __syncthreads();
}

constexpr int RL_AT = 0, RL_BT = 9216, RL_KT = 18432, RL_ATT = 27648, RL_RT = 36864, RL_BTLT = 46080, RL_KTLT = 55296, RL_VT = 64512, RL_LAK = 73728, RL_MRB = 82944, RL_MRK = 92160,
              RL_LM = 101376, RL_AF = 117760, RL_TM = 134144, RL_XS = 150528;
__device__ __forceinline__ void rwkv_prep_item(const Params& p, unsigned char* smem, int hb, int row_start, int npad, const bf16_t* prev_row,
                                               bf16_t* halo_out, unsigned char* rec) {
    const int tid = otid(), w = tid >> 6, lane = tid & 63, q4 = lane >> 4, l15 = lane & 15;
    bf16_t* At = (bf16_t*)(smem + RL_AT); bf16_t* Tb = At; bf16_t* Bt = (bf16_t*)(smem + RL_BT); bf16_t* WaT = Bt; bf16_t* Kt = (bf16_t*)(smem + RL_KT); bf16_t* XT = Kt;
    bf16_t* At2 = (bf16_t*)(smem + RL_ATT); bf16_t* Rt = (bf16_t*)(smem + RL_RT); bf16_t* Btl = (bf16_t*)(smem + RL_BTLT); bf16_t* Ktl = (bf16_t*)(smem + RL_KTLT);
    bf16_t* Vr = (bf16_t*)(smem + RL_VT);        bf16_t* Lak = (bf16_t*)(smem + RL_LAK); bf16_t* Mrb = (bf16_t*)(smem + RL_MRB); bf16_t* Mrk = (bf16_t*)(smem + RL_MRK);
    float* Lm = (float*)(smem + RL_LM);
    bf16_t* thw = Lak; bf16_t* adb = Mrb; float* lc = Lm; float* af = (float*)(smem + RL_AF);
    const bf16_t* P = (const bf16_t*)(p.ws + WS_P);
    const float* pk = (const float*)(p.ws + WS_PK);
    const int t = tid >> 3, g = tid & 7;
    float rr[8], kb[8], vv[8], zb[8];
    {
        const bool real = t >= npad;
        const bf16_t* curp = P; const bf16_t* prevp = P; float fprev = 0.f;
        if (real) { curp = P + (size_t)(row_start + t - npad) * NPB; if (t > npad) { prevp = curp - NPB; fprev = 1.f; } else if (prev_row) { prevp = prev_row; fprev = 1.f; } }
        const int secbase[6] = {0, 1024, 2048, 3200, 3072, 3136};
        u32x4 rc[6], rp[6];
#pragma unroll
        for (int sidx = 0; sidx < 6; ++sidx) { const int col = secbase[sidx] + (sidx < 4 ? hb * 64 : 0) + g * 8; rc[sidx] = *(const u32x4*)(curp + C_RW + col); rp[sidx] = *(const u32x4*)(prevp + C_RW + col); }
        float m[6][8];
#pragma unroll
        for (int sidx = 0; sidx < 6; ++sidx) {
            const int col = secbase[sidx] + (sidx < 4 ? hb * 64 : 0) + g * 8;
            float cur[8], prv[8];
            unpack8(rc[sidx], cur); unpack8(rp[sidx], prv);
            const f32x4 mu0 = *(const f32x4*)(pk + PK_MU + col), mu1 = *(const f32x4*)(pk + PK_MU + col + 4);
            const float mu[8] = {mu0[0], mu0[1], mu0[2], mu0[3], mu1[0], mu1[1], mu1[2], mu1[3]};
#pragma unroll
            for (int e = 0; e < 8; ++e) m[sidx][e] = real ? cur[e] + mu[e] * (fprev * prv[e] - cur[e]) : 0.f;
            if (halo_out && t == 63 && (sidx < 4 || hb == 0)) *(u32x4*)(halo_out + C_RW + col) = rc[sidx];
        }
#pragma unroll
        for (int e = 0; e < 8; ++e) { rr[e] = m[0][e]; kb[e] = m[1][e]; vv[e] = m[2][e]; zb[e] = m[3][e]; }
        float th[8];
#pragma unroll
        for (int e = 0; e < 8; ++e) th[e] = tanh_(m[4][e]);
        *(u32x4*)(thw + t * TSTR + g * 8) = pack8(th);
        *(u32x4*)(adb + t * TSTR + g * 8) = pack8(m[5]);
    }
    __syncthreads();
    {
        const int which = w >> 2, ct = w & 3;
        const bf16_t* Wt = (const bf16_t*)(p.ws + (which ? WS_A2T : WS_W2T)) + (size_t)hb * 4096;
        const bf16x8 b0 = *(const bf16x8*)(Wt + (16 * ct + l15) * 64 + 8 * q4), b1 = *(const bf16x8*)(Wt + (16 * ct + l15) * 64 + 32 + 8 * q4);
        const bf16_t* Aarr = which ? adb : thw;
        const int c = 16 * ct + l15;
        const float bias = pk[(which ? PK_A0 : PK_W0) + hb * 64 + c];
        float carry = 0.f;
#pragma unroll
        for (int tt = 0; tt < 4; ++tt) {
            f32x4 acc = {0.f, 0.f, 0.f, 0.f};
            acc = MFMA16(ldfrag(Aarr, TSTR, 16 * tt, 0, lane), b0, acc); acc = MFMA16(ldfrag(Aarr, TSTR, 16 * tt, 32, lane), b1, acc);
            if (which) {
#pragma unroll
                for (int r = 0; r < 4; ++r) af[(16 * tt + 4 * q4 + r) * 64 + c] = sigm(bias + acc[r]);
            } else {
                float wl[4];
#pragma unroll
                for (int r = 0; r < 4; ++r) { const int tk = 16 * tt + 4 * q4 + r; wl[r] = (tk < npad) ? 0.f : -0.6065306597126334f * sigm(bias + acc[r]); }
                wl[1] += wl[0]; wl[2] += wl[1]; wl[3] += wl[2];
                const float Q = wl[3];
                const float Q0 = __shfl(Q, l15), Q1 = __shfl(Q, l15 + 16), Q2 = __shfl(Q, l15 + 32), Q3 = __shfl(Q, l15 + 48);
                const float ex = carry + (q4 > 0 ? Q0 : 0.f) + (q4 > 1 ? Q1 : 0.f) + (q4 > 2 ? Q2 : 0.f);
#pragma unroll
                for (int r = 0; r < 4; ++r) lc[(16 * tt + 4 * q4 + r) * 64 + c] = ex + wl[r];
                carry += Q0 + Q1 + Q2 + Q3;
            }
        }
    }
    __syncthreads();
    {
        float lct[8], lcp[8], lcC[8], av[8];
        { const f32x4 a = *(const f32x4*)(lc + t * 64 + g * 8), b2 = *(const f32x4*)(lc + t * 64 + g * 8 + 4); lct[0] = a[0]; lct[1] = a[1]; lct[2] = a[2]; lct[3] = a[3]; lct[4] = b2[0]; lct[5] = b2[1]; lct[6] = b2[2]; lct[7] = b2[3]; }
        if (t > 0) { const f32x4 a = *(const f32x4*)(lc + (t - 1) * 64 + g * 8), b2 = *(const f32x4*)(lc + (t - 1) * 64 + g * 8 + 4); lcp[0] = a[0]; lcp[1] = a[1]; lcp[2] = a[2]; lcp[3] = a[3]; lcp[4] = b2[0]; lcp[5] = b2[1]; lcp[6] = b2[2]; lcp[7] = b2[3]; }
        else {
#pragma unroll
            for (int e = 0; e < 8; ++e) lcp[e] = 0.f; }
        { const f32x4 a = *(const f32x4*)(lc + 63 * 64 + g * 8), b2 = *(const f32x4*)(lc + 63 * 64 + g * 8 + 4); lcC[0] = a[0]; lcC[1] = a[1]; lcC[2] = a[2]; lcC[3] = a[3]; lcC[4] = b2[0]; lcC[5] = b2[1]; lcC[6] = b2[2]; lcC[7] = b2[3]; }
        { const f32x4 a = *(const f32x4*)(af + t * 64 + g * 8), b2 = *(const f32x4*)(af + t * 64 + g * 8 + 4); av[0] = a[0]; av[1] = a[1]; av[2] = a[2]; av[3] = a[3]; av[4] = b2[0]; av[5] = b2[1]; av[6] = b2[2]; av[7] = b2[3]; }
        const int hc = hb * 64 + g * 8;
        float kk[8], km[8], ss = 0.f, rk = 0.f;
#pragma unroll
        for (int e = 0; e < 8; ++e) { kk[e] = kb[e] * pk[PK_KK + hc + e]; ss += kk[e] * kk[e]; km[e] = kb[e] * (1.f + (av[e] - 1.f) * pk[PK_KA + hc + e]); rk += rr[e] * km[e] * pk[PK_RK + hc + e]; }
        ss += __shfl_xor(ss, 1); ss += __shfl_xor(ss, 2); ss += __shfl_xor(ss, 4);
        rk += __shfl_xor(rk, 1); rk += __shfl_xor(rk, 2); rk += __shfl_xor(rk, 4);
        const float kn = __builtin_amdgcn_rsqf(ss + 1e-6f);
        float xa[8], xb[8], xk[8], xr[8], xbt[8], xkt[8];
#pragma unroll
        for (int e = 0; e < 8; ++e) { kk[e] *= kn; const float ka = kk[e] * av[e]; const float ip = __expf(-lct[e]), tl = __expf(lcC[e] - lct[e]);
            xa[e] = kk[e] * __expf(lcp[e]); xb[e] = ka * ip; xk[e] = km[e] * ip; xr[e] = rr[e] * __expf(lct[e]); xbt[e] = ka * tl; xkt[e] = km[e] * tl; }
        *(u32x4*)(At + t * TSTR + g * 8) = pack8(xa); *(u32x4*)(Bt + t * TSTR + g * 8) = pack8(xb); *(u32x4*)(Kt + t * TSTR + g * 8) = pack8(xk); *(u32x4*)(Rt + t * TSTR + g * 8) = pack8(xr);
        *(u32x4*)(At2 + t * TSTR + g * 8) = pack8(xa); *(u32x4*)(Btl + t * TSTR + g * 8) = pack8(xbt); *(u32x4*)(Ktl + t * TSTR + g * 8) = pack8(xkt); *(u32x4*)(Vr + t * TSTR + g * 8) = pack8(vv);
        float c1[8], c0[8];
#pragma unroll
        for (int e = 0; e < 8; ++e) { const float sz = silu_(zb[e]); c1[e] = pk[PK_GNW + hc + e] * sz; c0[e] = (pk[PK_GNB + hc + e] + rk * vv[e]) * sz; }
        *(u32x4*)((bf16_t*)(rec + RP_C1) + t * 64 + g * 8) = pack8(c1); *(u32x4*)((bf16_t*)(rec + RP_C0) + t * 64 + g * 8) = pack8(c0);
        if (t == 63) { float* pc = (float*)(rec + RP_PC) + g * 8; *(f32x4*)pc = (f32x4){__expf(lcC[0]), __expf(lcC[1]), __expf(lcC[2]), __expf(lcC[3])}; *(f32x4*)(pc + 4) = (f32x4){__expf(lcC[4]), __expf(lcC[5]), __expf(lcC[6]), __expf(lcC[7])}; }
    }
    __syncthreads();
    {
        const int pr = w >> 1;
        const bf16_t* Aarr = pr < 2 ? At : Rt; const bf16_t* Barr = (pr & 1) ? Kt : Bt;
#pragma unroll
        for (int x = 0; x < 2; ++x) { const int tt = 2 * (w & 1) + x;
            const bf16x8 a0 = ldfrag(Aarr, TSTR, 16 * tt, 0, lane), a1 = ldfrag(Aarr, TSTR, 16 * tt, 32, lane);
            const int tk = 16 * tt + l15;
#pragma unroll
            for (int it = 0; it < 4; ++it) { f32x4 acc = {0.f, 0.f, 0.f, 0.f};
                acc = MFMA16(ldfrag(Barr, TSTR, 16 * it, 0, lane), a0, acc); acc = MFMA16(ldfrag(Barr, TSTR, 16 * it, 32, lane), a1, acc);
                const int i0 = 16 * it + 4 * q4;
                f32x4 o;
#pragma unroll
                for (int r = 0; r < 4; ++r) { const int i = i0 + r; const bool keep = pr < 2 ? (tk > i) : (tk >= i); o[r] = keep ? acc[r] : 0.f; }
                if (pr == 0) *(f32x4*)(Lm + tk * 64 + i0) = o;
                else { bf16_t* Out = pr == 1 ? Lak : (pr == 2 ? Mrb : Mrk); *(u32x2*)(Out + tk * TSTR + i0) = (u32x2){pk2(o[0], o[1]), pk2(o[2], o[3])}; } }
        }
    }
    __syncthreads();
    {
        float* Tm = (float*)(smem + RL_TM);
        inv_block(Lm, Tm, (float*)(smem + RL_XS), tid);
        const int i = tid >> 3, j0 = (tid & 7) * 8;
        float a[8];
#pragma unroll
        for (int e = 0; e < 8; ++e) a[e] = Tm[i * 64 + j0 + e];
        *(u32x4*)(Tb + i * TSTR + j0) = pack8(a);
    }
    __syncthreads();
    {
        const int tt = w & 3, which = w >> 2;
        const bf16_t* Aarr = which ? Lak : Tb; const bf16_t* Barr = which ? Vr : At2; bf16_t* Out = which ? XT : WaT;
        const bf16x8 a0 = ldfrag(Aarr, TSTR, 16 * tt, 0, lane), a1 = ldfrag(Aarr, TSTR, 16 * tt, 32, lane);
#pragma unroll
        for (int ct = 0; ct < 4; ++ct) { f32x4 acc = {0.f, 0.f, 0.f, 0.f};
            acc = MFMA16(a0, ldfrag_tr(Barr, TSTR, 16 * ct, 0, lane), acc); acc = MFMA16(a1, ldfrag_tr(Barr, TSTR, 16 * ct, 32, lane), acc);
            *(u32x2*)(Out + (16 * ct + l15) * TSTR + 16 * tt + 4 * q4) = (u32x2){pk2(acc[0], acc[1]), pk2(acc[2], acc[3])}; }
    }
    __syncthreads();
    {
        f32x4 acc[4];
        if (w < 4) {
            const bf16x8 a0 = ldfrag(Tb, TSTR, 16 * w, 0, lane), a1 = ldfrag(Tb, TSTR, 16 * w, 32, lane);
#pragma unroll
            for (int ct = 0; ct < 4; ++ct) { acc[ct] = (f32x4){0.f, 0.f, 0.f, 0.f};
                acc[ct] = MFMA16(a0, ldfrag(XT, TSTR, 16 * ct, 0, lane), acc[ct]); acc[ct] = MFMA16(a1, ldfrag(XT, TSTR, 16 * ct, 32, lane), acc[ct]); }
        }
        __syncthreads();
        if (w < 4) {
#pragma unroll
            for (int ct = 0; ct < 4; ++ct) *(u32x2*)(XT + (16 * ct + l15) * TSTR + 16 * w + 4 * q4) = (u32x2){pk2(-acc[ct][0], -acc[ct][1]), pk2(-acc[ct][2], -acc[ct][3])};
        }
    }
    __syncthreads();
    {
        const bf16_t* UvT = XT;
        bf16_t* gAP = (bf16_t*)(rec + RP_AP); bf16_t* gRH = (bf16_t*)(rec + RP_RH); bf16_t* gKH = (bf16_t*)(rec + RP_KH); bf16_t* gYH = (bf16_t*)(rec + RP_YH);
        const int et = w & 3, part = w >> 2;
        {
            const bf16x8 a0 = ldfrag(WaT, TSTR, 16 * et, 0, lane), a1 = ldfrag(WaT, TSTR, 16 * et, 32, lane);
            if (part == 0) {
#pragma unroll
                for (int kt = 0; kt < 4; ++kt) { f32x4 acc = {0.f, 0.f, 0.f, 0.f};
                    acc = MFMA16(a0, ldfrag_tr(Btl, TSTR, 16 * kt, 0, lane), acc); acc = MFMA16(a1, ldfrag_tr(Btl, TSTR, 16 * kt, 32, lane), acc);
                    *(u32x2*)(gAP + ((size_t)(kt * 2 + (et >> 1)) * 64 + lane) * 8 + (et & 1) * 4) = (u32x2){pk2(-acc[0], -acc[1]), pk2(-acc[2], -acc[3])}; }
            } else {
#pragma unroll
                for (int tt = 0; tt < 4; ++tt) { f32x4 acc = {0.f, 0.f, 0.f, 0.f};
                    acc = MFMA16(a0, ldfrag(Mrb, TSTR, 16 * tt, 0, lane), acc); acc = MFMA16(a1, ldfrag(Mrb, TSTR, 16 * tt, 32, lane), acc);
                    const int tk = 16 * tt + l15, e0 = 16 * et + 4 * q4;
                    const u32x2 q2 = *(const u32x2*)(Rt + tk * TSTR + e0);
                    const float o0 = __uint_as_float(q2.x << 16) - acc[0], o1 = __uint_as_float(q2.x & 0xffff0000u) - acc[1], o2 = __uint_as_float(q2.y << 16) - acc[2], o3 = __uint_as_float(q2.y & 0xffff0000u) - acc[3];
                    *(u32x2*)(gRH + ((size_t)(tt * 2 + (et >> 1)) * 64 + lane) * 8 + (et & 1) * 4) = (u32x2){pk2(o0, o1), pk2(o2, o3)}; }
            }
        }
        {
            const int rt = w & 3;
            bf16_t* Out = part ? gKH : gYH;
            bf16x8 a0, a1, a2, a3;
            if (part) { a0 = ldfrag_tr(Btl, TSTR, 16 * rt, 0, lane); a1 = ldfrag_tr(Btl, TSTR, 16 * rt, 32, lane); a2 = ldfrag_tr(Ktl, TSTR, 16 * rt, 0, lane); a3 = ldfrag_tr(Ktl, TSTR, 16 * rt, 32, lane); }
            else { a0 = ldfrag(Mrb, TSTR, 16 * rt, 0, lane); a1 = ldfrag(Mrb, TSTR, 16 * rt, 32, lane); a2 = ldfrag(Mrk, TSTR, 16 * rt, 0, lane); a3 = ldfrag(Mrk, TSTR, 16 * rt, 32, lane); }
#pragma unroll
            for (int vt = 0; vt < 4; ++vt) { f32x4 acc = {0.f, 0.f, 0.f, 0.f};
                acc = MFMA16(a0, ldfrag(UvT, TSTR, 16 * vt, 0, lane), acc); acc = MFMA16(a1, ldfrag(UvT, TSTR, 16 * vt, 32, lane), acc);
                acc = MFMA16(a2, ldfrag_tr(Vr, TSTR, 16 * vt, 0, lane), acc); acc = MFMA16(a3, ldfrag_tr(Vr, TSTR, 16 * vt, 32, lane), acc);
                *(u32x2*)(Out + ((size_t)(vt * 4 + rt) * 64 + lane) * 4) = (u32x2){pk2(acc[0], acc[1]), pk2(acc[2], acc[3])}; }
        }
    }
    __syncthreads();
}

__device__ __forceinline__ void phase_rprep(const Params& p, int seg, unsigned char* smem) {
    const int blk = obid();
    const int n_items = (CPS + (seg == 0 ? 1 : 0)) * 128;
#pragma unroll 1
    for (int it = (blk + (gridDim.x >> 1)) % gridDim.x; it < n_items; it += gridDim.x) {
        const int bh = it & 127, b = bh >> 4, hb = bh & 15; int cl = it >> 7; if (seg != 0) cl += 1;
        unsigned char* rec = p.ws + WS_RP + (size_t)(cl * 128 + bh) * RP_STRIDE;
        const bf16_t* Pb = (const bf16_t*)(p.ws + WS_P);
        bf16_t* phalo2 = (bf16_t*)(p.ws + WS_PHALO);
        if (cl == 0) rwkv_prep_item(p, smem, hb, LEX0, 48, nullptr, nullptr, rec);
        else {
            const int row = b * SEGTOK + (cl - 1) * 64;
            const bf16_t* prow = Pb + (size_t)(row - 1) * NPB;
            if (cl == 1) prow = (seg == 0) ? Pb + (size_t)(LEX0 + NMETA - 1) * NPB : phalo2 + (size_t)(((seg - 1) & 1) * NBATCH + b) * NPB;
            bf16_t* ho = (cl == CPS) ? phalo2 + (size_t)((seg & 1) * NBATCH + b) * NPB : nullptr;
            rwkv_prep_item(p, smem, hb, row, 0, prow, ho, rec);
        }
    }
}

__device__ __forceinline__ void rwkv_scan_block(const Params& p, int seg, unsigned char* smem, int pairidx) {
    const int tid = otid(), w = tid >> 6, lane = tid & 63, q4 = lane >> 4, l15 = lane & 15;
    const int hsel = w >> 2, vt = w & 3;
    const int bh = pairidx * 2 + hsel, b = bh >> 4, hb = bh & 15;
    float* st = p.out + O_RWKV_P + (size_t)bh * 4096;
    f32x4 S[4];
    if (seg) {
#pragma unroll
        for (int mt = 0; mt < 4; ++mt) S[mt] = *(const f32x4*)(st + (size_t)(16 * vt + l15) * 64 + 16 * mt + 4 * q4);
    } else {
#pragma unroll
        for (int mt = 0; mt < 4; ++mt) S[mt] = (f32x4){0.f, 0.f, 0.f, 0.f};
    }
    const int c_lo = seg ? 1 : 0;
    float* ybuf = (float*)(smem + 65536) + hsel * (64 * 68);
    const int tl = tid & 255;
    {
        const u32x4* src = (const u32x4*)(p.ws + WS_RP + (size_t)(c_lo * 128 + bh) * RP_STRIDE); u32x4* dst = (u32x4*)(smem + hsel * 16384);
#pragma unroll
        for (int x = 0; x < 4; ++x) dst[tl + 256 * x] = src[tl + 256 * x];
    }
#pragma unroll 1
    for (int cl = c_lo; cl <= CPS; ++cl) {
        const unsigned char* rec = p.ws + WS_RP + (size_t)(cl * 128 + bh) * RP_STRIDE;
        const int cur = (cl - c_lo) & 1;
        __syncthreads();
        u32x4 nx[4];
        const bool more = cl < CPS;
        if (more) { const u32x4* src = (const u32x4*)(rec + (size_t)RP_STRIDE * 128);
#pragma unroll
            for (int x = 0; x < 4; ++x) nx[x] = src[tl + 256 * x]; }
        const bf16_t* gKH = (const bf16_t*)(rec + RP_KH); const bf16_t* gYH = (const bf16_t*)(rec + RP_YH);
        u32x2 kh[4], yh[4]; f32x4 pc[4];
#pragma unroll
        for (int mt = 0; mt < 4; ++mt) { kh[mt] = *(const u32x2*)(gKH + ((size_t)(vt * 4 + mt) * 64 + lane) * 4); yh[mt] = *(const u32x2*)(gYH + ((size_t)(vt * 4 + mt) * 64 + lane) * 4);
            pc[mt] = *(const f32x4*)((const float*)(rec + RP_PC) + 16 * mt + 4 * q4); }
        const int tk = tl >> 2, g = tl & 3;
        u32x4 a0 = {0u, 0u, 0u, 0u}, a1 = a0, b0 = a0, b1 = a0;
        if (cl > 0) { const bf16_t* c1p = (const bf16_t*)(rec + RP_C1) + tk * 64 + 16 * g; const bf16_t* c0p = (const bf16_t*)(rec + RP_C0) + tk * 64 + 16 * g;
            a0 = *(const u32x4*)c0p; a1 = *(const u32x4*)(c0p + 8); b0 = *(const u32x4*)c1p; b1 = *(const u32x4*)(c1p + 8); }
        bf16x8 Bf[2];
#pragma unroll
        for (int ks = 0; ks < 2; ++ks) { u32x4 tq; tq.x = pk2(S[2 * ks][0], S[2 * ks][1]); tq.y = pk2(S[2 * ks][2], S[2 * ks][3]); tq.z = pk2(S[2 * ks + 1][0], S[2 * ks + 1][1]); tq.w = pk2(S[2 * ks + 1][2], S[2 * ks + 1][3]);
            Bf[ks] = __builtin_bit_cast(bf16x8, tq); }
        const bf16x8* AP = (const bf16x8*)(smem + cur * 32768 + hsel * 16384); const bf16x8* RH = (const bf16x8*)(smem + cur * 32768 + hsel * 16384 + RP_RH);
        f32x4 y[4], tS[4];
#pragma unroll
        for (int tt = 0; tt < 4; ++tt) { y[tt] = (f32x4){0.f, 0.f, 0.f, 0.f}; y[tt] = MFMA16(RH[(tt * 2 + 0) * 64 + lane], Bf[0], y[tt]); y[tt] = MFMA16(RH[(tt * 2 + 1) * 64 + lane], Bf[1], y[tt]); }
#pragma unroll
        for (int mt = 0; mt < 4; ++mt) { tS[mt] = (f32x4){0.f, 0.f, 0.f, 0.f}; tS[mt] = MFMA16(AP[(mt * 2 + 0) * 64 + lane], Bf[0], tS[mt]); tS[mt] = MFMA16(AP[(mt * 2 + 1) * 64 + lane], Bf[1], tS[mt]); }
#pragma unroll
        for (int mt = 0; mt < 4; ++mt) {
            S[mt][0] = pc[mt][0] * S[mt][0] + tS[mt][0] + __uint_as_float(kh[mt].x << 16); S[mt][1] = pc[mt][1] * S[mt][1] + tS[mt][1] + __uint_as_float(kh[mt].x & 0xffff0000u);
            S[mt][2] = pc[mt][2] * S[mt][2] + tS[mt][2] + __uint_as_float(kh[mt].y << 16); S[mt][3] = pc[mt][3] * S[mt][3] + tS[mt][3] + __uint_as_float(kh[mt].y & 0xffff0000u); }
        if (cl > 0) {
#pragma unroll
            for (int tt = 0; tt < 4; ++tt) {
                y[tt][0] += __uint_as_float(yh[tt].x << 16); y[tt][1] += __uint_as_float(yh[tt].x & 0xffff0000u); y[tt][2] += __uint_as_float(yh[tt].y << 16); y[tt][3] += __uint_as_float(yh[tt].y & 0xffff0000u);
#pragma unroll
                for (int r = 0; r < 4; ++r) ybuf[(16 * tt + 4 * q4 + r) * 68 + 16 * vt + l15] = y[tt][r]; }
        }
        if (more) { u32x4* dst = (u32x4*)(smem + (cur ^ 1) * 32768 + hsel * 16384);
#pragma unroll
            for (int x = 0; x < 4; ++x) dst[tl + 256 * x] = nx[x]; }
        if (cl > 0) {
            __syncthreads();
            f32x4 yv[4]; float sm = 0.f;
#pragma unroll
            for (int j = 0; j < 4; ++j) { yv[j] = *(const f32x4*)(ybuf + tk * 68 + 16 * g + 4 * j); sm += yv[j][0] + yv[j][1] + yv[j][2] + yv[j][3]; }
            sm += __shfl_xor(sm, 1); sm += __shfl_xor(sm, 2);
            const float mu = sm * (1.f / 64.f); float vs = 0.f;
#pragma unroll
            for (int j = 0; j < 4; ++j) { yv[j] = yv[j] - mu; vs += yv[j][0] * yv[j][0] + yv[j][1] * yv[j][1] + yv[j][2] * yv[j][2] + yv[j][3] * yv[j][3]; }
            vs += __shfl_xor(vs, 1); vs += __shfl_xor(vs, 2);
            const float rs = __builtin_amdgcn_rsqf(vs * (1.f / 64.f) + 64e-5f);
            const unsigned c0w[8] = {a0.x, a0.y, a0.z, a0.w, a1.x, a1.y, a1.z, a1.w}, c1w[8] = {b0.x, b0.y, b0.z, b0.w, b1.x, b1.y, b1.z, b1.w};
            unsigned ow[8];
#pragma unroll
            for (int j = 0; j < 8; ++j) ow[j] = pk2(yv[j >> 1][(j & 1) * 2] * rs * __uint_as_float(c1w[j] << 16) + __uint_as_float(c0w[j] << 16),
                                                     yv[j >> 1][(j & 1) * 2 + 1] * rs * __uint_as_float(c1w[j] & 0xffff0000u) + __uint_as_float(c0w[j] & 0xffff0000u));
            const size_t grow = (size_t)b * SEQ + seg * SEGTOK + (cl - 1) * 64 + tk;
            bf16_t* ob = (bf16_t*)(p.ws + WS_OB) + grow * D + hb * 64 + 16 * g;
            *(u32x4*)ob = (u32x4){ow[0], ow[1], ow[2], ow[3]}; *(u32x4*)(ob + 8) = (u32x4){ow[4], ow[5], ow[6], ow[7]};
        }
    }
#pragma unroll
    for (int mt = 0; mt < 4; ++mt) *(f32x4*)(st + (size_t)(16 * vt + l15) * 64 + 16 * mt + 4 * q4) = S[mt];
    __syncthreads();
}

__device__ __forceinline__ void gdn_sample_item(const Params& p, unsigned char* smem, int bs, int h) {
    const int tid = otid(), w = tid >> 6, lane = tid & 63, kq = tid >> 7, v = tid & 127;
    float* qk_s = (float*)smem; float* v_s = qk_s + 1024; float* gb_s = v_s + 512; float* part = gb_s + 16; float* part2 = part + 512;
    const bf16_t* P = (const bf16_t*)(p.ws + WS_P);
    const float* pk = (const float*)(p.ws + WS_PK);
    const float* s_in = p.in[2] + (size_t)(bs * 8 + h) * 16384; float* s_out = p.out + O_GDN_S + (size_t)(bs * 8 + h) * 16384;
    const int row0 = LEX0 + EX_SAMP + bs * DECT;
    float s[32];
#pragma unroll
    for (int j = 0; j < 32; ++j) s[j] = s_in[(size_t)(kq * 32 + j) * 128 + v];
    if (tid < 384) {
        const int pcol = (tid >> 7) * 1024 + h * 128 + (tid & 127);
        const float* cw = pk + PK_CONVW; const float* hin = p.in[3] + (size_t)bs * 9216; float* hout = p.out + O_CONV_S + (size_t)bs * 9216;
        const float cw0 = cw[pcol], cw1 = cw[3072 + pcol], cw2 = cw[6144 + pcol], cw3 = cw[9216 + pcol];
        float x3 = hin[pcol], x2 = hin[3072 + pcol], x1 = hin[6144 + pcol];
        float xr[4];
#pragma unroll
        for (int i = 0; i < 4; ++i) xr[i] = bf2f(P[(size_t)(row0 + i) * NPB + pcol]);
#pragma unroll
        for (int i = 0; i < 4; ++i) { const float y = cw0 * x3 + cw1 * x2 + cw2 * x1 + cw3 * xr[i]; x3 = x2; x2 = x1; x1 = xr[i];
            if (tid < 256) qk_s[i * 256 + tid] = silu_(y); else v_s[i * 128 + (tid - 256)] = silu_(y); }
        hout[pcol] = x3; hout[3072 + pcol] = x2; hout[6144 + pcol] = x1;
    } else if (tid < 388) {
        const int i = tid - 384; const size_t r = (size_t)(row0 + i) * NPB;
        const float pa = bf2f(P[r + C_A + h]), pb = bf2f(P[r + C_B + h]);
        gb_s[2 * i] = __expf(-expf(pk[PK_ALOG + h]) * softplus_(pa + pk[PK_DTB + h])); gb_s[2 * i + 1] = sigm(pb);
    }
    __syncthreads();
    { const int i = w >> 1, which = w & 1; float* rp = qk_s + i * 256 + which * 128; const float a = rp[lane], b = rp[lane + 64];
      const float sc = __builtin_amdgcn_rsqf(wave_sum(a * a + b * b) + 1e-6f) * (which == 0 ? 0.08838834764831845f : 1.f); rp[lane] = a * sc; rp[lane + 64] = b * sc; }
    __syncthreads();
#pragma unroll 1
    for (int i = 0; i < 4; ++i) {
        const float* kp = qk_s + i * 256 + 128 + kq * 32; const float* qp = qk_s + i * 256 + kq * 32;
        float pa = 0.f;
#pragma unroll
        for (int j4 = 0; j4 < 8; ++j4) { const f32x4 k4 = *(const f32x4*)(kp + 4 * j4); pa += k4[0] * s[4 * j4] + k4[1] * s[4 * j4 + 1] + k4[2] * s[4 * j4 + 2] + k4[3] * s[4 * j4 + 3]; }
        part[kq * 128 + v] = pa;
        __syncthreads();
        const float kS = part[v] + part[128 + v] + part[256 + v] + part[384 + v];
        const float a = gb_s[2 * i], c = gb_s[2 * i + 1] * (v_s[i * 128 + v] - a * kS);
        float po = 0.f;
#pragma unroll
        for (int j4 = 0; j4 < 8; ++j4) { const f32x4 k4 = *(const f32x4*)(kp + 4 * j4), q4v = *(const f32x4*)(qp + 4 * j4);
#pragma unroll
            for (int e = 0; e < 4; ++e) { s[4 * j4 + e] = a * s[4 * j4 + e] + k4[e] * c; po += q4v[e] * s[4 * j4 + e]; } }
        part2[kq * 128 + v] = po;
        __syncthreads();
        if (kq == 0) ((float*)(p.ws + WS_ORAW))[(size_t)(row0 + i) * D + h * 128 + v] = part2[v] + part2[128 + v] + part2[256 + v] + part2[384 + v];
    }
#pragma unroll
    for (int j = 0; j < 32; ++j) s_out[(size_t)(kq * 32 + j) * 128 + v] = s[j];
    __syncthreads();
}

constexpr int SR_R = 0, SR_KK = 4096, SR_V = 8192, SR_ZB = 12288, SR_DEC = 16384, SR_KA = 20480, SR_KM = 24576, SR_WD = 28672, SR_AD = 28928, SR_RK = 29184;
__device__ __forceinline__ void rwkv_sample_item(const Params& p, unsigned char* smem, int bs) {
    const int tid = otid(), w = tid >> 6, lane = tid & 63;
    float* f = (float*)smem;
    const bf16_t* P = (const bf16_t*)(p.ws + WS_P);
    const float* pk = (const float*)(p.ws + WS_PK);
    const int row0 = LEX0 + EX_SAMP + bs * DECT;
    const bf16_t* prow = P + (size_t)(LEX0 + EX_SHIFT + bs) * NPB + C_RW;
#pragma unroll 1
    for (int col = tid; col < RW_SHIFT; col += 512) {
        const float mu = pk[PK_MU + col]; float prev = bf2f(prow[col]);
        float cur[4];
#pragma unroll
        for (int i = 0; i < 4; ++i) cur[i] = bf2f(P[(size_t)(row0 + i) * NPB + C_RW + col]);
        float* dst; int stride = 1024; bool th = false;
        if (col < 1024) dst = f + SR_R + col; else if (col < 2048) dst = f + SR_KK + (col - 1024); else if (col < 3072) dst = f + SR_V + (col - 2048);
        else if (col < 3136) { dst = f + SR_WD + (col - 3072); stride = 64; th = true; } else if (col < 3200) { dst = f + SR_AD + (col - 3136); stride = 64; } else dst = f + SR_ZB + (col - 3200);
#pragma unroll
        for (int i = 0; i < 4; ++i) { float m = cur[i] + mu * (prev - cur[i]); prev = cur[i]; if (th) m = tanh_(m); dst[i * stride] = m; }
    }
    __syncthreads();
#pragma unroll 1
    for (int cc = 0; cc < 2; ++cc) {
        const int c = tid + 512 * cc;
        float aw[4] = {0.f, 0.f, 0.f, 0.f}, aa[4] = {0.f, 0.f, 0.f, 0.f};
#pragma unroll 8
        for (int l = 0; l < 64; ++l) { const float w2v = pk[PK_W2 + l * D + c], a2v = pk[PK_A2 + l * D + c];
#pragma unroll
            for (int i = 0; i < 4; ++i) { aw[i] += f[SR_WD + i * 64 + l] * w2v; aa[i] += f[SR_AD + i * 64 + l] * a2v; } }
        const float w0c = pk[PK_W0 + c], a0c = pk[PK_A0 + c], kkc = pk[PK_KK + c], kac = pk[PK_KA + c];
#pragma unroll
        for (int i = 0; i < 4; ++i) { const float a = sigm(a0c + aa[i]); const float kbv = f[SR_KK + i * 1024 + c];
            f[SR_DEC + i * 1024 + c] = __expf(-0.6065306597126334f * sigm(w0c + aw[i])); f[SR_KA + i * 1024 + c] = a; f[SR_KK + i * 1024 + c] = kbv * kkc; f[SR_KM + i * 1024 + c] = kbv * (1.f + (a - 1.f) * kac); }
    }
    __syncthreads();
#pragma unroll 1
    for (int x = 0; x < 8; ++x) { const int pr = w * 8 + x, i = pr >> 4, hh = pr & 15; const int o = i * 1024 + hh * 64 + lane;
        const float kr = f[SR_KK + o]; const float kk = kr * __builtin_amdgcn_rsqf(wave_sum(kr * kr) + 1e-6f); f[SR_KK + o] = kk; f[SR_KA + o] = kk * f[SR_KA + o];
        const float rkv = wave_sum(f[SR_R + o] * f[SR_KM + o] * pk[PK_RK + hh * 64 + lane]); if (lane == 0) f[SR_RK + pr] = rkv; }
    __syncthreads();
#pragma unroll 1
    for (int hp = 0; hp < 2; ++hp) {
        const int hb = hp * 8 + w;
        const float* s_in = p.in[4] + (size_t)(bs * 16 + hb) * 4096 + (size_t)lane * 64; float* s_out = p.out + O_RWKV_S + (size_t)(bs * 16 + hb) * 4096 + (size_t)lane * 64;
        f32x4 S[16];
#pragma unroll
        for (int j = 0; j < 16; ++j) S[j] = *(const f32x4*)(s_in + 4 * j);
        const int cch = hb * 64 + lane;
        const float gnw = pk[PK_GNW + cch], gnb = pk[PK_GNB + cch];
#pragma unroll 1
        for (int i = 0; i < 4; ++i) {
            const int o = i * 1024 + hb * 64;
            const float vv = f[SR_V + o + lane], rk = f[SR_RK + i * 16 + hb];
            float sa = 0.f;
#pragma unroll
            for (int j = 0; j < 16; ++j) { const f32x4 kk4 = *(const f32x4*)(f + SR_KK + o + 4 * j); sa += S[j][0] * kk4[0] + S[j][1] * kk4[1] + S[j][2] * kk4[2] + S[j][3] * kk4[3]; }
            float y = 0.f;
#pragma unroll
            for (int j = 0; j < 16; ++j) { const f32x4 de4 = *(const f32x4*)(f + SR_DEC + o + 4 * j), ka4 = *(const f32x4*)(f + SR_KA + o + 4 * j), km4 = *(const f32x4*)(f + SR_KM + o + 4 * j), r4 = *(const f32x4*)(f + SR_R + o + 4 * j);
#pragma unroll
                for (int e = 0; e < 4; ++e) { S[j][e] = S[j][e] * de4[e] + (vv * km4[e] - sa * ka4[e]); y += S[j][e] * r4[e]; } }
            const float mu = wave_sum(y) * (1.f / 64.f); const float dy = y - mu;
            const float rs = __builtin_amdgcn_rsqf(wave_sum(dy * dy) * (1.f / 64.f) + 64e-5f);
            const float ov = (dy * rs * gnw + gnb + rk * vv) * silu_(f[SR_ZB + i * 1024 + cch]);
            ((bf16_t*)(p.ws + WS_OB))[(size_t)(XROWS + EX_SAMP + bs * DECT + i) * D + cch] = (bf16_t)f2bf(ov);
        }
#pragma unroll
        for (int j = 0; j < 16; ++j) *(f32x4*)(s_out + 4 * j) = S[j];
    }
    __syncthreads();
}

__device__ __forceinline__ void phase2(const Params& p, int seg, unsigned char* smem) {
    const int blk = obid();
    float* out = p.out;
    float* chalo = (float*)(p.ws + WS_CHALO); float* phalo = (float*)(p.ws + WS_PHALO);
#ifndef SUB
#define SUB 0
#endif
#define SEN(x) (SUB == 0 || SUB == (x))
    if (SEN(1) && blk < 64) gdn_scan_block(p, seg, smem, blk);
    if (SEN(3) && blk >= 64 && blk < 128) rwkv_scan_block(p, seg, smem, blk - 64);
#ifndef DUP
#define DUP 0
#endif
    if (seg == 0) {
#pragma unroll 1
        for (int it = blk; it < DECB * 8; it += gridDim.x) gdn_sample_item(p, smem, it >> 3, it & 7);
#pragma unroll 1
        for (int it = (blk + 128) & 255; it < DECB; it += gridDim.x) rwkv_sample_item(p, smem, it);
    }
}

__device__ __forceinline__ void phase25(const Params& p, int seg) {
    const int tid0 = otid(); const int lane = tid0 & 63; const int gw = obid() * 8 + (tid0 >> 6), NGW = gridDim.x * 8;
    const bf16_t* P = (const bf16_t*)(p.ws + WS_P);
    const float* ORAW = (const float*)(p.ws + WS_ORAW); const float* YRAW = (const float*)(p.ws + WS_YRAW);
    const bf16_t* C0 = (const bf16_t*)(p.ws + WS_C0); const bf16_t* C1 = (const bf16_t*)(p.ws + WS_C1);
    bf16_t* OA = (bf16_t*)(p.ws + WS_H); bf16_t* OB = (bf16_t*)(p.ws + WS_OB);
    const int nrows = LEX0 + (seg == 0 ? DECB * DECT : 0);
    const int c = lane * 16;
    f32x4 nw[4];
#pragma unroll
    for (int j = 0; j < 4; ++j) nw[j] = *(const f32x4*)((const float*)(p.ws + WS_PK) + PK_NORMW + (c & 127) + 4 * j);
#pragma unroll 1
    for (int rr = LEX0 + gw; rr < nrows; rr += NGW) {
        int lr; size_t grow;
        if (rr < LEX0) { lr = rr; grow = (size_t)(rr / SEGTOK) * SEQ + seg * SEGTOK + (rr % SEGTOK); } else { lr = LEX0 + EX_SAMP + (rr - LEX0); grow = (size_t)XROWS + EX_SAMP + (rr - LEX0); }
        {
            f32x4 o[4]; float ss = 0.f;
#pragma unroll
            for (int j = 0; j < 4; ++j) { o[j] = *(const f32x4*)(ORAW + (size_t)lr * D + c + 4 * j); ss += o[j][0] * o[j][0] + o[j][1] * o[j][1] + o[j][2] * o[j][2] + o[j][3] * o[j][3]; }
            ss += __shfl_xor(ss, 1); ss += __shfl_xor(ss, 2); ss += __shfl_xor(ss, 4);
            const float rs = __builtin_amdgcn_rsqf(ss * (1.f / 128.f) + 1e-6f);
            const u32x4 z0 = *(const u32x4*)(P + (size_t)lr * NPB + C_Z + c), z1 = *(const u32x4*)(P + (size_t)lr * NPB + C_Z + c + 8);
            const unsigned zz[8] = {z0.x, z0.y, z0.z, z0.w, z1.x, z1.y, z1.z, z1.w};
            unsigned ow[8];
#pragma unroll
            for (int j = 0; j < 8; ++j) { const float za = __uint_as_float(zz[j] << 16), zb = __uint_as_float(zz[j] & 0xffff0000u);
                const float a = o[j >> 1][(j & 1) * 2] * rs * nw[j >> 1][(j & 1) * 2] * silu_(za), b = o[j >> 1][(j & 1) * 2 + 1] * rs * nw[j >> 1][(j & 1) * 2 + 1] * silu_(zb);
                ow[j] = pk2(a, b); }
            *(u32x4*)(OA + grow * D + c) = (u32x4){ow[0], ow[1], ow[2], ow[3]}; *(u32x4*)(OA + grow * D + c + 8) = (u32x4){ow[4], ow[5], ow[6], ow[7]};
        }
    }
}

__device__ __forceinline__ void phase_final(const Params& p) {
    const int tid0 = otid(); const int lane = tid0 & 63; const int gw = obid() * 8 + (tid0 >> 6), NGW = gridDim.x * 8;
    const f32x4* wr = (const f32x4*)((const float*)(p.ws + WS_PK) + PK_LNF) + lane;
#pragma unroll 1
    for (int r = gw; r < XROWS + DECB * DECT; r += NGW) {
        f32x4* xr = (f32x4*)(p.out + (size_t)r * D) + lane;
        f32x4 v[4]; float ss = 0.f;
#pragma unroll
        for (int j = 0; j < 4; ++j) { v[j] = xr[64 * j]; ss += v[j][0] * v[j][0] + v[j][1] * v[j][1] + v[j][2] * v[j][2] + v[j][3] * v[j][3]; }
        const float rs = __builtin_amdgcn_rsqf(wave_sum(ss) * (1.f / D) + 1e-6f);
#pragma unroll
        for (int j = 0; j < 4; ++j) xr[64 * j] = v[j] * rs * wr[64 * j];
    }
}

__global__ __launch_bounds__(512, 2) void hybrid_mega(Params p) {
    extern __shared__ __attribute__((aligned(16))) unsigned char smem[];
    cg::grid_group grid = cg::this_grid();
    LAS unsigned char* lds = (LAS unsigned char*)smem;
    const int G = gridDim.x;
    volatile LAS unsigned* xst = (volatile LAS unsigned*)(lds + (LDS_TOTAL - 16));
    if (threadIdx.x == 0) { xst[0] = 0u; xst[1] = 0u; }
    __syncthreads();
    (void)xcd_barrier_post((unsigned*)(p.ws + WS_BAR), xst);
    if (G == 0x7fffffff) grid.sync();
#define GSYNC() do { XcdBarrier xb_; xb_.bar = (unsigned*)(p.ws + WS_BAR); xb_.x = xb_xcc_id(); xb_.st = (volatile LAS unsigned*)((LAS unsigned char*)smem + (LDS_TOTAL - 16)); xcd_barrier(xb_); } while (0)

#ifndef ONLY
#define ONLY 0
#endif
#define EN(x) (ONLY == 0 || ONLY == (x))
    if (EN(1)) phase0(p, smem);
    GSYNC();
#pragma unroll 1
    for (int it = 0; it <= NSEG + 2; ++it) {
        const int xblk = obid() - (G - 12);
        const bool xrole = xblk >= 0;
        if (it > 0 && it <= NSEG && EN(3)) phase2(p, it - 1, smem);
        if (((it == 2 && xrole) || it == NSEG + 1) && EN(5)) {
            const bool ex = it == 2;
            SchedAB S; S.ob.init(ex ? 3 : XROWS / 256, 4, ex ? 12 : G, ex ? xblk : obid()); S.pm0 = ex ? XROWS / 256 : 0;
            S.A0 = (const char*)(p.ws + WS_H); S.A1 = (const char*)(p.ws + WS_OB); S.B0 = (const char*)(p.ws + WS_WT_A); S.B1 = (const char*)(p.ws + WS_WT_B);
            EpiAB E; E.tmp = ex ? (float*)(p.ws + WS_YRAW) - (size_t)XROWS * D : (float*)(p.ws + WS_P); E.merged = ex ? (bf16_t*)(p.ws + WS_C0) - (size_t)XROWS * D : (bf16_t*)(p.ws + WS_MG);
            E.gex = (const bf16_t*)(p.ws + WS_GEX); E.out = p.out;
            pg8::gemm_phase<EpiAB, SchedAB>(lds, D, S, E);
        }
        if (((it == 3 && xrole) || it == NSEG + 2) && EN(6)) {
            const bool ex = it == 3;
            SchedO S; S.ob.init(ex ? 3 : XROWS / 256, 4, ex ? 12 : G, ex ? xblk : obid()); S.pm0 = ex ? XROWS / 256 : 0;
            S.A = ex ? (const char*)((bf16_t*)(p.ws + WS_C0) - (size_t)XROWS * D) : (const char*)(p.ws + WS_MG); S.B = (const char*)(p.ws + WS_WT_O);
            EpiO E; E.out = p.out; E.xp = p.in[0]; E.xs = p.in[1];
            pg8::gemm_phase<EpiO, SchedO>(lds, D, S, E);
        }
        if (it < NSEG && EN(2) && !(it == 2 && xrole)) {
            const int seg = it;
            const int Gp = it == 2 ? G - 12 : G;
            const int cidx = it > 0 ? (obid() + (Gp >> 1)) % Gp : obid();
            SchedIn S; S.ob.init(seg == 0 ? LT_PROMPT + 3 : LT_PROMPT, NT_IN, Gp, cidx); S.seg = seg; S.A = (const char*)(p.ws + WS_H); S.B = (const char*)(p.ws + WS_WT_IN);
            EpiIn E; E.P = (bf16_t*)(p.ws + WS_P); E.gex = (bf16_t*)(p.ws + WS_GEX); E.out = p.out; E.seg = seg;
            pg8::gemm_phase<EpiIn, SchedIn>(lds, D, S, E);
        }
        GSYNC();
        if (it < NSEG) {
            if (EN(8)) { phase_gprep(p, it, smem); phase_rprep(p, it, smem); }
            if (it == 1 && EN(4)) phase25(p, 0);
            GSYNC();
        }
    }
    if (EN(7)) phase_final(p);
}

extern "C" void kernel_launch(void* const* d_in, const int* in_sizes, int n_in, void* d_out, int out_size, void* d_ws, size_t ws_size, hipStream_t stream) {
    static int grid_blocks = 0;
    constexpr int LDS_BYTES = LDS_TOTAL;
    if (grid_blocks == 0) {
        if (n_in != 27 || ws_size < WS_END) { fprintf(stderr, "kernel_launch: unexpected n_in %d / ws %zu (need %zu)\n", n_in, ws_size, (size_t)WS_END); grid_blocks = -1; return; }
        if (hipFuncSetAttribute((const void*)hybrid_mega, hipFuncAttributeMaxDynamicSharedMemorySize, LDS_BYTES) != hipSuccess) { fprintf(stderr, "kernel_launch: hipFuncSetAttribute failed\n"); grid_blocks = -1; return; }
        int dev = 0, cus = 0, per_cu = 0;
        hipGetDevice(&dev);
        hipDeviceGetAttribute(&cus, hipDeviceAttributeMultiprocessorCount, dev);
        hipOccupancyMaxActiveBlocksPerMultiprocessor(&per_cu, (const void*)hybrid_mega, 512, LDS_BYTES);
        if (per_cu < 1) { fprintf(stderr, "kernel_launch: occupancy query says %d blocks/CU\n", per_cu); per_cu = 1; }
        (void)hipGetLastError();
        grid_blocks = cus;
    }
    if (grid_blocks < 0) return;
    Params p{};
    for (int i = 0; i < 27; ++i) p.in[i] = (const float*)d_in[i];
    p.out = (float*)d_out; p.ws = (unsigned char*)d_ws;
    if (hipMemsetAsync((unsigned char*)d_ws + WS_BAR, 0, 16384, stream) != hipSuccess) { fprintf(stderr, "kernel_launch: memset of the barrier words failed\n"); return; }
    void* args[] = {&p};
    hipError_t e = hipLaunchCooperativeKernel((const void*)hybrid_mega, dim3(grid_blocks), dim3(512), args, LDS_BYTES, stream);
    if (e != hipSuccess) fprintf(stderr, "cooperative launch failed: %s (grid %d)\n", hipGetErrorString(e), grid_blocks);
}
```

```cpp
#include <hip/hip_runtime.h>
#include <hip/hip_cooperative_groups.h>
#include <cstdio>
namespace cg = cooperative_groups;

#define LAS __attribute__((address_space(3)))
typedef unsigned short bf16_t;
typedef short bf16x8 __attribute__((ext_vector_type(8)));
typedef float f32x4 __attribute__((ext_vector_type(4)));
typedef unsigned u32x4 __attribute__((ext_vector_type(4)));
typedef unsigned u32x2 __attribute__((ext_vector_type(2)));

constexpr int D = 1024;
constexpr int NBATCH = 8, SEQ = 2048, NMETA = 16, DECB = 128, DECT = 4;
constexpr int XROWS = NBATCH * SEQ;
constexpr int EX_SAMP = 16, EX_SHIFT = 528, EX_END = 656;
constexpr int HROWS = 17152, HTILES = 67;
constexpr int NSEG = 8, SEGTOK = SEQ / NSEG;
constexpr int CPS = SEGTOK / 64;
constexpr int TPB = SEGTOK / 256;
constexpr int LT_PROMPT = NBATCH * TPB;
constexpr int LEX0 = LT_PROMPT * 256;
constexpr int LROWS = LEX0 + 768;
constexpr int NP = 10496, NPB = 8448, NT_IN = 41, NT_PB = 33;
constexpr int C_A = 3072, C_B = 3080, C_Z = 3088, C_RW = 4112, C_GATE_REF = 8336;
constexpr int RW_SHIFT = 4224;

constexpr size_t O_YP = 0, O_YS = 16777216, O_GDN_P = 17301504, O_CONV_P = 18350080, O_RWKV_P = 18423808, O_SHIFT_P = 18948096,
                 O_GDN_S = 18956288, O_CONV_S = 35733504, O_RWKV_S = 36913152, O_SHIFT_S = 45301760;

constexpr size_t al256(size_t x) { return (x + 255) & ~(size_t)255; }
constexpr size_t WS_WT_IN = 0;
constexpr size_t WS_WT_A = al256(WS_WT_IN + (size_t)NP * D * 2);
constexpr size_t WS_WT_B = al256(WS_WT_A + (size_t)D * D * 2);
constexpr size_t WS_WT_O = al256(WS_WT_B + (size_t)D * D * 2);
constexpr size_t WS_H = al256(WS_WT_O + (size_t)D * D * 2);
constexpr size_t WS_OB = al256(WS_H + (size_t)HROWS * D * 2);
constexpr size_t WS_P = al256(WS_OB + (size_t)HROWS * D * 2);
constexpr size_t WS_ORAW = al256(WS_P + (size_t)LROWS * NPB * 2);
constexpr size_t WS_YRAW = al256(WS_ORAW + (size_t)LROWS * D * 4);
constexpr size_t WS_C0 = al256(WS_YRAW + (size_t)LROWS * D * 4);
constexpr size_t WS_C1 = al256(WS_C0 + (size_t)LROWS * D * 2);
constexpr size_t WS_GEX = al256(WS_C1 + (size_t)LROWS * D * 2);
constexpr size_t WS_CHALO = al256(WS_GEX + (size_t)768 * 2048 * 2);
constexpr size_t WS_PHALO = al256(WS_CHALO + (size_t)2 * NBATCH * 3 * NPB * 2);
constexpr size_t WS_PK = al256(WS_PHALO + (size_t)2 * NBATCH * NPB * 2);
constexpr int PK_CONVW = 0, PK_ALOG = 12288, PK_DTB = 12296, PK_NORMW = 12304, PK_MU = 12432, PK_W0 = 16656, PK_W2 = 17680, PK_A0 = 83216, PK_A2 = 84240,
              PK_KK = 149776, PK_KA = 150800, PK_RK = 151824, PK_GNW = 152848, PK_GNB = 153872, PK_LNF = 154896, PK_END = 155920;
constexpr size_t WS_BAR = al256(WS_PK + (size_t)PK_END * 4);
constexpr size_t WS_W2T = al256(WS_BAR + 16384);
constexpr size_t WS_A2T = al256(WS_W2T + 131072);
constexpr size_t WS_GP = al256(WS_A2T + 131072);
constexpr int GP_AP = 0, GP_QH = 32768, GP_KH = 49152, GP_OH = 81920, GP_EGL = 98304, GP_G = 98560, GP_STRIDE = 114944;
constexpr int RP_AP = 0, RP_RH = 8192, RP_KH = 16384, RP_YH = 24576, RP_C1 = 32768, RP_C0 = 40960, RP_PC = 49152, RP_STRIDE = 49408;
constexpr size_t WS_RP = al256(WS_GP + (size_t)(CPS + 1) * 64 * GP_STRIDE);
constexpr size_t WS_END = al256(WS_RP + (size_t)(CPS + 1) * 128 * RP_STRIDE);
constexpr size_t WS_MG = WS_GP;
static_assert((size_t)HROWS * D * 2 <= WS_END - WS_GP, "MERGED must fit in the prep records");
static_assert((size_t)HROWS * D * 4 <= (size_t)LROWS * NPB * 2 + 2 * (size_t)LROWS * D * 4, "TMP must fit in P+ORAW+YRAW");
static_assert(WS_END <= (size_t)268435456, "workspace");

constexpr int LDS_TOTAL = 163840;
struct Params { const float* in[27]; float* out; unsigned char* ws; };

__device__ __forceinline__ float bf2f(bf16_t v) { return __uint_as_float(((unsigned)v) << 16); }
typedef __bf16 bf16n2 __attribute__((ext_vector_type(2)));
typedef float f32n2 __attribute__((ext_vector_type(2)));
__device__ __forceinline__ unsigned cvt_pk_bf16(float lo, float hi) { const f32n2 v = {lo, hi}; return __builtin_bit_cast(unsigned, __builtin_convertvector(v, bf16n2)); }
__device__ __forceinline__ unsigned pk2(float lo, float hi) { return cvt_pk_bf16(lo, hi); }
__device__ __forceinline__ unsigned f2bf(float f) { return cvt_pk_bf16(f, 0.f) & 0xffffu; }
__device__ __forceinline__ float sigm(float x) { return __builtin_amdgcn_rcpf(1.f + __expf(-x)); }
__device__ __forceinline__ float silu_(float x) { return x * __builtin_amdgcn_rcpf(1.f + __expf(-x)); }
__device__ __forceinline__ float softplus_(float x) { return fmaxf(x, 0.f) + log1pf(expf(-fabsf(x))); }
__device__ __forceinline__ float wave_sum(float v) {
#pragma unroll
    for (int o = 1; o < 64; o <<= 1) v += __shfl_xor(v, o);
    return v;
}
__device__ __forceinline__ void unpack8(const u32x4 rw, float (&x)[8]) {
    x[0] = __uint_as_float(rw.x << 16); x[1] = __uint_as_float(rw.x & 0xffff0000u); x[2] = __uint_as_float(rw.y << 16); x[3] = __uint_as_float(rw.y & 0xffff0000u);
    x[4] = __uint_as_float(rw.z << 16); x[5] = __uint_as_float(rw.z & 0xffff0000u); x[6] = __uint_as_float(rw.w << 16); x[7] = __uint_as_float(rw.w & 0xffff0000u); }
__device__ __forceinline__ u32x4 pack8(const float (&x)[8]) { return (u32x4){pk2(x[0], x[1]), pk2(x[2], x[3]), pk2(x[4], x[5]), pk2(x[6], x[7])}; }

__device__ __forceinline__ int otid() { int t = threadIdx.x; asm volatile("" : "+v"(t)); return t; }
__device__ __forceinline__ int obid() { int t = blockIdx.x; asm volatile("" : "+s"(t)); return t; }
__device__ __forceinline__ float tanh_(float x) { const float e = __expf(2.f * x); return 1.f - 2.f * __builtin_amdgcn_rcpf(e + 1.f); }
template <int CTRL> __device__ __forceinline__ float dppf(float x) { return __builtin_bit_cast(float, __builtin_amdgcn_mov_dpp(__builtin_bit_cast(int, x), CTRL, 0xf, 0xf, true)); }
__device__ __forceinline__ float rowsum16(float x) { x += dppf<0x128>(x); x += dppf<0x124>(x); x += dppf<0x122>(x); x += dppf<0x121>(x); return x; }


#define XB_TMO      128
#define XB_XCNT(j)  (256  + 64 * (j))
#define XB_XSUB(j)  (1280 + 64 * (j))
#define XB_XGEN(j)  (2304 + 64 * (j))
#define XB_TOP      3328
#define XB_TOPGEN   3392
#define XCD_BAR_WORDS 3456
#define XB_SPIN_CAP (1u << 22)
__device__ __forceinline__ unsigned xb_ld(unsigned* p)              { return __hip_atomic_load(p, __ATOMIC_RELAXED, __HIP_MEMORY_SCOPE_AGENT); }
__device__ __forceinline__ unsigned xb_add(unsigned* p, unsigned v) { return __hip_atomic_fetch_add(p, v, __ATOMIC_RELAXED, __HIP_MEMORY_SCOPE_AGENT); }
__device__ __forceinline__ unsigned xb_xcc_id() { return (unsigned)__builtin_amdgcn_s_getreg((3 << 11) | 20) & 0xFu; }
#define XB_SPIN(cond, bar) do { unsigned _sp = 0; while (cond) { __builtin_amdgcn_s_sleep(1); \
    if ((++_sp & 255u) == 0u) { if (xb_ld(&(bar)[XB_TMO])) break; if (_sp > XB_SPIN_CAP) { atomicAdd(&(bar)[XB_TMO], 1u); break; } } } } while (0)
struct XcdBarrier { unsigned* bar; unsigned x; volatile LAS unsigned* st; };
__device__ __forceinline__ XcdBarrier xcd_barrier_post(unsigned* bar, volatile LAS unsigned* st) {
    XcdBarrier b; b.bar = bar; b.x = xb_xcc_id(); b.st = st;
    if (threadIdx.x == 0) (void)xb_add(&bar[XB_XCNT(b.x)], 1u);
    return b;
}
__device__ __forceinline__ void xcd_barrier_complete(unsigned* bar, unsigned x, unsigned& nloc, unsigned& nx) {
    const unsigned G = gridDim.x * gridDim.y * gridDim.z;
    unsigned sum, cnt, mine, sp = 0u;
    for (;;) {
        sum = 0u; cnt = 0u; mine = 0u;
#pragma unroll
        for (unsigned j = 0; j < 16; ++j) { const unsigned c = xb_ld(&bar[XB_XCNT(j)]); sum += c; cnt += (c > 0u) ? 1u : 0u; mine = (j == x) ? c : mine; }
        if (sum == G) break;
        __builtin_amdgcn_s_sleep(1);
        if ((++sp & 255u) == 0u) { if (xb_ld(&bar[XB_TMO])) break; if (sp > XB_SPIN_CAP) { atomicAdd(&bar[XB_TMO], 1u); break; } }
    }
    nloc = mine > 0u ? mine : 1u; nx = cnt > 0u ? cnt : 1u;
}
__device__ __forceinline__ void xcd_barrier(const XcdBarrier& b) {
    asm volatile("s_waitcnt vmcnt(0)" ::: "memory");
    __syncthreads();
    if (threadIdx.x == 0) {
        unsigned* bar = b.bar;
        __builtin_amdgcn_s_waitcnt(0);
        unsigned nloc = b.st[0], nx = b.st[1];
        if (nloc == 0u) { xcd_barrier_complete(bar, b.x, nloc, nx); b.st[0] = nloc; b.st[1] = nx; }
        const unsigned old = xb_add(&bar[XB_XSUB(b.x)], 1u);
        const unsigned gen = old / nloc;
        if (old + 1u == (gen + 1u) * nloc) {
            __builtin_amdgcn_fence(__ATOMIC_RELEASE, "agent");
            asm volatile("s_waitcnt vmcnt(0)" ::: "memory");
            const unsigned og = xb_add(&bar[XB_TOP], 1u);
            const unsigned tg = og / nx;
            if (og + 1u == (tg + 1u) * nx) xb_add(&bar[XB_TOPGEN], 1u);
            else XB_SPIN(xb_ld(&bar[XB_TOPGEN]) == tg, bar);
            __builtin_amdgcn_fence(__ATOMIC_ACQUIRE, "agent");
            xb_add(&bar[XB_XGEN(b.x)], 1u);
            asm volatile("s_waitcnt vmcnt(0)" ::: "memory");
        } else {
            XB_SPIN(xb_ld(&bar[XB_XGEN(b.x)]) == gen, bar);
            __builtin_amdgcn_fence(__ATOMIC_ACQUIRE, "agent");
            asm volatile("s_waitcnt vmcnt(0)" ::: "memory");
        }
    }
    __syncthreads();
}

namespace pg8 {
constexpr int BM = 256, BK = 64, HALF = 128, HTB = HALF * BK * 2, STAGE_BYTES = 8 * HTB, NXCD = 8, WGM = 8;
__device__ __forceinline__ int lds_byte(int r, int c) { const int st = (r >> 4) * 2 + (c >> 5), rr = r & 15, cc = c & 31, ob = rr * 64 + cc * 2; return st * 1024 + (ob ^ (((ob >> 9) & 1) << 5)); }
__device__ __forceinline__ void stage_rc(int b, int& R, int& C) { const int st = b / 1024, sb = b % 1024, swz = sb ^ (((sb >> 9) & 1) << 5); R = (st >> 1) * 16 + swz / 64; C = (st & 1) * 32 + (swz % 64) / 2; }
__device__ __forceinline__ int perm32(int rho) { const int n = rho >> 4, i = rho & 15; return 8 * (i >> 2) + 4 * n + (i & 3); }

struct Unit { int pm, pn, w; };
struct OrderBase {
    int nM, nN, nwg, G, c;
    __device__ void init(int nM_, int nN_, int G_, int c_) { nM = nM_; nN = nN_; nwg = nM * nN; G = G_; c = c_; }
    __device__ bool nextb(int i, Unit& u) const {
        const long L = (long)i * G + c; if (L >= nwg) return false;
        int wgid = (int)L; { const int q = nwg / NXCD, r = nwg % NXCD, xcd = wgid % NXCD, off = wgid / NXCD; wgid = (xcd < r ? xcd * (q + 1) : r * (q + 1) + (xcd - r) * q) + off; }
        const int nig = WGM * nN, gid = wgid / nig, fm = gid * WGM, gsz = (nM - fm) < WGM ? (nM - fm) : WGM;
        u.pm = fm + ((wgid % nig) % gsz); u.pn = (wgid % nig) / gsz; u.w = 0; return true;
    }
};

template <class Epi, class Sched>
__device__ __forceinline__ void gemm_phase(LAS unsigned char* lds, const int K, const Sched& S, const Epi& E) {
    const int tid = otid(), wid = __builtin_amdgcn_readfirstlane(tid >> 6), lane = tid & 63, wr = wid >> 2, wc = wid & 3, fr = lane & 15, fq = lane >> 4;
    const int nt = K / BK;
    unsigned voffA[2], voffB[2];
#pragma unroll
    for (int i = 0; i < 2; ++i) { int R, C; stage_rc(tid * 16 + i * 8192, R, C); const int Rb = Epi::PERM ? ((R & ~31) + perm32(R & 31)) : R;
        voffA[i] = (unsigned)(R * K + C) * 2u; voffB[i] = (unsigned)(Rb * K + C) * 2u; }
    const size_t kstep = (size_t)(BK * 2);
    const size_t hstep = (size_t)HALF * K * 2;
    const unsigned ldsw = (unsigned)wid * 1024u;
    const int aoff = lds_byte(wr * 64 + fr, fq * 8), boff = lds_byte(wc * 32 + fr, fq * 8);
#define PG8_SA(b, h) (((b) * 2 + (h)) * HTB)
#define PG8_SB(b, h) ((4 + (b) * 2 + (h)) * HTB)
#define PG8_STAGE(bufoff, gbase, voff) do { _Pragma("unroll") for (int _i = 0; _i < 2; ++_i) \
        __builtin_amdgcn_global_load_lds((const unsigned*)((const char*)(gbase) + (voff)[_i]), (LAS unsigned*)(lds + (bufoff) + ldsw + _i * 8192), 16, 0, 0); } while (0)
#define PG8_LDA(dst, b, h) do { _Pragma("unroll") for (int m = 0; m < 4; ++m) _Pragma("unroll") for (int k = 0; k < 2; ++k) dst[m][k] = *(const LAS bf16x8*)(lds + PG8_SA(b, h) + aoff + m * 2048 + k * 1024); } while (0)
#define PG8_LDB(dst, b, h) do { _Pragma("unroll") for (int n = 0; n < 2; ++n) _Pragma("unroll") for (int k = 0; k < 2; ++k) dst[n][k] = *(const LAS bf16x8*)(lds + PG8_SB(b, h) + boff + n * 2048 + k * 1024); } while (0)
#define PG8_MMA(ai, bj, At, Bt) do { __builtin_amdgcn_s_setprio(1); _Pragma("unroll") for (int m = 0; m < 4; ++m) _Pragma("unroll") for (int n = 0; n < 2; ++n) _Pragma("unroll") for (int k = 0; k < 2; ++k) \
        acc[ai][bj][m][n] = __builtin_amdgcn_mfma_f32_16x16x32_bf16(Bt[n][k], At[m][k], acc[ai][bj][m][n], 0, 0, 0); __builtin_amdgcn_s_setprio(0); } while (0)
#define PG8_WAIT_V(n) asm volatile("s_waitcnt vmcnt(" #n ")" ::: "memory")
#define PG8_WAIT_L(n) asm volatile("s_waitcnt lgkmcnt(" #n ")" ::: "memory")
#define PG8_BAR __builtin_amdgcn_s_barrier()
#define PG8_SCHED __builtin_amdgcn_sched_barrier(0)
    Unit cur, nxt; int ui = 0;
    if (!S.next(0, cur)) return;
    f32x4 acc[2][2][4][2];
#pragma unroll
    for (int a = 0; a < 2; ++a)
#pragma unroll
        for (int b = 0; b < 2; ++b)
#pragma unroll
            for (int m = 0; m < 4; ++m)
#pragma unroll
                for (int n = 0; n < 2; ++n) acc[a][b][m][n] = (f32x4){0.f, 0.f, 0.f, 0.f};
    bf16x8 At[4][2], B0[2][2], B1[2][2];
    const char* cA = S.a_ptr(cur); const char* cB = S.b_ptr(cur);
    PG8_STAGE(PG8_SB(0, 0), cB, voffB); PG8_STAGE(PG8_SA(0, 0), cA, voffA); PG8_STAGE(PG8_SB(0, 1), cB + hstep, voffB); PG8_STAGE(PG8_SA(0, 1), cA + hstep, voffA);
    if (wr == 1) PG8_BAR;
    PG8_WAIT_V(4); PG8_BAR;
    PG8_STAGE(PG8_SB(1, 0), cB + kstep, voffB); PG8_STAGE(PG8_SA(1, 0), cA + kstep, voffA); PG8_STAGE(PG8_SB(1, 1), cB + hstep + kstep, voffB);
    PG8_WAIT_V(6); PG8_BAR;
    for (;;) {
        const bool has_next = S.next(ui + 1, nxt);
        const char* nA = has_next ? S.a_ptr(nxt) : cA; const char* nB = has_next ? S.b_ptr(nxt) : cB;
        for (int t = 0; t < nt; t += 2) {
            const bool last = (t == nt - 2);
            const char* a1 = cA + (size_t)(t + 1) * kstep;
            const char* a2 = last ? nA : cA + (size_t)(t + 2) * kstep; const char* b2 = last ? nB : cB + (size_t)(t + 2) * kstep;
            const char* a3 = a2 + kstep; const char* b3 = b2 + kstep;
            PG8_LDB(B0, 0, 0); PG8_SCHED; PG8_LDA(At, 0, 0); PG8_STAGE(PG8_SA(1, 1), a1 + hstep, voffA);
            PG8_WAIT_L(8); PG8_BAR; PG8_WAIT_L(0); PG8_MMA(0, 0, At, B0); PG8_BAR; PG8_SCHED;
            PG8_LDB(B1, 0, 1); PG8_STAGE(PG8_SB(0, 0), b2, voffB);
            PG8_BAR; PG8_WAIT_L(0); PG8_MMA(0, 1, At, B1); PG8_BAR;
            PG8_LDA(At, 0, 1); PG8_STAGE(PG8_SA(0, 0), a2, voffA);
            PG8_BAR; PG8_WAIT_L(0); PG8_MMA(1, 0, At, B0); PG8_BAR; PG8_SCHED;
            PG8_STAGE(PG8_SB(0, 1), b2 + hstep, voffB);
            PG8_WAIT_V(6); PG8_BAR; PG8_MMA(1, 1, At, B1); PG8_BAR;
            PG8_LDB(B0, 1, 0); PG8_SCHED; PG8_LDA(At, 1, 0); PG8_STAGE(PG8_SA(0, 1), a2 + hstep, voffA);
            PG8_WAIT_L(8); PG8_BAR; PG8_WAIT_L(0); PG8_MMA(0, 0, At, B0); PG8_BAR; PG8_SCHED;
            PG8_LDB(B1, 1, 1); PG8_STAGE(PG8_SB(1, 0), b3, voffB);
            PG8_BAR; PG8_WAIT_L(0); PG8_MMA(0, 1, At, B1); PG8_BAR;
            PG8_LDA(At, 1, 1); PG8_STAGE(PG8_SA(1, 0), a3, voffA);
            PG8_BAR; PG8_WAIT_L(0); PG8_MMA(1, 0, At, B0); PG8_BAR; PG8_SCHED;
            PG8_STAGE(PG8_SB(1, 1), b3 + hstep, voffB);
            PG8_WAIT_V(6); PG8_BAR; PG8_MMA(1, 1, At, B1); PG8_BAR;
        }
        E(acc, cur, wr, wc, fr, fq);
        if (!has_next) break;
#pragma unroll
        for (int a = 0; a < 2; ++a)
#pragma unroll
            for (int b = 0; b < 2; ++b)
#pragma unroll
                for (int m = 0; m < 4; ++m)
#pragma unroll
                    for (int n = 0; n < 2; ++n) acc[a][b][m][n] = (f32x4){0.f, 0.f, 0.f, 0.f};
        cur = nxt; cA = nA; cB = nB; ++ui;
    }
    PG8_WAIT_V(0);
    if (wr == 0) PG8_BAR;
    PG8_BAR;
#undef PG8_SA
#undef PG8_SB
#undef PG8_STAGE
#undef PG8_LDA
#undef PG8_LDB
#undef PG8_MMA
#undef PG8_WAIT_V
#undef PG8_WAIT_L
#undef PG8_BAR
#undef PG8_SCHED
}
}
using pg8::Unit;

struct SchedIn {
    pg8::OrderBase ob; int seg; const char* A; const char* B;
    __device__ bool next(int i, Unit& u) const { return ob.nextb(i, u); }
    __device__ const char* a_ptr(const Unit& u) const {
        const int gt = u.pm < LT_PROMPT ? ((u.pm / TPB) * (SEQ / 256) + seg * TPB + (u.pm % TPB)) : (XROWS / 256 + (u.pm - LT_PROMPT));
        return A + (size_t)gt * 256 * D * 2; }
    __device__ const char* b_ptr(const Unit& u) const { return B + (size_t)u.pn * 256 * D * 2; }
};
struct SchedAB {
    pg8::OrderBase ob; int pm0; const char* A0; const char* A1; const char* B0; const char* B1;
    __device__ bool next(int i, Unit& u) const { const bool ok = ob.nextb(i >> 1, u); u.pm += pm0; u.w = i & 1; return ok; }
    __device__ const char* a_ptr(const Unit& u) const { return (u.w ? A1 : A0) + (size_t)u.pm * 256 * D * 2; }
    __device__ const char* b_ptr(const Unit& u) const { return (u.w ? B1 : B0) + (size_t)u.pn * 256 * D * 2; }
};
struct SchedO {
    pg8::OrderBase ob; int pm0; const char* A; const char* B;
    __device__ bool next(int i, Unit& u) const { const bool ok = ob.nextb(i, u); u.pm += pm0; return ok; }
    __device__ const char* a_ptr(const Unit& u) const { return A + (size_t)u.pm * 256 * D * 2; }
    __device__ const char* b_ptr(const Unit& u) const { return B + (size_t)u.pn * 256 * D * 2; }
};

struct EpiIn {
    static constexpr bool PERM = true;
    bf16_t* P; bf16_t* gex; float* out; int seg;
    __device__ __forceinline__ void operator()(const f32x4 (&acc)[2][2][4][2], const Unit& u, int wr, int wc, int fr, int fq) const {
        const int lr0 = u.pm * 256 + wr * 64 + fr;
        const int c0 = u.pn * 256 + wc * 32 + 8 * fq;
#pragma unroll
        for (int ai = 0; ai < 2; ++ai)
#pragma unroll
            for (int m = 0; m < 4; ++m) {
                const int lr = lr0 + ai * 128 + m * 16;
                bf16_t* rowp;
                if (u.pn < NT_PB) rowp = P + (size_t)lr * NPB + c0;
                else if (lr < LEX0) { const int b = lr / SEGTOK; const size_t grow = (size_t)b * SEQ + seg * SEGTOK + (lr % SEGTOK); rowp = (bf16_t*)(out + O_YP + grow * D) + (c0 - NPB); }
                else rowp = gex + (size_t)(lr - LEX0) * 2048 + (c0 - NPB);
#pragma unroll
                for (int bj = 0; bj < 2; ++bj) { const f32x4 v0 = acc[ai][bj][m][0], v1 = acc[ai][bj][m][1];
                    u32x4 w; w.x = cvt_pk_bf16(v0[0], v0[1]); w.y = cvt_pk_bf16(v0[2], v0[3]); w.z = cvt_pk_bf16(v1[0], v1[1]); w.w = cvt_pk_bf16(v1[2], v1[3]);
                    *(u32x4*)(rowp + bj * 128) = w; }
            }
    }
};
struct EpiAB {
    static constexpr bool PERM = true;
    bf16_t* tmp; bf16_t* merged; const bf16_t* gex; const float* out;
    __device__ __forceinline__ void operator()(const f32x4 (&acc)[2][2][4][2], const Unit& u, int wr, int wc, int fr, int fq) const {
        const int row0 = u.pm * 256 + wr * 64 + fr, col0 = u.pn * 256 + wc * 32 + 8 * fq;
#pragma unroll
        for (int ai = 0; ai < 2; ++ai)
#pragma unroll
            for (int m = 0; m < 4; ++m) {
                const int grow = row0 + ai * 128 + m * 16;
                const bf16_t* gp = (grow < XROWS) ? ((const bf16_t*)(out + O_YP + (size_t)grow * D) + u.w * D) : (gex + (size_t)(grow - XROWS) * 2048 + u.w * D);
#pragma unroll
                for (int bj = 0; bj < 2; ++bj) {
                    const int c = col0 + bj * 128;
                    float g[8]; unpack8(*(const u32x4*)(gp + c), g);
                    const f32x4 v0 = acc[ai][bj][m][0], v1 = acc[ai][bj][m][1];
                    float v[8] = {v0[0] * sigm(g[0]), v0[1] * sigm(g[1]), v0[2] * sigm(g[2]), v0[3] * sigm(g[3]), v1[0] * sigm(g[4]), v1[1] * sigm(g[5]), v1[2] * sigm(g[6]), v1[3] * sigm(g[7])};
                    bf16_t* tp = tmp + (size_t)grow * D + c;
                    if (u.w == 0) *(u32x4*)tp = pack8(v);
                    else { float t[8]; unpack8(*(const u32x4*)tp, t);
#pragma unroll
                        for (int e = 0; e < 8; ++e) v[e] += t[e];
                        *(u32x4*)(merged + (size_t)grow * D + c) = pack8(v); }
                }
            }
    }
};
struct EpiO {
    static constexpr bool PERM = false;
    float* out; const float* xp; const float* xs;
    __device__ __forceinline__ void operator()(const f32x4 (&acc)[2][2][4][2], const Unit& u, int wr, int wc, int fr, int fq) const {
        const int row0 = u.pm * 256 + wr * 64 + fr, col0 = u.pn * 256 + wc * 32 + 4 * fq;
#pragma unroll
        for (int ai = 0; ai < 2; ++ai)
#pragma unroll
            for (int m = 0; m < 4; ++m) {
                const int grow = row0 + ai * 128 + m * 16;
                const float* xr; float* yr;
                if (grow < XROWS) { xr = xp + (size_t)grow * D; yr = out + O_YP + (size_t)grow * D; }
                else { const int e = grow - XROWS; if (e < EX_SAMP || e >= EX_SHIFT) continue; xr = xs + (size_t)(e - EX_SAMP) * D; yr = out + O_YS + (size_t)(e - EX_SAMP) * D; }
#pragma unroll
                for (int bj = 0; bj < 2; ++bj)
#pragma unroll
                    for (int n = 0; n < 2; ++n) { const int c = col0 + bj * 128 + n * 16; *(f32x4*)(yr + c) = *(const f32x4*)(xr + c) + acc[ai][bj][m][n]; }
            }
    }
};

__device__ __forceinline__ void p0_row(const Params& p, int r, int lane) {
    bf16_t* hrow = (bf16_t*)(p.ws + WS_H) + (size_t)r * D;
    const float* src = nullptr; bool norm = true; float* sh = nullptr;
    if (r < XROWS) { src = p.in[0] + (size_t)r * D; if ((r & (SEQ - 1)) == SEQ - 1) sh = p.out + O_SHIFT_P + (size_t)(r / SEQ) * D; }
    else { const int e = r - XROWS;
        if (e < EX_SAMP) src = p.in[6] + (size_t)e * D;
        else if (e < EX_SHIFT) { src = p.in[1] + (size_t)(e - EX_SAMP) * D; if (((e - EX_SAMP) & 3) == 3) sh = p.out + O_SHIFT_S + (size_t)((e - EX_SAMP) >> 2) * D; }
        else if (e < EX_END) { src = p.in[5] + (size_t)(e - EX_SHIFT) * D; norm = false; } }
    u32x2* o8 = (u32x2*)hrow + lane;
    if (!src) {
#pragma unroll
        for (int j = 0; j < 4; ++j) o8[64 * j] = (u32x2){0u, 0u};
        return; }
    const f32x4* xr = (const f32x4*)src + lane;
    f32x4 v[4]; float ss = 0.f;
#pragma unroll
    for (int j = 0; j < 4; ++j) { v[j] = xr[64 * j]; ss += v[j][0] * v[j][0] + v[j][1] * v[j][1] + v[j][2] * v[j][2] + v[j][3] * v[j][3]; }
    if (norm) {
        const float rs = __builtin_amdgcn_rsqf(wave_sum(ss) * (1.f / D) + 1e-6f);
        const f32x4* wr = (const f32x4*)p.in[7] + lane;
#pragma unroll
        for (int j = 0; j < 4; ++j) v[j] = v[j] * rs * wr[64 * j];
    }
#pragma unroll
    for (int j = 0; j < 4; ++j) { o8[64 * j] = (u32x2){pk2(v[j][0], v[j][1]), pk2(v[j][2], v[j][3])}; if (sh) ((f32x4*)sh)[lane + 64 * j] = v[j]; }
}
template <int MODE> __device__ __forceinline__ void p0_tr_item(const float* W, int N, bf16_t* WT, float* scr, int kb, int nb, int lane) {
    const int k0 = 64 * kb, n0 = 32 * nb;
    const int nn = n0 + (lane & 31);
    int srcc = nn;
    if (MODE == 1) srcc = nn < C_GATE_REF ? nn : (nn < NPB ? -1 : nn - (NPB - C_GATE_REF));
#pragma unroll 8
    for (int i = 0; i < 32; ++i) { const int kk = 2 * i + (lane >> 5); scr[kk * 33 + (lane & 31)] = srcc >= 0 ? W[(size_t)(k0 + kk) * N + srcc] : 0.f; }
    asm volatile("s_waitcnt lgkmcnt(0)" ::: "memory");
    const int c = lane & 7;
#pragma unroll
    for (int j = 0; j < 4; ++j) { const int n = (lane >> 3) + 8 * j; const float* s = scr + (8 * c) * 33 + n;
        u32x4 o; o.x = pk2(s[0 * 33], s[1 * 33]); o.y = pk2(s[2 * 33], s[3 * 33]); o.z = pk2(s[4 * 33], s[5 * 33]); o.w = pk2(s[6 * 33], s[7 * 33]);
        *(u32x4*)(WT + (size_t)(n0 + n) * D + k0 + 8 * c) = o; }
    asm volatile("s_waitcnt lgkmcnt(0)" ::: "memory");
}
__device__ __forceinline__ void phase0(const Params& p, unsigned char* smem) {
    const int tid0 = otid(), wave = tid0 >> 6, lane = tid0 & 63;
    const int gw = obid() * 8 + wave, NGW = gridDim.x * 8;
    float* scr = (float*)smem + wave * (64 * 33);
    constexpr int I_IN = 16 * (NP / 32), I_SQ = 16 * 32;
    for (int it = gw; it < I_IN + 3 * I_SQ; it += NGW) {
        int r = it;
        if (r < I_IN) { p0_tr_item<1>(p.in[8], 10384, (bf16_t*)(p.ws + WS_WT_IN), scr, r / (NP / 32), r % (NP / 32), lane); continue; } r -= I_IN;
        if (r < I_SQ) { p0_tr_item<0>(p.in[13], D, (bf16_t*)(p.ws + WS_WT_A), scr, r / 32, r % 32, lane); continue; } r -= I_SQ;
        if (r < I_SQ) { p0_tr_item<0>(p.in[24], D, (bf16_t*)(p.ws + WS_WT_B), scr, r / 32, r % 32, lane); continue; } r -= I_SQ;
        p0_tr_item<0>(p.in[25], D, (bf16_t*)(p.ws + WS_WT_O), scr, r / 32, r % 32, lane);
    }
    {
        const f32x4* lw = (const f32x4*)p.in[7] + lane;
        f32x4 wv[4];
#pragma unroll
        for (int j = 0; j < 4; ++j) wv[j] = lw[64 * j];
#pragma unroll 1
        for (int r = gw; r < XROWS; r += 2 * NGW) {
            const int r1 = r + NGW; const bool has1 = r1 < XROWS;
            const f32x4* x0 = (const f32x4*)(p.in[0] + (size_t)r * D) + lane; const f32x4* x1 = (const f32x4*)(p.in[0] + (size_t)(has1 ? r1 : r) * D) + lane;
            f32x4 a[4], b[4]; float s0 = 0.f, s1 = 0.f;
#pragma unroll
            for (int j = 0; j < 4; ++j) { a[j] = x0[64 * j]; b[j] = x1[64 * j]; }
#pragma unroll
            for (int j = 0; j < 4; ++j) { s0 += a[j][0] * a[j][0] + a[j][1] * a[j][1] + a[j][2] * a[j][2] + a[j][3] * a[j][3]; s1 += b[j][0] * b[j][0] + b[j][1] * b[j][1] + b[j][2] * b[j][2] + b[j][3] * b[j][3]; }
            const float q0 = __builtin_amdgcn_rsqf(wave_sum(s0) * (1.f / D) + 1e-6f), q1 = __builtin_amdgcn_rsqf(wave_sum(s1) * (1.f / D) + 1e-6f);
            u32x2* o0 = (u32x2*)((bf16_t*)(p.ws + WS_H) + (size_t)r * D) + lane; u32x2* o1 = (u32x2*)((bf16_t*)(p.ws + WS_H) + (size_t)r1 * D) + lane;
#pragma unroll
            for (int j = 0; j < 4; ++j) { a[j] = a[j] * q0 * wv[j]; o0[64 * j] = (u32x2){pk2(a[j][0], a[j][1]), pk2(a[j][2], a[j][3])}; }
            if ((r & (SEQ - 1)) == SEQ - 1) { f32x4* sh = (f32x4*)(p.out + O_SHIFT_P + (size_t)(r / SEQ) * D) + lane;
#pragma unroll
                for (int j = 0; j < 4; ++j) sh[64 * j] = a[j]; }
            if (has1) {
#pragma unroll
                for (int j = 0; j < 4; ++j) { b[j] = b[j] * q1 * wv[j]; o1[64 * j] = (u32x2){pk2(b[j][0], b[j][1]), pk2(b[j][2], b[j][3])}; }
                if ((r1 & (SEQ - 1)) == SEQ - 1) { f32x4* sh = (f32x4*)(p.out + O_SHIFT_P + (size_t)(r1 / SEQ) * D) + lane;
#pragma unroll
                    for (int j = 0; j < 4; ++j) sh[64 * j] = b[j]; }
            }
        }
    }
    for (int r = XROWS + gw; r < HROWS; r += NGW) p0_row(p, r, lane);
    {
        float* pk = (float*)(p.ws + WS_PK);
        const int gt = obid() * 512 + tid0, NT = gridDim.x * 512;
        for (int i = gt; i < PK_END; i += NT) {
            const float* src; int o;
            if (i < PK_ALOG) { src = p.in[9]; o = i - PK_CONVW; } else if (i < PK_DTB) { src = p.in[10]; o = i - PK_ALOG; } else if (i < PK_NORMW) { src = p.in[11]; o = i - PK_DTB; }
            else if (i < PK_MU) { src = p.in[12]; o = i - PK_NORMW; } else if (i < PK_W0) { src = p.in[14]; o = i - PK_MU; } else if (i < PK_W2) { src = p.in[15]; o = i - PK_W0; }
            else if (i < PK_A0) { src = p.in[16]; o = i - PK_W2; } else if (i < PK_A2) { src = p.in[17]; o = i - PK_A0; } else if (i < PK_KK) { src = p.in[18]; o = i - PK_A2; }
            else if (i < PK_KA) { src = p.in[19]; o = i - PK_KK; } else if (i < PK_RK) { src = p.in[20]; o = i - PK_KA; } else if (i < PK_GNW) { src = p.in[21]; o = i - PK_RK; }
            else if (i < PK_GNB) { src = p.in[22]; o = i - PK_GNW; } else if (i < PK_LNF) { src = p.in[23]; o = i - PK_GNB; } else { src = p.in[26]; o = i - PK_LNF; }
            pk[i] = src[o];
        }
        bf16_t* w2t = (bf16_t*)(p.ws + WS_W2T); bf16_t* a2t = (bf16_t*)(p.ws + WS_A2T);
        for (int i = gt; i < 65536; i += NT) { const int l = i & 63, c = (i >> 6) & 63, hb = i >> 12;
            w2t[i] = (bf16_t)f2bf(p.in[16][(size_t)l * D + hb * 64 + c]); a2t[i] = (bf16_t)f2bf(p.in[18][(size_t)l * D + hb * 64 + c]); }
    }
}

__device__ __forceinline__ void gdn_item(const Params& p, unsigned char* smem, const float* s_in, float* s_out, const float* halo_in, float* halo_out,
                                         int h, int sl, int rowA, int nA, int rowB, int nB) {
    const int tid = otid(), w = tid >> 6, lane = tid & 63, vl = lane >> 4, kg = lane & 15;
    float* qk_s = (float*)smem; float* v_s = qk_s + 16384; float* o_s = v_s + 2048; float* gb_s = o_s + 2048; float* sst = gb_s + 128;
    const bf16_t* P = (const bf16_t*)(p.ws + WS_P);
    float* ORAW = (float*)(p.ws + WS_ORAW);
    float s[8];
    if (s_in) {
        { const int k = tid >> 2, q4 = tid & 3; const f32x4* src = (const f32x4*)(s_in + (size_t)k * 128 + sl * 32 + q4 * 8); const f32x4 a = src[0], b = src[1];
          float* d = sst + k * 33 + q4 * 8; d[0] = a[0]; d[1] = a[1]; d[2] = a[2]; d[3] = a[3]; d[4] = b[0]; d[5] = b[1]; d[6] = b[2]; d[7] = b[3]; }
        __syncthreads();
#pragma unroll
        for (int j = 0; j < 8; ++j) s[j] = sst[(kg * 8 + j) * 33 + 4 * w + vl];
        __syncthreads();
    } else {
#pragma unroll
        for (int j = 0; j < 8; ++j) s[j] = 0.f;
    }
    int pcol = -1;
    if (tid < 128) pcol = h * 128 + tid; else if (tid < 256) pcol = 1024 + h * 128 + (tid - 128); else if (tid < 288) pcol = 2048 + h * 128 + sl * 32 + (tid - 256);
    float cw0 = 0.f, cw1 = 0.f, cw2 = 0.f, cw3 = 0.f, x1 = 0.f, x2 = 0.f, x3 = 0.f;
    const float* pk = (const float*)(p.ws + WS_PK);
    if (pcol >= 0) { const float* cw = pk + PK_CONVW; cw0 = cw[pcol]; cw1 = cw[3072 + pcol]; cw2 = cw[6144 + pcol]; cw3 = cw[9216 + pcol];
        if (halo_in) { x3 = halo_in[pcol]; x2 = halo_in[3072 + pcol]; x1 = halo_in[6144 + pcol]; } }
    const float nalog = -expf(pk[PK_ALOG + h]), dtb = pk[PK_DTB + h];
#pragma unroll 1
    for (int run = 0; run < 2; ++run) {
        const int rrow = run ? rowB : rowA, rn = run ? nB : nA; const bool wout = run != 0;
#pragma unroll 1
        for (int c0 = 0; c0 < rn; c0 += 64) {
            const int nt = (rn - c0) < 64 ? (rn - c0) : 64; const int row = rrow + c0;
            if (pcol >= 0) {
                const bf16_t* src = P + (size_t)row * NPB + pcol;
                float* dst = tid < 256 ? (qk_s + tid) : (v_s + (tid - 256)); const int dstride = tid < 256 ? 256 : 32;
#pragma unroll 8
                for (int i = 0; i < nt; ++i) { const float x0 = bf2f(src[(size_t)i * NPB]); const float y = cw0 * x3 + cw1 * x2 + cw2 * x1 + cw3 * x0; x3 = x2; x2 = x1; x1 = x0; dst[i * dstride] = silu_(y); }
            } else if (tid < 352) {
                const int i = tid - 288;
                if (i < nt) { const float pa = bf2f(P[(size_t)(row + i) * NPB + C_A + h]), pb = bf2f(P[(size_t)(row + i) * NPB + C_B + h]);
                    gb_s[2 * i] = expf(nalog * softplus_(pa + dtb)); gb_s[2 * i + 1] = sigm(pb); }
            }
            __syncthreads();
#pragma unroll 1
            for (int ii = 0; ii < 8; ++ii) { const int i = w * 8 + ii;
                if (i < nt) {
#pragma unroll
                    for (int which = 0; which < 2; ++which) { float* rp = qk_s + i * 256 + which * 128; const float a = rp[lane], b = rp[lane + 64];
                        const float sc = __builtin_amdgcn_rsqf(wave_sum(a * a + b * b) + 1e-6f) * (which == 0 ? 0.08838834764831845f : 1.f); rp[lane] = a * sc; rp[lane + 64] = b * sc; } } }
            __syncthreads();
#pragma unroll 1
            for (int i = 0; i < nt; ++i) {
                const f32x4 q0 = *(const f32x4*)(qk_s + i * 256 + kg * 8), q1 = *(const f32x4*)(qk_s + i * 256 + kg * 8 + 4);
                const f32x4 k0 = *(const f32x4*)(qk_s + i * 256 + 128 + kg * 8), k1 = *(const f32x4*)(qk_s + i * 256 + 128 + kg * 8 + 4);
                const float vv = v_s[i * 32 + 4 * w + vl], a = gb_s[2 * i], be = gb_s[2 * i + 1];
                float part = k0[0] * s[0] + k0[1] * s[1] + k0[2] * s[2] + k0[3] * s[3] + k1[0] * s[4] + k1[1] * s[5] + k1[2] * s[6] + k1[3] * s[7];
                const float kS = rowsum16(part);
                const float c = be * (vv - a * kS);
                s[0] = a * s[0] + k0[0] * c; s[1] = a * s[1] + k0[1] * c; s[2] = a * s[2] + k0[2] * c; s[3] = a * s[3] + k0[3] * c;
                s[4] = a * s[4] + k1[0] * c; s[5] = a * s[5] + k1[1] * c; s[6] = a * s[6] + k1[2] * c; s[7] = a * s[7] + k1[3] * c;
                float op = q0[0] * s[0] + q0[1] * s[1] + q0[2] * s[2] + q0[3] * s[3] + q1[0] * s[4] + q1[1] * s[5] + q1[2] * s[6] + q1[3] * s[7];
                const float o = rowsum16(op);
                if (kg == 0) o_s[i * 32 + 4 * w + vl] = o;
            }
            __syncthreads();
            if (wout) { const int i = tid >> 3, c4 = (tid & 7) * 4; if (i < nt) *(f32x4*)(ORAW + (size_t)(row + i) * D + h * 128 + sl * 32 + c4) = *(const f32x4*)(o_s + i * 32 + c4); }
        }
    }
    if (pcol >= 0 && (sl == 0 || tid >= 256)) { halo_out[pcol] = x3; halo_out[3072 + pcol] = x2; halo_out[6144 + pcol] = x1; }
#pragma unroll
    for (int j = 0; j < 8; ++j) sst[(kg * 8 + j) * 33 + 4 * w + vl] = s[j];
    __syncthreads();
    { const int k = tid >> 2, q4 = tid & 3; const float* d = sst + k * 33 + q4 * 8; f32x4* dst = (f32x4*)(s_out + (size_t)k * 128 + sl * 32 + q4 * 8);
      dst[0] = (f32x4){d[0], d[1], d[2], d[3]}; dst[1] = (f32x4){d[4], d[5], d[6], d[7]}; }
    __syncthreads();
}

constexpr int RW_W2 = 20544, RW_A2 = 24640;
__device__ __forceinline__ void rwkv_load_lora(const Params& p, unsigned char* smem, int hb) {
    float* w2_s = (float*)smem + RW_W2; float* a2_s = (float*)smem + RW_A2; const float* pk = (const float*)(p.ws + WS_PK);
    for (int i = otid(); i < 4096; i += 512) { const int l = i >> 6, c = i & 63; w2_s[i] = pk[PK_W2 + l * D + hb * 64 + c]; a2_s[i] = pk[PK_A2 + l * D + hb * 64 + c]; }
    __syncthreads();
}
__device__ __forceinline__ void rwkv_item(const Params& p, unsigned char* smem, const float* s_in, float* s_out, const bf16_t* prev_row, const float* halo_in, float* halo_out,
                                          int hb, int half, int rowA, int nA, int rowB, int nB) {
    const int tid = otid(), w = tid >> 6, lane = tid & 63, row = tid >> 4, kq = tid & 15;
    float* f = (float*)smem;
    float* r_s = f; float* kb_s = f + 2048; float* v_s = f + 4096; float* wd_s = f + 6144; float* ad_s = f + 8192; float* dec_s = f + 10240; float* a_s = f + 12288;
    float* kk_s = f + 14336; float* km_s = f + 16384; float* zb_s = f + 18432; float* y_s = f + 19456; float* bonus_s = f + 20480;
    const float* w2_s = f + RW_W2; const float* a2_s = f + RW_A2;
    const bf16_t* P = (const bf16_t*)(p.ws + WS_P);
    float* YRAW = (float*)(p.ws + WS_YRAW); bf16_t* C0 = (bf16_t*)(p.ws + WS_C0); bf16_t* C1 = (bf16_t*)(p.ws + WS_C1);
    float s[4];
    if (s_in) { const f32x4 t = *(const f32x4*)(s_in + (size_t)(half * 32 + row) * 64 + kq * 4); s[0] = t[0]; s[1] = t[1]; s[2] = t[2]; s[3] = t[3]; }
    else { s[0] = s[1] = s[2] = s[3] = 0.f; }
    int col = -1; float* dst = nullptr; int dstride = 64; bool is_wd = false, owner = false;
    if (tid < 64) { col = hb * 64 + tid; dst = r_s + tid; owner = half == 0; }
    else if (tid < 128) { col = 1024 + hb * 64 + (tid - 64); dst = kb_s + (tid - 64); owner = half == 0; }
    else if (tid < 192) { col = 2048 + hb * 64 + (tid - 128); dst = v_s + (tid - 128); owner = half == 0; }
    else if (tid < 256) { col = 3072 + (tid - 192); dst = wd_s + (tid - 192); is_wd = true; owner = (half == 0 && hb == 0); }
    else if (tid < 320) { col = 3136 + (tid - 256); dst = ad_s + (tid - 256); owner = (half == 0 && hb == 0); }
    else if (tid < 352) { col = 3200 + hb * 64 + half * 32 + (tid - 320); dst = zb_s + (tid - 320); dstride = 32; owner = true; }
    float mu = 0.f, prev = 0.f;
    const float* pk = (const float*)(p.ws + WS_PK);
    if (col >= 0) { mu = pk[PK_MU + col]; prev = prev_row ? bf2f(prev_row[C_RW + col]) : (halo_in ? halo_in[col] : 0.f); }
    const int cc = tid & 63, ig = tid >> 6;
    const int hc = hb * 64 + cc;
    const float w0c = pk[PK_W0 + hc], a0c = pk[PK_A0 + hc], kkc = pk[PK_KK + hc], kac = pk[PK_KA + hc];
    const float rkl = pk[PK_RK + hb * 64 + lane];
#pragma unroll 1
    for (int run = 0; run < 2; ++run) {
        const int rrow = run ? rowB : rowA, rn = run ? nB : nA; const bool wout = run != 0;
#pragma unroll 1
        for (int c0 = 0; c0 < rn; c0 += 32) {
            const int nt = (rn - c0) < 32 ? (rn - c0) : 32; const int row0 = rrow + c0;
            if (col >= 0) {
                const bf16_t* src = P + (size_t)row0 * NPB + C_RW + col;
#pragma unroll 8
                for (int i = 0; i < nt; ++i) { const float cur = bf2f(src[(size_t)i * NPB]); float m = cur + mu * (prev - cur); prev = cur; if (is_wd) m = tanh_(m); dst[i * dstride] = m; }
            }
            __syncthreads();
            {
                float aw[4] = {0.f, 0.f, 0.f, 0.f}, aa[4] = {0.f, 0.f, 0.f, 0.f};
#pragma unroll 4
                for (int l = 0; l < 64; ++l) { const float w2v = w2_s[l * 64 + cc], a2v = a2_s[l * 64 + cc];
#pragma unroll
                    for (int ii = 0; ii < 4; ++ii) { aw[ii] += wd_s[(ig * 4 + ii) * 64 + l] * w2v; aa[ii] += ad_s[(ig * 4 + ii) * 64 + l] * a2v; } }
#pragma unroll
                for (int ii = 0; ii < 4; ++ii) { const int i = ig * 4 + ii;
                    if (i < nt) { const float wraw = w0c + aw[ii]; const float wlog = -0.6065306597126334f * sigm(wraw); const float a = sigm(a0c + aa[ii]);
                        const float kbv = kb_s[i * 64 + cc];
                        dec_s[i * 64 + cc] = expf(wlog); a_s[i * 64 + cc] = a; kk_s[i * 64 + cc] = kbv * kkc; km_s[i * 64 + cc] = kbv * (1.f + (a - 1.f) * kac); } }
            }
            __syncthreads();
#pragma unroll 1
            for (int ii = 0; ii < 4; ++ii) { const int i = w * 4 + ii;
                if (i < nt) { const float kkr = kk_s[i * 64 + lane]; const float kk = kkr * __builtin_amdgcn_rsqf(wave_sum(kkr * kkr) + 1e-6f); kk_s[i * 64 + lane] = kk;
                    const float a = a_s[i * 64 + lane]; a_s[i * 64 + lane] = kk * a;
                    const float rk = wave_sum(r_s[i * 64 + lane] * km_s[i * 64 + lane] * rkl); if (lane == 0) bonus_s[i] = rk; } }
            __syncthreads();
#pragma unroll 1
            for (int i = 0; i < nt; ++i) {
                const f32x4 kk4 = *(const f32x4*)(kk_s + i * 64 + kq * 4), de4 = *(const f32x4*)(dec_s + i * 64 + kq * 4), ka4 = *(const f32x4*)(a_s + i * 64 + kq * 4),
                            km4 = *(const f32x4*)(km_s + i * 64 + kq * 4), r4 = *(const f32x4*)(r_s + i * 64 + kq * 4);
                const float vv = v_s[i * 64 + half * 32 + row];
                const float sa = rowsum16(s[0] * kk4[0] + s[1] * kk4[1] + s[2] * kk4[2] + s[3] * kk4[3]);
#pragma unroll
                for (int j = 0; j < 4; ++j) s[j] = s[j] * de4[j] + (vv * km4[j] - sa * ka4[j]);
                const float y = rowsum16(s[0] * r4[0] + s[1] * r4[1] + s[2] * r4[2] + s[3] * r4[3]);
                if (kq == 0) y_s[i * 32 + row] = y;
            }
            __syncthreads();
            if (wout) { const int i = tid >> 4;
                if (i < nt) {
#pragma unroll
                    for (int q = 0; q < 2; ++q) { const int rr = (tid & 15) * 2 + q, v = half * 32 + rr, colo = hb * 64 + v;
                        const float sz = silu_(zb_s[i * 32 + rr]);
                        const size_t o = (size_t)(row0 + i) * D + colo;
                        YRAW[o] = y_s[i * 32 + rr]; C1[o] = (bf16_t)f2bf(pk[PK_GNW + colo] * sz); C0[o] = (bf16_t)f2bf((pk[PK_GNB + colo] + bonus_s[i] * v_s[i * 64 + v]) * sz); } } }
            __syncthreads();
        }
    }
    *(f32x4*)(s_out + (size_t)(half * 32 + row) * 64 + kq * 4) = (f32x4){s[0], s[1], s[2], s[3]};
    if (col >= 0 && owner && halo_out) halo_out[col] = prev;
}


__device__ __forceinline__ bf16x8 ldfrag(const bf16_t* base, int stride, int r0, int k0, int lane) {
    return *(const bf16x8*)(base + (r0 + (lane & 15)) * stride + k0 + 8 * (lane >> 4));
}
#define MFMA16(a, b, c) __builtin_amdgcn_mfma_f32_16x16x32_bf16((a), (b), (c), 0, 0, 0)
typedef short s16x4 __attribute__((ext_vector_type(4)));
__device__ __forceinline__ bf16x8 ldfrag_tr(const bf16_t* X, int stride, int c0, int k0, int lane) {
    const int l15 = lane & 15;
    const bf16_t* a = X + (k0 + 8 * (lane >> 4) + (l15 >> 2)) * stride + c0 + 4 * (l15 & 3);
    const s16x4 lo = __builtin_amdgcn_ds_read_tr16_b64_v4i16((LAS s16x4*)a), hi = __builtin_amdgcn_ds_read_tr16_b64_v4i16((LAS s16x4*)(a + 4 * stride));
    return __builtin_shufflevector(lo, hi, 0, 1, 2, 3, 4, 5, 6, 7);
}
__device__ __forceinline__ void inv_block(const float* L, float* Tm, float* XS, int tid) {
    const int w = tid >> 6, lane = tid & 63;
    if (w < 4 && lane < 16) {
        const float* Lb = L + (16 * w) * 64 + 16 * w; float* Tb = Tm + (16 * w) * 64 + 16 * w;
        float tr[16];
#pragma unroll
        for (int i = 0; i < 16; ++i) { float a = (lane == i) ? 1.f : 0.f;
#pragma unroll
            for (int j = 0; j < i; ++j) a -= Lb[i * 64 + j] * tr[j];
            tr[i] = a; Tb[i * 64 + lane] = a; }
    }
    for (int e = tid; e < 1536; e += 512) { const int k = e >> 8, r = (e >> 4) & 15, c = e & 15;
        const int rb = k < 3 ? 0 : (k < 5 ? 1 : 2), cb = k < 3 ? k + 1 : (k < 5 ? k - 1 : 3);
        Tm[(16 * rb + r) * 64 + 16 * cb + c] = 0.f; }
    __syncthreads();
    {
        const int B = tid >> 8, i = (tid >> 4) & 15, c = tid & 15, o = 32 * B;
        float x = 0.f;
#pragma unroll
        for (int j = 0; j < 16; ++j) x += L[(o + 16 + i) * 64 + o + j] * Tm[(o + j) * 64 + o + c];
        XS[tid] = x;
        __syncthreads();
        float t = 0.f;
#pragma unroll
        for (int j = 0; j < 16; ++j) t += Tm[(o + 16 + i) * 64 + o + 16 + j] * XS[(B << 8) + j * 16 + c];
        Tm[(o + 16 + i) * 64 + o + c] = -t;
    }
    __syncthreads();
    {
        const int i = tid >> 4, c2 = (tid & 15) * 2;
        float x0 = 0.f, x1 = 0.f;
#pragma unroll 8
        for (int j = 0; j < 32; ++j) { const float l = L[(32 + i) * 64 + j]; x0 += l * Tm[j * 64 + c2]; x1 += l * Tm[j * 64 + c2 + 1]; }
        XS[i * 32 + c2] = x0; XS[i * 32 + c2 + 1] = x1;
        __syncthreads();
        float t0 = 0.f, t1 = 0.f;
#pragma unroll 8
        for (int j = 0; j < 32; ++j) { const float tv = Tm[(32 + i) * 64 + 32 + j]; t0 += tv * XS[j * 32 + c2]; t1 += tv * XS[j * 32 + c2 + 1]; }
        Tm[(32 + i) * 64 + c2] = -t0; Tm[(32 + i) * 64 + c2 + 1] = -t1;
    }
    __syncthreads();
}
constexpr int PL_QS = 0, PL_R1 = 17408, PL_KT = 35840, PL_KTT = 54272, PL_VT = 72704, PL_R3 = 91136, PL_QKM = 109568, PL_TP = 118784, PL_TPP = 128000, PL_SM = 137216, PL_TM = 139264, PL_XS = 155648;
constexpr int QSTR = 136, TSTR = 72;

__device__ __forceinline__ void gdn_prep_item(const Params& p, unsigned char* smem, int h, int row_start, int npad, const bf16_t* hbase,
                                              bf16_t* halo_out, float* conv_out, unsigned char* rec) {
    const int tid = otid(), w = tid >> 6, lane = tid & 63, q4 = lane >> 4, l15 = lane & 15;
    bf16_t* qs = (bf16_t*)(smem + PL_QS); bf16_t* ks = (bf16_t*)(smem + PL_R1); bf16_t* WT = ks; bf16_t* kts = (bf16_t*)(smem + PL_KT);
    bf16_t* vs = (bf16_t*)(smem + PL_VT);         float* Lm = (float*)(smem + PL_R3); bf16_t* UT = (bf16_t*)(smem + PL_R3); bf16_t* QKm = (bf16_t*)(smem + PL_QKM);
    bf16_t* Tp = (bf16_t*)(smem + PL_TP); bf16_t* Tpp = (bf16_t*)(smem + PL_TPP);
    float* sm = (float*)(smem + PL_SM);
    float* gcs = sm; float* bes = sm + 64; float* ssq = sm + 128; float* ssk = sm + 192; float* egs = sm + 256; float* egl_s = sm + 320; float* beg = sm + 384;
    const bf16_t* P = (const bf16_t*)(p.ws + WS_P);
    const float* pk = (const float*)(p.ws + WS_PK);
    if (npad == 0) {
        const int t = tid >> 3, g = tid & 7;
        const bf16_t* zp = P + (size_t)(row_start + t) * NPB + C_Z + h * 128 + 16 * g;
        const u32x4 z0 = *(const u32x4*)zp, z1 = *(const u32x4*)(zp + 8);
        float za[8], zb[8]; unpack8(z0, za); unpack8(z1, zb);
        const float* nwp = pk + PK_NORMW + 16 * g;
        float ga[8], gb2[8];
#pragma unroll
        for (int e = 0; e < 8; ++e) { ga[e] = nwp[e] * silu_(za[e]); gb2[e] = nwp[8 + e] * silu_(zb[e]); }
        bf16_t* gp = (bf16_t*)(rec + GP_G) + t * 128 + 16 * g;
        *(u32x4*)gp = pack8(ga); *(u32x4*)(gp + 8) = pack8(gb2);
    }
    if (w == 7) {
        const int i = lane;
        float g = 0.f, be = 0.f;
        if (i >= npad) { const size_t r = (size_t)(row_start + i - npad) * NPB; const float pa = bf2f(P[r + C_A + h]), pb = bf2f(P[r + C_B + h]);
            g = -expf(pk[PK_ALOG + h]) * softplus_(pa + pk[PK_DTB + h]); be = sigm(pb); }
        float x = g;
#pragma unroll
        for (int o = 1; o < 64; o <<= 1) { const float y = __shfl_up(x, o); if (lane >= o) x += y; }
        const float gl = __shfl(x, 63);
        gcs[lane] = x; bes[lane] = be; egs[lane] = __expf(x); egl_s[lane] = __expf(gl - x); beg[lane] = be * __expf(x);
        if (lane == 0) *(float*)(rec + GP_EGL) = __expf(gl);
    }
    __syncthreads();
    if (tid < 384) {
        const int sec = tid >> 7, ts = (tid >> 4) & 7, t0 = 8 * ts, d0 = l15 * 8;
        const int pcol = sec * 1024 + h * 128 + d0;
        float cw[4][8];
#pragma unroll
        for (int j = 0; j < 4; ++j) { const f32x4 a = *(const f32x4*)(pk + PK_CONVW + j * 3072 + pcol), b = *(const f32x4*)(pk + PK_CONVW + j * 3072 + pcol + 4);
            cw[j][0] = a[0]; cw[j][1] = a[1]; cw[j][2] = a[2]; cw[j][3] = a[3]; cw[j][4] = b[0]; cw[j][5] = b[1]; cw[j][6] = b[2]; cw[j][7] = b[3]; }
        u32x4 rw[11]; float fv[11];
#pragma unroll
        for (int k = 0; k < 11; ++k) {
            const int ii = t0 - 3 + k;
            const bf16_t* ptr = P + pcol; float f = 0.f;
            if (ii >= npad) { ptr = P + (size_t)(row_start + ii - npad) * NPB + pcol; f = 1.f; }
            else if (ii < 0 && npad == 0 && hbase) { ptr = hbase + (size_t)(ii + 3) * NPB + pcol; f = 1.f; }
            rw[k] = *(const u32x4*)ptr; fv[k] = f;
        }
        if (halo_out && ts == 7) {
#pragma unroll
            for (int dd = 0; dd < 3; ++dd) { *(u32x4*)(halo_out + (size_t)dd * NPB + pcol) = rw[8 + dd];
                if (conv_out) { float x[8]; unpack8(rw[8 + dd], x); *(f32x4*)(conv_out + dd * 3072 + pcol) = (f32x4){x[0], x[1], x[2], x[3]}; *(f32x4*)(conv_out + dd * 3072 + pcol + 4) = (f32x4){x[4], x[5], x[6], x[7]}; } }
        }
        float y[8][8];
#pragma unroll
        for (int t = 0; t < 8; ++t)
#pragma unroll
            for (int e = 0; e < 8; ++e) y[t][e] = 0.f;
#pragma unroll
        for (int k = 0; k < 11; ++k) { float x[8]; unpack8(rw[k], x);
#pragma unroll
            for (int e = 0; e < 8; ++e) x[e] *= fv[k];
#pragma unroll
            for (int dlt = 0; dlt < 4; ++dlt) { const int t = k - dlt;
                if (t >= 0 && t < 8) {
#pragma unroll
                    for (int e = 0; e < 8; ++e) y[t][e] += cw[dlt][e] * x[e]; } }
        }
        const float qsc = sec == 0 ? 0.08838834764831845f : 1.f;
#pragma unroll
        for (int t = 0; t < 8; ++t) {
            const bool tokv = (t0 + t) >= npad;
            float ss = 0.f;
#pragma unroll
            for (int e = 0; e < 8; ++e) { y[t][e] = tokv ? silu_(y[t][e]) : 0.f; ss += y[t][e] * y[t][e]; }
            if (sec < 2) { const float sc = __builtin_amdgcn_rsqf(rowsum16(ss) + 1e-6f) * qsc;
#pragma unroll
                for (int e = 0; e < 8; ++e) y[t][e] *= sc; }
        }
        { bf16_t* dst = sec == 0 ? qs : (sec == 1 ? ks : vs);
#pragma unroll
            for (int t = 0; t < 8; ++t) *(u32x4*)(dst + (t0 + t) * QSTR + d0) = pack8(y[t]); }
        if (sec == 1) {
#pragma unroll
            for (int t = 0; t < 8; ++t) { const float eg = egl_s[t0 + t]; float z[8];
#pragma unroll
                for (int e = 0; e < 8; ++e) z[e] = y[t][e] * eg;
                *(u32x4*)(kts + (t0 + t) * QSTR + d0) = pack8(z); } }
    }
    __syncthreads();
    {
        const int which = w >> 2, it = w & 3;
        const bf16_t* Barr = which ? qs : ks;
        bf16x8 bfr[4];
#pragma unroll
        for (int kk = 0; kk < 4; ++kk) bfr[kk] = ldfrag(Barr, QSTR, 16 * it, 32 * kk, lane);
        const int i = 16 * it + l15; const float gi = gcs[i], bi = bes[i];
#pragma unroll
        for (int jt = 0; jt < 4; ++jt) {
            f32x4 acc = {0.f, 0.f, 0.f, 0.f};
#pragma unroll
            for (int kk = 0; kk < 4; ++kk) acc = MFMA16(ldfrag(ks, QSTR, 16 * jt, 32 * kk, lane), bfr[kk], acc);
            const int j0 = 16 * jt + 4 * q4; const f32x4 gj = *(const f32x4*)(gcs + j0);
            f32x4 o;
#pragma unroll
            for (int r = 0; r < 4; ++r) { const int j = j0 + r; const bool keep = which ? (i >= j) : (i > j); o[r] = keep ? acc[r] * __expf(gi - gj[r]) : 0.f; }
            if (which == 0) *(f32x4*)(Lm + i * 64 + j0) = o * bi;
            else *(u32x2*)(QKm + i * TSTR + j0) = (u32x2){pk2(o[0], o[1]), pk2(o[2], o[3])};
        }
    }
    __syncthreads();
    {
        float* Tm = (float*)(smem + PL_TM);
        inv_block(Lm, Tm, (float*)(smem + PL_XS), tid);
        const int i = tid >> 3, j0 = (tid & 7) * 8;
        float a[8], b2[8];
#pragma unroll
        for (int e = 0; e < 8; ++e) { const float tv = Tm[i * 64 + j0 + e]; a[e] = tv * beg[j0 + e]; b2[e] = tv * bes[j0 + e]; }
        *(u32x4*)(Tp + i * TSTR + j0) = (u32x4){pk2(a[0], a[1]), pk2(a[2], a[3]), pk2(a[4], a[5]), pk2(a[6], a[7])};
        *(u32x4*)(Tpp + i * TSTR + j0) = (u32x4){pk2(b2[0], b2[1]), pk2(b2[2], b2[3]), pk2(b2[4], b2[5]), pk2(b2[6], b2[7])};
    }
    __syncthreads();
    {
        const int it = w & 3, half = w >> 2;
        f32x4 aw[4], au[4];
#pragma unroll
        for (int x = 0; x < 4; ++x) { aw[x] = (f32x4){0.f, 0.f, 0.f, 0.f}; au[x] = (f32x4){0.f, 0.f, 0.f, 0.f}; }
#pragma unroll
        for (int kk = 0; kk < 2; ++kk) {
            const bf16x8 a1 = ldfrag(Tp, TSTR, 16 * it, 32 * kk, lane), a2 = ldfrag(Tpp, TSTR, 16 * it, 32 * kk, lane);
#pragma unroll
            for (int x = 0; x < 4; ++x) { const int dt = half * 4 + x;
                aw[x] = MFMA16(a1, ldfrag_tr(ks, QSTR, 16 * dt, 32 * kk, lane), aw[x]);
                au[x] = MFMA16(a2, ldfrag_tr(vs, QSTR, 16 * dt, 32 * kk, lane), au[x]); }
        }
        __syncthreads();
#pragma unroll
        for (int x = 0; x < 4; ++x) { const int d = 16 * (half * 4 + x) + l15, i0 = 16 * it + 4 * q4;
            *(u32x2*)(WT + d * TSTR + i0) = (u32x2){pk2(aw[x][0], aw[x][1]), pk2(aw[x][2], aw[x][3])};
            *(u32x2*)(UT + d * TSTR + i0) = (u32x2){pk2(au[x][0], au[x][1]), pk2(au[x][2], au[x][3])}; }
    }
    __syncthreads();
    {
        bf16_t* gAP = (bf16_t*)(rec + GP_AP); bf16_t* gQH = (bf16_t*)(rec + GP_QH); bf16_t* gKH = (bf16_t*)(rec + GP_KH); bf16_t* gOH = (bf16_t*)(rec + GP_OH);
        {
            const int et = w;
            const bf16x8 a0 = ldfrag(WT, TSTR, 16 * et, 0, lane), a1 = ldfrag(WT, TSTR, 16 * et, 32, lane);
#pragma unroll
            for (int dt = 0; dt < 8; ++dt) { f32x4 acc = {0.f, 0.f, 0.f, 0.f};
                acc = MFMA16(a0, ldfrag_tr(kts, QSTR, 16 * dt, 0, lane), acc); acc = MFMA16(a1, ldfrag_tr(kts, QSTR, 16 * dt, 32, lane), acc);
                *(u32x2*)(gAP + ((size_t)(dt * 4 + (et >> 1)) * 64 + lane) * 8 + (et & 1) * 4) = (u32x2){pk2(-acc[0], -acc[1]), pk2(-acc[2], -acc[3])}; }
#pragma unroll
            for (int tt = 0; tt < 4; ++tt) { f32x4 acc = {0.f, 0.f, 0.f, 0.f};
                acc = MFMA16(a0, ldfrag(QKm, TSTR, 16 * tt, 0, lane), acc); acc = MFMA16(a1, ldfrag(QKm, TSTR, 16 * tt, 32, lane), acc);
                const int t = 16 * tt + l15, e0 = 16 * et + 4 * q4; const float eg = egs[t];
                const u32x2 qq = *(const u32x2*)(qs + t * QSTR + e0);
                const float o0 = __uint_as_float(qq.x << 16) * eg - acc[0], o1 = __uint_as_float(qq.x & 0xffff0000u) * eg - acc[1],
                            o2 = __uint_as_float(qq.y << 16) * eg - acc[2], o3 = __uint_as_float(qq.y & 0xffff0000u) * eg - acc[3];
                *(u32x2*)(gQH + ((size_t)(tt * 4 + (et >> 1)) * 64 + lane) * 8 + (et & 1) * 4) = (u32x2){pk2(o0, o1), pk2(o2, o3)}; }
        }
        {
            const int dt = w;
            const bf16x8 a0 = ldfrag_tr(kts, QSTR, 16 * dt, 0, lane), a1 = ldfrag_tr(kts, QSTR, 16 * dt, 32, lane);
#pragma unroll
            for (int vt = 0; vt < 8; ++vt) { f32x4 acc = {0.f, 0.f, 0.f, 0.f};
                acc = MFMA16(a0, ldfrag(UT, TSTR, 16 * vt, 0, lane), acc); acc = MFMA16(a1, ldfrag(UT, TSTR, 16 * vt, 32, lane), acc);
                *(u32x2*)(gKH + ((size_t)(vt * 8 + dt) * 64 + lane) * 4) = (u32x2){pk2(acc[0], acc[1]), pk2(acc[2], acc[3])}; }
            const int tt = w & 3, vh = w >> 2;
            const bf16x8 b0 = ldfrag(QKm, TSTR, 16 * tt, 0, lane), b1 = ldfrag(QKm, TSTR, 16 * tt, 32, lane);
#pragma unroll
            for (int x = 0; x < 4; ++x) { const int vt = vh * 4 + x; f32x4 acc = {0.f, 0.f, 0.f, 0.f};
                acc = MFMA16(b0, ldfrag(UT, TSTR, 16 * vt, 0, lane), acc); acc = MFMA16(b1, ldfrag(UT, TSTR, 16 * vt, 32, lane), acc);
                *(u32x2*)(gOH + ((size_t)(vt * 4 + tt) * 64 + lane) * 4) = (u32x2){pk2(acc[0], acc[1]), pk2(acc[2], acc[3])}; }
        }
    }
    __syncthreads();
}

__device__ __forceinline__ void phase_gprep(const Params& p, int seg, unsigned char* smem) {
    const int blk = obid();
    const int n_items = (CPS + (seg == 0 ? 1 : 0)) * 64;
#pragma unroll 1
    for (int it = blk; it < n_items; it += gridDim.x) {
        const int bh = it & 63, b = bh >> 3, h = bh & 7; int cl = it >> 6; if (seg != 0) cl += 1;
        unsigned char* rec = p.ws + WS_GP + (size_t)(cl * 64 + bh) * GP_STRIDE;
        const bf16_t* Pb = (const bf16_t*)(p.ws + WS_P);
        bf16_t* chalo2 = (bf16_t*)(p.ws + WS_CHALO);
        if (cl == 0) gdn_prep_item(p, smem, h, LEX0, 48, nullptr, nullptr, nullptr, rec);
        else {
            const int row = b * SEGTOK + (cl - 1) * 64;
            const bf16_t* hbase = Pb + (size_t)(row - 3) * NPB;
            if (cl == 1) hbase = (seg == 0) ? Pb + (size_t)(LEX0 + NMETA - 3) * NPB : chalo2 + (size_t)(((seg - 1) & 1) * NBATCH + b) * 3 * NPB;
            bf16_t* ho = (cl == CPS) ? chalo2 + (size_t)((seg & 1) * NBATCH + b) * 3 * NPB : nullptr;
            float* co = (cl == CPS && seg == NSEG - 1) ? p.out + O_CONV_P + (size_t)b * 9216 : nullptr;
            gdn_prep_item(p, smem, h, row, 0, hbase, ho, co, rec);
        }
    }
}

__device__ __forceinline__ void gdn_scan_block(const Params& p, int seg, unsigned char* smem, int bh) {
    const int tid = otid(), w = tid >> 6, lane = tid & 63, q4 = lane >> 4, l15 = lane & 15;
    const int b = bh >> 3, h = bh & 7;
    float* st = p.out + O_GDN_P + (size_t)bh * 16384;
    f32x4 S[8];
    if (seg) {
#pragma unroll
        for (int mt = 0; mt < 8; ++mt)
#pragma unroll
            for (int r = 0; r < 4; ++r) S[mt][r] = st[(size_t)(16 * mt + 4 * q4 + r) * 128 + 16 * w + l15];
    } else {
#pragma unroll
        for (int mt = 0; mt < 8; ++mt) S[mt] = (f32x4){0.f, 0.f, 0.f, 0.f};
    }
    const int c_lo = seg ? 1 : 0;
    float* obuf = (float*)(smem + 98304);
    {
        const u32x4* src = (const u32x4*)(p.ws + WS_GP + (size_t)(c_lo * 64 + bh) * GP_STRIDE); u32x4* dst = (u32x4*)smem;
#pragma unroll
        for (int x = 0; x < 6; ++x) dst[tid + 512 * x] = src[tid + 512 * x];
    }
#pragma unroll 1
    for (int cl = c_lo; cl <= CPS; ++cl) {
        const unsigned char* rec = p.ws + WS_GP + (size_t)(cl * 64 + bh) * GP_STRIDE;
        const int cur = (cl - c_lo) & 1;
        __syncthreads();
        u32x4 nx[6];
        const bool more = cl < CPS;
        if (more) { const u32x4* src = (const u32x4*)(rec + GP_STRIDE * 64);
#pragma unroll
            for (int x = 0; x < 6; ++x) nx[x] = src[tid + 512 * x]; }
        const bf16_t* gKH = (const bf16_t*)(rec + GP_KH); const bf16_t* gOH = (const bf16_t*)(rec + GP_OH);
        u32x2 kh[8], oh[4];
#pragma unroll
        for (int mt = 0; mt < 8; ++mt) kh[mt] = *(const u32x2*)(gKH + ((size_t)(w * 8 + mt) * 64 + lane) * 4);
#pragma unroll
        for (int tt = 0; tt < 4; ++tt) oh[tt] = *(const u32x2*)(gOH + ((size_t)(w * 4 + tt) * 64 + lane) * 4);
        const float egl = *(const float*)(rec + GP_EGL);
        const int et = tid >> 3, eg = tid & 7;
        const bf16_t* gp = (const bf16_t*)(rec + GP_G) + et * 128 + 16 * eg;
        u32x4 z0 = {0u, 0u, 0u, 0u}, z1 = {0u, 0u, 0u, 0u};
        if (cl > 0) { z0 = *(const u32x4*)gp; z1 = *(const u32x4*)(gp + 8); }
        bf16x8 Bf[4];
#pragma unroll
        for (int ks = 0; ks < 4; ++ks) { u32x4 t; t.x = pk2(S[2 * ks][0], S[2 * ks][1]); t.y = pk2(S[2 * ks][2], S[2 * ks][3]); t.z = pk2(S[2 * ks + 1][0], S[2 * ks + 1][1]); t.w = pk2(S[2 * ks + 1][2], S[2 * ks + 1][3]);
            Bf[ks] = __builtin_bit_cast(bf16x8, t); }
        const bf16x8* AP = (const bf16x8*)(smem + cur * 49152); const bf16x8* QH = (const bf16x8*)(smem + cur * 49152 + GP_QH);
        f32x4 o[4], tS[8];
#pragma unroll
        for (int tt = 0; tt < 4; ++tt) { o[tt] = (f32x4){0.f, 0.f, 0.f, 0.f};
#pragma unroll
            for (int ks = 0; ks < 4; ++ks) o[tt] = MFMA16(QH[(tt * 4 + ks) * 64 + lane], Bf[ks], o[tt]); }
#pragma unroll
        for (int mt = 0; mt < 8; ++mt) { tS[mt] = (f32x4){0.f, 0.f, 0.f, 0.f};
#pragma unroll
            for (int ks = 0; ks < 4; ++ks) tS[mt] = MFMA16(AP[(mt * 4 + ks) * 64 + lane], Bf[ks], tS[mt]); }
#pragma unroll
        for (int mt = 0; mt < 8; ++mt) {
            S[mt][0] = egl * S[mt][0] + tS[mt][0] + __uint_as_float(kh[mt].x << 16); S[mt][1] = egl * S[mt][1] + tS[mt][1] + __uint_as_float(kh[mt].x & 0xffff0000u);
            S[mt][2] = egl * S[mt][2] + tS[mt][2] + __uint_as_float(kh[mt].y << 16); S[mt][3] = egl * S[mt][3] + tS[mt][3] + __uint_as_float(kh[mt].y & 0xffff0000u); }
        if (cl > 0) {
#pragma unroll
            for (int tt = 0; tt < 4; ++tt) {
                o[tt][0] += __uint_as_float(oh[tt].x << 16); o[tt][1] += __uint_as_float(oh[tt].x & 0xffff0000u); o[tt][2] += __uint_as_float(oh[tt].y << 16); o[tt][3] += __uint_as_float(oh[tt].y & 0xffff0000u);
#pragma unroll
                for (int r = 0; r < 4; ++r) obuf[(16 * tt + 4 * q4 + r) * 132 + 16 * w + l15] = o[tt][r]; }
        }
        if (more) { u32x4* dst = (u32x4*)(smem + (cur ^ 1) * 49152);
#pragma unroll
            for (int x = 0; x < 6; ++x) dst[tid + 512 * x] = nx[x]; }
        if (cl > 0) {
            __syncthreads();
            f32x4 ov[4]; float ss = 0.f;
#pragma unroll
            for (int j = 0; j < 4; ++j) { ov[j] = *(const f32x4*)(obuf + et * 132 + 16 * eg + 4 * j); ss += ov[j][0] * ov[j][0] + ov[j][1] * ov[j][1] + ov[j][2] * ov[j][2] + ov[j][3] * ov[j][3]; }
            ss += __shfl_xor(ss, 1); ss += __shfl_xor(ss, 2); ss += __shfl_xor(ss, 4);
            const float rs = __builtin_amdgcn_rsqf(ss * (1.f / 128.f) + 1e-6f);
            const unsigned zz[8] = {z0.x, z0.y, z0.z, z0.w, z1.x, z1.y, z1.z, z1.w};
            unsigned ow[8];
#pragma unroll
            for (int j = 0; j < 8; ++j) ow[j] = pk2(ov[j >> 1][(j & 1) * 2] * rs * __uint_as_float(zz[j] << 16), ov[j >> 1][(j & 1) * 2 + 1] * rs * __uint_as_float(zz[j] & 0xffff0000u));
            const size_t grow = (size_t)b * SEQ + seg * SEGTOK + (cl - 1) * 64 + et;
            bf16_t* oa = (bf16_t*)(p.ws + WS_H) + grow * D + h * 128 + 16 * eg;
            *(u32x4*)oa = (u32x4){ow[0], ow[1], ow[2], ow[3]}; *(u32x4*)(oa + 8) = (u32x4){ow[4], ow[5], ow[6], ow[7]};
        }
    }
#pragma unroll
    for (int mt = 0; mt < 8; ++mt)
#pragma unroll
        for (int r = 0; r < 4; ++r) st[(size_t)(16 * mt + 4 * q4 + r) * 128 + 16 * w + l15] = S[mt][r];
    __syncthreads();
}

constexpr int RL_AT = 0, RL_BT = 9216, RL_KT = 18432, RL_ATT = 27648, RL_RT = 36864, RL_BTLT = 46080, RL_KTLT = 55296, RL_VT = 64512, RL_LAK = 73728, RL_MRB = 82944, RL_MRK = 92160,
              RL_LM = 101376, RL_AF = 117760, RL_TM = 134144, RL_XS = 150528;
__device__ __forceinline__ void rwkv_prep_item(const Params& p, unsigned char* smem, int hb, int row_start, int npad, const bf16_t* prev_row,
                                               bf16_t* halo_out, unsigned char* rec) {
    const int tid = otid(), w = tid >> 6, lane = tid & 63, q4 = lane >> 4, l15 = lane & 15;
    bf16_t* At = (bf16_t*)(smem + RL_AT); bf16_t* Tb = At; bf16_t* Bt = (bf16_t*)(smem + RL_BT); bf16_t* WaT = Bt; bf16_t* Kt = (bf16_t*)(smem + RL_KT); bf16_t* XT = Kt;
    bf16_t* At2 = (bf16_t*)(smem + RL_ATT); bf16_t* Rt = (bf16_t*)(smem + RL_RT); bf16_t* Btl = (bf16_t*)(smem + RL_BTLT); bf16_t* Ktl = (bf16_t*)(smem + RL_KTLT);
    bf16_t* Vr = (bf16_t*)(smem + RL_VT);        bf16_t* Lak = (bf16_t*)(smem + RL_LAK); bf16_t* Mrb = (bf16_t*)(smem + RL_MRB); bf16_t* Mrk = (bf16_t*)(smem + RL_MRK);
    float* Lm = (float*)(smem + RL_LM);
    bf16_t* thw = Lak; bf16_t* adb = Mrb; float* lc = Lm; float* af = (float*)(smem + RL_AF);
    const bf16_t* P = (const bf16_t*)(p.ws + WS_P);
    const float* pk = (const float*)(p.ws + WS_PK);
    const int t = tid >> 3, g = tid & 7;
    float rr[8], kb[8], vv[8], zb[8];
    {
        const bool real = t >= npad;
        const bf16_t* curp = P; const bf16_t* prevp = P; float fprev = 0.f;
        if (real) { curp = P + (size_t)(row_start + t - npad) * NPB; if (t > npad) { prevp = curp - NPB; fprev = 1.f; } else if (prev_row) { prevp = prev_row; fprev = 1.f; } }
        const int secbase[6] = {0, 1024, 2048, 3200, 3072, 3136};
        u32x4 rc[6], rp[6];
#pragma unroll
        for (int sidx = 0; sidx < 6; ++sidx) { const int col = secbase[sidx] + (sidx < 4 ? hb * 64 : 0) + g * 8; rc[sidx] = *(const u32x4*)(curp + C_RW + col); rp[sidx] = *(const u32x4*)(prevp + C_RW + col); }
        float m[6][8];
#pragma unroll
        for (int sidx = 0; sidx < 6; ++sidx) {
            const int col = secbase[sidx] + (sidx < 4 ? hb * 64 : 0) + g * 8;
            float cur[8], prv[8];
            unpack8(rc[sidx], cur); unpack8(rp[sidx], prv);
            const f32x4 mu0 = *(const f32x4*)(pk + PK_MU + col), mu1 = *(const f32x4*)(pk + PK_MU + col + 4);
            const float mu[8] = {mu0[0], mu0[1], mu0[2], mu0[3], mu1[0], mu1[1], mu1[2], mu1[3]};
#pragma unroll
            for (int e = 0; e < 8; ++e) m[sidx][e] = real ? cur[e] + mu[e] * (fprev * prv[e] - cur[e]) : 0.f;
            if (halo_out && t == 63 && (sidx < 4 || hb == 0)) *(u32x4*)(halo_out + C_RW + col) = rc[sidx];
        }
#pragma unroll
        for (int e = 0; e < 8; ++e) { rr[e] = m[0][e]; kb[e] = m[1][e]; vv[e] = m[2][e]; zb[e] = m[3][e]; }
        float th[8];
#pragma unroll
        for (int e = 0; e < 8; ++e) th[e] = tanh_(m[4][e]);
        *(u32x4*)(thw + t * TSTR + g * 8) = pack8(th);
        *(u32x4*)(adb + t * TSTR + g * 8) = pack8(m[5]);
    }
    __syncthreads();
    {
        const int which = w >> 2, ct = w & 3;
        const bf16_t* Wt = (const bf16_t*)(p.ws + (which ? WS_A2T : WS_W2T)) + (size_t)hb * 4096;
        const bf16x8 b0 = *(const bf16x8*)(Wt + (16 * ct + l15) * 64 + 8 * q4), b1 = *(const bf16x8*)(Wt + (16 * ct + l15) * 64 + 32 + 8 * q4);
        const bf16_t* Aarr = which ? adb : thw;
        const int c = 16 * ct + l15;
        const float bias = pk[(which ? PK_A0 : PK_W0) + hb * 64 + c];
        float carry = 0.f;
#pragma unroll
        for (int tt = 0; tt < 4; ++tt) {
            f32x4 acc = {0.f, 0.f, 0.f, 0.f};
            acc = MFMA16(ldfrag(Aarr, TSTR, 16 * tt, 0, lane), b0, acc); acc = MFMA16(ldfrag(Aarr, TSTR, 16 * tt, 32, lane), b1, acc);
            if (which) {
#pragma unroll
                for (int r = 0; r < 4; ++r) af[(16 * tt + 4 * q4 + r) * 64 + c] = sigm(bias + acc[r]);
            } else {
                float wl[4];
#pragma unroll
                for (int r = 0; r < 4; ++r) { const int tk = 16 * tt + 4 * q4 + r; wl[r] = (tk < npad) ? 0.f : -0.6065306597126334f * sigm(bias + acc[r]); }
                wl[1] += wl[0]; wl[2] += wl[1]; wl[3] += wl[2];
                const float Q = wl[3];
                const float Q0 = __shfl(Q, l15), Q1 = __shfl(Q, l15 + 16), Q2 = __shfl(Q, l15 + 32), Q3 = __shfl(Q, l15 + 48);
                const float ex = carry + (q4 > 0 ? Q0 : 0.f) + (q4 > 1 ? Q1 : 0.f) + (q4 > 2 ? Q2 : 0.f);
#pragma unroll
                for (int r = 0; r < 4; ++r) lc[(16 * tt + 4 * q4 + r) * 64 + c] = ex + wl[r];
                carry += Q0 + Q1 + Q2 + Q3;
            }
        }
    }
    __syncthreads();
    {
        float lct[8], lcp[8], lcC[8], av[8];
        { const f32x4 a = *(const f32x4*)(lc + t * 64 + g * 8), b2 = *(const f32x4*)(lc + t * 64 + g * 8 + 4); lct[0] = a[0]; lct[1] = a[1]; lct[2] = a[2]; lct[3] = a[3]; lct[4] = b2[0]; lct[5] = b2[1]; lct[6] = b2[2]; lct[7] = b2[3]; }
        if (t > 0) { const f32x4 a = *(const f32x4*)(lc + (t - 1) * 64 + g * 8), b2 = *(const f32x4*)(lc + (t - 1) * 64 + g * 8 + 4); lcp[0] = a[0]; lcp[1] = a[1]; lcp[2] = a[2]; lcp[3] = a[3]; lcp[4] = b2[0]; lcp[5] = b2[1]; lcp[6] = b2[2]; lcp[7] = b2[3]; }
        else {
#pragma unroll
            for (int e = 0; e < 8; ++e) lcp[e] = 0.f; }
        { const f32x4 a = *(const f32x4*)(lc + 63 * 64 + g * 8), b2 = *(const f32x4*)(lc + 63 * 64 + g * 8 + 4); lcC[0] = a[0]; lcC[1] = a[1]; lcC[2] = a[2]; lcC[3] = a[3]; lcC[4] = b2[0]; lcC[5] = b2[1]; lcC[6] = b2[2]; lcC[7] = b2[3]; }
        { const f32x4 a = *(const f32x4*)(af + t * 64 + g * 8), b2 = *(const f32x4*)(af + t * 64 + g * 8 + 4); av[0] = a[0]; av[1] = a[1]; av[2] = a[2]; av[3] = a[3]; av[4] = b2[0]; av[5] = b2[1]; av[6] = b2[2]; av[7] = b2[3]; }
        const int hc = hb * 64 + g * 8;
        float kk[8], km[8], ss = 0.f, rk = 0.f;
#pragma unroll
        for (int e = 0; e < 8; ++e) { kk[e] = kb[e] * pk[PK_KK + hc + e]; ss += kk[e] * kk[e]; km[e] = kb[e] * (1.f + (av[e] - 1.f) * pk[PK_KA + hc + e]); rk += rr[e] * km[e] * pk[PK_RK + hc + e]; }
        ss += __shfl_xor(ss, 1); ss += __shfl_xor(ss, 2); ss += __shfl_xor(ss, 4);
        rk += __shfl_xor(rk, 1); rk += __shfl_xor(rk, 2); rk += __shfl_xor(rk, 4);
        const float kn = __builtin_amdgcn_rsqf(ss + 1e-6f);
        float xa[8], xb[8], xk[8], xr[8], xbt[8], xkt[8];
#pragma unroll
        for (int e = 0; e < 8; ++e) { kk[e] *= kn; const float ka = kk[e] * av[e]; const float ip = __expf(-lct[e]), tl = __expf(lcC[e] - lct[e]);
            xa[e] = kk[e] * __expf(lcp[e]); xb[e] = ka * ip; xk[e] = km[e] * ip; xr[e] = rr[e] * __expf(lct[e]); xbt[e] = ka * tl; xkt[e] = km[e] * tl; }
        *(u32x4*)(At + t * TSTR + g * 8) = pack8(xa); *(u32x4*)(Bt + t * TSTR + g * 8) = pack8(xb); *(u32x4*)(Kt + t * TSTR + g * 8) = pack8(xk); *(u32x4*)(Rt + t * TSTR + g * 8) = pack8(xr);
        *(u32x4*)(At2 + t * TSTR + g * 8) = pack8(xa); *(u32x4*)(Btl + t * TSTR + g * 8) = pack8(xbt); *(u32x4*)(Ktl + t * TSTR + g * 8) = pack8(xkt); *(u32x4*)(Vr + t * TSTR + g * 8) = pack8(vv);
        float c1[8], c0[8];
#pragma unroll
        for (int e = 0; e < 8; ++e) { const float sz = silu_(zb[e]); c1[e] = pk[PK_GNW + hc + e] * sz; c0[e] = (pk[PK_GNB + hc + e] + rk * vv[e]) * sz; }
        *(u32x4*)((bf16_t*)(rec + RP_C1) + t * 64 + g * 8) = pack8(c1); *(u32x4*)((bf16_t*)(rec + RP_C0) + t * 64 + g * 8) = pack8(c0);
        if (t == 63) { float* pc = (float*)(rec + RP_PC) + g * 8; *(f32x4*)pc = (f32x4){__expf(lcC[0]), __expf(lcC[1]), __expf(lcC[2]), __expf(lcC[3])}; *(f32x4*)(pc + 4) = (f32x4){__expf(lcC[4]), __expf(lcC[5]), __expf(lcC[6]), __expf(lcC[7])}; }
    }
    __syncthreads();
    {
        const int pr = w >> 1;
        const bf16_t* Aarr = pr < 2 ? At : Rt; const bf16_t* Barr = (pr & 1) ? Kt : Bt;
#pragma unroll
        for (int x = 0; x < 2; ++x) { const int tt = 2 * (w & 1) + x;
            const bf16x8 a0 = ldfrag(Aarr, TSTR, 16 * tt, 0, lane), a1 = ldfrag(Aarr, TSTR, 16 * tt, 32, lane);
            const int tk = 16 * tt + l15;
#pragma unroll
            for (int it = 0; it < 4; ++it) { f32x4 acc = {0.f, 0.f, 0.f, 0.f};
                acc = MFMA16(ldfrag(Barr, TSTR, 16 * it, 0, lane), a0, acc); acc = MFMA16(ldfrag(Barr, TSTR, 16 * it, 32, lane), a1, acc);
                const int i0 = 16 * it + 4 * q4;
                f32x4 o;
#pragma unroll
                for (int r = 0; r < 4; ++r) { const int i = i0 + r; const bool keep = pr < 2 ? (tk > i) : (tk >= i); o[r] = keep ? acc[r] : 0.f; }
                if (pr == 0) *(f32x4*)(Lm + tk * 64 + i0) = o;
                else { bf16_t* Out = pr == 1 ? Lak : (pr == 2 ? Mrb : Mrk); *(u32x2*)(Out + tk * TSTR + i0) = (u32x2){pk2(o[0], o[1]), pk2(o[2], o[3])}; } }
        }
    }
    __syncthreads();
    {
        float* Tm = (float*)(smem + RL_TM);
        inv_block(Lm, Tm, (float*)(smem + RL_XS), tid);
        const int i = tid >> 3, j0 = (tid & 7) * 8;
        float a[8];
#pragma unroll
        for (int e = 0; e < 8; ++e) a[e] = Tm[i * 64 + j0 + e];
        *(u32x4*)(Tb + i * TSTR + j0) = pack8(a);
    }
    __syncthreads();
    {
        const int tt = w & 3, which = w >> 2;
        const bf16_t* Aarr = which ? Lak : Tb; const bf16_t* Barr = which ? Vr : At2; bf16_t* Out = which ? XT : WaT;
        const bf16x8 a0 = ldfrag(Aarr, TSTR, 16 * tt, 0, lane), a1 = ldfrag(Aarr, TSTR, 16 * tt, 32, lane);
#pragma unroll
        for (int ct = 0; ct < 4; ++ct) { f32x4 acc = {0.f, 0.f, 0.f, 0.f};
            acc = MFMA16(a0, ldfrag_tr(Barr, TSTR, 16 * ct, 0, lane), acc); acc = MFMA16(a1, ldfrag_tr(Barr, TSTR, 16 * ct, 32, lane), acc);
            *(u32x2*)(Out + (16 * ct + l15) * TSTR + 16 * tt + 4 * q4) = (u32x2){pk2(acc[0], acc[1]), pk2(acc[2], acc[3])}; }
    }
    __syncthreads();
    {
        f32x4 acc[4];
        if (w < 4) {
            const bf16x8 a0 = ldfrag(Tb, TSTR, 16 * w, 0, lane), a1 = ldfrag(Tb, TSTR, 16 * w, 32, lane);
#pragma unroll
            for (int ct = 0; ct < 4; ++ct) { acc[ct] = (f32x4){0.f, 0.f, 0.f, 0.f};
                acc[ct] = MFMA16(a0, ldfrag(XT, TSTR, 16 * ct, 0, lane), acc[ct]); acc[ct] = MFMA16(a1, ldfrag(XT, TSTR, 16 * ct, 32, lane), acc[ct]); }
        }
        __syncthreads();
        if (w < 4) {
#pragma unroll
            for (int ct = 0; ct < 4; ++ct) *(u32x2*)(XT + (16 * ct + l15) * TSTR + 16 * w + 4 * q4) = (u32x2){pk2(-acc[ct][0], -acc[ct][1]), pk2(-acc[ct][2], -acc[ct][3])};
        }
    }
    __syncthreads();
    {
        const bf16_t* UvT = XT;
        bf16_t* gAP = (bf16_t*)(rec + RP_AP); bf16_t* gRH = (bf16_t*)(rec + RP_RH); bf16_t* gKH = (bf16_t*)(rec + RP_KH); bf16_t* gYH = (bf16_t*)(rec + RP_YH);
        const int et = w & 3, part = w >> 2;
        {
            const bf16x8 a0 = ldfrag(WaT, TSTR, 16 * et, 0, lane), a1 = ldfrag(WaT, TSTR, 16 * et, 32, lane);
            if (part == 0) {
#pragma unroll
                for (int kt = 0; kt < 4; ++kt) { f32x4 acc = {0.f, 0.f, 0.f, 0.f};
                    acc = MFMA16(a0, ldfrag_tr(Btl, TSTR, 16 * kt, 0, lane), acc); acc = MFMA16(a1, ldfrag_tr(Btl, TSTR, 16 * kt, 32, lane), acc);
                    *(u32x2*)(gAP + ((size_t)(kt * 2 + (et >> 1)) * 64 + lane) * 8 + (et & 1) * 4) = (u32x2){pk2(-acc[0], -acc[1]), pk2(-acc[2], -acc[3])}; }
            } else {
#pragma unroll
                for (int tt = 0; tt < 4; ++tt) { f32x4 acc = {0.f, 0.f, 0.f, 0.f};
                    acc = MFMA16(a0, ldfrag(Mrb, TSTR, 16 * tt, 0, lane), acc); acc = MFMA16(a1, ldfrag(Mrb, TSTR, 16 * tt, 32, lane), acc);
                    const int tk = 16 * tt + l15, e0 = 16 * et + 4 * q4;
                    const u32x2 q2 = *(const u32x2*)(Rt + tk * TSTR + e0);
                    const float o0 = __uint_as_float(q2.x << 16) - acc[0], o1 = __uint_as_float(q2.x & 0xffff0000u) - acc[1], o2 = __uint_as_float(q2.y << 16) - acc[2], o3 = __uint_as_float(q2.y & 0xffff0000u) - acc[3];
                    *(u32x2*)(gRH + ((size_t)(tt * 2 + (et >> 1)) * 64 + lane) * 8 + (et & 1) * 4) = (u32x2){pk2(o0, o1), pk2(o2, o3)}; }
            }
        }
        {
            const int rt = w & 3;
            bf16_t* Out = part ? gKH : gYH;
            bf16x8 a0, a1, a2, a3;
            if (part) { a0 = ldfrag_tr(Btl, TSTR, 16 * rt, 0, lane); a1 = ldfrag_tr(Btl, TSTR, 16 * rt, 32, lane); a2 = ldfrag_tr(Ktl, TSTR, 16 * rt, 0, lane); a3 = ldfrag_tr(Ktl, TSTR, 16 * rt, 32, lane); }
            else { a0 = ldfrag(Mrb, TSTR, 16 * rt, 0, lane); a1 = ldfrag(Mrb, TSTR, 16 * rt, 32, lane); a2 = ldfrag(Mrk, TSTR, 16 * rt, 0, lane); a3 = ldfrag(Mrk, TSTR, 16 * rt, 32, lane); }
#pragma unroll
            for (int vt = 0; vt < 4; ++vt) { f32x4 acc = {0.f, 0.f, 0.f, 0.f};
                acc = MFMA16(a0, ldfrag(UvT, TSTR, 16 * vt, 0, lane), acc); acc = MFMA16(a1, ldfrag(UvT, TSTR, 16 * vt, 32, lane), acc);
                acc = MFMA16(a2, ldfrag_tr(Vr, TSTR, 16 * vt, 0, lane), acc); acc = MFMA16(a3, ldfrag_tr(Vr, TSTR, 16 * vt, 32, lane), acc);
                *(u32x2*)(Out + ((size_t)(vt * 4 + rt) * 64 + lane) * 4) = (u32x2){pk2(acc[0], acc[1]), pk2(acc[2], acc[3])}; }
        }
    }
    __syncthreads();
}

__device__ __forceinline__ void phase_rprep(const Params& p, int seg, unsigned char* smem) {
    const int blk = obid();
    const int n_items = (CPS + (seg == 0 ? 1 : 0)) * 128;
#pragma unroll 1
    for (int it = (blk + (gridDim.x >> 1)) % gridDim.x; it < n_items; it += gridDim.x) {
        const int bh = it & 127, b = bh >> 4, hb = bh & 15; int cl = it >> 7; if (seg != 0) cl += 1;
        unsigned char* rec = p.ws + WS_RP + (size_t)(cl * 128 + bh) * RP_STRIDE;
        const bf16_t* Pb = (const bf16_t*)(p.ws + WS_P);
        bf16_t* phalo2 = (bf16_t*)(p.ws + WS_PHALO);
        if (cl == 0) rwkv_prep_item(p, smem, hb, LEX0, 48, nullptr, nullptr, rec);
        else {
            const int row = b * SEGTOK + (cl - 1) * 64;
            const bf16_t* prow = Pb + (size_t)(row - 1) * NPB;
            if (cl == 1) prow = (seg == 0) ? Pb + (size_t)(LEX0 + NMETA - 1) * NPB : phalo2 + (size_t)(((seg - 1) & 1) * NBATCH + b) * NPB;
            bf16_t* ho = (cl == CPS) ? phalo2 + (size_t)((seg & 1) * NBATCH + b) * NPB : nullptr;
            rwkv_prep_item(p, smem, hb, row, 0, prow, ho, rec);
        }
    }
}

__device__ __forceinline__ void rwkv_scan_block(const Params& p, int seg, unsigned char* smem, int pairidx) {
    const int tid = otid(), w = tid >> 6, lane = tid & 63, q4 = lane >> 4, l15 = lane & 15;
    const int hsel = w >> 2, vt = w & 3;
    const int bh = pairidx * 2 + hsel, b = bh >> 4, hb = bh & 15;
    float* st = p.out + O_RWKV_P + (size_t)bh * 4096;
    f32x4 S[4];
    if (seg) {
#pragma unroll
        for (int mt = 0; mt < 4; ++mt) S[mt] = *(const f32x4*)(st + (size_t)(16 * vt + l15) * 64 + 16 * mt + 4 * q4);
    } else {
#pragma unroll
        for (int mt = 0; mt < 4; ++mt) S[mt] = (f32x4){0.f, 0.f, 0.f, 0.f};
    }
    const int c_lo = seg ? 1 : 0;
    float* ybuf = (float*)(smem + 65536) + hsel * (64 * 68);
    const int tl = tid & 255;
    {
        const u32x4* src = (const u32x4*)(p.ws + WS_RP + (size_t)(c_lo * 128 + bh) * RP_STRIDE); u32x4* dst = (u32x4*)(smem + hsel * 16384);
#pragma unroll
        for (int x = 0; x < 4; ++x) dst[tl + 256 * x] = src[tl + 256 * x];
    }
#pragma unroll 1
    for (int cl = c_lo; cl <= CPS; ++cl) {
        const unsigned char* rec = p.ws + WS_RP + (size_t)(cl * 128 + bh) * RP_STRIDE;
        const int cur = (cl - c_lo) & 1;
        __syncthreads();
        u32x4 nx[4];
        const bool more = cl < CPS;
        if (more) { const u32x4* src = (const u32x4*)(rec + (size_t)RP_STRIDE * 128);
#pragma unroll
            for (int x = 0; x < 4; ++x) nx[x] = src[tl + 256 * x]; }
        const bf16_t* gKH = (const bf16_t*)(rec + RP_KH); const bf16_t* gYH = (const bf16_t*)(rec + RP_YH);
        u32x2 kh[4], yh[4]; f32x4 pc[4];
#pragma unroll
        for (int mt = 0; mt < 4; ++mt) { kh[mt] = *(const u32x2*)(gKH + ((size_t)(vt * 4 + mt) * 64 + lane) * 4); yh[mt] = *(const u32x2*)(gYH + ((size_t)(vt * 4 + mt) * 64 + lane) * 4);
            pc[mt] = *(const f32x4*)((const float*)(rec + RP_PC) + 16 * mt + 4 * q4); }
        const int tk = tl >> 2, g = tl & 3;
        u32x4 a0 = {0u, 0u, 0u, 0u}, a1 = a0, b0 = a0, b1 = a0;
        if (cl > 0) { const bf16_t* c1p = (const bf16_t*)(rec + RP_C1) + tk * 64 + 16 * g; const bf16_t* c0p = (const bf16_t*)(rec + RP_C0) + tk * 64 + 16 * g;
            a0 = *(const u32x4*)c0p; a1 = *(const u32x4*)(c0p + 8); b0 = *(const u32x4*)c1p; b1 = *(const u32x4*)(c1p + 8); }
        bf16x8 Bf[2];
#pragma unroll
        for (int ks = 0; ks < 2; ++ks) { u32x4 tq; tq.x = pk2(S[2 * ks][0], S[2 * ks][1]); tq.y = pk2(S[2 * ks][2], S[2 * ks][3]); tq.z = pk2(S[2 * ks + 1][0], S[2 * ks + 1][1]); tq.w = pk2(S[2 * ks + 1][2], S[2 * ks + 1][3]);
            Bf[ks] = __builtin_bit_cast(bf16x8, tq); }
        const bf16x8* AP = (const bf16x8*)(smem + cur * 32768 + hsel * 16384); const bf16x8* RH = (const bf16x8*)(smem + cur * 32768 + hsel * 16384 + RP_RH);
        f32x4 y[4], tS[4];
#pragma unroll
        for (int tt = 0; tt < 4; ++tt) { y[tt] = (f32x4){0.f, 0.f, 0.f, 0.f}; y[tt] = MFMA16(RH[(tt * 2 + 0) * 64 + lane], Bf[0], y[tt]); y[tt] = MFMA16(RH[(tt * 2 + 1) * 64 + lane], Bf[1], y[tt]); }
#pragma unroll
        for (int mt = 0; mt < 4; ++mt) { tS[mt] = (f32x4){0.f, 0.f, 0.f, 0.f}; tS[mt] = MFMA16(AP[(mt * 2 + 0) * 64 + lane], Bf[0], tS[mt]); tS[mt] = MFMA16(AP[(mt * 2 + 1) * 64 + lane], Bf[1], tS[mt]); }
#pragma unroll
        for (int mt = 0; mt < 4; ++mt) {
            S[mt][0] = pc[mt][0] * S[mt][0] + tS[mt][0] + __uint_as_float(kh[mt].x << 16); S[mt][1] = pc[mt][1] * S[mt][1] + tS[mt][1] + __uint_as_float(kh[mt].x & 0xffff0000u);
            S[mt][2] = pc[mt][2] * S[mt][2] + tS[mt][2] + __uint_as_float(kh[mt].y << 16); S[mt][3] = pc[mt][3] * S[mt][3] + tS[mt][3] + __uint_as_float(kh[mt].y & 0xffff0000u); }
        if (cl > 0) {
#pragma unroll
            for (int tt = 0; tt < 4; ++tt) {
                y[tt][0] += __uint_as_float(yh[tt].x << 16); y[tt][1] += __uint_as_float(yh[tt].x & 0xffff0000u); y[tt][2] += __uint_as_float(yh[tt].y << 16); y[tt][3] += __uint_as_float(yh[tt].y & 0xffff0000u);
#pragma unroll
                for (int r = 0; r < 4; ++r) ybuf[(16 * tt + 4 * q4 + r) * 68 + 16 * vt + l15] = y[tt][r]; }
        }
        if (more) { u32x4* dst = (u32x4*)(smem + (cur ^ 1) * 32768 + hsel * 16384);
#pragma unroll
            for (int x = 0; x < 4; ++x) dst[tl + 256 * x] = nx[x]; }
        if (cl > 0) {
            __syncthreads();
            f32x4 yv[4]; float sm = 0.f;
#pragma unroll
            for (int j = 0; j < 4; ++j) { yv[j] = *(const f32x4*)(ybuf + tk * 68 + 16 * g + 4 * j); sm += yv[j][0] + yv[j][1] + yv[j][2] + yv[j][3]; }
            sm += __shfl_xor(sm, 1); sm += __shfl_xor(sm, 2);
            const float mu = sm * (1.f / 64.f); float vs = 0.f;
#pragma unroll
            for (int j = 0; j < 4; ++j) { yv[j] = yv[j] - mu; vs += yv[j][0] * yv[j][0] + yv[j][1] * yv[j][1] + yv[j][2] * yv[j][2] + yv[j][3] * yv[j][3]; }
            vs += __shfl_xor(vs, 1); vs += __shfl_xor(vs, 2);
            const float rs = __builtin_amdgcn_rsqf(vs * (1.f / 64.f) + 64e-5f);
            const unsigned c0w[8] = {a0.x, a0.y, a0.z, a0.w, a1.x, a1.y, a1.z, a1.w}, c1w[8] = {b0.x, b0.y, b0.z, b0.w, b1.x, b1.y, b1.z, b1.w};
            unsigned ow[8];
#pragma unroll
            for (int j = 0; j < 8; ++j) ow[j] = pk2(yv[j >> 1][(j & 1) * 2] * rs * __uint_as_float(c1w[j] << 16) + __uint_as_float(c0w[j] << 16),
                                                     yv[j >> 1][(j & 1) * 2 + 1] * rs * __uint_as_float(c1w[j] & 0xffff0000u) + __uint_as_float(c0w[j] & 0xffff0000u));
            const size_t grow = (size_t)b * SEQ + seg * SEGTOK + (cl - 1) * 64 + tk;
            bf16_t* ob = (bf16_t*)(p.ws + WS_OB) + grow * D + hb * 64 + 16 * g;
            *(u32x4*)ob = (u32x4){ow[0], ow[1], ow[2], ow[3]}; *(u32x4*)(ob + 8) = (u32x4){ow[4], ow[5], ow[6], ow[7]};
        }
    }
#pragma unroll
    for (int mt = 0; mt < 4; ++mt) *(f32x4*)(st + (size_t)(16 * vt + l15) * 64 + 16 * mt + 4 * q4) = S[mt];
    __syncthreads();
}

__device__ __forceinline__ void gdn_sample_item(const Params& p, unsigned char* smem, int bs, int h) {
    const int tid = otid(), w = tid >> 6, lane = tid & 63, kq = tid >> 7, v = tid & 127;
    float* qk_s = (float*)smem; float* v_s = qk_s + 1024; float* gb_s = v_s + 512; float* part = gb_s + 16; float* part2 = part + 512;
    const bf16_t* P = (const bf16_t*)(p.ws + WS_P);
    const float* pk = (const float*)(p.ws + WS_PK);
    const float* s_in = p.in[2] + (size_t)(bs * 8 + h) * 16384; float* s_out = p.out + O_GDN_S + (size_t)(bs * 8 + h) * 16384;
    const int row0 = LEX0 + EX_SAMP + bs * DECT;
    float s[32];
#pragma unroll
    for (int j = 0; j < 32; ++j) s[j] = s_in[(size_t)(kq * 32 + j) * 128 + v];
    if (tid < 384) {
        const int pcol = (tid >> 7) * 1024 + h * 128 + (tid & 127);
        const float* cw = pk + PK_CONVW; const float* hin = p.in[3] + (size_t)bs * 9216; float* hout = p.out + O_CONV_S + (size_t)bs * 9216;
        const float cw0 = cw[pcol], cw1 = cw[3072 + pcol], cw2 = cw[6144 + pcol], cw3 = cw[9216 + pcol];
        float x3 = hin[pcol], x2 = hin[3072 + pcol], x1 = hin[6144 + pcol];
        float xr[4];
#pragma unroll
        for (int i = 0; i < 4; ++i) xr[i] = bf2f(P[(size_t)(row0 + i) * NPB + pcol]);
#pragma unroll
        for (int i = 0; i < 4; ++i) { const float y = cw0 * x3 + cw1 * x2 + cw2 * x1 + cw3 * xr[i]; x3 = x2; x2 = x1; x1 = xr[i];
            if (tid < 256) qk_s[i * 256 + tid] = silu_(y); else v_s[i * 128 + (tid - 256)] = silu_(y); }
        hout[pcol] = x3; hout[3072 + pcol] = x2; hout[6144 + pcol] = x1;
    } else if (tid < 388) {
        const int i = tid - 384; const size_t r = (size_t)(row0 + i) * NPB;
        const float pa = bf2f(P[r + C_A + h]), pb = bf2f(P[r + C_B + h]);
        gb_s[2 * i] = __expf(-expf(pk[PK_ALOG + h]) * softplus_(pa + pk[PK_DTB + h])); gb_s[2 * i + 1] = sigm(pb);
    }
    __syncthreads();
    { const int i = w >> 1, which = w & 1; float* rp = qk_s + i * 256 + which * 128; const float a = rp[lane], b = rp[lane + 64];
      const float sc = __builtin_amdgcn_rsqf(wave_sum(a * a + b * b) + 1e-6f) * (which == 0 ? 0.08838834764831845f : 1.f); rp[lane] = a * sc; rp[lane + 64] = b * sc; }
    __syncthreads();
#pragma unroll 1
    for (int i = 0; i < 4; ++i) {
        const float* kp = qk_s + i * 256 + 128 + kq * 32; const float* qp = qk_s + i * 256 + kq * 32;
        float pa = 0.f;
#pragma unroll
        for (int j4 = 0; j4 < 8; ++j4) { const f32x4 k4 = *(const f32x4*)(kp + 4 * j4); pa += k4[0] * s[4 * j4] + k4[1] * s[4 * j4 + 1] + k4[2] * s[4 * j4 + 2] + k4[3] * s[4 * j4 + 3]; }
        part[kq * 128 + v] = pa;
        __syncthreads();
        const float kS = part[v] + part[128 + v] + part[256 + v] + part[384 + v];
        const float a = gb_s[2 * i], c = gb_s[2 * i + 1] * (v_s[i * 128 + v] - a * kS);
        float po = 0.f;
#pragma unroll
        for (int j4 = 0; j4 < 8; ++j4) { const f32x4 k4 = *(const f32x4*)(kp + 4 * j4), q4v = *(const f32x4*)(qp + 4 * j4);
#pragma unroll
            for (int e = 0; e < 4; ++e) { s[4 * j4 + e] = a * s[4 * j4 + e] + k4[e] * c; po += q4v[e] * s[4 * j4 + e]; } }
        part2[kq * 128 + v] = po;
        __syncthreads();
        if (kq == 0) ((float*)(p.ws + WS_ORAW))[(size_t)(row0 + i) * D + h * 128 + v] = part2[v] + part2[128 + v] + part2[256 + v] + part2[384 + v];
    }
#pragma unroll
    for (int j = 0; j < 32; ++j) s_out[(size_t)(kq * 32 + j) * 128 + v] = s[j];
    __syncthreads();
}

constexpr int SR_R = 0, SR_KK = 4096, SR_V = 8192, SR_ZB = 12288, SR_DEC = 16384, SR_KA = 20480, SR_KM = 24576, SR_WD = 28672, SR_AD = 28928, SR_RK = 29184;
__device__ __forceinline__ void rwkv_sample_item(const Params& p, unsigned char* smem, int bs) {
    const int tid = otid(), w = tid >> 6, lane = tid & 63;
    float* f = (float*)smem;
    const bf16_t* P = (const bf16_t*)(p.ws + WS_P);
    const float* pk = (const float*)(p.ws + WS_PK);
    const int row0 = LEX0 + EX_SAMP + bs * DECT;
    const bf16_t* prow = P + (size_t)(LEX0 + EX_SHIFT + bs) * NPB + C_RW;
#pragma unroll 1
    for (int col = tid; col < RW_SHIFT; col += 512) {
        const float mu = pk[PK_MU + col]; float prev = bf2f(prow[col]);
        float cur[4];
#pragma unroll
        for (int i = 0; i < 4; ++i) cur[i] = bf2f(P[(size_t)(row0 + i) * NPB + C_RW + col]);
        float* dst; int stride = 1024; bool th = false;
        if (col < 1024) dst = f + SR_R + col; else if (col < 2048) dst = f + SR_KK + (col - 1024); else if (col < 3072) dst = f + SR_V + (col - 2048);
        else if (col < 3136) { dst = f + SR_WD + (col - 3072); stride = 64; th = true; } else if (col < 3200) { dst = f + SR_AD + (col - 3136); stride = 64; } else dst = f + SR_ZB + (col - 3200);
#pragma unroll
        for (int i = 0; i < 4; ++i) { float m = cur[i] + mu * (prev - cur[i]); prev = cur[i]; if (th) m = tanh_(m); dst[i * stride] = m; }
    }
    __syncthreads();
#pragma unroll 1
    for (int cc = 0; cc < 2; ++cc) {
        const int c = tid + 512 * cc;
        float aw[4] = {0.f, 0.f, 0.f, 0.f}, aa[4] = {0.f, 0.f, 0.f, 0.f};
#pragma unroll 8
        for (int l = 0; l < 64; ++l) { const float w2v = pk[PK_W2 + l * D + c], a2v = pk[PK_A2 + l * D + c];
#pragma unroll
            for (int i = 0; i < 4; ++i) { aw[i] += f[SR_WD + i * 64 + l] * w2v; aa[i] += f[SR_AD + i * 64 + l] * a2v; } }
        const float w0c = pk[PK_W0 + c], a0c = pk[PK_A0 + c], kkc = pk[PK_KK + c], kac = pk[PK_KA + c];
#pragma unroll
        for (int i = 0; i < 4; ++i) { const float a = sigm(a0c + aa[i]); const float kbv = f[SR_KK + i * 1024 + c];
            f[SR_DEC + i * 1024 + c] = __expf(-0.6065306597126334f * sigm(w0c + aw[i])); f[SR_KA + i * 1024 + c] = a; f[SR_KK + i * 1024 + c] = kbv * kkc; f[SR_KM + i * 1024 + c] = kbv * (1.f + (a - 1.f) * kac); }
    }
    __syncthreads();
#pragma unroll 1
    for (int x = 0; x < 8; ++x) { const int pr = w * 8 + x, i = pr >> 4, hh = pr & 15; const int o = i * 1024 + hh * 64 + lane;
        const float kr = f[SR_KK + o]; const float kk = kr * __builtin_amdgcn_rsqf(wave_sum(kr * kr) + 1e-6f); f[SR_KK + o] = kk; f[SR_KA + o] = kk * f[SR_KA + o];
        const float rkv = wave_sum(f[SR_R + o] * f[SR_KM + o] * pk[PK_RK + hh * 64 + lane]); if (lane == 0) f[SR_RK + pr] = rkv; }
    __syncthreads();
#pragma unroll 1
    for (int hp = 0; hp < 2; ++hp) {
        const int hb = hp * 8 + w;
        const float* s_in = p.in[4] + (size_t)(bs * 16 + hb) * 4096 + (size_t)lane * 64; float* s_out = p.out + O_RWKV_S + (size_t)(bs * 16 + hb) * 4096 + (size_t)lane * 64;
        f32x4 S[16];
#pragma unroll
        for (int j = 0; j < 16; ++j) S[j] = *(const f32x4*)(s_in + 4 * j);
        const int cch = hb * 64 + lane;
        const float gnw = pk[PK_GNW + cch], gnb = pk[PK_GNB + cch];
#pragma unroll 1
        for (int i = 0; i < 4; ++i) {
            const int o = i * 1024 + hb * 64;
            const float vv = f[SR_V + o + lane], rk = f[SR_RK + i * 16 + hb];
            float sa = 0.f;
#pragma unroll
            for (int j = 0; j < 16; ++j) { const f32x4 kk4 = *(const f32x4*)(f + SR_KK + o + 4 * j); sa += S[j][0] * kk4[0] + S[j][1] * kk4[1] + S[j][2] * kk4[2] + S[j][3] * kk4[3]; }
            float y = 0.f;
#pragma unroll
            for (int j = 0; j < 16; ++j) { const f32x4 de4 = *(const f32x4*)(f + SR_DEC + o + 4 * j), ka4 = *(const f32x4*)(f + SR_KA + o + 4 * j), km4 = *(const f32x4*)(f + SR_KM + o + 4 * j), r4 = *(const f32x4*)(f + SR_R + o + 4 * j);
#pragma unroll
                for (int e = 0; e < 4; ++e) { S[j][e] = S[j][e] * de4[e] + (vv * km4[e] - sa * ka4[e]); y += S[j][e] * r4[e]; } }
            const float mu = wave_sum(y) * (1.f / 64.f); const float dy = y - mu;
            const float rs = __builtin_amdgcn_rsqf(wave_sum(dy * dy) * (1.f / 64.f) + 64e-5f);
            const float ov = (dy * rs * gnw + gnb + rk * vv) * silu_(f[SR_ZB + i * 1024 + cch]);
            ((bf16_t*)(p.ws + WS_OB))[(size_t)(XROWS + EX_SAMP + bs * DECT + i) * D + cch] = (bf16_t)f2bf(ov);
        }
#pragma unroll
        for (int j = 0; j < 16; ++j) *(f32x4*)(s_out + 4 * j) = S[j];
    }
    __syncthreads();
}

__device__ __forceinline__ void phase2(const Params& p, int seg, unsigned char* smem) {
    const int blk = obid();
    float* out = p.out;
    float* chalo = (float*)(p.ws + WS_CHALO); float* phalo = (float*)(p.ws + WS_PHALO);
#ifndef SUB
#define SUB 0
#endif
#define SEN(x) (SUB == 0 || SUB == (x))
    if (SEN(1) && blk < 64) gdn_scan_block(p, seg, smem, blk);
    if (SEN(3) && blk >= 64 && blk < 128) rwkv_scan_block(p, seg, smem, blk - 64);
#ifndef DUP
#define DUP 0
#endif
    if (seg == 0) {
#pragma unroll 1
        for (int it = blk; it < DECB * 8; it += gridDim.x) gdn_sample_item(p, smem, it >> 3, it & 7);
#pragma unroll 1
        for (int it = (blk + 128) & 255; it < DECB; it += gridDim.x) rwkv_sample_item(p, smem, it);
    }
}

__device__ __forceinline__ void phase25(const Params& p, int seg) {
    const int tid0 = otid(); const int lane = tid0 & 63; const int gw = obid() * 8 + (tid0 >> 6), NGW = gridDim.x * 8;
    const bf16_t* P = (const bf16_t*)(p.ws + WS_P);
    const float* ORAW = (const float*)(p.ws + WS_ORAW); const float* YRAW = (const float*)(p.ws + WS_YRAW);
    const bf16_t* C0 = (const bf16_t*)(p.ws + WS_C0); const bf16_t* C1 = (const bf16_t*)(p.ws + WS_C1);
    bf16_t* OA = (bf16_t*)(p.ws + WS_H); bf16_t* OB = (bf16_t*)(p.ws + WS_OB);
    const int nrows = LEX0 + (seg == 0 ? DECB * DECT : 0);
    const int c = lane * 16;
    f32x4 nw[4];
#pragma unroll
    for (int j = 0; j < 4; ++j) nw[j] = *(const f32x4*)((const float*)(p.ws + WS_PK) + PK_NORMW + (c & 127) + 4 * j);
#pragma unroll 1
    for (int rr = LEX0 + gw; rr < nrows; rr += NGW) {
        int lr; size_t grow;
        if (rr < LEX0) { lr = rr; grow = (size_t)(rr / SEGTOK) * SEQ + seg * SEGTOK + (rr % SEGTOK); } else { lr = LEX0 + EX_SAMP + (rr - LEX0); grow = (size_t)XROWS + EX_SAMP + (rr - LEX0); }
        {
            f32x4 o[4]; float ss = 0.f;
#pragma unroll
            for (int j = 0; j < 4; ++j) { o[j] = *(const f32x4*)(ORAW + (size_t)lr * D + c + 4 * j); ss += o[j][0] * o[j][0] + o[j][1] * o[j][1] + o[j][2] * o[j][2] + o[j][3] * o[j][3]; }
            ss += __shfl_xor(ss, 1); ss += __shfl_xor(ss, 2); ss += __shfl_xor(ss, 4);
            const float rs = __builtin_amdgcn_rsqf(ss * (1.f / 128.f) + 1e-6f);
            const u32x4 z0 = *(const u32x4*)(P + (size_t)lr * NPB + C_Z + c), z1 = *(const u32x4*)(P + (size_t)lr * NPB + C_Z + c + 8);
            const unsigned zz[8] = {z0.x, z0.y, z0.z, z0.w, z1.x, z1.y, z1.z, z1.w};
            unsigned ow[8];
#pragma unroll
            for (int j = 0; j < 8; ++j) { const float za = __uint_as_float(zz[j] << 16), zb = __uint_as_float(zz[j] & 0xffff0000u);
                const float a = o[j >> 1][(j & 1) * 2] * rs * nw[j >> 1][(j & 1) * 2] * silu_(za), b = o[j >> 1][(j & 1) * 2 + 1] * rs * nw[j >> 1][(j & 1) * 2 + 1] * silu_(zb);
                ow[j] = pk2(a, b); }
            *(u32x4*)(OA + grow * D + c) = (u32x4){ow[0], ow[1], ow[2], ow[3]}; *(u32x4*)(OA + grow * D + c + 8) = (u32x4){ow[4], ow[5], ow[6], ow[7]};
        }
    }
}

__device__ __forceinline__ void phase_final(const Params& p) {
    const int tid0 = otid(); const int lane = tid0 & 63; const int gw = obid() * 8 + (tid0 >> 6), NGW = gridDim.x * 8;
    const f32x4* wr = (const f32x4*)((const float*)(p.ws + WS_PK) + PK_LNF) + lane;
#pragma unroll 1
    for (int r = gw; r < XROWS + DECB * DECT; r += NGW) {
        f32x4* xr = (f32x4*)(p.out + (size_t)r * D) + lane;
        f32x4 v[4]; float ss = 0.f;
#pragma unroll
        for (int j = 0; j < 4; ++j) { v[j] = xr[64 * j]; ss += v[j][0] * v[j][0] + v[j][1] * v[j][1] + v[j][2] * v[j][2] + v[j][3] * v[j][3]; }
        const float rs = __builtin_amdgcn_rsqf(wave_sum(ss) * (1.f / D) + 1e-6f);
#pragma unroll
        for (int j = 0; j < 4; ++j) xr[64 * j] = v[j] * rs * wr[64 * j];
    }
}

__global__ __launch_bounds__(512, 2) void hybrid_mega(Params p) {
    extern __shared__ __attribute__((aligned(16))) unsigned char smem[];
    cg::grid_group grid = cg::this_grid();
    LAS unsigned char* lds = (LAS unsigned char*)smem;
    const int G = gridDim.x;
    volatile LAS unsigned* xst = (volatile LAS unsigned*)(lds + (LDS_TOTAL - 16));
    if (threadIdx.x == 0) { xst[0] = 0u; xst[1] = 0u; }
    __syncthreads();
    (void)xcd_barrier_post((unsigned*)(p.ws + WS_BAR), xst);
    if (G == 0x7fffffff) grid.sync();
#define GSYNC() do { XcdBarrier xb_; xb_.bar = (unsigned*)(p.ws + WS_BAR); xb_.x = xb_xcc_id(); xb_.st = (volatile LAS unsigned*)((LAS unsigned char*)smem + (LDS_TOTAL - 16)); xcd_barrier(xb_); } while (0)

#ifndef ONLY
#define ONLY 0
#endif
#define EN(x) (ONLY == 0 || ONLY == (x))
    if (EN(1)) phase0(p, smem);
    GSYNC();
#pragma unroll 1
    for (int it = 0; it <= NSEG + 2; ++it) {
        const int xblk = obid() - (G - 12);
        const bool xrole = xblk >= 0;
        if (it > 0 && it <= NSEG && EN(3)) phase2(p, it - 1, smem);
        if (((it == 2 && xrole) || it == NSEG + 1) && EN(5)) {
            const bool ex = it == 2;
            SchedAB S; S.ob.init(ex ? 3 : XROWS / 256, 4, ex ? 12 : G, ex ? xblk : obid()); S.pm0 = ex ? XROWS / 256 : 0;
            S.A0 = (const char*)(p.ws + WS_H); S.A1 = (const char*)(p.ws + WS_OB); S.B0 = (const char*)(p.ws + WS_WT_A); S.B1 = (const char*)(p.ws + WS_WT_B);
            EpiAB E; E.tmp = ex ? (bf16_t*)(p.ws + WS_YRAW) - (size_t)XROWS * D : (bf16_t*)(p.ws + WS_P); E.merged = ex ? (bf16_t*)(p.ws + WS_C0) - (size_t)XROWS * D : (bf16_t*)(p.ws + WS_MG);
            E.gex = (const bf16_t*)(p.ws + WS_GEX); E.out = p.out;
            pg8::gemm_phase<EpiAB, SchedAB>(lds, D, S, E);
        }
        if (((it == 3 && xrole) || it == NSEG + 2) && EN(6)) {
            const bool ex = it == 3;
            SchedO S; S.ob.init(ex ? 3 : XROWS / 256, 4, ex ? 12 : G, ex ? xblk : obid()); S.pm0 = ex ? XROWS / 256 : 0;
            S.A = ex ? (const char*)((bf16_t*)(p.ws + WS_C0) - (size_t)XROWS * D) : (const char*)(p.ws + WS_MG); S.B = (const char*)(p.ws + WS_WT_O);
            EpiO E; E.out = p.out; E.xp = p.in[0]; E.xs = p.in[1];
            pg8::gemm_phase<EpiO, SchedO>(lds, D, S, E);
        }
        if (it < NSEG && EN(2) && !(it == 2 && xrole)) {
            const int seg = it;
            const int Gp = it == 2 ? G - 12 : G;
            const int cidx = it > 0 ? (obid() + (Gp >> 1)) % Gp : obid();
            SchedIn S; S.ob.init(seg == 0 ? LT_PROMPT + 3 : LT_PROMPT, NT_IN, Gp, cidx); S.seg = seg; S.A = (const char*)(p.ws + WS_H); S.B = (const char*)(p.ws + WS_WT_IN);
            EpiIn E; E.P = (bf16_t*)(p.ws + WS_P); E.gex = (bf16_t*)(p.ws + WS_GEX); E.out = p.out; E.seg = seg;
            pg8::gemm_phase<EpiIn, SchedIn>(lds, D, S, E);
        }
        GSYNC();
        if (it < NSEG) {
            if (EN(8)) { phase_gprep(p, it, smem); phase_rprep(p, it, smem); }
            if (it == 1 && EN(4)) phase25(p, 0);
            GSYNC();
        }
    }
    if (EN(7)) phase_final(p);
}

extern "C" void kernel_launch(void* const* d_in, const int* in_sizes, int n_in, void* d_out, int out_size, void* d_ws, size_t ws_size, hipStream_t stream) {
    static int grid_blocks = 0;
    constexpr int LDS_BYTES = LDS_TOTAL;
    if (grid_blocks == 0) {
        if (n_in != 27 || ws_size < WS_END) { fprintf(stderr, "kernel_launch: unexpected n_in %d / ws %zu (need %zu)\n", n_in, ws_size, (size_t)WS_END); grid_blocks = -1; return; }
        if (hipFuncSetAttribute((const void*)hybrid_mega, hipFuncAttributeMaxDynamicSharedMemorySize, LDS_BYTES) != hipSuccess) { fprintf(stderr, "kernel_launch: hipFuncSetAttribute failed\n"); grid_blocks = -1; return; }
        int dev = 0, cus = 0, per_cu = 0;
        hipGetDevice(&dev);
        hipDeviceGetAttribute(&cus, hipDeviceAttributeMultiprocessorCount, dev);
        hipOccupancyMaxActiveBlocksPerMultiprocessor(&per_cu, (const void*)hybrid_mega, 512, LDS_BYTES);
        if (per_cu < 1) { fprintf(stderr, "kernel_launch: occupancy query says %d blocks/CU\n", per_cu); per_cu = 1; }
        (void)hipGetLastError();
        grid_blocks = cus;
    }
    if (grid_blocks < 0) return;
    Params p{};
    for (int i = 0; i < 27; ++i) p.in[i] = (const float*)d_in[i];
    p.out = (float*)d_out; p.ws = (unsigned char*)d_ws;
    if (hipMemsetAsync((unsigned char*)d_ws + WS_BAR, 0, 16384, stream) != hipSuccess) { fprintf(stderr, "kernel_launch: memset of the barrier words failed\n"); return; }
    void* args[] = {&p};
    hipError_t e = hipLaunchCooperativeKernel((const void*)hybrid_mega, dim3(grid_blocks), dim3(512), args, LDS_BYTES, stream);
    if (e != hipSuccess) fprintf(stderr, "cooperative launch failed: %s (grid %d)\n", hipGetErrorString(e), grid_blocks);
}
```

```cpp
#include <hip/hip_runtime.h>
#include <hip/hip_cooperative_groups.h>
#include <cstdio>
namespace cg = cooperative_groups;

#define LAS __attribute__((address_space(3)))
typedef unsigned short bf16_t;
typedef short bf16x8 __attribute__((ext_vector_type(8)));
typedef float f32x4 __attribute__((ext_vector_type(4)));
typedef unsigned u32x4 __attribute__((ext_vector_type(4)));
typedef unsigned u32x2 __attribute__((ext_vector_type(2)));

constexpr int D = 1024;
constexpr int NBATCH = 8, SEQ = 2048, NMETA = 16, DECB = 128, DECT = 4;
constexpr int XROWS = NBATCH * SEQ;
constexpr int EX_SAMP = 16, EX_SHIFT = 528, EX_END = 656;
constexpr int HROWS = 17152, HTILES = 67;
constexpr int NSEG = 8, SEGTOK = SEQ / NSEG;
constexpr int CPS = SEGTOK / 64;
constexpr int TPB = SEGTOK / 256;
constexpr int LT_PROMPT = NBATCH * TPB;
constexpr int LEX0 = LT_PROMPT * 256;
constexpr int LROWS = LEX0 + 768;
constexpr int NP = 10496, NPB = 8448, NT_IN = 41, NT_PB = 33;
constexpr int C_A = 3072, C_B = 3080, C_Z = 3088, C_RW = 4112, C_GATE_REF = 8336;
constexpr int RW_SHIFT = 4224;

constexpr size_t O_YP = 0, O_YS = 16777216, O_GDN_P = 17301504, O_CONV_P = 18350080, O_RWKV_P = 18423808, O_SHIFT_P = 18948096,
                 O_GDN_S = 18956288, O_CONV_S = 35733504, O_RWKV_S = 36913152, O_SHIFT_S = 45301760;

constexpr size_t al256(size_t x) { return (x + 255) & ~(size_t)255; }
constexpr size_t WS_WT_IN = 0;
constexpr size_t WS_WT_A = al256(WS_WT_IN + (size_t)NP * D * 2);
constexpr size_t WS_WT_B = al256(WS_WT_A + (size_t)D * D * 2);
constexpr size_t WS_WT_O = al256(WS_WT_B + (size_t)D * D * 2);
constexpr size_t WS_H = al256(WS_WT_O + (size_t)D * D * 2);
constexpr size_t WS_OB = al256(WS_H + (size_t)HROWS * D * 2);
constexpr size_t WS_P = al256(WS_OB + (size_t)HROWS * D * 2);
constexpr size_t WS_ORAW = al256(WS_P + (size_t)LROWS * NPB * 2);
constexpr size_t WS_YRAW = al256(WS_ORAW + (size_t)LROWS * D * 4);
constexpr size_t WS_C0 = al256(WS_YRAW + (size_t)LROWS * D * 4);
constexpr size_t WS_C1 = al256(WS_C0 + (size_t)LROWS * D * 2);
constexpr size_t WS_GEX = al256(WS_C1 + (size_t)LROWS * D * 2);
constexpr size_t WS_CHALO = al256(WS_GEX + (size_t)768 * 2048 * 2);
constexpr size_t WS_PHALO = al256(WS_CHALO + (size_t)2 * NBATCH * 3 * NPB * 2);
constexpr size_t WS_PK = al256(WS_PHALO + (size_t)2 * NBATCH * NPB * 2);
constexpr int PK_CONVW = 0, PK_ALOG = 12288, PK_DTB = 12296, PK_NORMW = 12304, PK_MU = 12432, PK_W0 = 16656, PK_W2 = 17680, PK_A0 = 83216, PK_A2 = 84240,
              PK_KK = 149776, PK_KA = 150800, PK_RK = 151824, PK_GNW = 152848, PK_GNB = 153872, PK_LNF = 154896, PK_END = 155920;
constexpr size_t WS_BAR = al256(WS_PK + (size_t)PK_END * 4);
constexpr size_t WS_W2T = al256(WS_BAR + 16384);
constexpr size_t WS_A2T = al256(WS_W2T + 131072);
constexpr size_t WS_GP = al256(WS_A2T + 131072);
constexpr int GP_AP = 0, GP_QH = 32768, GP_KH = 49152, GP_OH = 81920, GP_EGL = 98304, GP_G = 98560, GP_STRIDE = 114944;
constexpr int RP_AP = 0, RP_RH = 8192, RP_KH = 16384, RP_YH = 24576, RP_C1 = 32768, RP_C0 = 40960, RP_PC = 49152, RP_STRIDE = 49408;
constexpr size_t WS_RP = al256(WS_GP + (size_t)(CPS + 1) * 64 * GP_STRIDE);
constexpr size_t WS_END = al256(WS_RP + (size_t)(CPS + 1) * 128 * RP_STRIDE);
constexpr size_t WS_MG = WS_GP;
static_assert((size_t)HROWS * D * 2 <= WS_END - WS_GP, "MERGED must fit in the prep records");
static_assert((size_t)HROWS * D * 4 <= (size_t)LROWS * NPB * 2 + 2 * (size_t)LROWS * D * 4, "TMP must fit in P+ORAW+YRAW");
static_assert(WS_END <= (size_t)268435456, "workspace");

constexpr int LDS_TOTAL = 163840;
struct Params { const float* in[27]; float* out; unsigned char* ws; };

__device__ __forceinline__ float bf2f(bf16_t v) { return __uint_as_float(((unsigned)v) << 16); }
typedef __bf16 bf16n2 __attribute__((ext_vector_type(2)));
typedef float f32n2 __attribute__((ext_vector_type(2)));
__device__ __forceinline__ unsigned cvt_pk_bf16(float lo, float hi) { const f32n2 v = {lo, hi}; return __builtin_bit_cast(unsigned, __builtin_convertvector(v, bf16n2)); }
__device__ __forceinline__ unsigned pk2(float lo, float hi) { return cvt_pk_bf16(lo, hi); }
__device__ __forceinline__ unsigned f2bf(float f) { return cvt_pk_bf16(f, 0.f) & 0xffffu; }
__device__ __forceinline__ float sigm(float x) { return __builtin_amdgcn_rcpf(1.f + __expf(-x)); }
__device__ __forceinline__ float silu_(float x) { return x * __builtin_amdgcn_rcpf(1.f + __expf(-x)); }
__device__ __forceinline__ float softplus_(float x) { return fmaxf(x, 0.f) + log1pf(expf(-fabsf(x))); }
__device__ __forceinline__ float wave_sum(float v) {
#pragma unroll
    for (int o = 1; o < 64; o <<= 1) v += __shfl_xor(v, o);
    return v;
}
__device__ __forceinline__ void unpack8(const u32x4 rw, float (&x)[8]) {
    x[0] = __uint_as_float(rw.x << 16); x[1] = __uint_as_float(rw.x & 0xffff0000u); x[2] = __uint_as_float(rw.y << 16); x[3] = __uint_as_float(rw.y & 0xffff0000u);
    x[4] = __uint_as_float(rw.z << 16); x[5] = __uint_as_float(rw.z & 0xffff0000u); x[6] = __uint_as_float(rw.w << 16); x[7] = __uint_as_float(rw.w & 0xffff0000u); }
__device__ __forceinline__ u32x4 pack8(const float (&x)[8]) { return (u32x4){pk2(x[0], x[1]), pk2(x[2], x[3]), pk2(x[4], x[5]), pk2(x[6], x[7])}; }

__device__ __forceinline__ int otid() { int t = threadIdx.x; asm volatile("" : "+v"(t)); return t; }
__device__ __forceinline__ int obid() { int t = blockIdx.x; asm volatile("" : "+s"(t)); return t; }
__device__ __forceinline__ float tanh_(float x) { const float e = __expf(2.f * x); return 1.f - 2.f * __builtin_amdgcn_rcpf(e + 1.f); }
template <int CTRL> __device__ __forceinline__ float dppf(float x) { return __builtin_bit_cast(float, __builtin_amdgcn_mov_dpp(__builtin_bit_cast(int, x), CTRL, 0xf, 0xf, true)); }
__device__ __forceinline__ float rowsum16(float x) { x += dppf<0x128>(x); x += dppf<0x124>(x); x += dppf<0x122>(x); x += dppf<0x121>(x); return x; }


#define XB_TMO      128
#define XB_XCNT(j)  (256  + 64 * (j))
#define XB_XSUB(j)  (1280 + 64 * (j))
#define XB_XGEN(j)  (2304 + 64 * (j))
#define XB_TOP      3328
#define XB_TOPGEN   3392
#define XCD_BAR_WORDS 3456
#define XB_SPIN_CAP (1u << 22)
__device__ __forceinline__ unsigned xb_ld(unsigned* p)              { return __hip_atomic_load(p, __ATOMIC_RELAXED, __HIP_MEMORY_SCOPE_AGENT); }
__device__ __forceinline__ unsigned xb_add(unsigned* p, unsigned v) { return __hip_atomic_fetch_add(p, v, __ATOMIC_RELAXED, __HIP_MEMORY_SCOPE_AGENT); }
__device__ __forceinline__ unsigned xb_xcc_id() { return (unsigned)__builtin_amdgcn_s_getreg((3 << 11) | 20) & 0xFu; }
#define XB_SPIN(cond, bar) do { unsigned _sp = 0; while (cond) { __builtin_amdgcn_s_sleep(1); \
    if ((++_sp & 255u) == 0u) { if (xb_ld(&(bar)[XB_TMO])) break; if (_sp > XB_SPIN_CAP) { atomicAdd(&(bar)[XB_TMO], 1u); break; } } } } while (0)
struct XcdBarrier { unsigned* bar; unsigned x; volatile LAS unsigned* st; };
__device__ __forceinline__ XcdBarrier xcd_barrier_post(unsigned* bar, volatile LAS unsigned* st) {
    XcdBarrier b; b.bar = bar; b.x = xb_xcc_id(); b.st = st;
    if (threadIdx.x == 0) (void)xb_add(&bar[XB_XCNT(b.x)], 1u);
    return b;
}
__device__ __forceinline__ void xcd_barrier_complete(unsigned* bar, unsigned x, unsigned& nloc, unsigned& nx) {
    const unsigned G = gridDim.x * gridDim.y * gridDim.z;
    unsigned sum, cnt, mine, sp = 0u;
    for (;;) {
        sum = 0u; cnt = 0u; mine = 0u;
#pragma unroll
        for (unsigned j = 0; j < 16; ++j) { const unsigned c = xb_ld(&bar[XB_XCNT(j)]); sum += c; cnt += (c > 0u) ? 1u : 0u; mine = (j == x) ? c : mine; }
        if (sum == G) break;
        __builtin_amdgcn_s_sleep(1);
        if ((++sp & 255u) == 0u) { if (xb_ld(&bar[XB_TMO])) break; if (sp > XB_SPIN_CAP) { atomicAdd(&bar[XB_TMO], 1u); break; } }
    }
    nloc = mine > 0u ? mine : 1u; nx = cnt > 0u ? cnt : 1u;
}
__device__ __forceinline__ void xcd_barrier(const XcdBarrier& b) {
    asm volatile("s_waitcnt vmcnt(0)" ::: "memory");
    __syncthreads();
    if (threadIdx.x == 0) {
        unsigned* bar = b.bar;
        __builtin_amdgcn_s_waitcnt(0);
        unsigned nloc = b.st[0], nx = b.st[1];
        if (nloc == 0u) { xcd_barrier_complete(bar, b.x, nloc, nx); b.st[0] = nloc; b.st[1] = nx; }
        const unsigned old = xb_add(&bar[XB_XSUB(b.x)], 1u);
        const unsigned gen = old / nloc;
        if (old + 1u == (gen + 1u) * nloc) {
            __builtin_amdgcn_fence(__ATOMIC_RELEASE, "agent");
            asm volatile("s_waitcnt vmcnt(0)" ::: "memory");
            const unsigned og = xb_add(&bar[XB_TOP], 1u);
            const unsigned tg = og / nx;
            if (og + 1u == (tg + 1u) * nx) xb_add(&bar[XB_TOPGEN], 1u);
            else XB_SPIN(xb_ld(&bar[XB_TOPGEN]) == tg, bar);
            __builtin_amdgcn_fence(__ATOMIC_ACQUIRE, "agent");
            xb_add(&bar[XB_XGEN(b.x)], 1u);
            asm volatile("s_waitcnt vmcnt(0)" ::: "memory");
        } else {
            XB_SPIN(xb_ld(&bar[XB_XGEN(b.x)]) == gen, bar);
            __builtin_amdgcn_fence(__ATOMIC_ACQUIRE, "agent");
            asm volatile("s_waitcnt vmcnt(0)" ::: "memory");
        }
    }
    __syncthreads();
}

namespace pg8 {
constexpr int BM = 256, BK = 64, HALF = 128, HTB = HALF * BK * 2, STAGE_BYTES = 8 * HTB, NXCD = 8, WGM = 8;
__device__ __forceinline__ int lds_byte(int r, int c) { const int st = (r >> 4) * 2 + (c >> 5), rr = r & 15, cc = c & 31, ob = rr * 64 + cc * 2; return st * 1024 + (ob ^ (((ob >> 9) & 1) << 5)); }
__device__ __forceinline__ void stage_rc(int b, int& R, int& C) { const int st = b / 1024, sb = b % 1024, swz = sb ^ (((sb >> 9) & 1) << 5); R = (st >> 1) * 16 + swz / 64; C = (st & 1) * 32 + (swz % 64) / 2; }
__device__ __forceinline__ int perm32(int rho) { const int n = rho >> 4, i = rho & 15; return 8 * (i >> 2) + 4 * n + (i & 3); }

struct Unit { int pm, pn, w; };
struct OrderBase {
    int nM, nN, nwg, G, c;
    __device__ void init(int nM_, int nN_, int G_, int c_) { nM = nM_; nN = nN_; nwg = nM * nN; G = G_; c = c_; }
    __device__ bool nextb(int i, Unit& u) const {
        const long L = (long)i * G + c; if (L >= nwg) return false;
        int wgid = (int)L; { const int q = nwg / NXCD, r = nwg % NXCD, xcd = wgid % NXCD, off = wgid / NXCD; wgid = (xcd < r ? xcd * (q + 1) : r * (q + 1) + (xcd - r) * q) + off; }
        const int nig = WGM * nN, gid = wgid / nig, fm = gid * WGM, gsz = (nM - fm) < WGM ? (nM - fm) : WGM;
        u.pm = fm + ((wgid % nig) % gsz); u.pn = (wgid % nig) / gsz; u.w = 0; return true;
    }
};

template <class Epi, class Sched>
__device__ __forceinline__ void gemm_phase(LAS unsigned char* lds, const int K, const Sched& S, const Epi& E) {
    const int tid = otid(), wid = __builtin_amdgcn_readfirstlane(tid >> 6), lane = tid & 63, wr = wid >> 2, wc = wid & 3, fr = lane & 15, fq = lane >> 4;
    const int nt = K / BK;
    unsigned voffA[2], voffB[2];
#pragma unroll
    for (int i = 0; i < 2; ++i) { int R, C; stage_rc(tid * 16 + i * 8192, R, C); const int Rb = Epi::PERM ? ((R & ~31) + perm32(R & 31)) : R;
        voffA[i] = (unsigned)(R * K + C) * 2u; voffB[i] = (unsigned)(Rb * K + C) * 2u; }
    const size_t kstep = (size_t)(BK * 2);
    const size_t hstep = (size_t)HALF * K * 2;
    const unsigned ldsw = (unsigned)wid * 1024u;
    const int aoff = lds_byte(wr * 64 + fr, fq * 8), boff = lds_byte(wc * 32 + fr, fq * 8);
#define PG8_SA(b, h) (((b) * 2 + (h)) * HTB)
#define PG8_SB(b, h) ((4 + (b) * 2 + (h)) * HTB)
#define PG8_STAGE(bufoff, gbase, voff) do { _Pragma("unroll") for (int _i = 0; _i < 2; ++_i) \
        __builtin_amdgcn_global_load_lds((const unsigned*)((const char*)(gbase) + (voff)[_i]), (LAS unsigned*)(lds + (bufoff) + ldsw + _i * 8192), 16, 0, 0); } while (0)
#define PG8_LDA(dst, b, h) do { _Pragma("unroll") for (int m = 0; m < 4; ++m) _Pragma("unroll") for (int k = 0; k < 2; ++k) dst[m][k] = *(const LAS bf16x8*)(lds + PG8_SA(b, h) + aoff + m * 2048 + k * 1024); } while (0)
#define PG8_LDB(dst, b, h) do { _Pragma("unroll") for (int n = 0; n < 2; ++n) _Pragma("unroll") for (int k = 0; k < 2; ++k) dst[n][k] = *(const LAS bf16x8*)(lds + PG8_SB(b, h) + boff + n * 2048 + k * 1024); } while (0)
#define PG8_MMA(ai, bj, At, Bt) do { __builtin_amdgcn_s_setprio(1); _Pragma("unroll") for (int m = 0; m < 4; ++m) _Pragma("unroll") for (int n = 0; n < 2; ++n) _Pragma("unroll") for (int k = 0; k < 2; ++k) \
        acc[ai][bj][m][n] = __builtin_amdgcn_mfma_f32_16x16x32_bf16(Bt[n][k], At[m][k], acc[ai][bj][m][n], 0, 0, 0); __builtin_amdgcn_s_setprio(0); } while (0)
#define PG8_WAIT_V(n) asm volatile("s_waitcnt vmcnt(" #n ")" ::: "memory")
#define PG8_WAIT_L(n) asm volatile("s_waitcnt lgkmcnt(" #n ")" ::: "memory")
#define PG8_BAR __builtin_amdgcn_s_barrier()
#define PG8_SCHED __builtin_amdgcn_sched_barrier(0)
    Unit cur, nxt; int ui = 0;
    if (!S.next(0, cur)) return;
    f32x4 acc[2][2][4][2];
#pragma unroll
    for (int a = 0; a < 2; ++a)
#pragma unroll
        for (int b = 0; b < 2; ++b)
#pragma unroll
            for (int m = 0; m < 4; ++m)
#pragma unroll
                for (int n = 0; n < 2; ++n) acc[a][b][m][n] = (f32x4){0.f, 0.f, 0.f, 0.f};
    bf16x8 At[4][2], B0[2][2], B1[2][2];
    const char* cA = S.a_ptr(cur); const char* cB = S.b_ptr(cur);
    PG8_STAGE(PG8_SB(0, 0), cB, voffB); PG8_STAGE(PG8_SA(0, 0), cA, voffA); PG8_STAGE(PG8_SB(0, 1), cB + hstep, voffB); PG8_STAGE(PG8_SA(0, 1), cA + hstep, voffA);
    if (wr == 1) PG8_BAR;
    PG8_WAIT_V(4); PG8_BAR;
    PG8_STAGE(PG8_SB(1, 0), cB + kstep, voffB); PG8_STAGE(PG8_SA(1, 0), cA + kstep, voffA); PG8_STAGE(PG8_SB(1, 1), cB + hstep + kstep, voffB);
    PG8_WAIT_V(6); PG8_BAR;
    for (;;) {
        const bool has_next = S.next(ui + 1, nxt);
        const char* nA = has_next ? S.a_ptr(nxt) : cA; const char* nB = has_next ? S.b_ptr(nxt) : cB;
        for (int t = 0; t < nt; t += 2) {
            const bool last = (t == nt - 2);
            const char* a1 = cA + (size_t)(t + 1) * kstep;
            const char* a2 = last ? nA : cA + (size_t)(t + 2) * kstep; const char* b2 = last ? nB : cB + (size_t)(t + 2) * kstep;
            const char* a3 = a2 + kstep; const char* b3 = b2 + kstep;
            PG8_LDB(B0, 0, 0); PG8_SCHED; PG8_LDA(At, 0, 0); PG8_STAGE(PG8_SA(1, 1), a1 + hstep, voffA);
            PG8_WAIT_L(8); PG8_BAR; PG8_WAIT_L(0); PG8_MMA(0, 0, At, B0); PG8_BAR; PG8_SCHED;
            PG8_LDB(B1, 0, 1); PG8_STAGE(PG8_SB(0, 0), b2, voffB);
            PG8_BAR; PG8_WAIT_L(0); PG8_MMA(0, 1, At, B1); PG8_BAR;
            PG8_LDA(At, 0, 1); PG8_STAGE(PG8_SA(0, 0), a2, voffA);
            PG8_BAR; PG8_WAIT_L(0); PG8_MMA(1, 0, At, B0); PG8_BAR; PG8_SCHED;
            PG8_STAGE(PG8_SB(0, 1), b2 + hstep, voffB);
            PG8_WAIT_V(6); PG8_BAR; PG8_MMA(1, 1, At, B1); PG8_BAR;
            PG8_LDB(B0, 1, 0); PG8_SCHED; PG8_LDA(At, 1, 0); PG8_STAGE(PG8_SA(0, 1), a2 + hstep, voffA);
            PG8_WAIT_L(8); PG8_BAR; PG8_WAIT_L(0); PG8_MMA(0, 0, At, B0); PG8_BAR; PG8_SCHED;
            PG8_LDB(B1, 1, 1); PG8_STAGE(PG8_SB(1, 0), b3, voffB);
            PG8_BAR; PG8_WAIT_L(0); PG8_MMA(0, 1, At, B1); PG8_BAR;
            PG8_LDA(At, 1, 1); PG8_STAGE(PG8_SA(1, 0), a3, voffA);
            PG8_BAR; PG8_WAIT_L(0); PG8_MMA(1, 0, At, B0); PG8_BAR; PG8_SCHED;
            PG8_STAGE(PG8_SB(1, 1), b3 + hstep, voffB);
            PG8_WAIT_V(6); PG8_BAR; PG8_MMA(1, 1, At, B1); PG8_BAR;
        }
        E(acc, cur, wr, wc, fr, fq);
        if (!has_next) break;
#pragma unroll
        for (int a = 0; a < 2; ++a)
#pragma unroll
            for (int b = 0; b < 2; ++b)
#pragma unroll
                for (int m = 0; m < 4; ++m)
#pragma unroll
                    for (int n = 0; n < 2; ++n) acc[a][b][m][n] = (f32x4){0.f, 0.f, 0.f, 0.f};
        cur = nxt; cA = nA; cB = nB; ++ui;
    }
    PG8_WAIT_V(0);
    if (wr == 0) PG8_BAR;
    PG8_BAR;
#undef PG8_SA
#undef PG8_SB
#undef PG8_STAGE
#undef PG8_LDA
#undef PG8_LDB
#undef PG8_MMA
#undef PG8_WAIT_V
#undef PG8_WAIT_L
#undef PG8_BAR
#undef PG8_SCHED
}
}
using pg8::Unit;

struct SchedIn {
    pg8::OrderBase ob; int seg; const char* A; const char* B;
    __device__ bool next(int i, Unit& u) const { return ob.nextb(i, u); }
    __device__ const char* a_ptr(const Unit& u) const {
        const int gt = u.pm < LT_PROMPT ? ((u.pm / TPB) * (SEQ / 256) + seg * TPB + (u.pm % TPB)) : (XROWS / 256 + (u.pm - LT_PROMPT));
        return A + (size_t)gt * 256 * D * 2; }
    __device__ const char* b_ptr(const Unit& u) const { return B + (size_t)u.pn * 256 * D * 2; }
};
struct SchedAB {
    pg8::OrderBase ob; int pm0; const char* A0; const char* A1; const char* B0; const char* B1;
    __device__ bool next(int i, Unit& u) const { const bool ok = ob.nextb(i >> 1, u); u.pm += pm0; u.w = i & 1; return ok; }
    __device__ const char* a_ptr(const Unit& u) const { return (u.w ? A1 : A0) + (size_t)u.pm * 256 * D * 2; }
    __device__ const char* b_ptr(const Unit& u) const { return (u.w ? B1 : B0) + (size_t)u.pn * 256 * D * 2; }
};
struct SchedO {
    pg8::OrderBase ob; int pm0; const char* A; const char* B;
    __device__ bool next(int i, Unit& u) const { const bool ok = ob.nextb(i, u); u.pm += pm0; return ok; }
    __device__ const char* a_ptr(const Unit& u) const { return A + (size_t)u.pm * 256 * D * 2; }
    __device__ const char* b_ptr(const Unit& u) const { return B + (size_t)u.pn * 256 * D * 2; }
};

struct EpiIn {
    static constexpr bool PERM = true;
    bf16_t* P; bf16_t* gex; float* out; int seg;
    __device__ __forceinline__ void operator()(const f32x4 (&acc)[2][2][4][2], const Unit& u, int wr, int wc, int fr, int fq) const {
        const int lr0 = u.pm * 256 + wr * 64 + fr;
        const int c0 = u.pn * 256 + wc * 32 + 8 * fq;
#pragma unroll
        for (int ai = 0; ai < 2; ++ai)
#pragma unroll
            for (int m = 0; m < 4; ++m) {
                const int lr = lr0 + ai * 128 + m * 16;
                bf16_t* rowp;
                if (u.pn < NT_PB) rowp = P + (size_t)lr * NPB + c0;
                else if (lr < LEX0) { const int b = lr / SEGTOK; const size_t grow = (size_t)b * SEQ + seg * SEGTOK + (lr % SEGTOK); rowp = (bf16_t*)(out + O_YP + grow * D) + (c0 - NPB); }
                else rowp = gex + (size_t)(lr - LEX0) * 2048 + (c0 - NPB);
#pragma unroll
                for (int bj = 0; bj < 2; ++bj) { const f32x4 v0 = acc[ai][bj][m][0], v1 = acc[ai][bj][m][1];
                    u32x4 w; w.x = cvt_pk_bf16(v0[0], v0[1]); w.y = cvt_pk_bf16(v0[2], v0[3]); w.z = cvt_pk_bf16(v1[0], v1[1]); w.w = cvt_pk_bf16(v1[2], v1[3]);
                    *(u32x4*)(rowp + bj * 128) = w; }
            }
    }
};
struct EpiAB {
    static constexpr bool PERM = true;
    bf16_t* tmp; bf16_t* merged; const bf16_t* gex; const float* out;
    __device__ __forceinline__ void operator()(const f32x4 (&acc)[2][2][4][2], const Unit& u, int wr, int wc, int fr, int fq) const {
        const int row0 = u.pm * 256 + wr * 64 + fr, col0 = u.pn * 256 + wc * 32 + 8 * fq;
#pragma unroll
        for (int ai = 0; ai < 2; ++ai)
#pragma unroll
            for (int m = 0; m < 4; ++m) {
                const int grow = row0 + ai * 128 + m * 16;
                const bf16_t* gp = (grow < XROWS) ? ((const bf16_t*)(out + O_YP + (size_t)grow * D) + u.w * D) : (gex + (size_t)(grow - XROWS) * 2048 + u.w * D);
#pragma unroll
                for (int bj = 0; bj < 2; ++bj) {
                    const int c = col0 + bj * 128;
                    float g[8]; unpack8(*(const u32x4*)(gp + c), g);
                    const f32x4 v0 = acc[ai][bj][m][0], v1 = acc[ai][bj][m][1];
                    float v[8] = {v0[0] * sigm(g[0]), v0[1] * sigm(g[1]), v0[2] * sigm(g[2]), v0[3] * sigm(g[3]), v1[0] * sigm(g[4]), v1[1] * sigm(g[5]), v1[2] * sigm(g[6]), v1[3] * sigm(g[7])};
                    bf16_t* tp = tmp + (size_t)grow * D + c;
                    if (u.w == 0) *(u32x4*)tp = pack8(v);
                    else { float t[8]; unpack8(*(const u32x4*)tp, t);
#pragma unroll
                        for (int e = 0; e < 8; ++e) v[e] += t[e];
                        *(u32x4*)(merged + (size_t)grow * D + c) = pack8(v); }
                }
            }
    }
};
struct EpiO {
    static constexpr bool PERM = false;
    float* out; const float* xp; const float* xs;
    __device__ __forceinline__ void operator()(const f32x4 (&acc)[2][2][4][2], const Unit& u, int wr, int wc, int fr, int fq) const {
        const int row0 = u.pm * 256 + wr * 64 + fr, col0 = u.pn * 256 + wc * 32 + 4 * fq;
#pragma unroll
        for (int ai = 0; ai < 2; ++ai)
#pragma unroll
            for (int m = 0; m < 4; ++m) {
                const int grow = row0 + ai * 128 + m * 16;
                const float* xr; float* yr;
                if (grow < XROWS) { xr = xp + (size_t)grow * D; yr = out + O_YP + (size_t)grow * D; }
                else { const int e = grow - XROWS; if (e < EX_SAMP || e >= EX_SHIFT) continue; xr = xs + (size_t)(e - EX_SAMP) * D; yr = out + O_YS + (size_t)(e - EX_SAMP) * D; }
#pragma unroll
                for (int bj = 0; bj < 2; ++bj)
#pragma unroll
                    for (int n = 0; n < 2; ++n) { const int c = col0 + bj * 128 + n * 16; *(f32x4*)(yr + c) = *(const f32x4*)(xr + c) + acc[ai][bj][m][n]; }
            }
    }
};

__device__ __forceinline__ void p0_row(const Params& p, int r, int lane) {
    bf16_t* hrow = (bf16_t*)(p.ws + WS_H) + (size_t)r * D;
    const float* src = nullptr; bool norm = true; float* sh = nullptr;
    if (r < XROWS) { src = p.in[0] + (size_t)r * D; if ((r & (SEQ - 1)) == SEQ - 1) sh = p.out + O_SHIFT_P + (size_t)(r / SEQ) * D; }
    else { const int e = r - XROWS;
        if (e < EX_SAMP) src = p.in[6] + (size_t)e * D;
        else if (e < EX_SHIFT) { src = p.in[1] + (size_t)(e - EX_SAMP) * D; if (((e - EX_SAMP) & 3) == 3) sh = p.out + O_SHIFT_S + (size_t)((e - EX_SAMP) >> 2) * D; }
        else if (e < EX_END) { src = p.in[5] + (size_t)(e - EX_SHIFT) * D; norm = false; } }
    u32x2* o8 = (u32x2*)hrow + lane;
    if (!src) {
#pragma unroll
        for (int j = 0; j < 4; ++j) o8[64 * j] = (u32x2){0u, 0u};
        return; }
    const f32x4* xr = (const f32x4*)src + lane;
    f32x4 v[4]; float ss = 0.f;
#pragma unroll
    for (int j = 0; j < 4; ++j) { v[j] = xr[64 * j]; ss += v[j][0] * v[j][0] + v[j][1] * v[j][1] + v[j][2] * v[j][2] + v[j][3] * v[j][3]; }
    if (norm) {
        const float rs = __builtin_amdgcn_rsqf(wave_sum(ss) * (1.f / D) + 1e-6f);
        const f32x4* wr = (const f32x4*)p.in[7] + lane;
#pragma unroll
        for (int j = 0; j < 4; ++j) v[j] = v[j] * rs * wr[64 * j];
    }
#pragma unroll
    for (int j = 0; j < 4; ++j) { o8[64 * j] = (u32x2){pk2(v[j][0], v[j][1]), pk2(v[j][2], v[j][3])}; if (sh) ((f32x4*)sh)[lane + 64 * j] = v[j]; }
}
template <int MODE> __device__ __forceinline__ void p0_tr_item(const float* W, int N, bf16_t* WT, float* scr, int kb, int nb, int lane) {
    const int k0 = 64 * kb, n0 = 32 * nb;
    const int nn = n0 + (lane & 31);
    int srcc = nn;
    if (MODE == 1) srcc = nn < C_GATE_REF ? nn : (nn < NPB ? -1 : nn - (NPB - C_GATE_REF));
#pragma unroll 8
    for (int i = 0; i < 32; ++i) { const int kk = 2 * i + (lane >> 5); scr[kk * 33 + (lane & 31)] = srcc >= 0 ? W[(size_t)(k0 + kk) * N + srcc] : 0.f; }
    asm volatile("s_waitcnt lgkmcnt(0)" ::: "memory");
    const int c = lane & 7;
#pragma unroll
    for (int j = 0; j < 4; ++j) { const int n = (lane >> 3) + 8 * j; const float* s = scr + (8 * c) * 33 + n;
        u32x4 o; o.x = pk2(s[0 * 33], s[1 * 33]); o.y = pk2(s[2 * 33], s[3 * 33]); o.z = pk2(s[4 * 33], s[5 * 33]); o.w = pk2(s[6 * 33], s[7 * 33]);
        *(u32x4*)(WT + (size_t)(n0 + n) * D + k0 + 8 * c) = o; }
    asm volatile("s_waitcnt lgkmcnt(0)" ::: "memory");
}
__device__ __forceinline__ void phase0(const Params& p, unsigned char* smem) {
    const int tid0 = otid(), wave = tid0 >> 6, lane = tid0 & 63;
    const int gw = obid() * 8 + wave, NGW = gridDim.x * 8;
    float* scr = (float*)smem + wave * (64 * 33);
    constexpr int I_IN = 16 * (NP / 32), I_SQ = 16 * 32;
    for (int it = gw; it < I_IN + 3 * I_SQ; it += NGW) {
        int r = it;
        if (r < I_IN) { p0_tr_item<1>(p.in[8], 10384, (bf16_t*)(p.ws + WS_WT_IN), scr, r / (NP / 32), r % (NP / 32), lane); continue; } r -= I_IN;
        if (r < I_SQ) { p0_tr_item<0>(p.in[13], D, (bf16_t*)(p.ws + WS_WT_A), scr, r / 32, r % 32, lane); continue; } r -= I_SQ;
        if (r < I_SQ) { p0_tr_item<0>(p.in[24], D, (bf16_t*)(p.ws + WS_WT_B), scr, r / 32, r % 32, lane); continue; } r -= I_SQ;
        p0_tr_item<0>(p.in[25], D, (bf16_t*)(p.ws + WS_WT_O), scr, r / 32, r % 32, lane);
    }
    {
        const f32x4* lw = (const f32x4*)p.in[7] + lane;
        f32x4 wv[4];
#pragma unroll
        for (int j = 0; j < 4; ++j) wv[j] = lw[64 * j];
#pragma unroll 1
        for (int r = gw; r < XROWS; r += 2 * NGW) {
            const int r1 = r + NGW; const bool has1 = r1 < XROWS;
            const f32x4* x0 = (const f32x4*)(p.in[0] + (size_t)r * D) + lane; const f32x4* x1 = (const f32x4*)(p.in[0] + (size_t)(has1 ? r1 : r) * D) + lane;
            f32x4 a[4], b[4]; float s0 = 0.f, s1 = 0.f;
#pragma unroll
            for (int j = 0; j < 4; ++j) { a[j] = x0[64 * j]; b[j] = x1[64 * j]; }
#pragma unroll
            for (int j = 0; j < 4; ++j) { s0 += a[j][0] * a[j][0] + a[j][1] * a[j][1] + a[j][2] * a[j][2] + a[j][3] * a[j][3]; s1 += b[j][0] * b[j][0] + b[j][1] * b[j][1] + b[j][2] * b[j][2] + b[j][3] * b[j][3]; }
            const float q0 = __builtin_amdgcn_rsqf(wave_sum(s0) * (1.f / D) + 1e-6f), q1 = __builtin_amdgcn_rsqf(wave_sum(s1) * (1.f / D) + 1e-6f);
            u32x2* o0 = (u32x2*)((bf16_t*)(p.ws + WS_H) + (size_t)r * D) + lane; u32x2* o1 = (u32x2*)((bf16_t*)(p.ws + WS_H) + (size_t)r1 * D) + lane;
#pragma unroll
            for (int j = 0; j < 4; ++j) { a[j] = a[j] * q0 * wv[j]; o0[64 * j] = (u32x2){pk2(a[j][0], a[j][1]), pk2(a[j][2], a[j][3])}; }
            if ((r & (SEQ - 1)) == SEQ - 1) { f32x4* sh = (f32x4*)(p.out + O_SHIFT_P + (size_t)(r / SEQ) * D) + lane;
#pragma unroll
                for (int j = 0; j < 4; ++j) sh[64 * j] = a[j]; }
            if (has1) {
#pragma unroll
                for (int j = 0; j < 4; ++j) { b[j] = b[j] * q1 * wv[j]; o1[64 * j] = (u32x2){pk2(b[j][0], b[j][1]), pk2(b[j][2], b[j][3])}; }
                if ((r1 & (SEQ - 1)) == SEQ - 1) { f32x4* sh = (f32x4*)(p.out + O_SHIFT_P + (size_t)(r1 / SEQ) * D) + lane;
#pragma unroll
                    for (int j = 0; j < 4; ++j) sh[64 * j] = b[j]; }
            }
        }
    }
    for (int r = XROWS + gw; r < HROWS; r += NGW) p0_row(p, r, lane);
    {
        float* pk = (float*)(p.ws + WS_PK);
        const int gt = obid() * 512 + tid0, NT = gridDim.x * 512;
        for (int i = gt; i < PK_END; i += NT) {
            const float* src; int o;
            if (i < PK_ALOG) { src = p.in[9]; o = i - PK_CONVW; } else if (i < PK_DTB) { src = p.in[10]; o = i - PK_ALOG; } else if (i < PK_NORMW) { src = p.in[11]; o = i - PK_DTB; }
            else if (i < PK_MU) { src = p.in[12]; o = i - PK_NORMW; } else if (i < PK_W0) { src = p.in[14]; o = i - PK_MU; } else if (i < PK_W2) { src = p.in[15]; o = i - PK_W0; }
            else if (i < PK_A0) { src = p.in[16]; o = i - PK_W2; } else if (i < PK_A2) { src = p.in[17]; o = i - PK_A0; } else if (i < PK_KK) { src = p.in[18]; o = i - PK_A2; }
            else if (i < PK_KA) { src = p.in[19]; o = i - PK_KK; } else if (i < PK_RK) { src = p.in[20]; o = i - PK_KA; } else if (i < PK_GNW) { src = p.in[21]; o = i - PK_RK; }
            else if (i < PK_GNB) { src = p.in[22]; o = i - PK_GNW; } else if (i < PK_LNF) { src = p.in[23]; o = i - PK_GNB; } else { src = p.in[26]; o = i - PK_LNF; }
            pk[i] = src[o];
        }
        bf16_t* w2t = (bf16_t*)(p.ws + WS_W2T); bf16_t* a2t = (bf16_t*)(p.ws + WS_A2T);
        for (int i = gt; i < 65536; i += NT) { const int l = i & 63, c = (i >> 6) & 63, hb = i >> 12;
            w2t[i] = (bf16_t)f2bf(p.in[16][(size_t)l * D + hb * 64 + c]); a2t[i] = (bf16_t)f2bf(p.in[18][(size_t)l * D + hb * 64 + c]); }
    }
}

__device__ __forceinline__ void gdn_item(const Params& p, unsigned char* smem, const float* s_in, float* s_out, const float* halo_in, float* halo_out,
                                         int h, int sl, int rowA, int nA, int rowB, int nB) {
    const int tid = otid(), w = tid >> 6, lane = tid & 63, vl = lane >> 4, kg = lane & 15;
    float* qk_s = (float*)smem; float* v_s = qk_s + 16384; float* o_s = v_s + 2048; float* gb_s = o_s + 2048; float* sst = gb_s + 128;
    const bf16_t* P = (const bf16_t*)(p.ws + WS_P);
    float* ORAW = (float*)(p.ws + WS_ORAW);
    float s[8];
    if (s_in) {
        { const int k = tid >> 2, q4 = tid & 3; const f32x4* src = (const f32x4*)(s_in + (size_t)k * 128 + sl * 32 + q4 * 8); const f32x4 a = src[0], b = src[1];
          float* d = sst + k * 33 + q4 * 8; d[0] = a[0]; d[1] = a[1]; d[2] = a[2]; d[3] = a[3]; d[4] = b[0]; d[5] = b[1]; d[6] = b[2]; d[7] = b[3]; }
        __syncthreads();
#pragma unroll
        for (int j = 0; j < 8; ++j) s[j] = sst[(kg * 8 + j) * 33 + 4 * w + vl];
        __syncthreads();
    } else {
#pragma unroll
        for (int j = 0; j < 8; ++j) s[j] = 0.f;
    }
    int pcol = -1;
    if (tid < 128) pcol = h * 128 + tid; else if (tid < 256) pcol = 1024 + h * 128 + (tid - 128); else if (tid < 288) pcol = 2048 + h * 128 + sl * 32 + (tid - 256);
    float cw0 = 0.f, cw1 = 0.f, cw2 = 0.f, cw3 = 0.f, x1 = 0.f, x2 = 0.f, x3 = 0.f;
    const float* pk = (const float*)(p.ws + WS_PK);
    if (pcol >= 0) { const float* cw = pk + PK_CONVW; cw0 = cw[pcol]; cw1 = cw[3072 + pcol]; cw2 = cw[6144 + pcol]; cw3 = cw[9216 + pcol];
        if (halo_in) { x3 = halo_in[pcol]; x2 = halo_in[3072 + pcol]; x1 = halo_in[6144 + pcol]; } }
    const float nalog = -expf(pk[PK_ALOG + h]), dtb = pk[PK_DTB + h];
#pragma unroll 1
    for (int run = 0; run < 2; ++run) {
        const int rrow = run ? rowB : rowA, rn = run ? nB : nA; const bool wout = run != 0;
#pragma unroll 1
        for (int c0 = 0; c0 < rn; c0 += 64) {
            const int nt = (rn - c0) < 64 ? (rn - c0) : 64; const int row = rrow + c0;
            if (pcol >= 0) {
                const bf16_t* src = P + (size_t)row * NPB + pcol;
                float* dst = tid < 256 ? (qk_s + tid) : (v_s + (tid - 256)); const int dstride = tid < 256 ? 256 : 32;
#pragma unroll 8
                for (int i = 0; i < nt; ++i) { const float x0 = bf2f(src[(size_t)i * NPB]); const float y = cw0 * x3 + cw1 * x2 + cw2 * x1 + cw3 * x0; x3 = x2; x2 = x1; x1 = x0; dst[i * dstride] = silu_(y); }
            } else if (tid < 352) {
                const int i = tid - 288;
                if (i < nt) { const float pa = bf2f(P[(size_t)(row + i) * NPB + C_A + h]), pb = bf2f(P[(size_t)(row + i) * NPB + C_B + h]);
                    gb_s[2 * i] = expf(nalog * softplus_(pa + dtb)); gb_s[2 * i + 1] = sigm(pb); }
            }
            __syncthreads();
#pragma unroll 1
            for (int ii = 0; ii < 8; ++ii) { const int i = w * 8 + ii;
                if (i < nt) {
#pragma unroll
                    for (int which = 0; which < 2; ++which) { float* rp = qk_s + i * 256 + which * 128; const float a = rp[lane], b = rp[lane + 64];
                        const float sc = __builtin_amdgcn_rsqf(wave_sum(a * a + b * b) + 1e-6f) * (which == 0 ? 0.08838834764831845f : 1.f); rp[lane] = a * sc; rp[lane + 64] = b * sc; } } }
            __syncthreads();
#pragma unroll 1
            for (int i = 0; i < nt; ++i) {
                const f32x4 q0 = *(const f32x4*)(qk_s + i * 256 + kg * 8), q1 = *(const f32x4*)(qk_s + i * 256 + kg * 8 + 4);
                const f32x4 k0 = *(const f32x4*)(qk_s + i * 256 + 128 + kg * 8), k1 = *(const f32x4*)(qk_s + i * 256 + 128 + kg * 8 + 4);
                const float vv = v_s[i * 32 + 4 * w + vl], a = gb_s[2 * i], be = gb_s[2 * i + 1];
                float part = k0[0] * s[0] + k0[1] * s[1] + k0[2] * s[2] + k0[3] * s[3] + k1[0] * s[4] + k1[1] * s[5] + k1[2] * s[6] + k1[3] * s[7];
                const float kS = rowsum16(part);
                const float c = be * (vv - a * kS);
                s[0] = a * s[0] + k0[0] * c; s[1] = a * s[1] + k0[1] * c; s[2] = a * s[2] + k0[2] * c; s[3] = a * s[3] + k0[3] * c;
                s[4] = a * s[4] + k1[0] * c; s[5] = a * s[5] + k1[1] * c; s[6] = a * s[6] + k1[2] * c; s[7] = a * s[7] + k1[3] * c;
                float op = q0[0] * s[0] + q0[1] * s[1] + q0[2] * s[2] + q0[3] * s[3] + q1[0] * s[4] + q1[1] * s[5] + q1[2] * s[6] + q1[3] * s[7];
                const float o = rowsum16(op);
                if (kg == 0) o_s[i * 32 + 4 * w + vl] = o;
            }
            __syncthreads();
            if (wout) { const int i = tid >> 3, c4 = (tid & 7) * 4; if (i < nt) *(f32x4*)(ORAW + (size_t)(row + i) * D + h * 128 + sl * 32 + c4) = *(const f32x4*)(o_s + i * 32 + c4); }
        }
    }
    if (pcol >= 0 && (sl == 0 || tid >= 256)) { halo_out[pcol] = x3; halo_out[3072 + pcol] = x2; halo_out[6144 + pcol] = x1; }
#pragma unroll
    for (int j = 0; j < 8; ++j) sst[(kg * 8 + j) * 33 + 4 * w + vl] = s[j];
    __syncthreads();
    { const int k = tid >> 2, q4 = tid & 3; const float* d = sst + k * 33 + q4 * 8; f32x4* dst = (f32x4*)(s_out + (size_t)k * 128 + sl * 32 + q4 * 8);
      dst[0] = (f32x4){d[0], d[1], d[2], d[3]}; dst[1] = (f32x4){d[4], d[5], d[6], d[7]}; }
    __syncthreads();
}

constexpr int RW_W2 = 20544, RW_A2 = 24640;
__device__ __forceinline__ void rwkv_load_lora(const Params& p, unsigned char* smem, int hb) {
    float* w2_s = (float*)smem + RW_W2; float* a2_s = (float*)smem + RW_A2; const float* pk = (const float*)(p.ws + WS_PK);
    for (int i = otid(); i < 4096; i += 512) { const int l = i >> 6, c = i & 63; w2_s[i] = pk[PK_W2 + l * D + hb * 64 + c]; a2_s[i] = pk[PK_A2 + l * D + hb * 64 + c]; }
    __syncthreads();
}
__device__ __forceinline__ void rwkv_item(const Params& p, unsigned char* smem, const float* s_in, float* s_out, const bf16_t* prev_row, const float* halo_in, float* halo_out,
                                          int hb, int half, int rowA, int nA, int rowB, int nB) {
    const int tid = otid(), w = tid >> 6, lane = tid & 63, row = tid >> 4, kq = tid & 15;
    float* f = (float*)smem;
    float* r_s = f; float* kb_s = f + 2048; float* v_s = f + 4096; float* wd_s = f + 6144; float* ad_s = f + 8192; float* dec_s = f + 10240; float* a_s = f + 12288;
    float* kk_s = f + 14336; float* km_s = f + 16384; float* zb_s = f + 18432; float* y_s = f + 19456; float* bonus_s = f + 20480;
    const float* w2_s = f + RW_W2; const float* a2_s = f + RW_A2;
    const bf16_t* P = (const bf16_t*)(p.ws + WS_P);
    float* YRAW = (float*)(p.ws + WS_YRAW); bf16_t* C0 = (bf16_t*)(p.ws + WS_C0); bf16_t* C1 = (bf16_t*)(p.ws + WS_C1);
    float s[4];
    if (s_in) { const f32x4 t = *(const f32x4*)(s_in + (size_t)(half * 32 + row) * 64 + kq * 4); s[0] = t[0]; s[1] = t[1]; s[2] = t[2]; s[3] = t[3]; }
    else { s[0] = s[1] = s[2] = s[3] = 0.f; }
    int col = -1; float* dst = nullptr; int dstride = 64; bool is_wd = false, owner = false;
    if (tid < 64) { col = hb * 64 + tid; dst = r_s + tid; owner = half == 0; }
    else if (tid < 128) { col = 1024 + hb * 64 + (tid - 64); dst = kb_s + (tid - 64); owner = half == 0; }
    else if (tid < 192) { col = 2048 + hb * 64 + (tid - 128); dst = v_s + (tid - 128); owner = half == 0; }
    else if (tid < 256) { col = 3072 + (tid - 192); dst = wd_s + (tid - 192); is_wd = true; owner = (half == 0 && hb == 0); }
    else if (tid < 320) { col = 3136 + (tid - 256); dst = ad_s + (tid - 256); owner = (half == 0 && hb == 0); }
    else if (tid < 352) { col = 3200 + hb * 64 + half * 32 + (tid - 320); dst = zb_s + (tid - 320); dstride = 32; owner = true; }
    float mu = 0.f, prev = 0.f;
    const float* pk = (const float*)(p.ws + WS_PK);
    if (col >= 0) { mu = pk[PK_MU + col]; prev = prev_row ? bf2f(prev_row[C_RW + col]) : (halo_in ? halo_in[col] : 0.f); }
    const int cc = tid & 63, ig = tid >> 6;
    const int hc = hb * 64 + cc;
    const float w0c = pk[PK_W0 + hc], a0c = pk[PK_A0 + hc], kkc = pk[PK_KK + hc], kac = pk[PK_KA + hc];
    const float rkl = pk[PK_RK + hb * 64 + lane];
#pragma unroll 1
    for (int run = 0; run < 2; ++run) {
        const int rrow = run ? rowB : rowA, rn = run ? nB : nA; const bool wout = run != 0;
#pragma unroll 1
        for (int c0 = 0; c0 < rn; c0 += 32) {
            const int nt = (rn - c0) < 32 ? (rn - c0) : 32; const int row0 = rrow + c0;
            if (col >= 0) {
                const bf16_t* src = P + (size_t)row0 * NPB + C_RW + col;
#pragma unroll 8
                for (int i = 0; i < nt; ++i) { const float cur = bf2f(src[(size_t)i * NPB]); float m = cur + mu * (prev - cur); prev = cur; if (is_wd) m = tanh_(m); dst[i * dstride] = m; }
            }
            __syncthreads();
            {
                float aw[4] = {0.f, 0.f, 0.f, 0.f}, aa[4] = {0.f, 0.f, 0.f, 0.f};
#pragma unroll 4
                for (int l = 0; l < 64; ++l) { const float w2v = w2_s[l * 64 + cc], a2v = a2_s[l * 64 + cc];
#pragma unroll
                    for (int ii = 0; ii < 4; ++ii) { aw[ii] += wd_s[(ig * 4 + ii) * 64 + l] * w2v; aa[ii] += ad_s[(ig * 4 + ii) * 64 + l] * a2v; } }
#pragma unroll
                for (int ii = 0; ii < 4; ++ii) { const int i = ig * 4 + ii;
                    if (i < nt) { const float wraw = w0c + aw[ii]; const float wlog = -0.6065306597126334f * sigm(wraw); const float a = sigm(a0c + aa[ii]);
                        const float kbv = kb_s[i * 64 + cc];
                        dec_s[i * 64 + cc] = expf(wlog); a_s[i * 64 + cc] = a; kk_s[i * 64 + cc] = kbv * kkc; km_s[i * 64 + cc] = kbv * (1.f + (a - 1.f) * kac); } }
            }
            __syncthreads();
#pragma unroll 1
            for (int ii = 0; ii < 4; ++ii) { const int i = w * 4 + ii;
                if (i < nt) { const float kkr = kk_s[i * 64 + lane]; const float kk = kkr * __builtin_amdgcn_rsqf(wave_sum(kkr * kkr) + 1e-6f); kk_s[i * 64 + lane] = kk;
                    const float a = a_s[i * 64 + lane]; a_s[i * 64 + lane] = kk * a;
                    const float rk = wave_sum(r_s[i * 64 + lane] * km_s[i * 64 + lane] * rkl); if (lane == 0) bonus_s[i] = rk; } }
            __syncthreads();
#pragma unroll 1
            for (int i = 0; i < nt; ++i) {
                const f32x4 kk4 = *(const f32x4*)(kk_s + i * 64 + kq * 4), de4 = *(const f32x4*)(dec_s + i * 64 + kq * 4), ka4 = *(const f32x4*)(a_s + i * 64 + kq * 4),
                            km4 = *(const f32x4*)(km_s + i * 64 + kq * 4), r4 = *(const f32x4*)(r_s + i * 64 + kq * 4);
                const float vv = v_s[i * 64 + half * 32 + row];
                const float sa = rowsum16(s[0] * kk4[0] + s[1] * kk4[1] + s[2] * kk4[2] + s[3] * kk4[3]);
#pragma unroll
                for (int j = 0; j < 4; ++j) s[j] = s[j] * de4[j] + (vv * km4[j] - sa * ka4[j]);
                const float y = rowsum16(s[0] * r4[0] + s[1] * r4[1] + s[2] * r4[2] + s[3] * r4[3]);
                if (kq == 0) y_s[i * 32 + row] = y;
            }
            __syncthreads();
            if (wout) { const int i = tid >> 4;
                if (i < nt) {
#pragma unroll
                    for (int q = 0; q < 2; ++q) { const int rr = (tid & 15) * 2 + q, v = half * 32 + rr, colo = hb * 64 + v;
                        const float sz = silu_(zb_s[i * 32 + rr]);
                        const size_t o = (size_t)(row0 + i) * D + colo;
                        YRAW[o] = y_s[i * 32 + rr]; C1[o] = (bf16_t)f2bf(pk[PK_GNW + colo] * sz); C0[o] = (bf16_t)f2bf((pk[PK_GNB + colo] + bonus_s[i] * v_s[i * 64 + v]) * sz); } } }
            __syncthreads();
        }
    }
    *(f32x4*)(s_out + (size_t)(half * 32 + row) * 64 + kq * 4) = (f32x4){s[0], s[1], s[2], s[3]};
    if (col >= 0 && owner && halo_out) halo_out[col] = prev;
}


__device__ __forceinline__ bf16x8 ldfrag(const bf16_t* base, int stride, int r0, int k0, int lane) {
    return *(const bf16x8*)(base + (r0 + (lane & 15)) * stride + k0 + 8 * (lane >> 4));
}
#define MFMA16(a, b, c) __builtin_amdgcn_mfma_f32_16x16x32_bf16((a), (b), (c), 0, 0, 0)
typedef short s16x4 __attribute__((ext_vector_type(4)));
__device__ __forceinline__ bf16x8 ldfrag_tr(const bf16_t* X, int stride, int c0, int k0, int lane) {
    const int l15 = lane & 15;
    const bf16_t* a = X + (k0 + 8 * (lane >> 4) + (l15 >> 2)) * stride + c0 + 4 * (l15 & 3);
    const s16x4 lo = __builtin_amdgcn_ds_read_tr16_b64_v4i16((LAS s16x4*)a), hi = __builtin_amdgcn_ds_read_tr16_b64_v4i16((LAS s16x4*)(a + 4 * stride));
    return __builtin_shufflevector(lo, hi, 0, 1, 2, 3, 4, 5, 6, 7);
}
__device__ __forceinline__ void inv_block(const float* L, float* Tm, float* XS, int tid) {
    const int w = tid >> 6, lane = tid & 63;
    typedef float f32x2v __attribute__((ext_vector_type(2)));
    if (w < 4 && lane < 16) {
        const float* Lb = L + (16 * w) * 64 + 16 * w; float* Tb = Tm + (16 * w) * 64 + 16 * w;
        float tr[16];
#pragma unroll
        for (int i = 0; i < 16; ++i) tr[i] = 0.f;
#pragma unroll
        for (int i = 0; i < 16; ++i) { float a = (lane == i) ? 1.f : 0.f;
#pragma unroll
            for (int j0 = 0; j0 < i; j0 += 4) { const f32x4 l4 = *(const f32x4*)(Lb + i * 64 + j0);
                a -= l4[0] * tr[j0] + l4[1] * tr[j0 + 1] + l4[2] * tr[j0 + 2] + l4[3] * tr[j0 + 3]; }
            tr[i] = a; Tb[i * 64 + lane] = a; }
    }
    for (int e = tid; e < 1536; e += 512) { const int k = e >> 8, r = (e >> 4) & 15, c = e & 15;
        const int rb = k < 3 ? 0 : (k < 5 ? 1 : 2), cb = k < 3 ? k + 1 : (k < 5 ? k - 1 : 3);
        Tm[(16 * rb + r) * 64 + 16 * cb + c] = 0.f; }
    __syncthreads();
    {
        const int B = tid >> 8, i = (tid >> 4) & 15, c = tid & 15, o = 32 * B;
        float x = 0.f;
#pragma unroll
        for (int j0 = 0; j0 < 16; j0 += 4) { const f32x4 l4 = *(const f32x4*)(L + (o + 16 + i) * 64 + o + j0);
            x += l4[0] * Tm[(o + j0) * 64 + o + c] + l4[1] * Tm[(o + j0 + 1) * 64 + o + c] + l4[2] * Tm[(o + j0 + 2) * 64 + o + c] + l4[3] * Tm[(o + j0 + 3) * 64 + o + c]; }
        XS[tid] = x;
        __syncthreads();
        float t = 0.f;
#pragma unroll
        for (int j0 = 0; j0 < 16; j0 += 4) { const f32x4 t4 = *(const f32x4*)(Tm + (o + 16 + i) * 64 + o + 16 + j0);
            t += t4[0] * XS[(B << 8) + j0 * 16 + c] + t4[1] * XS[(B << 8) + (j0 + 1) * 16 + c] + t4[2] * XS[(B << 8) + (j0 + 2) * 16 + c] + t4[3] * XS[(B << 8) + (j0 + 3) * 16 + c]; }
        Tm[(o + 16 + i) * 64 + o + c] = -t;
    }
    __syncthreads();
    {
        const int i = tid >> 4, c2 = (tid & 15) * 2;
        float x0 = 0.f, x1 = 0.f;
#pragma unroll
        for (int j0 = 0; j0 < 32; j0 += 4) { const f32x4 l4 = *(const f32x4*)(L + (32 + i) * 64 + j0);
#pragma unroll
            for (int e = 0; e < 4; ++e) { const f32x2v tv = *(const f32x2v*)(Tm + (j0 + e) * 64 + c2); x0 += l4[e] * tv[0]; x1 += l4[e] * tv[1]; } }
        *(f32x2v*)(XS + i * 32 + c2) = (f32x2v){x0, x1};
        __syncthreads();
        float t0 = 0.f, t1 = 0.f;
#pragma unroll
        for (int j0 = 0; j0 < 32; j0 += 4) { const f32x4 t4 = *(const f32x4*)(Tm + (32 + i) * 64 + 32 + j0);
#pragma unroll
            for (int e = 0; e < 4; ++e) { const f32x2v xv = *(const f32x2v*)(XS + (j0 + e) * 32 + c2); t0 += t4[e] * xv[0]; t1 += t4[e] * xv[1]; } }
        *(f32x2v*)(Tm + (32 + i) * 64 + c2) = (f32x2v){-t0, -t1};
    }
    __syncthreads();
}
constexpr int PL_QS = 0, PL_R1 = 17408, PL_KT = 35840, PL_KTT = 54272, PL_VT = 72704, PL_R3 = 91136, PL_QKM = 109568, PL_TP = 118784, PL_TPP = 128000, PL_SM = 137216, PL_TM = 139264, PL_XS = 155648;
constexpr int QSTR = 136, TSTR = 72;

__device__ __forceinline__ void gdn_prep_item(const Params& p, unsigned char* smem, int h, int row_start, int npad, const bf16_t* hbase,
                                              bf16_t* halo_out, float* conv_out, unsigned char* rec) {
    const int tid = otid(), w = tid >> 6, lane = tid & 63, q4 = lane >> 4, l15 = lane & 15;
    bf16_t* qs = (bf16_t*)(smem + PL_QS); bf16_t* ks = (bf16_t*)(smem + PL_R1); bf16_t* WT = ks; bf16_t* kts = (bf16_t*)(smem + PL_KT);
    bf16_t* vs = (bf16_t*)(smem + PL_VT);         float* Lm = (float*)(smem + PL_R3); bf16_t* UT = (bf16_t*)(smem + PL_R3); bf16_t* QKm = (bf16_t*)(smem + PL_QKM);
    bf16_t* Tp = (bf16_t*)(smem + PL_TP); bf16_t* Tpp = (bf16_t*)(smem + PL_TPP);
    float* sm = (float*)(smem + PL_SM);
    float* gcs = sm; float* bes = sm + 64; float* ssq = sm + 128; float* ssk = sm + 192; float* egs = sm + 256; float* egl_s = sm + 320; float* beg = sm + 384;
    const bf16_t* P = (const bf16_t*)(p.ws + WS_P);
    const float* pk = (const float*)(p.ws + WS_PK);
    if (npad == 0) {
        const int t = tid >> 3, g = tid & 7;
        const bf16_t* zp = P + (size_t)(row_start + t) * NPB + C_Z + h * 128 + 16 * g;
        const u32x4 z0 = *(const u32x4*)zp, z1 = *(const u32x4*)(zp + 8);
        float za[8], zb[8]; unpack8(z0, za); unpack8(z1, zb);
        const float* nwp = pk + PK_NORMW + 16 * g;
        float ga[8], gb2[8];
#pragma unroll
        for (int e = 0; e < 8; ++e) { ga[e] = nwp[e] * silu_(za[e]); gb2[e] = nwp[8 + e] * silu_(zb[e]); }
        bf16_t* gp = (bf16_t*)(rec + GP_G) + t * 128 + 16 * g;
        *(u32x4*)gp = pack8(ga); *(u32x4*)(gp + 8) = pack8(gb2);
    }
    if (w == 7) {
        const int i = lane;
        float g = 0.f, be = 0.f;
        if (i >= npad) { const size_t r = (size_t)(row_start + i - npad) * NPB; const float pa = bf2f(P[r + C_A + h]), pb = bf2f(P[r + C_B + h]);
            g = -expf(pk[PK_ALOG + h]) * softplus_(pa + pk[PK_DTB + h]); be = sigm(pb); }
        float x = g;
#pragma unroll
        for (int o = 1; o < 64; o <<= 1) { const float y = __shfl_up(x, o); if (lane >= o) x += y; }
        const float gl = __shfl(x, 63);
        gcs[lane] = x; bes[lane] = be; egs[lane] = __expf(x); egl_s[lane] = __expf(gl - x); beg[lane] = be * __expf(x);
        if (lane == 0) *(float*)(rec + GP_EGL) = __expf(gl);
    }
    __syncthreads();
    if (tid < 384) {
        const int sec = tid >> 7, ts = (tid >> 4) & 7, t0 = 8 * ts, d0 = l15 * 8;
        const int pcol = sec * 1024 + h * 128 + d0;
        float cw[4][8];
#pragma unroll
        for (int j = 0; j < 4; ++j) { const f32x4 a = *(const f32x4*)(pk + PK_CONVW + j * 3072 + pcol), b = *(const f32x4*)(pk + PK_CONVW + j * 3072 + pcol + 4);
            cw[j][0] = a[0]; cw[j][1] = a[1]; cw[j][2] = a[2]; cw[j][3] = a[3]; cw[j][4] = b[0]; cw[j][5] = b[1]; cw[j][6] = b[2]; cw[j][7] = b[3]; }
        u32x4 rw[11]; float fv[11];
#pragma unroll
        for (int k = 0; k < 11; ++k) {
            const int ii = t0 - 3 + k;
            const bf16_t* ptr = P + pcol; float f = 0.f;
            if (ii >= npad) { ptr = P + (size_t)(row_start + ii - npad) * NPB + pcol; f = 1.f; }
            else if (ii < 0 && npad == 0 && hbase) { ptr = hbase + (size_t)(ii + 3) * NPB + pcol; f = 1.f; }
            rw[k] = *(const u32x4*)ptr; fv[k] = f;
        }
        if (halo_out && ts == 7) {
#pragma unroll
            for (int dd = 0; dd < 3; ++dd) { *(u32x4*)(halo_out + (size_t)dd * NPB + pcol) = rw[8 + dd];
                if (conv_out) { float x[8]; unpack8(rw[8 + dd], x); *(f32x4*)(conv_out + dd * 3072 + pcol) = (f32x4){x[0], x[1], x[2], x[3]}; *(f32x4*)(conv_out + dd * 3072 + pcol + 4) = (f32x4){x[4], x[5], x[6], x[7]}; } }
        }
        float y[8][8];
#pragma unroll
        for (int t = 0; t < 8; ++t)
#pragma unroll
            for (int e = 0; e < 8; ++e) y[t][e] = 0.f;
#pragma unroll
        for (int k = 0; k < 11; ++k) { float x[8]; unpack8(rw[k], x);
#pragma unroll
            for (int e = 0; e < 8; ++e) x[e] *= fv[k];
#pragma unroll
            for (int dlt = 0; dlt < 4; ++dlt) { const int t = k - dlt;
                if (t >= 0 && t < 8) {
#pragma unroll
                    for (int e = 0; e < 8; ++e) y[t][e] += cw[dlt][e] * x[e]; } }
        }
        const float qsc = sec == 0 ? 0.08838834764831845f : 1.f;
#pragma unroll
        for (int t = 0; t < 8; ++t) {
            const bool tokv = (t0 + t) >= npad;
            float ss = 0.f;
#pragma unroll
            for (int e = 0; e < 8; ++e) { y[t][e] = tokv ? silu_(y[t][e]) : 0.f; ss += y[t][e] * y[t][e]; }
            if (sec < 2) { const float sc = __builtin_amdgcn_rsqf(rowsum16(ss) + 1e-6f) * qsc;
#pragma unroll
                for (int e = 0; e < 8; ++e) y[t][e] *= sc; }
        }
        { bf16_t* dst = sec == 0 ? qs : (sec == 1 ? ks : vs);
#pragma unroll
            for (int t = 0; t < 8; ++t) *(u32x4*)(dst + (t0 + t) * QSTR + d0) = pack8(y[t]); }
        if (sec == 1) {
#pragma unroll
            for (int t = 0; t < 8; ++t) { const float eg = egl_s[t0 + t]; float z[8];
#pragma unroll
                for (int e = 0; e < 8; ++e) z[e] = y[t][e] * eg;
                *(u32x4*)(kts + (t0 + t) * QSTR + d0) = pack8(z); } }
    }
    __syncthreads();
    {
        const int which = w >> 2, it = w & 3;
        const bf16_t* Barr = which ? qs : ks;
        bf16x8 bfr[4];
#pragma unroll
        for (int kk = 0; kk < 4; ++kk) bfr[kk] = ldfrag(Barr, QSTR, 16 * it, 32 * kk, lane);
        const int i = 16 * it + l15; const float gi = gcs[i], bi = bes[i];
#pragma unroll
        for (int jt = 0; jt < 4; ++jt) {
            f32x4 acc = {0.f, 0.f, 0.f, 0.f};
#pragma unroll
            for (int kk = 0; kk < 4; ++kk) acc = MFMA16(ldfrag(ks, QSTR, 16 * jt, 32 * kk, lane), bfr[kk], acc);
            const int j0 = 16 * jt + 4 * q4; const f32x4 gj = *(const f32x4*)(gcs + j0);
            f32x4 o;
#pragma unroll
            for (int r = 0; r < 4; ++r) { const int j = j0 + r; const bool keep = which ? (i >= j) : (i > j); o[r] = keep ? acc[r] * __expf(gi - gj[r]) : 0.f; }
            if (which == 0) *(f32x4*)(Lm + i * 64 + j0) = o * bi;
            else *(u32x2*)(QKm + i * TSTR + j0) = (u32x2){pk2(o[0], o[1]), pk2(o[2], o[3])};
        }
    }
    __syncthreads();
    {
        float* Tm = (float*)(smem + PL_TM);
        inv_block(Lm, Tm, (float*)(smem + PL_XS), tid);
        const int i = tid >> 3, j0 = (tid & 7) * 8;
        float a[8], b2[8];
#pragma unroll
        for (int e = 0; e < 8; ++e) { const float tv = Tm[i * 64 + j0 + e]; a[e] = tv * beg[j0 + e]; b2[e] = tv * bes[j0 + e]; }
        *(u32x4*)(Tp + i * TSTR + j0) = (u32x4){pk2(a[0], a[1]), pk2(a[2], a[3]), pk2(a[4], a[5]), pk2(a[6], a[7])};
        *(u32x4*)(Tpp + i * TSTR + j0) = (u32x4){pk2(b2[0], b2[1]), pk2(b2[2], b2[3]), pk2(b2[4], b2[5]), pk2(b2[6], b2[7])};
    }
    __syncthreads();
    {
        const int it = w & 3, half = w >> 2;
        f32x4 aw[4], au[4];
#pragma unroll
        for (int x = 0; x < 4; ++x) { aw[x] = (f32x4){0.f, 0.f, 0.f, 0.f}; au[x] = (f32x4){0.f, 0.f, 0.f, 0.f}; }
#pragma unroll
        for (int kk = 0; kk < 2; ++kk) {
            const bf16x8 a1 = ldfrag(Tp, TSTR, 16 * it, 32 * kk, lane), a2 = ldfrag(Tpp, TSTR, 16 * it, 32 * kk, lane);
#pragma unroll
            for (int x = 0; x < 4; ++x) { const int dt = half * 4 + x;
                aw[x] = MFMA16(a1, ldfrag_tr(ks, QSTR, 16 * dt, 32 * kk, lane), aw[x]);
                au[x] = MFMA16(a2, ldfrag_tr(vs, QSTR, 16 * dt, 32 * kk, lane), au[x]); }
        }
        __syncthreads();
#pragma unroll
        for (int x = 0; x < 4; ++x) { const int d = 16 * (half * 4 + x) + l15, i0 = 16 * it + 4 * q4;
            *(u32x2*)(WT + d * TSTR + i0) = (u32x2){pk2(aw[x][0], aw[x][1]), pk2(aw[x][2], aw[x][3])};
            *(u32x2*)(UT + d * TSTR + i0) = (u32x2){pk2(au[x][0], au[x][1]), pk2(au[x][2], au[x][3])}; }
    }
    __syncthreads();
    {
        bf16_t* gAP = (bf16_t*)(rec + GP_AP); bf16_t* gQH = (bf16_t*)(rec + GP_QH); bf16_t* gKH = (bf16_t*)(rec + GP_KH); bf16_t* gOH = (bf16_t*)(rec + GP_OH);
        {
            const int et = w;
            const bf16x8 a0 = ldfrag(WT, TSTR, 16 * et, 0, lane), a1 = ldfrag(WT, TSTR, 16 * et, 32, lane);
#pragma unroll
            for (int dt = 0; dt < 8; ++dt) { f32x4 acc = {0.f, 0.f, 0.f, 0.f};
                acc = MFMA16(a0, ldfrag_tr(kts, QSTR, 16 * dt, 0, lane), acc); acc = MFMA16(a1, ldfrag_tr(kts, QSTR, 16 * dt, 32, lane), acc);
                *(u32x2*)(gAP + ((size_t)(dt * 4 + (et >> 1)) * 64 + lane) * 8 + (et & 1) * 4) = (u32x2){pk2(-acc[0], -acc[1]), pk2(-acc[2], -acc[3])}; }
#pragma unroll
            for (int tt = 0; tt < 4; ++tt) { f32x4 acc = {0.f, 0.f, 0.f, 0.f};
                acc = MFMA16(a0, ldfrag(QKm, TSTR, 16 * tt, 0, lane), acc); acc = MFMA16(a1, ldfrag(QKm, TSTR, 16 * tt, 32, lane), acc);
                const int t = 16 * tt + l15, e0 = 16 * et + 4 * q4; const float eg = egs[t];
                const u32x2 qq = *(const u32x2*)(qs + t * QSTR + e0);
                const float o0 = __uint_as_float(qq.x << 16) * eg - acc[0], o1 = __uint_as_float(qq.x & 0xffff0000u) * eg - acc[1],
                            o2 = __uint_as_float(qq.y << 16) * eg - acc[2], o3 = __uint_as_float(qq.y & 0xffff0000u) * eg - acc[3];
                *(u32x2*)(gQH + ((size_t)(tt * 4 + (et >> 1)) * 64 + lane) * 8 + (et & 1) * 4) = (u32x2){pk2(o0, o1), pk2(o2, o3)}; }
        }
        {
            const int dt = w;
            const bf16x8 a0 = ldfrag_tr(kts, QSTR, 16 * dt, 0, lane), a1 = ldfrag_tr(kts, QSTR, 16 * dt, 32, lane);
#pragma unroll
            for (int vt = 0; vt < 8; ++vt) { f32x4 acc = {0.f, 0.f, 0.f, 0.f};
                acc = MFMA16(a0, ldfrag(UT, TSTR, 16 * vt, 0, lane), acc); acc = MFMA16(a1, ldfrag(UT, TSTR, 16 * vt, 32, lane), acc);
                *(u32x2*)(gKH + ((size_t)(vt * 8 + dt) * 64 + lane) * 4) = (u32x2){pk2(acc[0], acc[1]), pk2(acc[2], acc[3])}; }
            const int tt = w & 3, vh = w >> 2;
            const bf16x8 b0 = ldfrag(QKm, TSTR, 16 * tt, 0, lane), b1 = ldfrag(QKm, TSTR, 16 * tt, 32, lane);
#pragma unroll
            for (int x = 0; x < 4; ++x) { const int vt = vh * 4 + x; f32x4 acc = {0.f, 0.f, 0.f, 0.f};
                acc = MFMA16(b0, ldfrag(UT, TSTR, 16 * vt, 0, lane), acc); acc = MFMA16(b1, ldfrag(UT, TSTR, 16 * vt, 32, lane), acc);
                *(u32x2*)(gOH + ((size_t)(vt * 4 + tt) * 64 + lane) * 4) = (u32x2){pk2(acc[0], acc[1]), pk2(acc[2], acc[3])}; }
        }
    }
    __syncthreads();
}

__device__ __forceinline__ void phase_gprep(const Params& p, int seg, unsigned char* smem) {
    const int blk = obid();
    const int n_items = (CPS + (seg == 0 ? 1 : 0)) * 64;
#pragma unroll 1
    for (int it = blk; it < n_items; it += gridDim.x) {
        const int bh = it & 63, b = bh >> 3, h = bh & 7; int cl = it >> 6; if (seg != 0) cl += 1;
        unsigned char* rec = p.ws + WS_GP + (size_t)(cl * 64 + bh) * GP_STRIDE;
        const bf16_t* Pb = (const bf16_t*)(p.ws + WS_P);
        bf16_t* chalo2 = (bf16_t*)(p.ws + WS_CHALO);
        if (cl == 0) gdn_prep_item(p, smem, h, LEX0, 48, nullptr, nullptr, nullptr, rec);
        else {
            const int row = b * SEGTOK + (cl - 1) * 64;
            const bf16_t* hbase = Pb + (size_t)(row - 3) * NPB;
            if (cl == 1) hbase = (seg == 0) ? Pb + (size_t)(LEX0 + NMETA - 3) * NPB : chalo2 + (size_t)(((seg - 1) & 1) * NBATCH + b) * 3 * NPB;
            bf16_t* ho = (cl == CPS) ? chalo2 + (size_t)((seg & 1) * NBATCH + b) * 3 * NPB : nullptr;
            float* co = (cl == CPS && seg == NSEG - 1) ? p.out + O_CONV_P + (size_t)b * 9216 : nullptr;
            gdn_prep_item(p, smem, h, row, 0, hbase, ho, co, rec);
        }
    }
}

__device__ __forceinline__ void gdn_scan_block(const Params& p, int seg, unsigned char* smem, int bh) {
    const int tid = otid(), w = tid >> 6, lane = tid & 63, q4 = lane >> 4, l15 = lane & 15;
    const int b = bh >> 3, h = bh & 7;
    float* st = p.out + O_GDN_P + (size_t)bh * 16384;
    f32x4 S[8];
    if (seg) {
#pragma unroll
        for (int mt = 0; mt < 8; ++mt)
#pragma unroll
            for (int r = 0; r < 4; ++r) S[mt][r] = st[(size_t)(16 * mt + 4 * q4 + r) * 128 + 16 * w + l15];
    } else {
#pragma unroll
        for (int mt = 0; mt < 8; ++mt) S[mt] = (f32x4){0.f, 0.f, 0.f, 0.f};
    }
    const int c_lo = seg ? 1 : 0;
    float* obuf = (float*)(smem + 98304);
    {
        const u32x4* src = (const u32x4*)(p.ws + WS_GP + (size_t)(c_lo * 64 + bh) * GP_STRIDE); u32x4* dst = (u32x4*)smem;
#pragma unroll
        for (int x = 0; x < 6; ++x) dst[tid + 512 * x] = src[tid + 512 * x];
    }
#pragma unroll 1
    for (int cl = c_lo; cl <= CPS; ++cl) {
        const unsigned char* rec = p.ws + WS_GP + (size_t)(cl * 64 + bh) * GP_STRIDE;
        const int cur = (cl - c_lo) & 1;
        __syncthreads();
        u32x4 nx[6];
        const bool more = cl < CPS;
        if (more) { const u32x4* src = (const u32x4*)(rec + GP_STRIDE * 64);
#pragma unroll
            for (int x = 0; x < 6; ++x) nx[x] = src[tid + 512 * x]; }
        const bf16_t* gKH = (const bf16_t*)(rec + GP_KH); const bf16_t* gOH = (const bf16_t*)(rec + GP_OH);
        u32x2 kh[8], oh[4];
#pragma unroll
        for (int mt = 0; mt < 8; ++mt) kh[mt] = *(const u32x2*)(gKH + ((size_t)(w * 8 + mt) * 64 + lane) * 4);
#pragma unroll
        for (int tt = 0; tt < 4; ++tt) oh[tt] = *(const u32x2*)(gOH + ((size_t)(w * 4 + tt) * 64 + lane) * 4);
        const float egl = *(const float*)(rec + GP_EGL);
        const int et = tid >> 3, eg = tid & 7;
        const bf16_t* gp = (const bf16_t*)(rec + GP_G) + et * 128 + 16 * eg;
        u32x4 z0 = {0u, 0u, 0u, 0u}, z1 = {0u, 0u, 0u, 0u};
        if (cl > 0) { z0 = *(const u32x4*)gp; z1 = *(const u32x4*)(gp + 8); }
        bf16x8 Bf[4];
#pragma unroll
        for (int ks = 0; ks < 4; ++ks) { u32x4 t; t.x = pk2(S[2 * ks][0], S[2 * ks][1]); t.y = pk2(S[2 * ks][2], S[2 * ks][3]); t.z = pk2(S[2 * ks + 1][0], S[2 * ks + 1][1]); t.w = pk2(S[2 * ks + 1][2], S[2 * ks + 1][3]);
            Bf[ks] = __builtin_bit_cast(bf16x8, t); }
        const bf16x8* AP = (const bf16x8*)(smem + cur * 49152); const bf16x8* QH = (const bf16x8*)(smem + cur * 49152 + GP_QH);
        f32x4 o[4], tS[8];
#pragma unroll
        for (int tt = 0; tt < 4; ++tt) { o[tt] = (f32x4){0.f, 0.f, 0.f, 0.f};
#pragma unroll
            for (int ks = 0; ks < 4; ++ks) o[tt] = MFMA16(QH[(tt * 4 + ks) * 64 + lane], Bf[ks], o[tt]); }
#pragma unroll
        for (int mt = 0; mt < 8; ++mt) { tS[mt] = (f32x4){0.f, 0.f, 0.f, 0.f};
#pragma unroll
            for (int ks = 0; ks < 4; ++ks) tS[mt] = MFMA16(AP[(mt * 4 + ks) * 64 + lane], Bf[ks], tS[mt]); }
#pragma unroll
        for (int mt = 0; mt < 8; ++mt) {
            S[mt][0] = egl * S[mt][0] + tS[mt][0] + __uint_as_float(kh[mt].x << 16); S[mt][1] = egl * S[mt][1] + tS[mt][1] + __uint_as_float(kh[mt].x & 0xffff0000u);
            S[mt][2] = egl * S[mt][2] + tS[mt][2] + __uint_as_float(kh[mt].y << 16); S[mt][3] = egl * S[mt][3] + tS[mt][3] + __uint_as_float(kh[mt].y & 0xffff0000u); }
        if (cl > 0) {
#pragma unroll
            for (int tt = 0; tt < 4; ++tt) {
                o[tt][0] += __uint_as_float(oh[tt].x << 16); o[tt][1] += __uint_as_float(oh[tt].x & 0xffff0000u); o[tt][2] += __uint_as_float(oh[tt].y << 16); o[tt][3] += __uint_as_float(oh[tt].y & 0xffff0000u);
#pragma unroll
                for (int r = 0; r < 4; ++r) obuf[(16 * tt + 4 * q4 + r) * 132 + 16 * w + l15] = o[tt][r]; }
        }
        if (more) { u32x4* dst = (u32x4*)(smem + (cur ^ 1) * 49152);
#pragma unroll
            for (int x = 0; x < 6; ++x) dst[tid + 512 * x] = nx[x]; }
        if (cl > 0) {
            __syncthreads();
            f32x4 ov[4]; float ss = 0.f;
#pragma unroll
            for (int j = 0; j < 4; ++j) { ov[j] = *(const f32x4*)(obuf + et * 132 + 16 * eg + 4 * j); ss += ov[j][0] * ov[j][0] + ov[j][1] * ov[j][1] + ov[j][2] * ov[j][2] + ov[j][3] * ov[j][3]; }
            ss += __shfl_xor(ss, 1); ss += __shfl_xor(ss, 2); ss += __shfl_xor(ss, 4);
            const float rs = __builtin_amdgcn_rsqf(ss * (1.f / 128.f) + 1e-6f);
            const unsigned zz[8] = {z0.x, z0.y, z0.z, z0.w, z1.x, z1.y, z1.z, z1.w};
            unsigned ow[8];
#pragma unroll
            for (int j = 0; j < 8; ++j) ow[j] = pk2(ov[j >> 1][(j & 1) * 2] * rs * __uint_as_float(zz[j] << 16), ov[j >> 1][(j & 1) * 2 + 1] * rs * __uint_as_float(zz[j] & 0xffff0000u));
            const size_t grow = (size_t)b * SEQ + seg * SEGTOK + (cl - 1) * 64 + et;
            bf16_t* oa = (bf16_t*)(p.ws + WS_H) + grow * D + h * 128 + 16 * eg;
            *(u32x4*)oa = (u32x4){ow[0], ow[1], ow[2], ow[3]}; *(u32x4*)(oa + 8) = (u32x4){ow[4], ow[5], ow[6], ow[7]};
        }
    }
#pragma unroll
    for (int mt = 0; mt < 8; ++mt)
#pragma unroll
        for (int r = 0; r < 4; ++r) st[(size_t)(16 * mt + 4 * q4 + r) * 128 + 16 * w + l15] = S[mt][r];
    __syncthreads();
}

constexpr int RL_AT = 0, RL_BT = 9216, RL_KT = 18432, RL_ATT = 27648, RL_RT = 36864, RL_BTLT = 46080, RL_KTLT = 55296, RL_VT = 64512, RL_LAK = 73728, RL_MRB = 82944, RL_MRK = 92160,
              RL_LM = 101376, RL_AF = 117760, RL_TM = 134144, RL_XS = 150528;
__device__ __forceinline__ void rwkv_prep_item(const Params& p, unsigned char* smem, int hb, int row_start, int npad, const bf16_t* prev_row,
                                               bf16_t* halo_out, unsigned char* rec) {
    const int tid = otid(), w = tid >> 6, lane = tid & 63, q4 = lane >> 4, l15 = lane & 15;
    bf16_t* At = (bf16_t*)(smem + RL_AT); bf16_t* Tb = At; bf16_t* Bt = (bf16_t*)(smem + RL_BT); bf16_t* WaT = Bt; bf16_t* Kt = (bf16_t*)(smem + RL_KT); bf16_t* XT = Kt;
    bf16_t* At2 = (bf16_t*)(smem + RL_ATT); bf16_t* Rt = (bf16_t*)(smem + RL_RT); bf16_t* Btl = (bf16_t*)(smem + RL_BTLT); bf16_t* Ktl = (bf16_t*)(smem + RL_KTLT);
    bf16_t* Vr = (bf16_t*)(smem + RL_VT);        bf16_t* Lak = (bf16_t*)(smem + RL_LAK); bf16_t* Mrb = (bf16_t*)(smem + RL_MRB); bf16_t* Mrk = (bf16_t*)(smem + RL_MRK);
    float* Lm = (float*)(smem + RL_LM);
    bf16_t* thw = Lak; bf16_t* adb = Mrb; float* lc = Lm; float* af = (float*)(smem + RL_AF);
    const bf16_t* P = (const bf16_t*)(p.ws + WS_P);
    const float* pk = (const float*)(p.ws + WS_PK);
    const int t = tid >> 3, g = tid & 7;
    float rr[8], kb[8], vv[8], zb[8];
    {
        const bool real = t >= npad;
        const bf16_t* curp = P; const bf16_t* prevp = P; float fprev = 0.f;
        if (real) { curp = P + (size_t)(row_start + t - npad) * NPB; if (t > npad) { prevp = curp - NPB; fprev = 1.f; } else if (prev_row) { prevp = prev_row; fprev = 1.f; } }
        const int secbase[6] = {0, 1024, 2048, 3200, 3072, 3136};
        u32x4 rc[6], rp[6];
#pragma unroll
        for (int sidx = 0; sidx < 6; ++sidx) { const int col = secbase[sidx] + (sidx < 4 ? hb * 64 : 0) + g * 8; rc[sidx] = *(const u32x4*)(curp + C_RW + col); rp[sidx] = *(const u32x4*)(prevp + C_RW + col); }
        float m[6][8];
#pragma unroll
        for (int sidx = 0; sidx < 6; ++sidx) {
            const int col = secbase[sidx] + (sidx < 4 ? hb * 64 : 0) + g * 8;
            float cur[8], prv[8];
            unpack8(rc[sidx], cur); unpack8(rp[sidx], prv);
            const f32x4 mu0 = *(const f32x4*)(pk + PK_MU + col), mu1 = *(const f32x4*)(pk + PK_MU + col + 4);
            const float mu[8] = {mu0[0], mu0[1], mu0[2], mu0[3], mu1[0], mu1[1], mu1[2], mu1[3]};
#pragma unroll
            for (int e = 0; e < 8; ++e) m[sidx][e] = real ? cur[e] + mu[e] * (fprev * prv[e] - cur[e]) : 0.f;
            if (halo_out && t == 63 && (sidx < 4 || hb == 0)) *(u32x4*)(halo_out + C_RW + col) = rc[sidx];
        }
#pragma unroll
        for (int e = 0; e < 8; ++e) { rr[e] = m[0][e]; kb[e] = m[1][e]; vv[e] = m[2][e]; zb[e] = m[3][e]; }
        float th[8];
#pragma unroll
        for (int e = 0; e < 8; ++e) th[e] = tanh_(m[4][e]);
        *(u32x4*)(thw + t * TSTR + g * 8) = pack8(th);
        *(u32x4*)(adb + t * TSTR + g * 8) = pack8(m[5]);
    }
    __syncthreads();
    {
        const int which = w >> 2, ct = w & 3;
        const bf16_t* Wt = (const bf16_t*)(p.ws + (which ? WS_A2T : WS_W2T)) + (size_t)hb * 4096;
        const bf16x8 b0 = *(const bf16x8*)(Wt + (16 * ct + l15) * 64 + 8 * q4), b1 = *(const bf16x8*)(Wt + (16 * ct + l15) * 64 + 32 + 8 * q4);
        const bf16_t* Aarr = which ? adb : thw;
        const int c = 16 * ct + l15;
        const float bias = pk[(which ? PK_A0 : PK_W0) + hb * 64 + c];
        float carry = 0.f;
#pragma unroll
        for (int tt = 0; tt < 4; ++tt) {
            f32x4 acc = {0.f, 0.f, 0.f, 0.f};
            acc = MFMA16(ldfrag(Aarr, TSTR, 16 * tt, 0, lane), b0, acc); acc = MFMA16(ldfrag(Aarr, TSTR, 16 * tt, 32, lane), b1, acc);
            if (which) {
#pragma unroll
                for (int r = 0; r < 4; ++r) af[(16 * tt + 4 * q4 + r) * 64 + c] = sigm(bias + acc[r]);
            } else {
                float wl[4];
#pragma unroll
                for (int r = 0; r < 4; ++r) { const int tk = 16 * tt + 4 * q4 + r; wl[r] = (tk < npad) ? 0.f : -0.6065306597126334f * sigm(bias + acc[r]); }
                wl[1] += wl[0]; wl[2] += wl[1]; wl[3] += wl[2];
                const float Q = wl[3];
                const float Q0 = __shfl(Q, l15), Q1 = __shfl(Q, l15 + 16), Q2 = __shfl(Q, l15 + 32), Q3 = __shfl(Q, l15 + 48);
                const float ex = carry + (q4 > 0 ? Q0 : 0.f) + (q4 > 1 ? Q1 : 0.f) + (q4 > 2 ? Q2 : 0.f);
#pragma unroll
                for (int r = 0; r < 4; ++r) lc[(16 * tt + 4 * q4 + r) * 64 + c] = ex + wl[r];
                carry += Q0 + Q1 + Q2 + Q3;
            }
        }
    }
    __syncthreads();
    {
        float lct[8], lcp[8], lcC[8], av[8];
        { const f32x4 a = *(const f32x4*)(lc + t * 64 + g * 8), b2 = *(const f32x4*)(lc + t * 64 + g * 8 + 4); lct[0] = a[0]; lct[1] = a[1]; lct[2] = a[2]; lct[3] = a[3]; lct[4] = b2[0]; lct[5] = b2[1]; lct[6] = b2[2]; lct[7] = b2[3]; }
        if (t > 0) { const f32x4 a = *(const f32x4*)(lc + (t - 1) * 64 + g * 8), b2 = *(const f32x4*)(lc + (t - 1) * 64 + g * 8 + 4); lcp[0] = a[0]; lcp[1] = a[1]; lcp[2] = a[2]; lcp[3] = a[3]; lcp[4] = b2[0]; lcp[5] = b2[1]; lcp[6] = b2[2]; lcp[7] = b2[3]; }
        else {
#pragma unroll
            for (int e = 0; e < 8; ++e) lcp[e] = 0.f; }
        { const f32x4 a = *(const f32x4*)(lc + 63 * 64 + g * 8), b2 = *(const f32x4*)(lc + 63 * 64 + g * 8 + 4); lcC[0] = a[0]; lcC[1] = a[1]; lcC[2] = a[2]; lcC[3] = a[3]; lcC[4] = b2[0]; lcC[5] = b2[1]; lcC[6] = b2[2]; lcC[7] = b2[3]; }
        { const f32x4 a = *(const f32x4*)(af + t * 64 + g * 8), b2 = *(const f32x4*)(af + t * 64 + g * 8 + 4); av[0] = a[0]; av[1] = a[1]; av[2] = a[2]; av[3] = a[3]; av[4] = b2[0]; av[5] = b2[1]; av[6] = b2[2]; av[7] = b2[3]; }
        const int hc = hb * 64 + g * 8;
        float kk[8], km[8], ss = 0.f, rk = 0.f;
#pragma unroll
        for (int e = 0; e < 8; ++e) { kk[e] = kb[e] * pk[PK_KK + hc + e]; ss += kk[e] * kk[e]; km[e] = kb[e] * (1.f + (av[e] - 1.f) * pk[PK_KA + hc + e]); rk += rr[e] * km[e] * pk[PK_RK + hc + e]; }
        ss += __shfl_xor(ss, 1); ss += __shfl_xor(ss, 2); ss += __shfl_xor(ss, 4);
        rk += __shfl_xor(rk, 1); rk += __shfl_xor(rk, 2); rk += __shfl_xor(rk, 4);
        const float kn = __builtin_amdgcn_rsqf(ss + 1e-6f);
        float xa[8], xb[8], xk[8], xr[8], xbt[8], xkt[8];
#pragma unroll
        for (int e = 0; e < 8; ++e) { kk[e] *= kn; const float ka = kk[e] * av[e]; const float ip = __expf(-lct[e]), tl = __expf(lcC[e] - lct[e]);
            xa[e] = kk[e] * __expf(lcp[e]); xb[e] = ka * ip; xk[e] = km[e] * ip; xr[e] = rr[e] * __expf(lct[e]); xbt[e] = ka * tl; xkt[e] = km[e] * tl; }
        *(u32x4*)(At + t * TSTR + g * 8) = pack8(xa); *(u32x4*)(Bt + t * TSTR + g * 8) = pack8(xb); *(u32x4*)(Kt + t * TSTR + g * 8) = pack8(xk); *(u32x4*)(Rt + t * TSTR + g * 8) = pack8(xr);
        *(u32x4*)(At2 + t * TSTR + g * 8) = pack8(xa); *(u32x4*)(Btl + t * TSTR + g * 8) = pack8(xbt); *(u32x4*)(Ktl + t * TSTR + g * 8) = pack8(xkt); *(u32x4*)(Vr + t * TSTR + g * 8) = pack8(vv);
        float c1[8], c0[8];
#pragma unroll
        for (int e = 0; e < 8; ++e) { const float sz = silu_(zb[e]); c1[e] = pk[PK_GNW + hc + e] * sz; c0[e] = (pk[PK_GNB + hc + e] + rk * vv[e]) * sz; }
        *(u32x4*)((bf16_t*)(rec + RP_C1) + t * 64 + g * 8) = pack8(c1); *(u32x4*)((bf16_t*)(rec + RP_C0) + t * 64 + g * 8) = pack8(c0);
        if (t == 63) { float* pc = (float*)(rec + RP_PC) + g * 8; *(f32x4*)pc = (f32x4){__expf(lcC[0]), __expf(lcC[1]), __expf(lcC[2]), __expf(lcC[3])}; *(f32x4*)(pc + 4) = (f32x4){__expf(lcC[4]), __expf(lcC[5]), __expf(lcC[6]), __expf(lcC[7])}; }
    }
    __syncthreads();
    {
        const int pr = w >> 1;
        const bf16_t* Aarr = pr < 2 ? At : Rt; const bf16_t* Barr = (pr & 1) ? Kt : Bt;
#pragma unroll
        for (int x = 0; x < 2; ++x) { const int tt = 2 * (w & 1) + x;
            const bf16x8 a0 = ldfrag(Aarr, TSTR, 16 * tt, 0, lane), a1 = ldfrag(Aarr, TSTR, 16 * tt, 32, lane);
            const int tk = 16 * tt + l15;
#pragma unroll
            for (int it = 0; it < 4; ++it) { f32x4 acc = {0.f, 0.f, 0.f, 0.f};
                acc = MFMA16(ldfrag(Barr, TSTR, 16 * it, 0, lane), a0, acc); acc = MFMA16(ldfrag(Barr, TSTR, 16 * it, 32, lane), a1, acc);
                const int i0 = 16 * it + 4 * q4;
                f32x4 o;
#pragma unroll
                for (int r = 0; r < 4; ++r) { const int i = i0 + r; const bool keep = pr < 2 ? (tk > i) : (tk >= i); o[r] = keep ? acc[r] : 0.f; }
                if (pr == 0) *(f32x4*)(Lm + tk * 64 + i0) = o;
                else { bf16_t* Out = pr == 1 ? Lak : (pr == 2 ? Mrb : Mrk); *(u32x2*)(Out + tk * TSTR + i0) = (u32x2){pk2(o[0], o[1]), pk2(o[2], o[3])}; } }
        }
    }
    __syncthreads();
    {
        float* Tm = (float*)(smem + RL_TM);
        inv_block(Lm, Tm, (float*)(smem + RL_XS), tid);
        const int i = tid >> 3, j0 = (tid & 7) * 8;
        float a[8];
#pragma unroll
        for (int e = 0; e < 8; ++e) a[e] = Tm[i * 64 + j0 + e];
        *(u32x4*)(Tb + i * TSTR + j0) = pack8(a);
    }
    __syncthreads();
    {
        const int tt = w & 3, which = w >> 2;
        const bf16_t* Aarr = which ? Lak : Tb; const bf16_t* Barr = which ? Vr : At2; bf16_t* Out = which ? XT : WaT;
        const bf16x8 a0 = ldfrag(Aarr, TSTR, 16 * tt, 0, lane), a1 = ldfrag(Aarr, TSTR, 16 * tt, 32, lane);
#pragma unroll
        for (int ct = 0; ct < 4; ++ct) { f32x4 acc = {0.f, 0.f, 0.f, 0.f};
            acc = MFMA16(a0, ldfrag_tr(Barr, TSTR, 16 * ct, 0, lane), acc); acc = MFMA16(a1, ldfrag_tr(Barr, TSTR, 16 * ct, 32, lane), acc);
            *(u32x2*)(Out + (16 * ct + l15) * TSTR + 16 * tt + 4 * q4) = (u32x2){pk2(acc[0], acc[1]), pk2(acc[2], acc[3])}; }
    }
    __syncthreads();
    {
        f32x4 acc[4];
        if (w < 4) {
            const bf16x8 a0 = ldfrag(Tb, TSTR, 16 * w, 0, lane), a1 = ldfrag(Tb, TSTR, 16 * w, 32, lane);
#pragma unroll
            for (int ct = 0; ct < 4; ++ct) { acc[ct] = (f32x4){0.f, 0.f, 0.f, 0.f};
                acc[ct] = MFMA16(a0, ldfrag(XT, TSTR, 16 * ct, 0, lane), acc[ct]); acc[ct] = MFMA16(a1, ldfrag(XT, TSTR, 16 * ct, 32, lane), acc[ct]); }
        }
        __syncthreads();
        if (w < 4) {
#pragma unroll
            for (int ct = 0; ct < 4; ++ct) *(u32x2*)(XT + (16 * ct + l15) * TSTR + 16 * w + 4 * q4) = (u32x2){pk2(-acc[ct][0], -acc[ct][1]), pk2(-acc[ct][2], -acc[ct][3])};
        }
    }
    __syncthreads();
    {
        const bf16_t* UvT = XT;
        bf16_t* gAP = (bf16_t*)(rec + RP_AP); bf16_t* gRH = (bf16_t*)(rec + RP_RH); bf16_t* gKH = (bf16_t*)(rec + RP_KH); bf16_t* gYH = (bf16_t*)(rec + RP_YH);
        const int et = w & 3, part = w >> 2;
        {
            const bf16x8 a0 = ldfrag(WaT, TSTR, 16 * et, 0, lane), a1 = ldfrag(WaT, TSTR, 16 * et, 32, lane);
            if (part == 0) {
#pragma unroll
                for (int kt = 0; kt < 4; ++kt) { f32x4 acc = {0.f, 0.f, 0.f, 0.f};
                    acc = MFMA16(a0, ldfrag_tr(Btl, TSTR, 16 * kt, 0, lane), acc); acc = MFMA16(a1, ldfrag_tr(Btl, TSTR, 16 * kt, 32, lane), acc);
                    *(u32x2*)(gAP + ((size_t)(kt * 2 + (et >> 1)) * 64 + lane) * 8 + (et & 1) * 4) = (u32x2){pk2(-acc[0], -acc[1]), pk2(-acc[2], -acc[3])}; }
            } else {
#pragma unroll
                for (int tt = 0; tt < 4; ++tt) { f32x4 acc = {0.f, 0.f, 0.f, 0.f};
                    acc = MFMA16(a0, ldfrag(Mrb, TSTR, 16 * tt, 0, lane), acc); acc = MFMA16(a1, ldfrag(Mrb, TSTR, 16 * tt, 32, lane), acc);
                    const int tk = 16 * tt + l15, e0 = 16 * et + 4 * q4;
                    const u32x2 q2 = *(const u32x2*)(Rt + tk * TSTR + e0);
                    const float o0 = __uint_as_float(q2.x << 16) - acc[0], o1 = __uint_as_float(q2.x & 0xffff0000u) - acc[1], o2 = __uint_as_float(q2.y << 16) - acc[2], o3 = __uint_as_float(q2.y & 0xffff0000u) - acc[3];
                    *(u32x2*)(gRH + ((size_t)(tt * 2 + (et >> 1)) * 64 + lane) * 8 + (et & 1) * 4) = (u32x2){pk2(o0, o1), pk2(o2, o3)}; }
            }
        }
        {
            const int rt = w & 3;
            bf16_t* Out = part ? gKH : gYH;
            bf16x8 a0, a1, a2, a3;
            if (part) { a0 = ldfrag_tr(Btl, TSTR, 16 * rt, 0, lane); a1 = ldfrag_tr(Btl, TSTR, 16 * rt, 32, lane); a2 = ldfrag_tr(Ktl, TSTR, 16 * rt, 0, lane); a3 = ldfrag_tr(Ktl, TSTR, 16 * rt, 32, lane); }
            else { a0 = ldfrag(Mrb, TSTR, 16 * rt, 0, lane); a1 = ldfrag(Mrb, TSTR, 16 * rt, 32, lane); a2 = ldfrag(Mrk, TSTR, 16 * rt, 0, lane); a3 = ldfrag(Mrk, TSTR, 16 * rt, 32, lane); }
#pragma unroll
            for (int vt = 0; vt < 4; ++vt) { f32x4 acc = {0.f, 0.f, 0.f, 0.f};
                acc = MFMA16(a0, ldfrag(UvT, TSTR, 16 * vt, 0, lane), acc); acc = MFMA16(a1, ldfrag(UvT, TSTR, 16 * vt, 32, lane), acc);
                acc = MFMA16(a2, ldfrag_tr(Vr, TSTR, 16 * vt, 0, lane), acc); acc = MFMA16(a3, ldfrag_tr(Vr, TSTR, 16 * vt, 32, lane), acc);
                *(u32x2*)(Out + ((size_t)(vt * 4 + rt) * 64 + lane) * 4) = (u32x2){pk2(acc[0], acc[1]), pk2(acc[2], acc[3])}; }
        }
    }
    __syncthreads();
}

__device__ __forceinline__ void phase_rprep(const Params& p, int seg, unsigned char* smem) {
    const int blk = obid();
    const int n_items = (CPS + (seg == 0 ? 1 : 0)) * 128;
#pragma unroll 1
    for (int it = (blk + (gridDim.x >> 1)) % gridDim.x; it < n_items; it += gridDim.x) {
        const int bh = it & 127, b = bh >> 4, hb = bh & 15; int cl = it >> 7; if (seg != 0) cl += 1;
        unsigned char* rec = p.ws + WS_RP + (size_t)(cl * 128 + bh) * RP_STRIDE;
        const bf16_t* Pb = (const bf16_t*)(p.ws + WS_P);
        bf16_t* phalo2 = (bf16_t*)(p.ws + WS_PHALO);
        if (cl == 0) rwkv_prep_item(p, smem, hb, LEX0, 48, nullptr, nullptr, rec);
        else {
            const int row = b * SEGTOK + (cl - 1) * 64;
            const bf16_t* prow = Pb + (size_t)(row - 1) * NPB;
            if (cl == 1) prow = (seg == 0) ? Pb + (size_t)(LEX0 + NMETA - 1) * NPB : phalo2 + (size_t)(((seg - 1) & 1) * NBATCH + b) * NPB;
            bf16_t* ho = (cl == CPS) ? phalo2 + (size_t)((seg & 1) * NBATCH + b) * NPB : nullptr;
            rwkv_prep_item(p, smem, hb, row, 0, prow, ho, rec);
        }
    }
}

__device__ __forceinline__ void rwkv_scan_block(const Params& p, int seg, unsigned char* smem, int pairidx) {
    const int tid = otid(), w = tid >> 6, lane = tid & 63, q4 = lane >> 4, l15 = lane & 15;
    const int hsel = w >> 2, vt = w & 3;
    const int bh = pairidx * 2 + hsel, b = bh >> 4, hb = bh & 15;
    float* st = p.out + O_RWKV_P + (size_t)bh * 4096;
    f32x4 S[4];
    if (seg) {
#pragma unroll
        for (int mt = 0; mt < 4; ++mt) S[mt] = *(const f32x4*)(st + (size_t)(16 * vt + l15) * 64 + 16 * mt + 4 * q4);
    } else {
#pragma unroll
        for (int mt = 0; mt < 4; ++mt) S[mt] = (f32x4){0.f, 0.f, 0.f, 0.f};
    }
    const int c_lo = seg ? 1 : 0;
    float* ybuf = (float*)(smem + 65536) + hsel * (64 * 68);
    const int tl = tid & 255;
    {
        const u32x4* src = (const u32x4*)(p.ws + WS_RP + (size_t)(c_lo * 128 + bh) * RP_STRIDE); u32x4* dst = (u32x4*)(smem + hsel * 16384);
#pragma unroll
        for (int x = 0; x < 4; ++x) dst[tl + 256 * x] = src[tl + 256 * x];
    }
#pragma unroll 1
    for (int cl = c_lo; cl <= CPS; ++cl) {
        const unsigned char* rec = p.ws + WS_RP + (size_t)(cl * 128 + bh) * RP_STRIDE;
        const int cur = (cl - c_lo) & 1;
        __syncthreads();
        u32x4 nx[4];
        const bool more = cl < CPS;
        if (more) { const u32x4* src = (const u32x4*)(rec + (size_t)RP_STRIDE * 128);
#pragma unroll
            for (int x = 0; x < 4; ++x) nx[x] = src[tl + 256 * x]; }
        const bf16_t* gKH = (const bf16_t*)(rec + RP_KH); const bf16_t* gYH = (const bf16_t*)(rec + RP_YH);
        u32x2 kh[4], yh[4]; f32x4 pc[4];
#pragma unroll
        for (int mt = 0; mt < 4; ++mt) { kh[mt] = *(const u32x2*)(gKH + ((size_t)(vt * 4 + mt) * 64 + lane) * 4); yh[mt] = *(const u32x2*)(gYH + ((size_t)(vt * 4 + mt) * 64 + lane) * 4);
            pc[mt] = *(const f32x4*)((const float*)(rec + RP_PC) + 16 * mt + 4 * q4); }
        const int tk = tl >> 2, g = tl & 3;
        u32x4 a0 = {0u, 0u, 0u, 0u}, a1 = a0, b0 = a0, b1 = a0;
        if (cl > 0) { const bf16_t* c1p = (const bf16_t*)(rec + RP_C1) + tk * 64 + 16 * g; const bf16_t* c0p = (const bf16_t*)(rec + RP_C0) + tk * 64 + 16 * g;
            a0 = *(const u32x4*)c0p; a1 = *(const u32x4*)(c0p + 8); b0 = *(const u32x4*)c1p; b1 = *(const u32x4*)(c1p + 8); }
        bf16x8 Bf[2];
#pragma unroll
        for (int ks = 0; ks < 2; ++ks) { u32x4 tq; tq.x = pk2(S[2 * ks][0], S[2 * ks][1]); tq.y = pk2(S[2 * ks][2], S[2 * ks][3]); tq.z = pk2(S[2 * ks + 1][0], S[2 * ks + 1][1]); tq.w = pk2(S[2 * ks + 1][2], S[2 * ks + 1][3]);
            Bf[ks] = __builtin_bit_cast(bf16x8, tq); }
        const bf16x8* AP = (const bf16x8*)(smem + cur * 32768 + hsel * 16384); const bf16x8* RH = (const bf16x8*)(smem + cur * 32768 + hsel * 16384 + RP_RH);
        f32x4 y[4], tS[4];
#pragma unroll
        for (int tt = 0; tt < 4; ++tt) { y[tt] = (f32x4){0.f, 0.f, 0.f, 0.f}; y[tt] = MFMA16(RH[(tt * 2 + 0) * 64 + lane], Bf[0], y[tt]); y[tt] = MFMA16(RH[(tt * 2 + 1) * 64 + lane], Bf[1], y[tt]); }
#pragma unroll
        for (int mt = 0; mt < 4; ++mt) { tS[mt] = (f32x4){0.f, 0.f, 0.f, 0.f}; tS[mt] = MFMA16(AP[(mt * 2 + 0) * 64 + lane], Bf[0], tS[mt]); tS[mt] = MFMA16(AP[(mt * 2 + 1) * 64 + lane], Bf[1], tS[mt]); }
#pragma unroll
        for (int mt = 0; mt < 4; ++mt) {
            S[mt][0] = pc[mt][0] * S[mt][0] + tS[mt][0] + __uint_as_float(kh[mt].x << 16); S[mt][1] = pc[mt][1] * S[mt][1] + tS[mt][1] + __uint_as_float(kh[mt].x & 0xffff0000u);
            S[mt][2] = pc[mt][2] * S[mt][2] + tS[mt][2] + __uint_as_float(kh[mt].y << 16); S[mt][3] = pc[mt][3] * S[mt][3] + tS[mt][3] + __uint_as_float(kh[mt].y & 0xffff0000u); }
        if (cl > 0) {
#pragma unroll
            for (int tt = 0; tt < 4; ++tt) {
                y[tt][0] += __uint_as_float(yh[tt].x << 16); y[tt][1] += __uint_as_float(yh[tt].x & 0xffff0000u); y[tt][2] += __uint_as_float(yh[tt].y << 16); y[tt][3] += __uint_as_float(yh[tt].y & 0xffff0000u);
#pragma unroll
                for (int r = 0; r < 4; ++r) ybuf[(16 * tt + 4 * q4 + r) * 68 + 16 * vt + l15] = y[tt][r]; }
        }
        if (more) { u32x4* dst = (u32x4*)(smem + (cur ^ 1) * 32768 + hsel * 16384);
#pragma unroll
            for (int x = 0; x < 4; ++x) dst[tl + 256 * x] = nx[x]; }
        if (cl > 0) {
            __syncthreads();
            f32x4 yv[4]; float sm = 0.f;
#pragma unroll
            for (int j = 0; j < 4; ++j) { yv[j] = *(const f32x4*)(ybuf + tk * 68 + 16 * g + 4 * j); sm += yv[j][0] + yv[j][1] + yv[j][2] + yv[j][3]; }
            sm += __shfl_xor(sm, 1); sm += __shfl_xor(sm, 2);
            const float mu = sm * (1.f / 64.f); float vs = 0.f;
#pragma unroll
            for (int j = 0; j < 4; ++j) { yv[j] = yv[j] - mu; vs += yv[j][0] * yv[j][0] + yv[j][1] * yv[j][1] + yv[j][2] * yv[j][2] + yv[j][3] * yv[j][3]; }
            vs += __shfl_xor(vs, 1); vs += __shfl_xor(vs, 2);
            const float rs = __builtin_amdgcn_rsqf(vs * (1.f / 64.f) + 64e-5f);
            const unsigned c0w[8] = {a0.x, a0.y, a0.z, a0.w, a1.x, a1.y, a1.z, a1.w}, c1w[8] = {b0.x, b0.y, b0.z, b0.w, b1.x, b1.y, b1.z, b1.w};
            unsigned ow[8];
#pragma unroll
            for (int j = 0; j < 8; ++j) ow[j] = pk2(yv[j >> 1][(j & 1) * 2] * rs * __uint_as_float(c1w[j] << 16) + __uint_as_float(c0w[j] << 16),
                                                     yv[j >> 1][(j & 1) * 2 + 1] * rs * __uint_as_float(c1w[j] & 0xffff0000u) + __uint_as_float(c0w[j] & 0xffff0000u));
            const size_t grow = (size_t)b * SEQ + seg * SEGTOK + (cl - 1) * 64 + tk;
            bf16_t* ob = (bf16_t*)(p.ws + WS_OB) + grow * D + hb * 64 + 16 * g;
            *(u32x4*)ob = (u32x4){ow[0], ow[1], ow[2], ow[3]}; *(u32x4*)(ob + 8) = (u32x4){ow[4], ow[5], ow[6], ow[7]};
        }
    }
#pragma unroll
    for (int mt = 0; mt < 4; ++mt) *(f32x4*)(st + (size_t)(16 * vt + l15) * 64 + 16 * mt + 4 * q4) = S[mt];
    __syncthreads();
}

__device__ __forceinline__ void gdn_sample_item(const Params& p, unsigned char* smem, int bs, int h) {
    const int tid = otid(), w = tid >> 6, lane = tid & 63, kq = tid >> 7, v = tid & 127;
    float* qk_s = (float*)smem; float* v_s = qk_s + 1024; float* gb_s = v_s + 512; float* part = gb_s + 16; float* part2 = part + 512;
    const bf16_t* P = (const bf16_t*)(p.ws + WS_P);
    const float* pk = (const float*)(p.ws + WS_PK);
    const float* s_in = p.in[2] + (size_t)(bs * 8 + h) * 16384; float* s_out = p.out + O_GDN_S + (size_t)(bs * 8 + h) * 16384;
    const int row0 = LEX0 + EX_SAMP + bs * DECT;
    float s[32];
#pragma unroll
    for (int j = 0; j < 32; ++j) s[j] = s_in[(size_t)(kq * 32 + j) * 128 + v];
    if (tid < 384) {
        const int pcol = (tid >> 7) * 1024 + h * 128 + (tid & 127);
        const float* cw = pk + PK_CONVW; const float* hin = p.in[3] + (size_t)bs * 9216; float* hout = p.out + O_CONV_S + (size_t)bs * 9216;
        const float cw0 = cw[pcol], cw1 = cw[3072 + pcol], cw2 = cw[6144 + pcol], cw3 = cw[9216 + pcol];
        float x3 = hin[pcol], x2 = hin[3072 + pcol], x1 = hin[6144 + pcol];
        float xr[4];
#pragma unroll
        for (int i = 0; i < 4; ++i) xr[i] = bf2f(P[(size_t)(row0 + i) * NPB + pcol]);
#pragma unroll
        for (int i = 0; i < 4; ++i) { const float y = cw0 * x3 + cw1 * x2 + cw2 * x1 + cw3 * xr[i]; x3 = x2; x2 = x1; x1 = xr[i];
            if (tid < 256) qk_s[i * 256 + tid] = silu_(y); else v_s[i * 128 + (tid - 256)] = silu_(y); }
        hout[pcol] = x3; hout[3072 + pcol] = x2; hout[6144 + pcol] = x1;
    } else if (tid < 388) {
        const int i = tid - 384; const size_t r = (size_t)(row0 + i) * NPB;
        const float pa = bf2f(P[r + C_A + h]), pb = bf2f(P[r + C_B + h]);
        gb_s[2 * i] = __expf(-expf(pk[PK_ALOG + h]) * softplus_(pa + pk[PK_DTB + h])); gb_s[2 * i + 1] = sigm(pb);
    }
    __syncthreads();
    { const int i = w >> 1, which = w & 1; float* rp = qk_s + i * 256 + which * 128; const float a = rp[lane], b = rp[lane + 64];
      const float sc = __builtin_amdgcn_rsqf(wave_sum(a * a + b * b) + 1e-6f) * (which == 0 ? 0.08838834764831845f : 1.f); rp[lane] = a * sc; rp[lane + 64] = b * sc; }
    __syncthreads();
#pragma unroll 1
    for (int i = 0; i < 4; ++i) {
        const float* kp = qk_s + i * 256 + 128 + kq * 32; const float* qp = qk_s + i * 256 + kq * 32;
        float pa = 0.f;
#pragma unroll
        for (int j4 = 0; j4 < 8; ++j4) { const f32x4 k4 = *(const f32x4*)(kp + 4 * j4); pa += k4[0] * s[4 * j4] + k4[1] * s[4 * j4 + 1] + k4[2] * s[4 * j4 + 2] + k4[3] * s[4 * j4 + 3]; }
        part[kq * 128 + v] = pa;
        __syncthreads();
        const float kS = part[v] + part[128 + v] + part[256 + v] + part[384 + v];
        const float a = gb_s[2 * i], c = gb_s[2 * i + 1] * (v_s[i * 128 + v] - a * kS);
        float po = 0.f;
#pragma unroll
        for (int j4 = 0; j4 < 8; ++j4) { const f32x4 k4 = *(const f32x4*)(kp + 4 * j4), q4v = *(const f32x4*)(qp + 4 * j4);
#pragma unroll
            for (int e = 0; e < 4; ++e) { s[4 * j4 + e] = a * s[4 * j4 + e] + k4[e] * c; po += q4v[e] * s[4 * j4 + e]; } }
        part2[kq * 128 + v] = po;
        __syncthreads();
        if (kq == 0) ((float*)(p.ws + WS_ORAW))[(size_t)(row0 + i) * D + h * 128 + v] = part2[v] + part2[128 + v] + part2[256 + v] + part2[384 + v];
    }
#pragma unroll
    for (int j = 0; j < 32; ++j) s_out[(size_t)(kq * 32 + j) * 128 + v] = s[j];
    __syncthreads();
}

constexpr int SR_R = 0, SR_KK = 4096, SR_V = 8192, SR_ZB = 12288, SR_DEC = 16384, SR_KA = 20480, SR_KM = 24576, SR_WD = 28672, SR_AD = 28928, SR_RK = 29184;
__device__ __forceinline__ void rwkv_sample_item(const Params& p, unsigned char* smem, int bs) {
    const int tid = otid(), w = tid >> 6, lane = tid & 63;
    float* f = (float*)smem;
    const bf16_t* P = (const bf16_t*)(p.ws + WS_P);
    const float* pk = (const float*)(p.ws + WS_PK);
    const int row0 = LEX0 + EX_SAMP + bs * DECT;
    const bf16_t* prow = P + (size_t)(LEX0 + EX_SHIFT + bs) * NPB + C_RW;
#pragma unroll 1
    for (int col = tid; col < RW_SHIFT; col += 512) {
        const float mu = pk[PK_MU + col]; float prev = bf2f(prow[col]);
        float cur[4];
#pragma unroll
        for (int i = 0; i < 4; ++i) cur[i] = bf2f(P[(size_t)(row0 + i) * NPB + C_RW + col]);
        float* dst; int stride = 1024; bool th = false;
        if (col < 1024) dst = f + SR_R + col; else if (col < 2048) dst = f + SR_KK + (col - 1024); else if (col < 3072) dst = f + SR_V + (col - 2048);
        else if (col < 3136) { dst = f + SR_WD + (col - 3072); stride = 64; th = true; } else if (col < 3200) { dst = f + SR_AD + (col - 3136); stride = 64; } else dst = f + SR_ZB + (col - 3200);
#pragma unroll
        for (int i = 0; i < 4; ++i) { float m = cur[i] + mu * (prev - cur[i]); prev = cur[i]; if (th) m = tanh_(m); dst[i * stride] = m; }
    }
    __syncthreads();
#pragma unroll 1
    for (int cc = 0; cc < 2; ++cc) {
        const int c = tid + 512 * cc;
        float aw[4] = {0.f, 0.f, 0.f, 0.f}, aa[4] = {0.f, 0.f, 0.f, 0.f};
#pragma unroll 8
        for (int l = 0; l < 64; ++l) { const float w2v = pk[PK_W2 + l * D + c], a2v = pk[PK_A2 + l * D + c];
#pragma unroll
            for (int i = 0; i < 4; ++i) { aw[i] += f[SR_WD + i * 64 + l] * w2v; aa[i] += f[SR_AD + i * 64 + l] * a2v; } }
        const float w0c = pk[PK_W0 + c], a0c = pk[PK_A0 + c], kkc = pk[PK_KK + c], kac = pk[PK_KA + c];
#pragma unroll
        for (int i = 0; i < 4; ++i) { const float a = sigm(a0c + aa[i]); const float kbv = f[SR_KK + i * 1024 + c];
            f[SR_DEC + i * 1024 + c] = __expf(-0.6065306597126334f * sigm(w0c + aw[i])); f[SR_KA + i * 1024 + c] = a; f[SR_KK + i * 1024 + c] = kbv * kkc; f[SR_KM + i * 1024 + c] = kbv * (1.f + (a - 1.f) * kac); }
    }
    __syncthreads();
#pragma unroll 1
    for (int x = 0; x < 8; ++x) { const int pr = w * 8 + x, i = pr >> 4, hh = pr & 15; const int o = i * 1024 + hh * 64 + lane;
        const float kr = f[SR_KK + o]; const float kk = kr * __builtin_amdgcn_rsqf(wave_sum(kr * kr) + 1e-6f); f[SR_KK + o] = kk; f[SR_KA + o] = kk * f[SR_KA + o];
        const float rkv = wave_sum(f[SR_R + o] * f[SR_KM + o] * pk[PK_RK + hh * 64 + lane]); if (lane == 0) f[SR_RK + pr] = rkv; }
    __syncthreads();
#pragma unroll 1
    for (int hp = 0; hp < 2; ++hp) {
        const int hb = hp * 8 + w;
        const float* s_in = p.in[4] + (size_t)(bs * 16 + hb) * 4096 + (size_t)lane * 64; float* s_out = p.out + O_RWKV_S + (size_t)(bs * 16 + hb) * 4096 + (size_t)lane * 64;
        f32x4 S[16];
#pragma unroll
        for (int j = 0; j < 16; ++j) S[j] = *(const f32x4*)(s_in + 4 * j);
        const int cch = hb * 64 + lane;
        const float gnw = pk[PK_GNW + cch], gnb = pk[PK_GNB + cch];
#pragma unroll 1
        for (int i = 0; i < 4; ++i) {
            const int o = i * 1024 + hb * 64;
            const float vv = f[SR_V + o + lane], rk = f[SR_RK + i * 16 + hb];
            float sa = 0.f;
#pragma unroll
            for (int j = 0; j < 16; ++j) { const f32x4 kk4 = *(const f32x4*)(f + SR_KK + o + 4 * j); sa += S[j][0] * kk4[0] + S[j][1] * kk4[1] + S[j][2] * kk4[2] + S[j][3] * kk4[3]; }
            float y = 0.f;
#pragma unroll
            for (int j = 0; j < 16; ++j) { const f32x4 de4 = *(const f32x4*)(f + SR_DEC + o + 4 * j), ka4 = *(const f32x4*)(f + SR_KA + o + 4 * j), km4 = *(const f32x4*)(f + SR_KM + o + 4 * j), r4 = *(const f32x4*)(f + SR_R + o + 4 * j);
#pragma unroll
                for (int e = 0; e < 4; ++e) { S[j][e] = S[j][e] * de4[e] + (vv * km4[e] - sa * ka4[e]); y += S[j][e] * r4[e]; } }
            const float mu = wave_sum(y) * (1.f / 64.f); const float dy = y - mu;
            const float rs = __builtin_amdgcn_rsqf(wave_sum(dy * dy) * (1.f / 64.f) + 64e-5f);
            const float ov = (dy * rs * gnw + gnb + rk * vv) * silu_(f[SR_ZB + i * 1024 + cch]);
            ((bf16_t*)(p.ws + WS_OB))[(size_t)(XROWS + EX_SAMP + bs * DECT + i) * D + cch] = (bf16_t)f2bf(ov);
        }
#pragma unroll
        for (int j = 0; j < 16; ++j) *(f32x4*)(s_out + 4 * j) = S[j];
    }
    __syncthreads();
}

__device__ __forceinline__ void phase2(const Params& p, int seg, unsigned char* smem) {
    const int blk = obid();
    float* out = p.out;
    float* chalo = (float*)(p.ws + WS_CHALO); float* phalo = (float*)(p.ws + WS_PHALO);
#ifndef SUB
#define SUB 0
#endif
#define SEN(x) (SUB == 0 || SUB == (x))
    if (SEN(1) && blk < 64) gdn_scan_block(p, seg, smem, blk);
    if (SEN(3) && blk >= 64 && blk < 128) rwkv_scan_block(p, seg, smem, blk - 64);
#ifndef DUP
#define DUP 0
#endif
    if (seg == 0) {
#pragma unroll 1
        for (int it = blk; it < DECB * 8; it += gridDim.x) gdn_sample_item(p, smem, it >> 3, it & 7);
#pragma unroll 1
        for (int it = (blk + 128) & 255; it < DECB; it += gridDim.x) rwkv_sample_item(p, smem, it);
    }
}

__device__ __forceinline__ void phase25(const Params& p, int seg) {
    const int tid0 = otid(); const int lane = tid0 & 63; const int gw = obid() * 8 + (tid0 >> 6), NGW = gridDim.x * 8;
    const bf16_t* P = (const bf16_t*)(p.ws + WS_P);
    const float* ORAW = (const float*)(p.ws + WS_ORAW); const float* YRAW = (const float*)(p.ws + WS_YRAW);
    const bf16_t* C0 = (const bf16_t*)(p.ws + WS_C0); const bf16_t* C1 = (const bf16_t*)(p.ws + WS_C1);
    bf16_t* OA = (bf16_t*)(p.ws + WS_H); bf16_t* OB = (bf16_t*)(p.ws + WS_OB);
    const int nrows = LEX0 + (seg == 0 ? DECB * DECT : 0);
    const int c = lane * 16;
    f32x4 nw[4];
#pragma unroll
    for (int j = 0; j < 4; ++j) nw[j] = *(const f32x4*)((const float*)(p.ws + WS_PK) + PK_NORMW + (c & 127) + 4 * j);
#pragma unroll 1
    for (int rr = LEX0 + gw; rr < nrows; rr += NGW) {
        int lr; size_t grow;
        if (rr < LEX0) { lr = rr; grow = (size_t)(rr / SEGTOK) * SEQ + seg * SEGTOK + (rr % SEGTOK); } else { lr = LEX0 + EX_SAMP + (rr - LEX0); grow = (size_t)XROWS + EX_SAMP + (rr - LEX0); }
        {
            f32x4 o[4]; float ss = 0.f;
#pragma unroll
            for (int j = 0; j < 4; ++j) { o[j] = *(const f32x4*)(ORAW + (size_t)lr * D + c + 4 * j); ss += o[j][0] * o[j][0] + o[j][1] * o[j][1] + o[j][2] * o[j][2] + o[j][3] * o[j][3]; }
            ss += __shfl_xor(ss, 1); ss += __shfl_xor(ss, 2); ss += __shfl_xor(ss, 4);
            const float rs = __builtin_amdgcn_rsqf(ss * (1.f / 128.f) + 1e-6f);
            const u32x4 z0 = *(const u32x4*)(P + (size_t)lr * NPB + C_Z + c), z1 = *(const u32x4*)(P + (size_t)lr * NPB + C_Z + c + 8);
            const unsigned zz[8] = {z0.x, z0.y, z0.z, z0.w, z1.x, z1.y, z1.z, z1.w};
            unsigned ow[8];
#pragma unroll
            for (int j = 0; j < 8; ++j) { const float za = __uint_as_float(zz[j] << 16), zb = __uint_as_float(zz[j] & 0xffff0000u);
                const float a = o[j >> 1][(j & 1) * 2] * rs * nw[j >> 1][(j & 1) * 2] * silu_(za), b = o[j >> 1][(j & 1) * 2 + 1] * rs * nw[j >> 1][(j & 1) * 2 + 1] * silu_(zb);
                ow[j] = pk2(a, b); }
            *(u32x4*)(OA + grow * D + c) = (u32x4){ow[0], ow[1], ow[2], ow[3]}; *(u32x4*)(OA + grow * D + c + 8) = (u32x4){ow[4], ow[5], ow[6], ow[7]};
        }
    }
}

__device__ __forceinline__ void phase_final(const Params& p) {
    const int tid0 = otid(); const int lane = tid0 & 63; const int gw = obid() * 8 + (tid0 >> 6), NGW = gridDim.x * 8;
    const f32x4* wr = (const f32x4*)((const float*)(p.ws + WS_PK) + PK_LNF) + lane;
#pragma unroll 1
    for (int r = gw; r < XROWS + DECB * DECT; r += NGW) {
        f32x4* xr = (f32x4*)(p.out + (size_t)r * D) + lane;
        f32x4 v[4]; float ss = 0.f;
#pragma unroll
        for (int j = 0; j < 4; ++j) { v[j] = xr[64 * j]; ss += v[j][0] * v[j][0] + v[j][1] * v[j][1] + v[j][2] * v[j][2] + v[j][3] * v[j][3]; }
        const float rs = __builtin_amdgcn_rsqf(wave_sum(ss) * (1.f / D) + 1e-6f);
#pragma unroll
        for (int j = 0; j < 4; ++j) xr[64 * j] = v[j] * rs * wr[64 * j];
    }
}

__global__ __launch_bounds__(512, 2) void hybrid_mega(Params p) {
    extern __shared__ __attribute__((aligned(16))) unsigned char smem[];
    cg::grid_group grid = cg::this_grid();
    LAS unsigned char* lds = (LAS unsigned char*)smem;
    const int G = gridDim.x;
    volatile LAS unsigned* xst = (volatile LAS unsigned*)(lds + (LDS_TOTAL - 16));
    if (threadIdx.x == 0) { xst[0] = 0u; xst[1] = 0u; }
    __syncthreads();
    (void)xcd_barrier_post((unsigned*)(p.ws + WS_BAR), xst);
    if (G == 0x7fffffff) grid.sync();
#define GSYNC() do { XcdBarrier xb_; xb_.bar = (unsigned*)(p.ws + WS_BAR); xb_.x = xb_xcc_id(); xb_.st = (volatile LAS unsigned*)((LAS unsigned char*)smem + (LDS_TOTAL - 16)); xcd_barrier(xb_); } while (0)

#ifndef ONLY
#define ONLY 0
#endif
#define EN(x) (ONLY == 0 || ONLY == (x))
    if (EN(1)) phase0(p, smem);
    GSYNC();
#pragma unroll 1
    for (int it = 0; it <= NSEG + 2; ++it) {
        const int xblk = obid() - (G - 12);
        const bool xrole = xblk >= 0;
        if (it > 0 && it <= NSEG && EN(3)) phase2(p, it - 1, smem);
        if (((it == 2 && xrole) || it == NSEG + 1) && EN(5)) {
            const bool ex = it == 2;
            SchedAB S; S.ob.init(ex ? 3 : XROWS / 256, 4, ex ? 12 : G, ex ? xblk : obid()); S.pm0 = ex ? XROWS / 256 : 0;
            S.A0 = (const char*)(p.ws + WS_H); S.A1 = (const char*)(p.ws + WS_OB); S.B0 = (const char*)(p.ws + WS_WT_A); S.B1 = (const char*)(p.ws + WS_WT_B);
            EpiAB E; E.tmp = ex ? (bf16_t*)(p.ws + WS_YRAW) - (size_t)XROWS * D : (bf16_t*)(p.ws + WS_P); E.merged = ex ? (bf16_t*)(p.ws + WS_C0) - (size_t)XROWS * D : (bf16_t*)(p.ws + WS_MG);
            E.gex = (const bf16_t*)(p.ws + WS_GEX); E.out = p.out;
            pg8::gemm_phase<EpiAB, SchedAB>(lds, D, S, E);
        }
        if (((it == 3 && xrole) || it == NSEG + 2) && EN(6)) {
            const bool ex = it == 3;
            SchedO S; S.ob.init(ex ? 3 : XROWS / 256, 4, ex ? 12 : G, ex ? xblk : obid()); S.pm0 = ex ? XROWS / 256 : 0;
            S.A = ex ? (const char*)((bf16_t*)(p.ws + WS_C0) - (size_t)XROWS * D) : (const char*)(p.ws + WS_MG); S.B = (const char*)(p.ws + WS_WT_O);
            EpiO E; E.out = p.out; E.xp = p.in[0]; E.xs = p.in[1];
            pg8::gemm_phase<EpiO, SchedO>(lds, D, S, E);
        }
        if (it < NSEG && EN(2) && !(it == 2 && xrole)) {
            const int seg = it;
            const int Gp = it == 2 ? G - 12 : G;
            const int cidx = it > 0 ? (obid() + (Gp >> 1)) % Gp : obid();
            SchedIn S; S.ob.init(seg == 0 ? LT_PROMPT + 3 : LT_PROMPT, NT_IN, Gp, cidx); S.seg = seg; S.A = (const char*)(p.ws + WS_H); S.B = (const char*)(p.ws + WS_WT_IN);
            EpiIn E; E.P = (bf16_t*)(p.ws + WS_P); E.gex = (bf16_t*)(p.ws + WS_GEX); E.out = p.out; E.seg = seg;
            pg8::gemm_phase<EpiIn, SchedIn>(lds, D, S, E);
        }
        GSYNC();
        if (it < NSEG) {
            if (EN(8)) { phase_gprep(p, it, smem); phase_rprep(p, it, smem); }
            if (it == 1 && EN(4)) phase25(p, 0);
            GSYNC();
        }
    }
    if (EN(7)) phase_final(p);
}

extern "C" void kernel_launch(void* const* d_in, const int* in_sizes, int n_in, void* d_out, int out_size, void* d_ws, size_t ws_size, hipStream_t stream) {
    static int grid_blocks = 0;
    constexpr int LDS_BYTES = LDS_TOTAL;
    if (grid_blocks == 0) {
        if (n_in != 27 || ws_size < WS_END) { fprintf(stderr, "kernel_launch: unexpected n_in %d / ws %zu (need %zu)\n", n_in, ws_size, (size_t)WS_END); grid_blocks = -1; return; }
        if (hipFuncSetAttribute((const void*)hybrid_mega, hipFuncAttributeMaxDynamicSharedMemorySize, LDS_BYTES) != hipSuccess) { fprintf(stderr, "kernel_launch: hipFuncSetAttribute failed\n"); grid_blocks = -1; return; }
        int dev = 0, cus = 0, per_cu = 0;
        hipGetDevice(&dev);
        hipDeviceGetAttribute(&cus, hipDeviceAttributeMultiprocessorCount, dev);
        hipOccupancyMaxActiveBlocksPerMultiprocessor(&per_cu, (const void*)hybrid_mega, 512, LDS_BYTES);
        if (per_cu < 1) { fprintf(stderr, "kernel_launch: occupancy query says %d blocks/CU\n", per_cu); per_cu = 1; }
        (void)hipGetLastError();
        grid_blocks = cus;
    }
    if (grid_blocks < 0) return;
    Params p{};
    for (int i = 0; i < 27; ++i) p.in[i] = (const float*)d_in[i];
    p.out = (float*)d_out; p.ws = (unsigned char*)d_ws;
    if (hipMemsetAsync((unsigned char*)d_ws + WS_BAR, 0, 16384, stream) != hipSuccess) { fprintf(stderr, "kernel_launch: memset of the barrier words failed\n"); return; }
    void* args[] = {&p};
    hipError_t e = hipLaunchCooperativeKernel((const void*)hybrid_mega, dim3(grid_blocks), dim3(512), args, LDS_BYTES, stream);
    if (e != hipSuccess) fprintf(stderr, "cooperative launch failed: %s (grid %d)\n", hipGetErrorString(e), grid_blocks);
}
```

```cpp
#include <hip/hip_runtime.h>
#include <hip/hip_cooperative_groups.h>
#include <cstdio>
namespace cg = cooperative_groups;

#define LAS __attribute__((address_space(3)))
typedef unsigned short bf16_t;
typedef short bf16x8 __attribute__((ext_vector_type(8)));
typedef float f32x4 __attribute__((ext_vector_type(4)));
typedef unsigned u32x4 __attribute__((ext_vector_type(4)));
typedef unsigned u32x2 __attribute__((ext_vector_type(2)));

constexpr int D = 1024;
constexpr int NBATCH = 8, SEQ = 2048, NMETA = 16, DECB = 128, DECT = 4;
constexpr int XROWS = NBATCH * SEQ;
constexpr int EX_SAMP = 16, EX_SHIFT = 528, EX_END = 656;
constexpr int HROWS = 17152, HTILES = 67;
constexpr int NSEG = 8, SEGTOK = SEQ / NSEG;
constexpr int CPS = SEGTOK / 64;
constexpr int TPB = SEGTOK / 256;
constexpr int LT_PROMPT = NBATCH * TPB;
constexpr int LEX0 = LT_PROMPT * 256;
constexpr int LROWS = LEX0 + 768;
constexpr int NP = 10496, NPB = 8448, NT_IN = 41, NT_PB = 33;
constexpr int C_A = 3072, C_B = 3080, C_Z = 3088, C_RW = 4112, C_GATE_REF = 8336;
constexpr int RW_SHIFT = 4224;

constexpr size_t O_YP = 0, O_YS = 16777216, O_GDN_P = 17301504, O_CONV_P = 18350080, O_RWKV_P = 18423808, O_SHIFT_P = 18948096,
                 O_GDN_S = 18956288, O_CONV_S = 35733504, O_RWKV_S = 36913152, O_SHIFT_S = 45301760;

constexpr size_t al256(size_t x) { return (x + 255) & ~(size_t)255; }
constexpr size_t WS_WT_IN = 0;
constexpr size_t WS_WT_A = al256(WS_WT_IN + (size_t)NP * D * 2);
constexpr size_t WS_WT_B = al256(WS_WT_A + (size_t)D * D * 2);
constexpr size_t WS_WT_O = al256(WS_WT_B + (size_t)D * D * 2);
constexpr size_t WS_H = al256(WS_WT_O + (size_t)D * D * 2);
constexpr size_t WS_OB = al256(WS_H + (size_t)HROWS * D * 2);
constexpr size_t WS_P = al256(WS_OB + (size_t)HROWS * D * 2);
constexpr size_t WS_ORAW = al256(WS_P + (size_t)LROWS * NPB * 2);
constexpr size_t WS_YRAW = al256(WS_ORAW + (size_t)LROWS * D * 4);
constexpr size_t WS_C0 = al256(WS_YRAW + (size_t)LROWS * D * 4);
constexpr size_t WS_C1 = al256(WS_C0 + (size_t)LROWS * D * 2);
constexpr size_t WS_GEX = al256(WS_C1 + (size_t)LROWS * D * 2);
constexpr size_t WS_CHALO = al256(WS_GEX + (size_t)768 * 2048 * 2);
constexpr size_t WS_PHALO = al256(WS_CHALO + (size_t)2 * NBATCH * 3 * NPB * 2);
constexpr size_t WS_PK = al256(WS_PHALO + (size_t)2 * NBATCH * NPB * 2);
constexpr int PK_CONVW = 0, PK_ALOG = 12288, PK_DTB = 12296, PK_NORMW = 12304, PK_MU = 12432, PK_W0 = 16656, PK_W2 = 17680, PK_A0 = 83216, PK_A2 = 84240,
              PK_KK = 149776, PK_KA = 150800, PK_RK = 151824, PK_GNW = 152848, PK_GNB = 153872, PK_LNF = 154896, PK_END = 155920;
constexpr size_t WS_BAR = al256(WS_PK + (size_t)PK_END * 4);
constexpr size_t WS_W2T = al256(WS_BAR + 16384);
constexpr size_t WS_A2T = al256(WS_W2T + 131072);
constexpr size_t WS_GP = al256(WS_A2T + 131072);
constexpr int GP_AP = 0, GP_QH = 32768, GP_KH = 49152, GP_OH = 81920, GP_EGL = 98304, GP_G = 98560, GP_STRIDE = 114944;
constexpr int RP_AP = 0, RP_RH = 8192, RP_KH = 16384, RP_YH = 24576, RP_C1 = 32768, RP_C0 = 40960, RP_PC = 49152, RP_STRIDE = 49408;
constexpr size_t WS_RP = al256(WS_GP + (size_t)(CPS + 1) * 64 * GP_STRIDE);
constexpr size_t WS_END = al256(WS_RP + (size_t)(CPS + 1) * 128 * RP_STRIDE);
constexpr size_t WS_MG = WS_GP;
static_assert((size_t)HROWS * D * 2 <= WS_END - WS_GP, "MERGED must fit in the prep records");
static_assert((size_t)HROWS * D * 4 <= (size_t)LROWS * NPB * 2 + 2 * (size_t)LROWS * D * 4, "TMP must fit in P+ORAW+YRAW");
static_assert(WS_END <= (size_t)268435456, "workspace");

constexpr int LDS_TOTAL = 163840;
struct Params { const float* in[27]; float* out; unsigned char* ws; };

__device__ __forceinline__ float bf2f(bf16_t v) { return __uint_as_float(((unsigned)v) << 16); }
typedef __bf16 bf16n2 __attribute__((ext_vector_type(2)));
typedef float f32n2 __attribute__((ext_vector_type(2)));
__device__ __forceinline__ unsigned cvt_pk_bf16(float lo, float hi) { const f32n2 v = {lo, hi}; return __builtin_bit_cast(unsigned, __builtin_convertvector(v, bf16n2)); }
__device__ __forceinline__ unsigned pk2(float lo, float hi) { return cvt_pk_bf16(lo, hi); }
__device__ __forceinline__ unsigned f2bf(float f) { return cvt_pk_bf16(f, 0.f) & 0xffffu; }
__device__ __forceinline__ float sigm(float x) { return __builtin_amdgcn_rcpf(1.f + __expf(-x)); }
__device__ __forceinline__ float silu_(float x) { return x * __builtin_amdgcn_rcpf(1.f + __expf(-x)); }
__device__ __forceinline__ float softplus_(float x) { return fmaxf(x, 0.f) + log1pf(expf(-fabsf(x))); }
__device__ __forceinline__ float wave_sum(float v) {
#pragma unroll
    for (int o = 1; o < 64; o <<= 1) v += __shfl_xor(v, o);
    return v;
}
__device__ __forceinline__ void unpack8(const u32x4 rw, float (&x)[8]) {
    x[0] = __uint_as_float(rw.x << 16); x[1] = __uint_as_float(rw.x & 0xffff0000u); x[2] = __uint_as_float(rw.y << 16); x[3] = __uint_as_float(rw.y & 0xffff0000u);
    x[4] = __uint_as_float(rw.z << 16); x[5] = __uint_as_float(rw.z & 0xffff0000u); x[6] = __uint_as_float(rw.w << 16); x[7] = __uint_as_float(rw.w & 0xffff0000u); }
__device__ __forceinline__ u32x4 pack8(const float (&x)[8]) { return (u32x4){pk2(x[0], x[1]), pk2(x[2], x[3]), pk2(x[4], x[5]), pk2(x[6], x[7])}; }

__device__ __forceinline__ int otid() { int t = threadIdx.x; asm volatile("" : "+v"(t)); return t; }
__device__ __forceinline__ int obid() { int t = blockIdx.x; asm volatile("" : "+s"(t)); return t; }
__device__ __forceinline__ float tanh_(float x) { const float e = __expf(2.f * x); return 1.f - 2.f * __builtin_amdgcn_rcpf(e + 1.f); }
template <int CTRL> __device__ __forceinline__ float dppf(float x) { return __builtin_bit_cast(float, __builtin_amdgcn_mov_dpp(__builtin_bit_cast(int, x), CTRL, 0xf, 0xf, true)); }
__device__ __forceinline__ float rowsum16(float x) { x += dppf<0x128>(x); x += dppf<0x124>(x); x += dppf<0x122>(x); x += dppf<0x121>(x); return x; }


#define XB_TMO      128
#define XB_XCNT(j)  (256  + 64 * (j))
#define XB_XSUB(j)  (1280 + 64 * (j))
#define XB_XGEN(j)  (2304 + 64 * (j))
#define XB_TOP      3328
#define XB_TOPGEN   3392
#define XCD_BAR_WORDS 3456
#define XB_SPIN_CAP (1u << 22)
__device__ __forceinline__ unsigned xb_ld(unsigned* p)              { return __hip_atomic_load(p, __ATOMIC_RELAXED, __HIP_MEMORY_SCOPE_AGENT); }
__device__ __forceinline__ unsigned xb_add(unsigned* p, unsigned v) { return __hip_atomic_fetch_add(p, v, __ATOMIC_RELAXED, __HIP_MEMORY_SCOPE_AGENT); }
__device__ __forceinline__ unsigned xb_xcc_id() { return (unsigned)__builtin_amdgcn_s_getreg((3 << 11) | 20) & 0xFu; }
#define XB_SPIN(cond, bar) do { unsigned _sp = 0; while (cond) { __builtin_amdgcn_s_sleep(1); \
    if ((++_sp & 255u) == 0u) { if (xb_ld(&(bar)[XB_TMO])) break; if (_sp > XB_SPIN_CAP) { atomicAdd(&(bar)[XB_TMO], 1u); break; } } } } while (0)
struct XcdBarrier { unsigned* bar; unsigned x; volatile LAS unsigned* st; };
__device__ __forceinline__ XcdBarrier xcd_barrier_post(unsigned* bar, volatile LAS unsigned* st) {
    XcdBarrier b; b.bar = bar; b.x = xb_xcc_id(); b.st = st;
    if (threadIdx.x == 0) (void)xb_add(&bar[XB_XCNT(b.x)], 1u);
    return b;
}
__device__ __forceinline__ void xcd_barrier_complete(unsigned* bar, unsigned x, unsigned& nloc, unsigned& nx) {
    const unsigned G = gridDim.x * gridDim.y * gridDim.z;
    unsigned sum, cnt, mine, sp = 0u;
    for (;;) {
        sum = 0u; cnt = 0u; mine = 0u;
#pragma unroll
        for (unsigned j = 0; j < 16; ++j) { const unsigned c = xb_ld(&bar[XB_XCNT(j)]); sum += c; cnt += (c > 0u) ? 1u : 0u; mine = (j == x) ? c : mine; }
        if (sum == G) break;
        __builtin_amdgcn_s_sleep(1);
        if ((++sp & 255u) == 0u) { if (xb_ld(&bar[XB_TMO])) break; if (sp > XB_SPIN_CAP) { atomicAdd(&bar[XB_TMO], 1u); break; } }
    }
    nloc = mine > 0u ? mine : 1u; nx = cnt > 0u ? cnt : 1u;
}
__device__ __forceinline__ void xcd_barrier(const XcdBarrier& b) {
    asm volatile("s_waitcnt vmcnt(0)" ::: "memory");
    __syncthreads();
    if (threadIdx.x == 0) {
        unsigned* bar = b.bar;
        __builtin_amdgcn_s_waitcnt(0);
        unsigned nloc = b.st[0], nx = b.st[1];
        if (nloc == 0u) { xcd_barrier_complete(bar, b.x, nloc, nx); b.st[0] = nloc; b.st[1] = nx; }
        const unsigned old = xb_add(&bar[XB_XSUB(b.x)], 1u);
        const unsigned gen = old / nloc;
        if (old + 1u == (gen + 1u) * nloc) {
            __builtin_amdgcn_fence(__ATOMIC_RELEASE, "agent");
            asm volatile("s_waitcnt vmcnt(0)" ::: "memory");
            const unsigned og = xb_add(&bar[XB_TOP], 1u);
            const unsigned tg = og / nx;
            if (og + 1u == (tg + 1u) * nx) xb_add(&bar[XB_TOPGEN], 1u);
            else XB_SPIN(xb_ld(&bar[XB_TOPGEN]) == tg, bar);
            __builtin_amdgcn_fence(__ATOMIC_ACQUIRE, "agent");
            xb_add(&bar[XB_XGEN(b.x)], 1u);
            asm volatile("s_waitcnt vmcnt(0)" ::: "memory");
        } else {
            XB_SPIN(xb_ld(&bar[XB_XGEN(b.x)]) == gen, bar);
            __builtin_amdgcn_fence(__ATOMIC_ACQUIRE, "agent");
            asm volatile("s_waitcnt vmcnt(0)" ::: "memory");
        }
    }
    __syncthreads();
}

namespace pg8 {
constexpr int BM = 256, BK = 64, HALF = 128, HTB = HALF * BK * 2, STAGE_BYTES = 8 * HTB, NXCD = 8, WGM = 8;
__device__ __forceinline__ int lds_byte(int r, int c) { const int st = (r >> 4) * 2 + (c >> 5), rr = r & 15, cc = c & 31, ob = rr * 64 + cc * 2; return st * 1024 + (ob ^ (((ob >> 9) & 1) << 5)); }
__device__ __forceinline__ void stage_rc(int b, int& R, int& C) { const int st = b / 1024, sb = b % 1024, swz = sb ^ (((sb >> 9) & 1) << 5); R = (st >> 1) * 16 + swz / 64; C = (st & 1) * 32 + (swz % 64) / 2; }
__device__ __forceinline__ int perm32(int rho) { const int n = rho >> 4, i = rho & 15; return 8 * (i >> 2) + 4 * n + (i & 3); }

struct Unit { int pm, pn, w; };
struct OrderBase {
    int nM, nN, nwg, G, c;
    __device__ void init(int nM_, int nN_, int G_, int c_) { nM = nM_; nN = nN_; nwg = nM * nN; G = G_; c = c_; }
    __device__ bool nextb(int i, Unit& u) const {
        const long L = (long)i * G + c; if (L >= nwg) return false;
        int wgid = (int)L; { const int q = nwg / NXCD, r = nwg % NXCD, xcd = wgid % NXCD, off = wgid / NXCD; wgid = (xcd < r ? xcd * (q + 1) : r * (q + 1) + (xcd - r) * q) + off; }
        const int nig = WGM * nN, gid = wgid / nig, fm = gid * WGM, gsz = (nM - fm) < WGM ? (nM - fm) : WGM;
        u.pm = fm + ((wgid % nig) % gsz); u.pn = (wgid % nig) / gsz; u.w = 0; return true;
    }
};

template <class Epi, class Sched>
__device__ __forceinline__ void gemm_phase(LAS unsigned char* lds, const int K, const Sched& S, const Epi& E) {
    const int tid = otid(), wid = __builtin_amdgcn_readfirstlane(tid >> 6), lane = tid & 63, wr = wid >> 2, wc = wid & 3, fr = lane & 15, fq = lane >> 4;
    const int nt = K / BK;
    unsigned voffA[2], voffB[2];
#pragma unroll
    for (int i = 0; i < 2; ++i) { int R, C; stage_rc(tid * 16 + i * 8192, R, C); const int Rb = Epi::PERM ? ((R & ~31) + perm32(R & 31)) : R;
        voffA[i] = (unsigned)(R * K + C) * 2u; voffB[i] = (unsigned)(Rb * K + C) * 2u; }
    const size_t kstep = (size_t)(BK * 2);
    const size_t hstep = (size_t)HALF * K * 2;
    const unsigned ldsw = (unsigned)wid * 1024u;
    const int aoff = lds_byte(wr * 64 + fr, fq * 8), boff = lds_byte(wc * 32 + fr, fq * 8);
#define PG8_SA(b, h) (((b) * 2 + (h)) * HTB)
#define PG8_SB(b, h) ((4 + (b) * 2 + (h)) * HTB)
#define PG8_STAGE(bufoff, gbase, voff) do { _Pragma("unroll") for (int _i = 0; _i < 2; ++_i) \
        __builtin_amdgcn_global_load_lds((const unsigned*)((const char*)(gbase) + (voff)[_i]), (LAS unsigned*)(lds + (bufoff) + ldsw + _i * 8192), 16, 0, 0); } while (0)
#define PG8_LDA(dst, b, h) do { _Pragma("unroll") for (int m = 0; m < 4; ++m) _Pragma("unroll") for (int k = 0; k < 2; ++k) dst[m][k] = *(const LAS bf16x8*)(lds + PG8_SA(b, h) + aoff + m * 2048 + k * 1024); } while (0)
#define PG8_LDB(dst, b, h) do { _Pragma("unroll") for (int n = 0; n < 2; ++n) _Pragma("unroll") for (int k = 0; k < 2; ++k) dst[n][k] = *(const LAS bf16x8*)(lds + PG8_SB(b, h) + boff + n * 2048 + k * 1024); } while (0)
#define PG8_MMA(ai, bj, At, Bt) do { __builtin_amdgcn_s_setprio(1); _Pragma("unroll") for (int m = 0; m < 4; ++m) _Pragma("unroll") for (int n = 0; n < 2; ++n) _Pragma("unroll") for (int k = 0; k < 2; ++k) \
        acc[ai][bj][m][n] = __builtin_amdgcn_mfma_f32_16x16x32_bf16(Bt[n][k], At[m][k], acc[ai][bj][m][n], 0, 0, 0); __builtin_amdgcn_s_setprio(0); } while (0)
#define PG8_WAIT_V(n) asm volatile("s_waitcnt vmcnt(" #n ")" ::: "memory")
#define PG8_WAIT_L(n) asm volatile("s_waitcnt lgkmcnt(" #n ")" ::: "memory")
#define PG8_BAR __builtin_amdgcn_s_barrier()
#define PG8_SCHED __builtin_amdgcn_sched_barrier(0)
    Unit cur, nxt; int ui = 0;
    if (!S.next(0, cur)) return;
    f32x4 acc[2][2][4][2];
#pragma unroll
    for (int a = 0; a < 2; ++a)
#pragma unroll
        for (int b = 0; b < 2; ++b)
#pragma unroll
            for (int m = 0; m < 4; ++m)
#pragma unroll
                for (int n = 0; n < 2; ++n) acc[a][b][m][n] = (f32x4){0.f, 0.f, 0.f, 0.f};
    bf16x8 At[4][2], B0[2][2], B1[2][2];
    const char* cA = S.a_ptr(cur); const char* cB = S.b_ptr(cur);
    PG8_STAGE(PG8_SB(0, 0), cB, voffB); PG8_STAGE(PG8_SA(0, 0), cA, voffA); PG8_STAGE(PG8_SB(0, 1), cB + hstep, voffB); PG8_STAGE(PG8_SA(0, 1), cA + hstep, voffA);
    if (wr == 1) PG8_BAR;
    PG8_WAIT_V(4); PG8_BAR;
    PG8_STAGE(PG8_SB(1, 0), cB + kstep, voffB); PG8_STAGE(PG8_SA(1, 0), cA + kstep, voffA); PG8_STAGE(PG8_SB(1, 1), cB + hstep + kstep, voffB);
    PG8_WAIT_V(6); PG8_BAR;
    for (;;) {
        const bool has_next = S.next(ui + 1, nxt);
        const char* nA = has_next ? S.a_ptr(nxt) : cA; const char* nB = has_next ? S.b_ptr(nxt) : cB;
        for (int t = 0; t < nt; t += 2) {
            const bool last = (t == nt - 2);
            const char* a1 = cA + (size_t)(t + 1) * kstep;
            const char* a2 = last ? nA : cA + (size_t)(t + 2) * kstep; const char* b2 = last ? nB : cB + (size_t)(t + 2) * kstep;
            const char* a3 = a2 + kstep; const char* b3 = b2 + kstep;
            PG8_LDB(B0, 0, 0); PG8_SCHED; PG8_LDA(At, 0, 0); PG8_STAGE(PG8_SA(1, 1), a1 + hstep, voffA);
            PG8_WAIT_L(8); PG8_BAR; PG8_WAIT_L(0); PG8_MMA(0, 0, At, B0); PG8_BAR; PG8_SCHED;
            PG8_LDB(B1, 0, 1); PG8_STAGE(PG8_SB(0, 0), b2, voffB);
            PG8_BAR; PG8_WAIT_L(0); PG8_MMA(0, 1, At, B1); PG8_BAR;
            PG8_LDA(At, 0, 1); PG8_STAGE(PG8_SA(0, 0), a2, voffA);
            PG8_BAR; PG8_WAIT_L(0); PG8_MMA(1, 0, At, B0); PG8_BAR; PG8_SCHED;
            PG8_STAGE(PG8_SB(0, 1), b2 + hstep, voffB);
            PG8_WAIT_V(6); PG8_BAR; PG8_MMA(1, 1, At, B1); PG8_BAR;
            PG8_LDB(B0, 1, 0); PG8_SCHED; PG8_LDA(At, 1, 0); PG8_STAGE(PG8_SA(0, 1), a2 + hstep, voffA);
            PG8_WAIT_L(8); PG8_BAR; PG8_WAIT_L(0); PG8_MMA(0, 0, At, B0); PG8_BAR; PG8_SCHED;
            PG8_LDB(B1, 1, 1); PG8_STAGE(PG8_SB(1, 0), b3, voffB);
            PG8_BAR; PG8_WAIT_L(0); PG8_MMA(0, 1, At, B1); PG8_BAR;
            PG8_LDA(At, 1, 1); PG8_STAGE(PG8_SA(1, 0), a3, voffA);
            PG8_BAR; PG8_WAIT_L(0); PG8_MMA(1, 0, At, B0); PG8_BAR; PG8_SCHED;
            PG8_STAGE(PG8_SB(1, 1), b3 + hstep, voffB);
            PG8_WAIT_V(6); PG8_BAR; PG8_MMA(1, 1, At, B1); PG8_BAR;
        }
        E(acc, cur, wr, wc, fr, fq);
        if (!has_next) break;
#pragma unroll
        for (int a = 0; a < 2; ++a)
#pragma unroll
            for (int b = 0; b < 2; ++b)
#pragma unroll
                for (int m = 0; m < 4; ++m)
#pragma unroll
                    for (int n = 0; n < 2; ++n) acc[a][b][m][n] = (f32x4){0.f, 0.f, 0.f, 0.f};
        cur = nxt; cA = nA; cB = nB; ++ui;
    }
    PG8_WAIT_V(0);
    if (wr == 0) PG8_BAR;
    PG8_BAR;
#undef PG8_SA
#undef PG8_SB
#undef PG8_STAGE
#undef PG8_LDA
#undef PG8_LDB
#undef PG8_MMA
#undef PG8_WAIT_V
#undef PG8_WAIT_L
#undef PG8_BAR
#undef PG8_SCHED
}
}
using pg8::Unit;

struct SchedIn {
    pg8::OrderBase ob; int seg; const char* A; const char* B;
    __device__ bool next(int i, Unit& u) const { return ob.nextb(i, u); }
    __device__ const char* a_ptr(const Unit& u) const {
        const int gt = u.pm < LT_PROMPT ? ((u.pm / TPB) * (SEQ / 256) + seg * TPB + (u.pm % TPB)) : (XROWS / 256 + (u.pm - LT_PROMPT));
        return A + (size_t)gt * 256 * D * 2; }
    __device__ const char* b_ptr(const Unit& u) const { return B + (size_t)u.pn * 256 * D * 2; }
};
struct SchedAB {
    pg8::OrderBase ob; int pm0; const char* A0; const char* A1; const char* B0; const char* B1;
    __device__ bool next(int i, Unit& u) const { const bool ok = ob.nextb(i >> 1, u); u.pm += pm0; u.w = i & 1; return ok; }
    __device__ const char* a_ptr(const Unit& u) const { return (u.w ? A1 : A0) + (size_t)u.pm * 256 * D * 2; }
    __device__ const char* b_ptr(const Unit& u) const { return (u.w ? B1 : B0) + (size_t)u.pn * 256 * D * 2; }
};
struct SchedO {
    pg8::OrderBase ob; int pm0; const char* A; const char* B;
    __device__ bool next(int i, Unit& u) const { const bool ok = ob.nextb(i, u); u.pm += pm0; return ok; }
    __device__ const char* a_ptr(const Unit& u) const { return A + (size_t)u.pm * 256 * D * 2; }
    __device__ const char* b_ptr(const Unit& u) const { return B + (size_t)u.pn * 256 * D * 2; }
};

struct EpiIn {
    static constexpr bool PERM = true;
    bf16_t* P; bf16_t* gex; float* out; int seg;
    __device__ __forceinline__ void operator()(const f32x4 (&acc)[2][2][4][2], const Unit& u, int wr, int wc, int fr, int fq) const {
        const int lr0 = u.pm * 256 + wr * 64 + fr;
        const int c0 = u.pn * 256 + wc * 32 + 8 * fq;
#pragma unroll
        for (int ai = 0; ai < 2; ++ai)
#pragma unroll
            for (int m = 0; m < 4; ++m) {
                const int lr = lr0 + ai * 128 + m * 16;
                bf16_t* rowp;
                if (u.pn < NT_PB) rowp = P + (size_t)lr * NPB + c0;
                else if (lr < LEX0) { const int b = lr / SEGTOK; const size_t grow = (size_t)b * SEQ + seg * SEGTOK + (lr % SEGTOK); rowp = (bf16_t*)(out + O_YP + grow * D) + (c0 - NPB); }
                else rowp = gex + (size_t)(lr - LEX0) * 2048 + (c0 - NPB);
#pragma unroll
                for (int bj = 0; bj < 2; ++bj) { const f32x4 v0 = acc[ai][bj][m][0], v1 = acc[ai][bj][m][1];
                    u32x4 w; w.x = cvt_pk_bf16(v0[0], v0[1]); w.y = cvt_pk_bf16(v0[2], v0[3]); w.z = cvt_pk_bf16(v1[0], v1[1]); w.w = cvt_pk_bf16(v1[2], v1[3]);
                    *(u32x4*)(rowp + bj * 128) = w; }
            }
    }
};
struct EpiAB {
    static constexpr bool PERM = true;
    bf16_t* tmp; bf16_t* merged; const bf16_t* gex; const float* out;
    __device__ __forceinline__ void operator()(const f32x4 (&acc)[2][2][4][2], const Unit& u, int wr, int wc, int fr, int fq) const {
        const int row0 = u.pm * 256 + wr * 64 + fr, col0 = u.pn * 256 + wc * 32 + 8 * fq;
#pragma unroll
        for (int ai = 0; ai < 2; ++ai)
#pragma unroll
            for (int m = 0; m < 4; ++m) {
                const int grow = row0 + ai * 128 + m * 16;
                const bf16_t* gp = (grow < XROWS) ? ((const bf16_t*)(out + O_YP + (size_t)grow * D) + u.w * D) : (gex + (size_t)(grow - XROWS) * 2048 + u.w * D);
#pragma unroll
                for (int bj = 0; bj < 2; ++bj) {
                    const int c = col0 + bj * 128;
                    float g[8]; unpack8(*(const u32x4*)(gp + c), g);
                    const f32x4 v0 = acc[ai][bj][m][0], v1 = acc[ai][bj][m][1];
                    float v[8] = {v0[0] * sigm(g[0]), v0[1] * sigm(g[1]), v0[2] * sigm(g[2]), v0[3] * sigm(g[3]), v1[0] * sigm(g[4]), v1[1] * sigm(g[5]), v1[2] * sigm(g[6]), v1[3] * sigm(g[7])};
                    bf16_t* tp = tmp + (size_t)grow * D + c;
                    if (u.w == 0) *(u32x4*)tp = pack8(v);
                    else { float t[8]; unpack8(*(const u32x4*)tp, t);
#pragma unroll
                        for (int e = 0; e < 8; ++e) v[e] += t[e];
                        *(u32x4*)(merged + (size_t)grow * D + c) = pack8(v); }
                }
            }
    }
};
struct EpiO {
    static constexpr bool PERM = false;
    float* out; const float* xp; const float* xs;
    __device__ __forceinline__ void operator()(const f32x4 (&acc)[2][2][4][2], const Unit& u, int wr, int wc, int fr, int fq) const {
        const int row0 = u.pm * 256 + wr * 64 + fr, col0 = u.pn * 256 + wc * 32 + 4 * fq;
#pragma unroll
        for (int ai = 0; ai < 2; ++ai)
#pragma unroll
            for (int m = 0; m < 4; ++m) {
                const int grow = row0 + ai * 128 + m * 16;
                const float* xr; float* yr;
                if (grow < XROWS) { xr = xp + (size_t)grow * D; yr = out + O_YP + (size_t)grow * D; }
                else { const int e = grow - XROWS; if (e < EX_SAMP || e >= EX_SHIFT) continue; xr = xs + (size_t)(e - EX_SAMP) * D; yr = out + O_YS + (size_t)(e - EX_SAMP) * D; }
#pragma unroll
                for (int bj = 0; bj < 2; ++bj)
#pragma unroll
                    for (int n = 0; n < 2; ++n) { const int c = col0 + bj * 128 + n * 16; *(f32x4*)(yr + c) = *(const f32x4*)(xr + c) + acc[ai][bj][m][n]; }
            }
    }
};

__device__ __forceinline__ void p0_row(const Params& p, int r, int lane) {
    bf16_t* hrow = (bf16_t*)(p.ws + WS_H) + (size_t)r * D;
    const float* src = nullptr; bool norm = true; float* sh = nullptr;
    if (r < XROWS) { src = p.in[0] + (size_t)r * D; if ((r & (SEQ - 1)) == SEQ - 1) sh = p.out + O_SHIFT_P + (size_t)(r / SEQ) * D; }
    else { const int e = r - XROWS;
        if (e < EX_SAMP) src = p.in[6] + (size_t)e * D;
        else if (e < EX_SHIFT) { src = p.in[1] + (size_t)(e - EX_SAMP) * D; if (((e - EX_SAMP) & 3) == 3) sh = p.out + O_SHIFT_S + (size_t)((e - EX_SAMP) >> 2) * D; }
        else if (e < EX_END) { src = p.in[5] + (size_t)(e - EX_SHIFT) * D; norm = false; } }
    u32x2* o8 = (u32x2*)hrow + lane;
    if (!src) {
#pragma unroll
        for (int j = 0; j < 4; ++j) o8[64 * j] = (u32x2){0u, 0u};
        return; }
    const f32x4* xr = (const f32x4*)src + lane;
    f32x4 v[4]; float ss = 0.f;
#pragma unroll
    for (int j = 0; j < 4; ++j) { v[j] = xr[64 * j]; ss += v[j][0] * v[j][0] + v[j][1] * v[j][1] + v[j][2] * v[j][2] + v[j][3] * v[j][3]; }
    if (norm) {
        const float rs = __builtin_amdgcn_rsqf(wave_sum(ss) * (1.f / D) + 1e-6f);
        const f32x4* wr = (const f32x4*)p.in[7] + lane;
#pragma unroll
        for (int j = 0; j < 4; ++j) v[j] = v[j] * rs * wr[64 * j];
    }
#pragma unroll
    for (int j = 0; j < 4; ++j) { o8[64 * j] = (u32x2){pk2(v[j][0], v[j][1]), pk2(v[j][2], v[j][3])}; if (sh) ((f32x4*)sh)[lane + 64 * j] = v[j]; }
}
template <int MODE> __device__ __forceinline__ void p0_tr_item(const float* W, int N, bf16_t* WT, float* scr, int kb, int nb, int lane) {
    const int k0 = 64 * kb, n0 = 32 * nb;
    const int nn = n0 + (lane & 31);
    int srcc = nn;
    if (MODE == 1) srcc = nn < C_GATE_REF ? nn : (nn < NPB ? -1 : nn - (NPB - C_GATE_REF));
#pragma unroll 8
    for (int i = 0; i < 32; ++i) { const int kk = 2 * i + (lane >> 5); scr[kk * 33 + (lane & 31)] = srcc >= 0 ? W[(size_t)(k0 + kk) * N + srcc] : 0.f; }
    asm volatile("s_waitcnt lgkmcnt(0)" ::: "memory");
    const int c = lane & 7;
#pragma unroll
    for (int j = 0; j < 4; ++j) { const int n = (lane >> 3) + 8 * j; const float* s = scr + (8 * c) * 33 + n;
        u32x4 o; o.x = pk2(s[0 * 33], s[1 * 33]); o.y = pk2(s[2 * 33], s[3 * 33]); o.z = pk2(s[4 * 33], s[5 * 33]); o.w = pk2(s[6 * 33], s[7 * 33]);
        *(u32x4*)(WT + (size_t)(n0 + n) * D + k0 + 8 * c) = o; }
    asm volatile("s_waitcnt lgkmcnt(0)" ::: "memory");
}
__device__ __forceinline__ void h_rows_pair(const Params& p, int r, int r1, bool has1, int lane, const f32x4 (&wv)[4]) {
    const f32x4* x0 = (const f32x4*)(p.in[0] + (size_t)r * D) + lane; const f32x4* x1 = (const f32x4*)(p.in[0] + (size_t)(has1 ? r1 : r) * D) + lane;
    f32x4 a[4], b[4]; float s0 = 0.f, s1 = 0.f;
#pragma unroll
    for (int j = 0; j < 4; ++j) { a[j] = x0[64 * j]; b[j] = x1[64 * j]; }
#pragma unroll
    for (int j = 0; j < 4; ++j) { s0 += a[j][0] * a[j][0] + a[j][1] * a[j][1] + a[j][2] * a[j][2] + a[j][3] * a[j][3]; s1 += b[j][0] * b[j][0] + b[j][1] * b[j][1] + b[j][2] * b[j][2] + b[j][3] * b[j][3]; }
    const float q0 = __builtin_amdgcn_rsqf(wave_sum(s0) * (1.f / D) + 1e-6f), q1 = __builtin_amdgcn_rsqf(wave_sum(s1) * (1.f / D) + 1e-6f);
    u32x2* o0 = (u32x2*)((bf16_t*)(p.ws + WS_H) + (size_t)r * D) + lane; u32x2* o1 = (u32x2*)((bf16_t*)(p.ws + WS_H) + (size_t)r1 * D) + lane;
#pragma unroll
    for (int j = 0; j < 4; ++j) { a[j] = a[j] * q0 * wv[j]; o0[64 * j] = (u32x2){pk2(a[j][0], a[j][1]), pk2(a[j][2], a[j][3])}; }
    if ((r & (SEQ - 1)) == SEQ - 1) { f32x4* sh = (f32x4*)(p.out + O_SHIFT_P + (size_t)(r / SEQ) * D) + lane;
#pragma unroll
        for (int j = 0; j < 4; ++j) sh[64 * j] = a[j]; }
    if (has1) {
#pragma unroll
        for (int j = 0; j < 4; ++j) { b[j] = b[j] * q1 * wv[j]; o1[64 * j] = (u32x2){pk2(b[j][0], b[j][1]), pk2(b[j][2], b[j][3])}; }
        if ((r1 & (SEQ - 1)) == SEQ - 1) { f32x4* sh = (f32x4*)(p.out + O_SHIFT_P + (size_t)(r1 / SEQ) * D) + lane;
#pragma unroll
            for (int j = 0; j < 4; ++j) sh[64 * j] = b[j]; }
    }
}
__device__ __forceinline__ void h_rows_segs(const Params& p, int s_lo, int s_hi, int wi, int nw, int lane) {
    const f32x4* lw = (const f32x4*)p.in[7] + lane;
    f32x4 wv[4];
#pragma unroll
    for (int j = 0; j < 4; ++j) wv[j] = lw[64 * j];
    const int n = (s_hi - s_lo) * NBATCH * SEGTOK;
#pragma unroll 1
    for (int x = wi; x < n; x += 2 * nw) {
        const int x1 = x + nw; const bool has1 = x1 < n;
        const int sg = s_lo + x / (NBATCH * SEGTOK), rem = x % (NBATCH * SEGTOK), r = (rem / SEGTOK) * SEQ + sg * SEGTOK + (rem % SEGTOK);
        const int xx = has1 ? x1 : x; const int sg1 = s_lo + xx / (NBATCH * SEGTOK), rem1 = xx % (NBATCH * SEGTOK), r1 = (rem1 / SEGTOK) * SEQ + sg1 * SEGTOK + (rem1 % SEGTOK);
        h_rows_pair(p, r, r1, has1, lane, wv);
    }
}
__device__ __forceinline__ void phase0(const Params& p, unsigned char* smem) {
    const int tid0 = otid(), wave = tid0 >> 6, lane = tid0 & 63;
    const int gw = obid() * 8 + wave, NGW = gridDim.x * 8;
    float* scr = (float*)smem + wave * (64 * 33);
    constexpr int I_IN = 16 * (NP / 32), I_SQ = 16 * 32;
    for (int it = gw; it < I_IN + 3 * I_SQ; it += NGW) {
        int r = it;
        if (r < I_IN) { p0_tr_item<1>(p.in[8], 10384, (bf16_t*)(p.ws + WS_WT_IN), scr, r / (NP / 32), r % (NP / 32), lane); continue; } r -= I_IN;
        if (r < I_SQ) { p0_tr_item<0>(p.in[13], D, (bf16_t*)(p.ws + WS_WT_A), scr, r / 32, r % 32, lane); continue; } r -= I_SQ;
        if (r < I_SQ) { p0_tr_item<0>(p.in[24], D, (bf16_t*)(p.ws + WS_WT_B), scr, r / 32, r % 32, lane); continue; } r -= I_SQ;
        p0_tr_item<0>(p.in[25], D, (bf16_t*)(p.ws + WS_WT_O), scr, r / 32, r % 32, lane);
    }
    h_rows_segs(p, 0, 2, gw, NGW, lane);
    for (int r = XROWS + gw; r < HROWS; r += NGW) p0_row(p, r, lane);
    {
        float* pk = (float*)(p.ws + WS_PK);
        const int gt = obid() * 512 + tid0, NT = gridDim.x * 512;
        for (int i = gt; i < PK_END; i += NT) {
            const float* src; int o;
            if (i < PK_ALOG) { src = p.in[9]; o = i - PK_CONVW; } else if (i < PK_DTB) { src = p.in[10]; o = i - PK_ALOG; } else if (i < PK_NORMW) { src = p.in[11]; o = i - PK_DTB; }
            else if (i < PK_MU) { src = p.in[12]; o = i - PK_NORMW; } else if (i < PK_W0) { src = p.in[14]; o = i - PK_MU; } else if (i < PK_W2) { src = p.in[15]; o = i - PK_W0; }
            else if (i < PK_A0) { src = p.in[16]; o = i - PK_W2; } else if (i < PK_A2) { src = p.in[17]; o = i - PK_A0; } else if (i < PK_KK) { src = p.in[18]; o = i - PK_A2; }
            else if (i < PK_KA) { src = p.in[19]; o = i - PK_KK; } else if (i < PK_RK) { src = p.in[20]; o = i - PK_KA; } else if (i < PK_GNW) { src = p.in[21]; o = i - PK_RK; }
            else if (i < PK_GNB) { src = p.in[22]; o = i - PK_GNW; } else if (i < PK_LNF) { src = p.in[23]; o = i - PK_GNB; } else { src = p.in[26]; o = i - PK_LNF; }
            pk[i] = src[o];
        }
        bf16_t* w2t = (bf16_t*)(p.ws + WS_W2T); bf16_t* a2t = (bf16_t*)(p.ws + WS_A2T);
        for (int i = gt; i < 65536; i += NT) { const int l = i & 63, c = (i >> 6) & 63, hb = i >> 12;
            w2t[i] = (bf16_t)f2bf(p.in[16][(size_t)l * D + hb * 64 + c]); a2t[i] = (bf16_t)f2bf(p.in[18][(size_t)l * D + hb * 64 + c]); }
    }
}

__device__ __forceinline__ void gdn_item(const Params& p, unsigned char* smem, const float* s_in, float* s_out, const float* halo_in, float* halo_out,
                                         int h, int sl, int rowA, int nA, int rowB, int nB) {
    const int tid = otid(), w = tid >> 6, lane = tid & 63, vl = lane >> 4, kg = lane & 15;
    float* qk_s = (float*)smem; float* v_s = qk_s + 16384; float* o_s = v_s + 2048; float* gb_s = o_s + 2048; float* sst = gb_s + 128;
    const bf16_t* P = (const bf16_t*)(p.ws + WS_P);
    float* ORAW = (float*)(p.ws + WS_ORAW);
    float s[8];
    if (s_in) {
        { const int k = tid >> 2, q4 = tid & 3; const f32x4* src = (const f32x4*)(s_in + (size_t)k * 128 + sl * 32 + q4 * 8); const f32x4 a = src[0], b = src[1];
          float* d = sst + k * 33 + q4 * 8; d[0] = a[0]; d[1] = a[1]; d[2] = a[2]; d[3] = a[3]; d[4] = b[0]; d[5] = b[1]; d[6] = b[2]; d[7] = b[3]; }
        __syncthreads();
#pragma unroll
        for (int j = 0; j < 8; ++j) s[j] = sst[(kg * 8 + j) * 33 + 4 * w + vl];
        __syncthreads();
    } else {
#pragma unroll
        for (int j = 0; j < 8; ++j) s[j] = 0.f;
    }
    int pcol = -1;
    if (tid < 128) pcol = h * 128 + tid; else if (tid < 256) pcol = 1024 + h * 128 + (tid - 128); else if (tid < 288) pcol = 2048 + h * 128 + sl * 32 + (tid - 256);
    float cw0 = 0.f, cw1 = 0.f, cw2 = 0.f, cw3 = 0.f, x1 = 0.f, x2 = 0.f, x3 = 0.f;
    const float* pk = (const float*)(p.ws + WS_PK);
    if (pcol >= 0) { const float* cw = pk + PK_CONVW; cw0 = cw[pcol]; cw1 = cw[3072 + pcol]; cw2 = cw[6144 + pcol]; cw3 = cw[9216 + pcol];
        if (halo_in) { x3 = halo_in[pcol]; x2 = halo_in[3072 + pcol]; x1 = halo_in[6144 + pcol]; } }
    const float nalog = -expf(pk[PK_ALOG + h]), dtb = pk[PK_DTB + h];
#pragma unroll 1
    for (int run = 0; run < 2; ++run) {
        const int rrow = run ? rowB : rowA, rn = run ? nB : nA; const bool wout = run != 0;
#pragma unroll 1
        for (int c0 = 0; c0 < rn; c0 += 64) {
            const int nt = (rn - c0) < 64 ? (rn - c0) : 64; const int row = rrow + c0;
            if (pcol >= 0) {
                const bf16_t* src = P + (size_t)row * NPB + pcol;
                float* dst = tid < 256 ? (qk_s + tid) : (v_s + (tid - 256)); const int dstride = tid < 256 ? 256 : 32;
#pragma unroll 8
                for (int i = 0; i < nt; ++i) { const float x0 = bf2f(src[(size_t)i * NPB]); const float y = cw0 * x3 + cw1 * x2 + cw2 * x1 + cw3 * x0; x3 = x2; x2 = x1; x1 = x0; dst[i * dstride] = silu_(y); }
            } else if (tid < 352) {
                const int i = tid - 288;
                if (i < nt) { const float pa = bf2f(P[(size_t)(row + i) * NPB + C_A + h]), pb = bf2f(P[(size_t)(row + i) * NPB + C_B + h]);
                    gb_s[2 * i] = expf(nalog * softplus_(pa + dtb)); gb_s[2 * i + 1] = sigm(pb); }
            }
            __syncthreads();
#pragma unroll 1
            for (int ii = 0; ii < 8; ++ii) { const int i = w * 8 + ii;
                if (i < nt) {
#pragma unroll
                    for (int which = 0; which < 2; ++which) { float* rp = qk_s + i * 256 + which * 128; const float a = rp[lane], b = rp[lane + 64];
                        const float sc = __builtin_amdgcn_rsqf(wave_sum(a * a + b * b) + 1e-6f) * (which == 0 ? 0.08838834764831845f : 1.f); rp[lane] = a * sc; rp[lane + 64] = b * sc; } } }
            __syncthreads();
#pragma unroll 1
            for (int i = 0; i < nt; ++i) {
                const f32x4 q0 = *(const f32x4*)(qk_s + i * 256 + kg * 8), q1 = *(const f32x4*)(qk_s + i * 256 + kg * 8 + 4);
                const f32x4 k0 = *(const f32x4*)(qk_s + i * 256 + 128 + kg * 8), k1 = *(const f32x4*)(qk_s + i * 256 + 128 + kg * 8 + 4);
                const float vv = v_s[i * 32 + 4 * w + vl], a = gb_s[2 * i], be = gb_s[2 * i + 1];
                float part = k0[0] * s[0] + k0[1] * s[1] + k0[2] * s[2] + k0[3] * s[3] + k1[0] * s[4] + k1[1] * s[5] + k1[2] * s[6] + k1[3] * s[7];
                const float kS = rowsum16(part);
                const float c = be * (vv - a * kS);
                s[0] = a * s[0] + k0[0] * c; s[1] = a * s[1] + k0[1] * c; s[2] = a * s[2] + k0[2] * c; s[3] = a * s[3] + k0[3] * c;
                s[4] = a * s[4] + k1[0] * c; s[5] = a * s[5] + k1[1] * c; s[6] = a * s[6] + k1[2] * c; s[7] = a * s[7] + k1[3] * c;
                float op = q0[0] * s[0] + q0[1] * s[1] + q0[2] * s[2] + q0[3] * s[3] + q1[0] * s[4] + q1[1] * s[5] + q1[2] * s[6] + q1[3] * s[7];
                const float o = rowsum16(op);
                if (kg == 0) o_s[i * 32 + 4 * w + vl] = o;
            }
            __syncthreads();
            if (wout) { const int i = tid >> 3, c4 = (tid & 7) * 4; if (i < nt) *(f32x4*)(ORAW + (size_t)(row + i) * D + h * 128 + sl * 32 + c4) = *(const f32x4*)(o_s + i * 32 + c4); }
        }
    }
    if (pcol >= 0 && (sl == 0 || tid >= 256)) { halo_out[pcol] = x3; halo_out[3072 + pcol] = x2; halo_out[6144 + pcol] = x1; }
#pragma unroll
    for (int j = 0; j < 8; ++j) sst[(kg * 8 + j) * 33 + 4 * w + vl] = s[j];
    __syncthreads();
    { const int k = tid >> 2, q4 = tid & 3; const float* d = sst + k * 33 + q4 * 8; f32x4* dst = (f32x4*)(s_out + (size_t)k * 128 + sl * 32 + q4 * 8);
      dst[0] = (f32x4){d[0], d[1], d[2], d[3]}; dst[1] = (f32x4){d[4], d[5], d[6], d[7]}; }
    __syncthreads();
}

constexpr int RW_W2 = 20544, RW_A2 = 24640;
__device__ __forceinline__ void rwkv_load_lora(const Params& p, unsigned char* smem, int hb) {
    float* w2_s = (float*)smem + RW_W2; float* a2_s = (float*)smem + RW_A2; const float* pk = (const float*)(p.ws + WS_PK);
    for (int i = otid(); i < 4096; i += 512) { const int l = i >> 6, c = i & 63; w2_s[i] = pk[PK_W2 + l * D + hb * 64 + c]; a2_s[i] = pk[PK_A2 + l * D + hb * 64 + c]; }
    __syncthreads();
}
__device__ __forceinline__ void rwkv_item(const Params& p, unsigned char* smem, const float* s_in, float* s_out, const bf16_t* prev_row, const float* halo_in, float* halo_out,
                                          int hb, int half, int rowA, int nA, int rowB, int nB) {
    const int tid = otid(), w = tid >> 6, lane = tid & 63, row = tid >> 4, kq = tid & 15;
    float* f = (float*)smem;
    float* r_s = f; float* kb_s = f + 2048; float* v_s = f + 4096; float* wd_s = f + 6144; float* ad_s = f + 8192; float* dec_s = f + 10240; float* a_s = f + 12288;
    float* kk_s = f + 14336; float* km_s = f + 16384; float* zb_s = f + 18432; float* y_s = f + 19456; float* bonus_s = f + 20480;
    const float* w2_s = f + RW_W2; const float* a2_s = f + RW_A2;
    const bf16_t* P = (const bf16_t*)(p.ws + WS_P);
    float* YRAW = (float*)(p.ws + WS_YRAW); bf16_t* C0 = (bf16_t*)(p.ws + WS_C0); bf16_t* C1 = (bf16_t*)(p.ws + WS_C1);
    float s[4];
    if (s_in) { const f32x4 t = *(const f32x4*)(s_in + (size_t)(half * 32 + row) * 64 + kq * 4); s[0] = t[0]; s[1] = t[1]; s[2] = t[2]; s[3] = t[3]; }
    else { s[0] = s[1] = s[2] = s[3] = 0.f; }
    int col = -1; float* dst = nullptr; int dstride = 64; bool is_wd = false, owner = false;
    if (tid < 64) { col = hb * 64 + tid; dst = r_s + tid; owner = half == 0; }
    else if (tid < 128) { col = 1024 + hb * 64 + (tid - 64); dst = kb_s + (tid - 64); owner = half == 0; }
    else if (tid < 192) { col = 2048 + hb * 64 + (tid - 128); dst = v_s + (tid - 128); owner = half == 0; }
    else if (tid < 256) { col = 3072 + (tid - 192); dst = wd_s + (tid - 192); is_wd = true; owner = (half == 0 && hb == 0); }
    else if (tid < 320) { col = 3136 + (tid - 256); dst = ad_s + (tid - 256); owner = (half == 0 && hb == 0); }
    else if (tid < 352) { col = 3200 + hb * 64 + half * 32 + (tid - 320); dst = zb_s + (tid - 320); dstride = 32; owner = true; }
    float mu = 0.f, prev = 0.f;
    const float* pk = (const float*)(p.ws + WS_PK);
    if (col >= 0) { mu = pk[PK_MU + col]; prev = prev_row ? bf2f(prev_row[C_RW + col]) : (halo_in ? halo_in[col] : 0.f); }
    const int cc = tid & 63, ig = tid >> 6;
    const int hc = hb * 64 + cc;
    const float w0c = pk[PK_W0 + hc], a0c = pk[PK_A0 + hc], kkc = pk[PK_KK + hc], kac = pk[PK_KA + hc];
    const float rkl = pk[PK_RK + hb * 64 + lane];
#pragma unroll 1
    for (int run = 0; run < 2; ++run) {
        const int rrow = run ? rowB : rowA, rn = run ? nB : nA; const bool wout = run != 0;
#pragma unroll 1
        for (int c0 = 0; c0 < rn; c0 += 32) {
            const int nt = (rn - c0) < 32 ? (rn - c0) : 32; const int row0 = rrow + c0;
            if (col >= 0) {
                const bf16_t* src = P + (size_t)row0 * NPB + C_RW + col;
#pragma unroll 8
                for (int i = 0; i < nt; ++i) { const float cur = bf2f(src[(size_t)i * NPB]); float m = cur + mu * (prev - cur); prev = cur; if (is_wd) m = tanh_(m); dst[i * dstride] = m; }
            }
            __syncthreads();
            {
                float aw[4] = {0.f, 0.f, 0.f, 0.f}, aa[4] = {0.f, 0.f, 0.f, 0.f};
#pragma unroll 4
                for (int l = 0; l < 64; ++l) { const float w2v = w2_s[l * 64 + cc], a2v = a2_s[l * 64 + cc];
#pragma unroll
                    for (int ii = 0; ii < 4; ++ii) { aw[ii] += wd_s[(ig * 4 + ii) * 64 + l] * w2v; aa[ii] += ad_s[(ig * 4 + ii) * 64 + l] * a2v; } }
#pragma unroll
                for (int ii = 0; ii < 4; ++ii) { const int i = ig * 4 + ii;
                    if (i < nt) { const float wraw = w0c + aw[ii]; const float wlog = -0.6065306597126334f * sigm(wraw); const float a = sigm(a0c + aa[ii]);
                        const float kbv = kb_s[i * 64 + cc];
                        dec_s[i * 64 + cc] = expf(wlog); a_s[i * 64 + cc] = a; kk_s[i * 64 + cc] = kbv * kkc; km_s[i * 64 + cc] = kbv * (1.f + (a - 1.f) * kac); } }
            }
            __syncthreads();
#pragma unroll 1
            for (int ii = 0; ii < 4; ++ii) { const int i = w * 4 + ii;
                if (i < nt) { const float kkr = kk_s[i * 64 + lane]; const float kk = kkr * __builtin_amdgcn_rsqf(wave_sum(kkr * kkr) + 1e-6f); kk_s[i * 64 + lane] = kk;
                    const float a = a_s[i * 64 + lane]; a_s[i * 64 + lane] = kk * a;
                    const float rk = wave_sum(r_s[i * 64 + lane] * km_s[i * 64 + lane] * rkl); if (lane == 0) bonus_s[i] = rk; } }
            __syncthreads();
#pragma unroll 1
            for (int i = 0; i < nt; ++i) {
                const f32x4 kk4 = *(const f32x4*)(kk_s + i * 64 + kq * 4), de4 = *(const f32x4*)(dec_s + i * 64 + kq * 4), ka4 = *(const f32x4*)(a_s + i * 64 + kq * 4),
                            km4 = *(const f32x4*)(km_s + i * 64 + kq * 4), r4 = *(const f32x4*)(r_s + i * 64 + kq * 4);
                const float vv = v_s[i * 64 + half * 32 + row];
                const float sa = rowsum16(s[0] * kk4[0] + s[1] * kk4[1] + s[2] * kk4[2] + s[3] * kk4[3]);
#pragma unroll
                for (int j = 0; j < 4; ++j) s[j] = s[j] * de4[j] + (vv * km4[j] - sa * ka4[j]);
                const float y = rowsum16(s[0] * r4[0] + s[1] * r4[1] + s[2] * r4[2] + s[3] * r4[3]);
                if (kq == 0) y_s[i * 32 + row] = y;
            }
            __syncthreads();
            if (wout) { const int i = tid >> 4;
                if (i < nt) {
#pragma unroll
                    for (int q = 0; q < 2; ++q) { const int rr = (tid & 15) * 2 + q, v = half * 32 + rr, colo = hb * 64 + v;
                        const float sz = silu_(zb_s[i * 32 + rr]);
                        const size_t o = (size_t)(row0 + i) * D + colo;
                        YRAW[o] = y_s[i * 32 + rr]; C1[o] = (bf16_t)f2bf(pk[PK_GNW + colo] * sz); C0[o] = (bf16_t)f2bf((pk[PK_GNB + colo] + bonus_s[i] * v_s[i * 64 + v]) * sz); } } }
            __syncthreads();
        }
    }
    *(f32x4*)(s_out + (size_t)(half * 32 + row) * 64 + kq * 4) = (f32x4){s[0], s[1], s[2], s[3]};
    if (col >= 0 && owner && halo_out) halo_out[col] = prev;
}


__device__ __forceinline__ bf16x8 ldfrag(const bf16_t* base, int stride, int r0, int k0, int lane) {
    return *(const bf16x8*)(base + (r0 + (lane & 15)) * stride + k0 + 8 * (lane >> 4));
}
#define MFMA16(a, b, c) __builtin_amdgcn_mfma_f32_16x16x32_bf16((a), (b), (c), 0, 0, 0)
typedef short s16x4 __attribute__((ext_vector_type(4)));
__device__ __forceinline__ bf16x8 ldfrag_tr(const bf16_t* X, int stride, int c0, int k0, int lane) {
    const int l15 = lane & 15;
    const bf16_t* a = X + (k0 + 8 * (lane >> 4) + (l15 >> 2)) * stride + c0 + 4 * (l15 & 3);
    const s16x4 lo = __builtin_amdgcn_ds_read_tr16_b64_v4i16((LAS s16x4*)a), hi = __builtin_amdgcn_ds_read_tr16_b64_v4i16((LAS s16x4*)(a + 4 * stride));
    return __builtin_shufflevector(lo, hi, 0, 1, 2, 3, 4, 5, 6, 7);
}
__device__ __forceinline__ void inv_block(const float* L, float* Tm, float* XS, int tid) {
    const int w = tid >> 6, lane = tid & 63;
    typedef float f32x2v __attribute__((ext_vector_type(2)));
    if (w < 4 && lane < 16) {
        const float* Lb = L + (16 * w) * 64 + 16 * w; float* Tb = Tm + (16 * w) * 64 + 16 * w;
        float tr[16];
#pragma unroll
        for (int i = 0; i < 16; ++i) tr[i] = 0.f;
#pragma unroll
        for (int i = 0; i < 16; ++i) { float a = (lane == i) ? 1.f : 0.f;
#pragma unroll
            for (int j0 = 0; j0 < i; j0 += 4) { const f32x4 l4 = *(const f32x4*)(Lb + i * 64 + j0);
                a -= l4[0] * tr[j0] + l4[1] * tr[j0 + 1] + l4[2] * tr[j0 + 2] + l4[3] * tr[j0 + 3]; }
            tr[i] = a; Tb[i * 64 + lane] = a; }
    }
    for (int e = tid; e < 1536; e += 512) { const int k = e >> 8, r = (e >> 4) & 15, c = e & 15;
        const int rb = k < 3 ? 0 : (k < 5 ? 1 : 2), cb = k < 3 ? k + 1 : (k < 5 ? k - 1 : 3);
        Tm[(16 * rb + r) * 64 + 16 * cb + c] = 0.f; }
    __syncthreads();
    {
        const int B = tid >> 8, i = (tid >> 4) & 15, c = tid & 15, o = 32 * B;
        float x = 0.f;
#pragma unroll
        for (int j0 = 0; j0 < 16; j0 += 4) { const f32x4 l4 = *(const f32x4*)(L + (o + 16 + i) * 64 + o + j0);
            x += l4[0] * Tm[(o + j0) * 64 + o + c] + l4[1] * Tm[(o + j0 + 1) * 64 + o + c] + l4[2] * Tm[(o + j0 + 2) * 64 + o + c] + l4[3] * Tm[(o + j0 + 3) * 64 + o + c]; }
        XS[tid] = x;
        __syncthreads();
        float t = 0.f;
#pragma unroll
        for (int j0 = 0; j0 < 16; j0 += 4) { const f32x4 t4 = *(const f32x4*)(Tm + (o + 16 + i) * 64 + o + 16 + j0);
            t += t4[0] * XS[(B << 8) + j0 * 16 + c] + t4[1] * XS[(B << 8) + (j0 + 1) * 16 + c] + t4[2] * XS[(B << 8) + (j0 + 2) * 16 + c] + t4[3] * XS[(B << 8) + (j0 + 3) * 16 + c]; }
        Tm[(o + 16 + i) * 64 + o + c] = -t;
    }
    __syncthreads();
    {
        const int i = tid >> 4, c2 = (tid & 15) * 2;
        float x0 = 0.f, x1 = 0.f;
#pragma unroll
        for (int j0 = 0; j0 < 32; j0 += 4) { const f32x4 l4 = *(const f32x4*)(L + (32 + i) * 64 + j0);
#pragma unroll
            for (int e = 0; e < 4; ++e) { const f32x2v tv = *(const f32x2v*)(Tm + (j0 + e) * 64 + c2); x0 += l4[e] * tv[0]; x1 += l4[e] * tv[1]; } }
        *(f32x2v*)(XS + i * 32 + c2) = (f32x2v){x0, x1};
        __syncthreads();
        float t0 = 0.f, t1 = 0.f;
#pragma unroll
        for (int j0 = 0; j0 < 32; j0 += 4) { const f32x4 t4 = *(const f32x4*)(Tm + (32 + i) * 64 + 32 + j0);
#pragma unroll
            for (int e = 0; e < 4; ++e) { const f32x2v xv = *(const f32x2v*)(XS + (j0 + e) * 32 + c2); t0 += t4[e] * xv[0]; t1 += t4[e] * xv[1]; } }
        *(f32x2v*)(Tm + (32 + i) * 64 + c2) = (f32x2v){-t0, -t1};
    }
    __syncthreads();
}
constexpr int PL_QS = 0, PL_R1 = 17408, PL_KT = 35840, PL_KTT = 54272, PL_VT = 72704, PL_R3 = 91136, PL_QKM = 109568, PL_TP = 118784, PL_TPP = 128000, PL_SM = 137216, PL_TM = 139264, PL_XS = 155648;
constexpr int QSTR = 136, TSTR = 72;

__device__ __forceinline__ void gdn_prep_item(const Params& p, unsigned char* smem, int h, int row_start, int npad, const bf16_t* hbase,
                                              bf16_t* halo_out, float* conv_out, unsigned char* rec) {
    const int tid = otid(), w = tid >> 6, lane = tid & 63, q4 = lane >> 4, l15 = lane & 15;
    bf16_t* qs = (bf16_t*)(smem + PL_QS); bf16_t* ks = (bf16_t*)(smem + PL_R1); bf16_t* WT = ks; bf16_t* kts = (bf16_t*)(smem + PL_KT);
    bf16_t* vs = (bf16_t*)(smem + PL_VT);         float* Lm = (float*)(smem + PL_R3); bf16_t* UT = (bf16_t*)(smem + PL_R3); bf16_t* QKm = (bf16_t*)(smem + PL_QKM);
    bf16_t* Tp = (bf16_t*)(smem + PL_TP); bf16_t* Tpp = (bf16_t*)(smem + PL_TPP);
    float* sm = (float*)(smem + PL_SM);
    float* gcs = sm; float* bes = sm + 64; float* ssq = sm + 128; float* ssk = sm + 192; float* egs = sm + 256; float* egl_s = sm + 320; float* beg = sm + 384;
    const bf16_t* P = (const bf16_t*)(p.ws + WS_P);
    const float* pk = (const float*)(p.ws + WS_PK);
    if (npad == 0) {
        const int t = tid >> 3, g = tid & 7;
        const bf16_t* zp = P + (size_t)(row_start + t) * NPB + C_Z + h * 128 + 16 * g;
        const u32x4 z0 = *(const u32x4*)zp, z1 = *(const u32x4*)(zp + 8);
        float za[8], zb[8]; unpack8(z0, za); unpack8(z1, zb);
        const float* nwp = pk + PK_NORMW + 16 * g;
        float ga[8], gb2[8];
#pragma unroll
        for (int e = 0; e < 8; ++e) { ga[e] = nwp[e] * silu_(za[e]); gb2[e] = nwp[8 + e] * silu_(zb[e]); }
        bf16_t* gp = (bf16_t*)(rec + GP_G) + t * 128 + 16 * g;
        *(u32x4*)gp = pack8(ga); *(u32x4*)(gp + 8) = pack8(gb2);
    }
    if (w == 7) {
        const int i = lane;
        float g = 0.f, be = 0.f;
        if (i >= npad) { const size_t r = (size_t)(row_start + i - npad) * NPB; const float pa = bf2f(P[r + C_A + h]), pb = bf2f(P[r + C_B + h]);
            g = -expf(pk[PK_ALOG + h]) * softplus_(pa + pk[PK_DTB + h]); be = sigm(pb); }
        float x = g;
#pragma unroll
        for (int o = 1; o < 64; o <<= 1) { const float y = __shfl_up(x, o); if (lane >= o) x += y; }
        const float gl = __shfl(x, 63);
        gcs[lane] = x; bes[lane] = be; egs[lane] = __expf(x); egl_s[lane] = __expf(gl - x); beg[lane] = be * __expf(x);
        if (lane == 0) *(float*)(rec + GP_EGL) = __expf(gl);
    }
    __syncthreads();
    if (tid < 384) {
        const int sec = tid >> 7, ts = (tid >> 4) & 7, t0 = 8 * ts, d0 = l15 * 8;
        const int pcol = sec * 1024 + h * 128 + d0;
        float cw[4][8];
#pragma unroll
        for (int j = 0; j < 4; ++j) { const f32x4 a = *(const f32x4*)(pk + PK_CONVW + j * 3072 + pcol), b = *(const f32x4*)(pk + PK_CONVW + j * 3072 + pcol + 4);
            cw[j][0] = a[0]; cw[j][1] = a[1]; cw[j][2] = a[2]; cw[j][3] = a[3]; cw[j][4] = b[0]; cw[j][5] = b[1]; cw[j][6] = b[2]; cw[j][7] = b[3]; }
        u32x4 rw[11]; float fv[11];
#pragma unroll
        for (int k = 0; k < 11; ++k) {
            const int ii = t0 - 3 + k;
            const bf16_t* ptr = P + pcol; float f = 0.f;
            if (ii >= npad) { ptr = P + (size_t)(row_start + ii - npad) * NPB + pcol; f = 1.f; }
            else if (ii < 0 && npad == 0 && hbase) { ptr = hbase + (size_t)(ii + 3) * NPB + pcol; f = 1.f; }
            rw[k] = *(const u32x4*)ptr; fv[k] = f;
        }
        if (halo_out && ts == 7) {
#pragma unroll
            for (int dd = 0; dd < 3; ++dd) { *(u32x4*)(halo_out + (size_t)dd * NPB + pcol) = rw[8 + dd];
                if (conv_out) { float x[8]; unpack8(rw[8 + dd], x); *(f32x4*)(conv_out + dd * 3072 + pcol) = (f32x4){x[0], x[1], x[2], x[3]}; *(f32x4*)(conv_out + dd * 3072 + pcol + 4) = (f32x4){x[4], x[5], x[6], x[7]}; } }
        }
        float y[8][8];
#pragma unroll
        for (int t = 0; t < 8; ++t)
#pragma unroll
            for (int e = 0; e < 8; ++e) y[t][e] = 0.f;
#pragma unroll
        for (int k = 0; k < 11; ++k) { float x[8]; unpack8(rw[k], x);
#pragma unroll
            for (int e = 0; e < 8; ++e) x[e] *= fv[k];
#pragma unroll
            for (int dlt = 0; dlt < 4; ++dlt) { const int t = k - dlt;
                if (t >= 0 && t < 8) {
#pragma unroll
                    for (int e = 0; e < 8; ++e) y[t][e] += cw[dlt][e] * x[e]; } }
        }
        const float qsc = sec == 0 ? 0.08838834764831845f : 1.f;
#pragma unroll
        for (int t = 0; t < 8; ++t) {
            const bool tokv = (t0 + t) >= npad;
            float ss = 0.f;
#pragma unroll
            for (int e = 0; e < 8; ++e) { y[t][e] = tokv ? silu_(y[t][e]) : 0.f; ss += y[t][e] * y[t][e]; }
            if (sec < 2) { const float sc = __builtin_amdgcn_rsqf(rowsum16(ss) + 1e-6f) * qsc;
#pragma unroll
                for (int e = 0; e < 8; ++e) y[t][e] *= sc; }
        }
        { bf16_t* dst = sec == 0 ? qs : (sec == 1 ? ks : vs);
#pragma unroll
            for (int t = 0; t < 8; ++t) *(u32x4*)(dst + (t0 + t) * QSTR + d0) = pack8(y[t]); }
        if (sec == 1) {
#pragma unroll
            for (int t = 0; t < 8; ++t) { const float eg = egl_s[t0 + t]; float z[8];
#pragma unroll
                for (int e = 0; e < 8; ++e) z[e] = y[t][e] * eg;
                *(u32x4*)(kts + (t0 + t) * QSTR + d0) = pack8(z); } }
    }
    __syncthreads();
    {
        const int which = w >> 2, it = w & 3;
        const bf16_t* Barr = which ? qs : ks;
        bf16x8 bfr[4];
#pragma unroll
        for (int kk = 0; kk < 4; ++kk) bfr[kk] = ldfrag(Barr, QSTR, 16 * it, 32 * kk, lane);
        const int i = 16 * it + l15; const float gi = gcs[i], bi = bes[i];
#pragma unroll
        for (int jt = 0; jt < 4; ++jt) {
            f32x4 acc = {0.f, 0.f, 0.f, 0.f};
#pragma unroll
            for (int kk = 0; kk < 4; ++kk) acc = MFMA16(ldfrag(ks, QSTR, 16 * jt, 32 * kk, lane), bfr[kk], acc);
            const int j0 = 16 * jt + 4 * q4; const f32x4 gj = *(const f32x4*)(gcs + j0);
            f32x4 o;
#pragma unroll
            for (int r = 0; r < 4; ++r) { const int j = j0 + r; const bool keep = which ? (i >= j) : (i > j); o[r] = keep ? acc[r] * __expf(gi - gj[r]) : 0.f; }
            if (which == 0) *(f32x4*)(Lm + i * 64 + j0) = o * bi;
            else *(u32x2*)(QKm + i * TSTR + j0) = (u32x2){pk2(o[0], o[1]), pk2(o[2], o[3])};
        }
    }
    __syncthreads();
    {
        float* Tm = (float*)(smem + PL_TM);
        inv_block(Lm, Tm, (float*)(smem + PL_XS), tid);
        const int i = tid >> 3, j0 = (tid & 7) * 8;
        float a[8], b2[8];
#pragma unroll
        for (int e = 0; e < 8; ++e) { const float tv = Tm[i * 64 + j0 + e]; a[e] = tv * beg[j0 + e]; b2[e] = tv * bes[j0 + e]; }
        *(u32x4*)(Tp + i * TSTR + j0) = (u32x4){pk2(a[0], a[1]), pk2(a[2], a[3]), pk2(a[4], a[5]), pk2(a[6], a[7])};
        *(u32x4*)(Tpp + i * TSTR + j0) = (u32x4){pk2(b2[0], b2[1]), pk2(b2[2], b2[3]), pk2(b2[4], b2[5]), pk2(b2[6], b2[7])};
    }
    __syncthreads();
    {
        const int it = w & 3, half = w >> 2;
        f32x4 aw[4], au[4];
#pragma unroll
        for (int x = 0; x < 4; ++x) { aw[x] = (f32x4){0.f, 0.f, 0.f, 0.f}; au[x] = (f32x4){0.f, 0.f, 0.f, 0.f}; }
#pragma unroll
        for (int kk = 0; kk < 2; ++kk) {
            const bf16x8 a1 = ldfrag(Tp, TSTR, 16 * it, 32 * kk, lane), a2 = ldfrag(Tpp, TSTR, 16 * it, 32 * kk, lane);
#pragma unroll
            for (int x = 0; x < 4; ++x) { const int dt = half * 4 + x;
                aw[x] = MFMA16(a1, ldfrag_tr(ks, QSTR, 16 * dt, 32 * kk, lane), aw[x]);
                au[x] = MFMA16(a2, ldfrag_tr(vs, QSTR, 16 * dt, 32 * kk, lane), au[x]); }
        }
        __syncthreads();
#pragma unroll
        for (int x = 0; x < 4; ++x) { const int d = 16 * (half * 4 + x) + l15, i0 = 16 * it + 4 * q4;
            *(u32x2*)(WT + d * TSTR + i0) = (u32x2){pk2(aw[x][0], aw[x][1]), pk2(aw[x][2], aw[x][3])};
            *(u32x2*)(UT + d * TSTR + i0) = (u32x2){pk2(au[x][0], au[x][1]), pk2(au[x][2], au[x][3])}; }
    }
    __syncthreads();
    {
        bf16_t* gAP = (bf16_t*)(rec + GP_AP); bf16_t* gQH = (bf16_t*)(rec + GP_QH); bf16_t* gKH = (bf16_t*)(rec + GP_KH); bf16_t* gOH = (bf16_t*)(rec + GP_OH);
        {
            const int et = w;
            const bf16x8 a0 = ldfrag(WT, TSTR, 16 * et, 0, lane), a1 = ldfrag(WT, TSTR, 16 * et, 32, lane);
#pragma unroll
            for (int dt = 0; dt < 8; ++dt) { f32x4 acc = {0.f, 0.f, 0.f, 0.f};
                acc = MFMA16(a0, ldfrag_tr(kts, QSTR, 16 * dt, 0, lane), acc); acc = MFMA16(a1, ldfrag_tr(kts, QSTR, 16 * dt, 32, lane), acc);
                *(u32x2*)(gAP + ((size_t)(dt * 4 + (et >> 1)) * 64 + lane) * 8 + (et & 1) * 4) = (u32x2){pk2(-acc[0], -acc[1]), pk2(-acc[2], -acc[3])}; }
#pragma unroll
            for (int tt = 0; tt < 4; ++tt) { f32x4 acc = {0.f, 0.f, 0.f, 0.f};
                acc = MFMA16(a0, ldfrag(QKm, TSTR, 16 * tt, 0, lane), acc); acc = MFMA16(a1, ldfrag(QKm, TSTR, 16 * tt, 32, lane), acc);
                const int t = 16 * tt + l15, e0 = 16 * et + 4 * q4; const float eg = egs[t];
                const u32x2 qq = *(const u32x2*)(qs + t * QSTR + e0);
                const float o0 = __uint_as_float(qq.x << 16) * eg - acc[0], o1 = __uint_as_float(qq.x & 0xffff0000u) * eg - acc[1],
                            o2 = __uint_as_float(qq.y << 16) * eg - acc[2], o3 = __uint_as_float(qq.y & 0xffff0000u) * eg - acc[3];
                *(u32x2*)(gQH + ((size_t)(tt * 4 + (et >> 1)) * 64 + lane) * 8 + (et & 1) * 4) = (u32x2){pk2(o0, o1), pk2(o2, o3)}; }
        }
        {
            const int dt = w;
            const bf16x8 a0 = ldfrag_tr(kts, QSTR, 16 * dt, 0, lane), a1 = ldfrag_tr(kts, QSTR, 16 * dt, 32, lane);
#pragma unroll
            for (int vt = 0; vt < 8; ++vt) { f32x4 acc = {0.f, 0.f, 0.f, 0.f};
                acc = MFMA16(a0, ldfrag(UT, TSTR, 16 * vt, 0, lane), acc); acc = MFMA16(a1, ldfrag(UT, TSTR, 16 * vt, 32, lane), acc);
                *(u32x2*)(gKH + ((size_t)(vt * 8 + dt) * 64 + lane) * 4) = (u32x2){pk2(acc[0], acc[1]), pk2(acc[2], acc[3])}; }
            const int tt = w & 3, vh = w >> 2;
            const bf16x8 b0 = ldfrag(QKm, TSTR, 16 * tt, 0, lane), b1 = ldfrag(QKm, TSTR, 16 * tt, 32, lane);
#pragma unroll
            for (int x = 0; x < 4; ++x) { const int vt = vh * 4 + x; f32x4 acc = {0.f, 0.f, 0.f, 0.f};
                acc = MFMA16(b0, ldfrag(UT, TSTR, 16 * vt, 0, lane), acc); acc = MFMA16(b1, ldfrag(UT, TSTR, 16 * vt, 32, lane), acc);
                *(u32x2*)(gOH + ((size_t)(vt * 4 + tt) * 64 + lane) * 4) = (u32x2){pk2(acc[0], acc[1]), pk2(acc[2], acc[3])}; }
        }
    }
    __syncthreads();
}

__device__ __forceinline__ void phase_gprep(const Params& p, int seg, unsigned char* smem) {
    const int blk = obid();
    const int n_items = (CPS + (seg == 0 ? 1 : 0)) * 64;
#pragma unroll 1
    for (int it = blk; it < n_items; it += gridDim.x) {
        const int bh = it & 63, b = bh >> 3, h = bh & 7; int cl = it >> 6; if (seg != 0) cl += 1;
        unsigned char* rec = p.ws + WS_GP + (size_t)(cl * 64 + bh) * GP_STRIDE;
        const bf16_t* Pb = (const bf16_t*)(p.ws + WS_P);
        bf16_t* chalo2 = (bf16_t*)(p.ws + WS_CHALO);
        if (cl == 0) gdn_prep_item(p, smem, h, LEX0, 48, nullptr, nullptr, nullptr, rec);
        else {
            const int row = b * SEGTOK + (cl - 1) * 64;
            const bf16_t* hbase = Pb + (size_t)(row - 3) * NPB;
            if (cl == 1) hbase = (seg == 0) ? Pb + (size_t)(LEX0 + NMETA - 3) * NPB : chalo2 + (size_t)(((seg - 1) & 1) * NBATCH + b) * 3 * NPB;
            bf16_t* ho = (cl == CPS) ? chalo2 + (size_t)((seg & 1) * NBATCH + b) * 3 * NPB : nullptr;
            float* co = (cl == CPS && seg == NSEG - 1) ? p.out + O_CONV_P + (size_t)b * 9216 : nullptr;
            gdn_prep_item(p, smem, h, row, 0, hbase, ho, co, rec);
        }
    }
}

__device__ __forceinline__ void gdn_scan_block(const Params& p, int seg, unsigned char* smem, int bh) {
    const int tid = otid(), w = tid >> 6, lane = tid & 63, q4 = lane >> 4, l15 = lane & 15;
    const int b = bh >> 3, h = bh & 7;
    float* st = p.out + O_GDN_P + (size_t)bh * 16384;
    f32x4 S[8];
    if (seg) {
#pragma unroll
        for (int mt = 0; mt < 8; ++mt)
#pragma unroll
            for (int r = 0; r < 4; ++r) S[mt][r] = st[(size_t)(16 * mt + 4 * q4 + r) * 128 + 16 * w + l15];
    } else {
#pragma unroll
        for (int mt = 0; mt < 8; ++mt) S[mt] = (f32x4){0.f, 0.f, 0.f, 0.f};
    }
    const int c_lo = seg ? 1 : 0;
    float* obuf = (float*)(smem + 98304);
    {
        const u32x4* src = (const u32x4*)(p.ws + WS_GP + (size_t)(c_lo * 64 + bh) * GP_STRIDE); u32x4* dst = (u32x4*)smem;
#pragma unroll
        for (int x = 0; x < 6; ++x) dst[tid + 512 * x] = src[tid + 512 * x];
    }
#pragma unroll 1
    for (int cl = c_lo; cl <= CPS; ++cl) {
        const unsigned char* rec = p.ws + WS_GP + (size_t)(cl * 64 + bh) * GP_STRIDE;
        const int cur = (cl - c_lo) & 1;
        __syncthreads();
        u32x4 nx[6];
        const bool more = cl < CPS;
        if (more) { const u32x4* src = (const u32x4*)(rec + GP_STRIDE * 64);
#pragma unroll
            for (int x = 0; x < 6; ++x) nx[x] = src[tid + 512 * x]; }
        const bf16_t* gKH = (const bf16_t*)(rec + GP_KH); const bf16_t* gOH = (const bf16_t*)(rec + GP_OH);
        u32x2 kh[8], oh[4];
#pragma unroll
        for (int mt = 0; mt < 8; ++mt) kh[mt] = *(const u32x2*)(gKH + ((size_t)(w * 8 + mt) * 64 + lane) * 4);
#pragma unroll
        for (int tt = 0; tt < 4; ++tt) oh[tt] = *(const u32x2*)(gOH + ((size_t)(w * 4 + tt) * 64 + lane) * 4);
        const float egl = *(const float*)(rec + GP_EGL);
        const int et = tid >> 3, eg = tid & 7;
        const bf16_t* gp = (const bf16_t*)(rec + GP_G) + et * 128 + 16 * eg;
        u32x4 z0 = {0u, 0u, 0u, 0u}, z1 = {0u, 0u, 0u, 0u};
        if (cl > 0) { z0 = *(const u32x4*)gp; z1 = *(const u32x4*)(gp + 8); }
        bf16x8 Bf[4];
#pragma unroll
        for (int ks = 0; ks < 4; ++ks) { u32x4 t; t.x = pk2(S[2 * ks][0], S[2 * ks][1]); t.y = pk2(S[2 * ks][2], S[2 * ks][3]); t.z = pk2(S[2 * ks + 1][0], S[2 * ks + 1][1]); t.w = pk2(S[2 * ks + 1][2], S[2 * ks + 1][3]);
            Bf[ks] = __builtin_bit_cast(bf16x8, t); }
        const bf16x8* AP = (const bf16x8*)(smem + cur * 49152); const bf16x8* QH = (const bf16x8*)(smem + cur * 49152 + GP_QH);
        f32x4 o[4], tS[8];
#pragma unroll
        for (int tt = 0; tt < 4; ++tt) { o[tt] = (f32x4){0.f, 0.f, 0.f, 0.f};
#pragma unroll
            for (int ks = 0; ks < 4; ++ks) o[tt] = MFMA16(QH[(tt * 4 + ks) * 64 + lane], Bf[ks], o[tt]); }
#pragma unroll
        for (int mt = 0; mt < 8; ++mt) { tS[mt] = (f32x4){0.f, 0.f, 0.f, 0.f};
#pragma unroll
            for (int ks = 0; ks < 4; ++ks) tS[mt] = MFMA16(AP[(mt * 4 + ks) * 64 + lane], Bf[ks], tS[mt]); }
#pragma unroll
        for (int mt = 0; mt < 8; ++mt) {
            S[mt][0] = egl * S[mt][0] + tS[mt][0] + __uint_as_float(kh[mt].x << 16); S[mt][1] = egl * S[mt][1] + tS[mt][1] + __uint_as_float(kh[mt].x & 0xffff0000u);
            S[mt][2] = egl * S[mt][2] + tS[mt][2] + __uint_as_float(kh[mt].y << 16); S[mt][3] = egl * S[mt][3] + tS[mt][3] + __uint_as_float(kh[mt].y & 0xffff0000u); }
        if (cl > 0) {
#pragma unroll
            for (int tt = 0; tt < 4; ++tt) {
                o[tt][0] += __uint_as_float(oh[tt].x << 16); o[tt][1] += __uint_as_float(oh[tt].x & 0xffff0000u); o[tt][2] += __uint_as_float(oh[tt].y << 16); o[tt][3] += __uint_as_float(oh[tt].y & 0xffff0000u);
#pragma unroll
                for (int r = 0; r < 4; ++r) obuf[(16 * tt + 4 * q4 + r) * 132 + 16 * w + l15] = o[tt][r]; }
        }
        if (more) { u32x4* dst = (u32x4*)(smem + (cur ^ 1) * 49152);
#pragma unroll
            for (int x = 0; x < 6; ++x) dst[tid + 512 * x] = nx[x]; }
        if (cl > 0) {
            __syncthreads();
            f32x4 ov[4]; float ss = 0.f;
#pragma unroll
            for (int j = 0; j < 4; ++j) { ov[j] = *(const f32x4*)(obuf + et * 132 + 16 * eg + 4 * j); ss += ov[j][0] * ov[j][0] + ov[j][1] * ov[j][1] + ov[j][2] * ov[j][2] + ov[j][3] * ov[j][3]; }
            ss += __shfl_xor(ss, 1); ss += __shfl_xor(ss, 2); ss += __shfl_xor(ss, 4);
            const float rs = __builtin_amdgcn_rsqf(ss * (1.f / 128.f) + 1e-6f);
            const unsigned zz[8] = {z0.x, z0.y, z0.z, z0.w, z1.x, z1.y, z1.z, z1.w};
            unsigned ow[8];
#pragma unroll
            for (int j = 0; j < 8; ++j) ow[j] = pk2(ov[j >> 1][(j & 1) * 2] * rs * __uint_as_float(zz[j] << 16), ov[j >> 1][(j & 1) * 2 + 1] * rs * __uint_as_float(zz[j] & 0xffff0000u));
            const size_t grow = (size_t)b * SEQ + seg * SEGTOK + (cl - 1) * 64 + et;
            bf16_t* oa = (bf16_t*)(p.ws + WS_H) + grow * D + h * 128 + 16 * eg;
            *(u32x4*)oa = (u32x4){ow[0], ow[1], ow[2], ow[3]}; *(u32x4*)(oa + 8) = (u32x4){ow[4], ow[5], ow[6], ow[7]};
        }
    }
#pragma unroll
    for (int mt = 0; mt < 8; ++mt)
#pragma unroll
        for (int r = 0; r < 4; ++r) st[(size_t)(16 * mt + 4 * q4 + r) * 128 + 16 * w + l15] = S[mt][r];
    __syncthreads();
}

constexpr int RL_AT = 0, RL_BT = 9216, RL_KT = 18432, RL_ATT = 27648, RL_RT = 36864, RL_BTLT = 46080, RL_KTLT = 55296, RL_VT = 64512, RL_LAK = 73728, RL_MRB = 82944, RL_MRK = 92160,
              RL_LM = 101376, RL_AF = 117760, RL_TM = 134144, RL_XS = 150528;
__device__ __forceinline__ void rwkv_prep_item(const Params& p, unsigned char* smem, int hb, int row_start, int npad, const bf16_t* prev_row,
                                               bf16_t* halo_out, unsigned char* rec) {
    const int tid = otid(), w = tid >> 6, lane = tid & 63, q4 = lane >> 4, l15 = lane & 15;
    bf16_t* At = (bf16_t*)(smem + RL_AT); bf16_t* Tb = At; bf16_t* Bt = (bf16_t*)(smem + RL_BT); bf16_t* WaT = Bt; bf16_t* Kt = (bf16_t*)(smem + RL_KT); bf16_t* XT = Kt;
    bf16_t* At2 = (bf16_t*)(smem + RL_ATT); bf16_t* Rt = (bf16_t*)(smem + RL_RT); bf16_t* Btl = (bf16_t*)(smem + RL_BTLT); bf16_t* Ktl = (bf16_t*)(smem + RL_KTLT);
    bf16_t* Vr = (bf16_t*)(smem + RL_VT);        bf16_t* Lak = (bf16_t*)(smem + RL_LAK); bf16_t* Mrb = (bf16_t*)(smem + RL_MRB); bf16_t* Mrk = (bf16_t*)(smem + RL_MRK);
    float* Lm = (float*)(smem + RL_LM);
    bf16_t* thw = Lak; bf16_t* adb = Mrb; float* lc = Lm; float* af = (float*)(smem + RL_AF);
    const bf16_t* P = (const bf16_t*)(p.ws + WS_P);
    const float* pk = (const float*)(p.ws + WS_PK);
    const int t = tid >> 3, g = tid & 7;
    float rr[8], kb[8], vv[8], zb[8];
    {
        const bool real = t >= npad;
        const bf16_t* curp = P; const bf16_t* prevp = P; float fprev = 0.f;
        if (real) { curp = P + (size_t)(row_start + t - npad) * NPB; if (t > npad) { prevp = curp - NPB; fprev = 1.f; } else if (prev_row) { prevp = prev_row; fprev = 1.f; } }
        const int secbase[6] = {0, 1024, 2048, 3200, 3072, 3136};
        u32x4 rc[6], rp[6];
#pragma unroll
        for (int sidx = 0; sidx < 6; ++sidx) { const int col = secbase[sidx] + (sidx < 4 ? hb * 64 : 0) + g * 8; rc[sidx] = *(const u32x4*)(curp + C_RW + col); rp[sidx] = *(const u32x4*)(prevp + C_RW + col); }
        float m[6][8];
#pragma unroll
        for (int sidx = 0; sidx < 6; ++sidx) {
            const int col = secbase[sidx] + (sidx < 4 ? hb * 64 : 0) + g * 8;
            float cur[8], prv[8];
            unpack8(rc[sidx], cur); unpack8(rp[sidx], prv);
            const f32x4 mu0 = *(const f32x4*)(pk + PK_MU + col), mu1 = *(const f32x4*)(pk + PK_MU + col + 4);
            const float mu[8] = {mu0[0], mu0[1], mu0[2], mu0[3], mu1[0], mu1[1], mu1[2], mu1[3]};
#pragma unroll
            for (int e = 0; e < 8; ++e) m[sidx][e] = real ? cur[e] + mu[e] * (fprev * prv[e] - cur[e]) : 0.f;
            if (halo_out && t == 63 && (sidx < 4 || hb == 0)) *(u32x4*)(halo_out + C_RW + col) = rc[sidx];
        }
#pragma unroll
        for (int e = 0; e < 8; ++e) { rr[e] = m[0][e]; kb[e] = m[1][e]; vv[e] = m[2][e]; zb[e] = m[3][e]; }
        float th[8];
#pragma unroll
        for (int e = 0; e < 8; ++e) th[e] = tanh_(m[4][e]);
        *(u32x4*)(thw + t * TSTR + g * 8) = pack8(th);
        *(u32x4*)(adb + t * TSTR + g * 8) = pack8(m[5]);
    }
    __syncthreads();
    {
        const int which = w >> 2, ct = w & 3;
        const bf16_t* Wt = (const bf16_t*)(p.ws + (which ? WS_A2T : WS_W2T)) + (size_t)hb * 4096;
        const bf16x8 b0 = *(const bf16x8*)(Wt + (16 * ct + l15) * 64 + 8 * q4), b1 = *(const bf16x8*)(Wt + (16 * ct + l15) * 64 + 32 + 8 * q4);
        const bf16_t* Aarr = which ? adb : thw;
        const int c = 16 * ct + l15;
        const float bias = pk[(which ? PK_A0 : PK_W0) + hb * 64 + c];
        float carry = 0.f;
#pragma unroll
        for (int tt = 0; tt < 4; ++tt) {
            f32x4 acc = {0.f, 0.f, 0.f, 0.f};
            acc = MFMA16(ldfrag(Aarr, TSTR, 16 * tt, 0, lane), b0, acc); acc = MFMA16(ldfrag(Aarr, TSTR, 16 * tt, 32, lane), b1, acc);
            if (which) {
#pragma unroll
                for (int r = 0; r < 4; ++r) af[(16 * tt + 4 * q4 + r) * 64 + c] = sigm(bias + acc[r]);
            } else {
                float wl[4];
#pragma unroll
                for (int r = 0; r < 4; ++r) { const int tk = 16 * tt + 4 * q4 + r; wl[r] = (tk < npad) ? 0.f : -0.6065306597126334f * sigm(bias + acc[r]); }
                wl[1] += wl[0]; wl[2] += wl[1]; wl[3] += wl[2];
                const float Q = wl[3];
                const float Q0 = __shfl(Q, l15), Q1 = __shfl(Q, l15 + 16), Q2 = __shfl(Q, l15 + 32), Q3 = __shfl(Q, l15 + 48);
                const float ex = carry + (q4 > 0 ? Q0 : 0.f) + (q4 > 1 ? Q1 : 0.f) + (q4 > 2 ? Q2 : 0.f);
#pragma unroll
                for (int r = 0; r < 4; ++r) lc[(16 * tt + 4 * q4 + r) * 64 + c] = ex + wl[r];
                carry += Q0 + Q1 + Q2 + Q3;
            }
        }
    }
    __syncthreads();
    {
        float lct[8], lcp[8], lcC[8], av[8];
        { const f32x4 a = *(const f32x4*)(lc + t * 64 + g * 8), b2 = *(const f32x4*)(lc + t * 64 + g * 8 + 4); lct[0] = a[0]; lct[1] = a[1]; lct[2] = a[2]; lct[3] = a[3]; lct[4] = b2[0]; lct[5] = b2[1]; lct[6] = b2[2]; lct[7] = b2[3]; }
        if (t > 0) { const f32x4 a = *(const f32x4*)(lc + (t - 1) * 64 + g * 8), b2 = *(const f32x4*)(lc + (t - 1) * 64 + g * 8 + 4); lcp[0] = a[0]; lcp[1] = a[1]; lcp[2] = a[2]; lcp[3] = a[3]; lcp[4] = b2[0]; lcp[5] = b2[1]; lcp[6] = b2[2]; lcp[7] = b2[3]; }
        else {
#pragma unroll
            for (int e = 0; e < 8; ++e) lcp[e] = 0.f; }
        { const f32x4 a = *(const f32x4*)(lc + 63 * 64 + g * 8), b2 = *(const f32x4*)(lc + 63 * 64 + g * 8 + 4); lcC[0] = a[0]; lcC[1] = a[1]; lcC[2] = a[2]; lcC[3] = a[3]; lcC[4] = b2[0]; lcC[5] = b2[1]; lcC[6] = b2[2]; lcC[7] = b2[3]; }
        { const f32x4 a = *(const f32x4*)(af + t * 64 + g * 8), b2 = *(const f32x4*)(af + t * 64 + g * 8 + 4); av[0] = a[0]; av[1] = a[1]; av[2] = a[2]; av[3] = a[3]; av[4] = b2[0]; av[5] = b2[1]; av[6] = b2[2]; av[7] = b2[3]; }
        const int hc = hb * 64 + g * 8;
        float kk[8], km[8], ss = 0.f, rk = 0.f;
#pragma unroll
        for (int e = 0; e < 8; ++e) { kk[e] = kb[e] * pk[PK_KK + hc + e]; ss += kk[e] * kk[e]; km[e] = kb[e] * (1.f + (av[e] - 1.f) * pk[PK_KA + hc + e]); rk += rr[e] * km[e] * pk[PK_RK + hc + e]; }
        ss += __shfl_xor(ss, 1); ss += __shfl_xor(ss, 2); ss += __shfl_xor(ss, 4);
        rk += __shfl_xor(rk, 1); rk += __shfl_xor(rk, 2); rk += __shfl_xor(rk, 4);
        const float kn = __builtin_amdgcn_rsqf(ss + 1e-6f);
        float xa[8], xb[8], xk[8], xr[8], xbt[8], xkt[8];
#pragma unroll
        for (int e = 0; e < 8; ++e) { kk[e] *= kn; const float ka = kk[e] * av[e]; const float ip = __expf(-lct[e]), tl = __expf(lcC[e] - lct[e]);
            xa[e] = kk[e] * __expf(lcp[e]); xb[e] = ka * ip; xk[e] = km[e] * ip; xr[e] = rr[e] * __expf(lct[e]); xbt[e] = ka * tl; xkt[e] = km[e] * tl; }
        *(u32x4*)(At + t * TSTR + g * 8) = pack8(xa); *(u32x4*)(Bt + t * TSTR + g * 8) = pack8(xb); *(u32x4*)(Kt + t * TSTR + g * 8) = pack8(xk); *(u32x4*)(Rt + t * TSTR + g * 8) = pack8(xr);
        *(u32x4*)(At2 + t * TSTR + g * 8) = pack8(xa); *(u32x4*)(Btl + t * TSTR + g * 8) = pack8(xbt); *(u32x4*)(Ktl + t * TSTR + g * 8) = pack8(xkt); *(u32x4*)(Vr + t * TSTR + g * 8) = pack8(vv);
        float c1[8], c0[8];
#pragma unroll
        for (int e = 0; e < 8; ++e) { const float sz = silu_(zb[e]); c1[e] = pk[PK_GNW + hc + e] * sz; c0[e] = (pk[PK_GNB + hc + e] + rk * vv[e]) * sz; }
        *(u32x4*)((bf16_t*)(rec + RP_C1) + t * 64 + g * 8) = pack8(c1); *(u32x4*)((bf16_t*)(rec + RP_C0) + t * 64 + g * 8) = pack8(c0);
        if (t == 63) { float* pc = (float*)(rec + RP_PC) + g * 8; *(f32x4*)pc = (f32x4){__expf(lcC[0]), __expf(lcC[1]), __expf(lcC[2]), __expf(lcC[3])}; *(f32x4*)(pc + 4) = (f32x4){__expf(lcC[4]), __expf(lcC[5]), __expf(lcC[6]), __expf(lcC[7])}; }
    }
    __syncthreads();
    {
        const int pr = w >> 1;
        const bf16_t* Aarr = pr < 2 ? At : Rt; const bf16_t* Barr = (pr & 1) ? Kt : Bt;
#pragma unroll
        for (int x = 0; x < 2; ++x) { const int tt = 2 * (w & 1) + x;
            const bf16x8 a0 = ldfrag(Aarr, TSTR, 16 * tt, 0, lane), a1 = ldfrag(Aarr, TSTR, 16 * tt, 32, lane);
            const int tk = 16 * tt + l15;
#pragma unroll
            for (int it = 0; it < 4; ++it) { f32x4 acc = {0.f, 0.f, 0.f, 0.f};
                acc = MFMA16(ldfrag(Barr, TSTR, 16 * it, 0, lane), a0, acc); acc = MFMA16(ldfrag(Barr, TSTR, 16 * it, 32, lane), a1, acc);
                const int i0 = 16 * it + 4 * q4;
                f32x4 o;
#pragma unroll
                for (int r = 0; r < 4; ++r) { const int i = i0 + r; const bool keep = pr < 2 ? (tk > i) : (tk >= i); o[r] = keep ? acc[r] : 0.f; }
                if (pr == 0) *(f32x4*)(Lm + tk * 64 + i0) = o;
                else { bf16_t* Out = pr == 1 ? Lak : (pr == 2 ? Mrb : Mrk); *(u32x2*)(Out + tk * TSTR + i0) = (u32x2){pk2(o[0], o[1]), pk2(o[2], o[3])}; } }
        }
    }
    __syncthreads();
    {
        float* Tm = (float*)(smem + RL_TM);
        inv_block(Lm, Tm, (float*)(smem + RL_XS), tid);
        const int i = tid >> 3, j0 = (tid & 7) * 8;
        float a[8];
#pragma unroll
        for (int e = 0; e < 8; ++e) a[e] = Tm[i * 64 + j0 + e];
        *(u32x4*)(Tb + i * TSTR + j0) = pack8(a);
    }
    __syncthreads();
    {
        const int tt = w & 3, which = w >> 2;
        const bf16_t* Aarr = which ? Lak : Tb; const bf16_t* Barr = which ? Vr : At2; bf16_t* Out = which ? XT : WaT;
        const bf16x8 a0 = ldfrag(Aarr, TSTR, 16 * tt, 0, lane), a1 = ldfrag(Aarr, TSTR, 16 * tt, 32, lane);
#pragma unroll
        for (int ct = 0; ct < 4; ++ct) { f32x4 acc = {0.f, 0.f, 0.f, 0.f};
            acc = MFMA16(a0, ldfrag_tr(Barr, TSTR, 16 * ct, 0, lane), acc); acc = MFMA16(a1, ldfrag_tr(Barr, TSTR, 16 * ct, 32, lane), acc);
            *(u32x2*)(Out + (16 * ct + l15) * TSTR + 16 * tt + 4 * q4) = (u32x2){pk2(acc[0], acc[1]), pk2(acc[2], acc[3])}; }
    }
    __syncthreads();
    {
        f32x4 acc[4];
        if (w < 4) {
            const bf16x8 a0 = ldfrag(Tb, TSTR, 16 * w, 0, lane), a1 = ldfrag(Tb, TSTR, 16 * w, 32, lane);
#pragma unroll
            for (int ct = 0; ct < 4; ++ct) { acc[ct] = (f32x4){0.f, 0.f, 0.f, 0.f};
                acc[ct] = MFMA16(a0, ldfrag(XT, TSTR, 16 * ct, 0, lane), acc[ct]); acc[ct] = MFMA16(a1, ldfrag(XT, TSTR, 16 * ct, 32, lane), acc[ct]); }
        }
        __syncthreads();
        if (w < 4) {
#pragma unroll
            for (int ct = 0; ct < 4; ++ct) *(u32x2*)(XT + (16 * ct + l15) * TSTR + 16 * w + 4 * q4) = (u32x2){pk2(-acc[ct][0], -acc[ct][1]), pk2(-acc[ct][2], -acc[ct][3])};
        }
    }
    __syncthreads();
    {
        const bf16_t* UvT = XT;
        bf16_t* gAP = (bf16_t*)(rec + RP_AP); bf16_t* gRH = (bf16_t*)(rec + RP_RH); bf16_t* gKH = (bf16_t*)(rec + RP_KH); bf16_t* gYH = (bf16_t*)(rec + RP_YH);
        const int et = w & 3, part = w >> 2;
        {
            const bf16x8 a0 = ldfrag(WaT, TSTR, 16 * et, 0, lane), a1 = ldfrag(WaT, TSTR, 16 * et, 32, lane);
            if (part == 0) {
#pragma unroll
                for (int kt = 0; kt < 4; ++kt) { f32x4 acc = {0.f, 0.f, 0.f, 0.f};
                    acc = MFMA16(a0, ldfrag_tr(Btl, TSTR, 16 * kt, 0, lane), acc); acc = MFMA16(a1, ldfrag_tr(Btl, TSTR, 16 * kt, 32, lane), acc);
                    *(u32x2*)(gAP + ((size_t)(kt * 2 + (et >> 1)) * 64 + lane) * 8 + (et & 1) * 4) = (u32x2){pk2(-acc[0], -acc[1]), pk2(-acc[2], -acc[3])}; }
            } else {
#pragma unroll
                for (int tt = 0; tt < 4; ++tt) { f32x4 acc = {0.f, 0.f, 0.f, 0.f};
                    acc = MFMA16(a0, ldfrag(Mrb, TSTR, 16 * tt, 0, lane), acc); acc = MFMA16(a1, ldfrag(Mrb, TSTR, 16 * tt, 32, lane), acc);
                    const int tk = 16 * tt + l15, e0 = 16 * et + 4 * q4;
                    const u32x2 q2 = *(const u32x2*)(Rt + tk * TSTR + e0);
                    const float o0 = __uint_as_float(q2.x << 16) - acc[0], o1 = __uint_as_float(q2.x & 0xffff0000u) - acc[1], o2 = __uint_as_float(q2.y << 16) - acc[2], o3 = __uint_as_float(q2.y & 0xffff0000u) - acc[3];
                    *(u32x2*)(gRH + ((size_t)(tt * 2 + (et >> 1)) * 64 + lane) * 8 + (et & 1) * 4) = (u32x2){pk2(o0, o1), pk2(o2, o3)}; }
            }
        }
        {
            const int rt = w & 3;
            bf16_t* Out = part ? gKH : gYH;
            bf16x8 a0, a1, a2, a3;
            if (part) { a0 = ldfrag_tr(Btl, TSTR, 16 * rt, 0, lane); a1 = ldfrag_tr(Btl, TSTR, 16 * rt, 32, lane); a2 = ldfrag_tr(Ktl, TSTR, 16 * rt, 0, lane); a3 = ldfrag_tr(Ktl, TSTR, 16 * rt, 32, lane); }
            else { a0 = ldfrag(Mrb, TSTR, 16 * rt, 0, lane); a1 = ldfrag(Mrb, TSTR, 16 * rt, 32, lane); a2 = ldfrag(Mrk, TSTR, 16 * rt, 0, lane); a3 = ldfrag(Mrk, TSTR, 16 * rt, 32, lane); }
#pragma unroll
            for (int vt = 0; vt < 4; ++vt) { f32x4 acc = {0.f, 0.f, 0.f, 0.f};
                acc = MFMA16(a0, ldfrag(UvT, TSTR, 16 * vt, 0, lane), acc); acc = MFMA16(a1, ldfrag(UvT, TSTR, 16 * vt, 32, lane), acc);
                acc = MFMA16(a2, ldfrag_tr(Vr, TSTR, 16 * vt, 0, lane), acc); acc = MFMA16(a3, ldfrag_tr(Vr, TSTR, 16 * vt, 32, lane), acc);
                *(u32x2*)(Out + ((size_t)(vt * 4 + rt) * 64 + lane) * 4) = (u32x2){pk2(acc[0], acc[1]), pk2(acc[2], acc[3])}; }
        }
    }
    __syncthreads();
}

__device__ __forceinline__ void phase_rprep(const Params& p, int seg, unsigned char* smem) {
    const int blk = obid();
    const int n_items = (CPS + (seg == 0 ? 1 : 0)) * 128;
#pragma unroll 1
    for (int it = (blk + (gridDim.x >> 1)) % gridDim.x; it < n_items; it += gridDim.x) {
        const int bh = it & 127, b = bh >> 4, hb = bh & 15; int cl = it >> 7; if (seg != 0) cl += 1;
        unsigned char* rec = p.ws + WS_RP + (size_t)(cl * 128 + bh) * RP_STRIDE;
        const bf16_t* Pb = (const bf16_t*)(p.ws + WS_P);
        bf16_t* phalo2 = (bf16_t*)(p.ws + WS_PHALO);
        if (cl == 0) rwkv_prep_item(p, smem, hb, LEX0, 48, nullptr, nullptr, rec);
        else {
            const int row = b * SEGTOK + (cl - 1) * 64;
            const bf16_t* prow = Pb + (size_t)(row - 1) * NPB;
            if (cl == 1) prow = (seg == 0) ? Pb + (size_t)(LEX0 + NMETA - 1) * NPB : phalo2 + (size_t)(((seg - 1) & 1) * NBATCH + b) * NPB;
            bf16_t* ho = (cl == CPS) ? phalo2 + (size_t)((seg & 1) * NBATCH + b) * NPB : nullptr;
            rwkv_prep_item(p, smem, hb, row, 0, prow, ho, rec);
        }
    }
}

__device__ __forceinline__ void rwkv_scan_block(const Params& p, int seg, unsigned char* smem, int pairidx) {
    const int tid = otid(), w = tid >> 6, lane = tid & 63, q4 = lane >> 4, l15 = lane & 15;
    const int hsel = w >> 2, vt = w & 3;
    const int bh = pairidx * 2 + hsel, b = bh >> 4, hb = bh & 15;
    float* st = p.out + O_RWKV_P + (size_t)bh * 4096;
    f32x4 S[4];
    if (seg) {
#pragma unroll
        for (int mt = 0; mt < 4; ++mt) S[mt] = *(const f32x4*)(st + (size_t)(16 * vt + l15) * 64 + 16 * mt + 4 * q4);
    } else {
#pragma unroll
        for (int mt = 0; mt < 4; ++mt) S[mt] = (f32x4){0.f, 0.f, 0.f, 0.f};
    }
    const int c_lo = seg ? 1 : 0;
    float* ybuf = (float*)(smem + 65536) + hsel * (64 * 68);
    const int tl = tid & 255;
    {
        const u32x4* src = (const u32x4*)(p.ws + WS_RP + (size_t)(c_lo * 128 + bh) * RP_STRIDE); u32x4* dst = (u32x4*)(smem + hsel * 16384);
#pragma unroll
        for (int x = 0; x < 4; ++x) dst[tl + 256 * x] = src[tl + 256 * x];
    }
#pragma unroll 1
    for (int cl = c_lo; cl <= CPS; ++cl) {
        const unsigned char* rec = p.ws + WS_RP + (size_t)(cl * 128 + bh) * RP_STRIDE;
        const int cur = (cl - c_lo) & 1;
        __syncthreads();
        u32x4 nx[4];
        const bool more = cl < CPS;
        if (more) { const u32x4* src = (const u32x4*)(rec + (size_t)RP_STRIDE * 128);
#pragma unroll
            for (int x = 0; x < 4; ++x) nx[x] = src[tl + 256 * x]; }
        const bf16_t* gKH = (const bf16_t*)(rec + RP_KH); const bf16_t* gYH = (const bf16_t*)(rec + RP_YH);
        u32x2 kh[4], yh[4]; f32x4 pc[4];
#pragma unroll
        for (int mt = 0; mt < 4; ++mt) { kh[mt] = *(const u32x2*)(gKH + ((size_t)(vt * 4 + mt) * 64 + lane) * 4); yh[mt] = *(const u32x2*)(gYH + ((size_t)(vt * 4 + mt) * 64 + lane) * 4);
            pc[mt] = *(const f32x4*)((const float*)(rec + RP_PC) + 16 * mt + 4 * q4); }
        const int tk = tl >> 2, g = tl & 3;
        u32x4 a0 = {0u, 0u, 0u, 0u}, a1 = a0, b0 = a0, b1 = a0;
        if (cl > 0) { const bf16_t* c1p = (const bf16_t*)(rec + RP_C1) + tk * 64 + 16 * g; const bf16_t* c0p = (const bf16_t*)(rec + RP_C0) + tk * 64 + 16 * g;
            a0 = *(const u32x4*)c0p; a1 = *(const u32x4*)(c0p + 8); b0 = *(const u32x4*)c1p; b1 = *(const u32x4*)(c1p + 8); }
        bf16x8 Bf[2];
#pragma unroll
        for (int ks = 0; ks < 2; ++ks) { u32x4 tq; tq.x = pk2(S[2 * ks][0], S[2 * ks][1]); tq.y = pk2(S[2 * ks][2], S[2 * ks][3]); tq.z = pk2(S[2 * ks + 1][0], S[2 * ks + 1][1]); tq.w = pk2(S[2 * ks + 1][2], S[2 * ks + 1][3]);
            Bf[ks] = __builtin_bit_cast(bf16x8, tq); }
        const bf16x8* AP = (const bf16x8*)(smem + cur * 32768 + hsel * 16384); const bf16x8* RH = (const bf16x8*)(smem + cur * 32768 + hsel * 16384 + RP_RH);
        f32x4 y[4], tS[4];
#pragma unroll
        for (int tt = 0; tt < 4; ++tt) { y[tt] = (f32x4){0.f, 0.f, 0.f, 0.f}; y[tt] = MFMA16(RH[(tt * 2 + 0) * 64 + lane], Bf[0], y[tt]); y[tt] = MFMA16(RH[(tt * 2 + 1) * 64 + lane], Bf[1], y[tt]); }
#pragma unroll
        for (int mt = 0; mt < 4; ++mt) { tS[mt] = (f32x4){0.f, 0.f, 0.f, 0.f}; tS[mt] = MFMA16(AP[(mt * 2 + 0) * 64 + lane], Bf[0], tS[mt]); tS[mt] = MFMA16(AP[(mt * 2 + 1) * 64 + lane], Bf[1], tS[mt]); }
#pragma unroll
        for (int mt = 0; mt < 4; ++mt) {
            S[mt][0] = pc[mt][0] * S[mt][0] + tS[mt][0] + __uint_as_float(kh[mt].x << 16); S[mt][1] = pc[mt][1] * S[mt][1] + tS[mt][1] + __uint_as_float(kh[mt].x & 0xffff0000u);
            S[mt][2] = pc[mt][2] * S[mt][2] + tS[mt][2] + __uint_as_float(kh[mt].y << 16); S[mt][3] = pc[mt][3] * S[mt][3] + tS[mt][3] + __uint_as_float(kh[mt].y & 0xffff0000u); }
        if (cl > 0) {
#pragma unroll
            for (int tt = 0; tt < 4; ++tt) {
                y[tt][0] += __uint_as_float(yh[tt].x << 16); y[tt][1] += __uint_as_float(yh[tt].x & 0xffff0000u); y[tt][2] += __uint_as_float(yh[tt].y << 16); y[tt][3] += __uint_as_float(yh[tt].y & 0xffff0000u);
#pragma unroll
                for (int r = 0; r < 4; ++r) ybuf[(16 * tt + 4 * q4 + r) * 68 + 16 * vt + l15] = y[tt][r]; }
        }
        if (more) { u32x4* dst = (u32x4*)(smem + (cur ^ 1) * 32768 + hsel * 16384);
#pragma unroll
            for (int x = 0; x < 4; ++x) dst[tl + 256 * x] = nx[x]; }
        if (cl > 0) {
            __syncthreads();
            f32x4 yv[4]; float sm = 0.f;
#pragma unroll
            for (int j = 0; j < 4; ++j) { yv[j] = *(const f32x4*)(ybuf + tk * 68 + 16 * g + 4 * j); sm += yv[j][0] + yv[j][1] + yv[j][2] + yv[j][3]; }
            sm += __shfl_xor(sm, 1); sm += __shfl_xor(sm, 2);
            const float mu = sm * (1.f / 64.f); float vs = 0.f;
#pragma unroll
            for (int j = 0; j < 4; ++j) { yv[j] = yv[j] - mu; vs += yv[j][0] * yv[j][0] + yv[j][1] * yv[j][1] + yv[j][2] * yv[j][2] + yv[j][3] * yv[j][3]; }
            vs += __shfl_xor(vs, 1); vs += __shfl_xor(vs, 2);
            const float rs = __builtin_amdgcn_rsqf(vs * (1.f / 64.f) + 64e-5f);
            const unsigned c0w[8] = {a0.x, a0.y, a0.z, a0.w, a1.x, a1.y, a1.z, a1.w}, c1w[8] = {b0.x, b0.y, b0.z, b0.w, b1.x, b1.y, b1.z, b1.w};
            unsigned ow[8];
#pragma unroll
            for (int j = 0; j < 8; ++j) ow[j] = pk2(yv[j >> 1][(j & 1) * 2] * rs * __uint_as_float(c1w[j] << 16) + __uint_as_float(c0w[j] << 16),
                                                     yv[j >> 1][(j & 1) * 2 + 1] * rs * __uint_as_float(c1w[j] & 0xffff0000u) + __uint_as_float(c0w[j] & 0xffff0000u));
            const size_t grow = (size_t)b * SEQ + seg * SEGTOK + (cl - 1) * 64 + tk;
            bf16_t* ob = (bf16_t*)(p.ws + WS_OB) + grow * D + hb * 64 + 16 * g;
            *(u32x4*)ob = (u32x4){ow[0], ow[1], ow[2], ow[3]}; *(u32x4*)(ob + 8) = (u32x4){ow[4], ow[5], ow[6], ow[7]};
        }
    }
#pragma unroll
    for (int mt = 0; mt < 4; ++mt) *(f32x4*)(st + (size_t)(16 * vt + l15) * 64 + 16 * mt + 4 * q4) = S[mt];
    __syncthreads();
}

__device__ __forceinline__ void gdn_sample_item(const Params& p, unsigned char* smem, int bs, int h) {
    const int tid = otid(), w = tid >> 6, lane = tid & 63, kq = tid >> 7, v = tid & 127;
    float* qk_s = (float*)smem; float* v_s = qk_s + 1024; float* gb_s = v_s + 512; float* part = gb_s + 16; float* part2 = part + 512;
    const bf16_t* P = (const bf16_t*)(p.ws + WS_P);
    const float* pk = (const float*)(p.ws + WS_PK);
    const float* s_in = p.in[2] + (size_t)(bs * 8 + h) * 16384; float* s_out = p.out + O_GDN_S + (size_t)(bs * 8 + h) * 16384;
    const int row0 = LEX0 + EX_SAMP + bs * DECT;
    float s[32];
#pragma unroll
    for (int j = 0; j < 32; ++j) s[j] = s_in[(size_t)(kq * 32 + j) * 128 + v];
    if (tid < 384) {
        const int pcol = (tid >> 7) * 1024 + h * 128 + (tid & 127);
        const float* cw = pk + PK_CONVW; const float* hin = p.in[3] + (size_t)bs * 9216; float* hout = p.out + O_CONV_S + (size_t)bs * 9216;
        const float cw0 = cw[pcol], cw1 = cw[3072 + pcol], cw2 = cw[6144 + pcol], cw3 = cw[9216 + pcol];
        float x3 = hin[pcol], x2 = hin[3072 + pcol], x1 = hin[6144 + pcol];
        float xr[4];
#pragma unroll
        for (int i = 0; i < 4; ++i) xr[i] = bf2f(P[(size_t)(row0 + i) * NPB + pcol]);
#pragma unroll
        for (int i = 0; i < 4; ++i) { const float y = cw0 * x3 + cw1 * x2 + cw2 * x1 + cw3 * xr[i]; x3 = x2; x2 = x1; x1 = xr[i];
            if (tid < 256) qk_s[i * 256 + tid] = silu_(y); else v_s[i * 128 + (tid - 256)] = silu_(y); }
        hout[pcol] = x3; hout[3072 + pcol] = x2; hout[6144 + pcol] = x1;
    } else if (tid < 388) {
        const int i = tid - 384; const size_t r = (size_t)(row0 + i) * NPB;
        const float pa = bf2f(P[r + C_A + h]), pb = bf2f(P[r + C_B + h]);
        gb_s[2 * i] = __expf(-expf(pk[PK_ALOG + h]) * softplus_(pa + pk[PK_DTB + h])); gb_s[2 * i + 1] = sigm(pb);
    }
    __syncthreads();
    { const int i = w >> 1, which = w & 1; float* rp = qk_s + i * 256 + which * 128; const float a = rp[lane], b = rp[lane + 64];
      const float sc = __builtin_amdgcn_rsqf(wave_sum(a * a + b * b) + 1e-6f) * (which == 0 ? 0.08838834764831845f : 1.f); rp[lane] = a * sc; rp[lane + 64] = b * sc; }
    __syncthreads();
#pragma unroll 1
    for (int i = 0; i < 4; ++i) {
        const float* kp = qk_s + i * 256 + 128 + kq * 32; const float* qp = qk_s + i * 256 + kq * 32;
        float pa = 0.f;
#pragma unroll
        for (int j4 = 0; j4 < 8; ++j4) { const f32x4 k4 = *(const f32x4*)(kp + 4 * j4); pa += k4[0] * s[4 * j4] + k4[1] * s[4 * j4 + 1] + k4[2] * s[4 * j4 + 2] + k4[3] * s[4 * j4 + 3]; }
        part[kq * 128 + v] = pa;
        __syncthreads();
        const float kS = part[v] + part[128 + v] + part[256 + v] + part[384 + v];
        const float a = gb_s[2 * i], c = gb_s[2 * i + 1] * (v_s[i * 128 + v] - a * kS);
        float po = 0.f;
#pragma unroll
        for (int j4 = 0; j4 < 8; ++j4) { const f32x4 k4 = *(const f32x4*)(kp + 4 * j4), q4v = *(const f32x4*)(qp + 4 * j4);
#pragma unroll
            for (int e = 0; e < 4; ++e) { s[4 * j4 + e] = a * s[4 * j4 + e] + k4[e] * c; po += q4v[e] * s[4 * j4 + e]; } }
        part2[kq * 128 + v] = po;
        __syncthreads();
        if (kq == 0) ((float*)(p.ws + WS_ORAW))[(size_t)(row0 + i) * D + h * 128 + v] = part2[v] + part2[128 + v] + part2[256 + v] + part2[384 + v];
    }
#pragma unroll
    for (int j = 0; j < 32; ++j) s_out[(size_t)(kq * 32 + j) * 128 + v] = s[j];
    __syncthreads();
}

constexpr int SR_R = 0, SR_KK = 4096, SR_V = 8192, SR_ZB = 12288, SR_DEC = 16384, SR_KA = 20480, SR_KM = 24576, SR_WD = 28672, SR_AD = 28928, SR_RK = 29184;
__device__ __forceinline__ void rwkv_sample_item(const Params& p, unsigned char* smem, int bs) {
    const int tid = otid(), w = tid >> 6, lane = tid & 63;
    float* f = (float*)smem;
    const bf16_t* P = (const bf16_t*)(p.ws + WS_P);
    const float* pk = (const float*)(p.ws + WS_PK);
    const int row0 = LEX0 + EX_SAMP + bs * DECT;
    const bf16_t* prow = P + (size_t)(LEX0 + EX_SHIFT + bs) * NPB + C_RW;
#pragma unroll 1
    for (int col = tid; col < RW_SHIFT; col += 512) {
        const float mu = pk[PK_MU + col]; float prev = bf2f(prow[col]);
        float cur[4];
#pragma unroll
        for (int i = 0; i < 4; ++i) cur[i] = bf2f(P[(size_t)(row0 + i) * NPB + C_RW + col]);
        float* dst; int stride = 1024; bool th = false;
        if (col < 1024) dst = f + SR_R + col; else if (col < 2048) dst = f + SR_KK + (col - 1024); else if (col < 3072) dst = f + SR_V + (col - 2048);
        else if (col < 3136) { dst = f + SR_WD + (col - 3072); stride = 64; th = true; } else if (col < 3200) { dst = f + SR_AD + (col - 3136); stride = 64; } else dst = f + SR_ZB + (col - 3200);
#pragma unroll
        for (int i = 0; i < 4; ++i) { float m = cur[i] + mu * (prev - cur[i]); prev = cur[i]; if (th) m = tanh_(m); dst[i * stride] = m; }
    }
    __syncthreads();
#pragma unroll 1
    for (int cc = 0; cc < 2; ++cc) {
        const int c = tid + 512 * cc;
        float aw[4] = {0.f, 0.f, 0.f, 0.f}, aa[4] = {0.f, 0.f, 0.f, 0.f};
#pragma unroll 8
        for (int l = 0; l < 64; ++l) { const float w2v = pk[PK_W2 + l * D + c], a2v = pk[PK_A2 + l * D + c];
#pragma unroll
            for (int i = 0; i < 4; ++i) { aw[i] += f[SR_WD + i * 64 + l] * w2v; aa[i] += f[SR_AD + i * 64 + l] * a2v; } }
        const float w0c = pk[PK_W0 + c], a0c = pk[PK_A0 + c], kkc = pk[PK_KK + c], kac = pk[PK_KA + c];
#pragma unroll
        for (int i = 0; i < 4; ++i) { const float a = sigm(a0c + aa[i]); const float kbv = f[SR_KK + i * 1024 + c];
            f[SR_DEC + i * 1024 + c] = __expf(-0.6065306597126334f * sigm(w0c + aw[i])); f[SR_KA + i * 1024 + c] = a; f[SR_KK + i * 1024 + c] = kbv * kkc; f[SR_KM + i * 1024 + c] = kbv * (1.f + (a - 1.f) * kac); }
    }
    __syncthreads();
#pragma unroll 1
    for (int x = 0; x < 8; ++x) { const int pr = w * 8 + x, i = pr >> 4, hh = pr & 15; const int o = i * 1024 + hh * 64 + lane;
        const float kr = f[SR_KK + o]; const float kk = kr * __builtin_amdgcn_rsqf(wave_sum(kr * kr) + 1e-6f); f[SR_KK + o] = kk; f[SR_KA + o] = kk * f[SR_KA + o];
        const float rkv = wave_sum(f[SR_R + o] * f[SR_KM + o] * pk[PK_RK + hh * 64 + lane]); if (lane == 0) f[SR_RK + pr] = rkv; }
    __syncthreads();
#pragma unroll 1
    for (int hp = 0; hp < 2; ++hp) {
        const int hb = hp * 8 + w;
        const float* s_in = p.in[4] + (size_t)(bs * 16 + hb) * 4096 + (size_t)lane * 64; float* s_out = p.out + O_RWKV_S + (size_t)(bs * 16 + hb) * 4096 + (size_t)lane * 64;
        f32x4 S[16];
#pragma unroll
        for (int j = 0; j < 16; ++j) S[j] = *(const f32x4*)(s_in + 4 * j);
        const int cch = hb * 64 + lane;
        const float gnw = pk[PK_GNW + cch], gnb = pk[PK_GNB + cch];
#pragma unroll 1
        for (int i = 0; i < 4; ++i) {
            const int o = i * 1024 + hb * 64;
            const float vv = f[SR_V + o + lane], rk = f[SR_RK + i * 16 + hb];
            float sa = 0.f;
#pragma unroll
            for (int j = 0; j < 16; ++j) { const f32x4 kk4 = *(const f32x4*)(f + SR_KK + o + 4 * j); sa += S[j][0] * kk4[0] + S[j][1] * kk4[1] + S[j][2] * kk4[2] + S[j][3] * kk4[3]; }
            float y = 0.f;
#pragma unroll
            for (int j = 0; j < 16; ++j) { const f32x4 de4 = *(const f32x4*)(f + SR_DEC + o + 4 * j), ka4 = *(const f32x4*)(f + SR_KA + o + 4 * j), km4 = *(const f32x4*)(f + SR_KM + o + 4 * j), r4 = *(const f32x4*)(f + SR_R + o + 4 * j);
#pragma unroll
                for (int e = 0; e < 4; ++e) { S[j][e] = S[j][e] * de4[e] + (vv * km4[e] - sa * ka4[e]); y += S[j][e] * r4[e]; } }
            const float mu = wave_sum(y) * (1.f / 64.f); const float dy = y - mu;
            const float rs = __builtin_amdgcn_rsqf(wave_sum(dy * dy) * (1.f / 64.f) + 64e-5f);
            const float ov = (dy * rs * gnw + gnb + rk * vv) * silu_(f[SR_ZB + i * 1024 + cch]);
            ((bf16_t*)(p.ws + WS_OB))[(size_t)(XROWS + EX_SAMP + bs * DECT + i) * D + cch] = (bf16_t)f2bf(ov);
        }
#pragma unroll
        for (int j = 0; j < 16; ++j) *(f32x4*)(s_out + 4 * j) = S[j];
    }
    __syncthreads();
}

__device__ __forceinline__ void phase2(const Params& p, int seg, unsigned char* smem) {
    const int blk = obid();
    float* out = p.out;
    float* chalo = (float*)(p.ws + WS_CHALO); float* phalo = (float*)(p.ws + WS_PHALO);
#ifndef SUB
#define SUB 0
#endif
#define SEN(x) (SUB == 0 || SUB == (x))
    if (SEN(1) && blk < 64) gdn_scan_block(p, seg, smem, blk);
    if (SEN(3) && blk >= 64 && blk < 128) rwkv_scan_block(p, seg, smem, blk - 64);
#ifndef DUP
#define DUP 0
#endif
    if (seg == 0) {
#pragma unroll 1
        for (int it = blk; it < DECB * 8; it += gridDim.x) gdn_sample_item(p, smem, it >> 3, it & 7);
#pragma unroll 1
        for (int it = blk; it < DECB; it += gridDim.x) rwkv_sample_item(p, smem, it);
    }
}

__device__ __forceinline__ void phase25(const Params& p, int seg) {
    const int tid0 = otid(); const int lane = tid0 & 63; const int gw = obid() * 8 + (tid0 >> 6), NGW = gridDim.x * 8;
    const bf16_t* P = (const bf16_t*)(p.ws + WS_P);
    const float* ORAW = (const float*)(p.ws + WS_ORAW); const float* YRAW = (const float*)(p.ws + WS_YRAW);
    const bf16_t* C0 = (const bf16_t*)(p.ws + WS_C0); const bf16_t* C1 = (const bf16_t*)(p.ws + WS_C1);
    bf16_t* OA = (bf16_t*)(p.ws + WS_H); bf16_t* OB = (bf16_t*)(p.ws + WS_OB);
    const int nrows = LEX0 + (seg == 0 ? DECB * DECT : 0);
    const int c = lane * 16;
    f32x4 nw[4];
#pragma unroll
    for (int j = 0; j < 4; ++j) nw[j] = *(const f32x4*)((const float*)(p.ws + WS_PK) + PK_NORMW + (c & 127) + 4 * j);
#pragma unroll 1
    for (int rr = LEX0 + gw; rr < nrows; rr += NGW) {
        int lr; size_t grow;
        if (rr < LEX0) { lr = rr; grow = (size_t)(rr / SEGTOK) * SEQ + seg * SEGTOK + (rr % SEGTOK); } else { lr = LEX0 + EX_SAMP + (rr - LEX0); grow = (size_t)XROWS + EX_SAMP + (rr - LEX0); }
        {
            f32x4 o[4]; float ss = 0.f;
#pragma unroll
            for (int j = 0; j < 4; ++j) { o[j] = *(const f32x4*)(ORAW + (size_t)lr * D + c + 4 * j); ss += o[j][0] * o[j][0] + o[j][1] * o[j][1] + o[j][2] * o[j][2] + o[j][3] * o[j][3]; }
            ss += __shfl_xor(ss, 1); ss += __shfl_xor(ss, 2); ss += __shfl_xor(ss, 4);
            const float rs = __builtin_amdgcn_rsqf(ss * (1.f / 128.f) + 1e-6f);
            const u32x4 z0 = *(const u32x4*)(P + (size_t)lr * NPB + C_Z + c), z1 = *(const u32x4*)(P + (size_t)lr * NPB + C_Z + c + 8);
            const unsigned zz[8] = {z0.x, z0.y, z0.z, z0.w, z1.x, z1.y, z1.z, z1.w};
            unsigned ow[8];
#pragma unroll
            for (int j = 0; j < 8; ++j) { const float za = __uint_as_float(zz[j] << 16), zb = __uint_as_float(zz[j] & 0xffff0000u);
                const float a = o[j >> 1][(j & 1) * 2] * rs * nw[j >> 1][(j & 1) * 2] * silu_(za), b = o[j >> 1][(j & 1) * 2 + 1] * rs * nw[j >> 1][(j & 1) * 2 + 1] * silu_(zb);
                ow[j] = pk2(a, b); }
            *(u32x4*)(OA + grow * D + c) = (u32x4){ow[0], ow[1], ow[2], ow[3]}; *(u32x4*)(OA + grow * D + c + 8) = (u32x4){ow[4], ow[5], ow[6], ow[7]};
        }
    }
}

__device__ __forceinline__ void phase_final(const Params& p) {
    const int tid0 = otid(); const int lane = tid0 & 63; const int gw = obid() * 8 + (tid0 >> 6), NGW = gridDim.x * 8;
    const f32x4* wr = (const f32x4*)((const float*)(p.ws + WS_PK) + PK_LNF) + lane;
#pragma unroll 1
    for (int r = gw; r < XROWS + DECB * DECT; r += NGW) {
        f32x4* xr = (f32x4*)(p.out + (size_t)r * D) + lane;
        f32x4 v[4]; float ss = 0.f;
#pragma unroll
        for (int j = 0; j < 4; ++j) { v[j] = xr[64 * j]; ss += v[j][0] * v[j][0] + v[j][1] * v[j][1] + v[j][2] * v[j][2] + v[j][3] * v[j][3]; }
        const float rs = __builtin_amdgcn_rsqf(wave_sum(ss) * (1.f / D) + 1e-6f);
#pragma unroll
        for (int j = 0; j < 4; ++j) xr[64 * j] = v[j] * rs * wr[64 * j];
    }
}

__global__ __launch_bounds__(512, 2) void hybrid_mega(Params p) {
    extern __shared__ __attribute__((aligned(16))) unsigned char smem[];
    cg::grid_group grid = cg::this_grid();
    LAS unsigned char* lds = (LAS unsigned char*)smem;
    const int G = gridDim.x;
    volatile LAS unsigned* xst = (volatile LAS unsigned*)(lds + (LDS_TOTAL - 16));
    if (threadIdx.x == 0) { xst[0] = 0u; xst[1] = 0u; }
    __syncthreads();
    (void)xcd_barrier_post((unsigned*)(p.ws + WS_BAR), xst);
    if (G == 0x7fffffff) grid.sync();
#define GSYNC() do { XcdBarrier xb_; xb_.bar = (unsigned*)(p.ws + WS_BAR); xb_.x = xb_xcc_id(); xb_.st = (volatile LAS unsigned*)((LAS unsigned char*)smem + (LDS_TOTAL - 16)); xcd_barrier(xb_); } while (0)

#ifndef ONLY
#define ONLY 0
#endif
#define EN(x) (ONLY == 0 || ONLY == (x))
    if (EN(1)) phase0(p, smem);
    GSYNC();
#pragma unroll 1
    for (int it = 0; it <= NSEG + 2; ++it) {
        const int xblk = obid() - (G - 12);
        const bool xrole = xblk >= 0;
        if (it > 0 && it <= NSEG && EN(3)) phase2(p, it - 1, smem);
        if (((it == 2 && xrole) || it == NSEG + 1) && EN(5)) {
            const bool ex = it == 2;
            SchedAB S; S.ob.init(ex ? 3 : XROWS / 256, 4, ex ? 12 : G, ex ? xblk : obid()); S.pm0 = ex ? XROWS / 256 : 0;
            S.A0 = (const char*)(p.ws + WS_H); S.A1 = (const char*)(p.ws + WS_OB); S.B0 = (const char*)(p.ws + WS_WT_A); S.B1 = (const char*)(p.ws + WS_WT_B);
            EpiAB E; E.tmp = ex ? (bf16_t*)(p.ws + WS_YRAW) - (size_t)XROWS * D : (bf16_t*)(p.ws + WS_P); E.merged = ex ? (bf16_t*)(p.ws + WS_C0) - (size_t)XROWS * D : (bf16_t*)(p.ws + WS_MG);
            E.gex = (const bf16_t*)(p.ws + WS_GEX); E.out = p.out;
            pg8::gemm_phase<EpiAB, SchedAB>(lds, D, S, E);
        }
        if (((it == 3 && xrole) || it == NSEG + 2) && EN(6)) {
            const bool ex = it == 3;
            SchedO S; S.ob.init(ex ? 3 : XROWS / 256, 4, ex ? 12 : G, ex ? xblk : obid()); S.pm0 = ex ? XROWS / 256 : 0;
            S.A = ex ? (const char*)((bf16_t*)(p.ws + WS_C0) - (size_t)XROWS * D) : (const char*)(p.ws + WS_MG); S.B = (const char*)(p.ws + WS_WT_O);
            EpiO E; E.out = p.out; E.xp = p.in[0]; E.xs = p.in[1];
            pg8::gemm_phase<EpiO, SchedO>(lds, D, S, E);
        }
        if (it < NSEG && EN(2) && !(it == 2 && xrole)) {
            const int seg = it;
            const int Gp = it == 2 ? G - 12 : G;
            const int cidx = it > 0 ? (obid() + (Gp >> 1)) % Gp : obid();
            SchedIn S; S.ob.init(seg == 0 ? LT_PROMPT + 3 : LT_PROMPT, NT_IN, Gp, cidx); S.seg = seg; S.A = (const char*)(p.ws + WS_H); S.B = (const char*)(p.ws + WS_WT_IN);
            EpiIn E; E.P = (bf16_t*)(p.ws + WS_P); E.gex = (bf16_t*)(p.ws + WS_GEX); E.out = p.out; E.seg = seg;
            pg8::gemm_phase<EpiIn, SchedIn>(lds, D, S, E);
        }
        if (it >= 1 && it + 1 < NSEG && obid() >= 200) { const int t0 = otid(); h_rows_segs(p, it + 1, it + 2, (obid() - 200) * 8 + (t0 >> 6), (G - 200) * 8, t0 & 63); }
        GSYNC();
        if (it < NSEG) {
            if (EN(8)) { phase_gprep(p, it, smem); phase_rprep(p, it, smem); }
            if (it == 1 && EN(4)) phase25(p, 0);
            GSYNC();
        }
    }
    if (EN(7)) phase_final(p);
}

extern "C" void kernel_launch(void* const* d_in, const int* in_sizes, int n_in, void* d_out, int out_size, void* d_ws, size_t ws_size, hipStream_t stream) {
    static int grid_blocks = 0;
    constexpr int LDS_BYTES = LDS_TOTAL;
    if (grid_blocks == 0) {
        if (n_in != 27 || ws_size < WS_END) { fprintf(stderr, "kernel_launch: unexpected n_in %d / ws %zu (need %zu)\n", n_in, ws_size, (size_t)WS_END); grid_blocks = -1; return; }
        if (hipFuncSetAttribute((const void*)hybrid_mega, hipFuncAttributeMaxDynamicSharedMemorySize, LDS_BYTES) != hipSuccess) { fprintf(stderr, "kernel_launch: hipFuncSetAttribute failed\n"); grid_blocks = -1; return; }
        int dev = 0, cus = 0, per_cu = 0;
        hipGetDevice(&dev);
        hipDeviceGetAttribute(&cus, hipDeviceAttributeMultiprocessorCount, dev);
        hipOccupancyMaxActiveBlocksPerMultiprocessor(&per_cu, (const void*)hybrid_mega, 512, LDS_BYTES);
        if (per_cu < 1) { fprintf(stderr, "kernel_launch: occupancy query says %d blocks/CU\n", per_cu); per_cu = 1; }
        (void)hipGetLastError();
        grid_blocks = cus;
    }
    if (grid_blocks < 0) return;
    Params p{};
    for (int i = 0; i < 27; ++i) p.in[i] = (const float*)d_in[i];
    p.out = (float*)d_out; p.ws = (unsigned char*)d_ws;
    if (hipMemsetAsync((unsigned char*)d_ws + WS_BAR, 0, 16384, stream) != hipSuccess) { fprintf(stderr, "kernel_launch: memset of the barrier words failed\n"); return; }
    void* args[] = {&p};
    hipError_t e = hipLaunchCooperativeKernel((const void*)hybrid_mega, dim3(grid_blocks), dim3(512), args, LDS_BYTES, stream);
    if (e != hipSuccess) fprintf(stderr, "cooperative launch failed: %s (grid %d)\n", hipGetErrorString(e), grid_blocks);
}
```

```cpp
#include <hip/hip_runtime.h>
#include <hip/hip_cooperative_groups.h>
#include <cstdio>
namespace cg = cooperative_groups;

#define LAS __attribute__((address_space(3)))
typedef unsigned short bf16_t;
typedef short bf16x8 __attribute__((ext_vector_type(8)));
typedef float f32x4 __attribute__((ext_vector_type(4)));
typedef unsigned u32x4 __attribute__((ext_vector_type(4)));
typedef unsigned u32x2 __attribute__((ext_vector_type(2)));

constexpr int D = 1024;
constexpr int NBATCH = 8, SEQ = 2048, NMETA = 16, DECB = 128, DECT = 4;
constexpr int XROWS = NBATCH * SEQ;
constexpr int EX_SAMP = 16, EX_SHIFT = 528, EX_END = 656;
constexpr int HROWS = 17152, HTILES = 67;
constexpr int NSEG = 8, SEGTOK = SEQ / NSEG;
constexpr int CPS = SEGTOK / 64;
constexpr int TPB = SEGTOK / 256;
constexpr int LT_PROMPT = NBATCH * TPB;
constexpr int LEX0 = LT_PROMPT * 256;
constexpr int LROWS = LEX0 + 768;
constexpr int NP = 10496, NPB = 8448, NT_IN = 41, NT_PB = 33;
constexpr int C_A = 3072, C_B = 3080, C_Z = 3088, C_RW = 4112, C_GATE_REF = 8336;
constexpr int RW_SHIFT = 4224;

constexpr size_t O_YP = 0, O_YS = 16777216, O_GDN_P = 17301504, O_CONV_P = 18350080, O_RWKV_P = 18423808, O_SHIFT_P = 18948096,
                 O_GDN_S = 18956288, O_CONV_S = 35733504, O_RWKV_S = 36913152, O_SHIFT_S = 45301760;

constexpr size_t al256(size_t x) { return (x + 255) & ~(size_t)255; }
constexpr size_t WS_WT_IN = 0;
constexpr size_t WS_WT_A = al256(WS_WT_IN + (size_t)NP * D * 2);
constexpr size_t WS_WT_B = al256(WS_WT_A + (size_t)D * D * 2);
constexpr size_t WS_WT_O = al256(WS_WT_B + (size_t)D * D * 2);
constexpr size_t WS_H = al256(WS_WT_O + (size_t)D * D * 2);
constexpr size_t WS_OB = al256(WS_H + (size_t)HROWS * D * 2);
constexpr size_t WS_P = al256(WS_OB + (size_t)HROWS * D * 2);
constexpr size_t WS_ORAW = al256(WS_P + (size_t)LROWS * NPB * 2);
constexpr size_t WS_YRAW = al256(WS_ORAW + (size_t)LROWS * D * 4);
constexpr size_t WS_C0 = al256(WS_YRAW + (size_t)LROWS * D * 4);
constexpr size_t WS_C1 = al256(WS_C0 + (size_t)LROWS * D * 2);
constexpr size_t WS_GEX = al256(WS_C1 + (size_t)LROWS * D * 2);
constexpr size_t WS_CHALO = al256(WS_GEX + (size_t)768 * 2048 * 2);
constexpr size_t WS_PHALO = al256(WS_CHALO + (size_t)2 * NBATCH * 3 * NPB * 2);
constexpr size_t WS_PK = al256(WS_PHALO + (size_t)2 * NBATCH * NPB * 2);
constexpr int PK_CONVW = 0, PK_ALOG = 12288, PK_DTB = 12296, PK_NORMW = 12304, PK_MU = 12432, PK_W0 = 16656, PK_W2 = 17680, PK_A0 = 83216, PK_A2 = 84240,
              PK_KK = 149776, PK_KA = 150800, PK_RK = 151824, PK_GNW = 152848, PK_GNB = 153872, PK_LNF = 154896, PK_END = 155920;
constexpr size_t WS_BAR = al256(WS_PK + (size_t)PK_END * 4);
constexpr size_t WS_W2T = al256(WS_BAR + 16384);
constexpr size_t WS_A2T = al256(WS_W2T + 131072);
constexpr size_t WS_GP = al256(WS_A2T + 131072);
constexpr int GP_AP = 0, GP_QH = 32768, GP_KH = 49152, GP_OH = 81920, GP_EGL = 98304, GP_G = 98560, GP_STRIDE = 114944;
constexpr int RP_AP = 0, RP_RH = 8192, RP_KH = 16384, RP_YH = 24576, RP_C1 = 32768, RP_C0 = 40960, RP_PC = 49152, RP_STRIDE = 49408;
constexpr size_t WS_RP = al256(WS_GP + (size_t)(CPS + 1) * 64 * GP_STRIDE);
constexpr size_t WS_END = al256(WS_RP + (size_t)(CPS + 1) * 128 * RP_STRIDE);
constexpr size_t WS_MG = WS_GP;
static_assert((size_t)HROWS * D * 2 <= WS_END - WS_GP, "MERGED must fit in the prep records");
static_assert((size_t)HROWS * D * 4 <= (size_t)LROWS * NPB * 2 + 2 * (size_t)LROWS * D * 4, "TMP must fit in P+ORAW+YRAW");
static_assert(WS_END <= (size_t)268435456, "workspace");

constexpr int LDS_TOTAL = 163840;
struct Params { const float* in[27]; float* out; unsigned char* ws; };

__device__ __forceinline__ float bf2f(bf16_t v) { return __uint_as_float(((unsigned)v) << 16); }
typedef __bf16 bf16n2 __attribute__((ext_vector_type(2)));
typedef float f32n2 __attribute__((ext_vector_type(2)));
__device__ __forceinline__ unsigned cvt_pk_bf16(float lo, float hi) { const f32n2 v = {lo, hi}; return __builtin_bit_cast(unsigned, __builtin_convertvector(v, bf16n2)); }
__device__ __forceinline__ unsigned pk2(float lo, float hi) { return cvt_pk_bf16(lo, hi); }
__device__ __forceinline__ unsigned f2bf(float f) { return cvt_pk_bf16(f, 0.f) & 0xffffu; }
__device__ __forceinline__ float sigm(float x) { return __builtin_amdgcn_rcpf(1.f + __expf(-x)); }
__device__ __forceinline__ float silu_(float x) { return x * __builtin_amdgcn_rcpf(1.f + __expf(-x)); }
__device__ __forceinline__ float softplus_(float x) { return fmaxf(x, 0.f) + log1pf(expf(-fabsf(x))); }
__device__ __forceinline__ float wave_sum(float v) {
#pragma unroll
    for (int o = 1; o < 64; o <<= 1) v += __shfl_xor(v, o);
    return v;
}
__device__ __forceinline__ void unpack8(const u32x4 rw, float (&x)[8]) {
    x[0] = __uint_as_float(rw.x << 16); x[1] = __uint_as_float(rw.x & 0xffff0000u); x[2] = __uint_as_float(rw.y << 16); x[3] = __uint_as_float(rw.y & 0xffff0000u);
    x[4] = __uint_as_float(rw.z << 16); x[5] = __uint_as_float(rw.z & 0xffff0000u); x[6] = __uint_as_float(rw.w << 16); x[7] = __uint_as_float(rw.w & 0xffff0000u); }
__device__ __forceinline__ u32x4 pack8(const float (&x)[8]) { return (u32x4){pk2(x[0], x[1]), pk2(x[2], x[3]), pk2(x[4], x[5]), pk2(x[6], x[7])}; }

__device__ __forceinline__ int otid() { int t = threadIdx.x; asm volatile("" : "+v"(t)); return t; }
__device__ __forceinline__ int obid() { int t = blockIdx.x; asm volatile("" : "+s"(t)); return t; }
__device__ __forceinline__ float tanh_(float x) { const float e = __expf(2.f * x); return 1.f - 2.f * __builtin_amdgcn_rcpf(e + 1.f); }
template <int CTRL> __device__ __forceinline__ float dppf(float x) { return __builtin_bit_cast(float, __builtin_amdgcn_mov_dpp(__builtin_bit_cast(int, x), CTRL, 0xf, 0xf, true)); }
__device__ __forceinline__ float rowsum16(float x) { x += dppf<0x128>(x); x += dppf<0x124>(x); x += dppf<0x122>(x); x += dppf<0x121>(x); return x; }


#define XB_TMO      128
#define XB_XCNT(j)  (256  + 64 * (j))
#define XB_XSUB(j)  (1280 + 64 * (j))
#define XB_XGEN(j)  (2304 + 64 * (j))
#define XB_TOP      3328
#define XB_TOPGEN   3392
#define XCD_BAR_WORDS 3456
#define XB_SPIN_CAP (1u << 22)
__device__ __forceinline__ unsigned xb_ld(unsigned* p)              { return __hip_atomic_load(p, __ATOMIC_RELAXED, __HIP_MEMORY_SCOPE_AGENT); }
__device__ __forceinline__ unsigned xb_add(unsigned* p, unsigned v) { return __hip_atomic_fetch_add(p, v, __ATOMIC_RELAXED, __HIP_MEMORY_SCOPE_AGENT); }
__device__ __forceinline__ unsigned xb_xcc_id() { return (unsigned)__builtin_amdgcn_s_getreg((3 << 11) | 20) & 0xFu; }
#define XB_SPIN(cond, bar) do { unsigned _sp = 0; while (cond) { __builtin_amdgcn_s_sleep(1); \
    if ((++_sp & 255u) == 0u) { if (xb_ld(&(bar)[XB_TMO])) break; if (_sp > XB_SPIN_CAP) { atomicAdd(&(bar)[XB_TMO], 1u); break; } } } } while (0)
struct XcdBarrier { unsigned* bar; unsigned x; volatile LAS unsigned* st; };
__device__ __forceinline__ XcdBarrier xcd_barrier_post(unsigned* bar, volatile LAS unsigned* st) {
    XcdBarrier b; b.bar = bar; b.x = xb_xcc_id(); b.st = st;
    if (threadIdx.x == 0) (void)xb_add(&bar[XB_XCNT(b.x)], 1u);
    return b;
}
__device__ __forceinline__ void xcd_barrier_complete(unsigned* bar, unsigned x, unsigned& nloc, unsigned& nx) {
    const unsigned G = gridDim.x * gridDim.y * gridDim.z;
    unsigned sum, cnt, mine, sp = 0u;
    for (;;) {
        sum = 0u; cnt = 0u; mine = 0u;
#pragma unroll
        for (unsigned j = 0; j < 16; ++j) { const unsigned c = xb_ld(&bar[XB_XCNT(j)]); sum += c; cnt += (c > 0u) ? 1u : 0u; mine = (j == x) ? c : mine; }
        if (sum == G) break;
        __builtin_amdgcn_s_sleep(1);
        if ((++sp & 255u) == 0u) { if (xb_ld(&bar[XB_TMO])) break; if (sp > XB_SPIN_CAP) { atomicAdd(&bar[XB_TMO], 1u); break; } }
    }
    nloc = mine > 0u ? mine : 1u; nx = cnt > 0u ? cnt : 1u;
}
__device__ __forceinline__ void xcd_barrier(const XcdBarrier& b) {
    asm volatile("s_waitcnt vmcnt(0)" ::: "memory");
    __syncthreads();
    if (threadIdx.x == 0) {
        unsigned* bar = b.bar;
        __builtin_amdgcn_s_waitcnt(0);
        unsigned nloc = b.st[0], nx = b.st[1];
        if (nloc == 0u) { xcd_barrier_complete(bar, b.x, nloc, nx); b.st[0] = nloc; b.st[1] = nx; }
        const unsigned old = xb_add(&bar[XB_XSUB(b.x)], 1u);
        const unsigned gen = old / nloc;
        if (old + 1u == (gen + 1u) * nloc) {
            __builtin_amdgcn_fence(__ATOMIC_RELEASE, "agent");
            asm volatile("s_waitcnt vmcnt(0)" ::: "memory");
            const unsigned og = xb_add(&bar[XB_TOP], 1u);
            const unsigned tg = og / nx;
            if (og + 1u == (tg + 1u) * nx) xb_add(&bar[XB_TOPGEN], 1u);
            else XB_SPIN(xb_ld(&bar[XB_TOPGEN]) == tg, bar);
            __builtin_amdgcn_fence(__ATOMIC_ACQUIRE, "agent");
            xb_add(&bar[XB_XGEN(b.x)], 1u);
            asm volatile("s_waitcnt vmcnt(0)" ::: "memory");
        } else {
            XB_SPIN(xb_ld(&bar[XB_XGEN(b.x)]) == gen, bar);
            __builtin_amdgcn_fence(__ATOMIC_ACQUIRE, "agent");
            asm volatile("s_waitcnt vmcnt(0)" ::: "memory");
        }
    }
    __syncthreads();
}

namespace pg8 {
constexpr int BM = 256, BK = 64, HALF = 128, HTB = HALF * BK * 2, STAGE_BYTES = 8 * HTB, NXCD = 8, WGM = 8;
__device__ __forceinline__ int lds_byte(int r, int c) { const int st = (r >> 4) * 2 + (c >> 5), rr = r & 15, cc = c & 31, ob = rr * 64 + cc * 2; return st * 1024 + (ob ^ (((ob >> 9) & 1) << 5)); }
__device__ __forceinline__ void stage_rc(int b, int& R, int& C) { const int st = b / 1024, sb = b % 1024, swz = sb ^ (((sb >> 9) & 1) << 5); R = (st >> 1) * 16 + swz / 64; C = (st & 1) * 32 + (swz % 64) / 2; }
__device__ __forceinline__ int perm32(int rho) { const int n = rho >> 4, i = rho & 15; return 8 * (i >> 2) + 4 * n + (i & 3); }

struct Unit { int pm, pn, w; };
struct OrderBase {
    int nM, nN, nwg, G, c;
    __device__ void init(int nM_, int nN_, int G_, int c_) { nM = nM_; nN = nN_; nwg = nM * nN; G = G_; c = c_; }
    __device__ bool nextb(int i, Unit& u) const {
        const long L = (long)i * G + c; if (L >= nwg) return false;
        int wgid = (int)L; { const int q = nwg / NXCD, r = nwg % NXCD, xcd = wgid % NXCD, off = wgid / NXCD; wgid = (xcd < r ? xcd * (q + 1) : r * (q + 1) + (xcd - r) * q) + off; }
        const int nig = WGM * nN, gid = wgid / nig, fm = gid * WGM, gsz = (nM - fm) < WGM ? (nM - fm) : WGM;
        u.pm = fm + ((wgid % nig) % gsz); u.pn = (wgid % nig) / gsz; u.w = 0; return true;
    }
};

template <class Epi, class Sched>
__device__ __forceinline__ void gemm_phase(LAS unsigned char* lds, const int K, const Sched& S, const Epi& E) {
    const int tid = otid(), wid = __builtin_amdgcn_readfirstlane(tid >> 6), lane = tid & 63, wr = wid >> 2, wc = wid & 3, fr = lane & 15, fq = lane >> 4;
    const int nt = K / BK;
    unsigned voffA[2], voffB[2];
#pragma unroll
    for (int i = 0; i < 2; ++i) { int R, C; stage_rc(tid * 16 + i * 8192, R, C); const int Rb = Epi::PERM ? ((R & ~31) + perm32(R & 31)) : R;
        voffA[i] = (unsigned)(R * K + C) * 2u; voffB[i] = (unsigned)(Rb * K + C) * 2u; }
    const size_t kstep = (size_t)(BK * 2);
    const size_t hstep = (size_t)HALF * K * 2;
    const unsigned ldsw = (unsigned)wid * 1024u;
    const int aoff = lds_byte(wr * 64 + fr, fq * 8), boff = lds_byte(wc * 32 + fr, fq * 8);
#define PG8_SA(b, h) (((b) * 2 + (h)) * HTB)
#define PG8_SB(b, h) ((4 + (b) * 2 + (h)) * HTB)
#define PG8_STAGE(bufoff, gbase, voff) do { _Pragma("unroll") for (int _i = 0; _i < 2; ++_i) \
        __builtin_amdgcn_global_load_lds((const unsigned*)((const char*)(gbase) + (voff)[_i]), (LAS unsigned*)(lds + (bufoff) + ldsw + _i * 8192), 16, 0, 0); } while (0)
#define PG8_LDA(dst, b, h) do { _Pragma("unroll") for (int m = 0; m < 4; ++m) _Pragma("unroll") for (int k = 0; k < 2; ++k) dst[m][k] = *(const LAS bf16x8*)(lds + PG8_SA(b, h) + aoff + m * 2048 + k * 1024); } while (0)
#define PG8_LDB(dst, b, h) do { _Pragma("unroll") for (int n = 0; n < 2; ++n) _Pragma("unroll") for (int k = 0; k < 2; ++k) dst[n][k] = *(const LAS bf16x8*)(lds + PG8_SB(b, h) + boff + n * 2048 + k * 1024); } while (0)
#define PG8_MMA(ai, bj, At, Bt) do { __builtin_amdgcn_s_setprio(1); _Pragma("unroll") for (int m = 0; m < 4; ++m) _Pragma("unroll") for (int n = 0; n < 2; ++n) _Pragma("unroll") for (int k = 0; k < 2; ++k) \
        acc[ai][bj][m][n] = __builtin_amdgcn_mfma_f32_16x16x32_bf16(Bt[n][k], At[m][k], acc[ai][bj][m][n], 0, 0, 0); __builtin_amdgcn_s_setprio(0); } while (0)
#define PG8_WAIT_V(n) asm volatile("s_waitcnt vmcnt(" #n ")" ::: "memory")
#define PG8_WAIT_L(n) asm volatile("s_waitcnt lgkmcnt(" #n ")" ::: "memory")
#define PG8_BAR __builtin_amdgcn_s_barrier()
#define PG8_SCHED __builtin_amdgcn_sched_barrier(0)
    Unit cur, nxt; int ui = 0;
    if (!S.next(0, cur)) return;
    f32x4 acc[2][2][4][2];
#pragma unroll
    for (int a = 0; a < 2; ++a)
#pragma unroll
        for (int b = 0; b < 2; ++b)
#pragma unroll
            for (int m = 0; m < 4; ++m)
#pragma unroll
                for (int n = 0; n < 2; ++n) acc[a][b][m][n] = (f32x4){0.f, 0.f, 0.f, 0.f};
    bf16x8 At[4][2], B0[2][2], B1[2][2];
    const char* cA = S.a_ptr(cur); const char* cB = S.b_ptr(cur);
    PG8_STAGE(PG8_SB(0, 0), cB, voffB); PG8_STAGE(PG8_SA(0, 0), cA, voffA); PG8_STAGE(PG8_SB(0, 1), cB + hstep, voffB); PG8_STAGE(PG8_SA(0, 1), cA + hstep, voffA);
    if (wr == 1) PG8_BAR;
    PG8_WAIT_V(4); PG8_BAR;
    PG8_STAGE(PG8_SB(1, 0), cB + kstep, voffB); PG8_STAGE(PG8_SA(1, 0), cA + kstep, voffA); PG8_STAGE(PG8_SB(1, 1), cB + hstep + kstep, voffB);
    PG8_WAIT_V(6); PG8_BAR;
    for (;;) {
        const bool has_next = S.next(ui + 1, nxt);
        const char* nA = has_next ? S.a_ptr(nxt) : cA; const char* nB = has_next ? S.b_ptr(nxt) : cB;
        for (int t = 0; t < nt; t += 2) {
            const bool last = (t == nt - 2);
            const char* a1 = cA + (size_t)(t + 1) * kstep;
            const char* a2 = last ? nA : cA + (size_t)(t + 2) * kstep; const char* b2 = last ? nB : cB + (size_t)(t + 2) * kstep;
            const char* a3 = a2 + kstep; const char* b3 = b2 + kstep;
            PG8_LDB(B0, 0, 0); PG8_SCHED; PG8_LDA(At, 0, 0); PG8_STAGE(PG8_SA(1, 1), a1 + hstep, voffA);
            PG8_WAIT_L(8); PG8_BAR; PG8_WAIT_L(0); PG8_MMA(0, 0, At, B0); PG8_BAR; PG8_SCHED;
            PG8_LDB(B1, 0, 1); PG8_STAGE(PG8_SB(0, 0), b2, voffB);
            PG8_BAR; PG8_WAIT_L(0); PG8_MMA(0, 1, At, B1); PG8_BAR;
            PG8_LDA(At, 0, 1); PG8_STAGE(PG8_SA(0, 0), a2, voffA);
            PG8_BAR; PG8_WAIT_L(0); PG8_MMA(1, 0, At, B0); PG8_BAR; PG8_SCHED;
            PG8_STAGE(PG8_SB(0, 1), b2 + hstep, voffB);
            PG8_WAIT_V(6); PG8_BAR; PG8_MMA(1, 1, At, B1); PG8_BAR;
            PG8_LDB(B0, 1, 0); PG8_SCHED; PG8_LDA(At, 1, 0); PG8_STAGE(PG8_SA(0, 1), a2 + hstep, voffA);
            PG8_WAIT_L(8); PG8_BAR; PG8_WAIT_L(0); PG8_MMA(0, 0, At, B0); PG8_BAR; PG8_SCHED;
            PG8_LDB(B1, 1, 1); PG8_STAGE(PG8_SB(1, 0), b3, voffB);
            PG8_BAR; PG8_WAIT_L(0); PG8_MMA(0, 1, At, B1); PG8_BAR;
            PG8_LDA(At, 1, 1); PG8_STAGE(PG8_SA(1, 0), a3, voffA);
            PG8_BAR; PG8_WAIT_L(0); PG8_MMA(1, 0, At, B0); PG8_BAR; PG8_SCHED;
            PG8_STAGE(PG8_SB(1, 1), b3 + hstep, voffB);
            PG8_WAIT_V(6); PG8_BAR; PG8_MMA(1, 1, At, B1); PG8_BAR;
        }
        E(acc, cur, wr, wc, fr, fq);
        if (!has_next) break;
#pragma unroll
        for (int a = 0; a < 2; ++a)
#pragma unroll
            for (int b = 0; b < 2; ++b)
#pragma unroll
                for (int m = 0; m < 4; ++m)
#pragma unroll
                    for (int n = 0; n < 2; ++n) acc[a][b][m][n] = (f32x4){0.f, 0.f, 0.f, 0.f};
        cur = nxt; cA = nA; cB = nB; ++ui;
    }
    PG8_WAIT_V(0);
    if (wr == 0) PG8_BAR;
    PG8_BAR;
#undef PG8_SA
#undef PG8_SB
#undef PG8_STAGE
#undef PG8_LDA
#undef PG8_LDB
#undef PG8_MMA
#undef PG8_WAIT_V
#undef PG8_WAIT_L
#undef PG8_BAR
#undef PG8_SCHED
}
}
using pg8::Unit;

struct SchedIn {
    pg8::OrderBase ob; int seg; const char* A; const char* B;
    __device__ bool next(int i, Unit& u) const { return ob.nextb(i, u); }
    __device__ const char* a_ptr(const Unit& u) const {
        const int gt = u.pm < LT_PROMPT ? ((u.pm / TPB) * (SEQ / 256) + seg * TPB + (u.pm % TPB)) : (XROWS / 256 + (u.pm - LT_PROMPT));
        return A + (size_t)gt * 256 * D * 2; }
    __device__ const char* b_ptr(const Unit& u) const { return B + (size_t)u.pn * 256 * D * 2; }
};
struct SchedAB {
    pg8::OrderBase ob; int pm0; const char* A0; const char* A1; const char* B0; const char* B1;
    __device__ bool next(int i, Unit& u) const { const bool ok = ob.nextb(i >> 1, u); u.pm += pm0; u.w = i & 1; return ok; }
    __device__ const char* a_ptr(const Unit& u) const { return (u.w ? A1 : A0) + (size_t)u.pm * 256 * D * 2; }
    __device__ const char* b_ptr(const Unit& u) const { return (u.w ? B1 : B0) + (size_t)u.pn * 256 * D * 2; }
};
struct SchedO {
    pg8::OrderBase ob; int pm0; const char* A; const char* B;
    __device__ bool next(int i, Unit& u) const { const bool ok = ob.nextb(i, u); u.pm += pm0; return ok; }
    __device__ const char* a_ptr(const Unit& u) const { return A + (size_t)u.pm * 256 * D * 2; }
    __device__ const char* b_ptr(const Unit& u) const { return B + (size_t)u.pn * 256 * D * 2; }
};

struct EpiIn {
    static constexpr bool PERM = true;
    bf16_t* P; bf16_t* gex; float* out; int seg;
    __device__ __forceinline__ void operator()(const f32x4 (&acc)[2][2][4][2], const Unit& u, int wr, int wc, int fr, int fq) const {
        const int lr0 = u.pm * 256 + wr * 64 + fr;
        const int c0 = u.pn * 256 + wc * 32 + 8 * fq;
#pragma unroll
        for (int ai = 0; ai < 2; ++ai)
#pragma unroll
            for (int m = 0; m < 4; ++m) {
                const int lr = lr0 + ai * 128 + m * 16;
                bf16_t* rowp;
                if (u.pn < NT_PB) rowp = P + (size_t)lr * NPB + c0;
                else if (lr < LEX0) { const int b = lr / SEGTOK; const size_t grow = (size_t)b * SEQ + seg * SEGTOK + (lr % SEGTOK); rowp = (bf16_t*)(out + O_YP + grow * D) + (c0 - NPB); }
                else rowp = gex + (size_t)(lr - LEX0) * 2048 + (c0 - NPB);
#pragma unroll
                for (int bj = 0; bj < 2; ++bj) { const f32x4 v0 = acc[ai][bj][m][0], v1 = acc[ai][bj][m][1];
                    u32x4 w; w.x = cvt_pk_bf16(v0[0], v0[1]); w.y = cvt_pk_bf16(v0[2], v0[3]); w.z = cvt_pk_bf16(v1[0], v1[1]); w.w = cvt_pk_bf16(v1[2], v1[3]);
                    *(u32x4*)(rowp + bj * 128) = w; }
            }
    }
};
struct EpiAB {
    static constexpr bool PERM = true;
    bf16_t* tmp; bf16_t* merged; const bf16_t* gex; const float* out;
    __device__ __forceinline__ void operator()(const f32x4 (&acc)[2][2][4][2], const Unit& u, int wr, int wc, int fr, int fq) const {
        const int row0 = u.pm * 256 + wr * 64 + fr, col0 = u.pn * 256 + wc * 32 + 8 * fq;
#pragma unroll
        for (int ai = 0; ai < 2; ++ai)
#pragma unroll
            for (int m = 0; m < 4; ++m) {
                const int grow = row0 + ai * 128 + m * 16;
                const bf16_t* gp = (grow < XROWS) ? ((const bf16_t*)(out + O_YP + (size_t)grow * D) + u.w * D) : (gex + (size_t)(grow - XROWS) * 2048 + u.w * D);
#pragma unroll
                for (int bj = 0; bj < 2; ++bj) {
                    const int c = col0 + bj * 128;
                    float g[8]; unpack8(*(const u32x4*)(gp + c), g);
                    const f32x4 v0 = acc[ai][bj][m][0], v1 = acc[ai][bj][m][1];
                    float v[8] = {v0[0] * sigm(g[0]), v0[1] * sigm(g[1]), v0[2] * sigm(g[2]), v0[3] * sigm(g[3]), v1[0] * sigm(g[4]), v1[1] * sigm(g[5]), v1[2] * sigm(g[6]), v1[3] * sigm(g[7])};
                    bf16_t* tp = tmp + (size_t)grow * D + c;
                    if (u.w == 0) *(u32x4*)tp = pack8(v);
                    else { float t[8]; unpack8(*(const u32x4*)tp, t);
#pragma unroll
                        for (int e = 0; e < 8; ++e) v[e] += t[e];
                        *(u32x4*)(merged + (size_t)grow * D + c) = pack8(v); }
                }
            }
    }
};
struct EpiO {
    static constexpr bool PERM = false;
    float* out; const float* xp; const float* xs;
    __device__ __forceinline__ void operator()(const f32x4 (&acc)[2][2][4][2], const Unit& u, int wr, int wc, int fr, int fq) const {
        const int row0 = u.pm * 256 + wr * 64 + fr, col0 = u.pn * 256 + wc * 32 + 4 * fq;
#pragma unroll
        for (int ai = 0; ai < 2; ++ai)
#pragma unroll
            for (int m = 0; m < 4; ++m) {
                const int grow = row0 + ai * 128 + m * 16;
                const float* xr; float* yr;
                if (grow < XROWS) { xr = xp + (size_t)grow * D; yr = out + O_YP + (size_t)grow * D; }
                else { const int e = grow - XROWS; if (e < EX_SAMP || e >= EX_SHIFT) continue; xr = xs + (size_t)(e - EX_SAMP) * D; yr = out + O_YS + (size_t)(e - EX_SAMP) * D; }
#pragma unroll
                for (int bj = 0; bj < 2; ++bj)
#pragma unroll
                    for (int n = 0; n < 2; ++n) { const int c = col0 + bj * 128 + n * 16; *(f32x4*)(yr + c) = *(const f32x4*)(xr + c) + acc[ai][bj][m][n]; }
            }
    }
};

__device__ __forceinline__ void p0_row(const Params& p, int r, int lane) {
    bf16_t* hrow = (bf16_t*)(p.ws + WS_H) + (size_t)r * D;
    const float* src = nullptr; bool norm = true; float* sh = nullptr;
    if (r < XROWS) { src = p.in[0] + (size_t)r * D; if ((r & (SEQ - 1)) == SEQ - 1) sh = p.out + O_SHIFT_P + (size_t)(r / SEQ) * D; }
    else { const int e = r - XROWS;
        if (e < EX_SAMP) src = p.in[6] + (size_t)e * D;
        else if (e < EX_SHIFT) { src = p.in[1] + (size_t)(e - EX_SAMP) * D; if (((e - EX_SAMP) & 3) == 3) sh = p.out + O_SHIFT_S + (size_t)((e - EX_SAMP) >> 2) * D; }
        else if (e < EX_END) { src = p.in[5] + (size_t)(e - EX_SHIFT) * D; norm = false; } }
    u32x2* o8 = (u32x2*)hrow + lane;
    if (!src) {
#pragma unroll
        for (int j = 0; j < 4; ++j) o8[64 * j] = (u32x2){0u, 0u};
        return; }
    const f32x4* xr = (const f32x4*)src + lane;
    f32x4 v[4]; float ss = 0.f;
#pragma unroll
    for (int j = 0; j < 4; ++j) { v[j] = xr[64 * j]; ss += v[j][0] * v[j][0] + v[j][1] * v[j][1] + v[j][2] * v[j][2] + v[j][3] * v[j][3]; }
    if (norm) {
        const float rs = __builtin_amdgcn_rsqf(wave_sum(ss) * (1.f / D) + 1e-6f);
        const f32x4* wr = (const f32x4*)p.in[7] + lane;
#pragma unroll
        for (int j = 0; j < 4; ++j) v[j] = v[j] * rs * wr[64 * j];
    }
#pragma unroll
    for (int j = 0; j < 4; ++j) { o8[64 * j] = (u32x2){pk2(v[j][0], v[j][1]), pk2(v[j][2], v[j][3])}; if (sh) ((f32x4*)sh)[lane + 64 * j] = v[j]; }
}
template <int MODE> __device__ __forceinline__ void p0_tr_item(const float* W, int N, bf16_t* WT, float* scr, int kb, int nb, int lane) {
    const int k0 = 64 * kb, n0 = 32 * nb;
    const int nn = n0 + (lane & 31);
    int srcc = nn;
    if (MODE == 1) srcc = nn < C_GATE_REF ? nn : (nn < NPB ? -1 : nn - (NPB - C_GATE_REF));
#pragma unroll 8
    for (int i = 0; i < 32; ++i) { const int kk = 2 * i + (lane >> 5); scr[kk * 33 + (lane & 31)] = srcc >= 0 ? W[(size_t)(k0 + kk) * N + srcc] : 0.f; }
    asm volatile("s_waitcnt lgkmcnt(0)" ::: "memory");
    const int c = lane & 7;
#pragma unroll
    for (int j = 0; j < 4; ++j) { const int n = (lane >> 3) + 8 * j; const float* s = scr + (8 * c) * 33 + n;
        u32x4 o; o.x = pk2(s[0 * 33], s[1 * 33]); o.y = pk2(s[2 * 33], s[3 * 33]); o.z = pk2(s[4 * 33], s[5 * 33]); o.w = pk2(s[6 * 33], s[7 * 33]);
        *(u32x4*)(WT + (size_t)(n0 + n) * D + k0 + 8 * c) = o; }
    asm volatile("s_waitcnt lgkmcnt(0)" ::: "memory");
}
__device__ __forceinline__ void h_rows_pair(const Params& p, int r, int r1, bool has1, int lane, const f32x4 (&wv)[4]) {
    const f32x4* x0 = (const f32x4*)(p.in[0] + (size_t)r * D) + lane; const f32x4* x1 = (const f32x4*)(p.in[0] + (size_t)(has1 ? r1 : r) * D) + lane;
    f32x4 a[4], b[4]; float s0 = 0.f, s1 = 0.f;
#pragma unroll
    for (int j = 0; j < 4; ++j) { a[j] = x0[64 * j]; b[j] = x1[64 * j]; }
#pragma unroll
    for (int j = 0; j < 4; ++j) { s0 += a[j][0] * a[j][0] + a[j][1] * a[j][1] + a[j][2] * a[j][2] + a[j][3] * a[j][3]; s1 += b[j][0] * b[j][0] + b[j][1] * b[j][1] + b[j][2] * b[j][2] + b[j][3] * b[j][3]; }
    const float q0 = __builtin_amdgcn_rsqf(wave_sum(s0) * (1.f / D) + 1e-6f), q1 = __builtin_amdgcn_rsqf(wave_sum(s1) * (1.f / D) + 1e-6f);
    u32x2* o0 = (u32x2*)((bf16_t*)(p.ws + WS_H) + (size_t)r * D) + lane; u32x2* o1 = (u32x2*)((bf16_t*)(p.ws + WS_H) + (size_t)r1 * D) + lane;
#pragma unroll
    for (int j = 0; j < 4; ++j) { a[j] = a[j] * q0 * wv[j]; o0[64 * j] = (u32x2){pk2(a[j][0], a[j][1]), pk2(a[j][2], a[j][3])}; }
    if ((r & (SEQ - 1)) == SEQ - 1) { f32x4* sh = (f32x4*)(p.out + O_SHIFT_P + (size_t)(r / SEQ) * D) + lane;
#pragma unroll
        for (int j = 0; j < 4; ++j) sh[64 * j] = a[j]; }
    if (has1) {
#pragma unroll
        for (int j = 0; j < 4; ++j) { b[j] = b[j] * q1 * wv[j]; o1[64 * j] = (u32x2){pk2(b[j][0], b[j][1]), pk2(b[j][2], b[j][3])}; }
        if ((r1 & (SEQ - 1)) == SEQ - 1) { f32x4* sh = (f32x4*)(p.out + O_SHIFT_P + (size_t)(r1 / SEQ) * D) + lane;
#pragma unroll
            for (int j = 0; j < 4; ++j) sh[64 * j] = b[j]; }
    }
}
__device__ __forceinline__ void h_rows_segs(const Params& p, int s_lo, int s_hi, int wi, int nw, int lane) {
    const f32x4* lw = (const f32x4*)p.in[7] + lane;
    f32x4 wv[4];
#pragma unroll
    for (int j = 0; j < 4; ++j) wv[j] = lw[64 * j];
    const int n = (s_hi - s_lo) * NBATCH * SEGTOK;
#pragma unroll 1
    for (int x = wi; x < n; x += 2 * nw) {
        const int x1 = x + nw; const bool has1 = x1 < n;
        const int sg = s_lo + x / (NBATCH * SEGTOK), rem = x % (NBATCH * SEGTOK), r = (rem / SEGTOK) * SEQ + sg * SEGTOK + (rem % SEGTOK);
        const int xx = has1 ? x1 : x; const int sg1 = s_lo + xx / (NBATCH * SEGTOK), rem1 = xx % (NBATCH * SEGTOK), r1 = (rem1 / SEGTOK) * SEQ + sg1 * SEGTOK + (rem1 % SEGTOK);
        h_rows_pair(p, r, r1, has1, lane, wv);
    }
}
__device__ __forceinline__ void phase0(const Params& p, unsigned char* smem) {
    const int tid0 = otid(), wave = tid0 >> 6, lane = tid0 & 63;
    const int gw = obid() * 8 + wave, NGW = gridDim.x * 8;
    float* scr = (float*)smem + wave * (64 * 33);
    constexpr int I_IN = 16 * (NP / 32), I_SQ = 16 * 32;
    for (int it = gw; it < I_IN + 3 * I_SQ; it += NGW) {
        int r = it;
        if (r < I_IN) { p0_tr_item<1>(p.in[8], 10384, (bf16_t*)(p.ws + WS_WT_IN), scr, r / (NP / 32), r % (NP / 32), lane); continue; } r -= I_IN;
        if (r < I_SQ) { p0_tr_item<0>(p.in[13], D, (bf16_t*)(p.ws + WS_WT_A), scr, r / 32, r % 32, lane); continue; } r -= I_SQ;
        if (r < I_SQ) { p0_tr_item<0>(p.in[24], D, (bf16_t*)(p.ws + WS_WT_B), scr, r / 32, r % 32, lane); continue; } r -= I_SQ;
        p0_tr_item<0>(p.in[25], D, (bf16_t*)(p.ws + WS_WT_O), scr, r / 32, r % 32, lane);
    }
    h_rows_segs(p, 0, 2, gw, NGW, lane);
    for (int r = XROWS + gw; r < HROWS; r += NGW) p0_row(p, r, lane);
    {
        float* pk = (float*)(p.ws + WS_PK);
        const int gt = obid() * 512 + tid0, NT = gridDim.x * 512;
        for (int i = gt; i < PK_END; i += NT) {
            const float* src; int o;
            if (i < PK_ALOG) { src = p.in[9]; o = i - PK_CONVW; } else if (i < PK_DTB) { src = p.in[10]; o = i - PK_ALOG; } else if (i < PK_NORMW) { src = p.in[11]; o = i - PK_DTB; }
            else if (i < PK_MU) { src = p.in[12]; o = i - PK_NORMW; } else if (i < PK_W0) { src = p.in[14]; o = i - PK_MU; } else if (i < PK_W2) { src = p.in[15]; o = i - PK_W0; }
            else if (i < PK_A0) { src = p.in[16]; o = i - PK_W2; } else if (i < PK_A2) { src = p.in[17]; o = i - PK_A0; } else if (i < PK_KK) { src = p.in[18]; o = i - PK_A2; }
            else if (i < PK_KA) { src = p.in[19]; o = i - PK_KK; } else if (i < PK_RK) { src = p.in[20]; o = i - PK_KA; } else if (i < PK_GNW) { src = p.in[21]; o = i - PK_RK; }
            else if (i < PK_GNB) { src = p.in[22]; o = i - PK_GNW; } else if (i < PK_LNF) { src = p.in[23]; o = i - PK_GNB; } else { src = p.in[26]; o = i - PK_LNF; }
            pk[i] = src[o];
        }
        bf16_t* w2t = (bf16_t*)(p.ws + WS_W2T); bf16_t* a2t = (bf16_t*)(p.ws + WS_A2T);
        for (int i = gt; i < 65536; i += NT) { const int l = i & 63, c = (i >> 6) & 63, hb = i >> 12;
            w2t[i] = (bf16_t)f2bf(p.in[16][(size_t)l * D + hb * 64 + c]); a2t[i] = (bf16_t)f2bf(p.in[18][(size_t)l * D + hb * 64 + c]); }
    }
}

__device__ __forceinline__ void gdn_item(const Params& p, unsigned char* smem, const float* s_in, float* s_out, const float* halo_in, float* halo_out,
                                         int h, int sl, int rowA, int nA, int rowB, int nB) {
    const int tid = otid(), w = tid >> 6, lane = tid & 63, vl = lane >> 4, kg = lane & 15;
    float* qk_s = (float*)smem; float* v_s = qk_s + 16384; float* o_s = v_s + 2048; float* gb_s = o_s + 2048; float* sst = gb_s + 128;
    const bf16_t* P = (const bf16_t*)(p.ws + WS_P);
    float* ORAW = (float*)(p.ws + WS_ORAW);
    float s[8];
    if (s_in) {
        { const int k = tid >> 2, q4 = tid & 3; const f32x4* src = (const f32x4*)(s_in + (size_t)k * 128 + sl * 32 + q4 * 8); const f32x4 a = src[0], b = src[1];
          float* d = sst + k * 33 + q4 * 8; d[0] = a[0]; d[1] = a[1]; d[2] = a[2]; d[3] = a[3]; d[4] = b[0]; d[5] = b[1]; d[6] = b[2]; d[7] = b[3]; }
        __syncthreads();
#pragma unroll
        for (int j = 0; j < 8; ++j) s[j] = sst[(kg * 8 + j) * 33 + 4 * w + vl];
        __syncthreads();
    } else {
#pragma unroll
        for (int j = 0; j < 8; ++j) s[j] = 0.f;
    }
    int pcol = -1;
    if (tid < 128) pcol = h * 128 + tid; else if (tid < 256) pcol = 1024 + h * 128 + (tid - 128); else if (tid < 288) pcol = 2048 + h * 128 + sl * 32 + (tid - 256);
    float cw0 = 0.f, cw1 = 0.f, cw2 = 0.f, cw3 = 0.f, x1 = 0.f, x2 = 0.f, x3 = 0.f;
    const float* pk = (const float*)(p.ws + WS_PK);
    if (pcol >= 0) { const float* cw = pk + PK_CONVW; cw0 = cw[pcol]; cw1 = cw[3072 + pcol]; cw2 = cw[6144 + pcol]; cw3 = cw[9216 + pcol];
        if (halo_in) { x3 = halo_in[pcol]; x2 = halo_in[3072 + pcol]; x1 = halo_in[6144 + pcol]; } }
    const float nalog = -expf(pk[PK_ALOG + h]), dtb = pk[PK_DTB + h];
#pragma unroll 1
    for (int run = 0; run < 2; ++run) {
        const int rrow = run ? rowB : rowA, rn = run ? nB : nA; const bool wout = run != 0;
#pragma unroll 1
        for (int c0 = 0; c0 < rn; c0 += 64) {
            const int nt = (rn - c0) < 64 ? (rn - c0) : 64; const int row = rrow + c0;
            if (pcol >= 0) {
                const bf16_t* src = P + (size_t)row * NPB + pcol;
                float* dst = tid < 256 ? (qk_s + tid) : (v_s + (tid - 256)); const int dstride = tid < 256 ? 256 : 32;
#pragma unroll 8
                for (int i = 0; i < nt; ++i) { const float x0 = bf2f(src[(size_t)i * NPB]); const float y = cw0 * x3 + cw1 * x2 + cw2 * x1 + cw3 * x0; x3 = x2; x2 = x1; x1 = x0; dst[i * dstride] = silu_(y); }
            } else if (tid < 352) {
                const int i = tid - 288;
                if (i < nt) { const float pa = bf2f(P[(size_t)(row + i) * NPB + C_A + h]), pb = bf2f(P[(size_t)(row + i) * NPB + C_B + h]);
                    gb_s[2 * i] = expf(nalog * softplus_(pa + dtb)); gb_s[2 * i + 1] = sigm(pb); }
            }
            __syncthreads();
#pragma unroll 1
            for (int ii = 0; ii < 8; ++ii) { const int i = w * 8 + ii;
                if (i < nt) {
#pragma unroll
                    for (int which = 0; which < 2; ++which) { float* rp = qk_s + i * 256 + which * 128; const float a = rp[lane], b = rp[lane + 64];
                        const float sc = __builtin_amdgcn_rsqf(wave_sum(a * a + b * b) + 1e-6f) * (which == 0 ? 0.08838834764831845f : 1.f); rp[lane] = a * sc; rp[lane + 64] = b * sc; } } }
            __syncthreads();
#pragma unroll 1
            for (int i = 0; i < nt; ++i) {
                const f32x4 q0 = *(const f32x4*)(qk_s + i * 256 + kg * 8), q1 = *(const f32x4*)(qk_s + i * 256 + kg * 8 + 4);
                const f32x4 k0 = *(const f32x4*)(qk_s + i * 256 + 128 + kg * 8), k1 = *(const f32x4*)(qk_s + i * 256 + 128 + kg * 8 + 4);
                const float vv = v_s[i * 32 + 4 * w + vl], a = gb_s[2 * i], be = gb_s[2 * i + 1];
                float part = k0[0] * s[0] + k0[1] * s[1] + k0[2] * s[2] + k0[3] * s[3] + k1[0] * s[4] + k1[1] * s[5] + k1[2] * s[6] + k1[3] * s[7];
                const float kS = rowsum16(part);
                const float c = be * (vv - a * kS);
                s[0] = a * s[0] + k0[0] * c; s[1] = a * s[1] + k0[1] * c; s[2] = a * s[2] + k0[2] * c; s[3] = a * s[3] + k0[3] * c;
                s[4] = a * s[4] + k1[0] * c; s[5] = a * s[5] + k1[1] * c; s[6] = a * s[6] + k1[2] * c; s[7] = a * s[7] + k1[3] * c;
                float op = q0[0] * s[0] + q0[1] * s[1] + q0[2] * s[2] + q0[3] * s[3] + q1[0] * s[4] + q1[1] * s[5] + q1[2] * s[6] + q1[3] * s[7];
                const float o = rowsum16(op);
                if (kg == 0) o_s[i * 32 + 4 * w + vl] = o;
            }
            __syncthreads();
            if (wout) { const int i = tid >> 3, c4 = (tid & 7) * 4; if (i < nt) *(f32x4*)(ORAW + (size_t)(row + i) * D + h * 128 + sl * 32 + c4) = *(const f32x4*)(o_s + i * 32 + c4); }
        }
    }
    if (pcol >= 0 && (sl == 0 || tid >= 256)) { halo_out[pcol] = x3; halo_out[3072 + pcol] = x2; halo_out[6144 + pcol] = x1; }
#pragma unroll
    for (int j = 0; j < 8; ++j) sst[(kg * 8 + j) * 33 + 4 * w + vl] = s[j];
    __syncthreads();
    { const int k = tid >> 2, q4 = tid & 3; const float* d = sst + k * 33 + q4 * 8; f32x4* dst = (f32x4*)(s_out + (size_t)k * 128 + sl * 32 + q4 * 8);
      dst[0] = (f32x4){d[0], d[1], d[2], d[3]}; dst[1] = (f32x4){d[4], d[5], d[6], d[7]}; }
    __syncthreads();
}

constexpr int RW_W2 = 20544, RW_A2 = 24640;
__device__ __forceinline__ void rwkv_load_lora(const Params& p, unsigned char* smem, int hb) {
    float* w2_s = (float*)smem + RW_W2; float* a2_s = (float*)smem + RW_A2; const float* pk = (const float*)(p.ws + WS_PK);
    for (int i = otid(); i < 4096; i += 512) { const int l = i >> 6, c = i & 63; w2_s[i] = pk[PK_W2 + l * D + hb * 64 + c]; a2_s[i] = pk[PK_A2 + l * D + hb * 64 + c]; }
    __syncthreads();
}
__device__ __forceinline__ void rwkv_item(const Params& p, unsigned char* smem, const float* s_in, float* s_out, const bf16_t* prev_row, const float* halo_in, float* halo_out,
                                          int hb, int half, int rowA, int nA, int rowB, int nB) {
    const int tid = otid(), w = tid >> 6, lane = tid & 63, row = tid >> 4, kq = tid & 15;
    float* f = (float*)smem;
    float* r_s = f; float* kb_s = f + 2048; float* v_s = f + 4096; float* wd_s = f + 6144; float* ad_s = f + 8192; float* dec_s = f + 10240; float* a_s = f + 12288;
    float* kk_s = f + 14336; float* km_s = f + 16384; float* zb_s = f + 18432; float* y_s = f + 19456; float* bonus_s = f + 20480;
    const float* w2_s = f + RW_W2; const float* a2_s = f + RW_A2;
    const bf16_t* P = (const bf16_t*)(p.ws + WS_P);
    float* YRAW = (float*)(p.ws + WS_YRAW); bf16_t* C0 = (bf16_t*)(p.ws + WS_C0); bf16_t* C1 = (bf16_t*)(p.ws + WS_C1);
    float s[4];
    if (s_in) { const f32x4 t = *(const f32x4*)(s_in + (size_t)(half * 32 + row) * 64 + kq * 4); s[0] = t[0]; s[1] = t[1]; s[2] = t[2]; s[3] = t[3]; }
    else { s[0] = s[1] = s[2] = s[3] = 0.f; }
    int col = -1; float* dst = nullptr; int dstride = 64; bool is_wd = false, owner = false;
    if (tid < 64) { col = hb * 64 + tid; dst = r_s + tid; owner = half == 0; }
    else if (tid < 128) { col = 1024 + hb * 64 + (tid - 64); dst = kb_s + (tid - 64); owner = half == 0; }
    else if (tid < 192) { col = 2048 + hb * 64 + (tid - 128); dst = v_s + (tid - 128); owner = half == 0; }
    else if (tid < 256) { col = 3072 + (tid - 192); dst = wd_s + (tid - 192); is_wd = true; owner = (half == 0 && hb == 0); }
    else if (tid < 320) { col = 3136 + (tid - 256); dst = ad_s + (tid - 256); owner = (half == 0 && hb == 0); }
    else if (tid < 352) { col = 3200 + hb * 64 + half * 32 + (tid - 320); dst = zb_s + (tid - 320); dstride = 32; owner = true; }
    float mu = 0.f, prev = 0.f;
    const float* pk = (const float*)(p.ws + WS_PK);
    if (col >= 0) { mu = pk[PK_MU + col]; prev = prev_row ? bf2f(prev_row[C_RW + col]) : (halo_in ? halo_in[col] : 0.f); }
    const int cc = tid & 63, ig = tid >> 6;
    const int hc = hb * 64 + cc;
    const float w0c = pk[PK_W0 + hc], a0c = pk[PK_A0 + hc], kkc = pk[PK_KK + hc], kac = pk[PK_KA + hc];
    const float rkl = pk[PK_RK + hb * 64 + lane];
#pragma unroll 1
    for (int run = 0; run < 2; ++run) {
        const int rrow = run ? rowB : rowA, rn = run ? nB : nA; const bool wout = run != 0;
#pragma unroll 1
        for (int c0 = 0; c0 < rn; c0 += 32) {
            const int nt = (rn - c0) < 32 ? (rn - c0) : 32; const int row0 = rrow + c0;
            if (col >= 0) {
                const bf16_t* src = P + (size_t)row0 * NPB + C_RW + col;
#pragma unroll 8
                for (int i = 0; i < nt; ++i) { const float cur = bf2f(src[(size_t)i * NPB]); float m = cur + mu * (prev - cur); prev = cur; if (is_wd) m = tanh_(m); dst[i * dstride] = m; }
            }
            __syncthreads();
            {
                float aw[4] = {0.f, 0.f, 0.f, 0.f}, aa[4] = {0.f, 0.f, 0.f, 0.f};
#pragma unroll 4
                for (int l = 0; l < 64; ++l) { const float w2v = w2_s[l * 64 + cc], a2v = a2_s[l * 64 + cc];
#pragma unroll
                    for (int ii = 0; ii < 4; ++ii) { aw[ii] += wd_s[(ig * 4 + ii) * 64 + l] * w2v; aa[ii] += ad_s[(ig * 4 + ii) * 64 + l] * a2v; } }
#pragma unroll
                for (int ii = 0; ii < 4; ++ii) { const int i = ig * 4 + ii;
                    if (i < nt) { const float wraw = w0c + aw[ii]; const float wlog = -0.6065306597126334f * sigm(wraw); const float a = sigm(a0c + aa[ii]);
                        const float kbv = kb_s[i * 64 + cc];
                        dec_s[i * 64 + cc] = expf(wlog); a_s[i * 64 + cc] = a; kk_s[i * 64 + cc] = kbv * kkc; km_s[i * 64 + cc] = kbv * (1.f + (a - 1.f) * kac); } }
            }
            __syncthreads();
#pragma unroll 1
            for (int ii = 0; ii < 4; ++ii) { const int i = w * 4 + ii;
                if (i < nt) { const float kkr = kk_s[i * 64 + lane]; const float kk = kkr * __builtin_amdgcn_rsqf(wave_sum(kkr * kkr) + 1e-6f); kk_s[i * 64 + lane] = kk;
                    const float a = a_s[i * 64 + lane]; a_s[i * 64 + lane] = kk * a;
                    const float rk = wave_sum(r_s[i * 64 + lane] * km_s[i * 64 + lane] * rkl); if (lane == 0) bonus_s[i] = rk; } }
            __syncthreads();
#pragma unroll 1
            for (int i = 0; i < nt; ++i) {
                const f32x4 kk4 = *(const f32x4*)(kk_s + i * 64 + kq * 4), de4 = *(const f32x4*)(dec_s + i * 64 + kq * 4), ka4 = *(const f32x4*)(a_s + i * 64 + kq * 4),
                            km4 = *(const f32x4*)(km_s + i * 64 + kq * 4), r4 = *(const f32x4*)(r_s + i * 64 + kq * 4);
                const float vv = v_s[i * 64 + half * 32 + row];
                const float sa = rowsum16(s[0] * kk4[0] + s[1] * kk4[1] + s[2] * kk4[2] + s[3] * kk4[3]);
#pragma unroll
                for (int j = 0; j < 4; ++j) s[j] = s[j] * de4[j] + (vv * km4[j] - sa * ka4[j]);
                const float y = rowsum16(s[0] * r4[0] + s[1] * r4[1] + s[2] * r4[2] + s[3] * r4[3]);
                if (kq == 0) y_s[i * 32 + row] = y;
            }
            __syncthreads();
            if (wout) { const int i = tid >> 4;
                if (i < nt) {
#pragma unroll
                    for (int q = 0; q < 2; ++q) { const int rr = (tid & 15) * 2 + q, v = half * 32 + rr, colo = hb * 64 + v;
                        const float sz = silu_(zb_s[i * 32 + rr]);
                        const size_t o = (size_t)(row0 + i) * D + colo;
                        YRAW[o] = y_s[i * 32 + rr]; C1[o] = (bf16_t)f2bf(pk[PK_GNW + colo] * sz); C0[o] = (bf16_t)f2bf((pk[PK_GNB + colo] + bonus_s[i] * v_s[i * 64 + v]) * sz); } } }
            __syncthreads();
        }
    }
    *(f32x4*)(s_out + (size_t)(half * 32 + row) * 64 + kq * 4) = (f32x4){s[0], s[1], s[2], s[3]};
    if (col >= 0 && owner && halo_out) halo_out[col] = prev;
}


__device__ __forceinline__ bf16x8 ldfrag(const bf16_t* base, int stride, int r0, int k0, int lane) {
    return *(const bf16x8*)(base + (r0 + (lane & 15)) * stride + k0 + 8 * (lane >> 4));
}
#define MFMA16(a, b, c) __builtin_amdgcn_mfma_f32_16x16x32_bf16((a), (b), (c), 0, 0, 0)
typedef short s16x4 __attribute__((ext_vector_type(4)));
__device__ __forceinline__ bf16x8 ldfrag_tr(const bf16_t* X, int stride, int c0, int k0, int lane) {
    const int l15 = lane & 15;
    const bf16_t* a = X + (k0 + 8 * (lane >> 4) + (l15 >> 2)) * stride + c0 + 4 * (l15 & 3);
    const s16x4 lo = __builtin_amdgcn_ds_read_tr16_b64_v4i16((LAS s16x4*)a), hi = __builtin_amdgcn_ds_read_tr16_b64_v4i16((LAS s16x4*)(a + 4 * stride));
    return __builtin_shufflevector(lo, hi, 0, 1, 2, 3, 4, 5, 6, 7);
}
__device__ __forceinline__ void inv_block(const float* L, float* Tm, float* XS, int tid) {
    const int w = tid >> 6, lane = tid & 63;
    typedef float f32x2v __attribute__((ext_vector_type(2)));
    if (w < 4 && lane < 16) {
        const float* Lb = L + (16 * w) * 64 + 16 * w; float* Tb = Tm + (16 * w) * 64 + 16 * w;
        float tr[16];
#pragma unroll
        for (int i = 0; i < 16; ++i) tr[i] = 0.f;
#pragma unroll
        for (int i = 0; i < 16; ++i) { float a = (lane == i) ? 1.f : 0.f;
#pragma unroll
            for (int j0 = 0; j0 < i; j0 += 4) { const f32x4 l4 = *(const f32x4*)(Lb + i * 64 + j0);
                a -= l4[0] * tr[j0] + l4[1] * tr[j0 + 1] + l4[2] * tr[j0 + 2] + l4[3] * tr[j0 + 3]; }
            tr[i] = a; Tb[i * 64 + lane] = a; }
    }
    for (int e = tid; e < 1536; e += 512) { const int k = e >> 8, r = (e >> 4) & 15, c = e & 15;
        const int rb = k < 3 ? 0 : (k < 5 ? 1 : 2), cb = k < 3 ? k + 1 : (k < 5 ? k - 1 : 3);
        Tm[(16 * rb + r) * 64 + 16 * cb + c] = 0.f; }
    __syncthreads();
    {
        const int B = tid >> 8, i = (tid >> 4) & 15, c = tid & 15, o = 32 * B;
        float x = 0.f;
#pragma unroll
        for (int j0 = 0; j0 < 16; j0 += 4) { const f32x4 l4 = *(const f32x4*)(L + (o + 16 + i) * 64 + o + j0);
            x += l4[0] * Tm[(o + j0) * 64 + o + c] + l4[1] * Tm[(o + j0 + 1) * 64 + o + c] + l4[2] * Tm[(o + j0 + 2) * 64 + o + c] + l4[3] * Tm[(o + j0 + 3) * 64 + o + c]; }
        XS[tid] = x;
        __syncthreads();
        float t = 0.f;
#pragma unroll
        for (int j0 = 0; j0 < 16; j0 += 4) { const f32x4 t4 = *(const f32x4*)(Tm + (o + 16 + i) * 64 + o + 16 + j0);
            t += t4[0] * XS[(B << 8) + j0 * 16 + c] + t4[1] * XS[(B << 8) + (j0 + 1) * 16 + c] + t4[2] * XS[(B << 8) + (j0 + 2) * 16 + c] + t4[3] * XS[(B << 8) + (j0 + 3) * 16 + c]; }
        Tm[(o + 16 + i) * 64 + o + c] = -t;
    }
    __syncthreads();
    {
        const int i = tid >> 4, c2 = (tid & 15) * 2;
        float x0 = 0.f, x1 = 0.f;
#pragma unroll
        for (int j0 = 0; j0 < 32; j0 += 4) { const f32x4 l4 = *(const f32x4*)(L + (32 + i) * 64 + j0);
#pragma unroll
            for (int e = 0; e < 4; ++e) { const f32x2v tv = *(const f32x2v*)(Tm + (j0 + e) * 64 + c2); x0 += l4[e] * tv[0]; x1 += l4[e] * tv[1]; } }
        *(f32x2v*)(XS + i * 32 + c2) = (f32x2v){x0, x1};
        __syncthreads();
        float t0 = 0.f, t1 = 0.f;
#pragma unroll
        for (int j0 = 0; j0 < 32; j0 += 4) { const f32x4 t4 = *(const f32x4*)(Tm + (32 + i) * 64 + 32 + j0);
#pragma unroll
            for (int e = 0; e < 4; ++e) { const f32x2v xv = *(const f32x2v*)(XS + (j0 + e) * 32 + c2); t0 += t4[e] * xv[0]; t1 += t4[e] * xv[1]; } }
        *(f32x2v*)(Tm + (32 + i) * 64 + c2) = (f32x2v){-t0, -t1};
    }
    __syncthreads();
}
constexpr int PL_QS = 0, PL_R1 = 17408, PL_KT = 35840, PL_KTT = 54272, PL_VT = 72704, PL_R3 = 91136, PL_QKM = 109568, PL_TP = 118784, PL_TPP = 128000, PL_SM = 137216, PL_TM = 139264, PL_XS = 155648;
constexpr int QSTR = 136, TSTR = 72;

__device__ __forceinline__ void gdn_prep_item(const Params& p, unsigned char* smem, int h, int row_start, int npad, const bf16_t* hbase,
                                              bf16_t* halo_out, float* conv_out, unsigned char* rec) {
    const int tid = otid(), w = tid >> 6, lane = tid & 63, q4 = lane >> 4, l15 = lane & 15;
    bf16_t* qs = (bf16_t*)(smem + PL_QS); bf16_t* ks = (bf16_t*)(smem + PL_R1); bf16_t* WT = ks; bf16_t* kts = (bf16_t*)(smem + PL_KT);
    bf16_t* vs = (bf16_t*)(smem + PL_VT);         float* Lm = (float*)(smem + PL_R3); bf16_t* UT = (bf16_t*)(smem + PL_R3); bf16_t* QKm = (bf16_t*)(smem + PL_QKM);
    bf16_t* Tp = (bf16_t*)(smem + PL_TP); bf16_t* Tpp = (bf16_t*)(smem + PL_TPP);
    float* sm = (float*)(smem + PL_SM);
    float* gcs = sm; float* bes = sm + 64; float* ssq = sm + 128; float* ssk = sm + 192; float* egs = sm + 256; float* egl_s = sm + 320; float* beg = sm + 384;
    const bf16_t* P = (const bf16_t*)(p.ws + WS_P);
    const float* pk = (const float*)(p.ws + WS_PK);
    if (w == 7) {
        const int i = lane;
        float g = 0.f, be = 0.f;
        if (i >= npad) { const size_t r = (size_t)(row_start + i - npad) * NPB; const float pa = bf2f(P[r + C_A + h]), pb = bf2f(P[r + C_B + h]);
            g = -expf(pk[PK_ALOG + h]) * softplus_(pa + pk[PK_DTB + h]); be = sigm(pb); }
        float x = g;
#pragma unroll
        for (int o = 1; o < 64; o <<= 1) { const float y = __shfl_up(x, o); if (lane >= o) x += y; }
        const float gl = __shfl(x, 63);
        gcs[lane] = x; bes[lane] = be; egs[lane] = __expf(x); egl_s[lane] = __expf(gl - x); beg[lane] = be * __expf(x);
        if (lane == 0) *(float*)(rec + GP_EGL) = __expf(gl);
    }
    __syncthreads();
    if (npad == 0 && tid >= 384) {
#pragma unroll 1
        for (int k = 0; k < 4; ++k) {
            const int slot = (tid - 384) + 128 * k, t = slot >> 3, g = slot & 7;
            const bf16_t* zp = P + (size_t)(row_start + t) * NPB + C_Z + h * 128 + 16 * g;
            const u32x4 z0 = *(const u32x4*)zp, z1 = *(const u32x4*)(zp + 8);
            float za[8], zb[8]; unpack8(z0, za); unpack8(z1, zb);
            const float* nwp = pk + PK_NORMW + 16 * g;
            float ga[8], gb2[8];
#pragma unroll
            for (int e = 0; e < 8; ++e) { ga[e] = nwp[e] * silu_(za[e]); gb2[e] = nwp[8 + e] * silu_(zb[e]); }
            bf16_t* gp = (bf16_t*)(rec + GP_G) + t * 128 + 16 * g;
            *(u32x4*)gp = pack8(ga); *(u32x4*)(gp + 8) = pack8(gb2);
        }
    }
    if (tid < 384) {
        const int sec = tid >> 7, ts = (tid >> 4) & 7, t0 = 8 * ts, d0 = l15 * 8;
        const int pcol = sec * 1024 + h * 128 + d0;
        float cw[4][8];
#pragma unroll
        for (int j = 0; j < 4; ++j) { const f32x4 a = *(const f32x4*)(pk + PK_CONVW + j * 3072 + pcol), b = *(const f32x4*)(pk + PK_CONVW + j * 3072 + pcol + 4);
            cw[j][0] = a[0]; cw[j][1] = a[1]; cw[j][2] = a[2]; cw[j][3] = a[3]; cw[j][4] = b[0]; cw[j][5] = b[1]; cw[j][6] = b[2]; cw[j][7] = b[3]; }
        u32x4 rw[11]; float fv[11];
#pragma unroll
        for (int k = 0; k < 11; ++k) {
            const int ii = t0 - 3 + k;
            const bf16_t* ptr = P + pcol; float f = 0.f;
            if (ii >= npad) { ptr = P + (size_t)(row_start + ii - npad) * NPB + pcol; f = 1.f; }
            else if (ii < 0 && npad == 0 && hbase) { ptr = hbase + (size_t)(ii + 3) * NPB + pcol; f = 1.f; }
            rw[k] = *(const u32x4*)ptr; fv[k] = f;
        }
        if (halo_out && ts == 7) {
#pragma unroll
            for (int dd = 0; dd < 3; ++dd) { *(u32x4*)(halo_out + (size_t)dd * NPB + pcol) = rw[8 + dd];
                if (conv_out) { float x[8]; unpack8(rw[8 + dd], x); *(f32x4*)(conv_out + dd * 3072 + pcol) = (f32x4){x[0], x[1], x[2], x[3]}; *(f32x4*)(conv_out + dd * 3072 + pcol + 4) = (f32x4){x[4], x[5], x[6], x[7]}; } }
        }
        float y[8][8];
#pragma unroll
        for (int t = 0; t < 8; ++t)
#pragma unroll
            for (int e = 0; e < 8; ++e) y[t][e] = 0.f;
#pragma unroll
        for (int k = 0; k < 11; ++k) { float x[8]; unpack8(rw[k], x);
#pragma unroll
            for (int e = 0; e < 8; ++e) x[e] *= fv[k];
#pragma unroll
            for (int dlt = 0; dlt < 4; ++dlt) { const int t = k - dlt;
                if (t >= 0 && t < 8) {
#pragma unroll
                    for (int e = 0; e < 8; ++e) y[t][e] += cw[dlt][e] * x[e]; } }
        }
        const float qsc = sec == 0 ? 0.08838834764831845f : 1.f;
#pragma unroll
        for (int t = 0; t < 8; ++t) {
            const bool tokv = (t0 + t) >= npad;
            float ss = 0.f;
#pragma unroll
            for (int e = 0; e < 8; ++e) { y[t][e] = tokv ? silu_(y[t][e]) : 0.f; ss += y[t][e] * y[t][e]; }
            if (sec < 2) { const float sc = __builtin_amdgcn_rsqf(rowsum16(ss) + 1e-6f) * qsc;
#pragma unroll
                for (int e = 0; e < 8; ++e) y[t][e] *= sc; }
        }
        { bf16_t* dst = sec == 0 ? qs : (sec == 1 ? ks : vs);
#pragma unroll
            for (int t = 0; t < 8; ++t) *(u32x4*)(dst + (t0 + t) * QSTR + d0) = pack8(y[t]); }
        if (sec == 1) {
#pragma unroll
            for (int t = 0; t < 8; ++t) { const float eg = egl_s[t0 + t]; float z[8];
#pragma unroll
                for (int e = 0; e < 8; ++e) z[e] = y[t][e] * eg;
                *(u32x4*)(kts + (t0 + t) * QSTR + d0) = pack8(z); } }
    }
    __syncthreads();
    {
        const int which = w >> 2, it = w & 3;
        const bf16_t* Barr = which ? qs : ks;
        bf16x8 bfr[4];
#pragma unroll
        for (int kk = 0; kk < 4; ++kk) bfr[kk] = ldfrag(Barr, QSTR, 16 * it, 32 * kk, lane);
        const int i = 16 * it + l15; const float gi = gcs[i], bi = bes[i];
#pragma unroll
        for (int jt = 0; jt < 4; ++jt) {
            f32x4 acc = {0.f, 0.f, 0.f, 0.f};
#pragma unroll
            for (int kk = 0; kk < 4; ++kk) acc = MFMA16(ldfrag(ks, QSTR, 16 * jt, 32 * kk, lane), bfr[kk], acc);
            const int j0 = 16 * jt + 4 * q4; const f32x4 gj = *(const f32x4*)(gcs + j0);
            f32x4 o;
#pragma unroll
            for (int r = 0; r < 4; ++r) { const int j = j0 + r; const bool keep = which ? (i >= j) : (i > j); o[r] = keep ? acc[r] * __expf(gi - gj[r]) : 0.f; }
            if (which == 0) *(f32x4*)(Lm + i * 64 + j0) = o * bi;
            else *(u32x2*)(QKm + i * TSTR + j0) = (u32x2){pk2(o[0], o[1]), pk2(o[2], o[3])};
        }
    }
    __syncthreads();
    {
        float* Tm = (float*)(smem + PL_TM);
        inv_block(Lm, Tm, (float*)(smem + PL_XS), tid);
        const int i = tid >> 3, j0 = (tid & 7) * 8;
        float a[8], b2[8];
#pragma unroll
        for (int e = 0; e < 8; ++e) { const float tv = Tm[i * 64 + j0 + e]; a[e] = tv * beg[j0 + e]; b2[e] = tv * bes[j0 + e]; }
        *(u32x4*)(Tp + i * TSTR + j0) = (u32x4){pk2(a[0], a[1]), pk2(a[2], a[3]), pk2(a[4], a[5]), pk2(a[6], a[7])};
        *(u32x4*)(Tpp + i * TSTR + j0) = (u32x4){pk2(b2[0], b2[1]), pk2(b2[2], b2[3]), pk2(b2[4], b2[5]), pk2(b2[6], b2[7])};
    }
    __syncthreads();
    {
        const int it = w & 3, half = w >> 2;
        f32x4 aw[4], au[4];
#pragma unroll
        for (int x = 0; x < 4; ++x) { aw[x] = (f32x4){0.f, 0.f, 0.f, 0.f}; au[x] = (f32x4){0.f, 0.f, 0.f, 0.f}; }
#pragma unroll
        for (int kk = 0; kk < 2; ++kk) {
            const bf16x8 a1 = ldfrag(Tp, TSTR, 16 * it, 32 * kk, lane), a2 = ldfrag(Tpp, TSTR, 16 * it, 32 * kk, lane);
#pragma unroll
            for (int x = 0; x < 4; ++x) { const int dt = half * 4 + x;
                aw[x] = MFMA16(a1, ldfrag_tr(ks, QSTR, 16 * dt, 32 * kk, lane), aw[x]);
                au[x] = MFMA16(a2, ldfrag_tr(vs, QSTR, 16 * dt, 32 * kk, lane), au[x]); }
        }
        __syncthreads();
#pragma unroll
        for (int x = 0; x < 4; ++x) { const int d = 16 * (half * 4 + x) + l15, i0 = 16 * it + 4 * q4;
            *(u32x2*)(WT + d * TSTR + i0) = (u32x2){pk2(aw[x][0], aw[x][1]), pk2(aw[x][2], aw[x][3])};
            *(u32x2*)(UT + d * TSTR + i0) = (u32x2){pk2(au[x][0], au[x][1]), pk2(au[x][2], au[x][3])}; }
    }
    __syncthreads();
    {
        bf16_t* gAP = (bf16_t*)(rec + GP_AP); bf16_t* gQH = (bf16_t*)(rec + GP_QH); bf16_t* gKH = (bf16_t*)(rec + GP_KH); bf16_t* gOH = (bf16_t*)(rec + GP_OH);
        {
            const int et = w;
            const bf16x8 a0 = ldfrag(WT, TSTR, 16 * et, 0, lane), a1 = ldfrag(WT, TSTR, 16 * et, 32, lane);
#pragma unroll
            for (int dt = 0; dt < 8; ++dt) { f32x4 acc = {0.f, 0.f, 0.f, 0.f};
                acc = MFMA16(a0, ldfrag_tr(kts, QSTR, 16 * dt, 0, lane), acc); acc = MFMA16(a1, ldfrag_tr(kts, QSTR, 16 * dt, 32, lane), acc);
                *(u32x2*)(gAP + ((size_t)(dt * 4 + (et >> 1)) * 64 + lane) * 8 + (et & 1) * 4) = (u32x2){pk2(-acc[0], -acc[1]), pk2(-acc[2], -acc[3])}; }
#pragma unroll
            for (int tt = 0; tt < 4; ++tt) { f32x4 acc = {0.f, 0.f, 0.f, 0.f};
                acc = MFMA16(a0, ldfrag(QKm, TSTR, 16 * tt, 0, lane), acc); acc = MFMA16(a1, ldfrag(QKm, TSTR, 16 * tt, 32, lane), acc);
                const int t = 16 * tt + l15, e0 = 16 * et + 4 * q4; const float eg = egs[t];
                const u32x2 qq = *(const u32x2*)(qs + t * QSTR + e0);
                const float o0 = __uint_as_float(qq.x << 16) * eg - acc[0], o1 = __uint_as_float(qq.x & 0xffff0000u) * eg - acc[1],
                            o2 = __uint_as_float(qq.y << 16) * eg - acc[2], o3 = __uint_as_float(qq.y & 0xffff0000u) * eg - acc[3];
                *(u32x2*)(gQH + ((size_t)(tt * 4 + (et >> 1)) * 64 + lane) * 8 + (et & 1) * 4) = (u32x2){pk2(o0, o1), pk2(o2, o3)}; }
        }
        {
            const int dt = w;
            const bf16x8 a0 = ldfrag_tr(kts, QSTR, 16 * dt, 0, lane), a1 = ldfrag_tr(kts, QSTR, 16 * dt, 32, lane);
#pragma unroll
            for (int vt = 0; vt < 8; ++vt) { f32x4 acc = {0.f, 0.f, 0.f, 0.f};
                acc = MFMA16(a0, ldfrag(UT, TSTR, 16 * vt, 0, lane), acc); acc = MFMA16(a1, ldfrag(UT, TSTR, 16 * vt, 32, lane), acc);
                *(u32x2*)(gKH + ((size_t)(vt * 8 + dt) * 64 + lane) * 4) = (u32x2){pk2(acc[0], acc[1]), pk2(acc[2], acc[3])}; }
            const int tt = w & 3, vh = w >> 2;
            const bf16x8 b0 = ldfrag(QKm, TSTR, 16 * tt, 0, lane), b1 = ldfrag(QKm, TSTR, 16 * tt, 32, lane);
#pragma unroll
            for (int x = 0; x < 4; ++x) { const int vt = vh * 4 + x; f32x4 acc = {0.f, 0.f, 0.f, 0.f};
                acc = MFMA16(b0, ldfrag(UT, TSTR, 16 * vt, 0, lane), acc); acc = MFMA16(b1, ldfrag(UT, TSTR, 16 * vt, 32, lane), acc);
                *(u32x2*)(gOH + ((size_t)(vt * 4 + tt) * 64 + lane) * 4) = (u32x2){pk2(acc[0], acc[1]), pk2(acc[2], acc[3])}; }
        }
    }
    __syncthreads();
}

__device__ __forceinline__ void phase_gprep(const Params& p, int seg, unsigned char* smem) {
    const int blk = obid();
    const int n_items = (CPS + (seg == 0 ? 1 : 0)) * 64;
#pragma unroll 1
    for (int it = blk; it < n_items; it += gridDim.x) {
        const int bh = it & 63, b = bh >> 3, h = bh & 7; int cl = it >> 6; if (seg != 0) cl += 1;
        unsigned char* rec = p.ws + WS_GP + (size_t)(cl * 64 + bh) * GP_STRIDE;
        const bf16_t* Pb = (const bf16_t*)(p.ws + WS_P);
        bf16_t* chalo2 = (bf16_t*)(p.ws + WS_CHALO);
        if (cl == 0) gdn_prep_item(p, smem, h, LEX0, 48, nullptr, nullptr, nullptr, rec);
        else {
            const int row = b * SEGTOK + (cl - 1) * 64;
            const bf16_t* hbase = Pb + (size_t)(row - 3) * NPB;
            if (cl == 1) hbase = (seg == 0) ? Pb + (size_t)(LEX0 + NMETA - 3) * NPB : chalo2 + (size_t)(((seg - 1) & 1) * NBATCH + b) * 3 * NPB;
            bf16_t* ho = (cl == CPS) ? chalo2 + (size_t)((seg & 1) * NBATCH + b) * 3 * NPB : nullptr;
            float* co = (cl == CPS && seg == NSEG - 1) ? p.out + O_CONV_P + (size_t)b * 9216 : nullptr;
            gdn_prep_item(p, smem, h, row, 0, hbase, ho, co, rec);
        }
    }
}

__device__ __forceinline__ void gdn_scan_block(const Params& p, int seg, unsigned char* smem, int bh) {
    const int tid = otid(), w = tid >> 6, lane = tid & 63, q4 = lane >> 4, l15 = lane & 15;
    const int b = bh >> 3, h = bh & 7;
    float* st = p.out + O_GDN_P + (size_t)bh * 16384;
    f32x4 S[8];
    if (seg) {
#pragma unroll
        for (int mt = 0; mt < 8; ++mt)
#pragma unroll
            for (int r = 0; r < 4; ++r) S[mt][r] = st[(size_t)(16 * mt + 4 * q4 + r) * 128 + 16 * w + l15];
    } else {
#pragma unroll
        for (int mt = 0; mt < 8; ++mt) S[mt] = (f32x4){0.f, 0.f, 0.f, 0.f};
    }
    const int c_lo = seg ? 1 : 0;
    float* obuf = (float*)(smem + 98304);
    {
        const u32x4* src = (const u32x4*)(p.ws + WS_GP + (size_t)(c_lo * 64 + bh) * GP_STRIDE); u32x4* dst = (u32x4*)smem;
#pragma unroll
        for (int x = 0; x < 6; ++x) dst[tid + 512 * x] = src[tid + 512 * x];
    }
#pragma unroll 1
    for (int cl = c_lo; cl <= CPS; ++cl) {
        const unsigned char* rec = p.ws + WS_GP + (size_t)(cl * 64 + bh) * GP_STRIDE;
        const int cur = (cl - c_lo) & 1;
        __syncthreads();
        u32x4 nx[6];
        const bool more = cl < CPS;
        if (more) { const u32x4* src = (const u32x4*)(rec + GP_STRIDE * 64);
#pragma unroll
            for (int x = 0; x < 6; ++x) nx[x] = src[tid + 512 * x]; }
        const bf16_t* gKH = (const bf16_t*)(rec + GP_KH); const bf16_t* gOH = (const bf16_t*)(rec + GP_OH);
        u32x2 kh[8], oh[4];
#pragma unroll
        for (int mt = 0; mt < 8; ++mt) kh[mt] = *(const u32x2*)(gKH + ((size_t)(w * 8 + mt) * 64 + lane) * 4);
#pragma unroll
        for (int tt = 0; tt < 4; ++tt) oh[tt] = *(const u32x2*)(gOH + ((size_t)(w * 4 + tt) * 64 + lane) * 4);
        const float egl = *(const float*)(rec + GP_EGL);
        const int et = tid >> 3, eg = tid & 7;
        const bf16_t* gp = (const bf16_t*)(rec + GP_G) + et * 128 + 16 * eg;
        u32x4 z0 = {0u, 0u, 0u, 0u}, z1 = {0u, 0u, 0u, 0u};
        if (cl > 0) { z0 = *(const u32x4*)gp; z1 = *(const u32x4*)(gp + 8); }
        bf16x8 Bf[4];
#pragma unroll
        for (int ks = 0; ks < 4; ++ks) { u32x4 t; t.x = pk2(S[2 * ks][0], S[2 * ks][1]); t.y = pk2(S[2 * ks][2], S[2 * ks][3]); t.z = pk2(S[2 * ks + 1][0], S[2 * ks + 1][1]); t.w = pk2(S[2 * ks + 1][2], S[2 * ks + 1][3]);
            Bf[ks] = __builtin_bit_cast(bf16x8, t); }
        const bf16x8* AP = (const bf16x8*)(smem + cur * 49152); const bf16x8* QH = (const bf16x8*)(smem + cur * 49152 + GP_QH);
        f32x4 o[4], tS[8];
#pragma unroll
        for (int tt = 0; tt < 4; ++tt) { o[tt] = (f32x4){0.f, 0.f, 0.f, 0.f};
#pragma unroll
            for (int ks = 0; ks < 4; ++ks) o[tt] = MFMA16(QH[(tt * 4 + ks) * 64 + lane], Bf[ks], o[tt]); }
#pragma unroll
        for (int mt = 0; mt < 8; ++mt) { tS[mt] = (f32x4){0.f, 0.f, 0.f, 0.f};
#pragma unroll
            for (int ks = 0; ks < 4; ++ks) tS[mt] = MFMA16(AP[(mt * 4 + ks) * 64 + lane], Bf[ks], tS[mt]); }
#pragma unroll
        for (int mt = 0; mt < 8; ++mt) {
            S[mt][0] = egl * S[mt][0] + tS[mt][0] + __uint_as_float(kh[mt].x << 16); S[mt][1] = egl * S[mt][1] + tS[mt][1] + __uint_as_float(kh[mt].x & 0xffff0000u);
            S[mt][2] = egl * S[mt][2] + tS[mt][2] + __uint_as_float(kh[mt].y << 16); S[mt][3] = egl * S[mt][3] + tS[mt][3] + __uint_as_float(kh[mt].y & 0xffff0000u); }
        if (cl > 0) {
#pragma unroll
            for (int tt = 0; tt < 4; ++tt) {
                o[tt][0] += __uint_as_float(oh[tt].x << 16); o[tt][1] += __uint_as_float(oh[tt].x & 0xffff0000u); o[tt][2] += __uint_as_float(oh[tt].y << 16); o[tt][3] += __uint_as_float(oh[tt].y & 0xffff0000u);
#pragma unroll
                for (int r = 0; r < 4; ++r) obuf[(16 * tt + 4 * q4 + r) * 132 + 16 * w + l15] = o[tt][r]; }
        }
        if (more) { u32x4* dst = (u32x4*)(smem + (cur ^ 1) * 49152);
#pragma unroll
            for (int x = 0; x < 6; ++x) dst[tid + 512 * x] = nx[x]; }
        if (cl > 0) {
            __syncthreads();
            f32x4 ov[4]; float ss = 0.f;
#pragma unroll
            for (int j = 0; j < 4; ++j) { ov[j] = *(const f32x4*)(obuf + et * 132 + 16 * eg + 4 * j); ss += ov[j][0] * ov[j][0] + ov[j][1] * ov[j][1] + ov[j][2] * ov[j][2] + ov[j][3] * ov[j][3]; }
            ss += __shfl_xor(ss, 1); ss += __shfl_xor(ss, 2); ss += __shfl_xor(ss, 4);
            const float rs = __builtin_amdgcn_rsqf(ss * (1.f / 128.f) + 1e-6f);
            const unsigned zz[8] = {z0.x, z0.y, z0.z, z0.w, z1.x, z1.y, z1.z, z1.w};
            unsigned ow[8];
#pragma unroll
            for (int j = 0; j < 8; ++j) ow[j] = pk2(ov[j >> 1][(j & 1) * 2] * rs * __uint_as_float(zz[j] << 16), ov[j >> 1][(j & 1) * 2 + 1] * rs * __uint_as_float(zz[j] & 0xffff0000u));
            const size_t grow = (size_t)b * SEQ + seg * SEGTOK + (cl - 1) * 64 + et;
            bf16_t* oa = (bf16_t*)(p.ws + WS_H) + grow * D + h * 128 + 16 * eg;
            *(u32x4*)oa = (u32x4){ow[0], ow[1], ow[2], ow[3]}; *(u32x4*)(oa + 8) = (u32x4){ow[4], ow[5], ow[6], ow[7]};
        }
    }
#pragma unroll
    for (int mt = 0; mt < 8; ++mt)
#pragma unroll
        for (int r = 0; r < 4; ++r) st[(size_t)(16 * mt + 4 * q4 + r) * 128 + 16 * w + l15] = S[mt][r];
    __syncthreads();
}

constexpr int RL_AT = 0, RL_BT = 9216, RL_KT = 18432, RL_ATT = 27648, RL_RT = 36864, RL_BTLT = 46080, RL_KTLT = 55296, RL_VT = 64512, RL_LAK = 73728, RL_MRB = 82944, RL_MRK = 92160,
              RL_LM = 101376, RL_AF = 117760, RL_TM = 134144, RL_XS = 150528;
__device__ __forceinline__ void rwkv_prep_item(const Params& p, unsigned char* smem, int hb, int row_start, int npad, const bf16_t* prev_row,
                                               bf16_t* halo_out, unsigned char* rec) {
    const int tid = otid(), w = tid >> 6, lane = tid & 63, q4 = lane >> 4, l15 = lane & 15;
    bf16_t* At = (bf16_t*)(smem + RL_AT); bf16_t* Tb = At; bf16_t* Bt = (bf16_t*)(smem + RL_BT); bf16_t* WaT = Bt; bf16_t* Kt = (bf16_t*)(smem + RL_KT); bf16_t* XT = Kt;
    bf16_t* At2 = (bf16_t*)(smem + RL_ATT); bf16_t* Rt = (bf16_t*)(smem + RL_RT); bf16_t* Btl = (bf16_t*)(smem + RL_BTLT); bf16_t* Ktl = (bf16_t*)(smem + RL_KTLT);
    bf16_t* Vr = (bf16_t*)(smem + RL_VT);        bf16_t* Lak = (bf16_t*)(smem + RL_LAK); bf16_t* Mrb = (bf16_t*)(smem + RL_MRB); bf16_t* Mrk = (bf16_t*)(smem + RL_MRK);
    float* Lm = (float*)(smem + RL_LM);
    bf16_t* thw = Lak; bf16_t* adb = Mrb; float* lc = Lm; float* af = (float*)(smem + RL_AF);
    const bf16_t* P = (const bf16_t*)(p.ws + WS_P);
    const float* pk = (const float*)(p.ws + WS_PK);
    const int t = tid >> 3, g = tid & 7;
    float rr[8], kb[8], vv[8], zb[8];
    {
        const bool real = t >= npad;
        const bf16_t* curp = P; const bf16_t* prevp = P; float fprev = 0.f;
        if (real) { curp = P + (size_t)(row_start + t - npad) * NPB; if (t > npad) { prevp = curp - NPB; fprev = 1.f; } else if (prev_row) { prevp = prev_row; fprev = 1.f; } }
        const int secbase[6] = {0, 1024, 2048, 3200, 3072, 3136};
        u32x4 rc[6], rp[6];
#pragma unroll
        for (int sidx = 0; sidx < 6; ++sidx) { const int col = secbase[sidx] + (sidx < 4 ? hb * 64 : 0) + g * 8; rc[sidx] = *(const u32x4*)(curp + C_RW + col); rp[sidx] = *(const u32x4*)(prevp + C_RW + col); }
        float m[6][8];
#pragma unroll
        for (int sidx = 0; sidx < 6; ++sidx) {
            const int col = secbase[sidx] + (sidx < 4 ? hb * 64 : 0) + g * 8;
            float cur[8], prv[8];
            unpack8(rc[sidx], cur); unpack8(rp[sidx], prv);
            const f32x4 mu0 = *(const f32x4*)(pk + PK_MU + col), mu1 = *(const f32x4*)(pk + PK_MU + col + 4);
            const float mu[8] = {mu0[0], mu0[1], mu0[2], mu0[3], mu1[0], mu1[1], mu1[2], mu1[3]};
#pragma unroll
            for (int e = 0; e < 8; ++e) m[sidx][e] = real ? cur[e] + mu[e] * (fprev * prv[e] - cur[e]) : 0.f;
            if (halo_out && t == 63 && (sidx < 4 || hb == 0)) *(u32x4*)(halo_out + C_RW + col) = rc[sidx];
        }
#pragma unroll
        for (int e = 0; e < 8; ++e) { rr[e] = m[0][e]; kb[e] = m[1][e]; vv[e] = m[2][e]; zb[e] = m[3][e]; }
        float th[8];
#pragma unroll
        for (int e = 0; e < 8; ++e) th[e] = tanh_(m[4][e]);
        *(u32x4*)(thw + t * TSTR + g * 8) = pack8(th);
        *(u32x4*)(adb + t * TSTR + g * 8) = pack8(m[5]);
    }
    __syncthreads();
    {
        const int which = w >> 2, ct = w & 3;
        const bf16_t* Wt = (const bf16_t*)(p.ws + (which ? WS_A2T : WS_W2T)) + (size_t)hb * 4096;
        const bf16x8 b0 = *(const bf16x8*)(Wt + (16 * ct + l15) * 64 + 8 * q4), b1 = *(const bf16x8*)(Wt + (16 * ct + l15) * 64 + 32 + 8 * q4);
        const bf16_t* Aarr = which ? adb : thw;
        const int c = 16 * ct + l15;
        const float bias = pk[(which ? PK_A0 : PK_W0) + hb * 64 + c];
        float carry = 0.f;
#pragma unroll
        for (int tt = 0; tt < 4; ++tt) {
            f32x4 acc = {0.f, 0.f, 0.f, 0.f};
            acc = MFMA16(ldfrag(Aarr, TSTR, 16 * tt, 0, lane), b0, acc); acc = MFMA16(ldfrag(Aarr, TSTR, 16 * tt, 32, lane), b1, acc);
            if (which) {
#pragma unroll
                for (int r = 0; r < 4; ++r) af[(16 * tt + 4 * q4 + r) * 64 + c] = sigm(bias + acc[r]);
            } else {
                float wl[4];
#pragma unroll
                for (int r = 0; r < 4; ++r) { const int tk = 16 * tt + 4 * q4 + r; wl[r] = (tk < npad) ? 0.f : -0.6065306597126334f * sigm(bias + acc[r]); }
                wl[1] += wl[0]; wl[2] += wl[1]; wl[3] += wl[2];
                const float Q = wl[3];
                const float Q0 = __shfl(Q, l15), Q1 = __shfl(Q, l15 + 16), Q2 = __shfl(Q, l15 + 32), Q3 = __shfl(Q, l15 + 48);
                const float ex = carry + (q4 > 0 ? Q0 : 0.f) + (q4 > 1 ? Q1 : 0.f) + (q4 > 2 ? Q2 : 0.f);
#pragma unroll
                for (int r = 0; r < 4; ++r) lc[(16 * tt + 4 * q4 + r) * 64 + c] = ex + wl[r];
                carry += Q0 + Q1 + Q2 + Q3;
            }
        }
    }
    __syncthreads();
    {
        float lct[8], lcp[8], lcC[8], av[8];
        { const f32x4 a = *(const f32x4*)(lc + t * 64 + g * 8), b2 = *(const f32x4*)(lc + t * 64 + g * 8 + 4); lct[0] = a[0]; lct[1] = a[1]; lct[2] = a[2]; lct[3] = a[3]; lct[4] = b2[0]; lct[5] = b2[1]; lct[6] = b2[2]; lct[7] = b2[3]; }
        if (t > 0) { const f32x4 a = *(const f32x4*)(lc + (t - 1) * 64 + g * 8), b2 = *(const f32x4*)(lc + (t - 1) * 64 + g * 8 + 4); lcp[0] = a[0]; lcp[1] = a[1]; lcp[2] = a[2]; lcp[3] = a[3]; lcp[4] = b2[0]; lcp[5] = b2[1]; lcp[6] = b2[2]; lcp[7] = b2[3]; }
        else {
#pragma unroll
            for (int e = 0; e < 8; ++e) lcp[e] = 0.f; }
        { const f32x4 a = *(const f32x4*)(lc + 63 * 64 + g * 8), b2 = *(const f32x4*)(lc + 63 * 64 + g * 8 + 4); lcC[0] = a[0]; lcC[1] = a[1]; lcC[2] = a[2]; lcC[3] = a[3]; lcC[4] = b2[0]; lcC[5] = b2[1]; lcC[6] = b2[2]; lcC[7] = b2[3]; }
        { const f32x4 a = *(const f32x4*)(af + t * 64 + g * 8), b2 = *(const f32x4*)(af + t * 64 + g * 8 + 4); av[0] = a[0]; av[1] = a[1]; av[2] = a[2]; av[3] = a[3]; av[4] = b2[0]; av[5] = b2[1]; av[6] = b2[2]; av[7] = b2[3]; }
        const int hc = hb * 64 + g * 8;
        float kk[8], km[8], ss = 0.f, rk = 0.f;
        float pkk[8], pka[8], prk[8];
        { const f32x4 a0 = *(const f32x4*)(pk + PK_KK + hc), a1 = *(const f32x4*)(pk + PK_KK + hc + 4), b0 = *(const f32x4*)(pk + PK_KA + hc), b1 = *(const f32x4*)(pk + PK_KA + hc + 4), c0v = *(const f32x4*)(pk + PK_RK + hc), c1v = *(const f32x4*)(pk + PK_RK + hc + 4);
#pragma unroll
          for (int e = 0; e < 4; ++e) { pkk[e] = a0[e]; pkk[4 + e] = a1[e]; pka[e] = b0[e]; pka[4 + e] = b1[e]; prk[e] = c0v[e]; prk[4 + e] = c1v[e]; } }
#pragma unroll
        for (int e = 0; e < 8; ++e) { kk[e] = kb[e] * pkk[e]; ss += kk[e] * kk[e]; km[e] = kb[e] * (1.f + (av[e] - 1.f) * pka[e]); rk += rr[e] * km[e] * prk[e]; }
        ss += __shfl_xor(ss, 1); ss += __shfl_xor(ss, 2); ss += __shfl_xor(ss, 4);
        rk += __shfl_xor(rk, 1); rk += __shfl_xor(rk, 2); rk += __shfl_xor(rk, 4);
        const float kn = __builtin_amdgcn_rsqf(ss + 1e-6f);
        float xa[8], xb[8], xk[8], xr[8], xbt[8], xkt[8];
#pragma unroll
        for (int e = 0; e < 8; ++e) { kk[e] *= kn; const float ka = kk[e] * av[e]; const float ip = __expf(-lct[e]), tl = __expf(lcC[e] - lct[e]);
            xa[e] = kk[e] * __expf(lcp[e]); xb[e] = ka * ip; xk[e] = km[e] * ip; xr[e] = rr[e] * __expf(lct[e]); xbt[e] = ka * tl; xkt[e] = km[e] * tl; }
        *(u32x4*)(At + t * TSTR + g * 8) = pack8(xa); *(u32x4*)(Bt + t * TSTR + g * 8) = pack8(xb); *(u32x4*)(Kt + t * TSTR + g * 8) = pack8(xk); *(u32x4*)(Rt + t * TSTR + g * 8) = pack8(xr);
        *(u32x4*)(At2 + t * TSTR + g * 8) = pack8(xa); *(u32x4*)(Btl + t * TSTR + g * 8) = pack8(xbt); *(u32x4*)(Ktl + t * TSTR + g * 8) = pack8(xkt); *(u32x4*)(Vr + t * TSTR + g * 8) = pack8(vv);
        float c1[8], c0[8];
#pragma unroll
        for (int e = 0; e < 8; ++e) { c1[e] = 0.f; c0[e] = 0.f; }
        { const f32x4 g0 = *(const f32x4*)(pk + PK_GNW + hc), g1 = *(const f32x4*)(pk + PK_GNW + hc + 4), h0 = *(const f32x4*)(pk + PK_GNB + hc), h1 = *(const f32x4*)(pk + PK_GNB + hc + 4);
#pragma unroll
          for (int e = 0; e < 4; ++e) { const float sz0 = silu_(zb[e]), sz1 = silu_(zb[4 + e]); c1[e] = g0[e] * sz0; c1[4 + e] = g1[e] * sz1; c0[e] = (h0[e] + rk * vv[e]) * sz0; c0[4 + e] = (h1[e] + rk * vv[4 + e]) * sz1; } }
        *(u32x4*)((bf16_t*)(rec + RP_C1) + t * 64 + g * 8) = pack8(c1); *(u32x4*)((bf16_t*)(rec + RP_C0) + t * 64 + g * 8) = pack8(c0);
        if (t == 63) { float* pc = (float*)(rec + RP_PC) + g * 8; *(f32x4*)pc = (f32x4){__expf(lcC[0]), __expf(lcC[1]), __expf(lcC[2]), __expf(lcC[3])}; *(f32x4*)(pc + 4) = (f32x4){__expf(lcC[4]), __expf(lcC[5]), __expf(lcC[6]), __expf(lcC[7])}; }
    }
    __syncthreads();
    {
        const int pr = w >> 1;
        const bf16_t* Aarr = pr < 2 ? At : Rt; const bf16_t* Barr = (pr & 1) ? Kt : Bt;
#pragma unroll
        for (int x = 0; x < 2; ++x) { const int tt = 2 * (w & 1) + x;
            const bf16x8 a0 = ldfrag(Aarr, TSTR, 16 * tt, 0, lane), a1 = ldfrag(Aarr, TSTR, 16 * tt, 32, lane);
            const int tk = 16 * tt + l15;
#pragma unroll
            for (int it = 0; it < 4; ++it) { f32x4 acc = {0.f, 0.f, 0.f, 0.f};
                acc = MFMA16(ldfrag(Barr, TSTR, 16 * it, 0, lane), a0, acc); acc = MFMA16(ldfrag(Barr, TSTR, 16 * it, 32, lane), a1, acc);
                const int i0 = 16 * it + 4 * q4;
                f32x4 o;
#pragma unroll
                for (int r = 0; r < 4; ++r) { const int i = i0 + r; const bool keep = pr < 2 ? (tk > i) : (tk >= i); o[r] = keep ? acc[r] : 0.f; }
                if (pr == 0) *(f32x4*)(Lm + tk * 64 + i0) = o;
                else { bf16_t* Out = pr == 1 ? Lak : (pr == 2 ? Mrb : Mrk); *(u32x2*)(Out + tk * TSTR + i0) = (u32x2){pk2(o[0], o[1]), pk2(o[2], o[3])}; } }
        }
    }
    __syncthreads();
    {
        float* Tm = (float*)(smem + RL_TM);
        inv_block(Lm, Tm, (float*)(smem + RL_XS), tid);
        const int i = tid >> 3, j0 = (tid & 7) * 8;
        float a[8];
#pragma unroll
        for (int e = 0; e < 8; ++e) a[e] = Tm[i * 64 + j0 + e];
        *(u32x4*)(Tb + i * TSTR + j0) = pack8(a);
    }
    __syncthreads();
    {
        const int tt = w & 3, which = w >> 2;
        const bf16_t* Aarr = which ? Lak : Tb; const bf16_t* Barr = which ? Vr : At2; bf16_t* Out = which ? XT : WaT;
        const bf16x8 a0 = ldfrag(Aarr, TSTR, 16 * tt, 0, lane), a1 = ldfrag(Aarr, TSTR, 16 * tt, 32, lane);
#pragma unroll
        for (int ct = 0; ct < 4; ++ct) { f32x4 acc = {0.f, 0.f, 0.f, 0.f};
            acc = MFMA16(a0, ldfrag_tr(Barr, TSTR, 16 * ct, 0, lane), acc); acc = MFMA16(a1, ldfrag_tr(Barr, TSTR, 16 * ct, 32, lane), acc);
            *(u32x2*)(Out + (16 * ct + l15) * TSTR + 16 * tt + 4 * q4) = (u32x2){pk2(acc[0], acc[1]), pk2(acc[2], acc[3])}; }
    }
    __syncthreads();
    {
        f32x4 acc[4];
        if (w < 4) {
            const bf16x8 a0 = ldfrag(Tb, TSTR, 16 * w, 0, lane), a1 = ldfrag(Tb, TSTR, 16 * w, 32, lane);
#pragma unroll
            for (int ct = 0; ct < 4; ++ct) { acc[ct] = (f32x4){0.f, 0.f, 0.f, 0.f};
                acc[ct] = MFMA16(a0, ldfrag(XT, TSTR, 16 * ct, 0, lane), acc[ct]); acc[ct] = MFMA16(a1, ldfrag(XT, TSTR, 16 * ct, 32, lane), acc[ct]); }
        }
        __syncthreads();
        if (w < 4) {
#pragma unroll
            for (int ct = 0; ct < 4; ++ct) *(u32x2*)(XT + (16 * ct + l15) * TSTR + 16 * w + 4 * q4) = (u32x2){pk2(-acc[ct][0], -acc[ct][1]), pk2(-acc[ct][2], -acc[ct][3])};
        }
    }
    __syncthreads();
    {
        const bf16_t* UvT = XT;
        bf16_t* gAP = (bf16_t*)(rec + RP_AP); bf16_t* gRH = (bf16_t*)(rec + RP_RH); bf16_t* gKH = (bf16_t*)(rec + RP_KH); bf16_t* gYH = (bf16_t*)(rec + RP_YH);
        const int et = w & 3, part = w >> 2;
        {
            const bf16x8 a0 = ldfrag(WaT, TSTR, 16 * et, 0, lane), a1 = ldfrag(WaT, TSTR, 16 * et, 32, lane);
            if (part == 0) {
#pragma unroll
                for (int kt = 0; kt < 4; ++kt) { f32x4 acc = {0.f, 0.f, 0.f, 0.f};
                    acc = MFMA16(a0, ldfrag_tr(Btl, TSTR, 16 * kt, 0, lane), acc); acc = MFMA16(a1, ldfrag_tr(Btl, TSTR, 16 * kt, 32, lane), acc);
                    *(u32x2*)(gAP + ((size_t)(kt * 2 + (et >> 1)) * 64 + lane) * 8 + (et & 1) * 4) = (u32x2){pk2(-acc[0], -acc[1]), pk2(-acc[2], -acc[3])}; }
            } else {
#pragma unroll
                for (int tt = 0; tt < 4; ++tt) { f32x4 acc = {0.f, 0.f, 0.f, 0.f};
                    acc = MFMA16(a0, ldfrag(Mrb, TSTR, 16 * tt, 0, lane), acc); acc = MFMA16(a1, ldfrag(Mrb, TSTR, 16 * tt, 32, lane), acc);
                    const int tk = 16 * tt + l15, e0 = 16 * et + 4 * q4;
                    const u32x2 q2 = *(const u32x2*)(Rt + tk * TSTR + e0);
                    const float o0 = __uint_as_float(q2.x << 16) - acc[0], o1 = __uint_as_float(q2.x & 0xffff0000u) - acc[1], o2 = __uint_as_float(q2.y << 16) - acc[2], o3 = __uint_as_float(q2.y & 0xffff0000u) - acc[3];
                    *(u32x2*)(gRH + ((size_t)(tt * 2 + (et >> 1)) * 64 + lane) * 8 + (et & 1) * 4) = (u32x2){pk2(o0, o1), pk2(o2, o3)}; }
            }
        }
        {
            const int rt = w & 3;
            bf16_t* Out = part ? gKH : gYH;
            bf16x8 a0, a1, a2, a3;
            if (part) { a0 = ldfrag_tr(Btl, TSTR, 16 * rt, 0, lane); a1 = ldfrag_tr(Btl, TSTR, 16 * rt, 32, lane); a2 = ldfrag_tr(Ktl, TSTR, 16 * rt, 0, lane); a3 = ldfrag_tr(Ktl, TSTR, 16 * rt, 32, lane); }
            else { a0 = ldfrag(Mrb, TSTR, 16 * rt, 0, lane); a1 = ldfrag(Mrb, TSTR, 16 * rt, 32, lane); a2 = ldfrag(Mrk, TSTR, 16 * rt, 0, lane); a3 = ldfrag(Mrk, TSTR, 16 * rt, 32, lane); }
#pragma unroll
            for (int vt = 0; vt < 4; ++vt) { f32x4 acc = {0.f, 0.f, 0.f, 0.f};
                acc = MFMA16(a0, ldfrag(UvT, TSTR, 16 * vt, 0, lane), acc); acc = MFMA16(a1, ldfrag(UvT, TSTR, 16 * vt, 32, lane), acc);
                acc = MFMA16(a2, ldfrag_tr(Vr, TSTR, 16 * vt, 0, lane), acc); acc = MFMA16(a3, ldfrag_tr(Vr, TSTR, 16 * vt, 32, lane), acc);
                *(u32x2*)(Out + ((size_t)(vt * 4 + rt) * 64 + lane) * 4) = (u32x2){pk2(acc[0], acc[1]), pk2(acc[2], acc[3])}; }
        }
    }
    __syncthreads();
}

__device__ __forceinline__ void phase_rprep(const Params& p, int seg, unsigned char* smem) {
    const int blk = obid();
    const int n_items = (CPS + (seg == 0 ? 1 : 0)) * 128;
#pragma unroll 1
    for (int it = (blk + (gridDim.x >> 1)) % gridDim.x; it < n_items; it += gridDim.x) {
        const int bh = it & 127, b = bh >> 4, hb = bh & 15; int cl = it >> 7; if (seg != 0) cl += 1;
        unsigned char* rec = p.ws + WS_RP + (size_t)(cl * 128 + bh) * RP_STRIDE;
        const bf16_t* Pb = (const bf16_t*)(p.ws + WS_P);
        bf16_t* phalo2 = (bf16_t*)(p.ws + WS_PHALO);
        if (cl == 0) rwkv_prep_item(p, smem, hb, LEX0, 48, nullptr, nullptr, rec);
        else {
            const int row = b * SEGTOK + (cl - 1) * 64;
            const bf16_t* prow = Pb + (size_t)(row - 1) * NPB;
            if (cl == 1) prow = (seg == 0) ? Pb + (size_t)(LEX0 + NMETA - 1) * NPB : phalo2 + (size_t)(((seg - 1) & 1) * NBATCH + b) * NPB;
            bf16_t* ho = (cl == CPS) ? phalo2 + (size_t)((seg & 1) * NBATCH + b) * NPB : nullptr;
            rwkv_prep_item(p, smem, hb, row, 0, prow, ho, rec);
        }
    }
}

__device__ __forceinline__ void rwkv_scan_block(const Params& p, int seg, unsigned char* smem, int pairidx) {
    const int tid = otid(), w = tid >> 6, lane = tid & 63, q4 = lane >> 4, l15 = lane & 15;
    const int hsel = w >> 2, vt = w & 3;
    const int bh = pairidx * 2 + hsel, b = bh >> 4, hb = bh & 15;
    float* st = p.out + O_RWKV_P + (size_t)bh * 4096;
    f32x4 S[4];
    if (seg) {
#pragma unroll
        for (int mt = 0; mt < 4; ++mt) S[mt] = *(const f32x4*)(st + (size_t)(16 * vt + l15) * 64 + 16 * mt + 4 * q4);
    } else {
#pragma unroll
        for (int mt = 0; mt < 4; ++mt) S[mt] = (f32x4){0.f, 0.f, 0.f, 0.f};
    }
    const int c_lo = seg ? 1 : 0;
    float* ybuf = (float*)(smem + 65536) + hsel * (64 * 68);
    const int tl = tid & 255;
    {
        const u32x4* src = (const u32x4*)(p.ws + WS_RP + (size_t)(c_lo * 128 + bh) * RP_STRIDE); u32x4* dst = (u32x4*)(smem + hsel * 16384);
#pragma unroll
        for (int x = 0; x < 4; ++x) dst[tl + 256 * x] = src[tl + 256 * x];
    }
#pragma unroll 1
    for (int cl = c_lo; cl <= CPS; ++cl) {
        const unsigned char* rec = p.ws + WS_RP + (size_t)(cl * 128 + bh) * RP_STRIDE;
        const int cur = (cl - c_lo) & 1;
        __syncthreads();
        u32x4 nx[4];
        const bool more = cl < CPS;
        if (more) { const u32x4* src = (const u32x4*)(rec + (size_t)RP_STRIDE * 128);
#pragma unroll
            for (int x = 0; x < 4; ++x) nx[x] = src[tl + 256 * x]; }
        const bf16_t* gKH = (const bf16_t*)(rec + RP_KH); const bf16_t* gYH = (const bf16_t*)(rec + RP_YH);
        u32x2 kh[4], yh[4]; f32x4 pc[4];
#pragma unroll
        for (int mt = 0; mt < 4; ++mt) { kh[mt] = *(const u32x2*)(gKH + ((size_t)(vt * 4 + mt) * 64 + lane) * 4); yh[mt] = *(const u32x2*)(gYH + ((size_t)(vt * 4 + mt) * 64 + lane) * 4);
            pc[mt] = *(const f32x4*)((const float*)(rec + RP_PC) + 16 * mt + 4 * q4); }
        const int tk = tl >> 2, g = tl & 3;
        u32x4 a0 = {0u, 0u, 0u, 0u}, a1 = a0, b0 = a0, b1 = a0;
        if (cl > 0) { const bf16_t* c1p = (const bf16_t*)(rec + RP_C1) + tk * 64 + 16 * g; const bf16_t* c0p = (const bf16_t*)(rec + RP_C0) + tk * 64 + 16 * g;
            a0 = *(const u32x4*)c0p; a1 = *(const u32x4*)(c0p + 8); b0 = *(const u32x4*)c1p; b1 = *(const u32x4*)(c1p + 8); }
        bf16x8 Bf[2];
#pragma unroll
        for (int ks = 0; ks < 2; ++ks) { u32x4 tq; tq.x = pk2(S[2 * ks][0], S[2 * ks][1]); tq.y = pk2(S[2 * ks][2], S[2 * ks][3]); tq.z = pk2(S[2 * ks + 1][0], S[2 * ks + 1][1]); tq.w = pk2(S[2 * ks + 1][2], S[2 * ks + 1][3]);
            Bf[ks] = __builtin_bit_cast(bf16x8, tq); }
        const bf16x8* AP = (const bf16x8*)(smem + cur * 32768 + hsel * 16384); const bf16x8* RH = (const bf16x8*)(smem + cur * 32768 + hsel * 16384 + RP_RH);
        f32x4 y[4], tS[4];
#pragma unroll
        for (int tt = 0; tt < 4; ++tt) { y[tt] = (f32x4){0.f, 0.f, 0.f, 0.f}; y[tt] = MFMA16(RH[(tt * 2 + 0) * 64 + lane], Bf[0], y[tt]); y[tt] = MFMA16(RH[(tt * 2 + 1) * 64 + lane], Bf[1], y[tt]); }
#pragma unroll
        for (int mt = 0; mt < 4; ++mt) { tS[mt] = (f32x4){0.f, 0.f, 0.f, 0.f}; tS[mt] = MFMA16(AP[(mt * 2 + 0) * 64 + lane], Bf[0], tS[mt]); tS[mt] = MFMA16(AP[(mt * 2 + 1) * 64 + lane], Bf[1], tS[mt]); }
#pragma unroll
        for (int mt = 0; mt < 4; ++mt) {
            S[mt][0] = pc[mt][0] * S[mt][0] + tS[mt][0] + __uint_as_float(kh[mt].x << 16); S[mt][1] = pc[mt][1] * S[mt][1] + tS[mt][1] + __uint_as_float(kh[mt].x & 0xffff0000u);
            S[mt][2] = pc[mt][2] * S[mt][2] + tS[mt][2] + __uint_as_float(kh[mt].y << 16); S[mt][3] = pc[mt][3] * S[mt][3] + tS[mt][3] + __uint_as_float(kh[mt].y & 0xffff0000u); }
        if (cl > 0) {
#pragma unroll
            for (int tt = 0; tt < 4; ++tt) {
                y[tt][0] += __uint_as_float(yh[tt].x << 16); y[tt][1] += __uint_as_float(yh[tt].x & 0xffff0000u); y[tt][2] += __uint_as_float(yh[tt].y << 16); y[tt][3] += __uint_as_float(yh[tt].y & 0xffff0000u);
#pragma unroll
                for (int r = 0; r < 4; ++r) ybuf[(16 * tt + 4 * q4 + r) * 68 + 16 * vt + l15] = y[tt][r]; }
        }
        if (more) { u32x4* dst = (u32x4*)(smem + (cur ^ 1) * 32768 + hsel * 16384);
#pragma unroll
            for (int x = 0; x < 4; ++x) dst[tl + 256 * x] = nx[x]; }
        if (cl > 0) {
            __syncthreads();
            f32x4 yv[4]; float sm = 0.f;
#pragma unroll
            for (int j = 0; j < 4; ++j) { yv[j] = *(const f32x4*)(ybuf + tk * 68 + 16 * g + 4 * j); sm += yv[j][0] + yv[j][1] + yv[j][2] + yv[j][3]; }
            sm += __shfl_xor(sm, 1); sm += __shfl_xor(sm, 2);
            const float mu = sm * (1.f / 64.f); float vs = 0.f;
#pragma unroll
            for (int j = 0; j < 4; ++j) { yv[j] = yv[j] - mu; vs += yv[j][0] * yv[j][0] + yv[j][1] * yv[j][1] + yv[j][2] * yv[j][2] + yv[j][3] * yv[j][3]; }
            vs += __shfl_xor(vs, 1); vs += __shfl_xor(vs, 2);
            const float rs = __builtin_amdgcn_rsqf(vs * (1.f / 64.f) + 64e-5f);
            const unsigned c0w[8] = {a0.x, a0.y, a0.z, a0.w, a1.x, a1.y, a1.z, a1.w}, c1w[8] = {b0.x, b0.y, b0.z, b0.w, b1.x, b1.y, b1.z, b1.w};
            unsigned ow[8];
#pragma unroll
            for (int j = 0; j < 8; ++j) ow[j] = pk2(yv[j >> 1][(j & 1) * 2] * rs * __uint_as_float(c1w[j] << 16) + __uint_as_float(c0w[j] << 16),
                                                     yv[j >> 1][(j & 1) * 2 + 1] * rs * __uint_as_float(c1w[j] & 0xffff0000u) + __uint_as_float(c0w[j] & 0xffff0000u));
            const size_t grow = (size_t)b * SEQ + seg * SEGTOK + (cl - 1) * 64 + tk;
            bf16_t* ob = (bf16_t*)(p.ws + WS_OB) + grow * D + hb * 64 + 16 * g;
            *(u32x4*)ob = (u32x4){ow[0], ow[1], ow[2], ow[3]}; *(u32x4*)(ob + 8) = (u32x4){ow[4], ow[5], ow[6], ow[7]};
        }
    }
#pragma unroll
    for (int mt = 0; mt < 4; ++mt) *(f32x4*)(st + (size_t)(16 * vt + l15) * 64 + 16 * mt + 4 * q4) = S[mt];
    __syncthreads();
}

__device__ __forceinline__ void gdn_sample_item(const Params& p, unsigned char* smem, int bs, int h) {
    const int tid = otid(), w = tid >> 6, lane = tid & 63, kq = tid >> 7, v = tid & 127;
    float* qk_s = (float*)smem; float* v_s = qk_s + 1024; float* gb_s = v_s + 512; float* part = gb_s + 16; float* part2 = part + 512;
    const bf16_t* P = (const bf16_t*)(p.ws + WS_P);
    const float* pk = (const float*)(p.ws + WS_PK);
    const float* s_in = p.in[2] + (size_t)(bs * 8 + h) * 16384; float* s_out = p.out + O_GDN_S + (size_t)(bs * 8 + h) * 16384;
    const int row0 = LEX0 + EX_SAMP + bs * DECT;
    float s[32];
#pragma unroll
    for (int j = 0; j < 32; ++j) s[j] = s_in[(size_t)(kq * 32 + j) * 128 + v];
    if (tid < 384) {
        const int pcol = (tid >> 7) * 1024 + h * 128 + (tid & 127);
        const float* cw = pk + PK_CONVW; const float* hin = p.in[3] + (size_t)bs * 9216; float* hout = p.out + O_CONV_S + (size_t)bs * 9216;
        const float cw0 = cw[pcol], cw1 = cw[3072 + pcol], cw2 = cw[6144 + pcol], cw3 = cw[9216 + pcol];
        float x3 = hin[pcol], x2 = hin[3072 + pcol], x1 = hin[6144 + pcol];
        float xr[4];
#pragma unroll
        for (int i = 0; i < 4; ++i) xr[i] = bf2f(P[(size_t)(row0 + i) * NPB + pcol]);
#pragma unroll
        for (int i = 0; i < 4; ++i) { const float y = cw0 * x3 + cw1 * x2 + cw2 * x1 + cw3 * xr[i]; x3 = x2; x2 = x1; x1 = xr[i];
            if (tid < 256) qk_s[i * 256 + tid] = silu_(y); else v_s[i * 128 + (tid - 256)] = silu_(y); }
        hout[pcol] = x3; hout[3072 + pcol] = x2; hout[6144 + pcol] = x1;
    } else if (tid < 388) {
        const int i = tid - 384; const size_t r = (size_t)(row0 + i) * NPB;
        const float pa = bf2f(P[r + C_A + h]), pb = bf2f(P[r + C_B + h]);
        gb_s[2 * i] = __expf(-expf(pk[PK_ALOG + h]) * softplus_(pa + pk[PK_DTB + h])); gb_s[2 * i + 1] = sigm(pb);
    }
    __syncthreads();
    { const int i = w >> 1, which = w & 1; float* rp = qk_s + i * 256 + which * 128; const float a = rp[lane], b = rp[lane + 64];
      const float sc = __builtin_amdgcn_rsqf(wave_sum(a * a + b * b) + 1e-6f) * (which == 0 ? 0.08838834764831845f : 1.f); rp[lane] = a * sc; rp[lane + 64] = b * sc; }
    __syncthreads();
#pragma unroll 1
    for (int i = 0; i < 4; ++i) {
        const float* kp = qk_s + i * 256 + 128 + kq * 32; const float* qp = qk_s + i * 256 + kq * 32;
        float pa = 0.f;
#pragma unroll
        for (int j4 = 0; j4 < 8; ++j4) { const f32x4 k4 = *(const f32x4*)(kp + 4 * j4); pa += k4[0] * s[4 * j4] + k4[1] * s[4 * j4 + 1] + k4[2] * s[4 * j4 + 2] + k4[3] * s[4 * j4 + 3]; }
        part[kq * 128 + v] = pa;
        __syncthreads();
        const float kS = part[v] + part[128 + v] + part[256 + v] + part[384 + v];
        const float a = gb_s[2 * i], c = gb_s[2 * i + 1] * (v_s[i * 128 + v] - a * kS);
        float po = 0.f;
#pragma unroll
        for (int j4 = 0; j4 < 8; ++j4) { const f32x4 k4 = *(const f32x4*)(kp + 4 * j4), q4v = *(const f32x4*)(qp + 4 * j4);
#pragma unroll
            for (int e = 0; e < 4; ++e) { s[4 * j4 + e] = a * s[4 * j4 + e] + k4[e] * c; po += q4v[e] * s[4 * j4 + e]; } }
        part2[kq * 128 + v] = po;
        __syncthreads();
        if (kq == 0) ((float*)(p.ws + WS_ORAW))[(size_t)(row0 + i) * D + h * 128 + v] = part2[v] + part2[128 + v] + part2[256 + v] + part2[384 + v];
    }
#pragma unroll
    for (int j = 0; j < 32; ++j) s_out[(size_t)(kq * 32 + j) * 128 + v] = s[j];
    __syncthreads();
}

constexpr int SR_R = 0, SR_KK = 4096, SR_V = 8192, SR_ZB = 12288, SR_DEC = 16384, SR_KA = 20480, SR_KM = 24576, SR_WD = 28672, SR_AD = 28928, SR_RK = 29184;
__device__ __forceinline__ void rwkv_sample_item(const Params& p, unsigned char* smem, int bs) {
    const int tid = otid(), w = tid >> 6, lane = tid & 63;
    float* f = (float*)smem;
    const bf16_t* P = (const bf16_t*)(p.ws + WS_P);
    const float* pk = (const float*)(p.ws + WS_PK);
    const int row0 = LEX0 + EX_SAMP + bs * DECT;
    const bf16_t* prow = P + (size_t)(LEX0 + EX_SHIFT + bs) * NPB + C_RW;
#pragma unroll 1
    for (int col = tid; col < RW_SHIFT; col += 512) {
        const float mu = pk[PK_MU + col]; float prev = bf2f(prow[col]);
        float cur[4];
#pragma unroll
        for (int i = 0; i < 4; ++i) cur[i] = bf2f(P[(size_t)(row0 + i) * NPB + C_RW + col]);
        float* dst; int stride = 1024; bool th = false;
        if (col < 1024) dst = f + SR_R + col; else if (col < 2048) dst = f + SR_KK + (col - 1024); else if (col < 3072) dst = f + SR_V + (col - 2048);
        else if (col < 3136) { dst = f + SR_WD + (col - 3072); stride = 64; th = true; } else if (col < 3200) { dst = f + SR_AD + (col - 3136); stride = 64; } else dst = f + SR_ZB + (col - 3200);
#pragma unroll
        for (int i = 0; i < 4; ++i) { float m = cur[i] + mu * (prev - cur[i]); prev = cur[i]; if (th) m = tanh_(m); dst[i * stride] = m; }
    }
    __syncthreads();
#pragma unroll 1
    for (int cc = 0; cc < 2; ++cc) {
        const int c = tid + 512 * cc;
        float aw[4] = {0.f, 0.f, 0.f, 0.f}, aa[4] = {0.f, 0.f, 0.f, 0.f};
#pragma unroll 8
        for (int l = 0; l < 64; ++l) { const float w2v = pk[PK_W2 + l * D + c], a2v = pk[PK_A2 + l * D + c];
#pragma unroll
            for (int i = 0; i < 4; ++i) { aw[i] += f[SR_WD + i * 64 + l] * w2v; aa[i] += f[SR_AD + i * 64 + l] * a2v; } }
        const float w0c = pk[PK_W0 + c], a0c = pk[PK_A0 + c], kkc = pk[PK_KK + c], kac = pk[PK_KA + c];
#pragma unroll
        for (int i = 0; i < 4; ++i) { const float a = sigm(a0c + aa[i]); const float kbv = f[SR_KK + i * 1024 + c];
            f[SR_DEC + i * 1024 + c] = __expf(-0.6065306597126334f * sigm(w0c + aw[i])); f[SR_KA + i * 1024 + c] = a; f[SR_KK + i * 1024 + c] = kbv * kkc; f[SR_KM + i * 1024 + c] = kbv * (1.f + (a - 1.f) * kac); }
    }
    __syncthreads();
#pragma unroll 1
    for (int x = 0; x < 8; ++x) { const int pr = w * 8 + x, i = pr >> 4, hh = pr & 15; const int o = i * 1024 + hh * 64 + lane;
        const float kr = f[SR_KK + o]; const float kk = kr * __builtin_amdgcn_rsqf(wave_sum(kr * kr) + 1e-6f); f[SR_KK + o] = kk; f[SR_KA + o] = kk * f[SR_KA + o];
        const float rkv = wave_sum(f[SR_R + o] * f[SR_KM + o] * pk[PK_RK + hh * 64 + lane]); if (lane == 0) f[SR_RK + pr] = rkv; }
    __syncthreads();
#pragma unroll 1
    for (int hp = 0; hp < 2; ++hp) {
        const int hb = hp * 8 + w;
        const float* s_in = p.in[4] + (size_t)(bs * 16 + hb) * 4096 + (size_t)lane * 64; float* s_out = p.out + O_RWKV_S + (size_t)(bs * 16 + hb) * 4096 + (size_t)lane * 64;
        f32x4 S[16];
#pragma unroll
        for (int j = 0; j < 16; ++j) S[j] = *(const f32x4*)(s_in + 4 * j);
        const int cch = hb * 64 + lane;
        const float gnw = pk[PK_GNW + cch], gnb = pk[PK_GNB + cch];
#pragma unroll 1
        for (int i = 0; i < 4; ++i) {
            const int o = i * 1024 + hb * 64;
            const float vv = f[SR_V + o + lane], rk = f[SR_RK + i * 16 + hb];
            float sa = 0.f;
#pragma unroll
            for (int j = 0; j < 16; ++j) { const f32x4 kk4 = *(const f32x4*)(f + SR_KK + o + 4 * j); sa += S[j][0] * kk4[0] + S[j][1] * kk4[1] + S[j][2] * kk4[2] + S[j][3] * kk4[3]; }
            float y = 0.f;
#pragma unroll
            for (int j = 0; j < 16; ++j) { const f32x4 de4 = *(const f32x4*)(f + SR_DEC + o + 4 * j), ka4 = *(const f32x4*)(f + SR_KA + o + 4 * j), km4 = *(const f32x4*)(f + SR_KM + o + 4 * j), r4 = *(const f32x4*)(f + SR_R + o + 4 * j);
#pragma unroll
                for (int e = 0; e < 4; ++e) { S[j][e] = S[j][e] * de4[e] + (vv * km4[e] - sa * ka4[e]); y += S[j][e] * r4[e]; } }
            const float mu = wave_sum(y) * (1.f / 64.f); const float dy = y - mu;
            const float rs = __builtin_amdgcn_rsqf(wave_sum(dy * dy) * (1.f / 64.f) + 64e-5f);
            const float ov = (dy * rs * gnw + gnb + rk * vv) * silu_(f[SR_ZB + i * 1024 + cch]);
            ((bf16_t*)(p.ws + WS_OB))[(size_t)(XROWS + EX_SAMP + bs * DECT + i) * D + cch] = (bf16_t)f2bf(ov);
        }
#pragma unroll
        for (int j = 0; j < 16; ++j) *(f32x4*)(s_out + 4 * j) = S[j];
    }
    __syncthreads();
}

__device__ __forceinline__ void phase2(const Params& p, int seg, unsigned char* smem) {
    const int blk = obid();
    float* out = p.out;
    float* chalo = (float*)(p.ws + WS_CHALO); float* phalo = (float*)(p.ws + WS_PHALO);
#ifndef SUB
#define SUB 0
#endif
#define SEN(x) (SUB == 0 || SUB == (x))
    if (SEN(1) && blk < 64) gdn_scan_block(p, seg, smem, blk);
    if (SEN(3) && blk >= 64 && blk < 128) rwkv_scan_block(p, seg, smem, blk - 64);
#ifndef DUP
#define DUP 0
#endif
    if (seg == 0) {
#pragma unroll 1
        for (int it = blk; it < DECB * 8; it += gridDim.x) gdn_sample_item(p, smem, it >> 3, it & 7);
#pragma unroll 1
        for (int it = blk; it < DECB; it += gridDim.x) rwkv_sample_item(p, smem, it);
    }
}

__device__ __forceinline__ void phase25(const Params& p, int seg) {
    const int tid0 = otid(); const int lane = tid0 & 63; const int gw = obid() * 8 + (tid0 >> 6), NGW = gridDim.x * 8;
    const bf16_t* P = (const bf16_t*)(p.ws + WS_P);
    const float* ORAW = (const float*)(p.ws + WS_ORAW); const float* YRAW = (const float*)(p.ws + WS_YRAW);
    const bf16_t* C0 = (const bf16_t*)(p.ws + WS_C0); const bf16_t* C1 = (const bf16_t*)(p.ws + WS_C1);
    bf16_t* OA = (bf16_t*)(p.ws + WS_H); bf16_t* OB = (bf16_t*)(p.ws + WS_OB);
    const int nrows = LEX0 + (seg == 0 ? DECB * DECT : 0);
    const int c = lane * 16;
    f32x4 nw[4];
#pragma unroll
    for (int j = 0; j < 4; ++j) nw[j] = *(const f32x4*)((const float*)(p.ws + WS_PK) + PK_NORMW + (c & 127) + 4 * j);
#pragma unroll 1
    for (int rr = LEX0 + gw; rr < nrows; rr += NGW) {
        int lr; size_t grow;
        if (rr < LEX0) { lr = rr; grow = (size_t)(rr / SEGTOK) * SEQ + seg * SEGTOK + (rr % SEGTOK); } else { lr = LEX0 + EX_SAMP + (rr - LEX0); grow = (size_t)XROWS + EX_SAMP + (rr - LEX0); }
        {
            f32x4 o[4]; float ss = 0.f;
#pragma unroll
            for (int j = 0; j < 4; ++j) { o[j] = *(const f32x4*)(ORAW + (size_t)lr * D + c + 4 * j); ss += o[j][0] * o[j][0] + o[j][1] * o[j][1] + o[j][2] * o[j][2] + o[j][3] * o[j][3]; }
            ss += __shfl_xor(ss, 1); ss += __shfl_xor(ss, 2); ss += __shfl_xor(ss, 4);
            const float rs = __builtin_amdgcn_rsqf(ss * (1.f / 128.f) + 1e-6f);
            const u32x4 z0 = *(const u32x4*)(P + (size_t)lr * NPB + C_Z + c), z1 = *(const u32x4*)(P + (size_t)lr * NPB + C_Z + c + 8);
            const unsigned zz[8] = {z0.x, z0.y, z0.z, z0.w, z1.x, z1.y, z1.z, z1.w};
            unsigned ow[8];
#pragma unroll
            for (int j = 0; j < 8; ++j) { const float za = __uint_as_float(zz[j] << 16), zb = __uint_as_float(zz[j] & 0xffff0000u);
                const float a = o[j >> 1][(j & 1) * 2] * rs * nw[j >> 1][(j & 1) * 2] * silu_(za), b = o[j >> 1][(j & 1) * 2 + 1] * rs * nw[j >> 1][(j & 1) * 2 + 1] * silu_(zb);
                ow[j] = pk2(a, b); }
            *(u32x4*)(OA + grow * D + c) = (u32x4){ow[0], ow[1], ow[2], ow[3]}; *(u32x4*)(OA + grow * D + c + 8) = (u32x4){ow[4], ow[5], ow[6], ow[7]};
        }
    }
}

__device__ __forceinline__ void phase_final(const Params& p) {
    const int tid0 = otid(); const int lane = tid0 & 63; const int gw = obid() * 8 + (tid0 >> 6), NGW = gridDim.x * 8;
    const f32x4* wr = (const f32x4*)((const float*)(p.ws + WS_PK) + PK_LNF) + lane;
#pragma unroll 1
    for (int r = gw; r < XROWS + DECB * DECT; r += NGW) {
        f32x4* xr = (f32x4*)(p.out + (size_t)r * D) + lane;
        f32x4 v[4]; float ss = 0.f;
#pragma unroll
        for (int j = 0; j < 4; ++j) { v[j] = xr[64 * j]; ss += v[j][0] * v[j][0] + v[j][1] * v[j][1] + v[j][2] * v[j][2] + v[j][3] * v[j][3]; }
        const float rs = __builtin_amdgcn_rsqf(wave_sum(ss) * (1.f / D) + 1e-6f);
#pragma unroll
        for (int j = 0; j < 4; ++j) xr[64 * j] = v[j] * rs * wr[64 * j];
    }
}

__global__ __launch_bounds__(512, 2) void hybrid_mega(Params p) {
    extern __shared__ __attribute__((aligned(16))) unsigned char smem[];
    cg::grid_group grid = cg::this_grid();
    LAS unsigned char* lds = (LAS unsigned char*)smem;
    const int G = gridDim.x;
    volatile LAS unsigned* xst = (volatile LAS unsigned*)(lds + (LDS_TOTAL - 16));
    if (threadIdx.x == 0) { xst[0] = 0u; xst[1] = 0u; }
    __syncthreads();
    (void)xcd_barrier_post((unsigned*)(p.ws + WS_BAR), xst);
    if (G == 0x7fffffff) grid.sync();
#define GSYNC() do { XcdBarrier xb_; xb_.bar = (unsigned*)(p.ws + WS_BAR); xb_.x = xb_xcc_id(); xb_.st = (volatile LAS unsigned*)((LAS unsigned char*)smem + (LDS_TOTAL - 16)); xcd_barrier(xb_); } while (0)

#ifndef ONLY
#define ONLY 0
#endif
#define EN(x) (ONLY == 0 || ONLY == (x))
    if (EN(1)) phase0(p, smem);
    GSYNC();
#pragma unroll 1
    for (int it = 0; it <= NSEG + 2; ++it) {
        const int xblk = obid() - (G - 12);
        const bool xrole = xblk >= 0;
        if (it > 0 && it <= NSEG && EN(3)) phase2(p, it - 1, smem);
        if (((it == 2 && xrole) || it == NSEG + 1) && EN(5)) {
            const bool ex = it == 2;
            SchedAB S; S.ob.init(ex ? 3 : XROWS / 256, 4, ex ? 12 : G, ex ? xblk : obid()); S.pm0 = ex ? XROWS / 256 : 0;
            S.A0 = (const char*)(p.ws + WS_H); S.A1 = (const char*)(p.ws + WS_OB); S.B0 = (const char*)(p.ws + WS_WT_A); S.B1 = (const char*)(p.ws + WS_WT_B);
            EpiAB E; E.tmp = ex ? (bf16_t*)(p.ws + WS_YRAW) - (size_t)XROWS * D : (bf16_t*)(p.ws + WS_P); E.merged = ex ? (bf16_t*)(p.ws + WS_C0) - (size_t)XROWS * D : (bf16_t*)(p.ws + WS_MG);
            E.gex = (const bf16_t*)(p.ws + WS_GEX); E.out = p.out;
            pg8::gemm_phase<EpiAB, SchedAB>(lds, D, S, E);
        }
        if (((it == 3 && xrole) || it == NSEG + 2) && EN(6)) {
            const bool ex = it == 3;
            SchedO S; S.ob.init(ex ? 3 : XROWS / 256, 4, ex ? 12 : G, ex ? xblk : obid()); S.pm0 = ex ? XROWS / 256 : 0;
            S.A = ex ? (const char*)((bf16_t*)(p.ws + WS_C0) - (size_t)XROWS * D) : (const char*)(p.ws + WS_MG); S.B = (const char*)(p.ws + WS_WT_O);
            EpiO E; E.out = p.out; E.xp = p.in[0]; E.xs = p.in[1];
            pg8::gemm_phase<EpiO, SchedO>(lds, D, S, E);
        }
        if (it < NSEG && EN(2) && !(it == 2 && xrole)) {
            const int seg = it;
            const int Gp = it == 2 ? G - 12 : G;
            const int cidx = it > 0 ? (obid() + (Gp >> 1)) % Gp : obid();
            SchedIn S; S.ob.init(seg == 0 ? LT_PROMPT + 3 : LT_PROMPT, NT_IN, Gp, cidx); S.seg = seg; S.A = (const char*)(p.ws + WS_H); S.B = (const char*)(p.ws + WS_WT_IN);
            EpiIn E; E.P = (bf16_t*)(p.ws + WS_P); E.gex = (bf16_t*)(p.ws + WS_GEX); E.out = p.out; E.seg = seg;
            pg8::gemm_phase<EpiIn, SchedIn>(lds, D, S, E);
        }
        if (it >= 1 && it + 1 < NSEG && obid() >= 200) { const int t0 = otid(); h_rows_segs(p, it + 1, it + 2, (obid() - 200) * 8 + (t0 >> 6), (G - 200) * 8, t0 & 63); }
        GSYNC();
        if (it < NSEG) {
            if (EN(8)) { phase_gprep(p, it, smem); phase_rprep(p, it, smem); }
            if (it == 1 && EN(4)) phase25(p, 0);
            GSYNC();
        }
    }
    if (EN(7)) phase_final(p);
}

extern "C" void kernel_launch(void* const* d_in, const int* in_sizes, int n_in, void* d_out, int out_size, void* d_ws, size_t ws_size, hipStream_t stream) {
    static int grid_blocks = 0;
    constexpr int LDS_BYTES = LDS_TOTAL;
    if (grid_blocks == 0) {
        if (n_in != 27 || ws_size < WS_END) { fprintf(stderr, "kernel_launch: unexpected n_in %d / ws %zu (need %zu)\n", n_in, ws_size, (size_t)WS_END); grid_blocks = -1; return; }
        if (hipFuncSetAttribute((const void*)hybrid_mega, hipFuncAttributeMaxDynamicSharedMemorySize, LDS_BYTES) != hipSuccess) { fprintf(stderr, "kernel_launch: hipFuncSetAttribute failed\n"); grid_blocks = -1; return; }
        int dev = 0, cus = 0, per_cu = 0;
        hipGetDevice(&dev);
        hipDeviceGetAttribute(&cus, hipDeviceAttributeMultiprocessorCount, dev);
        hipOccupancyMaxActiveBlocksPerMultiprocessor(&per_cu, (const void*)hybrid_mega, 512, LDS_BYTES);
        if (per_cu < 1) { fprintf(stderr, "kernel_launch: occupancy query says %d blocks/CU\n", per_cu); per_cu = 1; }
        (void)hipGetLastError();
        grid_blocks = cus;
    }
    if (grid_blocks < 0) return;
    Params p{};
    for (int i = 0; i < 27; ++i) p.in[i] = (const float*)d_in[i];
    p.out = (float*)d_out; p.ws = (unsigned char*)d_ws;
    if (hipMemsetAsync((unsigned char*)d_ws + WS_BAR, 0, 16384, stream) != hipSuccess) { fprintf(stderr, "kernel_launch: memset of the barrier words failed\n"); return; }
    void* args[] = {&p};
    hipError_t e = hipLaunchCooperativeKernel((const void*)hybrid_mega, dim3(grid_blocks), dim3(512), args, LDS_BYTES, stream);
    if (e != hipSuccess) fprintf(stderr, "cooperative launch failed: %s (grid %d)\n", hipGetErrorString(e), grid_blocks);
}
```

```cpp
#include <hip/hip_runtime.h>
#include <hip/hip_cooperative_groups.h>
#include <cstdio>
namespace cg = cooperative_groups;

#define LAS __attribute__((address_space(3)))
typedef unsigned short bf16_t;
typedef short bf16x8 __attribute__((ext_vector_type(8)));
typedef float f32x4 __attribute__((ext_vector_type(4)));
typedef unsigned u32x4 __attribute__((ext_vector_type(4)));
typedef unsigned u32x2 __attribute__((ext_vector_type(2)));

constexpr int D = 1024;
constexpr int NBATCH = 8, SEQ = 2048, NMETA = 16, DECB = 128, DECT = 4;
constexpr int XROWS = NBATCH * SEQ;
constexpr int EX_SAMP = 16, EX_SHIFT = 528, EX_END = 656;
constexpr int HROWS = 17152, HTILES = 67;
constexpr int NSEG = 8, SEGTOK = SEQ / NSEG;
constexpr int CPS = SEGTOK / 64;
constexpr int TPB = SEGTOK / 256;
constexpr int LT_PROMPT = NBATCH * TPB;
constexpr int LEX0 = LT_PROMPT * 256;
constexpr int LROWS = LEX0 + 768;
constexpr int NP = 10496, NPB = 8448, NT_IN = 41, NT_PB = 33;
constexpr int C_A = 3072, C_B = 3080, C_Z = 3088, C_RW = 4112, C_GATE_REF = 8336;
constexpr int RW_SHIFT = 4224;

constexpr size_t O_YP = 0, O_YS = 16777216, O_GDN_P = 17301504, O_CONV_P = 18350080, O_RWKV_P = 18423808, O_SHIFT_P = 18948096,
                 O_GDN_S = 18956288, O_CONV_S = 35733504, O_RWKV_S = 36913152, O_SHIFT_S = 45301760;

constexpr size_t al256(size_t x) { return (x + 255) & ~(size_t)255; }
constexpr size_t WS_WT_IN = 0;
constexpr size_t WS_WT_A = al256(WS_WT_IN + (size_t)NP * D * 2);
constexpr size_t WS_WT_B = al256(WS_WT_A + (size_t)D * D * 2);
constexpr size_t WS_WT_O = al256(WS_WT_B + (size_t)D * D * 2);
constexpr size_t WS_H = al256(WS_WT_O + (size_t)D * D * 2);
constexpr size_t WS_OB = al256(WS_H + (size_t)HROWS * D * 2);
constexpr size_t WS_P = al256(WS_OB + (size_t)HROWS * D * 2);
constexpr size_t WS_ORAW = al256(WS_P + (size_t)LROWS * NPB * 2);
constexpr size_t WS_YRAW = al256(WS_ORAW + (size_t)LROWS * D * 4);
constexpr size_t WS_C0 = al256(WS_YRAW + (size_t)LROWS * D * 4);
constexpr size_t WS_C1 = al256(WS_C0 + (size_t)LROWS * D * 2);
constexpr size_t WS_GEX = al256(WS_C1 + (size_t)LROWS * D * 2);
constexpr size_t WS_CHALO = al256(WS_GEX + (size_t)768 * 2048 * 2);
constexpr size_t WS_PHALO = al256(WS_CHALO + (size_t)2 * NBATCH * 3 * NPB * 2);
constexpr size_t WS_PK = al256(WS_PHALO + (size_t)2 * NBATCH * NPB * 2);
constexpr int PK_CONVW = 0, PK_ALOG = 12288, PK_DTB = 12296, PK_NORMW = 12304, PK_MU = 12432, PK_W0 = 16656, PK_W2 = 17680, PK_A0 = 83216, PK_A2 = 84240,
              PK_KK = 149776, PK_KA = 150800, PK_RK = 151824, PK_GNW = 152848, PK_GNB = 153872, PK_LNF = 154896, PK_END = 155920;
constexpr size_t WS_BAR = al256(WS_PK + (size_t)PK_END * 4);
constexpr size_t WS_W2T = al256(WS_BAR + 16384);
constexpr size_t WS_A2T = al256(WS_W2T + 131072);
constexpr size_t WS_GP = al256(WS_A2T + 131072);
constexpr int GP_AP = 0, GP_QH = 32768, GP_KH = 49152, GP_OH = 81920, GP_EGL = 98304, GP_G = 98560, GP_STRIDE = 114944;
constexpr int RP_AP = 0, RP_RH = 8192, RP_KH = 16384, RP_YH = 24576, RP_C1 = 32768, RP_C0 = 40960, RP_PC = 49152, RP_STRIDE = 49408;
constexpr size_t WS_RP = al256(WS_GP + (size_t)(CPS + 1) * 64 * GP_STRIDE);
constexpr size_t WS_END = al256(WS_RP + (size_t)(CPS + 1) * 128 * RP_STRIDE);
constexpr size_t WS_MG = WS_GP;
static_assert((size_t)HROWS * D * 2 <= WS_END - WS_GP, "MERGED must fit in the prep records");
static_assert((size_t)HROWS * D * 4 <= (size_t)LROWS * NPB * 2 + 2 * (size_t)LROWS * D * 4, "TMP must fit in P+ORAW+YRAW");
static_assert(WS_END <= (size_t)268435456, "workspace");

constexpr int LDS_TOTAL = 163840;
struct Params { const float* in[27]; float* out; unsigned char* ws; };

__device__ __forceinline__ float bf2f(bf16_t v) { return __uint_as_float(((unsigned)v) << 16); }
typedef __bf16 bf16n2 __attribute__((ext_vector_type(2)));
typedef float f32n2 __attribute__((ext_vector_type(2)));
__device__ __forceinline__ unsigned cvt_pk_bf16(float lo, float hi) { const f32n2 v = {lo, hi}; return __builtin_bit_cast(unsigned, __builtin_convertvector(v, bf16n2)); }
__device__ __forceinline__ unsigned pk2(float lo, float hi) { return cvt_pk_bf16(lo, hi); }
__device__ __forceinline__ unsigned f2bf(float f) { return cvt_pk_bf16(f, 0.f) & 0xffffu; }
__device__ __forceinline__ float sigm(float x) { return __builtin_amdgcn_rcpf(1.f + __expf(-x)); }
__device__ __forceinline__ float silu_(float x) { return x * __builtin_amdgcn_rcpf(1.f + __expf(-x)); }
__device__ __forceinline__ float softplus_(float x) { return fmaxf(x, 0.f) + log1pf(expf(-fabsf(x))); }
__device__ __forceinline__ float wave_sum(float v) {
#pragma unroll
    for (int o = 1; o < 64; o <<= 1) v += __shfl_xor(v, o);
    return v;
}
__device__ __forceinline__ void unpack8(const u32x4 rw, float (&x)[8]) {
    x[0] = __uint_as_float(rw.x << 16); x[1] = __uint_as_float(rw.x & 0xffff0000u); x[2] = __uint_as_float(rw.y << 16); x[3] = __uint_as_float(rw.y & 0xffff0000u);
    x[4] = __uint_as_float(rw.z << 16); x[5] = __uint_as_float(rw.z & 0xffff0000u); x[6] = __uint_as_float(rw.w << 16); x[7] = __uint_as_float(rw.w & 0xffff0000u); }
__device__ __forceinline__ u32x4 pack8(const float (&x)[8]) { return (u32x4){pk2(x[0], x[1]), pk2(x[2], x[3]), pk2(x[4], x[5]), pk2(x[6], x[7])}; }

__device__ __forceinline__ int otid() { int t = threadIdx.x; asm volatile("" : "+v"(t)); return t; }
__device__ __forceinline__ int obid() { int t = blockIdx.x; asm volatile("" : "+s"(t)); return t; }
__device__ __forceinline__ float tanh_(float x) { const float e = __expf(2.f * x); return 1.f - 2.f * __builtin_amdgcn_rcpf(e + 1.f); }
template <int CTRL> __device__ __forceinline__ float dppf(float x) { return __builtin_bit_cast(float, __builtin_amdgcn_mov_dpp(__builtin_bit_cast(int, x), CTRL, 0xf, 0xf, true)); }
__device__ __forceinline__ float rowsum16(float x) { x += dppf<0x128>(x); x += dppf<0x124>(x); x += dppf<0x122>(x); x += dppf<0x121>(x); return x; }


#define XB_TMO      128
#define XB_XCNT(j)  (256  + 64 * (j))
#define XB_XSUB(j)  (1280 + 64 * (j))
#define XB_XGEN(j)  (2304 + 64 * (j))
#define XB_TOP      3328
#define XB_TOPGEN   3392
#define XCD_BAR_WORDS 3456
#define XB_SPIN_CAP (1u << 22)
__device__ __forceinline__ unsigned xb_ld(unsigned* p)              { return __hip_atomic_load(p, __ATOMIC_RELAXED, __HIP_MEMORY_SCOPE_AGENT); }
__device__ __forceinline__ unsigned xb_add(unsigned* p, unsigned v) { return __hip_atomic_fetch_add(p, v, __ATOMIC_RELAXED, __HIP_MEMORY_SCOPE_AGENT); }
__device__ __forceinline__ unsigned xb_xcc_id() { return (unsigned)__builtin_amdgcn_s_getreg((3 << 11) | 20) & 0xFu; }
#define XB_SPIN(cond, bar) do { unsigned _sp = 0; while (cond) { __builtin_amdgcn_s_sleep(1); \
    if ((++_sp & 255u) == 0u) { if (xb_ld(&(bar)[XB_TMO])) break; if (_sp > XB_SPIN_CAP) { atomicAdd(&(bar)[XB_TMO], 1u); break; } } } } while (0)
struct XcdBarrier { unsigned* bar; unsigned x; volatile LAS unsigned* st; };
__device__ __forceinline__ XcdBarrier xcd_barrier_post(unsigned* bar, volatile LAS unsigned* st) {
    XcdBarrier b; b.bar = bar; b.x = xb_xcc_id(); b.st = st;
    if (threadIdx.x == 0) (void)xb_add(&bar[XB_XCNT(b.x)], 1u);
    return b;
}
__device__ __forceinline__ void xcd_barrier_complete(unsigned* bar, unsigned x, unsigned& nloc, unsigned& nx) {
    const unsigned G = gridDim.x * gridDim.y * gridDim.z;
    unsigned sum, cnt, mine, sp = 0u;
    for (;;) {
        sum = 0u; cnt = 0u; mine = 0u;
#pragma unroll
        for (unsigned j = 0; j < 16; ++j) { const unsigned c = xb_ld(&bar[XB_XCNT(j)]); sum += c; cnt += (c > 0u) ? 1u : 0u; mine = (j == x) ? c : mine; }
        if (sum == G) break;
        __builtin_amdgcn_s_sleep(1);
        if ((++sp & 255u) == 0u) { if (xb_ld(&bar[XB_TMO])) break; if (sp > XB_SPIN_CAP) { atomicAdd(&bar[XB_TMO], 1u); break; } }
    }
    nloc = mine > 0u ? mine : 1u; nx = cnt > 0u ? cnt : 1u;
}
__device__ __forceinline__ void xcd_barrier(const XcdBarrier& b) {
    asm volatile("s_waitcnt vmcnt(0)" ::: "memory");
    __syncthreads();
    if (threadIdx.x == 0) {
        unsigned* bar = b.bar;
        __builtin_amdgcn_s_waitcnt(0);
        unsigned nloc = b.st[0], nx = b.st[1];
        if (nloc == 0u) { xcd_barrier_complete(bar, b.x, nloc, nx); b.st[0] = nloc; b.st[1] = nx; }
        const unsigned old = xb_add(&bar[XB_XSUB(b.x)], 1u);
        const unsigned gen = old / nloc;
        if (old + 1u == (gen + 1u) * nloc) {
            __builtin_amdgcn_fence(__ATOMIC_RELEASE, "agent");
            asm volatile("s_waitcnt vmcnt(0)" ::: "memory");
            const unsigned og = xb_add(&bar[XB_TOP], 1u);
            const unsigned tg = og / nx;
            if (og + 1u == (tg + 1u) * nx) xb_add(&bar[XB_TOPGEN], 1u);
            else XB_SPIN(xb_ld(&bar[XB_TOPGEN]) == tg, bar);
            __builtin_amdgcn_fence(__ATOMIC_ACQUIRE, "agent");
            xb_add(&bar[XB_XGEN(b.x)], 1u);
            asm volatile("s_waitcnt vmcnt(0)" ::: "memory");
        } else {
            XB_SPIN(xb_ld(&bar[XB_XGEN(b.x)]) == gen, bar);
            __builtin_amdgcn_fence(__ATOMIC_ACQUIRE, "agent");
            asm volatile("s_waitcnt vmcnt(0)" ::: "memory");
        }
    }
    __syncthreads();
}

namespace pg8 {
constexpr int BM = 256, BK = 64, HALF = 128, HTB = HALF * BK * 2, STAGE_BYTES = 8 * HTB, NXCD = 8, WGM = 8;
__device__ __forceinline__ int lds_byte(int r, int c) { const int st = (r >> 4) * 2 + (c >> 5), rr = r & 15, cc = c & 31, ob = rr * 64 + cc * 2; return st * 1024 + (ob ^ (((ob >> 9) & 1) << 5)); }
__device__ __forceinline__ void stage_rc(int b, int& R, int& C) { const int st = b / 1024, sb = b % 1024, swz = sb ^ (((sb >> 9) & 1) << 5); R = (st >> 1) * 16 + swz / 64; C = (st & 1) * 32 + (swz % 64) / 2; }
__device__ __forceinline__ int perm32(int rho) { const int n = rho >> 4, i = rho & 15; return 8 * (i >> 2) + 4 * n + (i & 3); }

struct Unit { int pm, pn, w; };
struct OrderBase {
    int nM, nN, nwg, G, c;
    __device__ void init(int nM_, int nN_, int G_, int c_) { nM = nM_; nN = nN_; nwg = nM * nN; G = G_; c = c_; }
    __device__ bool nextb(int i, Unit& u) const {
        const long L = (long)i * G + c; if (L >= nwg) return false;
        int wgid = (int)L; { const int q = nwg / NXCD, r = nwg % NXCD, xcd = wgid % NXCD, off = wgid / NXCD; wgid = (xcd < r ? xcd * (q + 1) : r * (q + 1) + (xcd - r) * q) + off; }
        const int nig = WGM * nN, gid = wgid / nig, fm = gid * WGM, gsz = (nM - fm) < WGM ? (nM - fm) : WGM;
        u.pm = fm + ((wgid % nig) % gsz); u.pn = (wgid % nig) / gsz; u.w = 0; return true;
    }
};

template <class Epi, class Sched>
__device__ __forceinline__ void gemm_phase(LAS unsigned char* lds, const int K, const Sched& S, const Epi& E) {
    const int tid = otid(), wid = __builtin_amdgcn_readfirstlane(tid >> 6), lane = tid & 63, wr = wid >> 2, wc = wid & 3, fr = lane & 15, fq = lane >> 4;
    const int nt = K / BK;
    unsigned voffA[2], voffB[2];
#pragma unroll
    for (int i = 0; i < 2; ++i) { int R, C; stage_rc(tid * 16 + i * 8192, R, C); const int Rb = Epi::PERM ? ((R & ~31) + perm32(R & 31)) : R;
        voffA[i] = (unsigned)(R * K + C) * 2u; voffB[i] = (unsigned)(Rb * K + C) * 2u; }
    const size_t kstep = (size_t)(BK * 2);
    const size_t hstep = (size_t)HALF * K * 2;
    const unsigned ldsw = (unsigned)wid * 1024u;
    const int aoff = lds_byte(wr * 64 + fr, fq * 8), boff = lds_byte(wc * 32 + fr, fq * 8);
#define PG8_SA(b, h) (((b) * 2 + (h)) * HTB)
#define PG8_SB(b, h) ((4 + (b) * 2 + (h)) * HTB)
#define PG8_STAGE(bufoff, gbase, voff) do { _Pragma("unroll") for (int _i = 0; _i < 2; ++_i) \
        __builtin_amdgcn_global_load_lds((const unsigned*)((const char*)(gbase) + (voff)[_i]), (LAS unsigned*)(lds + (bufoff) + ldsw + _i * 8192), 16, 0, 0); } while (0)
#define PG8_LDA(dst, b, h) do { _Pragma("unroll") for (int m = 0; m < 4; ++m) _Pragma("unroll") for (int k = 0; k < 2; ++k) dst[m][k] = *(const LAS bf16x8*)(lds + PG8_SA(b, h) + aoff + m * 2048 + k * 1024); } while (0)
#define PG8_LDB(dst, b, h) do { _Pragma("unroll") for (int n = 0; n < 2; ++n) _Pragma("unroll") for (int k = 0; k < 2; ++k) dst[n][k] = *(const LAS bf16x8*)(lds + PG8_SB(b, h) + boff + n * 2048 + k * 1024); } while (0)
#define PG8_MMA(ai, bj, At, Bt) do { __builtin_amdgcn_s_setprio(1); _Pragma("unroll") for (int m = 0; m < 4; ++m) _Pragma("unroll") for (int n = 0; n < 2; ++n) _Pragma("unroll") for (int k = 0; k < 2; ++k) \
        acc[ai][bj][m][n] = __builtin_amdgcn_mfma_f32_16x16x32_bf16(Bt[n][k], At[m][k], acc[ai][bj][m][n], 0, 0, 0); __builtin_amdgcn_s_setprio(0); } while (0)
#define PG8_WAIT_V(n) asm volatile("s_waitcnt vmcnt(" #n ")" ::: "memory")
#define PG8_WAIT_L(n) asm volatile("s_waitcnt lgkmcnt(" #n ")" ::: "memory")
#define PG8_BAR __builtin_amdgcn_s_barrier()
#define PG8_SCHED __builtin_amdgcn_sched_barrier(0)
    Unit cur, nxt; int ui = 0;
    if (!S.next(0, cur)) return;
    f32x4 acc[2][2][4][2];
#pragma unroll
    for (int a = 0; a < 2; ++a)
#pragma unroll
        for (int b = 0; b < 2; ++b)
#pragma unroll
            for (int m = 0; m < 4; ++m)
#pragma unroll
                for (int n = 0; n < 2; ++n) acc[a][b][m][n] = (f32x4){0.f, 0.f, 0.f, 0.f};
    bf16x8 At[4][2], B0[2][2], B1[2][2];
    const char* cA = S.a_ptr(cur); const char* cB = S.b_ptr(cur);
    PG8_STAGE(PG8_SB(0, 0), cB, voffB); PG8_STAGE(PG8_SA(0, 0), cA, voffA); PG8_STAGE(PG8_SB(0, 1), cB + hstep, voffB); PG8_STAGE(PG8_SA(0, 1), cA + hstep, voffA);
    if (wr == 1) PG8_BAR;
    PG8_WAIT_V(4); PG8_BAR;
    PG8_STAGE(PG8_SB(1, 0), cB + kstep, voffB); PG8_STAGE(PG8_SA(1, 0), cA + kstep, voffA); PG8_STAGE(PG8_SB(1, 1), cB + hstep + kstep, voffB);
    PG8_WAIT_V(6); PG8_BAR;
    for (;;) {
        const bool has_next = S.next(ui + 1, nxt);
        const char* nA = has_next ? S.a_ptr(nxt) : cA; const char* nB = has_next ? S.b_ptr(nxt) : cB;
        for (int t = 0; t < nt; t += 2) {
            const bool last = (t == nt - 2);
            const char* a1 = cA + (size_t)(t + 1) * kstep;
            const char* a2 = last ? nA : cA + (size_t)(t + 2) * kstep; const char* b2 = last ? nB : cB + (size_t)(t + 2) * kstep;
            const char* a3 = a2 + kstep; const char* b3 = b2 + kstep;
            PG8_LDB(B0, 0, 0); PG8_SCHED; PG8_LDA(At, 0, 0); PG8_STAGE(PG8_SA(1, 1), a1 + hstep, voffA);
            PG8_WAIT_L(8); PG8_BAR; PG8_WAIT_L(0); PG8_MMA(0, 0, At, B0); PG8_BAR; PG8_SCHED;
            PG8_LDB(B1, 0, 1); PG8_STAGE(PG8_SB(0, 0), b2, voffB);
            PG8_BAR; PG8_WAIT_L(0); PG8_MMA(0, 1, At, B1); PG8_BAR;
            PG8_LDA(At, 0, 1); PG8_STAGE(PG8_SA(0, 0), a2, voffA);
            PG8_BAR; PG8_WAIT_L(0); PG8_MMA(1, 0, At, B0); PG8_BAR; PG8_SCHED;
            PG8_STAGE(PG8_SB(0, 1), b2 + hstep, voffB);
            PG8_WAIT_V(6); PG8_BAR; PG8_MMA(1, 1, At, B1); PG8_BAR;
            PG8_LDB(B0, 1, 0); PG8_SCHED; PG8_LDA(At, 1, 0); PG8_STAGE(PG8_SA(0, 1), a2 + hstep, voffA);
            PG8_WAIT_L(8); PG8_BAR; PG8_WAIT_L(0); PG8_MMA(0, 0, At, B0); PG8_BAR; PG8_SCHED;
            PG8_LDB(B1, 1, 1); PG8_STAGE(PG8_SB(1, 0), b3, voffB);
            PG8_BAR; PG8_WAIT_L(0); PG8_MMA(0, 1, At, B1); PG8_BAR;
            PG8_LDA(At, 1, 1); PG8_STAGE(PG8_SA(1, 0), a3, voffA);
            PG8_BAR; PG8_WAIT_L(0); PG8_MMA(1, 0, At, B0); PG8_BAR; PG8_SCHED;
            PG8_STAGE(PG8_SB(1, 1), b3 + hstep, voffB);
            PG8_WAIT_V(6); PG8_BAR; PG8_MMA(1, 1, At, B1); PG8_BAR;
        }
        E(acc, cur, wr, wc, fr, fq);
        if (!has_next) break;
#pragma unroll
        for (int a = 0; a < 2; ++a)
#pragma unroll
            for (int b = 0; b < 2; ++b)
#pragma unroll
                for (int m = 0; m < 4; ++m)
#pragma unroll
                    for (int n = 0; n < 2; ++n) acc[a][b][m][n] = (f32x4){0.f, 0.f, 0.f, 0.f};
        cur = nxt; cA = nA; cB = nB; ++ui;
    }
    PG8_WAIT_V(0);
    if (wr == 0) PG8_BAR;
    PG8_BAR;
#undef PG8_SA
#undef PG8_SB
#undef PG8_STAGE
#undef PG8_LDA
#undef PG8_LDB
#undef PG8_MMA
#undef PG8_WAIT_V
#undef PG8_WAIT_L
#undef PG8_BAR
#undef PG8_SCHED
}
}
using pg8::Unit;

struct SchedIn {
    pg8::OrderBase ob; int seg; const char* A; const char* B;
    __device__ bool next(int i, Unit& u) const { return ob.nextb(i, u); }
    __device__ const char* a_ptr(const Unit& u) const {
        const int gt = u.pm < LT_PROMPT ? ((u.pm / TPB) * (SEQ / 256) + seg * TPB + (u.pm % TPB)) : (XROWS / 256 + (u.pm - LT_PROMPT));
        return A + (size_t)gt * 256 * D * 2; }
    __device__ const char* b_ptr(const Unit& u) const { return B + (size_t)u.pn * 256 * D * 2; }
};
struct SchedAB {
    pg8::OrderBase ob; int pm0; const char* A0; const char* A1; const char* B0; const char* B1;
    __device__ bool next(int i, Unit& u) const { const bool ok = ob.nextb(i >> 1, u); u.pm += pm0; u.w = i & 1; return ok; }
    __device__ const char* a_ptr(const Unit& u) const { return (u.w ? A1 : A0) + (size_t)u.pm * 256 * D * 2; }
    __device__ const char* b_ptr(const Unit& u) const { return (u.w ? B1 : B0) + (size_t)u.pn * 256 * D * 2; }
};
struct SchedO {
    pg8::OrderBase ob; int pm0; const char* A; const char* B;
    __device__ bool next(int i, Unit& u) const { const bool ok = ob.nextb(i, u); u.pm += pm0; return ok; }
    __device__ const char* a_ptr(const Unit& u) const { return A + (size_t)u.pm * 256 * D * 2; }
    __device__ const char* b_ptr(const Unit& u) const { return B + (size_t)u.pn * 256 * D * 2; }
};

struct EpiIn {
    static constexpr bool PERM = true;
    bf16_t* P; bf16_t* gex; float* out; int seg;
    __device__ __forceinline__ void operator()(const f32x4 (&acc)[2][2][4][2], const Unit& u, int wr, int wc, int fr, int fq) const {
        const int lr0 = u.pm * 256 + wr * 64 + fr;
        const int c0 = u.pn * 256 + wc * 32 + 8 * fq;
#pragma unroll
        for (int ai = 0; ai < 2; ++ai)
#pragma unroll
            for (int m = 0; m < 4; ++m) {
                const int lr = lr0 + ai * 128 + m * 16;
                bf16_t* rowp;
                if (u.pn < NT_PB) rowp = P + (size_t)lr * NPB + c0;
                else if (lr < LEX0) { const int b = lr / SEGTOK; const size_t grow = (size_t)b * SEQ + seg * SEGTOK + (lr % SEGTOK); rowp = (bf16_t*)(out + O_YP + grow * D) + (c0 - NPB); }
                else rowp = gex + (size_t)(lr - LEX0) * 2048 + (c0 - NPB);
#pragma unroll
                for (int bj = 0; bj < 2; ++bj) { const f32x4 v0 = acc[ai][bj][m][0], v1 = acc[ai][bj][m][1];
                    u32x4 w; w.x = cvt_pk_bf16(v0[0], v0[1]); w.y = cvt_pk_bf16(v0[2], v0[3]); w.z = cvt_pk_bf16(v1[0], v1[1]); w.w = cvt_pk_bf16(v1[2], v1[3]);
                    *(u32x4*)(rowp + bj * 128) = w; }
            }
    }
};
struct EpiAB {
    static constexpr bool PERM = true;
    bf16_t* tmp; bf16_t* merged; const bf16_t* gex; const float* out;
    __device__ __forceinline__ void operator()(const f32x4 (&acc)[2][2][4][2], const Unit& u, int wr, int wc, int fr, int fq) const {
        const int row0 = u.pm * 256 + wr * 64 + fr, col0 = u.pn * 256 + wc * 32 + 8 * fq;
#pragma unroll
        for (int ai = 0; ai < 2; ++ai)
#pragma unroll
            for (int m = 0; m < 4; ++m) {
                const int grow = row0 + ai * 128 + m * 16;
                const bf16_t* gp = (grow < XROWS) ? ((const bf16_t*)(out + O_YP + (size_t)grow * D) + u.w * D) : (gex + (size_t)(grow - XROWS) * 2048 + u.w * D);
#pragma unroll
                for (int bj = 0; bj < 2; ++bj) {
                    const int c = col0 + bj * 128;
                    float g[8]; unpack8(*(const u32x4*)(gp + c), g);
                    const f32x4 v0 = acc[ai][bj][m][0], v1 = acc[ai][bj][m][1];
                    float v[8] = {v0[0] * sigm(g[0]), v0[1] * sigm(g[1]), v0[2] * sigm(g[2]), v0[3] * sigm(g[3]), v1[0] * sigm(g[4]), v1[1] * sigm(g[5]), v1[2] * sigm(g[6]), v1[3] * sigm(g[7])};
                    bf16_t* tp = tmp + (size_t)grow * D + c;
                    if (u.w == 0) *(u32x4*)tp = pack8(v);
                    else { float t[8]; unpack8(*(const u32x4*)tp, t);
#pragma unroll
                        for (int e = 0; e < 8; ++e) v[e] += t[e];
                        *(u32x4*)(merged + (size_t)grow * D + c) = pack8(v); }
                }
            }
    }
};
struct EpiO {
    static constexpr bool PERM = false;
    float* out; const float* xp; const float* xs;
    __device__ __forceinline__ void operator()(const f32x4 (&acc)[2][2][4][2], const Unit& u, int wr, int wc, int fr, int fq) const {
        const int row0 = u.pm * 256 + wr * 64 + fr, col0 = u.pn * 256 + wc * 32 + 4 * fq;
#pragma unroll
        for (int ai = 0; ai < 2; ++ai)
#pragma unroll
            for (int m = 0; m < 4; ++m) {
                const int grow = row0 + ai * 128 + m * 16;
                const float* xr; float* yr;
                if (grow < XROWS) { xr = xp + (size_t)grow * D; yr = out + O_YP + (size_t)grow * D; }
                else { const int e = grow - XROWS; if (e < EX_SAMP || e >= EX_SHIFT) continue; xr = xs + (size_t)(e - EX_SAMP) * D; yr = out + O_YS + (size_t)(e - EX_SAMP) * D; }
#pragma unroll
                for (int bj = 0; bj < 2; ++bj)
#pragma unroll
                    for (int n = 0; n < 2; ++n) { const int c = col0 + bj * 128 + n * 16; *(f32x4*)(yr + c) = *(const f32x4*)(xr + c) + acc[ai][bj][m][n]; }
            }
    }
};

__device__ __forceinline__ void p0_row(const Params& p, int r, int lane) {
    bf16_t* hrow = (bf16_t*)(p.ws + WS_H) + (size_t)r * D;
    const float* src = nullptr; bool norm = true; float* sh = nullptr;
    if (r < XROWS) { src = p.in[0] + (size_t)r * D; if ((r & (SEQ - 1)) == SEQ - 1) sh = p.out + O_SHIFT_P + (size_t)(r / SEQ) * D; }
    else { const int e = r - XROWS;
        if (e < EX_SAMP) src = p.in[6] + (size_t)e * D;
        else if (e < EX_SHIFT) { src = p.in[1] + (size_t)(e - EX_SAMP) * D; if (((e - EX_SAMP) & 3) == 3) sh = p.out + O_SHIFT_S + (size_t)((e - EX_SAMP) >> 2) * D; }
        else if (e < EX_END) { src = p.in[5] + (size_t)(e - EX_SHIFT) * D; norm = false; } }
    u32x2* o8 = (u32x2*)hrow + lane;
    if (!src) {
#pragma unroll
        for (int j = 0; j < 4; ++j) o8[64 * j] = (u32x2){0u, 0u};
        return; }
    const f32x4* xr = (const f32x4*)src + lane;
    f32x4 v[4]; float ss = 0.f;
#pragma unroll
    for (int j = 0; j < 4; ++j) { v[j] = xr[64 * j]; ss += v[j][0] * v[j][0] + v[j][1] * v[j][1] + v[j][2] * v[j][2] + v[j][3] * v[j][3]; }
    if (norm) {
        const float rs = __builtin_amdgcn_rsqf(wave_sum(ss) * (1.f / D) + 1e-6f);
        const f32x4* wr = (const f32x4*)p.in[7] + lane;
#pragma unroll
        for (int j = 0; j < 4; ++j) v[j] = v[j] * rs * wr[64 * j];
    }
#pragma unroll
    for (int j = 0; j < 4; ++j) { o8[64 * j] = (u32x2){pk2(v[j][0], v[j][1]), pk2(v[j][2], v[j][3])}; if (sh) ((f32x4*)sh)[lane + 64 * j] = v[j]; }
}
template <int MODE> __device__ __forceinline__ void p0_tr_item(const float* W, int N, bf16_t* WT, float* scr, int kb, int nb, int lane) {
    const int k0 = 64 * kb, n0 = 32 * nb;
    const int l8 = lane & 7, r8 = lane >> 3;
    const int nn = n0 + 4 * l8;
    int srcc = nn;
    if (MODE == 1) srcc = nn < C_GATE_REF ? nn : (nn < NPB ? -1 : nn - (NPB - C_GATE_REF));
    f32x4 v[8];
#pragma unroll
    for (int i = 0; i < 8; ++i) { const int kk = 8 * i + r8; v[i] = srcc >= 0 ? *(const f32x4*)(W + (size_t)(k0 + kk) * N + srcc) : (f32x4){0.f, 0.f, 0.f, 0.f}; }
#pragma unroll
    for (int i = 0; i < 8; ++i) { const int kk = 8 * i + r8; float* d = scr + kk * 33 + 4 * l8; d[0] = v[i][0]; d[1] = v[i][1]; d[2] = v[i][2]; d[3] = v[i][3]; }
    asm volatile("s_waitcnt lgkmcnt(0)" ::: "memory");
    const int c = lane & 7;
#pragma unroll
    for (int j = 0; j < 4; ++j) { const int n = (lane >> 3) + 8 * j; const float* s = scr + (8 * c) * 33 + n;
        u32x4 o; o.x = pk2(s[0 * 33], s[1 * 33]); o.y = pk2(s[2 * 33], s[3 * 33]); o.z = pk2(s[4 * 33], s[5 * 33]); o.w = pk2(s[6 * 33], s[7 * 33]);
        *(u32x4*)(WT + (size_t)(n0 + n) * D + k0 + 8 * c) = o; }
    asm volatile("s_waitcnt lgkmcnt(0)" ::: "memory");
}
__device__ __forceinline__ void h_rows_pair(const Params& p, int r, int r1, bool has1, int lane, const f32x4 (&wv)[4]) {
    const f32x4* x0 = (const f32x4*)(p.in[0] + (size_t)r * D) + lane; const f32x4* x1 = (const f32x4*)(p.in[0] + (size_t)(has1 ? r1 : r) * D) + lane;
    f32x4 a[4], b[4]; float s0 = 0.f, s1 = 0.f;
#pragma unroll
    for (int j = 0; j < 4; ++j) { a[j] = x0[64 * j]; b[j] = x1[64 * j]; }
#pragma unroll
    for (int j = 0; j < 4; ++j) { s0 += a[j][0] * a[j][0] + a[j][1] * a[j][1] + a[j][2] * a[j][2] + a[j][3] * a[j][3]; s1 += b[j][0] * b[j][0] + b[j][1] * b[j][1] + b[j][2] * b[j][2] + b[j][3] * b[j][3]; }
    const float q0 = __builtin_amdgcn_rsqf(wave_sum(s0) * (1.f / D) + 1e-6f), q1 = __builtin_amdgcn_rsqf(wave_sum(s1) * (1.f / D) + 1e-6f);
    u32x2* o0 = (u32x2*)((bf16_t*)(p.ws + WS_H) + (size_t)r * D) + lane; u32x2* o1 = (u32x2*)((bf16_t*)(p.ws + WS_H) + (size_t)r1 * D) + lane;
#pragma unroll
    for (int j = 0; j < 4; ++j) { a[j] = a[j] * q0 * wv[j]; o0[64 * j] = (u32x2){pk2(a[j][0], a[j][1]), pk2(a[j][2], a[j][3])}; }
    if ((r & (SEQ - 1)) == SEQ - 1) { f32x4* sh = (f32x4*)(p.out + O_SHIFT_P + (size_t)(r / SEQ) * D) + lane;
#pragma unroll
        for (int j = 0; j < 4; ++j) sh[64 * j] = a[j]; }
    if (has1) {
#pragma unroll
        for (int j = 0; j < 4; ++j) { b[j] = b[j] * q1 * wv[j]; o1[64 * j] = (u32x2){pk2(b[j][0], b[j][1]), pk2(b[j][2], b[j][3])}; }
        if ((r1 & (SEQ - 1)) == SEQ - 1) { f32x4* sh = (f32x4*)(p.out + O_SHIFT_P + (size_t)(r1 / SEQ) * D) + lane;
#pragma unroll
            for (int j = 0; j < 4; ++j) sh[64 * j] = b[j]; }
    }
}
__device__ __forceinline__ void h_rows_segs(const Params& p, int s_lo, int s_hi, int wi, int nw, int lane) {
    const f32x4* lw = (const f32x4*)p.in[7] + lane;
    f32x4 wv[4];
#pragma unroll
    for (int j = 0; j < 4; ++j) wv[j] = lw[64 * j];
    const int n = (s_hi - s_lo) * NBATCH * SEGTOK;
#pragma unroll 1
    for (int x = wi; x < n; x += 2 * nw) {
        const int x1 = x + nw; const bool has1 = x1 < n;
        const int sg = s_lo + x / (NBATCH * SEGTOK), rem = x % (NBATCH * SEGTOK), r = (rem / SEGTOK) * SEQ + sg * SEGTOK + (rem % SEGTOK);
        const int xx = has1 ? x1 : x; const int sg1 = s_lo + xx / (NBATCH * SEGTOK), rem1 = xx % (NBATCH * SEGTOK), r1 = (rem1 / SEGTOK) * SEQ + sg1 * SEGTOK + (rem1 % SEGTOK);
        h_rows_pair(p, r, r1, has1, lane, wv);
    }
}
__device__ __forceinline__ void phase0(const Params& p, unsigned char* smem) {
    const int tid0 = otid(), wave = tid0 >> 6, lane = tid0 & 63;
    const int gw = obid() * 8 + wave, NGW = gridDim.x * 8;
    float* scr = (float*)smem + wave * (64 * 33);
    constexpr int I_IN = 16 * (NP / 32), I_SQ = 16 * 32;
    for (int it = gw; it < I_IN + 3 * I_SQ; it += NGW) {
        int r = it;
        if (r < I_IN) { p0_tr_item<1>(p.in[8], 10384, (bf16_t*)(p.ws + WS_WT_IN), scr, r / (NP / 32), r % (NP / 32), lane); continue; } r -= I_IN;
        if (r < I_SQ) { p0_tr_item<0>(p.in[13], D, (bf16_t*)(p.ws + WS_WT_A), scr, r / 32, r % 32, lane); continue; } r -= I_SQ;
        if (r < I_SQ) { p0_tr_item<0>(p.in[24], D, (bf16_t*)(p.ws + WS_WT_B), scr, r / 32, r % 32, lane); continue; } r -= I_SQ;
        p0_tr_item<0>(p.in[25], D, (bf16_t*)(p.ws + WS_WT_O), scr, r / 32, r % 32, lane);
    }
    h_rows_segs(p, 0, 2, gw, NGW, lane);
    for (int r = XROWS + gw; r < HROWS; r += NGW) p0_row(p, r, lane);
    {
        float* pk = (float*)(p.ws + WS_PK);
        const int gt = obid() * 512 + tid0, NT = gridDim.x * 512;
        for (int i = gt; i < PK_END; i += NT) {
            const float* src; int o;
            if (i < PK_ALOG) { src = p.in[9]; o = i - PK_CONVW; } else if (i < PK_DTB) { src = p.in[10]; o = i - PK_ALOG; } else if (i < PK_NORMW) { src = p.in[11]; o = i - PK_DTB; }
            else if (i < PK_MU) { src = p.in[12]; o = i - PK_NORMW; } else if (i < PK_W0) { src = p.in[14]; o = i - PK_MU; } else if (i < PK_W2) { src = p.in[15]; o = i - PK_W0; }
            else if (i < PK_A0) { src = p.in[16]; o = i - PK_W2; } else if (i < PK_A2) { src = p.in[17]; o = i - PK_A0; } else if (i < PK_KK) { src = p.in[18]; o = i - PK_A2; }
            else if (i < PK_KA) { src = p.in[19]; o = i - PK_KK; } else if (i < PK_RK) { src = p.in[20]; o = i - PK_KA; } else if (i < PK_GNW) { src = p.in[21]; o = i - PK_RK; }
            else if (i < PK_GNB) { src = p.in[22]; o = i - PK_GNW; } else if (i < PK_LNF) { src = p.in[23]; o = i - PK_GNB; } else { src = p.in[26]; o = i - PK_LNF; }
            pk[i] = src[o];
        }
        bf16_t* w2t = (bf16_t*)(p.ws + WS_W2T); bf16_t* a2t = (bf16_t*)(p.ws + WS_A2T);
        for (int i = gt; i < 65536; i += NT) { const int l = i & 63, c = (i >> 6) & 63, hb = i >> 12;
            w2t[i] = (bf16_t)f2bf(p.in[16][(size_t)l * D + hb * 64 + c]); a2t[i] = (bf16_t)f2bf(p.in[18][(size_t)l * D + hb * 64 + c]); }
    }
}

__device__ __forceinline__ void gdn_item(const Params& p, unsigned char* smem, const float* s_in, float* s_out, const float* halo_in, float* halo_out,
                                         int h, int sl, int rowA, int nA, int rowB, int nB) {
    const int tid = otid(), w = tid >> 6, lane = tid & 63, vl = lane >> 4, kg = lane & 15;
    float* qk_s = (float*)smem; float* v_s = qk_s + 16384; float* o_s = v_s + 2048; float* gb_s = o_s + 2048; float* sst = gb_s + 128;
    const bf16_t* P = (const bf16_t*)(p.ws + WS_P);
    float* ORAW = (float*)(p.ws + WS_ORAW);
    float s[8];
    if (s_in) {
        { const int k = tid >> 2, q4 = tid & 3; const f32x4* src = (const f32x4*)(s_in + (size_t)k * 128 + sl * 32 + q4 * 8); const f32x4 a = src[0], b = src[1];
          float* d = sst + k * 33 + q4 * 8; d[0] = a[0]; d[1] = a[1]; d[2] = a[2]; d[3] = a[3]; d[4] = b[0]; d[5] = b[1]; d[6] = b[2]; d[7] = b[3]; }
        __syncthreads();
#pragma unroll
        for (int j = 0; j < 8; ++j) s[j] = sst[(kg * 8 + j) * 33 + 4 * w + vl];
        __syncthreads();
    } else {
#pragma unroll
        for (int j = 0; j < 8; ++j) s[j] = 0.f;
    }
    int pcol = -1;
    if (tid < 128) pcol = h * 128 + tid; else if (tid < 256) pcol = 1024 + h * 128 + (tid - 128); else if (tid < 288) pcol = 2048 + h * 128 + sl * 32 + (tid - 256);
    float cw0 = 0.f, cw1 = 0.f, cw2 = 0.f, cw3 = 0.f, x1 = 0.f, x2 = 0.f, x3 = 0.f;
    const float* pk = (const float*)(p.ws + WS_PK);
    if (pcol >= 0) { const float* cw = pk + PK_CONVW; cw0 = cw[pcol]; cw1 = cw[3072 + pcol]; cw2 = cw[6144 + pcol]; cw3 = cw[9216 + pcol];
        if (halo_in) { x3 = halo_in[pcol]; x2 = halo_in[3072 + pcol]; x1 = halo_in[6144 + pcol]; } }
    const float nalog = -expf(pk[PK_ALOG + h]), dtb = pk[PK_DTB + h];
#pragma unroll 1
    for (int run = 0; run < 2; ++run) {
        const int rrow = run ? rowB : rowA, rn = run ? nB : nA; const bool wout = run != 0;
#pragma unroll 1
        for (int c0 = 0; c0 < rn; c0 += 64) {
            const int nt = (rn - c0) < 64 ? (rn - c0) : 64; const int row = rrow + c0;
            if (pcol >= 0) {
                const bf16_t* src = P + (size_t)row * NPB + pcol;
                float* dst = tid < 256 ? (qk_s + tid) : (v_s + (tid - 256)); const int dstride = tid < 256 ? 256 : 32;
#pragma unroll 8
                for (int i = 0; i < nt; ++i) { const float x0 = bf2f(src[(size_t)i * NPB]); const float y = cw0 * x3 + cw1 * x2 + cw2 * x1 + cw3 * x0; x3 = x2; x2 = x1; x1 = x0; dst[i * dstride] = silu_(y); }
            } else if (tid < 352) {
                const int i = tid - 288;
                if (i < nt) { const float pa = bf2f(P[(size_t)(row + i) * NPB + C_A + h]), pb = bf2f(P[(size_t)(row + i) * NPB + C_B + h]);
                    gb_s[2 * i] = expf(nalog * softplus_(pa + dtb)); gb_s[2 * i + 1] = sigm(pb); }
            }
            __syncthreads();
#pragma unroll 1
            for (int ii = 0; ii < 8; ++ii) { const int i = w * 8 + ii;
                if (i < nt) {
#pragma unroll
                    for (int which = 0; which < 2; ++which) { float* rp = qk_s + i * 256 + which * 128; const float a = rp[lane], b = rp[lane + 64];
                        const float sc = __builtin_amdgcn_rsqf(wave_sum(a * a + b * b) + 1e-6f) * (which == 0 ? 0.08838834764831845f : 1.f); rp[lane] = a * sc; rp[lane + 64] = b * sc; } } }
            __syncthreads();
#pragma unroll 1
            for (int i = 0; i < nt; ++i) {
                const f32x4 q0 = *(const f32x4*)(qk_s + i * 256 + kg * 8), q1 = *(const f32x4*)(qk_s + i * 256 + kg * 8 + 4);
                const f32x4 k0 = *(const f32x4*)(qk_s + i * 256 + 128 + kg * 8), k1 = *(const f32x4*)(qk_s + i * 256 + 128 + kg * 8 + 4);
                const float vv = v_s[i * 32 + 4 * w + vl], a = gb_s[2 * i], be = gb_s[2 * i + 1];
                float part = k0[0] * s[0] + k0[1] * s[1] + k0[2] * s[2] + k0[3] * s[3] + k1[0] * s[4] + k1[1] * s[5] + k1[2] * s[6] + k1[3] * s[7];
                const float kS = rowsum16(part);
                const float c = be * (vv - a * kS);
                s[0] = a * s[0] + k0[0] * c; s[1] = a * s[1] + k0[1] * c; s[2] = a * s[2] + k0[2] * c; s[3] = a * s[3] + k0[3] * c;
                s[4] = a * s[4] + k1[0] * c; s[5] = a * s[5] + k1[1] * c; s[6] = a * s[6] + k1[2] * c; s[7] = a * s[7] + k1[3] * c;
                float op = q0[0] * s[0] + q0[1] * s[1] + q0[2] * s[2] + q0[3] * s[3] + q1[0] * s[4] + q1[1] * s[5] + q1[2] * s[6] + q1[3] * s[7];
                const float o = rowsum16(op);
                if (kg == 0) o_s[i * 32 + 4 * w + vl] = o;
            }
            __syncthreads();
            if (wout) { const int i = tid >> 3, c4 = (tid & 7) * 4; if (i < nt) *(f32x4*)(ORAW + (size_t)(row + i) * D + h * 128 + sl * 32 + c4) = *(const f32x4*)(o_s + i * 32 + c4); }
        }
    }
    if (pcol >= 0 && (sl == 0 || tid >= 256)) { halo_out[pcol] = x3; halo_out[3072 + pcol] = x2; halo_out[6144 + pcol] = x1; }
#pragma unroll
    for (int j = 0; j < 8; ++j) sst[(kg * 8 + j) * 33 + 4 * w + vl] = s[j];
    __syncthreads();
    { const int k = tid >> 2, q4 = tid & 3; const float* d = sst + k * 33 + q4 * 8; f32x4* dst = (f32x4*)(s_out + (size_t)k * 128 + sl * 32 + q4 * 8);
      dst[0] = (f32x4){d[0], d[1], d[2], d[3]}; dst[1] = (f32x4){d[4], d[5], d[6], d[7]}; }
    __syncthreads();
}

constexpr int RW_W2 = 20544, RW_A2 = 24640;
__device__ __forceinline__ void rwkv_load_lora(const Params& p, unsigned char* smem, int hb) {
    float* w2_s = (float*)smem + RW_W2; float* a2_s = (float*)smem + RW_A2; const float* pk = (const float*)(p.ws + WS_PK);
    for (int i = otid(); i < 4096; i += 512) { const int l = i >> 6, c = i & 63; w2_s[i] = pk[PK_W2 + l * D + hb * 64 + c]; a2_s[i] = pk[PK_A2 + l * D + hb * 64 + c]; }
    __syncthreads();
}
__device__ __forceinline__ void rwkv_item(const Params& p, unsigned char* smem, const float* s_in, float* s_out, const bf16_t* prev_row, const float* halo_in, float* halo_out,
                                          int hb, int half, int rowA, int nA, int rowB, int nB) {
    const int tid = otid(), w = tid >> 6, lane = tid & 63, row = tid >> 4, kq = tid & 15;
    float* f = (float*)smem;
    float* r_s = f; float* kb_s = f + 2048; float* v_s = f + 4096; float* wd_s = f + 6144; float* ad_s = f + 8192; float* dec_s = f + 10240; float* a_s = f + 12288;
    float* kk_s = f + 14336; float* km_s = f + 16384; float* zb_s = f + 18432; float* y_s = f + 19456; float* bonus_s = f + 20480;
    const float* w2_s = f + RW_W2; const float* a2_s = f + RW_A2;
    const bf16_t* P = (const bf16_t*)(p.ws + WS_P);
    float* YRAW = (float*)(p.ws + WS_YRAW); bf16_t* C0 = (bf16_t*)(p.ws + WS_C0); bf16_t* C1 = (bf16_t*)(p.ws + WS_C1);
    float s[4];
    if (s_in) { const f32x4 t = *(const f32x4*)(s_in + (size_t)(half * 32 + row) * 64 + kq * 4); s[0] = t[0]; s[1] = t[1]; s[2] = t[2]; s[3] = t[3]; }
    else { s[0] = s[1] = s[2] = s[3] = 0.f; }
    int col = -1; float* dst = nullptr; int dstride = 64; bool is_wd = false, owner = false;
    if (tid < 64) { col = hb * 64 + tid; dst = r_s + tid; owner = half == 0; }
    else if (tid < 128) { col = 1024 + hb * 64 + (tid - 64); dst = kb_s + (tid - 64); owner = half == 0; }
    else if (tid < 192) { col = 2048 + hb * 64 + (tid - 128); dst = v_s + (tid - 128); owner = half == 0; }
    else if (tid < 256) { col = 3072 + (tid - 192); dst = wd_s + (tid - 192); is_wd = true; owner = (half == 0 && hb == 0); }
    else if (tid < 320) { col = 3136 + (tid - 256); dst = ad_s + (tid - 256); owner = (half == 0 && hb == 0); }
    else if (tid < 352) { col = 3200 + hb * 64 + half * 32 + (tid - 320); dst = zb_s + (tid - 320); dstride = 32; owner = true; }
    float mu = 0.f, prev = 0.f;
    const float* pk = (const float*)(p.ws + WS_PK);
    if (col >= 0) { mu = pk[PK_MU + col]; prev = prev_row ? bf2f(prev_row[C_RW + col]) : (halo_in ? halo_in[col] : 0.f); }
    const int cc = tid & 63, ig = tid >> 6;
    const int hc = hb * 64 + cc;
    const float w0c = pk[PK_W0 + hc], a0c = pk[PK_A0 + hc], kkc = pk[PK_KK + hc], kac = pk[PK_KA + hc];
    const float rkl = pk[PK_RK + hb * 64 + lane];
#pragma unroll 1
    for (int run = 0; run < 2; ++run) {
        const int rrow = run ? rowB : rowA, rn = run ? nB : nA; const bool wout = run != 0;
#pragma unroll 1
        for (int c0 = 0; c0 < rn; c0 += 32) {
            const int nt = (rn - c0) < 32 ? (rn - c0) : 32; const int row0 = rrow + c0;
            if (col >= 0) {
                const bf16_t* src = P + (size_t)row0 * NPB + C_RW + col;
#pragma unroll 8
                for (int i = 0; i < nt; ++i) { const float cur = bf2f(src[(size_t)i * NPB]); float m = cur + mu * (prev - cur); prev = cur; if (is_wd) m = tanh_(m); dst[i * dstride] = m; }
            }
            __syncthreads();
            {
                float aw[4] = {0.f, 0.f, 0.f, 0.f}, aa[4] = {0.f, 0.f, 0.f, 0.f};
#pragma unroll 4
                for (int l = 0; l < 64; ++l) { const float w2v = w2_s[l * 64 + cc], a2v = a2_s[l * 64 + cc];
#pragma unroll
                    for (int ii = 0; ii < 4; ++ii) { aw[ii] += wd_s[(ig * 4 + ii) * 64 + l] * w2v; aa[ii] += ad_s[(ig * 4 + ii) * 64 + l] * a2v; } }
#pragma unroll
                for (int ii = 0; ii < 4; ++ii) { const int i = ig * 4 + ii;
                    if (i < nt) { const float wraw = w0c + aw[ii]; const float wlog = -0.6065306597126334f * sigm(wraw); const float a = sigm(a0c + aa[ii]);
                        const float kbv = kb_s[i * 64 + cc];
                        dec_s[i * 64 + cc] = expf(wlog); a_s[i * 64 + cc] = a; kk_s[i * 64 + cc] = kbv * kkc; km_s[i * 64 + cc] = kbv * (1.f + (a - 1.f) * kac); } }
            }
            __syncthreads();
#pragma unroll 1
            for (int ii = 0; ii < 4; ++ii) { const int i = w * 4 + ii;
                if (i < nt) { const float kkr = kk_s[i * 64 + lane]; const float kk = kkr * __builtin_amdgcn_rsqf(wave_sum(kkr * kkr) + 1e-6f); kk_s[i * 64 + lane] = kk;
                    const float a = a_s[i * 64 + lane]; a_s[i * 64 + lane] = kk * a;
                    const float rk = wave_sum(r_s[i * 64 + lane] * km_s[i * 64 + lane] * rkl); if (lane == 0) bonus_s[i] = rk; } }
            __syncthreads();
#pragma unroll 1
            for (int i = 0; i < nt; ++i) {
                const f32x4 kk4 = *(const f32x4*)(kk_s + i * 64 + kq * 4), de4 = *(const f32x4*)(dec_s + i * 64 + kq * 4), ka4 = *(const f32x4*)(a_s + i * 64 + kq * 4),
                            km4 = *(const f32x4*)(km_s + i * 64 + kq * 4), r4 = *(const f32x4*)(r_s + i * 64 + kq * 4);
                const float vv = v_s[i * 64 + half * 32 + row];
                const float sa = rowsum16(s[0] * kk4[0] + s[1] * kk4[1] + s[2] * kk4[2] + s[3] * kk4[3]);
#pragma unroll
                for (int j = 0; j < 4; ++j) s[j] = s[j] * de4[j] + (vv * km4[j] - sa * ka4[j]);
                const float y = rowsum16(s[0] * r4[0] + s[1] * r4[1] + s[2] * r4[2] + s[3] * r4[3]);
                if (kq == 0) y_s[i * 32 + row] = y;
            }
            __syncthreads();
            if (wout) { const int i = tid >> 4;
                if (i < nt) {
#pragma unroll
                    for (int q = 0; q < 2; ++q) { const int rr = (tid & 15) * 2 + q, v = half * 32 + rr, colo = hb * 64 + v;
                        const float sz = silu_(zb_s[i * 32 + rr]);
                        const size_t o = (size_t)(row0 + i) * D + colo;
                        YRAW[o] = y_s[i * 32 + rr]; C1[o] = (bf16_t)f2bf(pk[PK_GNW + colo] * sz); C0[o] = (bf16_t)f2bf((pk[PK_GNB + colo] + bonus_s[i] * v_s[i * 64 + v]) * sz); } } }
            __syncthreads();
        }
    }
    *(f32x4*)(s_out + (size_t)(half * 32 + row) * 64 + kq * 4) = (f32x4){s[0], s[1], s[2], s[3]};
    if (col >= 0 && owner && halo_out) halo_out[col] = prev;
}


__device__ __forceinline__ bf16x8 ldfrag(const bf16_t* base, int stride, int r0, int k0, int lane) {
    return *(const bf16x8*)(base + (r0 + (lane & 15)) * stride + k0 + 8 * (lane >> 4));
}
#define MFMA16(a, b, c) __builtin_amdgcn_mfma_f32_16x16x32_bf16((a), (b), (c), 0, 0, 0)
typedef short s16x4 __attribute__((ext_vector_type(4)));
__device__ __forceinline__ bf16x8 ldfrag_tr(const bf16_t* X, int stride, int c0, int k0, int lane) {
    const int l15 = lane & 15;
    const bf16_t* a = X + (k0 + 8 * (lane >> 4) + (l15 >> 2)) * stride + c0 + 4 * (l15 & 3);
    const s16x4 lo = __builtin_amdgcn_ds_read_tr16_b64_v4i16((LAS s16x4*)a), hi = __builtin_amdgcn_ds_read_tr16_b64_v4i16((LAS s16x4*)(a + 4 * stride));
    return __builtin_shufflevector(lo, hi, 0, 1, 2, 3, 4, 5, 6, 7);
}
__device__ __forceinline__ void inv_block(const float* L, float* Tm, float* XS, int tid) {
    const int w = tid >> 6, lane = tid & 63;
    typedef float f32x2v __attribute__((ext_vector_type(2)));
    if (w < 4 && lane < 16) {
        const float* Lb = L + (16 * w) * 64 + 16 * w; float* Tb = Tm + (16 * w) * 64 + 16 * w;
        float tr[16];
#pragma unroll
        for (int i = 0; i < 16; ++i) tr[i] = 0.f;
#pragma unroll
        for (int i = 0; i < 16; ++i) { float a = (lane == i) ? 1.f : 0.f;
#pragma unroll
            for (int j0 = 0; j0 < i; j0 += 4) { const f32x4 l4 = *(const f32x4*)(Lb + i * 64 + j0);
                a -= l4[0] * tr[j0] + l4[1] * tr[j0 + 1] + l4[2] * tr[j0 + 2] + l4[3] * tr[j0 + 3]; }
            tr[i] = a; Tb[i * 64 + lane] = a; }
    }
    for (int e = tid; e < 1536; e += 512) { const int k = e >> 8, r = (e >> 4) & 15, c = e & 15;
        const int rb = k < 3 ? 0 : (k < 5 ? 1 : 2), cb = k < 3 ? k + 1 : (k < 5 ? k - 1 : 3);
        Tm[(16 * rb + r) * 64 + 16 * cb + c] = 0.f; }
    __syncthreads();
    {
        const int B = tid >> 8, i = (tid >> 4) & 15, c = tid & 15, o = 32 * B;
        float x = 0.f;
#pragma unroll
        for (int j0 = 0; j0 < 16; j0 += 4) { const f32x4 l4 = *(const f32x4*)(L + (o + 16 + i) * 64 + o + j0);
            x += l4[0] * Tm[(o + j0) * 64 + o + c] + l4[1] * Tm[(o + j0 + 1) * 64 + o + c] + l4[2] * Tm[(o + j0 + 2) * 64 + o + c] + l4[3] * Tm[(o + j0 + 3) * 64 + o + c]; }
        XS[tid] = x;
        __syncthreads();
        float t = 0.f;
#pragma unroll
        for (int j0 = 0; j0 < 16; j0 += 4) { const f32x4 t4 = *(const f32x4*)(Tm + (o + 16 + i) * 64 + o + 16 + j0);
            t += t4[0] * XS[(B << 8) + j0 * 16 + c] + t4[1] * XS[(B << 8) + (j0 + 1) * 16 + c] + t4[2] * XS[(B << 8) + (j0 + 2) * 16 + c] + t4[3] * XS[(B << 8) + (j0 + 3) * 16 + c]; }
        Tm[(o + 16 + i) * 64 + o + c] = -t;
    }
    __syncthreads();
    {
        const int i = tid >> 4, c2 = (tid & 15) * 2;
        float x0 = 0.f, x1 = 0.f;
#pragma unroll
        for (int j0 = 0; j0 < 32; j0 += 4) { const f32x4 l4 = *(const f32x4*)(L + (32 + i) * 64 + j0);
#pragma unroll
            for (int e = 0; e < 4; ++e) { const f32x2v tv = *(const f32x2v*)(Tm + (j0 + e) * 64 + c2); x0 += l4[e] * tv[0]; x1 += l4[e] * tv[1]; } }
        *(f32x2v*)(XS + i * 32 + c2) = (f32x2v){x0, x1};
        __syncthreads();
        float t0 = 0.f, t1 = 0.f;
#pragma unroll
        for (int j0 = 0; j0 < 32; j0 += 4) { const f32x4 t4 = *(const f32x4*)(Tm + (32 + i) * 64 + 32 + j0);
#pragma unroll
            for (int e = 0; e < 4; ++e) { const f32x2v xv = *(const f32x2v*)(XS + (j0 + e) * 32 + c2); t0 += t4[e] * xv[0]; t1 += t4[e] * xv[1]; } }
        *(f32x2v*)(Tm + (32 + i) * 64 + c2) = (f32x2v){-t0, -t1};
    }
    __syncthreads();
}
constexpr int PL_QS = 0, PL_R1 = 17408, PL_KT = 35840, PL_KTT = 54272, PL_VT = 72704, PL_R3 = 91136, PL_QKM = 109568, PL_TP = 118784, PL_TPP = 128000, PL_SM = 137216, PL_TM = 139264, PL_XS = 155648;
constexpr int QSTR = 136, TSTR = 72;

__device__ __forceinline__ void gdn_prep_item(const Params& p, unsigned char* smem, int h, int row_start, int npad, const bf16_t* hbase,
                                              bf16_t* halo_out, float* conv_out, unsigned char* rec) {
    const int tid = otid(), w = tid >> 6, lane = tid & 63, q4 = lane >> 4, l15 = lane & 15;
    bf16_t* qs = (bf16_t*)(smem + PL_QS); bf16_t* ks = (bf16_t*)(smem + PL_R1); bf16_t* WT = ks; bf16_t* kts = (bf16_t*)(smem + PL_KT);
    bf16_t* vs = (bf16_t*)(smem + PL_VT);         float* Lm = (float*)(smem + PL_R3); bf16_t* UT = (bf16_t*)(smem + PL_R3); bf16_t* QKm = (bf16_t*)(smem + PL_QKM);
    bf16_t* Tp = (bf16_t*)(smem + PL_TP); bf16_t* Tpp = (bf16_t*)(smem + PL_TPP);
    float* sm = (float*)(smem + PL_SM);
    float* gcs = sm; float* bes = sm + 64; float* ssq = sm + 128; float* ssk = sm + 192; float* egs = sm + 256; float* egl_s = sm + 320; float* beg = sm + 384;
    const bf16_t* P = (const bf16_t*)(p.ws + WS_P);
    const float* pk = (const float*)(p.ws + WS_PK);
    if (w == 7) {
        const int i = lane;
        float g = 0.f, be = 0.f;
        if (i >= npad) { const size_t r = (size_t)(row_start + i - npad) * NPB; const float pa = bf2f(P[r + C_A + h]), pb = bf2f(P[r + C_B + h]);
            g = -expf(pk[PK_ALOG + h]) * softplus_(pa + pk[PK_DTB + h]); be = sigm(pb); }
        float x = g;
#pragma unroll
        for (int o = 1; o < 64; o <<= 1) { const float y = __shfl_up(x, o); if (lane >= o) x += y; }
        const float gl = __shfl(x, 63);
        gcs[lane] = x; bes[lane] = be; egs[lane] = __expf(x); egl_s[lane] = __expf(gl - x); beg[lane] = be * __expf(x);
        if (lane == 0) *(float*)(rec + GP_EGL) = __expf(gl);
    }
    __syncthreads();
    if (npad == 0 && tid >= 384) {
#pragma unroll 1
        for (int k = 0; k < 4; ++k) {
            const int slot = (tid - 384) + 128 * k, t = slot >> 3, g = slot & 7;
            const bf16_t* zp = P + (size_t)(row_start + t) * NPB + C_Z + h * 128 + 16 * g;
            const u32x4 z0 = *(const u32x4*)zp, z1 = *(const u32x4*)(zp + 8);
            float za[8], zb[8]; unpack8(z0, za); unpack8(z1, zb);
            const float* nwp = pk + PK_NORMW + 16 * g;
            float ga[8], gb2[8];
#pragma unroll
            for (int e = 0; e < 8; ++e) { ga[e] = nwp[e] * silu_(za[e]); gb2[e] = nwp[8 + e] * silu_(zb[e]); }
            bf16_t* gp = (bf16_t*)(rec + GP_G) + t * 128 + 16 * g;
            *(u32x4*)gp = pack8(ga); *(u32x4*)(gp + 8) = pack8(gb2);
        }
    }
    if (tid < 384) {
        const int sec = tid >> 7, ts = (tid >> 4) & 7, t0 = 8 * ts, d0 = l15 * 8;
        const int pcol = sec * 1024 + h * 128 + d0;
        float cw[4][8];
#pragma unroll
        for (int j = 0; j < 4; ++j) { const f32x4 a = *(const f32x4*)(pk + PK_CONVW + j * 3072 + pcol), b = *(const f32x4*)(pk + PK_CONVW + j * 3072 + pcol + 4);
            cw[j][0] = a[0]; cw[j][1] = a[1]; cw[j][2] = a[2]; cw[j][3] = a[3]; cw[j][4] = b[0]; cw[j][5] = b[1]; cw[j][6] = b[2]; cw[j][7] = b[3]; }
        u32x4 rw[11]; float fv[11];
#pragma unroll
        for (int k = 0; k < 11; ++k) {
            const int ii = t0 - 3 + k;
            const bf16_t* ptr = P + pcol; float f = 0.f;
            if (ii >= npad) { ptr = P + (size_t)(row_start + ii - npad) * NPB + pcol; f = 1.f; }
            else if (ii < 0 && npad == 0 && hbase) { ptr = hbase + (size_t)(ii + 3) * NPB + pcol; f = 1.f; }
            rw[k] = *(const u32x4*)ptr; fv[k] = f;
        }
        if (halo_out && ts == 7) {
#pragma unroll
            for (int dd = 0; dd < 3; ++dd) { *(u32x4*)(halo_out + (size_t)dd * NPB + pcol) = rw[8 + dd];
                if (conv_out) { float x[8]; unpack8(rw[8 + dd], x); *(f32x4*)(conv_out + dd * 3072 + pcol) = (f32x4){x[0], x[1], x[2], x[3]}; *(f32x4*)(conv_out + dd * 3072 + pcol + 4) = (f32x4){x[4], x[5], x[6], x[7]}; } }
        }
        float y[8][8];
#pragma unroll
        for (int t = 0; t < 8; ++t)
#pragma unroll
            for (int e = 0; e < 8; ++e) y[t][e] = 0.f;
#pragma unroll
        for (int k = 0; k < 11; ++k) { float x[8]; unpack8(rw[k], x);
#pragma unroll
            for (int e = 0; e < 8; ++e) x[e] *= fv[k];
#pragma unroll
            for (int dlt = 0; dlt < 4; ++dlt) { const int t = k - dlt;
                if (t >= 0 && t < 8) {
#pragma unroll
                    for (int e = 0; e < 8; ++e) y[t][e] += cw[dlt][e] * x[e]; } }
        }
        const float qsc = sec == 0 ? 0.08838834764831845f : 1.f;
#pragma unroll
        for (int t = 0; t < 8; ++t) {
            const bool tokv = (t0 + t) >= npad;
            float ss = 0.f;
#pragma unroll
            for (int e = 0; e < 8; ++e) { y[t][e] = tokv ? silu_(y[t][e]) : 0.f; ss += y[t][e] * y[t][e]; }
            if (sec < 2) { const float sc = __builtin_amdgcn_rsqf(rowsum16(ss) + 1e-6f) * qsc;
#pragma unroll
                for (int e = 0; e < 8; ++e) y[t][e] *= sc; }
        }
        { bf16_t* dst = sec == 0 ? qs : (sec == 1 ? ks : vs);
#pragma unroll
            for (int t = 0; t < 8; ++t) *(u32x4*)(dst + (t0 + t) * QSTR + d0) = pack8(y[t]); }
        if (sec == 1) {
#pragma unroll
            for (int t = 0; t < 8; ++t) { const float eg = egl_s[t0 + t]; float z[8];
#pragma unroll
                for (int e = 0; e < 8; ++e) z[e] = y[t][e] * eg;
                *(u32x4*)(kts + (t0 + t) * QSTR + d0) = pack8(z); } }
    }
    __syncthreads();
    {
        const int which = w >> 2, it = w & 3;
        const bf16_t* Barr = which ? qs : ks;
        bf16x8 bfr[4];
#pragma unroll
        for (int kk = 0; kk < 4; ++kk) bfr[kk] = ldfrag(Barr, QSTR, 16 * it, 32 * kk, lane);
        const int i = 16 * it + l15; const float gi = gcs[i], bi = bes[i];
#pragma unroll
        for (int jt = 0; jt < 4; ++jt) {
            f32x4 acc = {0.f, 0.f, 0.f, 0.f};
#pragma unroll
            for (int kk = 0; kk < 4; ++kk) acc = MFMA16(ldfrag(ks, QSTR, 16 * jt, 32 * kk, lane), bfr[kk], acc);
            const int j0 = 16 * jt + 4 * q4; const f32x4 gj = *(const f32x4*)(gcs + j0);
            f32x4 o;
#pragma unroll
            for (int r = 0; r < 4; ++r) { const int j = j0 + r; const bool keep = which ? (i >= j) : (i > j); o[r] = keep ? acc[r] * __expf(gi - gj[r]) : 0.f; }
            if (which == 0) *(f32x4*)(Lm + i * 64 + j0) = o * bi;
            else *(u32x2*)(QKm + i * TSTR + j0) = (u32x2){pk2(o[0], o[1]), pk2(o[2], o[3])};
        }
    }
    __syncthreads();
    {
        float* Tm = (float*)(smem + PL_TM);
        inv_block(Lm, Tm, (float*)(smem + PL_XS), tid);
        const int i = tid >> 3, j0 = (tid & 7) * 8;
        float a[8], b2[8];
#pragma unroll
        for (int e = 0; e < 8; ++e) { const float tv = Tm[i * 64 + j0 + e]; a[e] = tv * beg[j0 + e]; b2[e] = tv * bes[j0 + e]; }
        *(u32x4*)(Tp + i * TSTR + j0) = (u32x4){pk2(a[0], a[1]), pk2(a[2], a[3]), pk2(a[4], a[5]), pk2(a[6], a[7])};
        *(u32x4*)(Tpp + i * TSTR + j0) = (u32x4){pk2(b2[0], b2[1]), pk2(b2[2], b2[3]), pk2(b2[4], b2[5]), pk2(b2[6], b2[7])};
    }
    __syncthreads();
    {
        const int it = w & 3, half = w >> 2;
        f32x4 aw[4], au[4];
#pragma unroll
        for (int x = 0; x < 4; ++x) { aw[x] = (f32x4){0.f, 0.f, 0.f, 0.f}; au[x] = (f32x4){0.f, 0.f, 0.f, 0.f}; }
#pragma unroll
        for (int kk = 0; kk < 2; ++kk) {
            const bf16x8 a1 = ldfrag(Tp, TSTR, 16 * it, 32 * kk, lane), a2 = ldfrag(Tpp, TSTR, 16 * it, 32 * kk, lane);
#pragma unroll
            for (int x = 0; x < 4; ++x) { const int dt = half * 4 + x;
                aw[x] = MFMA16(a1, ldfrag_tr(ks, QSTR, 16 * dt, 32 * kk, lane), aw[x]);
                au[x] = MFMA16(a2, ldfrag_tr(vs, QSTR, 16 * dt, 32 * kk, lane), au[x]); }
        }
        __syncthreads();
#pragma unroll
        for (int x = 0; x < 4; ++x) { const int d = 16 * (half * 4 + x) + l15, i0 = 16 * it + 4 * q4;
            *(u32x2*)(WT + d * TSTR + i0) = (u32x2){pk2(aw[x][0], aw[x][1]), pk2(aw[x][2], aw[x][3])};
            *(u32x2*)(UT + d * TSTR + i0) = (u32x2){pk2(au[x][0], au[x][1]), pk2(au[x][2], au[x][3])}; }
    }
    __syncthreads();
    {
        bf16_t* gAP = (bf16_t*)(rec + GP_AP); bf16_t* gQH = (bf16_t*)(rec + GP_QH); bf16_t* gKH = (bf16_t*)(rec + GP_KH); bf16_t* gOH = (bf16_t*)(rec + GP_OH);
        {
            const int et = w;
            const bf16x8 a0 = ldfrag(WT, TSTR, 16 * et, 0, lane), a1 = ldfrag(WT, TSTR, 16 * et, 32, lane);
#pragma unroll
            for (int dt = 0; dt < 8; ++dt) { f32x4 acc = {0.f, 0.f, 0.f, 0.f};
                acc = MFMA16(a0, ldfrag_tr(kts, QSTR, 16 * dt, 0, lane), acc); acc = MFMA16(a1, ldfrag_tr(kts, QSTR, 16 * dt, 32, lane), acc);
                *(u32x2*)(gAP + ((size_t)(dt * 4 + (et >> 1)) * 64 + lane) * 8 + (et & 1) * 4) = (u32x2){pk2(-acc[0], -acc[1]), pk2(-acc[2], -acc[3])}; }
#pragma unroll
            for (int tt = 0; tt < 4; ++tt) { f32x4 acc = {0.f, 0.f, 0.f, 0.f};
                acc = MFMA16(a0, ldfrag(QKm, TSTR, 16 * tt, 0, lane), acc); acc = MFMA16(a1, ldfrag(QKm, TSTR, 16 * tt, 32, lane), acc);
                const int t = 16 * tt + l15, e0 = 16 * et + 4 * q4; const float eg = egs[t];
                const u32x2 qq = *(const u32x2*)(qs + t * QSTR + e0);
                const float o0 = __uint_as_float(qq.x << 16) * eg - acc[0], o1 = __uint_as_float(qq.x & 0xffff0000u) * eg - acc[1],
                            o2 = __uint_as_float(qq.y << 16) * eg - acc[2], o3 = __uint_as_float(qq.y & 0xffff0000u) * eg - acc[3];
                *(u32x2*)(gQH + ((size_t)(tt * 4 + (et >> 1)) * 64 + lane) * 8 + (et & 1) * 4) = (u32x2){pk2(o0, o1), pk2(o2, o3)}; }
        }
        {
            const int dt = w;
            const bf16x8 a0 = ldfrag_tr(kts, QSTR, 16 * dt, 0, lane), a1 = ldfrag_tr(kts, QSTR, 16 * dt, 32, lane);
#pragma unroll
            for (int vt = 0; vt < 8; ++vt) { f32x4 acc = {0.f, 0.f, 0.f, 0.f};
                acc = MFMA16(a0, ldfrag(UT, TSTR, 16 * vt, 0, lane), acc); acc = MFMA16(a1, ldfrag(UT, TSTR, 16 * vt, 32, lane), acc);
                *(u32x2*)(gKH + ((size_t)(vt * 8 + dt) * 64 + lane) * 4) = (u32x2){pk2(acc[0], acc[1]), pk2(acc[2], acc[3])}; }
            const int tt = w & 3, vh = w >> 2;
            const bf16x8 b0 = ldfrag(QKm, TSTR, 16 * tt, 0, lane), b1 = ldfrag(QKm, TSTR, 16 * tt, 32, lane);
#pragma unroll
            for (int x = 0; x < 4; ++x) { const int vt = vh * 4 + x; f32x4 acc = {0.f, 0.f, 0.f, 0.f};
                acc = MFMA16(b0, ldfrag(UT, TSTR, 16 * vt, 0, lane), acc); acc = MFMA16(b1, ldfrag(UT, TSTR, 16 * vt, 32, lane), acc);
                *(u32x2*)(gOH + ((size_t)(vt * 4 + tt) * 64 + lane) * 4) = (u32x2){pk2(acc[0], acc[1]), pk2(acc[2], acc[3])}; }
        }
    }
    __syncthreads();
}

__device__ __forceinline__ void phase_gprep(const Params& p, int seg, unsigned char* smem) {
    const int blk = obid();
    const int n_items = (CPS + (seg == 0 ? 1 : 0)) * 64;
#pragma unroll 1
    for (int it = blk; it < n_items; it += gridDim.x) {
        const int bh = it & 63, b = bh >> 3, h = bh & 7; int cl = it >> 6; if (seg != 0) cl += 1;
        unsigned char* rec = p.ws + WS_GP + (size_t)(cl * 64 + bh) * GP_STRIDE;
        const bf16_t* Pb = (const bf16_t*)(p.ws + WS_P);
        bf16_t* chalo2 = (bf16_t*)(p.ws + WS_CHALO);
        if (cl == 0) gdn_prep_item(p, smem, h, LEX0, 48, nullptr, nullptr, nullptr, rec);
        else {
            const int row = b * SEGTOK + (cl - 1) * 64;
            const bf16_t* hbase = Pb + (size_t)(row - 3) * NPB;
            if (cl == 1) hbase = (seg == 0) ? Pb + (size_t)(LEX0 + NMETA - 3) * NPB : chalo2 + (size_t)(((seg - 1) & 1) * NBATCH + b) * 3 * NPB;
            bf16_t* ho = (cl == CPS) ? chalo2 + (size_t)((seg & 1) * NBATCH + b) * 3 * NPB : nullptr;
            float* co = (cl == CPS && seg == NSEG - 1) ? p.out + O_CONV_P + (size_t)b * 9216 : nullptr;
            gdn_prep_item(p, smem, h, row, 0, hbase, ho, co, rec);
        }
    }
}

__device__ __forceinline__ void gdn_scan_block(const Params& p, int seg, unsigned char* smem, int bh) {
    const int tid = otid(), w = tid >> 6, lane = tid & 63, q4 = lane >> 4, l15 = lane & 15;
    const int b = bh >> 3, h = bh & 7;
    float* st = p.out + O_GDN_P + (size_t)bh * 16384;
    f32x4 S[8];
    if (seg) {
#pragma unroll
        for (int mt = 0; mt < 8; ++mt)
#pragma unroll
            for (int r = 0; r < 4; ++r) S[mt][r] = st[(size_t)(16 * mt + 4 * q4 + r) * 128 + 16 * w + l15];
    } else {
#pragma unroll
        for (int mt = 0; mt < 8; ++mt) S[mt] = (f32x4){0.f, 0.f, 0.f, 0.f};
    }
    const int c_lo = seg ? 1 : 0;
    float* obuf = (float*)(smem + 98304);
    {
        const u32x4* src = (const u32x4*)(p.ws + WS_GP + (size_t)(c_lo * 64 + bh) * GP_STRIDE); u32x4* dst = (u32x4*)smem;
#pragma unroll
        for (int x = 0; x < 6; ++x) dst[tid + 512 * x] = src[tid + 512 * x];
    }
#pragma unroll 1
    for (int cl = c_lo; cl <= CPS; ++cl) {
        const unsigned char* rec = p.ws + WS_GP + (size_t)(cl * 64 + bh) * GP_STRIDE;
        const int cur = (cl - c_lo) & 1;
        __syncthreads();
        u32x4 nx[6];
        const bool more = cl < CPS;
        if (more) { const u32x4* src = (const u32x4*)(rec + GP_STRIDE * 64);
#pragma unroll
            for (int x = 0; x < 6; ++x) nx[x] = src[tid + 512 * x]; }
        const bf16_t* gKH = (const bf16_t*)(rec + GP_KH); const bf16_t* gOH = (const bf16_t*)(rec + GP_OH);
        u32x2 kh[8], oh[4];
#pragma unroll
        for (int mt = 0; mt < 8; ++mt) kh[mt] = *(const u32x2*)(gKH + ((size_t)(w * 8 + mt) * 64 + lane) * 4);
#pragma unroll
        for (int tt = 0; tt < 4; ++tt) oh[tt] = *(const u32x2*)(gOH + ((size_t)(w * 4 + tt) * 64 + lane) * 4);
        const float egl = *(const float*)(rec + GP_EGL);
        const int et = tid >> 3, eg = tid & 7;
        const bf16_t* gp = (const bf16_t*)(rec + GP_G) + et * 128 + 16 * eg;
        u32x4 z0 = {0u, 0u, 0u, 0u}, z1 = {0u, 0u, 0u, 0u};
        if (cl > 0) { z0 = *(const u32x4*)gp; z1 = *(const u32x4*)(gp + 8); }
        bf16x8 Bf[4];
#pragma unroll
        for (int ks = 0; ks < 4; ++ks) { u32x4 t; t.x = pk2(S[2 * ks][0], S[2 * ks][1]); t.y = pk2(S[2 * ks][2], S[2 * ks][3]); t.z = pk2(S[2 * ks + 1][0], S[2 * ks + 1][1]); t.w = pk2(S[2 * ks + 1][2], S[2 * ks + 1][3]);
            Bf[ks] = __builtin_bit_cast(bf16x8, t); }
        const bf16x8* AP = (const bf16x8*)(smem + cur * 49152); const bf16x8* QH = (const bf16x8*)(smem + cur * 49152 + GP_QH);
        f32x4 o[4], tS[8];
#pragma unroll
        for (int tt = 0; tt < 4; ++tt) { o[tt] = (f32x4){0.f, 0.f, 0.f, 0.f};
#pragma unroll
            for (int ks = 0; ks < 4; ++ks) o[tt] = MFMA16(QH[(tt * 4 + ks) * 64 + lane], Bf[ks], o[tt]); }
#pragma unroll
        for (int mt = 0; mt < 8; ++mt) { tS[mt] = (f32x4){0.f, 0.f, 0.f, 0.f};
#pragma unroll
            for (int ks = 0; ks < 4; ++ks) tS[mt] = MFMA16(AP[(mt * 4 + ks) * 64 + lane], Bf[ks], tS[mt]); }
#pragma unroll
        for (int mt = 0; mt < 8; ++mt) {
            S[mt][0] = egl * S[mt][0] + tS[mt][0] + __uint_as_float(kh[mt].x << 16); S[mt][1] = egl * S[mt][1] + tS[mt][1] + __uint_as_float(kh[mt].x & 0xffff0000u);
            S[mt][2] = egl * S[mt][2] + tS[mt][2] + __uint_as_float(kh[mt].y << 16); S[mt][3] = egl * S[mt][3] + tS[mt][3] + __uint_as_float(kh[mt].y & 0xffff0000u); }
        if (cl > 0) {
#pragma unroll
            for (int tt = 0; tt < 4; ++tt) {
                o[tt][0] += __uint_as_float(oh[tt].x << 16); o[tt][1] += __uint_as_float(oh[tt].x & 0xffff0000u); o[tt][2] += __uint_as_float(oh[tt].y << 16); o[tt][3] += __uint_as_float(oh[tt].y & 0xffff0000u);
#pragma unroll
                for (int r = 0; r < 4; ++r) obuf[(16 * tt + 4 * q4 + r) * 132 + 16 * w + l15] = o[tt][r]; }
        }
        if (more) { u32x4* dst = (u32x4*)(smem + (cur ^ 1) * 49152);
#pragma unroll
            for (int x = 0; x < 6; ++x) dst[tid + 512 * x] = nx[x]; }
        if (cl > 0) {
            __syncthreads();
            f32x4 ov[4]; float ss = 0.f;
#pragma unroll
            for (int j = 0; j < 4; ++j) { ov[j] = *(const f32x4*)(obuf + et * 132 + 16 * eg + 4 * j); ss += ov[j][0] * ov[j][0] + ov[j][1] * ov[j][1] + ov[j][2] * ov[j][2] + ov[j][3] * ov[j][3]; }
            ss += __shfl_xor(ss, 1); ss += __shfl_xor(ss, 2); ss += __shfl_xor(ss, 4);
            const float rs = __builtin_amdgcn_rsqf(ss * (1.f / 128.f) + 1e-6f);
            const unsigned zz[8] = {z0.x, z0.y, z0.z, z0.w, z1.x, z1.y, z1.z, z1.w};
            unsigned ow[8];
#pragma unroll
            for (int j = 0; j < 8; ++j) ow[j] = pk2(ov[j >> 1][(j & 1) * 2] * rs * __uint_as_float(zz[j] << 16), ov[j >> 1][(j & 1) * 2 + 1] * rs * __uint_as_float(zz[j] & 0xffff0000u));
            const size_t grow = (size_t)b * SEQ + seg * SEGTOK + (cl - 1) * 64 + et;
            bf16_t* oa = (bf16_t*)(p.ws + WS_H) + grow * D + h * 128 + 16 * eg;
            *(u32x4*)oa = (u32x4){ow[0], ow[1], ow[2], ow[3]}; *(u32x4*)(oa + 8) = (u32x4){ow[4], ow[5], ow[6], ow[7]};
        }
    }
#pragma unroll
    for (int mt = 0; mt < 8; ++mt)
#pragma unroll
        for (int r = 0; r < 4; ++r) st[(size_t)(16 * mt + 4 * q4 + r) * 128 + 16 * w + l15] = S[mt][r];
    __syncthreads();
}

constexpr int RL_AT = 0, RL_BT = 9216, RL_KT = 18432, RL_ATT = 27648, RL_RT = 36864, RL_BTLT = 46080, RL_KTLT = 55296, RL_VT = 64512, RL_LAK = 73728, RL_MRB = 82944, RL_MRK = 92160,
              RL_LM = 101376, RL_AF = 117760, RL_TM = 134144, RL_XS = 150528;
__device__ __forceinline__ void rwkv_prep_item(const Params& p, unsigned char* smem, int hb, int row_start, int npad, const bf16_t* prev_row,
                                               bf16_t* halo_out, unsigned char* rec) {
    const int tid = otid(), w = tid >> 6, lane = tid & 63, q4 = lane >> 4, l15 = lane & 15;
    bf16_t* At = (bf16_t*)(smem + RL_AT); bf16_t* Tb = At; bf16_t* Bt = (bf16_t*)(smem + RL_BT); bf16_t* WaT = Bt; bf16_t* Kt = (bf16_t*)(smem + RL_KT); bf16_t* XT = Kt;
    bf16_t* At2 = (bf16_t*)(smem + RL_ATT); bf16_t* Rt = (bf16_t*)(smem + RL_RT); bf16_t* Btl = (bf16_t*)(smem + RL_BTLT); bf16_t* Ktl = (bf16_t*)(smem + RL_KTLT);
    bf16_t* Vr = (bf16_t*)(smem + RL_VT);        bf16_t* Lak = (bf16_t*)(smem + RL_LAK); bf16_t* Mrb = (bf16_t*)(smem + RL_MRB); bf16_t* Mrk = (bf16_t*)(smem + RL_MRK);
    float* Lm = (float*)(smem + RL_LM);
    bf16_t* thw = Lak; bf16_t* adb = Mrb; float* lc = Lm; float* af = (float*)(smem + RL_AF);
    const bf16_t* P = (const bf16_t*)(p.ws + WS_P);
    const float* pk = (const float*)(p.ws + WS_PK);
    const int t = tid >> 3, g = tid & 7;
    float rr[8], kb[8], vv[8], zb[8];
    {
        const bool real = t >= npad;
        const bf16_t* curp = P; const bf16_t* prevp = P; float fprev = 0.f;
        if (real) { curp = P + (size_t)(row_start + t - npad) * NPB; if (t > npad) { prevp = curp - NPB; fprev = 1.f; } else if (prev_row) { prevp = prev_row; fprev = 1.f; } }
        const int secbase[6] = {0, 1024, 2048, 3200, 3072, 3136};
        u32x4 rc[6], rp[6];
#pragma unroll
        for (int sidx = 0; sidx < 6; ++sidx) { const int col = secbase[sidx] + (sidx < 4 ? hb * 64 : 0) + g * 8; rc[sidx] = *(const u32x4*)(curp + C_RW + col); rp[sidx] = *(const u32x4*)(prevp + C_RW + col); }
        float m[6][8];
#pragma unroll
        for (int sidx = 0; sidx < 6; ++sidx) {
            const int col = secbase[sidx] + (sidx < 4 ? hb * 64 : 0) + g * 8;
            float cur[8], prv[8];
            unpack8(rc[sidx], cur); unpack8(rp[sidx], prv);
            const f32x4 mu0 = *(const f32x4*)(pk + PK_MU + col), mu1 = *(const f32x4*)(pk + PK_MU + col + 4);
            const float mu[8] = {mu0[0], mu0[1], mu0[2], mu0[3], mu1[0], mu1[1], mu1[2], mu1[3]};
#pragma unroll
            for (int e = 0; e < 8; ++e) m[sidx][e] = real ? cur[e] + mu[e] * (fprev * prv[e] - cur[e]) : 0.f;
            if (halo_out && t == 63 && (sidx < 4 || hb == 0)) *(u32x4*)(halo_out + C_RW + col) = rc[sidx];
        }
#pragma unroll
        for (int e = 0; e < 8; ++e) { rr[e] = m[0][e]; kb[e] = m[1][e]; vv[e] = m[2][e]; zb[e] = m[3][e]; }
        float th[8];
#pragma unroll
        for (int e = 0; e < 8; ++e) th[e] = tanh_(m[4][e]);
        *(u32x4*)(thw + t * TSTR + g * 8) = pack8(th);
        *(u32x4*)(adb + t * TSTR + g * 8) = pack8(m[5]);
    }
    __syncthreads();
    {
        const int which = w >> 2, ct = w & 3;
        const bf16_t* Wt = (const bf16_t*)(p.ws + (which ? WS_A2T : WS_W2T)) + (size_t)hb * 4096;
        const bf16x8 b0 = *(const bf16x8*)(Wt + (16 * ct + l15) * 64 + 8 * q4), b1 = *(const bf16x8*)(Wt + (16 * ct + l15) * 64 + 32 + 8 * q4);
        const bf16_t* Aarr = which ? adb : thw;
        const int c = 16 * ct + l15;
        const float bias = pk[(which ? PK_A0 : PK_W0) + hb * 64 + c];
        float carry = 0.f;
#pragma unroll
        for (int tt = 0; tt < 4; ++tt) {
            f32x4 acc = {0.f, 0.f, 0.f, 0.f};
            acc = MFMA16(ldfrag(Aarr, TSTR, 16 * tt, 0, lane), b0, acc); acc = MFMA16(ldfrag(Aarr, TSTR, 16 * tt, 32, lane), b1, acc);
            if (which) {
#pragma unroll
                for (int r = 0; r < 4; ++r) af[(16 * tt + 4 * q4 + r) * 64 + c] = sigm(bias + acc[r]);
            } else {
                float wl[4];
#pragma unroll
                for (int r = 0; r < 4; ++r) { const int tk = 16 * tt + 4 * q4 + r; wl[r] = (tk < npad) ? 0.f : -0.6065306597126334f * sigm(bias + acc[r]); }
                wl[1] += wl[0]; wl[2] += wl[1]; wl[3] += wl[2];
                const float Q = wl[3];
                const float Q0 = __shfl(Q, l15), Q1 = __shfl(Q, l15 + 16), Q2 = __shfl(Q, l15 + 32), Q3 = __shfl(Q, l15 + 48);
                const float ex = carry + (q4 > 0 ? Q0 : 0.f) + (q4 > 1 ? Q1 : 0.f) + (q4 > 2 ? Q2 : 0.f);
#pragma unroll
                for (int r = 0; r < 4; ++r) lc[(16 * tt + 4 * q4 + r) * 64 + c] = ex + wl[r];
                carry += Q0 + Q1 + Q2 + Q3;
            }
        }
    }
    __syncthreads();
    {
        float lct[8], lcp[8], lcC[8], av[8];
        { const f32x4 a = *(const f32x4*)(lc + t * 64 + g * 8), b2 = *(const f32x4*)(lc + t * 64 + g * 8 + 4); lct[0] = a[0]; lct[1] = a[1]; lct[2] = a[2]; lct[3] = a[3]; lct[4] = b2[0]; lct[5] = b2[1]; lct[6] = b2[2]; lct[7] = b2[3]; }
        if (t > 0) { const f32x4 a = *(const f32x4*)(lc + (t - 1) * 64 + g * 8), b2 = *(const f32x4*)(lc + (t - 1) * 64 + g * 8 + 4); lcp[0] = a[0]; lcp[1] = a[1]; lcp[2] = a[2]; lcp[3] = a[3]; lcp[4] = b2[0]; lcp[5] = b2[1]; lcp[6] = b2[2]; lcp[7] = b2[3]; }
        else {
#pragma unroll
            for (int e = 0; e < 8; ++e) lcp[e] = 0.f; }
        { const f32x4 a = *(const f32x4*)(lc + 63 * 64 + g * 8), b2 = *(const f32x4*)(lc + 63 * 64 + g * 8 + 4); lcC[0] = a[0]; lcC[1] = a[1]; lcC[2] = a[2]; lcC[3] = a[3]; lcC[4] = b2[0]; lcC[5] = b2[1]; lcC[6] = b2[2]; lcC[7] = b2[3]; }
        { const f32x4 a = *(const f32x4*)(af + t * 64 + g * 8), b2 = *(const f32x4*)(af + t * 64 + g * 8 + 4); av[0] = a[0]; av[1] = a[1]; av[2] = a[2]; av[3] = a[3]; av[4] = b2[0]; av[5] = b2[1]; av[6] = b2[2]; av[7] = b2[3]; }
        const int hc = hb * 64 + g * 8;
        float kk[8], km[8], ss = 0.f, rk = 0.f;
        float pkk[8], pka[8], prk[8];
        { const f32x4 a0 = *(const f32x4*)(pk + PK_KK + hc), a1 = *(const f32x4*)(pk + PK_KK + hc + 4), b0 = *(const f32x4*)(pk + PK_KA + hc), b1 = *(const f32x4*)(pk + PK_KA + hc + 4), c0v = *(const f32x4*)(pk + PK_RK + hc), c1v = *(const f32x4*)(pk + PK_RK + hc + 4);
#pragma unroll
          for (int e = 0; e < 4; ++e) { pkk[e] = a0[e]; pkk[4 + e] = a1[e]; pka[e] = b0[e]; pka[4 + e] = b1[e]; prk[e] = c0v[e]; prk[4 + e] = c1v[e]; } }
#pragma unroll
        for (int e = 0; e < 8; ++e) { kk[e] = kb[e] * pkk[e]; ss += kk[e] * kk[e]; km[e] = kb[e] * (1.f + (av[e] - 1.f) * pka[e]); rk += rr[e] * km[e] * prk[e]; }
        ss += __shfl_xor(ss, 1); ss += __shfl_xor(ss, 2); ss += __shfl_xor(ss, 4);
        rk += __shfl_xor(rk, 1); rk += __shfl_xor(rk, 2); rk += __shfl_xor(rk, 4);
        const float kn = __builtin_amdgcn_rsqf(ss + 1e-6f);
        float xa[8], xb[8], xk[8], xr[8], xbt[8], xkt[8];
#pragma unroll
        for (int e = 0; e < 8; ++e) { kk[e] *= kn; const float ka = kk[e] * av[e]; const float ip = __expf(-lct[e]), tl = __expf(lcC[e] - lct[e]);
            xa[e] = kk[e] * __expf(lcp[e]); xb[e] = ka * ip; xk[e] = km[e] * ip; xr[e] = rr[e] * __expf(lct[e]); xbt[e] = ka * tl; xkt[e] = km[e] * tl; }
        *(u32x4*)(At + t * TSTR + g * 8) = pack8(xa); *(u32x4*)(Bt + t * TSTR + g * 8) = pack8(xb); *(u32x4*)(Kt + t * TSTR + g * 8) = pack8(xk); *(u32x4*)(Rt + t * TSTR + g * 8) = pack8(xr);
        *(u32x4*)(At2 + t * TSTR + g * 8) = pack8(xa); *(u32x4*)(Btl + t * TSTR + g * 8) = pack8(xbt); *(u32x4*)(Ktl + t * TSTR + g * 8) = pack8(xkt); *(u32x4*)(Vr + t * TSTR + g * 8) = pack8(vv);
        float c1[8], c0[8];
#pragma unroll
        for (int e = 0; e < 8; ++e) { c1[e] = 0.f; c0[e] = 0.f; }
        { const f32x4 g0 = *(const f32x4*)(pk + PK_GNW + hc), g1 = *(const f32x4*)(pk + PK_GNW + hc + 4), h0 = *(const f32x4*)(pk + PK_GNB + hc), h1 = *(const f32x4*)(pk + PK_GNB + hc + 4);
#pragma unroll
          for (int e = 0; e < 4; ++e) { const float sz0 = silu_(zb[e]), sz1 = silu_(zb[4 + e]); c1[e] = g0[e] * sz0; c1[4 + e] = g1[e] * sz1; c0[e] = (h0[e] + rk * vv[e]) * sz0; c0[4 + e] = (h1[e] + rk * vv[4 + e]) * sz1; } }
        *(u32x4*)((bf16_t*)(rec + RP_C1) + t * 64 + g * 8) = pack8(c1); *(u32x4*)((bf16_t*)(rec + RP_C0) + t * 64 + g * 8) = pack8(c0);
        if (t == 63) { float* pc = (float*)(rec + RP_PC) + g * 8; *(f32x4*)pc = (f32x4){__expf(lcC[0]), __expf(lcC[1]), __expf(lcC[2]), __expf(lcC[3])}; *(f32x4*)(pc + 4) = (f32x4){__expf(lcC[4]), __expf(lcC[5]), __expf(lcC[6]), __expf(lcC[7])}; }
    }
    __syncthreads();
    {
        const int pr = w >> 1;
        const bf16_t* Aarr = pr < 2 ? At : Rt; const bf16_t* Barr = (pr & 1) ? Kt : Bt;
#pragma unroll
        for (int x = 0; x < 2; ++x) { const int tt = 2 * (w & 1) + x;
            const bf16x8 a0 = ldfrag(Aarr, TSTR, 16 * tt, 0, lane), a1 = ldfrag(Aarr, TSTR, 16 * tt, 32, lane);
            const int tk = 16 * tt + l15;
#pragma unroll
            for (int it = 0; it < 4; ++it) { f32x4 acc = {0.f, 0.f, 0.f, 0.f};
                acc = MFMA16(ldfrag(Barr, TSTR, 16 * it, 0, lane), a0, acc); acc = MFMA16(ldfrag(Barr, TSTR, 16 * it, 32, lane), a1, acc);
                const int i0 = 16 * it + 4 * q4;
                f32x4 o;
#pragma unroll
                for (int r = 0; r < 4; ++r) { const int i = i0 + r; const bool keep = pr < 2 ? (tk > i) : (tk >= i); o[r] = keep ? acc[r] : 0.f; }
                if (pr == 0) *(f32x4*)(Lm + tk * 64 + i0) = o;
                else { bf16_t* Out = pr == 1 ? Lak : (pr == 2 ? Mrb : Mrk); *(u32x2*)(Out + tk * TSTR + i0) = (u32x2){pk2(o[0], o[1]), pk2(o[2], o[3])}; } }
        }
    }
    __syncthreads();
    {
        float* Tm = (float*)(smem + RL_TM);
        inv_block(Lm, Tm, (float*)(smem + RL_XS), tid);
        const int i = tid >> 3, j0 = (tid & 7) * 8;
        float a[8];
#pragma unroll
        for (int e = 0; e < 8; ++e) a[e] = Tm[i * 64 + j0 + e];
        *(u32x4*)(Tb + i * TSTR + j0) = pack8(a);
    }
    __syncthreads();
    {
        const int tt = w & 3, which = w >> 2;
        const bf16_t* Aarr = which ? Lak : Tb; const bf16_t* Barr = which ? Vr : At2; bf16_t* Out = which ? XT : WaT;
        const bf16x8 a0 = ldfrag(Aarr, TSTR, 16 * tt, 0, lane), a1 = ldfrag(Aarr, TSTR, 16 * tt, 32, lane);
#pragma unroll
        for (int ct = 0; ct < 4; ++ct) { f32x4 acc = {0.f, 0.f, 0.f, 0.f};
            acc = MFMA16(a0, ldfrag_tr(Barr, TSTR, 16 * ct, 0, lane), acc); acc = MFMA16(a1, ldfrag_tr(Barr, TSTR, 16 * ct, 32, lane), acc);
            *(u32x2*)(Out + (16 * ct + l15) * TSTR + 16 * tt + 4 * q4) = (u32x2){pk2(acc[0], acc[1]), pk2(acc[2], acc[3])}; }
    }
    __syncthreads();
    {
        f32x4 acc[4];
        if (w < 4) {
            const bf16x8 a0 = ldfrag(Tb, TSTR, 16 * w, 0, lane), a1 = ldfrag(Tb, TSTR, 16 * w, 32, lane);
#pragma unroll
            for (int ct = 0; ct < 4; ++ct) { acc[ct] = (f32x4){0.f, 0.f, 0.f, 0.f};
                acc[ct] = MFMA16(a0, ldfrag(XT, TSTR, 16 * ct, 0, lane), acc[ct]); acc[ct] = MFMA16(a1, ldfrag(XT, TSTR, 16 * ct, 32, lane), acc[ct]); }
        }
        __syncthreads();
        if (w < 4) {
#pragma unroll
            for (int ct = 0; ct < 4; ++ct) *(u32x2*)(XT + (16 * ct + l15) * TSTR + 16 * w + 4 * q4) = (u32x2){pk2(-acc[ct][0], -acc[ct][1]), pk2(-acc[ct][2], -acc[ct][3])};
        }
    }
    __syncthreads();
    {
        const bf16_t* UvT = XT;
        bf16_t* gAP = (bf16_t*)(rec + RP_AP); bf16_t* gRH = (bf16_t*)(rec + RP_RH); bf16_t* gKH = (bf16_t*)(rec + RP_KH); bf16_t* gYH = (bf16_t*)(rec + RP_YH);
        const int et = w & 3, part = w >> 2;
        {
            const bf16x8 a0 = ldfrag(WaT, TSTR, 16 * et, 0, lane), a1 = ldfrag(WaT, TSTR, 16 * et, 32, lane);
            if (part == 0) {
#pragma unroll
                for (int kt = 0; kt < 4; ++kt) { f32x4 acc = {0.f, 0.f, 0.f, 0.f};
                    acc = MFMA16(a0, ldfrag_tr(Btl, TSTR, 16 * kt, 0, lane), acc); acc = MFMA16(a1, ldfrag_tr(Btl, TSTR, 16 * kt, 32, lane), acc);
                    *(u32x2*)(gAP + ((size_t)(kt * 2 + (et >> 1)) * 64 + lane) * 8 + (et & 1) * 4) = (u32x2){pk2(-acc[0], -acc[1]), pk2(-acc[2], -acc[3])}; }
            } else {
#pragma unroll
                for (int tt = 0; tt < 4; ++tt) { f32x4 acc = {0.f, 0.f, 0.f, 0.f};
                    acc = MFMA16(a0, ldfrag(Mrb, TSTR, 16 * tt, 0, lane), acc); acc = MFMA16(a1, ldfrag(Mrb, TSTR, 16 * tt, 32, lane), acc);
                    const int tk = 16 * tt + l15, e0 = 16 * et + 4 * q4;
                    const u32x2 q2 = *(const u32x2*)(Rt + tk * TSTR + e0);
                    const float o0 = __uint_as_float(q2.x << 16) - acc[0], o1 = __uint_as_float(q2.x & 0xffff0000u) - acc[1], o2 = __uint_as_float(q2.y << 16) - acc[2], o3 = __uint_as_float(q2.y & 0xffff0000u) - acc[3];
                    *(u32x2*)(gRH + ((size_t)(tt * 2 + (et >> 1)) * 64 + lane) * 8 + (et & 1) * 4) = (u32x2){pk2(o0, o1), pk2(o2, o3)}; }
            }
        }
        {
            const int rt = w & 3;
            bf16_t* Out = part ? gKH : gYH;
            bf16x8 a0, a1, a2, a3;
            if (part) { a0 = ldfrag_tr(Btl, TSTR, 16 * rt, 0, lane); a1 = ldfrag_tr(Btl, TSTR, 16 * rt, 32, lane); a2 = ldfrag_tr(Ktl, TSTR, 16 * rt, 0, lane); a3 = ldfrag_tr(Ktl, TSTR, 16 * rt, 32, lane); }
            else { a0 = ldfrag(Mrb, TSTR, 16 * rt, 0, lane); a1 = ldfrag(Mrb, TSTR, 16 * rt, 32, lane); a2 = ldfrag(Mrk, TSTR, 16 * rt, 0, lane); a3 = ldfrag(Mrk, TSTR, 16 * rt, 32, lane); }
#pragma unroll
            for (int vt = 0; vt < 4; ++vt) { f32x4 acc = {0.f, 0.f, 0.f, 0.f};
                acc = MFMA16(a0, ldfrag(UvT, TSTR, 16 * vt, 0, lane), acc); acc = MFMA16(a1, ldfrag(UvT, TSTR, 16 * vt, 32, lane), acc);
                acc = MFMA16(a2, ldfrag_tr(Vr, TSTR, 16 * vt, 0, lane), acc); acc = MFMA16(a3, ldfrag_tr(Vr, TSTR, 16 * vt, 32, lane), acc);
                *(u32x2*)(Out + ((size_t)(vt * 4 + rt) * 64 + lane) * 4) = (u32x2){pk2(acc[0], acc[1]), pk2(acc[2], acc[3])}; }
        }
    }
    __syncthreads();
}

__device__ __forceinline__ void phase_rprep(const Params& p, int seg, unsigned char* smem) {
    const int blk = obid();
    const int n_items = (CPS + (seg == 0 ? 1 : 0)) * 128;
#pragma unroll 1
    for (int it = (blk + (gridDim.x >> 1)) % gridDim.x; it < n_items; it += gridDim.x) {
        const int bh = it & 127, b = bh >> 4, hb = bh & 15; int cl = it >> 7; if (seg != 0) cl += 1;
        unsigned char* rec = p.ws + WS_RP + (size_t)(cl * 128 + bh) * RP_STRIDE;
        const bf16_t* Pb = (const bf16_t*)(p.ws + WS_P);
        bf16_t* phalo2 = (bf16_t*)(p.ws + WS_PHALO);
        if (cl == 0) rwkv_prep_item(p, smem, hb, LEX0, 48, nullptr, nullptr, rec);
        else {
            const int row = b * SEGTOK + (cl - 1) * 64;
            const bf16_t* prow = Pb + (size_t)(row - 1) * NPB;
            if (cl == 1) prow = (seg == 0) ? Pb + (size_t)(LEX0 + NMETA - 1) * NPB : phalo2 + (size_t)(((seg - 1) & 1) * NBATCH + b) * NPB;
            bf16_t* ho = (cl == CPS) ? phalo2 + (size_t)((seg & 1) * NBATCH + b) * NPB : nullptr;
            rwkv_prep_item(p, smem, hb, row, 0, prow, ho, rec);
        }
    }
}

__device__ __forceinline__ void rwkv_scan_block(const Params& p, int seg, unsigned char* smem, int pairidx) {
    const int tid = otid(), w = tid >> 6, lane = tid & 63, q4 = lane >> 4, l15 = lane & 15;
    const int hsel = w >> 2, vt = w & 3;
    const int bh = pairidx * 2 + hsel, b = bh >> 4, hb = bh & 15;
    float* st = p.out + O_RWKV_P + (size_t)bh * 4096;
    f32x4 S[4];
    if (seg) {
#pragma unroll
        for (int mt = 0; mt < 4; ++mt) S[mt] = *(const f32x4*)(st + (size_t)(16 * vt + l15) * 64 + 16 * mt + 4 * q4);
    } else {
#pragma unroll
        for (int mt = 0; mt < 4; ++mt) S[mt] = (f32x4){0.f, 0.f, 0.f, 0.f};
    }
    const int c_lo = seg ? 1 : 0;
    float* ybuf = (float*)(smem + 65536) + hsel * (64 * 68);
    const int tl = tid & 255;
    {
        const u32x4* src = (const u32x4*)(p.ws + WS_RP + (size_t)(c_lo * 128 + bh) * RP_STRIDE); u32x4* dst = (u32x4*)(smem + hsel * 16384);
#pragma unroll
        for (int x = 0; x < 4; ++x) dst[tl + 256 * x] = src[tl + 256 * x];
    }
#pragma unroll 1
    for (int cl = c_lo; cl <= CPS; ++cl) {
        const unsigned char* rec = p.ws + WS_RP + (size_t)(cl * 128 + bh) * RP_STRIDE;
        const int cur = (cl - c_lo) & 1;
        __syncthreads();
        u32x4 nx[4];
        const bool more = cl < CPS;
        if (more) { const u32x4* src = (const u32x4*)(rec + (size_t)RP_STRIDE * 128);
#pragma unroll
            for (int x = 0; x < 4; ++x) nx[x] = src[tl + 256 * x]; }
        const bf16_t* gKH = (const bf16_t*)(rec + RP_KH); const bf16_t* gYH = (const bf16_t*)(rec + RP_YH);
        u32x2 kh[4], yh[4]; f32x4 pc[4];
#pragma unroll
        for (int mt = 0; mt < 4; ++mt) { kh[mt] = *(const u32x2*)(gKH + ((size_t)(vt * 4 + mt) * 64 + lane) * 4); yh[mt] = *(const u32x2*)(gYH + ((size_t)(vt * 4 + mt) * 64 + lane) * 4);
            pc[mt] = *(const f32x4*)((const float*)(rec + RP_PC) + 16 * mt + 4 * q4); }
        const int tk = tl >> 2, g = tl & 3;
        u32x4 a0 = {0u, 0u, 0u, 0u}, a1 = a0, b0 = a0, b1 = a0;
        if (cl > 0) { const bf16_t* c1p = (const bf16_t*)(rec + RP_C1) + tk * 64 + 16 * g; const bf16_t* c0p = (const bf16_t*)(rec + RP_C0) + tk * 64 + 16 * g;
            a0 = *(const u32x4*)c0p; a1 = *(const u32x4*)(c0p + 8); b0 = *(const u32x4*)c1p; b1 = *(const u32x4*)(c1p + 8); }
        bf16x8 Bf[2];
#pragma unroll
        for (int ks = 0; ks < 2; ++ks) { u32x4 tq; tq.x = pk2(S[2 * ks][0], S[2 * ks][1]); tq.y = pk2(S[2 * ks][2], S[2 * ks][3]); tq.z = pk2(S[2 * ks + 1][0], S[2 * ks + 1][1]); tq.w = pk2(S[2 * ks + 1][2], S[2 * ks + 1][3]);
            Bf[ks] = __builtin_bit_cast(bf16x8, tq); }
        const bf16x8* AP = (const bf16x8*)(smem + cur * 32768 + hsel * 16384); const bf16x8* RH = (const bf16x8*)(smem + cur * 32768 + hsel * 16384 + RP_RH);
        f32x4 y[4], tS[4];
#pragma unroll
        for (int tt = 0; tt < 4; ++tt) { y[tt] = (f32x4){0.f, 0.f, 0.f, 0.f}; y[tt] = MFMA16(RH[(tt * 2 + 0) * 64 + lane], Bf[0], y[tt]); y[tt] = MFMA16(RH[(tt * 2 + 1) * 64 + lane], Bf[1], y[tt]); }
#pragma unroll
        for (int mt = 0; mt < 4; ++mt) { tS[mt] = (f32x4){0.f, 0.f, 0.f, 0.f}; tS[mt] = MFMA16(AP[(mt * 2 + 0) * 64 + lane], Bf[0], tS[mt]); tS[mt] = MFMA16(AP[(mt * 2 + 1) * 64 + lane], Bf[1], tS[mt]); }
#pragma unroll
        for (int mt = 0; mt < 4; ++mt) {
            S[mt][0] = pc[mt][0] * S[mt][0] + tS[mt][0] + __uint_as_float(kh[mt].x << 16); S[mt][1] = pc[mt][1] * S[mt][1] + tS[mt][1] + __uint_as_float(kh[mt].x & 0xffff0000u);
            S[mt][2] = pc[mt][2] * S[mt][2] + tS[mt][2] + __uint_as_float(kh[mt].y << 16); S[mt][3] = pc[mt][3] * S[mt][3] + tS[mt][3] + __uint_as_float(kh[mt].y & 0xffff0000u); }
        if (cl > 0) {
#pragma unroll
            for (int tt = 0; tt < 4; ++tt) {
                y[tt][0] += __uint_as_float(yh[tt].x << 16); y[tt][1] += __uint_as_float(yh[tt].x & 0xffff0000u); y[tt][2] += __uint_as_float(yh[tt].y << 16); y[tt][3] += __uint_as_float(yh[tt].y & 0xffff0000u);
#pragma unroll
                for (int r = 0; r < 4; ++r) ybuf[(16 * tt + 4 * q4 + r) * 68 + 16 * vt + l15] = y[tt][r]; }
        }
        if (more) { u32x4* dst = (u32x4*)(smem + (cur ^ 1) * 32768 + hsel * 16384);
#pragma unroll
            for (int x = 0; x < 4; ++x) dst[tl + 256 * x] = nx[x]; }
        if (cl > 0) {
            __syncthreads();
            f32x4 yv[4]; float sm = 0.f;
#pragma unroll
            for (int j = 0; j < 4; ++j) { yv[j] = *(const f32x4*)(ybuf + tk * 68 + 16 * g + 4 * j); sm += yv[j][0] + yv[j][1] + yv[j][2] + yv[j][3]; }
            sm += __shfl_xor(sm, 1); sm += __shfl_xor(sm, 2);
            const float mu = sm * (1.f / 64.f); float vs = 0.f;
#pragma unroll
            for (int j = 0; j < 4; ++j) { yv[j] = yv[j] - mu; vs += yv[j][0] * yv[j][0] + yv[j][1] * yv[j][1] + yv[j][2] * yv[j][2] + yv[j][3] * yv[j][3]; }
            vs += __shfl_xor(vs, 1); vs += __shfl_xor(vs, 2);
            const float rs = __builtin_amdgcn_rsqf(vs * (1.f / 64.f) + 64e-5f);
            const unsigned c0w[8] = {a0.x, a0.y, a0.z, a0.w, a1.x, a1.y, a1.z, a1.w}, c1w[8] = {b0.x, b0.y, b0.z, b0.w, b1.x, b1.y, b1.z, b1.w};
            unsigned ow[8];
#pragma unroll
            for (int j = 0; j < 8; ++j) ow[j] = pk2(yv[j >> 1][(j & 1) * 2] * rs * __uint_as_float(c1w[j] << 16) + __uint_as_float(c0w[j] << 16),
                                                     yv[j >> 1][(j & 1) * 2 + 1] * rs * __uint_as_float(c1w[j] & 0xffff0000u) + __uint_as_float(c0w[j] & 0xffff0000u));
            const size_t grow = (size_t)b * SEQ + seg * SEGTOK + (cl - 1) * 64 + tk;
            bf16_t* ob = (bf16_t*)(p.ws + WS_OB) + grow * D + hb * 64 + 16 * g;
            *(u32x4*)ob = (u32x4){ow[0], ow[1], ow[2], ow[3]}; *(u32x4*)(ob + 8) = (u32x4){ow[4], ow[5], ow[6], ow[7]};
        }
    }
#pragma unroll
    for (int mt = 0; mt < 4; ++mt) *(f32x4*)(st + (size_t)(16 * vt + l15) * 64 + 16 * mt + 4 * q4) = S[mt];
    __syncthreads();
}

__device__ __forceinline__ void gdn_sample_item(const Params& p, unsigned char* smem, int bs, int h) {
    const int tid = otid(), w = tid >> 6, lane = tid & 63, kq = tid >> 7, v = tid & 127;
    float* qk_s = (float*)smem; float* v_s = qk_s + 1024; float* gb_s = v_s + 512; float* part = gb_s + 16; float* part2 = part + 512;
    const bf16_t* P = (const bf16_t*)(p.ws + WS_P);
    const float* pk = (const float*)(p.ws + WS_PK);
    const float* s_in = p.in[2] + (size_t)(bs * 8 + h) * 16384; float* s_out = p.out + O_GDN_S + (size_t)(bs * 8 + h) * 16384;
    const int row0 = LEX0 + EX_SAMP + bs * DECT;
    float s[32];
#pragma unroll
    for (int j = 0; j < 32; ++j) s[j] = s_in[(size_t)(kq * 32 + j) * 128 + v];
    if (tid < 384) {
        const int pcol = (tid >> 7) * 1024 + h * 128 + (tid & 127);
        const float* cw = pk + PK_CONVW; const float* hin = p.in[3] + (size_t)bs * 9216; float* hout = p.out + O_CONV_S + (size_t)bs * 9216;
        const float cw0 = cw[pcol], cw1 = cw[3072 + pcol], cw2 = cw[6144 + pcol], cw3 = cw[9216 + pcol];
        float x3 = hin[pcol], x2 = hin[3072 + pcol], x1 = hin[6144 + pcol];
        float xr[4];
#pragma unroll
        for (int i = 0; i < 4; ++i) xr[i] = bf2f(P[(size_t)(row0 + i) * NPB + pcol]);
#pragma unroll
        for (int i = 0; i < 4; ++i) { const float y = cw0 * x3 + cw1 * x2 + cw2 * x1 + cw3 * xr[i]; x3 = x2; x2 = x1; x1 = xr[i];
            if (tid < 256) qk_s[i * 256 + tid] = silu_(y); else v_s[i * 128 + (tid - 256)] = silu_(y); }
        hout[pcol] = x3; hout[3072 + pcol] = x2; hout[6144 + pcol] = x1;
    } else if (tid < 388) {
        const int i = tid - 384; const size_t r = (size_t)(row0 + i) * NPB;
        const float pa = bf2f(P[r + C_A + h]), pb = bf2f(P[r + C_B + h]);
        gb_s[2 * i] = __expf(-expf(pk[PK_ALOG + h]) * softplus_(pa + pk[PK_DTB + h])); gb_s[2 * i + 1] = sigm(pb);
    }
    __syncthreads();
    { const int i = w >> 1, which = w & 1; float* rp = qk_s + i * 256 + which * 128; const float a = rp[lane], b = rp[lane + 64];
      const float sc = __builtin_amdgcn_rsqf(wave_sum(a * a + b * b) + 1e-6f) * (which == 0 ? 0.08838834764831845f : 1.f); rp[lane] = a * sc; rp[lane + 64] = b * sc; }
    __syncthreads();
#pragma unroll 1
    for (int i = 0; i < 4; ++i) {
        const float* kp = qk_s + i * 256 + 128 + kq * 32; const float* qp = qk_s + i * 256 + kq * 32;
        float pa = 0.f;
#pragma unroll
        for (int j4 = 0; j4 < 8; ++j4) { const f32x4 k4 = *(const f32x4*)(kp + 4 * j4); pa += k4[0] * s[4 * j4] + k4[1] * s[4 * j4 + 1] + k4[2] * s[4 * j4 + 2] + k4[3] * s[4 * j4 + 3]; }
        part[kq * 128 + v] = pa;
        __syncthreads();
        const float kS = part[v] + part[128 + v] + part[256 + v] + part[384 + v];
        const float a = gb_s[2 * i], c = gb_s[2 * i + 1] * (v_s[i * 128 + v] - a * kS);
        float po = 0.f;
#pragma unroll
        for (int j4 = 0; j4 < 8; ++j4) { const f32x4 k4 = *(const f32x4*)(kp + 4 * j4), q4v = *(const f32x4*)(qp + 4 * j4);
#pragma unroll
            for (int e = 0; e < 4; ++e) { s[4 * j4 + e] = a * s[4 * j4 + e] + k4[e] * c; po += q4v[e] * s[4 * j4 + e]; } }
        part2[kq * 128 + v] = po;
        __syncthreads();
        if (kq == 0) ((float*)(p.ws + WS_ORAW))[(size_t)(row0 + i) * D + h * 128 + v] = part2[v] + part2[128 + v] + part2[256 + v] + part2[384 + v];
    }
#pragma unroll
    for (int j = 0; j < 32; ++j) s_out[(size_t)(kq * 32 + j) * 128 + v] = s[j];
    __syncthreads();
}

constexpr int SR_R = 0, SR_KK = 4096, SR_V = 8192, SR_ZB = 12288, SR_DEC = 16384, SR_KA = 20480, SR_KM = 24576, SR_WD = 28672, SR_AD = 28928, SR_RK = 29184;
__device__ __forceinline__ void rwkv_sample_item(const Params& p, unsigned char* smem, int bs) {
    const int tid = otid(), w = tid >> 6, lane = tid & 63;
    float* f = (float*)smem;
    const bf16_t* P = (const bf16_t*)(p.ws + WS_P);
    const float* pk = (const float*)(p.ws + WS_PK);
    const int row0 = LEX0 + EX_SAMP + bs * DECT;
    const bf16_t* prow = P + (size_t)(LEX0 + EX_SHIFT + bs) * NPB + C_RW;
#pragma unroll 1
    for (int col = tid; col < RW_SHIFT; col += 512) {
        const float mu = pk[PK_MU + col]; float prev = bf2f(prow[col]);
        float cur[4];
#pragma unroll
        for (int i = 0; i < 4; ++i) cur[i] = bf2f(P[(size_t)(row0 + i) * NPB + C_RW + col]);
        float* dst; int stride = 1024; bool th = false;
        if (col < 1024) dst = f + SR_R + col; else if (col < 2048) dst = f + SR_KK + (col - 1024); else if (col < 3072) dst = f + SR_V + (col - 2048);
        else if (col < 3136) { dst = f + SR_WD + (col - 3072); stride = 64; th = true; } else if (col < 3200) { dst = f + SR_AD + (col - 3136); stride = 64; } else dst = f + SR_ZB + (col - 3200);
#pragma unroll
        for (int i = 0; i < 4; ++i) { float m = cur[i] + mu * (prev - cur[i]); prev = cur[i]; if (th) m = tanh_(m); dst[i * stride] = m; }
    }
    __syncthreads();
#pragma unroll 1
    for (int cc = 0; cc < 2; ++cc) {
        const int c = tid + 512 * cc;
        float aw[4] = {0.f, 0.f, 0.f, 0.f}, aa[4] = {0.f, 0.f, 0.f, 0.f};
#pragma unroll 8
        for (int l = 0; l < 64; ++l) { const float w2v = pk[PK_W2 + l * D + c], a2v = pk[PK_A2 + l * D + c];
#pragma unroll
            for (int i = 0; i < 4; ++i) { aw[i] += f[SR_WD + i * 64 + l] * w2v; aa[i] += f[SR_AD + i * 64 + l] * a2v; } }
        const float w0c = pk[PK_W0 + c], a0c = pk[PK_A0 + c], kkc = pk[PK_KK + c], kac = pk[PK_KA + c];
#pragma unroll
        for (int i = 0; i < 4; ++i) { const float a = sigm(a0c + aa[i]); const float kbv = f[SR_KK + i * 1024 + c];
            f[SR_DEC + i * 1024 + c] = __expf(-0.6065306597126334f * sigm(w0c + aw[i])); f[SR_KA + i * 1024 + c] = a; f[SR_KK + i * 1024 + c] = kbv * kkc; f[SR_KM + i * 1024 + c] = kbv * (1.f + (a - 1.f) * kac); }
    }
    __syncthreads();
#pragma unroll 1
    for (int x = 0; x < 8; ++x) { const int pr = w * 8 + x, i = pr >> 4, hh = pr & 15; const int o = i * 1024 + hh * 64 + lane;
        const float kr = f[SR_KK + o]; const float kk = kr * __builtin_amdgcn_rsqf(wave_sum(kr * kr) + 1e-6f); f[SR_KK + o] = kk; f[SR_KA + o] = kk * f[SR_KA + o];
        const float rkv = wave_sum(f[SR_R + o] * f[SR_KM + o] * pk[PK_RK + hh * 64 + lane]); if (lane == 0) f[SR_RK + pr] = rkv; }
    __syncthreads();
#pragma unroll 1
    for (int hp = 0; hp < 2; ++hp) {
        const int hb = hp * 8 + w;
        const float* s_in = p.in[4] + (size_t)(bs * 16 + hb) * 4096 + (size_t)lane * 64; float* s_out = p.out + O_RWKV_S + (size_t)(bs * 16 + hb) * 4096 + (size_t)lane * 64;
        f32x4 S[16];
#pragma unroll
        for (int j = 0; j < 16; ++j) S[j] = *(const f32x4*)(s_in + 4 * j);
        const int cch = hb * 64 + lane;
        const float gnw = pk[PK_GNW + cch], gnb = pk[PK_GNB + cch];
#pragma unroll 1
        for (int i = 0; i < 4; ++i) {
            const int o = i * 1024 + hb * 64;
            const float vv = f[SR_V + o + lane], rk = f[SR_RK + i * 16 + hb];
            float sa = 0.f;
#pragma unroll
            for (int j = 0; j < 16; ++j) { const f32x4 kk4 = *(const f32x4*)(f + SR_KK + o + 4 * j); sa += S[j][0] * kk4[0] + S[j][1] * kk4[1] + S[j][2] * kk4[2] + S[j][3] * kk4[3]; }
            float y = 0.f;
#pragma unroll
            for (int j = 0; j < 16; ++j) { const f32x4 de4 = *(const f32x4*)(f + SR_DEC + o + 4 * j), ka4 = *(const f32x4*)(f + SR_KA + o + 4 * j), km4 = *(const f32x4*)(f + SR_KM + o + 4 * j), r4 = *(const f32x4*)(f + SR_R + o + 4 * j);
#pragma unroll
                for (int e = 0; e < 4; ++e) { S[j][e] = S[j][e] * de4[e] + (vv * km4[e] - sa * ka4[e]); y += S[j][e] * r4[e]; } }
            const float mu = wave_sum(y) * (1.f / 64.f); const float dy = y - mu;
            const float rs = __builtin_amdgcn_rsqf(wave_sum(dy * dy) * (1.f / 64.f) + 64e-5f);
            const float ov = (dy * rs * gnw + gnb + rk * vv) * silu_(f[SR_ZB + i * 1024 + cch]);
            ((bf16_t*)(p.ws + WS_OB))[(size_t)(XROWS + EX_SAMP + bs * DECT + i) * D + cch] = (bf16_t)f2bf(ov);
        }
#pragma unroll
        for (int j = 0; j < 16; ++j) *(f32x4*)(s_out + 4 * j) = S[j];
    }
    __syncthreads();
}

__device__ __forceinline__ void phase2(const Params& p, int seg, unsigned char* smem) {
    const int blk = obid();
    float* out = p.out;
    float* chalo = (float*)(p.ws + WS_CHALO); float* phalo = (float*)(p.ws + WS_PHALO);
#ifndef SUB
#define SUB 0
#endif
#define SEN(x) (SUB == 0 || SUB == (x))
    if (SEN(1) && blk < 64) gdn_scan_block(p, seg, smem, blk);
    if (SEN(3) && blk >= 64 && blk < 128) rwkv_scan_block(p, seg, smem, blk - 64);
#ifndef DUP
#define DUP 0
#endif
    if (seg == 0) {
#pragma unroll 1
        for (int it = blk; it < DECB * 8; it += gridDim.x) gdn_sample_item(p, smem, it >> 3, it & 7);
#pragma unroll 1
        for (int it = blk; it < DECB; it += gridDim.x) rwkv_sample_item(p, smem, it);
    }
}

__device__ __forceinline__ void phase25(const Params& p, int seg) {
    const int tid0 = otid(); const int lane = tid0 & 63; const int gw = obid() * 8 + (tid0 >> 6), NGW = gridDim.x * 8;
    const bf16_t* P = (const bf16_t*)(p.ws + WS_P);
    const float* ORAW = (const float*)(p.ws + WS_ORAW); const float* YRAW = (const float*)(p.ws + WS_YRAW);
    const bf16_t* C0 = (const bf16_t*)(p.ws + WS_C0); const bf16_t* C1 = (const bf16_t*)(p.ws + WS_C1);
    bf16_t* OA = (bf16_t*)(p.ws + WS_H); bf16_t* OB = (bf16_t*)(p.ws + WS_OB);
    const int nrows = LEX0 + (seg == 0 ? DECB * DECT : 0);
    const int c = lane * 16;
    f32x4 nw[4];
#pragma unroll
    for (int j = 0; j < 4; ++j) nw[j] = *(const f32x4*)((const float*)(p.ws + WS_PK) + PK_NORMW + (c & 127) + 4 * j);
#pragma unroll 1
    for (int rr = LEX0 + gw; rr < nrows; rr += NGW) {
        int lr; size_t grow;
        if (rr < LEX0) { lr = rr; grow = (size_t)(rr / SEGTOK) * SEQ + seg * SEGTOK + (rr % SEGTOK); } else { lr = LEX0 + EX_SAMP + (rr - LEX0); grow = (size_t)XROWS + EX_SAMP + (rr - LEX0); }
        {
            f32x4 o[4]; float ss = 0.f;
#pragma unroll
            for (int j = 0; j < 4; ++j) { o[j] = *(const f32x4*)(ORAW + (size_t)lr * D + c + 4 * j); ss += o[j][0] * o[j][0] + o[j][1] * o[j][1] + o[j][2] * o[j][2] + o[j][3] * o[j][3]; }
            ss += __shfl_xor(ss, 1); ss += __shfl_xor(ss, 2); ss += __shfl_xor(ss, 4);
            const float rs = __builtin_amdgcn_rsqf(ss * (1.f / 128.f) + 1e-6f);
            const u32x4 z0 = *(const u32x4*)(P + (size_t)lr * NPB + C_Z + c), z1 = *(const u32x4*)(P + (size_t)lr * NPB + C_Z + c + 8);
            const unsigned zz[8] = {z0.x, z0.y, z0.z, z0.w, z1.x, z1.y, z1.z, z1.w};
            unsigned ow[8];
#pragma unroll
            for (int j = 0; j < 8; ++j) { const float za = __uint_as_float(zz[j] << 16), zb = __uint_as_float(zz[j] & 0xffff0000u);
                const float a = o[j >> 1][(j & 1) * 2] * rs * nw[j >> 1][(j & 1) * 2] * silu_(za), b = o[j >> 1][(j & 1) * 2 + 1] * rs * nw[j >> 1][(j & 1) * 2 + 1] * silu_(zb);
                ow[j] = pk2(a, b); }
            *(u32x4*)(OA + grow * D + c) = (u32x4){ow[0], ow[1], ow[2], ow[3]}; *(u32x4*)(OA + grow * D + c + 8) = (u32x4){ow[4], ow[5], ow[6], ow[7]};
        }
    }
}

__device__ __forceinline__ void phase_final(const Params& p) {
    const int tid0 = otid(); const int lane = tid0 & 63; const int gw = obid() * 8 + (tid0 >> 6), NGW = gridDim.x * 8;
    const f32x4* wr = (const f32x4*)((const float*)(p.ws + WS_PK) + PK_LNF) + lane;
#pragma unroll 1
    for (int r = gw; r < XROWS + DECB * DECT; r += NGW) {
        f32x4* xr = (f32x4*)(p.out + (size_t)r * D) + lane;
        f32x4 v[4]; float ss = 0.f;
#pragma unroll
        for (int j = 0; j < 4; ++j) { v[j] = xr[64 * j]; ss += v[j][0] * v[j][0] + v[j][1] * v[j][1] + v[j][2] * v[j][2] + v[j][3] * v[j][3]; }
        const float rs = __builtin_amdgcn_rsqf(wave_sum(ss) * (1.f / D) + 1e-6f);
#pragma unroll
        for (int j = 0; j < 4; ++j) xr[64 * j] = v[j] * rs * wr[64 * j];
    }
}

__global__ __launch_bounds__(512, 2) void hybrid_mega(Params p) {
    extern __shared__ __attribute__((aligned(16))) unsigned char smem[];
    cg::grid_group grid = cg::this_grid();
    LAS unsigned char* lds = (LAS unsigned char*)smem;
    const int G = gridDim.x;
    volatile LAS unsigned* xst = (volatile LAS unsigned*)(lds + (LDS_TOTAL - 16));
    if (threadIdx.x == 0) { xst[0] = 0u; xst[1] = 0u; }
    __syncthreads();
    (void)xcd_barrier_post((unsigned*)(p.ws + WS_BAR), xst);
    if (G == 0x7fffffff) grid.sync();
#define GSYNC() do { XcdBarrier xb_; xb_.bar = (unsigned*)(p.ws + WS_BAR); xb_.x = xb_xcc_id(); xb_.st = (volatile LAS unsigned*)((LAS unsigned char*)smem + (LDS_TOTAL - 16)); xcd_barrier(xb_); } while (0)

#ifndef ONLY
#define ONLY 0
#endif
#define EN(x) (ONLY == 0 || ONLY == (x))
    if (EN(1)) phase0(p, smem);
    GSYNC();
#pragma unroll 1
    for (int it = 0; it <= NSEG + 2; ++it) {
        const int xblk = obid() - (G - 12);
        const bool xrole = xblk >= 0;
        if (it > 0 && it <= NSEG && EN(3)) phase2(p, it - 1, smem);
        if (((it == 2 && xrole) || it == NSEG + 1) && EN(5)) {
            const bool ex = it == 2;
            SchedAB S; S.ob.init(ex ? 3 : XROWS / 256, 4, ex ? 12 : G, ex ? xblk : obid()); S.pm0 = ex ? XROWS / 256 : 0;
            S.A0 = (const char*)(p.ws + WS_H); S.A1 = (const char*)(p.ws + WS_OB); S.B0 = (const char*)(p.ws + WS_WT_A); S.B1 = (const char*)(p.ws + WS_WT_B);
            EpiAB E; E.tmp = ex ? (bf16_t*)(p.ws + WS_YRAW) - (size_t)XROWS * D : (bf16_t*)(p.ws + WS_P); E.merged = ex ? (bf16_t*)(p.ws + WS_C0) - (size_t)XROWS * D : (bf16_t*)(p.ws + WS_MG);
            E.gex = (const bf16_t*)(p.ws + WS_GEX); E.out = p.out;
            pg8::gemm_phase<EpiAB, SchedAB>(lds, D, S, E);
        }
        if (((it == 3 && xrole) || it == NSEG + 2) && EN(6)) {
            const bool ex = it == 3;
            SchedO S; S.ob.init(ex ? 3 : XROWS / 256, 4, ex ? 12 : G, ex ? xblk : obid()); S.pm0 = ex ? XROWS / 256 : 0;
            S.A = ex ? (const char*)((bf16_t*)(p.ws + WS_C0) - (size_t)XROWS * D) : (const char*)(p.ws + WS_MG); S.B = (const char*)(p.ws + WS_WT_O);
            EpiO E; E.out = p.out; E.xp = p.in[0]; E.xs = p.in[1];
            pg8::gemm_phase<EpiO, SchedO>(lds, D, S, E);
        }
        if (it < NSEG && EN(2) && !(it == 2 && xrole)) {
            const int seg = it;
            const int Gp = it == 2 ? G - 12 : G;
            const int cidx = it > 0 ? (obid() + (Gp >> 1)) % Gp : obid();
            SchedIn S; S.ob.init(seg == 0 ? LT_PROMPT + 3 : LT_PROMPT, NT_IN, Gp, cidx); S.seg = seg; S.A = (const char*)(p.ws + WS_H); S.B = (const char*)(p.ws + WS_WT_IN);
            EpiIn E; E.P = (bf16_t*)(p.ws + WS_P); E.gex = (bf16_t*)(p.ws + WS_GEX); E.out = p.out; E.seg = seg;
            pg8::gemm_phase<EpiIn, SchedIn>(lds, D, S, E);
        }
        if (it >= 1 && it + 1 < NSEG && obid() >= 200) { const int t0 = otid(); h_rows_segs(p, it + 1, it + 2, (obid() - 200) * 8 + (t0 >> 6), (G - 200) * 8, t0 & 63); }
        GSYNC();
        if (it < NSEG) {
            if (EN(8)) { phase_gprep(p, it, smem); phase_rprep(p, it, smem); }
            if (it == 1 && EN(4)) phase25(p, 0);
            GSYNC();
        }
    }
    if (EN(7)) phase_final(p);
}

extern "C" void kernel_launch(void* const* d_in, const int* in_sizes, int n_in, void* d_out, int out_size, void* d_ws, size_t ws_size, hipStream_t stream) {
    static int grid_blocks = 0;
    constexpr int LDS_BYTES = LDS_TOTAL;
    if (grid_blocks == 0) {
        if (n_in != 27 || ws_size < WS_END) { fprintf(stderr, "kernel_launch: unexpected n_in %d / ws %zu (need %zu)\n", n_in, ws_size, (size_t)WS_END); grid_blocks = -1; return; }
        if (hipFuncSetAttribute((const void*)hybrid_mega, hipFuncAttributeMaxDynamicSharedMemorySize, LDS_BYTES) != hipSuccess) { fprintf(stderr, "kernel_launch: hipFuncSetAttribute failed\n"); grid_blocks = -1; return; }
        int dev = 0, cus = 0, per_cu = 0;
        hipGetDevice(&dev);
        hipDeviceGetAttribute(&cus, hipDeviceAttributeMultiprocessorCount, dev);
        hipOccupancyMaxActiveBlocksPerMultiprocessor(&per_cu, (const void*)hybrid_mega, 512, LDS_BYTES);
        if (per_cu < 1) { fprintf(stderr, "kernel_launch: occupancy query says %d blocks/CU\n", per_cu); per_cu = 1; }
        (void)hipGetLastError();
        grid_blocks = cus;
    }
    if (grid_blocks < 0) return;
    Params p{};
    for (int i = 0; i < 27; ++i) p.in[i] = (const float*)d_in[i];
    p.out = (float*)d_out; p.ws = (unsigned char*)d_ws;
    if (hipMemsetAsync((unsigned char*)d_ws + WS_BAR, 0, 16384, stream) != hipSuccess) { fprintf(stderr, "kernel_launch: memset of the barrier words failed\n"); return; }
    void* args[] = {&p};
    hipError_t e = hipLaunchCooperativeKernel((const void*)hybrid_mega, dim3(grid_blocks), dim3(512), args, LDS_BYTES, stream);
    if (e != hipSuccess) fprintf(stderr, "cooperative launch failed: %s (grid %d)\n", hipGetErrorString(e), grid_blocks);
}
```

```cpp
#include <hip/hip_runtime.h>
#include <hip/hip_cooperative_groups.h>
#include <cstdio>
namespace cg = cooperative_groups;

#define LAS __attribute__((address_space(3)))
typedef unsigned short bf16_t;
typedef short bf16x8 __attribute__((ext_vector_type(8)));
typedef float f32x4 __attribute__((ext_vector_type(4)));
typedef unsigned u32x4 __attribute__((ext_vector_type(4)));
typedef unsigned u32x2 __attribute__((ext_vector_type(2)));

constexpr int D = 1024;
constexpr int NBATCH = 8, SEQ = 2048, NMETA = 16, DECB = 128, DECT = 4;
constexpr int XROWS = NBATCH * SEQ;
constexpr int EX_SAMP = 16, EX_SHIFT = 528, EX_END = 656;
constexpr int HROWS = 17152, HTILES = 67;
constexpr int NSEG = 8, SEGTOK = SEQ / NSEG;
constexpr int CPS = SEGTOK / 64;
constexpr int TPB = SEGTOK / 256;
constexpr int LT_PROMPT = NBATCH * TPB;
constexpr int LEX0 = LT_PROMPT * 256;
constexpr int LROWS = LEX0 + 768;
constexpr int NP = 10496, NPB = 8448, NT_IN = 41, NT_PB = 33;
constexpr int C_A = 3072, C_B = 3080, C_Z = 3088, C_RW = 4112, C_GATE_REF = 8336;
constexpr int RW_SHIFT = 4224;

constexpr size_t O_YP = 0, O_YS = 16777216, O_GDN_P = 17301504, O_CONV_P = 18350080, O_RWKV_P = 18423808, O_SHIFT_P = 18948096,
                 O_GDN_S = 18956288, O_CONV_S = 35733504, O_RWKV_S = 36913152, O_SHIFT_S = 45301760;

constexpr size_t al256(size_t x) { return (x + 255) & ~(size_t)255; }
constexpr size_t WS_WT_IN = 0;
constexpr size_t WS_WT_A = al256(WS_WT_IN + (size_t)NP * D * 2);
constexpr size_t WS_WT_B = al256(WS_WT_A + (size_t)D * D * 2);
constexpr size_t WS_WT_O = al256(WS_WT_B + (size_t)D * D * 2);
constexpr size_t WS_H = al256(WS_WT_O + (size_t)D * D * 2);
constexpr size_t WS_OB = al256(WS_H + (size_t)HROWS * D * 2);
constexpr size_t WS_P = al256(WS_OB + (size_t)HROWS * D * 2);
constexpr size_t WS_ORAW = al256(WS_P + (size_t)LROWS * NPB * 2);
constexpr size_t WS_YRAW = al256(WS_ORAW + (size_t)LROWS * D * 4);
constexpr size_t WS_C0 = al256(WS_YRAW + (size_t)LROWS * D * 4);
constexpr size_t WS_C1 = al256(WS_C0 + (size_t)LROWS * D * 2);
constexpr size_t WS_GEX = al256(WS_C1 + (size_t)LROWS * D * 2);
constexpr size_t WS_CHALO = al256(WS_GEX + (size_t)768 * 2048 * 2);
constexpr size_t WS_PHALO = al256(WS_CHALO + (size_t)2 * NBATCH * 3 * NPB * 2);
constexpr size_t WS_PK = al256(WS_PHALO + (size_t)2 * NBATCH * NPB * 2);
constexpr int PK_CONVW = 0, PK_ALOG = 12288, PK_DTB = 12296, PK_NORMW = 12304, PK_MU = 12432, PK_W0 = 16656, PK_W2 = 17680, PK_A0 = 83216, PK_A2 = 84240,
              PK_KK = 149776, PK_KA = 150800, PK_RK = 151824, PK_GNW = 152848, PK_GNB = 153872, PK_LNF = 154896, PK_END = 155920;
constexpr size_t WS_BAR = al256(WS_PK + (size_t)PK_END * 4);
constexpr size_t WS_W2T = al256(WS_BAR + 16384);
constexpr size_t WS_A2T = al256(WS_W2T + 131072);
constexpr size_t WS_GP = al256(WS_A2T + 131072);
constexpr int GP_AP = 0, GP_QH = 32768, GP_KH = 49152, GP_OH = 81920, GP_EGL = 98304, GP_G = 98560, GP_STRIDE = 114944;
constexpr int RP_AP = 0, RP_RH = 8192, RP_KH = 16384, RP_YH = 24576, RP_C1 = 32768, RP_C0 = 40960, RP_PC = 49152, RP_STRIDE = 49408;
constexpr size_t WS_RP = al256(WS_GP + (size_t)(CPS + 1) * 64 * GP_STRIDE);
constexpr size_t WS_END = al256(WS_RP + (size_t)(CPS + 1) * 128 * RP_STRIDE);
constexpr size_t WS_MG = WS_GP;
static_assert((size_t)HROWS * D * 2 <= WS_END - WS_GP, "MERGED must fit in the prep records");
static_assert((size_t)HROWS * D * 4 <= (size_t)LROWS * NPB * 2 + 2 * (size_t)LROWS * D * 4, "TMP must fit in P+ORAW+YRAW");
static_assert(WS_END <= (size_t)268435456, "workspace");

constexpr int LDS_TOTAL = 163840;
struct Params { const float* in[27]; float* out; unsigned char* ws; };

__device__ __forceinline__ float bf2f(bf16_t v) { return __uint_as_float(((unsigned)v) << 16); }
typedef __bf16 bf16n2 __attribute__((ext_vector_type(2)));
typedef float f32n2 __attribute__((ext_vector_type(2)));
__device__ __forceinline__ unsigned cvt_pk_bf16(float lo, float hi) { const f32n2 v = {lo, hi}; return __builtin_bit_cast(unsigned, __builtin_convertvector(v, bf16n2)); }
__device__ __forceinline__ unsigned pk2(float lo, float hi) { return cvt_pk_bf16(lo, hi); }
__device__ __forceinline__ unsigned f2bf(float f) { return cvt_pk_bf16(f, 0.f) & 0xffffu; }
__device__ __forceinline__ float sigm(float x) { return __builtin_amdgcn_rcpf(1.f + __expf(-x)); }
__device__ __forceinline__ float silu_(float x) { return x * __builtin_amdgcn_rcpf(1.f + __expf(-x)); }
__device__ __forceinline__ float softplus_(float x) { return fmaxf(x, 0.f) + log1pf(expf(-fabsf(x))); }
__device__ __forceinline__ float wave_sum(float v) {
#pragma unroll
    for (int o = 1; o < 64; o <<= 1) v += __shfl_xor(v, o);
    return v;
}
__device__ __forceinline__ void unpack8(const u32x4 rw, float (&x)[8]) {
    x[0] = __uint_as_float(rw.x << 16); x[1] = __uint_as_float(rw.x & 0xffff0000u); x[2] = __uint_as_float(rw.y << 16); x[3] = __uint_as_float(rw.y & 0xffff0000u);
    x[4] = __uint_as_float(rw.z << 16); x[5] = __uint_as_float(rw.z & 0xffff0000u); x[6] = __uint_as_float(rw.w << 16); x[7] = __uint_as_float(rw.w & 0xffff0000u); }
__device__ __forceinline__ u32x4 pack8(const float (&x)[8]) { return (u32x4){pk2(x[0], x[1]), pk2(x[2], x[3]), pk2(x[4], x[5]), pk2(x[6], x[7])}; }

__device__ __forceinline__ int otid() { int t = threadIdx.x; asm volatile("" : "+v"(t)); return t; }
__device__ __forceinline__ int obid() { int t = blockIdx.x; asm volatile("" : "+s"(t)); return t; }
__device__ __forceinline__ float tanh_(float x) { const float e = __expf(2.f * x); return 1.f - 2.f * __builtin_amdgcn_rcpf(e + 1.f); }
template <int CTRL> __device__ __forceinline__ float dppf(float x) { return __builtin_bit_cast(float, __builtin_amdgcn_mov_dpp(__builtin_bit_cast(int, x), CTRL, 0xf, 0xf, true)); }
__device__ __forceinline__ float rowsum16(float x) { x += dppf<0x128>(x); x += dppf<0x124>(x); x += dppf<0x122>(x); x += dppf<0x121>(x); return x; }


#define XB_TMO      128
#define XB_XCNT(j)  (256  + 64 * (j))
#define XB_XSUB(j)  (1280 + 64 * (j))
#define XB_XGEN(j)  (2304 + 64 * (j))
#define XB_TOP      3328
#define XB_TOPGEN   3392
#define XCD_BAR_WORDS 3456
#define XB_SPIN_CAP (1u << 22)
__device__ __forceinline__ unsigned xb_ld(unsigned* p)              { return __hip_atomic_load(p, __ATOMIC_RELAXED, __HIP_MEMORY_SCOPE_AGENT); }
__device__ __forceinline__ unsigned xb_add(unsigned* p, unsigned v) { return __hip_atomic_fetch_add(p, v, __ATOMIC_RELAXED, __HIP_MEMORY_SCOPE_AGENT); }
__device__ __forceinline__ unsigned xb_xcc_id() { return (unsigned)__builtin_amdgcn_s_getreg((3 << 11) | 20) & 0xFu; }
#define XB_SPIN(cond, bar) do { unsigned _sp = 0; while (cond) { __builtin_amdgcn_s_sleep(1); \
    if ((++_sp & 255u) == 0u) { if (xb_ld(&(bar)[XB_TMO])) break; if (_sp > XB_SPIN_CAP) { atomicAdd(&(bar)[XB_TMO], 1u); break; } } } } while (0)
struct XcdBarrier { unsigned* bar; unsigned x; volatile LAS unsigned* st; };
__device__ __forceinline__ XcdBarrier xcd_barrier_post(unsigned* bar, volatile LAS unsigned* st) {
    XcdBarrier b; b.bar = bar; b.x = xb_xcc_id(); b.st = st;
    if (threadIdx.x == 0) (void)xb_add(&bar[XB_XCNT(b.x)], 1u);
    return b;
}
__device__ __forceinline__ void xcd_barrier_complete(unsigned* bar, unsigned x, unsigned& nloc, unsigned& nx) {
    const unsigned G = gridDim.x * gridDim.y * gridDim.z;
    unsigned sum, cnt, mine, sp = 0u;
    for (;;) {
        sum = 0u; cnt = 0u; mine = 0u;
#pragma unroll
        for (unsigned j = 0; j < 16; ++j) { const unsigned c = xb_ld(&bar[XB_XCNT(j)]); sum += c; cnt += (c > 0u) ? 1u : 0u; mine = (j == x) ? c : mine; }
        if (sum == G) break;
        __builtin_amdgcn_s_sleep(1);
        if ((++sp & 255u) == 0u) { if (xb_ld(&bar[XB_TMO])) break; if (sp > XB_SPIN_CAP) { atomicAdd(&bar[XB_TMO], 1u); break; } }
    }
    nloc = mine > 0u ? mine : 1u; nx = cnt > 0u ? cnt : 1u;
}
__device__ __forceinline__ void xcd_barrier(const XcdBarrier& b) {
    asm volatile("s_waitcnt vmcnt(0)" ::: "memory");
    __syncthreads();
    if (threadIdx.x == 0) {
        unsigned* bar = b.bar;
        __builtin_amdgcn_s_waitcnt(0);
        unsigned nloc = b.st[0], nx = b.st[1];
        if (nloc == 0u) { xcd_barrier_complete(bar, b.x, nloc, nx); b.st[0] = nloc; b.st[1] = nx; }
        const unsigned old = xb_add(&bar[XB_XSUB(b.x)], 1u);
        const unsigned gen = old / nloc;
        if (old + 1u == (gen + 1u) * nloc) {
            __builtin_amdgcn_fence(__ATOMIC_RELEASE, "agent");
            asm volatile("s_waitcnt vmcnt(0)" ::: "memory");
            const unsigned og = xb_add(&bar[XB_TOP], 1u);
            const unsigned tg = og / nx;
            if (og + 1u == (tg + 1u) * nx) xb_add(&bar[XB_TOPGEN], 1u);
            else XB_SPIN(xb_ld(&bar[XB_TOPGEN]) == tg, bar);
            __builtin_amdgcn_fence(__ATOMIC_ACQUIRE, "agent");
            xb_add(&bar[XB_XGEN(b.x)], 1u);
            asm volatile("s_waitcnt vmcnt(0)" ::: "memory");
        } else {
            XB_SPIN(xb_ld(&bar[XB_XGEN(b.x)]) == gen, bar);
            __builtin_amdgcn_fence(__ATOMIC_ACQUIRE, "agent");
            asm volatile("s_waitcnt vmcnt(0)" ::: "memory");
        }
    }
    __syncthreads();
}

namespace pg8 {
constexpr int BM = 256, BK = 64, HALF = 128, HTB = HALF * BK * 2, STAGE_BYTES = 8 * HTB, NXCD = 8, WGM = 8;
__device__ __forceinline__ int lds_byte(int r, int c) { const int st = (r >> 4) * 2 + (c >> 5), rr = r & 15, cc = c & 31, ob = rr * 64 + cc * 2; return st * 1024 + (ob ^ (((ob >> 9) & 1) << 5)); }
__device__ __forceinline__ void stage_rc(int b, int& R, int& C) { const int st = b / 1024, sb = b % 1024, swz = sb ^ (((sb >> 9) & 1) << 5); R = (st >> 1) * 16 + swz / 64; C = (st & 1) * 32 + (swz % 64) / 2; }
__device__ __forceinline__ int perm32(int rho) { const int n = rho >> 4, i = rho & 15; return 8 * (i >> 2) + 4 * n + (i & 3); }

struct Unit { int pm, pn, w; };
struct OrderBase {
    int nM, nN, nwg, G, c;
    __device__ void init(int nM_, int nN_, int G_, int c_) { nM = nM_; nN = nN_; nwg = nM * nN; G = G_; c = c_; }
    __device__ bool nextb(int i, Unit& u) const {
        const long L = (long)i * G + c; if (L >= nwg) return false;
        int wgid = (int)L; { const int q = nwg / NXCD, r = nwg % NXCD, xcd = wgid % NXCD, off = wgid / NXCD; wgid = (xcd < r ? xcd * (q + 1) : r * (q + 1) + (xcd - r) * q) + off; }
        const int nig = WGM * nN, gid = wgid / nig, fm = gid * WGM, gsz = (nM - fm) < WGM ? (nM - fm) : WGM;
        u.pm = fm + ((wgid % nig) % gsz); u.pn = (wgid % nig) / gsz; u.w = 0; return true;
    }
};

template <class Epi, class Sched>
__device__ __forceinline__ void gemm_phase(LAS unsigned char* lds, const int K, const Sched& S, const Epi& E) {
    const int tid = otid(), wid = __builtin_amdgcn_readfirstlane(tid >> 6), lane = tid & 63, wr = wid >> 2, wc = wid & 3, fr = lane & 15, fq = lane >> 4;
    const int nt = K / BK;
    unsigned voffA[2], voffB[2];
#pragma unroll
    for (int i = 0; i < 2; ++i) { int R, C; stage_rc(tid * 16 + i * 8192, R, C); const int Rb = Epi::PERM ? ((R & ~31) + perm32(R & 31)) : R;
        voffA[i] = (unsigned)(R * K + C) * 2u; voffB[i] = (unsigned)(Rb * K + C) * 2u; }
    const size_t kstep = (size_t)(BK * 2);
    const size_t hstep = (size_t)HALF * K * 2;
    const unsigned ldsw = (unsigned)wid * 1024u;
    const int aoff = lds_byte(wr * 64 + fr, fq * 8), boff = lds_byte(wc * 32 + fr, fq * 8);
#define PG8_SA(b, h) (((b) * 2 + (h)) * HTB)
#define PG8_SB(b, h) ((4 + (b) * 2 + (h)) * HTB)
#define PG8_STAGE(bufoff, gbase, voff) do { _Pragma("unroll") for (int _i = 0; _i < 2; ++_i) \
        __builtin_amdgcn_global_load_lds((const unsigned*)((const char*)(gbase) + (voff)[_i]), (LAS unsigned*)(lds + (bufoff) + ldsw + _i * 8192), 16, 0, 0); } while (0)
#define PG8_LDA(dst, b, h) do { _Pragma("unroll") for (int m = 0; m < 4; ++m) _Pragma("unroll") for (int k = 0; k < 2; ++k) dst[m][k] = *(const LAS bf16x8*)(lds + PG8_SA(b, h) + aoff + m * 2048 + k * 1024); } while (0)
#define PG8_LDB(dst, b, h) do { _Pragma("unroll") for (int n = 0; n < 2; ++n) _Pragma("unroll") for (int k = 0; k < 2; ++k) dst[n][k] = *(const LAS bf16x8*)(lds + PG8_SB(b, h) + boff + n * 2048 + k * 1024); } while (0)
#define PG8_MMA(ai, bj, At, Bt) do { __builtin_amdgcn_s_setprio(1); _Pragma("unroll") for (int m = 0; m < 4; ++m) _Pragma("unroll") for (int n = 0; n < 2; ++n) _Pragma("unroll") for (int k = 0; k < 2; ++k) \
        acc[ai][bj][m][n] = __builtin_amdgcn_mfma_f32_16x16x32_bf16(Bt[n][k], At[m][k], acc[ai][bj][m][n], 0, 0, 0); __builtin_amdgcn_s_setprio(0); } while (0)
#define PG8_WAIT_V(n) asm volatile("s_waitcnt vmcnt(" #n ")" ::: "memory")
#define PG8_WAIT_L(n) asm volatile("s_waitcnt lgkmcnt(" #n ")" ::: "memory")
#define PG8_BAR __builtin_amdgcn_s_barrier()
#define PG8_SCHED __builtin_amdgcn_sched_barrier(0)
    Unit cur, nxt; int ui = 0;
    if (!S.next(0, cur)) return;
    f32x4 acc[2][2][4][2];
#pragma unroll
    for (int a = 0; a < 2; ++a)
#pragma unroll
        for (int b = 0; b < 2; ++b)
#pragma unroll
            for (int m = 0; m < 4; ++m)
#pragma unroll
                for (int n = 0; n < 2; ++n) acc[a][b][m][n] = (f32x4){0.f, 0.f, 0.f, 0.f};
    bf16x8 At[4][2], B0[2][2], B1[2][2];
    const char* cA = S.a_ptr(cur); const char* cB = S.b_ptr(cur);
    PG8_STAGE(PG8_SB(0, 0), cB, voffB); PG8_STAGE(PG8_SA(0, 0), cA, voffA); PG8_STAGE(PG8_SB(0, 1), cB + hstep, voffB); PG8_STAGE(PG8_SA(0, 1), cA + hstep, voffA);
    if (wr == 1) PG8_BAR;
    PG8_WAIT_V(4); PG8_BAR;
    PG8_STAGE(PG8_SB(1, 0), cB + kstep, voffB); PG8_STAGE(PG8_SA(1, 0), cA + kstep, voffA); PG8_STAGE(PG8_SB(1, 1), cB + hstep + kstep, voffB);
    PG8_WAIT_V(6); PG8_BAR;
    for (;;) {
        const bool has_next = S.next(ui + 1, nxt);
        const char* nA = has_next ? S.a_ptr(nxt) : cA; const char* nB = has_next ? S.b_ptr(nxt) : cB;
        for (int t = 0; t < nt; t += 2) {
            const bool last = (t == nt - 2);
            const char* a1 = cA + (size_t)(t + 1) * kstep;
            const char* a2 = last ? nA : cA + (size_t)(t + 2) * kstep; const char* b2 = last ? nB : cB + (size_t)(t + 2) * kstep;
            const char* a3 = a2 + kstep; const char* b3 = b2 + kstep;
            PG8_LDB(B0, 0, 0); PG8_SCHED; PG8_LDA(At, 0, 0); PG8_STAGE(PG8_SA(1, 1), a1 + hstep, voffA);
            PG8_WAIT_L(8); PG8_BAR; PG8_WAIT_L(0); PG8_MMA(0, 0, At, B0); PG8_BAR; PG8_SCHED;
            PG8_LDB(B1, 0, 1); PG8_STAGE(PG8_SB(0, 0), b2, voffB);
            PG8_BAR; PG8_WAIT_L(0); PG8_MMA(0, 1, At, B1); PG8_BAR;
            PG8_LDA(At, 0, 1); PG8_STAGE(PG8_SA(0, 0), a2, voffA);
            PG8_BAR; PG8_WAIT_L(0); PG8_MMA(1, 0, At, B0); PG8_BAR; PG8_SCHED;
            PG8_STAGE(PG8_SB(0, 1), b2 + hstep, voffB);
            PG8_WAIT_V(6); PG8_BAR; PG8_MMA(1, 1, At, B1); PG8_BAR;
            PG8_LDB(B0, 1, 0); PG8_SCHED; PG8_LDA(At, 1, 0); PG8_STAGE(PG8_SA(0, 1), a2 + hstep, voffA);
            PG8_WAIT_L(8); PG8_BAR; PG8_WAIT_L(0); PG8_MMA(0, 0, At, B0); PG8_BAR; PG8_SCHED;
            PG8_LDB(B1, 1, 1); PG8_STAGE(PG8_SB(1, 0), b3, voffB);
            PG8_BAR; PG8_WAIT_L(0); PG8_MMA(0, 1, At, B1); PG8_BAR;
            PG8_LDA(At, 1, 1); PG8_STAGE(PG8_SA(1, 0), a3, voffA);
            PG8_BAR; PG8_WAIT_L(0); PG8_MMA(1, 0, At, B0); PG8_BAR; PG8_SCHED;
            PG8_STAGE(PG8_SB(1, 1), b3 + hstep, voffB);
            PG8_WAIT_V(6); PG8_BAR; PG8_MMA(1, 1, At, B1); PG8_BAR;
        }
        E(acc, cur, wr, wc, fr, fq);
        if (!has_next) break;
#pragma unroll
        for (int a = 0; a < 2; ++a)
#pragma unroll
            for (int b = 0; b < 2; ++b)
#pragma unroll
                for (int m = 0; m < 4; ++m)
#pragma unroll
                    for (int n = 0; n < 2; ++n) acc[a][b][m][n] = (f32x4){0.f, 0.f, 0.f, 0.f};
        cur = nxt; cA = nA; cB = nB; ++ui;
    }
    PG8_WAIT_V(0);
    if (wr == 0) PG8_BAR;
    PG8_BAR;
#undef PG8_SA
#undef PG8_SB
#undef PG8_STAGE
#undef PG8_LDA
#undef PG8_LDB
#undef PG8_MMA
#undef PG8_WAIT_V
#undef PG8_WAIT_L
#undef PG8_BAR
#undef PG8_SCHED
}
}
using pg8::Unit;

struct SchedIn {
    pg8::OrderBase ob; int seg; const char* A; const char* B;
    __device__ bool next(int i, Unit& u) const { return ob.nextb(i, u); }
    __device__ const char* a_ptr(const Unit& u) const {
        const int gt = u.pm < LT_PROMPT ? ((u.pm / TPB) * (SEQ / 256) + seg * TPB + (u.pm % TPB)) : (XROWS / 256 + (u.pm - LT_PROMPT));
        return A + (size_t)gt * 256 * D * 2; }
    __device__ const char* b_ptr(const Unit& u) const { return B + (size_t)u.pn * 256 * D * 2; }
};
struct SchedAB {
    pg8::OrderBase ob; int pm0; const char* A0; const char* A1; const char* B0; const char* B1;
    __device__ bool next(int i, Unit& u) const { const bool ok = ob.nextb(i >> 1, u); u.pm += pm0; u.w = i & 1; return ok; }
    __device__ const char* a_ptr(const Unit& u) const { return (u.w ? A1 : A0) + (size_t)u.pm * 256 * D * 2; }
    __device__ const char* b_ptr(const Unit& u) const { return (u.w ? B1 : B0) + (size_t)u.pn * 256 * D * 2; }
};
struct SchedO {
    pg8::OrderBase ob; int pm0; const char* A; const char* B;
    __device__ bool next(int i, Unit& u) const { const bool ok = ob.nextb(i, u); u.pm += pm0; return ok; }
    __device__ const char* a_ptr(const Unit& u) const { return A + (size_t)u.pm * 256 * D * 2; }
    __device__ const char* b_ptr(const Unit& u) const { return B + (size_t)u.pn * 256 * D * 2; }
};

struct EpiIn {
    static constexpr bool PERM = true;
    bf16_t* P; bf16_t* gex; float* out; int seg;
    __device__ __forceinline__ void operator()(const f32x4 (&acc)[2][2][4][2], const Unit& u, int wr, int wc, int fr, int fq) const {
        const int lr0 = u.pm * 256 + wr * 64 + fr;
        const int c0 = u.pn * 256 + wc * 32 + 8 * fq;
#pragma unroll
        for (int ai = 0; ai < 2; ++ai)
#pragma unroll
            for (int m = 0; m < 4; ++m) {
                const int lr = lr0 + ai * 128 + m * 16;
                bf16_t* rowp;
                if (u.pn < NT_PB) rowp = P + (size_t)lr * NPB + c0;
                else if (lr < LEX0) { const int b = lr / SEGTOK; const size_t grow = (size_t)b * SEQ + seg * SEGTOK + (lr % SEGTOK); rowp = (bf16_t*)(out + O_YP + grow * D) + (c0 - NPB); }
                else rowp = gex + (size_t)(lr - LEX0) * 2048 + (c0 - NPB);
#pragma unroll
                for (int bj = 0; bj < 2; ++bj) { const f32x4 v0 = acc[ai][bj][m][0], v1 = acc[ai][bj][m][1];
                    u32x4 w; w.x = cvt_pk_bf16(v0[0], v0[1]); w.y = cvt_pk_bf16(v0[2], v0[3]); w.z = cvt_pk_bf16(v1[0], v1[1]); w.w = cvt_pk_bf16(v1[2], v1[3]);
                    *(u32x4*)(rowp + bj * 128) = w; }
            }
    }
};
struct EpiAB {
    static constexpr bool PERM = true;
    bf16_t* tmp; bf16_t* merged; const bf16_t* gex; const float* out;
    __device__ __forceinline__ void operator()(const f32x4 (&acc)[2][2][4][2], const Unit& u, int wr, int wc, int fr, int fq) const {
        const int row0 = u.pm * 256 + wr * 64 + fr, col0 = u.pn * 256 + wc * 32 + 8 * fq;
#pragma unroll
        for (int ai = 0; ai < 2; ++ai)
#pragma unroll
            for (int m = 0; m < 4; ++m) {
                const int grow = row0 + ai * 128 + m * 16;
                const bf16_t* gp = (grow < XROWS) ? ((const bf16_t*)(out + O_YP + (size_t)grow * D) + u.w * D) : (gex + (size_t)(grow - XROWS) * 2048 + u.w * D);
#pragma unroll
                for (int bj = 0; bj < 2; ++bj) {
                    const int c = col0 + bj * 128;
                    float g[8]; unpack8(*(const u32x4*)(gp + c), g);
                    const f32x4 v0 = acc[ai][bj][m][0], v1 = acc[ai][bj][m][1];
                    float v[8] = {v0[0] * sigm(g[0]), v0[1] * sigm(g[1]), v0[2] * sigm(g[2]), v0[3] * sigm(g[3]), v1[0] * sigm(g[4]), v1[1] * sigm(g[5]), v1[2] * sigm(g[6]), v1[3] * sigm(g[7])};
                    bf16_t* tp = tmp + (size_t)grow * D + c;
                    if (u.w == 0) *(u32x4*)tp = pack8(v);
                    else { float t[8]; unpack8(*(const u32x4*)tp, t);
#pragma unroll
                        for (int e = 0; e < 8; ++e) v[e] += t[e];
                        *(u32x4*)(merged + (size_t)grow * D + c) = pack8(v); }
                }
            }
    }
};
struct EpiO {
    static constexpr bool PERM = false;
    float* out; const float* xp; const float* xs;
    __device__ __forceinline__ void operator()(const f32x4 (&acc)[2][2][4][2], const Unit& u, int wr, int wc, int fr, int fq) const {
        const int row0 = u.pm * 256 + wr * 64 + fr, col0 = u.pn * 256 + wc * 32 + 4 * fq;
#pragma unroll
        for (int ai = 0; ai < 2; ++ai)
#pragma unroll
            for (int m = 0; m < 4; ++m) {
                const int grow = row0 + ai * 128 + m * 16;
                const float* xr; float* yr;
                if (grow < XROWS) { xr = xp + (size_t)grow * D; yr = out + O_YP + (size_t)grow * D; }
                else { const int e = grow - XROWS; if (e < EX_SAMP || e >= EX_SHIFT) continue; xr = xs + (size_t)(e - EX_SAMP) * D; yr = out + O_YS + (size_t)(e - EX_SAMP) * D; }
#pragma unroll
                for (int bj = 0; bj < 2; ++bj)
#pragma unroll
                    for (int n = 0; n < 2; ++n) { const int c = col0 + bj * 128 + n * 16; *(f32x4*)(yr + c) = *(const f32x4*)(xr + c) + acc[ai][bj][m][n]; }
            }
    }
};

__device__ __forceinline__ void p0_row(const Params& p, int r, int lane) {
    bf16_t* hrow = (bf16_t*)(p.ws + WS_H) + (size_t)r * D;
    const float* src = nullptr; bool norm = true; float* sh = nullptr;
    if (r < XROWS) { src = p.in[0] + (size_t)r * D; if ((r & (SEQ - 1)) == SEQ - 1) sh = p.out + O_SHIFT_P + (size_t)(r / SEQ) * D; }
    else { const int e = r - XROWS;
        if (e < EX_SAMP) src = p.in[6] + (size_t)e * D;
        else if (e < EX_SHIFT) { src = p.in[1] + (size_t)(e - EX_SAMP) * D; if (((e - EX_SAMP) & 3) == 3) sh = p.out + O_SHIFT_S + (size_t)((e - EX_SAMP) >> 2) * D; }
        else if (e < EX_END) { src = p.in[5] + (size_t)(e - EX_SHIFT) * D; norm = false; } }
    u32x2* o8 = (u32x2*)hrow + lane;
    if (!src) {
#pragma unroll
        for (int j = 0; j < 4; ++j) o8[64 * j] = (u32x2){0u, 0u};
        return; }
    const f32x4* xr = (const f32x4*)src + lane;
    f32x4 v[4]; float ss = 0.f;
#pragma unroll
    for (int j = 0; j < 4; ++j) { v[j] = xr[64 * j]; ss += v[j][0] * v[j][0] + v[j][1] * v[j][1] + v[j][2] * v[j][2] + v[j][3] * v[j][3]; }
    if (norm) {
        const float rs = __builtin_amdgcn_rsqf(wave_sum(ss) * (1.f / D) + 1e-6f);
        const f32x4* wr = (const f32x4*)p.in[7] + lane;
#pragma unroll
        for (int j = 0; j < 4; ++j) v[j] = v[j] * rs * wr[64 * j];
    }
#pragma unroll
    for (int j = 0; j < 4; ++j) { o8[64 * j] = (u32x2){pk2(v[j][0], v[j][1]), pk2(v[j][2], v[j][3])}; if (sh) ((f32x4*)sh)[lane + 64 * j] = v[j]; }
}
template <int MODE> __device__ __forceinline__ void p0_tr_item(const float* W, int N, bf16_t* WT, float* scr, int kb, int nb, int lane) {
    const int k0 = 64 * kb, n0 = 32 * nb;
    const int l8 = lane & 7, r8 = lane >> 3;
    const int nn = n0 + 4 * l8;
    int srcc = nn;
    if (MODE == 1) srcc = nn < C_GATE_REF ? nn : (nn < NPB ? -1 : nn - (NPB - C_GATE_REF));
    f32x4 v[8];
#pragma unroll
    for (int i = 0; i < 8; ++i) { const int kk = 8 * i + r8; v[i] = srcc >= 0 ? *(const f32x4*)(W + (size_t)(k0 + kk) * N + srcc) : (f32x4){0.f, 0.f, 0.f, 0.f}; }
#pragma unroll
    for (int i = 0; i < 8; ++i) { const int kk = 8 * i + r8; float* d = scr + kk * 33 + 4 * l8; d[0] = v[i][0]; d[1] = v[i][1]; d[2] = v[i][2]; d[3] = v[i][3]; }
    asm volatile("s_waitcnt lgkmcnt(0)" ::: "memory");
    const int c = lane & 7;
#pragma unroll
    for (int j = 0; j < 4; ++j) { const int n = (lane >> 3) + 8 * j; const float* s = scr + (8 * c) * 33 + n;
        u32x4 o; o.x = pk2(s[0 * 33], s[1 * 33]); o.y = pk2(s[2 * 33], s[3 * 33]); o.z = pk2(s[4 * 33], s[5 * 33]); o.w = pk2(s[6 * 33], s[7 * 33]);
        *(u32x4*)(WT + (size_t)(n0 + n) * D + k0 + 8 * c) = o; }
    asm volatile("s_waitcnt lgkmcnt(0)" ::: "memory");
}
__device__ __forceinline__ void h_rows_pair(const Params& p, int r, int r1, bool has1, int lane, const f32x4 (&wv)[4]) {
    const f32x4* x0 = (const f32x4*)(p.in[0] + (size_t)r * D) + lane; const f32x4* x1 = (const f32x4*)(p.in[0] + (size_t)(has1 ? r1 : r) * D) + lane;
    f32x4 a[4], b[4]; float s0 = 0.f, s1 = 0.f;
#pragma unroll
    for (int j = 0; j < 4; ++j) { a[j] = x0[64 * j]; b[j] = x1[64 * j]; }
#pragma unroll
    for (int j = 0; j < 4; ++j) { s0 += a[j][0] * a[j][0] + a[j][1] * a[j][1] + a[j][2] * a[j][2] + a[j][3] * a[j][3]; s1 += b[j][0] * b[j][0] + b[j][1] * b[j][1] + b[j][2] * b[j][2] + b[j][3] * b[j][3]; }
    const float q0 = __builtin_amdgcn_rsqf(wave_sum(s0) * (1.f / D) + 1e-6f), q1 = __builtin_amdgcn_rsqf(wave_sum(s1) * (1.f / D) + 1e-6f);
    u32x2* o0 = (u32x2*)((bf16_t*)(p.ws + WS_H) + (size_t)r * D) + lane; u32x2* o1 = (u32x2*)((bf16_t*)(p.ws + WS_H) + (size_t)r1 * D) + lane;
#pragma unroll
    for (int j = 0; j < 4; ++j) { a[j] = a[j] * q0 * wv[j]; o0[64 * j] = (u32x2){pk2(a[j][0], a[j][1]), pk2(a[j][2], a[j][3])}; }
    if ((r & (SEQ - 1)) == SEQ - 1) { f32x4* sh = (f32x4*)(p.out + O_SHIFT_P + (size_t)(r / SEQ) * D) + lane;
#pragma unroll
        for (int j = 0; j < 4; ++j) sh[64 * j] = a[j]; }
    if (has1) {
#pragma unroll
        for (int j = 0; j < 4; ++j) { b[j] = b[j] * q1 * wv[j]; o1[64 * j] = (u32x2){pk2(b[j][0], b[j][1]), pk2(b[j][2], b[j][3])}; }
        if ((r1 & (SEQ - 1)) == SEQ - 1) { f32x4* sh = (f32x4*)(p.out + O_SHIFT_P + (size_t)(r1 / SEQ) * D) + lane;
#pragma unroll
            for (int j = 0; j < 4; ++j) sh[64 * j] = b[j]; }
    }
}
__device__ __forceinline__ void h_rows_segs(const Params& p, int s_lo, int s_hi, int wi, int nw, int lane) {
    const f32x4* lw = (const f32x4*)p.in[7] + lane;
    f32x4 wv[4];
#pragma unroll
    for (int j = 0; j < 4; ++j) wv[j] = lw[64 * j];
    const int n = (s_hi - s_lo) * NBATCH * SEGTOK;
#pragma unroll 1
    for (int x = wi; x < n; x += 2 * nw) {
        const int x1 = x + nw; const bool has1 = x1 < n;
        const int sg = s_lo + x / (NBATCH * SEGTOK), rem = x % (NBATCH * SEGTOK), r = (rem / SEGTOK) * SEQ + sg * SEGTOK + (rem % SEGTOK);
        const int xx = has1 ? x1 : x; const int sg1 = s_lo + xx / (NBATCH * SEGTOK), rem1 = xx % (NBATCH * SEGTOK), r1 = (rem1 / SEGTOK) * SEQ + sg1 * SEGTOK + (rem1 % SEGTOK);
        h_rows_pair(p, r, r1, has1, lane, wv);
    }
}
__device__ __forceinline__ void phase0(const Params& p, unsigned char* smem) {
    const int tid0 = otid(), wave = tid0 >> 6, lane = tid0 & 63;
    const int gw = obid() * 8 + wave, NGW = gridDim.x * 8;
    float* scr = (float*)smem + wave * (64 * 33);
    constexpr int I_IN = 16 * (NP / 32), I_SQ = 16 * 32;
    for (int it = gw; it < I_IN + 3 * I_SQ; it += NGW) {
        int r = it;
        if (r < I_IN) { p0_tr_item<1>(p.in[8], 10384, (bf16_t*)(p.ws + WS_WT_IN), scr, r / (NP / 32), r % (NP / 32), lane); continue; } r -= I_IN;
        if (r < I_SQ) { p0_tr_item<0>(p.in[13], D, (bf16_t*)(p.ws + WS_WT_A), scr, r / 32, r % 32, lane); continue; } r -= I_SQ;
        if (r < I_SQ) { p0_tr_item<0>(p.in[24], D, (bf16_t*)(p.ws + WS_WT_B), scr, r / 32, r % 32, lane); continue; } r -= I_SQ;
        p0_tr_item<0>(p.in[25], D, (bf16_t*)(p.ws + WS_WT_O), scr, r / 32, r % 32, lane);
    }
    h_rows_segs(p, 0, 2, gw, NGW, lane);
    for (int r = XROWS + gw; r < HROWS; r += NGW) p0_row(p, r, lane);
    {
        float* pk = (float*)(p.ws + WS_PK);
        const int gt = obid() * 512 + tid0, NT = gridDim.x * 512;
        for (int i = gt; i < PK_END; i += NT) {
            const float* src; int o;
            if (i < PK_ALOG) { src = p.in[9]; o = i - PK_CONVW; } else if (i < PK_DTB) { src = p.in[10]; o = i - PK_ALOG; } else if (i < PK_NORMW) { src = p.in[11]; o = i - PK_DTB; }
            else if (i < PK_MU) { src = p.in[12]; o = i - PK_NORMW; } else if (i < PK_W0) { src = p.in[14]; o = i - PK_MU; } else if (i < PK_W2) { src = p.in[15]; o = i - PK_W0; }
            else if (i < PK_A0) { src = p.in[16]; o = i - PK_W2; } else if (i < PK_A2) { src = p.in[17]; o = i - PK_A0; } else if (i < PK_KK) { src = p.in[18]; o = i - PK_A2; }
            else if (i < PK_KA) { src = p.in[19]; o = i - PK_KK; } else if (i < PK_RK) { src = p.in[20]; o = i - PK_KA; } else if (i < PK_GNW) { src = p.in[21]; o = i - PK_RK; }
            else if (i < PK_GNB) { src = p.in[22]; o = i - PK_GNW; } else if (i < PK_LNF) { src = p.in[23]; o = i - PK_GNB; } else { src = p.in[26]; o = i - PK_LNF; }
            pk[i] = src[o];
        }
        bf16_t* w2t = (bf16_t*)(p.ws + WS_W2T); bf16_t* a2t = (bf16_t*)(p.ws + WS_A2T);
        for (int i = gt; i < 65536; i += NT) { const int l = i & 63, c = (i >> 6) & 63, hb = i >> 12;
            w2t[i] = (bf16_t)f2bf(p.in[16][(size_t)l * D + hb * 64 + c]); a2t[i] = (bf16_t)f2bf(p.in[18][(size_t)l * D + hb * 64 + c]); }
    }
}

__device__ __forceinline__ void gdn_item(const Params& p, unsigned char* smem, const float* s_in, float* s_out, const float* halo_in, float* halo_out,
                                         int h, int sl, int rowA, int nA, int rowB, int nB) {
    const int tid = otid(), w = tid >> 6, lane = tid & 63, vl = lane >> 4, kg = lane & 15;
    float* qk_s = (float*)smem; float* v_s = qk_s + 16384; float* o_s = v_s + 2048; float* gb_s = o_s + 2048; float* sst = gb_s + 128;
    const bf16_t* P = (const bf16_t*)(p.ws + WS_P);
    float* ORAW = (float*)(p.ws + WS_ORAW);
    float s[8];
    if (s_in) {
        { const int k = tid >> 2, q4 = tid & 3; const f32x4* src = (const f32x4*)(s_in + (size_t)k * 128 + sl * 32 + q4 * 8); const f32x4 a = src[0], b = src[1];
          float* d = sst + k * 33 + q4 * 8; d[0] = a[0]; d[1] = a[1]; d[2] = a[2]; d[3] = a[3]; d[4] = b[0]; d[5] = b[1]; d[6] = b[2]; d[7] = b[3]; }
        __syncthreads();
#pragma unroll
        for (int j = 0; j < 8; ++j) s[j] = sst[(kg * 8 + j) * 33 + 4 * w + vl];
        __syncthreads();
    } else {
#pragma unroll
        for (int j = 0; j < 8; ++j) s[j] = 0.f;
    }
    int pcol = -1;
    if (tid < 128) pcol = h * 128 + tid; else if (tid < 256) pcol = 1024 + h * 128 + (tid - 128); else if (tid < 288) pcol = 2048 + h * 128 + sl * 32 + (tid - 256);
    float cw0 = 0.f, cw1 = 0.f, cw2 = 0.f, cw3 = 0.f, x1 = 0.f, x2 = 0.f, x3 = 0.f;
    const float* pk = (const float*)(p.ws + WS_PK);
    if (pcol >= 0) { const float* cw = pk + PK_CONVW; cw0 = cw[pcol]; cw1 = cw[3072 + pcol]; cw2 = cw[6144 + pcol]; cw3 = cw[9216 + pcol];
        if (halo_in) { x3 = halo_in[pcol]; x2 = halo_in[3072 + pcol]; x1 = halo_in[6144 + pcol]; } }
    const float nalog = -expf(pk[PK_ALOG + h]), dtb = pk[PK_DTB + h];
#pragma unroll 1
    for (int run = 0; run < 2; ++run) {
        const int rrow = run ? rowB : rowA, rn = run ? nB : nA; const bool wout = run != 0;
#pragma unroll 1
        for (int c0 = 0; c0 < rn; c0 += 64) {
            const int nt = (rn - c0) < 64 ? (rn - c0) : 64; const int row = rrow + c0;
            if (pcol >= 0) {
                const bf16_t* src = P + (size_t)row * NPB + pcol;
                float* dst = tid < 256 ? (qk_s + tid) : (v_s + (tid - 256)); const int dstride = tid < 256 ? 256 : 32;
#pragma unroll 8
                for (int i = 0; i < nt; ++i) { const float x0 = bf2f(src[(size_t)i * NPB]); const float y = cw0 * x3 + cw1 * x2 + cw2 * x1 + cw3 * x0; x3 = x2; x2 = x1; x1 = x0; dst[i * dstride] = silu_(y); }
            } else if (tid < 352) {
                const int i = tid - 288;
                if (i < nt) { const float pa = bf2f(P[(size_t)(row + i) * NPB + C_A + h]), pb = bf2f(P[(size_t)(row + i) * NPB + C_B + h]);
                    gb_s[2 * i] = expf(nalog * softplus_(pa + dtb)); gb_s[2 * i + 1] = sigm(pb); }
            }
            __syncthreads();
#pragma unroll 1
            for (int ii = 0; ii < 8; ++ii) { const int i = w * 8 + ii;
                if (i < nt) {
#pragma unroll
                    for (int which = 0; which < 2; ++which) { float* rp = qk_s + i * 256 + which * 128; const float a = rp[lane], b = rp[lane + 64];
                        const float sc = __builtin_amdgcn_rsqf(wave_sum(a * a + b * b) + 1e-6f) * (which == 0 ? 0.08838834764831845f : 1.f); rp[lane] = a * sc; rp[lane + 64] = b * sc; } } }
            __syncthreads();
#pragma unroll 1
            for (int i = 0; i < nt; ++i) {
                const f32x4 q0 = *(const f32x4*)(qk_s + i * 256 + kg * 8), q1 = *(const f32x4*)(qk_s + i * 256 + kg * 8 + 4);
                const f32x4 k0 = *(const f32x4*)(qk_s + i * 256 + 128 + kg * 8), k1 = *(const f32x4*)(qk_s + i * 256 + 128 + kg * 8 + 4);
                const float vv = v_s[i * 32 + 4 * w + vl], a = gb_s[2 * i], be = gb_s[2 * i + 1];
                float part = k0[0] * s[0] + k0[1] * s[1] + k0[2] * s[2] + k0[3] * s[3] + k1[0] * s[4] + k1[1] * s[5] + k1[2] * s[6] + k1[3] * s[7];
                const float kS = rowsum16(part);
                const float c = be * (vv - a * kS);
                s[0] = a * s[0] + k0[0] * c; s[1] = a * s[1] + k0[1] * c; s[2] = a * s[2] + k0[2] * c; s[3] = a * s[3] + k0[3] * c;
                s[4] = a * s[4] + k1[0] * c; s[5] = a * s[5] + k1[1] * c; s[6] = a * s[6] + k1[2] * c; s[7] = a * s[7] + k1[3] * c;
                float op = q0[0] * s[0] + q0[1] * s[1] + q0[2] * s[2] + q0[3] * s[3] + q1[0] * s[4] + q1[1] * s[5] + q1[2] * s[6] + q1[3] * s[7];
                const float o = rowsum16(op);
                if (kg == 0) o_s[i * 32 + 4 * w + vl] = o;
            }
            __syncthreads();
            if (wout) { const int i = tid >> 3, c4 = (tid & 7) * 4; if (i < nt) *(f32x4*)(ORAW + (size_t)(row + i) * D + h * 128 + sl * 32 + c4) = *(const f32x4*)(o_s + i * 32 + c4); }
        }
    }
    if (pcol >= 0 && (sl == 0 || tid >= 256)) { halo_out[pcol] = x3; halo_out[3072 + pcol] = x2; halo_out[6144 + pcol] = x1; }
#pragma unroll
    for (int j = 0; j < 8; ++j) sst[(kg * 8 + j) * 33 + 4 * w + vl] = s[j];
    __syncthreads();
    { const int k = tid >> 2, q4 = tid & 3; const float* d = sst + k * 33 + q4 * 8; f32x4* dst = (f32x4*)(s_out + (size_t)k * 128 + sl * 32 + q4 * 8);
      dst[0] = (f32x4){d[0], d[1], d[2], d[3]}; dst[1] = (f32x4){d[4], d[5], d[6], d[7]}; }
    __syncthreads();
}

constexpr int RW_W2 = 20544, RW_A2 = 24640;
__device__ __forceinline__ void rwkv_load_lora(const Params& p, unsigned char* smem, int hb) {
    float* w2_s = (float*)smem + RW_W2; float* a2_s = (float*)smem + RW_A2; const float* pk = (const float*)(p.ws + WS_PK);
    for (int i = otid(); i < 4096; i += 512) { const int l = i >> 6, c = i & 63; w2_s[i] = pk[PK_W2 + l * D + hb * 64 + c]; a2_s[i] = pk[PK_A2 + l * D + hb * 64 + c]; }
    __syncthreads();
}
__device__ __forceinline__ void rwkv_item(const Params& p, unsigned char* smem, const float* s_in, float* s_out, const bf16_t* prev_row, const float* halo_in, float* halo_out,
                                          int hb, int half, int rowA, int nA, int rowB, int nB) {
    const int tid = otid(), w = tid >> 6, lane = tid & 63, row = tid >> 4, kq = tid & 15;
    float* f = (float*)smem;
    float* r_s = f; float* kb_s = f + 2048; float* v_s = f + 4096; float* wd_s = f + 6144; float* ad_s = f + 8192; float* dec_s = f + 10240; float* a_s = f + 12288;
    float* kk_s = f + 14336; float* km_s = f + 16384; float* zb_s = f + 18432; float* y_s = f + 19456; float* bonus_s = f + 20480;
    const float* w2_s = f + RW_W2; const float* a2_s = f + RW_A2;
    const bf16_t* P = (const bf16_t*)(p.ws + WS_P);
    float* YRAW = (float*)(p.ws + WS_YRAW); bf16_t* C0 = (bf16_t*)(p.ws + WS_C0); bf16_t* C1 = (bf16_t*)(p.ws + WS_C1);
    float s[4];
    if (s_in) { const f32x4 t = *(const f32x4*)(s_in + (size_t)(half * 32 + row) * 64 + kq * 4); s[0] = t[0]; s[1] = t[1]; s[2] = t[2]; s[3] = t[3]; }
    else { s[0] = s[1] = s[2] = s[3] = 0.f; }
    int col = -1; float* dst = nullptr; int dstride = 64; bool is_wd = false, owner = false;
    if (tid < 64) { col = hb * 64 + tid; dst = r_s + tid; owner = half == 0; }
    else if (tid < 128) { col = 1024 + hb * 64 + (tid - 64); dst = kb_s + (tid - 64); owner = half == 0; }
    else if (tid < 192) { col = 2048 + hb * 64 + (tid - 128); dst = v_s + (tid - 128); owner = half == 0; }
    else if (tid < 256) { col = 3072 + (tid - 192); dst = wd_s + (tid - 192); is_wd = true; owner = (half == 0 && hb == 0); }
    else if (tid < 320) { col = 3136 + (tid - 256); dst = ad_s + (tid - 256); owner = (half == 0 && hb == 0); }
    else if (tid < 352) { col = 3200 + hb * 64 + half * 32 + (tid - 320); dst = zb_s + (tid - 320); dstride = 32; owner = true; }
    float mu = 0.f, prev = 0.f;
    const float* pk = (const float*)(p.ws + WS_PK);
    if (col >= 0) { mu = pk[PK_MU + col]; prev = prev_row ? bf2f(prev_row[C_RW + col]) : (halo_in ? halo_in[col] : 0.f); }
    const int cc = tid & 63, ig = tid >> 6;
    const int hc = hb * 64 + cc;
    const float w0c = pk[PK_W0 + hc], a0c = pk[PK_A0 + hc], kkc = pk[PK_KK + hc], kac = pk[PK_KA + hc];
    const float rkl = pk[PK_RK + hb * 64 + lane];
#pragma unroll 1
    for (int run = 0; run < 2; ++run) {
        const int rrow = run ? rowB : rowA, rn = run ? nB : nA; const bool wout = run != 0;
#pragma unroll 1
        for (int c0 = 0; c0 < rn; c0 += 32) {
            const int nt = (rn - c0) < 32 ? (rn - c0) : 32; const int row0 = rrow + c0;
            if (col >= 0) {
                const bf16_t* src = P + (size_t)row0 * NPB + C_RW + col;
#pragma unroll 8
                for (int i = 0; i < nt; ++i) { const float cur = bf2f(src[(size_t)i * NPB]); float m = cur + mu * (prev - cur); prev = cur; if (is_wd) m = tanh_(m); dst[i * dstride] = m; }
            }
            __syncthreads();
            {
                float aw[4] = {0.f, 0.f, 0.f, 0.f}, aa[4] = {0.f, 0.f, 0.f, 0.f};
#pragma unroll 4
                for (int l = 0; l < 64; ++l) { const float w2v = w2_s[l * 64 + cc], a2v = a2_s[l * 64 + cc];
#pragma unroll
                    for (int ii = 0; ii < 4; ++ii) { aw[ii] += wd_s[(ig * 4 + ii) * 64 + l] * w2v; aa[ii] += ad_s[(ig * 4 + ii) * 64 + l] * a2v; } }
#pragma unroll
                for (int ii = 0; ii < 4; ++ii) { const int i = ig * 4 + ii;
                    if (i < nt) { const float wraw = w0c + aw[ii]; const float wlog = -0.6065306597126334f * sigm(wraw); const float a = sigm(a0c + aa[ii]);
                        const float kbv = kb_s[i * 64 + cc];
                        dec_s[i * 64 + cc] = expf(wlog); a_s[i * 64 + cc] = a; kk_s[i * 64 + cc] = kbv * kkc; km_s[i * 64 + cc] = kbv * (1.f + (a - 1.f) * kac); } }
            }
            __syncthreads();
#pragma unroll 1
            for (int ii = 0; ii < 4; ++ii) { const int i = w * 4 + ii;
                if (i < nt) { const float kkr = kk_s[i * 64 + lane]; const float kk = kkr * __builtin_amdgcn_rsqf(wave_sum(kkr * kkr) + 1e-6f); kk_s[i * 64 + lane] = kk;
                    const float a = a_s[i * 64 + lane]; a_s[i * 64 + lane] = kk * a;
                    const float rk = wave_sum(r_s[i * 64 + lane] * km_s[i * 64 + lane] * rkl); if (lane == 0) bonus_s[i] = rk; } }
            __syncthreads();
#pragma unroll 1
            for (int i = 0; i < nt; ++i) {
                const f32x4 kk4 = *(const f32x4*)(kk_s + i * 64 + kq * 4), de4 = *(const f32x4*)(dec_s + i * 64 + kq * 4), ka4 = *(const f32x4*)(a_s + i * 64 + kq * 4),
                            km4 = *(const f32x4*)(km_s + i * 64 + kq * 4), r4 = *(const f32x4*)(r_s + i * 64 + kq * 4);
                const float vv = v_s[i * 64 + half * 32 + row];
                const float sa = rowsum16(s[0] * kk4[0] + s[1] * kk4[1] + s[2] * kk4[2] + s[3] * kk4[3]);
#pragma unroll
                for (int j = 0; j < 4; ++j) s[j] = s[j] * de4[j] + (vv * km4[j] - sa * ka4[j]);
                const float y = rowsum16(s[0] * r4[0] + s[1] * r4[1] + s[2] * r4[2] + s[3] * r4[3]);
                if (kq == 0) y_s[i * 32 + row] = y;
            }
            __syncthreads();
            if (wout) { const int i = tid >> 4;
                if (i < nt) {
#pragma unroll
                    for (int q = 0; q < 2; ++q) { const int rr = (tid & 15) * 2 + q, v = half * 32 + rr, colo = hb * 64 + v;
                        const float sz = silu_(zb_s[i * 32 + rr]);
                        const size_t o = (size_t)(row0 + i) * D + colo;
                        YRAW[o] = y_s[i * 32 + rr]; C1[o] = (bf16_t)f2bf(pk[PK_GNW + colo] * sz); C0[o] = (bf16_t)f2bf((pk[PK_GNB + colo] + bonus_s[i] * v_s[i * 64 + v]) * sz); } } }
            __syncthreads();
        }
    }
    *(f32x4*)(s_out + (size_t)(half * 32 + row) * 64 + kq * 4) = (f32x4){s[0], s[1], s[2], s[3]};
    if (col >= 0 && owner && halo_out) halo_out[col] = prev;
}


__device__ __forceinline__ bf16x8 ldfrag(const bf16_t* base, int stride, int r0, int k0, int lane) {
    return *(const bf16x8*)(base + (r0 + (lane & 15)) * stride + k0 + 8 * (lane >> 4));
}
#define MFMA16(a, b, c) __builtin_amdgcn_mfma_f32_16x16x32_bf16((a), (b), (c), 0, 0, 0)
typedef short s16x4 __attribute__((ext_vector_type(4)));
__device__ __forceinline__ bf16x8 ldfrag_tr(const bf16_t* X, int stride, int c0, int k0, int lane) {
    const int l15 = lane & 15;
    const bf16_t* a = X + (k0 + 8 * (lane >> 4) + (l15 >> 2)) * stride + c0 + 4 * (l15 & 3);
    const s16x4 lo = __builtin_amdgcn_ds_read_tr16_b64_v4i16((LAS s16x4*)a), hi = __builtin_amdgcn_ds_read_tr16_b64_v4i16((LAS s16x4*)(a + 4 * stride));
    return __builtin_shufflevector(lo, hi, 0, 1, 2, 3, 4, 5, 6, 7);
}
__device__ __forceinline__ void inv_block(const float* L, float* Tm, float* XS, int tid) {
    const int w = tid >> 6, lane = tid & 63;
    typedef float f32x2v __attribute__((ext_vector_type(2)));
    if (w < 4 && lane < 16) {
        const float* Lb = L + (16 * w) * 64 + 16 * w; float* Tb = Tm + (16 * w) * 64 + 16 * w;
        float tr[16];
#pragma unroll
        for (int i = 0; i < 16; ++i) tr[i] = 0.f;
#pragma unroll
        for (int i = 0; i < 16; ++i) { float a = (lane == i) ? 1.f : 0.f;
#pragma unroll
            for (int j0 = 0; j0 < i; j0 += 4) { const f32x4 l4 = *(const f32x4*)(Lb + i * 64 + j0);
                a -= l4[0] * tr[j0] + l4[1] * tr[j0 + 1] + l4[2] * tr[j0 + 2] + l4[3] * tr[j0 + 3]; }
            tr[i] = a; Tb[i * 64 + lane] = a; }
    }
    for (int e = tid; e < 1536; e += 512) { const int k = e >> 8, r = (e >> 4) & 15, c = e & 15;
        const int rb = k < 3 ? 0 : (k < 5 ? 1 : 2), cb = k < 3 ? k + 1 : (k < 5 ? k - 1 : 3);
        Tm[(16 * rb + r) * 64 + 16 * cb + c] = 0.f; }
    __syncthreads();
    {
        const int B = tid >> 8, i = (tid >> 4) & 15, c = tid & 15, o = 32 * B;
        float x = 0.f;
#pragma unroll
        for (int j0 = 0; j0 < 16; j0 += 4) { const f32x4 l4 = *(const f32x4*)(L + (o + 16 + i) * 64 + o + j0);
            x += l4[0] * Tm[(o + j0) * 64 + o + c] + l4[1] * Tm[(o + j0 + 1) * 64 + o + c] + l4[2] * Tm[(o + j0 + 2) * 64 + o + c] + l4[3] * Tm[(o + j0 + 3) * 64 + o + c]; }
        XS[tid] = x;
        __syncthreads();
        float t = 0.f;
#pragma unroll
        for (int j0 = 0; j0 < 16; j0 += 4) { const f32x4 t4 = *(const f32x4*)(Tm + (o + 16 + i) * 64 + o + 16 + j0);
            t += t4[0] * XS[(B << 8) + j0 * 16 + c] + t4[1] * XS[(B << 8) + (j0 + 1) * 16 + c] + t4[2] * XS[(B << 8) + (j0 + 2) * 16 + c] + t4[3] * XS[(B << 8) + (j0 + 3) * 16 + c]; }
        Tm[(o + 16 + i) * 64 + o + c] = -t;
    }
    __syncthreads();
    {
        const int i = tid >> 4, c2 = (tid & 15) * 2;
        float x0 = 0.f, x1 = 0.f;
#pragma unroll
        for (int j0 = 0; j0 < 32; j0 += 4) { const f32x4 l4 = *(const f32x4*)(L + (32 + i) * 64 + j0);
#pragma unroll
            for (int e = 0; e < 4; ++e) { const f32x2v tv = *(const f32x2v*)(Tm + (j0 + e) * 64 + c2); x0 += l4[e] * tv[0]; x1 += l4[e] * tv[1]; } }
        *(f32x2v*)(XS + i * 32 + c2) = (f32x2v){x0, x1};
        __syncthreads();
        float t0 = 0.f, t1 = 0.f;
#pragma unroll
        for (int j0 = 0; j0 < 32; j0 += 4) { const f32x4 t4 = *(const f32x4*)(Tm + (32 + i) * 64 + 32 + j0);
#pragma unroll
            for (int e = 0; e < 4; ++e) { const f32x2v xv = *(const f32x2v*)(XS + (j0 + e) * 32 + c2); t0 += t4[e] * xv[0]; t1 += t4[e] * xv[1]; } }
        *(f32x2v*)(Tm + (32 + i) * 64 + c2) = (f32x2v){-t0, -t1};
    }
    __syncthreads();
}
constexpr int PL_QS = 0, PL_R1 = 17408, PL_KT = 35840, PL_KTT = 54272, PL_VT = 72704, PL_R3 = 91136, PL_QKM = 109568, PL_TP = 118784, PL_TPP = 128000, PL_SM = 137216, PL_TM = 139264, PL_XS = 155648;
constexpr int QSTR = 136, TSTR = 72;

__device__ __forceinline__ void gdn_prep_item(const Params& p, unsigned char* smem, int h, int row_start, int npad, const bf16_t* hbase,
                                              bf16_t* halo_out, float* conv_out, unsigned char* rec) {
    const int tid = otid(), w = tid >> 6, lane = tid & 63, q4 = lane >> 4, l15 = lane & 15;
    bf16_t* qs = (bf16_t*)(smem + PL_QS); bf16_t* ks = (bf16_t*)(smem + PL_R1); bf16_t* WT = ks; bf16_t* kts = (bf16_t*)(smem + PL_KT);
    bf16_t* vs = (bf16_t*)(smem + PL_VT);         float* Lm = (float*)(smem + PL_R3); bf16_t* UT = (bf16_t*)(smem + PL_R3); bf16_t* QKm = (bf16_t*)(smem + PL_QKM);
    bf16_t* Tp = (bf16_t*)(smem + PL_TP); bf16_t* Tpp = (bf16_t*)(smem + PL_TPP);
    float* sm = (float*)(smem + PL_SM);
    float* gcs = sm; float* bes = sm + 64; float* ssq = sm + 128; float* ssk = sm + 192; float* egs = sm + 256; float* egl_s = sm + 320; float* beg = sm + 384;
    const bf16_t* P = (const bf16_t*)(p.ws + WS_P);
    const float* pk = (const float*)(p.ws + WS_PK);
    if (w == 7) {
        const int i = lane;
        float g = 0.f, be = 0.f;
        if (i >= npad) { const size_t r = (size_t)(row_start + i - npad) * NPB; const float pa = bf2f(P[r + C_A + h]), pb = bf2f(P[r + C_B + h]);
            g = -expf(pk[PK_ALOG + h]) * softplus_(pa + pk[PK_DTB + h]); be = sigm(pb); }
        float x = g;
#pragma unroll
        for (int o = 1; o < 64; o <<= 1) { const float y = __shfl_up(x, o); if (lane >= o) x += y; }
        const float gl = __shfl(x, 63);
        gcs[lane] = x; bes[lane] = be; egs[lane] = __expf(x); egl_s[lane] = __expf(gl - x); beg[lane] = be * __expf(x);
        if (lane == 0) *(float*)(rec + GP_EGL) = __expf(gl);
    }
    __syncthreads();
    if (npad == 0 && tid >= 384) {
#pragma unroll 1
        for (int k = 0; k < 4; ++k) {
            const int slot = (tid - 384) + 128 * k, t = slot >> 3, g = slot & 7;
            const bf16_t* zp = P + (size_t)(row_start + t) * NPB + C_Z + h * 128 + 16 * g;
            const u32x4 z0 = *(const u32x4*)zp, z1 = *(const u32x4*)(zp + 8);
            float za[8], zb[8]; unpack8(z0, za); unpack8(z1, zb);
            const float* nwp = pk + PK_NORMW + 16 * g;
            float ga[8], gb2[8];
#pragma unroll
            for (int e = 0; e < 8; ++e) { ga[e] = nwp[e] * silu_(za[e]); gb2[e] = nwp[8 + e] * silu_(zb[e]); }
            bf16_t* gp = (bf16_t*)(rec + GP_G) + t * 128 + 16 * g;
            *(u32x4*)gp = pack8(ga); *(u32x4*)(gp + 8) = pack8(gb2);
        }
    }
    if (tid < 384) {
        const int sec = tid >> 7, ts = (tid >> 4) & 7, t0 = 8 * ts, d0 = l15 * 8;
        const int pcol = sec * 1024 + h * 128 + d0;
        float cw[4][8];
#pragma unroll
        for (int j = 0; j < 4; ++j) { const f32x4 a = *(const f32x4*)(pk + PK_CONVW + j * 3072 + pcol), b = *(const f32x4*)(pk + PK_CONVW + j * 3072 + pcol + 4);
            cw[j][0] = a[0]; cw[j][1] = a[1]; cw[j][2] = a[2]; cw[j][3] = a[3]; cw[j][4] = b[0]; cw[j][5] = b[1]; cw[j][6] = b[2]; cw[j][7] = b[3]; }
        u32x4 rw[11]; float fv[11];
#pragma unroll
        for (int k = 0; k < 11; ++k) {
            const int ii = t0 - 3 + k;
            const bf16_t* ptr = P + pcol; float f = 0.f;
            if (ii >= npad) { ptr = P + (size_t)(row_start + ii - npad) * NPB + pcol; f = 1.f; }
            else if (ii < 0 && npad == 0 && hbase) { ptr = hbase + (size_t)(ii + 3) * NPB + pcol; f = 1.f; }
            rw[k] = *(const u32x4*)ptr; fv[k] = f;
        }
        if (halo_out && ts == 7) {
#pragma unroll
            for (int dd = 0; dd < 3; ++dd) { *(u32x4*)(halo_out + (size_t)dd * NPB + pcol) = rw[8 + dd];
                if (conv_out) { float x[8]; unpack8(rw[8 + dd], x); *(f32x4*)(conv_out + dd * 3072 + pcol) = (f32x4){x[0], x[1], x[2], x[3]}; *(f32x4*)(conv_out + dd * 3072 + pcol + 4) = (f32x4){x[4], x[5], x[6], x[7]}; } }
        }
        float y[8][8];
#pragma unroll
        for (int t = 0; t < 8; ++t)
#pragma unroll
            for (int e = 0; e < 8; ++e) y[t][e] = 0.f;
#pragma unroll
        for (int k = 0; k < 11; ++k) { float x[8]; unpack8(rw[k], x);
#pragma unroll
            for (int e = 0; e < 8; ++e) x[e] *= fv[k];
#pragma unroll
            for (int dlt = 0; dlt < 4; ++dlt) { const int t = k - dlt;
                if (t >= 0 && t < 8) {
#pragma unroll
                    for (int e = 0; e < 8; ++e) y[t][e] += cw[dlt][e] * x[e]; } }
        }
        const float qsc = sec == 0 ? 0.08838834764831845f : 1.f;
#pragma unroll
        for (int t = 0; t < 8; ++t) {
            const bool tokv = (t0 + t) >= npad;
            float ss = 0.f;
#pragma unroll
            for (int e = 0; e < 8; ++e) { y[t][e] = tokv ? silu_(y[t][e]) : 0.f; ss += y[t][e] * y[t][e]; }
            if (sec < 2) { const float sc = __builtin_amdgcn_rsqf(rowsum16(ss) + 1e-6f) * qsc;
#pragma unroll
                for (int e = 0; e < 8; ++e) y[t][e] *= sc; }
        }
        { bf16_t* dst = sec == 0 ? qs : (sec == 1 ? ks : vs);
#pragma unroll
            for (int t = 0; t < 8; ++t) *(u32x4*)(dst + (t0 + t) * QSTR + d0) = pack8(y[t]); }
        if (sec == 1) {
#pragma unroll
            for (int t = 0; t < 8; ++t) { const float eg = egl_s[t0 + t]; float z[8];
#pragma unroll
                for (int e = 0; e < 8; ++e) z[e] = y[t][e] * eg;
                *(u32x4*)(kts + (t0 + t) * QSTR + d0) = pack8(z); } }
    }
    __syncthreads();
    {
        const int which = w >> 2, it = w & 3;
        const bf16_t* Barr = which ? qs : ks;
        bf16x8 bfr[4];
#pragma unroll
        for (int kk = 0; kk < 4; ++kk) bfr[kk] = ldfrag(Barr, QSTR, 16 * it, 32 * kk, lane);
        const int i = 16 * it + l15; const float gi = gcs[i], bi = bes[i];
#pragma unroll
        for (int jt = 0; jt < 4; ++jt) {
            f32x4 acc = {0.f, 0.f, 0.f, 0.f};
#pragma unroll
            for (int kk = 0; kk < 4; ++kk) acc = MFMA16(ldfrag(ks, QSTR, 16 * jt, 32 * kk, lane), bfr[kk], acc);
            const int j0 = 16 * jt + 4 * q4; const f32x4 gj = *(const f32x4*)(gcs + j0);
            f32x4 o;
#pragma unroll
            for (int r = 0; r < 4; ++r) { const int j = j0 + r; const bool keep = which ? (i >= j) : (i > j); o[r] = keep ? acc[r] * __expf(gi - gj[r]) : 0.f; }
            if (which == 0) *(f32x4*)(Lm + i * 64 + j0) = o * bi;
            else *(u32x2*)(QKm + i * TSTR + j0) = (u32x2){pk2(o[0], o[1]), pk2(o[2], o[3])};
        }
    }
    __syncthreads();
    {
        float* Tm = (float*)(smem + PL_TM);
        inv_block(Lm, Tm, (float*)(smem + PL_XS), tid);
        const int i = tid >> 3, j0 = (tid & 7) * 8;
        float a[8], b2[8];
#pragma unroll
        for (int e = 0; e < 8; ++e) { const float tv = Tm[i * 64 + j0 + e]; a[e] = tv * beg[j0 + e]; b2[e] = tv * bes[j0 + e]; }
        *(u32x4*)(Tp + i * TSTR + j0) = (u32x4){pk2(a[0], a[1]), pk2(a[2], a[3]), pk2(a[4], a[5]), pk2(a[6], a[7])};
        *(u32x4*)(Tpp + i * TSTR + j0) = (u32x4){pk2(b2[0], b2[1]), pk2(b2[2], b2[3]), pk2(b2[4], b2[5]), pk2(b2[6], b2[7])};
    }
    __syncthreads();
    {
        const int it = w & 3, half = w >> 2;
        f32x4 aw[4], au[4];
#pragma unroll
        for (int x = 0; x < 4; ++x) { aw[x] = (f32x4){0.f, 0.f, 0.f, 0.f}; au[x] = (f32x4){0.f, 0.f, 0.f, 0.f}; }
#pragma unroll
        for (int kk = 0; kk < 2; ++kk) {
            const bf16x8 a1 = ldfrag(Tp, TSTR, 16 * it, 32 * kk, lane), a2 = ldfrag(Tpp, TSTR, 16 * it, 32 * kk, lane);
#pragma unroll
            for (int x = 0; x < 4; ++x) { const int dt = half * 4 + x;
                aw[x] = MFMA16(a1, ldfrag_tr(ks, QSTR, 16 * dt, 32 * kk, lane), aw[x]);
                au[x] = MFMA16(a2, ldfrag_tr(vs, QSTR, 16 * dt, 32 * kk, lane), au[x]); }
        }
        __syncthreads();
#pragma unroll
        for (int x = 0; x < 4; ++x) { const int d = 16 * (half * 4 + x) + l15, i0 = 16 * it + 4 * q4;
            *(u32x2*)(WT + d * TSTR + i0) = (u32x2){pk2(aw[x][0], aw[x][1]), pk2(aw[x][2], aw[x][3])};
            *(u32x2*)(UT + d * TSTR + i0) = (u32x2){pk2(au[x][0], au[x][1]), pk2(au[x][2], au[x][3])}; }
    }
    __syncthreads();
    {
        bf16_t* gAP = (bf16_t*)(rec + GP_AP); bf16_t* gQH = (bf16_t*)(rec + GP_QH); bf16_t* gKH = (bf16_t*)(rec + GP_KH); bf16_t* gOH = (bf16_t*)(rec + GP_OH);
        {
            const int et = w;
            const bf16x8 a0 = ldfrag(WT, TSTR, 16 * et, 0, lane), a1 = ldfrag(WT, TSTR, 16 * et, 32, lane);
#pragma unroll
            for (int dt = 0; dt < 8; ++dt) { f32x4 acc = {0.f, 0.f, 0.f, 0.f};
                acc = MFMA16(a0, ldfrag_tr(kts, QSTR, 16 * dt, 0, lane), acc); acc = MFMA16(a1, ldfrag_tr(kts, QSTR, 16 * dt, 32, lane), acc);
                *(u32x2*)(gAP + ((size_t)(dt * 4 + (et >> 1)) * 64 + lane) * 8 + (et & 1) * 4) = (u32x2){pk2(-acc[0], -acc[1]), pk2(-acc[2], -acc[3])}; }
#pragma unroll
            for (int tt = 0; tt < 4; ++tt) { f32x4 acc = {0.f, 0.f, 0.f, 0.f};
                acc = MFMA16(a0, ldfrag(QKm, TSTR, 16 * tt, 0, lane), acc); acc = MFMA16(a1, ldfrag(QKm, TSTR, 16 * tt, 32, lane), acc);
                const int t = 16 * tt + l15, e0 = 16 * et + 4 * q4; const float eg = egs[t];
                const u32x2 qq = *(const u32x2*)(qs + t * QSTR + e0);
                const float o0 = __uint_as_float(qq.x << 16) * eg - acc[0], o1 = __uint_as_float(qq.x & 0xffff0000u) * eg - acc[1],
                            o2 = __uint_as_float(qq.y << 16) * eg - acc[2], o3 = __uint_as_float(qq.y & 0xffff0000u) * eg - acc[3];
                *(u32x2*)(gQH + ((size_t)(tt * 4 + (et >> 1)) * 64 + lane) * 8 + (et & 1) * 4) = (u32x2){pk2(o0, o1), pk2(o2, o3)}; }
        }
        {
            const int dt = w;
            const bf16x8 a0 = ldfrag_tr(kts, QSTR, 16 * dt, 0, lane), a1 = ldfrag_tr(kts, QSTR, 16 * dt, 32, lane);
#pragma unroll
            for (int vt = 0; vt < 8; ++vt) { f32x4 acc = {0.f, 0.f, 0.f, 0.f};
                acc = MFMA16(a0, ldfrag(UT, TSTR, 16 * vt, 0, lane), acc); acc = MFMA16(a1, ldfrag(UT, TSTR, 16 * vt, 32, lane), acc);
                *(u32x2*)(gKH + ((size_t)(vt * 8 + dt) * 64 + lane) * 4) = (u32x2){pk2(acc[0], acc[1]), pk2(acc[2], acc[3])}; }
            const int tt = w & 3, vh = w >> 2;
            const bf16x8 b0 = ldfrag(QKm, TSTR, 16 * tt, 0, lane), b1 = ldfrag(QKm, TSTR, 16 * tt, 32, lane);
#pragma unroll
            for (int x = 0; x < 4; ++x) { const int vt = vh * 4 + x; f32x4 acc = {0.f, 0.f, 0.f, 0.f};
                acc = MFMA16(b0, ldfrag(UT, TSTR, 16 * vt, 0, lane), acc); acc = MFMA16(b1, ldfrag(UT, TSTR, 16 * vt, 32, lane), acc);
                *(u32x2*)(gOH + ((size_t)(vt * 4 + tt) * 64 + lane) * 4) = (u32x2){pk2(acc[0], acc[1]), pk2(acc[2], acc[3])}; }
        }
    }
    __syncthreads();
}

__device__ __forceinline__ void phase_gprep(const Params& p, int seg, unsigned char* smem) {
    const int blk = obid();
    const int n_items = (CPS + (seg == 0 ? 1 : 0)) * 64;
#pragma unroll 1
    for (int it = blk; it < n_items; it += gridDim.x) {
        const int bh = it & 63, b = bh >> 3, h = bh & 7; int cl = it >> 6; if (seg != 0) cl += 1;
        unsigned char* rec = p.ws + WS_GP + (size_t)(cl * 64 + bh) * GP_STRIDE;
        const bf16_t* Pb = (const bf16_t*)(p.ws + WS_P);
        bf16_t* chalo2 = (bf16_t*)(p.ws + WS_CHALO);
        if (cl == 0) gdn_prep_item(p, smem, h, LEX0, 48, nullptr, nullptr, nullptr, rec);
        else {
            const int row = b * SEGTOK + (cl - 1) * 64;
            const bf16_t* hbase = Pb + (size_t)(row - 3) * NPB;
            if (cl == 1) hbase = (seg == 0) ? Pb + (size_t)(LEX0 + NMETA - 3) * NPB : chalo2 + (size_t)(((seg - 1) & 1) * NBATCH + b) * 3 * NPB;
            bf16_t* ho = (cl == CPS) ? chalo2 + (size_t)((seg & 1) * NBATCH + b) * 3 * NPB : nullptr;
            float* co = (cl == CPS && seg == NSEG - 1) ? p.out + O_CONV_P + (size_t)b * 9216 : nullptr;
            gdn_prep_item(p, smem, h, row, 0, hbase, ho, co, rec);
        }
    }
}

__device__ __forceinline__ void gdn_scan_block(const Params& p, int seg, unsigned char* smem, int bh) {
    const int tid = otid(), w = tid >> 6, lane = tid & 63, q4 = lane >> 4, l15 = lane & 15;
    const int b = bh >> 3, h = bh & 7;
    float* st = p.out + O_GDN_P + (size_t)bh * 16384;
    f32x4 S[8];
    if (seg) {
#pragma unroll
        for (int mt = 0; mt < 8; ++mt)
#pragma unroll
            for (int r = 0; r < 4; ++r) S[mt][r] = st[(size_t)(16 * mt + 4 * q4 + r) * 128 + 16 * w + l15];
    } else {
#pragma unroll
        for (int mt = 0; mt < 8; ++mt) S[mt] = (f32x4){0.f, 0.f, 0.f, 0.f};
    }
    const int c_lo = seg ? 1 : 0;
    float* obuf = (float*)(smem + 98304);
    {
        const u32x4* src = (const u32x4*)(p.ws + WS_GP + (size_t)(c_lo * 64 + bh) * GP_STRIDE); u32x4* dst = (u32x4*)smem;
#pragma unroll
        for (int x = 0; x < 6; ++x) dst[tid + 512 * x] = src[tid + 512 * x];
    }
#pragma unroll 1
    for (int cl = c_lo; cl <= CPS; ++cl) {
        const unsigned char* rec = p.ws + WS_GP + (size_t)(cl * 64 + bh) * GP_STRIDE;
        const int cur = (cl - c_lo) & 1;
        __syncthreads();
        u32x4 nx[6];
        const bool more = cl < CPS;
        if (more) { const u32x4* src = (const u32x4*)(rec + GP_STRIDE * 64);
#pragma unroll
            for (int x = 0; x < 6; ++x) nx[x] = src[tid + 512 * x]; }
        const bf16_t* gKH = (const bf16_t*)(rec + GP_KH); const bf16_t* gOH = (const bf16_t*)(rec + GP_OH);
        u32x2 kh[8], oh[4];
#pragma unroll
        for (int mt = 0; mt < 8; ++mt) kh[mt] = *(const u32x2*)(gKH + ((size_t)(w * 8 + mt) * 64 + lane) * 4);
#pragma unroll
        for (int tt = 0; tt < 4; ++tt) oh[tt] = *(const u32x2*)(gOH + ((size_t)(w * 4 + tt) * 64 + lane) * 4);
        const float egl = *(const float*)(rec + GP_EGL);
        const int et = tid >> 3, eg = tid & 7;
        const bf16_t* gp = (const bf16_t*)(rec + GP_G) + et * 128 + 16 * eg;
        u32x4 z0 = {0u, 0u, 0u, 0u}, z1 = {0u, 0u, 0u, 0u};
        if (cl > 0) { z0 = *(const u32x4*)gp; z1 = *(const u32x4*)(gp + 8); }
        bf16x8 Bf[4];
#pragma unroll
        for (int ks = 0; ks < 4; ++ks) { u32x4 t; t.x = pk2(S[2 * ks][0], S[2 * ks][1]); t.y = pk2(S[2 * ks][2], S[2 * ks][3]); t.z = pk2(S[2 * ks + 1][0], S[2 * ks + 1][1]); t.w = pk2(S[2 * ks + 1][2], S[2 * ks + 1][3]);
            Bf[ks] = __builtin_bit_cast(bf16x8, t); }
        const bf16x8* AP = (const bf16x8*)(smem + cur * 49152); const bf16x8* QH = (const bf16x8*)(smem + cur * 49152 + GP_QH);
        f32x4 o[4], tS[8];
#pragma unroll
        for (int tt = 0; tt < 4; ++tt) { o[tt] = (f32x4){0.f, 0.f, 0.f, 0.f};
#pragma unroll
            for (int ks = 0; ks < 4; ++ks) o[tt] = MFMA16(QH[(tt * 4 + ks) * 64 + lane], Bf[ks], o[tt]); }
#pragma unroll
        for (int mt = 0; mt < 8; ++mt) { tS[mt] = (f32x4){0.f, 0.f, 0.f, 0.f};
#pragma unroll
            for (int ks = 0; ks < 4; ++ks) tS[mt] = MFMA16(AP[(mt * 4 + ks) * 64 + lane], Bf[ks], tS[mt]); }
#pragma unroll
        for (int mt = 0; mt < 8; ++mt) {
            S[mt][0] = egl * S[mt][0] + tS[mt][0] + __uint_as_float(kh[mt].x << 16); S[mt][1] = egl * S[mt][1] + tS[mt][1] + __uint_as_float(kh[mt].x & 0xffff0000u);
            S[mt][2] = egl * S[mt][2] + tS[mt][2] + __uint_as_float(kh[mt].y << 16); S[mt][3] = egl * S[mt][3] + tS[mt][3] + __uint_as_float(kh[mt].y & 0xffff0000u); }
        if (cl > 0) {
#pragma unroll
            for (int tt = 0; tt < 4; ++tt) {
                o[tt][0] += __uint_as_float(oh[tt].x << 16); o[tt][1] += __uint_as_float(oh[tt].x & 0xffff0000u); o[tt][2] += __uint_as_float(oh[tt].y << 16); o[tt][3] += __uint_as_float(oh[tt].y & 0xffff0000u);
#pragma unroll
                for (int r = 0; r < 4; ++r) obuf[(16 * tt + 4 * q4 + r) * 132 + 16 * w + l15] = o[tt][r]; }
        }
        if (more) { u32x4* dst = (u32x4*)(smem + (cur ^ 1) * 49152);
#pragma unroll
            for (int x = 0; x < 6; ++x) dst[tid + 512 * x] = nx[x]; }
        if (cl > 0) {
            __syncthreads();
            f32x4 ov[4]; float ss = 0.f;
#pragma unroll
            for (int j = 0; j < 4; ++j) { ov[j] = *(const f32x4*)(obuf + et * 132 + 16 * eg + 4 * j); ss += ov[j][0] * ov[j][0] + ov[j][1] * ov[j][1] + ov[j][2] * ov[j][2] + ov[j][3] * ov[j][3]; }
            ss += __shfl_xor(ss, 1); ss += __shfl_xor(ss, 2); ss += __shfl_xor(ss, 4);
            const float rs = __builtin_amdgcn_rsqf(ss * (1.f / 128.f) + 1e-6f);
            const unsigned zz[8] = {z0.x, z0.y, z0.z, z0.w, z1.x, z1.y, z1.z, z1.w};
            unsigned ow[8];
#pragma unroll
            for (int j = 0; j < 8; ++j) ow[j] = pk2(ov[j >> 1][(j & 1) * 2] * rs * __uint_as_float(zz[j] << 16), ov[j >> 1][(j & 1) * 2 + 1] * rs * __uint_as_float(zz[j] & 0xffff0000u));
            const size_t grow = (size_t)b * SEQ + seg * SEGTOK + (cl - 1) * 64 + et;
            bf16_t* oa = (bf16_t*)(p.ws + WS_H) + grow * D + h * 128 + 16 * eg;
            *(u32x4*)oa = (u32x4){ow[0], ow[1], ow[2], ow[3]}; *(u32x4*)(oa + 8) = (u32x4){ow[4], ow[5], ow[6], ow[7]};
        }
    }
#pragma unroll
    for (int mt = 0; mt < 8; ++mt)
#pragma unroll
        for (int r = 0; r < 4; ++r) st[(size_t)(16 * mt + 4 * q4 + r) * 128 + 16 * w + l15] = S[mt][r];
    __syncthreads();
}

constexpr int RL_AT = 0, RL_BT = 9216, RL_KT = 18432, RL_ATT = 27648, RL_RT = 36864, RL_BTLT = 46080, RL_KTLT = 55296, RL_VT = 64512, RL_LAK = 73728, RL_MRB = 82944, RL_MRK = 92160,
              RL_LM = 101376, RL_AF = 117760, RL_TM = 134144, RL_XS = 150528;
__device__ __forceinline__ void rwkv_prep_item(const Params& p, unsigned char* smem, int hb, int row_start, int npad, const bf16_t* prev_row,
                                               bf16_t* halo_out, unsigned char* rec) {
    const int tid = otid(), w = tid >> 6, lane = tid & 63, q4 = lane >> 4, l15 = lane & 15;
    bf16_t* At = (bf16_t*)(smem + RL_AT); bf16_t* Tb = At; bf16_t* Bt = (bf16_t*)(smem + RL_BT); bf16_t* WaT = Bt; bf16_t* Kt = (bf16_t*)(smem + RL_KT); bf16_t* XT = Kt;
    bf16_t* At2 = (bf16_t*)(smem + RL_ATT); bf16_t* Rt = (bf16_t*)(smem + RL_RT); bf16_t* Btl = (bf16_t*)(smem + RL_BTLT); bf16_t* Ktl = (bf16_t*)(smem + RL_KTLT);
    bf16_t* Vr = (bf16_t*)(smem + RL_VT);        bf16_t* Lak = (bf16_t*)(smem + RL_LAK); bf16_t* Mrb = (bf16_t*)(smem + RL_MRB); bf16_t* Mrk = (bf16_t*)(smem + RL_MRK);
    float* Lm = (float*)(smem + RL_LM);
    bf16_t* thw = Lak; bf16_t* adb = Mrb; float* lc = Lm; float* af = (float*)(smem + RL_AF);
    const bf16_t* P = (const bf16_t*)(p.ws + WS_P);
    const float* pk = (const float*)(p.ws + WS_PK);
    const int t = tid >> 3, g = tid & 7;
    float rr[8], kb[8], vv[8], zb[8];
    {
        const bool real = t >= npad;
        const bf16_t* curp = P; const bf16_t* prevp = P; float fprev = 0.f;
        if (real) { curp = P + (size_t)(row_start + t - npad) * NPB; if (t > npad) { prevp = curp - NPB; fprev = 1.f; } else if (prev_row) { prevp = prev_row; fprev = 1.f; } }
        const int secbase[6] = {0, 1024, 2048, 3200, 3072, 3136};
        u32x4 rc[6], rp[6];
#pragma unroll
        for (int sidx = 0; sidx < 6; ++sidx) { const int col = secbase[sidx] + (sidx < 4 ? hb * 64 : 0) + g * 8; rc[sidx] = *(const u32x4*)(curp + C_RW + col); rp[sidx] = *(const u32x4*)(prevp + C_RW + col); }
        float m[6][8];
#pragma unroll
        for (int sidx = 0; sidx < 6; ++sidx) {
            const int col = secbase[sidx] + (sidx < 4 ? hb * 64 : 0) + g * 8;
            float cur[8], prv[8];
            unpack8(rc[sidx], cur); unpack8(rp[sidx], prv);
            const f32x4 mu0 = *(const f32x4*)(pk + PK_MU + col), mu1 = *(const f32x4*)(pk + PK_MU + col + 4);
            const float mu[8] = {mu0[0], mu0[1], mu0[2], mu0[3], mu1[0], mu1[1], mu1[2], mu1[3]};
#pragma unroll
            for (int e = 0; e < 8; ++e) m[sidx][e] = real ? cur[e] + mu[e] * (fprev * prv[e] - cur[e]) : 0.f;
            if (halo_out && t == 63 && (sidx < 4 || hb == 0)) *(u32x4*)(halo_out + C_RW + col) = rc[sidx];
        }
#pragma unroll
        for (int e = 0; e < 8; ++e) { rr[e] = m[0][e]; kb[e] = m[1][e]; vv[e] = m[2][e]; zb[e] = m[3][e]; }
        float th[8];
#pragma unroll
        for (int e = 0; e < 8; ++e) th[e] = tanh_(m[4][e]);
        *(u32x4*)(thw + t * TSTR + g * 8) = pack8(th);
        *(u32x4*)(adb + t * TSTR + g * 8) = pack8(m[5]);
    }
    __syncthreads();
    {
        const int which = w >> 2, ct = w & 3;
        const bf16_t* Wt = (const bf16_t*)(p.ws + (which ? WS_A2T : WS_W2T)) + (size_t)hb * 4096;
        const bf16x8 b0 = *(const bf16x8*)(Wt + (16 * ct + l15) * 64 + 8 * q4), b1 = *(const bf16x8*)(Wt + (16 * ct + l15) * 64 + 32 + 8 * q4);
        const bf16_t* Aarr = which ? adb : thw;
        const int c = 16 * ct + l15;
        const float bias = pk[(which ? PK_A0 : PK_W0) + hb * 64 + c];
        float carry = 0.f;
#pragma unroll
        for (int tt = 0; tt < 4; ++tt) {
            f32x4 acc = {0.f, 0.f, 0.f, 0.f};
            acc = MFMA16(ldfrag(Aarr, TSTR, 16 * tt, 0, lane), b0, acc); acc = MFMA16(ldfrag(Aarr, TSTR, 16 * tt, 32, lane), b1, acc);
            if (which) {
#pragma unroll
                for (int r = 0; r < 4; ++r) af[(16 * tt + 4 * q4 + r) * 64 + c] = sigm(bias + acc[r]);
            } else {
                float wl[4];
#pragma unroll
                for (int r = 0; r < 4; ++r) { const int tk = 16 * tt + 4 * q4 + r; wl[r] = (tk < npad) ? 0.f : -0.6065306597126334f * sigm(bias + acc[r]); }
                wl[1] += wl[0]; wl[2] += wl[1]; wl[3] += wl[2];
                const float Q = wl[3];
                const float Q0 = __shfl(Q, l15), Q1 = __shfl(Q, l15 + 16), Q2 = __shfl(Q, l15 + 32), Q3 = __shfl(Q, l15 + 48);
                const float ex = carry + (q4 > 0 ? Q0 : 0.f) + (q4 > 1 ? Q1 : 0.f) + (q4 > 2 ? Q2 : 0.f);
#pragma unroll
                for (int r = 0; r < 4; ++r) lc[(16 * tt + 4 * q4 + r) * 64 + c] = ex + wl[r];
                carry += Q0 + Q1 + Q2 + Q3;
            }
        }
    }
    __syncthreads();
    {
        float lct[8], lcp[8], lcC[8], av[8];
        { const f32x4 a = *(const f32x4*)(lc + t * 64 + g * 8), b2 = *(const f32x4*)(lc + t * 64 + g * 8 + 4); lct[0] = a[0]; lct[1] = a[1]; lct[2] = a[2]; lct[3] = a[3]; lct[4] = b2[0]; lct[5] = b2[1]; lct[6] = b2[2]; lct[7] = b2[3]; }
        if (t > 0) { const f32x4 a = *(const f32x4*)(lc + (t - 1) * 64 + g * 8), b2 = *(const f32x4*)(lc + (t - 1) * 64 + g * 8 + 4); lcp[0] = a[0]; lcp[1] = a[1]; lcp[2] = a[2]; lcp[3] = a[3]; lcp[4] = b2[0]; lcp[5] = b2[1]; lcp[6] = b2[2]; lcp[7] = b2[3]; }
        else {
#pragma unroll
            for (int e = 0; e < 8; ++e) lcp[e] = 0.f; }
        { const f32x4 a = *(const f32x4*)(lc + 63 * 64 + g * 8), b2 = *(const f32x4*)(lc + 63 * 64 + g * 8 + 4); lcC[0] = a[0]; lcC[1] = a[1]; lcC[2] = a[2]; lcC[3] = a[3]; lcC[4] = b2[0]; lcC[5] = b2[1]; lcC[6] = b2[2]; lcC[7] = b2[3]; }
        { const f32x4 a = *(const f32x4*)(af + t * 64 + g * 8), b2 = *(const f32x4*)(af + t * 64 + g * 8 + 4); av[0] = a[0]; av[1] = a[1]; av[2] = a[2]; av[3] = a[3]; av[4] = b2[0]; av[5] = b2[1]; av[6] = b2[2]; av[7] = b2[3]; }
        const int hc = hb * 64 + g * 8;
        float kk[8], km[8], ss = 0.f, rk = 0.f;
        float pkk[8], pka[8], prk[8];
        { const f32x4 a0 = *(const f32x4*)(pk + PK_KK + hc), a1 = *(const f32x4*)(pk + PK_KK + hc + 4), b0 = *(const f32x4*)(pk + PK_KA + hc), b1 = *(const f32x4*)(pk + PK_KA + hc + 4), c0v = *(const f32x4*)(pk + PK_RK + hc), c1v = *(const f32x4*)(pk + PK_RK + hc + 4);
#pragma unroll
          for (int e = 0; e < 4; ++e) { pkk[e] = a0[e]; pkk[4 + e] = a1[e]; pka[e] = b0[e]; pka[4 + e] = b1[e]; prk[e] = c0v[e]; prk[4 + e] = c1v[e]; } }
#pragma unroll
        for (int e = 0; e < 8; ++e) { kk[e] = kb[e] * pkk[e]; ss += kk[e] * kk[e]; km[e] = kb[e] * (1.f + (av[e] - 1.f) * pka[e]); rk += rr[e] * km[e] * prk[e]; }
        ss += __shfl_xor(ss, 1); ss += __shfl_xor(ss, 2); ss += __shfl_xor(ss, 4);
        rk += __shfl_xor(rk, 1); rk += __shfl_xor(rk, 2); rk += __shfl_xor(rk, 4);
        const float kn = __builtin_amdgcn_rsqf(ss + 1e-6f);
        float xa[8], xb[8], xk[8], xr[8], xbt[8], xkt[8];
#pragma unroll
        for (int e = 0; e < 8; ++e) { kk[e] *= kn; const float ka = kk[e] * av[e]; const float ip = __expf(-lct[e]), tl = __expf(lcC[e] - lct[e]);
            xa[e] = kk[e] * __expf(lcp[e]); xb[e] = ka * ip; xk[e] = km[e] * ip; xr[e] = rr[e] * __expf(lct[e]); xbt[e] = ka * tl; xkt[e] = km[e] * tl; }
        *(u32x4*)(At + t * TSTR + g * 8) = pack8(xa); *(u32x4*)(Bt + t * TSTR + g * 8) = pack8(xb); *(u32x4*)(Kt + t * TSTR + g * 8) = pack8(xk); *(u32x4*)(Rt + t * TSTR + g * 8) = pack8(xr);
        *(u32x4*)(At2 + t * TSTR + g * 8) = pack8(xa); *(u32x4*)(Btl + t * TSTR + g * 8) = pack8(xbt); *(u32x4*)(Ktl + t * TSTR + g * 8) = pack8(xkt); *(u32x4*)(Vr + t * TSTR + g * 8) = pack8(vv);
        float c1[8], c0[8];
#pragma unroll
        for (int e = 0; e < 8; ++e) { c1[e] = 0.f; c0[e] = 0.f; }
        { const f32x4 g0 = *(const f32x4*)(pk + PK_GNW + hc), g1 = *(const f32x4*)(pk + PK_GNW + hc + 4), h0 = *(const f32x4*)(pk + PK_GNB + hc), h1 = *(const f32x4*)(pk + PK_GNB + hc + 4);
#pragma unroll
          for (int e = 0; e < 4; ++e) { const float sz0 = silu_(zb[e]), sz1 = silu_(zb[4 + e]); c1[e] = g0[e] * sz0; c1[4 + e] = g1[e] * sz1; c0[e] = (h0[e] + rk * vv[e]) * sz0; c0[4 + e] = (h1[e] + rk * vv[4 + e]) * sz1; } }
        *(u32x4*)((bf16_t*)(rec + RP_C1) + t * 64 + g * 8) = pack8(c1); *(u32x4*)((bf16_t*)(rec + RP_C0) + t * 64 + g * 8) = pack8(c0);
        if (t == 63) { float* pc = (float*)(rec + RP_PC) + g * 8; *(f32x4*)pc = (f32x4){__expf(lcC[0]), __expf(lcC[1]), __expf(lcC[2]), __expf(lcC[3])}; *(f32x4*)(pc + 4) = (f32x4){__expf(lcC[4]), __expf(lcC[5]), __expf(lcC[6]), __expf(lcC[7])}; }
    }
    __syncthreads();
    {
        const int pr = w >> 1;
        const bf16_t* Aarr = pr < 2 ? At : Rt; const bf16_t* Barr = (pr & 1) ? Kt : Bt;
#pragma unroll
        for (int x = 0; x < 2; ++x) { const int tt = 2 * (w & 1) + x;
            const bf16x8 a0 = ldfrag(Aarr, TSTR, 16 * tt, 0, lane), a1 = ldfrag(Aarr, TSTR, 16 * tt, 32, lane);
            const int tk = 16 * tt + l15;
#pragma unroll
            for (int it = 0; it < 4; ++it) { f32x4 acc = {0.f, 0.f, 0.f, 0.f};
                acc = MFMA16(ldfrag(Barr, TSTR, 16 * it, 0, lane), a0, acc); acc = MFMA16(ldfrag(Barr, TSTR, 16 * it, 32, lane), a1, acc);
                const int i0 = 16 * it + 4 * q4;
                f32x4 o;
#pragma unroll
                for (int r = 0; r < 4; ++r) { const int i = i0 + r; const bool keep = pr < 2 ? (tk > i) : (tk >= i); o[r] = keep ? acc[r] : 0.f; }
                if (pr == 0) *(f32x4*)(Lm + tk * 64 + i0) = o;
                else { bf16_t* Out = pr == 1 ? Lak : (pr == 2 ? Mrb : Mrk); *(u32x2*)(Out + tk * TSTR + i0) = (u32x2){pk2(o[0], o[1]), pk2(o[2], o[3])}; } }
        }
    }
    __syncthreads();
    {
        float* Tm = (float*)(smem + RL_TM);
        inv_block(Lm, Tm, (float*)(smem + RL_XS), tid);
        const int i = tid >> 3, j0 = (tid & 7) * 8;
        float a[8];
#pragma unroll
        for (int e = 0; e < 8; ++e) a[e] = Tm[i * 64 + j0 + e];
        *(u32x4*)(Tb + i * TSTR + j0) = pack8(a);
    }
    __syncthreads();
    {
        const int tt = w & 3, which = w >> 2;
        const bf16_t* Aarr = which ? Lak : Tb; const bf16_t* Barr = which ? Vr : At2; bf16_t* Out = which ? XT : WaT;
        const bf16x8 a0 = ldfrag(Aarr, TSTR, 16 * tt, 0, lane), a1 = ldfrag(Aarr, TSTR, 16 * tt, 32, lane);
#pragma unroll
        for (int ct = 0; ct < 4; ++ct) { f32x4 acc = {0.f, 0.f, 0.f, 0.f};
            acc = MFMA16(a0, ldfrag_tr(Barr, TSTR, 16 * ct, 0, lane), acc); acc = MFMA16(a1, ldfrag_tr(Barr, TSTR, 16 * ct, 32, lane), acc);
            *(u32x2*)(Out + (16 * ct + l15) * TSTR + 16 * tt + 4 * q4) = (u32x2){pk2(acc[0], acc[1]), pk2(acc[2], acc[3])}; }
    }
    __syncthreads();
    {
        f32x4 acc[4];
        if (w < 4) {
            const bf16x8 a0 = ldfrag(Tb, TSTR, 16 * w, 0, lane), a1 = ldfrag(Tb, TSTR, 16 * w, 32, lane);
#pragma unroll
            for (int ct = 0; ct < 4; ++ct) { acc[ct] = (f32x4){0.f, 0.f, 0.f, 0.f};
                acc[ct] = MFMA16(a0, ldfrag(XT, TSTR, 16 * ct, 0, lane), acc[ct]); acc[ct] = MFMA16(a1, ldfrag(XT, TSTR, 16 * ct, 32, lane), acc[ct]); }
        }
        __syncthreads();
        if (w < 4) {
#pragma unroll
            for (int ct = 0; ct < 4; ++ct) *(u32x2*)(XT + (16 * ct + l15) * TSTR + 16 * w + 4 * q4) = (u32x2){pk2(-acc[ct][0], -acc[ct][1]), pk2(-acc[ct][2], -acc[ct][3])};
        }
    }
    __syncthreads();
    {
        const bf16_t* UvT = XT;
        bf16_t* gAP = (bf16_t*)(rec + RP_AP); bf16_t* gRH = (bf16_t*)(rec + RP_RH); bf16_t* gKH = (bf16_t*)(rec + RP_KH); bf16_t* gYH = (bf16_t*)(rec + RP_YH);
        const int et = w & 3, part = w >> 2;
        {
            const bf16x8 a0 = ldfrag(WaT, TSTR, 16 * et, 0, lane), a1 = ldfrag(WaT, TSTR, 16 * et, 32, lane);
            if (part == 0) {
#pragma unroll
                for (int kt = 0; kt < 4; ++kt) { f32x4 acc = {0.f, 0.f, 0.f, 0.f};
                    acc = MFMA16(a0, ldfrag_tr(Btl, TSTR, 16 * kt, 0, lane), acc); acc = MFMA16(a1, ldfrag_tr(Btl, TSTR, 16 * kt, 32, lane), acc);
                    *(u32x2*)(gAP + ((size_t)(kt * 2 + (et >> 1)) * 64 + lane) * 8 + (et & 1) * 4) = (u32x2){pk2(-acc[0], -acc[1]), pk2(-acc[2], -acc[3])}; }
            } else {
#pragma unroll
                for (int tt = 0; tt < 4; ++tt) { f32x4 acc = {0.f, 0.f, 0.f, 0.f};
                    acc = MFMA16(a0, ldfrag(Mrb, TSTR, 16 * tt, 0, lane), acc); acc = MFMA16(a1, ldfrag(Mrb, TSTR, 16 * tt, 32, lane), acc);
                    const int tk = 16 * tt + l15, e0 = 16 * et + 4 * q4;
                    const u32x2 q2 = *(const u32x2*)(Rt + tk * TSTR + e0);
                    const float o0 = __uint_as_float(q2.x << 16) - acc[0], o1 = __uint_as_float(q2.x & 0xffff0000u) - acc[1], o2 = __uint_as_float(q2.y << 16) - acc[2], o3 = __uint_as_float(q2.y & 0xffff0000u) - acc[3];
                    *(u32x2*)(gRH + ((size_t)(tt * 2 + (et >> 1)) * 64 + lane) * 8 + (et & 1) * 4) = (u32x2){pk2(o0, o1), pk2(o2, o3)}; }
            }
        }
        {
            const int rt = w & 3;
            bf16_t* Out = part ? gKH : gYH;
            bf16x8 a0, a1, a2, a3;
            if (part) { a0 = ldfrag_tr(Btl, TSTR, 16 * rt, 0, lane); a1 = ldfrag_tr(Btl, TSTR, 16 * rt, 32, lane); a2 = ldfrag_tr(Ktl, TSTR, 16 * rt, 0, lane); a3 = ldfrag_tr(Ktl, TSTR, 16 * rt, 32, lane); }
            else { a0 = ldfrag(Mrb, TSTR, 16 * rt, 0, lane); a1 = ldfrag(Mrb, TSTR, 16 * rt, 32, lane); a2 = ldfrag(Mrk, TSTR, 16 * rt, 0, lane); a3 = ldfrag(Mrk, TSTR, 16 * rt, 32, lane); }
#pragma unroll
            for (int vt = 0; vt < 4; ++vt) { f32x4 acc = {0.f, 0.f, 0.f, 0.f};
                acc = MFMA16(a0, ldfrag(UvT, TSTR, 16 * vt, 0, lane), acc); acc = MFMA16(a1, ldfrag(UvT, TSTR, 16 * vt, 32, lane), acc);
                acc = MFMA16(a2, ldfrag_tr(Vr, TSTR, 16 * vt, 0, lane), acc); acc = MFMA16(a3, ldfrag_tr(Vr, TSTR, 16 * vt, 32, lane), acc);
                *(u32x2*)(Out + ((size_t)(vt * 4 + rt) * 64 + lane) * 4) = (u32x2){pk2(acc[0], acc[1]), pk2(acc[2], acc[3])}; }
        }
    }
    __syncthreads();
}

__device__ __forceinline__ void phase_rprep(const Params& p, int seg, unsigned char* smem) {
    const int blk = obid();
    const int n_items = (CPS + (seg == 0 ? 1 : 0)) * 128;
#pragma unroll 1
    for (int it = (blk + (gridDim.x >> 1)) % gridDim.x; it < n_items; it += gridDim.x) {
        const int bh = it & 127, b = bh >> 4, hb = bh & 15; int cl = it >> 7; if (seg != 0) cl += 1;
        unsigned char* rec = p.ws + WS_RP + (size_t)(cl * 128 + bh) * RP_STRIDE;
        const bf16_t* Pb = (const bf16_t*)(p.ws + WS_P);
        bf16_t* phalo2 = (bf16_t*)(p.ws + WS_PHALO);
        if (cl == 0) rwkv_prep_item(p, smem, hb, LEX0, 48, nullptr, nullptr, rec);
        else {
            const int row = b * SEGTOK + (cl - 1) * 64;
            const bf16_t* prow = Pb + (size_t)(row - 1) * NPB;
            if (cl == 1) prow = (seg == 0) ? Pb + (size_t)(LEX0 + NMETA - 1) * NPB : phalo2 + (size_t)(((seg - 1) & 1) * NBATCH + b) * NPB;
            bf16_t* ho = (cl == CPS) ? phalo2 + (size_t)((seg & 1) * NBATCH + b) * NPB : nullptr;
            rwkv_prep_item(p, smem, hb, row, 0, prow, ho, rec);
        }
    }
}

__device__ __forceinline__ void rwkv_scan_block(const Params& p, int seg, unsigned char* smem, int pairidx) {
    const int tid = otid(), w = tid >> 6, lane = tid & 63, q4 = lane >> 4, l15 = lane & 15;
    const int hsel = w >> 2, vt = w & 3;
    const int bh = pairidx * 2 + hsel, b = bh >> 4, hb = bh & 15;
    float* st = p.out + O_RWKV_P + (size_t)bh * 4096;
    f32x4 S[4];
    if (seg) {
#pragma unroll
        for (int mt = 0; mt < 4; ++mt) S[mt] = *(const f32x4*)(st + (size_t)(16 * vt + l15) * 64 + 16 * mt + 4 * q4);
    } else {
#pragma unroll
        for (int mt = 0; mt < 4; ++mt) S[mt] = (f32x4){0.f, 0.f, 0.f, 0.f};
    }
    const int c_lo = seg ? 1 : 0;
    float* ybuf = (float*)(smem + 65536) + hsel * (64 * 68);
    const int tl = tid & 255;
    {
        const u32x4* src = (const u32x4*)(p.ws + WS_RP + (size_t)(c_lo * 128 + bh) * RP_STRIDE); u32x4* dst = (u32x4*)(smem + hsel * 16384);
#pragma unroll
        for (int x = 0; x < 4; ++x) dst[tl + 256 * x] = src[tl + 256 * x];
    }
#pragma unroll 1
    for (int cl = c_lo; cl <= CPS; ++cl) {
        const unsigned char* rec = p.ws + WS_RP + (size_t)(cl * 128 + bh) * RP_STRIDE;
        const int cur = (cl - c_lo) & 1;
        __syncthreads();
        u32x4 nx[4];
        const bool more = cl < CPS;
        if (more) { const u32x4* src = (const u32x4*)(rec + (size_t)RP_STRIDE * 128);
#pragma unroll
            for (int x = 0; x < 4; ++x) nx[x] = src[tl + 256 * x]; }
        const bf16_t* gKH = (const bf16_t*)(rec + RP_KH); const bf16_t* gYH = (const bf16_t*)(rec + RP_YH);
        u32x2 kh[4], yh[4]; f32x4 pc[4];
#pragma unroll
        for (int mt = 0; mt < 4; ++mt) { kh[mt] = *(const u32x2*)(gKH + ((size_t)(vt * 4 + mt) * 64 + lane) * 4); yh[mt] = *(const u32x2*)(gYH + ((size_t)(vt * 4 + mt) * 64 + lane) * 4);
            pc[mt] = *(const f32x4*)((const float*)(rec + RP_PC) + 16 * mt + 4 * q4); }
        const int tk = tl >> 2, g = tl & 3;
        u32x4 a0 = {0u, 0u, 0u, 0u}, a1 = a0, b0 = a0, b1 = a0;
        if (cl > 0) { const bf16_t* c1p = (const bf16_t*)(rec + RP_C1) + tk * 64 + 16 * g; const bf16_t* c0p = (const bf16_t*)(rec + RP_C0) + tk * 64 + 16 * g;
            a0 = *(const u32x4*)c0p; a1 = *(const u32x4*)(c0p + 8); b0 = *(const u32x4*)c1p; b1 = *(const u32x4*)(c1p + 8); }
        bf16x8 Bf[2];
#pragma unroll
        for (int ks = 0; ks < 2; ++ks) { u32x4 tq; tq.x = pk2(S[2 * ks][0], S[2 * ks][1]); tq.y = pk2(S[2 * ks][2], S[2 * ks][3]); tq.z = pk2(S[2 * ks + 1][0], S[2 * ks + 1][1]); tq.w = pk2(S[2 * ks + 1][2], S[2 * ks + 1][3]);
            Bf[ks] = __builtin_bit_cast(bf16x8, tq); }
        const bf16x8* AP = (const bf16x8*)(smem + cur * 32768 + hsel * 16384); const bf16x8* RH = (const bf16x8*)(smem + cur * 32768 + hsel * 16384 + RP_RH);
        f32x4 y[4], tS[4];
#pragma unroll
        for (int tt = 0; tt < 4; ++tt) { y[tt] = (f32x4){0.f, 0.f, 0.f, 0.f}; y[tt] = MFMA16(RH[(tt * 2 + 0) * 64 + lane], Bf[0], y[tt]); y[tt] = MFMA16(RH[(tt * 2 + 1) * 64 + lane], Bf[1], y[tt]); }
#pragma unroll
        for (int mt = 0; mt < 4; ++mt) { tS[mt] = (f32x4){0.f, 0.f, 0.f, 0.f}; tS[mt] = MFMA16(AP[(mt * 2 + 0) * 64 + lane], Bf[0], tS[mt]); tS[mt] = MFMA16(AP[(mt * 2 + 1) * 64 + lane], Bf[1], tS[mt]); }
#pragma unroll
        for (int mt = 0; mt < 4; ++mt) {
            S[mt][0] = pc[mt][0] * S[mt][0] + tS[mt][0] + __uint_as_float(kh[mt].x << 16); S[mt][1] = pc[mt][1] * S[mt][1] + tS[mt][1] + __uint_as_float(kh[mt].x & 0xffff0000u);
            S[mt][2] = pc[mt][2] * S[mt][2] + tS[mt][2] + __uint_as_float(kh[mt].y << 16); S[mt][3] = pc[mt][3] * S[mt][3] + tS[mt][3] + __uint_as_float(kh[mt].y & 0xffff0000u); }
        if (cl > 0) {
#pragma unroll
            for (int tt = 0; tt < 4; ++tt) {
                y[tt][0] += __uint_as_float(yh[tt].x << 16); y[tt][1] += __uint_as_float(yh[tt].x & 0xffff0000u); y[tt][2] += __uint_as_float(yh[tt].y << 16); y[tt][3] += __uint_as_float(yh[tt].y & 0xffff0000u);
#pragma unroll
                for (int r = 0; r < 4; ++r) ybuf[(16 * tt + 4 * q4 + r) * 68 + 16 * vt + l15] = y[tt][r]; }
        }
        if (more) { u32x4* dst = (u32x4*)(smem + (cur ^ 1) * 32768 + hsel * 16384);
#pragma unroll
            for (int x = 0; x < 4; ++x) dst[tl + 256 * x] = nx[x]; }
        if (cl > 0) {
            __syncthreads();
            f32x4 yv[4]; float sm = 0.f;
#pragma unroll
            for (int j = 0; j < 4; ++j) { yv[j] = *(const f32x4*)(ybuf + tk * 68 + 16 * g + 4 * j); sm += yv[j][0] + yv[j][1] + yv[j][2] + yv[j][3]; }
            sm += __shfl_xor(sm, 1); sm += __shfl_xor(sm, 2);
            const float mu = sm * (1.f / 64.f); float vs = 0.f;
#pragma unroll
            for (int j = 0; j < 4; ++j) { yv[j] = yv[j] - mu; vs += yv[j][0] * yv[j][0] + yv[j][1] * yv[j][1] + yv[j][2] * yv[j][2] + yv[j][3] * yv[j][3]; }
            vs += __shfl_xor(vs, 1); vs += __shfl_xor(vs, 2);
            const float rs = __builtin_amdgcn_rsqf(vs * (1.f / 64.f) + 64e-5f);
            const unsigned c0w[8] = {a0.x, a0.y, a0.z, a0.w, a1.x, a1.y, a1.z, a1.w}, c1w[8] = {b0.x, b0.y, b0.z, b0.w, b1.x, b1.y, b1.z, b1.w};
            unsigned ow[8];
#pragma unroll
            for (int j = 0; j < 8; ++j) ow[j] = pk2(yv[j >> 1][(j & 1) * 2] * rs * __uint_as_float(c1w[j] << 16) + __uint_as_float(c0w[j] << 16),
                                                     yv[j >> 1][(j & 1) * 2 + 1] * rs * __uint_as_float(c1w[j] & 0xffff0000u) + __uint_as_float(c0w[j] & 0xffff0000u));
            const size_t grow = (size_t)b * SEQ + seg * SEGTOK + (cl - 1) * 64 + tk;
            bf16_t* ob = (bf16_t*)(p.ws + WS_OB) + grow * D + hb * 64 + 16 * g;
            *(u32x4*)ob = (u32x4){ow[0], ow[1], ow[2], ow[3]}; *(u32x4*)(ob + 8) = (u32x4){ow[4], ow[5], ow[6], ow[7]};
        }
    }
#pragma unroll
    for (int mt = 0; mt < 4; ++mt) *(f32x4*)(st + (size_t)(16 * vt + l15) * 64 + 16 * mt + 4 * q4) = S[mt];
    __syncthreads();
}

__device__ __forceinline__ void gdn_sample_item(const Params& p, unsigned char* smem, int bs, int h) {
    const int tid = otid(), w = tid >> 6, lane = tid & 63, kq = tid >> 7, v = tid & 127;
    float* qk_s = (float*)smem; float* v_s = qk_s + 1024; float* gb_s = v_s + 512; float* part = gb_s + 16; float* part2 = part + 512;
    const bf16_t* P = (const bf16_t*)(p.ws + WS_P);
    const float* pk = (const float*)(p.ws + WS_PK);
    const float* s_in = p.in[2] + (size_t)(bs * 8 + h) * 16384; float* s_out = p.out + O_GDN_S + (size_t)(bs * 8 + h) * 16384;
    const int row0 = LEX0 + EX_SAMP + bs * DECT;
    float s[32];
#pragma unroll
    for (int j = 0; j < 32; ++j) s[j] = s_in[(size_t)(kq * 32 + j) * 128 + v];
    if (tid < 384) {
        const int pcol = (tid >> 7) * 1024 + h * 128 + (tid & 127);
        const float* cw = pk + PK_CONVW; const float* hin = p.in[3] + (size_t)bs * 9216; float* hout = p.out + O_CONV_S + (size_t)bs * 9216;
        const float cw0 = cw[pcol], cw1 = cw[3072 + pcol], cw2 = cw[6144 + pcol], cw3 = cw[9216 + pcol];
        float x3 = hin[pcol], x2 = hin[3072 + pcol], x1 = hin[6144 + pcol];
        float xr[4];
#pragma unroll
        for (int i = 0; i < 4; ++i) xr[i] = bf2f(P[(size_t)(row0 + i) * NPB + pcol]);
#pragma unroll
        for (int i = 0; i < 4; ++i) { const float y = cw0 * x3 + cw1 * x2 + cw2 * x1 + cw3 * xr[i]; x3 = x2; x2 = x1; x1 = xr[i];
            if (tid < 256) qk_s[i * 256 + tid] = silu_(y); else v_s[i * 128 + (tid - 256)] = silu_(y); }
        hout[pcol] = x3; hout[3072 + pcol] = x2; hout[6144 + pcol] = x1;
    } else if (tid < 388) {
        const int i = tid - 384; const size_t r = (size_t)(row0 + i) * NPB;
        const float pa = bf2f(P[r + C_A + h]), pb = bf2f(P[r + C_B + h]);
        gb_s[2 * i] = __expf(-expf(pk[PK_ALOG + h]) * softplus_(pa + pk[PK_DTB + h])); gb_s[2 * i + 1] = sigm(pb);
    }
    __syncthreads();
    { const int i = w >> 1, which = w & 1; float* rp = qk_s + i * 256 + which * 128; const float a = rp[lane], b = rp[lane + 64];
      const float sc = __builtin_amdgcn_rsqf(wave_sum(a * a + b * b) + 1e-6f) * (which == 0 ? 0.08838834764831845f : 1.f); rp[lane] = a * sc; rp[lane + 64] = b * sc; }
    __syncthreads();
#pragma unroll 1
    for (int i = 0; i < 4; ++i) {
        const float* kp = qk_s + i * 256 + 128 + kq * 32; const float* qp = qk_s + i * 256 + kq * 32;
        float pa = 0.f;
#pragma unroll
        for (int j4 = 0; j4 < 8; ++j4) { const f32x4 k4 = *(const f32x4*)(kp + 4 * j4); pa += k4[0] * s[4 * j4] + k4[1] * s[4 * j4 + 1] + k4[2] * s[4 * j4 + 2] + k4[3] * s[4 * j4 + 3]; }
        part[kq * 128 + v] = pa;
        __syncthreads();
        const float kS = part[v] + part[128 + v] + part[256 + v] + part[384 + v];
        const float a = gb_s[2 * i], c = gb_s[2 * i + 1] * (v_s[i * 128 + v] - a * kS);
        float po = 0.f;
#pragma unroll
        for (int j4 = 0; j4 < 8; ++j4) { const f32x4 k4 = *(const f32x4*)(kp + 4 * j4), q4v = *(const f32x4*)(qp + 4 * j4);
#pragma unroll
            for (int e = 0; e < 4; ++e) { s[4 * j4 + e] = a * s[4 * j4 + e] + k4[e] * c; po += q4v[e] * s[4 * j4 + e]; } }
        part2[kq * 128 + v] = po;
        __syncthreads();
        if (kq == 0) ((float*)(p.ws + WS_ORAW))[(size_t)(row0 + i) * D + h * 128 + v] = part2[v] + part2[128 + v] + part2[256 + v] + part2[384 + v];
    }
#pragma unroll
    for (int j = 0; j < 32; ++j) s_out[(size_t)(kq * 32 + j) * 128 + v] = s[j];
    __syncthreads();
}

constexpr int SR_R = 0, SR_KK = 4096, SR_V = 8192, SR_ZB = 12288, SR_DEC = 16384, SR_KA = 20480, SR_KM = 24576, SR_WD = 28672, SR_AD = 28928, SR_RK = 29184;
__device__ __forceinline__ void rwkv_sample_item(const Params& p, unsigned char* smem, int bs) {
    const int tid = otid(), w = tid >> 6, lane = tid & 63;
    float* f = (float*)smem;
    const bf16_t* P = (const bf16_t*)(p.ws + WS_P);
    const float* pk = (const float*)(p.ws + WS_PK);
    const int row0 = LEX0 + EX_SAMP + bs * DECT;
    const bf16_t* prow = P + (size_t)(LEX0 + EX_SHIFT + bs) * NPB + C_RW;
#pragma unroll 1
    for (int col = tid; col < RW_SHIFT; col += 512) {
        const float mu = pk[PK_MU + col]; float prev = bf2f(prow[col]);
        float cur[4];
#pragma unroll
        for (int i = 0; i < 4; ++i) cur[i] = bf2f(P[(size_t)(row0 + i) * NPB + C_RW + col]);
        float* dst; int stride = 1024; bool th = false;
        if (col < 1024) dst = f + SR_R + col; else if (col < 2048) dst = f + SR_KK + (col - 1024); else if (col < 3072) dst = f + SR_V + (col - 2048);
        else if (col < 3136) { dst = f + SR_WD + (col - 3072); stride = 64; th = true; } else if (col < 3200) { dst = f + SR_AD + (col - 3136); stride = 64; } else dst = f + SR_ZB + (col - 3200);
#pragma unroll
        for (int i = 0; i < 4; ++i) { float m = cur[i] + mu * (prev - cur[i]); prev = cur[i]; if (th) m = tanh_(m); dst[i * stride] = m; }
    }
    __syncthreads();
#pragma unroll 1
    for (int cc = 0; cc < 2; ++cc) {
        const int c = tid + 512 * cc;
        float aw[4] = {0.f, 0.f, 0.f, 0.f}, aa[4] = {0.f, 0.f, 0.f, 0.f};
#pragma unroll 8
        for (int l = 0; l < 64; ++l) { const float w2v = pk[PK_W2 + l * D + c], a2v = pk[PK_A2 + l * D + c];
#pragma unroll
            for (int i = 0; i < 4; ++i) { aw[i] += f[SR_WD + i * 64 + l] * w2v; aa[i] += f[SR_AD + i * 64 + l] * a2v; } }
        const float w0c = pk[PK_W0 + c], a0c = pk[PK_A0 + c], kkc = pk[PK_KK + c], kac = pk[PK_KA + c];
#pragma unroll
        for (int i = 0; i < 4; ++i) { const float a = sigm(a0c + aa[i]); const float kbv = f[SR_KK + i * 1024 + c];
            f[SR_DEC + i * 1024 + c] = __expf(-0.6065306597126334f * sigm(w0c + aw[i])); f[SR_KA + i * 1024 + c] = a; f[SR_KK + i * 1024 + c] = kbv * kkc; f[SR_KM + i * 1024 + c] = kbv * (1.f + (a - 1.f) * kac); }
    }
    __syncthreads();
#pragma unroll 1
    for (int x = 0; x < 8; ++x) { const int pr = w * 8 + x, i = pr >> 4, hh = pr & 15; const int o = i * 1024 + hh * 64 + lane;
        const float kr = f[SR_KK + o]; const float kk = kr * __builtin_amdgcn_rsqf(wave_sum(kr * kr) + 1e-6f); f[SR_KK + o] = kk; f[SR_KA + o] = kk * f[SR_KA + o];
        const float rkv = wave_sum(f[SR_R + o] * f[SR_KM + o] * pk[PK_RK + hh * 64 + lane]); if (lane == 0) f[SR_RK + pr] = rkv; }
    __syncthreads();
#pragma unroll 1
    for (int hp = 0; hp < 2; ++hp) {
        const int hb = hp * 8 + w;
        const float* s_in = p.in[4] + (size_t)(bs * 16 + hb) * 4096 + (size_t)lane * 64; float* s_out = p.out + O_RWKV_S + (size_t)(bs * 16 + hb) * 4096 + (size_t)lane * 64;
        f32x4 S[16];
#pragma unroll
        for (int j = 0; j < 16; ++j) S[j] = *(const f32x4*)(s_in + 4 * j);
        const int cch = hb * 64 + lane;
        const float gnw = pk[PK_GNW + cch], gnb = pk[PK_GNB + cch];
#pragma unroll 1
        for (int i = 0; i < 4; ++i) {
            const int o = i * 1024 + hb * 64;
            const float vv = f[SR_V + o + lane], rk = f[SR_RK + i * 16 + hb];
            float sa = 0.f;
#pragma unroll
            for (int j = 0; j < 16; ++j) { const f32x4 kk4 = *(const f32x4*)(f + SR_KK + o + 4 * j); sa += S[j][0] * kk4[0] + S[j][1] * kk4[1] + S[j][2] * kk4[2] + S[j][3] * kk4[3]; }
            float y = 0.f;
#pragma unroll
            for (int j = 0; j < 16; ++j) { const f32x4 de4 = *(const f32x4*)(f + SR_DEC + o + 4 * j), ka4 = *(const f32x4*)(f + SR_KA + o + 4 * j), km4 = *(const f32x4*)(f + SR_KM + o + 4 * j), r4 = *(const f32x4*)(f + SR_R + o + 4 * j);
#pragma unroll
                for (int e = 0; e < 4; ++e) { S[j][e] = S[j][e] * de4[e] + (vv * km4[e] - sa * ka4[e]); y += S[j][e] * r4[e]; } }
            const float mu = wave_sum(y) * (1.f / 64.f); const float dy = y - mu;
            const float rs = __builtin_amdgcn_rsqf(wave_sum(dy * dy) * (1.f / 64.f) + 64e-5f);
            const float ov = (dy * rs * gnw + gnb + rk * vv) * silu_(f[SR_ZB + i * 1024 + cch]);
            ((bf16_t*)(p.ws + WS_OB))[(size_t)(XROWS + EX_SAMP + bs * DECT + i) * D + cch] = (bf16_t)f2bf(ov);
        }
#pragma unroll
        for (int j = 0; j < 16; ++j) *(f32x4*)(s_out + 4 * j) = S[j];
    }
    __syncthreads();
}

__device__ __forceinline__ void phase2(const Params& p, int seg, unsigned char* smem) {
    const int blk = obid();
    float* out = p.out;
    float* chalo = (float*)(p.ws + WS_CHALO); float* phalo = (float*)(p.ws + WS_PHALO);
#ifndef SUB
#define SUB 0
#endif
#define SEN(x) (SUB == 0 || SUB == (x))
    if (SEN(1) && blk < 64) gdn_scan_block(p, seg, smem, blk);
    if (SEN(3) && blk >= 64 && blk < 128) rwkv_scan_block(p, seg, smem, blk - 64);
#ifndef DUP
#define DUP 0
#endif
    if (seg == 0) {
#pragma unroll 1
        for (int it = blk; it < DECB * 8; it += gridDim.x) gdn_sample_item(p, smem, it >> 3, it & 7);
#pragma unroll 1
        for (int it = blk; it < DECB; it += gridDim.x) rwkv_sample_item(p, smem, it);
    }
}

__device__ __forceinline__ void phase25(const Params& p, int seg) {
    const int tid0 = otid(); const int lane = tid0 & 63; const int gw = obid() * 8 + (tid0 >> 6), NGW = gridDim.x * 8;
    const bf16_t* P = (const bf16_t*)(p.ws + WS_P);
    const float* ORAW = (const float*)(p.ws + WS_ORAW); const float* YRAW = (const float*)(p.ws + WS_YRAW);
    const bf16_t* C0 = (const bf16_t*)(p.ws + WS_C0); const bf16_t* C1 = (const bf16_t*)(p.ws + WS_C1);
    bf16_t* OA = (bf16_t*)(p.ws + WS_H); bf16_t* OB = (bf16_t*)(p.ws + WS_OB);
    const int nrows = LEX0 + (seg == 0 ? DECB * DECT : 0);
    const int c = lane * 16;
    f32x4 nw[4];
#pragma unroll
    for (int j = 0; j < 4; ++j) nw[j] = *(const f32x4*)((const float*)(p.ws + WS_PK) + PK_NORMW + (c & 127) + 4 * j);
#pragma unroll 1
    for (int rr = LEX0 + gw; rr < nrows; rr += NGW) {
        int lr; size_t grow;
        if (rr < LEX0) { lr = rr; grow = (size_t)(rr / SEGTOK) * SEQ + seg * SEGTOK + (rr % SEGTOK); } else { lr = LEX0 + EX_SAMP + (rr - LEX0); grow = (size_t)XROWS + EX_SAMP + (rr - LEX0); }
        {
            f32x4 o[4]; float ss = 0.f;
#pragma unroll
            for (int j = 0; j < 4; ++j) { o[j] = *(const f32x4*)(ORAW + (size_t)lr * D + c + 4 * j); ss += o[j][0] * o[j][0] + o[j][1] * o[j][1] + o[j][2] * o[j][2] + o[j][3] * o[j][3]; }
            ss += __shfl_xor(ss, 1); ss += __shfl_xor(ss, 2); ss += __shfl_xor(ss, 4);
            const float rs = __builtin_amdgcn_rsqf(ss * (1.f / 128.f) + 1e-6f);
            const u32x4 z0 = *(const u32x4*)(P + (size_t)lr * NPB + C_Z + c), z1 = *(const u32x4*)(P + (size_t)lr * NPB + C_Z + c + 8);
            const unsigned zz[8] = {z0.x, z0.y, z0.z, z0.w, z1.x, z1.y, z1.z, z1.w};
            unsigned ow[8];
#pragma unroll
            for (int j = 0; j < 8; ++j) { const float za = __uint_as_float(zz[j] << 16), zb = __uint_as_float(zz[j] & 0xffff0000u);
                const float a = o[j >> 1][(j & 1) * 2] * rs * nw[j >> 1][(j & 1) * 2] * silu_(za), b = o[j >> 1][(j & 1) * 2 + 1] * rs * nw[j >> 1][(j & 1) * 2 + 1] * silu_(zb);
                ow[j] = pk2(a, b); }
            *(u32x4*)(OA + grow * D + c) = (u32x4){ow[0], ow[1], ow[2], ow[3]}; *(u32x4*)(OA + grow * D + c + 8) = (u32x4){ow[4], ow[5], ow[6], ow[7]};
        }
    }
}

__device__ __forceinline__ void phase_final(const Params& p) {
    const int tid0 = otid(); const int lane = tid0 & 63; const int gw = obid() * 8 + (tid0 >> 6), NGW = gridDim.x * 8;
    const f32x4* wr = (const f32x4*)((const float*)(p.ws + WS_PK) + PK_LNF) + lane;
    f32x4 wv[4];
#pragma unroll
    for (int j = 0; j < 4; ++j) wv[j] = wr[64 * j];
    constexpr int NR = XROWS + DECB * DECT;
#pragma unroll 1
    for (int r = gw; r < NR; r += 2 * NGW) {
        const int r1 = r + NGW; const bool has1 = r1 < NR;
        f32x4* x0 = (f32x4*)(p.out + (size_t)r * D) + lane; f32x4* x1 = (f32x4*)(p.out + (size_t)(has1 ? r1 : r) * D) + lane;
        f32x4 a[4], b[4]; float s0 = 0.f, s1 = 0.f;
#pragma unroll
        for (int j = 0; j < 4; ++j) { a[j] = x0[64 * j]; b[j] = x1[64 * j]; }
#pragma unroll
        for (int j = 0; j < 4; ++j) { s0 += a[j][0] * a[j][0] + a[j][1] * a[j][1] + a[j][2] * a[j][2] + a[j][3] * a[j][3]; s1 += b[j][0] * b[j][0] + b[j][1] * b[j][1] + b[j][2] * b[j][2] + b[j][3] * b[j][3]; }
        const float q0 = __builtin_amdgcn_rsqf(wave_sum(s0) * (1.f / D) + 1e-6f), q1 = __builtin_amdgcn_rsqf(wave_sum(s1) * (1.f / D) + 1e-6f);
#pragma unroll
        for (int j = 0; j < 4; ++j) x0[64 * j] = a[j] * q0 * wv[j];
        if (has1) {
#pragma unroll
            for (int j = 0; j < 4; ++j) x1[64 * j] = b[j] * q1 * wv[j]; }
    }
}

__global__ __launch_bounds__(512, 2) void hybrid_mega(Params p) {
    extern __shared__ __attribute__((aligned(16))) unsigned char smem[];
    cg::grid_group grid = cg::this_grid();
    LAS unsigned char* lds = (LAS unsigned char*)smem;
    const int G = gridDim.x;
    volatile LAS unsigned* xst = (volatile LAS unsigned*)(lds + (LDS_TOTAL - 16));
    if (threadIdx.x == 0) { xst[0] = 0u; xst[1] = 0u; }
    __syncthreads();
    (void)xcd_barrier_post((unsigned*)(p.ws + WS_BAR), xst);
    if (G == 0x7fffffff) grid.sync();
#define GSYNC() do { XcdBarrier xb_; xb_.bar = (unsigned*)(p.ws + WS_BAR); xb_.x = xb_xcc_id(); xb_.st = (volatile LAS unsigned*)((LAS unsigned char*)smem + (LDS_TOTAL - 16)); xcd_barrier(xb_); } while (0)

#ifndef ONLY
#define ONLY 0
#endif
#define EN(x) (ONLY == 0 || ONLY == (x))
    if (EN(1)) phase0(p, smem);
    GSYNC();
#pragma unroll 1
    for (int it = 0; it <= NSEG + 2; ++it) {
        const int xblk = obid() - (G - 12);
        const bool xrole = xblk >= 0;
        if (it > 0 && it <= NSEG && EN(3)) phase2(p, it - 1, smem);
        if (((it == 2 && xrole) || it == NSEG + 1) && EN(5)) {
            const bool ex = it == 2;
            SchedAB S; S.ob.init(ex ? 3 : XROWS / 256, 4, ex ? 12 : G, ex ? xblk : obid()); S.pm0 = ex ? XROWS / 256 : 0;
            S.A0 = (const char*)(p.ws + WS_H); S.A1 = (const char*)(p.ws + WS_OB); S.B0 = (const char*)(p.ws + WS_WT_A); S.B1 = (const char*)(p.ws + WS_WT_B);
            EpiAB E; E.tmp = ex ? (bf16_t*)(p.ws + WS_YRAW) - (size_t)XROWS * D : (bf16_t*)(p.ws + WS_P); E.merged = ex ? (bf16_t*)(p.ws + WS_C0) - (size_t)XROWS * D : (bf16_t*)(p.ws + WS_MG);
            E.gex = (const bf16_t*)(p.ws + WS_GEX); E.out = p.out;
            pg8::gemm_phase<EpiAB, SchedAB>(lds, D, S, E);
        }
        if (((it == 3 && xrole) || it == NSEG + 2) && EN(6)) {
            const bool ex = it == 3;
            SchedO S; S.ob.init(ex ? 3 : XROWS / 256, 4, ex ? 12 : G, ex ? xblk : obid()); S.pm0 = ex ? XROWS / 256 : 0;
            S.A = ex ? (const char*)((bf16_t*)(p.ws + WS_C0) - (size_t)XROWS * D) : (const char*)(p.ws + WS_MG); S.B = (const char*)(p.ws + WS_WT_O);
            EpiO E; E.out = p.out; E.xp = p.in[0]; E.xs = p.in[1];
            pg8::gemm_phase<EpiO, SchedO>(lds, D, S, E);
        }
        if (it < NSEG && EN(2) && !(it == 2 && xrole)) {
            const int seg = it;
            const int Gp = it == 2 ? G - 12 : G;
            const int cidx = it > 0 ? (obid() + (Gp >> 1)) % Gp : obid();
            SchedIn S; S.ob.init(seg == 0 ? LT_PROMPT + 3 : LT_PROMPT, NT_IN, Gp, cidx); S.seg = seg; S.A = (const char*)(p.ws + WS_H); S.B = (const char*)(p.ws + WS_WT_IN);
            EpiIn E; E.P = (bf16_t*)(p.ws + WS_P); E.gex = (bf16_t*)(p.ws + WS_GEX); E.out = p.out; E.seg = seg;
            pg8::gemm_phase<EpiIn, SchedIn>(lds, D, S, E);
        }
        if (it >= 1 && it + 1 < NSEG && obid() >= 200) { const int t0 = otid(); h_rows_segs(p, it + 1, it + 2, (obid() - 200) * 8 + (t0 >> 6), (G - 200) * 8, t0 & 63); }
        GSYNC();
        if (it < NSEG) {
            if (EN(8)) { phase_gprep(p, it, smem); phase_rprep(p, it, smem); }
            if (it == 1 && EN(4)) phase25(p, 0);
            GSYNC();
        }
    }
    if (EN(7)) phase_final(p);
}

extern "C" void kernel_launch(void* const* d_in, const int* in_sizes, int n_in, void* d_out, int out_size, void* d_ws, size_t ws_size, hipStream_t stream) {
    static int grid_blocks = 0;
    constexpr int LDS_BYTES = LDS_TOTAL;
    if (grid_blocks == 0) {
        if (n_in != 27 || ws_size < WS_END) { fprintf(stderr, "kernel_launch: unexpected n_in %d / ws %zu (need %zu)\n", n_in, ws_size, (size_t)WS_END); grid_blocks = -1; return; }
        if (hipFuncSetAttribute((const void*)hybrid_mega, hipFuncAttributeMaxDynamicSharedMemorySize, LDS_BYTES) != hipSuccess) { fprintf(stderr, "kernel_launch: hipFuncSetAttribute failed\n"); grid_blocks = -1; return; }
        int dev = 0, cus = 0, per_cu = 0;
        hipGetDevice(&dev);
        hipDeviceGetAttribute(&cus, hipDeviceAttributeMultiprocessorCount, dev);
        hipOccupancyMaxActiveBlocksPerMultiprocessor(&per_cu, (const void*)hybrid_mega, 512, LDS_BYTES);
        if (per_cu < 1) { fprintf(stderr, "kernel_launch: occupancy query says %d blocks/CU\n", per_cu); per_cu = 1; }
        (void)hipGetLastError();
        grid_blocks = cus;
    }
    if (grid_blocks < 0) return;
    Params p{};
    for (int i = 0; i < 27; ++i) p.in[i] = (const float*)d_in[i];
    p.out = (float*)d_out; p.ws = (unsigned char*)d_ws;
    if (hipMemsetAsync((unsigned char*)d_ws + WS_BAR, 0, 16384, stream) != hipSuccess) { fprintf(stderr, "kernel_launch: memset of the barrier words failed\n"); return; }
    void* args[] = {&p};
    hipError_t e = hipLaunchCooperativeKernel((const void*)hybrid_mega, dim3(grid_blocks), dim3(512), args, LDS_BYTES, stream);
    if (e != hipSuccess) fprintf(stderr, "cooperative launch failed: %s (grid %d)\n", hipGetErrorString(e), grid_blocks);
}
```

```cpp
#include <hip/hip_runtime.h>
#include <hip/hip_cooperative_groups.h>
#include <cstdio>
namespace cg = cooperative_groups;

#define LAS __attribute__((address_space(3)))
typedef unsigned short bf16_t;
typedef short bf16x8 __attribute__((ext_vector_type(8)));
typedef float f32x4 __attribute__((ext_vector_type(4)));
typedef unsigned u32x4 __attribute__((ext_vector_type(4)));
typedef unsigned u32x2 __attribute__((ext_vector_type(2)));

constexpr int D = 1024;
constexpr int NBATCH = 8, SEQ = 2048, NMETA = 16, DECB = 128, DECT = 4;
constexpr int XROWS = NBATCH * SEQ;
constexpr int EX_SAMP = 16, EX_SHIFT = 528, EX_END = 656;
constexpr int HROWS = 17152, HTILES = 67;
constexpr int NSEG = 8, SEGTOK = SEQ / NSEG;
constexpr int CPS = SEGTOK / 64;
constexpr int TPB = SEGTOK / 256;
constexpr int LT_PROMPT = NBATCH * TPB;
constexpr int LEX0 = LT_PROMPT * 256;
constexpr int LROWS = LEX0 + 768;
constexpr int NP = 10496, NPB = 8448, NT_IN = 41, NT_PB = 33;
constexpr int C_A = 3072, C_B = 3080, C_Z = 3088, C_RW = 4112, C_GATE_REF = 8336;
constexpr int RW_SHIFT = 4224;

constexpr size_t O_YP = 0, O_YS = 16777216, O_GDN_P = 17301504, O_CONV_P = 18350080, O_RWKV_P = 18423808, O_SHIFT_P = 18948096,
                 O_GDN_S = 18956288, O_CONV_S = 35733504, O_RWKV_S = 36913152, O_SHIFT_S = 45301760;

constexpr size_t al256(size_t x) { return (x + 255) & ~(size_t)255; }
constexpr size_t WS_WT_IN = 0;
constexpr size_t WS_WT_A = al256(WS_WT_IN + (size_t)NP * D * 2);
constexpr size_t WS_WT_B = al256(WS_WT_A + (size_t)D * D * 2);
constexpr size_t WS_WT_O = al256(WS_WT_B + (size_t)D * D * 2);
constexpr size_t WS_H = al256(WS_WT_O + (size_t)D * D * 2);
constexpr size_t WS_OB = al256(WS_H + (size_t)HROWS * D * 2);
constexpr size_t WS_P = al256(WS_OB + (size_t)HROWS * D * 2);
constexpr size_t WS_ORAW = al256(WS_P + (size_t)LROWS * NPB * 2);
constexpr size_t WS_YRAW = al256(WS_ORAW + (size_t)LROWS * D * 4);
constexpr size_t WS_C0 = al256(WS_YRAW + (size_t)LROWS * D * 4);
constexpr size_t WS_C1 = al256(WS_C0 + (size_t)LROWS * D * 2);
constexpr size_t WS_GEX = al256(WS_C1 + (size_t)LROWS * D * 2);
constexpr size_t WS_CHALO = al256(WS_GEX + (size_t)768 * 2048 * 2);
constexpr size_t WS_PHALO = al256(WS_CHALO + (size_t)2 * NBATCH * 3 * NPB * 2);
constexpr size_t WS_PK = al256(WS_PHALO + (size_t)2 * NBATCH * NPB * 2);
constexpr int PK_CONVW = 0, PK_ALOG = 12288, PK_DTB = 12296, PK_NORMW = 12304, PK_MU = 12432, PK_W0 = 16656, PK_W2 = 17680, PK_A0 = 83216, PK_A2 = 84240,
              PK_KK = 149776, PK_KA = 150800, PK_RK = 151824, PK_GNW = 152848, PK_GNB = 153872, PK_LNF = 154896, PK_END = 155920;
constexpr size_t WS_BAR = al256(WS_PK + (size_t)PK_END * 4);
constexpr size_t WS_W2T = al256(WS_BAR + 16384);
constexpr size_t WS_A2T = al256(WS_W2T + 131072);
constexpr size_t WS_GP = al256(WS_A2T + 131072);
constexpr int GP_AP = 0, GP_QH = 32768, GP_KH = 49152, GP_OH = 81920, GP_EGL = 98304, GP_G = 98560, GP_STRIDE = 114944;
constexpr int RP_AP = 0, RP_RH = 8192, RP_KH = 16384, RP_YH = 24576, RP_C1 = 32768, RP_C0 = 40960, RP_PC = 49152, RP_STRIDE = 49408;
constexpr size_t WS_RP = al256(WS_GP + (size_t)(CPS + 1) * 64 * GP_STRIDE);
constexpr size_t WS_END = al256(WS_RP + (size_t)(CPS + 1) * 128 * RP_STRIDE);
constexpr size_t WS_MG = WS_GP;
static_assert((size_t)HROWS * D * 2 <= WS_END - WS_GP, "MERGED must fit in the prep records");
static_assert((size_t)HROWS * D * 4 <= (size_t)LROWS * NPB * 2 + 2 * (size_t)LROWS * D * 4, "TMP must fit in P+ORAW+YRAW");
static_assert(WS_END <= (size_t)268435456, "workspace");

constexpr int LDS_TOTAL = 163840;
struct Params { const float* in[27]; float* out; unsigned char* ws; };

__device__ __forceinline__ float bf2f(bf16_t v) { return __uint_as_float(((unsigned)v) << 16); }
typedef __bf16 bf16n2 __attribute__((ext_vector_type(2)));
typedef float f32n2 __attribute__((ext_vector_type(2)));
__device__ __forceinline__ unsigned cvt_pk_bf16(float lo, float hi) { const f32n2 v = {lo, hi}; return __builtin_bit_cast(unsigned, __builtin_convertvector(v, bf16n2)); }
__device__ __forceinline__ unsigned pk2(float lo, float hi) { return cvt_pk_bf16(lo, hi); }
__device__ __forceinline__ unsigned f2bf(float f) { return cvt_pk_bf16(f, 0.f) & 0xffffu; }
__device__ __forceinline__ float sigm(float x) { return __builtin_amdgcn_rcpf(1.f + __expf(-x)); }
__device__ __forceinline__ float silu_(float x) { return x * __builtin_amdgcn_rcpf(1.f + __expf(-x)); }
__device__ __forceinline__ float softplus_(float x) { return fmaxf(x, 0.f) + log1pf(expf(-fabsf(x))); }
__device__ __forceinline__ float wave_sum(float v) {
#pragma unroll
    for (int o = 1; o < 64; o <<= 1) v += __shfl_xor(v, o);
    return v;
}
__device__ __forceinline__ void unpack8(const u32x4 rw, float (&x)[8]) {
    x[0] = __uint_as_float(rw.x << 16); x[1] = __uint_as_float(rw.x & 0xffff0000u); x[2] = __uint_as_float(rw.y << 16); x[3] = __uint_as_float(rw.y & 0xffff0000u);
    x[4] = __uint_as_float(rw.z << 16); x[5] = __uint_as_float(rw.z & 0xffff0000u); x[6] = __uint_as_float(rw.w << 16); x[7] = __uint_as_float(rw.w & 0xffff0000u); }
__device__ __forceinline__ u32x4 pack8(const float (&x)[8]) { return (u32x4){pk2(x[0], x[1]), pk2(x[2], x[3]), pk2(x[4], x[5]), pk2(x[6], x[7])}; }

__device__ __forceinline__ int otid() { int t = threadIdx.x; asm volatile("" : "+v"(t)); return t; }
__device__ __forceinline__ int obid() { int t = blockIdx.x; asm volatile("" : "+s"(t)); return t; }
__device__ __forceinline__ float tanh_(float x) { const float e = __expf(2.f * x); return 1.f - 2.f * __builtin_amdgcn_rcpf(e + 1.f); }
template <int CTRL> __device__ __forceinline__ float dppf(float x) { return __builtin_bit_cast(float, __builtin_amdgcn_mov_dpp(__builtin_bit_cast(int, x), CTRL, 0xf, 0xf, true)); }
__device__ __forceinline__ float rowsum16(float x) { x += dppf<0x128>(x); x += dppf<0x124>(x); x += dppf<0x122>(x); x += dppf<0x121>(x); return x; }


#define XB_TMO      128
#define XB_XCNT(j)  (256  + 64 * (j))
#define XB_XSUB(j)  (1280 + 64 * (j))
#define XB_XGEN(j)  (2304 + 64 * (j))
#define XB_TOP      3328
#define XB_TOPGEN   3392
#define XCD_BAR_WORDS 3456
#define XB_SPIN_CAP (1u << 22)
__device__ __forceinline__ unsigned xb_ld(unsigned* p)              { return __hip_atomic_load(p, __ATOMIC_RELAXED, __HIP_MEMORY_SCOPE_AGENT); }
__device__ __forceinline__ unsigned xb_add(unsigned* p, unsigned v) { return __hip_atomic_fetch_add(p, v, __ATOMIC_RELAXED, __HIP_MEMORY_SCOPE_AGENT); }
__device__ __forceinline__ unsigned xb_xcc_id() { return (unsigned)__builtin_amdgcn_s_getreg((3 << 11) | 20) & 0xFu; }
#define XB_SPIN(cond, bar) do { unsigned _sp = 0; while (cond) { __builtin_amdgcn_s_sleep(1); \
    if ((++_sp & 255u) == 0u) { if (xb_ld(&(bar)[XB_TMO])) break; if (_sp > XB_SPIN_CAP) { atomicAdd(&(bar)[XB_TMO], 1u); break; } } } } while (0)
struct XcdBarrier { unsigned* bar; unsigned x; volatile LAS unsigned* st; };
__device__ __forceinline__ XcdBarrier xcd_barrier_post(unsigned* bar, volatile LAS unsigned* st) {
    XcdBarrier b; b.bar = bar; b.x = xb_xcc_id(); b.st = st;
    if (threadIdx.x == 0) (void)xb_add(&bar[XB_XCNT(b.x)], 1u);
    return b;
}
__device__ __forceinline__ void xcd_barrier_complete(unsigned* bar, unsigned x, unsigned& nloc, unsigned& nx) {
    const unsigned G = gridDim.x * gridDim.y * gridDim.z;
    unsigned sum, cnt, mine, sp = 0u;
    for (;;) {
        sum = 0u; cnt = 0u; mine = 0u;
#pragma unroll
        for (unsigned j = 0; j < 16; ++j) { const unsigned c = xb_ld(&bar[XB_XCNT(j)]); sum += c; cnt += (c > 0u) ? 1u : 0u; mine = (j == x) ? c : mine; }
        if (sum == G) break;
        __builtin_amdgcn_s_sleep(1);
        if ((++sp & 255u) == 0u) { if (xb_ld(&bar[XB_TMO])) break; if (sp > XB_SPIN_CAP) { atomicAdd(&bar[XB_TMO], 1u); break; } }
    }
    nloc = mine > 0u ? mine : 1u; nx = cnt > 0u ? cnt : 1u;
}
__device__ __forceinline__ void xcd_barrier(const XcdBarrier& b) {
    asm volatile("s_waitcnt vmcnt(0)" ::: "memory");
    __syncthreads();
    if (threadIdx.x == 0) {
        unsigned* bar = b.bar;
        __builtin_amdgcn_s_waitcnt(0);
        unsigned nloc = b.st[0], nx = b.st[1];
        if (nloc == 0u) { xcd_barrier_complete(bar, b.x, nloc, nx); b.st[0] = nloc; b.st[1] = nx; }
        const unsigned old = xb_add(&bar[XB_XSUB(b.x)], 1u);
        const unsigned gen = old / nloc;
        if (old + 1u == (gen + 1u) * nloc) {
            __builtin_amdgcn_fence(__ATOMIC_RELEASE, "agent");
            asm volatile("s_waitcnt vmcnt(0)" ::: "memory");
            const unsigned og = xb_add(&bar[XB_TOP], 1u);
            const unsigned tg = og / nx;
            if (og + 1u == (tg + 1u) * nx) xb_add(&bar[XB_TOPGEN], 1u);
            else XB_SPIN(xb_ld(&bar[XB_TOPGEN]) == tg, bar);
            __builtin_amdgcn_fence(__ATOMIC_ACQUIRE, "agent");
            xb_add(&bar[XB_XGEN(b.x)], 1u);
            asm volatile("s_waitcnt vmcnt(0)" ::: "memory");
        } else {
            XB_SPIN(xb_ld(&bar[XB_XGEN(b.x)]) == gen, bar);
            __builtin_amdgcn_fence(__ATOMIC_ACQUIRE, "agent");
            asm volatile("s_waitcnt vmcnt(0)" ::: "memory");
        }
    }
    __syncthreads();
}

namespace pg8 {
constexpr int BM = 256, BK = 64, HALF = 128, HTB = HALF * BK * 2, STAGE_BYTES = 8 * HTB, NXCD = 8, WGM = 8;
__device__ __forceinline__ int lds_byte(int r, int c) { const int st = (r >> 4) * 2 + (c >> 5), rr = r & 15, cc = c & 31, ob = rr * 64 + cc * 2; return st * 1024 + (ob ^ (((ob >> 9) & 1) << 5)); }
__device__ __forceinline__ void stage_rc(int b, int& R, int& C) { const int st = b / 1024, sb = b % 1024, swz = sb ^ (((sb >> 9) & 1) << 5); R = (st >> 1) * 16 + swz / 64; C = (st & 1) * 32 + (swz % 64) / 2; }
__device__ __forceinline__ int perm32(int rho) { const int n = rho >> 4, i = rho & 15; return 8 * (i >> 2) + 4 * n + (i & 3); }

struct Unit { int pm, pn, w; };
struct OrderBase {
    int nM, nN, nwg, G, c;
    __device__ void init(int nM_, int nN_, int G_, int c_) { nM = nM_; nN = nN_; nwg = nM * nN; G = G_; c = c_; }
    __device__ bool nextb(int i, Unit& u) const {
        const long L = (long)i * G + c; if (L >= nwg) return false;
        int wgid = (int)L; { const int q = nwg / NXCD, r = nwg % NXCD, xcd = wgid % NXCD, off = wgid / NXCD; wgid = (xcd < r ? xcd * (q + 1) : r * (q + 1) + (xcd - r) * q) + off; }
        const int nig = WGM * nN, gid = wgid / nig, fm = gid * WGM, gsz = (nM - fm) < WGM ? (nM - fm) : WGM;
        u.pm = fm + ((wgid % nig) % gsz); u.pn = (wgid % nig) / gsz; u.w = 0; return true;
    }
};

template <class Epi, class Sched>
__device__ __forceinline__ void gemm_phase(LAS unsigned char* lds, const int K, const Sched& S, const Epi& E) {
    const int tid = otid(), wid = __builtin_amdgcn_readfirstlane(tid >> 6), lane = tid & 63, wr = wid >> 2, wc = wid & 3, fr = lane & 15, fq = lane >> 4;
    const int nt = K / BK;
    unsigned voffA[2], voffB[2];
#pragma unroll
    for (int i = 0; i < 2; ++i) { int R, C; stage_rc(tid * 16 + i * 8192, R, C); const int Rb = Epi::PERM ? ((R & ~31) + perm32(R & 31)) : R;
        voffA[i] = (unsigned)(R * K + C) * 2u; voffB[i] = (unsigned)(Rb * K + C) * 2u; }
    const size_t kstep = (size_t)(BK * 2);
    const size_t hstep = (size_t)HALF * K * 2;
    const unsigned ldsw = (unsigned)wid * 1024u;
    const int aoff = lds_byte(wr * 64 + fr, fq * 8), boff = lds_byte(wc * 32 + fr, fq * 8);
#define PG8_SA(b, h) (((b) * 2 + (h)) * HTB)
#define PG8_SB(b, h) ((4 + (b) * 2 + (h)) * HTB)
#define PG8_STAGE(bufoff, gbase, voff) do { _Pragma("unroll") for (int _i = 0; _i < 2; ++_i) \
        __builtin_amdgcn_global_load_lds((const unsigned*)((const char*)(gbase) + (voff)[_i]), (LAS unsigned*)(lds + (bufoff) + ldsw + _i * 8192), 16, 0, 0); } while (0)
#define PG8_LDA(dst, b, h) do { _Pragma("unroll") for (int m = 0; m < 4; ++m) _Pragma("unroll") for (int k = 0; k < 2; ++k) dst[m][k] = *(const LAS bf16x8*)(lds + PG8_SA(b, h) + aoff + m * 2048 + k * 1024); } while (0)
#define PG8_LDB(dst, b, h) do { _Pragma("unroll") for (int n = 0; n < 2; ++n) _Pragma("unroll") for (int k = 0; k < 2; ++k) dst[n][k] = *(const LAS bf16x8*)(lds + PG8_SB(b, h) + boff + n * 2048 + k * 1024); } while (0)
#define PG8_MMA(ai, bj, At, Bt) do { __builtin_amdgcn_s_setprio(1); _Pragma("unroll") for (int m = 0; m < 4; ++m) _Pragma("unroll") for (int n = 0; n < 2; ++n) _Pragma("unroll") for (int k = 0; k < 2; ++k) \
        acc[ai][bj][m][n] = __builtin_amdgcn_mfma_f32_16x16x32_bf16(Bt[n][k], At[m][k], acc[ai][bj][m][n], 0, 0, 0); __builtin_amdgcn_s_setprio(0); } while (0)
#define PG8_WAIT_V(n) asm volatile("s_waitcnt vmcnt(" #n ")" ::: "memory")
#define PG8_WAIT_L(n) asm volatile("s_waitcnt lgkmcnt(" #n ")" ::: "memory")
#define PG8_BAR __builtin_amdgcn_s_barrier()
#define PG8_SCHED __builtin_amdgcn_sched_barrier(0)
    Unit cur, nxt; int ui = 0;
    if (!S.next(0, cur)) return;
    f32x4 acc[2][2][4][2];
#pragma unroll
    for (int a = 0; a < 2; ++a)
#pragma unroll
        for (int b = 0; b < 2; ++b)
#pragma unroll
            for (int m = 0; m < 4; ++m)
#pragma unroll
                for (int n = 0; n < 2; ++n) acc[a][b][m][n] = (f32x4){0.f, 0.f, 0.f, 0.f};
    bf16x8 At[4][2], B0[2][2], B1[2][2];
    const char* cA = S.a_ptr(cur); const char* cB = S.b_ptr(cur);
    PG8_STAGE(PG8_SB(0, 0), cB, voffB); PG8_STAGE(PG8_SA(0, 0), cA, voffA); PG8_STAGE(PG8_SB(0, 1), cB + hstep, voffB); PG8_STAGE(PG8_SA(0, 1), cA + hstep, voffA);
    if (wr == 1) PG8_BAR;
    PG8_WAIT_V(4); PG8_BAR;
    PG8_STAGE(PG8_SB(1, 0), cB + kstep, voffB); PG8_STAGE(PG8_SA(1, 0), cA + kstep, voffA); PG8_STAGE(PG8_SB(1, 1), cB + hstep + kstep, voffB);
    PG8_WAIT_V(6); PG8_BAR;
    for (;;) {
        const bool has_next = S.next(ui + 1, nxt);
        const char* nA = has_next ? S.a_ptr(nxt) : cA; const char* nB = has_next ? S.b_ptr(nxt) : cB;
        for (int t = 0; t < nt; t += 2) {
            const bool last = (t == nt - 2);
            const char* a1 = cA + (size_t)(t + 1) * kstep;
            const char* a2 = last ? nA : cA + (size_t)(t + 2) * kstep; const char* b2 = last ? nB : cB + (size_t)(t + 2) * kstep;
            const char* a3 = a2 + kstep; const char* b3 = b2 + kstep;
            PG8_LDB(B0, 0, 0); PG8_SCHED; PG8_LDA(At, 0, 0); PG8_STAGE(PG8_SA(1, 1), a1 + hstep, voffA);
            PG8_WAIT_L(8); PG8_BAR; PG8_WAIT_L(0); PG8_MMA(0, 0, At, B0); PG8_BAR; PG8_SCHED;
            PG8_LDB(B1, 0, 1); PG8_STAGE(PG8_SB(0, 0), b2, voffB);
            PG8_BAR; PG8_WAIT_L(0); PG8_MMA(0, 1, At, B1); PG8_BAR;
            PG8_LDA(At, 0, 1); PG8_STAGE(PG8_SA(0, 0), a2, voffA);
            PG8_BAR; PG8_WAIT_L(0); PG8_MMA(1, 0, At, B0); PG8_BAR; PG8_SCHED;
            PG8_STAGE(PG8_SB(0, 1), b2 + hstep, voffB);
            PG8_WAIT_V(6); PG8_BAR; PG8_MMA(1, 1, At, B1); PG8_BAR;
            PG8_LDB(B0, 1, 0); PG8_SCHED; PG8_LDA(At, 1, 0); PG8_STAGE(PG8_SA(0, 1), a2 + hstep, voffA);
            PG8_WAIT_L(8); PG8_BAR; PG8_WAIT_L(0); PG8_MMA(0, 0, At, B0); PG8_BAR; PG8_SCHED;
            PG8_LDB(B1, 1, 1); PG8_STAGE(PG8_SB(1, 0), b3, voffB);
            PG8_BAR; PG8_WAIT_L(0); PG8_MMA(0, 1, At, B1); PG8_BAR;
            PG8_LDA(At, 1, 1); PG8_STAGE(PG8_SA(1, 0), a3, voffA);
            PG8_BAR; PG8_WAIT_L(0); PG8_MMA(1, 0, At, B0); PG8_BAR; PG8_SCHED;
            PG8_STAGE(PG8_SB(1, 1), b3 + hstep, voffB);
            PG8_WAIT_V(6); PG8_BAR; PG8_MMA(1, 1, At, B1); PG8_BAR;
        }
        E(acc, cur, wr, wc, fr, fq);
        if (!has_next) break;
#pragma unroll
        for (int a = 0; a < 2; ++a)
#pragma unroll
            for (int b = 0; b < 2; ++b)
#pragma unroll
                for (int m = 0; m < 4; ++m)
#pragma unroll
                    for (int n = 0; n < 2; ++n) acc[a][b][m][n] = (f32x4){0.f, 0.f, 0.f, 0.f};
        cur = nxt; cA = nA; cB = nB; ++ui;
    }
    PG8_WAIT_V(0);
    if (wr == 0) PG8_BAR;
    PG8_BAR;
#undef PG8_SA
#undef PG8_SB
#undef PG8_STAGE
#undef PG8_LDA
#undef PG8_LDB
#undef PG8_MMA
#undef PG8_WAIT_V
#undef PG8_WAIT_L
#undef PG8_BAR
#undef PG8_SCHED
}
}
using pg8::Unit;

struct SchedIn {
    pg8::OrderBase ob; int seg; const char* A; const char* B;
    __device__ bool next(int i, Unit& u) const { return ob.nextb(i, u); }
    __device__ const char* a_ptr(const Unit& u) const {
        const int gt = u.pm < LT_PROMPT ? ((u.pm / TPB) * (SEQ / 256) + seg * TPB + (u.pm % TPB)) : (XROWS / 256 + (u.pm - LT_PROMPT));
        return A + (size_t)gt * 256 * D * 2; }
    __device__ const char* b_ptr(const Unit& u) const { return B + (size_t)u.pn * 256 * D * 2; }
};
struct SchedAB {
    pg8::OrderBase ob; int pm0, wfix; const char* A0; const char* A1; const char* B0; const char* B1;
    __device__ bool next(int i, Unit& u) const { const bool ok = wfix < 0 ? ob.nextb(i >> 1, u) : ob.nextb(i, u); u.pm += pm0; u.w = wfix < 0 ? (i & 1) : wfix; return ok; }
    __device__ const char* a_ptr(const Unit& u) const { return (u.w ? A1 : A0) + (size_t)u.pm * 256 * D * 2; }
    __device__ const char* b_ptr(const Unit& u) const { return (u.w ? B1 : B0) + (size_t)u.pn * 256 * D * 2; }
};
struct SchedO {
    pg8::OrderBase ob; int pm0; const char* A; const char* B;
    __device__ bool next(int i, Unit& u) const { const bool ok = ob.nextb(i, u); u.pm += pm0; return ok; }
    __device__ const char* a_ptr(const Unit& u) const { return A + (size_t)u.pm * 256 * D * 2; }
    __device__ const char* b_ptr(const Unit& u) const { return B + (size_t)u.pn * 256 * D * 2; }
};

struct EpiIn {
    static constexpr bool PERM = true;
    bf16_t* P; bf16_t* gex; float* out; int seg;
    __device__ __forceinline__ void operator()(const f32x4 (&acc)[2][2][4][2], const Unit& u, int wr, int wc, int fr, int fq) const {
        const int lr0 = u.pm * 256 + wr * 64 + fr;
        const int c0 = u.pn * 256 + wc * 32 + 8 * fq;
#pragma unroll
        for (int ai = 0; ai < 2; ++ai)
#pragma unroll
            for (int m = 0; m < 4; ++m) {
                const int lr = lr0 + ai * 128 + m * 16;
                bf16_t* rowp;
                if (u.pn < NT_PB) rowp = P + (size_t)lr * NPB + c0;
                else if (lr < LEX0) { const int b = lr / SEGTOK; const size_t grow = (size_t)b * SEQ + seg * SEGTOK + (lr % SEGTOK); rowp = (bf16_t*)(out + O_YP + grow * D) + (c0 - NPB); }
                else rowp = gex + (size_t)(lr - LEX0) * 2048 + (c0 - NPB);
#pragma unroll
                for (int bj = 0; bj < 2; ++bj) { const f32x4 v0 = acc[ai][bj][m][0], v1 = acc[ai][bj][m][1];
                    u32x4 w; w.x = cvt_pk_bf16(v0[0], v0[1]); w.y = cvt_pk_bf16(v0[2], v0[3]); w.z = cvt_pk_bf16(v1[0], v1[1]); w.w = cvt_pk_bf16(v1[2], v1[3]);
                    *(u32x4*)(rowp + bj * 128) = w; }
            }
    }
};
struct EpiAB {
    static constexpr bool PERM = true;
    bf16_t* tmp; bf16_t* merged; const bf16_t* gex; const float* out;
    __device__ __forceinline__ void operator()(const f32x4 (&acc)[2][2][4][2], const Unit& u, int wr, int wc, int fr, int fq) const {
        const int row0 = u.pm * 256 + wr * 64 + fr, col0 = u.pn * 256 + wc * 32 + 8 * fq;
#pragma unroll
        for (int ai = 0; ai < 2; ++ai)
#pragma unroll
            for (int m = 0; m < 4; ++m) {
                const int grow = row0 + ai * 128 + m * 16;
                const bf16_t* gp = (grow < XROWS) ? ((const bf16_t*)(out + O_YP + (size_t)grow * D) + u.w * D) : (gex + (size_t)(grow - XROWS) * 2048 + u.w * D);
#pragma unroll
                for (int bj = 0; bj < 2; ++bj) {
                    const int c = col0 + bj * 128;
                    float g[8]; unpack8(*(const u32x4*)(gp + c), g);
                    const f32x4 v0 = acc[ai][bj][m][0], v1 = acc[ai][bj][m][1];
                    float v[8] = {v0[0] * sigm(g[0]), v0[1] * sigm(g[1]), v0[2] * sigm(g[2]), v0[3] * sigm(g[3]), v1[0] * sigm(g[4]), v1[1] * sigm(g[5]), v1[2] * sigm(g[6]), v1[3] * sigm(g[7])};
                    bf16_t* tp = tmp + (size_t)grow * D + c;
                    if (u.w == 0) *(u32x4*)tp = pack8(v);
                    else { float t[8]; unpack8(*(const u32x4*)tp, t);
#pragma unroll
                        for (int e = 0; e < 8; ++e) v[e] += t[e];
                        *(u32x4*)(merged + (size_t)grow * D + c) = pack8(v); }
                }
            }
    }
};
struct EpiO {
    static constexpr bool PERM = false;
    float* out; const float* xp; const float* xs;
    __device__ __forceinline__ void operator()(const f32x4 (&acc)[2][2][4][2], const Unit& u, int wr, int wc, int fr, int fq) const {
        const int row0 = u.pm * 256 + wr * 64 + fr, col0 = u.pn * 256 + wc * 32 + 4 * fq;
#pragma unroll
        for (int ai = 0; ai < 2; ++ai)
#pragma unroll
            for (int m = 0; m < 4; ++m) {
                const int grow = row0 + ai * 128 + m * 16;
                const float* xr; float* yr;
                if (grow < XROWS) { xr = xp + (size_t)grow * D; yr = out + O_YP + (size_t)grow * D; }
                else { const int e = grow - XROWS; if (e < EX_SAMP || e >= EX_SHIFT) continue; xr = xs + (size_t)(e - EX_SAMP) * D; yr = out + O_YS + (size_t)(e - EX_SAMP) * D; }
#pragma unroll
                for (int bj = 0; bj < 2; ++bj)
#pragma unroll
                    for (int n = 0; n < 2; ++n) { const int c = col0 + bj * 128 + n * 16; *(f32x4*)(yr + c) = *(const f32x4*)(xr + c) + acc[ai][bj][m][n]; }
            }
    }
};

__device__ __forceinline__ void p0_row(const Params& p, int r, int lane) {
    bf16_t* hrow = (bf16_t*)(p.ws + WS_H) + (size_t)r * D;
    const float* src = nullptr; bool norm = true; float* sh = nullptr;
    if (r < XROWS) { src = p.in[0] + (size_t)r * D; if ((r & (SEQ - 1)) == SEQ - 1) sh = p.out + O_SHIFT_P + (size_t)(r / SEQ) * D; }
    else { const int e = r - XROWS;
        if (e < EX_SAMP) src = p.in[6] + (size_t)e * D;
        else if (e < EX_SHIFT) { src = p.in[1] + (size_t)(e - EX_SAMP) * D; if (((e - EX_SAMP) & 3) == 3) sh = p.out + O_SHIFT_S + (size_t)((e - EX_SAMP) >> 2) * D; }
        else if (e < EX_END) { src = p.in[5] + (size_t)(e - EX_SHIFT) * D; norm = false; } }
    u32x2* o8 = (u32x2*)hrow + lane;
    if (!src) {
#pragma unroll
        for (int j = 0; j < 4; ++j) o8[64 * j] = (u32x2){0u, 0u};
        return; }
    const f32x4* xr = (const f32x4*)src + lane;
    f32x4 v[4]; float ss = 0.f;
#pragma unroll
    for (int j = 0; j < 4; ++j) { v[j] = xr[64 * j]; ss += v[j][0] * v[j][0] + v[j][1] * v[j][1] + v[j][2] * v[j][2] + v[j][3] * v[j][3]; }
    if (norm) {
        const float rs = __builtin_amdgcn_rsqf(wave_sum(ss) * (1.f / D) + 1e-6f);
        const f32x4* wr = (const f32x4*)p.in[7] + lane;
#pragma unroll
        for (int j = 0; j < 4; ++j) v[j] = v[j] * rs * wr[64 * j];
    }
#pragma unroll
    for (int j = 0; j < 4; ++j) { o8[64 * j] = (u32x2){pk2(v[j][0], v[j][1]), pk2(v[j][2], v[j][3])}; if (sh) ((f32x4*)sh)[lane + 64 * j] = v[j]; }
}
template <int MODE> __device__ __forceinline__ void p0_tr_item(const float* W, int N, bf16_t* WT, float* scr, int kb, int nb, int lane) {
    const int k0 = 64 * kb, n0 = 32 * nb;
    const int l8 = lane & 7, r8 = lane >> 3;
    const int nn = n0 + 4 * l8;
    int srcc = nn;
    if (MODE == 1) srcc = nn < C_GATE_REF ? nn : (nn < NPB ? -1 : nn - (NPB - C_GATE_REF));
    f32x4 v[8];
#pragma unroll
    for (int i = 0; i < 8; ++i) { const int kk = 8 * i + r8; v[i] = srcc >= 0 ? *(const f32x4*)(W + (size_t)(k0 + kk) * N + srcc) : (f32x4){0.f, 0.f, 0.f, 0.f}; }
#pragma unroll
    for (int i = 0; i < 8; ++i) { const int kk = 8 * i + r8; float* d = scr + kk * 33 + 4 * l8; d[0] = v[i][0]; d[1] = v[i][1]; d[2] = v[i][2]; d[3] = v[i][3]; }
    asm volatile("s_waitcnt lgkmcnt(0)" ::: "memory");
    const int c = lane & 7;
#pragma unroll
    for (int j = 0; j < 4; ++j) { const int n = (lane >> 3) + 8 * j; const float* s = scr + (8 * c) * 33 + n;
        u32x4 o; o.x = pk2(s[0 * 33], s[1 * 33]); o.y = pk2(s[2 * 33], s[3 * 33]); o.z = pk2(s[4 * 33], s[5 * 33]); o.w = pk2(s[6 * 33], s[7 * 33]);
        *(u32x4*)(WT + (size_t)(n0 + n) * D + k0 + 8 * c) = o; }
    asm volatile("s_waitcnt lgkmcnt(0)" ::: "memory");
}
__device__ __forceinline__ void h_rows_pair(const Params& p, int r, int r1, bool has1, int lane, const f32x4 (&wv)[4]) {
    const f32x4* x0 = (const f32x4*)(p.in[0] + (size_t)r * D) + lane; const f32x4* x1 = (const f32x4*)(p.in[0] + (size_t)(has1 ? r1 : r) * D) + lane;
    f32x4 a[4], b[4]; float s0 = 0.f, s1 = 0.f;
#pragma unroll
    for (int j = 0; j < 4; ++j) { a[j] = x0[64 * j]; b[j] = x1[64 * j]; }
#pragma unroll
    for (int j = 0; j < 4; ++j) { s0 += a[j][0] * a[j][0] + a[j][1] * a[j][1] + a[j][2] * a[j][2] + a[j][3] * a[j][3]; s1 += b[j][0] * b[j][0] + b[j][1] * b[j][1] + b[j][2] * b[j][2] + b[j][3] * b[j][3]; }
    const float q0 = __builtin_amdgcn_rsqf(wave_sum(s0) * (1.f / D) + 1e-6f), q1 = __builtin_amdgcn_rsqf(wave_sum(s1) * (1.f / D) + 1e-6f);
    u32x2* o0 = (u32x2*)((bf16_t*)(p.ws + WS_H) + (size_t)r * D) + lane; u32x2* o1 = (u32x2*)((bf16_t*)(p.ws + WS_H) + (size_t)r1 * D) + lane;
#pragma unroll
    for (int j = 0; j < 4; ++j) { a[j] = a[j] * q0 * wv[j]; o0[64 * j] = (u32x2){pk2(a[j][0], a[j][1]), pk2(a[j][2], a[j][3])}; }
    if ((r & (SEQ - 1)) == SEQ - 1) { f32x4* sh = (f32x4*)(p.out + O_SHIFT_P + (size_t)(r / SEQ) * D) + lane;
#pragma unroll
        for (int j = 0; j < 4; ++j) sh[64 * j] = a[j]; }
    if (has1) {
#pragma unroll
        for (int j = 0; j < 4; ++j) { b[j] = b[j] * q1 * wv[j]; o1[64 * j] = (u32x2){pk2(b[j][0], b[j][1]), pk2(b[j][2], b[j][3])}; }
        if ((r1 & (SEQ - 1)) == SEQ - 1) { f32x4* sh = (f32x4*)(p.out + O_SHIFT_P + (size_t)(r1 / SEQ) * D) + lane;
#pragma unroll
            for (int j = 0; j < 4; ++j) sh[64 * j] = b[j]; }
    }
}
__device__ __forceinline__ void h_rows_segs(const Params& p, int s_lo, int s_hi, int wi, int nw, int lane) {
    const f32x4* lw = (const f32x4*)p.in[7] + lane;
    f32x4 wv[4];
#pragma unroll
    for (int j = 0; j < 4; ++j) wv[j] = lw[64 * j];
    const int n = (s_hi - s_lo) * NBATCH * SEGTOK;
#pragma unroll 1
    for (int x = wi; x < n; x += 2 * nw) {
        const int x1 = x + nw; const bool has1 = x1 < n;
        const int sg = s_lo + x / (NBATCH * SEGTOK), rem = x % (NBATCH * SEGTOK), r = (rem / SEGTOK) * SEQ + sg * SEGTOK + (rem % SEGTOK);
        const int xx = has1 ? x1 : x; const int sg1 = s_lo + xx / (NBATCH * SEGTOK), rem1 = xx % (NBATCH * SEGTOK), r1 = (rem1 / SEGTOK) * SEQ + sg1 * SEGTOK + (rem1 % SEGTOK);
        h_rows_pair(p, r, r1, has1, lane, wv);
    }
}
__device__ __forceinline__ void phase0(const Params& p, unsigned char* smem) {
    const int tid0 = otid(), wave = tid0 >> 6, lane = tid0 & 63;
    const int gw = obid() * 8 + wave, NGW = gridDim.x * 8;
    float* scr = (float*)smem + wave * (64 * 33);
    constexpr int I_IN = 16 * (NP / 32), I_SQ = 16 * 32;
    for (int it = gw; it < I_IN + 3 * I_SQ; it += NGW) {
        int r = it;
        if (r < I_IN) { p0_tr_item<1>(p.in[8], 10384, (bf16_t*)(p.ws + WS_WT_IN), scr, r / (NP / 32), r % (NP / 32), lane); continue; } r -= I_IN;
        if (r < I_SQ) { p0_tr_item<0>(p.in[13], D, (bf16_t*)(p.ws + WS_WT_A), scr, r / 32, r % 32, lane); continue; } r -= I_SQ;
        if (r < I_SQ) { p0_tr_item<0>(p.in[24], D, (bf16_t*)(p.ws + WS_WT_B), scr, r / 32, r % 32, lane); continue; } r -= I_SQ;
        p0_tr_item<0>(p.in[25], D, (bf16_t*)(p.ws + WS_WT_O), scr, r / 32, r % 32, lane);
    }
    h_rows_segs(p, 0, 2, gw, NGW, lane);
    for (int r = XROWS + gw; r < HROWS; r += NGW) p0_row(p, r, lane);
    {
        float* pk = (float*)(p.ws + WS_PK);
        const int gt = obid() * 512 + tid0, NT = gridDim.x * 512;
        for (int i = gt; i < PK_END; i += NT) {
            const float* src; int o;
            if (i < PK_ALOG) { src = p.in[9]; o = i - PK_CONVW; } else if (i < PK_DTB) { src = p.in[10]; o = i - PK_ALOG; } else if (i < PK_NORMW) { src = p.in[11]; o = i - PK_DTB; }
            else if (i < PK_MU) { src = p.in[12]; o = i - PK_NORMW; } else if (i < PK_W0) { src = p.in[14]; o = i - PK_MU; } else if (i < PK_W2) { src = p.in[15]; o = i - PK_W0; }
            else if (i < PK_A0) { src = p.in[16]; o = i - PK_W2; } else if (i < PK_A2) { src = p.in[17]; o = i - PK_A0; } else if (i < PK_KK) { src = p.in[18]; o = i - PK_A2; }
            else if (i < PK_KA) { src = p.in[19]; o = i - PK_KK; } else if (i < PK_RK) { src = p.in[20]; o = i - PK_KA; } else if (i < PK_GNW) { src = p.in[21]; o = i - PK_RK; }
            else if (i < PK_GNB) { src = p.in[22]; o = i - PK_GNW; } else if (i < PK_LNF) { src = p.in[23]; o = i - PK_GNB; } else { src = p.in[26]; o = i - PK_LNF; }
            pk[i] = src[o];
        }
        bf16_t* w2t = (bf16_t*)(p.ws + WS_W2T); bf16_t* a2t = (bf16_t*)(p.ws + WS_A2T);
        for (int i = gt; i < 65536; i += NT) { const int l = i & 63, c = (i >> 6) & 63, hb = i >> 12;
            w2t[i] = (bf16_t)f2bf(p.in[16][(size_t)l * D + hb * 64 + c]); a2t[i] = (bf16_t)f2bf(p.in[18][(size_t)l * D + hb * 64 + c]); }
    }
}

__device__ __forceinline__ void gdn_item(const Params& p, unsigned char* smem, const float* s_in, float* s_out, const float* halo_in, float* halo_out,
                                         int h, int sl, int rowA, int nA, int rowB, int nB) {
    const int tid = otid(), w = tid >> 6, lane = tid & 63, vl = lane >> 4, kg = lane & 15;
    float* qk_s = (float*)smem; float* v_s = qk_s + 16384; float* o_s = v_s + 2048; float* gb_s = o_s + 2048; float* sst = gb_s + 128;
    const bf16_t* P = (const bf16_t*)(p.ws + WS_P);
    float* ORAW = (float*)(p.ws + WS_ORAW);
    float s[8];
    if (s_in) {
        { const int k = tid >> 2, q4 = tid & 3; const f32x4* src = (const f32x4*)(s_in + (size_t)k * 128 + sl * 32 + q4 * 8); const f32x4 a = src[0], b = src[1];
          float* d = sst + k * 33 + q4 * 8; d[0] = a[0]; d[1] = a[1]; d[2] = a[2]; d[3] = a[3]; d[4] = b[0]; d[5] = b[1]; d[6] = b[2]; d[7] = b[3]; }
        __syncthreads();
#pragma unroll
        for (int j = 0; j < 8; ++j) s[j] = sst[(kg * 8 + j) * 33 + 4 * w + vl];
        __syncthreads();
    } else {
#pragma unroll
        for (int j = 0; j < 8; ++j) s[j] = 0.f;
    }
    int pcol = -1;
    if (tid < 128) pcol = h * 128 + tid; else if (tid < 256) pcol = 1024 + h * 128 + (tid - 128); else if (tid < 288) pcol = 2048 + h * 128 + sl * 32 + (tid - 256);
    float cw0 = 0.f, cw1 = 0.f, cw2 = 0.f, cw3 = 0.f, x1 = 0.f, x2 = 0.f, x3 = 0.f;
    const float* pk = (const float*)(p.ws + WS_PK);
    if (pcol >= 0) { const float* cw = pk + PK_CONVW; cw0 = cw[pcol]; cw1 = cw[3072 + pcol]; cw2 = cw[6144 + pcol]; cw3 = cw[9216 + pcol];
        if (halo_in) { x3 = halo_in[pcol]; x2 = halo_in[3072 + pcol]; x1 = halo_in[6144 + pcol]; } }
    const float nalog = -expf(pk[PK_ALOG + h]), dtb = pk[PK_DTB + h];
#pragma unroll 1
    for (int run = 0; run < 2; ++run) {
        const int rrow = run ? rowB : rowA, rn = run ? nB : nA; const bool wout = run != 0;
#pragma unroll 1
        for (int c0 = 0; c0 < rn; c0 += 64) {
            const int nt = (rn - c0) < 64 ? (rn - c0) : 64; const int row = rrow + c0;
            if (pcol >= 0) {
                const bf16_t* src = P + (size_t)row * NPB + pcol;
                float* dst = tid < 256 ? (qk_s + tid) : (v_s + (tid - 256)); const int dstride = tid < 256 ? 256 : 32;
#pragma unroll 8
                for (int i = 0; i < nt; ++i) { const float x0 = bf2f(src[(size_t)i * NPB]); const float y = cw0 * x3 + cw1 * x2 + cw2 * x1 + cw3 * x0; x3 = x2; x2 = x1; x1 = x0; dst[i * dstride] = silu_(y); }
            } else if (tid < 352) {
                const int i = tid - 288;
                if (i < nt) { const float pa = bf2f(P[(size_t)(row + i) * NPB + C_A + h]), pb = bf2f(P[(size_t)(row + i) * NPB + C_B + h]);
                    gb_s[2 * i] = expf(nalog * softplus_(pa + dtb)); gb_s[2 * i + 1] = sigm(pb); }
            }
            __syncthreads();
#pragma unroll 1
            for (int ii = 0; ii < 8; ++ii) { const int i = w * 8 + ii;
                if (i < nt) {
#pragma unroll
                    for (int which = 0; which < 2; ++which) { float* rp = qk_s + i * 256 + which * 128; const float a = rp[lane], b = rp[lane + 64];
                        const float sc = __builtin_amdgcn_rsqf(wave_sum(a * a + b * b) + 1e-6f) * (which == 0 ? 0.08838834764831845f : 1.f); rp[lane] = a * sc; rp[lane + 64] = b * sc; } } }
            __syncthreads();
#pragma unroll 1
            for (int i = 0; i < nt; ++i) {
                const f32x4 q0 = *(const f32x4*)(qk_s + i * 256 + kg * 8), q1 = *(const f32x4*)(qk_s + i * 256 + kg * 8 + 4);
                const f32x4 k0 = *(const f32x4*)(qk_s + i * 256 + 128 + kg * 8), k1 = *(const f32x4*)(qk_s + i * 256 + 128 + kg * 8 + 4);
                const float vv = v_s[i * 32 + 4 * w + vl], a = gb_s[2 * i], be = gb_s[2 * i + 1];
                float part = k0[0] * s[0] + k0[1] * s[1] + k0[2] * s[2] + k0[3] * s[3] + k1[0] * s[4] + k1[1] * s[5] + k1[2] * s[6] + k1[3] * s[7];
                const float kS = rowsum16(part);
                const float c = be * (vv - a * kS);
                s[0] = a * s[0] + k0[0] * c; s[1] = a * s[1] + k0[1] * c; s[2] = a * s[2] + k0[2] * c; s[3] = a * s[3] + k0[3] * c;
                s[4] = a * s[4] + k1[0] * c; s[5] = a * s[5] + k1[1] * c; s[6] = a * s[6] + k1[2] * c; s[7] = a * s[7] + k1[3] * c;
                float op = q0[0] * s[0] + q0[1] * s[1] + q0[2] * s[2] + q0[3] * s[3] + q1[0] * s[4] + q1[1] * s[5] + q1[2] * s[6] + q1[3] * s[7];
                const float o = rowsum16(op);
                if (kg == 0) o_s[i * 32 + 4 * w + vl] = o;
            }
            __syncthreads();
            if (wout) { const int i = tid >> 3, c4 = (tid & 7) * 4; if (i < nt) *(f32x4*)(ORAW + (size_t)(row + i) * D + h * 128 + sl * 32 + c4) = *(const f32x4*)(o_s + i * 32 + c4); }
        }
    }
    if (pcol >= 0 && (sl == 0 || tid >= 256)) { halo_out[pcol] = x3; halo_out[3072 + pcol] = x2; halo_out[6144 + pcol] = x1; }
#pragma unroll
    for (int j = 0; j < 8; ++j) sst[(kg * 8 + j) * 33 + 4 * w + vl] = s[j];
    __syncthreads();
    { const int k = tid >> 2, q4 = tid & 3; const float* d = sst + k * 33 + q4 * 8; f32x4* dst = (f32x4*)(s_out + (size_t)k * 128 + sl * 32 + q4 * 8);
      dst[0] = (f32x4){d[0], d[1], d[2], d[3]}; dst[1] = (f32x4){d[4], d[5], d[6], d[7]}; }
    __syncthreads();
}

constexpr int RW_W2 = 20544, RW_A2 = 24640;
__device__ __forceinline__ void rwkv_load_lora(const Params& p, unsigned char* smem, int hb) {
    float* w2_s = (float*)smem + RW_W2; float* a2_s = (float*)smem + RW_A2; const float* pk = (const float*)(p.ws + WS_PK);
    for (int i = otid(); i < 4096; i += 512) { const int l = i >> 6, c = i & 63; w2_s[i] = pk[PK_W2 + l * D + hb * 64 + c]; a2_s[i] = pk[PK_A2 + l * D + hb * 64 + c]; }
    __syncthreads();
}
__device__ __forceinline__ void rwkv_item(const Params& p, unsigned char* smem, const float* s_in, float* s_out, const bf16_t* prev_row, const float* halo_in, float* halo_out,
                                          int hb, int half, int rowA, int nA, int rowB, int nB) {
    const int tid = otid(), w = tid >> 6, lane = tid & 63, row = tid >> 4, kq = tid & 15;
    float* f = (float*)smem;
    float* r_s = f; float* kb_s = f + 2048; float* v_s = f + 4096; float* wd_s = f + 6144; float* ad_s = f + 8192; float* dec_s = f + 10240; float* a_s = f + 12288;
    float* kk_s = f + 14336; float* km_s = f + 16384; float* zb_s = f + 18432; float* y_s = f + 19456; float* bonus_s = f + 20480;
    const float* w2_s = f + RW_W2; const float* a2_s = f + RW_A2;
    const bf16_t* P = (const bf16_t*)(p.ws + WS_P);
    float* YRAW = (float*)(p.ws + WS_YRAW); bf16_t* C0 = (bf16_t*)(p.ws + WS_C0); bf16_t* C1 = (bf16_t*)(p.ws + WS_C1);
    float s[4];
    if (s_in) { const f32x4 t = *(const f32x4*)(s_in + (size_t)(half * 32 + row) * 64 + kq * 4); s[0] = t[0]; s[1] = t[1]; s[2] = t[2]; s[3] = t[3]; }
    else { s[0] = s[1] = s[2] = s[3] = 0.f; }
    int col = -1; float* dst = nullptr; int dstride = 64; bool is_wd = false, owner = false;
    if (tid < 64) { col = hb * 64 + tid; dst = r_s + tid; owner = half == 0; }
    else if (tid < 128) { col = 1024 + hb * 64 + (tid - 64); dst = kb_s + (tid - 64); owner = half == 0; }
    else if (tid < 192) { col = 2048 + hb * 64 + (tid - 128); dst = v_s + (tid - 128); owner = half == 0; }
    else if (tid < 256) { col = 3072 + (tid - 192); dst = wd_s + (tid - 192); is_wd = true; owner = (half == 0 && hb == 0); }
    else if (tid < 320) { col = 3136 + (tid - 256); dst = ad_s + (tid - 256); owner = (half == 0 && hb == 0); }
    else if (tid < 352) { col = 3200 + hb * 64 + half * 32 + (tid - 320); dst = zb_s + (tid - 320); dstride = 32; owner = true; }
    float mu = 0.f, prev = 0.f;
    const float* pk = (const float*)(p.ws + WS_PK);
    if (col >= 0) { mu = pk[PK_MU + col]; prev = prev_row ? bf2f(prev_row[C_RW + col]) : (halo_in ? halo_in[col] : 0.f); }
    const int cc = tid & 63, ig = tid >> 6;
    const int hc = hb * 64 + cc;
    const float w0c = pk[PK_W0 + hc], a0c = pk[PK_A0 + hc], kkc = pk[PK_KK + hc], kac = pk[PK_KA + hc];
    const float rkl = pk[PK_RK + hb * 64 + lane];
#pragma unroll 1
    for (int run = 0; run < 2; ++run) {
        const int rrow = run ? rowB : rowA, rn = run ? nB : nA; const bool wout = run != 0;
#pragma unroll 1
        for (int c0 = 0; c0 < rn; c0 += 32) {
            const int nt = (rn - c0) < 32 ? (rn - c0) : 32; const int row0 = rrow + c0;
            if (col >= 0) {
                const bf16_t* src = P + (size_t)row0 * NPB + C_RW + col;
#pragma unroll 8
                for (int i = 0; i < nt; ++i) { const float cur = bf2f(src[(size_t)i * NPB]); float m = cur + mu * (prev - cur); prev = cur; if (is_wd) m = tanh_(m); dst[i * dstride] = m; }
            }
            __syncthreads();
            {
                float aw[4] = {0.f, 0.f, 0.f, 0.f}, aa[4] = {0.f, 0.f, 0.f, 0.f};
#pragma unroll 4
                for (int l = 0; l < 64; ++l) { const float w2v = w2_s[l * 64 + cc], a2v = a2_s[l * 64 + cc];
#pragma unroll
                    for (int ii = 0; ii < 4; ++ii) { aw[ii] += wd_s[(ig * 4 + ii) * 64 + l] * w2v; aa[ii] += ad_s[(ig * 4 + ii) * 64 + l] * a2v; } }
#pragma unroll
                for (int ii = 0; ii < 4; ++ii) { const int i = ig * 4 + ii;
                    if (i < nt) { const float wraw = w0c + aw[ii]; const float wlog = -0.6065306597126334f * sigm(wraw); const float a = sigm(a0c + aa[ii]);
                        const float kbv = kb_s[i * 64 + cc];
                        dec_s[i * 64 + cc] = expf(wlog); a_s[i * 64 + cc] = a; kk_s[i * 64 + cc] = kbv * kkc; km_s[i * 64 + cc] = kbv * (1.f + (a - 1.f) * kac); } }
            }
            __syncthreads();
#pragma unroll 1
            for (int ii = 0; ii < 4; ++ii) { const int i = w * 4 + ii;
                if (i < nt) { const float kkr = kk_s[i * 64 + lane]; const float kk = kkr * __builtin_amdgcn_rsqf(wave_sum(kkr * kkr) + 1e-6f); kk_s[i * 64 + lane] = kk;
                    const float a = a_s[i * 64 + lane]; a_s[i * 64 + lane] = kk * a;
                    const float rk = wave_sum(r_s[i * 64 + lane] * km_s[i * 64 + lane] * rkl); if (lane == 0) bonus_s[i] = rk; } }
            __syncthreads();
#pragma unroll 1
            for (int i = 0; i < nt; ++i) {
                const f32x4 kk4 = *(const f32x4*)(kk_s + i * 64 + kq * 4), de4 = *(const f32x4*)(dec_s + i * 64 + kq * 4), ka4 = *(const f32x4*)(a_s + i * 64 + kq * 4),
                            km4 = *(const f32x4*)(km_s + i * 64 + kq * 4), r4 = *(const f32x4*)(r_s + i * 64 + kq * 4);
                const float vv = v_s[i * 64 + half * 32 + row];
                const float sa = rowsum16(s[0] * kk4[0] + s[1] * kk4[1] + s[2] * kk4[2] + s[3] * kk4[3]);
#pragma unroll
                for (int j = 0; j < 4; ++j) s[j] = s[j] * de4[j] + (vv * km4[j] - sa * ka4[j]);
                const float y = rowsum16(s[0] * r4[0] + s[1] * r4[1] + s[2] * r4[2] + s[3] * r4[3]);
                if (kq == 0) y_s[i * 32 + row] = y;
            }
            __syncthreads();
            if (wout) { const int i = tid >> 4;
                if (i < nt) {
#pragma unroll
                    for (int q = 0; q < 2; ++q) { const int rr = (tid & 15) * 2 + q, v = half * 32 + rr, colo = hb * 64 + v;
                        const float sz = silu_(zb_s[i * 32 + rr]);
                        const size_t o = (size_t)(row0 + i) * D + colo;
                        YRAW[o] = y_s[i * 32 + rr]; C1[o] = (bf16_t)f2bf(pk[PK_GNW + colo] * sz); C0[o] = (bf16_t)f2bf((pk[PK_GNB + colo] + bonus_s[i] * v_s[i * 64 + v]) * sz); } } }
            __syncthreads();
        }
    }
    *(f32x4*)(s_out + (size_t)(half * 32 + row) * 64 + kq * 4) = (f32x4){s[0], s[1], s[2], s[3]};
    if (col >= 0 && owner && halo_out) halo_out[col] = prev;
}


__device__ __forceinline__ bf16x8 ldfrag(const bf16_t* base, int stride, int r0, int k0, int lane) {
    return *(const bf16x8*)(base + (r0 + (lane & 15)) * stride + k0 + 8 * (lane >> 4));
}
#define MFMA16(a, b, c) __builtin_amdgcn_mfma_f32_16x16x32_bf16((a), (b), (c), 0, 0, 0)
typedef short s16x4 __attribute__((ext_vector_type(4)));
__device__ __forceinline__ bf16x8 ldfrag_tr(const bf16_t* X, int stride, int c0, int k0, int lane) {
    const int l15 = lane & 15;
    const bf16_t* a = X + (k0 + 8 * (lane >> 4) + (l15 >> 2)) * stride + c0 + 4 * (l15 & 3);
    const s16x4 lo = __builtin_amdgcn_ds_read_tr16_b64_v4i16((LAS s16x4*)a), hi = __builtin_amdgcn_ds_read_tr16_b64_v4i16((LAS s16x4*)(a + 4 * stride));
    return __builtin_shufflevector(lo, hi, 0, 1, 2, 3, 4, 5, 6, 7);
}
__device__ __forceinline__ void inv_block(const float* L, float* Tm, float* XS, int tid) {
    const int w = tid >> 6, lane = tid & 63;
    typedef float f32x2v __attribute__((ext_vector_type(2)));
    if (w < 4 && lane < 16) {
        const float* Lb = L + (16 * w) * 64 + 16 * w; float* Tb = Tm + (16 * w) * 64 + 16 * w;
        float tr[16];
#pragma unroll
        for (int i = 0; i < 16; ++i) tr[i] = 0.f;
#pragma unroll
        for (int i = 0; i < 16; ++i) { float a = (lane == i) ? 1.f : 0.f;
#pragma unroll
            for (int j0 = 0; j0 < i; j0 += 4) { const f32x4 l4 = *(const f32x4*)(Lb + i * 64 + j0);
                a -= l4[0] * tr[j0] + l4[1] * tr[j0 + 1] + l4[2] * tr[j0 + 2] + l4[3] * tr[j0 + 3]; }
            tr[i] = a; Tb[i * 64 + lane] = a; }
    }
    for (int e = tid; e < 1536; e += 512) { const int k = e >> 8, r = (e >> 4) & 15, c = e & 15;
        const int rb = k < 3 ? 0 : (k < 5 ? 1 : 2), cb = k < 3 ? k + 1 : (k < 5 ? k - 1 : 3);
        Tm[(16 * rb + r) * 64 + 16 * cb + c] = 0.f; }
    __syncthreads();
    {
        const int B = tid >> 8, i = (tid >> 4) & 15, c = tid & 15, o = 32 * B;
        float x = 0.f;
#pragma unroll
        for (int j0 = 0; j0 < 16; j0 += 4) { const f32x4 l4 = *(const f32x4*)(L + (o + 16 + i) * 64 + o + j0);
            x += l4[0] * Tm[(o + j0) * 64 + o + c] + l4[1] * Tm[(o + j0 + 1) * 64 + o + c] + l4[2] * Tm[(o + j0 + 2) * 64 + o + c] + l4[3] * Tm[(o + j0 + 3) * 64 + o + c]; }
        XS[tid] = x;
        __syncthreads();
        float t = 0.f;
#pragma unroll
        for (int j0 = 0; j0 < 16; j0 += 4) { const f32x4 t4 = *(const f32x4*)(Tm + (o + 16 + i) * 64 + o + 16 + j0);
            t += t4[0] * XS[(B << 8) + j0 * 16 + c] + t4[1] * XS[(B << 8) + (j0 + 1) * 16 + c] + t4[2] * XS[(B << 8) + (j0 + 2) * 16 + c] + t4[3] * XS[(B << 8) + (j0 + 3) * 16 + c]; }
        Tm[(o + 16 + i) * 64 + o + c] = -t;
    }
    __syncthreads();
    {
        const int i = tid >> 4, c2 = (tid & 15) * 2;
        float x0 = 0.f, x1 = 0.f;
#pragma unroll
        for (int j0 = 0; j0 < 32; j0 += 4) { const f32x4 l4 = *(const f32x4*)(L + (32 + i) * 64 + j0);
#pragma unroll
            for (int e = 0; e < 4; ++e) { const f32x2v tv = *(const f32x2v*)(Tm + (j0 + e) * 64 + c2); x0 += l4[e] * tv[0]; x1 += l4[e] * tv[1]; } }
        *(f32x2v*)(XS + i * 32 + c2) = (f32x2v){x0, x1};
        __syncthreads();
        float t0 = 0.f, t1 = 0.f;
#pragma unroll
        for (int j0 = 0; j0 < 32; j0 += 4) { const f32x4 t4 = *(const f32x4*)(Tm + (32 + i) * 64 + 32 + j0);
#pragma unroll
            for (int e = 0; e < 4; ++e) { const f32x2v xv = *(const f32x2v*)(XS + (j0 + e) * 32 + c2); t0 += t4[e] * xv[0]; t1 += t4[e] * xv[1]; } }
        *(f32x2v*)(Tm + (32 + i) * 64 + c2) = (f32x2v){-t0, -t1};
    }
    __syncthreads();
}
constexpr int PL_QS = 0, PL_R1 = 17408, PL_KT = 35840, PL_KTT = 54272, PL_VT = 72704, PL_R3 = 91136, PL_QKM = 109568, PL_TP = 118784, PL_TPP = 128000, PL_SM = 137216, PL_TM = 139264, PL_XS = 155648;
constexpr int QSTR = 136, TSTR = 72;

__device__ __forceinline__ void gdn_prep_item(const Params& p, unsigned char* smem, int h, int row_start, int npad, const bf16_t* hbase,
                                              bf16_t* halo_out, float* conv_out, unsigned char* rec) {
    const int tid = otid(), w = tid >> 6, lane = tid & 63, q4 = lane >> 4, l15 = lane & 15;
    bf16_t* qs = (bf16_t*)(smem + PL_QS); bf16_t* ks = (bf16_t*)(smem + PL_R1); bf16_t* WT = (bf16_t*)(smem + PL_KTT);     bf16_t* kts = (bf16_t*)(smem + PL_KT);
    bf16_t* vs = (bf16_t*)(smem + PL_VT);         float* Lm = (float*)(smem + PL_R3); bf16_t* UT = (bf16_t*)(smem + PL_R3); bf16_t* QKm = (bf16_t*)(smem + PL_QKM);
    bf16_t* Tp = (bf16_t*)(smem + PL_TP); bf16_t* Tpp = (bf16_t*)(smem + PL_TPP);
    float* sm = (float*)(smem + PL_SM);
    float* gcs = sm; float* bes = sm + 64; float* ssq = sm + 128; float* ssk = sm + 192; float* egs = sm + 256; float* egl_s = sm + 320; float* beg = sm + 384;
    const bf16_t* P = (const bf16_t*)(p.ws + WS_P);
    const float* pk = (const float*)(p.ws + WS_PK);
    if (w == 7) {
        const int i = lane;
        float g = 0.f, be = 0.f;
        if (i >= npad) { const size_t r = (size_t)(row_start + i - npad) * NPB; const float pa = bf2f(P[r + C_A + h]), pb = bf2f(P[r + C_B + h]);
            g = -expf(pk[PK_ALOG + h]) * softplus_(pa + pk[PK_DTB + h]); be = sigm(pb); }
        float x = g;
#pragma unroll
        for (int o = 1; o < 64; o <<= 1) { const float y = __shfl_up(x, o); if (lane >= o) x += y; }
        const float gl = __shfl(x, 63);
        gcs[lane] = x; bes[lane] = be; egs[lane] = __expf(x); egl_s[lane] = __expf(gl - x); beg[lane] = be * __expf(x);
        if (lane == 0) *(float*)(rec + GP_EGL) = __expf(gl);
    }
    __syncthreads();
    if (npad == 0 && tid >= 384) {
#pragma unroll 1
        for (int k = 0; k < 4; ++k) {
            const int slot = (tid - 384) + 128 * k, t = slot >> 3, g = slot & 7;
            const bf16_t* zp = P + (size_t)(row_start + t) * NPB + C_Z + h * 128 + 16 * g;
            const u32x4 z0 = *(const u32x4*)zp, z1 = *(const u32x4*)(zp + 8);
            float za[8], zb[8]; unpack8(z0, za); unpack8(z1, zb);
            const float* nwp = pk + PK_NORMW + 16 * g;
            float ga[8], gb2[8];
#pragma unroll
            for (int e = 0; e < 8; ++e) { ga[e] = nwp[e] * silu_(za[e]); gb2[e] = nwp[8 + e] * silu_(zb[e]); }
            bf16_t* gp = (bf16_t*)(rec + GP_G) + t * 128 + 16 * g;
            *(u32x4*)gp = pack8(ga); *(u32x4*)(gp + 8) = pack8(gb2);
        }
    }
    if (tid < 384) {
        const int sec = tid >> 7, ts = (tid >> 4) & 7, t0 = 8 * ts, d0 = l15 * 8;
        const int pcol = sec * 1024 + h * 128 + d0;
        float cw[4][8];
#pragma unroll
        for (int j = 0; j < 4; ++j) { const f32x4 a = *(const f32x4*)(pk + PK_CONVW + j * 3072 + pcol), b = *(const f32x4*)(pk + PK_CONVW + j * 3072 + pcol + 4);
            cw[j][0] = a[0]; cw[j][1] = a[1]; cw[j][2] = a[2]; cw[j][3] = a[3]; cw[j][4] = b[0]; cw[j][5] = b[1]; cw[j][6] = b[2]; cw[j][7] = b[3]; }
        u32x4 rw[11]; float fv[11];
#pragma unroll
        for (int k = 0; k < 11; ++k) {
            const int ii = t0 - 3 + k;
            const bf16_t* ptr = P + pcol; float f = 0.f;
            if (ii >= npad) { ptr = P + (size_t)(row_start + ii - npad) * NPB + pcol; f = 1.f; }
            else if (ii < 0 && npad == 0 && hbase) { ptr = hbase + (size_t)(ii + 3) * NPB + pcol; f = 1.f; }
            rw[k] = *(const u32x4*)ptr; fv[k] = f;
        }
        if (halo_out && ts == 7) {
#pragma unroll
            for (int dd = 0; dd < 3; ++dd) { *(u32x4*)(halo_out + (size_t)dd * NPB + pcol) = rw[8 + dd];
                if (conv_out) { float x[8]; unpack8(rw[8 + dd], x); *(f32x4*)(conv_out + dd * 3072 + pcol) = (f32x4){x[0], x[1], x[2], x[3]}; *(f32x4*)(conv_out + dd * 3072 + pcol + 4) = (f32x4){x[4], x[5], x[6], x[7]}; } }
        }
        float y[8][8];
#pragma unroll
        for (int t = 0; t < 8; ++t)
#pragma unroll
            for (int e = 0; e < 8; ++e) y[t][e] = 0.f;
#pragma unroll
        for (int k = 0; k < 11; ++k) { float x[8]; unpack8(rw[k], x);
#pragma unroll
            for (int e = 0; e < 8; ++e) x[e] *= fv[k];
#pragma unroll
            for (int dlt = 0; dlt < 4; ++dlt) { const int t = k - dlt;
                if (t >= 0 && t < 8) {
#pragma unroll
                    for (int e = 0; e < 8; ++e) y[t][e] += cw[dlt][e] * x[e]; } }
        }
        const float qsc = sec == 0 ? 0.08838834764831845f : 1.f;
#pragma unroll
        for (int t = 0; t < 8; ++t) {
            const bool tokv = (t0 + t) >= npad;
            float ss = 0.f;
#pragma unroll
            for (int e = 0; e < 8; ++e) { y[t][e] = tokv ? silu_(y[t][e]) : 0.f; ss += y[t][e] * y[t][e]; }
            if (sec < 2) { const float sc = __builtin_amdgcn_rsqf(rowsum16(ss) + 1e-6f) * qsc;
#pragma unroll
                for (int e = 0; e < 8; ++e) y[t][e] *= sc; }
        }
        { bf16_t* dst = sec == 0 ? qs : (sec == 1 ? ks : vs);
#pragma unroll
            for (int t = 0; t < 8; ++t) *(u32x4*)(dst + (t0 + t) * QSTR + d0) = pack8(y[t]); }
        if (sec == 1) {
#pragma unroll
            for (int t = 0; t < 8; ++t) { const float eg = egl_s[t0 + t]; float z[8];
#pragma unroll
                for (int e = 0; e < 8; ++e) z[e] = y[t][e] * eg;
                *(u32x4*)(kts + (t0 + t) * QSTR + d0) = pack8(z); } }
    }
    __syncthreads();
    {
        const int which = w >> 2, it = w & 3;
        const bf16_t* Barr = which ? qs : ks;
        bf16x8 bfr[4];
#pragma unroll
        for (int kk = 0; kk < 4; ++kk) bfr[kk] = ldfrag(Barr, QSTR, 16 * it, 32 * kk, lane);
        const int i = 16 * it + l15; const float gi = gcs[i], bi = bes[i];
#pragma unroll
        for (int jt = 0; jt < 4; ++jt) {
            f32x4 acc = {0.f, 0.f, 0.f, 0.f};
#pragma unroll
            for (int kk = 0; kk < 4; ++kk) acc = MFMA16(ldfrag(ks, QSTR, 16 * jt, 32 * kk, lane), bfr[kk], acc);
            const int j0 = 16 * jt + 4 * q4; const f32x4 gj = *(const f32x4*)(gcs + j0);
            f32x4 o;
#pragma unroll
            for (int r = 0; r < 4; ++r) { const int j = j0 + r; const bool keep = which ? (i >= j) : (i > j); o[r] = keep ? acc[r] * __expf(gi - gj[r]) : 0.f; }
            if (which == 0) *(f32x4*)(Lm + i * 64 + j0) = o * bi;
            else *(u32x2*)(QKm + i * TSTR + j0) = (u32x2){pk2(o[0], o[1]), pk2(o[2], o[3])};
        }
    }
    __syncthreads();
    {
        float* Tm = (float*)(smem + PL_TM);
        inv_block(Lm, Tm, (float*)(smem + PL_XS), tid);
        const int i = tid >> 3, j0 = (tid & 7) * 8;
        float a[8], b2[8];
#pragma unroll
        for (int e = 0; e < 8; ++e) { const float tv = Tm[i * 64 + j0 + e]; a[e] = tv * beg[j0 + e]; b2[e] = tv * bes[j0 + e]; }
        *(u32x4*)(Tp + i * TSTR + j0) = (u32x4){pk2(a[0], a[1]), pk2(a[2], a[3]), pk2(a[4], a[5]), pk2(a[6], a[7])};
        *(u32x4*)(Tpp + i * TSTR + j0) = (u32x4){pk2(b2[0], b2[1]), pk2(b2[2], b2[3]), pk2(b2[4], b2[5]), pk2(b2[6], b2[7])};
    }
    __syncthreads();
    {
        const int it = w & 3, half = w >> 2;
        f32x4 aw[4], au[4];
#pragma unroll
        for (int x = 0; x < 4; ++x) { aw[x] = (f32x4){0.f, 0.f, 0.f, 0.f}; au[x] = (f32x4){0.f, 0.f, 0.f, 0.f}; }
#pragma unroll
        for (int kk = 0; kk < 2; ++kk) {
            const bf16x8 a1 = ldfrag(Tp, TSTR, 16 * it, 32 * kk, lane), a2 = ldfrag(Tpp, TSTR, 16 * it, 32 * kk, lane);
#pragma unroll
            for (int x = 0; x < 4; ++x) { const int dt = half * 4 + x;
                aw[x] = MFMA16(a1, ldfrag_tr(ks, QSTR, 16 * dt, 32 * kk, lane), aw[x]);
                au[x] = MFMA16(a2, ldfrag_tr(vs, QSTR, 16 * dt, 32 * kk, lane), au[x]); }
        }
#pragma unroll
        for (int x = 0; x < 4; ++x) { const int d = 16 * (half * 4 + x) + l15, i0 = 16 * it + 4 * q4;
            *(u32x2*)(WT + d * TSTR + i0) = (u32x2){pk2(aw[x][0], aw[x][1]), pk2(aw[x][2], aw[x][3])};
            *(u32x2*)(UT + d * TSTR + i0) = (u32x2){pk2(au[x][0], au[x][1]), pk2(au[x][2], au[x][3])}; }
    }
    __syncthreads();
    {
        bf16_t* gAP = (bf16_t*)(rec + GP_AP); bf16_t* gQH = (bf16_t*)(rec + GP_QH); bf16_t* gKH = (bf16_t*)(rec + GP_KH); bf16_t* gOH = (bf16_t*)(rec + GP_OH);
        {
            const int et = w;
            const bf16x8 a0 = ldfrag(WT, TSTR, 16 * et, 0, lane), a1 = ldfrag(WT, TSTR, 16 * et, 32, lane);
#pragma unroll
            for (int dt = 0; dt < 8; ++dt) { f32x4 acc = {0.f, 0.f, 0.f, 0.f};
                acc = MFMA16(a0, ldfrag_tr(kts, QSTR, 16 * dt, 0, lane), acc); acc = MFMA16(a1, ldfrag_tr(kts, QSTR, 16 * dt, 32, lane), acc);
                *(u32x2*)(gAP + ((size_t)(dt * 4 + (et >> 1)) * 64 + lane) * 8 + (et & 1) * 4) = (u32x2){pk2(-acc[0], -acc[1]), pk2(-acc[2], -acc[3])}; }
#pragma unroll
            for (int tt = 0; tt < 4; ++tt) { f32x4 acc = {0.f, 0.f, 0.f, 0.f};
                acc = MFMA16(a0, ldfrag(QKm, TSTR, 16 * tt, 0, lane), acc); acc = MFMA16(a1, ldfrag(QKm, TSTR, 16 * tt, 32, lane), acc);
                const int t = 16 * tt + l15, e0 = 16 * et + 4 * q4; const float eg = egs[t];
                const u32x2 qq = *(const u32x2*)(qs + t * QSTR + e0);
                const float o0 = __uint_as_float(qq.x << 16) * eg - acc[0], o1 = __uint_as_float(qq.x & 0xffff0000u) * eg - acc[1],
                            o2 = __uint_as_float(qq.y << 16) * eg - acc[2], o3 = __uint_as_float(qq.y & 0xffff0000u) * eg - acc[3];
                *(u32x2*)(gQH + ((size_t)(tt * 4 + (et >> 1)) * 64 + lane) * 8 + (et & 1) * 4) = (u32x2){pk2(o0, o1), pk2(o2, o3)}; }
        }
        {
            const int dt = w;
            const bf16x8 a0 = ldfrag_tr(kts, QSTR, 16 * dt, 0, lane), a1 = ldfrag_tr(kts, QSTR, 16 * dt, 32, lane);
#pragma unroll
            for (int vt = 0; vt < 8; ++vt) { f32x4 acc = {0.f, 0.f, 0.f, 0.f};
                acc = MFMA16(a0, ldfrag(UT, TSTR, 16 * vt, 0, lane), acc); acc = MFMA16(a1, ldfrag(UT, TSTR, 16 * vt, 32, lane), acc);
                *(u32x2*)(gKH + ((size_t)(vt * 8 + dt) * 64 + lane) * 4) = (u32x2){pk2(acc[0], acc[1]), pk2(acc[2], acc[3])}; }
            const int tt = w & 3, vh = w >> 2;
            const bf16x8 b0 = ldfrag(QKm, TSTR, 16 * tt, 0, lane), b1 = ldfrag(QKm, TSTR, 16 * tt, 32, lane);
#pragma unroll
            for (int x = 0; x < 4; ++x) { const int vt = vh * 4 + x; f32x4 acc = {0.f, 0.f, 0.f, 0.f};
                acc = MFMA16(b0, ldfrag(UT, TSTR, 16 * vt, 0, lane), acc); acc = MFMA16(b1, ldfrag(UT, TSTR, 16 * vt, 32, lane), acc);
                *(u32x2*)(gOH + ((size_t)(vt * 4 + tt) * 64 + lane) * 4) = (u32x2){pk2(acc[0], acc[1]), pk2(acc[2], acc[3])}; }
        }
    }
    __syncthreads();
}

__device__ __forceinline__ void phase_gprep(const Params& p, int seg, unsigned char* smem) {
    const int blk = obid();
    const int n_items = (CPS + (seg == 0 ? 1 : 0)) * 64;
#pragma unroll 1
    for (int it = blk; it < n_items; it += gridDim.x) {
        const int bh = it & 63, b = bh >> 3, h = bh & 7; int cl = it >> 6; if (seg != 0) cl += 1;
        unsigned char* rec = p.ws + WS_GP + (size_t)(cl * 64 + bh) * GP_STRIDE;
        const bf16_t* Pb = (const bf16_t*)(p.ws + WS_P);
        bf16_t* chalo2 = (bf16_t*)(p.ws + WS_CHALO);
        if (cl == 0) gdn_prep_item(p, smem, h, LEX0, 48, nullptr, nullptr, nullptr, rec);
        else {
            const int row = b * SEGTOK + (cl - 1) * 64;
            const bf16_t* hbase = Pb + (size_t)(row - 3) * NPB;
            if (cl == 1) hbase = (seg == 0) ? Pb + (size_t)(LEX0 + NMETA - 3) * NPB : chalo2 + (size_t)(((seg - 1) & 1) * NBATCH + b) * 3 * NPB;
            bf16_t* ho = (cl == CPS) ? chalo2 + (size_t)((seg & 1) * NBATCH + b) * 3 * NPB : nullptr;
            float* co = (cl == CPS && seg == NSEG - 1) ? p.out + O_CONV_P + (size_t)b * 9216 : nullptr;
            gdn_prep_item(p, smem, h, row, 0, hbase, ho, co, rec);
        }
    }
}

__device__ __forceinline__ void gdn_scan_block(const Params& p, int seg, unsigned char* smem, int bh) {
    const int tid = otid(), w = tid >> 6, lane = tid & 63, q4 = lane >> 4, l15 = lane & 15;
    const int b = bh >> 3, h = bh & 7;
    float* st = p.out + O_GDN_P + (size_t)bh * 16384;
    f32x4 S[8];
    if (seg) {
#pragma unroll
        for (int mt = 0; mt < 8; ++mt)
#pragma unroll
            for (int r = 0; r < 4; ++r) S[mt][r] = st[(size_t)(16 * mt + 4 * q4 + r) * 128 + 16 * w + l15];
    } else {
#pragma unroll
        for (int mt = 0; mt < 8; ++mt) S[mt] = (f32x4){0.f, 0.f, 0.f, 0.f};
    }
    const int c_lo = seg ? 1 : 0;
    float* obuf = (float*)(smem + 98304);
    {
        const u32x4* src = (const u32x4*)(p.ws + WS_GP + (size_t)(c_lo * 64 + bh) * GP_STRIDE); u32x4* dst = (u32x4*)smem;
#pragma unroll
        for (int x = 0; x < 6; ++x) dst[tid + 512 * x] = src[tid + 512 * x];
    }
#pragma unroll 1
    for (int cl = c_lo; cl <= CPS; ++cl) {
        const unsigned char* rec = p.ws + WS_GP + (size_t)(cl * 64 + bh) * GP_STRIDE;
        const int cur = (cl - c_lo) & 1;
        __syncthreads();
        u32x4 nx[6];
        const bool more = cl < CPS;
        if (more) { const u32x4* src = (const u32x4*)(rec + GP_STRIDE * 64);
#pragma unroll
            for (int x = 0; x < 6; ++x) nx[x] = src[tid + 512 * x]; }
        const bf16_t* gKH = (const bf16_t*)(rec + GP_KH); const bf16_t* gOH = (const bf16_t*)(rec + GP_OH);
        u32x2 kh[8], oh[4];
#pragma unroll
        for (int mt = 0; mt < 8; ++mt) kh[mt] = *(const u32x2*)(gKH + ((size_t)(w * 8 + mt) * 64 + lane) * 4);
#pragma unroll
        for (int tt = 0; tt < 4; ++tt) oh[tt] = *(const u32x2*)(gOH + ((size_t)(w * 4 + tt) * 64 + lane) * 4);
        const float egl = *(const float*)(rec + GP_EGL);
        const int et = tid >> 3, eg = tid & 7;
        const bf16_t* gp = (const bf16_t*)(rec + GP_G) + et * 128 + 16 * eg;
        u32x4 z0 = {0u, 0u, 0u, 0u}, z1 = {0u, 0u, 0u, 0u};
        if (cl > 0) { z0 = *(const u32x4*)gp; z1 = *(const u32x4*)(gp + 8); }
        bf16x8 Bf[4];
#pragma unroll
        for (int ks = 0; ks < 4; ++ks) { u32x4 t; t.x = pk2(S[2 * ks][0], S[2 * ks][1]); t.y = pk2(S[2 * ks][2], S[2 * ks][3]); t.z = pk2(S[2 * ks + 1][0], S[2 * ks + 1][1]); t.w = pk2(S[2 * ks + 1][2], S[2 * ks + 1][3]);
            Bf[ks] = __builtin_bit_cast(bf16x8, t); }
        const bf16x8* AP = (const bf16x8*)(smem + cur * 49152); const bf16x8* QH = (const bf16x8*)(smem + cur * 49152 + GP_QH);
        f32x4 o[4], tS[8];
#pragma unroll
        for (int tt = 0; tt < 4; ++tt) { o[tt] = (f32x4){0.f, 0.f, 0.f, 0.f};
#pragma unroll
            for (int ks = 0; ks < 4; ++ks) o[tt] = MFMA16(QH[(tt * 4 + ks) * 64 + lane], Bf[ks], o[tt]); }
#pragma unroll
        for (int mt = 0; mt < 8; ++mt) { tS[mt] = (f32x4){0.f, 0.f, 0.f, 0.f};
#pragma unroll
            for (int ks = 0; ks < 4; ++ks) tS[mt] = MFMA16(AP[(mt * 4 + ks) * 64 + lane], Bf[ks], tS[mt]); }
#pragma unroll
        for (int mt = 0; mt < 8; ++mt) {
            S[mt][0] = egl * S[mt][0] + tS[mt][0] + __uint_as_float(kh[mt].x << 16); S[mt][1] = egl * S[mt][1] + tS[mt][1] + __uint_as_float(kh[mt].x & 0xffff0000u);
            S[mt][2] = egl * S[mt][2] + tS[mt][2] + __uint_as_float(kh[mt].y << 16); S[mt][3] = egl * S[mt][3] + tS[mt][3] + __uint_as_float(kh[mt].y & 0xffff0000u); }
        if (cl > 0) {
#pragma unroll
            for (int tt = 0; tt < 4; ++tt) {
                o[tt][0] += __uint_as_float(oh[tt].x << 16); o[tt][1] += __uint_as_float(oh[tt].x & 0xffff0000u); o[tt][2] += __uint_as_float(oh[tt].y << 16); o[tt][3] += __uint_as_float(oh[tt].y & 0xffff0000u);
#pragma unroll
                for (int r = 0; r < 4; ++r) obuf[(16 * tt + 4 * q4 + r) * 132 + 16 * w + l15] = o[tt][r]; }
        }
        if (more) { u32x4* dst = (u32x4*)(smem + (cur ^ 1) * 49152);
#pragma unroll
            for (int x = 0; x < 6; ++x) dst[tid + 512 * x] = nx[x]; }
        if (cl > 0) {
            __syncthreads();
            f32x4 ov[4]; float ss = 0.f;
#pragma unroll
            for (int j = 0; j < 4; ++j) { ov[j] = *(const f32x4*)(obuf + et * 132 + 16 * eg + 4 * j); ss += ov[j][0] * ov[j][0] + ov[j][1] * ov[j][1] + ov[j][2] * ov[j][2] + ov[j][3] * ov[j][3]; }
            ss += __shfl_xor(ss, 1); ss += __shfl_xor(ss, 2); ss += __shfl_xor(ss, 4);
            const float rs = __builtin_amdgcn_rsqf(ss * (1.f / 128.f) + 1e-6f);
            const unsigned zz[8] = {z0.x, z0.y, z0.z, z0.w, z1.x, z1.y, z1.z, z1.w};
            unsigned ow[8];
#pragma unroll
            for (int j = 0; j < 8; ++j) ow[j] = pk2(ov[j >> 1][(j & 1) * 2] * rs * __uint_as_float(zz[j] << 16), ov[j >> 1][(j & 1) * 2 + 1] * rs * __uint_as_float(zz[j] & 0xffff0000u));
            const size_t grow = (size_t)b * SEQ + seg * SEGTOK + (cl - 1) * 64 + et;
            bf16_t* oa = (bf16_t*)(p.ws + WS_H) + grow * D + h * 128 + 16 * eg;
            *(u32x4*)oa = (u32x4){ow[0], ow[1], ow[2], ow[3]}; *(u32x4*)(oa + 8) = (u32x4){ow[4], ow[5], ow[6], ow[7]};
        }
    }
#pragma unroll
    for (int mt = 0; mt < 8; ++mt)
#pragma unroll
        for (int r = 0; r < 4; ++r) st[(size_t)(16 * mt + 4 * q4 + r) * 128 + 16 * w + l15] = S[mt][r];
    __syncthreads();
}

constexpr int RL_AT = 0, RL_BT = 9216, RL_KT = 18432, RL_ATT = 27648, RL_RT = 36864, RL_BTLT = 46080, RL_KTLT = 55296, RL_VT = 64512, RL_LAK = 73728, RL_MRB = 82944, RL_MRK = 92160,
              RL_LM = 101376, RL_AF = 117760, RL_TM = 134144, RL_XS = 150528;
__device__ __forceinline__ void rwkv_prep_item(const Params& p, unsigned char* smem, int hb, int row_start, int npad, const bf16_t* prev_row,
                                               bf16_t* halo_out, unsigned char* rec) {
    const int tid = otid(), w = tid >> 6, lane = tid & 63, q4 = lane >> 4, l15 = lane & 15;
    bf16_t* At = (bf16_t*)(smem + RL_AT); bf16_t* Tb = At; bf16_t* Bt = (bf16_t*)(smem + RL_BT); bf16_t* WaT = Bt; bf16_t* Kt = (bf16_t*)(smem + RL_KT); bf16_t* XT = Kt;
    bf16_t* At2 = (bf16_t*)(smem + RL_ATT); bf16_t* Rt = (bf16_t*)(smem + RL_RT); bf16_t* Btl = (bf16_t*)(smem + RL_BTLT); bf16_t* Ktl = (bf16_t*)(smem + RL_KTLT);
    bf16_t* Vr = (bf16_t*)(smem + RL_VT);        bf16_t* Lak = (bf16_t*)(smem + RL_LAK); bf16_t* Mrb = (bf16_t*)(smem + RL_MRB); bf16_t* Mrk = (bf16_t*)(smem + RL_MRK);
    float* Lm = (float*)(smem + RL_LM);
    bf16_t* thw = Lak; bf16_t* adb = Mrb; float* lc = Lm; float* af = (float*)(smem + RL_AF);
    const bf16_t* P = (const bf16_t*)(p.ws + WS_P);
    const float* pk = (const float*)(p.ws + WS_PK);
    const int t = tid >> 3, g = tid & 7;
    float rr[8], kb[8], vv[8], zb[8];
    {
        const bool real = t >= npad;
        const bf16_t* curp = P; const bf16_t* prevp = P; float fprev = 0.f;
        if (real) { curp = P + (size_t)(row_start + t - npad) * NPB; if (t > npad) { prevp = curp - NPB; fprev = 1.f; } else if (prev_row) { prevp = prev_row; fprev = 1.f; } }
        const int secbase[6] = {0, 1024, 2048, 3200, 3072, 3136};
        u32x4 rc[6], rp[6];
#pragma unroll
        for (int sidx = 0; sidx < 6; ++sidx) { const int col = secbase[sidx] + (sidx < 4 ? hb * 64 : 0) + g * 8; rc[sidx] = *(const u32x4*)(curp + C_RW + col); rp[sidx] = *(const u32x4*)(prevp + C_RW + col); }
        float m[6][8];
#pragma unroll
        for (int sidx = 0; sidx < 6; ++sidx) {
            const int col = secbase[sidx] + (sidx < 4 ? hb * 64 : 0) + g * 8;
            float cur[8], prv[8];
            unpack8(rc[sidx], cur); unpack8(rp[sidx], prv);
            const f32x4 mu0 = *(const f32x4*)(pk + PK_MU + col), mu1 = *(const f32x4*)(pk + PK_MU + col + 4);
            const float mu[8] = {mu0[0], mu0[1], mu0[2], mu0[3], mu1[0], mu1[1], mu1[2], mu1[3]};
#pragma unroll
            for (int e = 0; e < 8; ++e) m[sidx][e] = real ? cur[e] + mu[e] * (fprev * prv[e] - cur[e]) : 0.f;
            if (halo_out && t == 63 && (sidx < 4 || hb == 0)) *(u32x4*)(halo_out + C_RW + col) = rc[sidx];
        }
#pragma unroll
        for (int e = 0; e < 8; ++e) { rr[e] = m[0][e]; kb[e] = m[1][e]; vv[e] = m[2][e]; zb[e] = m[3][e]; }
        float th[8];
#pragma unroll
        for (int e = 0; e < 8; ++e) th[e] = tanh_(m[4][e]);
        *(u32x4*)(thw + t * TSTR + g * 8) = pack8(th);
        *(u32x4*)(adb + t * TSTR + g * 8) = pack8(m[5]);
    }
    __syncthreads();
    {
        const int which = w >> 2, ct = w & 3;
        const bf16_t* Wt = (const bf16_t*)(p.ws + (which ? WS_A2T : WS_W2T)) + (size_t)hb * 4096;
        const bf16x8 b0 = *(const bf16x8*)(Wt + (16 * ct + l15) * 64 + 8 * q4), b1 = *(const bf16x8*)(Wt + (16 * ct + l15) * 64 + 32 + 8 * q4);
        const bf16_t* Aarr = which ? adb : thw;
        const int c = 16 * ct + l15;
        const float bias = pk[(which ? PK_A0 : PK_W0) + hb * 64 + c];
        float carry = 0.f;
#pragma unroll
        for (int tt = 0; tt < 4; ++tt) {
            f32x4 acc = {0.f, 0.f, 0.f, 0.f};
            acc = MFMA16(ldfrag(Aarr, TSTR, 16 * tt, 0, lane), b0, acc); acc = MFMA16(ldfrag(Aarr, TSTR, 16 * tt, 32, lane), b1, acc);
            if (which) {
#pragma unroll
                for (int r = 0; r < 4; ++r) af[(16 * tt + 4 * q4 + r) * 64 + c] = sigm(bias + acc[r]);
            } else {
                float wl[4];
#pragma unroll
                for (int r = 0; r < 4; ++r) { const int tk = 16 * tt + 4 * q4 + r; wl[r] = (tk < npad) ? 0.f : -0.6065306597126334f * sigm(bias + acc[r]); }
                wl[1] += wl[0]; wl[2] += wl[1]; wl[3] += wl[2];
                const float Q = wl[3];
                const float Q0 = __shfl(Q, l15), Q1 = __shfl(Q, l15 + 16), Q2 = __shfl(Q, l15 + 32), Q3 = __shfl(Q, l15 + 48);
                const float ex = carry + (q4 > 0 ? Q0 : 0.f) + (q4 > 1 ? Q1 : 0.f) + (q4 > 2 ? Q2 : 0.f);
#pragma unroll
                for (int r = 0; r < 4; ++r) lc[(16 * tt + 4 * q4 + r) * 64 + c] = ex + wl[r];
                carry += Q0 + Q1 + Q2 + Q3;
            }
        }
    }
    __syncthreads();
    {
        float lct[8], lcp[8], lcC[8], av[8];
        { const f32x4 a = *(const f32x4*)(lc + t * 64 + g * 8), b2 = *(const f32x4*)(lc + t * 64 + g * 8 + 4); lct[0] = a[0]; lct[1] = a[1]; lct[2] = a[2]; lct[3] = a[3]; lct[4] = b2[0]; lct[5] = b2[1]; lct[6] = b2[2]; lct[7] = b2[3]; }
        if (t > 0) { const f32x4 a = *(const f32x4*)(lc + (t - 1) * 64 + g * 8), b2 = *(const f32x4*)(lc + (t - 1) * 64 + g * 8 + 4); lcp[0] = a[0]; lcp[1] = a[1]; lcp[2] = a[2]; lcp[3] = a[3]; lcp[4] = b2[0]; lcp[5] = b2[1]; lcp[6] = b2[2]; lcp[7] = b2[3]; }
        else {
#pragma unroll
            for (int e = 0; e < 8; ++e) lcp[e] = 0.f; }
        { const f32x4 a = *(const f32x4*)(lc + 63 * 64 + g * 8), b2 = *(const f32x4*)(lc + 63 * 64 + g * 8 + 4); lcC[0] = a[0]; lcC[1] = a[1]; lcC[2] = a[2]; lcC[3] = a[3]; lcC[4] = b2[0]; lcC[5] = b2[1]; lcC[6] = b2[2]; lcC[7] = b2[3]; }
        { const f32x4 a = *(const f32x4*)(af + t * 64 + g * 8), b2 = *(const f32x4*)(af + t * 64 + g * 8 + 4); av[0] = a[0]; av[1] = a[1]; av[2] = a[2]; av[3] = a[3]; av[4] = b2[0]; av[5] = b2[1]; av[6] = b2[2]; av[7] = b2[3]; }
        const int hc = hb * 64 + g * 8;
        float kk[8], km[8], ss = 0.f, rk = 0.f;
        float pkk[8], pka[8], prk[8];
        { const f32x4 a0 = *(const f32x4*)(pk + PK_KK + hc), a1 = *(const f32x4*)(pk + PK_KK + hc + 4), b0 = *(const f32x4*)(pk + PK_KA + hc), b1 = *(const f32x4*)(pk + PK_KA + hc + 4), c0v = *(const f32x4*)(pk + PK_RK + hc), c1v = *(const f32x4*)(pk + PK_RK + hc + 4);
#pragma unroll
          for (int e = 0; e < 4; ++e) { pkk[e] = a0[e]; pkk[4 + e] = a1[e]; pka[e] = b0[e]; pka[4 + e] = b1[e]; prk[e] = c0v[e]; prk[4 + e] = c1v[e]; } }
#pragma unroll
        for (int e = 0; e < 8; ++e) { kk[e] = kb[e] * pkk[e]; ss += kk[e] * kk[e]; km[e] = kb[e] * (1.f + (av[e] - 1.f) * pka[e]); rk += rr[e] * km[e] * prk[e]; }
        ss += __shfl_xor(ss, 1); ss += __shfl_xor(ss, 2); ss += __shfl_xor(ss, 4);
        rk += __shfl_xor(rk, 1); rk += __shfl_xor(rk, 2); rk += __shfl_xor(rk, 4);
        const float kn = __builtin_amdgcn_rsqf(ss + 1e-6f);
        float xa[8], xb[8], xk[8], xr[8], xbt[8], xkt[8];
#pragma unroll
        for (int e = 0; e < 8; ++e) { kk[e] *= kn; const float ka = kk[e] * av[e]; const float ip = __expf(-lct[e]), tl = __expf(lcC[e] - lct[e]);
            xa[e] = kk[e] * __expf(lcp[e]); xb[e] = ka * ip; xk[e] = km[e] * ip; xr[e] = rr[e] * __expf(lct[e]); xbt[e] = ka * tl; xkt[e] = km[e] * tl; }
        *(u32x4*)(At + t * TSTR + g * 8) = pack8(xa); *(u32x4*)(Bt + t * TSTR + g * 8) = pack8(xb); *(u32x4*)(Kt + t * TSTR + g * 8) = pack8(xk); *(u32x4*)(Rt + t * TSTR + g * 8) = pack8(xr);
        *(u32x4*)(At2 + t * TSTR + g * 8) = pack8(xa); *(u32x4*)(Btl + t * TSTR + g * 8) = pack8(xbt); *(u32x4*)(Ktl + t * TSTR + g * 8) = pack8(xkt); *(u32x4*)(Vr + t * TSTR + g * 8) = pack8(vv);
        float c1[8], c0[8];
#pragma unroll
        for (int e = 0; e < 8; ++e) { c1[e] = 0.f; c0[e] = 0.f; }
        { const f32x4 g0 = *(const f32x4*)(pk + PK_GNW + hc), g1 = *(const f32x4*)(pk + PK_GNW + hc + 4), h0 = *(const f32x4*)(pk + PK_GNB + hc), h1 = *(const f32x4*)(pk + PK_GNB + hc + 4);
#pragma unroll
          for (int e = 0; e < 4; ++e) { const float sz0 = silu_(zb[e]), sz1 = silu_(zb[4 + e]); c1[e] = g0[e] * sz0; c1[4 + e] = g1[e] * sz1; c0[e] = (h0[e] + rk * vv[e]) * sz0; c0[4 + e] = (h1[e] + rk * vv[4 + e]) * sz1; } }
        *(u32x4*)((bf16_t*)(rec + RP_C1) + t * 64 + g * 8) = pack8(c1); *(u32x4*)((bf16_t*)(rec + RP_C0) + t * 64 + g * 8) = pack8(c0);
        if (t == 63) { float* pc = (float*)(rec + RP_PC) + g * 8; *(f32x4*)pc = (f32x4){__expf(lcC[0]), __expf(lcC[1]), __expf(lcC[2]), __expf(lcC[3])}; *(f32x4*)(pc + 4) = (f32x4){__expf(lcC[4]), __expf(lcC[5]), __expf(lcC[6]), __expf(lcC[7])}; }
    }
    __syncthreads();
    {
        const int pr = w >> 1;
        const bf16_t* Aarr = pr < 2 ? At : Rt; const bf16_t* Barr = (pr & 1) ? Kt : Bt;
#pragma unroll
        for (int x = 0; x < 2; ++x) { const int tt = 2 * (w & 1) + x;
            const bf16x8 a0 = ldfrag(Aarr, TSTR, 16 * tt, 0, lane), a1 = ldfrag(Aarr, TSTR, 16 * tt, 32, lane);
            const int tk = 16 * tt + l15;
#pragma unroll
            for (int it = 0; it < 4; ++it) { f32x4 acc = {0.f, 0.f, 0.f, 0.f};
                acc = MFMA16(ldfrag(Barr, TSTR, 16 * it, 0, lane), a0, acc); acc = MFMA16(ldfrag(Barr, TSTR, 16 * it, 32, lane), a1, acc);
                const int i0 = 16 * it + 4 * q4;
                f32x4 o;
#pragma unroll
                for (int r = 0; r < 4; ++r) { const int i = i0 + r; const bool keep = pr < 2 ? (tk > i) : (tk >= i); o[r] = keep ? acc[r] : 0.f; }
                if (pr == 0) *(f32x4*)(Lm + tk * 64 + i0) = o;
                else { bf16_t* Out = pr == 1 ? Lak : (pr == 2 ? Mrb : Mrk); *(u32x2*)(Out + tk * TSTR + i0) = (u32x2){pk2(o[0], o[1]), pk2(o[2], o[3])}; } }
        }
    }
    __syncthreads();
    {
        float* Tm = (float*)(smem + RL_TM);
        inv_block(Lm, Tm, (float*)(smem + RL_XS), tid);
        const int i = tid >> 3, j0 = (tid & 7) * 8;
        float a[8];
#pragma unroll
        for (int e = 0; e < 8; ++e) a[e] = Tm[i * 64 + j0 + e];
        *(u32x4*)(Tb + i * TSTR + j0) = pack8(a);
    }
    __syncthreads();
    {
        const int tt = w & 3, which = w >> 2;
        const bf16_t* Aarr = which ? Lak : Tb; const bf16_t* Barr = which ? Vr : At2; bf16_t* Out = which ? XT : WaT;
        const bf16x8 a0 = ldfrag(Aarr, TSTR, 16 * tt, 0, lane), a1 = ldfrag(Aarr, TSTR, 16 * tt, 32, lane);
#pragma unroll
        for (int ct = 0; ct < 4; ++ct) { f32x4 acc = {0.f, 0.f, 0.f, 0.f};
            acc = MFMA16(a0, ldfrag_tr(Barr, TSTR, 16 * ct, 0, lane), acc); acc = MFMA16(a1, ldfrag_tr(Barr, TSTR, 16 * ct, 32, lane), acc);
            *(u32x2*)(Out + (16 * ct + l15) * TSTR + 16 * tt + 4 * q4) = (u32x2){pk2(acc[0], acc[1]), pk2(acc[2], acc[3])}; }
    }
    __syncthreads();
    {
        f32x4 acc[4];
        if (w < 4) {
            const bf16x8 a0 = ldfrag(Tb, TSTR, 16 * w, 0, lane), a1 = ldfrag(Tb, TSTR, 16 * w, 32, lane);
#pragma unroll
            for (int ct = 0; ct < 4; ++ct) { acc[ct] = (f32x4){0.f, 0.f, 0.f, 0.f};
                acc[ct] = MFMA16(a0, ldfrag(XT, TSTR, 16 * ct, 0, lane), acc[ct]); acc[ct] = MFMA16(a1, ldfrag(XT, TSTR, 16 * ct, 32, lane), acc[ct]); }
        }
        if (w < 4) {
            bf16_t* UvTw = (bf16_t*)(smem + RL_LM);
#pragma unroll
            for (int ct = 0; ct < 4; ++ct) *(u32x2*)(UvTw + (16 * ct + l15) * TSTR + 16 * w + 4 * q4) = (u32x2){pk2(-acc[ct][0], -acc[ct][1]), pk2(-acc[ct][2], -acc[ct][3])};
        }
    }
    __syncthreads();
    {
        const bf16_t* UvT = (const bf16_t*)(smem + RL_LM);
        bf16_t* gAP = (bf16_t*)(rec + RP_AP); bf16_t* gRH = (bf16_t*)(rec + RP_RH); bf16_t* gKH = (bf16_t*)(rec + RP_KH); bf16_t* gYH = (bf16_t*)(rec + RP_YH);
        const int et = w & 3, part = w >> 2;
        {
            const bf16x8 a0 = ldfrag(WaT, TSTR, 16 * et, 0, lane), a1 = ldfrag(WaT, TSTR, 16 * et, 32, lane);
            if (part == 0) {
#pragma unroll
                for (int kt = 0; kt < 4; ++kt) { f32x4 acc = {0.f, 0.f, 0.f, 0.f};
                    acc = MFMA16(a0, ldfrag_tr(Btl, TSTR, 16 * kt, 0, lane), acc); acc = MFMA16(a1, ldfrag_tr(Btl, TSTR, 16 * kt, 32, lane), acc);
                    *(u32x2*)(gAP + ((size_t)(kt * 2 + (et >> 1)) * 64 + lane) * 8 + (et & 1) * 4) = (u32x2){pk2(-acc[0], -acc[1]), pk2(-acc[2], -acc[3])}; }
            } else {
#pragma unroll
                for (int tt = 0; tt < 4; ++tt) { f32x4 acc = {0.f, 0.f, 0.f, 0.f};
                    acc = MFMA16(a0, ldfrag(Mrb, TSTR, 16 * tt, 0, lane), acc); acc = MFMA16(a1, ldfrag(Mrb, TSTR, 16 * tt, 32, lane), acc);
                    const int tk = 16 * tt + l15, e0 = 16 * et + 4 * q4;
                    const u32x2 q2 = *(const u32x2*)(Rt + tk * TSTR + e0);
                    const float o0 = __uint_as_float(q2.x << 16) - acc[0], o1 = __uint_as_float(q2.x & 0xffff0000u) - acc[1], o2 = __uint_as_float(q2.y << 16) - acc[2], o3 = __uint_as_float(q2.y & 0xffff0000u) - acc[3];
                    *(u32x2*)(gRH + ((size_t)(tt * 2 + (et >> 1)) * 64 + lane) * 8 + (et & 1) * 4) = (u32x2){pk2(o0, o1), pk2(o2, o3)}; }
            }
        }
        {
            const int rt = w & 3;
            bf16_t* Out = part ? gKH : gYH;
            bf16x8 a0, a1, a2, a3;
            if (part) { a0 = ldfrag_tr(Btl, TSTR, 16 * rt, 0, lane); a1 = ldfrag_tr(Btl, TSTR, 16 * rt, 32, lane); a2 = ldfrag_tr(Ktl, TSTR, 16 * rt, 0, lane); a3 = ldfrag_tr(Ktl, TSTR, 16 * rt, 32, lane); }
            else { a0 = ldfrag(Mrb, TSTR, 16 * rt, 0, lane); a1 = ldfrag(Mrb, TSTR, 16 * rt, 32, lane); a2 = ldfrag(Mrk, TSTR, 16 * rt, 0, lane); a3 = ldfrag(Mrk, TSTR, 16 * rt, 32, lane); }
#pragma unroll
            for (int vt = 0; vt < 4; ++vt) { f32x4 acc = {0.f, 0.f, 0.f, 0.f};
                acc = MFMA16(a0, ldfrag(UvT, TSTR, 16 * vt, 0, lane), acc); acc = MFMA16(a1, ldfrag(UvT, TSTR, 16 * vt, 32, lane), acc);
                acc = MFMA16(a2, ldfrag_tr(Vr, TSTR, 16 * vt, 0, lane), acc); acc = MFMA16(a3, ldfrag_tr(Vr, TSTR, 16 * vt, 32, lane), acc);
                *(u32x2*)(Out + ((size_t)(vt * 4 + rt) * 64 + lane) * 4) = (u32x2){pk2(acc[0], acc[1]), pk2(acc[2], acc[3])}; }
        }
    }
    __syncthreads();
}

__device__ __forceinline__ void phase_rprep(const Params& p, int seg, unsigned char* smem) {
    const int blk = obid();
    const int n_items = (CPS + (seg == 0 ? 1 : 0)) * 128;
#pragma unroll 1
    for (int it = (blk + (gridDim.x >> 1)) % gridDim.x; it < n_items; it += gridDim.x) {
        const int bh = it & 127, b = bh >> 4, hb = bh & 15; int cl = it >> 7; if (seg != 0) cl += 1;
        unsigned char* rec = p.ws + WS_RP + (size_t)(cl * 128 + bh) * RP_STRIDE;
        const bf16_t* Pb = (const bf16_t*)(p.ws + WS_P);
        bf16_t* phalo2 = (bf16_t*)(p.ws + WS_PHALO);
        if (cl == 0) rwkv_prep_item(p, smem, hb, LEX0, 48, nullptr, nullptr, rec);
        else {
            const int row = b * SEGTOK + (cl - 1) * 64;
            const bf16_t* prow = Pb + (size_t)(row - 1) * NPB;
            if (cl == 1) prow = (seg == 0) ? Pb + (size_t)(LEX0 + NMETA - 1) * NPB : phalo2 + (size_t)(((seg - 1) & 1) * NBATCH + b) * NPB;
            bf16_t* ho = (cl == CPS) ? phalo2 + (size_t)((seg & 1) * NBATCH + b) * NPB : nullptr;
            rwkv_prep_item(p, smem, hb, row, 0, prow, ho, rec);
        }
    }
}

__device__ __forceinline__ void rwkv_scan_block(const Params& p, int seg, unsigned char* smem, int pairidx) {
    const int tid = otid(), w = tid >> 6, lane = tid & 63, q4 = lane >> 4, l15 = lane & 15;
    const int hsel = w >> 2, vt = w & 3;
    const int bh = pairidx * 2 + hsel, b = bh >> 4, hb = bh & 15;
    float* st = p.out + O_RWKV_P + (size_t)bh * 4096;
    f32x4 S[4];
    if (seg) {
#pragma unroll
        for (int mt = 0; mt < 4; ++mt) S[mt] = *(const f32x4*)(st + (size_t)(16 * vt + l15) * 64 + 16 * mt + 4 * q4);
    } else {
#pragma unroll
        for (int mt = 0; mt < 4; ++mt) S[mt] = (f32x4){0.f, 0.f, 0.f, 0.f};
    }
    const int c_lo = seg ? 1 : 0;
    float* ybuf = (float*)(smem + 65536) + hsel * (64 * 68);
    const int tl = tid & 255;
    {
        const u32x4* src = (const u32x4*)(p.ws + WS_RP + (size_t)(c_lo * 128 + bh) * RP_STRIDE); u32x4* dst = (u32x4*)(smem + hsel * 16384);
#pragma unroll
        for (int x = 0; x < 4; ++x) dst[tl + 256 * x] = src[tl + 256 * x];
    }
#pragma unroll 1
    for (int cl = c_lo; cl <= CPS; ++cl) {
        const unsigned char* rec = p.ws + WS_RP + (size_t)(cl * 128 + bh) * RP_STRIDE;
        const int cur = (cl - c_lo) & 1;
        __syncthreads();
        u32x4 nx[4];
        const bool more = cl < CPS;
        if (more) { const u32x4* src = (const u32x4*)(rec + (size_t)RP_STRIDE * 128);
#pragma unroll
            for (int x = 0; x < 4; ++x) nx[x] = src[tl + 256 * x]; }
        const bf16_t* gKH = (const bf16_t*)(rec + RP_KH); const bf16_t* gYH = (const bf16_t*)(rec + RP_YH);
        u32x2 kh[4], yh[4]; f32x4 pc[4];
#pragma unroll
        for (int mt = 0; mt < 4; ++mt) { kh[mt] = *(const u32x2*)(gKH + ((size_t)(vt * 4 + mt) * 64 + lane) * 4); yh[mt] = *(const u32x2*)(gYH + ((size_t)(vt * 4 + mt) * 64 + lane) * 4);
            pc[mt] = *(const f32x4*)((const float*)(rec + RP_PC) + 16 * mt + 4 * q4); }
        const int tk = tl >> 2, g = tl & 3;
        u32x4 a0 = {0u, 0u, 0u, 0u}, a1 = a0, b0 = a0, b1 = a0;
        if (cl > 0) { const bf16_t* c1p = (const bf16_t*)(rec + RP_C1) + tk * 64 + 16 * g; const bf16_t* c0p = (const bf16_t*)(rec + RP_C0) + tk * 64 + 16 * g;
            a0 = *(const u32x4*)c0p; a1 = *(const u32x4*)(c0p + 8); b0 = *(const u32x4*)c1p; b1 = *(const u32x4*)(c1p + 8); }
        bf16x8 Bf[2];
#pragma unroll
        for (int ks = 0; ks < 2; ++ks) { u32x4 tq; tq.x = pk2(S[2 * ks][0], S[2 * ks][1]); tq.y = pk2(S[2 * ks][2], S[2 * ks][3]); tq.z = pk2(S[2 * ks + 1][0], S[2 * ks + 1][1]); tq.w = pk2(S[2 * ks + 1][2], S[2 * ks + 1][3]);
            Bf[ks] = __builtin_bit_cast(bf16x8, tq); }
        const bf16x8* AP = (const bf16x8*)(smem + cur * 32768 + hsel * 16384); const bf16x8* RH = (const bf16x8*)(smem + cur * 32768 + hsel * 16384 + RP_RH);
        f32x4 y[4], tS[4];
#pragma unroll
        for (int tt = 0; tt < 4; ++tt) { y[tt] = (f32x4){0.f, 0.f, 0.f, 0.f}; y[tt] = MFMA16(RH[(tt * 2 + 0) * 64 + lane], Bf[0], y[tt]); y[tt] = MFMA16(RH[(tt * 2 + 1) * 64 + lane], Bf[1], y[tt]); }
#pragma unroll
        for (int mt = 0; mt < 4; ++mt) { tS[mt] = (f32x4){0.f, 0.f, 0.f, 0.f}; tS[mt] = MFMA16(AP[(mt * 2 + 0) * 64 + lane], Bf[0], tS[mt]); tS[mt] = MFMA16(AP[(mt * 2 + 1) * 64 + lane], Bf[1], tS[mt]); }
#pragma unroll
        for (int mt = 0; mt < 4; ++mt) {
            S[mt][0] = pc[mt][0] * S[mt][0] + tS[mt][0] + __uint_as_float(kh[mt].x << 16); S[mt][1] = pc[mt][1] * S[mt][1] + tS[mt][1] + __uint_as_float(kh[mt].x & 0xffff0000u);
            S[mt][2] = pc[mt][2] * S[mt][2] + tS[mt][2] + __uint_as_float(kh[mt].y << 16); S[mt][3] = pc[mt][3] * S[mt][3] + tS[mt][3] + __uint_as_float(kh[mt].y & 0xffff0000u); }
        if (cl > 0) {
#pragma unroll
            for (int tt = 0; tt < 4; ++tt) {
                y[tt][0] += __uint_as_float(yh[tt].x << 16); y[tt][1] += __uint_as_float(yh[tt].x & 0xffff0000u); y[tt][2] += __uint_as_float(yh[tt].y << 16); y[tt][3] += __uint_as_float(yh[tt].y & 0xffff0000u);
#pragma unroll
                for (int r = 0; r < 4; ++r) ybuf[(16 * tt + 4 * q4 + r) * 68 + 16 * vt + l15] = y[tt][r]; }
        }
        if (more) { u32x4* dst = (u32x4*)(smem + (cur ^ 1) * 32768 + hsel * 16384);
#pragma unroll
            for (int x = 0; x < 4; ++x) dst[tl + 256 * x] = nx[x]; }
        if (cl > 0) {
            __syncthreads();
            f32x4 yv[4]; float sm = 0.f;
#pragma unroll
            for (int j = 0; j < 4; ++j) { yv[j] = *(const f32x4*)(ybuf + tk * 68 + 16 * g + 4 * j); sm += yv[j][0] + yv[j][1] + yv[j][2] + yv[j][3]; }
            sm += __shfl_xor(sm, 1); sm += __shfl_xor(sm, 2);
            const float mu = sm * (1.f / 64.f); float vs = 0.f;
#pragma unroll
            for (int j = 0; j < 4; ++j) { yv[j] = yv[j] - mu; vs += yv[j][0] * yv[j][0] + yv[j][1] * yv[j][1] + yv[j][2] * yv[j][2] + yv[j][3] * yv[j][3]; }
            vs += __shfl_xor(vs, 1); vs += __shfl_xor(vs, 2);
            const float rs = __builtin_amdgcn_rsqf(vs * (1.f / 64.f) + 64e-5f);
            const unsigned c0w[8] = {a0.x, a0.y, a0.z, a0.w, a1.x, a1.y, a1.z, a1.w}, c1w[8] = {b0.x, b0.y, b0.z, b0.w, b1.x, b1.y, b1.z, b1.w};
            unsigned ow[8];
#pragma unroll
            for (int j = 0; j < 8; ++j) ow[j] = pk2(yv[j >> 1][(j & 1) * 2] * rs * __uint_as_float(c1w[j] << 16) + __uint_as_float(c0w[j] << 16),
                                                     yv[j >> 1][(j & 1) * 2 + 1] * rs * __uint_as_float(c1w[j] & 0xffff0000u) + __uint_as_float(c0w[j] & 0xffff0000u));
            const size_t grow = (size_t)b * SEQ + seg * SEGTOK + (cl - 1) * 64 + tk;
            bf16_t* ob = (bf16_t*)(p.ws + WS_OB) + grow * D + hb * 64 + 16 * g;
            *(u32x4*)ob = (u32x4){ow[0], ow[1], ow[2], ow[3]}; *(u32x4*)(ob + 8) = (u32x4){ow[4], ow[5], ow[6], ow[7]};
        }
    }
#pragma unroll
    for (int mt = 0; mt < 4; ++mt) *(f32x4*)(st + (size_t)(16 * vt + l15) * 64 + 16 * mt + 4 * q4) = S[mt];
    __syncthreads();
}

__device__ __forceinline__ void gdn_sample_item(const Params& p, unsigned char* smem, int bs, int h) {
    const int tid = otid(), w = tid >> 6, lane = tid & 63, kq = tid >> 7, v = tid & 127;
    float* qk_s = (float*)smem; float* v_s = qk_s + 1024; float* gb_s = v_s + 512; float* part = gb_s + 16; float* part2 = part + 512;
    const bf16_t* P = (const bf16_t*)(p.ws + WS_P);
    const float* pk = (const float*)(p.ws + WS_PK);
    const float* s_in = p.in[2] + (size_t)(bs * 8 + h) * 16384; float* s_out = p.out + O_GDN_S + (size_t)(bs * 8 + h) * 16384;
    const int row0 = LEX0 + EX_SAMP + bs * DECT;
    float s[32];
#pragma unroll
    for (int j = 0; j < 32; ++j) s[j] = s_in[(size_t)(kq * 32 + j) * 128 + v];
    if (tid < 384) {
        const int pcol = (tid >> 7) * 1024 + h * 128 + (tid & 127);
        const float* cw = pk + PK_CONVW; const float* hin = p.in[3] + (size_t)bs * 9216; float* hout = p.out + O_CONV_S + (size_t)bs * 9216;
        const float cw0 = cw[pcol], cw1 = cw[3072 + pcol], cw2 = cw[6144 + pcol], cw3 = cw[9216 + pcol];
        float x3 = hin[pcol], x2 = hin[3072 + pcol], x1 = hin[6144 + pcol];
        float xr[4];
#pragma unroll
        for (int i = 0; i < 4; ++i) xr[i] = bf2f(P[(size_t)(row0 + i) * NPB + pcol]);
#pragma unroll
        for (int i = 0; i < 4; ++i) { const float y = cw0 * x3 + cw1 * x2 + cw2 * x1 + cw3 * xr[i]; x3 = x2; x2 = x1; x1 = xr[i];
            if (tid < 256) qk_s[i * 256 + tid] = silu_(y); else v_s[i * 128 + (tid - 256)] = silu_(y); }
        hout[pcol] = x3; hout[3072 + pcol] = x2; hout[6144 + pcol] = x1;
    } else if (tid < 388) {
        const int i = tid - 384; const size_t r = (size_t)(row0 + i) * NPB;
        const float pa = bf2f(P[r + C_A + h]), pb = bf2f(P[r + C_B + h]);
        gb_s[2 * i] = __expf(-expf(pk[PK_ALOG + h]) * softplus_(pa + pk[PK_DTB + h])); gb_s[2 * i + 1] = sigm(pb);
    }
    __syncthreads();
    { const int i = w >> 1, which = w & 1; float* rp = qk_s + i * 256 + which * 128; const float a = rp[lane], b = rp[lane + 64];
      const float sc = __builtin_amdgcn_rsqf(wave_sum(a * a + b * b) + 1e-6f) * (which == 0 ? 0.08838834764831845f : 1.f); rp[lane] = a * sc; rp[lane + 64] = b * sc; }
    __syncthreads();
#pragma unroll 1
    for (int i = 0; i < 4; ++i) {
        const float* kp = qk_s + i * 256 + 128 + kq * 32; const float* qp = qk_s + i * 256 + kq * 32;
        float pa = 0.f;
#pragma unroll
        for (int j4 = 0; j4 < 8; ++j4) { const f32x4 k4 = *(const f32x4*)(kp + 4 * j4); pa += k4[0] * s[4 * j4] + k4[1] * s[4 * j4 + 1] + k4[2] * s[4 * j4 + 2] + k4[3] * s[4 * j4 + 3]; }
        part[kq * 128 + v] = pa;
        __syncthreads();
        const float kS = part[v] + part[128 + v] + part[256 + v] + part[384 + v];
        const float a = gb_s[2 * i], c = gb_s[2 * i + 1] * (v_s[i * 128 + v] - a * kS);
        float po = 0.f;
#pragma unroll
        for (int j4 = 0; j4 < 8; ++j4) { const f32x4 k4 = *(const f32x4*)(kp + 4 * j4), q4v = *(const f32x4*)(qp + 4 * j4);
#pragma unroll
            for (int e = 0; e < 4; ++e) { s[4 * j4 + e] = a * s[4 * j4 + e] + k4[e] * c; po += q4v[e] * s[4 * j4 + e]; } }
        part2[kq * 128 + v] = po;
        __syncthreads();
        if (kq == 0) ((float*)(p.ws + WS_ORAW))[(size_t)(row0 + i) * D + h * 128 + v] = part2[v] + part2[128 + v] + part2[256 + v] + part2[384 + v];
    }
#pragma unroll
    for (int j = 0; j < 32; ++j) s_out[(size_t)(kq * 32 + j) * 128 + v] = s[j];
    __syncthreads();
}

constexpr int SR_R = 0, SR_KK = 4096, SR_V = 8192, SR_ZB = 12288, SR_DEC = 16384, SR_KA = 20480, SR_KM = 24576, SR_WD = 28672, SR_AD = 28928, SR_RK = 29184;
__device__ __forceinline__ void rwkv_sample_item(const Params& p, unsigned char* smem, int bs) {
    const int tid = otid(), w = tid >> 6, lane = tid & 63;
    float* f = (float*)smem;
    const bf16_t* P = (const bf16_t*)(p.ws + WS_P);
    const float* pk = (const float*)(p.ws + WS_PK);
    const int row0 = LEX0 + EX_SAMP + bs * DECT;
    const bf16_t* prow = P + (size_t)(LEX0 + EX_SHIFT + bs) * NPB + C_RW;
#pragma unroll 1
    for (int col = tid; col < RW_SHIFT; col += 512) {
        const float mu = pk[PK_MU + col]; float prev = bf2f(prow[col]);
        float cur[4];
#pragma unroll
        for (int i = 0; i < 4; ++i) cur[i] = bf2f(P[(size_t)(row0 + i) * NPB + C_RW + col]);
        float* dst; int stride = 1024; bool th = false;
        if (col < 1024) dst = f + SR_R + col; else if (col < 2048) dst = f + SR_KK + (col - 1024); else if (col < 3072) dst = f + SR_V + (col - 2048);
        else if (col < 3136) { dst = f + SR_WD + (col - 3072); stride = 64; th = true; } else if (col < 3200) { dst = f + SR_AD + (col - 3136); stride = 64; } else dst = f + SR_ZB + (col - 3200);
#pragma unroll
        for (int i = 0; i < 4; ++i) { float m = cur[i] + mu * (prev - cur[i]); prev = cur[i]; if (th) m = tanh_(m); dst[i * stride] = m; }
    }
    __syncthreads();
#pragma unroll 1
    for (int cc = 0; cc < 2; ++cc) {
        const int c = tid + 512 * cc;
        float aw[4] = {0.f, 0.f, 0.f, 0.f}, aa[4] = {0.f, 0.f, 0.f, 0.f};
#pragma unroll 8
        for (int l = 0; l < 64; ++l) { const float w2v = pk[PK_W2 + l * D + c], a2v = pk[PK_A2 + l * D + c];
#pragma unroll
            for (int i = 0; i < 4; ++i) { aw[i] += f[SR_WD + i * 64 + l] * w2v; aa[i] += f[SR_AD + i * 64 + l] * a2v; } }
        const float w0c = pk[PK_W0 + c], a0c = pk[PK_A0 + c], kkc = pk[PK_KK + c], kac = pk[PK_KA + c];
#pragma unroll
        for (int i = 0; i < 4; ++i) { const float a = sigm(a0c + aa[i]); const float kbv = f[SR_KK + i * 1024 + c];
            f[SR_DEC + i * 1024 + c] = __expf(-0.6065306597126334f * sigm(w0c + aw[i])); f[SR_KA + i * 1024 + c] = a; f[SR_KK + i * 1024 + c] = kbv * kkc; f[SR_KM + i * 1024 + c] = kbv * (1.f + (a - 1.f) * kac); }
    }
    __syncthreads();
#pragma unroll 1
    for (int x = 0; x < 8; ++x) { const int pr = w * 8 + x, i = pr >> 4, hh = pr & 15; const int o = i * 1024 + hh * 64 + lane;
        const float kr = f[SR_KK + o]; const float kk = kr * __builtin_amdgcn_rsqf(wave_sum(kr * kr) + 1e-6f); f[SR_KK + o] = kk; f[SR_KA + o] = kk * f[SR_KA + o];
        const float rkv = wave_sum(f[SR_R + o] * f[SR_KM + o] * pk[PK_RK + hh * 64 + lane]); if (lane == 0) f[SR_RK + pr] = rkv; }
    __syncthreads();
#pragma unroll 1
    for (int hp = 0; hp < 2; ++hp) {
        const int hb = hp * 8 + w;
        const float* s_in = p.in[4] + (size_t)(bs * 16 + hb) * 4096 + (size_t)lane * 64; float* s_out = p.out + O_RWKV_S + (size_t)(bs * 16 + hb) * 4096 + (size_t)lane * 64;
        f32x4 S[16];
#pragma unroll
        for (int j = 0; j < 16; ++j) S[j] = *(const f32x4*)(s_in + 4 * j);
        const int cch = hb * 64 + lane;
        const float gnw = pk[PK_GNW + cch], gnb = pk[PK_GNB + cch];
#pragma unroll 1
        for (int i = 0; i < 4; ++i) {
            const int o = i * 1024 + hb * 64;
            const float vv = f[SR_V + o + lane], rk = f[SR_RK + i * 16 + hb];
            float sa = 0.f;
#pragma unroll
            for (int j = 0; j < 16; ++j) { const f32x4 kk4 = *(const f32x4*)(f + SR_KK + o + 4 * j); sa += S[j][0] * kk4[0] + S[j][1] * kk4[1] + S[j][2] * kk4[2] + S[j][3] * kk4[3]; }
            float y = 0.f;
#pragma unroll
            for (int j = 0; j < 16; ++j) { const f32x4 de4 = *(const f32x4*)(f + SR_DEC + o + 4 * j), ka4 = *(const f32x4*)(f + SR_KA + o + 4 * j), km4 = *(const f32x4*)(f + SR_KM + o + 4 * j), r4 = *(const f32x4*)(f + SR_R + o + 4 * j);
#pragma unroll
                for (int e = 0; e < 4; ++e) { S[j][e] = S[j][e] * de4[e] + (vv * km4[e] - sa * ka4[e]); y += S[j][e] * r4[e]; } }
            const float mu = wave_sum(y) * (1.f / 64.f); const float dy = y - mu;
            const float rs = __builtin_amdgcn_rsqf(wave_sum(dy * dy) * (1.f / 64.f) + 64e-5f);
            const float ov = (dy * rs * gnw + gnb + rk * vv) * silu_(f[SR_ZB + i * 1024 + cch]);
            ((bf16_t*)(p.ws + WS_OB))[(size_t)(XROWS + EX_SAMP + bs * DECT + i) * D + cch] = (bf16_t)f2bf(ov);
        }
#pragma unroll
        for (int j = 0; j < 16; ++j) *(f32x4*)(s_out + 4 * j) = S[j];
    }
    __syncthreads();
}

__device__ __forceinline__ void phase2(const Params& p, int seg, unsigned char* smem) {
    const int blk = obid();
    float* out = p.out;
    float* chalo = (float*)(p.ws + WS_CHALO); float* phalo = (float*)(p.ws + WS_PHALO);
#ifndef SUB
#define SUB 0
#endif
#define SEN(x) (SUB == 0 || SUB == (x))
    if (SEN(1) && blk < 64) gdn_scan_block(p, seg, smem, blk);
    if (SEN(3) && blk >= 64 && blk < 128) rwkv_scan_block(p, seg, smem, blk - 64);
#ifndef DUP
#define DUP 0
#endif
    if (seg == 0) {
#pragma unroll 1
        for (int it = blk; it < DECB * 8; it += gridDim.x) gdn_sample_item(p, smem, it >> 3, it & 7);
#pragma unroll 1
        for (int it = blk; it < DECB; it += gridDim.x) rwkv_sample_item(p, smem, it);
    }
}

__device__ __forceinline__ void phase25(const Params& p, int seg) {
    const int tid0 = otid(); const int lane = tid0 & 63; const int gw = obid() * 8 + (tid0 >> 6), NGW = gridDim.x * 8;
    const bf16_t* P = (const bf16_t*)(p.ws + WS_P);
    const float* ORAW = (const float*)(p.ws + WS_ORAW); const float* YRAW = (const float*)(p.ws + WS_YRAW);
    const bf16_t* C0 = (const bf16_t*)(p.ws + WS_C0); const bf16_t* C1 = (const bf16_t*)(p.ws + WS_C1);
    bf16_t* OA = (bf16_t*)(p.ws + WS_H); bf16_t* OB = (bf16_t*)(p.ws + WS_OB);
    const int nrows = LEX0 + (seg == 0 ? DECB * DECT : 0);
    const int c = lane * 16;
    f32x4 nw[4];
#pragma unroll
    for (int j = 0; j < 4; ++j) nw[j] = *(const f32x4*)((const float*)(p.ws + WS_PK) + PK_NORMW + (c & 127) + 4 * j);
#pragma unroll 1
    for (int rr = LEX0 + gw; rr < nrows; rr += NGW) {
        int lr; size_t grow;
        if (rr < LEX0) { lr = rr; grow = (size_t)(rr / SEGTOK) * SEQ + seg * SEGTOK + (rr % SEGTOK); } else { lr = LEX0 + EX_SAMP + (rr - LEX0); grow = (size_t)XROWS + EX_SAMP + (rr - LEX0); }
        {
            f32x4 o[4]; float ss = 0.f;
#pragma unroll
            for (int j = 0; j < 4; ++j) { o[j] = *(const f32x4*)(ORAW + (size_t)lr * D + c + 4 * j); ss += o[j][0] * o[j][0] + o[j][1] * o[j][1] + o[j][2] * o[j][2] + o[j][3] * o[j][3]; }
            ss += __shfl_xor(ss, 1); ss += __shfl_xor(ss, 2); ss += __shfl_xor(ss, 4);
            const float rs = __builtin_amdgcn_rsqf(ss * (1.f / 128.f) + 1e-6f);
            const u32x4 z0 = *(const u32x4*)(P + (size_t)lr * NPB + C_Z + c), z1 = *(const u32x4*)(P + (size_t)lr * NPB + C_Z + c + 8);
            const unsigned zz[8] = {z0.x, z0.y, z0.z, z0.w, z1.x, z1.y, z1.z, z1.w};
            unsigned ow[8];
#pragma unroll
            for (int j = 0; j < 8; ++j) { const float za = __uint_as_float(zz[j] << 16), zb = __uint_as_float(zz[j] & 0xffff0000u);
                const float a = o[j >> 1][(j & 1) * 2] * rs * nw[j >> 1][(j & 1) * 2] * silu_(za), b = o[j >> 1][(j & 1) * 2 + 1] * rs * nw[j >> 1][(j & 1) * 2 + 1] * silu_(zb);
                ow[j] = pk2(a, b); }
            *(u32x4*)(OA + grow * D + c) = (u32x4){ow[0], ow[1], ow[2], ow[3]}; *(u32x4*)(OA + grow * D + c + 8) = (u32x4){ow[4], ow[5], ow[6], ow[7]};
        }
    }
}

__device__ __forceinline__ void phase_final(const Params& p) {
    const int tid0 = otid(); const int lane = tid0 & 63; const int gw = obid() * 8 + (tid0 >> 6), NGW = gridDim.x * 8;
    const f32x4* wr = (const f32x4*)((const float*)(p.ws + WS_PK) + PK_LNF) + lane;
    f32x4 wv[4];
#pragma unroll
    for (int j = 0; j < 4; ++j) wv[j] = wr[64 * j];
    constexpr int NR = XROWS + DECB * DECT;
#pragma unroll 1
    for (int r = gw; r < NR; r += 2 * NGW) {
        const int r1 = r + NGW; const bool has1 = r1 < NR;
        f32x4* x0 = (f32x4*)(p.out + (size_t)r * D) + lane; f32x4* x1 = (f32x4*)(p.out + (size_t)(has1 ? r1 : r) * D) + lane;
        f32x4 a[4], b[4]; float s0 = 0.f, s1 = 0.f;
#pragma unroll
        for (int j = 0; j < 4; ++j) { a[j] = x0[64 * j]; b[j] = x1[64 * j]; }
#pragma unroll
        for (int j = 0; j < 4; ++j) { s0 += a[j][0] * a[j][0] + a[j][1] * a[j][1] + a[j][2] * a[j][2] + a[j][3] * a[j][3]; s1 += b[j][0] * b[j][0] + b[j][1] * b[j][1] + b[j][2] * b[j][2] + b[j][3] * b[j][3]; }
        const float q0 = __builtin_amdgcn_rsqf(wave_sum(s0) * (1.f / D) + 1e-6f), q1 = __builtin_amdgcn_rsqf(wave_sum(s1) * (1.f / D) + 1e-6f);
#pragma unroll
        for (int j = 0; j < 4; ++j) x0[64 * j] = a[j] * q0 * wv[j];
        if (has1) {
#pragma unroll
            for (int j = 0; j < 4; ++j) x1[64 * j] = b[j] * q1 * wv[j]; }
    }
}

__global__ __launch_bounds__(512, 2) void hybrid_mega(Params p) {
    extern __shared__ __attribute__((aligned(16))) unsigned char smem[];
    cg::grid_group grid = cg::this_grid();
    LAS unsigned char* lds = (LAS unsigned char*)smem;
    const int G = gridDim.x;
    volatile LAS unsigned* xst = (volatile LAS unsigned*)(lds + (LDS_TOTAL - 16));
    if (threadIdx.x == 0) { xst[0] = 0u; xst[1] = 0u; }
    __syncthreads();
    (void)xcd_barrier_post((unsigned*)(p.ws + WS_BAR), xst);
    if (G == 0x7fffffff) grid.sync();
#define GSYNC() do { XcdBarrier xb_; xb_.bar = (unsigned*)(p.ws + WS_BAR); xb_.x = xb_xcc_id(); xb_.st = (volatile LAS unsigned*)((LAS unsigned char*)smem + (LDS_TOTAL - 16)); xcd_barrier(xb_); } while (0)

#ifndef ONLY
#define ONLY 0
#endif
#define EN(x) (ONLY == 0 || ONLY == (x))
    if (EN(1)) phase0(p, smem);
    GSYNC();
#pragma unroll 1
    for (int it = 0; it <= NSEG + 2; ++it) {
        const int xblk = obid() - (G - 12);
        const bool xrole = xblk >= 0;
        if (it > 0 && it <= NSEG && EN(3)) phase2(p, it - 1, smem);
        if ((((it == 2 || it == 3) && xrole) || it == NSEG + 1) && EN(5)) {
            const bool ex = it <= 3;
            SchedAB S; S.ob.init(ex ? 3 : XROWS / 256, 4, ex ? 12 : G, ex ? xblk : obid()); S.pm0 = ex ? XROWS / 256 : 0; S.wfix = ex ? it - 2 : -1;
            S.A0 = (const char*)(p.ws + WS_H); S.A1 = (const char*)(p.ws + WS_OB); S.B0 = (const char*)(p.ws + WS_WT_A); S.B1 = (const char*)(p.ws + WS_WT_B);
            EpiAB E; E.tmp = ex ? (bf16_t*)(p.ws + WS_YRAW) - (size_t)XROWS * D : (bf16_t*)(p.ws + WS_P); E.merged = ex ? (bf16_t*)(p.ws + WS_C0) - (size_t)XROWS * D : (bf16_t*)(p.ws + WS_MG);
            E.gex = (const bf16_t*)(p.ws + WS_GEX); E.out = p.out;
            pg8::gemm_phase<EpiAB, SchedAB>(lds, D, S, E);
        }
        if (((it == 4 && xrole) || it == NSEG + 2) && EN(6)) {
            const bool ex = it == 4;
            SchedO S; S.ob.init(ex ? 3 : XROWS / 256, 4, ex ? 12 : G, ex ? xblk : obid()); S.pm0 = ex ? XROWS / 256 : 0;
            S.A = ex ? (const char*)((bf16_t*)(p.ws + WS_C0) - (size_t)XROWS * D) : (const char*)(p.ws + WS_MG); S.B = (const char*)(p.ws + WS_WT_O);
            EpiO E; E.out = p.out; E.xp = p.in[0]; E.xs = p.in[1];
            pg8::gemm_phase<EpiO, SchedO>(lds, D, S, E);
        }
        const bool xphase = it >= 2 && it <= 4;
        if (it < NSEG && EN(2) && !(xphase && xrole)) {
            const int seg = it;
            const int Gp = xphase ? G - 12 : G;
            const int cidx = it > 0 ? (obid() + (Gp >> 1)) % Gp : obid();
            SchedIn S; S.ob.init(seg == 0 ? LT_PROMPT + 3 : LT_PROMPT, NT_IN, Gp, cidx); S.seg = seg; S.A = (const char*)(p.ws + WS_H); S.B = (const char*)(p.ws + WS_WT_IN);
            EpiIn E; E.P = (bf16_t*)(p.ws + WS_P); E.gex = (bf16_t*)(p.ws + WS_GEX); E.out = p.out; E.seg = seg;
            pg8::gemm_phase<EpiIn, SchedIn>(lds, D, S, E);
        }
        if (it >= 1 && it + 1 < NSEG && obid() >= 200) { const int t0 = otid(); h_rows_segs(p, it + 1, it + 2, (obid() - 200) * 8 + (t0 >> 6), (G - 200) * 8, t0 & 63); }
        GSYNC();
        if (it < NSEG) {
            if (EN(8)) { phase_gprep(p, it, smem); phase_rprep(p, it, smem); }
            if (it == 1 && EN(4)) phase25(p, 0);
            GSYNC();
        }
    }
    if (EN(7)) phase_final(p);
}

extern "C" void kernel_launch(void* const* d_in, const int* in_sizes, int n_in, void* d_out, int out_size, void* d_ws, size_t ws_size, hipStream_t stream) {
    static int grid_blocks = 0;
    constexpr int LDS_BYTES = LDS_TOTAL;
    if (grid_blocks == 0) {
        if (n_in != 27 || ws_size < WS_END) { fprintf(stderr, "kernel_launch: unexpected n_in %d / ws %zu (need %zu)\n", n_in, ws_size, (size_t)WS_END); grid_blocks = -1; return; }
        if (hipFuncSetAttribute((const void*)hybrid_mega, hipFuncAttributeMaxDynamicSharedMemorySize, LDS_BYTES) != hipSuccess) { fprintf(stderr, "kernel_launch: hipFuncSetAttribute failed\n"); grid_blocks = -1; return; }
        int dev = 0, cus = 0, per_cu = 0;
        hipGetDevice(&dev);
        hipDeviceGetAttribute(&cus, hipDeviceAttributeMultiprocessorCount, dev);
        hipOccupancyMaxActiveBlocksPerMultiprocessor(&per_cu, (const void*)hybrid_mega, 512, LDS_BYTES);
        if (per_cu < 1) { fprintf(stderr, "kernel_launch: occupancy query says %d blocks/CU\n", per_cu); per_cu = 1; }
        (void)hipGetLastError();
        grid_blocks = cus;
    }
    if (grid_blocks < 0) return;
    Params p{};
    for (int i = 0; i < 27; ++i) p.in[i] = (const float*)d_in[i];
    p.out = (float*)d_out; p.ws = (unsigned char*)d_ws;
    if (hipMemsetAsync((unsigned char*)d_ws + WS_BAR, 0, 16384, stream) != hipSuccess) { fprintf(stderr, "kernel_launch: memset of the barrier words failed\n"); return; }
    void* args[] = {&p};
    hipError_t e = hipLaunchCooperativeKernel((const void*)hybrid_mega, dim3(grid_blocks), dim3(512), args, LDS_BYTES, stream);
    if (e != hipSuccess) fprintf(stderr, "cooperative launch failed: %s (grid %d)\n", hipGetErrorString(e), grid_blocks);
}
```

```cpp
#include <hip/hip_runtime.h>
#include <hip/hip_cooperative_groups.h>
#include <cstdio>
namespace cg = cooperative_groups;

#define LAS __attribute__((address_space(3)))
typedef unsigned short bf16_t;
typedef short bf16x8 __attribute__((ext_vector_type(8)));
typedef float f32x4 __attribute__((ext_vector_type(4)));
typedef unsigned u32x4 __attribute__((ext_vector_type(4)));
typedef unsigned u32x2 __attribute__((ext_vector_type(2)));

constexpr int D = 1024;
constexpr int NBATCH = 8, SEQ = 2048, NMETA = 16, DECB = 128, DECT = 4;
constexpr int XROWS = NBATCH * SEQ;
constexpr int EX_SAMP = 16, EX_SHIFT = 528, EX_END = 656;
constexpr int HROWS = 17152, HTILES = 67;
constexpr int NSEG = 8, SEGTOK = SEQ / NSEG;
constexpr int CPS = SEGTOK / 64;
constexpr int TPB = SEGTOK / 256;
constexpr int LT_PROMPT = NBATCH * TPB;
constexpr int LEX0 = LT_PROMPT * 256;
constexpr int LROWS = LEX0 + 768;
constexpr int NP = 10496, NPB = 8448, NT_IN = 41, NT_PB = 33;
constexpr int C_A = 3072, C_B = 3080, C_Z = 3088, C_RW = 4112, C_GATE_REF = 8336;
constexpr int RW_SHIFT = 4224;

constexpr size_t O_YP = 0, O_YS = 16777216, O_GDN_P = 17301504, O_CONV_P = 18350080, O_RWKV_P = 18423808, O_SHIFT_P = 18948096,
                 O_GDN_S = 18956288, O_CONV_S = 35733504, O_RWKV_S = 36913152, O_SHIFT_S = 45301760;

constexpr size_t al256(size_t x) { return (x + 255) & ~(size_t)255; }
constexpr size_t WS_WT_IN = 0;
constexpr size_t WS_WT_A = al256(WS_WT_IN + (size_t)NP * D * 2);
constexpr size_t WS_WT_B = al256(WS_WT_A + (size_t)D * D * 2);
constexpr size_t WS_WT_O = al256(WS_WT_B + (size_t)D * D * 2);
constexpr size_t WS_H = al256(WS_WT_O + (size_t)D * D * 2);
constexpr size_t WS_OB = al256(WS_H + (size_t)HROWS * D * 2);
constexpr size_t WS_P = al256(WS_OB + (size_t)HROWS * D * 2);
constexpr size_t WS_ORAW = al256(WS_P + (size_t)LROWS * NPB * 2);
constexpr size_t WS_YRAW = al256(WS_ORAW + (size_t)LROWS * D * 4);
constexpr size_t WS_C0 = al256(WS_YRAW + (size_t)LROWS * D * 4);
constexpr size_t WS_C1 = al256(WS_C0 + (size_t)LROWS * D * 2);
constexpr size_t WS_GEX = al256(WS_C1 + (size_t)LROWS * D * 2);
constexpr size_t WS_CHALO = al256(WS_GEX + (size_t)768 * 2048 * 2);
constexpr size_t WS_PHALO = al256(WS_CHALO + (size_t)2 * NBATCH * 3 * NPB * 2);
constexpr size_t WS_PK = al256(WS_PHALO + (size_t)2 * NBATCH * NPB * 2);
constexpr int PK_CONVW = 0, PK_ALOG = 12288, PK_DTB = 12296, PK_NORMW = 12304, PK_MU = 12432, PK_W0 = 16656, PK_W2 = 17680, PK_A0 = 83216, PK_A2 = 84240,
              PK_KK = 149776, PK_KA = 150800, PK_RK = 151824, PK_GNW = 152848, PK_GNB = 153872, PK_LNF = 154896, PK_END = 155920;
constexpr size_t WS_BAR = al256(WS_PK + (size_t)PK_END * 4);
constexpr size_t WS_W2T = al256(WS_BAR + 16384);
constexpr size_t WS_A2T = al256(WS_W2T + 131072);
constexpr size_t WS_GP = al256(WS_A2T + 131072);
constexpr int GP_AP = 0, GP_QH = 32768, GP_KH = 49152, GP_OH = 81920, GP_EGL = 98304, GP_G = 98560, GP_STRIDE = 114944;
constexpr int RP_AP = 0, RP_RH = 8192, RP_KH = 16384, RP_YH = 24576, RP_C1 = 32768, RP_C0 = 40960, RP_PC = 49152, RP_STRIDE = 49408;
constexpr size_t WS_RP = al256(WS_GP + (size_t)(CPS + 1) * 64 * GP_STRIDE);
constexpr size_t WS_END = al256(WS_RP + (size_t)(CPS + 1) * 128 * RP_STRIDE);
constexpr size_t WS_MG = WS_GP;
static_assert((size_t)HROWS * D * 2 <= WS_END - WS_GP, "MERGED must fit in the prep records");
static_assert((size_t)HROWS * D * 4 <= (size_t)LROWS * NPB * 2 + 2 * (size_t)LROWS * D * 4, "TMP must fit in P+ORAW+YRAW");
static_assert(WS_END <= (size_t)268435456, "workspace");

constexpr int LDS_TOTAL = 163840;
struct Params { const float* in[27]; float* out; unsigned char* ws; };

__device__ __forceinline__ float bf2f(bf16_t v) { return __uint_as_float(((unsigned)v) << 16); }
typedef __bf16 bf16n2 __attribute__((ext_vector_type(2)));
typedef float f32n2 __attribute__((ext_vector_type(2)));
__device__ __forceinline__ unsigned cvt_pk_bf16(float lo, float hi) { const f32n2 v = {lo, hi}; return __builtin_bit_cast(unsigned, __builtin_convertvector(v, bf16n2)); }
__device__ __forceinline__ unsigned pk2(float lo, float hi) { return cvt_pk_bf16(lo, hi); }
__device__ __forceinline__ unsigned f2bf(float f) { return cvt_pk_bf16(f, 0.f) & 0xffffu; }
__device__ __forceinline__ float sigm(float x) { return __builtin_amdgcn_rcpf(1.f + __expf(-x)); }
__device__ __forceinline__ float silu_(float x) { return x * __builtin_amdgcn_rcpf(1.f + __expf(-x)); }
__device__ __forceinline__ float softplus_(float x) { return fmaxf(x, 0.f) + log1pf(expf(-fabsf(x))); }
__device__ __forceinline__ float wave_sum(float v) {
#pragma unroll
    for (int o = 1; o < 64; o <<= 1) v += __shfl_xor(v, o);
    return v;
}
__device__ __forceinline__ void unpack8(const u32x4 rw, float (&x)[8]) {
    x[0] = __uint_as_float(rw.x << 16); x[1] = __uint_as_float(rw.x & 0xffff0000u); x[2] = __uint_as_float(rw.y << 16); x[3] = __uint_as_float(rw.y & 0xffff0000u);
    x[4] = __uint_as_float(rw.z << 16); x[5] = __uint_as_float(rw.z & 0xffff0000u); x[6] = __uint_as_float(rw.w << 16); x[7] = __uint_as_float(rw.w & 0xffff0000u); }
__device__ __forceinline__ u32x4 pack8(const float (&x)[8]) { return (u32x4){pk2(x[0], x[1]), pk2(x[2], x[3]), pk2(x[4], x[5]), pk2(x[6], x[7])}; }

__device__ __forceinline__ int otid() { int t = threadIdx.x; asm volatile("" : "+v"(t)); return t; }
__device__ __forceinline__ int obid() { int t = blockIdx.x; asm volatile("" : "+s"(t)); return t; }
__device__ __forceinline__ float tanh_(float x) { const float e = __expf(2.f * x); return 1.f - 2.f * __builtin_amdgcn_rcpf(e + 1.f); }
template <int CTRL> __device__ __forceinline__ float dppf(float x) { return __builtin_bit_cast(float, __builtin_amdgcn_mov_dpp(__builtin_bit_cast(int, x), CTRL, 0xf, 0xf, true)); }
__device__ __forceinline__ float rowsum16(float x) { x += dppf<0x128>(x); x += dppf<0x124>(x); x += dppf<0x122>(x); x += dppf<0x121>(x); return x; }


#define XB_TMO      128
#define XB_XCNT(j)  (256  + 64 * (j))
#define XB_XSUB(j)  (1280 + 64 * (j))
#define XB_XGEN(j)  (2304 + 64 * (j))
#define XB_TOP      3328
#define XB_TOPGEN   3392
#define XCD_BAR_WORDS 3456
#define XB_SPIN_CAP (1u << 22)
__device__ __forceinline__ unsigned xb_ld(unsigned* p)              { return __hip_atomic_load(p, __ATOMIC_RELAXED, __HIP_MEMORY_SCOPE_AGENT); }
__device__ __forceinline__ unsigned xb_add(unsigned* p, unsigned v) { return __hip_atomic_fetch_add(p, v, __ATOMIC_RELAXED, __HIP_MEMORY_SCOPE_AGENT); }
__device__ __forceinline__ unsigned xb_xcc_id() { return (unsigned)__builtin_amdgcn_s_getreg((3 << 11) | 20) & 0xFu; }
#define XB_SPIN(cond, bar) do { unsigned _sp = 0; while (cond) { __builtin_amdgcn_s_sleep(1); \
    if ((++_sp & 255u) == 0u) { if (xb_ld(&(bar)[XB_TMO])) break; if (_sp > XB_SPIN_CAP) { atomicAdd(&(bar)[XB_TMO], 1u); break; } } } } while (0)
struct XcdBarrier { unsigned* bar; unsigned x; volatile LAS unsigned* st; };
__device__ __forceinline__ XcdBarrier xcd_barrier_post(unsigned* bar, volatile LAS unsigned* st) {
    XcdBarrier b; b.bar = bar; b.x = xb_xcc_id(); b.st = st;
    if (threadIdx.x == 0) (void)xb_add(&bar[XB_XCNT(b.x)], 1u);
    return b;
}
__device__ __forceinline__ void xcd_barrier_complete(unsigned* bar, unsigned x, unsigned& nloc, unsigned& nx) {
    const unsigned G = gridDim.x * gridDim.y * gridDim.z;
    unsigned sum, cnt, mine, sp = 0u;
    for (;;) {
        sum = 0u; cnt = 0u; mine = 0u;
#pragma unroll
        for (unsigned j = 0; j < 16; ++j) { const unsigned c = xb_ld(&bar[XB_XCNT(j)]); sum += c; cnt += (c > 0u) ? 1u : 0u; mine = (j == x) ? c : mine; }
        if (sum == G) break;
        __builtin_amdgcn_s_sleep(1);
        if ((++sp & 255u) == 0u) { if (xb_ld(&bar[XB_TMO])) break; if (sp > XB_SPIN_CAP) { atomicAdd(&bar[XB_TMO], 1u); break; } }
    }
    nloc = mine > 0u ? mine : 1u; nx = cnt > 0u ? cnt : 1u;
}
__device__ __forceinline__ void xcd_barrier(const XcdBarrier& b) {
    asm volatile("s_waitcnt vmcnt(0)" ::: "memory");
    __syncthreads();
    if (threadIdx.x == 0) {
        unsigned* bar = b.bar;
        __builtin_amdgcn_s_waitcnt(0);
        unsigned nloc = b.st[0], nx = b.st[1];
        if (nloc == 0u) { xcd_barrier_complete(bar, b.x, nloc, nx); b.st[0] = nloc; b.st[1] = nx; }
        const unsigned old = xb_add(&bar[XB_XSUB(b.x)], 1u);
        const unsigned gen = old / nloc;
        if (old + 1u == (gen + 1u) * nloc) {
            __builtin_amdgcn_fence(__ATOMIC_RELEASE, "agent");
            asm volatile("s_waitcnt vmcnt(0)" ::: "memory");
            const unsigned og = xb_add(&bar[XB_TOP], 1u);
            const unsigned tg = og / nx;
            if (og + 1u == (tg + 1u) * nx) xb_add(&bar[XB_TOPGEN], 1u);
            else XB_SPIN(xb_ld(&bar[XB_TOPGEN]) == tg, bar);
            __builtin_amdgcn_fence(__ATOMIC_ACQUIRE, "agent");
            xb_add(&bar[XB_XGEN(b.x)], 1u);
            asm volatile("s_waitcnt vmcnt(0)" ::: "memory");
        } else {
            XB_SPIN(xb_ld(&bar[XB_XGEN(b.x)]) == gen, bar);
            __builtin_amdgcn_fence(__ATOMIC_ACQUIRE, "agent");
            asm volatile("s_waitcnt vmcnt(0)" ::: "memory");
        }
    }
    __syncthreads();
}

namespace pg8 {
constexpr int BM = 256, BK = 64, HALF = 128, HTB = HALF * BK * 2, STAGE_BYTES = 8 * HTB, NXCD = 8, WGM = 8;
__device__ __forceinline__ int lds_byte(int r, int c) { const int st = (r >> 4) * 2 + (c >> 5), rr = r & 15, cc = c & 31, ob = rr * 64 + cc * 2; return st * 1024 + (ob ^ (((ob >> 9) & 1) << 5)); }
__device__ __forceinline__ void stage_rc(int b, int& R, int& C) { const int st = b / 1024, sb = b % 1024, swz = sb ^ (((sb >> 9) & 1) << 5); R = (st >> 1) * 16 + swz / 64; C = (st & 1) * 32 + (swz % 64) / 2; }
__device__ __forceinline__ int perm32(int rho) { const int n = rho >> 4, i = rho & 15; return 8 * (i >> 2) + 4 * n + (i & 3); }

struct Unit { int pm, pn, w; };
struct OrderBase {
    int nM, nN, nwg, G, c;
    __device__ void init(int nM_, int nN_, int G_, int c_) { nM = nM_; nN = nN_; nwg = nM * nN; G = G_; c = c_; }
    __device__ bool nextb(int i, Unit& u) const {
        const long L = (long)i * G + c; if (L >= nwg) return false;
        int wgid = (int)L; { const int q = nwg / NXCD, r = nwg % NXCD, xcd = wgid % NXCD, off = wgid / NXCD; wgid = (xcd < r ? xcd * (q + 1) : r * (q + 1) + (xcd - r) * q) + off; }
        const int nig = WGM * nN, gid = wgid / nig, fm = gid * WGM, gsz = (nM - fm) < WGM ? (nM - fm) : WGM;
        u.pm = fm + ((wgid % nig) % gsz); u.pn = (wgid % nig) / gsz; u.w = 0; return true;
    }
};

template <class Epi, class Sched>
__device__ __forceinline__ void gemm_phase(LAS unsigned char* lds, const int K, const Sched& S, const Epi& E) {
    const int tid = otid(), wid = __builtin_amdgcn_readfirstlane(tid >> 6), lane = tid & 63, wr = wid >> 2, wc = wid & 3, fr = lane & 15, fq = lane >> 4;
    const int nt = K / BK;
    unsigned voffA[2], voffB[2];
#pragma unroll
    for (int i = 0; i < 2; ++i) { int R, C; stage_rc(tid * 16 + i * 8192, R, C); const int Rb = Epi::PERM ? ((R & ~31) + perm32(R & 31)) : R;
        voffA[i] = (unsigned)(R * K + C) * 2u; voffB[i] = (unsigned)(Rb * K + C) * 2u; }
    const size_t kstep = (size_t)(BK * 2);
    const size_t hstep = (size_t)HALF * K * 2;
    const unsigned ldsw = (unsigned)wid * 1024u;
    const int aoff = lds_byte(wr * 64 + fr, fq * 8), boff = lds_byte(wc * 32 + fr, fq * 8);
#define PG8_SA(b, h) (((b) * 2 + (h)) * HTB)
#define PG8_SB(b, h) ((4 + (b) * 2 + (h)) * HTB)
#define PG8_STAGE(bufoff, gbase, voff) do { _Pragma("unroll") for (int _i = 0; _i < 2; ++_i) \
        __builtin_amdgcn_global_load_lds((const unsigned*)((const char*)(gbase) + (voff)[_i]), (LAS unsigned*)(lds + (bufoff) + ldsw + _i * 8192), 16, 0, 0); } while (0)
#define PG8_LDA(dst, b, h) do { _Pragma("unroll") for (int m = 0; m < 4; ++m) _Pragma("unroll") for (int k = 0; k < 2; ++k) dst[m][k] = *(const LAS bf16x8*)(lds + PG8_SA(b, h) + aoff + m * 2048 + k * 1024); } while (0)
#define PG8_LDB(dst, b, h) do { _Pragma("unroll") for (int n = 0; n < 2; ++n) _Pragma("unroll") for (int k = 0; k < 2; ++k) dst[n][k] = *(const LAS bf16x8*)(lds + PG8_SB(b, h) + boff + n * 2048 + k * 1024); } while (0)
#define PG8_MMA(ai, bj, At, Bt) do { __builtin_amdgcn_s_setprio(1); _Pragma("unroll") for (int m = 0; m < 4; ++m) _Pragma("unroll") for (int n = 0; n < 2; ++n) _Pragma("unroll") for (int k = 0; k < 2; ++k) \
        acc[ai][bj][m][n] = __builtin_amdgcn_mfma_f32_16x16x32_bf16(Bt[n][k], At[m][k], acc[ai][bj][m][n], 0, 0, 0); __builtin_amdgcn_s_setprio(0); } while (0)
#define PG8_WAIT_V(n) asm volatile("s_waitcnt vmcnt(" #n ")" ::: "memory")
#define PG8_WAIT_L(n) asm volatile("s_waitcnt lgkmcnt(" #n ")" ::: "memory")
#define PG8_BAR __builtin_amdgcn_s_barrier()
#define PG8_SCHED __builtin_amdgcn_sched_barrier(0)
    Unit cur, nxt; int ui = 0;
    if (!S.next(0, cur)) return;
    f32x4 acc[2][2][4][2];
#pragma unroll
    for (int a = 0; a < 2; ++a)
#pragma unroll
        for (int b = 0; b < 2; ++b)
#pragma unroll
            for (int m = 0; m < 4; ++m)
#pragma unroll
                for (int n = 0; n < 2; ++n) acc[a][b][m][n] = (f32x4){0.f, 0.f, 0.f, 0.f};
    bf16x8 At[4][2], B0[2][2], B1[2][2];
    const char* cA = S.a_ptr(cur); const char* cB = S.b_ptr(cur);
    PG8_STAGE(PG8_SB(0, 0), cB, voffB); PG8_STAGE(PG8_SA(0, 0), cA, voffA); PG8_STAGE(PG8_SB(0, 1), cB + hstep, voffB); PG8_STAGE(PG8_SA(0, 1), cA + hstep, voffA);
    if (wr == 1) PG8_BAR;
    PG8_WAIT_V(4); PG8_BAR;
    PG8_STAGE(PG8_SB(1, 0), cB + kstep, voffB); PG8_STAGE(PG8_SA(1, 0), cA + kstep, voffA); PG8_STAGE(PG8_SB(1, 1), cB + hstep + kstep, voffB);
    PG8_WAIT_V(6); PG8_BAR;
    for (;;) {
        const bool has_next = S.next(ui + 1, nxt);
        const char* nA = has_next ? S.a_ptr(nxt) : cA; const char* nB = has_next ? S.b_ptr(nxt) : cB;
        for (int t = 0; t < nt; t += 2) {
            const bool last = (t == nt - 2);
            const char* a1 = cA + (size_t)(t + 1) * kstep;
            const char* a2 = last ? nA : cA + (size_t)(t + 2) * kstep; const char* b2 = last ? nB : cB + (size_t)(t + 2) * kstep;
            const char* a3 = a2 + kstep; const char* b3 = b2 + kstep;
            PG8_LDB(B0, 0, 0); PG8_SCHED; PG8_LDA(At, 0, 0); PG8_STAGE(PG8_SA(1, 1), a1 + hstep, voffA);
            PG8_WAIT_L(8); PG8_BAR; PG8_WAIT_L(0); PG8_MMA(0, 0, At, B0); PG8_BAR; PG8_SCHED;
            PG8_LDB(B1, 0, 1); PG8_STAGE(PG8_SB(0, 0), b2, voffB);
            PG8_BAR; PG8_WAIT_L(0); PG8_MMA(0, 1, At, B1); PG8_BAR;
            PG8_LDA(At, 0, 1); PG8_STAGE(PG8_SA(0, 0), a2, voffA);
            PG8_BAR; PG8_WAIT_L(0); PG8_MMA(1, 0, At, B0); PG8_BAR; PG8_SCHED;
            PG8_STAGE(PG8_SB(0, 1), b2 + hstep, voffB);
            PG8_WAIT_V(6); PG8_BAR; PG8_MMA(1, 1, At, B1); PG8_BAR;
            PG8_LDB(B0, 1, 0); PG8_SCHED; PG8_LDA(At, 1, 0); PG8_STAGE(PG8_SA(0, 1), a2 + hstep, voffA);
            PG8_WAIT_L(8); PG8_BAR; PG8_WAIT_L(0); PG8_MMA(0, 0, At, B0); PG8_BAR; PG8_SCHED;
            PG8_LDB(B1, 1, 1); PG8_STAGE(PG8_SB(1, 0), b3, voffB);
            PG8_BAR; PG8_WAIT_L(0); PG8_MMA(0, 1, At, B1); PG8_BAR;
            PG8_LDA(At, 1, 1); PG8_STAGE(PG8_SA(1, 0), a3, voffA);
            PG8_BAR; PG8_WAIT_L(0); PG8_MMA(1, 0, At, B0); PG8_BAR; PG8_SCHED;
            PG8_STAGE(PG8_SB(1, 1), b3 + hstep, voffB);
            PG8_WAIT_V(6); PG8_BAR; PG8_MMA(1, 1, At, B1); PG8_BAR;
        }
        E(acc, cur, wr, wc, fr, fq);
        if (!has_next) break;
#pragma unroll
        for (int a = 0; a < 2; ++a)
#pragma unroll
            for (int b = 0; b < 2; ++b)
#pragma unroll
                for (int m = 0; m < 4; ++m)
#pragma unroll
                    for (int n = 0; n < 2; ++n) acc[a][b][m][n] = (f32x4){0.f, 0.f, 0.f, 0.f};
        cur = nxt; cA = nA; cB = nB; ++ui;
    }
    PG8_WAIT_V(0);
    if (wr == 0) PG8_BAR;
    PG8_BAR;
#undef PG8_SA
#undef PG8_SB
#undef PG8_STAGE
#undef PG8_LDA
#undef PG8_LDB
#undef PG8_MMA
#undef PG8_WAIT_V
#undef PG8_WAIT_L
#undef PG8_BAR
#undef PG8_SCHED
}
}
using pg8::Unit;

struct SchedIn {
    pg8::OrderBase ob; int seg; const char* A; const char* B;
    __device__ bool next(int i, Unit& u) const { return ob.nextb(i, u); }
    __device__ const char* a_ptr(const Unit& u) const {
        const int gt = u.pm < LT_PROMPT ? ((u.pm / TPB) * (SEQ / 256) + seg * TPB + (u.pm % TPB)) : (XROWS / 256 + (u.pm - LT_PROMPT));
        return A + (size_t)gt * 256 * D * 2; }
    __device__ const char* b_ptr(const Unit& u) const { return B + (size_t)u.pn * 256 * D * 2; }
};
struct SchedAB {
    pg8::OrderBase ob; int pm0, wfix; const char* A0; const char* A1; const char* B0; const char* B1;
    __device__ bool next(int i, Unit& u) const { const bool ok = wfix < 0 ? ob.nextb(i >> 1, u) : ob.nextb(i, u); u.pm += pm0; u.w = wfix < 0 ? (i & 1) : wfix; return ok; }
    __device__ const char* a_ptr(const Unit& u) const { return (u.w ? A1 : A0) + (size_t)u.pm * 256 * D * 2; }
    __device__ const char* b_ptr(const Unit& u) const { return (u.w ? B1 : B0) + (size_t)u.pn * 256 * D * 2; }
};
struct SchedO {
    pg8::OrderBase ob; int pm0; const char* A; const char* B;
    __device__ bool next(int i, Unit& u) const { const bool ok = ob.nextb(i, u); u.pm += pm0; return ok; }
    __device__ const char* a_ptr(const Unit& u) const { return A + (size_t)u.pm * 256 * D * 2; }
    __device__ const char* b_ptr(const Unit& u) const { return B + (size_t)u.pn * 256 * D * 2; }
};

struct EpiIn {
    static constexpr bool PERM = true;
    bf16_t* P; bf16_t* gex; float* out; int seg;
    __device__ __forceinline__ void operator()(const f32x4 (&acc)[2][2][4][2], const Unit& u, int wr, int wc, int fr, int fq) const {
        const int lr0 = u.pm * 256 + wr * 64 + fr;
        const int c0 = u.pn * 256 + wc * 32 + 8 * fq;
#pragma unroll
        for (int ai = 0; ai < 2; ++ai)
#pragma unroll
            for (int m = 0; m < 4; ++m) {
                const int lr = lr0 + ai * 128 + m * 16;
                bf16_t* rowp;
                if (u.pn < NT_PB) rowp = P + (size_t)lr * NPB + c0;
                else if (lr < LEX0) { const int b = lr / SEGTOK; const size_t grow = (size_t)b * SEQ + seg * SEGTOK + (lr % SEGTOK); rowp = (bf16_t*)(out + O_YP + grow * D) + (c0 - NPB); }
                else rowp = gex + (size_t)(lr - LEX0) * 2048 + (c0 - NPB);
#pragma unroll
                for (int bj = 0; bj < 2; ++bj) { const f32x4 v0 = acc[ai][bj][m][0], v1 = acc[ai][bj][m][1];
                    u32x4 w; w.x = cvt_pk_bf16(v0[0], v0[1]); w.y = cvt_pk_bf16(v0[2], v0[3]); w.z = cvt_pk_bf16(v1[0], v1[1]); w.w = cvt_pk_bf16(v1[2], v1[3]);
                    *(u32x4*)(rowp + bj * 128) = w; }
            }
    }
};
struct EpiAB {
    static constexpr bool PERM = true;
    bf16_t* tmp; bf16_t* merged; const bf16_t* gex; const float* out;
    __device__ __forceinline__ void operator()(const f32x4 (&acc)[2][2][4][2], const Unit& u, int wr, int wc, int fr, int fq) const {
        const int row0 = u.pm * 256 + wr * 64 + fr, col0 = u.pn * 256 + wc * 32 + 8 * fq;
#pragma unroll
        for (int ai = 0; ai < 2; ++ai)
#pragma unroll
            for (int m = 0; m < 4; ++m) {
                const int grow = row0 + ai * 128 + m * 16;
                const bf16_t* gp = (grow < XROWS) ? ((const bf16_t*)(out + O_YP + (size_t)grow * D) + u.w * D) : (gex + (size_t)(grow - XROWS) * 2048 + u.w * D);
#pragma unroll
                for (int bj = 0; bj < 2; ++bj) {
                    const int c = col0 + bj * 128;
                    float g[8]; unpack8(*(const u32x4*)(gp + c), g);
                    const f32x4 v0 = acc[ai][bj][m][0], v1 = acc[ai][bj][m][1];
                    float v[8] = {v0[0] * sigm(g[0]), v0[1] * sigm(g[1]), v0[2] * sigm(g[2]), v0[3] * sigm(g[3]), v1[0] * sigm(g[4]), v1[1] * sigm(g[5]), v1[2] * sigm(g[6]), v1[3] * sigm(g[7])};
                    bf16_t* tp = tmp + (size_t)grow * D + c;
                    if (u.w == 0) *(u32x4*)tp = pack8(v);
                    else { float t[8]; unpack8(*(const u32x4*)tp, t);
#pragma unroll
                        for (int e = 0; e < 8; ++e) v[e] += t[e];
                        *(u32x4*)(merged + (size_t)grow * D + c) = pack8(v); }
                }
            }
    }
};
struct EpiO {
    static constexpr bool PERM = false;
    float* out; const float* xp; const float* xs;
    __device__ __forceinline__ void operator()(const f32x4 (&acc)[2][2][4][2], const Unit& u, int wr, int wc, int fr, int fq) const {
        const int row0 = u.pm * 256 + wr * 64 + fr, col0 = u.pn * 256 + wc * 32 + 4 * fq;
#pragma unroll
        for (int ai = 0; ai < 2; ++ai)
#pragma unroll
            for (int m = 0; m < 4; ++m) {
                const int grow = row0 + ai * 128 + m * 16;
                const float* xr; float* yr;
                if (grow < XROWS) { xr = xp + (size_t)grow * D; yr = out + O_YP + (size_t)grow * D; }
                else { const int e = grow - XROWS; if (e < EX_SAMP || e >= EX_SHIFT) continue; xr = xs + (size_t)(e - EX_SAMP) * D; yr = out + O_YS + (size_t)(e - EX_SAMP) * D; }
#pragma unroll
                for (int bj = 0; bj < 2; ++bj)
#pragma unroll
                    for (int n = 0; n < 2; ++n) { const int c = col0 + bj * 128 + n * 16; *(f32x4*)(yr + c) = *(const f32x4*)(xr + c) + acc[ai][bj][m][n]; }
            }
    }
};

__device__ __forceinline__ void p0_row(const Params& p, int r, int lane) {
    bf16_t* hrow = (bf16_t*)(p.ws + WS_H) + (size_t)r * D;
    const float* src = nullptr; bool norm = true; float* sh = nullptr;
    if (r < XROWS) { src = p.in[0] + (size_t)r * D; if ((r & (SEQ - 1)) == SEQ - 1) sh = p.out + O_SHIFT_P + (size_t)(r / SEQ) * D; }
    else { const int e = r - XROWS;
        if (e < EX_SAMP) src = p.in[6] + (size_t)e * D;
        else if (e < EX_SHIFT) { src = p.in[1] + (size_t)(e - EX_SAMP) * D; if (((e - EX_SAMP) & 3) == 3) sh = p.out + O_SHIFT_S + (size_t)((e - EX_SAMP) >> 2) * D; }
        else if (e < EX_END) { src = p.in[5] + (size_t)(e - EX_SHIFT) * D; norm = false; } }
    u32x2* o8 = (u32x2*)hrow + lane;
    if (!src) {
#pragma unroll
        for (int j = 0; j < 4; ++j) o8[64 * j] = (u32x2){0u, 0u};
        return; }
    const f32x4* xr = (const f32x4*)src + lane;
    f32x4 v[4]; float ss = 0.f;
#pragma unroll
    for (int j = 0; j < 4; ++j) { v[j] = xr[64 * j]; ss += v[j][0] * v[j][0] + v[j][1] * v[j][1] + v[j][2] * v[j][2] + v[j][3] * v[j][3]; }
    if (norm) {
        const float rs = __builtin_amdgcn_rsqf(wave_sum(ss) * (1.f / D) + 1e-6f);
        const f32x4* wr = (const f32x4*)p.in[7] + lane;
#pragma unroll
        for (int j = 0; j < 4; ++j) v[j] = v[j] * rs * wr[64 * j];
    }
#pragma unroll
    for (int j = 0; j < 4; ++j) { o8[64 * j] = (u32x2){pk2(v[j][0], v[j][1]), pk2(v[j][2], v[j][3])}; if (sh) ((f32x4*)sh)[lane + 64 * j] = v[j]; }
}
template <int MODE> __device__ __forceinline__ void p0_tr_item(const float* W, int N, bf16_t* WT, float* scr, int kb, int nb, int lane) {
    const int k0 = 64 * kb, n0 = 32 * nb;
    const int l8 = lane & 7, r8 = lane >> 3;
    const int nn = n0 + 4 * l8;
    int srcc = nn;
    if (MODE == 1) srcc = nn < C_GATE_REF ? nn : (nn < NPB ? -1 : nn - (NPB - C_GATE_REF));
    f32x4 v[8];
#pragma unroll
    for (int i = 0; i < 8; ++i) { const int kk = 8 * i + r8; v[i] = srcc >= 0 ? *(const f32x4*)(W + (size_t)(k0 + kk) * N + srcc) : (f32x4){0.f, 0.f, 0.f, 0.f}; }
#pragma unroll
    for (int i = 0; i < 8; ++i) { const int kk = 8 * i + r8; float* d = scr + kk * 33 + 4 * l8; d[0] = v[i][0]; d[1] = v[i][1]; d[2] = v[i][2]; d[3] = v[i][3]; }
    asm volatile("s_waitcnt lgkmcnt(0)" ::: "memory");
    const int c = lane & 7;
#pragma unroll
    for (int j = 0; j < 4; ++j) { const int n = (lane >> 3) + 8 * j; const float* s = scr + (8 * c) * 33 + n;
        u32x4 o; o.x = pk2(s[0 * 33], s[1 * 33]); o.y = pk2(s[2 * 33], s[3 * 33]); o.z = pk2(s[4 * 33], s[5 * 33]); o.w = pk2(s[6 * 33], s[7 * 33]);
        *(u32x4*)(WT + (size_t)(n0 + n) * D + k0 + 8 * c) = o; }
    asm volatile("s_waitcnt lgkmcnt(0)" ::: "memory");
}
__device__ __forceinline__ void h_rows_pair(const Params& p, int r, int r1, bool has1, int lane, const f32x4 (&wv)[4]) {
    const f32x4* x0 = (const f32x4*)(p.in[0] + (size_t)r * D) + lane; const f32x4* x1 = (const f32x4*)(p.in[0] + (size_t)(has1 ? r1 : r) * D) + lane;
    f32x4 a[4], b[4]; float s0 = 0.f, s1 = 0.f;
#pragma unroll
    for (int j = 0; j < 4; ++j) { a[j] = x0[64 * j]; b[j] = x1[64 * j]; }
#pragma unroll
    for (int j = 0; j < 4; ++j) { s0 += a[j][0] * a[j][0] + a[j][1] * a[j][1] + a[j][2] * a[j][2] + a[j][3] * a[j][3]; s1 += b[j][0] * b[j][0] + b[j][1] * b[j][1] + b[j][2] * b[j][2] + b[j][3] * b[j][3]; }
    const float q0 = __builtin_amdgcn_rsqf(wave_sum(s0) * (1.f / D) + 1e-6f), q1 = __builtin_amdgcn_rsqf(wave_sum(s1) * (1.f / D) + 1e-6f);
    u32x2* o0 = (u32x2*)((bf16_t*)(p.ws + WS_H) + (size_t)r * D) + lane; u32x2* o1 = (u32x2*)((bf16_t*)(p.ws + WS_H) + (size_t)r1 * D) + lane;
#pragma unroll
    for (int j = 0; j < 4; ++j) { a[j] = a[j] * q0 * wv[j]; o0[64 * j] = (u32x2){pk2(a[j][0], a[j][1]), pk2(a[j][2], a[j][3])}; }
    if ((r & (SEQ - 1)) == SEQ - 1) { f32x4* sh = (f32x4*)(p.out + O_SHIFT_P + (size_t)(r / SEQ) * D) + lane;
#pragma unroll
        for (int j = 0; j < 4; ++j) sh[64 * j] = a[j]; }
    if (has1) {
#pragma unroll
        for (int j = 0; j < 4; ++j) { b[j] = b[j] * q1 * wv[j]; o1[64 * j] = (u32x2){pk2(b[j][0], b[j][1]), pk2(b[j][2], b[j][3])}; }
        if ((r1 & (SEQ - 1)) == SEQ - 1) { f32x4* sh = (f32x4*)(p.out + O_SHIFT_P + (size_t)(r1 / SEQ) * D) + lane;
#pragma unroll
            for (int j = 0; j < 4; ++j) sh[64 * j] = b[j]; }
    }
}
__device__ __forceinline__ void h_rows_segs(const Params& p, int s_lo, int s_hi, int wi, int nw, int lane) {
    const f32x4* lw = (const f32x4*)p.in[7] + lane;
    f32x4 wv[4];
#pragma unroll
    for (int j = 0; j < 4; ++j) wv[j] = lw[64 * j];
    const int n = (s_hi - s_lo) * NBATCH * SEGTOK;
#pragma unroll 1
    for (int x = wi; x < n; x += 2 * nw) {
        const int x1 = x + nw; const bool has1 = x1 < n;
        const int sg = s_lo + x / (NBATCH * SEGTOK), rem = x % (NBATCH * SEGTOK), r = (rem / SEGTOK) * SEQ + sg * SEGTOK + (rem % SEGTOK);
        const int xx = has1 ? x1 : x; const int sg1 = s_lo + xx / (NBATCH * SEGTOK), rem1 = xx % (NBATCH * SEGTOK), r1 = (rem1 / SEGTOK) * SEQ + sg1 * SEGTOK + (rem1 % SEGTOK);
        h_rows_pair(p, r, r1, has1, lane, wv);
    }
}
__device__ __forceinline__ void phase0(const Params& p, unsigned char* smem) {
    const int tid0 = otid(), wave = tid0 >> 6, lane = tid0 & 63;
    const int gw = obid() * 8 + wave, NGW = gridDim.x * 8;
    float* scr = (float*)smem + wave * (64 * 33);
    constexpr int I_IN = 16 * (NP / 32), I_SQ = 16 * 32;
    for (int it = gw; it < I_IN + 3 * I_SQ; it += NGW) {
        int r = it;
        if (r < I_IN) { p0_tr_item<1>(p.in[8], 10384, (bf16_t*)(p.ws + WS_WT_IN), scr, r / (NP / 32), r % (NP / 32), lane); continue; } r -= I_IN;
        if (r < I_SQ) { p0_tr_item<0>(p.in[13], D, (bf16_t*)(p.ws + WS_WT_A), scr, r / 32, r % 32, lane); continue; } r -= I_SQ;
        if (r < I_SQ) { p0_tr_item<0>(p.in[24], D, (bf16_t*)(p.ws + WS_WT_B), scr, r / 32, r % 32, lane); continue; } r -= I_SQ;
        p0_tr_item<0>(p.in[25], D, (bf16_t*)(p.ws + WS_WT_O), scr, r / 32, r % 32, lane);
    }
    h_rows_segs(p, 0, 2, gw, NGW, lane);
    for (int r = XROWS + gw; r < HROWS; r += NGW) p0_row(p, r, lane);
    {
        float* pk = (float*)(p.ws + WS_PK);
        const int gt = obid() * 512 + tid0, NT = gridDim.x * 512;
        for (int i = gt; i < PK_END; i += NT) {
            const float* src; int o;
            if (i < PK_ALOG) { src = p.in[9]; o = i - PK_CONVW; } else if (i < PK_DTB) { src = p.in[10]; o = i - PK_ALOG; } else if (i < PK_NORMW) { src = p.in[11]; o = i - PK_DTB; }
            else if (i < PK_MU) { src = p.in[12]; o = i - PK_NORMW; } else if (i < PK_W0) { src = p.in[14]; o = i - PK_MU; } else if (i < PK_W2) { src = p.in[15]; o = i - PK_W0; }
            else if (i < PK_A0) { src = p.in[16]; o = i - PK_W2; } else if (i < PK_A2) { src = p.in[17]; o = i - PK_A0; } else if (i < PK_KK) { src = p.in[18]; o = i - PK_A2; }
            else if (i < PK_KA) { src = p.in[19]; o = i - PK_KK; } else if (i < PK_RK) { src = p.in[20]; o = i - PK_KA; } else if (i < PK_GNW) { src = p.in[21]; o = i - PK_RK; }
            else if (i < PK_GNB) { src = p.in[22]; o = i - PK_GNW; } else if (i < PK_LNF) { src = p.in[23]; o = i - PK_GNB; } else { src = p.in[26]; o = i - PK_LNF; }
            pk[i] = src[o];
        }
        bf16_t* w2t = (bf16_t*)(p.ws + WS_W2T); bf16_t* a2t = (bf16_t*)(p.ws + WS_A2T);
        for (int i = gt; i < 65536; i += NT) { const int l = i & 63, c = (i >> 6) & 63, hb = i >> 12;
            w2t[i] = (bf16_t)f2bf(p.in[16][(size_t)l * D + hb * 64 + c]); a2t[i] = (bf16_t)f2bf(p.in[18][(size_t)l * D + hb * 64 + c]); }
    }
}

__device__ __forceinline__ void gdn_item(const Params& p, unsigned char* smem, const float* s_in, float* s_out, const float* halo_in, float* halo_out,
                                         int h, int sl, int rowA, int nA, int rowB, int nB) {
    const int tid = otid(), w = tid >> 6, lane = tid & 63, vl = lane >> 4, kg = lane & 15;
    float* qk_s = (float*)smem; float* v_s = qk_s + 16384; float* o_s = v_s + 2048; float* gb_s = o_s + 2048; float* sst = gb_s + 128;
    const bf16_t* P = (const bf16_t*)(p.ws + WS_P);
    float* ORAW = (float*)(p.ws + WS_ORAW);
    float s[8];
    if (s_in) {
        { const int k = tid >> 2, q4 = tid & 3; const f32x4* src = (const f32x4*)(s_in + (size_t)k * 128 + sl * 32 + q4 * 8); const f32x4 a = src[0], b = src[1];
          float* d = sst + k * 33 + q4 * 8; d[0] = a[0]; d[1] = a[1]; d[2] = a[2]; d[3] = a[3]; d[4] = b[0]; d[5] = b[1]; d[6] = b[2]; d[7] = b[3]; }
        __syncthreads();
#pragma unroll
        for (int j = 0; j < 8; ++j) s[j] = sst[(kg * 8 + j) * 33 + 4 * w + vl];
        __syncthreads();
    } else {
#pragma unroll
        for (int j = 0; j < 8; ++j) s[j] = 0.f;
    }
    int pcol = -1;
    if (tid < 128) pcol = h * 128 + tid; else if (tid < 256) pcol = 1024 + h * 128 + (tid - 128); else if (tid < 288) pcol = 2048 + h * 128 + sl * 32 + (tid - 256);
    float cw0 = 0.f, cw1 = 0.f, cw2 = 0.f, cw3 = 0.f, x1 = 0.f, x2 = 0.f, x3 = 0.f;
    const float* pk = (const float*)(p.ws + WS_PK);
    if (pcol >= 0) { const float* cw = pk + PK_CONVW; cw0 = cw[pcol]; cw1 = cw[3072 + pcol]; cw2 = cw[6144 + pcol]; cw3 = cw[9216 + pcol];
        if (halo_in) { x3 = halo_in[pcol]; x2 = halo_in[3072 + pcol]; x1 = halo_in[6144 + pcol]; } }
    const float nalog = -expf(pk[PK_ALOG + h]), dtb = pk[PK_DTB + h];
#pragma unroll 1
    for (int run = 0; run < 2; ++run) {
        const int rrow = run ? rowB : rowA, rn = run ? nB : nA; const bool wout = run != 0;
#pragma unroll 1
        for (int c0 = 0; c0 < rn; c0 += 64) {
            const int nt = (rn - c0) < 64 ? (rn - c0) : 64; const int row = rrow + c0;
            if (pcol >= 0) {
                const bf16_t* src = P + (size_t)row * NPB + pcol;
                float* dst = tid < 256 ? (qk_s + tid) : (v_s + (tid - 256)); const int dstride = tid < 256 ? 256 : 32;
#pragma unroll 8
                for (int i = 0; i < nt; ++i) { const float x0 = bf2f(src[(size_t)i * NPB]); const float y = cw0 * x3 + cw1 * x2 + cw2 * x1 + cw3 * x0; x3 = x2; x2 = x1; x1 = x0; dst[i * dstride] = silu_(y); }
            } else if (tid < 352) {
                const int i = tid - 288;
                if (i < nt) { const float pa = bf2f(P[(size_t)(row + i) * NPB + C_A + h]), pb = bf2f(P[(size_t)(row + i) * NPB + C_B + h]);
                    gb_s[2 * i] = expf(nalog * softplus_(pa + dtb)); gb_s[2 * i + 1] = sigm(pb); }
            }
            __syncthreads();
#pragma unroll 1
            for (int ii = 0; ii < 8; ++ii) { const int i = w * 8 + ii;
                if (i < nt) {
#pragma unroll
                    for (int which = 0; which < 2; ++which) { float* rp = qk_s + i * 256 + which * 128; const float a = rp[lane], b = rp[lane + 64];
                        const float sc = __builtin_amdgcn_rsqf(wave_sum(a * a + b * b) + 1e-6f) * (which == 0 ? 0.08838834764831845f : 1.f); rp[lane] = a * sc; rp[lane + 64] = b * sc; } } }
            __syncthreads();
#pragma unroll 1
            for (int i = 0; i < nt; ++i) {
                const f32x4 q0 = *(const f32x4*)(qk_s + i * 256 + kg * 8), q1 = *(const f32x4*)(qk_s + i * 256 + kg * 8 + 4);
                const f32x4 k0 = *(const f32x4*)(qk_s + i * 256 + 128 + kg * 8), k1 = *(const f32x4*)(qk_s + i * 256 + 128 + kg * 8 + 4);
                const float vv = v_s[i * 32 + 4 * w + vl], a = gb_s[2 * i], be = gb_s[2 * i + 1];
                float part = k0[0] * s[0] + k0[1] * s[1] + k0[2] * s[2] + k0[3] * s[3] + k1[0] * s[4] + k1[1] * s[5] + k1[2] * s[6] + k1[3] * s[7];
                const float kS = rowsum16(part);
                const float c = be * (vv - a * kS);
                s[0] = a * s[0] + k0[0] * c; s[1] = a * s[1] + k0[1] * c; s[2] = a * s[2] + k0[2] * c; s[3] = a * s[3] + k0[3] * c;
                s[4] = a * s[4] + k1[0] * c; s[5] = a * s[5] + k1[1] * c; s[6] = a * s[6] + k1[2] * c; s[7] = a * s[7] + k1[3] * c;
                float op = q0[0] * s[0] + q0[1] * s[1] + q0[2] * s[2] + q0[3] * s[3] + q1[0] * s[4] + q1[1] * s[5] + q1[2] * s[6] + q1[3] * s[7];
                const float o = rowsum16(op);
                if (kg == 0) o_s[i * 32 + 4 * w + vl] = o;
            }
            __syncthreads();
            if (wout) { const int i = tid >> 3, c4 = (tid & 7) * 4; if (i < nt) *(f32x4*)(ORAW + (size_t)(row + i) * D + h * 128 + sl * 32 + c4) = *(const f32x4*)(o_s + i * 32 + c4); }
        }
    }
    if (pcol >= 0 && (sl == 0 || tid >= 256)) { halo_out[pcol] = x3; halo_out[3072 + pcol] = x2; halo_out[6144 + pcol] = x1; }
#pragma unroll
    for (int j = 0; j < 8; ++j) sst[(kg * 8 + j) * 33 + 4 * w + vl] = s[j];
    __syncthreads();
    { const int k = tid >> 2, q4 = tid & 3; const float* d = sst + k * 33 + q4 * 8; f32x4* dst = (f32x4*)(s_out + (size_t)k * 128 + sl * 32 + q4 * 8);
      dst[0] = (f32x4){d[0], d[1], d[2], d[3]}; dst[1] = (f32x4){d[4], d[5], d[6], d[7]}; }
    __syncthreads();
}

constexpr int RW_W2 = 20544, RW_A2 = 24640;
__device__ __forceinline__ void rwkv_load_lora(const Params& p, unsigned char* smem, int hb) {
    float* w2_s = (float*)smem + RW_W2; float* a2_s = (float*)smem + RW_A2; const float* pk = (const float*)(p.ws + WS_PK);
    for (int i = otid(); i < 4096; i += 512) { const int l = i >> 6, c = i & 63; w2_s[i] = pk[PK_W2 + l * D + hb * 64 + c]; a2_s[i] = pk[PK_A2 + l * D + hb * 64 + c]; }
    __syncthreads();
}
__device__ __forceinline__ void rwkv_item(const Params& p, unsigned char* smem, const float* s_in, float* s_out, const bf16_t* prev_row, const float* halo_in, float* halo_out,
                                          int hb, int half, int rowA, int nA, int rowB, int nB) {
    const int tid = otid(), w = tid >> 6, lane = tid & 63, row = tid >> 4, kq = tid & 15;
    float* f = (float*)smem;
    float* r_s = f; float* kb_s = f + 2048; float* v_s = f + 4096; float* wd_s = f + 6144; float* ad_s = f + 8192; float* dec_s = f + 10240; float* a_s = f + 12288;
    float* kk_s = f + 14336; float* km_s = f + 16384; float* zb_s = f + 18432; float* y_s = f + 19456; float* bonus_s = f + 20480;
    const float* w2_s = f + RW_W2; const float* a2_s = f + RW_A2;
    const bf16_t* P = (const bf16_t*)(p.ws + WS_P);
    float* YRAW = (float*)(p.ws + WS_YRAW); bf16_t* C0 = (bf16_t*)(p.ws + WS_C0); bf16_t* C1 = (bf16_t*)(p.ws + WS_C1);
    float s[4];
    if (s_in) { const f32x4 t = *(const f32x4*)(s_in + (size_t)(half * 32 + row) * 64 + kq * 4); s[0] = t[0]; s[1] = t[1]; s[2] = t[2]; s[3] = t[3]; }
    else { s[0] = s[1] = s[2] = s[3] = 0.f; }
    int col = -1; float* dst = nullptr; int dstride = 64; bool is_wd = false, owner = false;
    if (tid < 64) { col = hb * 64 + tid; dst = r_s + tid; owner = half == 0; }
    else if (tid < 128) { col = 1024 + hb * 64 + (tid - 64); dst = kb_s + (tid - 64); owner = half == 0; }
    else if (tid < 192) { col = 2048 + hb * 64 + (tid - 128); dst = v_s + (tid - 128); owner = half == 0; }
    else if (tid < 256) { col = 3072 + (tid - 192); dst = wd_s + (tid - 192); is_wd = true; owner = (half == 0 && hb == 0); }
    else if (tid < 320) { col = 3136 + (tid - 256); dst = ad_s + (tid - 256); owner = (half == 0 && hb == 0); }
    else if (tid < 352) { col = 3200 + hb * 64 + half * 32 + (tid - 320); dst = zb_s + (tid - 320); dstride = 32; owner = true; }
    float mu = 0.f, prev = 0.f;
    const float* pk = (const float*)(p.ws + WS_PK);
    if (col >= 0) { mu = pk[PK_MU + col]; prev = prev_row ? bf2f(prev_row[C_RW + col]) : (halo_in ? halo_in[col] : 0.f); }
    const int cc = tid & 63, ig = tid >> 6;
    const int hc = hb * 64 + cc;
    const float w0c = pk[PK_W0 + hc], a0c = pk[PK_A0 + hc], kkc = pk[PK_KK + hc], kac = pk[PK_KA + hc];
    const float rkl = pk[PK_RK + hb * 64 + lane];
#pragma unroll 1
    for (int run = 0; run < 2; ++run) {
        const int rrow = run ? rowB : rowA, rn = run ? nB : nA; const bool wout = run != 0;
#pragma unroll 1
        for (int c0 = 0; c0 < rn; c0 += 32) {
            const int nt = (rn - c0) < 32 ? (rn - c0) : 32; const int row0 = rrow + c0;
            if (col >= 0) {
                const bf16_t* src = P + (size_t)row0 * NPB + C_RW + col;
#pragma unroll 8
                for (int i = 0; i < nt; ++i) { const float cur = bf2f(src[(size_t)i * NPB]); float m = cur + mu * (prev - cur); prev = cur; if (is_wd) m = tanh_(m); dst[i * dstride] = m; }
            }
            __syncthreads();
            {
                float aw[4] = {0.f, 0.f, 0.f, 0.f}, aa[4] = {0.f, 0.f, 0.f, 0.f};
#pragma unroll 4
                for (int l = 0; l < 64; ++l) { const float w2v = w2_s[l * 64 + cc], a2v = a2_s[l * 64 + cc];
#pragma unroll
                    for (int ii = 0; ii < 4; ++ii) { aw[ii] += wd_s[(ig * 4 + ii) * 64 + l] * w2v; aa[ii] += ad_s[(ig * 4 + ii) * 64 + l] * a2v; } }
#pragma unroll
                for (int ii = 0; ii < 4; ++ii) { const int i = ig * 4 + ii;
                    if (i < nt) { const float wraw = w0c + aw[ii]; const float wlog = -0.6065306597126334f * sigm(wraw); const float a = sigm(a0c + aa[ii]);
                        const float kbv = kb_s[i * 64 + cc];
                        dec_s[i * 64 + cc] = expf(wlog); a_s[i * 64 + cc] = a; kk_s[i * 64 + cc] = kbv * kkc; km_s[i * 64 + cc] = kbv * (1.f + (a - 1.f) * kac); } }
            }
            __syncthreads();
#pragma unroll 1
            for (int ii = 0; ii < 4; ++ii) { const int i = w * 4 + ii;
                if (i < nt) { const float kkr = kk_s[i * 64 + lane]; const float kk = kkr * __builtin_amdgcn_rsqf(wave_sum(kkr * kkr) + 1e-6f); kk_s[i * 64 + lane] = kk;
                    const float a = a_s[i * 64 + lane]; a_s[i * 64 + lane] = kk * a;
                    const float rk = wave_sum(r_s[i * 64 + lane] * km_s[i * 64 + lane] * rkl); if (lane == 0) bonus_s[i] = rk; } }
            __syncthreads();
#pragma unroll 1
            for (int i = 0; i < nt; ++i) {
                const f32x4 kk4 = *(const f32x4*)(kk_s + i * 64 + kq * 4), de4 = *(const f32x4*)(dec_s + i * 64 + kq * 4), ka4 = *(const f32x4*)(a_s + i * 64 + kq * 4),
                            km4 = *(const f32x4*)(km_s + i * 64 + kq * 4), r4 = *(const f32x4*)(r_s + i * 64 + kq * 4);
                const float vv = v_s[i * 64 + half * 32 + row];
                const float sa = rowsum16(s[0] * kk4[0] + s[1] * kk4[1] + s[2] * kk4[2] + s[3] * kk4[3]);
#pragma unroll
                for (int j = 0; j < 4; ++j) s[j] = s[j] * de4[j] + (vv * km4[j] - sa * ka4[j]);
                const float y = rowsum16(s[0] * r4[0] + s[1] * r4[1] + s[2] * r4[2] + s[3] * r4[3]);
                if (kq == 0) y_s[i * 32 + row] = y;
            }
            __syncthreads();
            if (wout) { const int i = tid >> 4;
                if (i < nt) {
#pragma unroll
                    for (int q = 0; q < 2; ++q) { const int rr = (tid & 15) * 2 + q, v = half * 32 + rr, colo = hb * 64 + v;
                        const float sz = silu_(zb_s[i * 32 + rr]);
                        const size_t o = (size_t)(row0 + i) * D + colo;
                        YRAW[o] = y_s[i * 32 + rr]; C1[o] = (bf16_t)f2bf(pk[PK_GNW + colo] * sz); C0[o] = (bf16_t)f2bf((pk[PK_GNB + colo] + bonus_s[i] * v_s[i * 64 + v]) * sz); } } }
            __syncthreads();
        }
    }
    *(f32x4*)(s_out + (size_t)(half * 32 + row) * 64 + kq * 4) = (f32x4){s[0], s[1], s[2], s[3]};
    if (col >= 0 && owner && halo_out) halo_out[col] = prev;
}


__device__ __forceinline__ bf16x8 ldfrag(const bf16_t* base, int stride, int r0, int k0, int lane) {
    return *(const bf16x8*)(base + (r0 + (lane & 15)) * stride + k0 + 8 * (lane >> 4));
}
#define MFMA16(a, b, c) __builtin_amdgcn_mfma_f32_16x16x32_bf16((a), (b), (c), 0, 0, 0)
typedef short s16x4 __attribute__((ext_vector_type(4)));
__device__ __forceinline__ bf16x8 ldfrag_tr(const bf16_t* X, int stride, int c0, int k0, int lane) {
    const int l15 = lane & 15;
    const bf16_t* a = X + (k0 + 8 * (lane >> 4) + (l15 >> 2)) * stride + c0 + 4 * (l15 & 3);
    const s16x4 lo = __builtin_amdgcn_ds_read_tr16_b64_v4i16((LAS s16x4*)a), hi = __builtin_amdgcn_ds_read_tr16_b64_v4i16((LAS s16x4*)(a + 4 * stride));
    return __builtin_shufflevector(lo, hi, 0, 1, 2, 3, 4, 5, 6, 7);
}
__device__ __forceinline__ void inv_block(const float* L, float* Tm, float* XS, int tid) {
    const int w = tid >> 6, lane = tid & 63;
    typedef float f32x2v __attribute__((ext_vector_type(2)));
    if (w < 4 && lane < 16) {
        const float* Lb = L + (16 * w) * 64 + 16 * w; float* Tb = Tm + (16 * w) * 64 + 16 * w;
        float tr[16];
#pragma unroll
        for (int i = 0; i < 16; ++i) tr[i] = 0.f;
#pragma unroll
        for (int i = 0; i < 16; ++i) { float a = (lane == i) ? 1.f : 0.f;
#pragma unroll
            for (int j0 = 0; j0 < i; j0 += 4) { const f32x4 l4 = *(const f32x4*)(Lb + i * 64 + j0);
                a -= l4[0] * tr[j0] + l4[1] * tr[j0 + 1] + l4[2] * tr[j0 + 2] + l4[3] * tr[j0 + 3]; }
            tr[i] = a; Tb[i * 64 + lane] = a; }
    }
    for (int e = tid; e < 1536; e += 512) { const int k = e >> 8, r = (e >> 4) & 15, c = e & 15;
        const int rb = k < 3 ? 0 : (k < 5 ? 1 : 2), cb = k < 3 ? k + 1 : (k < 5 ? k - 1 : 3);
        Tm[(16 * rb + r) * 64 + 16 * cb + c] = 0.f; }
    __syncthreads();
    {
        const int B = tid >> 8, i = (tid >> 4) & 15, c = tid & 15, o = 32 * B;
        float x = 0.f;
#pragma unroll
        for (int j0 = 0; j0 < 16; j0 += 4) { const f32x4 l4 = *(const f32x4*)(L + (o + 16 + i) * 64 + o + j0);
            x += l4[0] * Tm[(o + j0) * 64 + o + c] + l4[1] * Tm[(o + j0 + 1) * 64 + o + c] + l4[2] * Tm[(o + j0 + 2) * 64 + o + c] + l4[3] * Tm[(o + j0 + 3) * 64 + o + c]; }
        XS[tid] = x;
        __syncthreads();
        float t = 0.f;
#pragma unroll
        for (int j0 = 0; j0 < 16; j0 += 4) { const f32x4 t4 = *(const f32x4*)(Tm + (o + 16 + i) * 64 + o + 16 + j0);
            t += t4[0] * XS[(B << 8) + j0 * 16 + c] + t4[1] * XS[(B << 8) + (j0 + 1) * 16 + c] + t4[2] * XS[(B << 8) + (j0 + 2) * 16 + c] + t4[3] * XS[(B << 8) + (j0 + 3) * 16 + c]; }
        Tm[(o + 16 + i) * 64 + o + c] = -t;
    }
    __syncthreads();
    {
        const int i = tid >> 4, c2 = (tid & 15) * 2;
        float x0 = 0.f, x1 = 0.f;
#pragma unroll
        for (int j0 = 0; j0 < 32; j0 += 4) { const f32x4 l4 = *(const f32x4*)(L + (32 + i) * 64 + j0);
#pragma unroll
            for (int e = 0; e < 4; ++e) { const f32x2v tv = *(const f32x2v*)(Tm + (j0 + e) * 64 + c2); x0 += l4[e] * tv[0]; x1 += l4[e] * tv[1]; } }
        *(f32x2v*)(XS + i * 32 + c2) = (f32x2v){x0, x1};
        __syncthreads();
        float t0 = 0.f, t1 = 0.f;
#pragma unroll
        for (int j0 = 0; j0 < 32; j0 += 4) { const f32x4 t4 = *(const f32x4*)(Tm + (32 + i) * 64 + 32 + j0);
#pragma unroll
            for (int e = 0; e < 4; ++e) { const f32x2v xv = *(const f32x2v*)(XS + (j0 + e) * 32 + c2); t0 += t4[e] * xv[0]; t1 += t4[e] * xv[1]; } }
        *(f32x2v*)(Tm + (32 + i) * 64 + c2) = (f32x2v){-t0, -t1};
    }
    __syncthreads();
}
constexpr int PL_QS = 0, PL_R1 = 17408, PL_KT = 35840, PL_KTT = 54272, PL_VT = 72704, PL_R3 = 91136, PL_QKM = 109568, PL_TP = 118784, PL_TPP = 128000, PL_SM = 137216, PL_TM = 139264, PL_XS = 155648;
constexpr int QSTR = 136, TSTR = 72;

__device__ __forceinline__ void gdn_prep_item(const Params& p, unsigned char* smem, int h, int row_start, int npad, const bf16_t* hbase,
                                              bf16_t* halo_out, float* conv_out, unsigned char* rec) {
    const int tid = otid(), w = tid >> 6, lane = tid & 63, q4 = lane >> 4, l15 = lane & 15;
    bf16_t* qs = (bf16_t*)(smem + PL_QS); bf16_t* ks = (bf16_t*)(smem + PL_R1); bf16_t* WT = (bf16_t*)(smem + PL_KTT);     bf16_t* kts = (bf16_t*)(smem + PL_KT);
    bf16_t* vs = (bf16_t*)(smem + PL_VT);         float* Lm = (float*)(smem + PL_R3); bf16_t* UT = (bf16_t*)(smem + PL_R3); bf16_t* QKm = (bf16_t*)(smem + PL_QKM);
    bf16_t* Tp = (bf16_t*)(smem + PL_TP); bf16_t* Tpp = (bf16_t*)(smem + PL_TPP);
    float* sm = (float*)(smem + PL_SM);
    float* gcs = sm; float* bes = sm + 64; float* ssq = sm + 128; float* ssk = sm + 192; float* egs = sm + 256; float* egl_s = sm + 320; float* beg = sm + 384;
    const bf16_t* P = (const bf16_t*)(p.ws + WS_P);
    const float* pk = (const float*)(p.ws + WS_PK);
    if (w == 7) {
        const int i = lane;
        float g = 0.f, be = 0.f;
        if (i >= npad) { const size_t r = (size_t)(row_start + i - npad) * NPB; const float pa = bf2f(P[r + C_A + h]), pb = bf2f(P[r + C_B + h]);
            g = -expf(pk[PK_ALOG + h]) * softplus_(pa + pk[PK_DTB + h]); be = sigm(pb); }
        float x = g;
#pragma unroll
        for (int o = 1; o < 64; o <<= 1) { const float y = __shfl_up(x, o); if (lane >= o) x += y; }
        const float gl = __shfl(x, 63);
        gcs[lane] = x; bes[lane] = be; egs[lane] = __expf(x); egl_s[lane] = __expf(gl - x); beg[lane] = be * __expf(x);
        if (lane == 0) *(float*)(rec + GP_EGL) = __expf(gl);
    }
    __syncthreads();
    if (npad == 0 && tid >= 384) {
#pragma unroll 1
        for (int k = 0; k < 4; ++k) {
            const int slot = (tid - 384) + 128 * k, t = slot >> 3, g = slot & 7;
            const bf16_t* zp = P + (size_t)(row_start + t) * NPB + C_Z + h * 128 + 16 * g;
            const u32x4 z0 = *(const u32x4*)zp, z1 = *(const u32x4*)(zp + 8);
            float za[8], zb[8]; unpack8(z0, za); unpack8(z1, zb);
            const float* nwp = pk + PK_NORMW + 16 * g;
            float ga[8], gb2[8];
#pragma unroll
            for (int e = 0; e < 8; ++e) { ga[e] = nwp[e] * silu_(za[e]); gb2[e] = nwp[8 + e] * silu_(zb[e]); }
            bf16_t* gp = (bf16_t*)(rec + GP_G) + t * 128 + 16 * g;
            *(u32x4*)gp = pack8(ga); *(u32x4*)(gp + 8) = pack8(gb2);
        }
    }
    if (tid < 384) {
        const int sec = tid >> 7, ts = (tid >> 4) & 7, t0 = 8 * ts, d0 = l15 * 8;
        const int pcol = sec * 1024 + h * 128 + d0;
        float cw[4][8];
#pragma unroll
        for (int j = 0; j < 4; ++j) { const f32x4 a = *(const f32x4*)(pk + PK_CONVW + j * 3072 + pcol), b = *(const f32x4*)(pk + PK_CONVW + j * 3072 + pcol + 4);
            cw[j][0] = a[0]; cw[j][1] = a[1]; cw[j][2] = a[2]; cw[j][3] = a[3]; cw[j][4] = b[0]; cw[j][5] = b[1]; cw[j][6] = b[2]; cw[j][7] = b[3]; }
        u32x4 rw[11]; float fv[11];
#pragma unroll
        for (int k = 0; k < 11; ++k) {
            const int ii = t0 - 3 + k;
            const bf16_t* ptr = P + pcol; float f = 0.f;
            if (ii >= npad) { ptr = P + (size_t)(row_start + ii - npad) * NPB + pcol; f = 1.f; }
            else if (ii < 0 && npad == 0 && hbase) { ptr = hbase + (size_t)(ii + 3) * NPB + pcol; f = 1.f; }
            rw[k] = *(const u32x4*)ptr; fv[k] = f;
        }
        if (halo_out && ts == 7) {
#pragma unroll
            for (int dd = 0; dd < 3; ++dd) { *(u32x4*)(halo_out + (size_t)dd * NPB + pcol) = rw[8 + dd];
                if (conv_out) { float x[8]; unpack8(rw[8 + dd], x); *(f32x4*)(conv_out + dd * 3072 + pcol) = (f32x4){x[0], x[1], x[2], x[3]}; *(f32x4*)(conv_out + dd * 3072 + pcol + 4) = (f32x4){x[4], x[5], x[6], x[7]}; } }
        }
        float y[8][8];
#pragma unroll
        for (int t = 0; t < 8; ++t)
#pragma unroll
            for (int e = 0; e < 8; ++e) y[t][e] = 0.f;
#pragma unroll
        for (int k = 0; k < 11; ++k) { float x[8]; unpack8(rw[k], x);
#pragma unroll
            for (int e = 0; e < 8; ++e) x[e] *= fv[k];
#pragma unroll
            for (int dlt = 0; dlt < 4; ++dlt) { const int t = k - dlt;
                if (t >= 0 && t < 8) {
#pragma unroll
                    for (int e = 0; e < 8; ++e) y[t][e] += cw[dlt][e] * x[e]; } }
        }
        const float qsc = sec == 0 ? 0.08838834764831845f : 1.f;
#pragma unroll
        for (int t = 0; t < 8; ++t) {
            const bool tokv = (t0 + t) >= npad;
            float ss = 0.f;
#pragma unroll
            for (int e = 0; e < 8; ++e) { y[t][e] = tokv ? silu_(y[t][e]) : 0.f; ss += y[t][e] * y[t][e]; }
            if (sec < 2) { const float sc = __builtin_amdgcn_rsqf(rowsum16(ss) + 1e-6f) * qsc;
#pragma unroll
                for (int e = 0; e < 8; ++e) y[t][e] *= sc; }
        }
        { bf16_t* dst = sec == 0 ? qs : (sec == 1 ? ks : vs);
#pragma unroll
            for (int t = 0; t < 8; ++t) *(u32x4*)(dst + (t0 + t) * QSTR + d0) = pack8(y[t]); }
        if (sec == 1) {
#pragma unroll
            for (int t = 0; t < 8; ++t) { const float eg = egl_s[t0 + t]; float z[8];
#pragma unroll
                for (int e = 0; e < 8; ++e) z[e] = y[t][e] * eg;
                *(u32x4*)(kts + (t0 + t) * QSTR + d0) = pack8(z); } }
    }
    __syncthreads();
    {
        const int which = w >> 2, it = w & 3;
        const bf16_t* Barr = which ? qs : ks;
        bf16x8 bfr[4];
#pragma unroll
        for (int kk = 0; kk < 4; ++kk) bfr[kk] = ldfrag(Barr, QSTR, 16 * it, 32 * kk, lane);
        const int i = 16 * it + l15; const float gi = gcs[i], bi = bes[i];
#pragma unroll
        for (int jt = 0; jt < 4; ++jt) {
            f32x4 acc = {0.f, 0.f, 0.f, 0.f};
#pragma unroll
            for (int kk = 0; kk < 4; ++kk) acc = MFMA16(ldfrag(ks, QSTR, 16 * jt, 32 * kk, lane), bfr[kk], acc);
            const int j0 = 16 * jt + 4 * q4; const f32x4 gj = *(const f32x4*)(gcs + j0);
            f32x4 o;
#pragma unroll
            for (int r = 0; r < 4; ++r) { const int j = j0 + r; const bool keep = which ? (i >= j) : (i > j); o[r] = keep ? acc[r] * __expf(gi - gj[r]) : 0.f; }
            if (which == 0) *(f32x4*)(Lm + i * 64 + j0) = o * bi;
            else *(u32x2*)(QKm + i * TSTR + j0) = (u32x2){pk2(o[0], o[1]), pk2(o[2], o[3])};
        }
    }
    __syncthreads();
    {
        float* Tm = (float*)(smem + PL_TM);
        inv_block(Lm, Tm, (float*)(smem + PL_XS), tid);
        const int i = tid >> 3, j0 = (tid & 7) * 8;
        float a[8], b2[8];
#pragma unroll
        for (int e = 0; e < 8; ++e) { const float tv = Tm[i * 64 + j0 + e]; a[e] = tv * beg[j0 + e]; b2[e] = tv * bes[j0 + e]; }
        *(u32x4*)(Tp + i * TSTR + j0) = (u32x4){pk2(a[0], a[1]), pk2(a[2], a[3]), pk2(a[4], a[5]), pk2(a[6], a[7])};
        *(u32x4*)(Tpp + i * TSTR + j0) = (u32x4){pk2(b2[0], b2[1]), pk2(b2[2], b2[3]), pk2(b2[4], b2[5]), pk2(b2[6], b2[7])};
    }
    __syncthreads();
    {
        const int it = w & 3, half = w >> 2;
        f32x4 aw[4], au[4];
#pragma unroll
        for (int x = 0; x < 4; ++x) { aw[x] = (f32x4){0.f, 0.f, 0.f, 0.f}; au[x] = (f32x4){0.f, 0.f, 0.f, 0.f}; }
#pragma unroll
        for (int kk = 0; kk < 2; ++kk) {
            const bf16x8 a1 = ldfrag(Tp, TSTR, 16 * it, 32 * kk, lane), a2 = ldfrag(Tpp, TSTR, 16 * it, 32 * kk, lane);
#pragma unroll
            for (int x = 0; x < 4; ++x) { const int dt = half * 4 + x;
                aw[x] = MFMA16(a1, ldfrag_tr(ks, QSTR, 16 * dt, 32 * kk, lane), aw[x]);
                au[x] = MFMA16(a2, ldfrag_tr(vs, QSTR, 16 * dt, 32 * kk, lane), au[x]); }
        }
#pragma unroll
        for (int x = 0; x < 4; ++x) { const int d = 16 * (half * 4 + x) + l15, i0 = 16 * it + 4 * q4;
            *(u32x2*)(WT + d * TSTR + i0) = (u32x2){pk2(aw[x][0], aw[x][1]), pk2(aw[x][2], aw[x][3])};
            *(u32x2*)(UT + d * TSTR + i0) = (u32x2){pk2(au[x][0], au[x][1]), pk2(au[x][2], au[x][3])}; }
    }
    __syncthreads();
    {
        bf16_t* gAP = (bf16_t*)(rec + GP_AP); bf16_t* gQH = (bf16_t*)(rec + GP_QH); bf16_t* gKH = (bf16_t*)(rec + GP_KH); bf16_t* gOH = (bf16_t*)(rec + GP_OH);
        {
            const int et = w;
            const bf16x8 a0 = ldfrag(WT, TSTR, 16 * et, 0, lane), a1 = ldfrag(WT, TSTR, 16 * et, 32, lane);
#pragma unroll
            for (int dt = 0; dt < 8; ++dt) { f32x4 acc = {0.f, 0.f, 0.f, 0.f};
                acc = MFMA16(a0, ldfrag_tr(kts, QSTR, 16 * dt, 0, lane), acc); acc = MFMA16(a1, ldfrag_tr(kts, QSTR, 16 * dt, 32, lane), acc);
                *(u32x2*)(gAP + ((size_t)(dt * 4 + (et >> 1)) * 64 + lane) * 8 + (et & 1) * 4) = (u32x2){pk2(-acc[0], -acc[1]), pk2(-acc[2], -acc[3])}; }
#pragma unroll
            for (int tt = 0; tt < 4; ++tt) { f32x4 acc = {0.f, 0.f, 0.f, 0.f};
                acc = MFMA16(a0, ldfrag(QKm, TSTR, 16 * tt, 0, lane), acc); acc = MFMA16(a1, ldfrag(QKm, TSTR, 16 * tt, 32, lane), acc);
                const int t = 16 * tt + l15, e0 = 16 * et + 4 * q4; const float eg = egs[t];
                const u32x2 qq = *(const u32x2*)(qs + t * QSTR + e0);
                const float o0 = __uint_as_float(qq.x << 16) * eg - acc[0], o1 = __uint_as_float(qq.x & 0xffff0000u) * eg - acc[1],
                            o2 = __uint_as_float(qq.y << 16) * eg - acc[2], o3 = __uint_as_float(qq.y & 0xffff0000u) * eg - acc[3];
                *(u32x2*)(gQH + ((size_t)(tt * 4 + (et >> 1)) * 64 + lane) * 8 + (et & 1) * 4) = (u32x2){pk2(o0, o1), pk2(o2, o3)}; }
        }
        {
            const int dt = w;
            const bf16x8 a0 = ldfrag_tr(kts, QSTR, 16 * dt, 0, lane), a1 = ldfrag_tr(kts, QSTR, 16 * dt, 32, lane);
#pragma unroll
            for (int vt = 0; vt < 8; ++vt) { f32x4 acc = {0.f, 0.f, 0.f, 0.f};
                acc = MFMA16(a0, ldfrag(UT, TSTR, 16 * vt, 0, lane), acc); acc = MFMA16(a1, ldfrag(UT, TSTR, 16 * vt, 32, lane), acc);
                *(u32x2*)(gKH + ((size_t)(vt * 8 + dt) * 64 + lane) * 4) = (u32x2){pk2(acc[0], acc[1]), pk2(acc[2], acc[3])}; }
            const int tt = w & 3, vh = w >> 2;
            const bf16x8 b0 = ldfrag(QKm, TSTR, 16 * tt, 0, lane), b1 = ldfrag(QKm, TSTR, 16 * tt, 32, lane);
#pragma unroll
            for (int x = 0; x < 4; ++x) { const int vt = vh * 4 + x; f32x4 acc = {0.f, 0.f, 0.f, 0.f};
                acc = MFMA16(b0, ldfrag(UT, TSTR, 16 * vt, 0, lane), acc); acc = MFMA16(b1, ldfrag(UT, TSTR, 16 * vt, 32, lane), acc);
                *(u32x2*)(gOH + ((size_t)(vt * 4 + tt) * 64 + lane) * 4) = (u32x2){pk2(acc[0], acc[1]), pk2(acc[2], acc[3])}; }
        }
    }
    __syncthreads();
}

__device__ __forceinline__ void phase_gprep(const Params& p, int seg, unsigned char* smem) {
    const int blk = obid();
    const int n_items = (CPS + (seg == 0 ? 1 : 0)) * 64;
#pragma unroll 1
    for (int it = blk; it < n_items; it += gridDim.x) {
        const int bh = it & 63, b = bh >> 3, h = bh & 7; int cl = it >> 6; if (seg != 0) cl += 1;
        unsigned char* rec = p.ws + WS_GP + (size_t)(cl * 64 + bh) * GP_STRIDE;
        const bf16_t* Pb = (const bf16_t*)(p.ws + WS_P);
        bf16_t* chalo2 = (bf16_t*)(p.ws + WS_CHALO);
        if (cl == 0) gdn_prep_item(p, smem, h, LEX0, 48, nullptr, nullptr, nullptr, rec);
        else {
            const int row = b * SEGTOK + (cl - 1) * 64;
            const bf16_t* hbase = Pb + (size_t)(row - 3) * NPB;
            if (cl == 1) hbase = (seg == 0) ? Pb + (size_t)(LEX0 + NMETA - 3) * NPB : chalo2 + (size_t)(((seg - 1) & 1) * NBATCH + b) * 3 * NPB;
            bf16_t* ho = (cl == CPS) ? chalo2 + (size_t)((seg & 1) * NBATCH + b) * 3 * NPB : nullptr;
            float* co = (cl == CPS && seg == NSEG - 1) ? p.out + O_CONV_P + (size_t)b * 9216 : nullptr;
            gdn_prep_item(p, smem, h, row, 0, hbase, ho, co, rec);
        }
    }
}

__device__ __forceinline__ void gdn_scan_block(const Params& p, int seg, unsigned char* smem, int bh) {
    const int tid = otid(), w = tid >> 6, lane = tid & 63, q4 = lane >> 4, l15 = lane & 15;
    const int b = bh >> 3, h = bh & 7;
    float* st = p.out + O_GDN_P + (size_t)bh * 16384;
    f32x4 S[8];
    if (seg) {
#pragma unroll
        for (int mt = 0; mt < 8; ++mt)
#pragma unroll
            for (int r = 0; r < 4; ++r) S[mt][r] = st[(size_t)(16 * mt + 4 * q4 + r) * 128 + 16 * w + l15];
    } else {
#pragma unroll
        for (int mt = 0; mt < 8; ++mt) S[mt] = (f32x4){0.f, 0.f, 0.f, 0.f};
    }
    const int c_lo = seg ? 1 : 0;
    float* obuf = (float*)(smem + 98304);
    {
        const u32x4* src = (const u32x4*)(p.ws + WS_GP + (size_t)(c_lo * 64 + bh) * GP_STRIDE); u32x4* dst = (u32x4*)smem;
#pragma unroll
        for (int x = 0; x < 6; ++x) dst[tid + 512 * x] = src[tid + 512 * x];
    }
#pragma unroll 1
    for (int cl = c_lo; cl <= CPS; ++cl) {
        const unsigned char* rec = p.ws + WS_GP + (size_t)(cl * 64 + bh) * GP_STRIDE;
        const int cur = (cl - c_lo) & 1;
        __syncthreads();
        u32x4 nx[6];
        const bool more = cl < CPS;
        if (more) { const u32x4* src = (const u32x4*)(rec + GP_STRIDE * 64);
#pragma unroll
            for (int x = 0; x < 6; ++x) nx[x] = src[tid + 512 * x]; }
        const bf16_t* gKH = (const bf16_t*)(rec + GP_KH); const bf16_t* gOH = (const bf16_t*)(rec + GP_OH);
        u32x2 kh[8], oh[4];
#pragma unroll
        for (int mt = 0; mt < 8; ++mt) kh[mt] = *(const u32x2*)(gKH + ((size_t)(w * 8 + mt) * 64 + lane) * 4);
#pragma unroll
        for (int tt = 0; tt < 4; ++tt) oh[tt] = *(const u32x2*)(gOH + ((size_t)(w * 4 + tt) * 64 + lane) * 4);
        const float egl = *(const float*)(rec + GP_EGL);
        const int et = tid >> 3, eg = tid & 7;
        const bf16_t* gp = (const bf16_t*)(rec + GP_G) + et * 128 + 16 * eg;
        u32x4 z0 = {0u, 0u, 0u, 0u}, z1 = {0u, 0u, 0u, 0u};
        if (cl > 0) { z0 = *(const u32x4*)gp; z1 = *(const u32x4*)(gp + 8); }
        bf16x8 Bf[4];
#pragma unroll
        for (int ks = 0; ks < 4; ++ks) { u32x4 t; t.x = pk2(S[2 * ks][0], S[2 * ks][1]); t.y = pk2(S[2 * ks][2], S[2 * ks][3]); t.z = pk2(S[2 * ks + 1][0], S[2 * ks + 1][1]); t.w = pk2(S[2 * ks + 1][2], S[2 * ks + 1][3]);
            Bf[ks] = __builtin_bit_cast(bf16x8, t); }
        const bf16x8* AP = (const bf16x8*)(smem + cur * 49152); const bf16x8* QH = (const bf16x8*)(smem + cur * 49152 + GP_QH);
        f32x4 o[4], tS[8];
#pragma unroll
        for (int tt = 0; tt < 4; ++tt) { o[tt] = (f32x4){0.f, 0.f, 0.f, 0.f};
#pragma unroll
            for (int ks = 0; ks < 4; ++ks) o[tt] = MFMA16(QH[(tt * 4 + ks) * 64 + lane], Bf[ks], o[tt]); }
#pragma unroll
        for (int mt = 0; mt < 8; ++mt) { tS[mt] = (f32x4){0.f, 0.f, 0.f, 0.f};
#pragma unroll
            for (int ks = 0; ks < 4; ++ks) tS[mt] = MFMA16(AP[(mt * 4 + ks) * 64 + lane], Bf[ks], tS[mt]); }
#pragma unroll
        for (int mt = 0; mt < 8; ++mt) {
            S[mt][0] = egl * S[mt][0] + tS[mt][0] + __uint_as_float(kh[mt].x << 16); S[mt][1] = egl * S[mt][1] + tS[mt][1] + __uint_as_float(kh[mt].x & 0xffff0000u);
            S[mt][2] = egl * S[mt][2] + tS[mt][2] + __uint_as_float(kh[mt].y << 16); S[mt][3] = egl * S[mt][3] + tS[mt][3] + __uint_as_float(kh[mt].y & 0xffff0000u); }
        if (cl > 0) {
#pragma unroll
            for (int tt = 0; tt < 4; ++tt) {
                o[tt][0] += __uint_as_float(oh[tt].x << 16); o[tt][1] += __uint_as_float(oh[tt].x & 0xffff0000u); o[tt][2] += __uint_as_float(oh[tt].y << 16); o[tt][3] += __uint_as_float(oh[tt].y & 0xffff0000u);
#pragma unroll
                for (int r = 0; r < 4; ++r) obuf[(16 * tt + 4 * q4 + r) * 132 + 16 * w + l15] = o[tt][r]; }
        }
        if (more) { u32x4* dst = (u32x4*)(smem + (cur ^ 1) * 49152);
#pragma unroll
            for (int x = 0; x < 6; ++x) dst[tid + 512 * x] = nx[x]; }
        if (cl > 0) {
            __syncthreads();
            f32x4 ov[4]; float ss = 0.f;
#pragma unroll
            for (int j = 0; j < 4; ++j) { ov[j] = *(const f32x4*)(obuf + et * 132 + 16 * eg + 4 * j); ss += ov[j][0] * ov[j][0] + ov[j][1] * ov[j][1] + ov[j][2] * ov[j][2] + ov[j][3] * ov[j][3]; }
            ss += __shfl_xor(ss, 1); ss += __shfl_xor(ss, 2); ss += __shfl_xor(ss, 4);
            const float rs = __builtin_amdgcn_rsqf(ss * (1.f / 128.f) + 1e-6f);
            const unsigned zz[8] = {z0.x, z0.y, z0.z, z0.w, z1.x, z1.y, z1.z, z1.w};
            unsigned ow[8];
#pragma unroll
            for (int j = 0; j < 8; ++j) ow[j] = pk2(ov[j >> 1][(j & 1) * 2] * rs * __uint_as_float(zz[j] << 16), ov[j >> 1][(j & 1) * 2 + 1] * rs * __uint_as_float(zz[j] & 0xffff0000u));
            const size_t grow = (size_t)b * SEQ + seg * SEGTOK + (cl - 1) * 64 + et;
            bf16_t* oa = (bf16_t*)(p.ws + WS_H) + grow * D + h * 128 + 16 * eg;
            *(u32x4*)oa = (u32x4){ow[0], ow[1], ow[2], ow[3]}; *(u32x4*)(oa + 8) = (u32x4){ow[4], ow[5], ow[6], ow[7]};
        }
    }
#pragma unroll
    for (int mt = 0; mt < 8; ++mt)
#pragma unroll
        for (int r = 0; r < 4; ++r) st[(size_t)(16 * mt + 4 * q4 + r) * 128 + 16 * w + l15] = S[mt][r];
    __syncthreads();
}

constexpr int RL_AT = 0, RL_BT = 9216, RL_KT = 18432, RL_ATT = 27648, RL_RT = 36864, RL_BTLT = 46080, RL_KTLT = 55296, RL_VT = 64512, RL_LAK = 73728, RL_MRB = 82944, RL_MRK = 92160,
              RL_LM = 101376, RL_AF = 117760, RL_TM = 134144, RL_XS = 150528;
__device__ __forceinline__ void rwkv_prep_item(const Params& p, unsigned char* smem, int hb, int row_start, int npad, const bf16_t* prev_row,
                                               bf16_t* halo_out, unsigned char* rec) {
    const int tid = otid(), w = tid >> 6, lane = tid & 63, q4 = lane >> 4, l15 = lane & 15;
    bf16_t* At = (bf16_t*)(smem + RL_AT); bf16_t* Tb = At; bf16_t* Bt = (bf16_t*)(smem + RL_BT); bf16_t* WaT = Bt; bf16_t* Kt = (bf16_t*)(smem + RL_KT); bf16_t* XT = Kt;
    bf16_t* At2 = (bf16_t*)(smem + RL_ATT); bf16_t* Rt = (bf16_t*)(smem + RL_RT); bf16_t* Btl = (bf16_t*)(smem + RL_BTLT); bf16_t* Ktl = (bf16_t*)(smem + RL_KTLT);
    bf16_t* Vr = (bf16_t*)(smem + RL_VT);        bf16_t* Lak = (bf16_t*)(smem + RL_LAK); bf16_t* Mrb = (bf16_t*)(smem + RL_MRB); bf16_t* Mrk = (bf16_t*)(smem + RL_MRK);
    float* Lm = (float*)(smem + RL_LM);
    bf16_t* thw = Lak; bf16_t* adb = Mrb; float* lc = Lm; float* af = (float*)(smem + RL_AF);
    const bf16_t* P = (const bf16_t*)(p.ws + WS_P);
    const float* pk = (const float*)(p.ws + WS_PK);
    const int t = tid >> 3, g = tid & 7;
    float rr[8], kb[8], vv[8], zb[8];
    {
        const bool real = t >= npad;
        const bf16_t* curp = P; const bf16_t* prevp = P; float fprev = 0.f;
        if (real) { curp = P + (size_t)(row_start + t - npad) * NPB; if (t > npad) { prevp = curp - NPB; fprev = 1.f; } else if (prev_row) { prevp = prev_row; fprev = 1.f; } }
        const int secbase[6] = {0, 1024, 2048, 3200, 3072, 3136};
        u32x4 rc[6], rp[6];
#pragma unroll
        for (int sidx = 0; sidx < 6; ++sidx) { const int col = secbase[sidx] + (sidx < 4 ? hb * 64 : 0) + g * 8; rc[sidx] = *(const u32x4*)(curp + C_RW + col); rp[sidx] = *(const u32x4*)(prevp + C_RW + col); }
        float m[6][8];
#pragma unroll
        for (int sidx = 0; sidx < 6; ++sidx) {
            const int col = secbase[sidx] + (sidx < 4 ? hb * 64 : 0) + g * 8;
            float cur[8], prv[8];
            unpack8(rc[sidx], cur); unpack8(rp[sidx], prv);
            const f32x4 mu0 = *(const f32x4*)(pk + PK_MU + col), mu1 = *(const f32x4*)(pk + PK_MU + col + 4);
            const float mu[8] = {mu0[0], mu0[1], mu0[2], mu0[3], mu1[0], mu1[1], mu1[2], mu1[3]};
#pragma unroll
            for (int e = 0; e < 8; ++e) m[sidx][e] = real ? cur[e] + mu[e] * (fprev * prv[e] - cur[e]) : 0.f;
            if (halo_out && t == 63 && (sidx < 4 || hb == 0)) *(u32x4*)(halo_out + C_RW + col) = rc[sidx];
        }
#pragma unroll
        for (int e = 0; e < 8; ++e) { rr[e] = m[0][e]; kb[e] = m[1][e]; vv[e] = m[2][e]; zb[e] = m[3][e]; }
        float th[8];
#pragma unroll
        for (int e = 0; e < 8; ++e) th[e] = tanh_(m[4][e]);
        *(u32x4*)(thw + t * TSTR + g * 8) = pack8(th);
        *(u32x4*)(adb + t * TSTR + g * 8) = pack8(m[5]);
    }
    __syncthreads();
    {
        const int which = w >> 2, ct = w & 3;
        const bf16_t* Wt = (const bf16_t*)(p.ws + (which ? WS_A2T : WS_W2T)) + (size_t)hb * 4096;
        const bf16x8 b0 = *(const bf16x8*)(Wt + (16 * ct + l15) * 64 + 8 * q4), b1 = *(const bf16x8*)(Wt + (16 * ct + l15) * 64 + 32 + 8 * q4);
        const bf16_t* Aarr = which ? adb : thw;
        const int c = 16 * ct + l15;
        const float bias = pk[(which ? PK_A0 : PK_W0) + hb * 64 + c];
        float carry = 0.f;
#pragma unroll
        for (int tt = 0; tt < 4; ++tt) {
            f32x4 acc = {0.f, 0.f, 0.f, 0.f};
            acc = MFMA16(ldfrag(Aarr, TSTR, 16 * tt, 0, lane), b0, acc); acc = MFMA16(ldfrag(Aarr, TSTR, 16 * tt, 32, lane), b1, acc);
            if (which) {
#pragma unroll
                for (int r = 0; r < 4; ++r) af[(16 * tt + 4 * q4 + r) * 64 + c] = sigm(bias + acc[r]);
            } else {
                float wl[4];
#pragma unroll
                for (int r = 0; r < 4; ++r) { const int tk = 16 * tt + 4 * q4 + r; wl[r] = (tk < npad) ? 0.f : -0.6065306597126334f * sigm(bias + acc[r]); }
                wl[1] += wl[0]; wl[2] += wl[1]; wl[3] += wl[2];
                const float Q = wl[3];
                const float Q0 = __shfl(Q, l15), Q1 = __shfl(Q, l15 + 16), Q2 = __shfl(Q, l15 + 32), Q3 = __shfl(Q, l15 + 48);
                const float ex = carry + (q4 > 0 ? Q0 : 0.f) + (q4 > 1 ? Q1 : 0.f) + (q4 > 2 ? Q2 : 0.f);
#pragma unroll
                for (int r = 0; r < 4; ++r) lc[(16 * tt + 4 * q4 + r) * 64 + c] = ex + wl[r];
                carry += Q0 + Q1 + Q2 + Q3;
            }
        }
    }
    __syncthreads();
    {
        float lct[8], lcp[8], lcC[8], av[8];
        { const f32x4 a = *(const f32x4*)(lc + t * 64 + g * 8), b2 = *(const f32x4*)(lc + t * 64 + g * 8 + 4); lct[0] = a[0]; lct[1] = a[1]; lct[2] = a[2]; lct[3] = a[3]; lct[4] = b2[0]; lct[5] = b2[1]; lct[6] = b2[2]; lct[7] = b2[3]; }
        if (t > 0) { const f32x4 a = *(const f32x4*)(lc + (t - 1) * 64 + g * 8), b2 = *(const f32x4*)(lc + (t - 1) * 64 + g * 8 + 4); lcp[0] = a[0]; lcp[1] = a[1]; lcp[2] = a[2]; lcp[3] = a[3]; lcp[4] = b2[0]; lcp[5] = b2[1]; lcp[6] = b2[2]; lcp[7] = b2[3]; }
        else {
#pragma unroll
            for (int e = 0; e < 8; ++e) lcp[e] = 0.f; }
        { const f32x4 a = *(const f32x4*)(lc + 63 * 64 + g * 8), b2 = *(const f32x4*)(lc + 63 * 64 + g * 8 + 4); lcC[0] = a[0]; lcC[1] = a[1]; lcC[2] = a[2]; lcC[3] = a[3]; lcC[4] = b2[0]; lcC[5] = b2[1]; lcC[6] = b2[2]; lcC[7] = b2[3]; }
        { const f32x4 a = *(const f32x4*)(af + t * 64 + g * 8), b2 = *(const f32x4*)(af + t * 64 + g * 8 + 4); av[0] = a[0]; av[1] = a[1]; av[2] = a[2]; av[3] = a[3]; av[4] = b2[0]; av[5] = b2[1]; av[6] = b2[2]; av[7] = b2[3]; }
        const int hc = hb * 64 + g * 8;
        float kk[8], km[8], ss = 0.f, rk = 0.f;
        float pkk[8], pka[8], prk[8];
        { const f32x4 a0 = *(const f32x4*)(pk + PK_KK + hc), a1 = *(const f32x4*)(pk + PK_KK + hc + 4), b0 = *(const f32x4*)(pk + PK_KA + hc), b1 = *(const f32x4*)(pk + PK_KA + hc + 4), c0v = *(const f32x4*)(pk + PK_RK + hc), c1v = *(const f32x4*)(pk + PK_RK + hc + 4);
#pragma unroll
          for (int e = 0; e < 4; ++e) { pkk[e] = a0[e]; pkk[4 + e] = a1[e]; pka[e] = b0[e]; pka[4 + e] = b1[e]; prk[e] = c0v[e]; prk[4 + e] = c1v[e]; } }
#pragma unroll
        for (int e = 0; e < 8; ++e) { kk[e] = kb[e] * pkk[e]; ss += kk[e] * kk[e]; km[e] = kb[e] * (1.f + (av[e] - 1.f) * pka[e]); rk += rr[e] * km[e] * prk[e]; }
        ss += __shfl_xor(ss, 1); ss += __shfl_xor(ss, 2); ss += __shfl_xor(ss, 4);
        rk += __shfl_xor(rk, 1); rk += __shfl_xor(rk, 2); rk += __shfl_xor(rk, 4);
        const float kn = __builtin_amdgcn_rsqf(ss + 1e-6f);
        float xa[8], xb[8], xk[8], xr[8], xbt[8], xkt[8];
#pragma unroll
        for (int e = 0; e < 8; ++e) { kk[e] *= kn; const float ka = kk[e] * av[e]; const float ip = __expf(-lct[e]), tl = __expf(lcC[e] - lct[e]);
            xa[e] = kk[e] * __expf(lcp[e]); xb[e] = ka * ip; xk[e] = km[e] * ip; xr[e] = rr[e] * __expf(lct[e]); xbt[e] = ka * tl; xkt[e] = km[e] * tl; }
        *(u32x4*)(At + t * TSTR + g * 8) = pack8(xa); *(u32x4*)(Bt + t * TSTR + g * 8) = pack8(xb); *(u32x4*)(Kt + t * TSTR + g * 8) = pack8(xk); *(u32x4*)(Rt + t * TSTR + g * 8) = pack8(xr);
        *(u32x4*)(At2 + t * TSTR + g * 8) = pack8(xa); *(u32x4*)(Btl + t * TSTR + g * 8) = pack8(xbt); *(u32x4*)(Ktl + t * TSTR + g * 8) = pack8(xkt); *(u32x4*)(Vr + t * TSTR + g * 8) = pack8(vv);
        float c1[8], c0[8];
#pragma unroll
        for (int e = 0; e < 8; ++e) { c1[e] = 0.f; c0[e] = 0.f; }
        { const f32x4 g0 = *(const f32x4*)(pk + PK_GNW + hc), g1 = *(const f32x4*)(pk + PK_GNW + hc + 4), h0 = *(const f32x4*)(pk + PK_GNB + hc), h1 = *(const f32x4*)(pk + PK_GNB + hc + 4);
#pragma unroll
          for (int e = 0; e < 4; ++e) { const float sz0 = silu_(zb[e]), sz1 = silu_(zb[4 + e]); c1[e] = g0[e] * sz0; c1[4 + e] = g1[e] * sz1; c0[e] = (h0[e] + rk * vv[e]) * sz0; c0[4 + e] = (h1[e] + rk * vv[4 + e]) * sz1; } }
        *(u32x4*)((bf16_t*)(rec + RP_C1) + t * 64 + g * 8) = pack8(c1); *(u32x4*)((bf16_t*)(rec + RP_C0) + t * 64 + g * 8) = pack8(c0);
        if (t == 63) { float* pc = (float*)(rec + RP_PC) + g * 8; *(f32x4*)pc = (f32x4){__expf(lcC[0]), __expf(lcC[1]), __expf(lcC[2]), __expf(lcC[3])}; *(f32x4*)(pc + 4) = (f32x4){__expf(lcC[4]), __expf(lcC[5]), __expf(lcC[6]), __expf(lcC[7])}; }
    }
    __syncthreads();
    {
        const int pr = w >> 1;
        const bf16_t* Aarr = pr < 2 ? At : Rt; const bf16_t* Barr = (pr & 1) ? Kt : Bt;
#pragma unroll
        for (int x = 0; x < 2; ++x) { const int tt = 2 * (w & 1) + x;
            const bf16x8 a0 = ldfrag(Aarr, TSTR, 16 * tt, 0, lane), a1 = ldfrag(Aarr, TSTR, 16 * tt, 32, lane);
            const int tk = 16 * tt + l15;
#pragma unroll
            for (int it = 0; it < 4; ++it) { f32x4 acc = {0.f, 0.f, 0.f, 0.f};
                acc = MFMA16(ldfrag(Barr, TSTR, 16 * it, 0, lane), a0, acc); acc = MFMA16(ldfrag(Barr, TSTR, 16 * it, 32, lane), a1, acc);
                const int i0 = 16 * it + 4 * q4;
                f32x4 o;
#pragma unroll
                for (int r = 0; r < 4; ++r) { const int i = i0 + r; const bool keep = pr < 2 ? (tk > i) : (tk >= i); o[r] = keep ? acc[r] : 0.f; }
                if (pr == 0) *(f32x4*)(Lm + tk * 64 + i0) = o;
                else { bf16_t* Out = pr == 1 ? Lak : (pr == 2 ? Mrb : Mrk); *(u32x2*)(Out + tk * TSTR + i0) = (u32x2){pk2(o[0], o[1]), pk2(o[2], o[3])}; } }
        }
    }
    __syncthreads();
    {
        float* Tm = (float*)(smem + RL_TM);
        inv_block(Lm, Tm, (float*)(smem + RL_XS), tid);
        const int i = tid >> 3, j0 = (tid & 7) * 8;
        float a[8];
#pragma unroll
        for (int e = 0; e < 8; ++e) a[e] = Tm[i * 64 + j0 + e];
        *(u32x4*)(Tb + i * TSTR + j0) = pack8(a);
    }
    __syncthreads();
    {
        const int tt = w & 3, which = w >> 2;
        const bf16_t* Aarr = which ? Lak : Tb; const bf16_t* Barr = which ? Vr : At2; bf16_t* Out = which ? XT : WaT;
        const bf16x8 a0 = ldfrag(Aarr, TSTR, 16 * tt, 0, lane), a1 = ldfrag(Aarr, TSTR, 16 * tt, 32, lane);
#pragma unroll
        for (int ct = 0; ct < 4; ++ct) { f32x4 acc = {0.f, 0.f, 0.f, 0.f};
            acc = MFMA16(a0, ldfrag_tr(Barr, TSTR, 16 * ct, 0, lane), acc); acc = MFMA16(a1, ldfrag_tr(Barr, TSTR, 16 * ct, 32, lane), acc);
            *(u32x2*)(Out + (16 * ct + l15) * TSTR + 16 * tt + 4 * q4) = (u32x2){pk2(acc[0], acc[1]), pk2(acc[2], acc[3])}; }
    }
    __syncthreads();
    {
        f32x4 acc[4];
        if (w < 4) {
            const bf16x8 a0 = ldfrag(Tb, TSTR, 16 * w, 0, lane), a1 = ldfrag(Tb, TSTR, 16 * w, 32, lane);
#pragma unroll
            for (int ct = 0; ct < 4; ++ct) { acc[ct] = (f32x4){0.f, 0.f, 0.f, 0.f};
                acc[ct] = MFMA16(a0, ldfrag(XT, TSTR, 16 * ct, 0, lane), acc[ct]); acc[ct] = MFMA16(a1, ldfrag(XT, TSTR, 16 * ct, 32, lane), acc[ct]); }
        }
        if (w < 4) {
            bf16_t* UvTw = (bf16_t*)(smem + RL_LM);
#pragma unroll
            for (int ct = 0; ct < 4; ++ct) *(u32x2*)(UvTw + (16 * ct + l15) * TSTR + 16 * w + 4 * q4) = (u32x2){pk2(-acc[ct][0], -acc[ct][1]), pk2(-acc[ct][2], -acc[ct][3])};
        }
    }
    __syncthreads();
    {
        const bf16_t* UvT = (const bf16_t*)(smem + RL_LM);
        bf16_t* gAP = (bf16_t*)(rec + RP_AP); bf16_t* gRH = (bf16_t*)(rec + RP_RH); bf16_t* gKH = (bf16_t*)(rec + RP_KH); bf16_t* gYH = (bf16_t*)(rec + RP_YH);
        const int et = w & 3, part = w >> 2;
        {
            const bf16x8 a0 = ldfrag(WaT, TSTR, 16 * et, 0, lane), a1 = ldfrag(WaT, TSTR, 16 * et, 32, lane);
            if (part == 0) {
#pragma unroll
                for (int kt = 0; kt < 4; ++kt) { f32x4 acc = {0.f, 0.f, 0.f, 0.f};
                    acc = MFMA16(a0, ldfrag_tr(Btl, TSTR, 16 * kt, 0, lane), acc); acc = MFMA16(a1, ldfrag_tr(Btl, TSTR, 16 * kt, 32, lane), acc);
                    *(u32x2*)(gAP + ((size_t)(kt * 2 + (et >> 1)) * 64 + lane) * 8 + (et & 1) * 4) = (u32x2){pk2(-acc[0], -acc[1]), pk2(-acc[2], -acc[3])}; }
            } else {
#pragma unroll
                for (int tt = 0; tt < 4; ++tt) { f32x4 acc = {0.f, 0.f, 0.f, 0.f};
                    acc = MFMA16(a0, ldfrag(Mrb, TSTR, 16 * tt, 0, lane), acc); acc = MFMA16(a1, ldfrag(Mrb, TSTR, 16 * tt, 32, lane), acc);
                    const int tk = 16 * tt + l15, e0 = 16 * et + 4 * q4;
                    const u32x2 q2 = *(const u32x2*)(Rt + tk * TSTR + e0);
                    const float o0 = __uint_as_float(q2.x << 16) - acc[0], o1 = __uint_as_float(q2.x & 0xffff0000u) - acc[1], o2 = __uint_as_float(q2.y << 16) - acc[2], o3 = __uint_as_float(q2.y & 0xffff0000u) - acc[3];
                    *(u32x2*)(gRH + ((size_t)(tt * 2 + (et >> 1)) * 64 + lane) * 8 + (et & 1) * 4) = (u32x2){pk2(o0, o1), pk2(o2, o3)}; }
            }
        }
        {
            const int rt = w & 3;
            bf16_t* Out = part ? gKH : gYH;
            bf16x8 a0, a1, a2, a3;
            if (part) { a0 = ldfrag_tr(Btl, TSTR, 16 * rt, 0, lane); a1 = ldfrag_tr(Btl, TSTR, 16 * rt, 32, lane); a2 = ldfrag_tr(Ktl, TSTR, 16 * rt, 0, lane); a3 = ldfrag_tr(Ktl, TSTR, 16 * rt, 32, lane); }
            else { a0 = ldfrag(Mrb, TSTR, 16 * rt, 0, lane); a1 = ldfrag(Mrb, TSTR, 16 * rt, 32, lane); a2 = ldfrag(Mrk, TSTR, 16 * rt, 0, lane); a3 = ldfrag(Mrk, TSTR, 16 * rt, 32, lane); }
#pragma unroll
            for (int vt = 0; vt < 4; ++vt) { f32x4 acc = {0.f, 0.f, 0.f, 0.f};
                acc = MFMA16(a0, ldfrag(UvT, TSTR, 16 * vt, 0, lane), acc); acc = MFMA16(a1, ldfrag(UvT, TSTR, 16 * vt, 32, lane), acc);
                acc = MFMA16(a2, ldfrag_tr(Vr, TSTR, 16 * vt, 0, lane), acc); acc = MFMA16(a3, ldfrag_tr(Vr, TSTR, 16 * vt, 32, lane), acc);
                *(u32x2*)(Out + ((size_t)(vt * 4 + rt) * 64 + lane) * 4) = (u32x2){pk2(acc[0], acc[1]), pk2(acc[2], acc[3])}; }
        }
    }
    __syncthreads();
}

__device__ __forceinline__ void phase_rprep(const Params& p, int seg, unsigned char* smem) {
    const int blk = obid();
    const int n_items = (CPS + (seg == 0 ? 1 : 0)) * 128;
#pragma unroll 1
    for (int it = (blk + (gridDim.x >> 1)) % gridDim.x; it < n_items; it += gridDim.x) {
        const int bh = it & 127, b = bh >> 4, hb = bh & 15; int cl = it >> 7; if (seg != 0) cl += 1;
        unsigned char* rec = p.ws + WS_RP + (size_t)(cl * 128 + bh) * RP_STRIDE;
        const bf16_t* Pb = (const bf16_t*)(p.ws + WS_P);
        bf16_t* phalo2 = (bf16_t*)(p.ws + WS_PHALO);
        if (cl == 0) rwkv_prep_item(p, smem, hb, LEX0, 48, nullptr, nullptr, rec);
        else {
            const int row = b * SEGTOK + (cl - 1) * 64;
            const bf16_t* prow = Pb + (size_t)(row - 1) * NPB;
            if (cl == 1) prow = (seg == 0) ? Pb + (size_t)(LEX0 + NMETA - 1) * NPB : phalo2 + (size_t)(((seg - 1) & 1) * NBATCH + b) * NPB;
            bf16_t* ho = (cl == CPS) ? phalo2 + (size_t)((seg & 1) * NBATCH + b) * NPB : nullptr;
            rwkv_prep_item(p, smem, hb, row, 0, prow, ho, rec);
        }
    }
}

__device__ __forceinline__ void rwkv_scan_block(const Params& p, int seg, unsigned char* smem, int pairidx) {
    const int tid = otid(), w = tid >> 6, lane = tid & 63, q4 = lane >> 4, l15 = lane & 15;
    const int hsel = w >> 2, vt = w & 3;
    const int bh = pairidx * 2 + hsel, b = bh >> 4, hb = bh & 15;
    float* st = p.out + O_RWKV_P + (size_t)bh * 4096;
    f32x4 S[4];
    if (seg) {
#pragma unroll
        for (int mt = 0; mt < 4; ++mt) S[mt] = *(const f32x4*)(st + (size_t)(16 * vt + l15) * 64 + 16 * mt + 4 * q4);
    } else {
#pragma unroll
        for (int mt = 0; mt < 4; ++mt) S[mt] = (f32x4){0.f, 0.f, 0.f, 0.f};
    }
    const int c_lo = seg ? 1 : 0;
    float* ybuf = (float*)(smem + 65536) + hsel * (64 * 68);
    const int tl = tid & 255;
    {
        const u32x4* src = (const u32x4*)(p.ws + WS_RP + (size_t)(c_lo * 128 + bh) * RP_STRIDE); u32x4* dst = (u32x4*)(smem + hsel * 16384);
#pragma unroll
        for (int x = 0; x < 4; ++x) dst[tl + 256 * x] = src[tl + 256 * x];
    }
#pragma unroll 1
    for (int cl = c_lo; cl <= CPS; ++cl) {
        const unsigned char* rec = p.ws + WS_RP + (size_t)(cl * 128 + bh) * RP_STRIDE;
        const int cur = (cl - c_lo) & 1;
        __syncthreads();
        u32x4 nx[4];
        const bool more = cl < CPS;
        if (more) { const u32x4* src = (const u32x4*)(rec + (size_t)RP_STRIDE * 128);
#pragma unroll
            for (int x = 0; x < 4; ++x) nx[x] = src[tl + 256 * x]; }
        const bf16_t* gKH = (const bf16_t*)(rec + RP_KH); const bf16_t* gYH = (const bf16_t*)(rec + RP_YH);
        u32x2 kh[4], yh[4]; f32x4 pc[4];
#pragma unroll
        for (int mt = 0; mt < 4; ++mt) { kh[mt] = *(const u32x2*)(gKH + ((size_t)(vt * 4 + mt) * 64 + lane) * 4); yh[mt] = *(const u32x2*)(gYH + ((size_t)(vt * 4 + mt) * 64 + lane) * 4);
            pc[mt] = *(const f32x4*)((const float*)(rec + RP_PC) + 16 * mt + 4 * q4); }
        const int tk = tl >> 2, g = tl & 3;
        u32x4 a0 = {0u, 0u, 0u, 0u}, a1 = a0, b0 = a0, b1 = a0;
        if (cl > 0) { const bf16_t* c1p = (const bf16_t*)(rec + RP_C1) + tk * 64 + 16 * g; const bf16_t* c0p = (const bf16_t*)(rec + RP_C0) + tk * 64 + 16 * g;
            a0 = *(const u32x4*)c0p; a1 = *(const u32x4*)(c0p + 8); b0 = *(const u32x4*)c1p; b1 = *(const u32x4*)(c1p + 8); }
        bf16x8 Bf[2];
#pragma unroll
        for (int ks = 0; ks < 2; ++ks) { u32x4 tq; tq.x = pk2(S[2 * ks][0], S[2 * ks][1]); tq.y = pk2(S[2 * ks][2], S[2 * ks][3]); tq.z = pk2(S[2 * ks + 1][0], S[2 * ks + 1][1]); tq.w = pk2(S[2 * ks + 1][2], S[2 * ks + 1][3]);
            Bf[ks] = __builtin_bit_cast(bf16x8, tq); }
        const bf16x8* AP = (const bf16x8*)(smem + cur * 32768 + hsel * 16384); const bf16x8* RH = (const bf16x8*)(smem + cur * 32768 + hsel * 16384 + RP_RH);
        f32x4 y[4], tS[4];
#pragma unroll
        for (int tt = 0; tt < 4; ++tt) { y[tt] = (f32x4){0.f, 0.f, 0.f, 0.f}; y[tt] = MFMA16(RH[(tt * 2 + 0) * 64 + lane], Bf[0], y[tt]); y[tt] = MFMA16(RH[(tt * 2 + 1) * 64 + lane], Bf[1], y[tt]); }
#pragma unroll
        for (int mt = 0; mt < 4; ++mt) { tS[mt] = (f32x4){0.f, 0.f, 0.f, 0.f}; tS[mt] = MFMA16(AP[(mt * 2 + 0) * 64 + lane], Bf[0], tS[mt]); tS[mt] = MFMA16(AP[(mt * 2 + 1) * 64 + lane], Bf[1], tS[mt]); }
#pragma unroll
        for (int mt = 0; mt < 4; ++mt) {
            S[mt][0] = pc[mt][0] * S[mt][0] + tS[mt][0] + __uint_as_float(kh[mt].x << 16); S[mt][1] = pc[mt][1] * S[mt][1] + tS[mt][1] + __uint_as_float(kh[mt].x & 0xffff0000u);
            S[mt][2] = pc[mt][2] * S[mt][2] + tS[mt][2] + __uint_as_float(kh[mt].y << 16); S[mt][3] = pc[mt][3] * S[mt][3] + tS[mt][3] + __uint_as_float(kh[mt].y & 0xffff0000u); }
        if (cl > 0) {
#pragma unroll
            for (int tt = 0; tt < 4; ++tt) {
                y[tt][0] += __uint_as_float(yh[tt].x << 16); y[tt][1] += __uint_as_float(yh[tt].x & 0xffff0000u); y[tt][2] += __uint_as_float(yh[tt].y << 16); y[tt][3] += __uint_as_float(yh[tt].y & 0xffff0000u);
#pragma unroll
                for (int r = 0; r < 4; ++r) ybuf[(16 * tt + 4 * q4 + r) * 68 + 16 * vt + l15] = y[tt][r]; }
        }
        if (more) { u32x4* dst = (u32x4*)(smem + (cur ^ 1) * 32768 + hsel * 16384);
#pragma unroll
            for (int x = 0; x < 4; ++x) dst[tl + 256 * x] = nx[x]; }
        if (cl > 0) {
            __syncthreads();
            f32x4 yv[4]; float sm = 0.f;
#pragma unroll
            for (int j = 0; j < 4; ++j) { yv[j] = *(const f32x4*)(ybuf + tk * 68 + 16 * g + 4 * j); sm += yv[j][0] + yv[j][1] + yv[j][2] + yv[j][3]; }
            sm += __shfl_xor(sm, 1); sm += __shfl_xor(sm, 2);
            const float mu = sm * (1.f / 64.f); float vs = 0.f;
#pragma unroll
            for (int j = 0; j < 4; ++j) { yv[j] = yv[j] - mu; vs += yv[j][0] * yv[j][0] + yv[j][1] * yv[j][1] + yv[j][2] * yv[j][2] + yv[j][3] * yv[j][3]; }
            vs += __shfl_xor(vs, 1); vs += __shfl_xor(vs, 2);
            const float rs = __builtin_amdgcn_rsqf(vs * (1.f / 64.f) + 64e-5f);
            const unsigned c0w[8] = {a0.x, a0.y, a0.z, a0.w, a1.x, a1.y, a1.z, a1.w}, c1w[8] = {b0.x, b0.y, b0.z, b0.w, b1.x, b1.y, b1.z, b1.w};
            unsigned ow[8];
#pragma unroll
            for (int j = 0; j < 8; ++j) ow[j] = pk2(yv[j >> 1][(j & 1) * 2] * rs * __uint_as_float(c1w[j] << 16) + __uint_as_float(c0w[j] << 16),
                                                     yv[j >> 1][(j & 1) * 2 + 1] * rs * __uint_as_float(c1w[j] & 0xffff0000u) + __uint_as_float(c0w[j] & 0xffff0000u));
            const size_t grow = (size_t)b * SEQ + seg * SEGTOK + (cl - 1) * 64 + tk;
            bf16_t* ob = (bf16_t*)(p.ws + WS_OB) + grow * D + hb * 64 + 16 * g;
            *(u32x4*)ob = (u32x4){ow[0], ow[1], ow[2], ow[3]}; *(u32x4*)(ob + 8) = (u32x4){ow[4], ow[5], ow[6], ow[7]};
        }
    }
#pragma unroll
    for (int mt = 0; mt < 4; ++mt) *(f32x4*)(st + (size_t)(16 * vt + l15) * 64 + 16 * mt + 4 * q4) = S[mt];
    __syncthreads();
}

__device__ __forceinline__ void gdn_sample_item(const Params& p, unsigned char* smem, int bs, int h) {
    const int tid = otid(), w = tid >> 6, lane = tid & 63, kq = tid >> 7, v = tid & 127;
    float* qk_s = (float*)smem; float* v_s = qk_s + 1024; float* gb_s = v_s + 512; float* part = gb_s + 16; float* part2 = part + 512;
    const bf16_t* P = (const bf16_t*)(p.ws + WS_P);
    const float* pk = (const float*)(p.ws + WS_PK);
    const float* s_in = p.in[2] + (size_t)(bs * 8 + h) * 16384; float* s_out = p.out + O_GDN_S + (size_t)(bs * 8 + h) * 16384;
    const int row0 = LEX0 + EX_SAMP + bs * DECT;
    float s[32];
#pragma unroll
    for (int j = 0; j < 32; ++j) s[j] = s_in[(size_t)(kq * 32 + j) * 128 + v];
    if (tid < 384) {
        const int pcol = (tid >> 7) * 1024 + h * 128 + (tid & 127);
        const float* cw = pk + PK_CONVW; const float* hin = p.in[3] + (size_t)bs * 9216; float* hout = p.out + O_CONV_S + (size_t)bs * 9216;
        const float cw0 = cw[pcol], cw1 = cw[3072 + pcol], cw2 = cw[6144 + pcol], cw3 = cw[9216 + pcol];
        float x3 = hin[pcol], x2 = hin[3072 + pcol], x1 = hin[6144 + pcol];
        float xr[4];
#pragma unroll
        for (int i = 0; i < 4; ++i) xr[i] = bf2f(P[(size_t)(row0 + i) * NPB + pcol]);
#pragma unroll
        for (int i = 0; i < 4; ++i) { const float y = cw0 * x3 + cw1 * x2 + cw2 * x1 + cw3 * xr[i]; x3 = x2; x2 = x1; x1 = xr[i];
            if (tid < 256) qk_s[i * 256 + tid] = silu_(y); else v_s[i * 128 + (tid - 256)] = silu_(y); }
        hout[pcol] = x3; hout[3072 + pcol] = x2; hout[6144 + pcol] = x1;
    } else if (tid < 388) {
        const int i = tid - 384; const size_t r = (size_t)(row0 + i) * NPB;
        const float pa = bf2f(P[r + C_A + h]), pb = bf2f(P[r + C_B + h]);
        gb_s[2 * i] = __expf(-expf(pk[PK_ALOG + h]) * softplus_(pa + pk[PK_DTB + h])); gb_s[2 * i + 1] = sigm(pb);
    }
    __syncthreads();
    { const int i = w >> 1, which = w & 1; float* rp = qk_s + i * 256 + which * 128; const float a = rp[lane], b = rp[lane + 64];
      const float sc = __builtin_amdgcn_rsqf(wave_sum(a * a + b * b) + 1e-6f) * (which == 0 ? 0.08838834764831845f : 1.f); rp[lane] = a * sc; rp[lane + 64] = b * sc; }
    __syncthreads();
#pragma unroll 1
    for (int i = 0; i < 4; ++i) {
        const float* kp = qk_s + i * 256 + 128 + kq * 32; const float* qp = qk_s + i * 256 + kq * 32;
        float pa = 0.f;
#pragma unroll
        for (int j4 = 0; j4 < 8; ++j4) { const f32x4 k4 = *(const f32x4*)(kp + 4 * j4); pa += k4[0] * s[4 * j4] + k4[1] * s[4 * j4 + 1] + k4[2] * s[4 * j4 + 2] + k4[3] * s[4 * j4 + 3]; }
        part[kq * 128 + v] = pa;
        __syncthreads();
        const float kS = part[v] + part[128 + v] + part[256 + v] + part[384 + v];
        const float a = gb_s[2 * i], c = gb_s[2 * i + 1] * (v_s[i * 128 + v] - a * kS);
        float po = 0.f;
#pragma unroll
        for (int j4 = 0; j4 < 8; ++j4) { const f32x4 k4 = *(const f32x4*)(kp + 4 * j4), q4v = *(const f32x4*)(qp + 4 * j4);
#pragma unroll
            for (int e = 0; e < 4; ++e) { s[4 * j4 + e] = a * s[4 * j4 + e] + k4[e] * c; po += q4v[e] * s[4 * j4 + e]; } }
        part2[kq * 128 + v] = po;
        __syncthreads();
        if (kq == 0) ((float*)(p.ws + WS_ORAW))[(size_t)(row0 + i) * D + h * 128 + v] = part2[v] + part2[128 + v] + part2[256 + v] + part2[384 + v];
    }
#pragma unroll
    for (int j = 0; j < 32; ++j) s_out[(size_t)(kq * 32 + j) * 128 + v] = s[j];
    __syncthreads();
}

constexpr int SR_R = 0, SR_KK = 4096, SR_V = 8192, SR_ZB = 12288, SR_DEC = 16384, SR_KA = 20480, SR_KM = 24576, SR_WD = 28672, SR_AD = 28928, SR_RK = 29184;
__device__ __forceinline__ void rwkv_sample_item(const Params& p, unsigned char* smem, int bs) {
    const int tid = otid(), w = tid >> 6, lane = tid & 63;
    float* f = (float*)smem;
    const bf16_t* P = (const bf16_t*)(p.ws + WS_P);
    const float* pk = (const float*)(p.ws + WS_PK);
    const int row0 = LEX0 + EX_SAMP + bs * DECT;
    const bf16_t* prow = P + (size_t)(LEX0 + EX_SHIFT + bs) * NPB + C_RW;
#pragma unroll 1
    for (int col = tid; col < RW_SHIFT; col += 512) {
        const float mu = pk[PK_MU + col]; float prev = bf2f(prow[col]);
        float cur[4];
#pragma unroll
        for (int i = 0; i < 4; ++i) cur[i] = bf2f(P[(size_t)(row0 + i) * NPB + C_RW + col]);
        float* dst; int stride = 1024; bool th = false;
        if (col < 1024) dst = f + SR_R + col; else if (col < 2048) dst = f + SR_KK + (col - 1024); else if (col < 3072) dst = f + SR_V + (col - 2048);
        else if (col < 3136) { dst = f + SR_WD + (col - 3072); stride = 64; th = true; } else if (col < 3200) { dst = f + SR_AD + (col - 3136); stride = 64; } else dst = f + SR_ZB + (col - 3200);
#pragma unroll
        for (int i = 0; i < 4; ++i) { float m = cur[i] + mu * (prev - cur[i]); prev = cur[i]; if (th) m = tanh_(m); dst[i * stride] = m; }
    }
    __syncthreads();
#pragma unroll 1
    for (int cc = 0; cc < 2; ++cc) {
        const int c = tid + 512 * cc;
        float aw[4] = {0.f, 0.f, 0.f, 0.f}, aa[4] = {0.f, 0.f, 0.f, 0.f};
#pragma unroll 8
        for (int l = 0; l < 64; ++l) { const float w2v = pk[PK_W2 + l * D + c], a2v = pk[PK_A2 + l * D + c];
#pragma unroll
            for (int i = 0; i < 4; ++i) { aw[i] += f[SR_WD + i * 64 + l] * w2v; aa[i] += f[SR_AD + i * 64 + l] * a2v; } }
        const float w0c = pk[PK_W0 + c], a0c = pk[PK_A0 + c], kkc = pk[PK_KK + c], kac = pk[PK_KA + c];
#pragma unroll
        for (int i = 0; i < 4; ++i) { const float a = sigm(a0c + aa[i]); const float kbv = f[SR_KK + i * 1024 + c];
            f[SR_DEC + i * 1024 + c] = __expf(-0.6065306597126334f * sigm(w0c + aw[i])); f[SR_KA + i * 1024 + c] = a; f[SR_KK + i * 1024 + c] = kbv * kkc; f[SR_KM + i * 1024 + c] = kbv * (1.f + (a - 1.f) * kac); }
    }
    __syncthreads();
#pragma unroll 1
    for (int x = 0; x < 8; ++x) { const int pr = w * 8 + x, i = pr >> 4, hh = pr & 15; const int o = i * 1024 + hh * 64 + lane;
        const float kr = f[SR_KK + o]; const float kk = kr * __builtin_amdgcn_rsqf(wave_sum(kr * kr) + 1e-6f); f[SR_KK + o] = kk; f[SR_KA + o] = kk * f[SR_KA + o];
        const float rkv = wave_sum(f[SR_R + o] * f[SR_KM + o] * pk[PK_RK + hh * 64 + lane]); if (lane == 0) f[SR_RK + pr] = rkv; }
    __syncthreads();
#pragma unroll 1
    for (int hp = 0; hp < 2; ++hp) {
        const int hb = hp * 8 + w;
        const float* s_in = p.in[4] + (size_t)(bs * 16 + hb) * 4096 + (size_t)lane * 64; float* s_out = p.out + O_RWKV_S + (size_t)(bs * 16 + hb) * 4096 + (size_t)lane * 64;
        f32x4 S[16];
#pragma unroll
        for (int j = 0; j < 16; ++j) S[j] = *(const f32x4*)(s_in + 4 * j);
        const int cch = hb * 64 + lane;
        const float gnw = pk[PK_GNW + cch], gnb = pk[PK_GNB + cch];
#pragma unroll 1
        for (int i = 0; i < 4; ++i) {
            const int o = i * 1024 + hb * 64;
            const float vv = f[SR_V + o + lane], rk = f[SR_RK + i * 16 + hb];
            float sa = 0.f;
#pragma unroll
            for (int j = 0; j < 16; ++j) { const f32x4 kk4 = *(const f32x4*)(f + SR_KK + o + 4 * j); sa += S[j][0] * kk4[0] + S[j][1] * kk4[1] + S[j][2] * kk4[2] + S[j][3] * kk4[3]; }
            float y = 0.f;
#pragma unroll
            for (int j = 0; j < 16; ++j) { const f32x4 de4 = *(const f32x4*)(f + SR_DEC + o + 4 * j), ka4 = *(const f32x4*)(f + SR_KA + o + 4 * j), km4 = *(const f32x4*)(f + SR_KM + o + 4 * j), r4 = *(const f32x4*)(f + SR_R + o + 4 * j);
#pragma unroll
                for (int e = 0; e < 4; ++e) { S[j][e] = S[j][e] * de4[e] + (vv * km4[e] - sa * ka4[e]); y += S[j][e] * r4[e]; } }
            const float mu = wave_sum(y) * (1.f / 64.f); const float dy = y - mu;
            const float rs = __builtin_amdgcn_rsqf(wave_sum(dy * dy) * (1.f / 64.f) + 64e-5f);
            const float ov = (dy * rs * gnw + gnb + rk * vv) * silu_(f[SR_ZB + i * 1024 + cch]);
            ((bf16_t*)(p.ws + WS_OB))[(size_t)(XROWS + EX_SAMP + bs * DECT + i) * D + cch] = (bf16_t)f2bf(ov);
        }
#pragma unroll
        for (int j = 0; j < 16; ++j) *(f32x4*)(s_out + 4 * j) = S[j];
    }
    __syncthreads();
}

__device__ __forceinline__ void phase2(const Params& p, int seg, unsigned char* smem) {
    const int blk = obid();
    float* out = p.out;
    float* chalo = (float*)(p.ws + WS_CHALO); float* phalo = (float*)(p.ws + WS_PHALO);
#ifndef SUB
#define SUB 0
#endif
#define SEN(x) (SUB == 0 || SUB == (x))
    if (SEN(1) && blk < 64) gdn_scan_block(p, seg, smem, blk);
    if (SEN(3) && blk >= 64 && blk < 128) rwkv_scan_block(p, seg, smem, blk - 64);
#ifndef DUP
#define DUP 0
#endif
    if (seg == 0) {
#pragma unroll 1
        for (int it = blk; it < DECB * 8; it += gridDim.x) gdn_sample_item(p, smem, it >> 3, it & 7);
#pragma unroll 1
        for (int it = blk; it < DECB; it += gridDim.x) rwkv_sample_item(p, smem, it);
    }
}

__device__ __forceinline__ void phase25(const Params& p, int seg) {
    const int tid0 = otid(); const int lane = tid0 & 63; const int gw = obid() * 8 + (tid0 >> 6), NGW = gridDim.x * 8;
    const bf16_t* P = (const bf16_t*)(p.ws + WS_P);
    const float* ORAW = (const float*)(p.ws + WS_ORAW); const float* YRAW = (const float*)(p.ws + WS_YRAW);
    const bf16_t* C0 = (const bf16_t*)(p.ws + WS_C0); const bf16_t* C1 = (const bf16_t*)(p.ws + WS_C1);
    bf16_t* OA = (bf16_t*)(p.ws + WS_H); bf16_t* OB = (bf16_t*)(p.ws + WS_OB);
    const int nrows = LEX0 + (seg == 0 ? DECB * DECT : 0);
    const int c = lane * 16;
    f32x4 nw[4];
#pragma unroll
    for (int j = 0; j < 4; ++j) nw[j] = *(const f32x4*)((const float*)(p.ws + WS_PK) + PK_NORMW + (c & 127) + 4 * j);
#pragma unroll 1
    for (int rr = LEX0 + gw; rr < nrows; rr += NGW) {
        int lr; size_t grow;
        if (rr < LEX0) { lr = rr; grow = (size_t)(rr / SEGTOK) * SEQ + seg * SEGTOK + (rr % SEGTOK); } else { lr = LEX0 + EX_SAMP + (rr - LEX0); grow = (size_t)XROWS + EX_SAMP + (rr - LEX0); }
        {
            f32x4 o[4]; float ss = 0.f;
#pragma unroll
            for (int j = 0; j < 4; ++j) { o[j] = *(const f32x4*)(ORAW + (size_t)lr * D + c + 4 * j); ss += o[j][0] * o[j][0] + o[j][1] * o[j][1] + o[j][2] * o[j][2] + o[j][3] * o[j][3]; }
            ss += __shfl_xor(ss, 1); ss += __shfl_xor(ss, 2); ss += __shfl_xor(ss, 4);
            const float rs = __builtin_amdgcn_rsqf(ss * (1.f / 128.f) + 1e-6f);
            const u32x4 z0 = *(const u32x4*)(P + (size_t)lr * NPB + C_Z + c), z1 = *(const u32x4*)(P + (size_t)lr * NPB + C_Z + c + 8);
            const unsigned zz[8] = {z0.x, z0.y, z0.z, z0.w, z1.x, z1.y, z1.z, z1.w};
            unsigned ow[8];
#pragma unroll
            for (int j = 0; j < 8; ++j) { const float za = __uint_as_float(zz[j] << 16), zb = __uint_as_float(zz[j] & 0xffff0000u);
                const float a = o[j >> 1][(j & 1) * 2] * rs * nw[j >> 1][(j & 1) * 2] * silu_(za), b = o[j >> 1][(j & 1) * 2 + 1] * rs * nw[j >> 1][(j & 1) * 2 + 1] * silu_(zb);
                ow[j] = pk2(a, b); }
            *(u32x4*)(OA + grow * D + c) = (u32x4){ow[0], ow[1], ow[2], ow[3]}; *(u32x4*)(OA + grow * D + c + 8) = (u32x4){ow[4], ow[5], ow[6], ow[7]};
        }
    }
}

__device__ __forceinline__ void phase_final(const Params& p) {
    const int tid0 = otid(); const int lane = tid0 & 63; const int gw = obid() * 8 + (tid0 >> 6), NGW = gridDim.x * 8;
    const f32x4* wr = (const f32x4*)((const float*)(p.ws + WS_PK) + PK_LNF) + lane;
    f32x4 wv[4];
#pragma unroll
    for (int j = 0; j < 4; ++j) wv[j] = wr[64 * j];
    constexpr int NR = XROWS + DECB * DECT;
#pragma unroll 1
    for (int r = gw; r < NR; r += 2 * NGW) {
        const int r1 = r + NGW; const bool has1 = r1 < NR;
        f32x4* x0 = (f32x4*)(p.out + (size_t)r * D) + lane; f32x4* x1 = (f32x4*)(p.out + (size_t)(has1 ? r1 : r) * D) + lane;
        f32x4 a[4], b[4]; float s0 = 0.f, s1 = 0.f;
#pragma unroll
        for (int j = 0; j < 4; ++j) { a[j] = x0[64 * j]; b[j] = x1[64 * j]; }
#pragma unroll
        for (int j = 0; j < 4; ++j) { s0 += a[j][0] * a[j][0] + a[j][1] * a[j][1] + a[j][2] * a[j][2] + a[j][3] * a[j][3]; s1 += b[j][0] * b[j][0] + b[j][1] * b[j][1] + b[j][2] * b[j][2] + b[j][3] * b[j][3]; }
        const float q0 = __builtin_amdgcn_rsqf(wave_sum(s0) * (1.f / D) + 1e-6f), q1 = __builtin_amdgcn_rsqf(wave_sum(s1) * (1.f / D) + 1e-6f);
#pragma unroll
        for (int j = 0; j < 4; ++j) x0[64 * j] = a[j] * q0 * wv[j];
        if (has1) {
#pragma unroll
            for (int j = 0; j < 4; ++j) x1[64 * j] = b[j] * q1 * wv[j]; }
    }
}

__global__ __launch_bounds__(512, 2) void hybrid_mega(Params p) {
    extern __shared__ __attribute__((aligned(16))) unsigned char smem[];
    cg::grid_group grid = cg::this_grid();
    LAS unsigned char* lds = (LAS unsigned char*)smem;
    const int G = gridDim.x;
    volatile LAS unsigned* xst = (volatile LAS unsigned*)(lds + (LDS_TOTAL - 16));
    if (threadIdx.x == 0) { xst[0] = 0u; xst[1] = 0u; }
    __syncthreads();
    (void)xcd_barrier_post((unsigned*)(p.ws + WS_BAR), xst);
    if (G == 0x7fffffff) grid.sync();
#define GSYNC() do { XcdBarrier xb_; xb_.bar = (unsigned*)(p.ws + WS_BAR); xb_.x = xb_xcc_id(); xb_.st = (volatile LAS unsigned*)((LAS unsigned char*)smem + (LDS_TOTAL - 16)); xcd_barrier(xb_); } while (0)

#ifndef ONLY
#define ONLY 0
#endif
#define EN(x) (ONLY == 0 || ONLY == (x))
    if (EN(1)) phase0(p, smem);
    GSYNC();
#pragma unroll 1
    for (int it = 0; it <= NSEG + 2; ++it) {
        const int xblk = obid() - (G - 12);
        const bool xrole = xblk >= 0;
        if (it > 0 && it <= NSEG && EN(3)) phase2(p, it - 1, smem);
        if ((((it == 2 || it == 3) && xrole) || it == NSEG + 1) && EN(5)) {
            const bool ex = it <= 3;
            SchedAB S; S.ob.init(ex ? 3 : XROWS / 256, 4, ex ? 12 : G, ex ? xblk : obid()); S.pm0 = ex ? XROWS / 256 : 0; S.wfix = ex ? it - 2 : -1;
            S.A0 = (const char*)(p.ws + WS_H); S.A1 = (const char*)(p.ws + WS_OB); S.B0 = (const char*)(p.ws + WS_WT_A); S.B1 = (const char*)(p.ws + WS_WT_B);
            EpiAB E; E.tmp = ex ? (bf16_t*)(p.ws + WS_YRAW) - (size_t)XROWS * D : (bf16_t*)(p.ws + WS_P); E.merged = ex ? (bf16_t*)(p.ws + WS_C0) - (size_t)XROWS * D : (bf16_t*)(p.ws + WS_MG);
            E.gex = (const bf16_t*)(p.ws + WS_GEX); E.out = p.out;
            pg8::gemm_phase<EpiAB, SchedAB>(lds, D, S, E);
        }
        if (((it == 4 && xrole) || it == NSEG + 2) && EN(6)) {
            const bool ex = it == 4;
            SchedO S; S.ob.init(ex ? 3 : XROWS / 256, 4, ex ? 12 : G, ex ? xblk : obid()); S.pm0 = ex ? XROWS / 256 : 0;
            S.A = ex ? (const char*)((bf16_t*)(p.ws + WS_C0) - (size_t)XROWS * D) : (const char*)(p.ws + WS_MG); S.B = (const char*)(p.ws + WS_WT_O);
            EpiO E; E.out = p.out; E.xp = p.in[0]; E.xs = p.in[1];
            pg8::gemm_phase<EpiO, SchedO>(lds, D, S, E);
        }
        const bool xphase = it >= 2 && it <= 4;
        if (it < NSEG && EN(2) && !(xphase && xrole)) {
            const int seg = it;
            const int Gp = xphase ? G - 12 : G;
            const int cidx = it > 0 ? (obid() + (Gp >> 1)) % Gp : obid();
            SchedIn S; S.ob.init(seg == 0 ? LT_PROMPT + 3 : LT_PROMPT, NT_IN, Gp, cidx); S.seg = seg; S.A = (const char*)(p.ws + WS_H); S.B = (const char*)(p.ws + WS_WT_IN);
            EpiIn E; E.P = (bf16_t*)(p.ws + WS_P); E.gex = (bf16_t*)(p.ws + WS_GEX); E.out = p.out; E.seg = seg;
            pg8::gemm_phase<EpiIn, SchedIn>(lds, D, S, E);
        }
        {
            const int hlo = 208, hhi = (it >= 2 && it <= 4) ? G - 12 : G;
            if (it >= 1 && it + 1 < NSEG && obid() >= hlo && obid() < hhi) { const int t0 = otid(); h_rows_segs(p, it + 1, it + 2, (obid() - hlo) * 8 + (t0 >> 6), (hhi - hlo) * 8, t0 & 63); }
        }
        GSYNC();
        if (it < NSEG) {
            if (EN(8)) { phase_gprep(p, it, smem); phase_rprep(p, it, smem); }
            if (it == 1 && EN(4)) phase25(p, 0);
            GSYNC();
        }
    }
    if (EN(7)) phase_final(p);
}

extern "C" void kernel_launch(void* const* d_in, const int* in_sizes, int n_in, void* d_out, int out_size, void* d_ws, size_t ws_size, hipStream_t stream) {
    static int grid_blocks = 0;
    constexpr int LDS_BYTES = LDS_TOTAL;
    if (grid_blocks == 0) {
        if (n_in != 27 || ws_size < WS_END) { fprintf(stderr, "kernel_launch: unexpected n_in %d / ws %zu (need %zu)\n", n_in, ws_size, (size_t)WS_END); grid_blocks = -1; return; }
        if (hipFuncSetAttribute((const void*)hybrid_mega, hipFuncAttributeMaxDynamicSharedMemorySize, LDS_BYTES) != hipSuccess) { fprintf(stderr, "kernel_launch: hipFuncSetAttribute failed\n"); grid_blocks = -1; return; }
        int dev = 0, cus = 0, per_cu = 0;
        hipGetDevice(&dev);
        hipDeviceGetAttribute(&cus, hipDeviceAttributeMultiprocessorCount, dev);
        hipOccupancyMaxActiveBlocksPerMultiprocessor(&per_cu, (const void*)hybrid_mega, 512, LDS_BYTES);
        if (per_cu < 1) { fprintf(stderr, "kernel_launch: occupancy query says %d blocks/CU\n", per_cu); per_cu = 1; }
        (void)hipGetLastError();
        grid_blocks = cus;
    }
    if (grid_blocks < 0) return;
    Params p{};
    for (int i = 0; i < 27; ++i) p.in[i] = (const float*)d_in[i];
    p.out = (float*)d_out; p.ws = (unsigned char*)d_ws;
    if (hipMemsetAsync((unsigned char*)d_ws + WS_BAR, 0, 16384, stream) != hipSuccess) { fprintf(stderr, "kernel_launch: memset of the barrier words failed\n"); return; }
    void* args[] = {&p};
    hipError_t e = hipLaunchCooperativeKernel((const void*)hybrid_mega, dim3(grid_blocks), dim3(512), args, LDS_BYTES, stream);
    if (e != hipSuccess) fprintf(stderr, "cooperative launch failed: %s (grid %d)\n", hipGetErrorString(e), grid_blocks);
}
```

```cpp
#include <hip/hip_runtime.h>
#include <hip/hip_cooperative_groups.h>
#include <cstdio>
namespace cg = cooperative_groups;

#define LAS __attribute__((address_space(3)))
typedef unsigned short bf16_t;
typedef short bf16x8 __attribute__((ext_vector_type(8)));
typedef float f32x4 __attribute__((ext_vector_type(4)));
typedef unsigned u32x4 __attribute__((ext_vector_type(4)));
typedef unsigned u32x2 __attribute__((ext_vector_type(2)));

constexpr int D = 1024;
constexpr int NBATCH = 8, SEQ = 2048, NMETA = 16, DECB = 128, DECT = 4;
constexpr int XROWS = NBATCH * SEQ;
constexpr int EX_SAMP = 16, EX_SHIFT = 528, EX_END = 656;
constexpr int HROWS = 17152, HTILES = 67;
constexpr int NSEG = 8, SEGTOK = SEQ / NSEG;
constexpr int CPS = SEGTOK / 64;
constexpr int TPB = SEGTOK / 256;
constexpr int LT_PROMPT = NBATCH * TPB;
constexpr int LEX0 = LT_PROMPT * 256;
constexpr int LROWS = LEX0 + 768;
constexpr int NP = 10496, NPB = 8448, NT_IN = 41, NT_PB = 33;
constexpr int C_A = 3072, C_B = 3080, C_Z = 3088, C_RW = 4112, C_GATE_REF = 8336;
constexpr int RW_SHIFT = 4224;

constexpr size_t O_YP = 0, O_YS = 16777216, O_GDN_P = 17301504, O_CONV_P = 18350080, O_RWKV_P = 18423808, O_SHIFT_P = 18948096,
                 O_GDN_S = 18956288, O_CONV_S = 35733504, O_RWKV_S = 36913152, O_SHIFT_S = 45301760;

constexpr size_t al256(size_t x) { return (x + 255) & ~(size_t)255; }
constexpr size_t WS_WT_IN = 0;
constexpr size_t WS_WT_A = al256(WS_WT_IN + (size_t)NP * D * 2);
constexpr size_t WS_WT_B = al256(WS_WT_A + (size_t)D * D * 2);
constexpr size_t WS_WT_O = al256(WS_WT_B + (size_t)D * D * 2);
constexpr size_t WS_H = al256(WS_WT_O + (size_t)D * D * 2);
constexpr size_t WS_OB = al256(WS_H + (size_t)HROWS * D * 2);
constexpr size_t WS_P = al256(WS_OB + (size_t)HROWS * D * 2);
constexpr size_t WS_ORAW = al256(WS_P + (size_t)LROWS * NPB * 2);
constexpr size_t WS_YRAW = al256(WS_ORAW + (size_t)LROWS * D * 4);
constexpr size_t WS_C0 = al256(WS_YRAW + (size_t)LROWS * D * 4);
constexpr size_t WS_C1 = al256(WS_C0 + (size_t)LROWS * D * 2);
constexpr size_t WS_GEX = al256(WS_C1 + (size_t)LROWS * D * 2);
constexpr size_t WS_CHALO = al256(WS_GEX + (size_t)768 * 2048 * 2);
constexpr size_t WS_PHALO = al256(WS_CHALO + (size_t)2 * NBATCH * 3 * NPB * 2);
constexpr size_t WS_PK = al256(WS_PHALO + (size_t)2 * NBATCH * NPB * 2);
constexpr int PK_CONVW = 0, PK_ALOG = 12288, PK_DTB = 12296, PK_NORMW = 12304, PK_MU = 12432, PK_W0 = 16656, PK_W2 = 17680, PK_A0 = 83216, PK_A2 = 84240,
              PK_KK = 149776, PK_KA = 150800, PK_RK = 151824, PK_GNW = 152848, PK_GNB = 153872, PK_LNF = 154896, PK_END = 155920;
constexpr size_t WS_BAR = al256(WS_PK + (size_t)PK_END * 4);
constexpr size_t WS_W2T = al256(WS_BAR + 16384);
constexpr size_t WS_A2T = al256(WS_W2T + 131072);
constexpr size_t WS_GP = al256(WS_A2T + 131072);
constexpr int GP_AP = 0, GP_QH = 32768, GP_KH = 49152, GP_OH = 81920, GP_EGL = 98304, GP_G = 98560, GP_STRIDE = 114944;
constexpr int RP_AP = 0, RP_RH = 8192, RP_KH = 16384, RP_YH = 24576, RP_C1 = 32768, RP_C0 = 40960, RP_PC = 49152, RP_STRIDE = 49408;
constexpr size_t WS_RP = al256(WS_GP + (size_t)(CPS + 1) * 64 * GP_STRIDE);
constexpr size_t WS_END = al256(WS_RP + (size_t)(CPS + 1) * 128 * RP_STRIDE);
constexpr size_t WS_MG = WS_GP;
static_assert((size_t)HROWS * D * 2 <= WS_END - WS_GP, "MERGED must fit in the prep records");
static_assert((size_t)HROWS * D * 4 <= (size_t)LROWS * NPB * 2 + 2 * (size_t)LROWS * D * 4, "TMP must fit in P+ORAW+YRAW");
static_assert(WS_END <= (size_t)268435456, "workspace");

constexpr int LDS_TOTAL = 163840;
struct Params { const float* in[27]; float* out; unsigned char* ws; };

__device__ __forceinline__ float bf2f(bf16_t v) { return __uint_as_float(((unsigned)v) << 16); }
typedef __bf16 bf16n2 __attribute__((ext_vector_type(2)));
typedef float f32n2 __attribute__((ext_vector_type(2)));
__device__ __forceinline__ unsigned cvt_pk_bf16(float lo, float hi) { const f32n2 v = {lo, hi}; return __builtin_bit_cast(unsigned, __builtin_convertvector(v, bf16n2)); }
__device__ __forceinline__ unsigned pk2(float lo, float hi) { return cvt_pk_bf16(lo, hi); }
__device__ __forceinline__ unsigned f2bf(float f) { return cvt_pk_bf16(f, 0.f) & 0xffffu; }
__device__ __forceinline__ float sigm(float x) { return __builtin_amdgcn_rcpf(1.f + __expf(-x)); }
__device__ __forceinline__ float silu_(float x) { return x * __builtin_amdgcn_rcpf(1.f + __expf(-x)); }
__device__ __forceinline__ float softplus_(float x) { return fmaxf(x, 0.f) + log1pf(expf(-fabsf(x))); }
__device__ __forceinline__ float wave_sum(float v) {
#pragma unroll
    for (int o = 1; o < 64; o <<= 1) v += __shfl_xor(v, o);
    return v;
}
__device__ __forceinline__ void unpack8(const u32x4 rw, float (&x)[8]) {
    x[0] = __uint_as_float(rw.x << 16); x[1] = __uint_as_float(rw.x & 0xffff0000u); x[2] = __uint_as_float(rw.y << 16); x[3] = __uint_as_float(rw.y & 0xffff0000u);
    x[4] = __uint_as_float(rw.z << 16); x[5] = __uint_as_float(rw.z & 0xffff0000u); x[6] = __uint_as_float(rw.w << 16); x[7] = __uint_as_float(rw.w & 0xffff0000u); }
__device__ __forceinline__ u32x4 pack8(const float (&x)[8]) { return (u32x4){pk2(x[0], x[1]), pk2(x[2], x[3]), pk2(x[4], x[5]), pk2(x[6], x[7])}; }

__device__ __forceinline__ int otid() { int t = threadIdx.x; asm volatile("" : "+v"(t)); return t; }
__device__ __forceinline__ int obid() { int t = blockIdx.x; asm volatile("" : "+s"(t)); return t; }
__device__ __forceinline__ float tanh_(float x) { const float e = __expf(2.f * x); return 1.f - 2.f * __builtin_amdgcn_rcpf(e + 1.f); }
template <int CTRL> __device__ __forceinline__ float dppf(float x) { return __builtin_bit_cast(float, __builtin_amdgcn_mov_dpp(__builtin_bit_cast(int, x), CTRL, 0xf, 0xf, true)); }
__device__ __forceinline__ float rowsum16(float x) { x += dppf<0x128>(x); x += dppf<0x124>(x); x += dppf<0x122>(x); x += dppf<0x121>(x); return x; }


#define XB_TMO      128
#define XB_XCNT(j)  (256  + 64 * (j))
#define XB_XSUB(j)  (1280 + 64 * (j))
#define XB_XGEN(j)  (2304 + 64 * (j))
#define XB_TOP      3328
#define XB_TOPGEN   3392
#define XCD_BAR_WORDS 3456
#define XB_SPIN_CAP (1u << 22)
__device__ __forceinline__ unsigned xb_ld(unsigned* p)              { return __hip_atomic_load(p, __ATOMIC_RELAXED, __HIP_MEMORY_SCOPE_AGENT); }
__device__ __forceinline__ unsigned xb_add(unsigned* p, unsigned v) { return __hip_atomic_fetch_add(p, v, __ATOMIC_RELAXED, __HIP_MEMORY_SCOPE_AGENT); }
__device__ __forceinline__ unsigned xb_xcc_id() { return (unsigned)__builtin_amdgcn_s_getreg((3 << 11) | 20) & 0xFu; }
#define XB_SPIN(cond, bar) do { unsigned _sp = 0; while (cond) { __builtin_amdgcn_s_sleep(1); \
    if ((++_sp & 255u) == 0u) { if (xb_ld(&(bar)[XB_TMO])) break; if (_sp > XB_SPIN_CAP) { atomicAdd(&(bar)[XB_TMO], 1u); break; } } } } while (0)
struct XcdBarrier { unsigned* bar; unsigned x; volatile LAS unsigned* st; };
__device__ __forceinline__ XcdBarrier xcd_barrier_post(unsigned* bar, volatile LAS unsigned* st) {
    XcdBarrier b; b.bar = bar; b.x = xb_xcc_id(); b.st = st;
    if (threadIdx.x == 0) (void)xb_add(&bar[XB_XCNT(b.x)], 1u);
    return b;
}
__device__ __forceinline__ void xcd_barrier_complete(unsigned* bar, unsigned x, unsigned& nloc, unsigned& nx) {
    const unsigned G = gridDim.x * gridDim.y * gridDim.z;
    unsigned sum, cnt, mine, sp = 0u;
    for (;;) {
        sum = 0u; cnt = 0u; mine = 0u;
#pragma unroll
        for (unsigned j = 0; j < 16; ++j) { const unsigned c = xb_ld(&bar[XB_XCNT(j)]); sum += c; cnt += (c > 0u) ? 1u : 0u; mine = (j == x) ? c : mine; }
        if (sum == G) break;
        __builtin_amdgcn_s_sleep(1);
        if ((++sp & 255u) == 0u) { if (xb_ld(&bar[XB_TMO])) break; if (sp > XB_SPIN_CAP) { atomicAdd(&bar[XB_TMO], 1u); break; } }
    }
    nloc = mine > 0u ? mine : 1u; nx = cnt > 0u ? cnt : 1u;
}
__device__ __forceinline__ void xcd_barrier(const XcdBarrier& b) {
    asm volatile("s_waitcnt vmcnt(0)" ::: "memory");
    __syncthreads();
    if (threadIdx.x == 0) {
        unsigned* bar = b.bar;
        __builtin_amdgcn_s_waitcnt(0);
        unsigned nloc = b.st[0], nx = b.st[1];
        if (nloc == 0u) { xcd_barrier_complete(bar, b.x, nloc, nx); b.st[0] = nloc; b.st[1] = nx; }
        const unsigned old = xb_add(&bar[XB_XSUB(b.x)], 1u);
        const unsigned gen = old / nloc;
        if (old + 1u == (gen + 1u) * nloc) {
            __builtin_amdgcn_fence(__ATOMIC_RELEASE, "agent");
            asm volatile("s_waitcnt vmcnt(0)" ::: "memory");
            const unsigned og = xb_add(&bar[XB_TOP], 1u);
            const unsigned tg = og / nx;
            if (og + 1u == (tg + 1u) * nx) xb_add(&bar[XB_TOPGEN], 1u);
            else XB_SPIN(xb_ld(&bar[XB_TOPGEN]) == tg, bar);
            __builtin_amdgcn_fence(__ATOMIC_ACQUIRE, "agent");
            xb_add(&bar[XB_XGEN(b.x)], 1u);
            asm volatile("s_waitcnt vmcnt(0)" ::: "memory");
        } else {
            XB_SPIN(xb_ld(&bar[XB_XGEN(b.x)]) == gen, bar);
            __builtin_amdgcn_fence(__ATOMIC_ACQUIRE, "agent");
            asm volatile("s_waitcnt vmcnt(0)" ::: "memory");
        }
    }
    __syncthreads();
}

namespace pg8 {
constexpr int BM = 256, BK = 64, HALF = 128, HTB = HALF * BK * 2, STAGE_BYTES = 8 * HTB, NXCD = 8, WGM = 8;
__device__ __forceinline__ int lds_byte(int r, int c) { const int st = (r >> 4) * 2 + (c >> 5), rr = r & 15, cc = c & 31, ob = rr * 64 + cc * 2; return st * 1024 + (ob ^ (((ob >> 9) & 1) << 5)); }
__device__ __forceinline__ void stage_rc(int b, int& R, int& C) { const int st = b / 1024, sb = b % 1024, swz = sb ^ (((sb >> 9) & 1) << 5); R = (st >> 1) * 16 + swz / 64; C = (st & 1) * 32 + (swz % 64) / 2; }
__device__ __forceinline__ int perm32(int rho) { const int n = rho >> 4, i = rho & 15; return 8 * (i >> 2) + 4 * n + (i & 3); }

struct Unit { int pm, pn, w; };
struct OrderBase {
    int nM, nN, nwg, G, c;
    __device__ void init(int nM_, int nN_, int G_, int c_) { nM = nM_; nN = nN_; nwg = nM * nN; G = G_; c = c_; }
    __device__ bool nextb(int i, Unit& u) const {
        const long L = (long)i * G + c; if (L >= nwg) return false;
        int wgid = (int)L; { const int q = nwg / NXCD, r = nwg % NXCD, xcd = wgid % NXCD, off = wgid / NXCD; wgid = (xcd < r ? xcd * (q + 1) : r * (q + 1) + (xcd - r) * q) + off; }
        const int nig = WGM * nN, gid = wgid / nig, fm = gid * WGM, gsz = (nM - fm) < WGM ? (nM - fm) : WGM;
        u.pm = fm + ((wgid % nig) % gsz); u.pn = (wgid % nig) / gsz; u.w = 0; return true;
    }
};

template <class Epi, class Sched>
__device__ __forceinline__ void gemm_phase(LAS unsigned char* lds, const int K, const Sched& S, const Epi& E) {
    const int tid = otid(), wid = __builtin_amdgcn_readfirstlane(tid >> 6), lane = tid & 63, wr = wid >> 2, wc = wid & 3, fr = lane & 15, fq = lane >> 4;
    const int nt = K / BK;
    unsigned voffA[2], voffB[2];
#pragma unroll
    for (int i = 0; i < 2; ++i) { int R, C; stage_rc(tid * 16 + i * 8192, R, C); const int Rb = Epi::PERM ? ((R & ~31) + perm32(R & 31)) : R;
        voffA[i] = (unsigned)(R * K + C) * 2u; voffB[i] = (unsigned)(Rb * K + C) * 2u; }
    const size_t kstep = (size_t)(BK * 2);
    const size_t hstep = (size_t)HALF * K * 2;
    const unsigned ldsw = (unsigned)wid * 1024u;
    const int aoff = lds_byte(wr * 64 + fr, fq * 8), boff = lds_byte(wc * 32 + fr, fq * 8);
#define PG8_SA(b, h) (((b) * 2 + (h)) * HTB)
#define PG8_SB(b, h) ((4 + (b) * 2 + (h)) * HTB)
#define PG8_STAGE(bufoff, gbase, voff) do { _Pragma("unroll") for (int _i = 0; _i < 2; ++_i) \
        __builtin_amdgcn_global_load_lds((const unsigned*)((const char*)(gbase) + (voff)[_i]), (LAS unsigned*)(lds + (bufoff) + ldsw + _i * 8192), 16, 0, 0); } while (0)
#define PG8_LDA(dst, b, h) do { _Pragma("unroll") for (int m = 0; m < 4; ++m) _Pragma("unroll") for (int k = 0; k < 2; ++k) dst[m][k] = *(const LAS bf16x8*)(lds + PG8_SA(b, h) + aoff + m * 2048 + k * 1024); } while (0)
#define PG8_LDB(dst, b, h) do { _Pragma("unroll") for (int n = 0; n < 2; ++n) _Pragma("unroll") for (int k = 0; k < 2; ++k) dst[n][k] = *(const LAS bf16x8*)(lds + PG8_SB(b, h) + boff + n * 2048 + k * 1024); } while (0)
#define PG8_MMA(ai, bj, At, Bt) do { __builtin_amdgcn_s_setprio(1); _Pragma("unroll") for (int m = 0; m < 4; ++m) _Pragma("unroll") for (int n = 0; n < 2; ++n) _Pragma("unroll") for (int k = 0; k < 2; ++k) \
        acc[ai][bj][m][n] = __builtin_amdgcn_mfma_f32_16x16x32_bf16(Bt[n][k], At[m][k], acc[ai][bj][m][n], 0, 0, 0); __builtin_amdgcn_s_setprio(0); } while (0)
#define PG8_WAIT_V(n) asm volatile("s_waitcnt vmcnt(" #n ")" ::: "memory")
#define PG8_WAIT_L(n) asm volatile("s_waitcnt lgkmcnt(" #n ")" ::: "memory")
#define PG8_BAR __builtin_amdgcn_s_barrier()
#define PG8_SCHED __builtin_amdgcn_sched_barrier(0)
    Unit cur, nxt; int ui = 0;
    if (!S.next(0, cur)) return;
    f32x4 acc[2][2][4][2];
#pragma unroll
    for (int a = 0; a < 2; ++a)
#pragma unroll
        for (int b = 0; b < 2; ++b)
#pragma unroll
            for (int m = 0; m < 4; ++m)
#pragma unroll
                for (int n = 0; n < 2; ++n) acc[a][b][m][n] = (f32x4){0.f, 0.f, 0.f, 0.f};
    bf16x8 At[4][2], B0[2][2], B1[2][2];
    const char* cA = S.a_ptr(cur); const char* cB = S.b_ptr(cur);
    PG8_STAGE(PG8_SB(0, 0), cB, voffB); PG8_STAGE(PG8_SA(0, 0), cA, voffA); PG8_STAGE(PG8_SB(0, 1), cB + hstep, voffB); PG8_STAGE(PG8_SA(0, 1), cA + hstep, voffA);
    if (wr == 1) PG8_BAR;
    PG8_WAIT_V(4); PG8_BAR;
    PG8_STAGE(PG8_SB(1, 0), cB + kstep, voffB); PG8_STAGE(PG8_SA(1, 0), cA + kstep, voffA); PG8_STAGE(PG8_SB(1, 1), cB + hstep + kstep, voffB);
    PG8_WAIT_V(6); PG8_BAR;
    for (;;) {
        const bool has_next = S.next(ui + 1, nxt);
        const char* nA = has_next ? S.a_ptr(nxt) : cA; const char* nB = has_next ? S.b_ptr(nxt) : cB;
        for (int t = 0; t < nt; t += 2) {
            const bool last = (t == nt - 2);
            const char* a1 = cA + (size_t)(t + 1) * kstep;
            const char* a2 = last ? nA : cA + (size_t)(t + 2) * kstep; const char* b2 = last ? nB : cB + (size_t)(t + 2) * kstep;
            const char* a3 = a2 + kstep; const char* b3 = b2 + kstep;
            PG8_LDB(B0, 0, 0); PG8_SCHED; PG8_LDA(At, 0, 0); PG8_STAGE(PG8_SA(1, 1), a1 + hstep, voffA);
            PG8_WAIT_L(8); PG8_BAR; PG8_WAIT_L(0); PG8_MMA(0, 0, At, B0); PG8_BAR; PG8_SCHED;
            PG8_LDB(B1, 0, 1); PG8_STAGE(PG8_SB(0, 0), b2, voffB);
            PG8_BAR; PG8_WAIT_L(0); PG8_MMA(0, 1, At, B1); PG8_BAR;
            PG8_LDA(At, 0, 1); PG8_STAGE(PG8_SA(0, 0), a2, voffA);
            PG8_BAR; PG8_WAIT_L(0); PG8_MMA(1, 0, At, B0); PG8_BAR; PG8_SCHED;
            PG8_STAGE(PG8_SB(0, 1), b2 + hstep, voffB);
            PG8_WAIT_V(6); PG8_BAR; PG8_MMA(1, 1, At, B1); PG8_BAR;
            PG8_LDB(B0, 1, 0); PG8_SCHED; PG8_LDA(At, 1, 0); PG8_STAGE(PG8_SA(0, 1), a2 + hstep, voffA);
            PG8_WAIT_L(8); PG8_BAR; PG8_WAIT_L(0); PG8_MMA(0, 0, At, B0); PG8_BAR; PG8_SCHED;
            PG8_LDB(B1, 1, 1); PG8_STAGE(PG8_SB(1, 0), b3, voffB);
            PG8_BAR; PG8_WAIT_L(0); PG8_MMA(0, 1, At, B1); PG8_BAR;
            PG8_LDA(At, 1, 1); PG8_STAGE(PG8_SA(1, 0), a3, voffA);
            PG8_BAR; PG8_WAIT_L(0); PG8_MMA(1, 0, At, B0); PG8_BAR; PG8_SCHED;
            PG8_STAGE(PG8_SB(1, 1), b3 + hstep, voffB);
            PG8_WAIT_V(6); PG8_BAR; PG8_MMA(1, 1, At, B1); PG8_BAR;
        }
        E(acc, cur, wr, wc, fr, fq);
        if (!has_next) break;
        if (!E.keep(cur)) {
#pragma unroll
        for (int a = 0; a < 2; ++a)
#pragma unroll
            for (int b = 0; b < 2; ++b)
#pragma unroll
                for (int m = 0; m < 4; ++m)
#pragma unroll
                    for (int n = 0; n < 2; ++n) acc[a][b][m][n] = (f32x4){0.f, 0.f, 0.f, 0.f};
        }
        cur = nxt; cA = nA; cB = nB; ++ui;
    }
    PG8_WAIT_V(0);
    if (wr == 0) PG8_BAR;
    PG8_BAR;
#undef PG8_SA
#undef PG8_SB
#undef PG8_STAGE
#undef PG8_LDA
#undef PG8_LDB
#undef PG8_MMA
#undef PG8_WAIT_V
#undef PG8_WAIT_L
#undef PG8_BAR
#undef PG8_SCHED
}
}
using pg8::Unit;

struct SchedIn {
    pg8::OrderBase ob; int seg; const char* A; const char* B;
    __device__ bool next(int i, Unit& u) const { return ob.nextb(i, u); }
    __device__ const char* a_ptr(const Unit& u) const {
        const int gt = u.pm < LT_PROMPT ? ((u.pm / TPB) * (SEQ / 256) + seg * TPB + (u.pm % TPB)) : (XROWS / 256 + (u.pm - LT_PROMPT));
        return A + (size_t)gt * 256 * D * 2; }
    __device__ const char* b_ptr(const Unit& u) const { return B + (size_t)u.pn * 256 * D * 2; }
};
struct SchedAB {
    pg8::OrderBase ob; int pm0, wfix; const char* A0; const char* A1; const char* B0; const char* B1;
    __device__ bool next(int i, Unit& u) const { const bool ok = wfix < 0 ? ob.nextb(i >> 1, u) : ob.nextb(i, u); u.pm += pm0; u.w = wfix < 0 ? (i & 1) : wfix; return ok; }
    __device__ const char* a_ptr(const Unit& u) const { return (u.w ? A1 : A0) + (size_t)u.pm * 256 * D * 2; }
    __device__ const char* b_ptr(const Unit& u) const { return (u.w ? B1 : B0) + (size_t)u.pn * 256 * D * 2; }
};
struct SchedO {
    pg8::OrderBase ob; int pm0; const char* A; const char* B;
    __device__ bool next(int i, Unit& u) const { const bool ok = ob.nextb(i, u); u.pm += pm0; return ok; }
    __device__ const char* a_ptr(const Unit& u) const { return A + (size_t)u.pm * 256 * D * 2; }
    __device__ const char* b_ptr(const Unit& u) const { return B + (size_t)u.pn * 256 * D * 2; }
};

struct EpiIn {
    static constexpr bool PERM = true;
    bf16_t* P; bf16_t* gex; float* out; int seg;
    __device__ __forceinline__ bool keep(const Unit&) const { return false; }
    __device__ __forceinline__ void operator()(const f32x4 (&acc)[2][2][4][2], const Unit& u, int wr, int wc, int fr, int fq) const {
        const int lr0 = u.pm * 256 + wr * 64 + fr;
        const int c0 = u.pn * 256 + wc * 32 + 8 * fq;
#pragma unroll
        for (int ai = 0; ai < 2; ++ai)
#pragma unroll
            for (int m = 0; m < 4; ++m) {
                const int lr = lr0 + ai * 128 + m * 16;
                bf16_t* rowp;
                if (u.pn < NT_PB) rowp = P + (size_t)lr * NPB + c0;
                else if (lr < LEX0) { const int b = lr / SEGTOK; const size_t grow = (size_t)b * SEQ + seg * SEGTOK + (lr % SEGTOK); rowp = (bf16_t*)(out + O_YP + grow * D) + (c0 - NPB); }
                else rowp = gex + (size_t)(lr - LEX0) * 2048 + (c0 - NPB);
#pragma unroll
                for (int bj = 0; bj < 2; ++bj) { const f32x4 v0 = acc[ai][bj][m][0], v1 = acc[ai][bj][m][1];
                    u32x4 w; w.x = cvt_pk_bf16(v0[0], v0[1]); w.y = cvt_pk_bf16(v0[2], v0[3]); w.z = cvt_pk_bf16(v1[0], v1[1]); w.w = cvt_pk_bf16(v1[2], v1[3]);
                    *(u32x4*)(rowp + bj * 128) = w; }
            }
    }
};
struct EpiAB {
    static constexpr bool PERM = true;
    bf16_t* tmp; bf16_t* merged; const bf16_t* gex; const float* out; int pairmode;
    __device__ __forceinline__ bool keep(const Unit& u) const { return pairmode && u.w == 0; }
    __device__ __forceinline__ void operator()(f32x4 (&acc)[2][2][4][2], const Unit& u, int wr, int wc, int fr, int fq) const {
        const int row0 = u.pm * 256 + wr * 64 + fr, col0 = u.pn * 256 + wc * 32 + 8 * fq;
#pragma unroll
        for (int ai = 0; ai < 2; ++ai)
#pragma unroll
            for (int m = 0; m < 4; ++m) {
                const int grow = row0 + ai * 128 + m * 16;
                const bf16_t* g0 = (grow < XROWS) ? (const bf16_t*)(out + O_YP + (size_t)grow * D) : (gex + (size_t)(grow - XROWS) * 2048);
#pragma unroll
                for (int bj = 0; bj < 2; ++bj) {
                    const int c = col0 + bj * 128;
                    if (pairmode) {
                        float gb[8]; unpack8(*(const u32x4*)(g0 + D + c), gb);
                        float eb[8];
#pragma unroll
                        for (int e = 0; e < 8; ++e) eb[e] = 1.f + fminf(__expf(-gb[e]), 1e18f);
                        if (u.w == 0) {
                            float ga[8]; unpack8(*(const u32x4*)(g0 + c), ga);
#pragma unroll
                            for (int e = 0; e < 4; ++e) { acc[ai][bj][m][0][e] *= sigm(ga[e]) * eb[e]; acc[ai][bj][m][1][e] *= sigm(ga[4 + e]) * eb[4 + e]; }
                        } else {
                            float v[8];
#pragma unroll
                            for (int e = 0; e < 4; ++e) { v[e] = acc[ai][bj][m][0][e] * __builtin_amdgcn_rcpf(eb[e]); v[4 + e] = acc[ai][bj][m][1][e] * __builtin_amdgcn_rcpf(eb[4 + e]); }
                            *(u32x4*)(merged + (size_t)grow * D + c) = pack8(v);
                        }
                    } else {
                        float g[8]; unpack8(*(const u32x4*)(g0 + u.w * D + c), g);
                        const f32x4 v0 = acc[ai][bj][m][0], v1 = acc[ai][bj][m][1];
                        float v[8] = {v0[0] * sigm(g[0]), v0[1] * sigm(g[1]), v0[2] * sigm(g[2]), v0[3] * sigm(g[3]), v1[0] * sigm(g[4]), v1[1] * sigm(g[5]), v1[2] * sigm(g[6]), v1[3] * sigm(g[7])};
                        bf16_t* tp = tmp + (size_t)grow * D + c;
                        if (u.w == 0) *(u32x4*)tp = pack8(v);
                        else { float t[8]; unpack8(*(const u32x4*)tp, t);
#pragma unroll
                            for (int e = 0; e < 8; ++e) v[e] += t[e];
                            *(u32x4*)(merged + (size_t)grow * D + c) = pack8(v); }
                    }
                }
            }
    }
};
struct EpiO {
    static constexpr bool PERM = false;
    float* out; const float* xp; const float* xs;
    __device__ __forceinline__ bool keep(const Unit&) const { return false; }
    __device__ __forceinline__ void operator()(const f32x4 (&acc)[2][2][4][2], const Unit& u, int wr, int wc, int fr, int fq) const {
        const int row0 = u.pm * 256 + wr * 64 + fr, col0 = u.pn * 256 + wc * 32 + 4 * fq;
#pragma unroll
        for (int ai = 0; ai < 2; ++ai)
#pragma unroll
            for (int m = 0; m < 4; ++m) {
                const int grow = row0 + ai * 128 + m * 16;
                const float* xr; float* yr;
                if (grow < XROWS) { xr = xp + (size_t)grow * D; yr = out + O_YP + (size_t)grow * D; }
                else { const int e = grow - XROWS; if (e < EX_SAMP || e >= EX_SHIFT) continue; xr = xs + (size_t)(e - EX_SAMP) * D; yr = out + O_YS + (size_t)(e - EX_SAMP) * D; }
#pragma unroll
                for (int bj = 0; bj < 2; ++bj)
#pragma unroll
                    for (int n = 0; n < 2; ++n) { const int c = col0 + bj * 128 + n * 16; *(f32x4*)(yr + c) = *(const f32x4*)(xr + c) + acc[ai][bj][m][n]; }
            }
    }
};

__device__ __forceinline__ void p0_row(const Params& p, int r, int lane) {
    bf16_t* hrow = (bf16_t*)(p.ws + WS_H) + (size_t)r * D;
    const float* src = nullptr; bool norm = true; float* sh = nullptr;
    if (r < XROWS) { src = p.in[0] + (size_t)r * D; if ((r & (SEQ - 1)) == SEQ - 1) sh = p.out + O_SHIFT_P + (size_t)(r / SEQ) * D; }
    else { const int e = r - XROWS;
        if (e < EX_SAMP) src = p.in[6] + (size_t)e * D;
        else if (e < EX_SHIFT) { src = p.in[1] + (size_t)(e - EX_SAMP) * D; if (((e - EX_SAMP) & 3) == 3) sh = p.out + O_SHIFT_S + (size_t)((e - EX_SAMP) >> 2) * D; }
        else if (e < EX_END) { src = p.in[5] + (size_t)(e - EX_SHIFT) * D; norm = false; } }
    u32x2* o8 = (u32x2*)hrow + lane;
    if (!src) {
#pragma unroll
        for (int j = 0; j < 4; ++j) o8[64 * j] = (u32x2){0u, 0u};
        return; }
    const f32x4* xr = (const f32x4*)src + lane;
    f32x4 v[4]; float ss = 0.f;
#pragma unroll
    for (int j = 0; j < 4; ++j) { v[j] = xr[64 * j]; ss += v[j][0] * v[j][0] + v[j][1] * v[j][1] + v[j][2] * v[j][2] + v[j][3] * v[j][3]; }
    if (norm) {
        const float rs = __builtin_amdgcn_rsqf(wave_sum(ss) * (1.f / D) + 1e-6f);
        const f32x4* wr = (const f32x4*)p.in[7] + lane;
#pragma unroll
        for (int j = 0; j < 4; ++j) v[j] = v[j] * rs * wr[64 * j];
    }
#pragma unroll
    for (int j = 0; j < 4; ++j) { o8[64 * j] = (u32x2){pk2(v[j][0], v[j][1]), pk2(v[j][2], v[j][3])}; if (sh) ((f32x4*)sh)[lane + 64 * j] = v[j]; }
}
template <int MODE> __device__ __forceinline__ void p0_tr_item(const float* W, int N, bf16_t* WT, float* scr, int kb, int nb, int lane) {
    const int k0 = 64 * kb, n0 = 32 * nb;
    const int l8 = lane & 7, r8 = lane >> 3;
    const int nn = n0 + 4 * l8;
    int srcc = nn;
    if (MODE == 1) srcc = nn < C_GATE_REF ? nn : (nn < NPB ? -1 : nn - (NPB - C_GATE_REF));
    f32x4 v[8];
#pragma unroll
    for (int i = 0; i < 8; ++i) { const int kk = 8 * i + r8; v[i] = srcc >= 0 ? *(const f32x4*)(W + (size_t)(k0 + kk) * N + srcc) : (f32x4){0.f, 0.f, 0.f, 0.f}; }
#pragma unroll
    for (int i = 0; i < 8; ++i) { const int kk = 8 * i + r8; float* d = scr + kk * 33 + 4 * l8; d[0] = v[i][0]; d[1] = v[i][1]; d[2] = v[i][2]; d[3] = v[i][3]; }
    asm volatile("s_waitcnt lgkmcnt(0)" ::: "memory");
    const int c = lane & 7;
#pragma unroll
    for (int j = 0; j < 4; ++j) { const int n = (lane >> 3) + 8 * j; const float* s = scr + (8 * c) * 33 + n;
        u32x4 o; o.x = pk2(s[0 * 33], s[1 * 33]); o.y = pk2(s[2 * 33], s[3 * 33]); o.z = pk2(s[4 * 33], s[5 * 33]); o.w = pk2(s[6 * 33], s[7 * 33]);
        *(u32x4*)(WT + (size_t)(n0 + n) * D + k0 + 8 * c) = o; }
    asm volatile("s_waitcnt lgkmcnt(0)" ::: "memory");
}
__device__ __forceinline__ void h_rows_pair(const Params& p, int r, int r1, bool has1, int lane, const f32x4 (&wv)[4]) {
    const f32x4* x0 = (const f32x4*)(p.in[0] + (size_t)r * D) + lane; const f32x4* x1 = (const f32x4*)(p.in[0] + (size_t)(has1 ? r1 : r) * D) + lane;
    f32x4 a[4], b[4]; float s0 = 0.f, s1 = 0.f;
#pragma unroll
    for (int j = 0; j < 4; ++j) { a[j] = x0[64 * j]; b[j] = x1[64 * j]; }
#pragma unroll
    for (int j = 0; j < 4; ++j) { s0 += a[j][0] * a[j][0] + a[j][1] * a[j][1] + a[j][2] * a[j][2] + a[j][3] * a[j][3]; s1 += b[j][0] * b[j][0] + b[j][1] * b[j][1] + b[j][2] * b[j][2] + b[j][3] * b[j][3]; }
    const float q0 = __builtin_amdgcn_rsqf(wave_sum(s0) * (1.f / D) + 1e-6f), q1 = __builtin_amdgcn_rsqf(wave_sum(s1) * (1.f / D) + 1e-6f);
    u32x2* o0 = (u32x2*)((bf16_t*)(p.ws + WS_H) + (size_t)r * D) + lane; u32x2* o1 = (u32x2*)((bf16_t*)(p.ws + WS_H) + (size_t)r1 * D) + lane;
#pragma unroll
    for (int j = 0; j < 4; ++j) { a[j] = a[j] * q0 * wv[j]; o0[64 * j] = (u32x2){pk2(a[j][0], a[j][1]), pk2(a[j][2], a[j][3])}; }
    if ((r & (SEQ - 1)) == SEQ - 1) { f32x4* sh = (f32x4*)(p.out + O_SHIFT_P + (size_t)(r / SEQ) * D) + lane;
#pragma unroll
        for (int j = 0; j < 4; ++j) sh[64 * j] = a[j]; }
    if (has1) {
#pragma unroll
        for (int j = 0; j < 4; ++j) { b[j] = b[j] * q1 * wv[j]; o1[64 * j] = (u32x2){pk2(b[j][0], b[j][1]), pk2(b[j][2], b[j][3])}; }
        if ((r1 & (SEQ - 1)) == SEQ - 1) { f32x4* sh = (f32x4*)(p.out + O_SHIFT_P + (size_t)(r1 / SEQ) * D) + lane;
#pragma unroll
            for (int j = 0; j < 4; ++j) sh[64 * j] = b[j]; }
    }
}
__device__ __forceinline__ void h_rows_segs(const Params& p, int s_lo, int s_hi, int wi, int nw, int lane) {
    const f32x4* lw = (const f32x4*)p.in[7] + lane;
    f32x4 wv[4];
#pragma unroll
    for (int j = 0; j < 4; ++j) wv[j] = lw[64 * j];
    const int n = (s_hi - s_lo) * NBATCH * SEGTOK;
#pragma unroll 1
    for (int x = wi; x < n; x += 2 * nw) {
        const int x1 = x + nw; const bool has1 = x1 < n;
        const int sg = s_lo + x / (NBATCH * SEGTOK), rem = x % (NBATCH * SEGTOK), r = (rem / SEGTOK) * SEQ + sg * SEGTOK + (rem % SEGTOK);
        const int xx = has1 ? x1 : x; const int sg1 = s_lo + xx / (NBATCH * SEGTOK), rem1 = xx % (NBATCH * SEGTOK), r1 = (rem1 / SEGTOK) * SEQ + sg1 * SEGTOK + (rem1 % SEGTOK);
        h_rows_pair(p, r, r1, has1, lane, wv);
    }
}
__device__ __forceinline__ void phase0(const Params& p, unsigned char* smem) {
    const int tid0 = otid(), wave = tid0 >> 6, lane = tid0 & 63;
    const int gw = obid() * 8 + wave, NGW = gridDim.x * 8;
    float* scr = (float*)smem + wave * (64 * 33);
    constexpr int I_IN = 16 * (NP / 32), I_SQ = 16 * 32;
    for (int it = gw; it < I_IN + 3 * I_SQ; it += NGW) {
        int r = it;
        if (r < I_IN) { p0_tr_item<1>(p.in[8], 10384, (bf16_t*)(p.ws + WS_WT_IN), scr, r / (NP / 32), r % (NP / 32), lane); continue; } r -= I_IN;
        if (r < I_SQ) { p0_tr_item<0>(p.in[13], D, (bf16_t*)(p.ws + WS_WT_A), scr, r / 32, r % 32, lane); continue; } r -= I_SQ;
        if (r < I_SQ) { p0_tr_item<0>(p.in[24], D, (bf16_t*)(p.ws + WS_WT_B), scr, r / 32, r % 32, lane); continue; } r -= I_SQ;
        p0_tr_item<0>(p.in[25], D, (bf16_t*)(p.ws + WS_WT_O), scr, r / 32, r % 32, lane);
    }
    h_rows_segs(p, 0, 2, gw, NGW, lane);
    for (int r = XROWS + gw; r < HROWS; r += NGW) p0_row(p, r, lane);
    {
        float* pk = (float*)(p.ws + WS_PK);
        const int gt = obid() * 512 + tid0, NT = gridDim.x * 512;
        for (int i = gt; i < PK_END; i += NT) {
            const float* src; int o;
            if (i < PK_ALOG) { src = p.in[9]; o = i - PK_CONVW; } else if (i < PK_DTB) { src = p.in[10]; o = i - PK_ALOG; } else if (i < PK_NORMW) { src = p.in[11]; o = i - PK_DTB; }
            else if (i < PK_MU) { src = p.in[12]; o = i - PK_NORMW; } else if (i < PK_W0) { src = p.in[14]; o = i - PK_MU; } else if (i < PK_W2) { src = p.in[15]; o = i - PK_W0; }
            else if (i < PK_A0) { src = p.in[16]; o = i - PK_W2; } else if (i < PK_A2) { src = p.in[17]; o = i - PK_A0; } else if (i < PK_KK) { src = p.in[18]; o = i - PK_A2; }
            else if (i < PK_KA) { src = p.in[19]; o = i - PK_KK; } else if (i < PK_RK) { src = p.in[20]; o = i - PK_KA; } else if (i < PK_GNW) { src = p.in[21]; o = i - PK_RK; }
            else if (i < PK_GNB) { src = p.in[22]; o = i - PK_GNW; } else if (i < PK_LNF) { src = p.in[23]; o = i - PK_GNB; } else { src = p.in[26]; o = i - PK_LNF; }
            pk[i] = src[o];
        }
        bf16_t* w2t = (bf16_t*)(p.ws + WS_W2T); bf16_t* a2t = (bf16_t*)(p.ws + WS_A2T);
        for (int i = gt; i < 65536; i += NT) { const int l = i & 63, c = (i >> 6) & 63, hb = i >> 12;
            w2t[i] = (bf16_t)f2bf(p.in[16][(size_t)l * D + hb * 64 + c]); a2t[i] = (bf16_t)f2bf(p.in[18][(size_t)l * D + hb * 64 + c]); }
    }
}

__device__ __forceinline__ void gdn_item(const Params& p, unsigned char* smem, const float* s_in, float* s_out, const float* halo_in, float* halo_out,
                                         int h, int sl, int rowA, int nA, int rowB, int nB) {
    const int tid = otid(), w = tid >> 6, lane = tid & 63, vl = lane >> 4, kg = lane & 15;
    float* qk_s = (float*)smem; float* v_s = qk_s + 16384; float* o_s = v_s + 2048; float* gb_s = o_s + 2048; float* sst = gb_s + 128;
    const bf16_t* P = (const bf16_t*)(p.ws + WS_P);
    float* ORAW = (float*)(p.ws + WS_ORAW);
    float s[8];
    if (s_in) {
        { const int k = tid >> 2, q4 = tid & 3; const f32x4* src = (const f32x4*)(s_in + (size_t)k * 128 + sl * 32 + q4 * 8); const f32x4 a = src[0], b = src[1];
          float* d = sst + k * 33 + q4 * 8; d[0] = a[0]; d[1] = a[1]; d[2] = a[2]; d[3] = a[3]; d[4] = b[0]; d[5] = b[1]; d[6] = b[2]; d[7] = b[3]; }
        __syncthreads();
#pragma unroll
        for (int j = 0; j < 8; ++j) s[j] = sst[(kg * 8 + j) * 33 + 4 * w + vl];
        __syncthreads();
    } else {
#pragma unroll
        for (int j = 0; j < 8; ++j) s[j] = 0.f;
    }
    int pcol = -1;
    if (tid < 128) pcol = h * 128 + tid; else if (tid < 256) pcol = 1024 + h * 128 + (tid - 128); else if (tid < 288) pcol = 2048 + h * 128 + sl * 32 + (tid - 256);
    float cw0 = 0.f, cw1 = 0.f, cw2 = 0.f, cw3 = 0.f, x1 = 0.f, x2 = 0.f, x3 = 0.f;
    const float* pk = (const float*)(p.ws + WS_PK);
    if (pcol >= 0) { const float* cw = pk + PK_CONVW; cw0 = cw[pcol]; cw1 = cw[3072 + pcol]; cw2 = cw[6144 + pcol]; cw3 = cw[9216 + pcol];
        if (halo_in) { x3 = halo_in[pcol]; x2 = halo_in[3072 + pcol]; x1 = halo_in[6144 + pcol]; } }
    const float nalog = -expf(pk[PK_ALOG + h]), dtb = pk[PK_DTB + h];
#pragma unroll 1
    for (int run = 0; run < 2; ++run) {
        const int rrow = run ? rowB : rowA, rn = run ? nB : nA; const bool wout = run != 0;
#pragma unroll 1
        for (int c0 = 0; c0 < rn; c0 += 64) {
            const int nt = (rn - c0) < 64 ? (rn - c0) : 64; const int row = rrow + c0;
            if (pcol >= 0) {
                const bf16_t* src = P + (size_t)row * NPB + pcol;
                float* dst = tid < 256 ? (qk_s + tid) : (v_s + (tid - 256)); const int dstride = tid < 256 ? 256 : 32;
#pragma unroll 8
                for (int i = 0; i < nt; ++i) { const float x0 = bf2f(src[(size_t)i * NPB]); const float y = cw0 * x3 + cw1 * x2 + cw2 * x1 + cw3 * x0; x3 = x2; x2 = x1; x1 = x0; dst[i * dstride] = silu_(y); }
            } else if (tid < 352) {
                const int i = tid - 288;
                if (i < nt) { const float pa = bf2f(P[(size_t)(row + i) * NPB + C_A + h]), pb = bf2f(P[(size_t)(row + i) * NPB + C_B + h]);
                    gb_s[2 * i] = expf(nalog * softplus_(pa + dtb)); gb_s[2 * i + 1] = sigm(pb); }
            }
            __syncthreads();
#pragma unroll 1
            for (int ii = 0; ii < 8; ++ii) { const int i = w * 8 + ii;
                if (i < nt) {
#pragma unroll
                    for (int which = 0; which < 2; ++which) { float* rp = qk_s + i * 256 + which * 128; const float a = rp[lane], b = rp[lane + 64];
                        const float sc = __builtin_amdgcn_rsqf(wave_sum(a * a + b * b) + 1e-6f) * (which == 0 ? 0.08838834764831845f : 1.f); rp[lane] = a * sc; rp[lane + 64] = b * sc; } } }
            __syncthreads();
#pragma unroll 1
            for (int i = 0; i < nt; ++i) {
                const f32x4 q0 = *(const f32x4*)(qk_s + i * 256 + kg * 8), q1 = *(const f32x4*)(qk_s + i * 256 + kg * 8 + 4);
                const f32x4 k0 = *(const f32x4*)(qk_s + i * 256 + 128 + kg * 8), k1 = *(const f32x4*)(qk_s + i * 256 + 128 + kg * 8 + 4);
                const float vv = v_s[i * 32 + 4 * w + vl], a = gb_s[2 * i], be = gb_s[2 * i + 1];
                float part = k0[0] * s[0] + k0[1] * s[1] + k0[2] * s[2] + k0[3] * s[3] + k1[0] * s[4] + k1[1] * s[5] + k1[2] * s[6] + k1[3] * s[7];
                const float kS = rowsum16(part);
                const float c = be * (vv - a * kS);
                s[0] = a * s[0] + k0[0] * c; s[1] = a * s[1] + k0[1] * c; s[2] = a * s[2] + k0[2] * c; s[3] = a * s[3] + k0[3] * c;
                s[4] = a * s[4] + k1[0] * c; s[5] = a * s[5] + k1[1] * c; s[6] = a * s[6] + k1[2] * c; s[7] = a * s[7] + k1[3] * c;
                float op = q0[0] * s[0] + q0[1] * s[1] + q0[2] * s[2] + q0[3] * s[3] + q1[0] * s[4] + q1[1] * s[5] + q1[2] * s[6] + q1[3] * s[7];
                const float o = rowsum16(op);
                if (kg == 0) o_s[i * 32 + 4 * w + vl] = o;
            }
            __syncthreads();
            if (wout) { const int i = tid >> 3, c4 = (tid & 7) * 4; if (i < nt) *(f32x4*)(ORAW + (size_t)(row + i) * D + h * 128 + sl * 32 + c4) = *(const f32x4*)(o_s + i * 32 + c4); }
        }
    }
    if (pcol >= 0 && (sl == 0 || tid >= 256)) { halo_out[pcol] = x3; halo_out[3072 + pcol] = x2; halo_out[6144 + pcol] = x1; }
#pragma unroll
    for (int j = 0; j < 8; ++j) sst[(kg * 8 + j) * 33 + 4 * w + vl] = s[j];
    __syncthreads();
    { const int k = tid >> 2, q4 = tid & 3; const float* d = sst + k * 33 + q4 * 8; f32x4* dst = (f32x4*)(s_out + (size_t)k * 128 + sl * 32 + q4 * 8);
      dst[0] = (f32x4){d[0], d[1], d[2], d[3]}; dst[1] = (f32x4){d[4], d[5], d[6], d[7]}; }
    __syncthreads();
}

constexpr int RW_W2 = 20544, RW_A2 = 24640;
__device__ __forceinline__ void rwkv_load_lora(const Params& p, unsigned char* smem, int hb) {
    float* w2_s = (float*)smem + RW_W2; float* a2_s = (float*)smem + RW_A2; const float* pk = (const float*)(p.ws + WS_PK);
    for (int i = otid(); i < 4096; i += 512) { const int l = i >> 6, c = i & 63; w2_s[i] = pk[PK_W2 + l * D + hb * 64 + c]; a2_s[i] = pk[PK_A2 + l * D + hb * 64 + c]; }
    __syncthreads();
}
__device__ __forceinline__ void rwkv_item(const Params& p, unsigned char* smem, const float* s_in, float* s_out, const bf16_t* prev_row, const float* halo_in, float* halo_out,
                                          int hb, int half, int rowA, int nA, int rowB, int nB) {
    const int tid = otid(), w = tid >> 6, lane = tid & 63, row = tid >> 4, kq = tid & 15;
    float* f = (float*)smem;
    float* r_s = f; float* kb_s = f + 2048; float* v_s = f + 4096; float* wd_s = f + 6144; float* ad_s = f + 8192; float* dec_s = f + 10240; float* a_s = f + 12288;
    float* kk_s = f + 14336; float* km_s = f + 16384; float* zb_s = f + 18432; float* y_s = f + 19456; float* bonus_s = f + 20480;
    const float* w2_s = f + RW_W2; const float* a2_s = f + RW_A2;
    const bf16_t* P = (const bf16_t*)(p.ws + WS_P);
    float* YRAW = (float*)(p.ws + WS_YRAW); bf16_t* C0 = (bf16_t*)(p.ws + WS_C0); bf16_t* C1 = (bf16_t*)(p.ws + WS_C1);
    float s[4];
    if (s_in) { const f32x4 t = *(const f32x4*)(s_in + (size_t)(half * 32 + row) * 64 + kq * 4); s[0] = t[0]; s[1] = t[1]; s[2] = t[2]; s[3] = t[3]; }
    else { s[0] = s[1] = s[2] = s[3] = 0.f; }
    int col = -1; float* dst = nullptr; int dstride = 64; bool is_wd = false, owner = false;
    if (tid < 64) { col = hb * 64 + tid; dst = r_s + tid; owner = half == 0; }
    else if (tid < 128) { col = 1024 + hb * 64 + (tid - 64); dst = kb_s + (tid - 64); owner = half == 0; }
    else if (tid < 192) { col = 2048 + hb * 64 + (tid - 128); dst = v_s + (tid - 128); owner = half == 0; }
    else if (tid < 256) { col = 3072 + (tid - 192); dst = wd_s + (tid - 192); is_wd = true; owner = (half == 0 && hb == 0); }
    else if (tid < 320) { col = 3136 + (tid - 256); dst = ad_s + (tid - 256); owner = (half == 0 && hb == 0); }
    else if (tid < 352) { col = 3200 + hb * 64 + half * 32 + (tid - 320); dst = zb_s + (tid - 320); dstride = 32; owner = true; }
    float mu = 0.f, prev = 0.f;
    const float* pk = (const float*)(p.ws + WS_PK);
    if (col >= 0) { mu = pk[PK_MU + col]; prev = prev_row ? bf2f(prev_row[C_RW + col]) : (halo_in ? halo_in[col] : 0.f); }
    const int cc = tid & 63, ig = tid >> 6;
    const int hc = hb * 64 + cc;
    const float w0c = pk[PK_W0 + hc], a0c = pk[PK_A0 + hc], kkc = pk[PK_KK + hc], kac = pk[PK_KA + hc];
    const float rkl = pk[PK_RK + hb * 64 + lane];
#pragma unroll 1
    for (int run = 0; run < 2; ++run) {
        const int rrow = run ? rowB : rowA, rn = run ? nB : nA; const bool wout = run != 0;
#pragma unroll 1
        for (int c0 = 0; c0 < rn; c0 += 32) {
            const int nt = (rn - c0) < 32 ? (rn - c0) : 32; const int row0 = rrow + c0;
            if (col >= 0) {
                const bf16_t* src = P + (size_t)row0 * NPB + C_RW + col;
#pragma unroll 8
                for (int i = 0; i < nt; ++i) { const float cur = bf2f(src[(size_t)i * NPB]); float m = cur + mu * (prev - cur); prev = cur; if (is_wd) m = tanh_(m); dst[i * dstride] = m; }
            }
            __syncthreads();
            {
                float aw[4] = {0.f, 0.f, 0.f, 0.f}, aa[4] = {0.f, 0.f, 0.f, 0.f};
#pragma unroll 4
                for (int l = 0; l < 64; ++l) { const float w2v = w2_s[l * 64 + cc], a2v = a2_s[l * 64 + cc];
#pragma unroll
                    for (int ii = 0; ii < 4; ++ii) { aw[ii] += wd_s[(ig * 4 + ii) * 64 + l] * w2v; aa[ii] += ad_s[(ig * 4 + ii) * 64 + l] * a2v; } }
#pragma unroll
                for (int ii = 0; ii < 4; ++ii) { const int i = ig * 4 + ii;
                    if (i < nt) { const float wraw = w0c + aw[ii]; const float wlog = -0.6065306597126334f * sigm(wraw); const float a = sigm(a0c + aa[ii]);
                        const float kbv = kb_s[i * 64 + cc];
                        dec_s[i * 64 + cc] = expf(wlog); a_s[i * 64 + cc] = a; kk_s[i * 64 + cc] = kbv * kkc; km_s[i * 64 + cc] = kbv * (1.f + (a - 1.f) * kac); } }
            }
            __syncthreads();
#pragma unroll 1
            for (int ii = 0; ii < 4; ++ii) { const int i = w * 4 + ii;
                if (i < nt) { const float kkr = kk_s[i * 64 + lane]; const float kk = kkr * __builtin_amdgcn_rsqf(wave_sum(kkr * kkr) + 1e-6f); kk_s[i * 64 + lane] = kk;
                    const float a = a_s[i * 64 + lane]; a_s[i * 64 + lane] = kk * a;
                    const float rk = wave_sum(r_s[i * 64 + lane] * km_s[i * 64 + lane] * rkl); if (lane == 0) bonus_s[i] = rk; } }
            __syncthreads();
#pragma unroll 1
            for (int i = 0; i < nt; ++i) {
                const f32x4 kk4 = *(const f32x4*)(kk_s + i * 64 + kq * 4), de4 = *(const f32x4*)(dec_s + i * 64 + kq * 4), ka4 = *(const f32x4*)(a_s + i * 64 + kq * 4),
                            km4 = *(const f32x4*)(km_s + i * 64 + kq * 4), r4 = *(const f32x4*)(r_s + i * 64 + kq * 4);
                const float vv = v_s[i * 64 + half * 32 + row];
                const float sa = rowsum16(s[0] * kk4[0] + s[1] * kk4[1] + s[2] * kk4[2] + s[3] * kk4[3]);
#pragma unroll
                for (int j = 0; j < 4; ++j) s[j] = s[j] * de4[j] + (vv * km4[j] - sa * ka4[j]);
                const float y = rowsum16(s[0] * r4[0] + s[1] * r4[1] + s[2] * r4[2] + s[3] * r4[3]);
                if (kq == 0) y_s[i * 32 + row] = y;
            }
            __syncthreads();
            if (wout) { const int i = tid >> 4;
                if (i < nt) {
#pragma unroll
                    for (int q = 0; q < 2; ++q) { const int rr = (tid & 15) * 2 + q, v = half * 32 + rr, colo = hb * 64 + v;
                        const float sz = silu_(zb_s[i * 32 + rr]);
                        const size_t o = (size_t)(row0 + i) * D + colo;
                        YRAW[o] = y_s[i * 32 + rr]; C1[o] = (bf16_t)f2bf(pk[PK_GNW + colo] * sz); C0[o] = (bf16_t)f2bf((pk[PK_GNB + colo] + bonus_s[i] * v_s[i * 64 + v]) * sz); } } }
            __syncthreads();
        }
    }
    *(f32x4*)(s_out + (size_t)(half * 32 + row) * 64 + kq * 4) = (f32x4){s[0], s[1], s[2], s[3]};
    if (col >= 0 && owner && halo_out) halo_out[col] = prev;
}


__device__ __forceinline__ bf16x8 ldfrag(const bf16_t* base, int stride, int r0, int k0, int lane) {
    return *(const bf16x8*)(base + (r0 + (lane & 15)) * stride + k0 + 8 * (lane >> 4));
}
#define MFMA16(a, b, c) __builtin_amdgcn_mfma_f32_16x16x32_bf16((a), (b), (c), 0, 0, 0)
typedef short s16x4 __attribute__((ext_vector_type(4)));
__device__ __forceinline__ bf16x8 ldfrag_tr(const bf16_t* X, int stride, int c0, int k0, int lane) {
    const int l15 = lane & 15;
    const bf16_t* a = X + (k0 + 8 * (lane >> 4) + (l15 >> 2)) * stride + c0 + 4 * (l15 & 3);
    const s16x4 lo = __builtin_amdgcn_ds_read_tr16_b64_v4i16((LAS s16x4*)a), hi = __builtin_amdgcn_ds_read_tr16_b64_v4i16((LAS s16x4*)(a + 4 * stride));
    return __builtin_shufflevector(lo, hi, 0, 1, 2, 3, 4, 5, 6, 7);
}
__device__ __forceinline__ void inv_block(const float* L, float* Tm, float* XS, int tid) {
    const int w = tid >> 6, lane = tid & 63;
    typedef float f32x2v __attribute__((ext_vector_type(2)));
    if (w < 4 && lane < 16) {
        const float* Lb = L + (16 * w) * 64 + 16 * w; float* Tb = Tm + (16 * w) * 64 + 16 * w;
        float tr[16];
#pragma unroll
        for (int i = 0; i < 16; ++i) tr[i] = 0.f;
#pragma unroll
        for (int i = 0; i < 16; ++i) { float a = (lane == i) ? 1.f : 0.f;
#pragma unroll
            for (int j0 = 0; j0 < i; j0 += 4) { const f32x4 l4 = *(const f32x4*)(Lb + i * 64 + j0);
                a -= l4[0] * tr[j0] + l4[1] * tr[j0 + 1] + l4[2] * tr[j0 + 2] + l4[3] * tr[j0 + 3]; }
            tr[i] = a; Tb[i * 64 + lane] = a; }
    }
    for (int e = tid; e < 1536; e += 512) { const int k = e >> 8, r = (e >> 4) & 15, c = e & 15;
        const int rb = k < 3 ? 0 : (k < 5 ? 1 : 2), cb = k < 3 ? k + 1 : (k < 5 ? k - 1 : 3);
        Tm[(16 * rb + r) * 64 + 16 * cb + c] = 0.f; }
    __syncthreads();
    {
        const int B = tid >> 8, i = (tid >> 4) & 15, c = tid & 15, o = 32 * B;
        float x = 0.f;
#pragma unroll
        for (int j0 = 0; j0 < 16; j0 += 4) { const f32x4 l4 = *(const f32x4*)(L + (o + 16 + i) * 64 + o + j0);
            x += l4[0] * Tm[(o + j0) * 64 + o + c] + l4[1] * Tm[(o + j0 + 1) * 64 + o + c] + l4[2] * Tm[(o + j0 + 2) * 64 + o + c] + l4[3] * Tm[(o + j0 + 3) * 64 + o + c]; }
        XS[tid] = x;
        __syncthreads();
        float t = 0.f;
#pragma unroll
        for (int j0 = 0; j0 < 16; j0 += 4) { const f32x4 t4 = *(const f32x4*)(Tm + (o + 16 + i) * 64 + o + 16 + j0);
            t += t4[0] * XS[(B << 8) + j0 * 16 + c] + t4[1] * XS[(B << 8) + (j0 + 1) * 16 + c] + t4[2] * XS[(B << 8) + (j0 + 2) * 16 + c] + t4[3] * XS[(B << 8) + (j0 + 3) * 16 + c]; }
        Tm[(o + 16 + i) * 64 + o + c] = -t;
    }
    __syncthreads();
    {
        const int i = tid >> 4, c2 = (tid & 15) * 2;
        float x0 = 0.f, x1 = 0.f;
#pragma unroll
        for (int j0 = 0; j0 < 32; j0 += 4) { const f32x4 l4 = *(const f32x4*)(L + (32 + i) * 64 + j0);
#pragma unroll
            for (int e = 0; e < 4; ++e) { const f32x2v tv = *(const f32x2v*)(Tm + (j0 + e) * 64 + c2); x0 += l4[e] * tv[0]; x1 += l4[e] * tv[1]; } }
        *(f32x2v*)(XS + i * 32 + c2) = (f32x2v){x0, x1};
        __syncthreads();
        float t0 = 0.f, t1 = 0.f;
#pragma unroll
        for (int j0 = 0; j0 < 32; j0 += 4) { const f32x4 t4 = *(const f32x4*)(Tm + (32 + i) * 64 + 32 + j0);
#pragma unroll
            for (int e = 0; e < 4; ++e) { const f32x2v xv = *(const f32x2v*)(XS + (j0 + e) * 32 + c2); t0 += t4[e] * xv[0]; t1 += t4[e] * xv[1]; } }
        *(f32x2v*)(Tm + (32 + i) * 64 + c2) = (f32x2v){-t0, -t1};
    }
    __syncthreads();
}
constexpr int PL_QS = 0, PL_R1 = 17408, PL_KT = 35840, PL_KTT = 54272, PL_VT = 72704, PL_R3 = 91136, PL_QKM = 109568, PL_TP = 118784, PL_TPP = 128000, PL_SM = 137216, PL_TM = 139264, PL_XS = 155648;
constexpr int QSTR = 136, TSTR = 72;

__device__ __forceinline__ void gdn_prep_item(const Params& p, unsigned char* smem, int h, int row_start, int npad, const bf16_t* hbase,
                                              bf16_t* halo_out, float* conv_out, unsigned char* rec) {
    const int tid = otid(), w = tid >> 6, lane = tid & 63, q4 = lane >> 4, l15 = lane & 15;
    bf16_t* qs = (bf16_t*)(smem + PL_QS); bf16_t* ks = (bf16_t*)(smem + PL_R1); bf16_t* WT = (bf16_t*)(smem + PL_KTT);     bf16_t* kts = (bf16_t*)(smem + PL_KT);
    bf16_t* vs = (bf16_t*)(smem + PL_VT);         float* Lm = (float*)(smem + PL_R3); bf16_t* UT = (bf16_t*)(smem + PL_R3); bf16_t* QKm = (bf16_t*)(smem + PL_QKM);
    bf16_t* Tp = (bf16_t*)(smem + PL_TP); bf16_t* Tpp = (bf16_t*)(smem + PL_TPP);
    float* sm = (float*)(smem + PL_SM);
    float* gcs = sm; float* bes = sm + 64; float* ssq = sm + 128; float* ssk = sm + 192; float* egs = sm + 256; float* egl_s = sm + 320; float* beg = sm + 384;
    const bf16_t* P = (const bf16_t*)(p.ws + WS_P);
    const float* pk = (const float*)(p.ws + WS_PK);
    if (w == 7) {
        const int i = lane;
        float g = 0.f, be = 0.f;
        if (i >= npad) { const size_t r = (size_t)(row_start + i - npad) * NPB; const float pa = bf2f(P[r + C_A + h]), pb = bf2f(P[r + C_B + h]);
            g = -expf(pk[PK_ALOG + h]) * softplus_(pa + pk[PK_DTB + h]); be = sigm(pb); }
        float x = g;
#pragma unroll
        for (int o = 1; o < 64; o <<= 1) { const float y = __shfl_up(x, o); if (lane >= o) x += y; }
        const float gl = __shfl(x, 63);
        gcs[lane] = x; bes[lane] = be; egs[lane] = __expf(x); egl_s[lane] = __expf(gl - x); beg[lane] = be * __expf(x);
        if (lane == 0) *(float*)(rec + GP_EGL) = __expf(gl);
    }
    __syncthreads();
    if (npad == 0 && tid >= 384) {
#pragma unroll 1
        for (int k = 0; k < 4; ++k) {
            const int slot = (tid - 384) + 128 * k, t = slot >> 3, g = slot & 7;
            const bf16_t* zp = P + (size_t)(row_start + t) * NPB + C_Z + h * 128 + 16 * g;
            const u32x4 z0 = *(const u32x4*)zp, z1 = *(const u32x4*)(zp + 8);
            float za[8], zb[8]; unpack8(z0, za); unpack8(z1, zb);
            const float* nwp = pk + PK_NORMW + 16 * g;
            float ga[8], gb2[8];
#pragma unroll
            for (int e = 0; e < 8; ++e) { ga[e] = nwp[e] * silu_(za[e]); gb2[e] = nwp[8 + e] * silu_(zb[e]); }
            bf16_t* gp = (bf16_t*)(rec + GP_G) + t * 128 + 16 * g;
            *(u32x4*)gp = pack8(ga); *(u32x4*)(gp + 8) = pack8(gb2);
        }
    }
    if (tid < 384) {
        const int sec = tid >> 7, ts = (tid >> 4) & 7, t0 = 8 * ts, d0 = l15 * 8;
        const int pcol = sec * 1024 + h * 128 + d0;
        float cw[4][8];
#pragma unroll
        for (int j = 0; j < 4; ++j) { const f32x4 a = *(const f32x4*)(pk + PK_CONVW + j * 3072 + pcol), b = *(const f32x4*)(pk + PK_CONVW + j * 3072 + pcol + 4);
            cw[j][0] = a[0]; cw[j][1] = a[1]; cw[j][2] = a[2]; cw[j][3] = a[3]; cw[j][4] = b[0]; cw[j][5] = b[1]; cw[j][6] = b[2]; cw[j][7] = b[3]; }
        u32x4 rw[11]; float fv[11];
#pragma unroll
        for (int k = 0; k < 11; ++k) {
            const int ii = t0 - 3 + k;
            const bf16_t* ptr = P + pcol; float f = 0.f;
            if (ii >= npad) { ptr = P + (size_t)(row_start + ii - npad) * NPB + pcol; f = 1.f; }
            else if (ii < 0 && npad == 0 && hbase) { ptr = hbase + (size_t)(ii + 3) * NPB + pcol; f = 1.f; }
            rw[k] = *(const u32x4*)ptr; fv[k] = f;
        }
        if (halo_out && ts == 7) {
#pragma unroll
            for (int dd = 0; dd < 3; ++dd) { *(u32x4*)(halo_out + (size_t)dd * NPB + pcol) = rw[8 + dd];
                if (conv_out) { float x[8]; unpack8(rw[8 + dd], x); *(f32x4*)(conv_out + dd * 3072 + pcol) = (f32x4){x[0], x[1], x[2], x[3]}; *(f32x4*)(conv_out + dd * 3072 + pcol + 4) = (f32x4){x[4], x[5], x[6], x[7]}; } }
        }
        float y[8][8];
#pragma unroll
        for (int t = 0; t < 8; ++t)
#pragma unroll
            for (int e = 0; e < 8; ++e) y[t][e] = 0.f;
#pragma unroll
        for (int k = 0; k < 11; ++k) { float x[8]; unpack8(rw[k], x);
#pragma unroll
            for (int e = 0; e < 8; ++e) x[e] *= fv[k];
#pragma unroll
            for (int dlt = 0; dlt < 4; ++dlt) { const int t = k - dlt;
                if (t >= 0 && t < 8) {
#pragma unroll
                    for (int e = 0; e < 8; ++e) y[t][e] += cw[dlt][e] * x[e]; } }
        }
        const float qsc = sec == 0 ? 0.08838834764831845f : 1.f;
#pragma unroll
        for (int t = 0; t < 8; ++t) {
            const bool tokv = (t0 + t) >= npad;
            float ss = 0.f;
#pragma unroll
            for (int e = 0; e < 8; ++e) { y[t][e] = tokv ? silu_(y[t][e]) : 0.f; ss += y[t][e] * y[t][e]; }
            if (sec < 2) { const float sc = __builtin_amdgcn_rsqf(rowsum16(ss) + 1e-6f) * qsc;
#pragma unroll
                for (int e = 0; e < 8; ++e) y[t][e] *= sc; }
        }
        { bf16_t* dst = sec == 0 ? qs : (sec == 1 ? ks : vs);
#pragma unroll
            for (int t = 0; t < 8; ++t) *(u32x4*)(dst + (t0 + t) * QSTR + d0) = pack8(y[t]); }
        if (sec == 1) {
#pragma unroll
            for (int t = 0; t < 8; ++t) { const float eg = egl_s[t0 + t]; float z[8];
#pragma unroll
                for (int e = 0; e < 8; ++e) z[e] = y[t][e] * eg;
                *(u32x4*)(kts + (t0 + t) * QSTR + d0) = pack8(z); } }
    }
    __syncthreads();
    {
        const int which = w >> 2, it = w & 3;
        const bf16_t* Barr = which ? qs : ks;
        bf16x8 bfr[4];
#pragma unroll
        for (int kk = 0; kk < 4; ++kk) bfr[kk] = ldfrag(Barr, QSTR, 16 * it, 32 * kk, lane);
        const int i = 16 * it + l15; const float gi = gcs[i], bi = bes[i];
#pragma unroll
        for (int jt = 0; jt < 4; ++jt) {
            f32x4 acc = {0.f, 0.f, 0.f, 0.f};
#pragma unroll
            for (int kk = 0; kk < 4; ++kk) acc = MFMA16(ldfrag(ks, QSTR, 16 * jt, 32 * kk, lane), bfr[kk], acc);
            const int j0 = 16 * jt + 4 * q4; const f32x4 gj = *(const f32x4*)(gcs + j0);
            f32x4 o;
#pragma unroll
            for (int r = 0; r < 4; ++r) { const int j = j0 + r; const bool keep = which ? (i >= j) : (i > j); o[r] = keep ? acc[r] * __expf(gi - gj[r]) : 0.f; }
            if (which == 0) *(f32x4*)(Lm + i * 64 + j0) = o * bi;
            else *(u32x2*)(QKm + i * TSTR + j0) = (u32x2){pk2(o[0], o[1]), pk2(o[2], o[3])};
        }
    }
    __syncthreads();
    {
        float* Tm = (float*)(smem + PL_TM);
        inv_block(Lm, Tm, (float*)(smem + PL_XS), tid);
        const int i = tid >> 3, j0 = (tid & 7) * 8;
        float a[8], b2[8];
#pragma unroll
        for (int e = 0; e < 8; ++e) { const float tv = Tm[i * 64 + j0 + e]; a[e] = tv * beg[j0 + e]; b2[e] = tv * bes[j0 + e]; }
        *(u32x4*)(Tp + i * TSTR + j0) = (u32x4){pk2(a[0], a[1]), pk2(a[2], a[3]), pk2(a[4], a[5]), pk2(a[6], a[7])};
        *(u32x4*)(Tpp + i * TSTR + j0) = (u32x4){pk2(b2[0], b2[1]), pk2(b2[2], b2[3]), pk2(b2[4], b2[5]), pk2(b2[6], b2[7])};
    }
    __syncthreads();
    {
        const int it = w & 3, half = w >> 2;
        f32x4 aw[4], au[4];
#pragma unroll
        for (int x = 0; x < 4; ++x) { aw[x] = (f32x4){0.f, 0.f, 0.f, 0.f}; au[x] = (f32x4){0.f, 0.f, 0.f, 0.f}; }
#pragma unroll
        for (int kk = 0; kk < 2; ++kk) {
            const bf16x8 a1 = ldfrag(Tp, TSTR, 16 * it, 32 * kk, lane), a2 = ldfrag(Tpp, TSTR, 16 * it, 32 * kk, lane);
#pragma unroll
            for (int x = 0; x < 4; ++x) { const int dt = half * 4 + x;
                aw[x] = MFMA16(a1, ldfrag_tr(ks, QSTR, 16 * dt, 32 * kk, lane), aw[x]);
                au[x] = MFMA16(a2, ldfrag_tr(vs, QSTR, 16 * dt, 32 * kk, lane), au[x]); }
        }
#pragma unroll
        for (int x = 0; x < 4; ++x) { const int d = 16 * (half * 4 + x) + l15, i0 = 16 * it + 4 * q4;
            *(u32x2*)(WT + d * TSTR + i0) = (u32x2){pk2(aw[x][0], aw[x][1]), pk2(aw[x][2], aw[x][3])};
            *(u32x2*)(UT + d * TSTR + i0) = (u32x2){pk2(au[x][0], au[x][1]), pk2(au[x][2], au[x][3])}; }
    }
    __syncthreads();
    {
        bf16_t* gAP = (bf16_t*)(rec + GP_AP); bf16_t* gQH = (bf16_t*)(rec + GP_QH); bf16_t* gKH = (bf16_t*)(rec + GP_KH); bf16_t* gOH = (bf16_t*)(rec + GP_OH);
        {
            const int et = w;
            const bf16x8 a0 = ldfrag(WT, TSTR, 16 * et, 0, lane), a1 = ldfrag(WT, TSTR, 16 * et, 32, lane);
#pragma unroll
            for (int dt = 0; dt < 8; ++dt) { f32x4 acc = {0.f, 0.f, 0.f, 0.f};
                acc = MFMA16(a0, ldfrag_tr(kts, QSTR, 16 * dt, 0, lane), acc); acc = MFMA16(a1, ldfrag_tr(kts, QSTR, 16 * dt, 32, lane), acc);
                *(u32x2*)(gAP + ((size_t)(dt * 4 + (et >> 1)) * 64 + lane) * 8 + (et & 1) * 4) = (u32x2){pk2(-acc[0], -acc[1]), pk2(-acc[2], -acc[3])}; }
#pragma unroll
            for (int tt = 0; tt < 4; ++tt) { f32x4 acc = {0.f, 0.f, 0.f, 0.f};
                acc = MFMA16(a0, ldfrag(QKm, TSTR, 16 * tt, 0, lane), acc); acc = MFMA16(a1, ldfrag(QKm, TSTR, 16 * tt, 32, lane), acc);
                const int t = 16 * tt + l15, e0 = 16 * et + 4 * q4; const float eg = egs[t];
                const u32x2 qq = *(const u32x2*)(qs + t * QSTR + e0);
                const float o0 = __uint_as_float(qq.x << 16) * eg - acc[0], o1 = __uint_as_float(qq.x & 0xffff0000u) * eg - acc[1],
                            o2 = __uint_as_float(qq.y << 16) * eg - acc[2], o3 = __uint_as_float(qq.y & 0xffff0000u) * eg - acc[3];
                *(u32x2*)(gQH + ((size_t)(tt * 4 + (et >> 1)) * 64 + lane) * 8 + (et & 1) * 4) = (u32x2){pk2(o0, o1), pk2(o2, o3)}; }
        }
        {
            const int dt = w;
            const bf16x8 a0 = ldfrag_tr(kts, QSTR, 16 * dt, 0, lane), a1 = ldfrag_tr(kts, QSTR, 16 * dt, 32, lane);
#pragma unroll
            for (int vt = 0; vt < 8; ++vt) { f32x4 acc = {0.f, 0.f, 0.f, 0.f};
                acc = MFMA16(a0, ldfrag(UT, TSTR, 16 * vt, 0, lane), acc); acc = MFMA16(a1, ldfrag(UT, TSTR, 16 * vt, 32, lane), acc);
                *(u32x2*)(gKH + ((size_t)(vt * 8 + dt) * 64 + lane) * 4) = (u32x2){pk2(acc[0], acc[1]), pk2(acc[2], acc[3])}; }
            const int tt = w & 3, vh = w >> 2;
            const bf16x8 b0 = ldfrag(QKm, TSTR, 16 * tt, 0, lane), b1 = ldfrag(QKm, TSTR, 16 * tt, 32, lane);
#pragma unroll
            for (int x = 0; x < 4; ++x) { const int vt = vh * 4 + x; f32x4 acc = {0.f, 0.f, 0.f, 0.f};
                acc = MFMA16(b0, ldfrag(UT, TSTR, 16 * vt, 0, lane), acc); acc = MFMA16(b1, ldfrag(UT, TSTR, 16 * vt, 32, lane), acc);
                *(u32x2*)(gOH + ((size_t)(vt * 4 + tt) * 64 + lane) * 4) = (u32x2){pk2(acc[0], acc[1]), pk2(acc[2], acc[3])}; }
        }
    }
    __syncthreads();
}

__device__ __forceinline__ void phase_gprep(const Params& p, int seg, unsigned char* smem) {
    const int blk = obid();
    const int n_items = (CPS + (seg == 0 ? 1 : 0)) * 64;
#pragma unroll 1
    for (int it = blk; it < n_items; it += gridDim.x) {
        const int bh = it & 63, b = bh >> 3, h = bh & 7; int cl = it >> 6; if (seg != 0) cl += 1;
        unsigned char* rec = p.ws + WS_GP + (size_t)(cl * 64 + bh) * GP_STRIDE;
        const bf16_t* Pb = (const bf16_t*)(p.ws + WS_P);
        bf16_t* chalo2 = (bf16_t*)(p.ws + WS_CHALO);
        if (cl == 0) gdn_prep_item(p, smem, h, LEX0, 48, nullptr, nullptr, nullptr, rec);
        else {
            const int row = b * SEGTOK + (cl - 1) * 64;
            const bf16_t* hbase = Pb + (size_t)(row - 3) * NPB;
            if (cl == 1) hbase = (seg == 0) ? Pb + (size_t)(LEX0 + NMETA - 3) * NPB : chalo2 + (size_t)(((seg - 1) & 1) * NBATCH + b) * 3 * NPB;
            bf16_t* ho = (cl == CPS) ? chalo2 + (size_t)((seg & 1) * NBATCH + b) * 3 * NPB : nullptr;
            float* co = (cl == CPS && seg == NSEG - 1) ? p.out + O_CONV_P + (size_t)b * 9216 : nullptr;
            gdn_prep_item(p, smem, h, row, 0, hbase, ho, co, rec);
        }
    }
}

__device__ __forceinline__ void gdn_scan_block(const Params& p, int seg, unsigned char* smem, int bh) {
    const int tid = otid(), w = tid >> 6, lane = tid & 63, q4 = lane >> 4, l15 = lane & 15;
    const int b = bh >> 3, h = bh & 7;
    float* st = p.out + O_GDN_P + (size_t)bh * 16384;
    f32x4 S[8];
    if (seg) {
#pragma unroll
        for (int mt = 0; mt < 8; ++mt)
#pragma unroll
            for (int r = 0; r < 4; ++r) S[mt][r] = st[(size_t)(16 * mt + 4 * q4 + r) * 128 + 16 * w + l15];
    } else {
#pragma unroll
        for (int mt = 0; mt < 8; ++mt) S[mt] = (f32x4){0.f, 0.f, 0.f, 0.f};
    }
    const int c_lo = seg ? 1 : 0;
    float* obuf = (float*)(smem + 98304);
    {
        const u32x4* src = (const u32x4*)(p.ws + WS_GP + (size_t)(c_lo * 64 + bh) * GP_STRIDE); u32x4* dst = (u32x4*)smem;
#pragma unroll
        for (int x = 0; x < 6; ++x) dst[tid + 512 * x] = src[tid + 512 * x];
    }
#pragma unroll 1
    for (int cl = c_lo; cl <= CPS; ++cl) {
        const unsigned char* rec = p.ws + WS_GP + (size_t)(cl * 64 + bh) * GP_STRIDE;
        const int cur = (cl - c_lo) & 1;
        __syncthreads();
        u32x4 nx[6];
        const bool more = cl < CPS;
        if (more) { const u32x4* src = (const u32x4*)(rec + GP_STRIDE * 64);
#pragma unroll
            for (int x = 0; x < 6; ++x) nx[x] = src[tid + 512 * x]; }
        const bf16_t* gKH = (const bf16_t*)(rec + GP_KH); const bf16_t* gOH = (const bf16_t*)(rec + GP_OH);
        u32x2 kh[8], oh[4];
#pragma unroll
        for (int mt = 0; mt < 8; ++mt) kh[mt] = *(const u32x2*)(gKH + ((size_t)(w * 8 + mt) * 64 + lane) * 4);
#pragma unroll
        for (int tt = 0; tt < 4; ++tt) oh[tt] = *(const u32x2*)(gOH + ((size_t)(w * 4 + tt) * 64 + lane) * 4);
        const float egl = *(const float*)(rec + GP_EGL);
        const int et = tid >> 3, eg = tid & 7;
        const bf16_t* gp = (const bf16_t*)(rec + GP_G) + et * 128 + 16 * eg;
        u32x4 z0 = {0u, 0u, 0u, 0u}, z1 = {0u, 0u, 0u, 0u};
        if (cl > 0) { z0 = *(const u32x4*)gp; z1 = *(const u32x4*)(gp + 8); }
        bf16x8 Bf[4];
#pragma unroll
        for (int ks = 0; ks < 4; ++ks) { u32x4 t; t.x = pk2(S[2 * ks][0], S[2 * ks][1]); t.y = pk2(S[2 * ks][2], S[2 * ks][3]); t.z = pk2(S[2 * ks + 1][0], S[2 * ks + 1][1]); t.w = pk2(S[2 * ks + 1][2], S[2 * ks + 1][3]);
            Bf[ks] = __builtin_bit_cast(bf16x8, t); }
        const bf16x8* AP = (const bf16x8*)(smem + cur * 49152); const bf16x8* QH = (const bf16x8*)(smem + cur * 49152 + GP_QH);
        f32x4 o[4], tS[8];
#pragma unroll
        for (int tt = 0; tt < 4; ++tt) { o[tt] = (f32x4){0.f, 0.f, 0.f, 0.f};
#pragma unroll
            for (int ks = 0; ks < 4; ++ks) o[tt] = MFMA16(QH[(tt * 4 + ks) * 64 + lane], Bf[ks], o[tt]); }
#pragma unroll
        for (int mt = 0; mt < 8; ++mt) { tS[mt] = (f32x4){0.f, 0.f, 0.f, 0.f};
#pragma unroll
            for (int ks = 0; ks < 4; ++ks) tS[mt] = MFMA16(AP[(mt * 4 + ks) * 64 + lane], Bf[ks], tS[mt]); }
#pragma unroll
        for (int mt = 0; mt < 8; ++mt) {
            S[mt][0] = egl * S[mt][0] + tS[mt][0] + __uint_as_float(kh[mt].x << 16); S[mt][1] = egl * S[mt][1] + tS[mt][1] + __uint_as_float(kh[mt].x & 0xffff0000u);
            S[mt][2] = egl * S[mt][2] + tS[mt][2] + __uint_as_float(kh[mt].y << 16); S[mt][3] = egl * S[mt][3] + tS[mt][3] + __uint_as_float(kh[mt].y & 0xffff0000u); }
        if (cl > 0) {
#pragma unroll
            for (int tt = 0; tt < 4; ++tt) {
                o[tt][0] += __uint_as_float(oh[tt].x << 16); o[tt][1] += __uint_as_float(oh[tt].x & 0xffff0000u); o[tt][2] += __uint_as_float(oh[tt].y << 16); o[tt][3] += __uint_as_float(oh[tt].y & 0xffff0000u);
#pragma unroll
                for (int r = 0; r < 4; ++r) obuf[(16 * tt + 4 * q4 + r) * 132 + 16 * w + l15] = o[tt][r]; }
        }
        if (more) { u32x4* dst = (u32x4*)(smem + (cur ^ 1) * 49152);
#pragma unroll
            for (int x = 0; x < 6; ++x) dst[tid + 512 * x] = nx[x]; }
        if (cl > 0) {
            __syncthreads();
            f32x4 ov[4]; float ss = 0.f;
#pragma unroll
            for (int j = 0; j < 4; ++j) { ov[j] = *(const f32x4*)(obuf + et * 132 + 16 * eg + 4 * j); ss += ov[j][0] * ov[j][0] + ov[j][1] * ov[j][1] + ov[j][2] * ov[j][2] + ov[j][3] * ov[j][3]; }
            ss += __shfl_xor(ss, 1); ss += __shfl_xor(ss, 2); ss += __shfl_xor(ss, 4);
            const float rs = __builtin_amdgcn_rsqf(ss * (1.f / 128.f) + 1e-6f);
            const unsigned zz[8] = {z0.x, z0.y, z0.z, z0.w, z1.x, z1.y, z1.z, z1.w};
            unsigned ow[8];
#pragma unroll
            for (int j = 0; j < 8; ++j) ow[j] = pk2(ov[j >> 1][(j & 1) * 2] * rs * __uint_as_float(zz[j] << 16), ov[j >> 1][(j & 1) * 2 + 1] * rs * __uint_as_float(zz[j] & 0xffff0000u));
            const size_t grow = (size_t)b * SEQ + seg * SEGTOK + (cl - 1) * 64 + et;
            bf16_t* oa = (bf16_t*)(p.ws + WS_H) + grow * D + h * 128 + 16 * eg;
            *(u32x4*)oa = (u32x4){ow[0], ow[1], ow[2], ow[3]}; *(u32x4*)(oa + 8) = (u32x4){ow[4], ow[5], ow[6], ow[7]};
        }
    }
#pragma unroll
    for (int mt = 0; mt < 8; ++mt)
#pragma unroll
        for (int r = 0; r < 4; ++r) st[(size_t)(16 * mt + 4 * q4 + r) * 128 + 16 * w + l15] = S[mt][r];
    __syncthreads();
}

constexpr int RL_AT = 0, RL_BT = 9216, RL_KT = 18432, RL_ATT = 27648, RL_RT = 36864, RL_BTLT = 46080, RL_KTLT = 55296, RL_VT = 64512, RL_LAK = 73728, RL_MRB = 82944, RL_MRK = 92160,
              RL_LM = 101376, RL_AF = 117760, RL_TM = 134144, RL_XS = 150528;
__device__ __forceinline__ void rwkv_prep_item(const Params& p, unsigned char* smem, int hb, int row_start, int npad, const bf16_t* prev_row,
                                               bf16_t* halo_out, unsigned char* rec) {
    const int tid = otid(), w = tid >> 6, lane = tid & 63, q4 = lane >> 4, l15 = lane & 15;
    bf16_t* At = (bf16_t*)(smem + RL_AT); bf16_t* Tb = At; bf16_t* Bt = (bf16_t*)(smem + RL_BT); bf16_t* WaT = Bt; bf16_t* Kt = (bf16_t*)(smem + RL_KT); bf16_t* XT = Kt;
    bf16_t* At2 = (bf16_t*)(smem + RL_ATT); bf16_t* Rt = (bf16_t*)(smem + RL_RT); bf16_t* Btl = (bf16_t*)(smem + RL_BTLT); bf16_t* Ktl = (bf16_t*)(smem + RL_KTLT);
    bf16_t* Vr = (bf16_t*)(smem + RL_VT);        bf16_t* Lak = (bf16_t*)(smem + RL_LAK); bf16_t* Mrb = (bf16_t*)(smem + RL_MRB); bf16_t* Mrk = (bf16_t*)(smem + RL_MRK);
    float* Lm = (float*)(smem + RL_LM);
    bf16_t* thw = Lak; bf16_t* adb = Mrb; float* lc = Lm; float* af = (float*)(smem + RL_AF);
    const bf16_t* P = (const bf16_t*)(p.ws + WS_P);
    const float* pk = (const float*)(p.ws + WS_PK);
    const int t = tid >> 3, g = tid & 7;
    float rr[8], kb[8], vv[8], zb[8];
    {
        const bool real = t >= npad;
        const bf16_t* curp = P; const bf16_t* prevp = P; float fprev = 0.f;
        if (real) { curp = P + (size_t)(row_start + t - npad) * NPB; if (t > npad) { prevp = curp - NPB; fprev = 1.f; } else if (prev_row) { prevp = prev_row; fprev = 1.f; } }
        const int secbase[6] = {0, 1024, 2048, 3200, 3072, 3136};
        u32x4 rc[6], rp[6];
#pragma unroll
        for (int sidx = 0; sidx < 6; ++sidx) { const int col = secbase[sidx] + (sidx < 4 ? hb * 64 : 0) + g * 8; rc[sidx] = *(const u32x4*)(curp + C_RW + col); rp[sidx] = *(const u32x4*)(prevp + C_RW + col); }
        float m[6][8];
#pragma unroll
        for (int sidx = 0; sidx < 6; ++sidx) {
            const int col = secbase[sidx] + (sidx < 4 ? hb * 64 : 0) + g * 8;
            float cur[8], prv[8];
            unpack8(rc[sidx], cur); unpack8(rp[sidx], prv);
            const f32x4 mu0 = *(const f32x4*)(pk + PK_MU + col), mu1 = *(const f32x4*)(pk + PK_MU + col + 4);
            const float mu[8] = {mu0[0], mu0[1], mu0[2], mu0[3], mu1[0], mu1[1], mu1[2], mu1[3]};
#pragma unroll
            for (int e = 0; e < 8; ++e) m[sidx][e] = real ? cur[e] + mu[e] * (fprev * prv[e] - cur[e]) : 0.f;
            if (halo_out && t == 63 && (sidx < 4 || hb == 0)) *(u32x4*)(halo_out + C_RW + col) = rc[sidx];
        }
#pragma unroll
        for (int e = 0; e < 8; ++e) { rr[e] = m[0][e]; kb[e] = m[1][e]; vv[e] = m[2][e]; zb[e] = m[3][e]; }
        float th[8];
#pragma unroll
        for (int e = 0; e < 8; ++e) th[e] = tanh_(m[4][e]);
        *(u32x4*)(thw + t * TSTR + g * 8) = pack8(th);
        *(u32x4*)(adb + t * TSTR + g * 8) = pack8(m[5]);
    }
    __syncthreads();
    {
        const int which = w >> 2, ct = w & 3;
        const bf16_t* Wt = (const bf16_t*)(p.ws + (which ? WS_A2T : WS_W2T)) + (size_t)hb * 4096;
        const bf16x8 b0 = *(const bf16x8*)(Wt + (16 * ct + l15) * 64 + 8 * q4), b1 = *(const bf16x8*)(Wt + (16 * ct + l15) * 64 + 32 + 8 * q4);
        const bf16_t* Aarr = which ? adb : thw;
        const int c = 16 * ct + l15;
        const float bias = pk[(which ? PK_A0 : PK_W0) + hb * 64 + c];
        float carry = 0.f;
#pragma unroll
        for (int tt = 0; tt < 4; ++tt) {
            f32x4 acc = {0.f, 0.f, 0.f, 0.f};
            acc = MFMA16(ldfrag(Aarr, TSTR, 16 * tt, 0, lane), b0, acc); acc = MFMA16(ldfrag(Aarr, TSTR, 16 * tt, 32, lane), b1, acc);
            if (which) {
#pragma unroll
                for (int r = 0; r < 4; ++r) af[(16 * tt + 4 * q4 + r) * 64 + c] = sigm(bias + acc[r]);
            } else {
                float wl[4];
#pragma unroll
                for (int r = 0; r < 4; ++r) { const int tk = 16 * tt + 4 * q4 + r; wl[r] = (tk < npad) ? 0.f : -0.6065306597126334f * sigm(bias + acc[r]); }
                wl[1] += wl[0]; wl[2] += wl[1]; wl[3] += wl[2];
                const float Q = wl[3];
                const float Q0 = __shfl(Q, l15), Q1 = __shfl(Q, l15 + 16), Q2 = __shfl(Q, l15 + 32), Q3 = __shfl(Q, l15 + 48);
                const float ex = carry + (q4 > 0 ? Q0 : 0.f) + (q4 > 1 ? Q1 : 0.f) + (q4 > 2 ? Q2 : 0.f);
#pragma unroll
                for (int r = 0; r < 4; ++r) lc[(16 * tt + 4 * q4 + r) * 64 + c] = ex + wl[r];
                carry += Q0 + Q1 + Q2 + Q3;
            }
        }
    }
    __syncthreads();
    {
        float lct[8], lcp[8], lcC[8], av[8];
        { const f32x4 a = *(const f32x4*)(lc + t * 64 + g * 8), b2 = *(const f32x4*)(lc + t * 64 + g * 8 + 4); lct[0] = a[0]; lct[1] = a[1]; lct[2] = a[2]; lct[3] = a[3]; lct[4] = b2[0]; lct[5] = b2[1]; lct[6] = b2[2]; lct[7] = b2[3]; }
        if (t > 0) { const f32x4 a = *(const f32x4*)(lc + (t - 1) * 64 + g * 8), b2 = *(const f32x4*)(lc + (t - 1) * 64 + g * 8 + 4); lcp[0] = a[0]; lcp[1] = a[1]; lcp[2] = a[2]; lcp[3] = a[3]; lcp[4] = b2[0]; lcp[5] = b2[1]; lcp[6] = b2[2]; lcp[7] = b2[3]; }
        else {
#pragma unroll
            for (int e = 0; e < 8; ++e) lcp[e] = 0.f; }
        { const f32x4 a = *(const f32x4*)(lc + 63 * 64 + g * 8), b2 = *(const f32x4*)(lc + 63 * 64 + g * 8 + 4); lcC[0] = a[0]; lcC[1] = a[1]; lcC[2] = a[2]; lcC[3] = a[3]; lcC[4] = b2[0]; lcC[5] = b2[1]; lcC[6] = b2[2]; lcC[7] = b2[3]; }
        { const f32x4 a = *(const f32x4*)(af + t * 64 + g * 8), b2 = *(const f32x4*)(af + t * 64 + g * 8 + 4); av[0] = a[0]; av[1] = a[1]; av[2] = a[2]; av[3] = a[3]; av[4] = b2[0]; av[5] = b2[1]; av[6] = b2[2]; av[7] = b2[3]; }
        const int hc = hb * 64 + g * 8;
        float kk[8], km[8], ss = 0.f, rk = 0.f;
        float pkk[8], pka[8], prk[8];
        { const f32x4 a0 = *(const f32x4*)(pk + PK_KK + hc), a1 = *(const f32x4*)(pk + PK_KK + hc + 4), b0 = *(const f32x4*)(pk + PK_KA + hc), b1 = *(const f32x4*)(pk + PK_KA + hc + 4), c0v = *(const f32x4*)(pk + PK_RK + hc), c1v = *(const f32x4*)(pk + PK_RK + hc + 4);
#pragma unroll
          for (int e = 0; e < 4; ++e) { pkk[e] = a0[e]; pkk[4 + e] = a1[e]; pka[e] = b0[e]; pka[4 + e] = b1[e]; prk[e] = c0v[e]; prk[4 + e] = c1v[e]; } }
#pragma unroll
        for (int e = 0; e < 8; ++e) { kk[e] = kb[e] * pkk[e]; ss += kk[e] * kk[e]; km[e] = kb[e] * (1.f + (av[e] - 1.f) * pka[e]); rk += rr[e] * km[e] * prk[e]; }
        ss += __shfl_xor(ss, 1); ss += __shfl_xor(ss, 2); ss += __shfl_xor(ss, 4);
        rk += __shfl_xor(rk, 1); rk += __shfl_xor(rk, 2); rk += __shfl_xor(rk, 4);
        const float kn = __builtin_amdgcn_rsqf(ss + 1e-6f);
        float xa[8], xb[8], xk[8], xr[8], xbt[8], xkt[8];
#pragma unroll
        for (int e = 0; e < 8; ++e) { kk[e] *= kn; const float ka = kk[e] * av[e]; const float ip = __expf(-lct[e]), tl = __expf(lcC[e] - lct[e]);
            xa[e] = kk[e] * __expf(lcp[e]); xb[e] = ka * ip; xk[e] = km[e] * ip; xr[e] = rr[e] * __expf(lct[e]); xbt[e] = ka * tl; xkt[e] = km[e] * tl; }
        *(u32x4*)(At + t * TSTR + g * 8) = pack8(xa); *(u32x4*)(Bt + t * TSTR + g * 8) = pack8(xb); *(u32x4*)(Kt + t * TSTR + g * 8) = pack8(xk); *(u32x4*)(Rt + t * TSTR + g * 8) = pack8(xr);
        *(u32x4*)(At2 + t * TSTR + g * 8) = pack8(xa); *(u32x4*)(Btl + t * TSTR + g * 8) = pack8(xbt); *(u32x4*)(Ktl + t * TSTR + g * 8) = pack8(xkt); *(u32x4*)(Vr + t * TSTR + g * 8) = pack8(vv);
        float c1[8], c0[8];
#pragma unroll
        for (int e = 0; e < 8; ++e) { c1[e] = 0.f; c0[e] = 0.f; }
        { const f32x4 g0 = *(const f32x4*)(pk + PK_GNW + hc), g1 = *(const f32x4*)(pk + PK_GNW + hc + 4), h0 = *(const f32x4*)(pk + PK_GNB + hc), h1 = *(const f32x4*)(pk + PK_GNB + hc + 4);
#pragma unroll
          for (int e = 0; e < 4; ++e) { const float sz0 = silu_(zb[e]), sz1 = silu_(zb[4 + e]); c1[e] = g0[e] * sz0; c1[4 + e] = g1[e] * sz1; c0[e] = (h0[e] + rk * vv[e]) * sz0; c0[4 + e] = (h1[e] + rk * vv[4 + e]) * sz1; } }
        *(u32x4*)((bf16_t*)(rec + RP_C1) + t * 64 + g * 8) = pack8(c1); *(u32x4*)((bf16_t*)(rec + RP_C0) + t * 64 + g * 8) = pack8(c0);
        if (t == 63) { float* pc = (float*)(rec + RP_PC) + g * 8; *(f32x4*)pc = (f32x4){__expf(lcC[0]), __expf(lcC[1]), __expf(lcC[2]), __expf(lcC[3])}; *(f32x4*)(pc + 4) = (f32x4){__expf(lcC[4]), __expf(lcC[5]), __expf(lcC[6]), __expf(lcC[7])}; }
    }
    __syncthreads();
    {
        const int pr = w >> 1;
        const bf16_t* Aarr = pr < 2 ? At : Rt; const bf16_t* Barr = (pr & 1) ? Kt : Bt;
#pragma unroll
        for (int x = 0; x < 2; ++x) { const int tt = 2 * (w & 1) + x;
            const bf16x8 a0 = ldfrag(Aarr, TSTR, 16 * tt, 0, lane), a1 = ldfrag(Aarr, TSTR, 16 * tt, 32, lane);
            const int tk = 16 * tt + l15;
#pragma unroll
            for (int it = 0; it < 4; ++it) { f32x4 acc = {0.f, 0.f, 0.f, 0.f};
                acc = MFMA16(ldfrag(Barr, TSTR, 16 * it, 0, lane), a0, acc); acc = MFMA16(ldfrag(Barr, TSTR, 16 * it, 32, lane), a1, acc);
                const int i0 = 16 * it + 4 * q4;
                f32x4 o;
#pragma unroll
                for (int r = 0; r < 4; ++r) { const int i = i0 + r; const bool keep = pr < 2 ? (tk > i) : (tk >= i); o[r] = keep ? acc[r] : 0.f; }
                if (pr == 0) *(f32x4*)(Lm + tk * 64 + i0) = o;
                else { bf16_t* Out = pr == 1 ? Lak : (pr == 2 ? Mrb : Mrk); *(u32x2*)(Out + tk * TSTR + i0) = (u32x2){pk2(o[0], o[1]), pk2(o[2], o[3])}; } }
        }
    }
    __syncthreads();
    {
        float* Tm = (float*)(smem + RL_TM);
        inv_block(Lm, Tm, (float*)(smem + RL_XS), tid);
        const int i = tid >> 3, j0 = (tid & 7) * 8;
        float a[8];
#pragma unroll
        for (int e = 0; e < 8; ++e) a[e] = Tm[i * 64 + j0 + e];
        *(u32x4*)(Tb + i * TSTR + j0) = pack8(a);
    }
    __syncthreads();
    {
        const int tt = w & 3, which = w >> 2;
        const bf16_t* Aarr = which ? Lak : Tb; const bf16_t* Barr = which ? Vr : At2; bf16_t* Out = which ? XT : WaT;
        const bf16x8 a0 = ldfrag(Aarr, TSTR, 16 * tt, 0, lane), a1 = ldfrag(Aarr, TSTR, 16 * tt, 32, lane);
#pragma unroll
        for (int ct = 0; ct < 4; ++ct) { f32x4 acc = {0.f, 0.f, 0.f, 0.f};
            acc = MFMA16(a0, ldfrag_tr(Barr, TSTR, 16 * ct, 0, lane), acc); acc = MFMA16(a1, ldfrag_tr(Barr, TSTR, 16 * ct, 32, lane), acc);
            *(u32x2*)(Out + (16 * ct + l15) * TSTR + 16 * tt + 4 * q4) = (u32x2){pk2(acc[0], acc[1]), pk2(acc[2], acc[3])}; }
    }
    __syncthreads();
    {
        f32x4 acc[4];
        if (w < 4) {
            const bf16x8 a0 = ldfrag(Tb, TSTR, 16 * w, 0, lane), a1 = ldfrag(Tb, TSTR, 16 * w, 32, lane);
#pragma unroll
            for (int ct = 0; ct < 4; ++ct) { acc[ct] = (f32x4){0.f, 0.f, 0.f, 0.f};
                acc[ct] = MFMA16(a0, ldfrag(XT, TSTR, 16 * ct, 0, lane), acc[ct]); acc[ct] = MFMA16(a1, ldfrag(XT, TSTR, 16 * ct, 32, lane), acc[ct]); }
        }
        if (w < 4) {
            bf16_t* UvTw = (bf16_t*)(smem + RL_LM);
#pragma unroll
            for (int ct = 0; ct < 4; ++ct) *(u32x2*)(UvTw + (16 * ct + l15) * TSTR + 16 * w + 4 * q4) = (u32x2){pk2(-acc[ct][0], -acc[ct][1]), pk2(-acc[ct][2], -acc[ct][3])};
        }
    }
    __syncthreads();
    {
        const bf16_t* UvT = (const bf16_t*)(smem + RL_LM);
        bf16_t* gAP = (bf16_t*)(rec + RP_AP); bf16_t* gRH = (bf16_t*)(rec + RP_RH); bf16_t* gKH = (bf16_t*)(rec + RP_KH); bf16_t* gYH = (bf16_t*)(rec + RP_YH);
        const int et = w & 3, part = w >> 2;
        {
            const bf16x8 a0 = ldfrag(WaT, TSTR, 16 * et, 0, lane), a1 = ldfrag(WaT, TSTR, 16 * et, 32, lane);
            if (part == 0) {
#pragma unroll
                for (int kt = 0; kt < 4; ++kt) { f32x4 acc = {0.f, 0.f, 0.f, 0.f};
                    acc = MFMA16(a0, ldfrag_tr(Btl, TSTR, 16 * kt, 0, lane), acc); acc = MFMA16(a1, ldfrag_tr(Btl, TSTR, 16 * kt, 32, lane), acc);
                    *(u32x2*)(gAP + ((size_t)(kt * 2 + (et >> 1)) * 64 + lane) * 8 + (et & 1) * 4) = (u32x2){pk2(-acc[0], -acc[1]), pk2(-acc[2], -acc[3])}; }
            } else {
#pragma unroll
                for (int tt = 0; tt < 4; ++tt) { f32x4 acc = {0.f, 0.f, 0.f, 0.f};
                    acc = MFMA16(a0, ldfrag(Mrb, TSTR, 16 * tt, 0, lane), acc); acc = MFMA16(a1, ldfrag(Mrb, TSTR, 16 * tt, 32, lane), acc);
                    const int tk = 16 * tt + l15, e0 = 16 * et + 4 * q4;
                    const u32x2 q2 = *(const u32x2*)(Rt + tk * TSTR + e0);
                    const float o0 = __uint_as_float(q2.x << 16) - acc[0], o1 = __uint_as_float(q2.x & 0xffff0000u) - acc[1], o2 = __uint_as_float(q2.y << 16) - acc[2], o3 = __uint_as_float(q2.y & 0xffff0000u) - acc[3];
                    *(u32x2*)(gRH + ((size_t)(tt * 2 + (et >> 1)) * 64 + lane) * 8 + (et & 1) * 4) = (u32x2){pk2(o0, o1), pk2(o2, o3)}; }
            }
        }
        {
            const int rt = w & 3;
            bf16_t* Out = part ? gKH : gYH;
            bf16x8 a0, a1, a2, a3;
            if (part) { a0 = ldfrag_tr(Btl, TSTR, 16 * rt, 0, lane); a1 = ldfrag_tr(Btl, TSTR, 16 * rt, 32, lane); a2 = ldfrag_tr(Ktl, TSTR, 16 * rt, 0, lane); a3 = ldfrag_tr(Ktl, TSTR, 16 * rt, 32, lane); }
            else { a0 = ldfrag(Mrb, TSTR, 16 * rt, 0, lane); a1 = ldfrag(Mrb, TSTR, 16 * rt, 32, lane); a2 = ldfrag(Mrk, TSTR, 16 * rt, 0, lane); a3 = ldfrag(Mrk, TSTR, 16 * rt, 32, lane); }
#pragma unroll
            for (int vt = 0; vt < 4; ++vt) { f32x4 acc = {0.f, 0.f, 0.f, 0.f};
                acc = MFMA16(a0, ldfrag(UvT, TSTR, 16 * vt, 0, lane), acc); acc = MFMA16(a1, ldfrag(UvT, TSTR, 16 * vt, 32, lane), acc);
                acc = MFMA16(a2, ldfrag_tr(Vr, TSTR, 16 * vt, 0, lane), acc); acc = MFMA16(a3, ldfrag_tr(Vr, TSTR, 16 * vt, 32, lane), acc);
                *(u32x2*)(Out + ((size_t)(vt * 4 + rt) * 64 + lane) * 4) = (u32x2){pk2(acc[0], acc[1]), pk2(acc[2], acc[3])}; }
        }
    }
    __syncthreads();
}

__device__ __forceinline__ void phase_rprep(const Params& p, int seg, unsigned char* smem) {
    const int blk = obid();
    const int n_items = (CPS + (seg == 0 ? 1 : 0)) * 128;
#pragma unroll 1
    for (int it = (blk + (gridDim.x >> 1)) % gridDim.x; it < n_items; it += gridDim.x) {
        const int bh = it & 127, b = bh >> 4, hb = bh & 15; int cl = it >> 7; if (seg != 0) cl += 1;
        unsigned char* rec = p.ws + WS_RP + (size_t)(cl * 128 + bh) * RP_STRIDE;
        const bf16_t* Pb = (const bf16_t*)(p.ws + WS_P);
        bf16_t* phalo2 = (bf16_t*)(p.ws + WS_PHALO);
        if (cl == 0) rwkv_prep_item(p, smem, hb, LEX0, 48, nullptr, nullptr, rec);
        else {
            const int row = b * SEGTOK + (cl - 1) * 64;
            const bf16_t* prow = Pb + (size_t)(row - 1) * NPB;
            if (cl == 1) prow = (seg == 0) ? Pb + (size_t)(LEX0 + NMETA - 1) * NPB : phalo2 + (size_t)(((seg - 1) & 1) * NBATCH + b) * NPB;
            bf16_t* ho = (cl == CPS) ? phalo2 + (size_t)((seg & 1) * NBATCH + b) * NPB : nullptr;
            rwkv_prep_item(p, smem, hb, row, 0, prow, ho, rec);
        }
    }
}

__device__ __forceinline__ void rwkv_scan_block(const Params& p, int seg, unsigned char* smem, int pairidx) {
    const int tid = otid(), w = tid >> 6, lane = tid & 63, q4 = lane >> 4, l15 = lane & 15;
    const int hsel = w >> 2, vt = w & 3;
    const int bh = pairidx * 2 + hsel, b = bh >> 4, hb = bh & 15;
    float* st = p.out + O_RWKV_P + (size_t)bh * 4096;
    f32x4 S[4];
    if (seg) {
#pragma unroll
        for (int mt = 0; mt < 4; ++mt) S[mt] = *(const f32x4*)(st + (size_t)(16 * vt + l15) * 64 + 16 * mt + 4 * q4);
    } else {
#pragma unroll
        for (int mt = 0; mt < 4; ++mt) S[mt] = (f32x4){0.f, 0.f, 0.f, 0.f};
    }
    const int c_lo = seg ? 1 : 0;
    float* ybuf = (float*)(smem + 65536) + hsel * (64 * 68);
    const int tl = tid & 255;
    {
        const u32x4* src = (const u32x4*)(p.ws + WS_RP + (size_t)(c_lo * 128 + bh) * RP_STRIDE); u32x4* dst = (u32x4*)(smem + hsel * 16384);
#pragma unroll
        for (int x = 0; x < 4; ++x) dst[tl + 256 * x] = src[tl + 256 * x];
    }
#pragma unroll 1
    for (int cl = c_lo; cl <= CPS; ++cl) {
        const unsigned char* rec = p.ws + WS_RP + (size_t)(cl * 128 + bh) * RP_STRIDE;
        const int cur = (cl - c_lo) & 1;
        __syncthreads();
        u32x4 nx[4];
        const bool more = cl < CPS;
        if (more) { const u32x4* src = (const u32x4*)(rec + (size_t)RP_STRIDE * 128);
#pragma unroll
            for (int x = 0; x < 4; ++x) nx[x] = src[tl + 256 * x]; }
        const bf16_t* gKH = (const bf16_t*)(rec + RP_KH); const bf16_t* gYH = (const bf16_t*)(rec + RP_YH);
        u32x2 kh[4], yh[4]; f32x4 pc[4];
#pragma unroll
        for (int mt = 0; mt < 4; ++mt) { kh[mt] = *(const u32x2*)(gKH + ((size_t)(vt * 4 + mt) * 64 + lane) * 4); yh[mt] = *(const u32x2*)(gYH + ((size_t)(vt * 4 + mt) * 64 + lane) * 4);
            pc[mt] = *(const f32x4*)((const float*)(rec + RP_PC) + 16 * mt + 4 * q4); }
        const int tk = tl >> 2, g = tl & 3;
        u32x4 a0 = {0u, 0u, 0u, 0u}, a1 = a0, b0 = a0, b1 = a0;
        if (cl > 0) { const bf16_t* c1p = (const bf16_t*)(rec + RP_C1) + tk * 64 + 16 * g; const bf16_t* c0p = (const bf16_t*)(rec + RP_C0) + tk * 64 + 16 * g;
            a0 = *(const u32x4*)c0p; a1 = *(const u32x4*)(c0p + 8); b0 = *(const u32x4*)c1p; b1 = *(const u32x4*)(c1p + 8); }
        bf16x8 Bf[2];
#pragma unroll
        for (int ks = 0; ks < 2; ++ks) { u32x4 tq; tq.x = pk2(S[2 * ks][0], S[2 * ks][1]); tq.y = pk2(S[2 * ks][2], S[2 * ks][3]); tq.z = pk2(S[2 * ks + 1][0], S[2 * ks + 1][1]); tq.w = pk2(S[2 * ks + 1][2], S[2 * ks + 1][3]);
            Bf[ks] = __builtin_bit_cast(bf16x8, tq); }
        const bf16x8* AP = (const bf16x8*)(smem + cur * 32768 + hsel * 16384); const bf16x8* RH = (const bf16x8*)(smem + cur * 32768 + hsel * 16384 + RP_RH);
        f32x4 y[4], tS[4];
#pragma unroll
        for (int tt = 0; tt < 4; ++tt) { y[tt] = (f32x4){0.f, 0.f, 0.f, 0.f}; y[tt] = MFMA16(RH[(tt * 2 + 0) * 64 + lane], Bf[0], y[tt]); y[tt] = MFMA16(RH[(tt * 2 + 1) * 64 + lane], Bf[1], y[tt]); }
#pragma unroll
        for (int mt = 0; mt < 4; ++mt) { tS[mt] = (f32x4){0.f, 0.f, 0.f, 0.f}; tS[mt] = MFMA16(AP[(mt * 2 + 0) * 64 + lane], Bf[0], tS[mt]); tS[mt] = MFMA16(AP[(mt * 2 + 1) * 64 + lane], Bf[1], tS[mt]); }
#pragma unroll
        for (int mt = 0; mt < 4; ++mt) {
            S[mt][0] = pc[mt][0] * S[mt][0] + tS[mt][0] + __uint_as_float(kh[mt].x << 16); S[mt][1] = pc[mt][1] * S[mt][1] + tS[mt][1] + __uint_as_float(kh[mt].x & 0xffff0000u);
            S[mt][2] = pc[mt][2] * S[mt][2] + tS[mt][2] + __uint_as_float(kh[mt].y << 16); S[mt][3] = pc[mt][3] * S[mt][3] + tS[mt][3] + __uint_as_float(kh[mt].y & 0xffff0000u); }
        if (cl > 0) {
#pragma unroll
            for (int tt = 0; tt < 4; ++tt) {
                y[tt][0] += __uint_as_float(yh[tt].x << 16); y[tt][1] += __uint_as_float(yh[tt].x & 0xffff0000u); y[tt][2] += __uint_as_float(yh[tt].y << 16); y[tt][3] += __uint_as_float(yh[tt].y & 0xffff0000u);
#pragma unroll
                for (int r = 0; r < 4; ++r) ybuf[(16 * tt + 4 * q4 + r) * 68 + 16 * vt + l15] = y[tt][r]; }
        }
        if (more) { u32x4* dst = (u32x4*)(smem + (cur ^ 1) * 32768 + hsel * 16384);
#pragma unroll
            for (int x = 0; x < 4; ++x) dst[tl + 256 * x] = nx[x]; }
        if (cl > 0) {
            __syncthreads();
            f32x4 yv[4]; float sm = 0.f;
#pragma unroll
            for (int j = 0; j < 4; ++j) { yv[j] = *(const f32x4*)(ybuf + tk * 68 + 16 * g + 4 * j); sm += yv[j][0] + yv[j][1] + yv[j][2] + yv[j][3]; }
            sm += __shfl_xor(sm, 1); sm += __shfl_xor(sm, 2);
            const float mu = sm * (1.f / 64.f); float vs = 0.f;
#pragma unroll
            for (int j = 0; j < 4; ++j) { yv[j] = yv[j] - mu; vs += yv[j][0] * yv[j][0] + yv[j][1] * yv[j][1] + yv[j][2] * yv[j][2] + yv[j][3] * yv[j][3]; }
            vs += __shfl_xor(vs, 1); vs += __shfl_xor(vs, 2);
            const float rs = __builtin_amdgcn_rsqf(vs * (1.f / 64.f) + 64e-5f);
            const unsigned c0w[8] = {a0.x, a0.y, a0.z, a0.w, a1.x, a1.y, a1.z, a1.w}, c1w[8] = {b0.x, b0.y, b0.z, b0.w, b1.x, b1.y, b1.z, b1.w};
            unsigned ow[8];
#pragma unroll
            for (int j = 0; j < 8; ++j) ow[j] = pk2(yv[j >> 1][(j & 1) * 2] * rs * __uint_as_float(c1w[j] << 16) + __uint_as_float(c0w[j] << 16),
                                                     yv[j >> 1][(j & 1) * 2 + 1] * rs * __uint_as_float(c1w[j] & 0xffff0000u) + __uint_as_float(c0w[j] & 0xffff0000u));
            const size_t grow = (size_t)b * SEQ + seg * SEGTOK + (cl - 1) * 64 + tk;
            bf16_t* ob = (bf16_t*)(p.ws + WS_OB) + grow * D + hb * 64 + 16 * g;
            *(u32x4*)ob = (u32x4){ow[0], ow[1], ow[2], ow[3]}; *(u32x4*)(ob + 8) = (u32x4){ow[4], ow[5], ow[6], ow[7]};
        }
    }
#pragma unroll
    for (int mt = 0; mt < 4; ++mt) *(f32x4*)(st + (size_t)(16 * vt + l15) * 64 + 16 * mt + 4 * q4) = S[mt];
    __syncthreads();
}

__device__ __forceinline__ void gdn_sample_item(const Params& p, unsigned char* smem, int bs, int h) {
    const int tid = otid(), w = tid >> 6, lane = tid & 63, kq = tid >> 7, v = tid & 127;
    float* qk_s = (float*)smem; float* v_s = qk_s + 1024; float* gb_s = v_s + 512; float* part = gb_s + 16; float* part2 = part + 512;
    const bf16_t* P = (const bf16_t*)(p.ws + WS_P);
    const float* pk = (const float*)(p.ws + WS_PK);
    const float* s_in = p.in[2] + (size_t)(bs * 8 + h) * 16384; float* s_out = p.out + O_GDN_S + (size_t)(bs * 8 + h) * 16384;
    const int row0 = LEX0 + EX_SAMP + bs * DECT;
    float s[32];
#pragma unroll
    for (int j = 0; j < 32; ++j) s[j] = s_in[(size_t)(kq * 32 + j) * 128 + v];
    if (tid < 384) {
        const int pcol = (tid >> 7) * 1024 + h * 128 + (tid & 127);
        const float* cw = pk + PK_CONVW; const float* hin = p.in[3] + (size_t)bs * 9216; float* hout = p.out + O_CONV_S + (size_t)bs * 9216;
        const float cw0 = cw[pcol], cw1 = cw[3072 + pcol], cw2 = cw[6144 + pcol], cw3 = cw[9216 + pcol];
        float x3 = hin[pcol], x2 = hin[3072 + pcol], x1 = hin[6144 + pcol];
        float xr[4];
#pragma unroll
        for (int i = 0; i < 4; ++i) xr[i] = bf2f(P[(size_t)(row0 + i) * NPB + pcol]);
#pragma unroll
        for (int i = 0; i < 4; ++i) { const float y = cw0 * x3 + cw1 * x2 + cw2 * x1 + cw3 * xr[i]; x3 = x2; x2 = x1; x1 = xr[i];
            if (tid < 256) qk_s[i * 256 + tid] = silu_(y); else v_s[i * 128 + (tid - 256)] = silu_(y); }
        hout[pcol] = x3; hout[3072 + pcol] = x2; hout[6144 + pcol] = x1;
    } else if (tid < 388) {
        const int i = tid - 384; const size_t r = (size_t)(row0 + i) * NPB;
        const float pa = bf2f(P[r + C_A + h]), pb = bf2f(P[r + C_B + h]);
        gb_s[2 * i] = __expf(-expf(pk[PK_ALOG + h]) * softplus_(pa + pk[PK_DTB + h])); gb_s[2 * i + 1] = sigm(pb);
    }
    __syncthreads();
    { const int i = w >> 1, which = w & 1; float* rp = qk_s + i * 256 + which * 128; const float a = rp[lane], b = rp[lane + 64];
      const float sc = __builtin_amdgcn_rsqf(wave_sum(a * a + b * b) + 1e-6f) * (which == 0 ? 0.08838834764831845f : 1.f); rp[lane] = a * sc; rp[lane + 64] = b * sc; }
    __syncthreads();
#pragma unroll 1
    for (int i = 0; i < 4; ++i) {
        const float* kp = qk_s + i * 256 + 128 + kq * 32; const float* qp = qk_s + i * 256 + kq * 32;
        float pa = 0.f;
#pragma unroll
        for (int j4 = 0; j4 < 8; ++j4) { const f32x4 k4 = *(const f32x4*)(kp + 4 * j4); pa += k4[0] * s[4 * j4] + k4[1] * s[4 * j4 + 1] + k4[2] * s[4 * j4 + 2] + k4[3] * s[4 * j4 + 3]; }
        part[kq * 128 + v] = pa;
        __syncthreads();
        const float kS = part[v] + part[128 + v] + part[256 + v] + part[384 + v];
        const float a = gb_s[2 * i], c = gb_s[2 * i + 1] * (v_s[i * 128 + v] - a * kS);
        float po = 0.f;
#pragma unroll
        for (int j4 = 0; j4 < 8; ++j4) { const f32x4 k4 = *(const f32x4*)(kp + 4 * j4), q4v = *(const f32x4*)(qp + 4 * j4);
#pragma unroll
            for (int e = 0; e < 4; ++e) { s[4 * j4 + e] = a * s[4 * j4 + e] + k4[e] * c; po += q4v[e] * s[4 * j4 + e]; } }
        part2[kq * 128 + v] = po;
        __syncthreads();
        if (kq == 0) ((float*)(p.ws + WS_ORAW))[(size_t)(row0 + i) * D + h * 128 + v] = part2[v] + part2[128 + v] + part2[256 + v] + part2[384 + v];
    }
#pragma unroll
    for (int j = 0; j < 32; ++j) s_out[(size_t)(kq * 32 + j) * 128 + v] = s[j];
    __syncthreads();
}

constexpr int SR_R = 0, SR_KK = 4096, SR_V = 8192, SR_ZB = 12288, SR_DEC = 16384, SR_KA = 20480, SR_KM = 24576, SR_WD = 28672, SR_AD = 28928, SR_RK = 29184;
__device__ __forceinline__ void rwkv_sample_item(const Params& p, unsigned char* smem, int bs) {
    const int tid = otid(), w = tid >> 6, lane = tid & 63;
    float* f = (float*)smem;
    const bf16_t* P = (const bf16_t*)(p.ws + WS_P);
    const float* pk = (const float*)(p.ws + WS_PK);
    const int row0 = LEX0 + EX_SAMP + bs * DECT;
    const bf16_t* prow = P + (size_t)(LEX0 + EX_SHIFT + bs) * NPB + C_RW;
#pragma unroll 1
    for (int col = tid; col < RW_SHIFT; col += 512) {
        const float mu = pk[PK_MU + col]; float prev = bf2f(prow[col]);
        float cur[4];
#pragma unroll
        for (int i = 0; i < 4; ++i) cur[i] = bf2f(P[(size_t)(row0 + i) * NPB + C_RW + col]);
        float* dst; int stride = 1024; bool th = false;
        if (col < 1024) dst = f + SR_R + col; else if (col < 2048) dst = f + SR_KK + (col - 1024); else if (col < 3072) dst = f + SR_V + (col - 2048);
        else if (col < 3136) { dst = f + SR_WD + (col - 3072); stride = 64; th = true; } else if (col < 3200) { dst = f + SR_AD + (col - 3136); stride = 64; } else dst = f + SR_ZB + (col - 3200);
#pragma unroll
        for (int i = 0; i < 4; ++i) { float m = cur[i] + mu * (prev - cur[i]); prev = cur[i]; if (th) m = tanh_(m); dst[i * stride] = m; }
    }
    __syncthreads();
#pragma unroll 1
    for (int cc = 0; cc < 2; ++cc) {
        const int c = tid + 512 * cc;
        float aw[4] = {0.f, 0.f, 0.f, 0.f}, aa[4] = {0.f, 0.f, 0.f, 0.f};
#pragma unroll 8
        for (int l = 0; l < 64; ++l) { const float w2v = pk[PK_W2 + l * D + c], a2v = pk[PK_A2 + l * D + c];
#pragma unroll
            for (int i = 0; i < 4; ++i) { aw[i] += f[SR_WD + i * 64 + l] * w2v; aa[i] += f[SR_AD + i * 64 + l] * a2v; } }
        const float w0c = pk[PK_W0 + c], a0c = pk[PK_A0 + c], kkc = pk[PK_KK + c], kac = pk[PK_KA + c];
#pragma unroll
        for (int i = 0; i < 4; ++i) { const float a = sigm(a0c + aa[i]); const float kbv = f[SR_KK + i * 1024 + c];
            f[SR_DEC + i * 1024 + c] = __expf(-0.6065306597126334f * sigm(w0c + aw[i])); f[SR_KA + i * 1024 + c] = a; f[SR_KK + i * 1024 + c] = kbv * kkc; f[SR_KM + i * 1024 + c] = kbv * (1.f + (a - 1.f) * kac); }
    }
    __syncthreads();
#pragma unroll 1
    for (int x = 0; x < 8; ++x) { const int pr = w * 8 + x, i = pr >> 4, hh = pr & 15; const int o = i * 1024 + hh * 64 + lane;
        const float kr = f[SR_KK + o]; const float kk = kr * __builtin_amdgcn_rsqf(wave_sum(kr * kr) + 1e-6f); f[SR_KK + o] = kk; f[SR_KA + o] = kk * f[SR_KA + o];
        const float rkv = wave_sum(f[SR_R + o] * f[SR_KM + o] * pk[PK_RK + hh * 64 + lane]); if (lane == 0) f[SR_RK + pr] = rkv; }
    __syncthreads();
#pragma unroll 1
    for (int hp = 0; hp < 2; ++hp) {
        const int hb = hp * 8 + w;
        const float* s_in = p.in[4] + (size_t)(bs * 16 + hb) * 4096 + (size_t)lane * 64; float* s_out = p.out + O_RWKV_S + (size_t)(bs * 16 + hb) * 4096 + (size_t)lane * 64;
        f32x4 S[16];
#pragma unroll
        for (int j = 0; j < 16; ++j) S[j] = *(const f32x4*)(s_in + 4 * j);
        const int cch = hb * 64 + lane;
        const float gnw = pk[PK_GNW + cch], gnb = pk[PK_GNB + cch];
#pragma unroll 1
        for (int i = 0; i < 4; ++i) {
            const int o = i * 1024 + hb * 64;
            const float vv = f[SR_V + o + lane], rk = f[SR_RK + i * 16 + hb];
            float sa = 0.f;
#pragma unroll
            for (int j = 0; j < 16; ++j) { const f32x4 kk4 = *(const f32x4*)(f + SR_KK + o + 4 * j); sa += S[j][0] * kk4[0] + S[j][1] * kk4[1] + S[j][2] * kk4[2] + S[j][3] * kk4[3]; }
            float y = 0.f;
#pragma unroll
            for (int j = 0; j < 16; ++j) { const f32x4 de4 = *(const f32x4*)(f + SR_DEC + o + 4 * j), ka4 = *(const f32x4*)(f + SR_KA + o + 4 * j), km4 = *(const f32x4*)(f + SR_KM + o + 4 * j), r4 = *(const f32x4*)(f + SR_R + o + 4 * j);
#pragma unroll
                for (int e = 0; e < 4; ++e) { S[j][e] = S[j][e] * de4[e] + (vv * km4[e] - sa * ka4[e]); y += S[j][e] * r4[e]; } }
            const float mu = wave_sum(y) * (1.f / 64.f); const float dy = y - mu;
            const float rs = __builtin_amdgcn_rsqf(wave_sum(dy * dy) * (1.f / 64.f) + 64e-5f);
            const float ov = (dy * rs * gnw + gnb + rk * vv) * silu_(f[SR_ZB + i * 1024 + cch]);
            ((bf16_t*)(p.ws + WS_OB))[(size_t)(XROWS + EX_SAMP + bs * DECT + i) * D + cch] = (bf16_t)f2bf(ov);
        }
#pragma unroll
        for (int j = 0; j < 16; ++j) *(f32x4*)(s_out + 4 * j) = S[j];
    }
    __syncthreads();
}

__device__ __forceinline__ void phase2(const Params& p, int seg, unsigned char* smem) {
    const int blk = obid();
    float* out = p.out;
    float* chalo = (float*)(p.ws + WS_CHALO); float* phalo = (float*)(p.ws + WS_PHALO);
#ifndef SUB
#define SUB 0
#endif
#define SEN(x) (SUB == 0 || SUB == (x))
    if (SEN(1) && blk < 64) gdn_scan_block(p, seg, smem, blk);
    if (SEN(3) && blk >= 64 && blk < 128) rwkv_scan_block(p, seg, smem, blk - 64);
#ifndef DUP
#define DUP 0
#endif
    if (seg == 0) {
#pragma unroll 1
        for (int it = blk; it < DECB * 8; it += gridDim.x) gdn_sample_item(p, smem, it >> 3, it & 7);
#pragma unroll 1
        for (int it = blk; it < DECB; it += gridDim.x) rwkv_sample_item(p, smem, it);
    }
}

__device__ __forceinline__ void phase25(const Params& p, int seg) {
    const int tid0 = otid(); const int lane = tid0 & 63; const int gw = obid() * 8 + (tid0 >> 6), NGW = gridDim.x * 8;
    const bf16_t* P = (const bf16_t*)(p.ws + WS_P);
    const float* ORAW = (const float*)(p.ws + WS_ORAW); const float* YRAW = (const float*)(p.ws + WS_YRAW);
    const bf16_t* C0 = (const bf16_t*)(p.ws + WS_C0); const bf16_t* C1 = (const bf16_t*)(p.ws + WS_C1);
    bf16_t* OA = (bf16_t*)(p.ws + WS_H); bf16_t* OB = (bf16_t*)(p.ws + WS_OB);
    const int nrows = LEX0 + (seg == 0 ? DECB * DECT : 0);
    const int c = lane * 16;
    f32x4 nw[4];
#pragma unroll
    for (int j = 0; j < 4; ++j) nw[j] = *(const f32x4*)((const float*)(p.ws + WS_PK) + PK_NORMW + (c & 127) + 4 * j);
#pragma unroll 1
    for (int rr = LEX0 + gw; rr < nrows; rr += NGW) {
        int lr; size_t grow;
        if (rr < LEX0) { lr = rr; grow = (size_t)(rr / SEGTOK) * SEQ + seg * SEGTOK + (rr % SEGTOK); } else { lr = LEX0 + EX_SAMP + (rr - LEX0); grow = (size_t)XROWS + EX_SAMP + (rr - LEX0); }
        {
            f32x4 o[4]; float ss = 0.f;
#pragma unroll
            for (int j = 0; j < 4; ++j) { o[j] = *(const f32x4*)(ORAW + (size_t)lr * D + c + 4 * j); ss += o[j][0] * o[j][0] + o[j][1] * o[j][1] + o[j][2] * o[j][2] + o[j][3] * o[j][3]; }
            ss += __shfl_xor(ss, 1); ss += __shfl_xor(ss, 2); ss += __shfl_xor(ss, 4);
            const float rs = __builtin_amdgcn_rsqf(ss * (1.f / 128.f) + 1e-6f);
            const u32x4 z0 = *(const u32x4*)(P + (size_t)lr * NPB + C_Z + c), z1 = *(const u32x4*)(P + (size_t)lr * NPB + C_Z + c + 8);
            const unsigned zz[8] = {z0.x, z0.y, z0.z, z0.w, z1.x, z1.y, z1.z, z1.w};
            unsigned ow[8];
#pragma unroll
            for (int j = 0; j < 8; ++j) { const float za = __uint_as_float(zz[j] << 16), zb = __uint_as_float(zz[j] & 0xffff0000u);
                const float a = o[j >> 1][(j & 1) * 2] * rs * nw[j >> 1][(j & 1) * 2] * silu_(za), b = o[j >> 1][(j & 1) * 2 + 1] * rs * nw[j >> 1][(j & 1) * 2 + 1] * silu_(zb);
                ow[j] = pk2(a, b); }
            *(u32x4*)(OA + grow * D + c) = (u32x4){ow[0], ow[1], ow[2], ow[3]}; *(u32x4*)(OA + grow * D + c + 8) = (u32x4){ow[4], ow[5], ow[6], ow[7]};
        }
    }
}

__device__ __forceinline__ void phase_final(const Params& p) {
    const int tid0 = otid(); const int lane = tid0 & 63; const int gw = obid() * 8 + (tid0 >> 6), NGW = gridDim.x * 8;
    const f32x4* wr = (const f32x4*)((const float*)(p.ws + WS_PK) + PK_LNF) + lane;
    f32x4 wv[4];
#pragma unroll
    for (int j = 0; j < 4; ++j) wv[j] = wr[64 * j];
    constexpr int NR = XROWS + DECB * DECT;
#pragma unroll 1
    for (int r = gw; r < NR; r += 2 * NGW) {
        const int r1 = r + NGW; const bool has1 = r1 < NR;
        f32x4* x0 = (f32x4*)(p.out + (size_t)r * D) + lane; f32x4* x1 = (f32x4*)(p.out + (size_t)(has1 ? r1 : r) * D) + lane;
        f32x4 a[4], b[4]; float s0 = 0.f, s1 = 0.f;
#pragma unroll
        for (int j = 0; j < 4; ++j) { a[j] = x0[64 * j]; b[j] = x1[64 * j]; }
#pragma unroll
        for (int j = 0; j < 4; ++j) { s0 += a[j][0] * a[j][0] + a[j][1] * a[j][1] + a[j][2] * a[j][2] + a[j][3] * a[j][3]; s1 += b[j][0] * b[j][0] + b[j][1] * b[j][1] + b[j][2] * b[j][2] + b[j][3] * b[j][3]; }
        const float q0 = __builtin_amdgcn_rsqf(wave_sum(s0) * (1.f / D) + 1e-6f), q1 = __builtin_amdgcn_rsqf(wave_sum(s1) * (1.f / D) + 1e-6f);
#pragma unroll
        for (int j = 0; j < 4; ++j) x0[64 * j] = a[j] * q0 * wv[j];
        if (has1) {
#pragma unroll
            for (int j = 0; j < 4; ++j) x1[64 * j] = b[j] * q1 * wv[j]; }
    }
}

__global__ __launch_bounds__(512, 2) void hybrid_mega(Params p) {
    extern __shared__ __attribute__((aligned(16))) unsigned char smem[];
    cg::grid_group grid = cg::this_grid();
    LAS unsigned char* lds = (LAS unsigned char*)smem;
    const int G = gridDim.x;
    volatile LAS unsigned* xst = (volatile LAS unsigned*)(lds + (LDS_TOTAL - 16));
    if (threadIdx.x == 0) { xst[0] = 0u; xst[1] = 0u; }
    __syncthreads();
    (void)xcd_barrier_post((unsigned*)(p.ws + WS_BAR), xst);
    if (G == 0x7fffffff) grid.sync();
#define GSYNC() do { XcdBarrier xb_; xb_.bar = (unsigned*)(p.ws + WS_BAR); xb_.x = xb_xcc_id(); xb_.st = (volatile LAS unsigned*)((LAS unsigned char*)smem + (LDS_TOTAL - 16)); xcd_barrier(xb_); } while (0)

#ifndef ONLY
#define ONLY 0
#endif
#define EN(x) (ONLY == 0 || ONLY == (x))
    if (EN(1)) phase0(p, smem);
    GSYNC();
#pragma unroll 1
    for (int it = 0; it <= NSEG + 2; ++it) {
        const int xblk = obid() - (G - 12);
        const bool xrole = xblk >= 0;
        if (it > 0 && it <= NSEG && EN(3)) phase2(p, it - 1, smem);
        if ((((it == 2 || it == 3) && xrole) || it == NSEG + 1) && EN(5)) {
            const bool ex = it <= 3;
            SchedAB S; S.ob.init(ex ? 3 : XROWS / 256, 4, ex ? 12 : G, ex ? xblk : obid()); S.pm0 = ex ? XROWS / 256 : 0; S.wfix = ex ? it - 2 : -1;
            S.A0 = (const char*)(p.ws + WS_H); S.A1 = (const char*)(p.ws + WS_OB); S.B0 = (const char*)(p.ws + WS_WT_A); S.B1 = (const char*)(p.ws + WS_WT_B);
            EpiAB E; E.tmp = ex ? (bf16_t*)(p.ws + WS_YRAW) - (size_t)XROWS * D : (bf16_t*)(p.ws + WS_P); E.merged = ex ? (bf16_t*)(p.ws + WS_C0) - (size_t)XROWS * D : (bf16_t*)(p.ws + WS_MG);
            E.gex = (const bf16_t*)(p.ws + WS_GEX); E.out = p.out; E.pairmode = ex ? 0 : 1;
            pg8::gemm_phase<EpiAB, SchedAB>(lds, D, S, E);
        }
        if (((it == 4 && xrole) || it == NSEG + 2) && EN(6)) {
            const bool ex = it == 4;
            SchedO S; S.ob.init(ex ? 3 : XROWS / 256, 4, ex ? 12 : G, ex ? xblk : obid()); S.pm0 = ex ? XROWS / 256 : 0;
            S.A = ex ? (const char*)((bf16_t*)(p.ws + WS_C0) - (size_t)XROWS * D) : (const char*)(p.ws + WS_MG); S.B = (const char*)(p.ws + WS_WT_O);
            EpiO E; E.out = p.out; E.xp = p.in[0]; E.xs = p.in[1];
            pg8::gemm_phase<EpiO, SchedO>(lds, D, S, E);
        }
        const bool xphase = it >= 2 && it <= 4;
        if (it < NSEG && EN(2) && !(xphase && xrole)) {
            const int seg = it;
            const int Gp = xphase ? G - 12 : G;
            const int cidx = it > 0 ? (obid() + (Gp >> 1)) % Gp : obid();
            SchedIn S; S.ob.init(seg == 0 ? LT_PROMPT + 3 : LT_PROMPT, NT_IN, Gp, cidx); S.seg = seg; S.A = (const char*)(p.ws + WS_H); S.B = (const char*)(p.ws + WS_WT_IN);
            EpiIn E; E.P = (bf16_t*)(p.ws + WS_P); E.gex = (bf16_t*)(p.ws + WS_GEX); E.out = p.out; E.seg = seg;
            pg8::gemm_phase<EpiIn, SchedIn>(lds, D, S, E);
        }
        {
            const int hlo = 208, hhi = (it >= 2 && it <= 4) ? G - 12 : G;
            if (it >= 1 && it + 1 < NSEG && obid() >= hlo && obid() < hhi) { const int t0 = otid(); h_rows_segs(p, it + 1, it + 2, (obid() - hlo) * 8 + (t0 >> 6), (hhi - hlo) * 8, t0 & 63); }
        }
        GSYNC();
        if (it < NSEG) {
            if (EN(8)) { phase_gprep(p, it, smem); phase_rprep(p, it, smem); }
            if (it == 1 && EN(4)) phase25(p, 0);
            GSYNC();
        }
    }
    if (EN(7)) phase_final(p);
}

extern "C" void kernel_launch(void* const* d_in, const int* in_sizes, int n_in, void* d_out, int out_size, void* d_ws, size_t ws_size, hipStream_t stream) {
    static int grid_blocks = 0;
    constexpr int LDS_BYTES = LDS_TOTAL;
    if (grid_blocks == 0) {
        if (n_in != 27 || ws_size < WS_END) { fprintf(stderr, "kernel_launch: unexpected n_in %d / ws %zu (need %zu)\n", n_in, ws_size, (size_t)WS_END); grid_blocks = -1; return; }
        if (hipFuncSetAttribute((const void*)hybrid_mega, hipFuncAttributeMaxDynamicSharedMemorySize, LDS_BYTES) != hipSuccess) { fprintf(stderr, "kernel_launch: hipFuncSetAttribute failed\n"); grid_blocks = -1; return; }
        int dev = 0, cus = 0, per_cu = 0;
        hipGetDevice(&dev);
        hipDeviceGetAttribute(&cus, hipDeviceAttributeMultiprocessorCount, dev);
        hipOccupancyMaxActiveBlocksPerMultiprocessor(&per_cu, (const void*)hybrid_mega, 512, LDS_BYTES);
        if (per_cu < 1) { fprintf(stderr, "kernel_launch: occupancy query says %d blocks/CU\n", per_cu); per_cu = 1; }
        (void)hipGetLastError();
        grid_blocks = cus;
    }
    if (grid_blocks < 0) return;
    Params p{};
    for (int i = 0; i < 27; ++i) p.in[i] = (const float*)d_in[i];
    p.out = (float*)d_out; p.ws = (unsigned char*)d_ws;
    if (hipMemsetAsync((unsigned char*)d_ws + WS_BAR, 0, 16384, stream) != hipSuccess) { fprintf(stderr, "kernel_launch: memset of the barrier words failed\n"); return; }
    void* args[] = {&p};
    hipError_t e = hipLaunchCooperativeKernel((const void*)hybrid_mega, dim3(grid_blocks), dim3(512), args, LDS_BYTES, stream);
    if (e != hipSuccess) fprintf(stderr, "cooperative launch failed: %s (grid %d)\n", hipGetErrorString(e), grid_blocks);
}
```

```cpp
#include <hip/hip_runtime.h>
#include <hip/hip_cooperative_groups.h>
#include <cstdio>
namespace cg = cooperative_groups;

#define LAS __attribute__((address_space(3)))
typedef unsigned short bf16_t;
typedef short bf16x8 __attribute__((ext_vector_type(8)));
typedef float f32x4 __attribute__((ext_vector_type(4)));
typedef unsigned u32x4 __attribute__((ext_vector_type(4)));
typedef unsigned u32x2 __attribute__((ext_vector_type(2)));

constexpr int D = 1024;
constexpr int NBATCH = 8, SEQ = 2048, NMETA = 16, DECB = 128, DECT = 4;
constexpr int XROWS = NBATCH * SEQ;
constexpr int EX_SAMP = 16, EX_SHIFT = 528, EX_END = 656;
constexpr int HROWS = 17152, HTILES = 67;
constexpr int NSEG = 8, SEGTOK = SEQ / NSEG;
constexpr int CPS = SEGTOK / 64;
constexpr int TPB = SEGTOK / 256;
constexpr int LT_PROMPT = NBATCH * TPB;
constexpr int LEX0 = LT_PROMPT * 256;
constexpr int LROWS = LEX0 + 768;
constexpr int NP = 10496, NPB = 8448, NT_IN = 41, NT_PB = 33;
constexpr int C_A = 3072, C_B = 3080, C_Z = 3088, C_RW = 4112, C_GATE_REF = 8336;
constexpr int RW_SHIFT = 4224;

constexpr size_t O_YP = 0, O_YS = 16777216, O_GDN_P = 17301504, O_CONV_P = 18350080, O_RWKV_P = 18423808, O_SHIFT_P = 18948096,
                 O_GDN_S = 18956288, O_CONV_S = 35733504, O_RWKV_S = 36913152, O_SHIFT_S = 45301760;

constexpr size_t al256(size_t x) { return (x + 255) & ~(size_t)255; }
constexpr size_t WS_WT_IN = 0;
constexpr size_t WS_WT_A = al256(WS_WT_IN + (size_t)NP * D * 2);
constexpr size_t WS_WT_B = al256(WS_WT_A + (size_t)D * D * 2);
constexpr size_t WS_WT_O = al256(WS_WT_B + (size_t)D * D * 2);
constexpr size_t WS_H = al256(WS_WT_O + (size_t)D * D * 2);
constexpr size_t WS_OB = al256(WS_H + (size_t)HROWS * D * 2);
constexpr size_t WS_P = al256(WS_OB + (size_t)HROWS * D * 2);
constexpr size_t WS_ORAW = al256(WS_P + (size_t)LROWS * NPB * 2);
constexpr size_t WS_YRAW = al256(WS_ORAW + (size_t)LROWS * D * 4);
constexpr size_t WS_C0 = al256(WS_YRAW + (size_t)LROWS * D * 4);
constexpr size_t WS_C1 = al256(WS_C0 + (size_t)LROWS * D * 2);
constexpr size_t WS_GEX = al256(WS_C1 + (size_t)LROWS * D * 2);
constexpr size_t WS_CHALO = al256(WS_GEX + (size_t)768 * 2048 * 2);
constexpr size_t WS_PHALO = al256(WS_CHALO + (size_t)2 * NBATCH * 3 * NPB * 2);
constexpr size_t WS_PK = al256(WS_PHALO + (size_t)2 * NBATCH * NPB * 2);
constexpr int PK_CONVW = 0, PK_ALOG = 12288, PK_DTB = 12296, PK_NORMW = 12304, PK_MU = 12432, PK_W0 = 16656, PK_W2 = 17680, PK_A0 = 83216, PK_A2 = 84240,
              PK_KK = 149776, PK_KA = 150800, PK_RK = 151824, PK_GNW = 152848, PK_GNB = 153872, PK_LNF = 154896, PK_END = 155920;
constexpr size_t WS_BAR = al256(WS_PK + (size_t)PK_END * 4);
constexpr size_t WS_W2T = al256(WS_BAR + 16384);
constexpr size_t WS_A2T = al256(WS_W2T + 131072);
constexpr size_t WS_GP = al256(WS_A2T + 131072);
constexpr int GP_AP = 0, GP_QH = 32768, GP_KH = 49152, GP_OH = 81920, GP_EGL = 98304, GP_G = 98560, GP_STRIDE = 114944;
constexpr int RP_AP = 0, RP_RH = 8192, RP_KH = 16384, RP_YH = 24576, RP_C1 = 32768, RP_C0 = 40960, RP_PC = 49152, RP_STRIDE = 49408;
constexpr size_t WS_RP = al256(WS_GP + (size_t)(CPS + 1) * 64 * GP_STRIDE);
constexpr size_t WS_END = al256(WS_RP + (size_t)(CPS + 1) * 128 * RP_STRIDE);
constexpr size_t WS_MG = WS_GP;
static_assert((size_t)HROWS * D * 2 <= WS_END - WS_GP, "MERGED must fit in the prep records");
static_assert((size_t)HROWS * D * 4 <= (size_t)LROWS * NPB * 2 + 2 * (size_t)LROWS * D * 4, "TMP must fit in P+ORAW+YRAW");
static_assert(WS_END <= (size_t)268435456, "workspace");

constexpr int LDS_TOTAL = 163840;
struct Params { const float* in[27]; float* out; unsigned char* ws; };

__device__ __forceinline__ float bf2f(bf16_t v) { return __uint_as_float(((unsigned)v) << 16); }
typedef __bf16 bf16n2 __attribute__((ext_vector_type(2)));
typedef float f32n2 __attribute__((ext_vector_type(2)));
__device__ __forceinline__ unsigned cvt_pk_bf16(float lo, float hi) { const f32n2 v = {lo, hi}; return __builtin_bit_cast(unsigned, __builtin_convertvector(v, bf16n2)); }
__device__ __forceinline__ unsigned pk2(float lo, float hi) { return cvt_pk_bf16(lo, hi); }
__device__ __forceinline__ unsigned f2bf(float f) { return cvt_pk_bf16(f, 0.f) & 0xffffu; }
__device__ __forceinline__ float sigm(float x) { return __builtin_amdgcn_rcpf(1.f + __expf(-x)); }
__device__ __forceinline__ float silu_(float x) { return x * __builtin_amdgcn_rcpf(1.f + __expf(-x)); }
__device__ __forceinline__ float softplus_(float x) { return fmaxf(x, 0.f) + log1pf(expf(-fabsf(x))); }
__device__ __forceinline__ float wave_sum(float v) {
#pragma unroll
    for (int o = 1; o < 64; o <<= 1) v += __shfl_xor(v, o);
    return v;
}
__device__ __forceinline__ void unpack8(const u32x4 rw, float (&x)[8]) {
    x[0] = __uint_as_float(rw.x << 16); x[1] = __uint_as_float(rw.x & 0xffff0000u); x[2] = __uint_as_float(rw.y << 16); x[3] = __uint_as_float(rw.y & 0xffff0000u);
    x[4] = __uint_as_float(rw.z << 16); x[5] = __uint_as_float(rw.z & 0xffff0000u); x[6] = __uint_as_float(rw.w << 16); x[7] = __uint_as_float(rw.w & 0xffff0000u); }
__device__ __forceinline__ u32x4 pack8(const float (&x)[8]) { return (u32x4){pk2(x[0], x[1]), pk2(x[2], x[3]), pk2(x[4], x[5]), pk2(x[6], x[7])}; }

__device__ __forceinline__ int otid() { int t = threadIdx.x; asm volatile("" : "+v"(t)); return t; }
__device__ __forceinline__ int obid() { int t = blockIdx.x; asm volatile("" : "+s"(t)); return t; }
__device__ __forceinline__ float tanh_(float x) { const float e = __expf(2.f * x); return 1.f - 2.f * __builtin_amdgcn_rcpf(e + 1.f); }
template <int CTRL> __device__ __forceinline__ float dppf(float x) { return __builtin_bit_cast(float, __builtin_amdgcn_mov_dpp(__builtin_bit_cast(int, x), CTRL, 0xf, 0xf, true)); }
__device__ __forceinline__ float rowsum16(float x) { x += dppf<0x128>(x); x += dppf<0x124>(x); x += dppf<0x122>(x); x += dppf<0x121>(x); return x; }


#define XB_TMO      128
#define XB_XCNT(j)  (256  + 64 * (j))
#define XB_XSUB(j)  (1280 + 64 * (j))
#define XB_XGEN(j)  (2304 + 64 * (j))
#define XB_TOP      3328
#define XB_TOPGEN   3392
#define XCD_BAR_WORDS 3456
#define XB_SPIN_CAP (1u << 22)
__device__ __forceinline__ unsigned xb_ld(unsigned* p)              { return __hip_atomic_load(p, __ATOMIC_RELAXED, __HIP_MEMORY_SCOPE_AGENT); }
__device__ __forceinline__ unsigned xb_add(unsigned* p, unsigned v) { return __hip_atomic_fetch_add(p, v, __ATOMIC_RELAXED, __HIP_MEMORY_SCOPE_AGENT); }
__device__ __forceinline__ unsigned xb_xcc_id() { return (unsigned)__builtin_amdgcn_s_getreg((3 << 11) | 20) & 0xFu; }
#define XB_SPIN(cond, bar) do { unsigned _sp = 0; while (cond) { __builtin_amdgcn_s_sleep(1); \
    if ((++_sp & 255u) == 0u) { if (xb_ld(&(bar)[XB_TMO])) break; if (_sp > XB_SPIN_CAP) { atomicAdd(&(bar)[XB_TMO], 1u); break; } } } } while (0)
struct XcdBarrier { unsigned* bar; unsigned x; volatile LAS unsigned* st; };
__device__ __forceinline__ XcdBarrier xcd_barrier_post(unsigned* bar, volatile LAS unsigned* st) {
    XcdBarrier b; b.bar = bar; b.x = xb_xcc_id(); b.st = st;
    if (threadIdx.x == 0) (void)xb_add(&bar[XB_XCNT(b.x)], 1u);
    return b;
}
__device__ __forceinline__ void xcd_barrier_complete(unsigned* bar, unsigned x, unsigned& nloc, unsigned& nx) {
    const unsigned G = gridDim.x * gridDim.y * gridDim.z;
    unsigned sum, cnt, mine, sp = 0u;
    for (;;) {
        sum = 0u; cnt = 0u; mine = 0u;
#pragma unroll
        for (unsigned j = 0; j < 16; ++j) { const unsigned c = xb_ld(&bar[XB_XCNT(j)]); sum += c; cnt += (c > 0u) ? 1u : 0u; mine = (j == x) ? c : mine; }
        if (sum == G) break;
        __builtin_amdgcn_s_sleep(1);
        if ((++sp & 255u) == 0u) { if (xb_ld(&bar[XB_TMO])) break; if (sp > XB_SPIN_CAP) { atomicAdd(&bar[XB_TMO], 1u); break; } }
    }
    nloc = mine > 0u ? mine : 1u; nx = cnt > 0u ? cnt : 1u;
}
__device__ __forceinline__ void xcd_barrier(const XcdBarrier& b) {
    asm volatile("s_waitcnt vmcnt(0)" ::: "memory");
    __syncthreads();
    if (threadIdx.x == 0) {
        unsigned* bar = b.bar;
        __builtin_amdgcn_s_waitcnt(0);
        unsigned nloc = b.st[0], nx = b.st[1];
        if (nloc == 0u) { xcd_barrier_complete(bar, b.x, nloc, nx); b.st[0] = nloc; b.st[1] = nx; }
        const unsigned old = xb_add(&bar[XB_XSUB(b.x)], 1u);
        const unsigned gen = old / nloc;
        if (old + 1u == (gen + 1u) * nloc) {
            __builtin_amdgcn_fence(__ATOMIC_RELEASE, "agent");
            asm volatile("s_waitcnt vmcnt(0)" ::: "memory");
            const unsigned og = xb_add(&bar[XB_TOP], 1u);
            const unsigned tg = og / nx;
            if (og + 1u == (tg + 1u) * nx) xb_add(&bar[XB_TOPGEN], 1u);
            else XB_SPIN(xb_ld(&bar[XB_TOPGEN]) == tg, bar);
            __builtin_amdgcn_fence(__ATOMIC_ACQUIRE, "agent");
            xb_add(&bar[XB_XGEN(b.x)], 1u);
            asm volatile("s_waitcnt vmcnt(0)" ::: "memory");
        } else {
            XB_SPIN(xb_ld(&bar[XB_XGEN(b.x)]) == gen, bar);
            __builtin_amdgcn_fence(__ATOMIC_ACQUIRE, "agent");
            asm volatile("s_waitcnt vmcnt(0)" ::: "memory");
        }
    }
    __syncthreads();
}

namespace pg8 {
constexpr int BM = 256, BK = 64, HALF = 128, HTB = HALF * BK * 2, STAGE_BYTES = 8 * HTB, NXCD = 8, WGM = 8;
__device__ __forceinline__ int lds_byte(int r, int c) { const int st = (r >> 4) * 2 + (c >> 5), rr = r & 15, cc = c & 31, ob = rr * 64 + cc * 2; return st * 1024 + (ob ^ (((ob >> 9) & 1) << 5)); }
__device__ __forceinline__ void stage_rc(int b, int& R, int& C) { const int st = b / 1024, sb = b % 1024, swz = sb ^ (((sb >> 9) & 1) << 5); R = (st >> 1) * 16 + swz / 64; C = (st & 1) * 32 + (swz % 64) / 2; }
__device__ __forceinline__ int perm32(int rho) { const int n = rho >> 4, i = rho & 15; return 8 * (i >> 2) + 4 * n + (i & 3); }

struct Unit { int pm, pn, w; };
struct OrderBase {
    int nM, nN, nwg, G, c;
    __device__ void init(int nM_, int nN_, int G_, int c_) { nM = nM_; nN = nN_; nwg = nM * nN; G = G_; c = c_; }
    __device__ bool nextb(int i, Unit& u) const {
        const long L = (long)i * G + c; if (L >= nwg) return false;
        int wgid = (int)L; { const int q = nwg / NXCD, r = nwg % NXCD, xcd = wgid % NXCD, off = wgid / NXCD; wgid = (xcd < r ? xcd * (q + 1) : r * (q + 1) + (xcd - r) * q) + off; }
        const int nig = WGM * nN, gid = wgid / nig, fm = gid * WGM, gsz = (nM - fm) < WGM ? (nM - fm) : WGM;
        u.pm = fm + ((wgid % nig) % gsz); u.pn = (wgid % nig) / gsz; u.w = 0; return true;
    }
};

template <class Epi, class Sched>
__device__ __forceinline__ void gemm_phase(LAS unsigned char* lds, const int K, const Sched& S, const Epi& E) {
    const int tid = otid(), wid = __builtin_amdgcn_readfirstlane(tid >> 6), lane = tid & 63, wr = wid >> 2, wc = wid & 3, fr = lane & 15, fq = lane >> 4;
    const int nt = K / BK;
    unsigned voffA[2], voffB[2];
#pragma unroll
    for (int i = 0; i < 2; ++i) { int R, C; stage_rc(tid * 16 + i * 8192, R, C); const int Rb = Epi::PERM ? ((R & ~31) + perm32(R & 31)) : R;
        voffA[i] = (unsigned)(R * K + C) * 2u; voffB[i] = (unsigned)(Rb * K + C) * 2u; }
    const size_t kstep = (size_t)(BK * 2);
    const size_t hstep = (size_t)HALF * K * 2;
    const unsigned ldsw = (unsigned)wid * 1024u;
    const int aoff = lds_byte(wr * 64 + fr, fq * 8), boff = lds_byte(wc * 32 + fr, fq * 8);
#define PG8_SA(b, h) (((b) * 2 + (h)) * HTB)
#define PG8_SB(b, h) ((4 + (b) * 2 + (h)) * HTB)
#define PG8_STAGE(bufoff, gbase, voff) do { _Pragma("unroll") for (int _i = 0; _i < 2; ++_i) \
        __builtin_amdgcn_global_load_lds((const unsigned*)((const char*)(gbase) + (voff)[_i]), (LAS unsigned*)(lds + (bufoff) + ldsw + _i * 8192), 16, 0, 0); } while (0)
#define PG8_LDA(dst, b, h) do { _Pragma("unroll") for (int m = 0; m < 4; ++m) _Pragma("unroll") for (int k = 0; k < 2; ++k) dst[m][k] = *(const LAS bf16x8*)(lds + PG8_SA(b, h) + aoff + m * 2048 + k * 1024); } while (0)
#define PG8_LDB(dst, b, h) do { _Pragma("unroll") for (int n = 0; n < 2; ++n) _Pragma("unroll") for (int k = 0; k < 2; ++k) dst[n][k] = *(const LAS bf16x8*)(lds + PG8_SB(b, h) + boff + n * 2048 + k * 1024); } while (0)
#define PG8_MMA(ai, bj, At, Bt) do { __builtin_amdgcn_s_setprio(1); _Pragma("unroll") for (int m = 0; m < 4; ++m) _Pragma("unroll") for (int n = 0; n < 2; ++n) _Pragma("unroll") for (int k = 0; k < 2; ++k) \
        acc[ai][bj][m][n] = __builtin_amdgcn_mfma_f32_16x16x32_bf16(Bt[n][k], At[m][k], acc[ai][bj][m][n], 0, 0, 0); __builtin_amdgcn_s_setprio(0); } while (0)
#define PG8_WAIT_V(n) asm volatile("s_waitcnt vmcnt(" #n ")" ::: "memory")
#define PG8_WAIT_L(n) asm volatile("s_waitcnt lgkmcnt(" #n ")" ::: "memory")
#define PG8_BAR __builtin_amdgcn_s_barrier()
#define PG8_SCHED __builtin_amdgcn_sched_barrier(0)
    Unit cur, nxt; int ui = 0;
    if (!S.next(0, cur)) return;
    f32x4 acc[2][2][4][2];
#pragma unroll
    for (int a = 0; a < 2; ++a)
#pragma unroll
        for (int b = 0; b < 2; ++b)
#pragma unroll
            for (int m = 0; m < 4; ++m)
#pragma unroll
                for (int n = 0; n < 2; ++n) acc[a][b][m][n] = (f32x4){0.f, 0.f, 0.f, 0.f};
    bf16x8 At[4][2], B0[2][2], B1[2][2];
    const char* cA = S.a_ptr(cur); const char* cB = S.b_ptr(cur);
    PG8_STAGE(PG8_SB(0, 0), cB, voffB); PG8_STAGE(PG8_SA(0, 0), cA, voffA); PG8_STAGE(PG8_SB(0, 1), cB + hstep, voffB); PG8_STAGE(PG8_SA(0, 1), cA + hstep, voffA);
    if (wr == 1) PG8_BAR;
    PG8_WAIT_V(4); PG8_BAR;
    PG8_STAGE(PG8_SB(1, 0), cB + kstep, voffB); PG8_STAGE(PG8_SA(1, 0), cA + kstep, voffA); PG8_STAGE(PG8_SB(1, 1), cB + hstep + kstep, voffB);
    PG8_WAIT_V(6); PG8_BAR;
    for (;;) {
        const bool has_next = S.next(ui + 1, nxt);
        const char* nA = has_next ? S.a_ptr(nxt) : cA; const char* nB = has_next ? S.b_ptr(nxt) : cB;
        for (int t = 0; t < nt; t += 2) {
            const bool last = (t == nt - 2);
            const char* a1 = cA + (size_t)(t + 1) * kstep;
            const char* a2 = last ? nA : cA + (size_t)(t + 2) * kstep; const char* b2 = last ? nB : cB + (size_t)(t + 2) * kstep;
            const char* a3 = a2 + kstep; const char* b3 = b2 + kstep;
            PG8_LDB(B0, 0, 0); PG8_SCHED; PG8_LDA(At, 0, 0); PG8_STAGE(PG8_SA(1, 1), a1 + hstep, voffA);
            PG8_WAIT_L(8); PG8_BAR; PG8_WAIT_L(0); PG8_MMA(0, 0, At, B0); PG8_BAR; PG8_SCHED;
            PG8_LDB(B1, 0, 1); PG8_STAGE(PG8_SB(0, 0), b2, voffB);
            PG8_BAR; PG8_WAIT_L(0); PG8_MMA(0, 1, At, B1); PG8_BAR;
            PG8_LDA(At, 0, 1); PG8_STAGE(PG8_SA(0, 0), a2, voffA);
            PG8_BAR; PG8_WAIT_L(0); PG8_MMA(1, 0, At, B0); PG8_BAR; PG8_SCHED;
            PG8_STAGE(PG8_SB(0, 1), b2 + hstep, voffB);
            PG8_WAIT_V(6); PG8_BAR; PG8_MMA(1, 1, At, B1); PG8_BAR;
            PG8_LDB(B0, 1, 0); PG8_SCHED; PG8_LDA(At, 1, 0); PG8_STAGE(PG8_SA(0, 1), a2 + hstep, voffA);
            PG8_WAIT_L(8); PG8_BAR; PG8_WAIT_L(0); PG8_MMA(0, 0, At, B0); PG8_BAR; PG8_SCHED;
            PG8_LDB(B1, 1, 1); PG8_STAGE(PG8_SB(1, 0), b3, voffB);
            PG8_BAR; PG8_WAIT_L(0); PG8_MMA(0, 1, At, B1); PG8_BAR;
            PG8_LDA(At, 1, 1); PG8_STAGE(PG8_SA(1, 0), a3, voffA);
            PG8_BAR; PG8_WAIT_L(0); PG8_MMA(1, 0, At, B0); PG8_BAR; PG8_SCHED;
            PG8_STAGE(PG8_SB(1, 1), b3 + hstep, voffB);
            PG8_WAIT_V(6); PG8_BAR; PG8_MMA(1, 1, At, B1); PG8_BAR;
        }
        E(acc, cur, wr, wc, fr, fq);
        if (!has_next) break;
        if (!E.keep(cur)) {
#pragma unroll
        for (int a = 0; a < 2; ++a)
#pragma unroll
            for (int b = 0; b < 2; ++b)
#pragma unroll
                for (int m = 0; m < 4; ++m)
#pragma unroll
                    for (int n = 0; n < 2; ++n) acc[a][b][m][n] = (f32x4){0.f, 0.f, 0.f, 0.f};
        }
        cur = nxt; cA = nA; cB = nB; ++ui;
    }
    PG8_WAIT_V(0);
    if (wr == 0) PG8_BAR;
    PG8_BAR;
#undef PG8_SA
#undef PG8_SB
#undef PG8_STAGE
#undef PG8_LDA
#undef PG8_LDB
#undef PG8_MMA
#undef PG8_WAIT_V
#undef PG8_WAIT_L
#undef PG8_BAR
#undef PG8_SCHED
}
}
using pg8::Unit;

struct SchedIn {
    pg8::OrderBase ob; int seg; const char* A; const char* B;
    __device__ bool next(int i, Unit& u) const { return ob.nextb(i, u); }
    __device__ const char* a_ptr(const Unit& u) const {
        const int gt = u.pm < LT_PROMPT ? ((u.pm / TPB) * (SEQ / 256) + seg * TPB + (u.pm % TPB)) : (XROWS / 256 + (u.pm - LT_PROMPT));
        return A + (size_t)gt * 256 * D * 2; }
    __device__ const char* b_ptr(const Unit& u) const { return B + (size_t)u.pn * 256 * D * 2; }
};
struct SchedAB {
    pg8::OrderBase ob; int pm0, wfix; const char* A0; const char* A1; const char* B0; const char* B1;
    __device__ bool next(int i, Unit& u) const { const bool ok = wfix < 0 ? ob.nextb(i >> 1, u) : ob.nextb(i, u); u.pm += pm0; u.w = wfix < 0 ? (i & 1) : wfix; return ok; }
    __device__ const char* a_ptr(const Unit& u) const { return (u.w ? A1 : A0) + (size_t)u.pm * 256 * D * 2; }
    __device__ const char* b_ptr(const Unit& u) const { return (u.w ? B1 : B0) + (size_t)u.pn * 256 * D * 2; }
};
struct SchedO {
    pg8::OrderBase ob; int pm0; const char* A; const char* B;
    __device__ bool next(int i, Unit& u) const { const bool ok = ob.nextb(i, u); u.pm += pm0; return ok; }
    __device__ const char* a_ptr(const Unit& u) const { return A + (size_t)u.pm * 256 * D * 2; }
    __device__ const char* b_ptr(const Unit& u) const { return B + (size_t)u.pn * 256 * D * 2; }
};

struct EpiIn {
    static constexpr bool PERM = true;
    bf16_t* P; bf16_t* gex; float* out; int seg;
    __device__ __forceinline__ bool keep(const Unit&) const { return false; }
    __device__ __forceinline__ void operator()(const f32x4 (&acc)[2][2][4][2], const Unit& u, int wr, int wc, int fr, int fq) const {
        const int lr0 = u.pm * 256 + wr * 64 + fr;
        const int c0 = u.pn * 256 + wc * 32 + 8 * fq;
#pragma unroll
        for (int ai = 0; ai < 2; ++ai)
#pragma unroll
            for (int m = 0; m < 4; ++m) {
                const int lr = lr0 + ai * 128 + m * 16;
                bf16_t* rowp;
                if (u.pn < NT_PB) rowp = P + (size_t)lr * NPB + c0;
                else if (lr < LEX0) { const int b = lr / SEGTOK; const size_t grow = (size_t)b * SEQ + seg * SEGTOK + (lr % SEGTOK); rowp = (bf16_t*)(out + O_YP + grow * D) + (c0 - NPB); }
                else rowp = gex + (size_t)(lr - LEX0) * 2048 + (c0 - NPB);
#pragma unroll
                for (int bj = 0; bj < 2; ++bj) { const f32x4 v0 = acc[ai][bj][m][0], v1 = acc[ai][bj][m][1];
                    u32x4 w; w.x = cvt_pk_bf16(v0[0], v0[1]); w.y = cvt_pk_bf16(v0[2], v0[3]); w.z = cvt_pk_bf16(v1[0], v1[1]); w.w = cvt_pk_bf16(v1[2], v1[3]);
                    *(u32x4*)(rowp + bj * 128) = w; }
            }
    }
};
struct EpiAB {
    static constexpr bool PERM = true;
    bf16_t* tmp; bf16_t* merged; const bf16_t* gex; const float* out; int pairmode;
    __device__ __forceinline__ bool keep(const Unit& u) const { return pairmode && u.w == 0; }
    __device__ __forceinline__ void operator()(f32x4 (&acc)[2][2][4][2], const Unit& u, int wr, int wc, int fr, int fq) const {
        const int row0 = u.pm * 256 + wr * 64 + fr, col0 = u.pn * 256 + wc * 32 + 8 * fq;
#pragma unroll
        for (int ai = 0; ai < 2; ++ai)
#pragma unroll
            for (int m = 0; m < 4; ++m) {
                const int grow = row0 + ai * 128 + m * 16;
                const bf16_t* g0 = (grow < XROWS) ? (const bf16_t*)(out + O_YP + (size_t)grow * D) : (gex + (size_t)(grow - XROWS) * 2048);
#pragma unroll
                for (int bj = 0; bj < 2; ++bj) {
                    const int c = col0 + bj * 128;
                    if (pairmode) {
                        float gb[8]; unpack8(*(const u32x4*)(g0 + D + c), gb);
                        float eb[8];
#pragma unroll
                        for (int e = 0; e < 8; ++e) eb[e] = 1.f + fminf(__expf(-gb[e]), 1e18f);
                        if (u.w == 0) {
                            float ga[8]; unpack8(*(const u32x4*)(g0 + c), ga);
#pragma unroll
                            for (int e = 0; e < 4; ++e) { acc[ai][bj][m][0][e] *= sigm(ga[e]) * eb[e]; acc[ai][bj][m][1][e] *= sigm(ga[4 + e]) * eb[4 + e]; }
                        } else {
                            float v[8];
#pragma unroll
                            for (int e = 0; e < 4; ++e) { v[e] = acc[ai][bj][m][0][e] * __builtin_amdgcn_rcpf(eb[e]); v[4 + e] = acc[ai][bj][m][1][e] * __builtin_amdgcn_rcpf(eb[4 + e]); }
                            *(u32x4*)(merged + (size_t)grow * D + c) = pack8(v);
                        }
                    } else {
                        float g[8]; unpack8(*(const u32x4*)(g0 + u.w * D + c), g);
                        const f32x4 v0 = acc[ai][bj][m][0], v1 = acc[ai][bj][m][1];
                        float v[8] = {v0[0] * sigm(g[0]), v0[1] * sigm(g[1]), v0[2] * sigm(g[2]), v0[3] * sigm(g[3]), v1[0] * sigm(g[4]), v1[1] * sigm(g[5]), v1[2] * sigm(g[6]), v1[3] * sigm(g[7])};
                        bf16_t* tp = tmp + (size_t)grow * D + c;
                        if (u.w == 0) *(u32x4*)tp = pack8(v);
                        else { float t[8]; unpack8(*(const u32x4*)tp, t);
#pragma unroll
                            for (int e = 0; e < 8; ++e) v[e] += t[e];
                            *(u32x4*)(merged + (size_t)grow * D + c) = pack8(v); }
                    }
                }
            }
    }
};
struct EpiO {
    static constexpr bool PERM = true;
    float* out; const float* xp; const float* xs;
    __device__ __forceinline__ bool keep(const Unit&) const { return false; }
    __device__ __forceinline__ void operator()(const f32x4 (&acc)[2][2][4][2], const Unit& u, int wr, int wc, int fr, int fq) const {
        const int row0 = u.pm * 256 + wr * 64 + fr, col0 = u.pn * 256 + wc * 32 + 8 * fq;
#pragma unroll
        for (int ai = 0; ai < 2; ++ai)
#pragma unroll
            for (int m = 0; m < 4; ++m) {
                const int grow = row0 + ai * 128 + m * 16;
                const float* xr; float* yr;
                if (grow < XROWS) { xr = xp + (size_t)grow * D; yr = out + O_YP + (size_t)grow * D; }
                else { const int e = grow - XROWS; if (e < EX_SAMP || e >= EX_SHIFT) continue; xr = xs + (size_t)(e - EX_SAMP) * D; yr = out + O_YS + (size_t)(e - EX_SAMP) * D; }
                bf16_t* yb = (bf16_t*)yr;
#pragma unroll
                for (int bj = 0; bj < 2; ++bj) { const int c = col0 + bj * 128;
                    const f32x4 v0 = *(const f32x4*)(xr + c) + acc[ai][bj][m][0], v1 = *(const f32x4*)(xr + c + 4) + acc[ai][bj][m][1];
                    *(u32x4*)(yb + c) = (u32x4){pk2(v0[0], v0[1]), pk2(v0[2], v0[3]), pk2(v1[0], v1[1]), pk2(v1[2], v1[3])}; }
            }
    }
};

__device__ __forceinline__ void p0_row(const Params& p, int r, int lane) {
    bf16_t* hrow = (bf16_t*)(p.ws + WS_H) + (size_t)r * D;
    const float* src = nullptr; bool norm = true; float* sh = nullptr;
    if (r < XROWS) { src = p.in[0] + (size_t)r * D; if ((r & (SEQ - 1)) == SEQ - 1) sh = p.out + O_SHIFT_P + (size_t)(r / SEQ) * D; }
    else { const int e = r - XROWS;
        if (e < EX_SAMP) src = p.in[6] + (size_t)e * D;
        else if (e < EX_SHIFT) { src = p.in[1] + (size_t)(e - EX_SAMP) * D; if (((e - EX_SAMP) & 3) == 3) sh = p.out + O_SHIFT_S + (size_t)((e - EX_SAMP) >> 2) * D; }
        else if (e < EX_END) { src = p.in[5] + (size_t)(e - EX_SHIFT) * D; norm = false; } }
    u32x2* o8 = (u32x2*)hrow + lane;
    if (!src) {
#pragma unroll
        for (int j = 0; j < 4; ++j) o8[64 * j] = (u32x2){0u, 0u};
        return; }
    const f32x4* xr = (const f32x4*)src + lane;
    f32x4 v[4]; float ss = 0.f;
#pragma unroll
    for (int j = 0; j < 4; ++j) { v[j] = xr[64 * j]; ss += v[j][0] * v[j][0] + v[j][1] * v[j][1] + v[j][2] * v[j][2] + v[j][3] * v[j][3]; }
    if (norm) {
        const float rs = __builtin_amdgcn_rsqf(wave_sum(ss) * (1.f / D) + 1e-6f);
        const f32x4* wr = (const f32x4*)p.in[7] + lane;
#pragma unroll
        for (int j = 0; j < 4; ++j) v[j] = v[j] * rs * wr[64 * j];
    }
#pragma unroll
    for (int j = 0; j < 4; ++j) { o8[64 * j] = (u32x2){pk2(v[j][0], v[j][1]), pk2(v[j][2], v[j][3])}; if (sh) ((f32x4*)sh)[lane + 64 * j] = v[j]; }
}
template <int MODE> __device__ __forceinline__ void p0_tr_item(const float* W, int N, bf16_t* WT, float* scr, int kb, int nb, int lane) {
    const int k0 = 64 * kb, n0 = 32 * nb;
    const int l8 = lane & 7, r8 = lane >> 3;
    const int nn = n0 + 4 * l8;
    int srcc = nn;
    if (MODE == 1) srcc = nn < C_GATE_REF ? nn : (nn < NPB ? -1 : nn - (NPB - C_GATE_REF));
    f32x4 v[8];
#pragma unroll
    for (int i = 0; i < 8; ++i) { const int kk = 8 * i + r8; v[i] = srcc >= 0 ? *(const f32x4*)(W + (size_t)(k0 + kk) * N + srcc) : (f32x4){0.f, 0.f, 0.f, 0.f}; }
#pragma unroll
    for (int i = 0; i < 8; ++i) { const int kk = 8 * i + r8; float* d = scr + kk * 33 + 4 * l8; d[0] = v[i][0]; d[1] = v[i][1]; d[2] = v[i][2]; d[3] = v[i][3]; }
    asm volatile("s_waitcnt lgkmcnt(0)" ::: "memory");
    const int c = lane & 7;
#pragma unroll
    for (int j = 0; j < 4; ++j) { const int n = (lane >> 3) + 8 * j; const float* s = scr + (8 * c) * 33 + n;
        u32x4 o; o.x = pk2(s[0 * 33], s[1 * 33]); o.y = pk2(s[2 * 33], s[3 * 33]); o.z = pk2(s[4 * 33], s[5 * 33]); o.w = pk2(s[6 * 33], s[7 * 33]);
        *(u32x4*)(WT + (size_t)(n0 + n) * D + k0 + 8 * c) = o; }
    asm volatile("s_waitcnt lgkmcnt(0)" ::: "memory");
}
__device__ __forceinline__ void h_rows_pair(const Params& p, int r, int r1, bool has1, int lane, const f32x4 (&wv)[4]) {
    const f32x4* x0 = (const f32x4*)(p.in[0] + (size_t)r * D) + lane; const f32x4* x1 = (const f32x4*)(p.in[0] + (size_t)(has1 ? r1 : r) * D) + lane;
    f32x4 a[4], b[4]; float s0 = 0.f, s1 = 0.f;
#pragma unroll
    for (int j = 0; j < 4; ++j) { a[j] = x0[64 * j]; b[j] = x1[64 * j]; }
#pragma unroll
    for (int j = 0; j < 4; ++j) { s0 += a[j][0] * a[j][0] + a[j][1] * a[j][1] + a[j][2] * a[j][2] + a[j][3] * a[j][3]; s1 += b[j][0] * b[j][0] + b[j][1] * b[j][1] + b[j][2] * b[j][2] + b[j][3] * b[j][3]; }
    const float q0 = __builtin_amdgcn_rsqf(wave_sum(s0) * (1.f / D) + 1e-6f), q1 = __builtin_amdgcn_rsqf(wave_sum(s1) * (1.f / D) + 1e-6f);
    u32x2* o0 = (u32x2*)((bf16_t*)(p.ws + WS_H) + (size_t)r * D) + lane; u32x2* o1 = (u32x2*)((bf16_t*)(p.ws + WS_H) + (size_t)r1 * D) + lane;
#pragma unroll
    for (int j = 0; j < 4; ++j) { a[j] = a[j] * q0 * wv[j]; o0[64 * j] = (u32x2){pk2(a[j][0], a[j][1]), pk2(a[j][2], a[j][3])}; }
    if ((r & (SEQ - 1)) == SEQ - 1) { f32x4* sh = (f32x4*)(p.out + O_SHIFT_P + (size_t)(r / SEQ) * D) + lane;
#pragma unroll
        for (int j = 0; j < 4; ++j) sh[64 * j] = a[j]; }
    if (has1) {
#pragma unroll
        for (int j = 0; j < 4; ++j) { b[j] = b[j] * q1 * wv[j]; o1[64 * j] = (u32x2){pk2(b[j][0], b[j][1]), pk2(b[j][2], b[j][3])}; }
        if ((r1 & (SEQ - 1)) == SEQ - 1) { f32x4* sh = (f32x4*)(p.out + O_SHIFT_P + (size_t)(r1 / SEQ) * D) + lane;
#pragma unroll
            for (int j = 0; j < 4; ++j) sh[64 * j] = b[j]; }
    }
}
__device__ __forceinline__ void h_rows_segs(const Params& p, int s_lo, int s_hi, int wi, int nw, int lane) {
    const f32x4* lw = (const f32x4*)p.in[7] + lane;
    f32x4 wv[4];
#pragma unroll
    for (int j = 0; j < 4; ++j) wv[j] = lw[64 * j];
    const int n = (s_hi - s_lo) * NBATCH * SEGTOK;
#pragma unroll 1
    for (int x = wi; x < n; x += 2 * nw) {
        const int x1 = x + nw; const bool has1 = x1 < n;
        const int sg = s_lo + x / (NBATCH * SEGTOK), rem = x % (NBATCH * SEGTOK), r = (rem / SEGTOK) * SEQ + sg * SEGTOK + (rem % SEGTOK);
        const int xx = has1 ? x1 : x; const int sg1 = s_lo + xx / (NBATCH * SEGTOK), rem1 = xx % (NBATCH * SEGTOK), r1 = (rem1 / SEGTOK) * SEQ + sg1 * SEGTOK + (rem1 % SEGTOK);
        h_rows_pair(p, r, r1, has1, lane, wv);
    }
}
__device__ __forceinline__ void phase0(const Params& p, unsigned char* smem) {
    const int tid0 = otid(), wave = tid0 >> 6, lane = tid0 & 63;
    const int gw = obid() * 8 + wave, NGW = gridDim.x * 8;
    float* scr = (float*)smem + wave * (64 * 33);
    constexpr int I_IN = 16 * (NP / 32), I_SQ = 16 * 32;
    for (int it = gw; it < I_IN + 3 * I_SQ; it += NGW) {
        int r = it;
        if (r < I_IN) { p0_tr_item<1>(p.in[8], 10384, (bf16_t*)(p.ws + WS_WT_IN), scr, r / (NP / 32), r % (NP / 32), lane); continue; } r -= I_IN;
        if (r < I_SQ) { p0_tr_item<0>(p.in[13], D, (bf16_t*)(p.ws + WS_WT_A), scr, r / 32, r % 32, lane); continue; } r -= I_SQ;
        if (r < I_SQ) { p0_tr_item<0>(p.in[24], D, (bf16_t*)(p.ws + WS_WT_B), scr, r / 32, r % 32, lane); continue; } r -= I_SQ;
        p0_tr_item<0>(p.in[25], D, (bf16_t*)(p.ws + WS_WT_O), scr, r / 32, r % 32, lane);
    }
    h_rows_segs(p, 0, 2, gw, NGW, lane);
    for (int r = XROWS + gw; r < HROWS; r += NGW) p0_row(p, r, lane);
    {
        float* pk = (float*)(p.ws + WS_PK);
        const int gt = obid() * 512 + tid0, NT = gridDim.x * 512;
        for (int i = gt; i < PK_END; i += NT) {
            const float* src; int o;
            if (i < PK_ALOG) { src = p.in[9]; o = i - PK_CONVW; } else if (i < PK_DTB) { src = p.in[10]; o = i - PK_ALOG; } else if (i < PK_NORMW) { src = p.in[11]; o = i - PK_DTB; }
            else if (i < PK_MU) { src = p.in[12]; o = i - PK_NORMW; } else if (i < PK_W0) { src = p.in[14]; o = i - PK_MU; } else if (i < PK_W2) { src = p.in[15]; o = i - PK_W0; }
            else if (i < PK_A0) { src = p.in[16]; o = i - PK_W2; } else if (i < PK_A2) { src = p.in[17]; o = i - PK_A0; } else if (i < PK_KK) { src = p.in[18]; o = i - PK_A2; }
            else if (i < PK_KA) { src = p.in[19]; o = i - PK_KK; } else if (i < PK_RK) { src = p.in[20]; o = i - PK_KA; } else if (i < PK_GNW) { src = p.in[21]; o = i - PK_RK; }
            else if (i < PK_GNB) { src = p.in[22]; o = i - PK_GNW; } else if (i < PK_LNF) { src = p.in[23]; o = i - PK_GNB; } else { src = p.in[26]; o = i - PK_LNF; }
            pk[i] = src[o];
        }
        bf16_t* w2t = (bf16_t*)(p.ws + WS_W2T); bf16_t* a2t = (bf16_t*)(p.ws + WS_A2T);
        for (int i = gt; i < 65536; i += NT) { const int l = i & 63, c = (i >> 6) & 63, hb = i >> 12;
            w2t[i] = (bf16_t)f2bf(p.in[16][(size_t)l * D + hb * 64 + c]); a2t[i] = (bf16_t)f2bf(p.in[18][(size_t)l * D + hb * 64 + c]); }
    }
}

__device__ __forceinline__ void gdn_item(const Params& p, unsigned char* smem, const float* s_in, float* s_out, const float* halo_in, float* halo_out,
                                         int h, int sl, int rowA, int nA, int rowB, int nB) {
    const int tid = otid(), w = tid >> 6, lane = tid & 63, vl = lane >> 4, kg = lane & 15;
    float* qk_s = (float*)smem; float* v_s = qk_s + 16384; float* o_s = v_s + 2048; float* gb_s = o_s + 2048; float* sst = gb_s + 128;
    const bf16_t* P = (const bf16_t*)(p.ws + WS_P);
    float* ORAW = (float*)(p.ws + WS_ORAW);
    float s[8];
    if (s_in) {
        { const int k = tid >> 2, q4 = tid & 3; const f32x4* src = (const f32x4*)(s_in + (size_t)k * 128 + sl * 32 + q4 * 8); const f32x4 a = src[0], b = src[1];
          float* d = sst + k * 33 + q4 * 8; d[0] = a[0]; d[1] = a[1]; d[2] = a[2]; d[3] = a[3]; d[4] = b[0]; d[5] = b[1]; d[6] = b[2]; d[7] = b[3]; }
        __syncthreads();
#pragma unroll
        for (int j = 0; j < 8; ++j) s[j] = sst[(kg * 8 + j) * 33 + 4 * w + vl];
        __syncthreads();
    } else {
#pragma unroll
        for (int j = 0; j < 8; ++j) s[j] = 0.f;
    }
    int pcol = -1;
    if (tid < 128) pcol = h * 128 + tid; else if (tid < 256) pcol = 1024 + h * 128 + (tid - 128); else if (tid < 288) pcol = 2048 + h * 128 + sl * 32 + (tid - 256);
    float cw0 = 0.f, cw1 = 0.f, cw2 = 0.f, cw3 = 0.f, x1 = 0.f, x2 = 0.f, x3 = 0.f;
    const float* pk = (const float*)(p.ws + WS_PK);
    if (pcol >= 0) { const float* cw = pk + PK_CONVW; cw0 = cw[pcol]; cw1 = cw[3072 + pcol]; cw2 = cw[6144 + pcol]; cw3 = cw[9216 + pcol];
        if (halo_in) { x3 = halo_in[pcol]; x2 = halo_in[3072 + pcol]; x1 = halo_in[6144 + pcol]; } }
    const float nalog = -expf(pk[PK_ALOG + h]), dtb = pk[PK_DTB + h];
#pragma unroll 1
    for (int run = 0; run < 2; ++run) {
        const int rrow = run ? rowB : rowA, rn = run ? nB : nA; const bool wout = run != 0;
#pragma unroll 1
        for (int c0 = 0; c0 < rn; c0 += 64) {
            const int nt = (rn - c0) < 64 ? (rn - c0) : 64; const int row = rrow + c0;
            if (pcol >= 0) {
                const bf16_t* src = P + (size_t)row * NPB + pcol;
                float* dst = tid < 256 ? (qk_s + tid) : (v_s + (tid - 256)); const int dstride = tid < 256 ? 256 : 32;
#pragma unroll 8
                for (int i = 0; i < nt; ++i) { const float x0 = bf2f(src[(size_t)i * NPB]); const float y = cw0 * x3 + cw1 * x2 + cw2 * x1 + cw3 * x0; x3 = x2; x2 = x1; x1 = x0; dst[i * dstride] = silu_(y); }
            } else if (tid < 352) {
                const int i = tid - 288;
                if (i < nt) { const float pa = bf2f(P[(size_t)(row + i) * NPB + C_A + h]), pb = bf2f(P[(size_t)(row + i) * NPB + C_B + h]);
                    gb_s[2 * i] = expf(nalog * softplus_(pa + dtb)); gb_s[2 * i + 1] = sigm(pb); }
            }
            __syncthreads();
#pragma unroll 1
            for (int ii = 0; ii < 8; ++ii) { const int i = w * 8 + ii;
                if (i < nt) {
#pragma unroll
                    for (int which = 0; which < 2; ++which) { float* rp = qk_s + i * 256 + which * 128; const float a = rp[lane], b = rp[lane + 64];
                        const float sc = __builtin_amdgcn_rsqf(wave_sum(a * a + b * b) + 1e-6f) * (which == 0 ? 0.08838834764831845f : 1.f); rp[lane] = a * sc; rp[lane + 64] = b * sc; } } }
            __syncthreads();
#pragma unroll 1
            for (int i = 0; i < nt; ++i) {
                const f32x4 q0 = *(const f32x4*)(qk_s + i * 256 + kg * 8), q1 = *(const f32x4*)(qk_s + i * 256 + kg * 8 + 4);
                const f32x4 k0 = *(const f32x4*)(qk_s + i * 256 + 128 + kg * 8), k1 = *(const f32x4*)(qk_s + i * 256 + 128 + kg * 8 + 4);
                const float vv = v_s[i * 32 + 4 * w + vl], a = gb_s[2 * i], be = gb_s[2 * i + 1];
                float part = k0[0] * s[0] + k0[1] * s[1] + k0[2] * s[2] + k0[3] * s[3] + k1[0] * s[4] + k1[1] * s[5] + k1[2] * s[6] + k1[3] * s[7];
                const float kS = rowsum16(part);
                const float c = be * (vv - a * kS);
                s[0] = a * s[0] + k0[0] * c; s[1] = a * s[1] + k0[1] * c; s[2] = a * s[2] + k0[2] * c; s[3] = a * s[3] + k0[3] * c;
                s[4] = a * s[4] + k1[0] * c; s[5] = a * s[5] + k1[1] * c; s[6] = a * s[6] + k1[2] * c; s[7] = a * s[7] + k1[3] * c;
                float op = q0[0] * s[0] + q0[1] * s[1] + q0[2] * s[2] + q0[3] * s[3] + q1[0] * s[4] + q1[1] * s[5] + q1[2] * s[6] + q1[3] * s[7];
                const float o = rowsum16(op);
                if (kg == 0) o_s[i * 32 + 4 * w + vl] = o;
            }
            __syncthreads();
            if (wout) { const int i = tid >> 3, c4 = (tid & 7) * 4; if (i < nt) *(f32x4*)(ORAW + (size_t)(row + i) * D + h * 128 + sl * 32 + c4) = *(const f32x4*)(o_s + i * 32 + c4); }
        }
    }
    if (pcol >= 0 && (sl == 0 || tid >= 256)) { halo_out[pcol] = x3; halo_out[3072 + pcol] = x2; halo_out[6144 + pcol] = x1; }
#pragma unroll
    for (int j = 0; j < 8; ++j) sst[(kg * 8 + j) * 33 + 4 * w + vl] = s[j];
    __syncthreads();
    { const int k = tid >> 2, q4 = tid & 3; const float* d = sst + k * 33 + q4 * 8; f32x4* dst = (f32x4*)(s_out + (size_t)k * 128 + sl * 32 + q4 * 8);
      dst[0] = (f32x4){d[0], d[1], d[2], d[3]}; dst[1] = (f32x4){d[4], d[5], d[6], d[7]}; }
    __syncthreads();
}

constexpr int RW_W2 = 20544, RW_A2 = 24640;
__device__ __forceinline__ void rwkv_load_lora(const Params& p, unsigned char* smem, int hb) {
    float* w2_s = (float*)smem + RW_W2; float* a2_s = (float*)smem + RW_A2; const float* pk = (const float*)(p.ws + WS_PK);
    for (int i = otid(); i < 4096; i += 512) { const int l = i >> 6, c = i & 63; w2_s[i] = pk[PK_W2 + l * D + hb * 64 + c]; a2_s[i] = pk[PK_A2 + l * D + hb * 64 + c]; }
    __syncthreads();
}
__device__ __forceinline__ void rwkv_item(const Params& p, unsigned char* smem, const float* s_in, float* s_out, const bf16_t* prev_row, const float* halo_in, float* halo_out,
                                          int hb, int half, int rowA, int nA, int rowB, int nB) {
    const int tid = otid(), w = tid >> 6, lane = tid & 63, row = tid >> 4, kq = tid & 15;
    float* f = (float*)smem;
    float* r_s = f; float* kb_s = f + 2048; float* v_s = f + 4096; float* wd_s = f + 6144; float* ad_s = f + 8192; float* dec_s = f + 10240; float* a_s = f + 12288;
    float* kk_s = f + 14336; float* km_s = f + 16384; float* zb_s = f + 18432; float* y_s = f + 19456; float* bonus_s = f + 20480;
    const float* w2_s = f + RW_W2; const float* a2_s = f + RW_A2;
    const bf16_t* P = (const bf16_t*)(p.ws + WS_P);
    float* YRAW = (float*)(p.ws + WS_YRAW); bf16_t* C0 = (bf16_t*)(p.ws + WS_C0); bf16_t* C1 = (bf16_t*)(p.ws + WS_C1);
    float s[4];
    if (s_in) { const f32x4 t = *(const f32x4*)(s_in + (size_t)(half * 32 + row) * 64 + kq * 4); s[0] = t[0]; s[1] = t[1]; s[2] = t[2]; s[3] = t[3]; }
    else { s[0] = s[1] = s[2] = s[3] = 0.f; }
    int col = -1; float* dst = nullptr; int dstride = 64; bool is_wd = false, owner = false;
    if (tid < 64) { col = hb * 64 + tid; dst = r_s + tid; owner = half == 0; }
    else if (tid < 128) { col = 1024 + hb * 64 + (tid - 64); dst = kb_s + (tid - 64); owner = half == 0; }
    else if (tid < 192) { col = 2048 + hb * 64 + (tid - 128); dst = v_s + (tid - 128); owner = half == 0; }
    else if (tid < 256) { col = 3072 + (tid - 192); dst = wd_s + (tid - 192); is_wd = true; owner = (half == 0 && hb == 0); }
    else if (tid < 320) { col = 3136 + (tid - 256); dst = ad_s + (tid - 256); owner = (half == 0 && hb == 0); }
    else if (tid < 352) { col = 3200 + hb * 64 + half * 32 + (tid - 320); dst = zb_s + (tid - 320); dstride = 32; owner = true; }
    float mu = 0.f, prev = 0.f;
    const float* pk = (const float*)(p.ws + WS_PK);
    if (col >= 0) { mu = pk[PK_MU + col]; prev = prev_row ? bf2f(prev_row[C_RW + col]) : (halo_in ? halo_in[col] : 0.f); }
    const int cc = tid & 63, ig = tid >> 6;
    const int hc = hb * 64 + cc;
    const float w0c = pk[PK_W0 + hc], a0c = pk[PK_A0 + hc], kkc = pk[PK_KK + hc], kac = pk[PK_KA + hc];
    const float rkl = pk[PK_RK + hb * 64 + lane];
#pragma unroll 1
    for (int run = 0; run < 2; ++run) {
        const int rrow = run ? rowB : rowA, rn = run ? nB : nA; const bool wout = run != 0;
#pragma unroll 1
        for (int c0 = 0; c0 < rn; c0 += 32) {
            const int nt = (rn - c0) < 32 ? (rn - c0) : 32; const int row0 = rrow + c0;
            if (col >= 0) {
                const bf16_t* src = P + (size_t)row0 * NPB + C_RW + col;
#pragma unroll 8
                for (int i = 0; i < nt; ++i) { const float cur = bf2f(src[(size_t)i * NPB]); float m = cur + mu * (prev - cur); prev = cur; if (is_wd) m = tanh_(m); dst[i * dstride] = m; }
            }
            __syncthreads();
            {
                float aw[4] = {0.f, 0.f, 0.f, 0.f}, aa[4] = {0.f, 0.f, 0.f, 0.f};
#pragma unroll 4
                for (int l = 0; l < 64; ++l) { const float w2v = w2_s[l * 64 + cc], a2v = a2_s[l * 64 + cc];
#pragma unroll
                    for (int ii = 0; ii < 4; ++ii) { aw[ii] += wd_s[(ig * 4 + ii) * 64 + l] * w2v; aa[ii] += ad_s[(ig * 4 + ii) * 64 + l] * a2v; } }
#pragma unroll
                for (int ii = 0; ii < 4; ++ii) { const int i = ig * 4 + ii;
                    if (i < nt) { const float wraw = w0c + aw[ii]; const float wlog = -0.6065306597126334f * sigm(wraw); const float a = sigm(a0c + aa[ii]);
                        const float kbv = kb_s[i * 64 + cc];
                        dec_s[i * 64 + cc] = expf(wlog); a_s[i * 64 + cc] = a; kk_s[i * 64 + cc] = kbv * kkc; km_s[i * 64 + cc] = kbv * (1.f + (a - 1.f) * kac); } }
            }
            __syncthreads();
#pragma unroll 1
            for (int ii = 0; ii < 4; ++ii) { const int i = w * 4 + ii;
                if (i < nt) { const float kkr = kk_s[i * 64 + lane]; const float kk = kkr * __builtin_amdgcn_rsqf(wave_sum(kkr * kkr) + 1e-6f); kk_s[i * 64 + lane] = kk;
                    const float a = a_s[i * 64 + lane]; a_s[i * 64 + lane] = kk * a;
                    const float rk = wave_sum(r_s[i * 64 + lane] * km_s[i * 64 + lane] * rkl); if (lane == 0) bonus_s[i] = rk; } }
            __syncthreads();
#pragma unroll 1
            for (int i = 0; i < nt; ++i) {
                const f32x4 kk4 = *(const f32x4*)(kk_s + i * 64 + kq * 4), de4 = *(const f32x4*)(dec_s + i * 64 + kq * 4), ka4 = *(const f32x4*)(a_s + i * 64 + kq * 4),
                            km4 = *(const f32x4*)(km_s + i * 64 + kq * 4), r4 = *(const f32x4*)(r_s + i * 64 + kq * 4);
                const float vv = v_s[i * 64 + half * 32 + row];
                const float sa = rowsum16(s[0] * kk4[0] + s[1] * kk4[1] + s[2] * kk4[2] + s[3] * kk4[3]);
#pragma unroll
                for (int j = 0; j < 4; ++j) s[j] = s[j] * de4[j] + (vv * km4[j] - sa * ka4[j]);
                const float y = rowsum16(s[0] * r4[0] + s[1] * r4[1] + s[2] * r4[2] + s[3] * r4[3]);
                if (kq == 0) y_s[i * 32 + row] = y;
            }
            __syncthreads();
            if (wout) { const int i = tid >> 4;
                if (i < nt) {
#pragma unroll
                    for (int q = 0; q < 2; ++q) { const int rr = (tid & 15) * 2 + q, v = half * 32 + rr, colo = hb * 64 + v;
                        const float sz = silu_(zb_s[i * 32 + rr]);
                        const size_t o = (size_t)(row0 + i) * D + colo;
                        YRAW[o] = y_s[i * 32 + rr]; C1[o] = (bf16_t)f2bf(pk[PK_GNW + colo] * sz); C0[o] = (bf16_t)f2bf((pk[PK_GNB + colo] + bonus_s[i] * v_s[i * 64 + v]) * sz); } } }
            __syncthreads();
        }
    }
    *(f32x4*)(s_out + (size_t)(half * 32 + row) * 64 + kq * 4) = (f32x4){s[0], s[1], s[2], s[3]};
    if (col >= 0 && owner && halo_out) halo_out[col] = prev;
}


__device__ __forceinline__ bf16x8 ldfrag(const bf16_t* base, int stride, int r0, int k0, int lane) {
    return *(const bf16x8*)(base + (r0 + (lane & 15)) * stride + k0 + 8 * (lane >> 4));
}
#define MFMA16(a, b, c) __builtin_amdgcn_mfma_f32_16x16x32_bf16((a), (b), (c), 0, 0, 0)
typedef short s16x4 __attribute__((ext_vector_type(4)));
__device__ __forceinline__ bf16x8 ldfrag_tr(const bf16_t* X, int stride, int c0, int k0, int lane) {
    const int l15 = lane & 15;
    const bf16_t* a = X + (k0 + 8 * (lane >> 4) + (l15 >> 2)) * stride + c0 + 4 * (l15 & 3);
    const s16x4 lo = __builtin_amdgcn_ds_read_tr16_b64_v4i16((LAS s16x4*)a), hi = __builtin_amdgcn_ds_read_tr16_b64_v4i16((LAS s16x4*)(a + 4 * stride));
    return __builtin_shufflevector(lo, hi, 0, 1, 2, 3, 4, 5, 6, 7);
}
__device__ __forceinline__ void inv_block(const float* L, float* Tm, float* XS, int tid) {
    const int w = tid >> 6, lane = tid & 63;
    typedef float f32x2v __attribute__((ext_vector_type(2)));
    if (w < 4 && lane < 16) {
        const float* Lb = L + (16 * w) * 64 + 16 * w; float* Tb = Tm + (16 * w) * 64 + 16 * w;
        float tr[16];
#pragma unroll
        for (int i = 0; i < 16; ++i) tr[i] = 0.f;
#pragma unroll
        for (int i = 0; i < 16; ++i) { float a = (lane == i) ? 1.f : 0.f;
#pragma unroll
            for (int j0 = 0; j0 < i; j0 += 4) { const f32x4 l4 = *(const f32x4*)(Lb + i * 64 + j0);
                a -= l4[0] * tr[j0] + l4[1] * tr[j0 + 1] + l4[2] * tr[j0 + 2] + l4[3] * tr[j0 + 3]; }
            tr[i] = a; Tb[i * 64 + lane] = a; }
    }
    for (int e = tid; e < 1536; e += 512) { const int k = e >> 8, r = (e >> 4) & 15, c = e & 15;
        const int rb = k < 3 ? 0 : (k < 5 ? 1 : 2), cb = k < 3 ? k + 1 : (k < 5 ? k - 1 : 3);
        Tm[(16 * rb + r) * 64 + 16 * cb + c] = 0.f; }
    __syncthreads();
    {
        const int B = tid >> 8, i = (tid >> 4) & 15, c = tid & 15, o = 32 * B;
        float x = 0.f;
#pragma unroll
        for (int j0 = 0; j0 < 16; j0 += 4) { const f32x4 l4 = *(const f32x4*)(L + (o + 16 + i) * 64 + o + j0);
            x += l4[0] * Tm[(o + j0) * 64 + o + c] + l4[1] * Tm[(o + j0 + 1) * 64 + o + c] + l4[2] * Tm[(o + j0 + 2) * 64 + o + c] + l4[3] * Tm[(o + j0 + 3) * 64 + o + c]; }
        XS[tid] = x;
        __syncthreads();
        float t = 0.f;
#pragma unroll
        for (int j0 = 0; j0 < 16; j0 += 4) { const f32x4 t4 = *(const f32x4*)(Tm + (o + 16 + i) * 64 + o + 16 + j0);
            t += t4[0] * XS[(B << 8) + j0 * 16 + c] + t4[1] * XS[(B << 8) + (j0 + 1) * 16 + c] + t4[2] * XS[(B << 8) + (j0 + 2) * 16 + c] + t4[3] * XS[(B << 8) + (j0 + 3) * 16 + c]; }
        Tm[(o + 16 + i) * 64 + o + c] = -t;
    }
    __syncthreads();
    {
        const int i = tid >> 4, c2 = (tid & 15) * 2;
        float x0 = 0.f, x1 = 0.f;
#pragma unroll
        for (int j0 = 0; j0 < 32; j0 += 4) { const f32x4 l4 = *(const f32x4*)(L + (32 + i) * 64 + j0);
#pragma unroll
            for (int e = 0; e < 4; ++e) { const f32x2v tv = *(const f32x2v*)(Tm + (j0 + e) * 64 + c2); x0 += l4[e] * tv[0]; x1 += l4[e] * tv[1]; } }
        *(f32x2v*)(XS + i * 32 + c2) = (f32x2v){x0, x1};
        __syncthreads();
        float t0 = 0.f, t1 = 0.f;
#pragma unroll
        for (int j0 = 0; j0 < 32; j0 += 4) { const f32x4 t4 = *(const f32x4*)(Tm + (32 + i) * 64 + 32 + j0);
#pragma unroll
            for (int e = 0; e < 4; ++e) { const f32x2v xv = *(const f32x2v*)(XS + (j0 + e) * 32 + c2); t0 += t4[e] * xv[0]; t1 += t4[e] * xv[1]; } }
        *(f32x2v*)(Tm + (32 + i) * 64 + c2) = (f32x2v){-t0, -t1};
    }
    __syncthreads();
}
constexpr int PL_QS = 0, PL_R1 = 17408, PL_KT = 35840, PL_KTT = 54272, PL_VT = 72704, PL_R3 = 91136, PL_QKM = 109568, PL_TP = 118784, PL_TPP = 128000, PL_SM = 137216, PL_TM = 139264, PL_XS = 155648;
constexpr int QSTR = 136, TSTR = 72;

__device__ __forceinline__ void gdn_prep_item(const Params& p, unsigned char* smem, int h, int row_start, int npad, const bf16_t* hbase,
                                              bf16_t* halo_out, float* conv_out, unsigned char* rec) {
    const int tid = otid(), w = tid >> 6, lane = tid & 63, q4 = lane >> 4, l15 = lane & 15;
    bf16_t* qs = (bf16_t*)(smem + PL_QS); bf16_t* ks = (bf16_t*)(smem + PL_R1); bf16_t* WT = (bf16_t*)(smem + PL_KTT);     bf16_t* kts = (bf16_t*)(smem + PL_KT);
    bf16_t* vs = (bf16_t*)(smem + PL_VT);         float* Lm = (float*)(smem + PL_R3); bf16_t* UT = (bf16_t*)(smem + PL_R3); bf16_t* QKm = (bf16_t*)(smem + PL_QKM);
    bf16_t* Tp = (bf16_t*)(smem + PL_TP); bf16_t* Tpp = (bf16_t*)(smem + PL_TPP);
    float* sm = (float*)(smem + PL_SM);
    float* gcs = sm; float* bes = sm + 64; float* ssq = sm + 128; float* ssk = sm + 192; float* egs = sm + 256; float* egl_s = sm + 320; float* beg = sm + 384;
    const bf16_t* P = (const bf16_t*)(p.ws + WS_P);
    const float* pk = (const float*)(p.ws + WS_PK);
    if (w == 7) {
        const int i = lane;
        float g = 0.f, be = 0.f;
        if (i >= npad) { const size_t r = (size_t)(row_start + i - npad) * NPB; const float pa = bf2f(P[r + C_A + h]), pb = bf2f(P[r + C_B + h]);
            g = -expf(pk[PK_ALOG + h]) * softplus_(pa + pk[PK_DTB + h]); be = sigm(pb); }
        float x = g;
#pragma unroll
        for (int o = 1; o < 64; o <<= 1) { const float y = __shfl_up(x, o); if (lane >= o) x += y; }
        const float gl = __shfl(x, 63);
        gcs[lane] = x; bes[lane] = be; egs[lane] = __expf(x); egl_s[lane] = __expf(gl - x); beg[lane] = be * __expf(x);
        if (lane == 0) *(float*)(rec + GP_EGL) = __expf(gl);
    }
    __syncthreads();
    if (npad == 0 && tid >= 384) {
#pragma unroll 1
        for (int k = 0; k < 4; ++k) {
            const int slot = (tid - 384) + 128 * k, t = slot >> 3, g = slot & 7;
            const bf16_t* zp = P + (size_t)(row_start + t) * NPB + C_Z + h * 128 + 16 * g;
            const u32x4 z0 = *(const u32x4*)zp, z1 = *(const u32x4*)(zp + 8);
            float za[8], zb[8]; unpack8(z0, za); unpack8(z1, zb);
            const float* nwp = pk + PK_NORMW + 16 * g;
            float ga[8], gb2[8];
#pragma unroll
            for (int e = 0; e < 8; ++e) { ga[e] = nwp[e] * silu_(za[e]); gb2[e] = nwp[8 + e] * silu_(zb[e]); }
            bf16_t* gp = (bf16_t*)(rec + GP_G) + t * 128 + 16 * g;
            *(u32x4*)gp = pack8(ga); *(u32x4*)(gp + 8) = pack8(gb2);
        }
    }
    if (tid < 384) {
        const int sec = tid >> 7, ts = (tid >> 4) & 7, t0 = 8 * ts, d0 = l15 * 8;
        const int pcol = sec * 1024 + h * 128 + d0;
        float cw[4][8];
#pragma unroll
        for (int j = 0; j < 4; ++j) { const f32x4 a = *(const f32x4*)(pk + PK_CONVW + j * 3072 + pcol), b = *(const f32x4*)(pk + PK_CONVW + j * 3072 + pcol + 4);
            cw[j][0] = a[0]; cw[j][1] = a[1]; cw[j][2] = a[2]; cw[j][3] = a[3]; cw[j][4] = b[0]; cw[j][5] = b[1]; cw[j][6] = b[2]; cw[j][7] = b[3]; }
        u32x4 rw[11]; float fv[11];
#pragma unroll
        for (int k = 0; k < 11; ++k) {
            const int ii = t0 - 3 + k;
            const bf16_t* ptr = P + pcol; float f = 0.f;
            if (ii >= npad) { ptr = P + (size_t)(row_start + ii - npad) * NPB + pcol; f = 1.f; }
            else if (ii < 0 && npad == 0 && hbase) { ptr = hbase + (size_t)(ii + 3) * NPB + pcol; f = 1.f; }
            rw[k] = *(const u32x4*)ptr; fv[k] = f;
        }
        if (halo_out && ts == 7) {
#pragma unroll
            for (int dd = 0; dd < 3; ++dd) { *(u32x4*)(halo_out + (size_t)dd * NPB + pcol) = rw[8 + dd];
                if (conv_out) { float x[8]; unpack8(rw[8 + dd], x); *(f32x4*)(conv_out + dd * 3072 + pcol) = (f32x4){x[0], x[1], x[2], x[3]}; *(f32x4*)(conv_out + dd * 3072 + pcol + 4) = (f32x4){x[4], x[5], x[6], x[7]}; } }
        }
        float y[8][8];
#pragma unroll
        for (int t = 0; t < 8; ++t)
#pragma unroll
            for (int e = 0; e < 8; ++e) y[t][e] = 0.f;
#pragma unroll
        for (int k = 0; k < 11; ++k) { float x[8]; unpack8(rw[k], x);
#pragma unroll
            for (int e = 0; e < 8; ++e) x[e] *= fv[k];
#pragma unroll
            for (int dlt = 0; dlt < 4; ++dlt) { const int t = k - dlt;
                if (t >= 0 && t < 8) {
#pragma unroll
                    for (int e = 0; e < 8; ++e) y[t][e] += cw[dlt][e] * x[e]; } }
        }
        const float qsc = sec == 0 ? 0.08838834764831845f : 1.f;
#pragma unroll
        for (int t = 0; t < 8; ++t) {
            const bool tokv = (t0 + t) >= npad;
            float ss = 0.f;
#pragma unroll
            for (int e = 0; e < 8; ++e) { y[t][e] = tokv ? silu_(y[t][e]) : 0.f; ss += y[t][e] * y[t][e]; }
            if (sec < 2) { const float sc = __builtin_amdgcn_rsqf(rowsum16(ss) + 1e-6f) * qsc;
#pragma unroll
                for (int e = 0; e < 8; ++e) y[t][e] *= sc; }
        }
        { bf16_t* dst = sec == 0 ? qs : (sec == 1 ? ks : vs);
#pragma unroll
            for (int t = 0; t < 8; ++t) *(u32x4*)(dst + (t0 + t) * QSTR + d0) = pack8(y[t]); }
        if (sec == 1) {
#pragma unroll
            for (int t = 0; t < 8; ++t) { const float eg = egl_s[t0 + t]; float z[8];
#pragma unroll
                for (int e = 0; e < 8; ++e) z[e] = y[t][e] * eg;
                *(u32x4*)(kts + (t0 + t) * QSTR + d0) = pack8(z); } }
    }
    __syncthreads();
    {
        const int which = w >> 2, it = w & 3;
        const bf16_t* Barr = which ? qs : ks;
        bf16x8 bfr[4];
#pragma unroll
        for (int kk = 0; kk < 4; ++kk) bfr[kk] = ldfrag(Barr, QSTR, 16 * it, 32 * kk, lane);
        const int i = 16 * it + l15; const float gi = gcs[i], bi = bes[i];
#pragma unroll
        for (int jt = 0; jt < 4; ++jt) {
            f32x4 acc = {0.f, 0.f, 0.f, 0.f};
#pragma unroll
            for (int kk = 0; kk < 4; ++kk) acc = MFMA16(ldfrag(ks, QSTR, 16 * jt, 32 * kk, lane), bfr[kk], acc);
            const int j0 = 16 * jt + 4 * q4; const f32x4 gj = *(const f32x4*)(gcs + j0);
            f32x4 o;
#pragma unroll
            for (int r = 0; r < 4; ++r) { const int j = j0 + r; const bool keep = which ? (i >= j) : (i > j); o[r] = keep ? acc[r] * __expf(gi - gj[r]) : 0.f; }
            if (which == 0) *(f32x4*)(Lm + i * 64 + j0) = o * bi;
            else *(u32x2*)(QKm + i * TSTR + j0) = (u32x2){pk2(o[0], o[1]), pk2(o[2], o[3])};
        }
    }
    __syncthreads();
    {
        float* Tm = (float*)(smem + PL_TM);
        inv_block(Lm, Tm, (float*)(smem + PL_XS), tid);
        const int i = tid >> 3, j0 = (tid & 7) * 8;
        float a[8], b2[8];
#pragma unroll
        for (int e = 0; e < 8; ++e) { const float tv = Tm[i * 64 + j0 + e]; a[e] = tv * beg[j0 + e]; b2[e] = tv * bes[j0 + e]; }
        *(u32x4*)(Tp + i * TSTR + j0) = (u32x4){pk2(a[0], a[1]), pk2(a[2], a[3]), pk2(a[4], a[5]), pk2(a[6], a[7])};
        *(u32x4*)(Tpp + i * TSTR + j0) = (u32x4){pk2(b2[0], b2[1]), pk2(b2[2], b2[3]), pk2(b2[4], b2[5]), pk2(b2[6], b2[7])};
    }
    __syncthreads();
    {
        const int it = w & 3, half = w >> 2;
        f32x4 aw[4], au[4];
#pragma unroll
        for (int x = 0; x < 4; ++x) { aw[x] = (f32x4){0.f, 0.f, 0.f, 0.f}; au[x] = (f32x4){0.f, 0.f, 0.f, 0.f}; }
#pragma unroll
        for (int kk = 0; kk < 2; ++kk) {
            const bf16x8 a1 = ldfrag(Tp, TSTR, 16 * it, 32 * kk, lane), a2 = ldfrag(Tpp, TSTR, 16 * it, 32 * kk, lane);
#pragma unroll
            for (int x = 0; x < 4; ++x) { const int dt = half * 4 + x;
                aw[x] = MFMA16(a1, ldfrag_tr(ks, QSTR, 16 * dt, 32 * kk, lane), aw[x]);
                au[x] = MFMA16(a2, ldfrag_tr(vs, QSTR, 16 * dt, 32 * kk, lane), au[x]); }
        }
#pragma unroll
        for (int x = 0; x < 4; ++x) { const int d = 16 * (half * 4 + x) + l15, i0 = 16 * it + 4 * q4;
            *(u32x2*)(WT + d * TSTR + i0) = (u32x2){pk2(aw[x][0], aw[x][1]), pk2(aw[x][2], aw[x][3])};
            *(u32x2*)(UT + d * TSTR + i0) = (u32x2){pk2(au[x][0], au[x][1]), pk2(au[x][2], au[x][3])}; }
    }
    __syncthreads();
    {
        bf16_t* gAP = (bf16_t*)(rec + GP_AP); bf16_t* gQH = (bf16_t*)(rec + GP_QH); bf16_t* gKH = (bf16_t*)(rec + GP_KH); bf16_t* gOH = (bf16_t*)(rec + GP_OH);
        {
            const int et = w;
            const bf16x8 a0 = ldfrag(WT, TSTR, 16 * et, 0, lane), a1 = ldfrag(WT, TSTR, 16 * et, 32, lane);
#pragma unroll
            for (int dt = 0; dt < 8; ++dt) { f32x4 acc = {0.f, 0.f, 0.f, 0.f};
                acc = MFMA16(a0, ldfrag_tr(kts, QSTR, 16 * dt, 0, lane), acc); acc = MFMA16(a1, ldfrag_tr(kts, QSTR, 16 * dt, 32, lane), acc);
                *(u32x2*)(gAP + ((size_t)(dt * 4 + (et >> 1)) * 64 + lane) * 8 + (et & 1) * 4) = (u32x2){pk2(-acc[0], -acc[1]), pk2(-acc[2], -acc[3])}; }
#pragma unroll
            for (int tt = 0; tt < 4; ++tt) { f32x4 acc = {0.f, 0.f, 0.f, 0.f};
                acc = MFMA16(a0, ldfrag(QKm, TSTR, 16 * tt, 0, lane), acc); acc = MFMA16(a1, ldfrag(QKm, TSTR, 16 * tt, 32, lane), acc);
                const int t = 16 * tt + l15, e0 = 16 * et + 4 * q4; const float eg = egs[t];
                const u32x2 qq = *(const u32x2*)(qs + t * QSTR + e0);
                const float o0 = __uint_as_float(qq.x << 16) * eg - acc[0], o1 = __uint_as_float(qq.x & 0xffff0000u) * eg - acc[1],
                            o2 = __uint_as_float(qq.y << 16) * eg - acc[2], o3 = __uint_as_float(qq.y & 0xffff0000u) * eg - acc[3];
                *(u32x2*)(gQH + ((size_t)(tt * 4 + (et >> 1)) * 64 + lane) * 8 + (et & 1) * 4) = (u32x2){pk2(o0, o1), pk2(o2, o3)}; }
        }
        {
            const int dt = w;
            const bf16x8 a0 = ldfrag_tr(kts, QSTR, 16 * dt, 0, lane), a1 = ldfrag_tr(kts, QSTR, 16 * dt, 32, lane);
#pragma unroll
            for (int vt = 0; vt < 8; ++vt) { f32x4 acc = {0.f, 0.f, 0.f, 0.f};
                acc = MFMA16(a0, ldfrag(UT, TSTR, 16 * vt, 0, lane), acc); acc = MFMA16(a1, ldfrag(UT, TSTR, 16 * vt, 32, lane), acc);
                *(u32x2*)(gKH + ((size_t)(vt * 8 + dt) * 64 + lane) * 4) = (u32x2){pk2(acc[0], acc[1]), pk2(acc[2], acc[3])}; }
            const int tt = w & 3, vh = w >> 2;
            const bf16x8 b0 = ldfrag(QKm, TSTR, 16 * tt, 0, lane), b1 = ldfrag(QKm, TSTR, 16 * tt, 32, lane);
#pragma unroll
            for (int x = 0; x < 4; ++x) { const int vt = vh * 4 + x; f32x4 acc = {0.f, 0.f, 0.f, 0.f};
                acc = MFMA16(b0, ldfrag(UT, TSTR, 16 * vt, 0, lane), acc); acc = MFMA16(b1, ldfrag(UT, TSTR, 16 * vt, 32, lane), acc);
                *(u32x2*)(gOH + ((size_t)(vt * 4 + tt) * 64 + lane) * 4) = (u32x2){pk2(acc[0], acc[1]), pk2(acc[2], acc[3])}; }
        }
    }
    __syncthreads();
}

__device__ __forceinline__ void phase_gprep(const Params& p, int seg, unsigned char* smem) {
    const int blk = obid();
    const int n_items = (CPS + (seg == 0 ? 1 : 0)) * 64;
#pragma unroll 1
    for (int it = blk; it < n_items; it += gridDim.x) {
        const int bh = it & 63, b = bh >> 3, h = bh & 7; int cl = it >> 6; if (seg != 0) cl += 1;
        unsigned char* rec = p.ws + WS_GP + (size_t)(cl * 64 + bh) * GP_STRIDE;
        const bf16_t* Pb = (const bf16_t*)(p.ws + WS_P);
        bf16_t* chalo2 = (bf16_t*)(p.ws + WS_CHALO);
        if (cl == 0) gdn_prep_item(p, smem, h, LEX0, 48, nullptr, nullptr, nullptr, rec);
        else {
            const int row = b * SEGTOK + (cl - 1) * 64;
            const bf16_t* hbase = Pb + (size_t)(row - 3) * NPB;
            if (cl == 1) hbase = (seg == 0) ? Pb + (size_t)(LEX0 + NMETA - 3) * NPB : chalo2 + (size_t)(((seg - 1) & 1) * NBATCH + b) * 3 * NPB;
            bf16_t* ho = (cl == CPS) ? chalo2 + (size_t)((seg & 1) * NBATCH + b) * 3 * NPB : nullptr;
            float* co = (cl == CPS && seg == NSEG - 1) ? p.out + O_CONV_P + (size_t)b * 9216 : nullptr;
            gdn_prep_item(p, smem, h, row, 0, hbase, ho, co, rec);
        }
    }
}

__device__ __forceinline__ void gdn_scan_block(const Params& p, int seg, unsigned char* smem, int bh) {
    const int tid = otid(), w = tid >> 6, lane = tid & 63, q4 = lane >> 4, l15 = lane & 15;
    const int b = bh >> 3, h = bh & 7;
    float* st = p.out + O_GDN_P + (size_t)bh * 16384;
    f32x4 S[8];
    if (seg) {
#pragma unroll
        for (int mt = 0; mt < 8; ++mt)
#pragma unroll
            for (int r = 0; r < 4; ++r) S[mt][r] = st[(size_t)(16 * mt + 4 * q4 + r) * 128 + 16 * w + l15];
    } else {
#pragma unroll
        for (int mt = 0; mt < 8; ++mt) S[mt] = (f32x4){0.f, 0.f, 0.f, 0.f};
    }
    const int c_lo = seg ? 1 : 0;
    float* obuf = (float*)(smem + 98304);
    {
        const u32x4* src = (const u32x4*)(p.ws + WS_GP + (size_t)(c_lo * 64 + bh) * GP_STRIDE); u32x4* dst = (u32x4*)smem;
#pragma unroll
        for (int x = 0; x < 6; ++x) dst[tid + 512 * x] = src[tid + 512 * x];
    }
#pragma unroll 1
    for (int cl = c_lo; cl <= CPS; ++cl) {
        const unsigned char* rec = p.ws + WS_GP + (size_t)(cl * 64 + bh) * GP_STRIDE;
        const int cur = (cl - c_lo) & 1;
        __syncthreads();
        u32x4 nx[6];
        const bool more = cl < CPS;
        if (more) { const u32x4* src = (const u32x4*)(rec + GP_STRIDE * 64);
#pragma unroll
            for (int x = 0; x < 6; ++x) nx[x] = src[tid + 512 * x]; }
        const bf16_t* gKH = (const bf16_t*)(rec + GP_KH); const bf16_t* gOH = (const bf16_t*)(rec + GP_OH);
        u32x2 kh[8], oh[4];
#pragma unroll
        for (int mt = 0; mt < 8; ++mt) kh[mt] = *(const u32x2*)(gKH + ((size_t)(w * 8 + mt) * 64 + lane) * 4);
#pragma unroll
        for (int tt = 0; tt < 4; ++tt) oh[tt] = *(const u32x2*)(gOH + ((size_t)(w * 4 + tt) * 64 + lane) * 4);
        const float egl = *(const float*)(rec + GP_EGL);
        const int et = tid >> 3, eg = tid & 7;
        const bf16_t* gp = (const bf16_t*)(rec + GP_G) + et * 128 + 16 * eg;
        u32x4 z0 = {0u, 0u, 0u, 0u}, z1 = {0u, 0u, 0u, 0u};
        if (cl > 0) { z0 = *(const u32x4*)gp; z1 = *(const u32x4*)(gp + 8); }
        bf16x8 Bf[4];
#pragma unroll
        for (int ks = 0; ks < 4; ++ks) { u32x4 t; t.x = pk2(S[2 * ks][0], S[2 * ks][1]); t.y = pk2(S[2 * ks][2], S[2 * ks][3]); t.z = pk2(S[2 * ks + 1][0], S[2 * ks + 1][1]); t.w = pk2(S[2 * ks + 1][2], S[2 * ks + 1][3]);
            Bf[ks] = __builtin_bit_cast(bf16x8, t); }
        const bf16x8* AP = (const bf16x8*)(smem + cur * 49152); const bf16x8* QH = (const bf16x8*)(smem + cur * 49152 + GP_QH);
        f32x4 o[4], tS[8];
#pragma unroll
        for (int tt = 0; tt < 4; ++tt) { o[tt] = (f32x4){0.f, 0.f, 0.f, 0.f};
#pragma unroll
            for (int ks = 0; ks < 4; ++ks) o[tt] = MFMA16(QH[(tt * 4 + ks) * 64 + lane], Bf[ks], o[tt]); }
#pragma unroll
        for (int mt = 0; mt < 8; ++mt) { tS[mt] = (f32x4){0.f, 0.f, 0.f, 0.f};
#pragma unroll
            for (int ks = 0; ks < 4; ++ks) tS[mt] = MFMA16(AP[(mt * 4 + ks) * 64 + lane], Bf[ks], tS[mt]); }
#pragma unroll
        for (int mt = 0; mt < 8; ++mt) {
            S[mt][0] = egl * S[mt][0] + tS[mt][0] + __uint_as_float(kh[mt].x << 16); S[mt][1] = egl * S[mt][1] + tS[mt][1] + __uint_as_float(kh[mt].x & 0xffff0000u);
            S[mt][2] = egl * S[mt][2] + tS[mt][2] + __uint_as_float(kh[mt].y << 16); S[mt][3] = egl * S[mt][3] + tS[mt][3] + __uint_as_float(kh[mt].y & 0xffff0000u); }
        if (cl > 0) {
#pragma unroll
            for (int tt = 0; tt < 4; ++tt) {
                o[tt][0] += __uint_as_float(oh[tt].x << 16); o[tt][1] += __uint_as_float(oh[tt].x & 0xffff0000u); o[tt][2] += __uint_as_float(oh[tt].y << 16); o[tt][3] += __uint_as_float(oh[tt].y & 0xffff0000u);
#pragma unroll
                for (int r = 0; r < 4; ++r) obuf[(16 * tt + 4 * q4 + r) * 132 + 16 * w + l15] = o[tt][r]; }
        }
        if (more) { u32x4* dst = (u32x4*)(smem + (cur ^ 1) * 49152);
#pragma unroll
            for (int x = 0; x < 6; ++x) dst[tid + 512 * x] = nx[x]; }
        if (cl > 0) {
            __syncthreads();
            f32x4 ov[4]; float ss = 0.f;
#pragma unroll
            for (int j = 0; j < 4; ++j) { ov[j] = *(const f32x4*)(obuf + et * 132 + 16 * eg + 4 * j); ss += ov[j][0] * ov[j][0] + ov[j][1] * ov[j][1] + ov[j][2] * ov[j][2] + ov[j][3] * ov[j][3]; }
            ss += __shfl_xor(ss, 1); ss += __shfl_xor(ss, 2); ss += __shfl_xor(ss, 4);
            const float rs = __builtin_amdgcn_rsqf(ss * (1.f / 128.f) + 1e-6f);
            const unsigned zz[8] = {z0.x, z0.y, z0.z, z0.w, z1.x, z1.y, z1.z, z1.w};
            unsigned ow[8];
#pragma unroll
            for (int j = 0; j < 8; ++j) ow[j] = pk2(ov[j >> 1][(j & 1) * 2] * rs * __uint_as_float(zz[j] << 16), ov[j >> 1][(j & 1) * 2 + 1] * rs * __uint_as_float(zz[j] & 0xffff0000u));
            const size_t grow = (size_t)b * SEQ + seg * SEGTOK + (cl - 1) * 64 + et;
            bf16_t* oa = (bf16_t*)(p.ws + WS_H) + grow * D + h * 128 + 16 * eg;
            *(u32x4*)oa = (u32x4){ow[0], ow[1], ow[2], ow[3]}; *(u32x4*)(oa + 8) = (u32x4){ow[4], ow[5], ow[6], ow[7]};
        }
    }
#pragma unroll
    for (int mt = 0; mt < 8; ++mt)
#pragma unroll
        for (int r = 0; r < 4; ++r) st[(size_t)(16 * mt + 4 * q4 + r) * 128 + 16 * w + l15] = S[mt][r];
    __syncthreads();
}

constexpr int RL_AT = 0, RL_BT = 9216, RL_KT = 18432, RL_ATT = 27648, RL_RT = 36864, RL_BTLT = 46080, RL_KTLT = 55296, RL_VT = 64512, RL_LAK = 73728, RL_MRB = 82944, RL_MRK = 92160,
              RL_LM = 101376, RL_AF = 117760, RL_TM = 134144, RL_XS = 150528;
__device__ __forceinline__ void rwkv_prep_item(const Params& p, unsigned char* smem, int hb, int row_start, int npad, const bf16_t* prev_row,
                                               bf16_t* halo_out, unsigned char* rec) {
    const int tid = otid(), w = tid >> 6, lane = tid & 63, q4 = lane >> 4, l15 = lane & 15;
    bf16_t* At = (bf16_t*)(smem + RL_AT); bf16_t* Tb = At; bf16_t* Bt = (bf16_t*)(smem + RL_BT); bf16_t* WaT = Bt; bf16_t* Kt = (bf16_t*)(smem + RL_KT); bf16_t* XT = Kt;
    bf16_t* At2 = (bf16_t*)(smem + RL_ATT); bf16_t* Rt = (bf16_t*)(smem + RL_RT); bf16_t* Btl = (bf16_t*)(smem + RL_BTLT); bf16_t* Ktl = (bf16_t*)(smem + RL_KTLT);
    bf16_t* Vr = (bf16_t*)(smem + RL_VT);        bf16_t* Lak = (bf16_t*)(smem + RL_LAK); bf16_t* Mrb = (bf16_t*)(smem + RL_MRB); bf16_t* Mrk = (bf16_t*)(smem + RL_MRK);
    float* Lm = (float*)(smem + RL_LM);
    bf16_t* thw = Lak; bf16_t* adb = Mrb; float* lc = Lm; float* af = (float*)(smem + RL_AF);
    const bf16_t* P = (const bf16_t*)(p.ws + WS_P);
    const float* pk = (const float*)(p.ws + WS_PK);
    const int t = tid >> 3, g = tid & 7;
    float rr[8], kb[8], vv[8], zb[8];
    {
        const bool real = t >= npad;
        const bf16_t* curp = P; const bf16_t* prevp = P; float fprev = 0.f;
        if (real) { curp = P + (size_t)(row_start + t - npad) * NPB; if (t > npad) { prevp = curp - NPB; fprev = 1.f; } else if (prev_row) { prevp = prev_row; fprev = 1.f; } }
        const int secbase[6] = {0, 1024, 2048, 3200, 3072, 3136};
        u32x4 rc[6], rp[6];
#pragma unroll
        for (int sidx = 0; sidx < 6; ++sidx) { const int col = secbase[sidx] + (sidx < 4 ? hb * 64 : 0) + g * 8; rc[sidx] = *(const u32x4*)(curp + C_RW + col); rp[sidx] = *(const u32x4*)(prevp + C_RW + col); }
        float m[6][8];
#pragma unroll
        for (int sidx = 0; sidx < 6; ++sidx) {
            const int col = secbase[sidx] + (sidx < 4 ? hb * 64 : 0) + g * 8;
            float cur[8], prv[8];
            unpack8(rc[sidx], cur); unpack8(rp[sidx], prv);
            const f32x4 mu0 = *(const f32x4*)(pk + PK_MU + col), mu1 = *(const f32x4*)(pk + PK_MU + col + 4);
            const float mu[8] = {mu0[0], mu0[1], mu0[2], mu0[3], mu1[0], mu1[1], mu1[2], mu1[3]};
#pragma unroll
            for (int e = 0; e < 8; ++e) m[sidx][e] = real ? cur[e] + mu[e] * (fprev * prv[e] - cur[e]) : 0.f;
            if (halo_out && t == 63 && (sidx < 4 || hb == 0)) *(u32x4*)(halo_out + C_RW + col) = rc[sidx];
        }
#pragma unroll
        for (int e = 0; e < 8; ++e) { rr[e] = m[0][e]; kb[e] = m[1][e]; vv[e] = m[2][e]; zb[e] = m[3][e]; }
        float th[8];
#pragma unroll
        for (int e = 0; e < 8; ++e) th[e] = tanh_(m[4][e]);
        *(u32x4*)(thw + t * TSTR + g * 8) = pack8(th);
        *(u32x4*)(adb + t * TSTR + g * 8) = pack8(m[5]);
    }
    __syncthreads();
    {
        const int which = w >> 2, ct = w & 3;
        const bf16_t* Wt = (const bf16_t*)(p.ws + (which ? WS_A2T : WS_W2T)) + (size_t)hb * 4096;
        const bf16x8 b0 = *(const bf16x8*)(Wt + (16 * ct + l15) * 64 + 8 * q4), b1 = *(const bf16x8*)(Wt + (16 * ct + l15) * 64 + 32 + 8 * q4);
        const bf16_t* Aarr = which ? adb : thw;
        const int c = 16 * ct + l15;
        const float bias = pk[(which ? PK_A0 : PK_W0) + hb * 64 + c];
        float carry = 0.f;
#pragma unroll
        for (int tt = 0; tt < 4; ++tt) {
            f32x4 acc = {0.f, 0.f, 0.f, 0.f};
            acc = MFMA16(ldfrag(Aarr, TSTR, 16 * tt, 0, lane), b0, acc); acc = MFMA16(ldfrag(Aarr, TSTR, 16 * tt, 32, lane), b1, acc);
            if (which) {
#pragma unroll
                for (int r = 0; r < 4; ++r) af[(16 * tt + 4 * q4 + r) * 64 + c] = sigm(bias + acc[r]);
            } else {
                float wl[4];
#pragma unroll
                for (int r = 0; r < 4; ++r) { const int tk = 16 * tt + 4 * q4 + r; wl[r] = (tk < npad) ? 0.f : -0.6065306597126334f * sigm(bias + acc[r]); }
                wl[1] += wl[0]; wl[2] += wl[1]; wl[3] += wl[2];
                const float Q = wl[3];
                const float Q0 = __shfl(Q, l15), Q1 = __shfl(Q, l15 + 16), Q2 = __shfl(Q, l15 + 32), Q3 = __shfl(Q, l15 + 48);
                const float ex = carry + (q4 > 0 ? Q0 : 0.f) + (q4 > 1 ? Q1 : 0.f) + (q4 > 2 ? Q2 : 0.f);
#pragma unroll
                for (int r = 0; r < 4; ++r) lc[(16 * tt + 4 * q4 + r) * 64 + c] = ex + wl[r];
                carry += Q0 + Q1 + Q2 + Q3;
            }
        }
    }
    __syncthreads();
    {
        float lct[8], lcp[8], lcC[8], av[8];
        { const f32x4 a = *(const f32x4*)(lc + t * 64 + g * 8), b2 = *(const f32x4*)(lc + t * 64 + g * 8 + 4); lct[0] = a[0]; lct[1] = a[1]; lct[2] = a[2]; lct[3] = a[3]; lct[4] = b2[0]; lct[5] = b2[1]; lct[6] = b2[2]; lct[7] = b2[3]; }
        if (t > 0) { const f32x4 a = *(const f32x4*)(lc + (t - 1) * 64 + g * 8), b2 = *(const f32x4*)(lc + (t - 1) * 64 + g * 8 + 4); lcp[0] = a[0]; lcp[1] = a[1]; lcp[2] = a[2]; lcp[3] = a[3]; lcp[4] = b2[0]; lcp[5] = b2[1]; lcp[6] = b2[2]; lcp[7] = b2[3]; }
        else {
#pragma unroll
            for (int e = 0; e < 8; ++e) lcp[e] = 0.f; }
        { const f32x4 a = *(const f32x4*)(lc + 63 * 64 + g * 8), b2 = *(const f32x4*)(lc + 63 * 64 + g * 8 + 4); lcC[0] = a[0]; lcC[1] = a[1]; lcC[2] = a[2]; lcC[3] = a[3]; lcC[4] = b2[0]; lcC[5] = b2[1]; lcC[6] = b2[2]; lcC[7] = b2[3]; }
        { const f32x4 a = *(const f32x4*)(af + t * 64 + g * 8), b2 = *(const f32x4*)(af + t * 64 + g * 8 + 4); av[0] = a[0]; av[1] = a[1]; av[2] = a[2]; av[3] = a[3]; av[4] = b2[0]; av[5] = b2[1]; av[6] = b2[2]; av[7] = b2[3]; }
        const int hc = hb * 64 + g * 8;
        float kk[8], km[8], ss = 0.f, rk = 0.f;
        float pkk[8], pka[8], prk[8];
        { const f32x4 a0 = *(const f32x4*)(pk + PK_KK + hc), a1 = *(const f32x4*)(pk + PK_KK + hc + 4), b0 = *(const f32x4*)(pk + PK_KA + hc), b1 = *(const f32x4*)(pk + PK_KA + hc + 4), c0v = *(const f32x4*)(pk + PK_RK + hc), c1v = *(const f32x4*)(pk + PK_RK + hc + 4);
#pragma unroll
          for (int e = 0; e < 4; ++e) { pkk[e] = a0[e]; pkk[4 + e] = a1[e]; pka[e] = b0[e]; pka[4 + e] = b1[e]; prk[e] = c0v[e]; prk[4 + e] = c1v[e]; } }
#pragma unroll
        for (int e = 0; e < 8; ++e) { kk[e] = kb[e] * pkk[e]; ss += kk[e] * kk[e]; km[e] = kb[e] * (1.f + (av[e] - 1.f) * pka[e]); rk += rr[e] * km[e] * prk[e]; }
        ss += __shfl_xor(ss, 1); ss += __shfl_xor(ss, 2); ss += __shfl_xor(ss, 4);
        rk += __shfl_xor(rk, 1); rk += __shfl_xor(rk, 2); rk += __shfl_xor(rk, 4);
        const float kn = __builtin_amdgcn_rsqf(ss + 1e-6f);
        float xa[8], xb[8], xk[8], xr[8], xbt[8], xkt[8];
#pragma unroll
        for (int e = 0; e < 8; ++e) { kk[e] *= kn; const float ka = kk[e] * av[e]; const float ip = __expf(-lct[e]), tl = __expf(lcC[e] - lct[e]);
            xa[e] = kk[e] * __expf(lcp[e]); xb[e] = ka * ip; xk[e] = km[e] * ip; xr[e] = rr[e] * __expf(lct[e]); xbt[e] = ka * tl; xkt[e] = km[e] * tl; }
        *(u32x4*)(At + t * TSTR + g * 8) = pack8(xa); *(u32x4*)(Bt + t * TSTR + g * 8) = pack8(xb); *(u32x4*)(Kt + t * TSTR + g * 8) = pack8(xk); *(u32x4*)(Rt + t * TSTR + g * 8) = pack8(xr);
        *(u32x4*)(At2 + t * TSTR + g * 8) = pack8(xa); *(u32x4*)(Btl + t * TSTR + g * 8) = pack8(xbt); *(u32x4*)(Ktl + t * TSTR + g * 8) = pack8(xkt); *(u32x4*)(Vr + t * TSTR + g * 8) = pack8(vv);
        float c1[8], c0[8];
#pragma unroll
        for (int e = 0; e < 8; ++e) { c1[e] = 0.f; c0[e] = 0.f; }
        { const f32x4 g0 = *(const f32x4*)(pk + PK_GNW + hc), g1 = *(const f32x4*)(pk + PK_GNW + hc + 4), h0 = *(const f32x4*)(pk + PK_GNB + hc), h1 = *(const f32x4*)(pk + PK_GNB + hc + 4);
#pragma unroll
          for (int e = 0; e < 4; ++e) { const float sz0 = silu_(zb[e]), sz1 = silu_(zb[4 + e]); c1[e] = g0[e] * sz0; c1[4 + e] = g1[e] * sz1; c0[e] = (h0[e] + rk * vv[e]) * sz0; c0[4 + e] = (h1[e] + rk * vv[4 + e]) * sz1; } }
        *(u32x4*)((bf16_t*)(rec + RP_C1) + t * 64 + g * 8) = pack8(c1); *(u32x4*)((bf16_t*)(rec + RP_C0) + t * 64 + g * 8) = pack8(c0);
        if (t == 63) { float* pc = (float*)(rec + RP_PC) + g * 8; *(f32x4*)pc = (f32x4){__expf(lcC[0]), __expf(lcC[1]), __expf(lcC[2]), __expf(lcC[3])}; *(f32x4*)(pc + 4) = (f32x4){__expf(lcC[4]), __expf(lcC[5]), __expf(lcC[6]), __expf(lcC[7])}; }
    }
    __syncthreads();
    {
        const int pr = w >> 1;
        const bf16_t* Aarr = pr < 2 ? At : Rt; const bf16_t* Barr = (pr & 1) ? Kt : Bt;
#pragma unroll
        for (int x = 0; x < 2; ++x) { const int tt = 2 * (w & 1) + x;
            const bf16x8 a0 = ldfrag(Aarr, TSTR, 16 * tt, 0, lane), a1 = ldfrag(Aarr, TSTR, 16 * tt, 32, lane);
            const int tk = 16 * tt + l15;
#pragma unroll
            for (int it = 0; it < 4; ++it) { f32x4 acc = {0.f, 0.f, 0.f, 0.f};
                acc = MFMA16(ldfrag(Barr, TSTR, 16 * it, 0, lane), a0, acc); acc = MFMA16(ldfrag(Barr, TSTR, 16 * it, 32, lane), a1, acc);
                const int i0 = 16 * it + 4 * q4;
                f32x4 o;
#pragma unroll
                for (int r = 0; r < 4; ++r) { const int i = i0 + r; const bool keep = pr < 2 ? (tk > i) : (tk >= i); o[r] = keep ? acc[r] : 0.f; }
                if (pr == 0) *(f32x4*)(Lm + tk * 64 + i0) = o;
                else { bf16_t* Out = pr == 1 ? Lak : (pr == 2 ? Mrb : Mrk); *(u32x2*)(Out + tk * TSTR + i0) = (u32x2){pk2(o[0], o[1]), pk2(o[2], o[3])}; } }
        }
    }
    __syncthreads();
    {
        float* Tm = (float*)(smem + RL_TM);
        inv_block(Lm, Tm, (float*)(smem + RL_XS), tid);
        const int i = tid >> 3, j0 = (tid & 7) * 8;
        float a[8];
#pragma unroll
        for (int e = 0; e < 8; ++e) a[e] = Tm[i * 64 + j0 + e];
        *(u32x4*)(Tb + i * TSTR + j0) = pack8(a);
    }
    __syncthreads();
    {
        const int tt = w & 3, which = w >> 2;
        const bf16_t* Aarr = which ? Lak : Tb; const bf16_t* Barr = which ? Vr : At2; bf16_t* Out = which ? XT : WaT;
        const bf16x8 a0 = ldfrag(Aarr, TSTR, 16 * tt, 0, lane), a1 = ldfrag(Aarr, TSTR, 16 * tt, 32, lane);
#pragma unroll
        for (int ct = 0; ct < 4; ++ct) { f32x4 acc = {0.f, 0.f, 0.f, 0.f};
            acc = MFMA16(a0, ldfrag_tr(Barr, TSTR, 16 * ct, 0, lane), acc); acc = MFMA16(a1, ldfrag_tr(Barr, TSTR, 16 * ct, 32, lane), acc);
            *(u32x2*)(Out + (16 * ct + l15) * TSTR + 16 * tt + 4 * q4) = (u32x2){pk2(acc[0], acc[1]), pk2(acc[2], acc[3])}; }
    }
    __syncthreads();
    {
        f32x4 acc[4];
        if (w < 4) {
            const bf16x8 a0 = ldfrag(Tb, TSTR, 16 * w, 0, lane), a1 = ldfrag(Tb, TSTR, 16 * w, 32, lane);
#pragma unroll
            for (int ct = 0; ct < 4; ++ct) { acc[ct] = (f32x4){0.f, 0.f, 0.f, 0.f};
                acc[ct] = MFMA16(a0, ldfrag(XT, TSTR, 16 * ct, 0, lane), acc[ct]); acc[ct] = MFMA16(a1, ldfrag(XT, TSTR, 16 * ct, 32, lane), acc[ct]); }
        }
        if (w < 4) {
            bf16_t* UvTw = (bf16_t*)(smem + RL_LM);
#pragma unroll
            for (int ct = 0; ct < 4; ++ct) *(u32x2*)(UvTw + (16 * ct + l15) * TSTR + 16 * w + 4 * q4) = (u32x2){pk2(-acc[ct][0], -acc[ct][1]), pk2(-acc[ct][2], -acc[ct][3])};
        }
    }
    __syncthreads();
    {
        const bf16_t* UvT = (const bf16_t*)(smem + RL_LM);
        bf16_t* gAP = (bf16_t*)(rec + RP_AP); bf16_t* gRH = (bf16_t*)(rec + RP_RH); bf16_t* gKH = (bf16_t*)(rec + RP_KH); bf16_t* gYH = (bf16_t*)(rec + RP_YH);
        const int et = w & 3, part = w >> 2;
        {
            const bf16x8 a0 = ldfrag(WaT, TSTR, 16 * et, 0, lane), a1 = ldfrag(WaT, TSTR, 16 * et, 32, lane);
            if (part == 0) {
#pragma unroll
                for (int kt = 0; kt < 4; ++kt) { f32x4 acc = {0.f, 0.f, 0.f, 0.f};
                    acc = MFMA16(a0, ldfrag_tr(Btl, TSTR, 16 * kt, 0, lane), acc); acc = MFMA16(a1, ldfrag_tr(Btl, TSTR, 16 * kt, 32, lane), acc);
                    *(u32x2*)(gAP + ((size_t)(kt * 2 + (et >> 1)) * 64 + lane) * 8 + (et & 1) * 4) = (u32x2){pk2(-acc[0], -acc[1]), pk2(-acc[2], -acc[3])}; }
            } else {
#pragma unroll
                for (int tt = 0; tt < 4; ++tt) { f32x4 acc = {0.f, 0.f, 0.f, 0.f};
                    acc = MFMA16(a0, ldfrag(Mrb, TSTR, 16 * tt, 0, lane), acc); acc = MFMA16(a1, ldfrag(Mrb, TSTR, 16 * tt, 32, lane), acc);
                    const int tk = 16 * tt + l15, e0 = 16 * et + 4 * q4;
                    const u32x2 q2 = *(const u32x2*)(Rt + tk * TSTR + e0);
                    const float o0 = __uint_as_float(q2.x << 16) - acc[0], o1 = __uint_as_float(q2.x & 0xffff0000u) - acc[1], o2 = __uint_as_float(q2.y << 16) - acc[2], o3 = __uint_as_float(q2.y & 0xffff0000u) - acc[3];
                    *(u32x2*)(gRH + ((size_t)(tt * 2 + (et >> 1)) * 64 + lane) * 8 + (et & 1) * 4) = (u32x2){pk2(o0, o1), pk2(o2, o3)}; }
            }
        }
        {
            const int rt = w & 3;
            bf16_t* Out = part ? gKH : gYH;
            bf16x8 a0, a1, a2, a3;
            if (part) { a0 = ldfrag_tr(Btl, TSTR, 16 * rt, 0, lane); a1 = ldfrag_tr(Btl, TSTR, 16 * rt, 32, lane); a2 = ldfrag_tr(Ktl, TSTR, 16 * rt, 0, lane); a3 = ldfrag_tr(Ktl, TSTR, 16 * rt, 32, lane); }
            else { a0 = ldfrag(Mrb, TSTR, 16 * rt, 0, lane); a1 = ldfrag(Mrb, TSTR, 16 * rt, 32, lane); a2 = ldfrag(Mrk, TSTR, 16 * rt, 0, lane); a3 = ldfrag(Mrk, TSTR, 16 * rt, 32, lane); }
#pragma unroll
            for (int vt = 0; vt < 4; ++vt) { f32x4 acc = {0.f, 0.f, 0.f, 0.f};
                acc = MFMA16(a0, ldfrag(UvT, TSTR, 16 * vt, 0, lane), acc); acc = MFMA16(a1, ldfrag(UvT, TSTR, 16 * vt, 32, lane), acc);
                acc = MFMA16(a2, ldfrag_tr(Vr, TSTR, 16 * vt, 0, lane), acc); acc = MFMA16(a3, ldfrag_tr(Vr, TSTR, 16 * vt, 32, lane), acc);
                *(u32x2*)(Out + ((size_t)(vt * 4 + rt) * 64 + lane) * 4) = (u32x2){pk2(acc[0], acc[1]), pk2(acc[2], acc[3])}; }
        }
    }
    __syncthreads();
}

__device__ __forceinline__ void phase_rprep(const Params& p, int seg, unsigned char* smem) {
    const int blk = obid();
    const int n_items = (CPS + (seg == 0 ? 1 : 0)) * 128;
#pragma unroll 1
    for (int it = (blk + (gridDim.x >> 1)) % gridDim.x; it < n_items; it += gridDim.x) {
        const int bh = it & 127, b = bh >> 4, hb = bh & 15; int cl = it >> 7; if (seg != 0) cl += 1;
        unsigned char* rec = p.ws + WS_RP + (size_t)(cl * 128 + bh) * RP_STRIDE;
        const bf16_t* Pb = (const bf16_t*)(p.ws + WS_P);
        bf16_t* phalo2 = (bf16_t*)(p.ws + WS_PHALO);
        if (cl == 0) rwkv_prep_item(p, smem, hb, LEX0, 48, nullptr, nullptr, rec);
        else {
            const int row = b * SEGTOK + (cl - 1) * 64;
            const bf16_t* prow = Pb + (size_t)(row - 1) * NPB;
            if (cl == 1) prow = (seg == 0) ? Pb + (size_t)(LEX0 + NMETA - 1) * NPB : phalo2 + (size_t)(((seg - 1) & 1) * NBATCH + b) * NPB;
            bf16_t* ho = (cl == CPS) ? phalo2 + (size_t)((seg & 1) * NBATCH + b) * NPB : nullptr;
            rwkv_prep_item(p, smem, hb, row, 0, prow, ho, rec);
        }
    }
}

__device__ __forceinline__ void rwkv_scan_block(const Params& p, int seg, unsigned char* smem, int pairidx) {
    const int tid = otid(), w = tid >> 6, lane = tid & 63, q4 = lane >> 4, l15 = lane & 15;
    const int hsel = w >> 2, vt = w & 3;
    const int bh = pairidx * 2 + hsel, b = bh >> 4, hb = bh & 15;
    float* st = p.out + O_RWKV_P + (size_t)bh * 4096;
    f32x4 S[4];
    if (seg) {
#pragma unroll
        for (int mt = 0; mt < 4; ++mt) S[mt] = *(const f32x4*)(st + (size_t)(16 * vt + l15) * 64 + 16 * mt + 4 * q4);
    } else {
#pragma unroll
        for (int mt = 0; mt < 4; ++mt) S[mt] = (f32x4){0.f, 0.f, 0.f, 0.f};
    }
    const int c_lo = seg ? 1 : 0;
    float* ybuf = (float*)(smem + 65536) + hsel * (64 * 68);
    const int tl = tid & 255;
    {
        const u32x4* src = (const u32x4*)(p.ws + WS_RP + (size_t)(c_lo * 128 + bh) * RP_STRIDE); u32x4* dst = (u32x4*)(smem + hsel * 16384);
#pragma unroll
        for (int x = 0; x < 4; ++x) dst[tl + 256 * x] = src[tl + 256 * x];
    }
#pragma unroll 1
    for (int cl = c_lo; cl <= CPS; ++cl) {
        const unsigned char* rec = p.ws + WS_RP + (size_t)(cl * 128 + bh) * RP_STRIDE;
        const int cur = (cl - c_lo) & 1;
        __syncthreads();
        u32x4 nx[4];
        const bool more = cl < CPS;
        if (more) { const u32x4* src = (const u32x4*)(rec + (size_t)RP_STRIDE * 128);
#pragma unroll
            for (int x = 0; x < 4; ++x) nx[x] = src[tl + 256 * x]; }
        const bf16_t* gKH = (const bf16_t*)(rec + RP_KH); const bf16_t* gYH = (const bf16_t*)(rec + RP_YH);
        u32x2 kh[4], yh[4]; f32x4 pc[4];
#pragma unroll
        for (int mt = 0; mt < 4; ++mt) { kh[mt] = *(const u32x2*)(gKH + ((size_t)(vt * 4 + mt) * 64 + lane) * 4); yh[mt] = *(const u32x2*)(gYH + ((size_t)(vt * 4 + mt) * 64 + lane) * 4);
            pc[mt] = *(const f32x4*)((const float*)(rec + RP_PC) + 16 * mt + 4 * q4); }
        const int tk = tl >> 2, g = tl & 3;
        u32x4 a0 = {0u, 0u, 0u, 0u}, a1 = a0, b0 = a0, b1 = a0;
        if (cl > 0) { const bf16_t* c1p = (const bf16_t*)(rec + RP_C1) + tk * 64 + 16 * g; const bf16_t* c0p = (const bf16_t*)(rec + RP_C0) + tk * 64 + 16 * g;
            a0 = *(const u32x4*)c0p; a1 = *(const u32x4*)(c0p + 8); b0 = *(const u32x4*)c1p; b1 = *(const u32x4*)(c1p + 8); }
        bf16x8 Bf[2];
#pragma unroll
        for (int ks = 0; ks < 2; ++ks) { u32x4 tq; tq.x = pk2(S[2 * ks][0], S[2 * ks][1]); tq.y = pk2(S[2 * ks][2], S[2 * ks][3]); tq.z = pk2(S[2 * ks + 1][0], S[2 * ks + 1][1]); tq.w = pk2(S[2 * ks + 1][2], S[2 * ks + 1][3]);
            Bf[ks] = __builtin_bit_cast(bf16x8, tq); }
        const bf16x8* AP = (const bf16x8*)(smem + cur * 32768 + hsel * 16384); const bf16x8* RH = (const bf16x8*)(smem + cur * 32768 + hsel * 16384 + RP_RH);
        f32x4 y[4], tS[4];
#pragma unroll
        for (int tt = 0; tt < 4; ++tt) { y[tt] = (f32x4){0.f, 0.f, 0.f, 0.f}; y[tt] = MFMA16(RH[(tt * 2 + 0) * 64 + lane], Bf[0], y[tt]); y[tt] = MFMA16(RH[(tt * 2 + 1) * 64 + lane], Bf[1], y[tt]); }
#pragma unroll
        for (int mt = 0; mt < 4; ++mt) { tS[mt] = (f32x4){0.f, 0.f, 0.f, 0.f}; tS[mt] = MFMA16(AP[(mt * 2 + 0) * 64 + lane], Bf[0], tS[mt]); tS[mt] = MFMA16(AP[(mt * 2 + 1) * 64 + lane], Bf[1], tS[mt]); }
#pragma unroll
        for (int mt = 0; mt < 4; ++mt) {
            S[mt][0] = pc[mt][0] * S[mt][0] + tS[mt][0] + __uint_as_float(kh[mt].x << 16); S[mt][1] = pc[mt][1] * S[mt][1] + tS[mt][1] + __uint_as_float(kh[mt].x & 0xffff0000u);
            S[mt][2] = pc[mt][2] * S[mt][2] + tS[mt][2] + __uint_as_float(kh[mt].y << 16); S[mt][3] = pc[mt][3] * S[mt][3] + tS[mt][3] + __uint_as_float(kh[mt].y & 0xffff0000u); }
        if (cl > 0) {
#pragma unroll
            for (int tt = 0; tt < 4; ++tt) {
                y[tt][0] += __uint_as_float(yh[tt].x << 16); y[tt][1] += __uint_as_float(yh[tt].x & 0xffff0000u); y[tt][2] += __uint_as_float(yh[tt].y << 16); y[tt][3] += __uint_as_float(yh[tt].y & 0xffff0000u);
#pragma unroll
                for (int r = 0; r < 4; ++r) ybuf[(16 * tt + 4 * q4 + r) * 68 + 16 * vt + l15] = y[tt][r]; }
        }
        if (more) { u32x4* dst = (u32x4*)(smem + (cur ^ 1) * 32768 + hsel * 16384);
#pragma unroll
            for (int x = 0; x < 4; ++x) dst[tl + 256 * x] = nx[x]; }
        if (cl > 0) {
            __syncthreads();
            f32x4 yv[4]; float sm = 0.f;
#pragma unroll
            for (int j = 0; j < 4; ++j) { yv[j] = *(const f32x4*)(ybuf + tk * 68 + 16 * g + 4 * j); sm += yv[j][0] + yv[j][1] + yv[j][2] + yv[j][3]; }
            sm += __shfl_xor(sm, 1); sm += __shfl_xor(sm, 2);
            const float mu = sm * (1.f / 64.f); float vs = 0.f;
#pragma unroll
            for (int j = 0; j < 4; ++j) { yv[j] = yv[j] - mu; vs += yv[j][0] * yv[j][0] + yv[j][1] * yv[j][1] + yv[j][2] * yv[j][2] + yv[j][3] * yv[j][3]; }
            vs += __shfl_xor(vs, 1); vs += __shfl_xor(vs, 2);
            const float rs = __builtin_amdgcn_rsqf(vs * (1.f / 64.f) + 64e-5f);
            const unsigned c0w[8] = {a0.x, a0.y, a0.z, a0.w, a1.x, a1.y, a1.z, a1.w}, c1w[8] = {b0.x, b0.y, b0.z, b0.w, b1.x, b1.y, b1.z, b1.w};
            unsigned ow[8];
#pragma unroll
            for (int j = 0; j < 8; ++j) ow[j] = pk2(yv[j >> 1][(j & 1) * 2] * rs * __uint_as_float(c1w[j] << 16) + __uint_as_float(c0w[j] << 16),
                                                     yv[j >> 1][(j & 1) * 2 + 1] * rs * __uint_as_float(c1w[j] & 0xffff0000u) + __uint_as_float(c0w[j] & 0xffff0000u));
            const size_t grow = (size_t)b * SEQ + seg * SEGTOK + (cl - 1) * 64 + tk;
            bf16_t* ob = (bf16_t*)(p.ws + WS_OB) + grow * D + hb * 64 + 16 * g;
            *(u32x4*)ob = (u32x4){ow[0], ow[1], ow[2], ow[3]}; *(u32x4*)(ob + 8) = (u32x4){ow[4], ow[5], ow[6], ow[7]};
        }
    }
#pragma unroll
    for (int mt = 0; mt < 4; ++mt) *(f32x4*)(st + (size_t)(16 * vt + l15) * 64 + 16 * mt + 4 * q4) = S[mt];
    __syncthreads();
}

__device__ __forceinline__ void gdn_sample_item(const Params& p, unsigned char* smem, int bs, int h) {
    const int tid = otid(), w = tid >> 6, lane = tid & 63, kq = tid >> 7, v = tid & 127;
    float* qk_s = (float*)smem; float* v_s = qk_s + 1024; float* gb_s = v_s + 512; float* part = gb_s + 16; float* part2 = part + 512;
    const bf16_t* P = (const bf16_t*)(p.ws + WS_P);
    const float* pk = (const float*)(p.ws + WS_PK);
    const float* s_in = p.in[2] + (size_t)(bs * 8 + h) * 16384; float* s_out = p.out + O_GDN_S + (size_t)(bs * 8 + h) * 16384;
    const int row0 = LEX0 + EX_SAMP + bs * DECT;
    float s[32];
#pragma unroll
    for (int j = 0; j < 32; ++j) s[j] = s_in[(size_t)(kq * 32 + j) * 128 + v];
    if (tid < 384) {
        const int pcol = (tid >> 7) * 1024 + h * 128 + (tid & 127);
        const float* cw = pk + PK_CONVW; const float* hin = p.in[3] + (size_t)bs * 9216; float* hout = p.out + O_CONV_S + (size_t)bs * 9216;
        const float cw0 = cw[pcol], cw1 = cw[3072 + pcol], cw2 = cw[6144 + pcol], cw3 = cw[9216 + pcol];
        float x3 = hin[pcol], x2 = hin[3072 + pcol], x1 = hin[6144 + pcol];
        float xr[4];
#pragma unroll
        for (int i = 0; i < 4; ++i) xr[i] = bf2f(P[(size_t)(row0 + i) * NPB + pcol]);
#pragma unroll
        for (int i = 0; i < 4; ++i) { const float y = cw0 * x3 + cw1 * x2 + cw2 * x1 + cw3 * xr[i]; x3 = x2; x2 = x1; x1 = xr[i];
            if (tid < 256) qk_s[i * 256 + tid] = silu_(y); else v_s[i * 128 + (tid - 256)] = silu_(y); }
        hout[pcol] = x3; hout[3072 + pcol] = x2; hout[6144 + pcol] = x1;
    } else if (tid < 388) {
        const int i = tid - 384; const size_t r = (size_t)(row0 + i) * NPB;
        const float pa = bf2f(P[r + C_A + h]), pb = bf2f(P[r + C_B + h]);
        gb_s[2 * i] = __expf(-expf(pk[PK_ALOG + h]) * softplus_(pa + pk[PK_DTB + h])); gb_s[2 * i + 1] = sigm(pb);
    }
    __syncthreads();
    { const int i = w >> 1, which = w & 1; float* rp = qk_s + i * 256 + which * 128; const float a = rp[lane], b = rp[lane + 64];
      const float sc = __builtin_amdgcn_rsqf(wave_sum(a * a + b * b) + 1e-6f) * (which == 0 ? 0.08838834764831845f : 1.f); rp[lane] = a * sc; rp[lane + 64] = b * sc; }
    __syncthreads();
#pragma unroll 1
    for (int i = 0; i < 4; ++i) {
        const float* kp = qk_s + i * 256 + 128 + kq * 32; const float* qp = qk_s + i * 256 + kq * 32;
        float pa = 0.f;
#pragma unroll
        for (int j4 = 0; j4 < 8; ++j4) { const f32x4 k4 = *(const f32x4*)(kp + 4 * j4); pa += k4[0] * s[4 * j4] + k4[1] * s[4 * j4 + 1] + k4[2] * s[4 * j4 + 2] + k4[3] * s[4 * j4 + 3]; }
        part[kq * 128 + v] = pa;
        __syncthreads();
        const float kS = part[v] + part[128 + v] + part[256 + v] + part[384 + v];
        const float a = gb_s[2 * i], c = gb_s[2 * i + 1] * (v_s[i * 128 + v] - a * kS);
        float po = 0.f;
#pragma unroll
        for (int j4 = 0; j4 < 8; ++j4) { const f32x4 k4 = *(const f32x4*)(kp + 4 * j4), q4v = *(const f32x4*)(qp + 4 * j4);
#pragma unroll
            for (int e = 0; e < 4; ++e) { s[4 * j4 + e] = a * s[4 * j4 + e] + k4[e] * c; po += q4v[e] * s[4 * j4 + e]; } }
        part2[kq * 128 + v] = po;
        __syncthreads();
        if (kq == 0) ((float*)(p.ws + WS_ORAW))[(size_t)(row0 + i) * D + h * 128 + v] = part2[v] + part2[128 + v] + part2[256 + v] + part2[384 + v];
    }
#pragma unroll
    for (int j = 0; j < 32; ++j) s_out[(size_t)(kq * 32 + j) * 128 + v] = s[j];
    __syncthreads();
}

constexpr int SR_R = 0, SR_KK = 4096, SR_V = 8192, SR_ZB = 12288, SR_DEC = 16384, SR_KA = 20480, SR_KM = 24576, SR_WD = 28672, SR_AD = 28928, SR_RK = 29184;
__device__ __forceinline__ void rwkv_sample_item(const Params& p, unsigned char* smem, int bs) {
    const int tid = otid(), w = tid >> 6, lane = tid & 63;
    float* f = (float*)smem;
    const bf16_t* P = (const bf16_t*)(p.ws + WS_P);
    const float* pk = (const float*)(p.ws + WS_PK);
    const int row0 = LEX0 + EX_SAMP + bs * DECT;
    const bf16_t* prow = P + (size_t)(LEX0 + EX_SHIFT + bs) * NPB + C_RW;
#pragma unroll 1
    for (int col = tid; col < RW_SHIFT; col += 512) {
        const float mu = pk[PK_MU + col]; float prev = bf2f(prow[col]);
        float cur[4];
#pragma unroll
        for (int i = 0; i < 4; ++i) cur[i] = bf2f(P[(size_t)(row0 + i) * NPB + C_RW + col]);
        float* dst; int stride = 1024; bool th = false;
        if (col < 1024) dst = f + SR_R + col; else if (col < 2048) dst = f + SR_KK + (col - 1024); else if (col < 3072) dst = f + SR_V + (col - 2048);
        else if (col < 3136) { dst = f + SR_WD + (col - 3072); stride = 64; th = true; } else if (col < 3200) { dst = f + SR_AD + (col - 3136); stride = 64; } else dst = f + SR_ZB + (col - 3200);
#pragma unroll
        for (int i = 0; i < 4; ++i) { float m = cur[i] + mu * (prev - cur[i]); prev = cur[i]; if (th) m = tanh_(m); dst[i * stride] = m; }
    }
    __syncthreads();
#pragma unroll 1
    for (int cc = 0; cc < 2; ++cc) {
        const int c = tid + 512 * cc;
        float aw[4] = {0.f, 0.f, 0.f, 0.f}, aa[4] = {0.f, 0.f, 0.f, 0.f};
#pragma unroll 8
        for (int l = 0; l < 64; ++l) { const float w2v = pk[PK_W2 + l * D + c], a2v = pk[PK_A2 + l * D + c];
#pragma unroll
            for (int i = 0; i < 4; ++i) { aw[i] += f[SR_WD + i * 64 + l] * w2v; aa[i] += f[SR_AD + i * 64 + l] * a2v; } }
        const float w0c = pk[PK_W0 + c], a0c = pk[PK_A0 + c], kkc = pk[PK_KK + c], kac = pk[PK_KA + c];
#pragma unroll
        for (int i = 0; i < 4; ++i) { const float a = sigm(a0c + aa[i]); const float kbv = f[SR_KK + i * 1024 + c];
            f[SR_DEC + i * 1024 + c] = __expf(-0.6065306597126334f * sigm(w0c + aw[i])); f[SR_KA + i * 1024 + c] = a; f[SR_KK + i * 1024 + c] = kbv * kkc; f[SR_KM + i * 1024 + c] = kbv * (1.f + (a - 1.f) * kac); }
    }
    __syncthreads();
#pragma unroll 1
    for (int x = 0; x < 8; ++x) { const int pr = w * 8 + x, i = pr >> 4, hh = pr & 15; const int o = i * 1024 + hh * 64 + lane;
        const float kr = f[SR_KK + o]; const float kk = kr * __builtin_amdgcn_rsqf(wave_sum(kr * kr) + 1e-6f); f[SR_KK + o] = kk; f[SR_KA + o] = kk * f[SR_KA + o];
        const float rkv = wave_sum(f[SR_R + o] * f[SR_KM + o] * pk[PK_RK + hh * 64 + lane]); if (lane == 0) f[SR_RK + pr] = rkv; }
    __syncthreads();
#pragma unroll 1
    for (int hp = 0; hp < 2; ++hp) {
        const int hb = hp * 8 + w;
        const float* s_in = p.in[4] + (size_t)(bs * 16 + hb) * 4096 + (size_t)lane * 64; float* s_out = p.out + O_RWKV_S + (size_t)(bs * 16 + hb) * 4096 + (size_t)lane * 64;
        f32x4 S[16];
#pragma unroll
        for (int j = 0; j < 16; ++j) S[j] = *(const f32x4*)(s_in + 4 * j);
        const int cch = hb * 64 + lane;
        const float gnw = pk[PK_GNW + cch], gnb = pk[PK_GNB + cch];
#pragma unroll 1
        for (int i = 0; i < 4; ++i) {
            const int o = i * 1024 + hb * 64;
            const float vv = f[SR_V + o + lane], rk = f[SR_RK + i * 16 + hb];
            float sa = 0.f;
#pragma unroll
            for (int j = 0; j < 16; ++j) { const f32x4 kk4 = *(const f32x4*)(f + SR_KK + o + 4 * j); sa += S[j][0] * kk4[0] + S[j][1] * kk4[1] + S[j][2] * kk4[2] + S[j][3] * kk4[3]; }
            float y = 0.f;
#pragma unroll
            for (int j = 0; j < 16; ++j) { const f32x4 de4 = *(const f32x4*)(f + SR_DEC + o + 4 * j), ka4 = *(const f32x4*)(f + SR_KA + o + 4 * j), km4 = *(const f32x4*)(f + SR_KM + o + 4 * j), r4 = *(const f32x4*)(f + SR_R + o + 4 * j);
#pragma unroll
                for (int e = 0; e < 4; ++e) { S[j][e] = S[j][e] * de4[e] + (vv * km4[e] - sa * ka4[e]); y += S[j][e] * r4[e]; } }
            const float mu = wave_sum(y) * (1.f / 64.f); const float dy = y - mu;
            const float rs = __builtin_amdgcn_rsqf(wave_sum(dy * dy) * (1.f / 64.f) + 64e-5f);
            const float ov = (dy * rs * gnw + gnb + rk * vv) * silu_(f[SR_ZB + i * 1024 + cch]);
            ((bf16_t*)(p.ws + WS_OB))[(size_t)(XROWS + EX_SAMP + bs * DECT + i) * D + cch] = (bf16_t)f2bf(ov);
        }
#pragma unroll
        for (int j = 0; j < 16; ++j) *(f32x4*)(s_out + 4 * j) = S[j];
    }
    __syncthreads();
}

__device__ __forceinline__ void phase2(const Params& p, int seg, unsigned char* smem) {
    const int blk = obid();
    float* out = p.out;
    float* chalo = (float*)(p.ws + WS_CHALO); float* phalo = (float*)(p.ws + WS_PHALO);
#ifndef SUB
#define SUB 0
#endif
#define SEN(x) (SUB == 0 || SUB == (x))
    if (SEN(1) && blk < 64) gdn_scan_block(p, seg, smem, blk);
    if (SEN(3) && blk >= 64 && blk < 128) rwkv_scan_block(p, seg, smem, blk - 64);
#ifndef DUP
#define DUP 0
#endif
    if (seg == 0) {
#pragma unroll 1
        for (int it = blk; it < DECB * 8; it += gridDim.x) gdn_sample_item(p, smem, it >> 3, it & 7);
#pragma unroll 1
        for (int it = blk; it < DECB; it += gridDim.x) rwkv_sample_item(p, smem, it);
    }
}

__device__ __forceinline__ void phase25(const Params& p, int seg) {
    const int tid0 = otid(); const int lane = tid0 & 63; const int gw = obid() * 8 + (tid0 >> 6), NGW = gridDim.x * 8;
    const bf16_t* P = (const bf16_t*)(p.ws + WS_P);
    const float* ORAW = (const float*)(p.ws + WS_ORAW); const float* YRAW = (const float*)(p.ws + WS_YRAW);
    const bf16_t* C0 = (const bf16_t*)(p.ws + WS_C0); const bf16_t* C1 = (const bf16_t*)(p.ws + WS_C1);
    bf16_t* OA = (bf16_t*)(p.ws + WS_H); bf16_t* OB = (bf16_t*)(p.ws + WS_OB);
    const int nrows = LEX0 + (seg == 0 ? DECB * DECT : 0);
    const int c = lane * 16;
    f32x4 nw[4];
#pragma unroll
    for (int j = 0; j < 4; ++j) nw[j] = *(const f32x4*)((const float*)(p.ws + WS_PK) + PK_NORMW + (c & 127) + 4 * j);
#pragma unroll 1
    for (int rr = LEX0 + gw; rr < nrows; rr += NGW) {
        int lr; size_t grow;
        if (rr < LEX0) { lr = rr; grow = (size_t)(rr / SEGTOK) * SEQ + seg * SEGTOK + (rr % SEGTOK); } else { lr = LEX0 + EX_SAMP + (rr - LEX0); grow = (size_t)XROWS + EX_SAMP + (rr - LEX0); }
        {
            f32x4 o[4]; float ss = 0.f;
#pragma unroll
            for (int j = 0; j < 4; ++j) { o[j] = *(const f32x4*)(ORAW + (size_t)lr * D + c + 4 * j); ss += o[j][0] * o[j][0] + o[j][1] * o[j][1] + o[j][2] * o[j][2] + o[j][3] * o[j][3]; }
            ss += __shfl_xor(ss, 1); ss += __shfl_xor(ss, 2); ss += __shfl_xor(ss, 4);
            const float rs = __builtin_amdgcn_rsqf(ss * (1.f / 128.f) + 1e-6f);
            const u32x4 z0 = *(const u32x4*)(P + (size_t)lr * NPB + C_Z + c), z1 = *(const u32x4*)(P + (size_t)lr * NPB + C_Z + c + 8);
            const unsigned zz[8] = {z0.x, z0.y, z0.z, z0.w, z1.x, z1.y, z1.z, z1.w};
            unsigned ow[8];
#pragma unroll
            for (int j = 0; j < 8; ++j) { const float za = __uint_as_float(zz[j] << 16), zb = __uint_as_float(zz[j] & 0xffff0000u);
                const float a = o[j >> 1][(j & 1) * 2] * rs * nw[j >> 1][(j & 1) * 2] * silu_(za), b = o[j >> 1][(j & 1) * 2 + 1] * rs * nw[j >> 1][(j & 1) * 2 + 1] * silu_(zb);
                ow[j] = pk2(a, b); }
            *(u32x4*)(OA + grow * D + c) = (u32x4){ow[0], ow[1], ow[2], ow[3]}; *(u32x4*)(OA + grow * D + c + 8) = (u32x4){ow[4], ow[5], ow[6], ow[7]};
        }
    }
}

__device__ __forceinline__ void phase_final(const Params& p) {
    const int tid0 = otid(); const int lane = tid0 & 63; const int gw = obid() * 8 + (tid0 >> 6), NGW = gridDim.x * 8;
    const float* lw = (const float*)(p.ws + WS_PK) + PK_LNF + 16 * lane;
    f32x4 wv[4];
#pragma unroll
    for (int j = 0; j < 4; ++j) wv[j] = *(const f32x4*)(lw + 4 * j);
    constexpr int NR = XROWS + DECB * DECT;
#pragma unroll 1
    for (int r = gw; r < NR; r += 2 * NGW) {
        const int r1 = r + NGW; const bool has1 = r1 < NR;
        float* y0 = p.out + (size_t)r * D; float* y1 = p.out + (size_t)(has1 ? r1 : r) * D;
        const u32x4 a0 = *(const u32x4*)((const bf16_t*)y0 + 16 * lane), a1 = *(const u32x4*)((const bf16_t*)y0 + 16 * lane + 8);
        const u32x4 b0 = *(const u32x4*)((const bf16_t*)y1 + 16 * lane), b1 = *(const u32x4*)((const bf16_t*)y1 + 16 * lane + 8);
        float a[16], b[16];
        { float t[8]; unpack8(a0, t);
#pragma unroll
          for (int e = 0; e < 8; ++e) a[e] = t[e];
          unpack8(a1, t);
#pragma unroll
          for (int e = 0; e < 8; ++e) a[8 + e] = t[e];
          unpack8(b0, t);
#pragma unroll
          for (int e = 0; e < 8; ++e) b[e] = t[e];
          unpack8(b1, t);
#pragma unroll
          for (int e = 0; e < 8; ++e) b[8 + e] = t[e]; }
        float s0 = 0.f, s1 = 0.f;
#pragma unroll
        for (int e = 0; e < 16; ++e) { s0 += a[e] * a[e]; s1 += b[e] * b[e]; }
        const float q0 = __builtin_amdgcn_rsqf(wave_sum(s0) * (1.f / D) + 1e-6f), q1 = __builtin_amdgcn_rsqf(wave_sum(s1) * (1.f / D) + 1e-6f);
        asm volatile("s_waitcnt vmcnt(0)" ::: "memory");
#pragma unroll
        for (int j = 0; j < 4; ++j) *(f32x4*)(y0 + 16 * lane + 4 * j) = (f32x4){a[4 * j] * q0 * wv[j][0], a[4 * j + 1] * q0 * wv[j][1], a[4 * j + 2] * q0 * wv[j][2], a[4 * j + 3] * q0 * wv[j][3]};
        if (has1) {
#pragma unroll
            for (int j = 0; j < 4; ++j) *(f32x4*)(y1 + 16 * lane + 4 * j) = (f32x4){b[4 * j] * q1 * wv[j][0], b[4 * j + 1] * q1 * wv[j][1], b[4 * j + 2] * q1 * wv[j][2], b[4 * j + 3] * q1 * wv[j][3]}; }
    }
}

__global__ __launch_bounds__(512, 2) void hybrid_mega(Params p) {
    extern __shared__ __attribute__((aligned(16))) unsigned char smem[];
    cg::grid_group grid = cg::this_grid();
    LAS unsigned char* lds = (LAS unsigned char*)smem;
    const int G = gridDim.x;
    volatile LAS unsigned* xst = (volatile LAS unsigned*)(lds + (LDS_TOTAL - 16));
    if (threadIdx.x == 0) { xst[0] = 0u; xst[1] = 0u; }
    __syncthreads();
    (void)xcd_barrier_post((unsigned*)(p.ws + WS_BAR), xst);
    if (G == 0x7fffffff) grid.sync();
#define GSYNC() do { XcdBarrier xb_; xb_.bar = (unsigned*)(p.ws + WS_BAR); xb_.x = xb_xcc_id(); xb_.st = (volatile LAS unsigned*)((LAS unsigned char*)smem + (LDS_TOTAL - 16)); xcd_barrier(xb_); } while (0)

#ifndef ONLY
#define ONLY 0
#endif
#define EN(x) (ONLY == 0 || ONLY == (x))
    if (EN(1)) phase0(p, smem);
    GSYNC();
#pragma unroll 1
    for (int it = 0; it <= NSEG + 2; ++it) {
        const int xblk = obid() - (G - 12);
        const bool xrole = xblk >= 0;
        if (it > 0 && it <= NSEG && EN(3)) phase2(p, it - 1, smem);
        if ((((it == 2 || it == 3) && xrole) || it == NSEG + 1) && EN(5)) {
            const bool ex = it <= 3;
            SchedAB S; S.ob.init(ex ? 3 : XROWS / 256, 4, ex ? 12 : G, ex ? xblk : obid()); S.pm0 = ex ? XROWS / 256 : 0; S.wfix = ex ? it - 2 : -1;
            S.A0 = (const char*)(p.ws + WS_H); S.A1 = (const char*)(p.ws + WS_OB); S.B0 = (const char*)(p.ws + WS_WT_A); S.B1 = (const char*)(p.ws + WS_WT_B);
            EpiAB E; E.tmp = ex ? (bf16_t*)(p.ws + WS_YRAW) - (size_t)XROWS * D : (bf16_t*)(p.ws + WS_P); E.merged = ex ? (bf16_t*)(p.ws + WS_C0) - (size_t)XROWS * D : (bf16_t*)(p.ws + WS_MG);
            E.gex = (const bf16_t*)(p.ws + WS_GEX); E.out = p.out; E.pairmode = ex ? 0 : 1;
            pg8::gemm_phase<EpiAB, SchedAB>(lds, D, S, E);
        }
        if (((it == 4 && xrole) || it == NSEG + 2) && EN(6)) {
            const bool ex = it == 4;
            SchedO S; S.ob.init(ex ? 3 : XROWS / 256, 4, ex ? 12 : G, ex ? xblk : obid()); S.pm0 = ex ? XROWS / 256 : 0;
            S.A = ex ? (const char*)((bf16_t*)(p.ws + WS_C0) - (size_t)XROWS * D) : (const char*)(p.ws + WS_MG); S.B = (const char*)(p.ws + WS_WT_O);
            EpiO E; E.out = p.out; E.xp = p.in[0]; E.xs = p.in[1];
            pg8::gemm_phase<EpiO, SchedO>(lds, D, S, E);
        }
        const bool xphase = it >= 2 && it <= 4;
        if (it < NSEG && EN(2) && !(xphase && xrole)) {
            const int seg = it;
            const int Gp = xphase ? G - 12 : G;
            const int cidx = it > 0 ? (obid() + (Gp >> 1)) % Gp : obid();
            SchedIn S; S.ob.init(seg == 0 ? LT_PROMPT + 3 : LT_PROMPT, NT_IN, Gp, cidx); S.seg = seg; S.A = (const char*)(p.ws + WS_H); S.B = (const char*)(p.ws + WS_WT_IN);
            EpiIn E; E.P = (bf16_t*)(p.ws + WS_P); E.gex = (bf16_t*)(p.ws + WS_GEX); E.out = p.out; E.seg = seg;
            pg8::gemm_phase<EpiIn, SchedIn>(lds, D, S, E);
        }
        {
            const int hlo = 208, hhi = (it >= 2 && it <= 4) ? G - 12 : G;
            if (it >= 1 && it + 1 < NSEG && obid() >= hlo && obid() < hhi) { const int t0 = otid(); h_rows_segs(p, it + 1, it + 2, (obid() - hlo) * 8 + (t0 >> 6), (hhi - hlo) * 8, t0 & 63); }
        }
        GSYNC();
        if (it < NSEG) {
            if (EN(8)) { phase_gprep(p, it, smem); phase_rprep(p, it, smem); }
            if (it == 1 && EN(4)) phase25(p, 0);
            GSYNC();
        }
    }
    if (EN(7)) phase_final(p);
}

extern "C" void kernel_launch(void* const* d_in, const int* in_sizes, int n_in, void* d_out, int out_size, void* d_ws, size_t ws_size, hipStream_t stream) {
    static int grid_blocks = 0;
    constexpr int LDS_BYTES = LDS_TOTAL;
    if (grid_blocks == 0) {
        if (n_in != 27 || ws_size < WS_END) { fprintf(stderr, "kernel_launch: unexpected n_in %d / ws %zu (need %zu)\n", n_in, ws_size, (size_t)WS_END); grid_blocks = -1; return; }
        if (hipFuncSetAttribute((const void*)hybrid_mega, hipFuncAttributeMaxDynamicSharedMemorySize, LDS_BYTES) != hipSuccess) { fprintf(stderr, "kernel_launch: hipFuncSetAttribute failed\n"); grid_blocks = -1; return; }
        int dev = 0, cus = 0, per_cu = 0;
        hipGetDevice(&dev);
        hipDeviceGetAttribute(&cus, hipDeviceAttributeMultiprocessorCount, dev);
        hipOccupancyMaxActiveBlocksPerMultiprocessor(&per_cu, (const void*)hybrid_mega, 512, LDS_BYTES);
        if (per_cu < 1) { fprintf(stderr, "kernel_launch: occupancy query says %d blocks/CU\n", per_cu); per_cu = 1; }
        (void)hipGetLastError();
        grid_blocks = cus;
    }
    if (grid_blocks < 0) return;
    Params p{};
    for (int i = 0; i < 27; ++i) p.in[i] = (const float*)d_in[i];
    p.out = (float*)d_out; p.ws = (unsigned char*)d_ws;
    if (hipMemsetAsync((unsigned char*)d_ws + WS_BAR, 0, 16384, stream) != hipSuccess) { fprintf(stderr, "kernel_launch: memset of the barrier words failed\n"); return; }
    void* args[] = {&p};
    hipError_t e = hipLaunchCooperativeKernel((const void*)hybrid_mega, dim3(grid_blocks), dim3(512), args, LDS_BYTES, stream);
    if (e != hipSuccess) fprintf(stderr, "cooperative launch failed: %s (grid %d)\n", hipGetErrorString(e), grid_blocks);
}
```

```cpp
#include <hip/hip_runtime.h>
#include <hip/hip_cooperative_groups.h>
#include <cstdio>
namespace cg = cooperative_groups;

#define LAS __attribute__((address_space(3)))
typedef unsigned short bf16_t;
typedef short bf16x8 __attribute__((ext_vector_type(8)));
typedef float f32x4 __attribute__((ext_vector_type(4)));
typedef unsigned u32x4 __attribute__((ext_vector_type(4)));
typedef unsigned u32x2 __attribute__((ext_vector_type(2)));

constexpr int D = 1024;
constexpr int NBATCH = 8, SEQ = 2048, NMETA = 16, DECB = 128, DECT = 4;
constexpr int XROWS = NBATCH * SEQ;
constexpr int EX_SAMP = 16, EX_SHIFT = 528, EX_END = 656;
constexpr int HROWS = 17152, HTILES = 67;
constexpr int NSEG = 8, SEGTOK = SEQ / NSEG;
constexpr int CPS = SEGTOK / 64;
constexpr int TPB = SEGTOK / 256;
constexpr int LT_PROMPT = NBATCH * TPB;
constexpr int LEX0 = LT_PROMPT * 256;
constexpr int LROWS = LEX0 + 768;
constexpr int NP = 10496, NPB = 8448, NT_IN = 41, NT_PB = 33;
constexpr int C_A = 3072, C_B = 3080, C_Z = 3088, C_RW = 4112, C_GATE_REF = 8336;
constexpr int RW_SHIFT = 4224;

constexpr size_t O_YP = 0, O_YS = 16777216, O_GDN_P = 17301504, O_CONV_P = 18350080, O_RWKV_P = 18423808, O_SHIFT_P = 18948096,
                 O_GDN_S = 18956288, O_CONV_S = 35733504, O_RWKV_S = 36913152, O_SHIFT_S = 45301760;

constexpr size_t al256(size_t x) { return (x + 255) & ~(size_t)255; }
constexpr size_t WS_WT_IN = 0;
constexpr size_t WS_WT_A = al256(WS_WT_IN + (size_t)NP * D * 2);
constexpr size_t WS_WT_B = al256(WS_WT_A + (size_t)D * D * 2);
constexpr size_t WS_WT_O = al256(WS_WT_B + (size_t)D * D * 2);
constexpr size_t WS_H = al256(WS_WT_O + (size_t)D * D * 2);
constexpr size_t WS_OB = al256(WS_H + (size_t)HROWS * D * 2);
constexpr size_t WS_P = al256(WS_OB + (size_t)HROWS * D * 2);
constexpr size_t WS_ORAW = al256(WS_P + (size_t)LROWS * NPB * 2);
constexpr size_t WS_YRAW = al256(WS_ORAW + (size_t)LROWS * D * 4);
constexpr size_t WS_C0 = al256(WS_YRAW + (size_t)LROWS * D * 4);
constexpr size_t WS_C1 = al256(WS_C0 + (size_t)LROWS * D * 2);
constexpr size_t WS_GEX = al256(WS_C1 + (size_t)LROWS * D * 2);
constexpr size_t WS_CHALO = al256(WS_GEX + (size_t)768 * 2048 * 2);
constexpr size_t WS_PHALO = al256(WS_CHALO + (size_t)2 * NBATCH * 3 * NPB * 2);
constexpr size_t WS_PK = al256(WS_PHALO + (size_t)2 * NBATCH * NPB * 2);
constexpr int PK_CONVW = 0, PK_ALOG = 12288, PK_DTB = 12296, PK_NORMW = 12304, PK_MU = 12432, PK_W0 = 16656, PK_W2 = 17680, PK_A0 = 83216, PK_A2 = 84240,
              PK_KK = 149776, PK_KA = 150800, PK_RK = 151824, PK_GNW = 152848, PK_GNB = 153872, PK_LNF = 154896, PK_END = 155920;
constexpr size_t WS_BAR = al256(WS_PK + (size_t)PK_END * 4);
constexpr size_t WS_W2T = al256(WS_BAR + 16384);
constexpr size_t WS_A2T = al256(WS_W2T + 131072);
constexpr size_t WS_GP = al256(WS_A2T + 131072);
constexpr int GP_AP = 0, GP_QH = 32768, GP_KH = 49152, GP_OH = 81920, GP_EGL = 98304, GP_G = 98560, GP_STRIDE = 114944;
constexpr int RP_AP = 0, RP_RH = 8192, RP_KH = 16384, RP_YH = 24576, RP_C1 = 32768, RP_C0 = 40960, RP_PC = 49152, RP_STRIDE = 49408;
constexpr size_t WS_RP = al256(WS_GP + (size_t)(CPS + 1) * 64 * GP_STRIDE);
constexpr size_t WS_END = al256(WS_RP + (size_t)(CPS + 1) * 128 * RP_STRIDE);
constexpr size_t WS_MG = WS_GP;
static_assert((size_t)HROWS * D * 2 <= WS_END - WS_GP, "MERGED must fit in the prep records");
static_assert((size_t)HROWS * D * 4 <= (size_t)LROWS * NPB * 2 + 2 * (size_t)LROWS * D * 4, "TMP must fit in P+ORAW+YRAW");
static_assert(WS_END <= (size_t)268435456, "workspace");

constexpr int LDS_TOTAL = 163840;
struct Params { const float* in[27]; float* out; unsigned char* ws; };

__device__ __forceinline__ float bf2f(bf16_t v) { return __uint_as_float(((unsigned)v) << 16); }
typedef __bf16 bf16n2 __attribute__((ext_vector_type(2)));
typedef float f32n2 __attribute__((ext_vector_type(2)));
__device__ __forceinline__ unsigned cvt_pk_bf16(float lo, float hi) { const f32n2 v = {lo, hi}; return __builtin_bit_cast(unsigned, __builtin_convertvector(v, bf16n2)); }
__device__ __forceinline__ unsigned pk2(float lo, float hi) { return cvt_pk_bf16(lo, hi); }
__device__ __forceinline__ unsigned f2bf(float f) { return cvt_pk_bf16(f, 0.f) & 0xffffu; }
__device__ __forceinline__ float sigm(float x) { return __builtin_amdgcn_rcpf(1.f + __expf(-x)); }
__device__ __forceinline__ float silu_(float x) { return x * __builtin_amdgcn_rcpf(1.f + __expf(-x)); }
__device__ __forceinline__ float softplus_(float x) { return fmaxf(x, 0.f) + log1pf(expf(-fabsf(x))); }
__device__ __forceinline__ float wave_sum(float v) {
#pragma unroll
    for (int o = 1; o < 64; o <<= 1) v += __shfl_xor(v, o);
    return v;
}
__device__ __forceinline__ void unpack8(const u32x4 rw, float (&x)[8]) {
    x[0] = __uint_as_float(rw.x << 16); x[1] = __uint_as_float(rw.x & 0xffff0000u); x[2] = __uint_as_float(rw.y << 16); x[3] = __uint_as_float(rw.y & 0xffff0000u);
    x[4] = __uint_as_float(rw.z << 16); x[5] = __uint_as_float(rw.z & 0xffff0000u); x[6] = __uint_as_float(rw.w << 16); x[7] = __uint_as_float(rw.w & 0xffff0000u); }
__device__ __forceinline__ u32x4 pack8(const float (&x)[8]) { return (u32x4){pk2(x[0], x[1]), pk2(x[2], x[3]), pk2(x[4], x[5]), pk2(x[6], x[7])}; }

__device__ __forceinline__ int otid() { int t = threadIdx.x; asm volatile("" : "+v"(t)); return t; }
__device__ __forceinline__ int obid() { int t = blockIdx.x; asm volatile("" : "+s"(t)); return t; }
__device__ __forceinline__ float tanh_(float x) { const float e = __expf(2.f * x); return 1.f - 2.f * __builtin_amdgcn_rcpf(e + 1.f); }
template <int CTRL> __device__ __forceinline__ float dppf(float x) { return __builtin_bit_cast(float, __builtin_amdgcn_mov_dpp(__builtin_bit_cast(int, x), CTRL, 0xf, 0xf, true)); }
__device__ __forceinline__ float rowsum16(float x) { x += dppf<0x128>(x); x += dppf<0x124>(x); x += dppf<0x122>(x); x += dppf<0x121>(x); return x; }


#define XB_TMO      128
#define XB_XCNT(j)  (256  + 64 * (j))
#define XB_XSUB(j)  (1280 + 64 * (j))
#define XB_XGEN(j)  (2304 + 64 * (j))
#define XB_TOP      3328
#define XB_TOPGEN   3392
#define XCD_BAR_WORDS 3456
#define XB_SPIN_CAP (1u << 22)
__device__ __forceinline__ unsigned xb_ld(unsigned* p)              { return __hip_atomic_load(p, __ATOMIC_RELAXED, __HIP_MEMORY_SCOPE_AGENT); }
__device__ __forceinline__ unsigned xb_add(unsigned* p, unsigned v) { return __hip_atomic_fetch_add(p, v, __ATOMIC_RELAXED, __HIP_MEMORY_SCOPE_AGENT); }
__device__ __forceinline__ unsigned xb_xcc_id() { return (unsigned)__builtin_amdgcn_s_getreg((3 << 11) | 20) & 0xFu; }
#define XB_SPIN(cond, bar) do { unsigned _sp = 0; while (cond) { __builtin_amdgcn_s_sleep(1); \
    if ((++_sp & 255u) == 0u) { if (xb_ld(&(bar)[XB_TMO])) break; if (_sp > XB_SPIN_CAP) { atomicAdd(&(bar)[XB_TMO], 1u); break; } } } } while (0)
struct XcdBarrier { unsigned* bar; unsigned x; volatile LAS unsigned* st; };
__device__ __forceinline__ XcdBarrier xcd_barrier_post(unsigned* bar, volatile LAS unsigned* st) {
    XcdBarrier b; b.bar = bar; b.x = xb_xcc_id(); b.st = st;
    if (threadIdx.x == 0) (void)xb_add(&bar[XB_XCNT(b.x)], 1u);
    return b;
}
__device__ __forceinline__ void xcd_barrier_complete(unsigned* bar, unsigned x, unsigned& nloc, unsigned& nx) {
    const unsigned G = gridDim.x * gridDim.y * gridDim.z;
    unsigned sum, cnt, mine, sp = 0u;
    for (;;) {
        sum = 0u; cnt = 0u; mine = 0u;
#pragma unroll
        for (unsigned j = 0; j < 16; ++j) { const unsigned c = xb_ld(&bar[XB_XCNT(j)]); sum += c; cnt += (c > 0u) ? 1u : 0u; mine = (j == x) ? c : mine; }
        if (sum == G) break;
        __builtin_amdgcn_s_sleep(1);
        if ((++sp & 255u) == 0u) { if (xb_ld(&bar[XB_TMO])) break; if (sp > XB_SPIN_CAP) { atomicAdd(&bar[XB_TMO], 1u); break; } }
    }
    nloc = mine > 0u ? mine : 1u; nx = cnt > 0u ? cnt : 1u;
}
__device__ __forceinline__ void xcd_barrier(const XcdBarrier& b) {
    asm volatile("s_waitcnt vmcnt(0)" ::: "memory");
    __syncthreads();
    if (threadIdx.x == 0) {
        unsigned* bar = b.bar;
        __builtin_amdgcn_s_waitcnt(0);
        unsigned nloc = b.st[0], nx = b.st[1];
        if (nloc == 0u) { xcd_barrier_complete(bar, b.x, nloc, nx); b.st[0] = nloc; b.st[1] = nx; }
        const unsigned old = xb_add(&bar[XB_XSUB(b.x)], 1u);
        const unsigned gen = old / nloc;
        if (old + 1u == (gen + 1u) * nloc) {
            __builtin_amdgcn_fence(__ATOMIC_RELEASE, "agent");
            asm volatile("s_waitcnt vmcnt(0)" ::: "memory");
            const unsigned og = xb_add(&bar[XB_TOP], 1u);
            const unsigned tg = og / nx;
            if (og + 1u == (tg + 1u) * nx) xb_add(&bar[XB_TOPGEN], 1u);
            else XB_SPIN(xb_ld(&bar[XB_TOPGEN]) == tg, bar);
            __builtin_amdgcn_fence(__ATOMIC_ACQUIRE, "agent");
            xb_add(&bar[XB_XGEN(b.x)], 1u);
            asm volatile("s_waitcnt vmcnt(0)" ::: "memory");
        } else {
            XB_SPIN(xb_ld(&bar[XB_XGEN(b.x)]) == gen, bar);
            __builtin_amdgcn_fence(__ATOMIC_ACQUIRE, "agent");
            asm volatile("s_waitcnt vmcnt(0)" ::: "memory");
        }
    }
    __syncthreads();
}

namespace pg8 {
constexpr int BM = 256, BK = 64, HALF = 128, HTB = HALF * BK * 2, STAGE_BYTES = 8 * HTB, NXCD = 8, WGM = 8;
__device__ __forceinline__ int lds_byte(int r, int c) { const int st = (r >> 4) * 2 + (c >> 5), rr = r & 15, cc = c & 31, ob = rr * 64 + cc * 2; return st * 1024 + (ob ^ (((ob >> 9) & 1) << 5)); }
__device__ __forceinline__ void stage_rc(int b, int& R, int& C) { const int st = b / 1024, sb = b % 1024, swz = sb ^ (((sb >> 9) & 1) << 5); R = (st >> 1) * 16 + swz / 64; C = (st & 1) * 32 + (swz % 64) / 2; }
__device__ __forceinline__ int perm32(int rho) { const int n = rho >> 4, i = rho & 15; return 8 * (i >> 2) + 4 * n + (i & 3); }

struct Unit { int pm, pn, w; };
struct OrderBase {
    int nM, nN, nwg, G, c;
    __device__ void init(int nM_, int nN_, int G_, int c_) { nM = nM_; nN = nN_; nwg = nM * nN; G = G_; c = c_; }
    __device__ bool nextb(int i, Unit& u) const {
        const long L = (long)i * G + c; if (L >= nwg) return false;
        int wgid = (int)L; { const int q = nwg / NXCD, r = nwg % NXCD, xcd = wgid % NXCD, off = wgid / NXCD; wgid = (xcd < r ? xcd * (q + 1) : r * (q + 1) + (xcd - r) * q) + off; }
        const int nig = WGM * nN, gid = wgid / nig, fm = gid * WGM, gsz = (nM - fm) < WGM ? (nM - fm) : WGM;
        u.pm = fm + ((wgid % nig) % gsz); u.pn = (wgid % nig) / gsz; u.w = 0; return true;
    }
};

template <class Epi, class Sched>
__device__ __forceinline__ void gemm_phase(LAS unsigned char* lds, const int K, const Sched& S, const Epi& E) {
    const int tid = otid(), wid = __builtin_amdgcn_readfirstlane(tid >> 6), lane = tid & 63, wr = wid >> 2, wc = wid & 3, fr = lane & 15, fq = lane >> 4;
    const int nt = K / BK;
    unsigned voffA[2], voffB[2];
#pragma unroll
    for (int i = 0; i < 2; ++i) { int R, C; stage_rc(tid * 16 + i * 8192, R, C); const int Rb = Epi::PERM ? ((R & ~31) + perm32(R & 31)) : R;
        voffA[i] = (unsigned)(R * K + C) * 2u; voffB[i] = (unsigned)(Rb * K + C) * 2u; }
    const size_t kstep = (size_t)(BK * 2);
    const size_t hstep = (size_t)HALF * K * 2;
    const unsigned ldsw = (unsigned)wid * 1024u;
    const int aoff = lds_byte(wr * 64 + fr, fq * 8), boff = lds_byte(wc * 32 + fr, fq * 8);
#define PG8_SA(b, h) (((b) * 2 + (h)) * HTB)
#define PG8_SB(b, h) ((4 + (b) * 2 + (h)) * HTB)
#define PG8_STAGE(bufoff, gbase, voff) do { _Pragma("unroll") for (int _i = 0; _i < 2; ++_i) \
        __builtin_amdgcn_global_load_lds((const unsigned*)((const char*)(gbase) + (voff)[_i]), (LAS unsigned*)(lds + (bufoff) + ldsw + _i * 8192), 16, 0, 0); } while (0)
#define PG8_LDA(dst, b, h) do { _Pragma("unroll") for (int m = 0; m < 4; ++m) _Pragma("unroll") for (int k = 0; k < 2; ++k) dst[m][k] = *(const LAS bf16x8*)(lds + PG8_SA(b, h) + aoff + m * 2048 + k * 1024); } while (0)
#define PG8_LDB(dst, b, h) do { _Pragma("unroll") for (int n = 0; n < 2; ++n) _Pragma("unroll") for (int k = 0; k < 2; ++k) dst[n][k] = *(const LAS bf16x8*)(lds + PG8_SB(b, h) + boff + n * 2048 + k * 1024); } while (0)
#define PG8_MMA(ai, bj, At, Bt) do { __builtin_amdgcn_s_setprio(1); _Pragma("unroll") for (int m = 0; m < 4; ++m) _Pragma("unroll") for (int n = 0; n < 2; ++n) _Pragma("unroll") for (int k = 0; k < 2; ++k) \
        acc[ai][bj][m][n] = __builtin_amdgcn_mfma_f32_16x16x32_bf16(Bt[n][k], At[m][k], acc[ai][bj][m][n], 0, 0, 0); __builtin_amdgcn_s_setprio(0); } while (0)
#define PG8_WAIT_V(n) asm volatile("s_waitcnt vmcnt(" #n ")" ::: "memory")
#define PG8_WAIT_L(n) asm volatile("s_waitcnt lgkmcnt(" #n ")" ::: "memory")
#define PG8_BAR __builtin_amdgcn_s_barrier()
#define PG8_SCHED __builtin_amdgcn_sched_barrier(0)
    Unit cur, nxt; int ui = 0;
    if (!S.next(0, cur)) return;
    f32x4 acc[2][2][4][2];
#pragma unroll
    for (int a = 0; a < 2; ++a)
#pragma unroll
        for (int b = 0; b < 2; ++b)
#pragma unroll
            for (int m = 0; m < 4; ++m)
#pragma unroll
                for (int n = 0; n < 2; ++n) acc[a][b][m][n] = (f32x4){0.f, 0.f, 0.f, 0.f};
    bf16x8 At[4][2], B0[2][2], B1[2][2];
    const char* cA = S.a_ptr(cur); const char* cB = S.b_ptr(cur);
    PG8_STAGE(PG8_SB(0, 0), cB, voffB); PG8_STAGE(PG8_SA(0, 0), cA, voffA); PG8_STAGE(PG8_SB(0, 1), cB + hstep, voffB); PG8_STAGE(PG8_SA(0, 1), cA + hstep, voffA);
    if (wr == 1) PG8_BAR;
    PG8_WAIT_V(4); PG8_BAR;
    PG8_STAGE(PG8_SB(1, 0), cB + kstep, voffB); PG8_STAGE(PG8_SA(1, 0), cA + kstep, voffA); PG8_STAGE(PG8_SB(1, 1), cB + hstep + kstep, voffB);
    PG8_WAIT_V(6); PG8_BAR;
    for (;;) {
        const bool has_next = S.next(ui + 1, nxt);
        const char* nA = has_next ? S.a_ptr(nxt) : cA; const char* nB = has_next ? S.b_ptr(nxt) : cB;
        for (int t = 0; t < nt; t += 2) {
            const bool last = (t == nt - 2);
            const char* a1 = cA + (size_t)(t + 1) * kstep;
            const char* a2 = last ? nA : cA + (size_t)(t + 2) * kstep; const char* b2 = last ? nB : cB + (size_t)(t + 2) * kstep;
            const char* a3 = a2 + kstep; const char* b3 = b2 + kstep;
            PG8_LDB(B0, 0, 0); PG8_SCHED; PG8_LDA(At, 0, 0); PG8_STAGE(PG8_SA(1, 1), a1 + hstep, voffA);
            PG8_WAIT_L(8); PG8_BAR; PG8_WAIT_L(0); PG8_MMA(0, 0, At, B0); PG8_BAR; PG8_SCHED;
            PG8_LDB(B1, 0, 1); PG8_STAGE(PG8_SB(0, 0), b2, voffB);
            PG8_BAR; PG8_WAIT_L(0); PG8_MMA(0, 1, At, B1); PG8_BAR;
            PG8_LDA(At, 0, 1); PG8_STAGE(PG8_SA(0, 0), a2, voffA);
            PG8_BAR; PG8_WAIT_L(0); PG8_MMA(1, 0, At, B0); PG8_BAR; PG8_SCHED;
            PG8_STAGE(PG8_SB(0, 1), b2 + hstep, voffB);
            PG8_WAIT_V(6); PG8_BAR; PG8_MMA(1, 1, At, B1); PG8_BAR;
            PG8_LDB(B0, 1, 0); PG8_SCHED; PG8_LDA(At, 1, 0); PG8_STAGE(PG8_SA(0, 1), a2 + hstep, voffA);
            PG8_WAIT_L(8); PG8_BAR; PG8_WAIT_L(0); PG8_MMA(0, 0, At, B0); PG8_BAR; PG8_SCHED;
            PG8_LDB(B1, 1, 1); PG8_STAGE(PG8_SB(1, 0), b3, voffB);
            PG8_BAR; PG8_WAIT_L(0); PG8_MMA(0, 1, At, B1); PG8_BAR;
            PG8_LDA(At, 1, 1); PG8_STAGE(PG8_SA(1, 0), a3, voffA);
            PG8_BAR; PG8_WAIT_L(0); PG8_MMA(1, 0, At, B0); PG8_BAR; PG8_SCHED;
            PG8_STAGE(PG8_SB(1, 1), b3 + hstep, voffB);
            PG8_WAIT_V(6); PG8_BAR; PG8_MMA(1, 1, At, B1); PG8_BAR;
        }
        E(acc, cur, wr, wc, fr, fq);
        if (!has_next) break;
        if (!E.keep(cur)) {
#pragma unroll
        for (int a = 0; a < 2; ++a)
#pragma unroll
            for (int b = 0; b < 2; ++b)
#pragma unroll
                for (int m = 0; m < 4; ++m)
#pragma unroll
                    for (int n = 0; n < 2; ++n) acc[a][b][m][n] = (f32x4){0.f, 0.f, 0.f, 0.f};
        }
        cur = nxt; cA = nA; cB = nB; ++ui;
    }
    PG8_WAIT_V(0);
    if (wr == 0) PG8_BAR;
    PG8_BAR;
#undef PG8_SA
#undef PG8_SB
#undef PG8_STAGE
#undef PG8_LDA
#undef PG8_LDB
#undef PG8_MMA
#undef PG8_WAIT_V
#undef PG8_WAIT_L
#undef PG8_BAR
#undef PG8_SCHED
}
}
using pg8::Unit;

struct SchedIn {
    pg8::OrderBase ob; int seg; const char* A; const char* B;
    __device__ bool next(int i, Unit& u) const { return ob.nextb(i, u); }
    __device__ const char* a_ptr(const Unit& u) const {
        const int gt = u.pm < LT_PROMPT ? ((u.pm / TPB) * (SEQ / 256) + seg * TPB + (u.pm % TPB)) : (XROWS / 256 + (u.pm - LT_PROMPT));
        return A + (size_t)gt * 256 * D * 2; }
    __device__ const char* b_ptr(const Unit& u) const { return B + (size_t)u.pn * 256 * D * 2; }
};
struct SchedAB {
    pg8::OrderBase ob; int pm0, wfix; const char* A0; const char* A1; const char* B0; const char* B1;
    __device__ bool next(int i, Unit& u) const { const bool ok = wfix < 0 ? ob.nextb(i >> 1, u) : ob.nextb(i, u); u.pm += pm0; u.w = wfix < 0 ? (i & 1) : wfix; return ok; }
    __device__ const char* a_ptr(const Unit& u) const { return (u.w ? A1 : A0) + (size_t)u.pm * 256 * D * 2; }
    __device__ const char* b_ptr(const Unit& u) const { return (u.w ? B1 : B0) + (size_t)u.pn * 256 * D * 2; }
};
struct SchedO {
    pg8::OrderBase ob; int pm0; const char* A; const char* B;
    __device__ bool next(int i, Unit& u) const { const bool ok = ob.nextb(i, u); u.pm += pm0; return ok; }
    __device__ const char* a_ptr(const Unit& u) const { return A + (size_t)u.pm * 256 * D * 2; }
    __device__ const char* b_ptr(const Unit& u) const { return B + (size_t)u.pn * 256 * D * 2; }
};

struct EpiIn {
    static constexpr bool PERM = true;
    bf16_t* P; bf16_t* gex; float* out; int seg;
    __device__ __forceinline__ bool keep(const Unit&) const { return false; }
    __device__ __forceinline__ void operator()(const f32x4 (&acc)[2][2][4][2], const Unit& u, int wr, int wc, int fr, int fq) const {
        const int lr0 = u.pm * 256 + wr * 64 + fr;
        const int c0 = u.pn * 256 + wc * 32 + 8 * fq;
#pragma unroll
        for (int ai = 0; ai < 2; ++ai)
#pragma unroll
            for (int m = 0; m < 4; ++m) {
                const int lr = lr0 + ai * 128 + m * 16;
                bf16_t* rowp;
                if (u.pn < NT_PB) rowp = P + (size_t)lr * NPB + c0;
                else if (lr < LEX0) { const int b = lr / SEGTOK; const size_t grow = (size_t)b * SEQ + seg * SEGTOK + (lr % SEGTOK); rowp = (bf16_t*)(out + O_YP + grow * D) + (c0 - NPB); }
                else rowp = gex + (size_t)(lr - LEX0) * 2048 + (c0 - NPB);
#pragma unroll
                for (int bj = 0; bj < 2; ++bj) { const f32x4 v0 = acc[ai][bj][m][0], v1 = acc[ai][bj][m][1];
                    u32x4 w; w.x = cvt_pk_bf16(v0[0], v0[1]); w.y = cvt_pk_bf16(v0[2], v0[3]); w.z = cvt_pk_bf16(v1[0], v1[1]); w.w = cvt_pk_bf16(v1[2], v1[3]);
                    *(u32x4*)(rowp + bj * 128) = w; }
            }
    }
};
struct EpiAB {
    static constexpr bool PERM = true;
    bf16_t* tmp; bf16_t* merged; const bf16_t* gex; const float* out; int pairmode;
    __device__ __forceinline__ bool keep(const Unit& u) const { return pairmode && u.w == 0; }
    __device__ __forceinline__ void operator()(f32x4 (&acc)[2][2][4][2], const Unit& u, int wr, int wc, int fr, int fq) const {
        const int row0 = u.pm * 256 + wr * 64 + fr, col0 = u.pn * 256 + wc * 32 + 8 * fq;
        if (pairmode) {
#pragma unroll
            for (int ai = 0; ai < 2; ++ai) {
                const bf16_t* g0[4];
#pragma unroll
                for (int m = 0; m < 4; ++m) { const int grow = row0 + ai * 128 + m * 16;
                    g0[m] = (grow < XROWS) ? (const bf16_t*)(out + O_YP + (size_t)grow * D) : (gex + (size_t)(grow - XROWS) * 2048); }
#pragma unroll
                for (int mp = 0; mp < 2; ++mp) {
                u32x4 gbv[2][2], gav[2][2];
#pragma unroll
                for (int mm = 0; mm < 2; ++mm)
#pragma unroll
                    for (int bj = 0; bj < 2; ++bj) { gbv[mm][bj] = *(const u32x4*)(g0[2 * mp + mm] + D + col0 + bj * 128); gav[mm][bj] = (u.w == 0) ? *(const u32x4*)(g0[2 * mp + mm] + col0 + bj * 128) : gbv[mm][bj]; }
#pragma unroll
                for (int mm = 0; mm < 2; ++mm)
#pragma unroll
                    for (int bj = 0; bj < 2; ++bj) { const int m = 2 * mp + mm;
                        float gb[8]; unpack8(gbv[mm][bj], gb);
                        float eb[8];
#pragma unroll
                        for (int e = 0; e < 8; ++e) eb[e] = 1.f + fminf(__expf(-gb[e]), 1e18f);
                        if (u.w == 0) {
                            float ga[8]; unpack8(gav[mm][bj], ga);
#pragma unroll
                            for (int e = 0; e < 4; ++e) { acc[ai][bj][m][0][e] *= sigm(ga[e]) * eb[e]; acc[ai][bj][m][1][e] *= sigm(ga[4 + e]) * eb[4 + e]; }
                        } else {
                            float v[8];
#pragma unroll
                            for (int e = 0; e < 4; ++e) { v[e] = acc[ai][bj][m][0][e] * __builtin_amdgcn_rcpf(eb[e]); v[4 + e] = acc[ai][bj][m][1][e] * __builtin_amdgcn_rcpf(eb[4 + e]); }
                            const int grow = row0 + ai * 128 + m * 16;
                            *(u32x4*)(merged + (size_t)grow * D + col0 + bj * 128) = pack8(v);
                        }
                    }
                asm volatile("" ::: "memory");
                }
            }
            return;
        }
#pragma unroll
        for (int ai = 0; ai < 2; ++ai)
#pragma unroll
            for (int m = 0; m < 4; ++m) {
                const int grow = row0 + ai * 128 + m * 16;
                const bf16_t* g0 = (grow < XROWS) ? (const bf16_t*)(out + O_YP + (size_t)grow * D) : (gex + (size_t)(grow - XROWS) * 2048);
#pragma unroll
                for (int bj = 0; bj < 2; ++bj) {
                    const int c = col0 + bj * 128;
                    float g[8]; unpack8(*(const u32x4*)(g0 + u.w * D + c), g);
                    const f32x4 v0 = acc[ai][bj][m][0], v1 = acc[ai][bj][m][1];
                    float v[8] = {v0[0] * sigm(g[0]), v0[1] * sigm(g[1]), v0[2] * sigm(g[2]), v0[3] * sigm(g[3]), v1[0] * sigm(g[4]), v1[1] * sigm(g[5]), v1[2] * sigm(g[6]), v1[3] * sigm(g[7])};
                    bf16_t* tp = tmp + (size_t)grow * D + c;
                    if (u.w == 0) *(u32x4*)tp = pack8(v);
                    else { float t[8]; unpack8(*(const u32x4*)tp, t);
#pragma unroll
                        for (int e = 0; e < 8; ++e) v[e] += t[e];
                        *(u32x4*)(merged + (size_t)grow * D + c) = pack8(v); }
                }
            }
    }
};
struct EpiO {
    static constexpr bool PERM = false;
    float* out; const float* xp; const float* xs;
    __device__ __forceinline__ bool keep(const Unit&) const { return false; }
    __device__ __forceinline__ void operator()(const f32x4 (&acc)[2][2][4][2], const Unit& u, int wr, int wc, int fr, int fq) const {
        const int row0 = u.pm * 256 + wr * 64 + fr, col0 = u.pn * 256 + wc * 32 + 4 * fq;
#pragma unroll
        for (int ai = 0; ai < 2; ++ai) {
            const float* xr[4]; float* yr[4]; bool ok[4];
#pragma unroll
            for (int m = 0; m < 4; ++m) {
                const int grow = row0 + ai * 128 + m * 16;
                ok[m] = true;
                if (grow < XROWS) { xr[m] = xp + (size_t)grow * D; yr[m] = out + O_YP + (size_t)grow * D; }
                else { const int e = grow - XROWS; ok[m] = !(e < EX_SAMP || e >= EX_SHIFT); const int es = ok[m] ? e - EX_SAMP : 0; xr[m] = xs + (size_t)es * D; yr[m] = out + O_YS + (size_t)es * D; }
            }
#pragma unroll
            for (int mp = 0; mp < 2; ++mp) {
                f32x4 xv[2][2][2];
#pragma unroll
                for (int mm = 0; mm < 2; ++mm)
#pragma unroll
                    for (int bj = 0; bj < 2; ++bj)
#pragma unroll
                        for (int n = 0; n < 2; ++n) xv[mm][bj][n] = *(const f32x4*)(xr[2 * mp + mm] + col0 + bj * 128 + n * 16);
#pragma unroll
                for (int mm = 0; mm < 2; ++mm) { const int m = 2 * mp + mm;
                    if (ok[m]) {
#pragma unroll
                        for (int bj = 0; bj < 2; ++bj)
#pragma unroll
                            for (int n = 0; n < 2; ++n) *(f32x4*)(yr[m] + col0 + bj * 128 + n * 16) = xv[mm][bj][n] + acc[ai][bj][m][n];
                    } }
                asm volatile("" ::: "memory");
            }
        }
    }
};

__device__ __forceinline__ void p0_row(const Params& p, int r, int lane) {
    bf16_t* hrow = (bf16_t*)(p.ws + WS_H) + (size_t)r * D;
    const float* src = nullptr; bool norm = true; float* sh = nullptr;
    if (r < XROWS) { src = p.in[0] + (size_t)r * D; if ((r & (SEQ - 1)) == SEQ - 1) sh = p.out + O_SHIFT_P + (size_t)(r / SEQ) * D; }
    else { const int e = r - XROWS;
        if (e < EX_SAMP) src = p.in[6] + (size_t)e * D;
        else if (e < EX_SHIFT) { src = p.in[1] + (size_t)(e - EX_SAMP) * D; if (((e - EX_SAMP) & 3) == 3) sh = p.out + O_SHIFT_S + (size_t)((e - EX_SAMP) >> 2) * D; }
        else if (e < EX_END) { src = p.in[5] + (size_t)(e - EX_SHIFT) * D; norm = false; } }
    u32x2* o8 = (u32x2*)hrow + lane;
    if (!src) {
#pragma unroll
        for (int j = 0; j < 4; ++j) o8[64 * j] = (u32x2){0u, 0u};
        return; }
    const f32x4* xr = (const f32x4*)src + lane;
    f32x4 v[4]; float ss = 0.f;
#pragma unroll
    for (int j = 0; j < 4; ++j) { v[j] = xr[64 * j]; ss += v[j][0] * v[j][0] + v[j][1] * v[j][1] + v[j][2] * v[j][2] + v[j][3] * v[j][3]; }
    if (norm) {
        const float rs = __builtin_amdgcn_rsqf(wave_sum(ss) * (1.f / D) + 1e-6f);
        const f32x4* wr = (const f32x4*)p.in[7] + lane;
#pragma unroll
        for (int j = 0; j < 4; ++j) v[j] = v[j] * rs * wr[64 * j];
    }
#pragma unroll
    for (int j = 0; j < 4; ++j) { o8[64 * j] = (u32x2){pk2(v[j][0], v[j][1]), pk2(v[j][2], v[j][3])}; if (sh) ((f32x4*)sh)[lane + 64 * j] = v[j]; }
}
template <int MODE> __device__ __forceinline__ void p0_tr_item(const float* W, int N, bf16_t* WT, float* scr, int kb, int nb, int lane) {
    const int k0 = 64 * kb, n0 = 32 * nb;
    const int l8 = lane & 7, r8 = lane >> 3;
    const int nn = n0 + 4 * l8;
    int srcc = nn;
    if (MODE == 1) srcc = nn < C_GATE_REF ? nn : (nn < NPB ? -1 : nn - (NPB - C_GATE_REF));
    f32x4 v[8];
#pragma unroll
    for (int i = 0; i < 8; ++i) { const int kk = 8 * i + r8; v[i] = srcc >= 0 ? *(const f32x4*)(W + (size_t)(k0 + kk) * N + srcc) : (f32x4){0.f, 0.f, 0.f, 0.f}; }
#pragma unroll
    for (int i = 0; i < 8; ++i) { const int kk = 8 * i + r8; float* d = scr + kk * 33 + 4 * l8; d[0] = v[i][0]; d[1] = v[i][1]; d[2] = v[i][2]; d[3] = v[i][3]; }
    asm volatile("s_waitcnt lgkmcnt(0)" ::: "memory");
    const int c = lane & 7;
#pragma unroll
    for (int j = 0; j < 4; ++j) { const int n = (lane >> 3) + 8 * j; const float* s = scr + (8 * c) * 33 + n;
        u32x4 o; o.x = pk2(s[0 * 33], s[1 * 33]); o.y = pk2(s[2 * 33], s[3 * 33]); o.z = pk2(s[4 * 33], s[5 * 33]); o.w = pk2(s[6 * 33], s[7 * 33]);
        *(u32x4*)(WT + (size_t)(n0 + n) * D + k0 + 8 * c) = o; }
    asm volatile("s_waitcnt lgkmcnt(0)" ::: "memory");
}
__device__ __forceinline__ void h_rows_pair(const Params& p, int r, int r1, bool has1, int lane, const f32x4 (&wv)[4]) {
    const f32x4* x0 = (const f32x4*)(p.in[0] + (size_t)r * D) + lane; const f32x4* x1 = (const f32x4*)(p.in[0] + (size_t)(has1 ? r1 : r) * D) + lane;
    f32x4 a[4], b[4]; float s0 = 0.f, s1 = 0.f;
#pragma unroll
    for (int j = 0; j < 4; ++j) { a[j] = x0[64 * j]; b[j] = x1[64 * j]; }
#pragma unroll
    for (int j = 0; j < 4; ++j) { s0 += a[j][0] * a[j][0] + a[j][1] * a[j][1] + a[j][2] * a[j][2] + a[j][3] * a[j][3]; s1 += b[j][0] * b[j][0] + b[j][1] * b[j][1] + b[j][2] * b[j][2] + b[j][3] * b[j][3]; }
    const float q0 = __builtin_amdgcn_rsqf(wave_sum(s0) * (1.f / D) + 1e-6f), q1 = __builtin_amdgcn_rsqf(wave_sum(s1) * (1.f / D) + 1e-6f);
    u32x2* o0 = (u32x2*)((bf16_t*)(p.ws + WS_H) + (size_t)r * D) + lane; u32x2* o1 = (u32x2*)((bf16_t*)(p.ws + WS_H) + (size_t)r1 * D) + lane;
#pragma unroll
    for (int j = 0; j < 4; ++j) { a[j] = a[j] * q0 * wv[j]; o0[64 * j] = (u32x2){pk2(a[j][0], a[j][1]), pk2(a[j][2], a[j][3])}; }
    if ((r & (SEQ - 1)) == SEQ - 1) { f32x4* sh = (f32x4*)(p.out + O_SHIFT_P + (size_t)(r / SEQ) * D) + lane;
#pragma unroll
        for (int j = 0; j < 4; ++j) sh[64 * j] = a[j]; }
    if (has1) {
#pragma unroll
        for (int j = 0; j < 4; ++j) { b[j] = b[j] * q1 * wv[j]; o1[64 * j] = (u32x2){pk2(b[j][0], b[j][1]), pk2(b[j][2], b[j][3])}; }
        if ((r1 & (SEQ - 1)) == SEQ - 1) { f32x4* sh = (f32x4*)(p.out + O_SHIFT_P + (size_t)(r1 / SEQ) * D) + lane;
#pragma unroll
            for (int j = 0; j < 4; ++j) sh[64 * j] = b[j]; }
    }
}
__device__ __forceinline__ void h_rows_segs(const Params& p, int s_lo, int s_hi, int wi, int nw, int lane) {
    const f32x4* lw = (const f32x4*)p.in[7] + lane;
    f32x4 wv[4];
#pragma unroll
    for (int j = 0; j < 4; ++j) wv[j] = lw[64 * j];
    const int n = (s_hi - s_lo) * NBATCH * SEGTOK;
#pragma unroll 1
    for (int x = wi; x < n; x += 2 * nw) {
        const int x1 = x + nw; const bool has1 = x1 < n;
        const int sg = s_lo + x / (NBATCH * SEGTOK), rem = x % (NBATCH * SEGTOK), r = (rem / SEGTOK) * SEQ + sg * SEGTOK + (rem % SEGTOK);
        const int xx = has1 ? x1 : x; const int sg1 = s_lo + xx / (NBATCH * SEGTOK), rem1 = xx % (NBATCH * SEGTOK), r1 = (rem1 / SEGTOK) * SEQ + sg1 * SEGTOK + (rem1 % SEGTOK);
        h_rows_pair(p, r, r1, has1, lane, wv);
    }
}
__device__ __forceinline__ void phase0(const Params& p, unsigned char* smem) {
    const int tid0 = otid(), wave = tid0 >> 6, lane = tid0 & 63;
    const int gw = obid() * 8 + wave, NGW = gridDim.x * 8;
    float* scr = (float*)smem + wave * (64 * 33);
    constexpr int I_IN = 16 * (NP / 32), I_SQ = 16 * 32;
    for (int it = gw; it < I_IN + 3 * I_SQ; it += NGW) {
        int r = it;
        if (r < I_IN) { p0_tr_item<1>(p.in[8], 10384, (bf16_t*)(p.ws + WS_WT_IN), scr, r / (NP / 32), r % (NP / 32), lane); continue; } r -= I_IN;
        if (r < I_SQ) { p0_tr_item<0>(p.in[13], D, (bf16_t*)(p.ws + WS_WT_A), scr, r / 32, r % 32, lane); continue; } r -= I_SQ;
        if (r < I_SQ) { p0_tr_item<0>(p.in[24], D, (bf16_t*)(p.ws + WS_WT_B), scr, r / 32, r % 32, lane); continue; } r -= I_SQ;
        p0_tr_item<0>(p.in[25], D, (bf16_t*)(p.ws + WS_WT_O), scr, r / 32, r % 32, lane);
    }
    h_rows_segs(p, 0, 2, gw, NGW, lane);
    for (int r = XROWS + gw; r < HROWS; r += NGW) p0_row(p, r, lane);
    {
        float* pk = (float*)(p.ws + WS_PK);
        const int gt = obid() * 512 + tid0, NT = gridDim.x * 512;
        for (int i = gt; i < PK_END; i += NT) {
            const float* src; int o;
            if (i < PK_ALOG) { src = p.in[9]; o = i - PK_CONVW; } else if (i < PK_DTB) { src = p.in[10]; o = i - PK_ALOG; } else if (i < PK_NORMW) { src = p.in[11]; o = i - PK_DTB; }
            else if (i < PK_MU) { src = p.in[12]; o = i - PK_NORMW; } else if (i < PK_W0) { src = p.in[14]; o = i - PK_MU; } else if (i < PK_W2) { src = p.in[15]; o = i - PK_W0; }
            else if (i < PK_A0) { src = p.in[16]; o = i - PK_W2; } else if (i < PK_A2) { src = p.in[17]; o = i - PK_A0; } else if (i < PK_KK) { src = p.in[18]; o = i - PK_A2; }
            else if (i < PK_KA) { src = p.in[19]; o = i - PK_KK; } else if (i < PK_RK) { src = p.in[20]; o = i - PK_KA; } else if (i < PK_GNW) { src = p.in[21]; o = i - PK_RK; }
            else if (i < PK_GNB) { src = p.in[22]; o = i - PK_GNW; } else if (i < PK_LNF) { src = p.in[23]; o = i - PK_GNB; } else { src = p.in[26]; o = i - PK_LNF; }
            pk[i] = src[o];
        }
        bf16_t* w2t = (bf16_t*)(p.ws + WS_W2T); bf16_t* a2t = (bf16_t*)(p.ws + WS_A2T);
        for (int i = gt; i < 65536; i += NT) { const int l = i & 63, c = (i >> 6) & 63, hb = i >> 12;
            w2t[i] = (bf16_t)f2bf(p.in[16][(size_t)l * D + hb * 64 + c]); a2t[i] = (bf16_t)f2bf(p.in[18][(size_t)l * D + hb * 64 + c]); }
    }
}

__device__ __forceinline__ void gdn_item(const Params& p, unsigned char* smem, const float* s_in, float* s_out, const float* halo_in, float* halo_out,
                                         int h, int sl, int rowA, int nA, int rowB, int nB) {
    const int tid = otid(), w = tid >> 6, lane = tid & 63, vl = lane >> 4, kg = lane & 15;
    float* qk_s = (float*)smem; float* v_s = qk_s + 16384; float* o_s = v_s + 2048; float* gb_s = o_s + 2048; float* sst = gb_s + 128;
    const bf16_t* P = (const bf16_t*)(p.ws + WS_P);
    float* ORAW = (float*)(p.ws + WS_ORAW);
    float s[8];
    if (s_in) {
        { const int k = tid >> 2, q4 = tid & 3; const f32x4* src = (const f32x4*)(s_in + (size_t)k * 128 + sl * 32 + q4 * 8); const f32x4 a = src[0], b = src[1];
          float* d = sst + k * 33 + q4 * 8; d[0] = a[0]; d[1] = a[1]; d[2] = a[2]; d[3] = a[3]; d[4] = b[0]; d[5] = b[1]; d[6] = b[2]; d[7] = b[3]; }
        __syncthreads();
#pragma unroll
        for (int j = 0; j < 8; ++j) s[j] = sst[(kg * 8 + j) * 33 + 4 * w + vl];
        __syncthreads();
    } else {
#pragma unroll
        for (int j = 0; j < 8; ++j) s[j] = 0.f;
    }
    int pcol = -1;
    if (tid < 128) pcol = h * 128 + tid; else if (tid < 256) pcol = 1024 + h * 128 + (tid - 128); else if (tid < 288) pcol = 2048 + h * 128 + sl * 32 + (tid - 256);
    float cw0 = 0.f, cw1 = 0.f, cw2 = 0.f, cw3 = 0.f, x1 = 0.f, x2 = 0.f, x3 = 0.f;
    const float* pk = (const float*)(p.ws + WS_PK);
    if (pcol >= 0) { const float* cw = pk + PK_CONVW; cw0 = cw[pcol]; cw1 = cw[3072 + pcol]; cw2 = cw[6144 + pcol]; cw3 = cw[9216 + pcol];
        if (halo_in) { x3 = halo_in[pcol]; x2 = halo_in[3072 + pcol]; x1 = halo_in[6144 + pcol]; } }
    const float nalog = -expf(pk[PK_ALOG + h]), dtb = pk[PK_DTB + h];
#pragma unroll 1
    for (int run = 0; run < 2; ++run) {
        const int rrow = run ? rowB : rowA, rn = run ? nB : nA; const bool wout = run != 0;
#pragma unroll 1
        for (int c0 = 0; c0 < rn; c0 += 64) {
            const int nt = (rn - c0) < 64 ? (rn - c0) : 64; const int row = rrow + c0;
            if (pcol >= 0) {
                const bf16_t* src = P + (size_t)row * NPB + pcol;
                float* dst = tid < 256 ? (qk_s + tid) : (v_s + (tid - 256)); const int dstride = tid < 256 ? 256 : 32;
#pragma unroll 8
                for (int i = 0; i < nt; ++i) { const float x0 = bf2f(src[(size_t)i * NPB]); const float y = cw0 * x3 + cw1 * x2 + cw2 * x1 + cw3 * x0; x3 = x2; x2 = x1; x1 = x0; dst[i * dstride] = silu_(y); }
            } else if (tid < 352) {
                const int i = tid - 288;
                if (i < nt) { const float pa = bf2f(P[(size_t)(row + i) * NPB + C_A + h]), pb = bf2f(P[(size_t)(row + i) * NPB + C_B + h]);
                    gb_s[2 * i] = expf(nalog * softplus_(pa + dtb)); gb_s[2 * i + 1] = sigm(pb); }
            }
            __syncthreads();
#pragma unroll 1
            for (int ii = 0; ii < 8; ++ii) { const int i = w * 8 + ii;
                if (i < nt) {
#pragma unroll
                    for (int which = 0; which < 2; ++which) { float* rp = qk_s + i * 256 + which * 128; const float a = rp[lane], b = rp[lane + 64];
                        const float sc = __builtin_amdgcn_rsqf(wave_sum(a * a + b * b) + 1e-6f) * (which == 0 ? 0.08838834764831845f : 1.f); rp[lane] = a * sc; rp[lane + 64] = b * sc; } } }
            __syncthreads();
#pragma unroll 1
            for (int i = 0; i < nt; ++i) {
                const f32x4 q0 = *(const f32x4*)(qk_s + i * 256 + kg * 8), q1 = *(const f32x4*)(qk_s + i * 256 + kg * 8 + 4);
                const f32x4 k0 = *(const f32x4*)(qk_s + i * 256 + 128 + kg * 8), k1 = *(const f32x4*)(qk_s + i * 256 + 128 + kg * 8 + 4);
                const float vv = v_s[i * 32 + 4 * w + vl], a = gb_s[2 * i], be = gb_s[2 * i + 1];
                float part = k0[0] * s[0] + k0[1] * s[1] + k0[2] * s[2] + k0[3] * s[3] + k1[0] * s[4] + k1[1] * s[5] + k1[2] * s[6] + k1[3] * s[7];
                const float kS = rowsum16(part);
                const float c = be * (vv - a * kS);
                s[0] = a * s[0] + k0[0] * c; s[1] = a * s[1] + k0[1] * c; s[2] = a * s[2] + k0[2] * c; s[3] = a * s[3] + k0[3] * c;
                s[4] = a * s[4] + k1[0] * c; s[5] = a * s[5] + k1[1] * c; s[6] = a * s[6] + k1[2] * c; s[7] = a * s[7] + k1[3] * c;
                float op = q0[0] * s[0] + q0[1] * s[1] + q0[2] * s[2] + q0[3] * s[3] + q1[0] * s[4] + q1[1] * s[5] + q1[2] * s[6] + q1[3] * s[7];
                const float o = rowsum16(op);
                if (kg == 0) o_s[i * 32 + 4 * w + vl] = o;
            }
            __syncthreads();
            if (wout) { const int i = tid >> 3, c4 = (tid & 7) * 4; if (i < nt) *(f32x4*)(ORAW + (size_t)(row + i) * D + h * 128 + sl * 32 + c4) = *(const f32x4*)(o_s + i * 32 + c4); }
        }
    }
    if (pcol >= 0 && (sl == 0 || tid >= 256)) { halo_out[pcol] = x3; halo_out[3072 + pcol] = x2; halo_out[6144 + pcol] = x1; }
#pragma unroll
    for (int j = 0; j < 8; ++j) sst[(kg * 8 + j) * 33 + 4 * w + vl] = s[j];
    __syncthreads();
    { const int k = tid >> 2, q4 = tid & 3; const float* d = sst + k * 33 + q4 * 8; f32x4* dst = (f32x4*)(s_out + (size_t)k * 128 + sl * 32 + q4 * 8);
      dst[0] = (f32x4){d[0], d[1], d[2], d[3]}; dst[1] = (f32x4){d[4], d[5], d[6], d[7]}; }
    __syncthreads();
}

constexpr int RW_W2 = 20544, RW_A2 = 24640;
__device__ __forceinline__ void rwkv_load_lora(const Params& p, unsigned char* smem, int hb) {
    float* w2_s = (float*)smem + RW_W2; float* a2_s = (float*)smem + RW_A2; const float* pk = (const float*)(p.ws + WS_PK);
    for (int i = otid(); i < 4096; i += 512) { const int l = i >> 6, c = i & 63; w2_s[i] = pk[PK_W2 + l * D + hb * 64 + c]; a2_s[i] = pk[PK_A2 + l * D + hb * 64 + c]; }
    __syncthreads();
}
__device__ __forceinline__ void rwkv_item(const Params& p, unsigned char* smem, const float* s_in, float* s_out, const bf16_t* prev_row, const float* halo_in, float* halo_out,
                                          int hb, int half, int rowA, int nA, int rowB, int nB) {
    const int tid = otid(), w = tid >> 6, lane = tid & 63, row = tid >> 4, kq = tid & 15;
    float* f = (float*)smem;
    float* r_s = f; float* kb_s = f + 2048; float* v_s = f + 4096; float* wd_s = f + 6144; float* ad_s = f + 8192; float* dec_s = f + 10240; float* a_s = f + 12288;
    float* kk_s = f + 14336; float* km_s = f + 16384; float* zb_s = f + 18432; float* y_s = f + 19456; float* bonus_s = f + 20480;
    const float* w2_s = f + RW_W2; const float* a2_s = f + RW_A2;
    const bf16_t* P = (const bf16_t*)(p.ws + WS_P);
    float* YRAW = (float*)(p.ws + WS_YRAW); bf16_t* C0 = (bf16_t*)(p.ws + WS_C0); bf16_t* C1 = (bf16_t*)(p.ws + WS_C1);
    float s[4];
    if (s_in) { const f32x4 t = *(const f32x4*)(s_in + (size_t)(half * 32 + row) * 64 + kq * 4); s[0] = t[0]; s[1] = t[1]; s[2] = t[2]; s[3] = t[3]; }
    else { s[0] = s[1] = s[2] = s[3] = 0.f; }
    int col = -1; float* dst = nullptr; int dstride = 64; bool is_wd = false, owner = false;
    if (tid < 64) { col = hb * 64 + tid; dst = r_s + tid; owner = half == 0; }
    else if (tid < 128) { col = 1024 + hb * 64 + (tid - 64); dst = kb_s + (tid - 64); owner = half == 0; }
    else if (tid < 192) { col = 2048 + hb * 64 + (tid - 128); dst = v_s + (tid - 128); owner = half == 0; }
    else if (tid < 256) { col = 3072 + (tid - 192); dst = wd_s + (tid - 192); is_wd = true; owner = (half == 0 && hb == 0); }
    else if (tid < 320) { col = 3136 + (tid - 256); dst = ad_s + (tid - 256); owner = (half == 0 && hb == 0); }
    else if (tid < 352) { col = 3200 + hb * 64 + half * 32 + (tid - 320); dst = zb_s + (tid - 320); dstride = 32; owner = true; }
    float mu = 0.f, prev = 0.f;
    const float* pk = (const float*)(p.ws + WS_PK);
    if (col >= 0) { mu = pk[PK_MU + col]; prev = prev_row ? bf2f(prev_row[C_RW + col]) : (halo_in ? halo_in[col] : 0.f); }
    const int cc = tid & 63, ig = tid >> 6;
    const int hc = hb * 64 + cc;
    const float w0c = pk[PK_W0 + hc], a0c = pk[PK_A0 + hc], kkc = pk[PK_KK + hc], kac = pk[PK_KA + hc];
    const float rkl = pk[PK_RK + hb * 64 + lane];
#pragma unroll 1
    for (int run = 0; run < 2; ++run) {
        const int rrow = run ? rowB : rowA, rn = run ? nB : nA; const bool wout = run != 0;
#pragma unroll 1
        for (int c0 = 0; c0 < rn; c0 += 32) {
            const int nt = (rn - c0) < 32 ? (rn - c0) : 32; const int row0 = rrow + c0;
            if (col >= 0) {
                const bf16_t* src = P + (size_t)row0 * NPB + C_RW + col;
#pragma unroll 8
                for (int i = 0; i < nt; ++i) { const float cur = bf2f(src[(size_t)i * NPB]); float m = cur + mu * (prev - cur); prev = cur; if (is_wd) m = tanh_(m); dst[i * dstride] = m; }
            }
            __syncthreads();
            {
                float aw[4] = {0.f, 0.f, 0.f, 0.f}, aa[4] = {0.f, 0.f, 0.f, 0.f};
#pragma unroll 4
                for (int l = 0; l < 64; ++l) { const float w2v = w2_s[l * 64 + cc], a2v = a2_s[l * 64 + cc];
#pragma unroll
                    for (int ii = 0; ii < 4; ++ii) { aw[ii] += wd_s[(ig * 4 + ii) * 64 + l] * w2v; aa[ii] += ad_s[(ig * 4 + ii) * 64 + l] * a2v; } }
#pragma unroll
                for (int ii = 0; ii < 4; ++ii) { const int i = ig * 4 + ii;
                    if (i < nt) { const float wraw = w0c + aw[ii]; const float wlog = -0.6065306597126334f * sigm(wraw); const float a = sigm(a0c + aa[ii]);
                        const float kbv = kb_s[i * 64 + cc];
                        dec_s[i * 64 + cc] = expf(wlog); a_s[i * 64 + cc] = a; kk_s[i * 64 + cc] = kbv * kkc; km_s[i * 64 + cc] = kbv * (1.f + (a - 1.f) * kac); } }
            }
            __syncthreads();
#pragma unroll 1
            for (int ii = 0; ii < 4; ++ii) { const int i = w * 4 + ii;
                if (i < nt) { const float kkr = kk_s[i * 64 + lane]; const float kk = kkr * __builtin_amdgcn_rsqf(wave_sum(kkr * kkr) + 1e-6f); kk_s[i * 64 + lane] = kk;
                    const float a = a_s[i * 64 + lane]; a_s[i * 64 + lane] = kk * a;
                    const float rk = wave_sum(r_s[i * 64 + lane] * km_s[i * 64 + lane] * rkl); if (lane == 0) bonus_s[i] = rk; } }
            __syncthreads();
#pragma unroll 1
            for (int i = 0; i < nt; ++i) {
                const f32x4 kk4 = *(const f32x4*)(kk_s + i * 64 + kq * 4), de4 = *(const f32x4*)(dec_s + i * 64 + kq * 4), ka4 = *(const f32x4*)(a_s + i * 64 + kq * 4),
                            km4 = *(const f32x4*)(km_s + i * 64 + kq * 4), r4 = *(const f32x4*)(r_s + i * 64 + kq * 4);
                const float vv = v_s[i * 64 + half * 32 + row];
                const float sa = rowsum16(s[0] * kk4[0] + s[1] * kk4[1] + s[2] * kk4[2] + s[3] * kk4[3]);
#pragma unroll
                for (int j = 0; j < 4; ++j) s[j] = s[j] * de4[j] + (vv * km4[j] - sa * ka4[j]);
                const float y = rowsum16(s[0] * r4[0] + s[1] * r4[1] + s[2] * r4[2] + s[3] * r4[3]);
                if (kq == 0) y_s[i * 32 + row] = y;
            }
            __syncthreads();
            if (wout) { const int i = tid >> 4;
                if (i < nt) {
#pragma unroll
                    for (int q = 0; q < 2; ++q) { const int rr = (tid & 15) * 2 + q, v = half * 32 + rr, colo = hb * 64 + v;
                        const float sz = silu_(zb_s[i * 32 + rr]);
                        const size_t o = (size_t)(row0 + i) * D + colo;
                        YRAW[o] = y_s[i * 32 + rr]; C1[o] = (bf16_t)f2bf(pk[PK_GNW + colo] * sz); C0[o] = (bf16_t)f2bf((pk[PK_GNB + colo] + bonus_s[i] * v_s[i * 64 + v]) * sz); } } }
            __syncthreads();
        }
    }
    *(f32x4*)(s_out + (size_t)(half * 32 + row) * 64 + kq * 4) = (f32x4){s[0], s[1], s[2], s[3]};
    if (col >= 0 && owner && halo_out) halo_out[col] = prev;
}


__device__ __forceinline__ bf16x8 ldfrag(const bf16_t* base, int stride, int r0, int k0, int lane) {
    return *(const bf16x8*)(base + (r0 + (lane & 15)) * stride + k0 + 8 * (lane >> 4));
}
#define MFMA16(a, b, c) __builtin_amdgcn_mfma_f32_16x16x32_bf16((a), (b), (c), 0, 0, 0)
typedef short s16x4 __attribute__((ext_vector_type(4)));
__device__ __forceinline__ bf16x8 ldfrag_tr(const bf16_t* X, int stride, int c0, int k0, int lane) {
    const int l15 = lane & 15;
    const bf16_t* a = X + (k0 + 8 * (lane >> 4) + (l15 >> 2)) * stride + c0 + 4 * (l15 & 3);
    const s16x4 lo = __builtin_amdgcn_ds_read_tr16_b64_v4i16((LAS s16x4*)a), hi = __builtin_amdgcn_ds_read_tr16_b64_v4i16((LAS s16x4*)(a + 4 * stride));
    return __builtin_shufflevector(lo, hi, 0, 1, 2, 3, 4, 5, 6, 7);
}
__device__ __forceinline__ void inv_block(const float* L, float* Tm, float* XS, int tid) {
    const int w = tid >> 6, lane = tid & 63;
    typedef float f32x2v __attribute__((ext_vector_type(2)));
    if (w < 4 && lane < 16) {
        const float* Lb = L + (16 * w) * 64 + 16 * w; float* Tb = Tm + (16 * w) * 64 + 16 * w;
        float tr[16];
#pragma unroll
        for (int i = 0; i < 16; ++i) tr[i] = 0.f;
#pragma unroll
        for (int i = 0; i < 16; ++i) { float a = (lane == i) ? 1.f : 0.f;
#pragma unroll
            for (int j0 = 0; j0 < i; j0 += 4) { const f32x4 l4 = *(const f32x4*)(Lb + i * 64 + j0);
                a -= l4[0] * tr[j0] + l4[1] * tr[j0 + 1] + l4[2] * tr[j0 + 2] + l4[3] * tr[j0 + 3]; }
            tr[i] = a; Tb[i * 64 + lane] = a; }
    }
    for (int e = tid; e < 1536; e += 512) { const int k = e >> 8, r = (e >> 4) & 15, c = e & 15;
        const int rb = k < 3 ? 0 : (k < 5 ? 1 : 2), cb = k < 3 ? k + 1 : (k < 5 ? k - 1 : 3);
        Tm[(16 * rb + r) * 64 + 16 * cb + c] = 0.f; }
    __syncthreads();
    {
        const int B = tid >> 8, i = (tid >> 4) & 15, c = tid & 15, o = 32 * B;
        float x = 0.f;
#pragma unroll
        for (int j0 = 0; j0 < 16; j0 += 4) { const f32x4 l4 = *(const f32x4*)(L + (o + 16 + i) * 64 + o + j0);
            x += l4[0] * Tm[(o + j0) * 64 + o + c] + l4[1] * Tm[(o + j0 + 1) * 64 + o + c] + l4[2] * Tm[(o + j0 + 2) * 64 + o + c] + l4[3] * Tm[(o + j0 + 3) * 64 + o + c]; }
        XS[tid] = x;
        __syncthreads();
        float t = 0.f;
#pragma unroll
        for (int j0 = 0; j0 < 16; j0 += 4) { const f32x4 t4 = *(const f32x4*)(Tm + (o + 16 + i) * 64 + o + 16 + j0);
            t += t4[0] * XS[(B << 8) + j0 * 16 + c] + t4[1] * XS[(B << 8) + (j0 + 1) * 16 + c] + t4[2] * XS[(B << 8) + (j0 + 2) * 16 + c] + t4[3] * XS[(B << 8) + (j0 + 3) * 16 + c]; }
        Tm[(o + 16 + i) * 64 + o + c] = -t;
    }
    __syncthreads();
    {
        const int i = tid >> 4, c2 = (tid & 15) * 2;
        float x0 = 0.f, x1 = 0.f;
#pragma unroll
        for (int j0 = 0; j0 < 32; j0 += 4) { const f32x4 l4 = *(const f32x4*)(L + (32 + i) * 64 + j0);
#pragma unroll
            for (int e = 0; e < 4; ++e) { const f32x2v tv = *(const f32x2v*)(Tm + (j0 + e) * 64 + c2); x0 += l4[e] * tv[0]; x1 += l4[e] * tv[1]; } }
        *(f32x2v*)(XS + i * 32 + c2) = (f32x2v){x0, x1};
        __syncthreads();
        float t0 = 0.f, t1 = 0.f;
#pragma unroll
        for (int j0 = 0; j0 < 32; j0 += 4) { const f32x4 t4 = *(const f32x4*)(Tm + (32 + i) * 64 + 32 + j0);
#pragma unroll
            for (int e = 0; e < 4; ++e) { const f32x2v xv = *(const f32x2v*)(XS + (j0 + e) * 32 + c2); t0 += t4[e] * xv[0]; t1 += t4[e] * xv[1]; } }
        *(f32x2v*)(Tm + (32 + i) * 64 + c2) = (f32x2v){-t0, -t1};
    }
    __syncthreads();
}
constexpr int PL_QS = 0, PL_R1 = 17408, PL_KT = 35840, PL_KTT = 54272, PL_VT = 72704, PL_R3 = 91136, PL_QKM = 109568, PL_TP = 118784, PL_TPP = 128000, PL_SM = 137216, PL_TM = 139264, PL_XS = 155648;
constexpr int QSTR = 136, TSTR = 72;

__device__ __forceinline__ void gdn_prep_item(const Params& p, unsigned char* smem, int h, int row_start, int npad, const bf16_t* hbase,
                                              bf16_t* halo_out, float* conv_out, unsigned char* rec) {
    const int tid = otid(), w = tid >> 6, lane = tid & 63, q4 = lane >> 4, l15 = lane & 15;
    bf16_t* qs = (bf16_t*)(smem + PL_QS); bf16_t* ks = (bf16_t*)(smem + PL_R1); bf16_t* WT = (bf16_t*)(smem + PL_KTT);     bf16_t* kts = (bf16_t*)(smem + PL_KT);
    bf16_t* vs = (bf16_t*)(smem + PL_VT);         float* Lm = (float*)(smem + PL_R3); bf16_t* UT = (bf16_t*)(smem + PL_R3); bf16_t* QKm = (bf16_t*)(smem + PL_QKM);
    bf16_t* Tp = (bf16_t*)(smem + PL_TP); bf16_t* Tpp = (bf16_t*)(smem + PL_TPP);
    float* sm = (float*)(smem + PL_SM);
    float* gcs = sm; float* bes = sm + 64; float* ssq = sm + 128; float* ssk = sm + 192; float* egs = sm + 256; float* egl_s = sm + 320; float* beg = sm + 384;
    const bf16_t* P = (const bf16_t*)(p.ws + WS_P);
    const float* pk = (const float*)(p.ws + WS_PK);
    if (w == 7) {
        const int i = lane;
        float g = 0.f, be = 0.f;
        if (i >= npad) { const size_t r = (size_t)(row_start + i - npad) * NPB; const float pa = bf2f(P[r + C_A + h]), pb = bf2f(P[r + C_B + h]);
            g = -expf(pk[PK_ALOG + h]) * softplus_(pa + pk[PK_DTB + h]); be = sigm(pb); }
        float x = g;
#pragma unroll
        for (int o = 1; o < 64; o <<= 1) { const float y = __shfl_up(x, o); if (lane >= o) x += y; }
        const float gl = __shfl(x, 63);
        gcs[lane] = x; bes[lane] = be; egs[lane] = __expf(x); egl_s[lane] = __expf(gl - x); beg[lane] = be * __expf(x);
        if (lane == 0) *(float*)(rec + GP_EGL) = __expf(gl);
    }
    __syncthreads();
    if (npad == 0 && tid >= 384) {
#pragma unroll 1
        for (int k = 0; k < 4; ++k) {
            const int slot = (tid - 384) + 128 * k, t = slot >> 3, g = slot & 7;
            const bf16_t* zp = P + (size_t)(row_start + t) * NPB + C_Z + h * 128 + 16 * g;
            const u32x4 z0 = *(const u32x4*)zp, z1 = *(const u32x4*)(zp + 8);
            float za[8], zb[8]; unpack8(z0, za); unpack8(z1, zb);
            const float* nwp = pk + PK_NORMW + 16 * g;
            float ga[8], gb2[8];
#pragma unroll
            for (int e = 0; e < 8; ++e) { ga[e] = nwp[e] * silu_(za[e]); gb2[e] = nwp[8 + e] * silu_(zb[e]); }
            bf16_t* gp = (bf16_t*)(rec + GP_G) + t * 128 + 16 * g;
            *(u32x4*)gp = pack8(ga); *(u32x4*)(gp + 8) = pack8(gb2);
        }
    }
    if (tid < 384) {
        const int sec = tid >> 7, ts = (tid >> 4) & 7, t0 = 8 * ts, d0 = l15 * 8;
        const int pcol = sec * 1024 + h * 128 + d0;
        float cw[4][8];
#pragma unroll
        for (int j = 0; j < 4; ++j) { const f32x4 a = *(const f32x4*)(pk + PK_CONVW + j * 3072 + pcol), b = *(const f32x4*)(pk + PK_CONVW + j * 3072 + pcol + 4);
            cw[j][0] = a[0]; cw[j][1] = a[1]; cw[j][2] = a[2]; cw[j][3] = a[3]; cw[j][4] = b[0]; cw[j][5] = b[1]; cw[j][6] = b[2]; cw[j][7] = b[3]; }
        u32x4 rw[11]; float fv[11];
#pragma unroll
        for (int k = 0; k < 11; ++k) {
            const int ii = t0 - 3 + k;
            const bf16_t* ptr = P + pcol; float f = 0.f;
            if (ii >= npad) { ptr = P + (size_t)(row_start + ii - npad) * NPB + pcol; f = 1.f; }
            else if (ii < 0 && npad == 0 && hbase) { ptr = hbase + (size_t)(ii + 3) * NPB + pcol; f = 1.f; }
            rw[k] = *(const u32x4*)ptr; fv[k] = f;
        }
        if (halo_out && ts == 7) {
#pragma unroll
            for (int dd = 0; dd < 3; ++dd) { *(u32x4*)(halo_out + (size_t)dd * NPB + pcol) = rw[8 + dd];
                if (conv_out) { float x[8]; unpack8(rw[8 + dd], x); *(f32x4*)(conv_out + dd * 3072 + pcol) = (f32x4){x[0], x[1], x[2], x[3]}; *(f32x4*)(conv_out + dd * 3072 + pcol + 4) = (f32x4){x[4], x[5], x[6], x[7]}; } }
        }
        float y[8][8];
#pragma unroll
        for (int t = 0; t < 8; ++t)
#pragma unroll
            for (int e = 0; e < 8; ++e) y[t][e] = 0.f;
#pragma unroll
        for (int k = 0; k < 11; ++k) { float x[8]; unpack8(rw[k], x);
#pragma unroll
            for (int e = 0; e < 8; ++e) x[e] *= fv[k];
#pragma unroll
            for (int dlt = 0; dlt < 4; ++dlt) { const int t = k - dlt;
                if (t >= 0 && t < 8) {
#pragma unroll
                    for (int e = 0; e < 8; ++e) y[t][e] += cw[dlt][e] * x[e]; } }
        }
        const float qsc = sec == 0 ? 0.08838834764831845f : 1.f;
#pragma unroll
        for (int t = 0; t < 8; ++t) {
            const bool tokv = (t0 + t) >= npad;
            float ss = 0.f;
#pragma unroll
            for (int e = 0; e < 8; ++e) { y[t][e] = tokv ? silu_(y[t][e]) : 0.f; ss += y[t][e] * y[t][e]; }
            if (sec < 2) { const float sc = __builtin_amdgcn_rsqf(rowsum16(ss) + 1e-6f) * qsc;
#pragma unroll
                for (int e = 0; e < 8; ++e) y[t][e] *= sc; }
        }
        { bf16_t* dst = sec == 0 ? qs : (sec == 1 ? ks : vs);
#pragma unroll
            for (int t = 0; t < 8; ++t) *(u32x4*)(dst + (t0 + t) * QSTR + d0) = pack8(y[t]); }
        if (sec == 1) {
#pragma unroll
            for (int t = 0; t < 8; ++t) { const float eg = egl_s[t0 + t]; float z[8];
#pragma unroll
                for (int e = 0; e < 8; ++e) z[e] = y[t][e] * eg;
                *(u32x4*)(kts + (t0 + t) * QSTR + d0) = pack8(z); } }
    }
    __syncthreads();
    {
        const int which = w >> 2, it = w & 3;
        const bf16_t* Barr = which ? qs : ks;
        bf16x8 bfr[4];
#pragma unroll
        for (int kk = 0; kk < 4; ++kk) bfr[kk] = ldfrag(Barr, QSTR, 16 * it, 32 * kk, lane);
        const int i = 16 * it + l15; const float gi = gcs[i], bi = bes[i];
#pragma unroll
        for (int jt = 0; jt < 4; ++jt) {
            f32x4 acc = {0.f, 0.f, 0.f, 0.f};
#pragma unroll
            for (int kk = 0; kk < 4; ++kk) acc = MFMA16(ldfrag(ks, QSTR, 16 * jt, 32 * kk, lane), bfr[kk], acc);
            const int j0 = 16 * jt + 4 * q4; const f32x4 gj = *(const f32x4*)(gcs + j0);
            f32x4 o;
#pragma unroll
            for (int r = 0; r < 4; ++r) { const int j = j0 + r; const bool keep = which ? (i >= j) : (i > j); o[r] = keep ? acc[r] * __expf(gi - gj[r]) : 0.f; }
            if (which == 0) *(f32x4*)(Lm + i * 64 + j0) = o * bi;
            else *(u32x2*)(QKm + i * TSTR + j0) = (u32x2){pk2(o[0], o[1]), pk2(o[2], o[3])};
        }
    }
    __syncthreads();
    {
        float* Tm = (float*)(smem + PL_TM);
        inv_block(Lm, Tm, (float*)(smem + PL_XS), tid);
        const int i = tid >> 3, j0 = (tid & 7) * 8;
        float a[8], b2[8];
#pragma unroll
        for (int e = 0; e < 8; ++e) { const float tv = Tm[i * 64 + j0 + e]; a[e] = tv * beg[j0 + e]; b2[e] = tv * bes[j0 + e]; }
        *(u32x4*)(Tp + i * TSTR + j0) = (u32x4){pk2(a[0], a[1]), pk2(a[2], a[3]), pk2(a[4], a[5]), pk2(a[6], a[7])};
        *(u32x4*)(Tpp + i * TSTR + j0) = (u32x4){pk2(b2[0], b2[1]), pk2(b2[2], b2[3]), pk2(b2[4], b2[5]), pk2(b2[6], b2[7])};
    }
    __syncthreads();
    {
        const int it = w & 3, half = w >> 2;
        f32x4 aw[4], au[4];
#pragma unroll
        for (int x = 0; x < 4; ++x) { aw[x] = (f32x4){0.f, 0.f, 0.f, 0.f}; au[x] = (f32x4){0.f, 0.f, 0.f, 0.f}; }
#pragma unroll
        for (int kk = 0; kk < 2; ++kk) {
            const bf16x8 a1 = ldfrag(Tp, TSTR, 16 * it, 32 * kk, lane), a2 = ldfrag(Tpp, TSTR, 16 * it, 32 * kk, lane);
#pragma unroll
            for (int x = 0; x < 4; ++x) { const int dt = half * 4 + x;
                aw[x] = MFMA16(a1, ldfrag_tr(ks, QSTR, 16 * dt, 32 * kk, lane), aw[x]);
                au[x] = MFMA16(a2, ldfrag_tr(vs, QSTR, 16 * dt, 32 * kk, lane), au[x]); }
        }
#pragma unroll
        for (int x = 0; x < 4; ++x) { const int d = 16 * (half * 4 + x) + l15, i0 = 16 * it + 4 * q4;
            *(u32x2*)(WT + d * TSTR + i0) = (u32x2){pk2(aw[x][0], aw[x][1]), pk2(aw[x][2], aw[x][3])};
            *(u32x2*)(UT + d * TSTR + i0) = (u32x2){pk2(au[x][0], au[x][1]), pk2(au[x][2], au[x][3])}; }
    }
    __syncthreads();
    {
        bf16_t* gAP = (bf16_t*)(rec + GP_AP); bf16_t* gQH = (bf16_t*)(rec + GP_QH); bf16_t* gKH = (bf16_t*)(rec + GP_KH); bf16_t* gOH = (bf16_t*)(rec + GP_OH);
        {
            const int et = w;
            const bf16x8 a0 = ldfrag(WT, TSTR, 16 * et, 0, lane), a1 = ldfrag(WT, TSTR, 16 * et, 32, lane);
#pragma unroll
            for (int dt = 0; dt < 8; ++dt) { f32x4 acc = {0.f, 0.f, 0.f, 0.f};
                acc = MFMA16(a0, ldfrag_tr(kts, QSTR, 16 * dt, 0, lane), acc); acc = MFMA16(a1, ldfrag_tr(kts, QSTR, 16 * dt, 32, lane), acc);
                *(u32x2*)(gAP + ((size_t)(dt * 4 + (et >> 1)) * 64 + lane) * 8 + (et & 1) * 4) = (u32x2){pk2(-acc[0], -acc[1]), pk2(-acc[2], -acc[3])}; }
#pragma unroll
            for (int tt = 0; tt < 4; ++tt) { f32x4 acc = {0.f, 0.f, 0.f, 0.f};
                acc = MFMA16(a0, ldfrag(QKm, TSTR, 16 * tt, 0, lane), acc); acc = MFMA16(a1, ldfrag(QKm, TSTR, 16 * tt, 32, lane), acc);
                const int t = 16 * tt + l15, e0 = 16 * et + 4 * q4; const float eg = egs[t];
                const u32x2 qq = *(const u32x2*)(qs + t * QSTR + e0);
                const float o0 = __uint_as_float(qq.x << 16) * eg - acc[0], o1 = __uint_as_float(qq.x & 0xffff0000u) * eg - acc[1],
                            o2 = __uint_as_float(qq.y << 16) * eg - acc[2], o3 = __uint_as_float(qq.y & 0xffff0000u) * eg - acc[3];
                *(u32x2*)(gQH + ((size_t)(tt * 4 + (et >> 1)) * 64 + lane) * 8 + (et & 1) * 4) = (u32x2){pk2(o0, o1), pk2(o2, o3)}; }
        }
        {
            const int dt = w;
            const bf16x8 a0 = ldfrag_tr(kts, QSTR, 16 * dt, 0, lane), a1 = ldfrag_tr(kts, QSTR, 16 * dt, 32, lane);
#pragma unroll
            for (int vt = 0; vt < 8; ++vt) { f32x4 acc = {0.f, 0.f, 0.f, 0.f};
                acc = MFMA16(a0, ldfrag(UT, TSTR, 16 * vt, 0, lane), acc); acc = MFMA16(a1, ldfrag(UT, TSTR, 16 * vt, 32, lane), acc);
                *(u32x2*)(gKH + ((size_t)(vt * 8 + dt) * 64 + lane) * 4) = (u32x2){pk2(acc[0], acc[1]), pk2(acc[2], acc[3])}; }
            const int tt = w & 3, vh = w >> 2;
            const bf16x8 b0 = ldfrag(QKm, TSTR, 16 * tt, 0, lane), b1 = ldfrag(QKm, TSTR, 16 * tt, 32, lane);
#pragma unroll
            for (int x = 0; x < 4; ++x) { const int vt = vh * 4 + x; f32x4 acc = {0.f, 0.f, 0.f, 0.f};
                acc = MFMA16(b0, ldfrag(UT, TSTR, 16 * vt, 0, lane), acc); acc = MFMA16(b1, ldfrag(UT, TSTR, 16 * vt, 32, lane), acc);
                *(u32x2*)(gOH + ((size_t)(vt * 4 + tt) * 64 + lane) * 4) = (u32x2){pk2(acc[0], acc[1]), pk2(acc[2], acc[3])}; }
        }
    }
    __syncthreads();
}

__device__ __forceinline__ void phase_gprep(const Params& p, int seg, unsigned char* smem) {
    const int blk = obid();
    const int n_items = (CPS + (seg == 0 ? 1 : 0)) * 64;
#pragma unroll 1
    for (int it = blk; it < n_items; it += gridDim.x) {
        const int bh = it & 63, b = bh >> 3, h = bh & 7; int cl = it >> 6; if (seg != 0) cl += 1;
        unsigned char* rec = p.ws + WS_GP + (size_t)(cl * 64 + bh) * GP_STRIDE;
        const bf16_t* Pb = (const bf16_t*)(p.ws + WS_P);
        bf16_t* chalo2 = (bf16_t*)(p.ws + WS_CHALO);
        if (cl == 0) gdn_prep_item(p, smem, h, LEX0, 48, nullptr, nullptr, nullptr, rec);
        else {
            const int row = b * SEGTOK + (cl - 1) * 64;
            const bf16_t* hbase = Pb + (size_t)(row - 3) * NPB;
            if (cl == 1) hbase = (seg == 0) ? Pb + (size_t)(LEX0 + NMETA - 3) * NPB : chalo2 + (size_t)(((seg - 1) & 1) * NBATCH + b) * 3 * NPB;
            bf16_t* ho = (cl == CPS) ? chalo2 + (size_t)((seg & 1) * NBATCH + b) * 3 * NPB : nullptr;
            float* co = (cl == CPS && seg == NSEG - 1) ? p.out + O_CONV_P + (size_t)b * 9216 : nullptr;
            gdn_prep_item(p, smem, h, row, 0, hbase, ho, co, rec);
        }
    }
}

__device__ __forceinline__ void gdn_scan_block(const Params& p, int seg, unsigned char* smem, int bh) {
    const int tid = otid(), w = tid >> 6, lane = tid & 63, q4 = lane >> 4, l15 = lane & 15;
    const int b = bh >> 3, h = bh & 7;
    float* st = p.out + O_GDN_P + (size_t)bh * 16384;
    f32x4 S[8];
    if (seg) {
#pragma unroll
        for (int mt = 0; mt < 8; ++mt)
#pragma unroll
            for (int r = 0; r < 4; ++r) S[mt][r] = st[(size_t)(16 * mt + 4 * q4 + r) * 128 + 16 * w + l15];
    } else {
#pragma unroll
        for (int mt = 0; mt < 8; ++mt) S[mt] = (f32x4){0.f, 0.f, 0.f, 0.f};
    }
    const int c_lo = seg ? 1 : 0;
    float* obuf = (float*)(smem + 98304);
    {
        const u32x4* src = (const u32x4*)(p.ws + WS_GP + (size_t)(c_lo * 64 + bh) * GP_STRIDE); u32x4* dst = (u32x4*)smem;
#pragma unroll
        for (int x = 0; x < 6; ++x) dst[tid + 512 * x] = src[tid + 512 * x];
    }
#pragma unroll 1
    for (int cl = c_lo; cl <= CPS; ++cl) {
        const unsigned char* rec = p.ws + WS_GP + (size_t)(cl * 64 + bh) * GP_STRIDE;
        const int cur = (cl - c_lo) & 1;
        __syncthreads();
        u32x4 nx[6];
        const bool more = cl < CPS;
        if (more) { const u32x4* src = (const u32x4*)(rec + GP_STRIDE * 64);
#pragma unroll
            for (int x = 0; x < 6; ++x) nx[x] = src[tid + 512 * x]; }
        const bf16_t* gKH = (const bf16_t*)(rec + GP_KH); const bf16_t* gOH = (const bf16_t*)(rec + GP_OH);
        u32x2 kh[8], oh[4];
#pragma unroll
        for (int mt = 0; mt < 8; ++mt) kh[mt] = *(const u32x2*)(gKH + ((size_t)(w * 8 + mt) * 64 + lane) * 4);
#pragma unroll
        for (int tt = 0; tt < 4; ++tt) oh[tt] = *(const u32x2*)(gOH + ((size_t)(w * 4 + tt) * 64 + lane) * 4);
        const float egl = *(const float*)(rec + GP_EGL);
        const int et = tid >> 3, eg = tid & 7;
        const bf16_t* gp = (const bf16_t*)(rec + GP_G) + et * 128 + 16 * eg;
        u32x4 z0 = {0u, 0u, 0u, 0u}, z1 = {0u, 0u, 0u, 0u};
        if (cl > 0) { z0 = *(const u32x4*)gp; z1 = *(const u32x4*)(gp + 8); }
        bf16x8 Bf[4];
#pragma unroll
        for (int ks = 0; ks < 4; ++ks) { u32x4 t; t.x = pk2(S[2 * ks][0], S[2 * ks][1]); t.y = pk2(S[2 * ks][2], S[2 * ks][3]); t.z = pk2(S[2 * ks + 1][0], S[2 * ks + 1][1]); t.w = pk2(S[2 * ks + 1][2], S[2 * ks + 1][3]);
            Bf[ks] = __builtin_bit_cast(bf16x8, t); }
        const bf16x8* AP = (const bf16x8*)(smem + cur * 49152); const bf16x8* QH = (const bf16x8*)(smem + cur * 49152 + GP_QH);
        f32x4 o[4], tS[8];
#pragma unroll
        for (int tt = 0; tt < 4; ++tt) { o[tt] = (f32x4){0.f, 0.f, 0.f, 0.f};
#pragma unroll
            for (int ks = 0; ks < 4; ++ks) o[tt] = MFMA16(QH[(tt * 4 + ks) * 64 + lane], Bf[ks], o[tt]); }
#pragma unroll
        for (int mt = 0; mt < 8; ++mt) { tS[mt] = (f32x4){0.f, 0.f, 0.f, 0.f};
#pragma unroll
            for (int ks = 0; ks < 4; ++ks) tS[mt] = MFMA16(AP[(mt * 4 + ks) * 64 + lane], Bf[ks], tS[mt]); }
#pragma unroll
        for (int mt = 0; mt < 8; ++mt) {
            S[mt][0] = egl * S[mt][0] + tS[mt][0] + __uint_as_float(kh[mt].x << 16); S[mt][1] = egl * S[mt][1] + tS[mt][1] + __uint_as_float(kh[mt].x & 0xffff0000u);
            S[mt][2] = egl * S[mt][2] + tS[mt][2] + __uint_as_float(kh[mt].y << 16); S[mt][3] = egl * S[mt][3] + tS[mt][3] + __uint_as_float(kh[mt].y & 0xffff0000u); }
        if (cl > 0) {
#pragma unroll
            for (int tt = 0; tt < 4; ++tt) {
                o[tt][0] += __uint_as_float(oh[tt].x << 16); o[tt][1] += __uint_as_float(oh[tt].x & 0xffff0000u); o[tt][2] += __uint_as_float(oh[tt].y << 16); o[tt][3] += __uint_as_float(oh[tt].y & 0xffff0000u);
#pragma unroll
                for (int r = 0; r < 4; ++r) obuf[(16 * tt + 4 * q4 + r) * 132 + 16 * w + l15] = o[tt][r]; }
        }
        if (more) { u32x4* dst = (u32x4*)(smem + (cur ^ 1) * 49152);
#pragma unroll
            for (int x = 0; x < 6; ++x) dst[tid + 512 * x] = nx[x]; }
        if (cl > 0) {
            __syncthreads();
            f32x4 ov[4]; float ss = 0.f;
#pragma unroll
            for (int j = 0; j < 4; ++j) { ov[j] = *(const f32x4*)(obuf + et * 132 + 16 * eg + 4 * j); ss += ov[j][0] * ov[j][0] + ov[j][1] * ov[j][1] + ov[j][2] * ov[j][2] + ov[j][3] * ov[j][3]; }
            ss += __shfl_xor(ss, 1); ss += __shfl_xor(ss, 2); ss += __shfl_xor(ss, 4);
            const float rs = __builtin_amdgcn_rsqf(ss * (1.f / 128.f) + 1e-6f);
            const unsigned zz[8] = {z0.x, z0.y, z0.z, z0.w, z1.x, z1.y, z1.z, z1.w};
            unsigned ow[8];
#pragma unroll
            for (int j = 0; j < 8; ++j) ow[j] = pk2(ov[j >> 1][(j & 1) * 2] * rs * __uint_as_float(zz[j] << 16), ov[j >> 1][(j & 1) * 2 + 1] * rs * __uint_as_float(zz[j] & 0xffff0000u));
            const size_t grow = (size_t)b * SEQ + seg * SEGTOK + (cl - 1) * 64 + et;
            bf16_t* oa = (bf16_t*)(p.ws + WS_H) + grow * D + h * 128 + 16 * eg;
            *(u32x4*)oa = (u32x4){ow[0], ow[1], ow[2], ow[3]}; *(u32x4*)(oa + 8) = (u32x4){ow[4], ow[5], ow[6], ow[7]};
        }
    }
#pragma unroll
    for (int mt = 0; mt < 8; ++mt)
#pragma unroll
        for (int r = 0; r < 4; ++r) st[(size_t)(16 * mt + 4 * q4 + r) * 128 + 16 * w + l15] = S[mt][r];
    __syncthreads();
}

constexpr int RL_AT = 0, RL_BT = 9216, RL_KT = 18432, RL_ATT = 27648, RL_RT = 36864, RL_BTLT = 46080, RL_KTLT = 55296, RL_VT = 64512, RL_LAK = 73728, RL_MRB = 82944, RL_MRK = 92160,
              RL_LM = 101376, RL_AF = 117760, RL_TM = 134144, RL_XS = 150528;
__device__ __forceinline__ void rwkv_prep_item(const Params& p, unsigned char* smem, int hb, int row_start, int npad, const bf16_t* prev_row,
                                               bf16_t* halo_out, unsigned char* rec) {
    const int tid = otid(), w = tid >> 6, lane = tid & 63, q4 = lane >> 4, l15 = lane & 15;
    bf16_t* At = (bf16_t*)(smem + RL_AT); bf16_t* Tb = At; bf16_t* Bt = (bf16_t*)(smem + RL_BT); bf16_t* WaT = Bt; bf16_t* Kt = (bf16_t*)(smem + RL_KT); bf16_t* XT = Kt;
    bf16_t* At2 = (bf16_t*)(smem + RL_ATT); bf16_t* Rt = (bf16_t*)(smem + RL_RT); bf16_t* Btl = (bf16_t*)(smem + RL_BTLT); bf16_t* Ktl = (bf16_t*)(smem + RL_KTLT);
    bf16_t* Vr = (bf16_t*)(smem + RL_VT);        bf16_t* Lak = (bf16_t*)(smem + RL_LAK); bf16_t* Mrb = (bf16_t*)(smem + RL_MRB); bf16_t* Mrk = (bf16_t*)(smem + RL_MRK);
    float* Lm = (float*)(smem + RL_LM);
    bf16_t* thw = Lak; bf16_t* adb = Mrb; float* lc = Lm; float* af = (float*)(smem + RL_AF);
    const bf16_t* P = (const bf16_t*)(p.ws + WS_P);
    const float* pk = (const float*)(p.ws + WS_PK);
    const int t = tid >> 3, g = tid & 7;
    float rr[8], kb[8], vv[8], zb[8];
    {
        const bool real = t >= npad;
        const bf16_t* curp = P; const bf16_t* prevp = P; float fprev = 0.f;
        if (real) { curp = P + (size_t)(row_start + t - npad) * NPB; if (t > npad) { prevp = curp - NPB; fprev = 1.f; } else if (prev_row) { prevp = prev_row; fprev = 1.f; } }
        const int secbase[6] = {0, 1024, 2048, 3200, 3072, 3136};
        u32x4 rc[6], rp[6];
#pragma unroll
        for (int sidx = 0; sidx < 6; ++sidx) { const int col = secbase[sidx] + (sidx < 4 ? hb * 64 : 0) + g * 8; rc[sidx] = *(const u32x4*)(curp + C_RW + col); rp[sidx] = *(const u32x4*)(prevp + C_RW + col); }
        float m[6][8];
#pragma unroll
        for (int sidx = 0; sidx < 6; ++sidx) {
            const int col = secbase[sidx] + (sidx < 4 ? hb * 64 : 0) + g * 8;
            float cur[8], prv[8];
            unpack8(rc[sidx], cur); unpack8(rp[sidx], prv);
            const f32x4 mu0 = *(const f32x4*)(pk + PK_MU + col), mu1 = *(const f32x4*)(pk + PK_MU + col + 4);
            const float mu[8] = {mu0[0], mu0[1], mu0[2], mu0[3], mu1[0], mu1[1], mu1[2], mu1[3]};
#pragma unroll
            for (int e = 0; e < 8; ++e) m[sidx][e] = real ? cur[e] + mu[e] * (fprev * prv[e] - cur[e]) : 0.f;
            if (halo_out && t == 63 && (sidx < 4 || hb == 0)) *(u32x4*)(halo_out + C_RW + col) = rc[sidx];
        }
#pragma unroll
        for (int e = 0; e < 8; ++e) { rr[e] = m[0][e]; kb[e] = m[1][e]; vv[e] = m[2][e]; zb[e] = m[3][e]; }
        float th[8];
#pragma unroll
        for (int e = 0; e < 8; ++e) th[e] = tanh_(m[4][e]);
        *(u32x4*)(thw + t * TSTR + g * 8) = pack8(th);
        *(u32x4*)(adb + t * TSTR + g * 8) = pack8(m[5]);
    }
    __syncthreads();
    {
        const int which = w >> 2, ct = w & 3;
        const bf16_t* Wt = (const bf16_t*)(p.ws + (which ? WS_A2T : WS_W2T)) + (size_t)hb * 4096;
        const bf16x8 b0 = *(const bf16x8*)(Wt + (16 * ct + l15) * 64 + 8 * q4), b1 = *(const bf16x8*)(Wt + (16 * ct + l15) * 64 + 32 + 8 * q4);
        const bf16_t* Aarr = which ? adb : thw;
        const int c = 16 * ct + l15;
        const float bias = pk[(which ? PK_A0 : PK_W0) + hb * 64 + c];
        float carry = 0.f;
#pragma unroll
        for (int tt = 0; tt < 4; ++tt) {
            f32x4 acc = {0.f, 0.f, 0.f, 0.f};
            acc = MFMA16(ldfrag(Aarr, TSTR, 16 * tt, 0, lane), b0, acc); acc = MFMA16(ldfrag(Aarr, TSTR, 16 * tt, 32, lane), b1, acc);
            if (which) {
#pragma unroll
                for (int r = 0; r < 4; ++r) af[(16 * tt + 4 * q4 + r) * 64 + c] = sigm(bias + acc[r]);
            } else {
                float wl[4];
#pragma unroll
                for (int r = 0; r < 4; ++r) { const int tk = 16 * tt + 4 * q4 + r; wl[r] = (tk < npad) ? 0.f : -0.6065306597126334f * sigm(bias + acc[r]); }
                wl[1] += wl[0]; wl[2] += wl[1]; wl[3] += wl[2];
                const float Q = wl[3];
                const float Q0 = __shfl(Q, l15), Q1 = __shfl(Q, l15 + 16), Q2 = __shfl(Q, l15 + 32), Q3 = __shfl(Q, l15 + 48);
                const float ex = carry + (q4 > 0 ? Q0 : 0.f) + (q4 > 1 ? Q1 : 0.f) + (q4 > 2 ? Q2 : 0.f);
#pragma unroll
                for (int r = 0; r < 4; ++r) lc[(16 * tt + 4 * q4 + r) * 64 + c] = ex + wl[r];
                carry += Q0 + Q1 + Q2 + Q3;
            }
        }
    }
    __syncthreads();
    {
        float lct[8], lcp[8], lcC[8], av[8];
        { const f32x4 a = *(const f32x4*)(lc + t * 64 + g * 8), b2 = *(const f32x4*)(lc + t * 64 + g * 8 + 4); lct[0] = a[0]; lct[1] = a[1]; lct[2] = a[2]; lct[3] = a[3]; lct[4] = b2[0]; lct[5] = b2[1]; lct[6] = b2[2]; lct[7] = b2[3]; }
        if (t > 0) { const f32x4 a = *(const f32x4*)(lc + (t - 1) * 64 + g * 8), b2 = *(const f32x4*)(lc + (t - 1) * 64 + g * 8 + 4); lcp[0] = a[0]; lcp[1] = a[1]; lcp[2] = a[2]; lcp[3] = a[3]; lcp[4] = b2[0]; lcp[5] = b2[1]; lcp[6] = b2[2]; lcp[7] = b2[3]; }
        else {
#pragma unroll
            for (int e = 0; e < 8; ++e) lcp[e] = 0.f; }
        { const f32x4 a = *(const f32x4*)(lc + 63 * 64 + g * 8), b2 = *(const f32x4*)(lc + 63 * 64 + g * 8 + 4); lcC[0] = a[0]; lcC[1] = a[1]; lcC[2] = a[2]; lcC[3] = a[3]; lcC[4] = b2[0]; lcC[5] = b2[1]; lcC[6] = b2[2]; lcC[7] = b2[3]; }
        { const f32x4 a = *(const f32x4*)(af + t * 64 + g * 8), b2 = *(const f32x4*)(af + t * 64 + g * 8 + 4); av[0] = a[0]; av[1] = a[1]; av[2] = a[2]; av[3] = a[3]; av[4] = b2[0]; av[5] = b2[1]; av[6] = b2[2]; av[7] = b2[3]; }
        const int hc = hb * 64 + g * 8;
        float kk[8], km[8], ss = 0.f, rk = 0.f;
        float pkk[8], pka[8], prk[8];
        { const f32x4 a0 = *(const f32x4*)(pk + PK_KK + hc), a1 = *(const f32x4*)(pk + PK_KK + hc + 4), b0 = *(const f32x4*)(pk + PK_KA + hc), b1 = *(const f32x4*)(pk + PK_KA + hc + 4), c0v = *(const f32x4*)(pk + PK_RK + hc), c1v = *(const f32x4*)(pk + PK_RK + hc + 4);
#pragma unroll
          for (int e = 0; e < 4; ++e) { pkk[e] = a0[e]; pkk[4 + e] = a1[e]; pka[e] = b0[e]; pka[4 + e] = b1[e]; prk[e] = c0v[e]; prk[4 + e] = c1v[e]; } }
#pragma unroll
        for (int e = 0; e < 8; ++e) { kk[e] = kb[e] * pkk[e]; ss += kk[e] * kk[e]; km[e] = kb[e] * (1.f + (av[e] - 1.f) * pka[e]); rk += rr[e] * km[e] * prk[e]; }
        ss += __shfl_xor(ss, 1); ss += __shfl_xor(ss, 2); ss += __shfl_xor(ss, 4);
        rk += __shfl_xor(rk, 1); rk += __shfl_xor(rk, 2); rk += __shfl_xor(rk, 4);
        const float kn = __builtin_amdgcn_rsqf(ss + 1e-6f);
        float xa[8], xb[8], xk[8], xr[8], xbt[8], xkt[8];
#pragma unroll
        for (int e = 0; e < 8; ++e) { kk[e] *= kn; const float ka = kk[e] * av[e]; const float ip = __expf(-lct[e]), tl = __expf(lcC[e] - lct[e]);
            xa[e] = kk[e] * __expf(lcp[e]); xb[e] = ka * ip; xk[e] = km[e] * ip; xr[e] = rr[e] * __expf(lct[e]); xbt[e] = ka * tl; xkt[e] = km[e] * tl; }
        *(u32x4*)(At + t * TSTR + g * 8) = pack8(xa); *(u32x4*)(Bt + t * TSTR + g * 8) = pack8(xb); *(u32x4*)(Kt + t * TSTR + g * 8) = pack8(xk); *(u32x4*)(Rt + t * TSTR + g * 8) = pack8(xr);
        *(u32x4*)(At2 + t * TSTR + g * 8) = pack8(xa); *(u32x4*)(Btl + t * TSTR + g * 8) = pack8(xbt); *(u32x4*)(Ktl + t * TSTR + g * 8) = pack8(xkt); *(u32x4*)(Vr + t * TSTR + g * 8) = pack8(vv);
        float c1[8], c0[8];
#pragma unroll
        for (int e = 0; e < 8; ++e) { c1[e] = 0.f; c0[e] = 0.f; }
        { const f32x4 g0 = *(const f32x4*)(pk + PK_GNW + hc), g1 = *(const f32x4*)(pk + PK_GNW + hc + 4), h0 = *(const f32x4*)(pk + PK_GNB + hc), h1 = *(const f32x4*)(pk + PK_GNB + hc + 4);
#pragma unroll
          for (int e = 0; e < 4; ++e) { const float sz0 = silu_(zb[e]), sz1 = silu_(zb[4 + e]); c1[e] = g0[e] * sz0; c1[4 + e] = g1[e] * sz1; c0[e] = (h0[e] + rk * vv[e]) * sz0; c0[4 + e] = (h1[e] + rk * vv[4 + e]) * sz1; } }
        *(u32x4*)((bf16_t*)(rec + RP_C1) + t * 64 + g * 8) = pack8(c1); *(u32x4*)((bf16_t*)(rec + RP_C0) + t * 64 + g * 8) = pack8(c0);
        if (t == 63) { float* pc = (float*)(rec + RP_PC) + g * 8; *(f32x4*)pc = (f32x4){__expf(lcC[0]), __expf(lcC[1]), __expf(lcC[2]), __expf(lcC[3])}; *(f32x4*)(pc + 4) = (f32x4){__expf(lcC[4]), __expf(lcC[5]), __expf(lcC[6]), __expf(lcC[7])}; }
    }
    __syncthreads();
    {
        const int pr = w >> 1;
        const bf16_t* Aarr = pr < 2 ? At : Rt; const bf16_t* Barr = (pr & 1) ? Kt : Bt;
#pragma unroll
        for (int x = 0; x < 2; ++x) { const int tt = 2 * (w & 1) + x;
            const bf16x8 a0 = ldfrag(Aarr, TSTR, 16 * tt, 0, lane), a1 = ldfrag(Aarr, TSTR, 16 * tt, 32, lane);
            const int tk = 16 * tt + l15;
#pragma unroll
            for (int it = 0; it < 4; ++it) { f32x4 acc = {0.f, 0.f, 0.f, 0.f};
                acc = MFMA16(ldfrag(Barr, TSTR, 16 * it, 0, lane), a0, acc); acc = MFMA16(ldfrag(Barr, TSTR, 16 * it, 32, lane), a1, acc);
                const int i0 = 16 * it + 4 * q4;
                f32x4 o;
#pragma unroll
                for (int r = 0; r < 4; ++r) { const int i = i0 + r; const bool keep = pr < 2 ? (tk > i) : (tk >= i); o[r] = keep ? acc[r] : 0.f; }
                if (pr == 0) *(f32x4*)(Lm + tk * 64 + i0) = o;
                else { bf16_t* Out = pr == 1 ? Lak : (pr == 2 ? Mrb : Mrk); *(u32x2*)(Out + tk * TSTR + i0) = (u32x2){pk2(o[0], o[1]), pk2(o[2], o[3])}; } }
        }
    }
    __syncthreads();
    {
        float* Tm = (float*)(smem + RL_TM);
        inv_block(Lm, Tm, (float*)(smem + RL_XS), tid);
        const int i = tid >> 3, j0 = (tid & 7) * 8;
        float a[8];
#pragma unroll
        for (int e = 0; e < 8; ++e) a[e] = Tm[i * 64 + j0 + e];
        *(u32x4*)(Tb + i * TSTR + j0) = pack8(a);
    }
    __syncthreads();
    {
        const int tt = w & 3, which = w >> 2;
        const bf16_t* Aarr = which ? Lak : Tb; const bf16_t* Barr = which ? Vr : At2; bf16_t* Out = which ? XT : WaT;
        const bf16x8 a0 = ldfrag(Aarr, TSTR, 16 * tt, 0, lane), a1 = ldfrag(Aarr, TSTR, 16 * tt, 32, lane);
#pragma unroll
        for (int ct = 0; ct < 4; ++ct) { f32x4 acc = {0.f, 0.f, 0.f, 0.f};
            acc = MFMA16(a0, ldfrag_tr(Barr, TSTR, 16 * ct, 0, lane), acc); acc = MFMA16(a1, ldfrag_tr(Barr, TSTR, 16 * ct, 32, lane), acc);
            *(u32x2*)(Out + (16 * ct + l15) * TSTR + 16 * tt + 4 * q4) = (u32x2){pk2(acc[0], acc[1]), pk2(acc[2], acc[3])}; }
    }
    __syncthreads();
    {
        f32x4 acc[4];
        if (w < 4) {
            const bf16x8 a0 = ldfrag(Tb, TSTR, 16 * w, 0, lane), a1 = ldfrag(Tb, TSTR, 16 * w, 32, lane);
#pragma unroll
            for (int ct = 0; ct < 4; ++ct) { acc[ct] = (f32x4){0.f, 0.f, 0.f, 0.f};
                acc[ct] = MFMA16(a0, ldfrag(XT, TSTR, 16 * ct, 0, lane), acc[ct]); acc[ct] = MFMA16(a1, ldfrag(XT, TSTR, 16 * ct, 32, lane), acc[ct]); }
        }
        if (w < 4) {
            bf16_t* UvTw = (bf16_t*)(smem + RL_LM);
#pragma unroll
            for (int ct = 0; ct < 4; ++ct) *(u32x2*)(UvTw + (16 * ct + l15) * TSTR + 16 * w + 4 * q4) = (u32x2){pk2(-acc[ct][0], -acc[ct][1]), pk2(-acc[ct][2], -acc[ct][3])};
        }
    }
    __syncthreads();
    {
        const bf16_t* UvT = (const bf16_t*)(smem + RL_LM);
        bf16_t* gAP = (bf16_t*)(rec + RP_AP); bf16_t* gRH = (bf16_t*)(rec + RP_RH); bf16_t* gKH = (bf16_t*)(rec + RP_KH); bf16_t* gYH = (bf16_t*)(rec + RP_YH);
        const int et = w & 3, part = w >> 2;
        {
            const bf16x8 a0 = ldfrag(WaT, TSTR, 16 * et, 0, lane), a1 = ldfrag(WaT, TSTR, 16 * et, 32, lane);
            if (part == 0) {
#pragma unroll
                for (int kt = 0; kt < 4; ++kt) { f32x4 acc = {0.f, 0.f, 0.f, 0.f};
                    acc = MFMA16(a0, ldfrag_tr(Btl, TSTR, 16 * kt, 0, lane), acc); acc = MFMA16(a1, ldfrag_tr(Btl, TSTR, 16 * kt, 32, lane), acc);
                    *(u32x2*)(gAP + ((size_t)(kt * 2 + (et >> 1)) * 64 + lane) * 8 + (et & 1) * 4) = (u32x2){pk2(-acc[0], -acc[1]), pk2(-acc[2], -acc[3])}; }
            } else {
#pragma unroll
                for (int tt = 0; tt < 4; ++tt) { f32x4 acc = {0.f, 0.f, 0.f, 0.f};
                    acc = MFMA16(a0, ldfrag(Mrb, TSTR, 16 * tt, 0, lane), acc); acc = MFMA16(a1, ldfrag(Mrb, TSTR, 16 * tt, 32, lane), acc);
                    const int tk = 16 * tt + l15, e0 = 16 * et + 4 * q4;
                    const u32x2 q2 = *(const u32x2*)(Rt + tk * TSTR + e0);
                    const float o0 = __uint_as_float(q2.x << 16) - acc[0], o1 = __uint_as_float(q2.x & 0xffff0000u) - acc[1], o2 = __uint_as_float(q2.y << 16) - acc[2], o3 = __uint_as_float(q2.y & 0xffff0000u) - acc[3];
                    *(u32x2*)(gRH + ((size_t)(tt * 2 + (et >> 1)) * 64 + lane) * 8 + (et & 1) * 4) = (u32x2){pk2(o0, o1), pk2(o2, o3)}; }
            }
        }
        {
            const int rt = w & 3;
            bf16_t* Out = part ? gKH : gYH;
            bf16x8 a0, a1, a2, a3;
            if (part) { a0 = ldfrag_tr(Btl, TSTR, 16 * rt, 0, lane); a1 = ldfrag_tr(Btl, TSTR, 16 * rt, 32, lane); a2 = ldfrag_tr(Ktl, TSTR, 16 * rt, 0, lane); a3 = ldfrag_tr(Ktl, TSTR, 16 * rt, 32, lane); }
            else { a0 = ldfrag(Mrb, TSTR, 16 * rt, 0, lane); a1 = ldfrag(Mrb, TSTR, 16 * rt, 32, lane); a2 = ldfrag(Mrk, TSTR, 16 * rt, 0, lane); a3 = ldfrag(Mrk, TSTR, 16 * rt, 32, lane); }
#pragma unroll
            for (int vt = 0; vt < 4; ++vt) { f32x4 acc = {0.f, 0.f, 0.f, 0.f};
                acc = MFMA16(a0, ldfrag(UvT, TSTR, 16 * vt, 0, lane), acc); acc = MFMA16(a1, ldfrag(UvT, TSTR, 16 * vt, 32, lane), acc);
                acc = MFMA16(a2, ldfrag_tr(Vr, TSTR, 16 * vt, 0, lane), acc); acc = MFMA16(a3, ldfrag_tr(Vr, TSTR, 16 * vt, 32, lane), acc);
                *(u32x2*)(Out + ((size_t)(vt * 4 + rt) * 64 + lane) * 4) = (u32x2){pk2(acc[0], acc[1]), pk2(acc[2], acc[3])}; }
        }
    }
    __syncthreads();
}

__device__ __forceinline__ void phase_rprep(const Params& p, int seg, unsigned char* smem) {
    const int blk = obid();
    const int n_items = (CPS + (seg == 0 ? 1 : 0)) * 128;
#pragma unroll 1
    for (int it = (blk + (gridDim.x >> 1)) % gridDim.x; it < n_items; it += gridDim.x) {
        const int bh = it & 127, b = bh >> 4, hb = bh & 15; int cl = it >> 7; if (seg != 0) cl += 1;
        unsigned char* rec = p.ws + WS_RP + (size_t)(cl * 128 + bh) * RP_STRIDE;
        const bf16_t* Pb = (const bf16_t*)(p.ws + WS_P);
        bf16_t* phalo2 = (bf16_t*)(p.ws + WS_PHALO);
        if (cl == 0) rwkv_prep_item(p, smem, hb, LEX0, 48, nullptr, nullptr, rec);
        else {
            const int row = b * SEGTOK + (cl - 1) * 64;
            const bf16_t* prow = Pb + (size_t)(row - 1) * NPB;
            if (cl == 1) prow = (seg == 0) ? Pb + (size_t)(LEX0 + NMETA - 1) * NPB : phalo2 + (size_t)(((seg - 1) & 1) * NBATCH + b) * NPB;
            bf16_t* ho = (cl == CPS) ? phalo2 + (size_t)((seg & 1) * NBATCH + b) * NPB : nullptr;
            rwkv_prep_item(p, smem, hb, row, 0, prow, ho, rec);
        }
    }
}

__device__ __forceinline__ void rwkv_scan_block(const Params& p, int seg, unsigned char* smem, int pairidx) {
    const int tid = otid(), w = tid >> 6, lane = tid & 63, q4 = lane >> 4, l15 = lane & 15;
    const int hsel = w >> 2, vt = w & 3;
    const int bh = pairidx * 2 + hsel, b = bh >> 4, hb = bh & 15;
    float* st = p.out + O_RWKV_P + (size_t)bh * 4096;
    f32x4 S[4];
    if (seg) {
#pragma unroll
        for (int mt = 0; mt < 4; ++mt) S[mt] = *(const f32x4*)(st + (size_t)(16 * vt + l15) * 64 + 16 * mt + 4 * q4);
    } else {
#pragma unroll
        for (int mt = 0; mt < 4; ++mt) S[mt] = (f32x4){0.f, 0.f, 0.f, 0.f};
    }
    const int c_lo = seg ? 1 : 0;
    float* ybuf = (float*)(smem + 65536) + hsel * (64 * 68);
    const int tl = tid & 255;
    {
        const u32x4* src = (const u32x4*)(p.ws + WS_RP + (size_t)(c_lo * 128 + bh) * RP_STRIDE); u32x4* dst = (u32x4*)(smem + hsel * 16384);
#pragma unroll
        for (int x = 0; x < 4; ++x) dst[tl + 256 * x] = src[tl + 256 * x];
    }
#pragma unroll 1
    for (int cl = c_lo; cl <= CPS; ++cl) {
        const unsigned char* rec = p.ws + WS_RP + (size_t)(cl * 128 + bh) * RP_STRIDE;
        const int cur = (cl - c_lo) & 1;
        __syncthreads();
        u32x4 nx[4];
        const bool more = cl < CPS;
        if (more) { const u32x4* src = (const u32x4*)(rec + (size_t)RP_STRIDE * 128);
#pragma unroll
            for (int x = 0; x < 4; ++x) nx[x] = src[tl + 256 * x]; }
        const bf16_t* gKH = (const bf16_t*)(rec + RP_KH); const bf16_t* gYH = (const bf16_t*)(rec + RP_YH);
        u32x2 kh[4], yh[4]; f32x4 pc[4];
#pragma unroll
        for (int mt = 0; mt < 4; ++mt) { kh[mt] = *(const u32x2*)(gKH + ((size_t)(vt * 4 + mt) * 64 + lane) * 4); yh[mt] = *(const u32x2*)(gYH + ((size_t)(vt * 4 + mt) * 64 + lane) * 4);
            pc[mt] = *(const f32x4*)((const float*)(rec + RP_PC) + 16 * mt + 4 * q4); }
        const int tk = tl >> 2, g = tl & 3;
        u32x4 a0 = {0u, 0u, 0u, 0u}, a1 = a0, b0 = a0, b1 = a0;
        if (cl > 0) { const bf16_t* c1p = (const bf16_t*)(rec + RP_C1) + tk * 64 + 16 * g; const bf16_t* c0p = (const bf16_t*)(rec + RP_C0) + tk * 64 + 16 * g;
            a0 = *(const u32x4*)c0p; a1 = *(const u32x4*)(c0p + 8); b0 = *(const u32x4*)c1p; b1 = *(const u32x4*)(c1p + 8); }
        bf16x8 Bf[2];
#pragma unroll
        for (int ks = 0; ks < 2; ++ks) { u32x4 tq; tq.x = pk2(S[2 * ks][0], S[2 * ks][1]); tq.y = pk2(S[2 * ks][2], S[2 * ks][3]); tq.z = pk2(S[2 * ks + 1][0], S[2 * ks + 1][1]); tq.w = pk2(S[2 * ks + 1][2], S[2 * ks + 1][3]);
            Bf[ks] = __builtin_bit_cast(bf16x8, tq); }
        const bf16x8* AP = (const bf16x8*)(smem + cur * 32768 + hsel * 16384); const bf16x8* RH = (const bf16x8*)(smem + cur * 32768 + hsel * 16384 + RP_RH);
        f32x4 y[4], tS[4];
#pragma unroll
        for (int tt = 0; tt < 4; ++tt) { y[tt] = (f32x4){0.f, 0.f, 0.f, 0.f}; y[tt] = MFMA16(RH[(tt * 2 + 0) * 64 + lane], Bf[0], y[tt]); y[tt] = MFMA16(RH[(tt * 2 + 1) * 64 + lane], Bf[1], y[tt]); }
#pragma unroll
        for (int mt = 0; mt < 4; ++mt) { tS[mt] = (f32x4){0.f, 0.f, 0.f, 0.f}; tS[mt] = MFMA16(AP[(mt * 2 + 0) * 64 + lane], Bf[0], tS[mt]); tS[mt] = MFMA16(AP[(mt * 2 + 1) * 64 + lane], Bf[1], tS[mt]); }
#pragma unroll
        for (int mt = 0; mt < 4; ++mt) {
            S[mt][0] = pc[mt][0] * S[mt][0] + tS[mt][0] + __uint_as_float(kh[mt].x << 16); S[mt][1] = pc[mt][1] * S[mt][1] + tS[mt][1] + __uint_as_float(kh[mt].x & 0xffff0000u);
            S[mt][2] = pc[mt][2] * S[mt][2] + tS[mt][2] + __uint_as_float(kh[mt].y << 16); S[mt][3] = pc[mt][3] * S[mt][3] + tS[mt][3] + __uint_as_float(kh[mt].y & 0xffff0000u); }
        if (cl > 0) {
#pragma unroll
            for (int tt = 0; tt < 4; ++tt) {
                y[tt][0] += __uint_as_float(yh[tt].x << 16); y[tt][1] += __uint_as_float(yh[tt].x & 0xffff0000u); y[tt][2] += __uint_as_float(yh[tt].y << 16); y[tt][3] += __uint_as_float(yh[tt].y & 0xffff0000u);
#pragma unroll
                for (int r = 0; r < 4; ++r) ybuf[(16 * tt + 4 * q4 + r) * 68 + 16 * vt + l15] = y[tt][r]; }
        }
        if (more) { u32x4* dst = (u32x4*)(smem + (cur ^ 1) * 32768 + hsel * 16384);
#pragma unroll
            for (int x = 0; x < 4; ++x) dst[tl + 256 * x] = nx[x]; }
        if (cl > 0) {
            __syncthreads();
            f32x4 yv[4]; float sm = 0.f;
#pragma unroll
            for (int j = 0; j < 4; ++j) { yv[j] = *(const f32x4*)(ybuf + tk * 68 + 16 * g + 4 * j); sm += yv[j][0] + yv[j][1] + yv[j][2] + yv[j][3]; }
            sm += __shfl_xor(sm, 1); sm += __shfl_xor(sm, 2);
            const float mu = sm * (1.f / 64.f); float vs = 0.f;
#pragma unroll
            for (int j = 0; j < 4; ++j) { yv[j] = yv[j] - mu; vs += yv[j][0] * yv[j][0] + yv[j][1] * yv[j][1] + yv[j][2] * yv[j][2] + yv[j][3] * yv[j][3]; }
            vs += __shfl_xor(vs, 1); vs += __shfl_xor(vs, 2);
            const float rs = __builtin_amdgcn_rsqf(vs * (1.f / 64.f) + 64e-5f);
            const unsigned c0w[8] = {a0.x, a0.y, a0.z, a0.w, a1.x, a1.y, a1.z, a1.w}, c1w[8] = {b0.x, b0.y, b0.z, b0.w, b1.x, b1.y, b1.z, b1.w};
            unsigned ow[8];
#pragma unroll
            for (int j = 0; j < 8; ++j) ow[j] = pk2(yv[j >> 1][(j & 1) * 2] * rs * __uint_as_float(c1w[j] << 16) + __uint_as_float(c0w[j] << 16),
                                                     yv[j >> 1][(j & 1) * 2 + 1] * rs * __uint_as_float(c1w[j] & 0xffff0000u) + __uint_as_float(c0w[j] & 0xffff0000u));
            const size_t grow = (size_t)b * SEQ + seg * SEGTOK + (cl - 1) * 64 + tk;
            bf16_t* ob = (bf16_t*)(p.ws + WS_OB) + grow * D + hb * 64 + 16 * g;
            *(u32x4*)ob = (u32x4){ow[0], ow[1], ow[2], ow[3]}; *(u32x4*)(ob + 8) = (u32x4){ow[4], ow[5], ow[6], ow[7]};
        }
    }
#pragma unroll
    for (int mt = 0; mt < 4; ++mt) *(f32x4*)(st + (size_t)(16 * vt + l15) * 64 + 16 * mt + 4 * q4) = S[mt];
    __syncthreads();
}

__device__ __forceinline__ void gdn_sample_item(const Params& p, unsigned char* smem, int bs, int h) {
    const int tid = otid(), w = tid >> 6, lane = tid & 63, kq = tid >> 7, v = tid & 127;
    float* qk_s = (float*)smem; float* v_s = qk_s + 1024; float* gb_s = v_s + 512; float* part = gb_s + 16; float* part2 = part + 512;
    const bf16_t* P = (const bf16_t*)(p.ws + WS_P);
    const float* pk = (const float*)(p.ws + WS_PK);
    const float* s_in = p.in[2] + (size_t)(bs * 8 + h) * 16384; float* s_out = p.out + O_GDN_S + (size_t)(bs * 8 + h) * 16384;
    const int row0 = LEX0 + EX_SAMP + bs * DECT;
    float s[32];
#pragma unroll
    for (int j = 0; j < 32; ++j) s[j] = s_in[(size_t)(kq * 32 + j) * 128 + v];
    if (tid < 384) {
        const int pcol = (tid >> 7) * 1024 + h * 128 + (tid & 127);
        const float* cw = pk + PK_CONVW; const float* hin = p.in[3] + (size_t)bs * 9216; float* hout = p.out + O_CONV_S + (size_t)bs * 9216;
        const float cw0 = cw[pcol], cw1 = cw[3072 + pcol], cw2 = cw[6144 + pcol], cw3 = cw[9216 + pcol];
        float x3 = hin[pcol], x2 = hin[3072 + pcol], x1 = hin[6144 + pcol];
        float xr[4];
#pragma unroll
        for (int i = 0; i < 4; ++i) xr[i] = bf2f(P[(size_t)(row0 + i) * NPB + pcol]);
#pragma unroll
        for (int i = 0; i < 4; ++i) { const float y = cw0 * x3 + cw1 * x2 + cw2 * x1 + cw3 * xr[i]; x3 = x2; x2 = x1; x1 = xr[i];
            if (tid < 256) qk_s[i * 256 + tid] = silu_(y); else v_s[i * 128 + (tid - 256)] = silu_(y); }
        hout[pcol] = x3; hout[3072 + pcol] = x2; hout[6144 + pcol] = x1;
    } else if (tid < 388) {
        const int i = tid - 384; const size_t r = (size_t)(row0 + i) * NPB;
        const float pa = bf2f(P[r + C_A + h]), pb = bf2f(P[r + C_B + h]);
        gb_s[2 * i] = __expf(-expf(pk[PK_ALOG + h]) * softplus_(pa + pk[PK_DTB + h])); gb_s[2 * i + 1] = sigm(pb);
    }
    __syncthreads();
    { const int i = w >> 1, which = w & 1; float* rp = qk_s + i * 256 + which * 128; const float a = rp[lane], b = rp[lane + 64];
      const float sc = __builtin_amdgcn_rsqf(wave_sum(a * a + b * b) + 1e-6f) * (which == 0 ? 0.08838834764831845f : 1.f); rp[lane] = a * sc; rp[lane + 64] = b * sc; }
    __syncthreads();
#pragma unroll 1
    for (int i = 0; i < 4; ++i) {
        const float* kp = qk_s + i * 256 + 128 + kq * 32; const float* qp = qk_s + i * 256 + kq * 32;
        float pa = 0.f;
#pragma unroll
        for (int j4 = 0; j4 < 8; ++j4) { const f32x4 k4 = *(const f32x4*)(kp + 4 * j4); pa += k4[0] * s[4 * j4] + k4[1] * s[4 * j4 + 1] + k4[2] * s[4 * j4 + 2] + k4[3] * s[4 * j4 + 3]; }
        part[kq * 128 + v] = pa;
        __syncthreads();
        const float kS = part[v] + part[128 + v] + part[256 + v] + part[384 + v];
        const float a = gb_s[2 * i], c = gb_s[2 * i + 1] * (v_s[i * 128 + v] - a * kS);
        float po = 0.f;
#pragma unroll
        for (int j4 = 0; j4 < 8; ++j4) { const f32x4 k4 = *(const f32x4*)(kp + 4 * j4), q4v = *(const f32x4*)(qp + 4 * j4);
#pragma unroll
            for (int e = 0; e < 4; ++e) { s[4 * j4 + e] = a * s[4 * j4 + e] + k4[e] * c; po += q4v[e] * s[4 * j4 + e]; } }
        part2[kq * 128 + v] = po;
        __syncthreads();
        if (kq == 0) ((float*)(p.ws + WS_ORAW))[(size_t)(row0 + i) * D + h * 128 + v] = part2[v] + part2[128 + v] + part2[256 + v] + part2[384 + v];
    }
#pragma unroll
    for (int j = 0; j < 32; ++j) s_out[(size_t)(kq * 32 + j) * 128 + v] = s[j];
    __syncthreads();
}

constexpr int SR_R = 0, SR_KK = 4096, SR_V = 8192, SR_ZB = 12288, SR_DEC = 16384, SR_KA = 20480, SR_KM = 24576, SR_WD = 28672, SR_AD = 28928, SR_RK = 29184;
__device__ __forceinline__ void rwkv_sample_item(const Params& p, unsigned char* smem, int bs) {
    const int tid = otid(), w = tid >> 6, lane = tid & 63;
    float* f = (float*)smem;
    const bf16_t* P = (const bf16_t*)(p.ws + WS_P);
    const float* pk = (const float*)(p.ws + WS_PK);
    const int row0 = LEX0 + EX_SAMP + bs * DECT;
    const bf16_t* prow = P + (size_t)(LEX0 + EX_SHIFT + bs) * NPB + C_RW;
#pragma unroll 1
    for (int col = tid; col < RW_SHIFT; col += 512) {
        const float mu = pk[PK_MU + col]; float prev = bf2f(prow[col]);
        float cur[4];
#pragma unroll
        for (int i = 0; i < 4; ++i) cur[i] = bf2f(P[(size_t)(row0 + i) * NPB + C_RW + col]);
        float* dst; int stride = 1024; bool th = false;
        if (col < 1024) dst = f + SR_R + col; else if (col < 2048) dst = f + SR_KK + (col - 1024); else if (col < 3072) dst = f + SR_V + (col - 2048);
        else if (col < 3136) { dst = f + SR_WD + (col - 3072); stride = 64; th = true; } else if (col < 3200) { dst = f + SR_AD + (col - 3136); stride = 64; } else dst = f + SR_ZB + (col - 3200);
#pragma unroll
        for (int i = 0; i < 4; ++i) { float m = cur[i] + mu * (prev - cur[i]); prev = cur[i]; if (th) m = tanh_(m); dst[i * stride] = m; }
    }
    __syncthreads();
#pragma unroll 1
    for (int cc = 0; cc < 2; ++cc) {
        const int c = tid + 512 * cc;
        float aw[4] = {0.f, 0.f, 0.f, 0.f}, aa[4] = {0.f, 0.f, 0.f, 0.f};
#pragma unroll 8
        for (int l = 0; l < 64; ++l) { const float w2v = pk[PK_W2 + l * D + c], a2v = pk[PK_A2 + l * D + c];
#pragma unroll
            for (int i = 0; i < 4; ++i) { aw[i] += f[SR_WD + i * 64 + l] * w2v; aa[i] += f[SR_AD + i * 64 + l] * a2v; } }
        const float w0c = pk[PK_W0 + c], a0c = pk[PK_A0 + c], kkc = pk[PK_KK + c], kac = pk[PK_KA + c];
#pragma unroll
        for (int i = 0; i < 4; ++i) { const float a = sigm(a0c + aa[i]); const float kbv = f[SR_KK + i * 1024 + c];
            f[SR_DEC + i * 1024 + c] = __expf(-0.6065306597126334f * sigm(w0c + aw[i])); f[SR_KA + i * 1024 + c] = a; f[SR_KK + i * 1024 + c] = kbv * kkc; f[SR_KM + i * 1024 + c] = kbv * (1.f + (a - 1.f) * kac); }
    }
    __syncthreads();
#pragma unroll 1
    for (int x = 0; x < 8; ++x) { const int pr = w * 8 + x, i = pr >> 4, hh = pr & 15; const int o = i * 1024 + hh * 64 + lane;
        const float kr = f[SR_KK + o]; const float kk = kr * __builtin_amdgcn_rsqf(wave_sum(kr * kr) + 1e-6f); f[SR_KK + o] = kk; f[SR_KA + o] = kk * f[SR_KA + o];
        const float rkv = wave_sum(f[SR_R + o] * f[SR_KM + o] * pk[PK_RK + hh * 64 + lane]); if (lane == 0) f[SR_RK + pr] = rkv; }
    __syncthreads();
#pragma unroll 1
    for (int hp = 0; hp < 2; ++hp) {
        const int hb = hp * 8 + w;
        const float* s_in = p.in[4] + (size_t)(bs * 16 + hb) * 4096 + (size_t)lane * 64; float* s_out = p.out + O_RWKV_S + (size_t)(bs * 16 + hb) * 4096 + (size_t)lane * 64;
        f32x4 S[16];
#pragma unroll
        for (int j = 0; j < 16; ++j) S[j] = *(const f32x4*)(s_in + 4 * j);
        const int cch = hb * 64 + lane;
        const float gnw = pk[PK_GNW + cch], gnb = pk[PK_GNB + cch];
#pragma unroll 1
        for (int i = 0; i < 4; ++i) {
            const int o = i * 1024 + hb * 64;
            const float vv = f[SR_V + o + lane], rk = f[SR_RK + i * 16 + hb];
            float sa = 0.f;
#pragma unroll
            for (int j = 0; j < 16; ++j) { const f32x4 kk4 = *(const f32x4*)(f + SR_KK + o + 4 * j); sa += S[j][0] * kk4[0] + S[j][1] * kk4[1] + S[j][2] * kk4[2] + S[j][3] * kk4[3]; }
            float y = 0.f;
#pragma unroll
            for (int j = 0; j < 16; ++j) { const f32x4 de4 = *(const f32x4*)(f + SR_DEC + o + 4 * j), ka4 = *(const f32x4*)(f + SR_KA + o + 4 * j), km4 = *(const f32x4*)(f + SR_KM + o + 4 * j), r4 = *(const f32x4*)(f + SR_R + o + 4 * j);
#pragma unroll
                for (int e = 0; e < 4; ++e) { S[j][e] = S[j][e] * de4[e] + (vv * km4[e] - sa * ka4[e]); y += S[j][e] * r4[e]; } }
            const float mu = wave_sum(y) * (1.f / 64.f); const float dy = y - mu;
            const float rs = __builtin_amdgcn_rsqf(wave_sum(dy * dy) * (1.f / 64.f) + 64e-5f);
            const float ov = (dy * rs * gnw + gnb + rk * vv) * silu_(f[SR_ZB + i * 1024 + cch]);
            ((bf16_t*)(p.ws + WS_OB))[(size_t)(XROWS + EX_SAMP + bs * DECT + i) * D + cch] = (bf16_t)f2bf(ov);
        }
#pragma unroll
        for (int j = 0; j < 16; ++j) *(f32x4*)(s_out + 4 * j) = S[j];
    }
    __syncthreads();
}

__device__ __forceinline__ void phase2(const Params& p, int seg, unsigned char* smem) {
    const int blk = obid();
    float* out = p.out;
    float* chalo = (float*)(p.ws + WS_CHALO); float* phalo = (float*)(p.ws + WS_PHALO);
#ifndef SUB
#define SUB 0
#endif
#define SEN(x) (SUB == 0 || SUB == (x))
    if (SEN(1) && blk < 64) gdn_scan_block(p, seg, smem, blk);
    if (SEN(3) && blk >= 64 && blk < 128) rwkv_scan_block(p, seg, smem, blk - 64);
#ifndef DUP
#define DUP 0
#endif
    if (seg == 0) {
#pragma unroll 1
        for (int it = blk; it < DECB * 8; it += gridDim.x) gdn_sample_item(p, smem, it >> 3, it & 7);
#pragma unroll 1
        for (int it = blk; it < DECB; it += gridDim.x) rwkv_sample_item(p, smem, it);
    }
}

__device__ __forceinline__ void phase25(const Params& p, int seg) {
    const int tid0 = otid(); const int lane = tid0 & 63; const int gw = obid() * 8 + (tid0 >> 6), NGW = gridDim.x * 8;
    const bf16_t* P = (const bf16_t*)(p.ws + WS_P);
    const float* ORAW = (const float*)(p.ws + WS_ORAW); const float* YRAW = (const float*)(p.ws + WS_YRAW);
    const bf16_t* C0 = (const bf16_t*)(p.ws + WS_C0); const bf16_t* C1 = (const bf16_t*)(p.ws + WS_C1);
    bf16_t* OA = (bf16_t*)(p.ws + WS_H); bf16_t* OB = (bf16_t*)(p.ws + WS_OB);
    const int nrows = LEX0 + (seg == 0 ? DECB * DECT : 0);
    const int c = lane * 16;
    f32x4 nw[4];
#pragma unroll
    for (int j = 0; j < 4; ++j) nw[j] = *(const f32x4*)((const float*)(p.ws + WS_PK) + PK_NORMW + (c & 127) + 4 * j);
#pragma unroll 1
    for (int rr = LEX0 + gw; rr < nrows; rr += NGW) {
        int lr; size_t grow;
        if (rr < LEX0) { lr = rr; grow = (size_t)(rr / SEGTOK) * SEQ + seg * SEGTOK + (rr % SEGTOK); } else { lr = LEX0 + EX_SAMP + (rr - LEX0); grow = (size_t)XROWS + EX_SAMP + (rr - LEX0); }
        {
            f32x4 o[4]; float ss = 0.f;
#pragma unroll
            for (int j = 0; j < 4; ++j) { o[j] = *(const f32x4*)(ORAW + (size_t)lr * D + c + 4 * j); ss += o[j][0] * o[j][0] + o[j][1] * o[j][1] + o[j][2] * o[j][2] + o[j][3] * o[j][3]; }
            ss += __shfl_xor(ss, 1); ss += __shfl_xor(ss, 2); ss += __shfl_xor(ss, 4);
            const float rs = __builtin_amdgcn_rsqf(ss * (1.f / 128.f) + 1e-6f);
            const u32x4 z0 = *(const u32x4*)(P + (size_t)lr * NPB + C_Z + c), z1 = *(const u32x4*)(P + (size_t)lr * NPB + C_Z + c + 8);
            const unsigned zz[8] = {z0.x, z0.y, z0.z, z0.w, z1.x, z1.y, z1.z, z1.w};
            unsigned ow[8];
#pragma unroll
            for (int j = 0; j < 8; ++j) { const float za = __uint_as_float(zz[j] << 16), zb = __uint_as_float(zz[j] & 0xffff0000u);
                const float a = o[j >> 1][(j & 1) * 2] * rs * nw[j >> 1][(j & 1) * 2] * silu_(za), b = o[j >> 1][(j & 1) * 2 + 1] * rs * nw[j >> 1][(j & 1) * 2 + 1] * silu_(zb);
                ow[j] = pk2(a, b); }
            *(u32x4*)(OA + grow * D + c) = (u32x4){ow[0], ow[1], ow[2], ow[3]}; *(u32x4*)(OA + grow * D + c + 8) = (u32x4){ow[4], ow[5], ow[6], ow[7]};
        }
    }
}

__device__ __forceinline__ void phase_final(const Params& p) {
    const int tid0 = otid(); const int lane = tid0 & 63; const int gw = obid() * 8 + (tid0 >> 6), NGW = gridDim.x * 8;
    const f32x4* wr = (const f32x4*)((const float*)(p.ws + WS_PK) + PK_LNF) + lane;
    f32x4 wv[4];
#pragma unroll
    for (int j = 0; j < 4; ++j) wv[j] = wr[64 * j];
    constexpr int NR = XROWS + DECB * DECT;
#pragma unroll 1
    for (int r = gw; r < NR; r += 2 * NGW) {
        const int r1 = r + NGW; const bool has1 = r1 < NR;
        f32x4* x0 = (f32x4*)(p.out + (size_t)r * D) + lane; f32x4* x1 = (f32x4*)(p.out + (size_t)(has1 ? r1 : r) * D) + lane;
        f32x4 a[4], b[4]; float s0 = 0.f, s1 = 0.f;
#pragma unroll
        for (int j = 0; j < 4; ++j) { a[j] = x0[64 * j]; b[j] = x1[64 * j]; }
#pragma unroll
        for (int j = 0; j < 4; ++j) { s0 += a[j][0] * a[j][0] + a[j][1] * a[j][1] + a[j][2] * a[j][2] + a[j][3] * a[j][3]; s1 += b[j][0] * b[j][0] + b[j][1] * b[j][1] + b[j][2] * b[j][2] + b[j][3] * b[j][3]; }
        const float q0 = __builtin_amdgcn_rsqf(wave_sum(s0) * (1.f / D) + 1e-6f), q1 = __builtin_amdgcn_rsqf(wave_sum(s1) * (1.f / D) + 1e-6f);
#pragma unroll
        for (int j = 0; j < 4; ++j) x0[64 * j] = a[j] * q0 * wv[j];
        if (has1) {
#pragma unroll
            for (int j = 0; j < 4; ++j) x1[64 * j] = b[j] * q1 * wv[j]; }
    }
}

__global__ __launch_bounds__(512, 2) void hybrid_mega(Params p) {
    extern __shared__ __attribute__((aligned(16))) unsigned char smem[];
    cg::grid_group grid = cg::this_grid();
    LAS unsigned char* lds = (LAS unsigned char*)smem;
    const int G = gridDim.x;
    volatile LAS unsigned* xst = (volatile LAS unsigned*)(lds + (LDS_TOTAL - 16));
    if (threadIdx.x == 0) { xst[0] = 0u; xst[1] = 0u; }
    __syncthreads();
    (void)xcd_barrier_post((unsigned*)(p.ws + WS_BAR), xst);
    if (G == 0x7fffffff) grid.sync();
#define GSYNC() do { XcdBarrier xb_; xb_.bar = (unsigned*)(p.ws + WS_BAR); xb_.x = xb_xcc_id(); xb_.st = (volatile LAS unsigned*)((LAS unsigned char*)smem + (LDS_TOTAL - 16)); xcd_barrier(xb_); } while (0)

#ifndef ONLY
#define ONLY 0
#endif
#define EN(x) (ONLY == 0 || ONLY == (x))
    if (EN(1)) phase0(p, smem);
    GSYNC();
#pragma unroll 1
    for (int it = 0; it <= NSEG + 2; ++it) {
        const int xblk = obid() - (G - 12);
        const bool xrole = xblk >= 0;
        if (it > 0 && it <= NSEG && EN(3)) phase2(p, it - 1, smem);
        if ((((it == 2 || it == 3) && xrole) || it == NSEG + 1) && EN(5)) {
            const bool ex = it <= 3;
            SchedAB S; S.ob.init(ex ? 3 : XROWS / 256, 4, ex ? 12 : G, ex ? xblk : obid()); S.pm0 = ex ? XROWS / 256 : 0; S.wfix = ex ? it - 2 : -1;
            S.A0 = (const char*)(p.ws + WS_H); S.A1 = (const char*)(p.ws + WS_OB); S.B0 = (const char*)(p.ws + WS_WT_A); S.B1 = (const char*)(p.ws + WS_WT_B);
            EpiAB E; E.tmp = ex ? (bf16_t*)(p.ws + WS_YRAW) - (size_t)XROWS * D : (bf16_t*)(p.ws + WS_P); E.merged = ex ? (bf16_t*)(p.ws + WS_C0) - (size_t)XROWS * D : (bf16_t*)(p.ws + WS_MG);
            E.gex = (const bf16_t*)(p.ws + WS_GEX); E.out = p.out; E.pairmode = ex ? 0 : 1;
            pg8::gemm_phase<EpiAB, SchedAB>(lds, D, S, E);
        }
        if (((it == 4 && xrole) || it == NSEG + 2) && EN(6)) {
            const bool ex = it == 4;
            SchedO S; S.ob.init(ex ? 3 : XROWS / 256, 4, ex ? 12 : G, ex ? xblk : obid()); S.pm0 = ex ? XROWS / 256 : 0;
            S.A = ex ? (const char*)((bf16_t*)(p.ws + WS_C0) - (size_t)XROWS * D) : (const char*)(p.ws + WS_MG); S.B = (const char*)(p.ws + WS_WT_O);
            EpiO E; E.out = p.out; E.xp = p.in[0]; E.xs = p.in[1];
            pg8::gemm_phase<EpiO, SchedO>(lds, D, S, E);
        }
        const bool xphase = it >= 2 && it <= 4;
        if (it < NSEG && EN(2) && !(xphase && xrole)) {
            const int seg = it;
            const int Gp = xphase ? G - 12 : G;
            const int cidx = it > 0 ? (obid() + (Gp >> 1)) % Gp : obid();
            SchedIn S; S.ob.init(seg == 0 ? LT_PROMPT + 3 : LT_PROMPT, NT_IN, Gp, cidx); S.seg = seg; S.A = (const char*)(p.ws + WS_H); S.B = (const char*)(p.ws + WS_WT_IN);
            EpiIn E; E.P = (bf16_t*)(p.ws + WS_P); E.gex = (bf16_t*)(p.ws + WS_GEX); E.out = p.out; E.seg = seg;
            pg8::gemm_phase<EpiIn, SchedIn>(lds, D, S, E);
        }
        {
            const int hlo = 208, hhi = (it >= 2 && it <= 4) ? G - 12 : G;
            if (it >= 1 && it + 1 < NSEG && obid() >= hlo && obid() < hhi) { const int t0 = otid(); h_rows_segs(p, it + 1, it + 2, (obid() - hlo) * 8 + (t0 >> 6), (hhi - hlo) * 8, t0 & 63); }
        }
        GSYNC();
        if (it < NSEG) {
            if (EN(8)) { phase_gprep(p, it, smem); phase_rprep(p, it, smem); }
            if (it == 1 && EN(4)) phase25(p, 0);
            GSYNC();
        }
    }
    if (EN(7)) phase_final(p);
}

extern "C" void kernel_launch(void* const* d_in, const int* in_sizes, int n_in, void* d_out, int out_size, void* d_ws, size_t ws_size, hipStream_t stream) {
    static int grid_blocks = 0;
    constexpr int LDS_BYTES = LDS_TOTAL;
    if (grid_blocks == 0) {
        if (n_in != 27 || ws_size < WS_END) { fprintf(stderr, "kernel_launch: unexpected n_in %d / ws %zu (need %zu)\n", n_in, ws_size, (size_t)WS_END); grid_blocks = -1; return; }
        if (hipFuncSetAttribute((const void*)hybrid_mega, hipFuncAttributeMaxDynamicSharedMemorySize, LDS_BYTES) != hipSuccess) { fprintf(stderr, "kernel_launch: hipFuncSetAttribute failed\n"); grid_blocks = -1; return; }
        int dev = 0, cus = 0, per_cu = 0;
        hipGetDevice(&dev);
        hipDeviceGetAttribute(&cus, hipDeviceAttributeMultiprocessorCount, dev);
        hipOccupancyMaxActiveBlocksPerMultiprocessor(&per_cu, (const void*)hybrid_mega, 512, LDS_BYTES);
        if (per_cu < 1) { fprintf(stderr, "kernel_launch: occupancy query says %d blocks/CU\n", per_cu); per_cu = 1; }
        (void)hipGetLastError();
        grid_blocks = cus;
    }
    if (grid_blocks < 0) return;
    Params p{};
    for (int i = 0; i < 27; ++i) p.in[i] = (const float*)d_in[i];
    p.out = (float*)d_out; p.ws = (unsigned char*)d_ws;
    if (hipMemsetAsync((unsigned char*)d_ws + WS_BAR, 0, 16384, stream) != hipSuccess) { fprintf(stderr, "kernel_launch: memset of the barrier words failed\n"); return; }
    void* args[] = {&p};
    hipError_t e = hipLaunchCooperativeKernel((const void*)hybrid_mega, dim3(grid_blocks), dim3(512), args, LDS_BYTES, stream);
    if (e != hipSuccess) fprintf(stderr, "cooperative launch failed: %s (grid %d)\n", hipGetErrorString(e), grid_blocks);
}
```

```cpp
#include <hip/hip_runtime.h>
#include <hip/hip_cooperative_groups.h>
#include <cstdio>
namespace cg = cooperative_groups;

#define LAS __attribute__((address_space(3)))
typedef unsigned short bf16_t;
typedef short bf16x8 __attribute__((ext_vector_type(8)));
typedef float f32x4 __attribute__((ext_vector_type(4)));
typedef unsigned u32x4 __attribute__((ext_vector_type(4)));
typedef unsigned u32x2 __attribute__((ext_vector_type(2)));

constexpr int D = 1024;
constexpr int NBATCH = 8, SEQ = 2048, NMETA = 16, DECB = 128, DECT = 4;
constexpr int XROWS = NBATCH * SEQ;
constexpr int EX_SAMP = 16, EX_SHIFT = 528, EX_END = 656;
constexpr int HROWS = 17152, HTILES = 67;
constexpr int NSEG = 8, SEGTOK = SEQ / NSEG;
constexpr int CPS = SEGTOK / 64;
constexpr int TPB = SEGTOK / 256;
constexpr int LT_PROMPT = NBATCH * TPB;
constexpr int LEX0 = LT_PROMPT * 256;
constexpr int LROWS = LEX0 + 768;
constexpr int NP = 10496, NPB = 8448, NT_IN = 41, NT_PB = 33;
constexpr int C_A = 3072, C_B = 3080, C_Z = 3088, C_RW = 4112, C_GATE_REF = 8336;
constexpr int RW_SHIFT = 4224;

constexpr size_t O_YP = 0, O_YS = 16777216, O_GDN_P = 17301504, O_CONV_P = 18350080, O_RWKV_P = 18423808, O_SHIFT_P = 18948096,
                 O_GDN_S = 18956288, O_CONV_S = 35733504, O_RWKV_S = 36913152, O_SHIFT_S = 45301760;

constexpr size_t al256(size_t x) { return (x + 255) & ~(size_t)255; }
constexpr size_t WS_WT_IN = 0;
constexpr size_t WS_WT_A = al256(WS_WT_IN + (size_t)NP * D * 2);
constexpr size_t WS_WT_B = al256(WS_WT_A + (size_t)D * D * 2);
constexpr size_t WS_WT_O = al256(WS_WT_B + (size_t)D * D * 2);
constexpr size_t WS_H = al256(WS_WT_O + (size_t)D * D * 2);
constexpr size_t WS_OB = al256(WS_H + (size_t)HROWS * D * 2);
constexpr size_t WS_P = al256(WS_OB + (size_t)HROWS * D * 2);
constexpr size_t WS_ORAW = al256(WS_P + (size_t)LROWS * NPB * 2);
constexpr size_t WS_YRAW = al256(WS_ORAW + (size_t)LROWS * D * 4);
constexpr size_t WS_C0 = al256(WS_YRAW + (size_t)LROWS * D * 4);
constexpr size_t WS_C1 = al256(WS_C0 + (size_t)LROWS * D * 2);
constexpr size_t WS_GEX = al256(WS_C1 + (size_t)LROWS * D * 2);
constexpr size_t WS_CHALO = al256(WS_GEX + (size_t)768 * 2048 * 2);
constexpr size_t WS_PHALO = al256(WS_CHALO + (size_t)2 * NBATCH * 3 * NPB * 2);
constexpr size_t WS_PK = al256(WS_PHALO + (size_t)2 * NBATCH * NPB * 2);
constexpr int PK_CONVW = 0, PK_ALOG = 12288, PK_DTB = 12296, PK_NORMW = 12304, PK_MU = 12432, PK_W0 = 16656, PK_W2 = 17680, PK_A0 = 83216, PK_A2 = 84240,
              PK_KK = 149776, PK_KA = 150800, PK_RK = 151824, PK_GNW = 152848, PK_GNB = 153872, PK_LNF = 154896, PK_END = 155920;
constexpr size_t WS_BAR = al256(WS_PK + (size_t)PK_END * 4);
constexpr size_t WS_W2T = al256(WS_BAR + 16384);
constexpr size_t WS_A2T = al256(WS_W2T + 131072);
constexpr size_t WS_GP = al256(WS_A2T + 131072);
constexpr int GP_AP = 0, GP_QH = 32768, GP_KH = 49152, GP_OH = 81920, GP_EGL = 98304, GP_G = 98560, GP_STRIDE = 114944;
constexpr int RP_AP = 0, RP_RH = 8192, RP_KH = 16384, RP_YH = 24576, RP_C1 = 32768, RP_C0 = 40960, RP_PC = 49152, RP_STRIDE = 49408;
constexpr size_t WS_RP = al256(WS_GP + (size_t)(CPS + 1) * 64 * GP_STRIDE);
constexpr size_t WS_END = al256(WS_RP + (size_t)(CPS + 1) * 128 * RP_STRIDE);
constexpr size_t WS_MG = WS_GP;
static_assert((size_t)HROWS * D * 2 <= WS_END - WS_GP, "MERGED must fit in the prep records");
static_assert((size_t)HROWS * D * 4 <= (size_t)LROWS * NPB * 2 + 2 * (size_t)LROWS * D * 4, "TMP must fit in P+ORAW+YRAW");
static_assert(WS_END <= (size_t)268435456, "workspace");

constexpr int LDS_TOTAL = 163840;
struct Params { const float* in[27]; float* out; unsigned char* ws; };

__device__ __forceinline__ float bf2f(bf16_t v) { return __uint_as_float(((unsigned)v) << 16); }
typedef __bf16 bf16n2 __attribute__((ext_vector_type(2)));
typedef float f32n2 __attribute__((ext_vector_type(2)));
__device__ __forceinline__ unsigned cvt_pk_bf16(float lo, float hi) { const f32n2 v = {lo, hi}; return __builtin_bit_cast(unsigned, __builtin_convertvector(v, bf16n2)); }
__device__ __forceinline__ unsigned pk2(float lo, float hi) { return cvt_pk_bf16(lo, hi); }
__device__ __forceinline__ unsigned f2bf(float f) { return cvt_pk_bf16(f, 0.f) & 0xffffu; }
__device__ __forceinline__ float sigm(float x) { return __builtin_amdgcn_rcpf(1.f + __expf(-x)); }
__device__ __forceinline__ float silu_(float x) { return x * __builtin_amdgcn_rcpf(1.f + __expf(-x)); }
__device__ __forceinline__ float softplus_(float x) { return fmaxf(x, 0.f) + log1pf(expf(-fabsf(x))); }
__device__ __forceinline__ float wave_sum(float v) {
#pragma unroll
    for (int o = 1; o < 64; o <<= 1) v += __shfl_xor(v, o);
    return v;
}
__device__ __forceinline__ void unpack8(const u32x4 rw, float (&x)[8]) {
    x[0] = __uint_as_float(rw.x << 16); x[1] = __uint_as_float(rw.x & 0xffff0000u); x[2] = __uint_as_float(rw.y << 16); x[3] = __uint_as_float(rw.y & 0xffff0000u);
    x[4] = __uint_as_float(rw.z << 16); x[5] = __uint_as_float(rw.z & 0xffff0000u); x[6] = __uint_as_float(rw.w << 16); x[7] = __uint_as_float(rw.w & 0xffff0000u); }
__device__ __forceinline__ u32x4 pack8(const float (&x)[8]) { return (u32x4){pk2(x[0], x[1]), pk2(x[2], x[3]), pk2(x[4], x[5]), pk2(x[6], x[7])}; }

__device__ __forceinline__ int otid() { int t = threadIdx.x; asm volatile("" : "+v"(t)); return t; }
__device__ __forceinline__ int obid() { int t = blockIdx.x; asm volatile("" : "+s"(t)); return t; }
__device__ __forceinline__ float tanh_(float x) { const float e = __expf(2.f * x); return 1.f - 2.f * __builtin_amdgcn_rcpf(e + 1.f); }
template <int CTRL> __device__ __forceinline__ float dppf(float x) { return __builtin_bit_cast(float, __builtin_amdgcn_mov_dpp(__builtin_bit_cast(int, x), CTRL, 0xf, 0xf, true)); }
__device__ __forceinline__ float rowsum16(float x) { x += dppf<0x128>(x); x += dppf<0x124>(x); x += dppf<0x122>(x); x += dppf<0x121>(x); return x; }


#define XB_TMO      128
#define XB_XCNT(j)  (256  + 64 * (j))
#define XB_XSUB(j)  (1280 + 64 * (j))
#define XB_XGEN(j)  (2304 + 64 * (j))
#define XB_TOP      3328
#define XB_TOPGEN   3392
#define XCD_BAR_WORDS 3456
#define XB_SPIN_CAP (1u << 22)
__device__ __forceinline__ unsigned xb_ld(unsigned* p)              { return __hip_atomic_load(p, __ATOMIC_RELAXED, __HIP_MEMORY_SCOPE_AGENT); }
__device__ __forceinline__ unsigned xb_add(unsigned* p, unsigned v) { return __hip_atomic_fetch_add(p, v, __ATOMIC_RELAXED, __HIP_MEMORY_SCOPE_AGENT); }
__device__ __forceinline__ unsigned xb_xcc_id() { return (unsigned)__builtin_amdgcn_s_getreg((3 << 11) | 20) & 0xFu; }
#define XB_SPIN(cond, bar) do { unsigned _sp = 0; while (cond) { __builtin_amdgcn_s_sleep(1); \
    if ((++_sp & 255u) == 0u) { if (xb_ld(&(bar)[XB_TMO])) break; if (_sp > XB_SPIN_CAP) { atomicAdd(&(bar)[XB_TMO], 1u); break; } } } } while (0)
struct XcdBarrier { unsigned* bar; unsigned x; volatile LAS unsigned* st; };
__device__ __forceinline__ XcdBarrier xcd_barrier_post(unsigned* bar, volatile LAS unsigned* st) {
    XcdBarrier b; b.bar = bar; b.x = xb_xcc_id(); b.st = st;
    if (threadIdx.x == 0) (void)xb_add(&bar[XB_XCNT(b.x)], 1u);
    return b;
}
__device__ __forceinline__ void xcd_barrier_complete(unsigned* bar, unsigned x, unsigned& nloc, unsigned& nx) {
    const unsigned G = gridDim.x * gridDim.y * gridDim.z;
    unsigned sum, cnt, mine, sp = 0u;
    for (;;) {
        sum = 0u; cnt = 0u; mine = 0u;
#pragma unroll
        for (unsigned j = 0; j < 16; ++j) { const unsigned c = xb_ld(&bar[XB_XCNT(j)]); sum += c; cnt += (c > 0u) ? 1u : 0u; mine = (j == x) ? c : mine; }
        if (sum == G) break;
        __builtin_amdgcn_s_sleep(1);
        if ((++sp & 255u) == 0u) { if (xb_ld(&bar[XB_TMO])) break; if (sp > XB_SPIN_CAP) { atomicAdd(&bar[XB_TMO], 1u); break; } }
    }
    nloc = mine > 0u ? mine : 1u; nx = cnt > 0u ? cnt : 1u;
}
__device__ __forceinline__ void xcd_barrier(const XcdBarrier& b) {
    asm volatile("s_waitcnt vmcnt(0)" ::: "memory");
    __syncthreads();
    if (threadIdx.x == 0) {
        unsigned* bar = b.bar;
        __builtin_amdgcn_s_waitcnt(0);
        unsigned nloc = b.st[0], nx = b.st[1];
        if (nloc == 0u) { xcd_barrier_complete(bar, b.x, nloc, nx); b.st[0] = nloc; b.st[1] = nx; }
        const unsigned old = xb_add(&bar[XB_XSUB(b.x)], 1u);
        const unsigned gen = old / nloc;
        if (old + 1u == (gen + 1u) * nloc) {
            __builtin_amdgcn_fence(__ATOMIC_RELEASE, "agent");
            asm volatile("s_waitcnt vmcnt(0)" ::: "memory");
            const unsigned og = xb_add(&bar[XB_TOP], 1u);
            const unsigned tg = og / nx;
            if (og + 1u == (tg + 1u) * nx) xb_add(&bar[XB_TOPGEN], 1u);
            else XB_SPIN(xb_ld(&bar[XB_TOPGEN]) == tg, bar);
            __builtin_amdgcn_fence(__ATOMIC_ACQUIRE, "agent");
            xb_add(&bar[XB_XGEN(b.x)], 1u);
            asm volatile("s_waitcnt vmcnt(0)" ::: "memory");
        } else {
            XB_SPIN(xb_ld(&bar[XB_XGEN(b.x)]) == gen, bar);
            __builtin_amdgcn_fence(__ATOMIC_ACQUIRE, "agent");
            asm volatile("s_waitcnt vmcnt(0)" ::: "memory");
        }
    }
    __syncthreads();
}

namespace pg8 {
constexpr int BM = 256, BK = 64, HALF = 128, HTB = HALF * BK * 2, STAGE_BYTES = 8 * HTB, NXCD = 8, WGM = 8;
__device__ __forceinline__ int lds_byte(int r, int c) { const int st = (r >> 4) * 2 + (c >> 5), rr = r & 15, cc = c & 31, ob = rr * 64 + cc * 2; return st * 1024 + (ob ^ (((ob >> 9) & 1) << 5)); }
__device__ __forceinline__ void stage_rc(int b, int& R, int& C) { const int st = b / 1024, sb = b % 1024, swz = sb ^ (((sb >> 9) & 1) << 5); R = (st >> 1) * 16 + swz / 64; C = (st & 1) * 32 + (swz % 64) / 2; }
__device__ __forceinline__ int perm32(int rho) { const int n = rho >> 4, i = rho & 15; return 8 * (i >> 2) + 4 * n + (i & 3); }

struct Unit { int pm, pn, w; };
struct OrderBase {
    int nM, nN, nwg, G, c;
    __device__ void init(int nM_, int nN_, int G_, int c_) { nM = nM_; nN = nN_; nwg = nM * nN; G = G_; c = c_; }
    __device__ bool nextb(int i, Unit& u) const {
        const long L = (long)i * G + c; if (L >= nwg) return false;
        int wgid = (int)L; { const int q = nwg / NXCD, r = nwg % NXCD, xcd = wgid % NXCD, off = wgid / NXCD; wgid = (xcd < r ? xcd * (q + 1) : r * (q + 1) + (xcd - r) * q) + off; }
        const int nig = WGM * nN, gid = wgid / nig, fm = gid * WGM, gsz = (nM - fm) < WGM ? (nM - fm) : WGM;
        u.pm = fm + ((wgid % nig) % gsz); u.pn = (wgid % nig) / gsz; u.w = 0; return true;
    }
};

template <class Epi, class Sched>
__device__ __forceinline__ void gemm_phase(LAS unsigned char* lds, const int K, const Sched& S, const Epi& E) {
    const int tid = otid(), wid = __builtin_amdgcn_readfirstlane(tid >> 6), lane = tid & 63, wr = wid >> 2, wc = wid & 3, fr = lane & 15, fq = lane >> 4;
    const int nt = K / BK;
    unsigned voffA[2], voffB[2];
#pragma unroll
    for (int i = 0; i < 2; ++i) { int R, C; stage_rc(tid * 16 + i * 8192, R, C); const int Rb = Epi::PERM ? ((R & ~31) + perm32(R & 31)) : R;
        voffA[i] = (unsigned)(R * K + C) * 2u; voffB[i] = (unsigned)(Rb * K + C) * 2u; }
    const size_t kstep = (size_t)(BK * 2);
    const size_t hstep = (size_t)HALF * K * 2;
    const unsigned ldsw = (unsigned)wid * 1024u;
    const int aoff = lds_byte(wr * 64 + fr, fq * 8), boff = lds_byte(wc * 32 + fr, fq * 8);
#define PG8_SA(b, h) (((b) * 2 + (h)) * HTB)
#define PG8_SB(b, h) ((4 + (b) * 2 + (h)) * HTB)
#define PG8_STAGE(bufoff, gbase, voff) do { _Pragma("unroll") for (int _i = 0; _i < 2; ++_i) \
        __builtin_amdgcn_global_load_lds((const unsigned*)((const char*)(gbase) + (voff)[_i]), (LAS unsigned*)(lds + (bufoff) + ldsw + _i * 8192), 16, 0, 0); } while (0)
#define PG8_LDA(dst, b, h) do { _Pragma("unroll") for (int m = 0; m < 4; ++m) _Pragma("unroll") for (int k = 0; k < 2; ++k) dst[m][k] = *(const LAS bf16x8*)(lds + PG8_SA(b, h) + aoff + m * 2048 + k * 1024); } while (0)
#define PG8_LDB(dst, b, h) do { _Pragma("unroll") for (int n = 0; n < 2; ++n) _Pragma("unroll") for (int k = 0; k < 2; ++k) dst[n][k] = *(const LAS bf16x8*)(lds + PG8_SB(b, h) + boff + n * 2048 + k * 1024); } while (0)
#define PG8_MMA(ai, bj, At, Bt) do { __builtin_amdgcn_s_setprio(1); _Pragma("unroll") for (int m = 0; m < 4; ++m) _Pragma("unroll") for (int n = 0; n < 2; ++n) _Pragma("unroll") for (int k = 0; k < 2; ++k) \
        acc[ai][bj][m][n] = __builtin_amdgcn_mfma_f32_16x16x32_bf16(Bt[n][k], At[m][k], acc[ai][bj][m][n], 0, 0, 0); __builtin_amdgcn_s_setprio(0); } while (0)
#define PG8_WAIT_V(n) asm volatile("s_waitcnt vmcnt(" #n ")" ::: "memory")
#define PG8_WAIT_L(n) asm volatile("s_waitcnt lgkmcnt(" #n ")" ::: "memory")
#define PG8_BAR __builtin_amdgcn_s_barrier()
#define PG8_SCHED __builtin_amdgcn_sched_barrier(0)
    Unit cur, nxt; int ui = 0;
    if (!S.next(0, cur)) return;
    f32x4 acc[2][2][4][2];
#pragma unroll
    for (int a = 0; a < 2; ++a)
#pragma unroll
        for (int b = 0; b < 2; ++b)
#pragma unroll
            for (int m = 0; m < 4; ++m)
#pragma unroll
                for (int n = 0; n < 2; ++n) acc[a][b][m][n] = (f32x4){0.f, 0.f, 0.f, 0.f};
    bf16x8 At[4][2], B0[2][2], B1[2][2];
    const char* cA = S.a_ptr(cur); const char* cB = S.b_ptr(cur);
    PG8_STAGE(PG8_SB(0, 0), cB, voffB); PG8_STAGE(PG8_SA(0, 0), cA, voffA); PG8_STAGE(PG8_SB(0, 1), cB + hstep, voffB); PG8_STAGE(PG8_SA(0, 1), cA + hstep, voffA);
    if (wr == 1) PG8_BAR;
    PG8_WAIT_V(4); PG8_BAR;
    PG8_STAGE(PG8_SB(1, 0), cB + kstep, voffB); PG8_STAGE(PG8_SA(1, 0), cA + kstep, voffA); PG8_STAGE(PG8_SB(1, 1), cB + hstep + kstep, voffB);
    PG8_WAIT_V(6); PG8_BAR;
    for (;;) {
        const bool has_next = S.next(ui + 1, nxt);
        const char* nA = has_next ? S.a_ptr(nxt) : cA; const char* nB = has_next ? S.b_ptr(nxt) : cB;
        for (int t = 0; t < nt; t += 2) {
            const bool last = (t == nt - 2);
            const char* a1 = cA + (size_t)(t + 1) * kstep;
            const char* a2 = last ? nA : cA + (size_t)(t + 2) * kstep; const char* b2 = last ? nB : cB + (size_t)(t + 2) * kstep;
            const char* a3 = a2 + kstep; const char* b3 = b2 + kstep;
            PG8_LDB(B0, 0, 0); PG8_SCHED; PG8_LDA(At, 0, 0); PG8_STAGE(PG8_SA(1, 1), a1 + hstep, voffA);
            PG8_WAIT_L(8); PG8_BAR; PG8_WAIT_L(0); PG8_MMA(0, 0, At, B0); PG8_BAR; PG8_SCHED;
            PG8_LDB(B1, 0, 1); PG8_STAGE(PG8_SB(0, 0), b2, voffB);
            PG8_BAR; PG8_WAIT_L(0); PG8_MMA(0, 1, At, B1); PG8_BAR;
            PG8_LDA(At, 0, 1); PG8_STAGE(PG8_SA(0, 0), a2, voffA);
            PG8_BAR; PG8_WAIT_L(0); PG8_MMA(1, 0, At, B0); PG8_BAR; PG8_SCHED;
            PG8_STAGE(PG8_SB(0, 1), b2 + hstep, voffB);
            PG8_WAIT_V(6); PG8_BAR; PG8_MMA(1, 1, At, B1); PG8_BAR;
            PG8_LDB(B0, 1, 0); PG8_SCHED; PG8_LDA(At, 1, 0); PG8_STAGE(PG8_SA(0, 1), a2 + hstep, voffA);
            PG8_WAIT_L(8); PG8_BAR; PG8_WAIT_L(0); PG8_MMA(0, 0, At, B0); PG8_BAR; PG8_SCHED;
            PG8_LDB(B1, 1, 1); PG8_STAGE(PG8_SB(1, 0), b3, voffB);
            PG8_BAR; PG8_WAIT_L(0); PG8_MMA(0, 1, At, B1); PG8_BAR;
            PG8_LDA(At, 1, 1); PG8_STAGE(PG8_SA(1, 0), a3, voffA);
            PG8_BAR; PG8_WAIT_L(0); PG8_MMA(1, 0, At, B0); PG8_BAR; PG8_SCHED;
            PG8_STAGE(PG8_SB(1, 1), b3 + hstep, voffB);
            PG8_WAIT_V(6); PG8_BAR; PG8_MMA(1, 1, At, B1); PG8_BAR;
        }
        E(acc, cur, wr, wc, fr, fq);
        if (!has_next) break;
        if (!E.keep(cur)) {
#pragma unroll
        for (int a = 0; a < 2; ++a)
#pragma unroll
            for (int b = 0; b < 2; ++b)
#pragma unroll
                for (int m = 0; m < 4; ++m)
#pragma unroll
                    for (int n = 0; n < 2; ++n) acc[a][b][m][n] = (f32x4){0.f, 0.f, 0.f, 0.f};
        }
        cur = nxt; cA = nA; cB = nB; ++ui;
    }
    PG8_WAIT_V(0);
    if (wr == 0) PG8_BAR;
    PG8_BAR;
#undef PG8_SA
#undef PG8_SB
#undef PG8_STAGE
#undef PG8_LDA
#undef PG8_LDB
#undef PG8_MMA
#undef PG8_WAIT_V
#undef PG8_WAIT_L
#undef PG8_BAR
#undef PG8_SCHED
}
}
using pg8::Unit;

struct SchedIn {
    pg8::OrderBase ob; int seg; const char* A; const char* B;
    __device__ bool next(int i, Unit& u) const { return ob.nextb(i, u); }
    __device__ const char* a_ptr(const Unit& u) const {
        const int gt = u.pm < LT_PROMPT ? ((u.pm / TPB) * (SEQ / 256) + seg * TPB + (u.pm % TPB)) : (XROWS / 256 + (u.pm - LT_PROMPT));
        return A + (size_t)gt * 256 * D * 2; }
    __device__ const char* b_ptr(const Unit& u) const { return B + (size_t)u.pn * 256 * D * 2; }
};
struct SchedAB {
    pg8::OrderBase ob; int pm0, wfix; const char* A0; const char* A1; const char* B0; const char* B1;
    __device__ bool next(int i, Unit& u) const { const bool ok = wfix < 0 ? ob.nextb(i >> 1, u) : ob.nextb(i, u); u.pm += pm0; u.w = wfix < 0 ? (i & 1) : wfix; return ok; }
    __device__ const char* a_ptr(const Unit& u) const { return (u.w ? A1 : A0) + (size_t)u.pm * 256 * D * 2; }
    __device__ const char* b_ptr(const Unit& u) const { return (u.w ? B1 : B0) + (size_t)u.pn * 256 * D * 2; }
};
struct SchedO {
    pg8::OrderBase ob; int pm0; const char* A; const char* B;
    __device__ bool next(int i, Unit& u) const { const bool ok = ob.nextb(i, u); u.pm += pm0; return ok; }
    __device__ const char* a_ptr(const Unit& u) const { return A + (size_t)u.pm * 256 * D * 2; }
    __device__ const char* b_ptr(const Unit& u) const { return B + (size_t)u.pn * 256 * D * 2; }
};

struct EpiIn {
    static constexpr bool PERM = true;
    bf16_t* P; bf16_t* gex; float* out; int seg;
    __device__ __forceinline__ bool keep(const Unit&) const { return false; }
    __device__ __forceinline__ void operator()(const f32x4 (&acc)[2][2][4][2], const Unit& u, int wr, int wc, int fr, int fq) const {
        const int lr0 = u.pm * 256 + wr * 64 + fr;
        const int c0 = u.pn * 256 + wc * 32 + 8 * fq;
#pragma unroll
        for (int ai = 0; ai < 2; ++ai)
#pragma unroll
            for (int m = 0; m < 4; ++m) {
                const int lr = lr0 + ai * 128 + m * 16;
                bf16_t* rowp;
                if (u.pn < NT_PB) rowp = P + (size_t)lr * NPB + c0;
                else if (lr < LEX0) { const int b = lr / SEGTOK; const size_t grow = (size_t)b * SEQ + seg * SEGTOK + (lr % SEGTOK); rowp = (bf16_t*)(out + O_YP + grow * D) + (c0 - NPB); }
                else rowp = gex + (size_t)(lr - LEX0) * 2048 + (c0 - NPB);
#pragma unroll
                for (int bj = 0; bj < 2; ++bj) { const f32x4 v0 = acc[ai][bj][m][0], v1 = acc[ai][bj][m][1];
                    u32x4 w; w.x = cvt_pk_bf16(v0[0], v0[1]); w.y = cvt_pk_bf16(v0[2], v0[3]); w.z = cvt_pk_bf16(v1[0], v1[1]); w.w = cvt_pk_bf16(v1[2], v1[3]);
                    *(u32x4*)(rowp + bj * 128) = w; }
            }
    }
};
struct EpiAB {
    static constexpr bool PERM = true;
    bf16_t* tmp; bf16_t* merged; const bf16_t* gex; const float* out; int pairmode;
    __device__ __forceinline__ bool keep(const Unit& u) const { return pairmode && u.w == 0; }
    __device__ __forceinline__ void operator()(f32x4 (&acc)[2][2][4][2], const Unit& u, int wr, int wc, int fr, int fq) const {
        const int row0 = u.pm * 256 + wr * 64 + fr, col0 = u.pn * 256 + wc * 32 + 8 * fq;
        if (pairmode) {
#pragma unroll
            for (int ai = 0; ai < 2; ++ai) {
                const bf16_t* g0[4];
#pragma unroll
                for (int m = 0; m < 4; ++m) { const int grow = row0 + ai * 128 + m * 16;
                    g0[m] = (grow < XROWS) ? (const bf16_t*)(out + O_YP + (size_t)grow * D) : (gex + (size_t)(grow - XROWS) * 2048); }
#pragma unroll
                for (int mp = 0; mp < 2; ++mp) {
                u32x4 gbv[2][2], gav[2][2];
#pragma unroll
                for (int mm = 0; mm < 2; ++mm)
#pragma unroll
                    for (int bj = 0; bj < 2; ++bj) { gbv[mm][bj] = *(const u32x4*)(g0[2 * mp + mm] + D + col0 + bj * 128); gav[mm][bj] = (u.w == 0) ? *(const u32x4*)(g0[2 * mp + mm] + col0 + bj * 128) : gbv[mm][bj]; }
#pragma unroll
                for (int mm = 0; mm < 2; ++mm)
#pragma unroll
                    for (int bj = 0; bj < 2; ++bj) { const int m = 2 * mp + mm;
                        float gb[8]; unpack8(gbv[mm][bj], gb);
                        float eb[8];
#pragma unroll
                        for (int e = 0; e < 8; ++e) eb[e] = 1.f + fminf(__expf(-gb[e]), 1e18f);
                        if (u.w == 0) {
                            float ga[8]; unpack8(gav[mm][bj], ga);
#pragma unroll
                            for (int e = 0; e < 4; ++e) { acc[ai][bj][m][0][e] *= sigm(ga[e]) * eb[e]; acc[ai][bj][m][1][e] *= sigm(ga[4 + e]) * eb[4 + e]; }
                        } else {
                            float v[8];
#pragma unroll
                            for (int e = 0; e < 4; ++e) { v[e] = acc[ai][bj][m][0][e] * __builtin_amdgcn_rcpf(eb[e]); v[4 + e] = acc[ai][bj][m][1][e] * __builtin_amdgcn_rcpf(eb[4 + e]); }
                            const int grow = row0 + ai * 128 + m * 16;
                            *(u32x4*)(merged + (size_t)grow * D + col0 + bj * 128) = pack8(v);
                        }
                    }
                asm volatile("" ::: "memory");
                }
            }
            return;
        }
#pragma unroll
        for (int ai = 0; ai < 2; ++ai)
#pragma unroll
            for (int m = 0; m < 4; ++m) {
                const int grow = row0 + ai * 128 + m * 16;
                const bf16_t* g0 = (grow < XROWS) ? (const bf16_t*)(out + O_YP + (size_t)grow * D) : (gex + (size_t)(grow - XROWS) * 2048);
#pragma unroll
                for (int bj = 0; bj < 2; ++bj) {
                    const int c = col0 + bj * 128;
                    float g[8]; unpack8(*(const u32x4*)(g0 + u.w * D + c), g);
                    const f32x4 v0 = acc[ai][bj][m][0], v1 = acc[ai][bj][m][1];
                    float v[8] = {v0[0] * sigm(g[0]), v0[1] * sigm(g[1]), v0[2] * sigm(g[2]), v0[3] * sigm(g[3]), v1[0] * sigm(g[4]), v1[1] * sigm(g[5]), v1[2] * sigm(g[6]), v1[3] * sigm(g[7])};
                    bf16_t* tp = tmp + (size_t)grow * D + c;
                    if (u.w == 0) *(u32x4*)tp = pack8(v);
                    else { float t[8]; unpack8(*(const u32x4*)tp, t);
#pragma unroll
                        for (int e = 0; e < 8; ++e) v[e] += t[e];
                        *(u32x4*)(merged + (size_t)grow * D + c) = pack8(v); }
                }
            }
    }
};
struct EpiO {
    static constexpr bool PERM = false;
    float* out; const float* xp; const float* xs;
    __device__ __forceinline__ bool keep(const Unit&) const { return false; }
    __device__ __forceinline__ void operator()(const f32x4 (&acc)[2][2][4][2], const Unit& u, int wr, int wc, int fr, int fq) const {
        const int row0 = u.pm * 256 + wr * 64 + fr, col0 = u.pn * 256 + wc * 32 + 4 * fq;
#pragma unroll
        for (int ai = 0; ai < 2; ++ai) {
            const float* xr[4]; float* yr[4]; bool ok[4];
#pragma unroll
            for (int m = 0; m < 4; ++m) {
                const int grow = row0 + ai * 128 + m * 16;
                ok[m] = true;
                if (grow < XROWS) { xr[m] = xp + (size_t)grow * D; yr[m] = out + O_YP + (size_t)grow * D; }
                else { const int e = grow - XROWS; ok[m] = !(e < EX_SAMP || e >= EX_SHIFT); const int es = ok[m] ? e - EX_SAMP : 0; xr[m] = xs + (size_t)es * D; yr[m] = out + O_YS + (size_t)es * D; }
            }
#pragma unroll
            for (int mp = 0; mp < 2; ++mp) {
                f32x4 xv[2][2][2];
#pragma unroll
                for (int mm = 0; mm < 2; ++mm)
#pragma unroll
                    for (int bj = 0; bj < 2; ++bj)
#pragma unroll
                        for (int n = 0; n < 2; ++n) xv[mm][bj][n] = *(const f32x4*)(xr[2 * mp + mm] + col0 + bj * 128 + n * 16);
#pragma unroll
                for (int mm = 0; mm < 2; ++mm) { const int m = 2 * mp + mm;
                    if (ok[m]) {
#pragma unroll
                        for (int bj = 0; bj < 2; ++bj)
#pragma unroll
                            for (int n = 0; n < 2; ++n) *(f32x4*)(yr[m] + col0 + bj * 128 + n * 16) = xv[mm][bj][n] + acc[ai][bj][m][n];
                    } }
                asm volatile("" ::: "memory");
            }
        }
    }
};

__device__ __forceinline__ void p0_row(const Params& p, int r, int lane) {
    bf16_t* hrow = (bf16_t*)(p.ws + WS_H) + (size_t)r * D;
    const float* src = nullptr; bool norm = true; float* sh = nullptr;
    if (r < XROWS) { src = p.in[0] + (size_t)r * D; if ((r & (SEQ - 1)) == SEQ - 1) sh = p.out + O_SHIFT_P + (size_t)(r / SEQ) * D; }
    else { const int e = r - XROWS;
        if (e < EX_SAMP) src = p.in[6] + (size_t)e * D;
        else if (e < EX_SHIFT) { src = p.in[1] + (size_t)(e - EX_SAMP) * D; if (((e - EX_SAMP) & 3) == 3) sh = p.out + O_SHIFT_S + (size_t)((e - EX_SAMP) >> 2) * D; }
        else if (e < EX_END) { src = p.in[5] + (size_t)(e - EX_SHIFT) * D; norm = false; } }
    u32x2* o8 = (u32x2*)hrow + lane;
    if (!src) {
#pragma unroll
        for (int j = 0; j < 4; ++j) o8[64 * j] = (u32x2){0u, 0u};
        return; }
    const f32x4* xr = (const f32x4*)src + lane;
    f32x4 v[4]; float ss = 0.f;
#pragma unroll
    for (int j = 0; j < 4; ++j) { v[j] = xr[64 * j]; ss += v[j][0] * v[j][0] + v[j][1] * v[j][1] + v[j][2] * v[j][2] + v[j][3] * v[j][3]; }
    if (norm) {
        const float rs = __builtin_amdgcn_rsqf(wave_sum(ss) * (1.f / D) + 1e-6f);
        const f32x4* wr = (const f32x4*)p.in[7] + lane;
#pragma unroll
        for (int j = 0; j < 4; ++j) v[j] = v[j] * rs * wr[64 * j];
    }
#pragma unroll
    for (int j = 0; j < 4; ++j) { o8[64 * j] = (u32x2){pk2(v[j][0], v[j][1]), pk2(v[j][2], v[j][3])}; if (sh) ((f32x4*)sh)[lane + 64 * j] = v[j]; }
}
template <int MODE> __device__ __forceinline__ void p0_tr_item(const float* W, int N, bf16_t* WT, float* scr, int kb, int nb, int lane) {
    const int k0 = 64 * kb, n0 = 32 * nb;
    const int l8 = lane & 7, r8 = lane >> 3;
    const int nn = n0 + 4 * l8;
    int srcc = nn;
    if (MODE == 1) srcc = nn < C_GATE_REF ? nn : (nn < NPB ? -1 : nn - (NPB - C_GATE_REF));
    f32x4 v[8];
#pragma unroll
    for (int i = 0; i < 8; ++i) { const int kk = 8 * i + r8; v[i] = srcc >= 0 ? *(const f32x4*)(W + (size_t)(k0 + kk) * N + srcc) : (f32x4){0.f, 0.f, 0.f, 0.f}; }
#pragma unroll
    for (int i = 0; i < 8; ++i) { const int kk = 8 * i + r8; float* d = scr + kk * 33 + 4 * l8; d[0] = v[i][0]; d[1] = v[i][1]; d[2] = v[i][2]; d[3] = v[i][3]; }
    asm volatile("s_waitcnt lgkmcnt(0)" ::: "memory");
    const int c = lane & 7;
#pragma unroll
    for (int j = 0; j < 4; ++j) { const int n = (lane >> 3) + 8 * j; const float* s = scr + (8 * c) * 33 + n;
        u32x4 o; o.x = pk2(s[0 * 33], s[1 * 33]); o.y = pk2(s[2 * 33], s[3 * 33]); o.z = pk2(s[4 * 33], s[5 * 33]); o.w = pk2(s[6 * 33], s[7 * 33]);
        *(u32x4*)(WT + (size_t)(n0 + n) * D + k0 + 8 * c) = o; }
    asm volatile("s_waitcnt lgkmcnt(0)" ::: "memory");
}
__device__ __forceinline__ void h_rows_pair(const Params& p, int r, int r1, bool has1, int lane, const f32x4 (&wv)[4]) {
    const f32x4* x0 = (const f32x4*)(p.in[0] + (size_t)r * D) + lane; const f32x4* x1 = (const f32x4*)(p.in[0] + (size_t)(has1 ? r1 : r) * D) + lane;
    f32x4 a[4], b[4]; float s0 = 0.f, s1 = 0.f;
#pragma unroll
    for (int j = 0; j < 4; ++j) { a[j] = x0[64 * j]; b[j] = x1[64 * j]; }
#pragma unroll
    for (int j = 0; j < 4; ++j) { s0 += a[j][0] * a[j][0] + a[j][1] * a[j][1] + a[j][2] * a[j][2] + a[j][3] * a[j][3]; s1 += b[j][0] * b[j][0] + b[j][1] * b[j][1] + b[j][2] * b[j][2] + b[j][3] * b[j][3]; }
    const float q0 = __builtin_amdgcn_rsqf(wave_sum(s0) * (1.f / D) + 1e-6f), q1 = __builtin_amdgcn_rsqf(wave_sum(s1) * (1.f / D) + 1e-6f);
    u32x2* o0 = (u32x2*)((bf16_t*)(p.ws + WS_H) + (size_t)r * D) + lane; u32x2* o1 = (u32x2*)((bf16_t*)(p.ws + WS_H) + (size_t)r1 * D) + lane;
#pragma unroll
    for (int j = 0; j < 4; ++j) { a[j] = a[j] * q0 * wv[j]; o0[64 * j] = (u32x2){pk2(a[j][0], a[j][1]), pk2(a[j][2], a[j][3])}; }
    if ((r & (SEQ - 1)) == SEQ - 1) { f32x4* sh = (f32x4*)(p.out + O_SHIFT_P + (size_t)(r / SEQ) * D) + lane;
#pragma unroll
        for (int j = 0; j < 4; ++j) sh[64 * j] = a[j]; }
    if (has1) {
#pragma unroll
        for (int j = 0; j < 4; ++j) { b[j] = b[j] * q1 * wv[j]; o1[64 * j] = (u32x2){pk2(b[j][0], b[j][1]), pk2(b[j][2], b[j][3])}; }
        if ((r1 & (SEQ - 1)) == SEQ - 1) { f32x4* sh = (f32x4*)(p.out + O_SHIFT_P + (size_t)(r1 / SEQ) * D) + lane;
#pragma unroll
            for (int j = 0; j < 4; ++j) sh[64 * j] = b[j]; }
    }
}
__device__ __forceinline__ void h_rows_segs(const Params& p, int s_lo, int s_hi, int wi, int nw, int lane) {
    const f32x4* lw = (const f32x4*)p.in[7] + lane;
    f32x4 wv[4];
#pragma unroll
    for (int j = 0; j < 4; ++j) wv[j] = lw[64 * j];
    const int n = (s_hi - s_lo) * NBATCH * SEGTOK;
#pragma unroll 1
    for (int x = wi; x < n; x += 2 * nw) {
        const int x1 = x + nw; const bool has1 = x1 < n;
        const int sg = s_lo + x / (NBATCH * SEGTOK), rem = x % (NBATCH * SEGTOK), r = (rem / SEGTOK) * SEQ + sg * SEGTOK + (rem % SEGTOK);
        const int xx = has1 ? x1 : x; const int sg1 = s_lo + xx / (NBATCH * SEGTOK), rem1 = xx % (NBATCH * SEGTOK), r1 = (rem1 / SEGTOK) * SEQ + sg1 * SEGTOK + (rem1 % SEGTOK);
        h_rows_pair(p, r, r1, has1, lane, wv);
    }
}
__device__ __forceinline__ void phase0(const Params& p, unsigned char* smem) {
    const int tid0 = otid(), wave = tid0 >> 6, lane = tid0 & 63;
    const int gw = obid() * 8 + wave, NGW = gridDim.x * 8;
    float* scr = (float*)smem + wave * (64 * 33);
    constexpr int I_IN = 16 * (NP / 32), I_SQ = 16 * 32;
    for (int it = gw; it < I_IN + 3 * I_SQ; it += NGW) {
        int r = it;
        if (r < I_IN) { p0_tr_item<1>(p.in[8], 10384, (bf16_t*)(p.ws + WS_WT_IN), scr, r / (NP / 32), r % (NP / 32), lane); continue; } r -= I_IN;
        if (r < I_SQ) { p0_tr_item<0>(p.in[13], D, (bf16_t*)(p.ws + WS_WT_A), scr, r / 32, r % 32, lane); continue; } r -= I_SQ;
        if (r < I_SQ) { p0_tr_item<0>(p.in[24], D, (bf16_t*)(p.ws + WS_WT_B), scr, r / 32, r % 32, lane); continue; } r -= I_SQ;
        p0_tr_item<0>(p.in[25], D, (bf16_t*)(p.ws + WS_WT_O), scr, r / 32, r % 32, lane);
    }
    h_rows_segs(p, 0, 2, gw, NGW, lane);
    for (int r = XROWS + gw; r < HROWS; r += NGW) p0_row(p, r, lane);
    {
        float* pk = (float*)(p.ws + WS_PK);
        const int gt = obid() * 512 + tid0, NT = gridDim.x * 512;
        for (int i = gt; i < PK_END; i += NT) {
            const float* src; int o;
            if (i < PK_ALOG) { src = p.in[9]; o = i - PK_CONVW; } else if (i < PK_DTB) { src = p.in[10]; o = i - PK_ALOG; } else if (i < PK_NORMW) { src = p.in[11]; o = i - PK_DTB; }
            else if (i < PK_MU) { src = p.in[12]; o = i - PK_NORMW; } else if (i < PK_W0) { src = p.in[14]; o = i - PK_MU; } else if (i < PK_W2) { src = p.in[15]; o = i - PK_W0; }
            else if (i < PK_A0) { src = p.in[16]; o = i - PK_W2; } else if (i < PK_A2) { src = p.in[17]; o = i - PK_A0; } else if (i < PK_KK) { src = p.in[18]; o = i - PK_A2; }
            else if (i < PK_KA) { src = p.in[19]; o = i - PK_KK; } else if (i < PK_RK) { src = p.in[20]; o = i - PK_KA; } else if (i < PK_GNW) { src = p.in[21]; o = i - PK_RK; }
            else if (i < PK_GNB) { src = p.in[22]; o = i - PK_GNW; } else if (i < PK_LNF) { src = p.in[23]; o = i - PK_GNB; } else { src = p.in[26]; o = i - PK_LNF; }
            pk[i] = src[o];
        }
        bf16_t* w2t = (bf16_t*)(p.ws + WS_W2T); bf16_t* a2t = (bf16_t*)(p.ws + WS_A2T);
        for (int i = gt; i < 65536; i += NT) { const int l = i & 63, c = (i >> 6) & 63, hb = i >> 12;
            w2t[i] = (bf16_t)f2bf(p.in[16][(size_t)l * D + hb * 64 + c]); a2t[i] = (bf16_t)f2bf(p.in[18][(size_t)l * D + hb * 64 + c]); }
    }
}

__device__ __forceinline__ void gdn_item(const Params& p, unsigned char* smem, const float* s_in, float* s_out, const float* halo_in, float* halo_out,
                                         int h, int sl, int rowA, int nA, int rowB, int nB) {
    const int tid = otid(), w = tid >> 6, lane = tid & 63, vl = lane >> 4, kg = lane & 15;
    float* qk_s = (float*)smem; float* v_s = qk_s + 16384; float* o_s = v_s + 2048; float* gb_s = o_s + 2048; float* sst = gb_s + 128;
    const bf16_t* P = (const bf16_t*)(p.ws + WS_P);
    float* ORAW = (float*)(p.ws + WS_ORAW);
    float s[8];
    if (s_in) {
        { const int k = tid >> 2, q4 = tid & 3; const f32x4* src = (const f32x4*)(s_in + (size_t)k * 128 + sl * 32 + q4 * 8); const f32x4 a = src[0], b = src[1];
          float* d = sst + k * 33 + q4 * 8; d[0] = a[0]; d[1] = a[1]; d[2] = a[2]; d[3] = a[3]; d[4] = b[0]; d[5] = b[1]; d[6] = b[2]; d[7] = b[3]; }
        __syncthreads();
#pragma unroll
        for (int j = 0; j < 8; ++j) s[j] = sst[(kg * 8 + j) * 33 + 4 * w + vl];
        __syncthreads();
    } else {
#pragma unroll
        for (int j = 0; j < 8; ++j) s[j] = 0.f;
    }
    int pcol = -1;
    if (tid < 128) pcol = h * 128 + tid; else if (tid < 256) pcol = 1024 + h * 128 + (tid - 128); else if (tid < 288) pcol = 2048 + h * 128 + sl * 32 + (tid - 256);
    float cw0 = 0.f, cw1 = 0.f, cw2 = 0.f, cw3 = 0.f, x1 = 0.f, x2 = 0.f, x3 = 0.f;
    const float* pk = (const float*)(p.ws + WS_PK);
    if (pcol >= 0) { const float* cw = pk + PK_CONVW; cw0 = cw[pcol]; cw1 = cw[3072 + pcol]; cw2 = cw[6144 + pcol]; cw3 = cw[9216 + pcol];
        if (halo_in) { x3 = halo_in[pcol]; x2 = halo_in[3072 + pcol]; x1 = halo_in[6144 + pcol]; } }
    const float nalog = -expf(pk[PK_ALOG + h]), dtb = pk[PK_DTB + h];
#pragma unroll 1
    for (int run = 0; run < 2; ++run) {
        const int rrow = run ? rowB : rowA, rn = run ? nB : nA; const bool wout = run != 0;
#pragma unroll 1
        for (int c0 = 0; c0 < rn; c0 += 64) {
            const int nt = (rn - c0) < 64 ? (rn - c0) : 64; const int row = rrow + c0;
            if (pcol >= 0) {
                const bf16_t* src = P + (size_t)row * NPB + pcol;
                float* dst = tid < 256 ? (qk_s + tid) : (v_s + (tid - 256)); const int dstride = tid < 256 ? 256 : 32;
#pragma unroll 8
                for (int i = 0; i < nt; ++i) { const float x0 = bf2f(src[(size_t)i * NPB]); const float y = cw0 * x3 + cw1 * x2 + cw2 * x1 + cw3 * x0; x3 = x2; x2 = x1; x1 = x0; dst[i * dstride] = silu_(y); }
            } else if (tid < 352) {
                const int i = tid - 288;
                if (i < nt) { const float pa = bf2f(P[(size_t)(row + i) * NPB + C_A + h]), pb = bf2f(P[(size_t)(row + i) * NPB + C_B + h]);
                    gb_s[2 * i] = expf(nalog * softplus_(pa + dtb)); gb_s[2 * i + 1] = sigm(pb); }
            }
            __syncthreads();
#pragma unroll 1
            for (int ii = 0; ii < 8; ++ii) { const int i = w * 8 + ii;
                if (i < nt) {
#pragma unroll
                    for (int which = 0; which < 2; ++which) { float* rp = qk_s + i * 256 + which * 128; const float a = rp[lane], b = rp[lane + 64];
                        const float sc = __builtin_amdgcn_rsqf(wave_sum(a * a + b * b) + 1e-6f) * (which == 0 ? 0.08838834764831845f : 1.f); rp[lane] = a * sc; rp[lane + 64] = b * sc; } } }
            __syncthreads();
#pragma unroll 1
            for (int i = 0; i < nt; ++i) {
                const f32x4 q0 = *(const f32x4*)(qk_s + i * 256 + kg * 8), q1 = *(const f32x4*)(qk_s + i * 256 + kg * 8 + 4);
                const f32x4 k0 = *(const f32x4*)(qk_s + i * 256 + 128 + kg * 8), k1 = *(const f32x4*)(qk_s + i * 256 + 128 + kg * 8 + 4);
                const float vv = v_s[i * 32 + 4 * w + vl], a = gb_s[2 * i], be = gb_s[2 * i + 1];
                float part = k0[0] * s[0] + k0[1] * s[1] + k0[2] * s[2] + k0[3] * s[3] + k1[0] * s[4] + k1[1] * s[5] + k1[2] * s[6] + k1[3] * s[7];
                const float kS = rowsum16(part);
                const float c = be * (vv - a * kS);
                s[0] = a * s[0] + k0[0] * c; s[1] = a * s[1] + k0[1] * c; s[2] = a * s[2] + k0[2] * c; s[3] = a * s[3] + k0[3] * c;
                s[4] = a * s[4] + k1[0] * c; s[5] = a * s[5] + k1[1] * c; s[6] = a * s[6] + k1[2] * c; s[7] = a * s[7] + k1[3] * c;
                float op = q0[0] * s[0] + q0[1] * s[1] + q0[2] * s[2] + q0[3] * s[3] + q1[0] * s[4] + q1[1] * s[5] + q1[2] * s[6] + q1[3] * s[7];
                const float o = rowsum16(op);
                if (kg == 0) o_s[i * 32 + 4 * w + vl] = o;
            }
            __syncthreads();
            if (wout) { const int i = tid >> 3, c4 = (tid & 7) * 4; if (i < nt) *(f32x4*)(ORAW + (size_t)(row + i) * D + h * 128 + sl * 32 + c4) = *(const f32x4*)(o_s + i * 32 + c4); }
        }
    }
    if (pcol >= 0 && (sl == 0 || tid >= 256)) { halo_out[pcol] = x3; halo_out[3072 + pcol] = x2; halo_out[6144 + pcol] = x1; }
#pragma unroll
    for (int j = 0; j < 8; ++j) sst[(kg * 8 + j) * 33 + 4 * w + vl] = s[j];
    __syncthreads();
    { const int k = tid >> 2, q4 = tid & 3; const float* d = sst + k * 33 + q4 * 8; f32x4* dst = (f32x4*)(s_out + (size_t)k * 128 + sl * 32 + q4 * 8);
      dst[0] = (f32x4){d[0], d[1], d[2], d[3]}; dst[1] = (f32x4){d[4], d[5], d[6], d[7]}; }
    __syncthreads();
}

constexpr int RW_W2 = 20544, RW_A2 = 24640;
__device__ __forceinline__ void rwkv_load_lora(const Params& p, unsigned char* smem, int hb) {
    float* w2_s = (float*)smem + RW_W2; float* a2_s = (float*)smem + RW_A2; const float* pk = (const float*)(p.ws + WS_PK);
    for (int i = otid(); i < 4096; i += 512) { const int l = i >> 6, c = i & 63; w2_s[i] = pk[PK_W2 + l * D + hb * 64 + c]; a2_s[i] = pk[PK_A2 + l * D + hb * 64 + c]; }
    __syncthreads();
}
__device__ __forceinline__ void rwkv_item(const Params& p, unsigned char* smem, const float* s_in, float* s_out, const bf16_t* prev_row, const float* halo_in, float* halo_out,
                                          int hb, int half, int rowA, int nA, int rowB, int nB) {
    const int tid = otid(), w = tid >> 6, lane = tid & 63, row = tid >> 4, kq = tid & 15;
    float* f = (float*)smem;
    float* r_s = f; float* kb_s = f + 2048; float* v_s = f + 4096; float* wd_s = f + 6144; float* ad_s = f + 8192; float* dec_s = f + 10240; float* a_s = f + 12288;
    float* kk_s = f + 14336; float* km_s = f + 16384; float* zb_s = f + 18432; float* y_s = f + 19456; float* bonus_s = f + 20480;
    const float* w2_s = f + RW_W2; const float* a2_s = f + RW_A2;
    const bf16_t* P = (const bf16_t*)(p.ws + WS_P);
    float* YRAW = (float*)(p.ws + WS_YRAW); bf16_t* C0 = (bf16_t*)(p.ws + WS_C0); bf16_t* C1 = (bf16_t*)(p.ws + WS_C1);
    float s[4];
    if (s_in) { const f32x4 t = *(const f32x4*)(s_in + (size_t)(half * 32 + row) * 64 + kq * 4); s[0] = t[0]; s[1] = t[1]; s[2] = t[2]; s[3] = t[3]; }
    else { s[0] = s[1] = s[2] = s[3] = 0.f; }
    int col = -1; float* dst = nullptr; int dstride = 64; bool is_wd = false, owner = false;
    if (tid < 64) { col = hb * 64 + tid; dst = r_s + tid; owner = half == 0; }
    else if (tid < 128) { col = 1024 + hb * 64 + (tid - 64); dst = kb_s + (tid - 64); owner = half == 0; }
    else if (tid < 192) { col = 2048 + hb * 64 + (tid - 128); dst = v_s + (tid - 128); owner = half == 0; }
    else if (tid < 256) { col = 3072 + (tid - 192); dst = wd_s + (tid - 192); is_wd = true; owner = (half == 0 && hb == 0); }
    else if (tid < 320) { col = 3136 + (tid - 256); dst = ad_s + (tid - 256); owner = (half == 0 && hb == 0); }
    else if (tid < 352) { col = 3200 + hb * 64 + half * 32 + (tid - 320); dst = zb_s + (tid - 320); dstride = 32; owner = true; }
    float mu = 0.f, prev = 0.f;
    const float* pk = (const float*)(p.ws + WS_PK);
    if (col >= 0) { mu = pk[PK_MU + col]; prev = prev_row ? bf2f(prev_row[C_RW + col]) : (halo_in ? halo_in[col] : 0.f); }
    const int cc = tid & 63, ig = tid >> 6;
    const int hc = hb * 64 + cc;
    const float w0c = pk[PK_W0 + hc], a0c = pk[PK_A0 + hc], kkc = pk[PK_KK + hc], kac = pk[PK_KA + hc];
    const float rkl = pk[PK_RK + hb * 64 + lane];
#pragma unroll 1
    for (int run = 0; run < 2; ++run) {
        const int rrow = run ? rowB : rowA, rn = run ? nB : nA; const bool wout = run != 0;
#pragma unroll 1
        for (int c0 = 0; c0 < rn; c0 += 32) {
            const int nt = (rn - c0) < 32 ? (rn - c0) : 32; const int row0 = rrow + c0;
            if (col >= 0) {
                const bf16_t* src = P + (size_t)row0 * NPB + C_RW + col;
#pragma unroll 8
                for (int i = 0; i < nt; ++i) { const float cur = bf2f(src[(size_t)i * NPB]); float m = cur + mu * (prev - cur); prev = cur; if (is_wd) m = tanh_(m); dst[i * dstride] = m; }
            }
            __syncthreads();
            {
                float aw[4] = {0.f, 0.f, 0.f, 0.f}, aa[4] = {0.f, 0.f, 0.f, 0.f};
#pragma unroll 4
                for (int l = 0; l < 64; ++l) { const float w2v = w2_s[l * 64 + cc], a2v = a2_s[l * 64 + cc];
#pragma unroll
                    for (int ii = 0; ii < 4; ++ii) { aw[ii] += wd_s[(ig * 4 + ii) * 64 + l] * w2v; aa[ii] += ad_s[(ig * 4 + ii) * 64 + l] * a2v; } }
#pragma unroll
                for (int ii = 0; ii < 4; ++ii) { const int i = ig * 4 + ii;
                    if (i < nt) { const float wraw = w0c + aw[ii]; const float wlog = -0.6065306597126334f * sigm(wraw); const float a = sigm(a0c + aa[ii]);
                        const float kbv = kb_s[i * 64 + cc];
                        dec_s[i * 64 + cc] = expf(wlog); a_s[i * 64 + cc] = a; kk_s[i * 64 + cc] = kbv * kkc; km_s[i * 64 + cc] = kbv * (1.f + (a - 1.f) * kac); } }
            }
            __syncthreads();
#pragma unroll 1
            for (int ii = 0; ii < 4; ++ii) { const int i = w * 4 + ii;
                if (i < nt) { const float kkr = kk_s[i * 64 + lane]; const float kk = kkr * __builtin_amdgcn_rsqf(wave_sum(kkr * kkr) + 1e-6f); kk_s[i * 64 + lane] = kk;
                    const float a = a_s[i * 64 + lane]; a_s[i * 64 + lane] = kk * a;
                    const float rk = wave_sum(r_s[i * 64 + lane] * km_s[i * 64 + lane] * rkl); if (lane == 0) bonus_s[i] = rk; } }
            __syncthreads();
#pragma unroll 1
            for (int i = 0; i < nt; ++i) {
                const f32x4 kk4 = *(const f32x4*)(kk_s + i * 64 + kq * 4), de4 = *(const f32x4*)(dec_s + i * 64 + kq * 4), ka4 = *(const f32x4*)(a_s + i * 64 + kq * 4),
                            km4 = *(const f32x4*)(km_s + i * 64 + kq * 4), r4 = *(const f32x4*)(r_s + i * 64 + kq * 4);
                const float vv = v_s[i * 64 + half * 32 + row];
                const float sa = rowsum16(s[0] * kk4[0] + s[1] * kk4[1] + s[2] * kk4[2] + s[3] * kk4[3]);
#pragma unroll
                for (int j = 0; j < 4; ++j) s[j] = s[j] * de4[j] + (vv * km4[j] - sa * ka4[j]);
                const float y = rowsum16(s[0] * r4[0] + s[1] * r4[1] + s[2] * r4[2] + s[3] * r4[3]);
                if (kq == 0) y_s[i * 32 + row] = y;
            }
            __syncthreads();
            if (wout) { const int i = tid >> 4;
                if (i < nt) {
#pragma unroll
                    for (int q = 0; q < 2; ++q) { const int rr = (tid & 15) * 2 + q, v = half * 32 + rr, colo = hb * 64 + v;
                        const float sz = silu_(zb_s[i * 32 + rr]);
                        const size_t o = (size_t)(row0 + i) * D + colo;
                        YRAW[o] = y_s[i * 32 + rr]; C1[o] = (bf16_t)f2bf(pk[PK_GNW + colo] * sz); C0[o] = (bf16_t)f2bf((pk[PK_GNB + colo] + bonus_s[i] * v_s[i * 64 + v]) * sz); } } }
            __syncthreads();
        }
    }
    *(f32x4*)(s_out + (size_t)(half * 32 + row) * 64 + kq * 4) = (f32x4){s[0], s[1], s[2], s[3]};
    if (col >= 0 && owner && halo_out) halo_out[col] = prev;
}


__device__ __forceinline__ bf16x8 ldfrag(const bf16_t* base, int stride, int r0, int k0, int lane) {
    return *(const bf16x8*)(base + (r0 + (lane & 15)) * stride + k0 + 8 * (lane >> 4));
}
#define MFMA16(a, b, c) __builtin_amdgcn_mfma_f32_16x16x32_bf16((a), (b), (c), 0, 0, 0)
typedef short s16x4 __attribute__((ext_vector_type(4)));
__device__ __forceinline__ bf16x8 ldfrag_tr(const bf16_t* X, int stride, int c0, int k0, int lane) {
    const int l15 = lane & 15;
    const bf16_t* a = X + (k0 + 8 * (lane >> 4) + (l15 >> 2)) * stride + c0 + 4 * (l15 & 3);
    const s16x4 lo = __builtin_amdgcn_ds_read_tr16_b64_v4i16((LAS s16x4*)a), hi = __builtin_amdgcn_ds_read_tr16_b64_v4i16((LAS s16x4*)(a + 4 * stride));
    return __builtin_shufflevector(lo, hi, 0, 1, 2, 3, 4, 5, 6, 7);
}
__device__ __forceinline__ void inv_block(const float* L, float* Tm, float* XS, int tid) {
    const int w = tid >> 6, lane = tid & 63;
    typedef float f32x2v __attribute__((ext_vector_type(2)));
    if (w < 4 && lane < 16) {
        const float* Lb = L + (16 * w) * 64 + 16 * w; float* Tb = Tm + (16 * w) * 64 + 16 * w;
        float tr[16];
#pragma unroll
        for (int i = 0; i < 16; ++i) tr[i] = 0.f;
#pragma unroll
        for (int i = 0; i < 16; ++i) { float a = (lane == i) ? 1.f : 0.f;
#pragma unroll
            for (int j0 = 0; j0 < i; j0 += 4) { const f32x4 l4 = *(const f32x4*)(Lb + i * 64 + j0);
                a -= l4[0] * tr[j0] + l4[1] * tr[j0 + 1] + l4[2] * tr[j0 + 2] + l4[3] * tr[j0 + 3]; }
            tr[i] = a; Tb[i * 64 + lane] = a; }
    }
    for (int e = tid; e < 1536; e += 512) { const int k = e >> 8, r = (e >> 4) & 15, c = e & 15;
        const int rb = k < 3 ? 0 : (k < 5 ? 1 : 2), cb = k < 3 ? k + 1 : (k < 5 ? k - 1 : 3);
        Tm[(16 * rb + r) * 64 + 16 * cb + c] = 0.f; }
    __syncthreads();
    {
        const int B = tid >> 8, i = (tid >> 4) & 15, c = tid & 15, o = 32 * B;
        float x = 0.f;
#pragma unroll
        for (int j0 = 0; j0 < 16; j0 += 4) { const f32x4 l4 = *(const f32x4*)(L + (o + 16 + i) * 64 + o + j0);
            x += l4[0] * Tm[(o + j0) * 64 + o + c] + l4[1] * Tm[(o + j0 + 1) * 64 + o + c] + l4[2] * Tm[(o + j0 + 2) * 64 + o + c] + l4[3] * Tm[(o + j0 + 3) * 64 + o + c]; }
        XS[tid] = x;
        __syncthreads();
        float t = 0.f;
#pragma unroll
        for (int j0 = 0; j0 < 16; j0 += 4) { const f32x4 t4 = *(const f32x4*)(Tm + (o + 16 + i) * 64 + o + 16 + j0);
            t += t4[0] * XS[(B << 8) + j0 * 16 + c] + t4[1] * XS[(B << 8) + (j0 + 1) * 16 + c] + t4[2] * XS[(B << 8) + (j0 + 2) * 16 + c] + t4[3] * XS[(B << 8) + (j0 + 3) * 16 + c]; }
        Tm[(o + 16 + i) * 64 + o + c] = -t;
    }
    __syncthreads();
    {
        const int i = tid >> 4, c2 = (tid & 15) * 2;
        float x0 = 0.f, x1 = 0.f;
#pragma unroll
        for (int j0 = 0; j0 < 32; j0 += 4) { const f32x4 l4 = *(const f32x4*)(L + (32 + i) * 64 + j0);
#pragma unroll
            for (int e = 0; e < 4; ++e) { const f32x2v tv = *(const f32x2v*)(Tm + (j0 + e) * 64 + c2); x0 += l4[e] * tv[0]; x1 += l4[e] * tv[1]; } }
        *(f32x2v*)(XS + i * 32 + c2) = (f32x2v){x0, x1};
        __syncthreads();
        float t0 = 0.f, t1 = 0.f;
#pragma unroll
        for (int j0 = 0; j0 < 32; j0 += 4) { const f32x4 t4 = *(const f32x4*)(Tm + (32 + i) * 64 + 32 + j0);
#pragma unroll
            for (int e = 0; e < 4; ++e) { const f32x2v xv = *(const f32x2v*)(XS + (j0 + e) * 32 + c2); t0 += t4[e] * xv[0]; t1 += t4[e] * xv[1]; } }
        *(f32x2v*)(Tm + (32 + i) * 64 + c2) = (f32x2v){-t0, -t1};
    }
    __syncthreads();
}
constexpr int PL_QS = 0, PL_R1 = 17408, PL_KT = 35840, PL_KTT = 54272, PL_VT = 72704, PL_R3 = 91136, PL_QKM = 109568, PL_TP = 118784, PL_TPP = 128000, PL_SM = 137216, PL_TM = 139264, PL_XS = 155648;
constexpr int QSTR = 136, TSTR = 72;

__device__ __forceinline__ void gdn_prep_item(const Params& p, unsigned char* smem, int h, int row_start, int npad, const bf16_t* hbase,
                                              bf16_t* halo_out, float* conv_out, unsigned char* rec) {
    const int tid = otid(), w = tid >> 6, lane = tid & 63, q4 = lane >> 4, l15 = lane & 15;
    bf16_t* qs = (bf16_t*)(smem + PL_QS); bf16_t* ks = (bf16_t*)(smem + PL_R1); bf16_t* WT = (bf16_t*)(smem + PL_KTT);     bf16_t* kts = (bf16_t*)(smem + PL_KT);
    bf16_t* vs = (bf16_t*)(smem + PL_VT);         float* Lm = (float*)(smem + PL_R3); bf16_t* UT = (bf16_t*)(smem + PL_R3); bf16_t* QKm = (bf16_t*)(smem + PL_QKM);
    bf16_t* Tp = (bf16_t*)(smem + PL_TP); bf16_t* Tpp = (bf16_t*)(smem + PL_TPP);
    float* sm = (float*)(smem + PL_SM);
    float* gcs = sm; float* bes = sm + 64; float* ssq = sm + 128; float* ssk = sm + 192; float* egs = sm + 256; float* egl_s = sm + 320; float* beg = sm + 384;
    const bf16_t* P = (const bf16_t*)(p.ws + WS_P);
    const float* pk = (const float*)(p.ws + WS_PK);
    if (w == 7) {
        const int i = lane;
        float g = 0.f, be = 0.f;
        if (i >= npad) { const size_t r = (size_t)(row_start + i - npad) * NPB; const float pa = bf2f(P[r + C_A + h]), pb = bf2f(P[r + C_B + h]);
            g = -expf(pk[PK_ALOG + h]) * softplus_(pa + pk[PK_DTB + h]); be = sigm(pb); }
        float x = g;
#pragma unroll
        for (int o = 1; o < 64; o <<= 1) { const float y = __shfl_up(x, o); if (lane >= o) x += y; }
        const float gl = __shfl(x, 63);
        gcs[lane] = x; bes[lane] = be; egs[lane] = __expf(x); egl_s[lane] = __expf(gl - x); beg[lane] = be * __expf(x);
        if (lane == 0) *(float*)(rec + GP_EGL) = __expf(gl);
    }
    if (npad == 0 && tid >= 384) {
#pragma unroll
        for (int k = 0; k < 4; ++k) {
            const int slot = (tid - 384) + 128 * k, t = slot >> 3, g = slot & 7;
            const bf16_t* zp = P + (size_t)(row_start + t) * NPB + C_Z + h * 128 + 16 * g;
            const u32x4 z0 = *(const u32x4*)zp, z1 = *(const u32x4*)(zp + 8);
            float za[8], zb[8]; unpack8(z0, za); unpack8(z1, zb);
            const float* nwp = pk + PK_NORMW + 16 * g;
            float ga[8], gb2[8];
#pragma unroll
            for (int e = 0; e < 8; ++e) { ga[e] = nwp[e] * silu_(za[e]); gb2[e] = nwp[8 + e] * silu_(zb[e]); }
            bf16_t* gp = (bf16_t*)(rec + GP_G) + t * 128 + 16 * g;
            *(u32x4*)gp = pack8(ga); *(u32x4*)(gp + 8) = pack8(gb2);
        }
    }
    float y[8][8];
    const int sec = tid >> 7, t0 = 8 * ((tid >> 4) & 7), d0 = l15 * 8;
    if (tid < 384) {
        const int pcol = sec * 1024 + h * 128 + d0;
        float cw[4][8];
#pragma unroll
        for (int j = 0; j < 4; ++j) { const f32x4 a = *(const f32x4*)(pk + PK_CONVW + j * 3072 + pcol), b = *(const f32x4*)(pk + PK_CONVW + j * 3072 + pcol + 4);
            cw[j][0] = a[0]; cw[j][1] = a[1]; cw[j][2] = a[2]; cw[j][3] = a[3]; cw[j][4] = b[0]; cw[j][5] = b[1]; cw[j][6] = b[2]; cw[j][7] = b[3]; }
        u32x4 rw[11]; float fv[11];
#pragma unroll
        for (int k = 0; k < 11; ++k) {
            const int ii = t0 - 3 + k;
            const bf16_t* ptr = P + pcol; float f = 0.f;
            if (ii >= npad) { ptr = P + (size_t)(row_start + ii - npad) * NPB + pcol; f = 1.f; }
            else if (ii < 0 && npad == 0 && hbase) { ptr = hbase + (size_t)(ii + 3) * NPB + pcol; f = 1.f; }
            rw[k] = *(const u32x4*)ptr; fv[k] = f;
        }
        if (halo_out && t0 == 56) {
#pragma unroll
            for (int dd = 0; dd < 3; ++dd) { *(u32x4*)(halo_out + (size_t)dd * NPB + pcol) = rw[8 + dd];
                if (conv_out) { float x[8]; unpack8(rw[8 + dd], x); *(f32x4*)(conv_out + dd * 3072 + pcol) = (f32x4){x[0], x[1], x[2], x[3]}; *(f32x4*)(conv_out + dd * 3072 + pcol + 4) = (f32x4){x[4], x[5], x[6], x[7]}; } }
        }
#pragma unroll
        for (int t = 0; t < 8; ++t)
#pragma unroll
            for (int e = 0; e < 8; ++e) y[t][e] = 0.f;
#pragma unroll
        for (int k = 0; k < 11; ++k) { float x[8]; unpack8(rw[k], x);
#pragma unroll
            for (int e = 0; e < 8; ++e) x[e] *= fv[k];
#pragma unroll
            for (int dlt = 0; dlt < 4; ++dlt) { const int t = k - dlt;
                if (t >= 0 && t < 8) {
#pragma unroll
                    for (int e = 0; e < 8; ++e) y[t][e] += cw[dlt][e] * x[e]; } }
        }
        const float qsc = sec == 0 ? 0.08838834764831845f : 1.f;
#pragma unroll
        for (int t = 0; t < 8; ++t) {
            const bool tokv = (t0 + t) >= npad;
            float ss = 0.f;
#pragma unroll
            for (int e = 0; e < 8; ++e) { y[t][e] = tokv ? silu_(y[t][e]) : 0.f; ss += y[t][e] * y[t][e]; }
            if (sec < 2) { const float sc = __builtin_amdgcn_rsqf(rowsum16(ss) + 1e-6f) * qsc;
#pragma unroll
                for (int e = 0; e < 8; ++e) y[t][e] *= sc; }
        }
        { bf16_t* dst = sec == 0 ? qs : (sec == 1 ? ks : vs);
#pragma unroll
            for (int t = 0; t < 8; ++t) *(u32x4*)(dst + (t0 + t) * QSTR + d0) = pack8(y[t]); }
    }
    __syncthreads();
    if (sec == 1) {
#pragma unroll
        for (int t = 0; t < 8; ++t) { const float eg = egl_s[t0 + t]; float z[8];
#pragma unroll
            for (int e = 0; e < 8; ++e) z[e] = y[t][e] * eg;
            *(u32x4*)(kts + (t0 + t) * QSTR + d0) = pack8(z); } }
    {
        const int which = w >> 2, it = w & 3;
        const bf16_t* Barr = which ? qs : ks;
        bf16x8 bfr[4];
#pragma unroll
        for (int kk = 0; kk < 4; ++kk) bfr[kk] = ldfrag(Barr, QSTR, 16 * it, 32 * kk, lane);
        const int i = 16 * it + l15; const float gi = gcs[i], bi = bes[i];
#pragma unroll
        for (int jt = 0; jt < 4; ++jt) {
            f32x4 acc = {0.f, 0.f, 0.f, 0.f};
#pragma unroll
            for (int kk = 0; kk < 4; ++kk) acc = MFMA16(ldfrag(ks, QSTR, 16 * jt, 32 * kk, lane), bfr[kk], acc);
            const int j0 = 16 * jt + 4 * q4; const f32x4 gj = *(const f32x4*)(gcs + j0);
            f32x4 o;
#pragma unroll
            for (int r = 0; r < 4; ++r) { const int j = j0 + r; const bool keep = which ? (i >= j) : (i > j); o[r] = keep ? acc[r] * __expf(gi - gj[r]) : 0.f; }
            if (which == 0) *(f32x4*)(Lm + i * 64 + j0) = o * bi;
            else *(u32x2*)(QKm + i * TSTR + j0) = (u32x2){pk2(o[0], o[1]), pk2(o[2], o[3])};
        }
    }
    __syncthreads();
    {
        float* Tm = (float*)(smem + PL_TM);
        inv_block(Lm, Tm, (float*)(smem + PL_XS), tid);
        const int i = tid >> 3, j0 = (tid & 7) * 8;
        float a[8], b2[8];
#pragma unroll
        for (int e = 0; e < 8; ++e) { const float tv = Tm[i * 64 + j0 + e]; a[e] = tv * beg[j0 + e]; b2[e] = tv * bes[j0 + e]; }
        *(u32x4*)(Tp + i * TSTR + j0) = (u32x4){pk2(a[0], a[1]), pk2(a[2], a[3]), pk2(a[4], a[5]), pk2(a[6], a[7])};
        *(u32x4*)(Tpp + i * TSTR + j0) = (u32x4){pk2(b2[0], b2[1]), pk2(b2[2], b2[3]), pk2(b2[4], b2[5]), pk2(b2[6], b2[7])};
    }
    __syncthreads();
    {
        const int it = w & 3, half = w >> 2;
        f32x4 aw[4], au[4];
#pragma unroll
        for (int x = 0; x < 4; ++x) { aw[x] = (f32x4){0.f, 0.f, 0.f, 0.f}; au[x] = (f32x4){0.f, 0.f, 0.f, 0.f}; }
#pragma unroll
        for (int kk = 0; kk < 2; ++kk) {
            const bf16x8 a1 = ldfrag(Tp, TSTR, 16 * it, 32 * kk, lane), a2 = ldfrag(Tpp, TSTR, 16 * it, 32 * kk, lane);
#pragma unroll
            for (int x = 0; x < 4; ++x) { const int dt = half * 4 + x;
                aw[x] = MFMA16(a1, ldfrag_tr(ks, QSTR, 16 * dt, 32 * kk, lane), aw[x]);
                au[x] = MFMA16(a2, ldfrag_tr(vs, QSTR, 16 * dt, 32 * kk, lane), au[x]); }
        }
#pragma unroll
        for (int x = 0; x < 4; ++x) { const int d = 16 * (half * 4 + x) + l15, i0 = 16 * it + 4 * q4;
            *(u32x2*)(WT + d * TSTR + i0) = (u32x2){pk2(aw[x][0], aw[x][1]), pk2(aw[x][2], aw[x][3])};
            *(u32x2*)(UT + d * TSTR + i0) = (u32x2){pk2(au[x][0], au[x][1]), pk2(au[x][2], au[x][3])}; }
    }
    __syncthreads();
    {
        bf16_t* gAP = (bf16_t*)(rec + GP_AP); bf16_t* gQH = (bf16_t*)(rec + GP_QH); bf16_t* gKH = (bf16_t*)(rec + GP_KH); bf16_t* gOH = (bf16_t*)(rec + GP_OH);
        {
            const int et = w;
            const bf16x8 a0 = ldfrag(WT, TSTR, 16 * et, 0, lane), a1 = ldfrag(WT, TSTR, 16 * et, 32, lane);
#pragma unroll
            for (int dt = 0; dt < 8; ++dt) { f32x4 acc = {0.f, 0.f, 0.f, 0.f};
                acc = MFMA16(a0, ldfrag_tr(kts, QSTR, 16 * dt, 0, lane), acc); acc = MFMA16(a1, ldfrag_tr(kts, QSTR, 16 * dt, 32, lane), acc);
                *(u32x2*)(gAP + ((size_t)(dt * 4 + (et >> 1)) * 64 + lane) * 8 + (et & 1) * 4) = (u32x2){pk2(-acc[0], -acc[1]), pk2(-acc[2], -acc[3])}; }
#pragma unroll
            for (int tt = 0; tt < 4; ++tt) { f32x4 acc = {0.f, 0.f, 0.f, 0.f};
                acc = MFMA16(a0, ldfrag(QKm, TSTR, 16 * tt, 0, lane), acc); acc = MFMA16(a1, ldfrag(QKm, TSTR, 16 * tt, 32, lane), acc);
                const int t = 16 * tt + l15, e0 = 16 * et + 4 * q4; const float eg = egs[t];
                const u32x2 qq = *(const u32x2*)(qs + t * QSTR + e0);
                const float o0 = __uint_as_float(qq.x << 16) * eg - acc[0], o1 = __uint_as_float(qq.x & 0xffff0000u) * eg - acc[1],
                            o2 = __uint_as_float(qq.y << 16) * eg - acc[2], o3 = __uint_as_float(qq.y & 0xffff0000u) * eg - acc[3];
                *(u32x2*)(gQH + ((size_t)(tt * 4 + (et >> 1)) * 64 + lane) * 8 + (et & 1) * 4) = (u32x2){pk2(o0, o1), pk2(o2, o3)}; }
        }
        {
            const int dt = w;
            const bf16x8 a0 = ldfrag_tr(kts, QSTR, 16 * dt, 0, lane), a1 = ldfrag_tr(kts, QSTR, 16 * dt, 32, lane);
#pragma unroll
            for (int vt = 0; vt < 8; ++vt) { f32x4 acc = {0.f, 0.f, 0.f, 0.f};
                acc = MFMA16(a0, ldfrag(UT, TSTR, 16 * vt, 0, lane), acc); acc = MFMA16(a1, ldfrag(UT, TSTR, 16 * vt, 32, lane), acc);
                *(u32x2*)(gKH + ((size_t)(vt * 8 + dt) * 64 + lane) * 4) = (u32x2){pk2(acc[0], acc[1]), pk2(acc[2], acc[3])}; }
            const int tt = w & 3, vh = w >> 2;
            const bf16x8 b0 = ldfrag(QKm, TSTR, 16 * tt, 0, lane), b1 = ldfrag(QKm, TSTR, 16 * tt, 32, lane);
#pragma unroll
            for (int x = 0; x < 4; ++x) { const int vt = vh * 4 + x; f32x4 acc = {0.f, 0.f, 0.f, 0.f};
                acc = MFMA16(b0, ldfrag(UT, TSTR, 16 * vt, 0, lane), acc); acc = MFMA16(b1, ldfrag(UT, TSTR, 16 * vt, 32, lane), acc);
                *(u32x2*)(gOH + ((size_t)(vt * 4 + tt) * 64 + lane) * 4) = (u32x2){pk2(acc[0], acc[1]), pk2(acc[2], acc[3])}; }
        }
    }
    __syncthreads();
}

__device__ __forceinline__ void phase_gprep(const Params& p, int seg, unsigned char* smem) {
    const int blk = obid();
    const int n_items = (CPS + (seg == 0 ? 1 : 0)) * 64;
#pragma unroll 1
    for (int it = blk; it < n_items; it += gridDim.x) {
        const int bh = it & 63, b = bh >> 3, h = bh & 7; int cl = it >> 6; if (seg != 0) cl += 1;
        unsigned char* rec = p.ws + WS_GP + (size_t)(cl * 64 + bh) * GP_STRIDE;
        const bf16_t* Pb = (const bf16_t*)(p.ws + WS_P);
        bf16_t* chalo2 = (bf16_t*)(p.ws + WS_CHALO);
        if (cl == 0) gdn_prep_item(p, smem, h, LEX0, 48, nullptr, nullptr, nullptr, rec);
        else {
            const int row = b * SEGTOK + (cl - 1) * 64;
            const bf16_t* hbase = Pb + (size_t)(row - 3) * NPB;
            if (cl == 1) hbase = (seg == 0) ? Pb + (size_t)(LEX0 + NMETA - 3) * NPB : chalo2 + (size_t)(((seg - 1) & 1) * NBATCH + b) * 3 * NPB;
            bf16_t* ho = (cl == CPS) ? chalo2 + (size_t)((seg & 1) * NBATCH + b) * 3 * NPB : nullptr;
            float* co = (cl == CPS && seg == NSEG - 1) ? p.out + O_CONV_P + (size_t)b * 9216 : nullptr;
            gdn_prep_item(p, smem, h, row, 0, hbase, ho, co, rec);
        }
    }
}

__device__ __forceinline__ void gdn_scan_block(const Params& p, int seg, unsigned char* smem, int bh) {
    const int tid = otid(), w = tid >> 6, lane = tid & 63, q4 = lane >> 4, l15 = lane & 15;
    const int b = bh >> 3, h = bh & 7;
    float* st = p.out + O_GDN_P + (size_t)bh * 16384;
    f32x4 S[8];
    if (seg) {
#pragma unroll
        for (int mt = 0; mt < 8; ++mt)
#pragma unroll
            for (int r = 0; r < 4; ++r) S[mt][r] = st[(size_t)(16 * mt + 4 * q4 + r) * 128 + 16 * w + l15];
    } else {
#pragma unroll
        for (int mt = 0; mt < 8; ++mt) S[mt] = (f32x4){0.f, 0.f, 0.f, 0.f};
    }
    const int c_lo = seg ? 1 : 0;
    float* obuf = (float*)(smem + 98304);
    {
        const u32x4* src = (const u32x4*)(p.ws + WS_GP + (size_t)(c_lo * 64 + bh) * GP_STRIDE); u32x4* dst = (u32x4*)smem;
#pragma unroll
        for (int x = 0; x < 6; ++x) dst[tid + 512 * x] = src[tid + 512 * x];
    }
#pragma unroll 1
    for (int cl = c_lo; cl <= CPS; ++cl) {
        const unsigned char* rec = p.ws + WS_GP + (size_t)(cl * 64 + bh) * GP_STRIDE;
        const int cur = (cl - c_lo) & 1;
        __syncthreads();
        u32x4 nx[6];
        const bool more = cl < CPS;
        if (more) { const u32x4* src = (const u32x4*)(rec + GP_STRIDE * 64);
#pragma unroll
            for (int x = 0; x < 6; ++x) nx[x] = src[tid + 512 * x]; }
        const bf16_t* gKH = (const bf16_t*)(rec + GP_KH); const bf16_t* gOH = (const bf16_t*)(rec + GP_OH);
        u32x2 kh[8], oh[4];
#pragma unroll
        for (int mt = 0; mt < 8; ++mt) kh[mt] = *(const u32x2*)(gKH + ((size_t)(w * 8 + mt) * 64 + lane) * 4);
#pragma unroll
        for (int tt = 0; tt < 4; ++tt) oh[tt] = *(const u32x2*)(gOH + ((size_t)(w * 4 + tt) * 64 + lane) * 4);
        const float egl = *(const float*)(rec + GP_EGL);
        const int et = tid >> 3, eg = tid & 7;
        const bf16_t* gp = (const bf16_t*)(rec + GP_G) + et * 128 + 16 * eg;
        u32x4 z0 = {0u, 0u, 0u, 0u}, z1 = {0u, 0u, 0u, 0u};
        if (cl > 0) { z0 = *(const u32x4*)gp; z1 = *(const u32x4*)(gp + 8); }
        bf16x8 Bf[4];
#pragma unroll
        for (int ks = 0; ks < 4; ++ks) { u32x4 t; t.x = pk2(S[2 * ks][0], S[2 * ks][1]); t.y = pk2(S[2 * ks][2], S[2 * ks][3]); t.z = pk2(S[2 * ks + 1][0], S[2 * ks + 1][1]); t.w = pk2(S[2 * ks + 1][2], S[2 * ks + 1][3]);
            Bf[ks] = __builtin_bit_cast(bf16x8, t); }
        const bf16x8* AP = (const bf16x8*)(smem + cur * 49152); const bf16x8* QH = (const bf16x8*)(smem + cur * 49152 + GP_QH);
        f32x4 o[4], tS[8];
#pragma unroll
        for (int tt = 0; tt < 4; ++tt) { o[tt] = (f32x4){0.f, 0.f, 0.f, 0.f};
#pragma unroll
            for (int ks = 0; ks < 4; ++ks) o[tt] = MFMA16(QH[(tt * 4 + ks) * 64 + lane], Bf[ks], o[tt]); }
#pragma unroll
        for (int mt = 0; mt < 8; ++mt) { tS[mt] = (f32x4){0.f, 0.f, 0.f, 0.f};
#pragma unroll
            for (int ks = 0; ks < 4; ++ks) tS[mt] = MFMA16(AP[(mt * 4 + ks) * 64 + lane], Bf[ks], tS[mt]); }
#pragma unroll
        for (int mt = 0; mt < 8; ++mt) {
            S[mt][0] = egl * S[mt][0] + tS[mt][0] + __uint_as_float(kh[mt].x << 16); S[mt][1] = egl * S[mt][1] + tS[mt][1] + __uint_as_float(kh[mt].x & 0xffff0000u);
            S[mt][2] = egl * S[mt][2] + tS[mt][2] + __uint_as_float(kh[mt].y << 16); S[mt][3] = egl * S[mt][3] + tS[mt][3] + __uint_as_float(kh[mt].y & 0xffff0000u); }
        if (cl > 0) {
#pragma unroll
            for (int tt = 0; tt < 4; ++tt) {
                o[tt][0] += __uint_as_float(oh[tt].x << 16); o[tt][1] += __uint_as_float(oh[tt].x & 0xffff0000u); o[tt][2] += __uint_as_float(oh[tt].y << 16); o[tt][3] += __uint_as_float(oh[tt].y & 0xffff0000u);
#pragma unroll
                for (int r = 0; r < 4; ++r) obuf[(16 * tt + 4 * q4 + r) * 132 + 16 * w + l15] = o[tt][r]; }
        }
        if (more) { u32x4* dst = (u32x4*)(smem + (cur ^ 1) * 49152);
#pragma unroll
            for (int x = 0; x < 6; ++x) dst[tid + 512 * x] = nx[x]; }
        if (cl > 0) {
            __syncthreads();
            f32x4 ov[4]; float ss = 0.f;
#pragma unroll
            for (int j = 0; j < 4; ++j) { ov[j] = *(const f32x4*)(obuf + et * 132 + 16 * eg + 4 * j); ss += ov[j][0] * ov[j][0] + ov[j][1] * ov[j][1] + ov[j][2] * ov[j][2] + ov[j][3] * ov[j][3]; }
            ss += __shfl_xor(ss, 1); ss += __shfl_xor(ss, 2); ss += __shfl_xor(ss, 4);
            const float rs = __builtin_amdgcn_rsqf(ss * (1.f / 128.f) + 1e-6f);
            const unsigned zz[8] = {z0.x, z0.y, z0.z, z0.w, z1.x, z1.y, z1.z, z1.w};
            unsigned ow[8];
#pragma unroll
            for (int j = 0; j < 8; ++j) ow[j] = pk2(ov[j >> 1][(j & 1) * 2] * rs * __uint_as_float(zz[j] << 16), ov[j >> 1][(j & 1) * 2 + 1] * rs * __uint_as_float(zz[j] & 0xffff0000u));
            const size_t grow = (size_t)b * SEQ + seg * SEGTOK + (cl - 1) * 64 + et;
            bf16_t* oa = (bf16_t*)(p.ws + WS_H) + grow * D + h * 128 + 16 * eg;
            *(u32x4*)oa = (u32x4){ow[0], ow[1], ow[2], ow[3]}; *(u32x4*)(oa + 8) = (u32x4){ow[4], ow[5], ow[6], ow[7]};
        }
    }
#pragma unroll
    for (int mt = 0; mt < 8; ++mt)
#pragma unroll
        for (int r = 0; r < 4; ++r) st[(size_t)(16 * mt + 4 * q4 + r) * 128 + 16 * w + l15] = S[mt][r];
    __syncthreads();
}

constexpr int RL_AT = 0, RL_BT = 9216, RL_KT = 18432, RL_ATT = 27648, RL_RT = 36864, RL_BTLT = 46080, RL_KTLT = 55296, RL_VT = 64512, RL_LAK = 73728, RL_MRB = 82944, RL_MRK = 92160,
              RL_LM = 101376, RL_AF = 117760, RL_TM = 134144, RL_XS = 150528;
__device__ __forceinline__ void rwkv_prep_item(const Params& p, unsigned char* smem, int hb, int row_start, int npad, const bf16_t* prev_row,
                                               bf16_t* halo_out, unsigned char* rec) {
    const int tid = otid(), w = tid >> 6, lane = tid & 63, q4 = lane >> 4, l15 = lane & 15;
    bf16_t* At = (bf16_t*)(smem + RL_AT); bf16_t* Tb = At; bf16_t* Bt = (bf16_t*)(smem + RL_BT); bf16_t* WaT = Bt; bf16_t* Kt = (bf16_t*)(smem + RL_KT); bf16_t* XT = Kt;
    bf16_t* At2 = (bf16_t*)(smem + RL_ATT); bf16_t* Rt = (bf16_t*)(smem + RL_RT); bf16_t* Btl = (bf16_t*)(smem + RL_BTLT); bf16_t* Ktl = (bf16_t*)(smem + RL_KTLT);
    bf16_t* Vr = (bf16_t*)(smem + RL_VT);        bf16_t* Lak = (bf16_t*)(smem + RL_LAK); bf16_t* Mrb = (bf16_t*)(smem + RL_MRB); bf16_t* Mrk = (bf16_t*)(smem + RL_MRK);
    float* Lm = (float*)(smem + RL_LM);
    bf16_t* thw = Lak; bf16_t* adb = Mrb; float* lc = Lm; float* af = (float*)(smem + RL_AF);
    const bf16_t* P = (const bf16_t*)(p.ws + WS_P);
    const float* pk = (const float*)(p.ws + WS_PK);
    const int t = tid >> 3, g = tid & 7;
    float rr[8], kb[8], vv[8], zb[8];
    {
        const bool real = t >= npad;
        const bf16_t* curp = P; const bf16_t* prevp = P; float fprev = 0.f;
        if (real) { curp = P + (size_t)(row_start + t - npad) * NPB; if (t > npad) { prevp = curp - NPB; fprev = 1.f; } else if (prev_row) { prevp = prev_row; fprev = 1.f; } }
        const int secbase[6] = {0, 1024, 2048, 3200, 3072, 3136};
        u32x4 rc[6], rp[6];
#pragma unroll
        for (int sidx = 0; sidx < 6; ++sidx) { const int col = secbase[sidx] + (sidx < 4 ? hb * 64 : 0) + g * 8; rc[sidx] = *(const u32x4*)(curp + C_RW + col); rp[sidx] = *(const u32x4*)(prevp + C_RW + col); }
        float m[6][8];
#pragma unroll
        for (int sidx = 0; sidx < 6; ++sidx) {
            const int col = secbase[sidx] + (sidx < 4 ? hb * 64 : 0) + g * 8;
            float cur[8], prv[8];
            unpack8(rc[sidx], cur); unpack8(rp[sidx], prv);
            const f32x4 mu0 = *(const f32x4*)(pk + PK_MU + col), mu1 = *(const f32x4*)(pk + PK_MU + col + 4);
            const float mu[8] = {mu0[0], mu0[1], mu0[2], mu0[3], mu1[0], mu1[1], mu1[2], mu1[3]};
#pragma unroll
            for (int e = 0; e < 8; ++e) m[sidx][e] = real ? cur[e] + mu[e] * (fprev * prv[e] - cur[e]) : 0.f;
            if (halo_out && t == 63 && (sidx < 4 || hb == 0)) *(u32x4*)(halo_out + C_RW + col) = rc[sidx];
        }
#pragma unroll
        for (int e = 0; e < 8; ++e) { rr[e] = m[0][e]; kb[e] = m[1][e]; vv[e] = m[2][e]; zb[e] = m[3][e]; }
        float th[8];
#pragma unroll
        for (int e = 0; e < 8; ++e) th[e] = tanh_(m[4][e]);
        *(u32x4*)(thw + t * TSTR + g * 8) = pack8(th);
        *(u32x4*)(adb + t * TSTR + g * 8) = pack8(m[5]);
    }
    __syncthreads();
    {
        const int which = w >> 2, ct = w & 3;
        const bf16_t* Wt = (const bf16_t*)(p.ws + (which ? WS_A2T : WS_W2T)) + (size_t)hb * 4096;
        const bf16x8 b0 = *(const bf16x8*)(Wt + (16 * ct + l15) * 64 + 8 * q4), b1 = *(const bf16x8*)(Wt + (16 * ct + l15) * 64 + 32 + 8 * q4);
        const bf16_t* Aarr = which ? adb : thw;
        const int c = 16 * ct + l15;
        const float bias = pk[(which ? PK_A0 : PK_W0) + hb * 64 + c];
        float carry = 0.f;
#pragma unroll
        for (int tt = 0; tt < 4; ++tt) {
            f32x4 acc = {0.f, 0.f, 0.f, 0.f};
            acc = MFMA16(ldfrag(Aarr, TSTR, 16 * tt, 0, lane), b0, acc); acc = MFMA16(ldfrag(Aarr, TSTR, 16 * tt, 32, lane), b1, acc);
            if (which) {
#pragma unroll
                for (int r = 0; r < 4; ++r) af[(16 * tt + 4 * q4 + r) * 64 + c] = sigm(bias + acc[r]);
            } else {
                float wl[4];
#pragma unroll
                for (int r = 0; r < 4; ++r) { const int tk = 16 * tt + 4 * q4 + r; wl[r] = (tk < npad) ? 0.f : -0.6065306597126334f * sigm(bias + acc[r]); }
                wl[1] += wl[0]; wl[2] += wl[1]; wl[3] += wl[2];
                const float Q = wl[3];
                const float Q0 = __shfl(Q, l15), Q1 = __shfl(Q, l15 + 16), Q2 = __shfl(Q, l15 + 32), Q3 = __shfl(Q, l15 + 48);
                const float ex = carry + (q4 > 0 ? Q0 : 0.f) + (q4 > 1 ? Q1 : 0.f) + (q4 > 2 ? Q2 : 0.f);
#pragma unroll
                for (int r = 0; r < 4; ++r) lc[(16 * tt + 4 * q4 + r) * 64 + c] = ex + wl[r];
                carry += Q0 + Q1 + Q2 + Q3;
            }
        }
    }
    __syncthreads();
    {
        float lct[8], lcp[8], lcC[8], av[8];
        { const f32x4 a = *(const f32x4*)(lc + t * 64 + g * 8), b2 = *(const f32x4*)(lc + t * 64 + g * 8 + 4); lct[0] = a[0]; lct[1] = a[1]; lct[2] = a[2]; lct[3] = a[3]; lct[4] = b2[0]; lct[5] = b2[1]; lct[6] = b2[2]; lct[7] = b2[3]; }
        if (t > 0) { const f32x4 a = *(const f32x4*)(lc + (t - 1) * 64 + g * 8), b2 = *(const f32x4*)(lc + (t - 1) * 64 + g * 8 + 4); lcp[0] = a[0]; lcp[1] = a[1]; lcp[2] = a[2]; lcp[3] = a[3]; lcp[4] = b2[0]; lcp[5] = b2[1]; lcp[6] = b2[2]; lcp[7] = b2[3]; }
        else {
#pragma unroll
            for (int e = 0; e < 8; ++e) lcp[e] = 0.f; }
        { const f32x4 a = *(const f32x4*)(lc + 63 * 64 + g * 8), b2 = *(const f32x4*)(lc + 63 * 64 + g * 8 + 4); lcC[0] = a[0]; lcC[1] = a[1]; lcC[2] = a[2]; lcC[3] = a[3]; lcC[4] = b2[0]; lcC[5] = b2[1]; lcC[6] = b2[2]; lcC[7] = b2[3]; }
        { const f32x4 a = *(const f32x4*)(af + t * 64 + g * 8), b2 = *(const f32x4*)(af + t * 64 + g * 8 + 4); av[0] = a[0]; av[1] = a[1]; av[2] = a[2]; av[3] = a[3]; av[4] = b2[0]; av[5] = b2[1]; av[6] = b2[2]; av[7] = b2[3]; }
        const int hc = hb * 64 + g * 8;
        float kk[8], km[8], ss = 0.f, rk = 0.f;
        float pkk[8], pka[8], prk[8];
        { const f32x4 a0 = *(const f32x4*)(pk + PK_KK + hc), a1 = *(const f32x4*)(pk + PK_KK + hc + 4), b0 = *(const f32x4*)(pk + PK_KA + hc), b1 = *(const f32x4*)(pk + PK_KA + hc + 4), c0v = *(const f32x4*)(pk + PK_RK + hc), c1v = *(const f32x4*)(pk + PK_RK + hc + 4);
#pragma unroll
          for (int e = 0; e < 4; ++e) { pkk[e] = a0[e]; pkk[4 + e] = a1[e]; pka[e] = b0[e]; pka[4 + e] = b1[e]; prk[e] = c0v[e]; prk[4 + e] = c1v[e]; } }
#pragma unroll
        for (int e = 0; e < 8; ++e) { kk[e] = kb[e] * pkk[e]; ss += kk[e] * kk[e]; km[e] = kb[e] * (1.f + (av[e] - 1.f) * pka[e]); rk += rr[e] * km[e] * prk[e]; }
        ss += __shfl_xor(ss, 1); ss += __shfl_xor(ss, 2); ss += __shfl_xor(ss, 4);
        rk += __shfl_xor(rk, 1); rk += __shfl_xor(rk, 2); rk += __shfl_xor(rk, 4);
        const float kn = __builtin_amdgcn_rsqf(ss + 1e-6f);
        float xa[8], xb[8], xk[8], xr[8], xbt[8], xkt[8];
#pragma unroll
        for (int e = 0; e < 8; ++e) { kk[e] *= kn; const float ka = kk[e] * av[e]; const float ip = __expf(-lct[e]), tl = __expf(lcC[e] - lct[e]);
            xa[e] = kk[e] * __expf(lcp[e]); xb[e] = ka * ip; xk[e] = km[e] * ip; xr[e] = rr[e] * __expf(lct[e]); xbt[e] = ka * tl; xkt[e] = km[e] * tl; }
        *(u32x4*)(At + t * TSTR + g * 8) = pack8(xa); *(u32x4*)(Bt + t * TSTR + g * 8) = pack8(xb); *(u32x4*)(Kt + t * TSTR + g * 8) = pack8(xk); *(u32x4*)(Rt + t * TSTR + g * 8) = pack8(xr);
        *(u32x4*)(At2 + t * TSTR + g * 8) = pack8(xa); *(u32x4*)(Btl + t * TSTR + g * 8) = pack8(xbt); *(u32x4*)(Ktl + t * TSTR + g * 8) = pack8(xkt); *(u32x4*)(Vr + t * TSTR + g * 8) = pack8(vv);
        float c1[8], c0[8];
#pragma unroll
        for (int e = 0; e < 8; ++e) { c1[e] = 0.f; c0[e] = 0.f; }
        { const f32x4 g0 = *(const f32x4*)(pk + PK_GNW + hc), g1 = *(const f32x4*)(pk + PK_GNW + hc + 4), h0 = *(const f32x4*)(pk + PK_GNB + hc), h1 = *(const f32x4*)(pk + PK_GNB + hc + 4);
#pragma unroll
          for (int e = 0; e < 4; ++e) { const float sz0 = silu_(zb[e]), sz1 = silu_(zb[4 + e]); c1[e] = g0[e] * sz0; c1[4 + e] = g1[e] * sz1; c0[e] = (h0[e] + rk * vv[e]) * sz0; c0[4 + e] = (h1[e] + rk * vv[4 + e]) * sz1; } }
        *(u32x4*)((bf16_t*)(rec + RP_C1) + t * 64 + g * 8) = pack8(c1); *(u32x4*)((bf16_t*)(rec + RP_C0) + t * 64 + g * 8) = pack8(c0);
        if (t == 63) { float* pc = (float*)(rec + RP_PC) + g * 8; *(f32x4*)pc = (f32x4){__expf(lcC[0]), __expf(lcC[1]), __expf(lcC[2]), __expf(lcC[3])}; *(f32x4*)(pc + 4) = (f32x4){__expf(lcC[4]), __expf(lcC[5]), __expf(lcC[6]), __expf(lcC[7])}; }
    }
    __syncthreads();
    {
        const int pr = w >> 1;
        const bf16_t* Aarr = pr < 2 ? At : Rt; const bf16_t* Barr = (pr & 1) ? Kt : Bt;
#pragma unroll
        for (int x = 0; x < 2; ++x) { const int tt = 2 * (w & 1) + x;
            const bf16x8 a0 = ldfrag(Aarr, TSTR, 16 * tt, 0, lane), a1 = ldfrag(Aarr, TSTR, 16 * tt, 32, lane);
            const int tk = 16 * tt + l15;
#pragma unroll
            for (int it = 0; it < 4; ++it) { f32x4 acc = {0.f, 0.f, 0.f, 0.f};
                acc = MFMA16(ldfrag(Barr, TSTR, 16 * it, 0, lane), a0, acc); acc = MFMA16(ldfrag(Barr, TSTR, 16 * it, 32, lane), a1, acc);
                const int i0 = 16 * it + 4 * q4;
                f32x4 o;
#pragma unroll
                for (int r = 0; r < 4; ++r) { const int i = i0 + r; const bool keep = pr < 2 ? (tk > i) : (tk >= i); o[r] = keep ? acc[r] : 0.f; }
                if (pr == 0) *(f32x4*)(Lm + tk * 64 + i0) = o;
                else { bf16_t* Out = pr == 1 ? Lak : (pr == 2 ? Mrb : Mrk); *(u32x2*)(Out + tk * TSTR + i0) = (u32x2){pk2(o[0], o[1]), pk2(o[2], o[3])}; } }
        }
    }
    __syncthreads();
    {
        float* Tm = (float*)(smem + RL_TM);
        inv_block(Lm, Tm, (float*)(smem + RL_XS), tid);
        const int i = tid >> 3, j0 = (tid & 7) * 8;
        float a[8];
#pragma unroll
        for (int e = 0; e < 8; ++e) a[e] = Tm[i * 64 + j0 + e];
        *(u32x4*)(Tb + i * TSTR + j0) = pack8(a);
    }
    __syncthreads();
    {
        const int tt = w & 3, which = w >> 2;
        const bf16_t* Aarr = which ? Lak : Tb; const bf16_t* Barr = which ? Vr : At2; bf16_t* Out = which ? XT : WaT;
        const bf16x8 a0 = ldfrag(Aarr, TSTR, 16 * tt, 0, lane), a1 = ldfrag(Aarr, TSTR, 16 * tt, 32, lane);
#pragma unroll
        for (int ct = 0; ct < 4; ++ct) { f32x4 acc = {0.f, 0.f, 0.f, 0.f};
            acc = MFMA16(a0, ldfrag_tr(Barr, TSTR, 16 * ct, 0, lane), acc); acc = MFMA16(a1, ldfrag_tr(Barr, TSTR, 16 * ct, 32, lane), acc);
            *(u32x2*)(Out + (16 * ct + l15) * TSTR + 16 * tt + 4 * q4) = (u32x2){pk2(acc[0], acc[1]), pk2(acc[2], acc[3])}; }
    }
    __syncthreads();
    {
        f32x4 acc[4];
        if (w < 4) {
            const bf16x8 a0 = ldfrag(Tb, TSTR, 16 * w, 0, lane), a1 = ldfrag(Tb, TSTR, 16 * w, 32, lane);
#pragma unroll
            for (int ct = 0; ct < 4; ++ct) { acc[ct] = (f32x4){0.f, 0.f, 0.f, 0.f};
                acc[ct] = MFMA16(a0, ldfrag(XT, TSTR, 16 * ct, 0, lane), acc[ct]); acc[ct] = MFMA16(a1, ldfrag(XT, TSTR, 16 * ct, 32, lane), acc[ct]); }
        }
        if (w < 4) {
            bf16_t* UvTw = (bf16_t*)(smem + RL_LM);
#pragma unroll
            for (int ct = 0; ct < 4; ++ct) *(u32x2*)(UvTw + (16 * ct + l15) * TSTR + 16 * w + 4 * q4) = (u32x2){pk2(-acc[ct][0], -acc[ct][1]), pk2(-acc[ct][2], -acc[ct][3])};
        }
    }
    __syncthreads();
    {
        const bf16_t* UvT = (const bf16_t*)(smem + RL_LM);
        bf16_t* gAP = (bf16_t*)(rec + RP_AP); bf16_t* gRH = (bf16_t*)(rec + RP_RH); bf16_t* gKH = (bf16_t*)(rec + RP_KH); bf16_t* gYH = (bf16_t*)(rec + RP_YH);
        const int et = w & 3, part = w >> 2;
        {
            const bf16x8 a0 = ldfrag(WaT, TSTR, 16 * et, 0, lane), a1 = ldfrag(WaT, TSTR, 16 * et, 32, lane);
            if (part == 0) {
#pragma unroll
                for (int kt = 0; kt < 4; ++kt) { f32x4 acc = {0.f, 0.f, 0.f, 0.f};
                    acc = MFMA16(a0, ldfrag_tr(Btl, TSTR, 16 * kt, 0, lane), acc); acc = MFMA16(a1, ldfrag_tr(Btl, TSTR, 16 * kt, 32, lane), acc);
                    *(u32x2*)(gAP + ((size_t)(kt * 2 + (et >> 1)) * 64 + lane) * 8 + (et & 1) * 4) = (u32x2){pk2(-acc[0], -acc[1]), pk2(-acc[2], -acc[3])}; }
            } else {
#pragma unroll
                for (int tt = 0; tt < 4; ++tt) { f32x4 acc = {0.f, 0.f, 0.f, 0.f};
                    acc = MFMA16(a0, ldfrag(Mrb, TSTR, 16 * tt, 0, lane), acc); acc = MFMA16(a1, ldfrag(Mrb, TSTR, 16 * tt, 32, lane), acc);
                    const int tk = 16 * tt + l15, e0 = 16 * et + 4 * q4;
                    const u32x2 q2 = *(const u32x2*)(Rt + tk * TSTR + e0);
                    const float o0 = __uint_as_float(q2.x << 16) - acc[0], o1 = __uint_as_float(q2.x & 0xffff0000u) - acc[1], o2 = __uint_as_float(q2.y << 16) - acc[2], o3 = __uint_as_float(q2.y & 0xffff0000u) - acc[3];
                    *(u32x2*)(gRH + ((size_t)(tt * 2 + (et >> 1)) * 64 + lane) * 8 + (et & 1) * 4) = (u32x2){pk2(o0, o1), pk2(o2, o3)}; }
            }
        }
        {
            const int rt = w & 3;
            bf16_t* Out = part ? gKH : gYH;
            bf16x8 a0, a1, a2, a3;
            if (part) { a0 = ldfrag_tr(Btl, TSTR, 16 * rt, 0, lane); a1 = ldfrag_tr(Btl, TSTR, 16 * rt, 32, lane); a2 = ldfrag_tr(Ktl, TSTR, 16 * rt, 0, lane); a3 = ldfrag_tr(Ktl, TSTR, 16 * rt, 32, lane); }
            else { a0 = ldfrag(Mrb, TSTR, 16 * rt, 0, lane); a1 = ldfrag(Mrb, TSTR, 16 * rt, 32, lane); a2 = ldfrag(Mrk, TSTR, 16 * rt, 0, lane); a3 = ldfrag(Mrk, TSTR, 16 * rt, 32, lane); }
#pragma unroll
            for (int vt = 0; vt < 4; ++vt) { f32x4 acc = {0.f, 0.f, 0.f, 0.f};
                acc = MFMA16(a0, ldfrag(UvT, TSTR, 16 * vt, 0, lane), acc); acc = MFMA16(a1, ldfrag(UvT, TSTR, 16 * vt, 32, lane), acc);
                acc = MFMA16(a2, ldfrag_tr(Vr, TSTR, 16 * vt, 0, lane), acc); acc = MFMA16(a3, ldfrag_tr(Vr, TSTR, 16 * vt, 32, lane), acc);
                *(u32x2*)(Out + ((size_t)(vt * 4 + rt) * 64 + lane) * 4) = (u32x2){pk2(acc[0], acc[1]), pk2(acc[2], acc[3])}; }
        }
    }
    __syncthreads();
}

__device__ __forceinline__ void phase_rprep(const Params& p, int seg, unsigned char* smem) {
    const int blk = obid();
    const int n_items = (CPS + (seg == 0 ? 1 : 0)) * 128;
#pragma unroll 1
    for (int it = (blk + (gridDim.x >> 1)) % gridDim.x; it < n_items; it += gridDim.x) {
        const int bh = it & 127, b = bh >> 4, hb = bh & 15; int cl = it >> 7; if (seg != 0) cl += 1;
        unsigned char* rec = p.ws + WS_RP + (size_t)(cl * 128 + bh) * RP_STRIDE;
        const bf16_t* Pb = (const bf16_t*)(p.ws + WS_P);
        bf16_t* phalo2 = (bf16_t*)(p.ws + WS_PHALO);
        if (cl == 0) rwkv_prep_item(p, smem, hb, LEX0, 48, nullptr, nullptr, rec);
        else {
            const int row = b * SEGTOK + (cl - 1) * 64;
            const bf16_t* prow = Pb + (size_t)(row - 1) * NPB;
            if (cl == 1) prow = (seg == 0) ? Pb + (size_t)(LEX0 + NMETA - 1) * NPB : phalo2 + (size_t)(((seg - 1) & 1) * NBATCH + b) * NPB;
            bf16_t* ho = (cl == CPS) ? phalo2 + (size_t)((seg & 1) * NBATCH + b) * NPB : nullptr;
            rwkv_prep_item(p, smem, hb, row, 0, prow, ho, rec);
        }
    }
}

__device__ __forceinline__ void rwkv_scan_block(const Params& p, int seg, unsigned char* smem, int pairidx) {
    const int tid = otid(), w = tid >> 6, lane = tid & 63, q4 = lane >> 4, l15 = lane & 15;
    const int hsel = w >> 2, vt = w & 3;
    const int bh = pairidx * 2 + hsel, b = bh >> 4, hb = bh & 15;
    float* st = p.out + O_RWKV_P + (size_t)bh * 4096;
    f32x4 S[4];
    if (seg) {
#pragma unroll
        for (int mt = 0; mt < 4; ++mt) S[mt] = *(const f32x4*)(st + (size_t)(16 * vt + l15) * 64 + 16 * mt + 4 * q4);
    } else {
#pragma unroll
        for (int mt = 0; mt < 4; ++mt) S[mt] = (f32x4){0.f, 0.f, 0.f, 0.f};
    }
    const int c_lo = seg ? 1 : 0;
    float* ybuf = (float*)(smem + 65536) + hsel * (64 * 68);
    const int tl = tid & 255;
    {
        const u32x4* src = (const u32x4*)(p.ws + WS_RP + (size_t)(c_lo * 128 + bh) * RP_STRIDE); u32x4* dst = (u32x4*)(smem + hsel * 16384);
#pragma unroll
        for (int x = 0; x < 4; ++x) dst[tl + 256 * x] = src[tl + 256 * x];
    }
#pragma unroll 1
    for (int cl = c_lo; cl <= CPS; ++cl) {
        const unsigned char* rec = p.ws + WS_RP + (size_t)(cl * 128 + bh) * RP_STRIDE;
        const int cur = (cl - c_lo) & 1;
        __syncthreads();
        u32x4 nx[4];
        const bool more = cl < CPS;
        if (more) { const u32x4* src = (const u32x4*)(rec + (size_t)RP_STRIDE * 128);
#pragma unroll
            for (int x = 0; x < 4; ++x) nx[x] = src[tl + 256 * x]; }
        const bf16_t* gKH = (const bf16_t*)(rec + RP_KH); const bf16_t* gYH = (const bf16_t*)(rec + RP_YH);
        u32x2 kh[4], yh[4]; f32x4 pc[4];
#pragma unroll
        for (int mt = 0; mt < 4; ++mt) { kh[mt] = *(const u32x2*)(gKH + ((size_t)(vt * 4 + mt) * 64 + lane) * 4); yh[mt] = *(const u32x2*)(gYH + ((size_t)(vt * 4 + mt) * 64 + lane) * 4);
            pc[mt] = *(const f32x4*)((const float*)(rec + RP_PC) + 16 * mt + 4 * q4); }
        const int tk = tl >> 2, g = tl & 3;
        u32x4 a0 = {0u, 0u, 0u, 0u}, a1 = a0, b0 = a0, b1 = a0;
        if (cl > 0) { const bf16_t* c1p = (const bf16_t*)(rec + RP_C1) + tk * 64 + 16 * g; const bf16_t* c0p = (const bf16_t*)(rec + RP_C0) + tk * 64 + 16 * g;
            a0 = *(const u32x4*)c0p; a1 = *(const u32x4*)(c0p + 8); b0 = *(const u32x4*)c1p; b1 = *(const u32x4*)(c1p + 8); }
        bf16x8 Bf[2];
#pragma unroll
        for (int ks = 0; ks < 2; ++ks) { u32x4 tq; tq.x = pk2(S[2 * ks][0], S[2 * ks][1]); tq.y = pk2(S[2 * ks][2], S[2 * ks][3]); tq.z = pk2(S[2 * ks + 1][0], S[2 * ks + 1][1]); tq.w = pk2(S[2 * ks + 1][2], S[2 * ks + 1][3]);
            Bf[ks] = __builtin_bit_cast(bf16x8, tq); }
        const bf16x8* AP = (const bf16x8*)(smem + cur * 32768 + hsel * 16384); const bf16x8* RH = (const bf16x8*)(smem + cur * 32768 + hsel * 16384 + RP_RH);
        f32x4 y[4], tS[4];
#pragma unroll
        for (int tt = 0; tt < 4; ++tt) { y[tt] = (f32x4){0.f, 0.f, 0.f, 0.f}; y[tt] = MFMA16(RH[(tt * 2 + 0) * 64 + lane], Bf[0], y[tt]); y[tt] = MFMA16(RH[(tt * 2 + 1) * 64 + lane], Bf[1], y[tt]); }
#pragma unroll
        for (int mt = 0; mt < 4; ++mt) { tS[mt] = (f32x4){0.f, 0.f, 0.f, 0.f}; tS[mt] = MFMA16(AP[(mt * 2 + 0) * 64 + lane], Bf[0], tS[mt]); tS[mt] = MFMA16(AP[(mt * 2 + 1) * 64 + lane], Bf[1], tS[mt]); }
#pragma unroll
        for (int mt = 0; mt < 4; ++mt) {
            S[mt][0] = pc[mt][0] * S[mt][0] + tS[mt][0] + __uint_as_float(kh[mt].x << 16); S[mt][1] = pc[mt][1] * S[mt][1] + tS[mt][1] + __uint_as_float(kh[mt].x & 0xffff0000u);
            S[mt][2] = pc[mt][2] * S[mt][2] + tS[mt][2] + __uint_as_float(kh[mt].y << 16); S[mt][3] = pc[mt][3] * S[mt][3] + tS[mt][3] + __uint_as_float(kh[mt].y & 0xffff0000u); }
        if (cl > 0) {
#pragma unroll
            for (int tt = 0; tt < 4; ++tt) {
                y[tt][0] += __uint_as_float(yh[tt].x << 16); y[tt][1] += __uint_as_float(yh[tt].x & 0xffff0000u); y[tt][2] += __uint_as_float(yh[tt].y << 16); y[tt][3] += __uint_as_float(yh[tt].y & 0xffff0000u);
#pragma unroll
                for (int r = 0; r < 4; ++r) ybuf[(16 * tt + 4 * q4 + r) * 68 + 16 * vt + l15] = y[tt][r]; }
        }
        if (more) { u32x4* dst = (u32x4*)(smem + (cur ^ 1) * 32768 + hsel * 16384);
#pragma unroll
            for (int x = 0; x < 4; ++x) dst[tl + 256 * x] = nx[x]; }
        if (cl > 0) {
            __syncthreads();
            f32x4 yv[4]; float sm = 0.f;
#pragma unroll
            for (int j = 0; j < 4; ++j) { yv[j] = *(const f32x4*)(ybuf + tk * 68 + 16 * g + 4 * j); sm += yv[j][0] + yv[j][1] + yv[j][2] + yv[j][3]; }
            sm += __shfl_xor(sm, 1); sm += __shfl_xor(sm, 2);
            const float mu = sm * (1.f / 64.f); float vs = 0.f;
#pragma unroll
            for (int j = 0; j < 4; ++j) { yv[j] = yv[j] - mu; vs += yv[j][0] * yv[j][0] + yv[j][1] * yv[j][1] + yv[j][2] * yv[j][2] + yv[j][3] * yv[j][3]; }
            vs += __shfl_xor(vs, 1); vs += __shfl_xor(vs, 2);
            const float rs = __builtin_amdgcn_rsqf(vs * (1.f / 64.f) + 64e-5f);
            const unsigned c0w[8] = {a0.x, a0.y, a0.z, a0.w, a1.x, a1.y, a1.z, a1.w}, c1w[8] = {b0.x, b0.y, b0.z, b0.w, b1.x, b1.y, b1.z, b1.w};
            unsigned ow[8];
#pragma unroll
            for (int j = 0; j < 8; ++j) ow[j] = pk2(yv[j >> 1][(j & 1) * 2] * rs * __uint_as_float(c1w[j] << 16) + __uint_as_float(c0w[j] << 16),
                                                     yv[j >> 1][(j & 1) * 2 + 1] * rs * __uint_as_float(c1w[j] & 0xffff0000u) + __uint_as_float(c0w[j] & 0xffff0000u));
            const size_t grow = (size_t)b * SEQ + seg * SEGTOK + (cl - 1) * 64 + tk;
            bf16_t* ob = (bf16_t*)(p.ws + WS_OB) + grow * D + hb * 64 + 16 * g;
            *(u32x4*)ob = (u32x4){ow[0], ow[1], ow[2], ow[3]}; *(u32x4*)(ob + 8) = (u32x4){ow[4], ow[5], ow[6], ow[7]};
        }
    }
#pragma unroll
    for (int mt = 0; mt < 4; ++mt) *(f32x4*)(st + (size_t)(16 * vt + l15) * 64 + 16 * mt + 4 * q4) = S[mt];
    __syncthreads();
}

__device__ __forceinline__ void gdn_sample_item(const Params& p, unsigned char* smem, int bs, int h) {
    const int tid = otid(), w = tid >> 6, lane = tid & 63, kq = tid >> 7, v = tid & 127;
    float* qk_s = (float*)smem; float* v_s = qk_s + 1024; float* gb_s = v_s + 512; float* part = gb_s + 16; float* part2 = part + 512;
    const bf16_t* P = (const bf16_t*)(p.ws + WS_P);
    const float* pk = (const float*)(p.ws + WS_PK);
    const float* s_in = p.in[2] + (size_t)(bs * 8 + h) * 16384; float* s_out = p.out + O_GDN_S + (size_t)(bs * 8 + h) * 16384;
    const int row0 = LEX0 + EX_SAMP + bs * DECT;
    float s[32];
#pragma unroll
    for (int j = 0; j < 32; ++j) s[j] = s_in[(size_t)(kq * 32 + j) * 128 + v];
    if (tid < 384) {
        const int pcol = (tid >> 7) * 1024 + h * 128 + (tid & 127);
        const float* cw = pk + PK_CONVW; const float* hin = p.in[3] + (size_t)bs * 9216; float* hout = p.out + O_CONV_S + (size_t)bs * 9216;
        const float cw0 = cw[pcol], cw1 = cw[3072 + pcol], cw2 = cw[6144 + pcol], cw3 = cw[9216 + pcol];
        float x3 = hin[pcol], x2 = hin[3072 + pcol], x1 = hin[6144 + pcol];
        float xr[4];
#pragma unroll
        for (int i = 0; i < 4; ++i) xr[i] = bf2f(P[(size_t)(row0 + i) * NPB + pcol]);
#pragma unroll
        for (int i = 0; i < 4; ++i) { const float y = cw0 * x3 + cw1 * x2 + cw2 * x1 + cw3 * xr[i]; x3 = x2; x2 = x1; x1 = xr[i];
            if (tid < 256) qk_s[i * 256 + tid] = silu_(y); else v_s[i * 128 + (tid - 256)] = silu_(y); }
        hout[pcol] = x3; hout[3072 + pcol] = x2; hout[6144 + pcol] = x1;
    } else if (tid < 388) {
        const int i = tid - 384; const size_t r = (size_t)(row0 + i) * NPB;
        const float pa = bf2f(P[r + C_A + h]), pb = bf2f(P[r + C_B + h]);
        gb_s[2 * i] = __expf(-expf(pk[PK_ALOG + h]) * softplus_(pa + pk[PK_DTB + h])); gb_s[2 * i + 1] = sigm(pb);
    }
    __syncthreads();
    { const int i = w >> 1, which = w & 1; float* rp = qk_s + i * 256 + which * 128; const float a = rp[lane], b = rp[lane + 64];
      const float sc = __builtin_amdgcn_rsqf(wave_sum(a * a + b * b) + 1e-6f) * (which == 0 ? 0.08838834764831845f : 1.f); rp[lane] = a * sc; rp[lane + 64] = b * sc; }
    __syncthreads();
#pragma unroll 1
    for (int i = 0; i < 4; ++i) {
        const float* kp = qk_s + i * 256 + 128 + kq * 32; const float* qp = qk_s + i * 256 + kq * 32;
        float pa = 0.f;
#pragma unroll
        for (int j4 = 0; j4 < 8; ++j4) { const f32x4 k4 = *(const f32x4*)(kp + 4 * j4); pa += k4[0] * s[4 * j4] + k4[1] * s[4 * j4 + 1] + k4[2] * s[4 * j4 + 2] + k4[3] * s[4 * j4 + 3]; }
        part[kq * 128 + v] = pa;
        __syncthreads();
        const float kS = part[v] + part[128 + v] + part[256 + v] + part[384 + v];
        const float a = gb_s[2 * i], c = gb_s[2 * i + 1] * (v_s[i * 128 + v] - a * kS);
        float po = 0.f;
#pragma unroll
        for (int j4 = 0; j4 < 8; ++j4) { const f32x4 k4 = *(const f32x4*)(kp + 4 * j4), q4v = *(const f32x4*)(qp + 4 * j4);
#pragma unroll
            for (int e = 0; e < 4; ++e) { s[4 * j4 + e] = a * s[4 * j4 + e] + k4[e] * c; po += q4v[e] * s[4 * j4 + e]; } }
        part2[kq * 128 + v] = po;
        __syncthreads();
        if (kq == 0) ((float*)(p.ws + WS_ORAW))[(size_t)(row0 + i) * D + h * 128 + v] = part2[v] + part2[128 + v] + part2[256 + v] + part2[384 + v];
    }
#pragma unroll
    for (int j = 0; j < 32; ++j) s_out[(size_t)(kq * 32 + j) * 128 + v] = s[j];
    __syncthreads();
}

constexpr int SR_R = 0, SR_KK = 4096, SR_V = 8192, SR_ZB = 12288, SR_DEC = 16384, SR_KA = 20480, SR_KM = 24576, SR_WD = 28672, SR_AD = 28928, SR_RK = 29184;
__device__ __forceinline__ void rwkv_sample_item(const Params& p, unsigned char* smem, int bs) {
    const int tid = otid(), w = tid >> 6, lane = tid & 63;
    float* f = (float*)smem;
    const bf16_t* P = (const bf16_t*)(p.ws + WS_P);
    const float* pk = (const float*)(p.ws + WS_PK);
    const int row0 = LEX0 + EX_SAMP + bs * DECT;
    const bf16_t* prow = P + (size_t)(LEX0 + EX_SHIFT + bs) * NPB + C_RW;
#pragma unroll 1
    for (int col = tid; col < RW_SHIFT; col += 512) {
        const float mu = pk[PK_MU + col]; float prev = bf2f(prow[col]);
        float cur[4];
#pragma unroll
        for (int i = 0; i < 4; ++i) cur[i] = bf2f(P[(size_t)(row0 + i) * NPB + C_RW + col]);
        float* dst; int stride = 1024; bool th = false;
        if (col < 1024) dst = f + SR_R + col; else if (col < 2048) dst = f + SR_KK + (col - 1024); else if (col < 3072) dst = f + SR_V + (col - 2048);
        else if (col < 3136) { dst = f + SR_WD + (col - 3072); stride = 64; th = true; } else if (col < 3200) { dst = f + SR_AD + (col - 3136); stride = 64; } else dst = f + SR_ZB + (col - 3200);
#pragma unroll
        for (int i = 0; i < 4; ++i) { float m = cur[i] + mu * (prev - cur[i]); prev = cur[i]; if (th) m = tanh_(m); dst[i * stride] = m; }
    }
    __syncthreads();
#pragma unroll 1
    for (int cc = 0; cc < 2; ++cc) {
        const int c = tid + 512 * cc;
        float aw[4] = {0.f, 0.f, 0.f, 0.f}, aa[4] = {0.f, 0.f, 0.f, 0.f};
#pragma unroll 16
        for (int l = 0; l < 64; ++l) { const float w2v = pk[PK_W2 + l * D + c], a2v = pk[PK_A2 + l * D + c];
#pragma unroll
            for (int i = 0; i < 4; ++i) { aw[i] += f[SR_WD + i * 64 + l] * w2v; aa[i] += f[SR_AD + i * 64 + l] * a2v; } }
        const float w0c = pk[PK_W0 + c], a0c = pk[PK_A0 + c], kkc = pk[PK_KK + c], kac = pk[PK_KA + c];
#pragma unroll
        for (int i = 0; i < 4; ++i) { const float a = sigm(a0c + aa[i]); const float kbv = f[SR_KK + i * 1024 + c];
            f[SR_DEC + i * 1024 + c] = __expf(-0.6065306597126334f * sigm(w0c + aw[i])); f[SR_KA + i * 1024 + c] = a; f[SR_KK + i * 1024 + c] = kbv * kkc; f[SR_KM + i * 1024 + c] = kbv * (1.f + (a - 1.f) * kac); }
    }
    __syncthreads();
#pragma unroll 1
    for (int x = 0; x < 8; ++x) { const int pr = w * 8 + x, i = pr >> 4, hh = pr & 15; const int o = i * 1024 + hh * 64 + lane;
        const float kr = f[SR_KK + o]; const float kk = kr * __builtin_amdgcn_rsqf(wave_sum(kr * kr) + 1e-6f); f[SR_KK + o] = kk; f[SR_KA + o] = kk * f[SR_KA + o];
        const float rkv = wave_sum(f[SR_R + o] * f[SR_KM + o] * pk[PK_RK + hh * 64 + lane]); if (lane == 0) f[SR_RK + pr] = rkv; }
    __syncthreads();
#pragma unroll 1
    for (int hp = 0; hp < 2; ++hp) {
        const int hb = hp * 8 + w;
        const float* s_in = p.in[4] + (size_t)(bs * 16 + hb) * 4096 + (size_t)lane * 64; float* s_out = p.out + O_RWKV_S + (size_t)(bs * 16 + hb) * 4096 + (size_t)lane * 64;
        f32x4 S[16];
#pragma unroll
        for (int j = 0; j < 16; ++j) S[j] = *(const f32x4*)(s_in + 4 * j);
        const int cch = hb * 64 + lane;
        const float gnw = pk[PK_GNW + cch], gnb = pk[PK_GNB + cch];
#pragma unroll 1
        for (int i = 0; i < 4; ++i) {
            const int o = i * 1024 + hb * 64;
            const float vv = f[SR_V + o + lane], rk = f[SR_RK + i * 16 + hb];
            float sa = 0.f;
#pragma unroll
            for (int j = 0; j < 16; ++j) { const f32x4 kk4 = *(const f32x4*)(f + SR_KK + o + 4 * j); sa += S[j][0] * kk4[0] + S[j][1] * kk4[1] + S[j][2] * kk4[2] + S[j][3] * kk4[3]; }
            float y = 0.f;
#pragma unroll
            for (int j = 0; j < 16; ++j) { const f32x4 de4 = *(const f32x4*)(f + SR_DEC + o + 4 * j), ka4 = *(const f32x4*)(f + SR_KA + o + 4 * j), km4 = *(const f32x4*)(f + SR_KM + o + 4 * j), r4 = *(const f32x4*)(f + SR_R + o + 4 * j);
#pragma unroll
                for (int e = 0; e < 4; ++e) { S[j][e] = S[j][e] * de4[e] + (vv * km4[e] - sa * ka4[e]); y += S[j][e] * r4[e]; } }
            const float mu = wave_sum(y) * (1.f / 64.f); const float dy = y - mu;
            const float rs = __builtin_amdgcn_rsqf(wave_sum(dy * dy) * (1.f / 64.f) + 64e-5f);
            const float ov = (dy * rs * gnw + gnb + rk * vv) * silu_(f[SR_ZB + i * 1024 + cch]);
            ((bf16_t*)(p.ws + WS_OB))[(size_t)(XROWS + EX_SAMP + bs * DECT + i) * D + cch] = (bf16_t)f2bf(ov);
        }
#pragma unroll
        for (int j = 0; j < 16; ++j) *(f32x4*)(s_out + 4 * j) = S[j];
    }
    __syncthreads();
}

__device__ __forceinline__ void phase2(const Params& p, int seg, unsigned char* smem) {
    const int blk = obid();
    float* out = p.out;
    float* chalo = (float*)(p.ws + WS_CHALO); float* phalo = (float*)(p.ws + WS_PHALO);
#ifndef SUB
#define SUB 0
#endif
#define SEN(x) (SUB == 0 || SUB == (x))
    if (SEN(1) && blk < 64) gdn_scan_block(p, seg, smem, blk);
    if (SEN(3) && blk >= 64 && blk < 128) rwkv_scan_block(p, seg, smem, blk - 64);
#ifndef DUP
#define DUP 0
#endif
    if (seg == 0) {
#pragma unroll 1
        for (int it = blk; it < DECB * 8; it += gridDim.x) gdn_sample_item(p, smem, it >> 3, it & 7);
#pragma unroll 1
        for (int it = blk; it < DECB; it += gridDim.x) rwkv_sample_item(p, smem, it);
    }
}

__device__ __forceinline__ void phase25(const Params& p, int seg) {
    const int tid0 = otid(); const int lane = tid0 & 63; const int gw = obid() * 8 + (tid0 >> 6), NGW = gridDim.x * 8;
    const bf16_t* P = (const bf16_t*)(p.ws + WS_P);
    const float* ORAW = (const float*)(p.ws + WS_ORAW); const float* YRAW = (const float*)(p.ws + WS_YRAW);
    const bf16_t* C0 = (const bf16_t*)(p.ws + WS_C0); const bf16_t* C1 = (const bf16_t*)(p.ws + WS_C1);
    bf16_t* OA = (bf16_t*)(p.ws + WS_H); bf16_t* OB = (bf16_t*)(p.ws + WS_OB);
    const int nrows = LEX0 + (seg == 0 ? DECB * DECT : 0);
    const int c = lane * 16;
    f32x4 nw[4];
#pragma unroll
    for (int j = 0; j < 4; ++j) nw[j] = *(const f32x4*)((const float*)(p.ws + WS_PK) + PK_NORMW + (c & 127) + 4 * j);
#pragma unroll 1
    for (int rr = LEX0 + gw; rr < nrows; rr += NGW) {
        int lr; size_t grow;
        if (rr < LEX0) { lr = rr; grow = (size_t)(rr / SEGTOK) * SEQ + seg * SEGTOK + (rr % SEGTOK); } else { lr = LEX0 + EX_SAMP + (rr - LEX0); grow = (size_t)XROWS + EX_SAMP + (rr - LEX0); }
        {
            f32x4 o[4]; float ss = 0.f;
#pragma unroll
            for (int j = 0; j < 4; ++j) { o[j] = *(const f32x4*)(ORAW + (size_t)lr * D + c + 4 * j); ss += o[j][0] * o[j][0] + o[j][1] * o[j][1] + o[j][2] * o[j][2] + o[j][3] * o[j][3]; }
            ss += __shfl_xor(ss, 1); ss += __shfl_xor(ss, 2); ss += __shfl_xor(ss, 4);
            const float rs = __builtin_amdgcn_rsqf(ss * (1.f / 128.f) + 1e-6f);
            const u32x4 z0 = *(const u32x4*)(P + (size_t)lr * NPB + C_Z + c), z1 = *(const u32x4*)(P + (size_t)lr * NPB + C_Z + c + 8);
            const unsigned zz[8] = {z0.x, z0.y, z0.z, z0.w, z1.x, z1.y, z1.z, z1.w};
            unsigned ow[8];
#pragma unroll
            for (int j = 0; j < 8; ++j) { const float za = __uint_as_float(zz[j] << 16), zb = __uint_as_float(zz[j] & 0xffff0000u);
                const float a = o[j >> 1][(j & 1) * 2] * rs * nw[j >> 1][(j & 1) * 2] * silu_(za), b = o[j >> 1][(j & 1) * 2 + 1] * rs * nw[j >> 1][(j & 1) * 2 + 1] * silu_(zb);
                ow[j] = pk2(a, b); }
            *(u32x4*)(OA + grow * D + c) = (u32x4){ow[0], ow[1], ow[2], ow[3]}; *(u32x4*)(OA + grow * D + c + 8) = (u32x4){ow[4], ow[5], ow[6], ow[7]};
        }
    }
}

__device__ __forceinline__ void phase_final(const Params& p) {
    const int tid0 = otid(); const int lane = tid0 & 63; const int gw = obid() * 8 + (tid0 >> 6), NGW = gridDim.x * 8;
    const f32x4* wr = (const f32x4*)((const float*)(p.ws + WS_PK) + PK_LNF) + lane;
    f32x4 wv[4];
#pragma unroll
    for (int j = 0; j < 4; ++j) wv[j] = wr[64 * j];
    constexpr int NR = XROWS + DECB * DECT;
#pragma unroll 1
    for (int r = gw; r < NR; r += 4 * NGW) {
        f32x4* xr[4]; bool has[4]; f32x4 v[4][4]; float ss[4];
#pragma unroll
        for (int q = 0; q < 4; ++q) { const int rq = r + q * NGW; has[q] = rq < NR; xr[q] = (f32x4*)(p.out + (size_t)(has[q] ? rq : r) * D) + lane; }
#pragma unroll
        for (int q = 0; q < 4; ++q)
#pragma unroll
            for (int j = 0; j < 4; ++j) v[q][j] = xr[q][64 * j];
#pragma unroll
        for (int q = 0; q < 4; ++q) { float s0 = 0.f;
#pragma unroll
            for (int j = 0; j < 4; ++j) s0 += v[q][j][0] * v[q][j][0] + v[q][j][1] * v[q][j][1] + v[q][j][2] * v[q][j][2] + v[q][j][3] * v[q][j][3];
            ss[q] = s0; }
#pragma unroll
        for (int q = 0; q < 4; ++q) { const float qs = __builtin_amdgcn_rsqf(wave_sum(ss[q]) * (1.f / D) + 1e-6f);
            if (has[q]) {
#pragma unroll
                for (int j = 0; j < 4; ++j) xr[q][64 * j] = v[q][j] * qs * wv[j]; } }
    }
}

__global__ __launch_bounds__(512, 2) void hybrid_mega(Params p) {
    extern __shared__ __attribute__((aligned(16))) unsigned char smem[];
    cg::grid_group grid = cg::this_grid();
    LAS unsigned char* lds = (LAS unsigned char*)smem;
    const int G = gridDim.x;
    volatile LAS unsigned* xst = (volatile LAS unsigned*)(lds + (LDS_TOTAL - 16));
    if (threadIdx.x == 0) { xst[0] = 0u; xst[1] = 0u; }
    __syncthreads();
    (void)xcd_barrier_post((unsigned*)(p.ws + WS_BAR), xst);
    if (G == 0x7fffffff) grid.sync();
#define GSYNC() do { XcdBarrier xb_; xb_.bar = (unsigned*)(p.ws + WS_BAR); xb_.x = xb_xcc_id(); xb_.st = (volatile LAS unsigned*)((LAS unsigned char*)smem + (LDS_TOTAL - 16)); xcd_barrier(xb_); } while (0)

#ifndef ONLY
#define ONLY 0
#endif
#define EN(x) (ONLY == 0 || ONLY == (x))
    if (EN(1)) phase0(p, smem);
    GSYNC();
#pragma unroll 1
    for (int it = 0; it <= NSEG + 2; ++it) {
        const int xblk = obid() - (G - 12);
        const bool xrole = xblk >= 0;
        if (it > 0 && it <= NSEG && EN(3)) phase2(p, it - 1, smem);
        if ((((it == 2 || it == 3) && xrole) || it == NSEG + 1) && EN(5)) {
            const bool ex = it <= 3;
            SchedAB S; S.ob.init(ex ? 3 : XROWS / 256, 4, ex ? 12 : G, ex ? xblk : obid()); S.pm0 = ex ? XROWS / 256 : 0; S.wfix = ex ? it - 2 : -1;
            S.A0 = (const char*)(p.ws + WS_H); S.A1 = (const char*)(p.ws + WS_OB); S.B0 = (const char*)(p.ws + WS_WT_A); S.B1 = (const char*)(p.ws + WS_WT_B);
            EpiAB E; E.tmp = ex ? (bf16_t*)(p.ws + WS_YRAW) - (size_t)XROWS * D : (bf16_t*)(p.ws + WS_P); E.merged = ex ? (bf16_t*)(p.ws + WS_C0) - (size_t)XROWS * D : (bf16_t*)(p.ws + WS_MG);
            E.gex = (const bf16_t*)(p.ws + WS_GEX); E.out = p.out; E.pairmode = ex ? 0 : 1;
            pg8::gemm_phase<EpiAB, SchedAB>(lds, D, S, E);
        }
        if (((it == 4 && xrole) || it == NSEG + 2) && EN(6)) {
            const bool ex = it == 4;
            SchedO S; S.ob.init(ex ? 3 : XROWS / 256, 4, ex ? 12 : G, ex ? xblk : obid()); S.pm0 = ex ? XROWS / 256 : 0;
            S.A = ex ? (const char*)((bf16_t*)(p.ws + WS_C0) - (size_t)XROWS * D) : (const char*)(p.ws + WS_MG); S.B = (const char*)(p.ws + WS_WT_O);
            EpiO E; E.out = p.out; E.xp = p.in[0]; E.xs = p.in[1];
            pg8::gemm_phase<EpiO, SchedO>(lds, D, S, E);
        }
        const bool xphase = it >= 2 && it <= 4;
        if (it < NSEG && EN(2) && !(xphase && xrole)) {
            const int seg = it;
            const int Gp = xphase ? G - 12 : G;
            const int cidx = it > 0 ? (obid() + (Gp >> 1)) % Gp : obid();
            SchedIn S; S.ob.init(seg == 0 ? LT_PROMPT + 3 : LT_PROMPT, NT_IN, Gp, cidx); S.seg = seg; S.A = (const char*)(p.ws + WS_H); S.B = (const char*)(p.ws + WS_WT_IN);
            EpiIn E; E.P = (bf16_t*)(p.ws + WS_P); E.gex = (bf16_t*)(p.ws + WS_GEX); E.out = p.out; E.seg = seg;
            pg8::gemm_phase<EpiIn, SchedIn>(lds, D, S, E);
        }
        {
            const int hlo = 208, hhi = (it >= 2 && it <= 4) ? G - 12 : G;
            if (it >= 1 && it + 1 < NSEG && obid() >= hlo && obid() < hhi) { const int t0 = otid(); h_rows_segs(p, it + 1, it + 2, (obid() - hlo) * 8 + (t0 >> 6), (hhi - hlo) * 8, t0 & 63); }
        }
        GSYNC();
        if (it < NSEG) {
            if (EN(8)) { phase_gprep(p, it, smem); phase_rprep(p, it, smem); }
            if (it == 1 && EN(4)) phase25(p, 0);
            GSYNC();
        }
    }
    if (EN(7)) phase_final(p);
}

extern "C" void kernel_launch(void* const* d_in, const int* in_sizes, int n_in, void* d_out, int out_size, void* d_ws, size_t ws_size, hipStream_t stream) {
    static int grid_blocks = 0;
    constexpr int LDS_BYTES = LDS_TOTAL;
    if (grid_blocks == 0) {
        if (n_in != 27 || ws_size < WS_END) { fprintf(stderr, "kernel_launch: unexpected n_in %d / ws %zu (need %zu)\n", n_in, ws_size, (size_t)WS_END); grid_blocks = -1; return; }
        if (hipFuncSetAttribute((const void*)hybrid_mega, hipFuncAttributeMaxDynamicSharedMemorySize, LDS_BYTES) != hipSuccess) { fprintf(stderr, "kernel_launch: hipFuncSetAttribute failed\n"); grid_blocks = -1; return; }
        int dev = 0, cus = 0, per_cu = 0;
        hipGetDevice(&dev);
        hipDeviceGetAttribute(&cus, hipDeviceAttributeMultiprocessorCount, dev);
        hipOccupancyMaxActiveBlocksPerMultiprocessor(&per_cu, (const void*)hybrid_mega, 512, LDS_BYTES);
        if (per_cu < 1) { fprintf(stderr, "kernel_launch: occupancy query says %d blocks/CU\n", per_cu); per_cu = 1; }
        (void)hipGetLastError();
        grid_blocks = cus;
    }
    if (grid_blocks < 0) return;
    Params p{};
    for (int i = 0; i < 27; ++i) p.in[i] = (const float*)d_in[i];
    p.out = (float*)d_out; p.ws = (unsigned char*)d_ws;
    if (hipMemsetAsync((unsigned char*)d_ws + WS_BAR, 0, 16384, stream) != hipSuccess) { fprintf(stderr, "kernel_launch: memset of the barrier words failed\n"); return; }
    void* args[] = {&p};
    hipError_t e = hipLaunchCooperativeKernel((const void*)hybrid_mega, dim3(grid_blocks), dim3(512), args, LDS_BYTES, stream);
    if (e != hipSuccess) fprintf(stderr, "cooperative launch failed: %s (grid %d)\n", hipGetErrorString(e), grid_blocks);
}
```

```cpp
#include <hip/hip_runtime.h>
#include <hip/hip_cooperative_groups.h>
#include <cstdio>
namespace cg = cooperative_groups;

#define LAS __attribute__((address_space(3)))
typedef unsigned short bf16_t;
typedef short bf16x8 __attribute__((ext_vector_type(8)));
typedef float f32x4 __attribute__((ext_vector_type(4)));
typedef unsigned u32x4 __attribute__((ext_vector_type(4)));
typedef unsigned u32x2 __attribute__((ext_vector_type(2)));

constexpr int D = 1024;
constexpr int NBATCH = 8, SEQ = 2048, NMETA = 16, DECB = 128, DECT = 4;
constexpr int XROWS = NBATCH * SEQ;
constexpr int EX_SAMP = 16, EX_SHIFT = 528, EX_END = 656;
constexpr int HROWS = 17152, HTILES = 67;
constexpr int NSEG = 8, SEGTOK = SEQ / NSEG;
constexpr int CPS = SEGTOK / 64;
constexpr int TPB = SEGTOK / 256;
constexpr int LT_PROMPT = NBATCH * TPB;
constexpr int LEX0 = LT_PROMPT * 256;
constexpr int LROWS = LEX0 + 768;
constexpr int NP = 10496, NPB = 8448, NT_IN = 41, NT_PB = 33;
constexpr int C_A = 3072, C_B = 3080, C_Z = 3088, C_RW = 4112, C_GATE_REF = 8336;
constexpr int RW_SHIFT = 4224;

constexpr size_t O_YP = 0, O_YS = 16777216, O_GDN_P = 17301504, O_CONV_P = 18350080, O_RWKV_P = 18423808, O_SHIFT_P = 18948096,
                 O_GDN_S = 18956288, O_CONV_S = 35733504, O_RWKV_S = 36913152, O_SHIFT_S = 45301760;

constexpr size_t al256(size_t x) { return (x + 255) & ~(size_t)255; }
constexpr size_t WS_WT_IN = 0;
constexpr size_t WS_WT_A = al256(WS_WT_IN + (size_t)NP * D * 2);
constexpr size_t WS_WT_B = al256(WS_WT_A + (size_t)D * D * 2);
constexpr size_t WS_WT_O = al256(WS_WT_B + (size_t)D * D * 2);
constexpr size_t WS_H = al256(WS_WT_O + (size_t)D * D * 2);
constexpr size_t WS_OB = al256(WS_H + (size_t)HROWS * D * 2);
constexpr size_t WS_P = al256(WS_OB + (size_t)HROWS * D * 2);
constexpr size_t WS_ORAW = al256(WS_P + (size_t)LROWS * NPB * 2);
constexpr size_t WS_YRAW = al256(WS_ORAW + (size_t)LROWS * D * 4);
constexpr size_t WS_C0 = al256(WS_YRAW + (size_t)LROWS * D * 4);
constexpr size_t WS_C1 = al256(WS_C0 + (size_t)LROWS * D * 2);
constexpr size_t WS_GEX = al256(WS_C1 + (size_t)LROWS * D * 2);
constexpr size_t WS_CHALO = al256(WS_GEX + (size_t)768 * 2048 * 2);
constexpr size_t WS_PHALO = al256(WS_CHALO + (size_t)2 * NBATCH * 3 * NPB * 2);
constexpr size_t WS_PK = al256(WS_PHALO + (size_t)2 * NBATCH * NPB * 2);
constexpr int PK_CONVW = 0, PK_ALOG = 12288, PK_DTB = 12296, PK_NORMW = 12304, PK_MU = 12432, PK_W0 = 16656, PK_W2 = 17680, PK_A0 = 83216, PK_A2 = 84240,
              PK_KK = 149776, PK_KA = 150800, PK_RK = 151824, PK_GNW = 152848, PK_GNB = 153872, PK_LNF = 154896, PK_END = 155920;
constexpr size_t WS_BAR = al256(WS_PK + (size_t)PK_END * 4);
constexpr int BAR_CNT_OFF = 14336;
constexpr size_t WS_XCH = al256(WS_BAR + 16384);
constexpr size_t WS_W2T = al256(WS_XCH + (size_t)HTILES * 256 * 4 * 4);
constexpr size_t WS_A2T = al256(WS_W2T + 131072);
constexpr size_t WS_GP = al256(WS_A2T + 131072);
constexpr int GP_AP = 0, GP_QH = 32768, GP_KH = 49152, GP_OH = 81920, GP_EGL = 98304, GP_G = 98560, GP_STRIDE = 114944;
constexpr int RP_AP = 0, RP_RH = 8192, RP_KH = 16384, RP_YH = 24576, RP_C1 = 32768, RP_C0 = 40960, RP_PC = 49152, RP_STRIDE = 49408;
constexpr size_t WS_RP = al256(WS_GP + (size_t)(CPS + 1) * 64 * GP_STRIDE);
constexpr size_t WS_END = al256(WS_RP + (size_t)(CPS + 1) * 128 * RP_STRIDE);
constexpr size_t WS_MG = WS_GP;
static_assert((size_t)HROWS * D * 2 <= WS_END - WS_GP, "MERGED must fit in the prep records");
static_assert((size_t)HROWS * D * 4 <= (size_t)LROWS * NPB * 2 + 2 * (size_t)LROWS * D * 4, "TMP must fit in P+ORAW+YRAW");
static_assert(WS_END <= (size_t)268435456, "workspace");

constexpr int LDS_TOTAL = 163840;
struct Params { const float* in[27]; float* out; unsigned char* ws; };

__device__ __forceinline__ float bf2f(bf16_t v) { return __uint_as_float(((unsigned)v) << 16); }
typedef __bf16 bf16n2 __attribute__((ext_vector_type(2)));
typedef float f32n2 __attribute__((ext_vector_type(2)));
__device__ __forceinline__ unsigned cvt_pk_bf16(float lo, float hi) { const f32n2 v = {lo, hi}; return __builtin_bit_cast(unsigned, __builtin_convertvector(v, bf16n2)); }
__device__ __forceinline__ unsigned pk2(float lo, float hi) { return cvt_pk_bf16(lo, hi); }
__device__ __forceinline__ unsigned f2bf(float f) { return cvt_pk_bf16(f, 0.f) & 0xffffu; }
__device__ __forceinline__ float sigm(float x) { return __builtin_amdgcn_rcpf(1.f + __expf(-x)); }
__device__ __forceinline__ float silu_(float x) { return x * __builtin_amdgcn_rcpf(1.f + __expf(-x)); }
__device__ __forceinline__ float softplus_(float x) { return fmaxf(x, 0.f) + log1pf(expf(-fabsf(x))); }
__device__ __forceinline__ float wave_sum(float v) {
#pragma unroll
    for (int o = 1; o < 64; o <<= 1) v += __shfl_xor(v, o);
    return v;
}
__device__ __forceinline__ void unpack8(const u32x4 rw, float (&x)[8]) {
    x[0] = __uint_as_float(rw.x << 16); x[1] = __uint_as_float(rw.x & 0xffff0000u); x[2] = __uint_as_float(rw.y << 16); x[3] = __uint_as_float(rw.y & 0xffff0000u);
    x[4] = __uint_as_float(rw.z << 16); x[5] = __uint_as_float(rw.z & 0xffff0000u); x[6] = __uint_as_float(rw.w << 16); x[7] = __uint_as_float(rw.w & 0xffff0000u); }
__device__ __forceinline__ u32x4 pack8(const float (&x)[8]) { return (u32x4){pk2(x[0], x[1]), pk2(x[2], x[3]), pk2(x[4], x[5]), pk2(x[6], x[7])}; }

__device__ __forceinline__ int otid() { int t = threadIdx.x; asm volatile("" : "+v"(t)); return t; }
__device__ __forceinline__ int obid() { int t = blockIdx.x; asm volatile("" : "+s"(t)); return t; }
__device__ __forceinline__ float tanh_(float x) { const float e = __expf(2.f * x); return 1.f - 2.f * __builtin_amdgcn_rcpf(e + 1.f); }
template <int CTRL> __device__ __forceinline__ float dppf(float x) { return __builtin_bit_cast(float, __builtin_amdgcn_mov_dpp(__builtin_bit_cast(int, x), CTRL, 0xf, 0xf, true)); }
__device__ __forceinline__ float rowsum16(float x) { x += dppf<0x128>(x); x += dppf<0x124>(x); x += dppf<0x122>(x); x += dppf<0x121>(x); return x; }


#define XB_TMO      128
#define XB_XCNT(j)  (256  + 64 * (j))
#define XB_XSUB(j)  (1280 + 64 * (j))
#define XB_XGEN(j)  (2304 + 64 * (j))
#define XB_TOP      3328
#define XB_TOPGEN   3392
#define XCD_BAR_WORDS 3456
#define XB_SPIN_CAP (1u << 22)
__device__ __forceinline__ unsigned xb_ld(unsigned* p)              { return __hip_atomic_load(p, __ATOMIC_RELAXED, __HIP_MEMORY_SCOPE_AGENT); }
__device__ __forceinline__ unsigned xb_add(unsigned* p, unsigned v) { return __hip_atomic_fetch_add(p, v, __ATOMIC_RELAXED, __HIP_MEMORY_SCOPE_AGENT); }
__device__ __forceinline__ unsigned xb_xcc_id() { return (unsigned)__builtin_amdgcn_s_getreg((3 << 11) | 20) & 0xFu; }
#define XB_SPIN(cond, bar) do { unsigned _sp = 0; while (cond) { __builtin_amdgcn_s_sleep(1); \
    if ((++_sp & 255u) == 0u) { if (xb_ld(&(bar)[XB_TMO])) break; if (_sp > XB_SPIN_CAP) { atomicAdd(&(bar)[XB_TMO], 1u); break; } } } } while (0)
struct XcdBarrier { unsigned* bar; unsigned x; volatile LAS unsigned* st; };
__device__ __forceinline__ XcdBarrier xcd_barrier_post(unsigned* bar, volatile LAS unsigned* st) {
    XcdBarrier b; b.bar = bar; b.x = xb_xcc_id(); b.st = st;
    if (threadIdx.x == 0) (void)xb_add(&bar[XB_XCNT(b.x)], 1u);
    return b;
}
__device__ __forceinline__ void xcd_barrier_complete(unsigned* bar, unsigned x, unsigned& nloc, unsigned& nx) {
    const unsigned G = gridDim.x * gridDim.y * gridDim.z;
    unsigned sum, cnt, mine, sp = 0u;
    for (;;) {
        sum = 0u; cnt = 0u; mine = 0u;
#pragma unroll
        for (unsigned j = 0; j < 16; ++j) { const unsigned c = xb_ld(&bar[XB_XCNT(j)]); sum += c; cnt += (c > 0u) ? 1u : 0u; mine = (j == x) ? c : mine; }
        if (sum == G) break;
        __builtin_amdgcn_s_sleep(1);
        if ((++sp & 255u) == 0u) { if (xb_ld(&bar[XB_TMO])) break; if (sp > XB_SPIN_CAP) { atomicAdd(&bar[XB_TMO], 1u); break; } }
    }
    nloc = mine > 0u ? mine : 1u; nx = cnt > 0u ? cnt : 1u;
}
__device__ __forceinline__ void xcd_barrier(const XcdBarrier& b) {
    asm volatile("s_waitcnt vmcnt(0)" ::: "memory");
    __syncthreads();
    if (threadIdx.x == 0) {
        unsigned* bar = b.bar;
        __builtin_amdgcn_s_waitcnt(0);
        unsigned nloc = b.st[0], nx = b.st[1];
        if (nloc == 0u) { xcd_barrier_complete(bar, b.x, nloc, nx); b.st[0] = nloc; b.st[1] = nx; }
        const unsigned old = xb_add(&bar[XB_XSUB(b.x)], 1u);
        const unsigned gen = old / nloc;
        if (old + 1u == (gen + 1u) * nloc) {
            __builtin_amdgcn_fence(__ATOMIC_RELEASE, "agent");
            asm volatile("s_waitcnt vmcnt(0)" ::: "memory");
            const unsigned og = xb_add(&bar[XB_TOP], 1u);
            const unsigned tg = og / nx;
            if (og + 1u == (tg + 1u) * nx) xb_add(&bar[XB_TOPGEN], 1u);
            else XB_SPIN(xb_ld(&bar[XB_TOPGEN]) == tg, bar);
            __builtin_amdgcn_fence(__ATOMIC_ACQUIRE, "agent");
            xb_add(&bar[XB_XGEN(b.x)], 1u);
            asm volatile("s_waitcnt vmcnt(0)" ::: "memory");
        } else {
            XB_SPIN(xb_ld(&bar[XB_XGEN(b.x)]) == gen, bar);
            __builtin_amdgcn_fence(__ATOMIC_ACQUIRE, "agent");
            asm volatile("s_waitcnt vmcnt(0)" ::: "memory");
        }
    }
    __syncthreads();
}

namespace pg8 {
constexpr int BM = 256, BK = 64, HALF = 128, HTB = HALF * BK * 2, STAGE_BYTES = 8 * HTB, NXCD = 8, WGM = 8;
__device__ __forceinline__ int lds_byte(int r, int c) { const int st = (r >> 4) * 2 + (c >> 5), rr = r & 15, cc = c & 31, ob = rr * 64 + cc * 2; return st * 1024 + (ob ^ (((ob >> 9) & 1) << 5)); }
__device__ __forceinline__ void stage_rc(int b, int& R, int& C) { const int st = b / 1024, sb = b % 1024, swz = sb ^ (((sb >> 9) & 1) << 5); R = (st >> 1) * 16 + swz / 64; C = (st & 1) * 32 + (swz % 64) / 2; }
__device__ __forceinline__ int perm32(int rho) { const int n = rho >> 4, i = rho & 15; return 8 * (i >> 2) + 4 * n + (i & 3); }

struct Unit { int pm, pn, w; };
struct OrderBase {
    int nM, nN, nwg, G, c;
    __device__ void init(int nM_, int nN_, int G_, int c_) { nM = nM_; nN = nN_; nwg = nM * nN; G = G_; c = c_; }
    __device__ bool nextb(int i, Unit& u) const {
        const long L = (long)i * G + c; if (L >= nwg) return false;
        int wgid = (int)L; { const int q = nwg / NXCD, r = nwg % NXCD, xcd = wgid % NXCD, off = wgid / NXCD; wgid = (xcd < r ? xcd * (q + 1) : r * (q + 1) + (xcd - r) * q) + off; }
        const int nig = WGM * nN, gid = wgid / nig, fm = gid * WGM, gsz = (nM - fm) < WGM ? (nM - fm) : WGM;
        u.pm = fm + ((wgid % nig) % gsz); u.pn = (wgid % nig) / gsz; u.w = 0; return true;
    }
};

template <class Epi, class Sched>
__device__ __forceinline__ void gemm_phase(LAS unsigned char* lds, const int K, const Sched& S, const Epi& E) {
    const int tid = otid(), wid = __builtin_amdgcn_readfirstlane(tid >> 6), lane = tid & 63, wr = wid >> 2, wc = wid & 3, fr = lane & 15, fq = lane >> 4;
    const int nt = K / BK;
    unsigned voffA[2], voffB[2];
#pragma unroll
    for (int i = 0; i < 2; ++i) { int R, C; stage_rc(tid * 16 + i * 8192, R, C); const int Rb = Epi::PERM ? ((R & ~31) + perm32(R & 31)) : R;
        voffA[i] = (unsigned)(R * K + C) * 2u; voffB[i] = (unsigned)(Rb * K + C) * 2u; }
    const size_t kstep = (size_t)(BK * 2);
    const size_t hstep = (size_t)HALF * K * 2;
    const unsigned ldsw = (unsigned)wid * 1024u;
    const int aoff = lds_byte(wr * 64 + fr, fq * 8), boff = lds_byte(wc * 32 + fr, fq * 8);
#define PG8_SA(b, h) (((b) * 2 + (h)) * HTB)
#define PG8_SB(b, h) ((4 + (b) * 2 + (h)) * HTB)
#define PG8_STAGE(bufoff, gbase, voff) do { _Pragma("unroll") for (int _i = 0; _i < 2; ++_i) \
        __builtin_amdgcn_global_load_lds((const unsigned*)((const char*)(gbase) + (voff)[_i]), (LAS unsigned*)(lds + (bufoff) + ldsw + _i * 8192), 16, 0, 0); } while (0)
#define PG8_LDA(dst, b, h) do { _Pragma("unroll") for (int m = 0; m < 4; ++m) _Pragma("unroll") for (int k = 0; k < 2; ++k) dst[m][k] = *(const LAS bf16x8*)(lds + PG8_SA(b, h) + aoff + m * 2048 + k * 1024); } while (0)
#define PG8_LDB(dst, b, h) do { _Pragma("unroll") for (int n = 0; n < 2; ++n) _Pragma("unroll") for (int k = 0; k < 2; ++k) dst[n][k] = *(const LAS bf16x8*)(lds + PG8_SB(b, h) + boff + n * 2048 + k * 1024); } while (0)
#define PG8_MMA(ai, bj, At, Bt) do { __builtin_amdgcn_s_setprio(1); _Pragma("unroll") for (int m = 0; m < 4; ++m) _Pragma("unroll") for (int n = 0; n < 2; ++n) _Pragma("unroll") for (int k = 0; k < 2; ++k) \
        acc[ai][bj][m][n] = __builtin_amdgcn_mfma_f32_16x16x32_bf16(Bt[n][k], At[m][k], acc[ai][bj][m][n], 0, 0, 0); __builtin_amdgcn_s_setprio(0); } while (0)
#define PG8_WAIT_V(n) asm volatile("s_waitcnt vmcnt(" #n ")" ::: "memory")
#define PG8_WAIT_L(n) asm volatile("s_waitcnt lgkmcnt(" #n ")" ::: "memory")
#define PG8_BAR __builtin_amdgcn_s_barrier()
#define PG8_SCHED __builtin_amdgcn_sched_barrier(0)
    Unit cur, nxt; int ui = 0;
    if (!S.next(0, cur)) return;
    f32x4 acc[2][2][4][2];
#pragma unroll
    for (int a = 0; a < 2; ++a)
#pragma unroll
        for (int b = 0; b < 2; ++b)
#pragma unroll
            for (int m = 0; m < 4; ++m)
#pragma unroll
                for (int n = 0; n < 2; ++n) acc[a][b][m][n] = (f32x4){0.f, 0.f, 0.f, 0.f};
    bf16x8 At[4][2], B0[2][2], B1[2][2];
    const char* cA = S.a_ptr(cur); const char* cB = S.b_ptr(cur);
    PG8_STAGE(PG8_SB(0, 0), cB, voffB); PG8_STAGE(PG8_SA(0, 0), cA, voffA); PG8_STAGE(PG8_SB(0, 1), cB + hstep, voffB); PG8_STAGE(PG8_SA(0, 1), cA + hstep, voffA);
    if (wr == 1) PG8_BAR;
    PG8_WAIT_V(4); PG8_BAR;
    PG8_STAGE(PG8_SB(1, 0), cB + kstep, voffB); PG8_STAGE(PG8_SA(1, 0), cA + kstep, voffA); PG8_STAGE(PG8_SB(1, 1), cB + hstep + kstep, voffB);
    PG8_WAIT_V(6); PG8_BAR;
    for (;;) {
        const bool has_next = S.next(ui + 1, nxt);
        const char* nA = has_next ? S.a_ptr(nxt) : cA; const char* nB = has_next ? S.b_ptr(nxt) : cB;
        for (int t = 0; t < nt; t += 2) {
            const bool last = (t == nt - 2);
            const char* a1 = cA + (size_t)(t + 1) * kstep;
            const char* a2 = last ? nA : cA + (size_t)(t + 2) * kstep; const char* b2 = last ? nB : cB + (size_t)(t + 2) * kstep;
            const char* a3 = a2 + kstep; const char* b3 = b2 + kstep;
            PG8_LDB(B0, 0, 0); PG8_SCHED; PG8_LDA(At, 0, 0); PG8_STAGE(PG8_SA(1, 1), a1 + hstep, voffA);
            PG8_WAIT_L(8); PG8_BAR; PG8_WAIT_L(0); PG8_MMA(0, 0, At, B0); PG8_BAR; PG8_SCHED;
            PG8_LDB(B1, 0, 1); PG8_STAGE(PG8_SB(0, 0), b2, voffB);
            PG8_BAR; PG8_WAIT_L(0); PG8_MMA(0, 1, At, B1); PG8_BAR;
            PG8_LDA(At, 0, 1); PG8_STAGE(PG8_SA(0, 0), a2, voffA);
            PG8_BAR; PG8_WAIT_L(0); PG8_MMA(1, 0, At, B0); PG8_BAR; PG8_SCHED;
            PG8_STAGE(PG8_SB(0, 1), b2 + hstep, voffB);
            PG8_WAIT_V(6); PG8_BAR; PG8_MMA(1, 1, At, B1); PG8_BAR;
            PG8_LDB(B0, 1, 0); PG8_SCHED; PG8_LDA(At, 1, 0); PG8_STAGE(PG8_SA(0, 1), a2 + hstep, voffA);
            PG8_WAIT_L(8); PG8_BAR; PG8_WAIT_L(0); PG8_MMA(0, 0, At, B0); PG8_BAR; PG8_SCHED;
            PG8_LDB(B1, 1, 1); PG8_STAGE(PG8_SB(1, 0), b3, voffB);
            PG8_BAR; PG8_WAIT_L(0); PG8_MMA(0, 1, At, B1); PG8_BAR;
            PG8_LDA(At, 1, 1); PG8_STAGE(PG8_SA(1, 0), a3, voffA);
            PG8_BAR; PG8_WAIT_L(0); PG8_MMA(1, 0, At, B0); PG8_BAR; PG8_SCHED;
            PG8_STAGE(PG8_SB(1, 1), b3 + hstep, voffB);
            PG8_WAIT_V(6); PG8_BAR; PG8_MMA(1, 1, At, B1); PG8_BAR;
        }
        if (!Epi::AFTER_DRAIN) E(acc, cur, wr, wc, fr, fq);
        if (!has_next) break;
        if (!E.keep(cur)) {
#pragma unroll
        for (int a = 0; a < 2; ++a)
#pragma unroll
            for (int b = 0; b < 2; ++b)
#pragma unroll
                for (int m = 0; m < 4; ++m)
#pragma unroll
                    for (int n = 0; n < 2; ++n) acc[a][b][m][n] = (f32x4){0.f, 0.f, 0.f, 0.f};
        }
        cur = nxt; cA = nA; cB = nB; ++ui;
    }
    PG8_WAIT_V(0);
    if (wr == 0) PG8_BAR;
    PG8_BAR;
    if (Epi::AFTER_DRAIN) E.fused(acc, cur, wr, wc, fr, fq, lds);
#undef PG8_SA
#undef PG8_SB
#undef PG8_STAGE
#undef PG8_LDA
#undef PG8_LDB
#undef PG8_MMA
#undef PG8_WAIT_V
#undef PG8_WAIT_L
#undef PG8_BAR
#undef PG8_SCHED
}
}
using pg8::Unit;

struct SchedIn {
    pg8::OrderBase ob; int seg; const char* A; const char* B;
    __device__ bool next(int i, Unit& u) const { return ob.nextb(i, u); }
    __device__ const char* a_ptr(const Unit& u) const {
        const int gt = u.pm < LT_PROMPT ? ((u.pm / TPB) * (SEQ / 256) + seg * TPB + (u.pm % TPB)) : (XROWS / 256 + (u.pm - LT_PROMPT));
        return A + (size_t)gt * 256 * D * 2; }
    __device__ const char* b_ptr(const Unit& u) const { return B + (size_t)u.pn * 256 * D * 2; }
};
struct SchedAB {
    pg8::OrderBase ob; int pm0, wfix; const char* A0; const char* A1; const char* B0; const char* B1;
    __device__ bool next(int i, Unit& u) const { const bool ok = wfix < 0 ? ob.nextb(i >> 1, u) : ob.nextb(i, u); u.pm += pm0; u.w = wfix < 0 ? (i & 1) : wfix; return ok; }
    __device__ const char* a_ptr(const Unit& u) const { return (u.w ? A1 : A0) + (size_t)u.pm * 256 * D * 2; }
    __device__ const char* b_ptr(const Unit& u) const { return (u.w ? B1 : B0) + (size_t)u.pn * 256 * D * 2; }
};
struct SchedO {
    pg8::OrderBase ob; int pm0; const char* A; const char* B;
    __device__ bool next(int i, Unit& u) const { const bool ok = ob.nextb(i, u); u.pm += pm0; return ok; }
    __device__ const char* a_ptr(const Unit& u) const { return A + (size_t)u.pm * 256 * D * 2; }
    __device__ const char* b_ptr(const Unit& u) const { return B + (size_t)u.pn * 256 * D * 2; }
};

struct EpiIn {
    static constexpr bool PERM = true, AFTER_DRAIN = false;
    __device__ __forceinline__ void fused(f32x4 (&)[2][2][4][2], const Unit&, int, int, int, int, LAS unsigned char*) const {}
    bf16_t* P; bf16_t* gex; float* out; int seg;
    __device__ __forceinline__ bool keep(const Unit&) const { return false; }
    __device__ __forceinline__ void operator()(const f32x4 (&acc)[2][2][4][2], const Unit& u, int wr, int wc, int fr, int fq) const {
        const int lr0 = u.pm * 256 + wr * 64 + fr;
        const int c0 = u.pn * 256 + wc * 32 + 8 * fq;
#pragma unroll
        for (int ai = 0; ai < 2; ++ai)
#pragma unroll
            for (int m = 0; m < 4; ++m) {
                const int lr = lr0 + ai * 128 + m * 16;
                bf16_t* rowp;
                if (u.pn < NT_PB) rowp = P + (size_t)lr * NPB + c0;
                else if (lr < LEX0) { const int b = lr / SEGTOK; const size_t grow = (size_t)b * SEQ + seg * SEGTOK + (lr % SEGTOK); rowp = (bf16_t*)(out + O_YP + grow * D) + (c0 - NPB); }
                else rowp = gex + (size_t)(lr - LEX0) * 2048 + (c0 - NPB);
#pragma unroll
                for (int bj = 0; bj < 2; ++bj) { const f32x4 v0 = acc[ai][bj][m][0], v1 = acc[ai][bj][m][1];
                    u32x4 w; w.x = cvt_pk_bf16(v0[0], v0[1]); w.y = cvt_pk_bf16(v0[2], v0[3]); w.z = cvt_pk_bf16(v1[0], v1[1]); w.w = cvt_pk_bf16(v1[2], v1[3]);
                    *(u32x4*)(rowp + bj * 128) = w; }
            }
    }
};
struct EpiAB {
    static constexpr bool PERM = true, AFTER_DRAIN = false;
    __device__ __forceinline__ void fused(f32x4 (&)[2][2][4][2], const Unit&, int, int, int, int, LAS unsigned char*) const {}
    bf16_t* tmp; bf16_t* merged; const bf16_t* gex; const float* out; int pairmode;
    __device__ __forceinline__ bool keep(const Unit& u) const { return pairmode && u.w == 0; }
    __device__ __forceinline__ void operator()(f32x4 (&acc)[2][2][4][2], const Unit& u, int wr, int wc, int fr, int fq) const {
        const int row0 = u.pm * 256 + wr * 64 + fr, col0 = u.pn * 256 + wc * 32 + 8 * fq;
        if (pairmode) {
#pragma unroll
            for (int ai = 0; ai < 2; ++ai) {
                const bf16_t* g0[4];
#pragma unroll
                for (int m = 0; m < 4; ++m) { const int grow = row0 + ai * 128 + m * 16;
                    g0[m] = (grow < XROWS) ? (const bf16_t*)(out + O_YP + (size_t)grow * D) : (gex + (size_t)(grow - XROWS) * 2048); }
#pragma unroll
                for (int mp = 0; mp < 2; ++mp) {
                u32x4 gbv[2][2], gav[2][2];
#pragma unroll
                for (int mm = 0; mm < 2; ++mm)
#pragma unroll
                    for (int bj = 0; bj < 2; ++bj) { gbv[mm][bj] = *(const u32x4*)(g0[2 * mp + mm] + D + col0 + bj * 128); gav[mm][bj] = (u.w == 0) ? *(const u32x4*)(g0[2 * mp + mm] + col0 + bj * 128) : gbv[mm][bj]; }
#pragma unroll
                for (int mm = 0; mm < 2; ++mm)
#pragma unroll
                    for (int bj = 0; bj < 2; ++bj) { const int m = 2 * mp + mm;
                        float gb[8]; unpack8(gbv[mm][bj], gb);
                        float eb[8];
#pragma unroll
                        for (int e = 0; e < 8; ++e) eb[e] = 1.f + fminf(__expf(-gb[e]), 1e18f);
                        if (u.w == 0) {
                            float ga[8]; unpack8(gav[mm][bj], ga);
#pragma unroll
                            for (int e = 0; e < 4; ++e) { acc[ai][bj][m][0][e] *= sigm(ga[e]) * eb[e]; acc[ai][bj][m][1][e] *= sigm(ga[4 + e]) * eb[4 + e]; }
                        } else {
                            float v[8];
#pragma unroll
                            for (int e = 0; e < 4; ++e) { v[e] = acc[ai][bj][m][0][e] * __builtin_amdgcn_rcpf(eb[e]); v[4 + e] = acc[ai][bj][m][1][e] * __builtin_amdgcn_rcpf(eb[4 + e]); }
                            const int grow = row0 + ai * 128 + m * 16;
                            *(u32x4*)(merged + (size_t)grow * D + col0 + bj * 128) = pack8(v);
                        }
                    }
                asm volatile("" ::: "memory");
                }
            }
            return;
        }
#pragma unroll
        for (int ai = 0; ai < 2; ++ai)
#pragma unroll
            for (int m = 0; m < 4; ++m) {
                const int grow = row0 + ai * 128 + m * 16;
                const bf16_t* g0 = (grow < XROWS) ? (const bf16_t*)(out + O_YP + (size_t)grow * D) : (gex + (size_t)(grow - XROWS) * 2048);
#pragma unroll
                for (int bj = 0; bj < 2; ++bj) {
                    const int c = col0 + bj * 128;
                    float g[8]; unpack8(*(const u32x4*)(g0 + u.w * D + c), g);
                    const f32x4 v0 = acc[ai][bj][m][0], v1 = acc[ai][bj][m][1];
                    float v[8] = {v0[0] * sigm(g[0]), v0[1] * sigm(g[1]), v0[2] * sigm(g[2]), v0[3] * sigm(g[3]), v1[0] * sigm(g[4]), v1[1] * sigm(g[5]), v1[2] * sigm(g[6]), v1[3] * sigm(g[7])};
                    bf16_t* tp = tmp + (size_t)grow * D + c;
                    if (u.w == 0) *(u32x4*)tp = pack8(v);
                    else { float t[8]; unpack8(*(const u32x4*)tp, t);
#pragma unroll
                        for (int e = 0; e < 8; ++e) v[e] += t[e];
                        *(u32x4*)(merged + (size_t)grow * D + c) = pack8(v); }
                }
            }
    }
};
struct EpiO {
    static constexpr bool PERM = false, AFTER_DRAIN = true;
    float* out; const float* xp; const float* xs; const float* lnf; float* xch; unsigned* cnt;
    __device__ __forceinline__ bool keep(const Unit&) const { return false; }
    __device__ __forceinline__ void operator()(const f32x4 (&)[2][2][4][2], const Unit&, int, int, int, int) const {}
    __device__ __forceinline__ void fused(f32x4 (&acc)[2][2][4][2], const Unit& u, int wr, int wc, int fr, int fq, LAS unsigned char* lds) const {
        float* part = (float*)lds; float* rstd = part + 1024;
        const int tid = otid();
        const int lrow0 = wr * 64 + fr, row0 = u.pm * 256 + lrow0, col0 = u.pn * 256 + wc * 32 + 4 * fq;
#pragma unroll
        for (int ai = 0; ai < 2; ++ai) {
#pragma unroll
            for (int m = 0; m < 4; ++m) {
                const int grow = row0 + ai * 128 + m * 16;
                const float* xr;
                if (grow < XROWS) xr = xp + (size_t)grow * D;
                else { const int e = grow - XROWS; const int es = (e < EX_SAMP || e >= EX_SHIFT) ? 0 : e - EX_SAMP; xr = xs + (size_t)es * D; }
                f32x4 xv[2][2];
#pragma unroll
                for (int bj = 0; bj < 2; ++bj)
#pragma unroll
                    for (int n = 0; n < 2; ++n) xv[bj][n] = *(const f32x4*)(xr + col0 + bj * 128 + n * 16);
                float sq = 0.f;
#pragma unroll
                for (int bj = 0; bj < 2; ++bj)
#pragma unroll
                    for (int n = 0; n < 2; ++n) { const f32x4 v = xv[bj][n] + acc[ai][bj][m][n]; acc[ai][bj][m][n] = v; sq += v[0] * v[0] + v[1] * v[1] + v[2] * v[2] + v[3] * v[3]; }
                sq += __shfl_xor(sq, 16); sq += __shfl_xor(sq, 32);
                if (fq == 0) part[(lrow0 + ai * 128 + m * 16) * 4 + wc] = sq;
            }
        }
        __syncthreads();
        if (tid < 256) { const f32x4 q = *(const f32x4*)(part + tid * 4);
            __hip_atomic_store(xch + ((size_t)u.pm * 256 + tid) * 4 + u.pn, q[0] + q[1] + q[2] + q[3], __ATOMIC_RELAXED, __HIP_MEMORY_SCOPE_AGENT); }
        asm volatile("s_waitcnt vmcnt(0)" ::: "memory");
        __syncthreads();
        if (tid == 0) {
            __hip_atomic_fetch_add(cnt + u.pm, 1u, __ATOMIC_RELAXED, __HIP_MEMORY_SCOPE_AGENT);
            unsigned spins = 0;
            while (__hip_atomic_load(cnt + u.pm, __ATOMIC_RELAXED, __HIP_MEMORY_SCOPE_AGENT) < 4u && ++spins < (1u << 22)) __builtin_amdgcn_s_sleep(1);
        }
        __syncthreads();
        if (tid < 256) { const float* xq = xch + ((size_t)u.pm * 256 + tid) * 4; float sm = 0.f;
#pragma unroll
            for (int j = 0; j < 4; ++j) sm += __hip_atomic_load(xq + j, __ATOMIC_RELAXED, __HIP_MEMORY_SCOPE_AGENT);
            rstd[tid] = __builtin_amdgcn_rsqf(sm * (1.f / D) + 1e-6f); }
        __syncthreads();
        f32x4 wv[2][2];
        asm volatile("" ::: "memory");
#pragma unroll
        for (int bj = 0; bj < 2; ++bj)
#pragma unroll
            for (int n = 0; n < 2; ++n) wv[bj][n] = *(const f32x4*)(lnf + col0 + bj * 128 + n * 16);
#pragma unroll
        for (int ai = 0; ai < 2; ++ai)
#pragma unroll
            for (int m = 0; m < 4; ++m) { const int lr = lrow0 + ai * 128 + m * 16, grow = u.pm * 256 + lr;
                float* yr;
                if (grow < XROWS) yr = out + O_YP + (size_t)grow * D;
                else { const int e = grow - XROWS; if (e < EX_SAMP || e >= EX_SHIFT) continue; yr = out + O_YS + (size_t)(e - EX_SAMP) * D; }
                const float rs = rstd[lr];
#pragma unroll
                for (int bj = 0; bj < 2; ++bj)
#pragma unroll
                    for (int n = 0; n < 2; ++n) *(f32x4*)(yr + col0 + bj * 128 + n * 16) = acc[ai][bj][m][n] * rs * wv[bj][n]; }
        __syncthreads();
    }
};

__device__ __forceinline__ void p0_row(const Params& p, int r, int lane) {
    bf16_t* hrow = (bf16_t*)(p.ws + WS_H) + (size_t)r * D;
    const float* src = nullptr; bool norm = true; float* sh = nullptr;
    if (r < XROWS) { src = p.in[0] + (size_t)r * D; if ((r & (SEQ - 1)) == SEQ - 1) sh = p.out + O_SHIFT_P + (size_t)(r / SEQ) * D; }
    else { const int e = r - XROWS;
        if (e < EX_SAMP) src = p.in[6] + (size_t)e * D;
        else if (e < EX_SHIFT) { src = p.in[1] + (size_t)(e - EX_SAMP) * D; if (((e - EX_SAMP) & 3) == 3) sh = p.out + O_SHIFT_S + (size_t)((e - EX_SAMP) >> 2) * D; }
        else if (e < EX_END) { src = p.in[5] + (size_t)(e - EX_SHIFT) * D; norm = false; } }
    u32x2* o8 = (u32x2*)hrow + lane;
    if (!src) {
#pragma unroll
        for (int j = 0; j < 4; ++j) o8[64 * j] = (u32x2){0u, 0u};
        return; }
    const f32x4* xr = (const f32x4*)src + lane;
    f32x4 v[4]; float ss = 0.f;
#pragma unroll
    for (int j = 0; j < 4; ++j) { v[j] = xr[64 * j]; ss += v[j][0] * v[j][0] + v[j][1] * v[j][1] + v[j][2] * v[j][2] + v[j][3] * v[j][3]; }
    if (norm) {
        const float rs = __builtin_amdgcn_rsqf(wave_sum(ss) * (1.f / D) + 1e-6f);
        const f32x4* wr = (const f32x4*)p.in[7] + lane;
#pragma unroll
        for (int j = 0; j < 4; ++j) v[j] = v[j] * rs * wr[64 * j];
    }
#pragma unroll
    for (int j = 0; j < 4; ++j) { o8[64 * j] = (u32x2){pk2(v[j][0], v[j][1]), pk2(v[j][2], v[j][3])}; if (sh) ((f32x4*)sh)[lane + 64 * j] = v[j]; }
}
template <int MODE> __device__ __forceinline__ void p0_tr_item(const float* W, int N, bf16_t* WT, float* scr, int kb, int nb, int lane) {
    const int k0 = 64 * kb, n0 = 32 * nb;
    const int l8 = lane & 7, r8 = lane >> 3;
    const int nn = n0 + 4 * l8;
    int srcc = nn;
    if (MODE == 1) srcc = nn < C_GATE_REF ? nn : (nn < NPB ? -1 : nn - (NPB - C_GATE_REF));
    f32x4 v[8];
#pragma unroll
    for (int i = 0; i < 8; ++i) { const int kk = 8 * i + r8; v[i] = srcc >= 0 ? *(const f32x4*)(W + (size_t)(k0 + kk) * N + srcc) : (f32x4){0.f, 0.f, 0.f, 0.f}; }
#pragma unroll
    for (int i = 0; i < 8; ++i) { const int kk = 8 * i + r8; float* d = scr + kk * 33 + 4 * l8; d[0] = v[i][0]; d[1] = v[i][1]; d[2] = v[i][2]; d[3] = v[i][3]; }
    asm volatile("s_waitcnt lgkmcnt(0)" ::: "memory");
    const int c = lane & 7;
#pragma unroll
    for (int j = 0; j < 4; ++j) { const int n = (lane >> 3) + 8 * j; const float* s = scr + (8 * c) * 33 + n;
        u32x4 o; o.x = pk2(s[0 * 33], s[1 * 33]); o.y = pk2(s[2 * 33], s[3 * 33]); o.z = pk2(s[4 * 33], s[5 * 33]); o.w = pk2(s[6 * 33], s[7 * 33]);
        *(u32x4*)(WT + (size_t)(n0 + n) * D + k0 + 8 * c) = o; }
    asm volatile("s_waitcnt lgkmcnt(0)" ::: "memory");
}
__device__ __forceinline__ void h_rows_pair(const Params& p, int r, int r1, bool has1, int lane, const f32x4 (&wv)[4]) {
    const f32x4* x0 = (const f32x4*)(p.in[0] + (size_t)r * D) + lane; const f32x4* x1 = (const f32x4*)(p.in[0] + (size_t)(has1 ? r1 : r) * D) + lane;
    f32x4 a[4], b[4]; float s0 = 0.f, s1 = 0.f;
#pragma unroll
    for (int j = 0; j < 4; ++j) { a[j] = x0[64 * j]; b[j] = x1[64 * j]; }
#pragma unroll
    for (int j = 0; j < 4; ++j) { s0 += a[j][0] * a[j][0] + a[j][1] * a[j][1] + a[j][2] * a[j][2] + a[j][3] * a[j][3]; s1 += b[j][0] * b[j][0] + b[j][1] * b[j][1] + b[j][2] * b[j][2] + b[j][3] * b[j][3]; }
    const float q0 = __builtin_amdgcn_rsqf(wave_sum(s0) * (1.f / D) + 1e-6f), q1 = __builtin_amdgcn_rsqf(wave_sum(s1) * (1.f / D) + 1e-6f);
    u32x2* o0 = (u32x2*)((bf16_t*)(p.ws + WS_H) + (size_t)r * D) + lane; u32x2* o1 = (u32x2*)((bf16_t*)(p.ws + WS_H) + (size_t)r1 * D) + lane;
#pragma unroll
    for (int j = 0; j < 4; ++j) { a[j] = a[j] * q0 * wv[j]; o0[64 * j] = (u32x2){pk2(a[j][0], a[j][1]), pk2(a[j][2], a[j][3])}; }
    if ((r & (SEQ - 1)) == SEQ - 1) { f32x4* sh = (f32x4*)(p.out + O_SHIFT_P + (size_t)(r / SEQ) * D) + lane;
#pragma unroll
        for (int j = 0; j < 4; ++j) sh[64 * j] = a[j]; }
    if (has1) {
#pragma unroll
        for (int j = 0; j < 4; ++j) { b[j] = b[j] * q1 * wv[j]; o1[64 * j] = (u32x2){pk2(b[j][0], b[j][1]), pk2(b[j][2], b[j][3])}; }
        if ((r1 & (SEQ - 1)) == SEQ - 1) { f32x4* sh = (f32x4*)(p.out + O_SHIFT_P + (size_t)(r1 / SEQ) * D) + lane;
#pragma unroll
            for (int j = 0; j < 4; ++j) sh[64 * j] = b[j]; }
    }
}
__device__ __forceinline__ void h_rows_segs(const Params& p, int s_lo, int s_hi, int wi, int nw, int lane) {
    const f32x4* lw = (const f32x4*)p.in[7] + lane;
    f32x4 wv[4];
#pragma unroll
    for (int j = 0; j < 4; ++j) wv[j] = lw[64 * j];
    const int n = (s_hi - s_lo) * NBATCH * SEGTOK;
#pragma unroll 1
    for (int x = wi; x < n; x += 2 * nw) {
        const int x1 = x + nw; const bool has1 = x1 < n;
        const int sg = s_lo + x / (NBATCH * SEGTOK), rem = x % (NBATCH * SEGTOK), r = (rem / SEGTOK) * SEQ + sg * SEGTOK + (rem % SEGTOK);
        const int xx = has1 ? x1 : x; const int sg1 = s_lo + xx / (NBATCH * SEGTOK), rem1 = xx % (NBATCH * SEGTOK), r1 = (rem1 / SEGTOK) * SEQ + sg1 * SEGTOK + (rem1 % SEGTOK);
        h_rows_pair(p, r, r1, has1, lane, wv);
    }
}
__device__ __forceinline__ void phase0(const Params& p, unsigned char* smem) {
    const int tid0 = otid(), wave = tid0 >> 6, lane = tid0 & 63;
    const int gw = obid() * 8 + wave, NGW = gridDim.x * 8;
    float* scr = (float*)smem + wave * (64 * 33);
    constexpr int I_IN = 16 * (NP / 32), I_SQ = 16 * 32;
    for (int it = gw; it < I_IN + 3 * I_SQ; it += NGW) {
        int r = it;
        if (r < I_IN) { p0_tr_item<1>(p.in[8], 10384, (bf16_t*)(p.ws + WS_WT_IN), scr, r / (NP / 32), r % (NP / 32), lane); continue; } r -= I_IN;
        if (r < I_SQ) { p0_tr_item<0>(p.in[13], D, (bf16_t*)(p.ws + WS_WT_A), scr, r / 32, r % 32, lane); continue; } r -= I_SQ;
        if (r < I_SQ) { p0_tr_item<0>(p.in[24], D, (bf16_t*)(p.ws + WS_WT_B), scr, r / 32, r % 32, lane); continue; } r -= I_SQ;
        p0_tr_item<0>(p.in[25], D, (bf16_t*)(p.ws + WS_WT_O), scr, r / 32, r % 32, lane);
    }
    h_rows_segs(p, 0, 2, gw, NGW, lane);
    for (int r = XROWS + gw; r < HROWS; r += NGW) p0_row(p, r, lane);
    {
        float* pk = (float*)(p.ws + WS_PK);
        const int gt = obid() * 512 + tid0, NT = gridDim.x * 512;
        for (int i = gt; i < PK_END; i += NT) {
            const float* src; int o;
            if (i < PK_ALOG) { src = p.in[9]; o = i - PK_CONVW; } else if (i < PK_DTB) { src = p.in[10]; o = i - PK_ALOG; } else if (i < PK_NORMW) { src = p.in[11]; o = i - PK_DTB; }
            else if (i < PK_MU) { src = p.in[12]; o = i - PK_NORMW; } else if (i < PK_W0) { src = p.in[14]; o = i - PK_MU; } else if (i < PK_W2) { src = p.in[15]; o = i - PK_W0; }
            else if (i < PK_A0) { src = p.in[16]; o = i - PK_W2; } else if (i < PK_A2) { src = p.in[17]; o = i - PK_A0; } else if (i < PK_KK) { src = p.in[18]; o = i - PK_A2; }
            else if (i < PK_KA) { src = p.in[19]; o = i - PK_KK; } else if (i < PK_RK) { src = p.in[20]; o = i - PK_KA; } else if (i < PK_GNW) { src = p.in[21]; o = i - PK_RK; }
            else if (i < PK_GNB) { src = p.in[22]; o = i - PK_GNW; } else if (i < PK_LNF) { src = p.in[23]; o = i - PK_GNB; } else { src = p.in[26]; o = i - PK_LNF; }
            pk[i] = src[o];
        }
        bf16_t* w2t = (bf16_t*)(p.ws + WS_W2T); bf16_t* a2t = (bf16_t*)(p.ws + WS_A2T);
        for (int i = gt; i < 65536; i += NT) { const int l = i & 63, c = (i >> 6) & 63, hb = i >> 12;
            w2t[i] = (bf16_t)f2bf(p.in[16][(size_t)l * D + hb * 64 + c]); a2t[i] = (bf16_t)f2bf(p.in[18][(size_t)l * D + hb * 64 + c]); }
    }
}

__device__ __forceinline__ void gdn_item(const Params& p, unsigned char* smem, const float* s_in, float* s_out, const float* halo_in, float* halo_out,
                                         int h, int sl, int rowA, int nA, int rowB, int nB) {
    const int tid = otid(), w = tid >> 6, lane = tid & 63, vl = lane >> 4, kg = lane & 15;
    float* qk_s = (float*)smem; float* v_s = qk_s + 16384; float* o_s = v_s + 2048; float* gb_s = o_s + 2048; float* sst = gb_s + 128;
    const bf16_t* P = (const bf16_t*)(p.ws + WS_P);
    float* ORAW = (float*)(p.ws + WS_ORAW);
    float s[8];
    if (s_in) {
        { const int k = tid >> 2, q4 = tid & 3; const f32x4* src = (const f32x4*)(s_in + (size_t)k * 128 + sl * 32 + q4 * 8); const f32x4 a = src[0], b = src[1];
          float* d = sst + k * 33 + q4 * 8; d[0] = a[0]; d[1] = a[1]; d[2] = a[2]; d[3] = a[3]; d[4] = b[0]; d[5] = b[1]; d[6] = b[2]; d[7] = b[3]; }
        __syncthreads();
#pragma unroll
        for (int j = 0; j < 8; ++j) s[j] = sst[(kg * 8 + j) * 33 + 4 * w + vl];
        __syncthreads();
    } else {
#pragma unroll
        for (int j = 0; j < 8; ++j) s[j] = 0.f;
    }
    int pcol = -1;
    if (tid < 128) pcol = h * 128 + tid; else if (tid < 256) pcol = 1024 + h * 128 + (tid - 128); else if (tid < 288) pcol = 2048 + h * 128 + sl * 32 + (tid - 256);
    float cw0 = 0.f, cw1 = 0.f, cw2 = 0.f, cw3 = 0.f, x1 = 0.f, x2 = 0.f, x3 = 0.f;
    const float* pk = (const float*)(p.ws + WS_PK);
    if (pcol >= 0) { const float* cw = pk + PK_CONVW; cw0 = cw[pcol]; cw1 = cw[3072 + pcol]; cw2 = cw[6144 + pcol]; cw3 = cw[9216 + pcol];
        if (halo_in) { x3 = halo_in[pcol]; x2 = halo_in[3072 + pcol]; x1 = halo_in[6144 + pcol]; } }
    const float nalog = -expf(pk[PK_ALOG + h]), dtb = pk[PK_DTB + h];
#pragma unroll 1
    for (int run = 0; run < 2; ++run) {
        const int rrow = run ? rowB : rowA, rn = run ? nB : nA; const bool wout = run != 0;
#pragma unroll 1
        for (int c0 = 0; c0 < rn; c0 += 64) {
            const int nt = (rn - c0) < 64 ? (rn - c0) : 64; const int row = rrow + c0;
            if (pcol >= 0) {
                const bf16_t* src = P + (size_t)row * NPB + pcol;
                float* dst = tid < 256 ? (qk_s + tid) : (v_s + (tid - 256)); const int dstride = tid < 256 ? 256 : 32;
#pragma unroll 8
                for (int i = 0; i < nt; ++i) { const float x0 = bf2f(src[(size_t)i * NPB]); const float y = cw0 * x3 + cw1 * x2 + cw2 * x1 + cw3 * x0; x3 = x2; x2 = x1; x1 = x0; dst[i * dstride] = silu_(y); }
            } else if (tid < 352) {
                const int i = tid - 288;
                if (i < nt) { const float pa = bf2f(P[(size_t)(row + i) * NPB + C_A + h]), pb = bf2f(P[(size_t)(row + i) * NPB + C_B + h]);
                    gb_s[2 * i] = expf(nalog * softplus_(pa + dtb)); gb_s[2 * i + 1] = sigm(pb); }
            }
            __syncthreads();
#pragma unroll 1
            for (int ii = 0; ii < 8; ++ii) { const int i = w * 8 + ii;
                if (i < nt) {
#pragma unroll
                    for (int which = 0; which < 2; ++which) { float* rp = qk_s + i * 256 + which * 128; const float a = rp[lane], b = rp[lane + 64];
                        const float sc = __builtin_amdgcn_rsqf(wave_sum(a * a + b * b) + 1e-6f) * (which == 0 ? 0.08838834764831845f : 1.f); rp[lane] = a * sc; rp[lane + 64] = b * sc; } } }
            __syncthreads();
#pragma unroll 1
            for (int i = 0; i < nt; ++i) {
                const f32x4 q0 = *(const f32x4*)(qk_s + i * 256 + kg * 8), q1 = *(const f32x4*)(qk_s + i * 256 + kg * 8 + 4);
                const f32x4 k0 = *(const f32x4*)(qk_s + i * 256 + 128 + kg * 8), k1 = *(const f32x4*)(qk_s + i * 256 + 128 + kg * 8 + 4);
                const float vv = v_s[i * 32 + 4 * w + vl], a = gb_s[2 * i], be = gb_s[2 * i + 1];
                float part = k0[0] * s[0] + k0[1] * s[1] + k0[2] * s[2] + k0[3] * s[3] + k1[0] * s[4] + k1[1] * s[5] + k1[2] * s[6] + k1[3] * s[7];
                const float kS = rowsum16(part);
                const float c = be * (vv - a * kS);
                s[0] = a * s[0] + k0[0] * c; s[1] = a * s[1] + k0[1] * c; s[2] = a * s[2] + k0[2] * c; s[3] = a * s[3] + k0[3] * c;
                s[4] = a * s[4] + k1[0] * c; s[5] = a * s[5] + k1[1] * c; s[6] = a * s[6] + k1[2] * c; s[7] = a * s[7] + k1[3] * c;
                float op = q0[0] * s[0] + q0[1] * s[1] + q0[2] * s[2] + q0[3] * s[3] + q1[0] * s[4] + q1[1] * s[5] + q1[2] * s[6] + q1[3] * s[7];
                const float o = rowsum16(op);
                if (kg == 0) o_s[i * 32 + 4 * w + vl] = o;
            }
            __syncthreads();
            if (wout) { const int i = tid >> 3, c4 = (tid & 7) * 4; if (i < nt) *(f32x4*)(ORAW + (size_t)(row + i) * D + h * 128 + sl * 32 + c4) = *(const f32x4*)(o_s + i * 32 + c4); }
        }
    }
    if (pcol >= 0 && (sl == 0 || tid >= 256)) { halo_out[pcol] = x3; halo_out[3072 + pcol] = x2; halo_out[6144 + pcol] = x1; }
#pragma unroll
    for (int j = 0; j < 8; ++j) sst[(kg * 8 + j) * 33 + 4 * w + vl] = s[j];
    __syncthreads();
    { const int k = tid >> 2, q4 = tid & 3; const float* d = sst + k * 33 + q4 * 8; f32x4* dst = (f32x4*)(s_out + (size_t)k * 128 + sl * 32 + q4 * 8);
      dst[0] = (f32x4){d[0], d[1], d[2], d[3]}; dst[1] = (f32x4){d[4], d[5], d[6], d[7]}; }
    __syncthreads();
}

constexpr int RW_W2 = 20544, RW_A2 = 24640;
__device__ __forceinline__ void rwkv_load_lora(const Params& p, unsigned char* smem, int hb) {
    float* w2_s = (float*)smem + RW_W2; float* a2_s = (float*)smem + RW_A2; const float* pk = (const float*)(p.ws + WS_PK);
    for (int i = otid(); i < 4096; i += 512) { const int l = i >> 6, c = i & 63; w2_s[i] = pk[PK_W2 + l * D + hb * 64 + c]; a2_s[i] = pk[PK_A2 + l * D + hb * 64 + c]; }
    __syncthreads();
}
__device__ __forceinline__ void rwkv_item(const Params& p, unsigned char* smem, const float* s_in, float* s_out, const bf16_t* prev_row, const float* halo_in, float* halo_out,
                                          int hb, int half, int rowA, int nA, int rowB, int nB) {
    const int tid = otid(), w = tid >> 6, lane = tid & 63, row = tid >> 4, kq = tid & 15;
    float* f = (float*)smem;
    float* r_s = f; float* kb_s = f + 2048; float* v_s = f + 4096; float* wd_s = f + 6144; float* ad_s = f + 8192; float* dec_s = f + 10240; float* a_s = f + 12288;
    float* kk_s = f + 14336; float* km_s = f + 16384; float* zb_s = f + 18432; float* y_s = f + 19456; float* bonus_s = f + 20480;
    const float* w2_s = f + RW_W2; const float* a2_s = f + RW_A2;
    const bf16_t* P = (const bf16_t*)(p.ws + WS_P);
    float* YRAW = (float*)(p.ws + WS_YRAW); bf16_t* C0 = (bf16_t*)(p.ws + WS_C0); bf16_t* C1 = (bf16_t*)(p.ws + WS_C1);
    float s[4];
    if (s_in) { const f32x4 t = *(const f32x4*)(s_in + (size_t)(half * 32 + row) * 64 + kq * 4); s[0] = t[0]; s[1] = t[1]; s[2] = t[2]; s[3] = t[3]; }
    else { s[0] = s[1] = s[2] = s[3] = 0.f; }
    int col = -1; float* dst = nullptr; int dstride = 64; bool is_wd = false, owner = false;
    if (tid < 64) { col = hb * 64 + tid; dst = r_s + tid; owner = half == 0; }
    else if (tid < 128) { col = 1024 + hb * 64 + (tid - 64); dst = kb_s + (tid - 64); owner = half == 0; }
    else if (tid < 192) { col = 2048 + hb * 64 + (tid - 128); dst = v_s + (tid - 128); owner = half == 0; }
    else if (tid < 256) { col = 3072 + (tid - 192); dst = wd_s + (tid - 192); is_wd = true; owner = (half == 0 && hb == 0); }
    else if (tid < 320) { col = 3136 + (tid - 256); dst = ad_s + (tid - 256); owner = (half == 0 && hb == 0); }
    else if (tid < 352) { col = 3200 + hb * 64 + half * 32 + (tid - 320); dst = zb_s + (tid - 320); dstride = 32; owner = true; }
    float mu = 0.f, prev = 0.f;
    const float* pk = (const float*)(p.ws + WS_PK);
    if (col >= 0) { mu = pk[PK_MU + col]; prev = prev_row ? bf2f(prev_row[C_RW + col]) : (halo_in ? halo_in[col] : 0.f); }
    const int cc = tid & 63, ig = tid >> 6;
    const int hc = hb * 64 + cc;
    const float w0c = pk[PK_W0 + hc], a0c = pk[PK_A0 + hc], kkc = pk[PK_KK + hc], kac = pk[PK_KA + hc];
    const float rkl = pk[PK_RK + hb * 64 + lane];
#pragma unroll 1
    for (int run = 0; run < 2; ++run) {
        const int rrow = run ? rowB : rowA, rn = run ? nB : nA; const bool wout = run != 0;
#pragma unroll 1
        for (int c0 = 0; c0 < rn; c0 += 32) {
            const int nt = (rn - c0) < 32 ? (rn - c0) : 32; const int row0 = rrow + c0;
            if (col >= 0) {
                const bf16_t* src = P + (size_t)row0 * NPB + C_RW + col;
#pragma unroll 8
                for (int i = 0; i < nt; ++i) { const float cur = bf2f(src[(size_t)i * NPB]); float m = cur + mu * (prev - cur); prev = cur; if (is_wd) m = tanh_(m); dst[i * dstride] = m; }
            }
            __syncthreads();
            {
                float aw[4] = {0.f, 0.f, 0.f, 0.f}, aa[4] = {0.f, 0.f, 0.f, 0.f};
#pragma unroll 4
                for (int l = 0; l < 64; ++l) { const float w2v = w2_s[l * 64 + cc], a2v = a2_s[l * 64 + cc];
#pragma unroll
                    for (int ii = 0; ii < 4; ++ii) { aw[ii] += wd_s[(ig * 4 + ii) * 64 + l] * w2v; aa[ii] += ad_s[(ig * 4 + ii) * 64 + l] * a2v; } }
#pragma unroll
                for (int ii = 0; ii < 4; ++ii) { const int i = ig * 4 + ii;
                    if (i < nt) { const float wraw = w0c + aw[ii]; const float wlog = -0.6065306597126334f * sigm(wraw); const float a = sigm(a0c + aa[ii]);
                        const float kbv = kb_s[i * 64 + cc];
                        dec_s[i * 64 + cc] = expf(wlog); a_s[i * 64 + cc] = a; kk_s[i * 64 + cc] = kbv * kkc; km_s[i * 64 + cc] = kbv * (1.f + (a - 1.f) * kac); } }
            }
            __syncthreads();
#pragma unroll 1
            for (int ii = 0; ii < 4; ++ii) { const int i = w * 4 + ii;
                if (i < nt) { const float kkr = kk_s[i * 64 + lane]; const float kk = kkr * __builtin_amdgcn_rsqf(wave_sum(kkr * kkr) + 1e-6f); kk_s[i * 64 + lane] = kk;
                    const float a = a_s[i * 64 + lane]; a_s[i * 64 + lane] = kk * a;
                    const float rk = wave_sum(r_s[i * 64 + lane] * km_s[i * 64 + lane] * rkl); if (lane == 0) bonus_s[i] = rk; } }
            __syncthreads();
#pragma unroll 1
            for (int i = 0; i < nt; ++i) {
                const f32x4 kk4 = *(const f32x4*)(kk_s + i * 64 + kq * 4), de4 = *(const f32x4*)(dec_s + i * 64 + kq * 4), ka4 = *(const f32x4*)(a_s + i * 64 + kq * 4),
                            km4 = *(const f32x4*)(km_s + i * 64 + kq * 4), r4 = *(const f32x4*)(r_s + i * 64 + kq * 4);
                const float vv = v_s[i * 64 + half * 32 + row];
                const float sa = rowsum16(s[0] * kk4[0] + s[1] * kk4[1] + s[2] * kk4[2] + s[3] * kk4[3]);
#pragma unroll
                for (int j = 0; j < 4; ++j) s[j] = s[j] * de4[j] + (vv * km4[j] - sa * ka4[j]);
                const float y = rowsum16(s[0] * r4[0] + s[1] * r4[1] + s[2] * r4[2] + s[3] * r4[3]);
                if (kq == 0) y_s[i * 32 + row] = y;
            }
            __syncthreads();
            if (wout) { const int i = tid >> 4;
                if (i < nt) {
#pragma unroll
                    for (int q = 0; q < 2; ++q) { const int rr = (tid & 15) * 2 + q, v = half * 32 + rr, colo = hb * 64 + v;
                        const float sz = silu_(zb_s[i * 32 + rr]);
                        const size_t o = (size_t)(row0 + i) * D + colo;
                        YRAW[o] = y_s[i * 32 + rr]; C1[o] = (bf16_t)f2bf(pk[PK_GNW + colo] * sz); C0[o] = (bf16_t)f2bf((pk[PK_GNB + colo] + bonus_s[i] * v_s[i * 64 + v]) * sz); } } }
            __syncthreads();
        }
    }
    *(f32x4*)(s_out + (size_t)(half * 32 + row) * 64 + kq * 4) = (f32x4){s[0], s[1], s[2], s[3]};
    if (col >= 0 && owner && halo_out) halo_out[col] = prev;
}


__device__ __forceinline__ bf16x8 ldfrag(const bf16_t* base, int stride, int r0, int k0, int lane) {
    return *(const bf16x8*)(base + (r0 + (lane & 15)) * stride + k0 + 8 * (lane >> 4));
}
#define MFMA16(a, b, c) __builtin_amdgcn_mfma_f32_16x16x32_bf16((a), (b), (c), 0, 0, 0)
typedef short s16x4 __attribute__((ext_vector_type(4)));
__device__ __forceinline__ bf16x8 ldfrag_tr(const bf16_t* X, int stride, int c0, int k0, int lane) {
    const int l15 = lane & 15;
    const bf16_t* a = X + (k0 + 8 * (lane >> 4) + (l15 >> 2)) * stride + c0 + 4 * (l15 & 3);
    const s16x4 lo = __builtin_amdgcn_ds_read_tr16_b64_v4i16((LAS s16x4*)a), hi = __builtin_amdgcn_ds_read_tr16_b64_v4i16((LAS s16x4*)(a + 4 * stride));
    return __builtin_shufflevector(lo, hi, 0, 1, 2, 3, 4, 5, 6, 7);
}
__device__ __forceinline__ void inv_block(const float* L, float* Tm, float* XS, int tid) {
    const int w = tid >> 6, lane = tid & 63;
    typedef float f32x2v __attribute__((ext_vector_type(2)));
    if (w < 4 && lane < 16) {
        const float* Lb = L + (16 * w) * 64 + 16 * w; float* Tb = Tm + (16 * w) * 64 + 16 * w;
        float tr[16];
#pragma unroll
        for (int i = 0; i < 16; ++i) tr[i] = 0.f;
#pragma unroll
        for (int i = 0; i < 16; ++i) { float a = (lane == i) ? 1.f : 0.f;
#pragma unroll
            for (int j0 = 0; j0 < i; j0 += 4) { const f32x4 l4 = *(const f32x4*)(Lb + i * 64 + j0);
                a -= l4[0] * tr[j0] + l4[1] * tr[j0 + 1] + l4[2] * tr[j0 + 2] + l4[3] * tr[j0 + 3]; }
            tr[i] = a; Tb[i * 64 + lane] = a; }
    }
    for (int e = tid; e < 1536; e += 512) { const int k = e >> 8, r = (e >> 4) & 15, c = e & 15;
        const int rb = k < 3 ? 0 : (k < 5 ? 1 : 2), cb = k < 3 ? k + 1 : (k < 5 ? k - 1 : 3);
        Tm[(16 * rb + r) * 64 + 16 * cb + c] = 0.f; }
    __syncthreads();
    {
        const int B = tid >> 8, i = (tid >> 4) & 15, c = tid & 15, o = 32 * B;
        float x = 0.f;
#pragma unroll
        for (int j0 = 0; j0 < 16; j0 += 4) { const f32x4 l4 = *(const f32x4*)(L + (o + 16 + i) * 64 + o + j0);
            x += l4[0] * Tm[(o + j0) * 64 + o + c] + l4[1] * Tm[(o + j0 + 1) * 64 + o + c] + l4[2] * Tm[(o + j0 + 2) * 64 + o + c] + l4[3] * Tm[(o + j0 + 3) * 64 + o + c]; }
        XS[tid] = x;
        __syncthreads();
        float t = 0.f;
#pragma unroll
        for (int j0 = 0; j0 < 16; j0 += 4) { const f32x4 t4 = *(const f32x4*)(Tm + (o + 16 + i) * 64 + o + 16 + j0);
            t += t4[0] * XS[(B << 8) + j0 * 16 + c] + t4[1] * XS[(B << 8) + (j0 + 1) * 16 + c] + t4[2] * XS[(B << 8) + (j0 + 2) * 16 + c] + t4[3] * XS[(B << 8) + (j0 + 3) * 16 + c]; }
        Tm[(o + 16 + i) * 64 + o + c] = -t;
    }
    __syncthreads();
    {
        const int i = tid >> 4, c2 = (tid & 15) * 2;
        float x0 = 0.f, x1 = 0.f;
#pragma unroll
        for (int j0 = 0; j0 < 32; j0 += 4) { const f32x4 l4 = *(const f32x4*)(L + (32 + i) * 64 + j0);
#pragma unroll
            for (int e = 0; e < 4; ++e) { const f32x2v tv = *(const f32x2v*)(Tm + (j0 + e) * 64 + c2); x0 += l4[e] * tv[0]; x1 += l4[e] * tv[1]; } }
        *(f32x2v*)(XS + i * 32 + c2) = (f32x2v){x0, x1};
        __syncthreads();
        float t0 = 0.f, t1 = 0.f;
#pragma unroll
        for (int j0 = 0; j0 < 32; j0 += 4) { const f32x4 t4 = *(const f32x4*)(Tm + (32 + i) * 64 + 32 + j0);
#pragma unroll
            for (int e = 0; e < 4; ++e) { const f32x2v xv = *(const f32x2v*)(XS + (j0 + e) * 32 + c2); t0 += t4[e] * xv[0]; t1 += t4[e] * xv[1]; } }
        *(f32x2v*)(Tm + (32 + i) * 64 + c2) = (f32x2v){-t0, -t1};
    }
    __syncthreads();
}
constexpr int PL_QS = 0, PL_R1 = 17408, PL_KT = 35840, PL_KTT = 54272, PL_VT = 72704, PL_R3 = 91136, PL_QKM = 109568, PL_TP = 118784, PL_TPP = 128000, PL_SM = 137216, PL_TM = 139264, PL_XS = 155648;
constexpr int QSTR = 136, TSTR = 72;

__device__ __forceinline__ void gdn_prep_item(const Params& p, unsigned char* smem, int h, int row_start, int npad, const bf16_t* hbase,
                                              bf16_t* halo_out, float* conv_out, unsigned char* rec) {
    const int tid = otid(), w = tid >> 6, lane = tid & 63, q4 = lane >> 4, l15 = lane & 15;
    bf16_t* qs = (bf16_t*)(smem + PL_QS); bf16_t* ks = (bf16_t*)(smem + PL_R1); bf16_t* WT = (bf16_t*)(smem + PL_KTT);     bf16_t* kts = (bf16_t*)(smem + PL_KT);
    bf16_t* vs = (bf16_t*)(smem + PL_VT);         float* Lm = (float*)(smem + PL_R3); bf16_t* UT = (bf16_t*)(smem + PL_R3); bf16_t* QKm = (bf16_t*)(smem + PL_QKM);
    bf16_t* Tp = (bf16_t*)(smem + PL_TP); bf16_t* Tpp = (bf16_t*)(smem + PL_TPP);
    float* sm = (float*)(smem + PL_SM);
    float* gcs = sm; float* bes = sm + 64; float* ssq = sm + 128; float* ssk = sm + 192; float* egs = sm + 256; float* egl_s = sm + 320; float* beg = sm + 384;
    const bf16_t* P = (const bf16_t*)(p.ws + WS_P);
    const float* pk = (const float*)(p.ws + WS_PK);
    if (w == 7) {
        const int i = lane;
        float g = 0.f, be = 0.f;
        if (i >= npad) { const size_t r = (size_t)(row_start + i - npad) * NPB; const float pa = bf2f(P[r + C_A + h]), pb = bf2f(P[r + C_B + h]);
            g = -expf(pk[PK_ALOG + h]) * softplus_(pa + pk[PK_DTB + h]); be = sigm(pb); }
        float x = g;
#pragma unroll
        for (int o = 1; o < 64; o <<= 1) { const float y = __shfl_up(x, o); if (lane >= o) x += y; }
        const float gl = __shfl(x, 63);
        gcs[lane] = x; bes[lane] = be; egs[lane] = __expf(x); egl_s[lane] = __expf(gl - x); beg[lane] = be * __expf(x);
        if (lane == 0) *(float*)(rec + GP_EGL) = __expf(gl);
    }
    if (npad == 0 && tid >= 384) {
#pragma unroll
        for (int k = 0; k < 4; ++k) {
            const int slot = (tid - 384) + 128 * k, t = slot >> 3, g = slot & 7;
            const bf16_t* zp = P + (size_t)(row_start + t) * NPB + C_Z + h * 128 + 16 * g;
            const u32x4 z0 = *(const u32x4*)zp, z1 = *(const u32x4*)(zp + 8);
            float za[8], zb[8]; unpack8(z0, za); unpack8(z1, zb);
            const float* nwp = pk + PK_NORMW + 16 * g;
            float ga[8], gb2[8];
#pragma unroll
            for (int e = 0; e < 8; ++e) { ga[e] = nwp[e] * silu_(za[e]); gb2[e] = nwp[8 + e] * silu_(zb[e]); }
            bf16_t* gp = (bf16_t*)(rec + GP_G) + t * 128 + 16 * g;
            *(u32x4*)gp = pack8(ga); *(u32x4*)(gp + 8) = pack8(gb2);
        }
    }
    float y[8][8];
    const int sec = tid >> 7, t0 = 8 * ((tid >> 4) & 7), d0 = l15 * 8;
    if (tid < 384) {
        const int pcol = sec * 1024 + h * 128 + d0;
        float cw[4][8];
#pragma unroll
        for (int j = 0; j < 4; ++j) { const f32x4 a = *(const f32x4*)(pk + PK_CONVW + j * 3072 + pcol), b = *(const f32x4*)(pk + PK_CONVW + j * 3072 + pcol + 4);
            cw[j][0] = a[0]; cw[j][1] = a[1]; cw[j][2] = a[2]; cw[j][3] = a[3]; cw[j][4] = b[0]; cw[j][5] = b[1]; cw[j][6] = b[2]; cw[j][7] = b[3]; }
        u32x4 rw[11]; float fv[11];
#pragma unroll
        for (int k = 0; k < 11; ++k) {
            const int ii = t0 - 3 + k;
            const bf16_t* ptr = P + pcol; float f = 0.f;
            if (ii >= npad) { ptr = P + (size_t)(row_start + ii - npad) * NPB + pcol; f = 1.f; }
            else if (ii < 0 && npad == 0 && hbase) { ptr = hbase + (size_t)(ii + 3) * NPB + pcol; f = 1.f; }
            rw[k] = *(const u32x4*)ptr; fv[k] = f;
        }
        if (halo_out && t0 == 56) {
#pragma unroll
            for (int dd = 0; dd < 3; ++dd) { *(u32x4*)(halo_out + (size_t)dd * NPB + pcol) = rw[8 + dd];
                if (conv_out) { float x[8]; unpack8(rw[8 + dd], x); *(f32x4*)(conv_out + dd * 3072 + pcol) = (f32x4){x[0], x[1], x[2], x[3]}; *(f32x4*)(conv_out + dd * 3072 + pcol + 4) = (f32x4){x[4], x[5], x[6], x[7]}; } }
        }
#pragma unroll
        for (int t = 0; t < 8; ++t)
#pragma unroll
            for (int e = 0; e < 8; ++e) y[t][e] = 0.f;
#pragma unroll
        for (int k = 0; k < 11; ++k) { float x[8]; unpack8(rw[k], x);
#pragma unroll
            for (int e = 0; e < 8; ++e) x[e] *= fv[k];
#pragma unroll
            for (int dlt = 0; dlt < 4; ++dlt) { const int t = k - dlt;
                if (t >= 0 && t < 8) {
#pragma unroll
                    for (int e = 0; e < 8; ++e) y[t][e] += cw[dlt][e] * x[e]; } }
        }
        const float qsc = sec == 0 ? 0.08838834764831845f : 1.f;
#pragma unroll
        for (int t = 0; t < 8; ++t) {
            const bool tokv = (t0 + t) >= npad;
            float ss = 0.f;
#pragma unroll
            for (int e = 0; e < 8; ++e) { y[t][e] = tokv ? silu_(y[t][e]) : 0.f; ss += y[t][e] * y[t][e]; }
            if (sec < 2) { const float sc = __builtin_amdgcn_rsqf(rowsum16(ss) + 1e-6f) * qsc;
#pragma unroll
                for (int e = 0; e < 8; ++e) y[t][e] *= sc; }
        }
        { bf16_t* dst = sec == 0 ? qs : (sec == 1 ? ks : vs);
#pragma unroll
            for (int t = 0; t < 8; ++t) *(u32x4*)(dst + (t0 + t) * QSTR + d0) = pack8(y[t]); }
    }
    __syncthreads();
    if (sec == 1) {
#pragma unroll
        for (int t = 0; t < 8; ++t) { const float eg = egl_s[t0 + t]; float z[8];
#pragma unroll
            for (int e = 0; e < 8; ++e) z[e] = y[t][e] * eg;
            *(u32x4*)(kts + (t0 + t) * QSTR + d0) = pack8(z); } }
    {
        const int which = w >> 2, it = w & 3;
        const bf16_t* Barr = which ? qs : ks;
        bf16x8 bfr[4];
#pragma unroll
        for (int kk = 0; kk < 4; ++kk) bfr[kk] = ldfrag(Barr, QSTR, 16 * it, 32 * kk, lane);
        const int i = 16 * it + l15; const float gi = gcs[i], bi = bes[i];
#pragma unroll
        for (int jt = 0; jt < 4; ++jt) {
            f32x4 acc = {0.f, 0.f, 0.f, 0.f};
#pragma unroll
            for (int kk = 0; kk < 4; ++kk) acc = MFMA16(ldfrag(ks, QSTR, 16 * jt, 32 * kk, lane), bfr[kk], acc);
            const int j0 = 16 * jt + 4 * q4; const f32x4 gj = *(const f32x4*)(gcs + j0);
            f32x4 o;
#pragma unroll
            for (int r = 0; r < 4; ++r) { const int j = j0 + r; const bool keep = which ? (i >= j) : (i > j); o[r] = keep ? acc[r] * __expf(gi - gj[r]) : 0.f; }
            if (which == 0) *(f32x4*)(Lm + i * 64 + j0) = o * bi;
            else *(u32x2*)(QKm + i * TSTR + j0) = (u32x2){pk2(o[0], o[1]), pk2(o[2], o[3])};
        }
    }
    __syncthreads();
    {
        float* Tm = (float*)(smem + PL_TM);
        inv_block(Lm, Tm, (float*)(smem + PL_XS), tid);
        const int i = tid >> 3, j0 = (tid & 7) * 8;
        float a[8], b2[8];
#pragma unroll
        for (int e = 0; e < 8; ++e) { const float tv = Tm[i * 64 + j0 + e]; a[e] = tv * beg[j0 + e]; b2[e] = tv * bes[j0 + e]; }
        *(u32x4*)(Tp + i * TSTR + j0) = (u32x4){pk2(a[0], a[1]), pk2(a[2], a[3]), pk2(a[4], a[5]), pk2(a[6], a[7])};
        *(u32x4*)(Tpp + i * TSTR + j0) = (u32x4){pk2(b2[0], b2[1]), pk2(b2[2], b2[3]), pk2(b2[4], b2[5]), pk2(b2[6], b2[7])};
    }
    __syncthreads();
    {
        const int it = w & 3, half = w >> 2;
        f32x4 aw[4], au[4];
#pragma unroll
        for (int x = 0; x < 4; ++x) { aw[x] = (f32x4){0.f, 0.f, 0.f, 0.f}; au[x] = (f32x4){0.f, 0.f, 0.f, 0.f}; }
#pragma unroll
        for (int kk = 0; kk < 2; ++kk) {
            const bf16x8 a1 = ldfrag(Tp, TSTR, 16 * it, 32 * kk, lane), a2 = ldfrag(Tpp, TSTR, 16 * it, 32 * kk, lane);
#pragma unroll
            for (int x = 0; x < 4; ++x) { const int dt = half * 4 + x;
                aw[x] = MFMA16(a1, ldfrag_tr(ks, QSTR, 16 * dt, 32 * kk, lane), aw[x]);
                au[x] = MFMA16(a2, ldfrag_tr(vs, QSTR, 16 * dt, 32 * kk, lane), au[x]); }
        }
#pragma unroll
        for (int x = 0; x < 4; ++x) { const int d = 16 * (half * 4 + x) + l15, i0 = 16 * it + 4 * q4;
            *(u32x2*)(WT + d * TSTR + i0) = (u32x2){pk2(aw[x][0], aw[x][1]), pk2(aw[x][2], aw[x][3])};
            *(u32x2*)(UT + d * TSTR + i0) = (u32x2){pk2(au[x][0], au[x][1]), pk2(au[x][2], au[x][3])}; }
    }
    __syncthreads();
    {
        bf16_t* gAP = (bf16_t*)(rec + GP_AP); bf16_t* gQH = (bf16_t*)(rec + GP_QH); bf16_t* gKH = (bf16_t*)(rec + GP_KH); bf16_t* gOH = (bf16_t*)(rec + GP_OH);
        {
            const int et = w;
            const bf16x8 a0 = ldfrag(WT, TSTR, 16 * et, 0, lane), a1 = ldfrag(WT, TSTR, 16 * et, 32, lane);
#pragma unroll
            for (int dt = 0; dt < 8; ++dt) { f32x4 acc = {0.f, 0.f, 0.f, 0.f};
                acc = MFMA16(a0, ldfrag_tr(kts, QSTR, 16 * dt, 0, lane), acc); acc = MFMA16(a1, ldfrag_tr(kts, QSTR, 16 * dt, 32, lane), acc);
                *(u32x2*)(gAP + ((size_t)(dt * 4 + (et >> 1)) * 64 + lane) * 8 + (et & 1) * 4) = (u32x2){pk2(-acc[0], -acc[1]), pk2(-acc[2], -acc[3])}; }
#pragma unroll
            for (int tt = 0; tt < 4; ++tt) { f32x4 acc = {0.f, 0.f, 0.f, 0.f};
                acc = MFMA16(a0, ldfrag(QKm, TSTR, 16 * tt, 0, lane), acc); acc = MFMA16(a1, ldfrag(QKm, TSTR, 16 * tt, 32, lane), acc);
                const int t = 16 * tt + l15, e0 = 16 * et + 4 * q4; const float eg = egs[t];
                const u32x2 qq = *(const u32x2*)(qs + t * QSTR + e0);
                const float o0 = __uint_as_float(qq.x << 16) * eg - acc[0], o1 = __uint_as_float(qq.x & 0xffff0000u) * eg - acc[1],
                            o2 = __uint_as_float(qq.y << 16) * eg - acc[2], o3 = __uint_as_float(qq.y & 0xffff0000u) * eg - acc[3];
                *(u32x2*)(gQH + ((size_t)(tt * 4 + (et >> 1)) * 64 + lane) * 8 + (et & 1) * 4) = (u32x2){pk2(o0, o1), pk2(o2, o3)}; }
        }
        {
            const int dt = w;
            const bf16x8 a0 = ldfrag_tr(kts, QSTR, 16 * dt, 0, lane), a1 = ldfrag_tr(kts, QSTR, 16 * dt, 32, lane);
#pragma unroll
            for (int vt = 0; vt < 8; ++vt) { f32x4 acc = {0.f, 0.f, 0.f, 0.f};
                acc = MFMA16(a0, ldfrag(UT, TSTR, 16 * vt, 0, lane), acc); acc = MFMA16(a1, ldfrag(UT, TSTR, 16 * vt, 32, lane), acc);
                *(u32x2*)(gKH + ((size_t)(vt * 8 + dt) * 64 + lane) * 4) = (u32x2){pk2(acc[0], acc[1]), pk2(acc[2], acc[3])}; }
            const int tt = w & 3, vh = w >> 2;
            const bf16x8 b0 = ldfrag(QKm, TSTR, 16 * tt, 0, lane), b1 = ldfrag(QKm, TSTR, 16 * tt, 32, lane);
#pragma unroll
            for (int x = 0; x < 4; ++x) { const int vt = vh * 4 + x; f32x4 acc = {0.f, 0.f, 0.f, 0.f};
                acc = MFMA16(b0, ldfrag(UT, TSTR, 16 * vt, 0, lane), acc); acc = MFMA16(b1, ldfrag(UT, TSTR, 16 * vt, 32, lane), acc);
                *(u32x2*)(gOH + ((size_t)(vt * 4 + tt) * 64 + lane) * 4) = (u32x2){pk2(acc[0], acc[1]), pk2(acc[2], acc[3])}; }
        }
    }
    __syncthreads();
}

__device__ __forceinline__ void phase_gprep(const Params& p, int seg, unsigned char* smem) {
    const int blk = obid();
    const int n_items = (CPS + (seg == 0 ? 1 : 0)) * 64;
#pragma unroll 1
    for (int it = blk; it < n_items; it += gridDim.x) {
        const int bh = it & 63, b = bh >> 3, h = bh & 7; int cl = it >> 6; if (seg != 0) cl += 1;
        unsigned char* rec = p.ws + WS_GP + (size_t)(cl * 64 + bh) * GP_STRIDE;
        const bf16_t* Pb = (const bf16_t*)(p.ws + WS_P);
        bf16_t* chalo2 = (bf16_t*)(p.ws + WS_CHALO);
        if (cl == 0) gdn_prep_item(p, smem, h, LEX0, 48, nullptr, nullptr, nullptr, rec);
        else {
            const int row = b * SEGTOK + (cl - 1) * 64;
            const bf16_t* hbase = Pb + (size_t)(row - 3) * NPB;
            if (cl == 1) hbase = (seg == 0) ? Pb + (size_t)(LEX0 + NMETA - 3) * NPB : chalo2 + (size_t)(((seg - 1) & 1) * NBATCH + b) * 3 * NPB;
            bf16_t* ho = (cl == CPS) ? chalo2 + (size_t)((seg & 1) * NBATCH + b) * 3 * NPB : nullptr;
            float* co = (cl == CPS && seg == NSEG - 1) ? p.out + O_CONV_P + (size_t)b * 9216 : nullptr;
            gdn_prep_item(p, smem, h, row, 0, hbase, ho, co, rec);
        }
    }
}

__device__ __forceinline__ void gdn_scan_block(const Params& p, int seg, unsigned char* smem, int bh) {
    const int tid = otid(), w = tid >> 6, lane = tid & 63, q4 = lane >> 4, l15 = lane & 15;
    const int b = bh >> 3, h = bh & 7;
    float* st = p.out + O_GDN_P + (size_t)bh * 16384;
    f32x4 S[8];
    if (seg) {
#pragma unroll
        for (int mt = 0; mt < 8; ++mt)
#pragma unroll
            for (int r = 0; r < 4; ++r) S[mt][r] = st[(size_t)(16 * mt + 4 * q4 + r) * 128 + 16 * w + l15];
    } else {
#pragma unroll
        for (int mt = 0; mt < 8; ++mt) S[mt] = (f32x4){0.f, 0.f, 0.f, 0.f};
    }
    const int c_lo = seg ? 1 : 0;
    float* obuf = (float*)(smem + 98304);
    {
        const u32x4* src = (const u32x4*)(p.ws + WS_GP + (size_t)(c_lo * 64 + bh) * GP_STRIDE); u32x4* dst = (u32x4*)smem;
#pragma unroll
        for (int x = 0; x < 6; ++x) dst[tid + 512 * x] = src[tid + 512 * x];
    }
#pragma unroll 1
    for (int cl = c_lo; cl <= CPS; ++cl) {
        const unsigned char* rec = p.ws + WS_GP + (size_t)(cl * 64 + bh) * GP_STRIDE;
        const int cur = (cl - c_lo) & 1;
        __syncthreads();
        u32x4 nx[6];
        const bool more = cl < CPS;
        if (more) { const u32x4* src = (const u32x4*)(rec + GP_STRIDE * 64);
#pragma unroll
            for (int x = 0; x < 6; ++x) nx[x] = src[tid + 512 * x]; }
        const bf16_t* gKH = (const bf16_t*)(rec + GP_KH); const bf16_t* gOH = (const bf16_t*)(rec + GP_OH);
        u32x2 kh[8], oh[4];
#pragma unroll
        for (int mt = 0; mt < 8; ++mt) kh[mt] = *(const u32x2*)(gKH + ((size_t)(w * 8 + mt) * 64 + lane) * 4);
#pragma unroll
        for (int tt = 0; tt < 4; ++tt) oh[tt] = *(const u32x2*)(gOH + ((size_t)(w * 4 + tt) * 64 + lane) * 4);
        const float egl = *(const float*)(rec + GP_EGL);
        const int et = tid >> 3, eg = tid & 7;
        const bf16_t* gp = (const bf16_t*)(rec + GP_G) + et * 128 + 16 * eg;
        u32x4 z0 = {0u, 0u, 0u, 0u}, z1 = {0u, 0u, 0u, 0u};
        if (cl > 0) { z0 = *(const u32x4*)gp; z1 = *(const u32x4*)(gp + 8); }
        bf16x8 Bf[4];
#pragma unroll
        for (int ks = 0; ks < 4; ++ks) { u32x4 t; t.x = pk2(S[2 * ks][0], S[2 * ks][1]); t.y = pk2(S[2 * ks][2], S[2 * ks][3]); t.z = pk2(S[2 * ks + 1][0], S[2 * ks + 1][1]); t.w = pk2(S[2 * ks + 1][2], S[2 * ks + 1][3]);
            Bf[ks] = __builtin_bit_cast(bf16x8, t); }
        const bf16x8* AP = (const bf16x8*)(smem + cur * 49152); const bf16x8* QH = (const bf16x8*)(smem + cur * 49152 + GP_QH);
        f32x4 o[4], tS[8];
#pragma unroll
        for (int tt = 0; tt < 4; ++tt) { o[tt] = (f32x4){0.f, 0.f, 0.f, 0.f};
#pragma unroll
            for (int ks = 0; ks < 4; ++ks) o[tt] = MFMA16(QH[(tt * 4 + ks) * 64 + lane], Bf[ks], o[tt]); }
#pragma unroll
        for (int mt = 0; mt < 8; ++mt) { tS[mt] = (f32x4){0.f, 0.f, 0.f, 0.f};
#pragma unroll
            for (int ks = 0; ks < 4; ++ks) tS[mt] = MFMA16(AP[(mt * 4 + ks) * 64 + lane], Bf[ks], tS[mt]); }
#pragma unroll
        for (int mt = 0; mt < 8; ++mt) {
            S[mt][0] = egl * S[mt][0] + tS[mt][0] + __uint_as_float(kh[mt].x << 16); S[mt][1] = egl * S[mt][1] + tS[mt][1] + __uint_as_float(kh[mt].x & 0xffff0000u);
            S[mt][2] = egl * S[mt][2] + tS[mt][2] + __uint_as_float(kh[mt].y << 16); S[mt][3] = egl * S[mt][3] + tS[mt][3] + __uint_as_float(kh[mt].y & 0xffff0000u); }
        if (cl > 0) {
#pragma unroll
            for (int tt = 0; tt < 4; ++tt) {
                o[tt][0] += __uint_as_float(oh[tt].x << 16); o[tt][1] += __uint_as_float(oh[tt].x & 0xffff0000u); o[tt][2] += __uint_as_float(oh[tt].y << 16); o[tt][3] += __uint_as_float(oh[tt].y & 0xffff0000u);
#pragma unroll
                for (int r = 0; r < 4; ++r) obuf[(16 * tt + 4 * q4 + r) * 132 + 16 * w + l15] = o[tt][r]; }
        }
        if (more) { u32x4* dst = (u32x4*)(smem + (cur ^ 1) * 49152);
#pragma unroll
            for (int x = 0; x < 6; ++x) dst[tid + 512 * x] = nx[x]; }
        if (cl > 0) {
            __syncthreads();
            f32x4 ov[4]; float ss = 0.f;
#pragma unroll
            for (int j = 0; j < 4; ++j) { ov[j] = *(const f32x4*)(obuf + et * 132 + 16 * eg + 4 * j); ss += ov[j][0] * ov[j][0] + ov[j][1] * ov[j][1] + ov[j][2] * ov[j][2] + ov[j][3] * ov[j][3]; }
            ss += __shfl_xor(ss, 1); ss += __shfl_xor(ss, 2); ss += __shfl_xor(ss, 4);
            const float rs = __builtin_amdgcn_rsqf(ss * (1.f / 128.f) + 1e-6f);
            const unsigned zz[8] = {z0.x, z0.y, z0.z, z0.w, z1.x, z1.y, z1.z, z1.w};
            unsigned ow[8];
#pragma unroll
            for (int j = 0; j < 8; ++j) ow[j] = pk2(ov[j >> 1][(j & 1) * 2] * rs * __uint_as_float(zz[j] << 16), ov[j >> 1][(j & 1) * 2 + 1] * rs * __uint_as_float(zz[j] & 0xffff0000u));
            const size_t grow = (size_t)b * SEQ + seg * SEGTOK + (cl - 1) * 64 + et;
            bf16_t* oa = (bf16_t*)(p.ws + WS_H) + grow * D + h * 128 + 16 * eg;
            *(u32x4*)oa = (u32x4){ow[0], ow[1], ow[2], ow[3]}; *(u32x4*)(oa + 8) = (u32x4){ow[4], ow[5], ow[6], ow[7]};
        }
    }
#pragma unroll
    for (int mt = 0; mt < 8; ++mt)
#pragma unroll
        for (int r = 0; r < 4; ++r) st[(size_t)(16 * mt + 4 * q4 + r) * 128 + 16 * w + l15] = S[mt][r];
    __syncthreads();
}

constexpr int RL_AT = 0, RL_BT = 9216, RL_KT = 18432, RL_ATT = 27648, RL_RT = 36864, RL_BTLT = 46080, RL_KTLT = 55296, RL_VT = 64512, RL_LAK = 73728, RL_MRB = 82944, RL_MRK = 92160,
              RL_LM = 101376, RL_AF = 117760, RL_TM = 134144, RL_XS = 150528;
__device__ __forceinline__ void rwkv_prep_item(const Params& p, unsigned char* smem, int hb, int row_start, int npad, const bf16_t* prev_row,
                                               bf16_t* halo_out, unsigned char* rec) {
    const int tid = otid(), w = tid >> 6, lane = tid & 63, q4 = lane >> 4, l15 = lane & 15;
    bf16_t* At = (bf16_t*)(smem + RL_AT); bf16_t* Tb = At; bf16_t* Bt = (bf16_t*)(smem + RL_BT); bf16_t* WaT = Bt; bf16_t* Kt = (bf16_t*)(smem + RL_KT); bf16_t* XT = Kt;
    bf16_t* At2 = (bf16_t*)(smem + RL_ATT); bf16_t* Rt = (bf16_t*)(smem + RL_RT); bf16_t* Btl = (bf16_t*)(smem + RL_BTLT); bf16_t* Ktl = (bf16_t*)(smem + RL_KTLT);
    bf16_t* Vr = (bf16_t*)(smem + RL_VT);        bf16_t* Lak = (bf16_t*)(smem + RL_LAK); bf16_t* Mrb = (bf16_t*)(smem + RL_MRB); bf16_t* Mrk = (bf16_t*)(smem + RL_MRK);
    float* Lm = (float*)(smem + RL_LM);
    bf16_t* thw = Lak; bf16_t* adb = Mrb; float* lc = Lm; float* af = (float*)(smem + RL_AF);
    const bf16_t* P = (const bf16_t*)(p.ws + WS_P);
    const float* pk = (const float*)(p.ws + WS_PK);
    const int t = tid >> 3, g = tid & 7;
    float rr[8], kb[8], vv[8], zb[8];
    {
        const bool real = t >= npad;
        const bf16_t* curp = P; const bf16_t* prevp = P; float fprev = 0.f;
        if (real) { curp = P + (size_t)(row_start + t - npad) * NPB; if (t > npad) { prevp = curp - NPB; fprev = 1.f; } else if (prev_row) { prevp = prev_row; fprev = 1.f; } }
        const int secbase[6] = {0, 1024, 2048, 3200, 3072, 3136};
        u32x4 rc[6], rp[6];
#pragma unroll
        for (int sidx = 0; sidx < 6; ++sidx) { const int col = secbase[sidx] + (sidx < 4 ? hb * 64 : 0) + g * 8; rc[sidx] = *(const u32x4*)(curp + C_RW + col); rp[sidx] = *(const u32x4*)(prevp + C_RW + col); }
        float m[6][8];
#pragma unroll
        for (int sidx = 0; sidx < 6; ++sidx) {
            const int col = secbase[sidx] + (sidx < 4 ? hb * 64 : 0) + g * 8;
            float cur[8], prv[8];
            unpack8(rc[sidx], cur); unpack8(rp[sidx], prv);
            const f32x4 mu0 = *(const f32x4*)(pk + PK_MU + col), mu1 = *(const f32x4*)(pk + PK_MU + col + 4);
            const float mu[8] = {mu0[0], mu0[1], mu0[2], mu0[3], mu1[0], mu1[1], mu1[2], mu1[3]};
#pragma unroll
            for (int e = 0; e < 8; ++e) m[sidx][e] = real ? cur[e] + mu[e] * (fprev * prv[e] - cur[e]) : 0.f;
            if (halo_out && t == 63 && (sidx < 4 || hb == 0)) *(u32x4*)(halo_out + C_RW + col) = rc[sidx];
        }
#pragma unroll
        for (int e = 0; e < 8; ++e) { rr[e] = m[0][e]; kb[e] = m[1][e]; vv[e] = m[2][e]; zb[e] = m[3][e]; }
        float th[8];
#pragma unroll
        for (int e = 0; e < 8; ++e) th[e] = tanh_(m[4][e]);
        *(u32x4*)(thw + t * TSTR + g * 8) = pack8(th);
        *(u32x4*)(adb + t * TSTR + g * 8) = pack8(m[5]);
    }
    __syncthreads();
    {
        const int which = w >> 2, ct = w & 3;
        const bf16_t* Wt = (const bf16_t*)(p.ws + (which ? WS_A2T : WS_W2T)) + (size_t)hb * 4096;
        const bf16x8 b0 = *(const bf16x8*)(Wt + (16 * ct + l15) * 64 + 8 * q4), b1 = *(const bf16x8*)(Wt + (16 * ct + l15) * 64 + 32 + 8 * q4);
        const bf16_t* Aarr = which ? adb : thw;
        const int c = 16 * ct + l15;
        const float bias = pk[(which ? PK_A0 : PK_W0) + hb * 64 + c];
        float carry = 0.f;
#pragma unroll
        for (int tt = 0; tt < 4; ++tt) {
            f32x4 acc = {0.f, 0.f, 0.f, 0.f};
            acc = MFMA16(ldfrag(Aarr, TSTR, 16 * tt, 0, lane), b0, acc); acc = MFMA16(ldfrag(Aarr, TSTR, 16 * tt, 32, lane), b1, acc);
            if (which) {
#pragma unroll
                for (int r = 0; r < 4; ++r) af[(16 * tt + 4 * q4 + r) * 64 + c] = sigm(bias + acc[r]);
            } else {
                float wl[4];
#pragma unroll
                for (int r = 0; r < 4; ++r) { const int tk = 16 * tt + 4 * q4 + r; wl[r] = (tk < npad) ? 0.f : -0.6065306597126334f * sigm(bias + acc[r]); }
                wl[1] += wl[0]; wl[2] += wl[1]; wl[3] += wl[2];
                const float Q = wl[3];
                const float Q0 = __shfl(Q, l15), Q1 = __shfl(Q, l15 + 16), Q2 = __shfl(Q, l15 + 32), Q3 = __shfl(Q, l15 + 48);
                const float ex = carry + (q4 > 0 ? Q0 : 0.f) + (q4 > 1 ? Q1 : 0.f) + (q4 > 2 ? Q2 : 0.f);
#pragma unroll
                for (int r = 0; r < 4; ++r) lc[(16 * tt + 4 * q4 + r) * 64 + c] = ex + wl[r];
                carry += Q0 + Q1 + Q2 + Q3;
            }
        }
    }
    __syncthreads();
    {
        float lct[8], lcp[8], lcC[8], av[8];
        { const f32x4 a = *(const f32x4*)(lc + t * 64 + g * 8), b2 = *(const f32x4*)(lc + t * 64 + g * 8 + 4); lct[0] = a[0]; lct[1] = a[1]; lct[2] = a[2]; lct[3] = a[3]; lct[4] = b2[0]; lct[5] = b2[1]; lct[6] = b2[2]; lct[7] = b2[3]; }
        if (t > 0) { const f32x4 a = *(const f32x4*)(lc + (t - 1) * 64 + g * 8), b2 = *(const f32x4*)(lc + (t - 1) * 64 + g * 8 + 4); lcp[0] = a[0]; lcp[1] = a[1]; lcp[2] = a[2]; lcp[3] = a[3]; lcp[4] = b2[0]; lcp[5] = b2[1]; lcp[6] = b2[2]; lcp[7] = b2[3]; }
        else {
#pragma unroll
            for (int e = 0; e < 8; ++e) lcp[e] = 0.f; }
        { const f32x4 a = *(const f32x4*)(lc + 63 * 64 + g * 8), b2 = *(const f32x4*)(lc + 63 * 64 + g * 8 + 4); lcC[0] = a[0]; lcC[1] = a[1]; lcC[2] = a[2]; lcC[3] = a[3]; lcC[4] = b2[0]; lcC[5] = b2[1]; lcC[6] = b2[2]; lcC[7] = b2[3]; }
        { const f32x4 a = *(const f32x4*)(af + t * 64 + g * 8), b2 = *(const f32x4*)(af + t * 64 + g * 8 + 4); av[0] = a[0]; av[1] = a[1]; av[2] = a[2]; av[3] = a[3]; av[4] = b2[0]; av[5] = b2[1]; av[6] = b2[2]; av[7] = b2[3]; }
        const int hc = hb * 64 + g * 8;
        float kk[8], km[8], ss = 0.f, rk = 0.f;
        float pkk[8], pka[8], prk[8];
        { const f32x4 a0 = *(const f32x4*)(pk + PK_KK + hc), a1 = *(const f32x4*)(pk + PK_KK + hc + 4), b0 = *(const f32x4*)(pk + PK_KA + hc), b1 = *(const f32x4*)(pk + PK_KA + hc + 4), c0v = *(const f32x4*)(pk + PK_RK + hc), c1v = *(const f32x4*)(pk + PK_RK + hc + 4);
#pragma unroll
          for (int e = 0; e < 4; ++e) { pkk[e] = a0[e]; pkk[4 + e] = a1[e]; pka[e] = b0[e]; pka[4 + e] = b1[e]; prk[e] = c0v[e]; prk[4 + e] = c1v[e]; } }
#pragma unroll
        for (int e = 0; e < 8; ++e) { kk[e] = kb[e] * pkk[e]; ss += kk[e] * kk[e]; km[e] = kb[e] * (1.f + (av[e] - 1.f) * pka[e]); rk += rr[e] * km[e] * prk[e]; }
        ss += __shfl_xor(ss, 1); ss += __shfl_xor(ss, 2); ss += __shfl_xor(ss, 4);
        rk += __shfl_xor(rk, 1); rk += __shfl_xor(rk, 2); rk += __shfl_xor(rk, 4);
        const float kn = __builtin_amdgcn_rsqf(ss + 1e-6f);
        float xa[8], xb[8], xk[8], xr[8], xbt[8], xkt[8];
#pragma unroll
        for (int e = 0; e < 8; ++e) { kk[e] *= kn; const float ka = kk[e] * av[e]; const float ip = __expf(-lct[e]), tl = __expf(lcC[e] - lct[e]);
            xa[e] = kk[e] * __expf(lcp[e]); xb[e] = ka * ip; xk[e] = km[e] * ip; xr[e] = rr[e] * __expf(lct[e]); xbt[e] = ka * tl; xkt[e] = km[e] * tl; }
        *(u32x4*)(At + t * TSTR + g * 8) = pack8(xa); *(u32x4*)(Bt + t * TSTR + g * 8) = pack8(xb); *(u32x4*)(Kt + t * TSTR + g * 8) = pack8(xk); *(u32x4*)(Rt + t * TSTR + g * 8) = pack8(xr);
        *(u32x4*)(At2 + t * TSTR + g * 8) = pack8(xa); *(u32x4*)(Btl + t * TSTR + g * 8) = pack8(xbt); *(u32x4*)(Ktl + t * TSTR + g * 8) = pack8(xkt); *(u32x4*)(Vr + t * TSTR + g * 8) = pack8(vv);
        float c1[8], c0[8];
#pragma unroll
        for (int e = 0; e < 8; ++e) { c1[e] = 0.f; c0[e] = 0.f; }
        { const f32x4 g0 = *(const f32x4*)(pk + PK_GNW + hc), g1 = *(const f32x4*)(pk + PK_GNW + hc + 4), h0 = *(const f32x4*)(pk + PK_GNB + hc), h1 = *(const f32x4*)(pk + PK_GNB + hc + 4);
#pragma unroll
          for (int e = 0; e < 4; ++e) { const float sz0 = silu_(zb[e]), sz1 = silu_(zb[4 + e]); c1[e] = g0[e] * sz0; c1[4 + e] = g1[e] * sz1; c0[e] = (h0[e] + rk * vv[e]) * sz0; c0[4 + e] = (h1[e] + rk * vv[4 + e]) * sz1; } }
        *(u32x4*)((bf16_t*)(rec + RP_C1) + t * 64 + g * 8) = pack8(c1); *(u32x4*)((bf16_t*)(rec + RP_C0) + t * 64 + g * 8) = pack8(c0);
        if (t == 63) { float* pc = (float*)(rec + RP_PC) + g * 8; *(f32x4*)pc = (f32x4){__expf(lcC[0]), __expf(lcC[1]), __expf(lcC[2]), __expf(lcC[3])}; *(f32x4*)(pc + 4) = (f32x4){__expf(lcC[4]), __expf(lcC[5]), __expf(lcC[6]), __expf(lcC[7])}; }
    }
    __syncthreads();
    {
        const int pr = w >> 1;
        const bf16_t* Aarr = pr < 2 ? At : Rt; const bf16_t* Barr = (pr & 1) ? Kt : Bt;
#pragma unroll
        for (int x = 0; x < 2; ++x) { const int tt = 2 * (w & 1) + x;
            const bf16x8 a0 = ldfrag(Aarr, TSTR, 16 * tt, 0, lane), a1 = ldfrag(Aarr, TSTR, 16 * tt, 32, lane);
            const int tk = 16 * tt + l15;
#pragma unroll
            for (int it = 0; it < 4; ++it) { f32x4 acc = {0.f, 0.f, 0.f, 0.f};
                acc = MFMA16(ldfrag(Barr, TSTR, 16 * it, 0, lane), a0, acc); acc = MFMA16(ldfrag(Barr, TSTR, 16 * it, 32, lane), a1, acc);
                const int i0 = 16 * it + 4 * q4;
                f32x4 o;
#pragma unroll
                for (int r = 0; r < 4; ++r) { const int i = i0 + r; const bool keep = pr < 2 ? (tk > i) : (tk >= i); o[r] = keep ? acc[r] : 0.f; }
                if (pr == 0) *(f32x4*)(Lm + tk * 64 + i0) = o;
                else { bf16_t* Out = pr == 1 ? Lak : (pr == 2 ? Mrb : Mrk); *(u32x2*)(Out + tk * TSTR + i0) = (u32x2){pk2(o[0], o[1]), pk2(o[2], o[3])}; } }
        }
    }
    __syncthreads();
    {
        float* Tm = (float*)(smem + RL_TM);
        inv_block(Lm, Tm, (float*)(smem + RL_XS), tid);
        const int i = tid >> 3, j0 = (tid & 7) * 8;
        float a[8];
#pragma unroll
        for (int e = 0; e < 8; ++e) a[e] = Tm[i * 64 + j0 + e];
        *(u32x4*)(Tb + i * TSTR + j0) = pack8(a);
    }
    __syncthreads();
    {
        const int tt = w & 3, which = w >> 2;
        const bf16_t* Aarr = which ? Lak : Tb; const bf16_t* Barr = which ? Vr : At2; bf16_t* Out = which ? XT : WaT;
        const bf16x8 a0 = ldfrag(Aarr, TSTR, 16 * tt, 0, lane), a1 = ldfrag(Aarr, TSTR, 16 * tt, 32, lane);
#pragma unroll
        for (int ct = 0; ct < 4; ++ct) { f32x4 acc = {0.f, 0.f, 0.f, 0.f};
            acc = MFMA16(a0, ldfrag_tr(Barr, TSTR, 16 * ct, 0, lane), acc); acc = MFMA16(a1, ldfrag_tr(Barr, TSTR, 16 * ct, 32, lane), acc);
            *(u32x2*)(Out + (16 * ct + l15) * TSTR + 16 * tt + 4 * q4) = (u32x2){pk2(acc[0], acc[1]), pk2(acc[2], acc[3])}; }
    }
    __syncthreads();
    {
        f32x4 acc[4];
        if (w < 4) {
            const bf16x8 a0 = ldfrag(Tb, TSTR, 16 * w, 0, lane), a1 = ldfrag(Tb, TSTR, 16 * w, 32, lane);
#pragma unroll
            for (int ct = 0; ct < 4; ++ct) { acc[ct] = (f32x4){0.f, 0.f, 0.f, 0.f};
                acc[ct] = MFMA16(a0, ldfrag(XT, TSTR, 16 * ct, 0, lane), acc[ct]); acc[ct] = MFMA16(a1, ldfrag(XT, TSTR, 16 * ct, 32, lane), acc[ct]); }
        }
        if (w < 4) {
            bf16_t* UvTw = (bf16_t*)(smem + RL_LM);
#pragma unroll
            for (int ct = 0; ct < 4; ++ct) *(u32x2*)(UvTw + (16 * ct + l15) * TSTR + 16 * w + 4 * q4) = (u32x2){pk2(-acc[ct][0], -acc[ct][1]), pk2(-acc[ct][2], -acc[ct][3])};
        }
    }
    __syncthreads();
    {
        const bf16_t* UvT = (const bf16_t*)(smem + RL_LM);
        bf16_t* gAP = (bf16_t*)(rec + RP_AP); bf16_t* gRH = (bf16_t*)(rec + RP_RH); bf16_t* gKH = (bf16_t*)(rec + RP_KH); bf16_t* gYH = (bf16_t*)(rec + RP_YH);
        const int et = w & 3, part = w >> 2;
        {
            const bf16x8 a0 = ldfrag(WaT, TSTR, 16 * et, 0, lane), a1 = ldfrag(WaT, TSTR, 16 * et, 32, lane);
            if (part == 0) {
#pragma unroll
                for (int kt = 0; kt < 4; ++kt) { f32x4 acc = {0.f, 0.f, 0.f, 0.f};
                    acc = MFMA16(a0, ldfrag_tr(Btl, TSTR, 16 * kt, 0, lane), acc); acc = MFMA16(a1, ldfrag_tr(Btl, TSTR, 16 * kt, 32, lane), acc);
                    *(u32x2*)(gAP + ((size_t)(kt * 2 + (et >> 1)) * 64 + lane) * 8 + (et & 1) * 4) = (u32x2){pk2(-acc[0], -acc[1]), pk2(-acc[2], -acc[3])}; }
            } else {
#pragma unroll
                for (int tt = 0; tt < 4; ++tt) { f32x4 acc = {0.f, 0.f, 0.f, 0.f};
                    acc = MFMA16(a0, ldfrag(Mrb, TSTR, 16 * tt, 0, lane), acc); acc = MFMA16(a1, ldfrag(Mrb, TSTR, 16 * tt, 32, lane), acc);
                    const int tk = 16 * tt + l15, e0 = 16 * et + 4 * q4;
                    const u32x2 q2 = *(const u32x2*)(Rt + tk * TSTR + e0);
                    const float o0 = __uint_as_float(q2.x << 16) - acc[0], o1 = __uint_as_float(q2.x & 0xffff0000u) - acc[1], o2 = __uint_as_float(q2.y << 16) - acc[2], o3 = __uint_as_float(q2.y & 0xffff0000u) - acc[3];
                    *(u32x2*)(gRH + ((size_t)(tt * 2 + (et >> 1)) * 64 + lane) * 8 + (et & 1) * 4) = (u32x2){pk2(o0, o1), pk2(o2, o3)}; }
            }
        }
        {
            const int rt = w & 3;
            bf16_t* Out = part ? gKH : gYH;
            bf16x8 a0, a1, a2, a3;
            if (part) { a0 = ldfrag_tr(Btl, TSTR, 16 * rt, 0, lane); a1 = ldfrag_tr(Btl, TSTR, 16 * rt, 32, lane); a2 = ldfrag_tr(Ktl, TSTR, 16 * rt, 0, lane); a3 = ldfrag_tr(Ktl, TSTR, 16 * rt, 32, lane); }
            else { a0 = ldfrag(Mrb, TSTR, 16 * rt, 0, lane); a1 = ldfrag(Mrb, TSTR, 16 * rt, 32, lane); a2 = ldfrag(Mrk, TSTR, 16 * rt, 0, lane); a3 = ldfrag(Mrk, TSTR, 16 * rt, 32, lane); }
#pragma unroll
            for (int vt = 0; vt < 4; ++vt) { f32x4 acc = {0.f, 0.f, 0.f, 0.f};
                acc = MFMA16(a0, ldfrag(UvT, TSTR, 16 * vt, 0, lane), acc); acc = MFMA16(a1, ldfrag(UvT, TSTR, 16 * vt, 32, lane), acc);
                acc = MFMA16(a2, ldfrag_tr(Vr, TSTR, 16 * vt, 0, lane), acc); acc = MFMA16(a3, ldfrag_tr(Vr, TSTR, 16 * vt, 32, lane), acc);
                *(u32x2*)(Out + ((size_t)(vt * 4 + rt) * 64 + lane) * 4) = (u32x2){pk2(acc[0], acc[1]), pk2(acc[2], acc[3])}; }
        }
    }
    __syncthreads();
}

__device__ __forceinline__ void phase_rprep(const Params& p, int seg, unsigned char* smem) {
    const int blk = obid();
    const int n_items = (CPS + (seg == 0 ? 1 : 0)) * 128;
#pragma unroll 1
    for (int it = (blk + (gridDim.x >> 1)) % gridDim.x; it < n_items; it += gridDim.x) {
        const int bh = it & 127, b = bh >> 4, hb = bh & 15; int cl = it >> 7; if (seg != 0) cl += 1;
        unsigned char* rec = p.ws + WS_RP + (size_t)(cl * 128 + bh) * RP_STRIDE;
        const bf16_t* Pb = (const bf16_t*)(p.ws + WS_P);
        bf16_t* phalo2 = (bf16_t*)(p.ws + WS_PHALO);
        if (cl == 0) rwkv_prep_item(p, smem, hb, LEX0, 48, nullptr, nullptr, rec);
        else {
            const int row = b * SEGTOK + (cl - 1) * 64;
            const bf16_t* prow = Pb + (size_t)(row - 1) * NPB;
            if (cl == 1) prow = (seg == 0) ? Pb + (size_t)(LEX0 + NMETA - 1) * NPB : phalo2 + (size_t)(((seg - 1) & 1) * NBATCH + b) * NPB;
            bf16_t* ho = (cl == CPS) ? phalo2 + (size_t)((seg & 1) * NBATCH + b) * NPB : nullptr;
            rwkv_prep_item(p, smem, hb, row, 0, prow, ho, rec);
        }
    }
}

__device__ __forceinline__ void rwkv_scan_block(const Params& p, int seg, unsigned char* smem, int pairidx) {
    const int tid = otid(), w = tid >> 6, lane = tid & 63, q4 = lane >> 4, l15 = lane & 15;
    const int hsel = w >> 2, vt = w & 3;
    const int bh = pairidx * 2 + hsel, b = bh >> 4, hb = bh & 15;
    float* st = p.out + O_RWKV_P + (size_t)bh * 4096;
    f32x4 S[4];
    if (seg) {
#pragma unroll
        for (int mt = 0; mt < 4; ++mt) S[mt] = *(const f32x4*)(st + (size_t)(16 * vt + l15) * 64 + 16 * mt + 4 * q4);
    } else {
#pragma unroll
        for (int mt = 0; mt < 4; ++mt) S[mt] = (f32x4){0.f, 0.f, 0.f, 0.f};
    }
    const int c_lo = seg ? 1 : 0;
    float* ybuf = (float*)(smem + 65536) + hsel * (64 * 68);
    const int tl = tid & 255;
    {
        const u32x4* src = (const u32x4*)(p.ws + WS_RP + (size_t)(c_lo * 128 + bh) * RP_STRIDE); u32x4* dst = (u32x4*)(smem + hsel * 16384);
#pragma unroll
        for (int x = 0; x < 4; ++x) dst[tl + 256 * x] = src[tl + 256 * x];
    }
#pragma unroll 1
    for (int cl = c_lo; cl <= CPS; ++cl) {
        const unsigned char* rec = p.ws + WS_RP + (size_t)(cl * 128 + bh) * RP_STRIDE;
        const int cur = (cl - c_lo) & 1;
        __syncthreads();
        u32x4 nx[4];
        const bool more = cl < CPS;
        if (more) { const u32x4* src = (const u32x4*)(rec + (size_t)RP_STRIDE * 128);
#pragma unroll
            for (int x = 0; x < 4; ++x) nx[x] = src[tl + 256 * x]; }
        const bf16_t* gKH = (const bf16_t*)(rec + RP_KH); const bf16_t* gYH = (const bf16_t*)(rec + RP_YH);
        u32x2 kh[4], yh[4]; f32x4 pc[4];
#pragma unroll
        for (int mt = 0; mt < 4; ++mt) { kh[mt] = *(const u32x2*)(gKH + ((size_t)(vt * 4 + mt) * 64 + lane) * 4); yh[mt] = *(const u32x2*)(gYH + ((size_t)(vt * 4 + mt) * 64 + lane) * 4);
            pc[mt] = *(const f32x4*)((const float*)(rec + RP_PC) + 16 * mt + 4 * q4); }
        const int tk = tl >> 2, g = tl & 3;
        u32x4 a0 = {0u, 0u, 0u, 0u}, a1 = a0, b0 = a0, b1 = a0;
        if (cl > 0) { const bf16_t* c1p = (const bf16_t*)(rec + RP_C1) + tk * 64 + 16 * g; const bf16_t* c0p = (const bf16_t*)(rec + RP_C0) + tk * 64 + 16 * g;
            a0 = *(const u32x4*)c0p; a1 = *(const u32x4*)(c0p + 8); b0 = *(const u32x4*)c1p; b1 = *(const u32x4*)(c1p + 8); }
        bf16x8 Bf[2];
#pragma unroll
        for (int ks = 0; ks < 2; ++ks) { u32x4 tq; tq.x = pk2(S[2 * ks][0], S[2 * ks][1]); tq.y = pk2(S[2 * ks][2], S[2 * ks][3]); tq.z = pk2(S[2 * ks + 1][0], S[2 * ks + 1][1]); tq.w = pk2(S[2 * ks + 1][2], S[2 * ks + 1][3]);
            Bf[ks] = __builtin_bit_cast(bf16x8, tq); }
        const bf16x8* AP = (const bf16x8*)(smem + cur * 32768 + hsel * 16384); const bf16x8* RH = (const bf16x8*)(smem + cur * 32768 + hsel * 16384 + RP_RH);
        f32x4 y[4], tS[4];
#pragma unroll
        for (int tt = 0; tt < 4; ++tt) { y[tt] = (f32x4){0.f, 0.f, 0.f, 0.f}; y[tt] = MFMA16(RH[(tt * 2 + 0) * 64 + lane], Bf[0], y[tt]); y[tt] = MFMA16(RH[(tt * 2 + 1) * 64 + lane], Bf[1], y[tt]); }
#pragma unroll
        for (int mt = 0; mt < 4; ++mt) { tS[mt] = (f32x4){0.f, 0.f, 0.f, 0.f}; tS[mt] = MFMA16(AP[(mt * 2 + 0) * 64 + lane], Bf[0], tS[mt]); tS[mt] = MFMA16(AP[(mt * 2 + 1) * 64 + lane], Bf[1], tS[mt]); }
#pragma unroll
        for (int mt = 0; mt < 4; ++mt) {
            S[mt][0] = pc[mt][0] * S[mt][0] + tS[mt][0] + __uint_as_float(kh[mt].x << 16); S[mt][1] = pc[mt][1] * S[mt][1] + tS[mt][1] + __uint_as_float(kh[mt].x & 0xffff0000u);
            S[mt][2] = pc[mt][2] * S[mt][2] + tS[mt][2] + __uint_as_float(kh[mt].y << 16); S[mt][3] = pc[mt][3] * S[mt][3] + tS[mt][3] + __uint_as_float(kh[mt].y & 0xffff0000u); }
        if (cl > 0) {
#pragma unroll
            for (int tt = 0; tt < 4; ++tt) {
                y[tt][0] += __uint_as_float(yh[tt].x << 16); y[tt][1] += __uint_as_float(yh[tt].x & 0xffff0000u); y[tt][2] += __uint_as_float(yh[tt].y << 16); y[tt][3] += __uint_as_float(yh[tt].y & 0xffff0000u);
#pragma unroll
                for (int r = 0; r < 4; ++r) ybuf[(16 * tt + 4 * q4 + r) * 68 + 16 * vt + l15] = y[tt][r]; }
        }
        if (more) { u32x4* dst = (u32x4*)(smem + (cur ^ 1) * 32768 + hsel * 16384);
#pragma unroll
            for (int x = 0; x < 4; ++x) dst[tl + 256 * x] = nx[x]; }
        if (cl > 0) {
            __syncthreads();
            f32x4 yv[4]; float sm = 0.f;
#pragma unroll
            for (int j = 0; j < 4; ++j) { yv[j] = *(const f32x4*)(ybuf + tk * 68 + 16 * g + 4 * j); sm += yv[j][0] + yv[j][1] + yv[j][2] + yv[j][3]; }
            sm += __shfl_xor(sm, 1); sm += __shfl_xor(sm, 2);
            const float mu = sm * (1.f / 64.f); float vs = 0.f;
#pragma unroll
            for (int j = 0; j < 4; ++j) { yv[j] = yv[j] - mu; vs += yv[j][0] * yv[j][0] + yv[j][1] * yv[j][1] + yv[j][2] * yv[j][2] + yv[j][3] * yv[j][3]; }
            vs += __shfl_xor(vs, 1); vs += __shfl_xor(vs, 2);
            const float rs = __builtin_amdgcn_rsqf(vs * (1.f / 64.f) + 64e-5f);
            const unsigned c0w[8] = {a0.x, a0.y, a0.z, a0.w, a1.x, a1.y, a1.z, a1.w}, c1w[8] = {b0.x, b0.y, b0.z, b0.w, b1.x, b1.y, b1.z, b1.w};
            unsigned ow[8];
#pragma unroll
            for (int j = 0; j < 8; ++j) ow[j] = pk2(yv[j >> 1][(j & 1) * 2] * rs * __uint_as_float(c1w[j] << 16) + __uint_as_float(c0w[j] << 16),
                                                     yv[j >> 1][(j & 1) * 2 + 1] * rs * __uint_as_float(c1w[j] & 0xffff0000u) + __uint_as_float(c0w[j] & 0xffff0000u));
            const size_t grow = (size_t)b * SEQ + seg * SEGTOK + (cl - 1) * 64 + tk;
            bf16_t* ob = (bf16_t*)(p.ws + WS_OB) + grow * D + hb * 64 + 16 * g;
            *(u32x4*)ob = (u32x4){ow[0], ow[1], ow[2], ow[3]}; *(u32x4*)(ob + 8) = (u32x4){ow[4], ow[5], ow[6], ow[7]};
        }
    }
#pragma unroll
    for (int mt = 0; mt < 4; ++mt) *(f32x4*)(st + (size_t)(16 * vt + l15) * 64 + 16 * mt + 4 * q4) = S[mt];
    __syncthreads();
}

__device__ __forceinline__ void gdn_sample_item(const Params& p, unsigned char* smem, int bs, int h) {
    const int tid = otid(), w = tid >> 6, lane = tid & 63, kq = tid >> 7, v = tid & 127;
    float* qk_s = (float*)smem; float* v_s = qk_s + 1024; float* gb_s = v_s + 512; float* part = gb_s + 16; float* part2 = part + 512;
    const bf16_t* P = (const bf16_t*)(p.ws + WS_P);
    const float* pk = (const float*)(p.ws + WS_PK);
    const float* s_in = p.in[2] + (size_t)(bs * 8 + h) * 16384; float* s_out = p.out + O_GDN_S + (size_t)(bs * 8 + h) * 16384;
    const int row0 = LEX0 + EX_SAMP + bs * DECT;
    float s[32];
#pragma unroll
    for (int j = 0; j < 32; ++j) s[j] = s_in[(size_t)(kq * 32 + j) * 128 + v];
    if (tid < 384) {
        const int pcol = (tid >> 7) * 1024 + h * 128 + (tid & 127);
        const float* cw = pk + PK_CONVW; const float* hin = p.in[3] + (size_t)bs * 9216; float* hout = p.out + O_CONV_S + (size_t)bs * 9216;
        const float cw0 = cw[pcol], cw1 = cw[3072 + pcol], cw2 = cw[6144 + pcol], cw3 = cw[9216 + pcol];
        float x3 = hin[pcol], x2 = hin[3072 + pcol], x1 = hin[6144 + pcol];
        float xr[4];
#pragma unroll
        for (int i = 0; i < 4; ++i) xr[i] = bf2f(P[(size_t)(row0 + i) * NPB + pcol]);
#pragma unroll
        for (int i = 0; i < 4; ++i) { const float y = cw0 * x3 + cw1 * x2 + cw2 * x1 + cw3 * xr[i]; x3 = x2; x2 = x1; x1 = xr[i];
            if (tid < 256) qk_s[i * 256 + tid] = silu_(y); else v_s[i * 128 + (tid - 256)] = silu_(y); }
        hout[pcol] = x3; hout[3072 + pcol] = x2; hout[6144 + pcol] = x1;
    } else if (tid < 388) {
        const int i = tid - 384; const size_t r = (size_t)(row0 + i) * NPB;
        const float pa = bf2f(P[r + C_A + h]), pb = bf2f(P[r + C_B + h]);
        gb_s[2 * i] = __expf(-expf(pk[PK_ALOG + h]) * softplus_(pa + pk[PK_DTB + h])); gb_s[2 * i + 1] = sigm(pb);
    }
    __syncthreads();
    { const int i = w >> 1, which = w & 1; float* rp = qk_s + i * 256 + which * 128; const float a = rp[lane], b = rp[lane + 64];
      const float sc = __builtin_amdgcn_rsqf(wave_sum(a * a + b * b) + 1e-6f) * (which == 0 ? 0.08838834764831845f : 1.f); rp[lane] = a * sc; rp[lane + 64] = b * sc; }
    __syncthreads();
#pragma unroll 1
    for (int i = 0; i < 4; ++i) {
        const float* kp = qk_s + i * 256 + 128 + kq * 32; const float* qp = qk_s + i * 256 + kq * 32;
        float pa = 0.f;
#pragma unroll
        for (int j4 = 0; j4 < 8; ++j4) { const f32x4 k4 = *(const f32x4*)(kp + 4 * j4); pa += k4[0] * s[4 * j4] + k4[1] * s[4 * j4 + 1] + k4[2] * s[4 * j4 + 2] + k4[3] * s[4 * j4 + 3]; }
        part[kq * 128 + v] = pa;
        __syncthreads();
        const float kS = part[v] + part[128 + v] + part[256 + v] + part[384 + v];
        const float a = gb_s[2 * i], c = gb_s[2 * i + 1] * (v_s[i * 128 + v] - a * kS);
        float po = 0.f;
#pragma unroll
        for (int j4 = 0; j4 < 8; ++j4) { const f32x4 k4 = *(const f32x4*)(kp + 4 * j4), q4v = *(const f32x4*)(qp + 4 * j4);
#pragma unroll
            for (int e = 0; e < 4; ++e) { s[4 * j4 + e] = a * s[4 * j4 + e] + k4[e] * c; po += q4v[e] * s[4 * j4 + e]; } }
        part2[kq * 128 + v] = po;
        __syncthreads();
        if (kq == 0) ((float*)(p.ws + WS_ORAW))[(size_t)(row0 + i) * D + h * 128 + v] = part2[v] + part2[128 + v] + part2[256 + v] + part2[384 + v];
    }
#pragma unroll
    for (int j = 0; j < 32; ++j) s_out[(size_t)(kq * 32 + j) * 128 + v] = s[j];
    __syncthreads();
}

constexpr int SR_R = 0, SR_KK = 4096, SR_V = 8192, SR_ZB = 12288, SR_DEC = 16384, SR_KA = 20480, SR_KM = 24576, SR_WD = 28672, SR_AD = 28928, SR_RK = 29184;
__device__ __forceinline__ void rwkv_sample_item(const Params& p, unsigned char* smem, int bs) {
    const int tid = otid(), w = tid >> 6, lane = tid & 63;
    float* f = (float*)smem;
    const bf16_t* P = (const bf16_t*)(p.ws + WS_P);
    const float* pk = (const float*)(p.ws + WS_PK);
    const int row0 = LEX0 + EX_SAMP + bs * DECT;
    const bf16_t* prow = P + (size_t)(LEX0 + EX_SHIFT + bs) * NPB + C_RW;
#pragma unroll 1
    for (int col = tid; col < RW_SHIFT; col += 512) {
        const float mu = pk[PK_MU + col]; float prev = bf2f(prow[col]);
        float cur[4];
#pragma unroll
        for (int i = 0; i < 4; ++i) cur[i] = bf2f(P[(size_t)(row0 + i) * NPB + C_RW + col]);
        float* dst; int stride = 1024; bool th = false;
        if (col < 1024) dst = f + SR_R + col; else if (col < 2048) dst = f + SR_KK + (col - 1024); else if (col < 3072) dst = f + SR_V + (col - 2048);
        else if (col < 3136) { dst = f + SR_WD + (col - 3072); stride = 64; th = true; } else if (col < 3200) { dst = f + SR_AD + (col - 3136); stride = 64; } else dst = f + SR_ZB + (col - 3200);
#pragma unroll
        for (int i = 0; i < 4; ++i) { float m = cur[i] + mu * (prev - cur[i]); prev = cur[i]; if (th) m = tanh_(m); dst[i * stride] = m; }
    }
    __syncthreads();
#pragma unroll 1
    for (int cc = 0; cc < 2; ++cc) {
        const int c = tid + 512 * cc;
        float aw[4] = {0.f, 0.f, 0.f, 0.f}, aa[4] = {0.f, 0.f, 0.f, 0.f};
#pragma unroll 16
        for (int l = 0; l < 64; ++l) { const float w2v = pk[PK_W2 + l * D + c], a2v = pk[PK_A2 + l * D + c];
#pragma unroll
            for (int i = 0; i < 4; ++i) { aw[i] += f[SR_WD + i * 64 + l] * w2v; aa[i] += f[SR_AD + i * 64 + l] * a2v; } }
        const float w0c = pk[PK_W0 + c], a0c = pk[PK_A0 + c], kkc = pk[PK_KK + c], kac = pk[PK_KA + c];
#pragma unroll
        for (int i = 0; i < 4; ++i) { const float a = sigm(a0c + aa[i]); const float kbv = f[SR_KK + i * 1024 + c];
            f[SR_DEC + i * 1024 + c] = __expf(-0.6065306597126334f * sigm(w0c + aw[i])); f[SR_KA + i * 1024 + c] = a; f[SR_KK + i * 1024 + c] = kbv * kkc; f[SR_KM + i * 1024 + c] = kbv * (1.f + (a - 1.f) * kac); }
    }
    __syncthreads();
#pragma unroll 1
    for (int x = 0; x < 8; ++x) { const int pr = w * 8 + x, i = pr >> 4, hh = pr & 15; const int o = i * 1024 + hh * 64 + lane;
        const float kr = f[SR_KK + o]; const float kk = kr * __builtin_amdgcn_rsqf(wave_sum(kr * kr) + 1e-6f); f[SR_KK + o] = kk; f[SR_KA + o] = kk * f[SR_KA + o];
        const float rkv = wave_sum(f[SR_R + o] * f[SR_KM + o] * pk[PK_RK + hh * 64 + lane]); if (lane == 0) f[SR_RK + pr] = rkv; }
    __syncthreads();
#pragma unroll 1
    for (int hp = 0; hp < 2; ++hp) {
        const int hb = hp * 8 + w;
        const float* s_in = p.in[4] + (size_t)(bs * 16 + hb) * 4096 + (size_t)lane * 64; float* s_out = p.out + O_RWKV_S + (size_t)(bs * 16 + hb) * 4096 + (size_t)lane * 64;
        f32x4 S[16];
#pragma unroll
        for (int j = 0; j < 16; ++j) S[j] = *(const f32x4*)(s_in + 4 * j);
        const int cch = hb * 64 + lane;
        const float gnw = pk[PK_GNW + cch], gnb = pk[PK_GNB + cch];
#pragma unroll 1
        for (int i = 0; i < 4; ++i) {
            const int o = i * 1024 + hb * 64;
            const float vv = f[SR_V + o + lane], rk = f[SR_RK + i * 16 + hb];
            float sa = 0.f;
#pragma unroll
            for (int j = 0; j < 16; ++j) { const f32x4 kk4 = *(const f32x4*)(f + SR_KK + o + 4 * j); sa += S[j][0] * kk4[0] + S[j][1] * kk4[1] + S[j][2] * kk4[2] + S[j][3] * kk4[3]; }
            float y = 0.f;
#pragma unroll
            for (int j = 0; j < 16; ++j) { const f32x4 de4 = *(const f32x4*)(f + SR_DEC + o + 4 * j), ka4 = *(const f32x4*)(f + SR_KA + o + 4 * j), km4 = *(const f32x4*)(f + SR_KM + o + 4 * j), r4 = *(const f32x4*)(f + SR_R + o + 4 * j);
#pragma unroll
                for (int e = 0; e < 4; ++e) { S[j][e] = S[j][e] * de4[e] + (vv * km4[e] - sa * ka4[e]); y += S[j][e] * r4[e]; } }
            const float mu = wave_sum(y) * (1.f / 64.f); const float dy = y - mu;
            const float rs = __builtin_amdgcn_rsqf(wave_sum(dy * dy) * (1.f / 64.f) + 64e-5f);
            const float ov = (dy * rs * gnw + gnb + rk * vv) * silu_(f[SR_ZB + i * 1024 + cch]);
            ((bf16_t*)(p.ws + WS_OB))[(size_t)(XROWS + EX_SAMP + bs * DECT + i) * D + cch] = (bf16_t)f2bf(ov);
        }
#pragma unroll
        for (int j = 0; j < 16; ++j) *(f32x4*)(s_out + 4 * j) = S[j];
    }
    __syncthreads();
}

__device__ __forceinline__ void phase2(const Params& p, int seg, unsigned char* smem) {
    const int blk = obid();
    float* out = p.out;
    float* chalo = (float*)(p.ws + WS_CHALO); float* phalo = (float*)(p.ws + WS_PHALO);
#ifndef SUB
#define SUB 0
#endif
#define SEN(x) (SUB == 0 || SUB == (x))
    if (SEN(1) && blk < 64) gdn_scan_block(p, seg, smem, blk);
    if (SEN(3) && blk >= 64 && blk < 128) rwkv_scan_block(p, seg, smem, blk - 64);
#ifndef DUP
#define DUP 0
#endif
    if (seg == 0) {
#pragma unroll 1
        for (int it = blk; it < DECB * 8; it += gridDim.x) gdn_sample_item(p, smem, it >> 3, it & 7);
#pragma unroll 1
        for (int it = blk; it < DECB; it += gridDim.x) rwkv_sample_item(p, smem, it);
    }
}

__device__ __forceinline__ void phase25(const Params& p, int seg) {
    const int tid0 = otid(); const int lane = tid0 & 63; const int gw = obid() * 8 + (tid0 >> 6), NGW = gridDim.x * 8;
    const bf16_t* P = (const bf16_t*)(p.ws + WS_P);
    const float* ORAW = (const float*)(p.ws + WS_ORAW); const float* YRAW = (const float*)(p.ws + WS_YRAW);
    const bf16_t* C0 = (const bf16_t*)(p.ws + WS_C0); const bf16_t* C1 = (const bf16_t*)(p.ws + WS_C1);
    bf16_t* OA = (bf16_t*)(p.ws + WS_H); bf16_t* OB = (bf16_t*)(p.ws + WS_OB);
    const int nrows = LEX0 + (seg == 0 ? DECB * DECT : 0);
    const int c = lane * 16;
    f32x4 nw[4];
#pragma unroll
    for (int j = 0; j < 4; ++j) nw[j] = *(const f32x4*)((const float*)(p.ws + WS_PK) + PK_NORMW + (c & 127) + 4 * j);
#pragma unroll 1
    for (int rr = LEX0 + gw; rr < nrows; rr += NGW) {
        int lr; size_t grow;
        if (rr < LEX0) { lr = rr; grow = (size_t)(rr / SEGTOK) * SEQ + seg * SEGTOK + (rr % SEGTOK); } else { lr = LEX0 + EX_SAMP + (rr - LEX0); grow = (size_t)XROWS + EX_SAMP + (rr - LEX0); }
        {
            f32x4 o[4]; float ss = 0.f;
#pragma unroll
            for (int j = 0; j < 4; ++j) { o[j] = *(const f32x4*)(ORAW + (size_t)lr * D + c + 4 * j); ss += o[j][0] * o[j][0] + o[j][1] * o[j][1] + o[j][2] * o[j][2] + o[j][3] * o[j][3]; }
            ss += __shfl_xor(ss, 1); ss += __shfl_xor(ss, 2); ss += __shfl_xor(ss, 4);
            const float rs = __builtin_amdgcn_rsqf(ss * (1.f / 128.f) + 1e-6f);
            const u32x4 z0 = *(const u32x4*)(P + (size_t)lr * NPB + C_Z + c), z1 = *(const u32x4*)(P + (size_t)lr * NPB + C_Z + c + 8);
            const unsigned zz[8] = {z0.x, z0.y, z0.z, z0.w, z1.x, z1.y, z1.z, z1.w};
            unsigned ow[8];
#pragma unroll
            for (int j = 0; j < 8; ++j) { const float za = __uint_as_float(zz[j] << 16), zb = __uint_as_float(zz[j] & 0xffff0000u);
                const float a = o[j >> 1][(j & 1) * 2] * rs * nw[j >> 1][(j & 1) * 2] * silu_(za), b = o[j >> 1][(j & 1) * 2 + 1] * rs * nw[j >> 1][(j & 1) * 2 + 1] * silu_(zb);
                ow[j] = pk2(a, b); }
            *(u32x4*)(OA + grow * D + c) = (u32x4){ow[0], ow[1], ow[2], ow[3]}; *(u32x4*)(OA + grow * D + c + 8) = (u32x4){ow[4], ow[5], ow[6], ow[7]};
        }
    }
}

__device__ __forceinline__ void phase_final(const Params& p) {
    const int tid0 = otid(); const int lane = tid0 & 63; const int gw = obid() * 8 + (tid0 >> 6), NGW = gridDim.x * 8;
    const f32x4* wr = (const f32x4*)((const float*)(p.ws + WS_PK) + PK_LNF) + lane;
    f32x4 wv[4];
#pragma unroll
    for (int j = 0; j < 4; ++j) wv[j] = wr[64 * j];
    constexpr int NR = XROWS + DECB * DECT;
#pragma unroll 1
    for (int r = gw; r < NR; r += 4 * NGW) {
        f32x4* xr[4]; bool has[4]; f32x4 v[4][4]; float ss[4];
#pragma unroll
        for (int q = 0; q < 4; ++q) { const int rq = r + q * NGW; has[q] = rq < NR; xr[q] = (f32x4*)(p.out + (size_t)(has[q] ? rq : r) * D) + lane; }
#pragma unroll
        for (int q = 0; q < 4; ++q)
#pragma unroll
            for (int j = 0; j < 4; ++j) v[q][j] = xr[q][64 * j];
#pragma unroll
        for (int q = 0; q < 4; ++q) { float s0 = 0.f;
#pragma unroll
            for (int j = 0; j < 4; ++j) s0 += v[q][j][0] * v[q][j][0] + v[q][j][1] * v[q][j][1] + v[q][j][2] * v[q][j][2] + v[q][j][3] * v[q][j][3];
            ss[q] = s0; }
#pragma unroll
        for (int q = 0; q < 4; ++q) { const float qs = __builtin_amdgcn_rsqf(wave_sum(ss[q]) * (1.f / D) + 1e-6f);
            if (has[q]) {
#pragma unroll
                for (int j = 0; j < 4; ++j) xr[q][64 * j] = v[q][j] * qs * wv[j]; } }
    }
}

__global__ __launch_bounds__(512, 2) void hybrid_mega(Params p) {
    extern __shared__ __attribute__((aligned(16))) unsigned char smem[];
    cg::grid_group grid = cg::this_grid();
    LAS unsigned char* lds = (LAS unsigned char*)smem;
    const int G = gridDim.x;
    volatile LAS unsigned* xst = (volatile LAS unsigned*)(lds + (LDS_TOTAL - 16));
    if (threadIdx.x == 0) { xst[0] = 0u; xst[1] = 0u; }
    __syncthreads();
    (void)xcd_barrier_post((unsigned*)(p.ws + WS_BAR), xst);
    if (G == 0x7fffffff) grid.sync();
#define GSYNC() do { XcdBarrier xb_; xb_.bar = (unsigned*)(p.ws + WS_BAR); xb_.x = xb_xcc_id(); xb_.st = (volatile LAS unsigned*)((LAS unsigned char*)smem + (LDS_TOTAL - 16)); xcd_barrier(xb_); } while (0)

#ifndef ONLY
#define ONLY 0
#endif
#define EN(x) (ONLY == 0 || ONLY == (x))
    if (EN(1)) phase0(p, smem);
    GSYNC();
#pragma unroll 1
    for (int it = 0; it <= NSEG + 2; ++it) {
        const int xblk = obid() - (G - 12);
        const bool xrole = xblk >= 0;
        if (it > 0 && it <= NSEG && EN(3)) phase2(p, it - 1, smem);
        if ((((it == 2 || it == 3) && xrole) || it == NSEG + 1) && EN(5)) {
            const bool ex = it <= 3;
            SchedAB S; S.ob.init(ex ? 3 : XROWS / 256, 4, ex ? 12 : G, ex ? xblk : obid()); S.pm0 = ex ? XROWS / 256 : 0; S.wfix = ex ? it - 2 : -1;
            S.A0 = (const char*)(p.ws + WS_H); S.A1 = (const char*)(p.ws + WS_OB); S.B0 = (const char*)(p.ws + WS_WT_A); S.B1 = (const char*)(p.ws + WS_WT_B);
            EpiAB E; E.tmp = ex ? (bf16_t*)(p.ws + WS_YRAW) - (size_t)XROWS * D : (bf16_t*)(p.ws + WS_P); E.merged = ex ? (bf16_t*)(p.ws + WS_C0) - (size_t)XROWS * D : (bf16_t*)(p.ws + WS_MG);
            E.gex = (const bf16_t*)(p.ws + WS_GEX); E.out = p.out; E.pairmode = ex ? 0 : 1;
            pg8::gemm_phase<EpiAB, SchedAB>(lds, D, S, E);
        }
        if (((it == 4 && xrole) || it == NSEG + 2) && EN(6)) {
            const bool ex = it == 4;
            SchedO S; S.ob.init(ex ? 3 : XROWS / 256, 4, ex ? 12 : G, ex ? xblk : obid()); S.pm0 = ex ? XROWS / 256 : 0;
            S.A = ex ? (const char*)((bf16_t*)(p.ws + WS_C0) - (size_t)XROWS * D) : (const char*)(p.ws + WS_MG); S.B = (const char*)(p.ws + WS_WT_O);
            EpiO E; E.out = p.out; E.xp = p.in[0]; E.xs = p.in[1]; E.lnf = (const float*)(p.ws + WS_PK) + PK_LNF; E.xch = (float*)(p.ws + WS_XCH); E.cnt = (unsigned*)(p.ws + WS_BAR + BAR_CNT_OFF);
            pg8::gemm_phase<EpiO, SchedO>(lds, D, S, E);
        }
        const bool xphase = it >= 2 && it <= 4;
        if (it < NSEG && EN(2) && !(xphase && xrole)) {
            const int seg = it;
            const int Gp = xphase ? G - 12 : G;
            const int cidx = it > 0 ? (obid() + (Gp >> 1)) % Gp : obid();
            SchedIn S; S.ob.init(seg == 0 ? LT_PROMPT + 3 : LT_PROMPT, NT_IN, Gp, cidx); S.seg = seg; S.A = (const char*)(p.ws + WS_H); S.B = (const char*)(p.ws + WS_WT_IN);
            EpiIn E; E.P = (bf16_t*)(p.ws + WS_P); E.gex = (bf16_t*)(p.ws + WS_GEX); E.out = p.out; E.seg = seg;
            pg8::gemm_phase<EpiIn, SchedIn>(lds, D, S, E);
        }
        {
            const int hlo = 208, hhi = (it >= 2 && it <= 4) ? G - 12 : G;
            if (it >= 1 && it + 1 < NSEG && obid() >= hlo && obid() < hhi) { const int t0 = otid(); h_rows_segs(p, it + 1, it + 2, (obid() - hlo) * 8 + (t0 >> 6), (hhi - hlo) * 8, t0 & 63); }
        }
        if (it <= NSEG + 1) GSYNC();
        if (it < NSEG) {
            if (EN(8)) { phase_gprep(p, it, smem); phase_rprep(p, it, smem); }
            if (it == 1 && EN(4)) phase25(p, 0);
            GSYNC();
        }
    }
}

extern "C" void kernel_launch(void* const* d_in, const int* in_sizes, int n_in, void* d_out, int out_size, void* d_ws, size_t ws_size, hipStream_t stream) {
    static int grid_blocks = 0;
    constexpr int LDS_BYTES = LDS_TOTAL;
    if (grid_blocks == 0) {
        if (n_in != 27 || ws_size < WS_END) { fprintf(stderr, "kernel_launch: unexpected n_in %d / ws %zu (need %zu)\n", n_in, ws_size, (size_t)WS_END); grid_blocks = -1; return; }
        if (hipFuncSetAttribute((const void*)hybrid_mega, hipFuncAttributeMaxDynamicSharedMemorySize, LDS_BYTES) != hipSuccess) { fprintf(stderr, "kernel_launch: hipFuncSetAttribute failed\n"); grid_blocks = -1; return; }
        int dev = 0, cus = 0, per_cu = 0;
        hipGetDevice(&dev);
        hipDeviceGetAttribute(&cus, hipDeviceAttributeMultiprocessorCount, dev);
        hipOccupancyMaxActiveBlocksPerMultiprocessor(&per_cu, (const void*)hybrid_mega, 512, LDS_BYTES);
        if (per_cu < 1) { fprintf(stderr, "kernel_launch: occupancy query says %d blocks/CU\n", per_cu); per_cu = 1; }
        (void)hipGetLastError();
        grid_blocks = cus;
    }
    if (grid_blocks < 0) return;
    Params p{};
    for (int i = 0; i < 27; ++i) p.in[i] = (const float*)d_in[i];
    p.out = (float*)d_out; p.ws = (unsigned char*)d_ws;
    if (hipMemsetAsync((unsigned char*)d_ws + WS_BAR, 0, 16384, stream) != hipSuccess) { fprintf(stderr, "kernel_launch: memset of the barrier words failed\n"); return; }
    void* args[] = {&p};
    hipError_t e = hipLaunchCooperativeKernel((const void*)hybrid_mega, dim3(grid_blocks), dim3(512), args, LDS_BYTES, stream);
    if (e != hipSuccess) fprintf(stderr, "cooperative launch failed: %s (grid %d)\n", hipGetErrorString(e), grid_blocks);
}
```
